# Optimizing an MI355X kernel written in HIP

```python
import jax, jax.numpy as jnp
from jax import lax
import numpy as np

D_MODEL = 1024
BATCH = 8
SEQ = 4096
DEPTH = 2
DEC_BATCH = 1
DEC_SEQ = 16384
PAST_LEN = 128

HEAD_DIM = 64
N_META = 16
GRID_W = 64
BLOCK = 128
RMS_EPS = 1e-6
A_HEADS = 12
A_KV_HEADS = 4
A_THETA = 10000.0
B_GROUPS = 4
B_DIM = 64
C_HEADS = 8
C_KV_HEADS = 2
WINDOW = 128
ROPE_THETA = 500000.0
ROPE_DIMS = HEAD_DIM // 4
D_HEADS = 8
D_WIDTH = D_HEADS * HEAD_DIM
DECAY_RANK = 64
ICLR_RANK = 64
GATE_RANK = 128
LNX_EPS = 64e-5
D_FF = ((8 * D_MODEL // 3 + 255) // 256) * 256
N_EVEN = (DEPTH + 1) // 2
N_ODD = DEPTH // 2
A_Q = A_HEADS * HEAD_DIM
A_KV = A_KV_HEADS * HEAD_DIM
B_W = B_GROUPS * B_DIM
EVEN_IN = A_Q + 2 * A_KV + B_W
EVEN_OUT = A_Q + B_W
C_Q = C_HEADS * HEAD_DIM
C_KV = C_KV_HEADS * HEAD_DIM
D_IN = 3 * D_WIDTH + 2 * DECAY_RANK + 2 * ICLR_RANK + GATE_RANK
ODD_IN = C_Q + 2 * C_KV + D_IN
ODD_OUT = C_Q + D_WIDTH
D_SPLITS = (D_WIDTH, 2 * D_WIDTH, 3 * D_WIDTH,
            3 * D_WIDTH + DECAY_RANK, 3 * D_WIDTH + 2 * DECAY_RANK,
            3 * D_WIDTH + 2 * DECAY_RANK + ICLR_RANK, 3 * D_WIDTH + 2 * DECAY_RANK + 2 * ICLR_RANK)

kernel_name = 'hybrid_axialgqa_fnet_swa_rwkv7_encoder'


def rms_norm(x, g):
    xf = x.astype(jnp.float32)
    return xf * lax.rsqrt(jnp.mean(xf * xf, axis=-1, keepdims=True) + RMS_EPS) * g.astype(jnp.float32)


def rotate_half(x, ang):
    c = jnp.cos(ang)[:, None, :]
    s = jnp.sin(ang)[:, None, :]
    h = x.shape[-1] // 2
    x1, x2 = x[..., :h], x[..., h:]
    return jnp.concatenate([x1 * c - x2 * s, x1 * s + x2 * c], axis=-1)


def axial_angles(n_tok):
    rows = n_tok // GRID_W
    row = jnp.repeat(jnp.arange(rows), GRID_W)
    col = jnp.arange(rows * GRID_W) % GRID_W
    meta = jnp.arange(N_META) - N_META
    row = jnp.concatenate([meta, row]).astype(jnp.float32)
    col = jnp.concatenate([meta, col]).astype(jnp.float32)
    half = HEAD_DIM // 2
    inv = A_THETA ** (-jnp.arange(0, half, 2, dtype=jnp.float32) / half)
    return row[:, None] * inv, col[:, None] * inv


def partial_angles(n_pos):
    inv = ROPE_THETA ** (-jnp.arange(0, ROPE_DIMS, 2, dtype=jnp.float32) / ROPE_DIMS)
    return jnp.arange(n_pos, dtype=jnp.float32)[:, None] * inv


def dense_attention(qb, k, v):
    s = jnp.einsum('bqhgd,bshd->bhgqs', qb, k)
    p = jax.nn.softmax(s, axis=-1)
    return jnp.einsum('bhgqs,bshd->bqhgd', p, v)


def mixer_a(qa, ka, va, ang_row, ang_col, q_gain, k_gain):
    B, L = qa.shape[:2]
    G = A_HEADS // A_KV_HEADS
    half = HEAD_DIM // 2
    q = rms_norm(qa, q_gain)
    k = rms_norm(ka, k_gain)
    q = jnp.concatenate([rotate_half(q[..., :half], ang_row), rotate_half(q[..., half:], ang_col)], axis=-1) * HEAD_DIM ** -0.5
    k = jnp.concatenate([rotate_half(k[..., :half], ang_row), rotate_half(k[..., half:], ang_col)], axis=-1)
    v = va.astype(jnp.float32)
    q = q.reshape(B, L, A_KV_HEADS, G, HEAD_DIM)
    out_meta = dense_attention(q[:, :N_META], k, v)
    nb = (L - N_META) // BLOCK
    q_blocks = jnp.moveaxis(q[:, N_META:].reshape(B, nb, BLOCK, A_KV_HEADS, G, HEAD_DIM), 1, 0)
    out_real = lax.map(lambda qb: dense_attention(qb, k, v), q_blocks)
    out_real = jnp.moveaxis(out_real, 0, 1).reshape(B, L - N_META, A_KV_HEADS, G, HEAD_DIM)
    return jnp.concatenate([out_meta, out_real], axis=1).reshape(B, L, A_Q)


def mixer_b(fb, norm_g, w_lin, b_lin):
    B, L = fb.shape[:2]
    f = rms_norm(fb, norm_g)
    spec = jnp.fft.fft2(f, axes=(1, 3), norm='ortho').real.astype(jnp.float32)
    y = jnp.einsum('blgc,gcd->blgd', spec, w_lin) + b_lin
    return y.reshape(B, L, B_W)


def partial_rope(x, ang):
    return jnp.concatenate([rotate_half(x[..., :ROPE_DIMS], ang), x[..., ROPE_DIMS:]], axis=-1)


def attend_with_sink(s, mask, sink):
    s = jnp.where(mask, s, -jnp.inf)
    sk = jnp.broadcast_to(sink[:, :, None, None], s.shape[:-1] + (1,))
    return jax.nn.softmax(jnp.concatenate([s, sk], axis=-1), axis=-1)[..., :-1]


def mixer_c(qc, kc, vc, ang, sink):
    B, L = qc.shape[:2]
    S = L - N_META
    nb = S // BLOCK
    G = C_HEADS // C_KV_HEADS
    q = partial_rope(qc.astype(jnp.float32), ang) * HEAD_DIM ** -0.5
    k = partial_rope(kc.astype(jnp.float32), ang)
    v = vc.astype(jnp.float32)
    q = q.reshape(B, L, C_KV_HEADS, G, HEAD_DIM)
    sink = sink.astype(jnp.float32).reshape(C_KV_HEADS, G)
    pos_m = jnp.arange(N_META)
    t0 = jnp.arange(BLOCK)
    mask_m = jnp.concatenate([jnp.ones((N_META, N_META), bool),
                              (t0[None, :] + N_META - pos_m[:, None]) <= WINDOW], axis=1)
    k_m = jnp.concatenate([k[:, :N_META], k[:, N_META:N_META + BLOCK]], axis=1)
    v_m = jnp.concatenate([v[:, :N_META], v[:, N_META:N_META + BLOCK]], axis=1)
    s_m = jnp.einsum('bqhgd,bshd->bhgqs', q[:, :N_META], k_m)
    p_m = attend_with_sink(s_m, mask_m, sink)
    out_meta = jnp.einsum('bhgqs,bshd->bqhgd', p_m, v_m).reshape(B, N_META, C_Q)

    def band(t):
        tp = jnp.pad(t[:, N_META:], ((0, 0), (BLOCK, BLOCK), (0, 0), (0, 0)))
        tp = tp.reshape(B, nb + 2, BLOCK, C_KV_HEADS, HEAD_DIM)
        win = jnp.concatenate([tp[:, :-2], tp[:, 1:-1], tp[:, 2:]], axis=2)
        lead = jnp.broadcast_to(t[:, None, :N_META], (B, nb, N_META, C_KV_HEADS, HEAD_DIM))
        return jnp.concatenate([lead, win], axis=2)

    k_b, v_b = band(k), band(v)
    c = jnp.arange(nb)[:, None, None]
    i = jnp.arange(BLOCK)[None, :, None]
    j = jnp.arange(3 * BLOCK)[None, None, :]
    tq = c * BLOCK + i
    tk = (c - 1) * BLOCK + j
    mask_band = (jnp.abs(tq - tk) <= WINDOW) & (tk >= 0) & (tk < S)
    mask_r = jnp.concatenate([jnp.ones((nb, BLOCK, N_META), bool), mask_band], axis=-1)
    q_r = q[:, N_META:].reshape(B, nb, BLOCK, C_KV_HEADS, G, HEAD_DIM)
    s_r = jnp.einsum('bnqhgd,bnshd->bnhgqs', q_r, k_b)
    p_r = attend_with_sink(s_r, mask_r[:, None, None], sink)
    out_real = jnp.einsum('bnhgqs,bnshd->bnqhgd', p_r, v_b).reshape(B, S, C_Q)
    return jnp.concatenate([out_meta, out_real], axis=1)


def wkv_scan(r, w, k, v, a, b, reverse):
    B, L, H, N = r.shape
    xs = tuple(jnp.moveaxis(t, 1, 0) for t in (r, w, k, v, a, b))

    def step(S, inp):
        rt, wt, kt, vt, at, bt = inp
        sa = jnp.einsum('bhij,bhj->bhi', S, at)
        S = S * wt[:, :, None, :] + sa[..., None] * bt[:, :, None, :] + vt[..., None] * kt[:, :, None, :]
        return S, jnp.einsum('bhij,bhj->bhi', S, rt)

    S0 = jnp.zeros((B, H, N, N), jnp.float32)
    _, o = lax.scan(step, S0, xs, reverse=reverse)
    return jnp.moveaxis(o, 0, 1)


def mixer_d(u, mu_prev, mu_next, w0, w_up, a0, a_up, g_up, k_k, k_a, r_k, ln_g, ln_b):
    B, L, _ = u.shape
    u = u.astype(jnp.float32)
    u_prev = jnp.pad(u, ((0, 0), (1, 0), (0, 0)))[:, :-1]
    u_next = jnp.pad(u, ((0, 0), (0, 1), (0, 0)))[:, 1:]
    u = u + mu_prev * (u_prev - u) + mu_next * (u_next - u)
    r, k, v, wfd, wbd, afd, abd, gd = jnp.split(u, D_SPLITS, axis=-1)
    heads = lambda t: t.reshape(B, L, D_HEADS, HEAD_DIM)
    g = jax.nn.sigmoid(gd) @ g_up
    kk = heads(k * k_k)
    kk = kk * lax.rsqrt(jnp.maximum(jnp.sum(kk * kk, axis=-1, keepdims=True), 1e-24))
    r, k, v = heads(r), heads(k), heads(v)
    k_a = k_a.reshape(D_HEADS, HEAD_DIM)
    outs = []
    bonuses = []
    for d, (wd, ad) in enumerate(((wfd, afd), (wbd, abd))):
        w_log = -jax.nn.softplus(-(w0[d] + jnp.tanh(wd) @ w_up[d])) - 0.5
        decay = heads(jnp.exp(-jnp.exp(w_log)))
        a = heads(jax.nn.sigmoid(a0[d] + ad @ a_up[d]))
        kd = k * (1.0 + (a - 1.0) * k_a)
        outs.append(wkv_scan(r, decay, kd, v, -kk, kk * a, reverse=(d == 1)))
        bonuses.append(jnp.sum(r * kd * r_k, axis=-1, keepdims=True) * v)
    o = outs[0] + outs[1]
    mean = jnp.mean(o, axis=-1, keepdims=True)
    var = jnp.mean(jnp.square(o - mean), axis=-1, keepdims=True)
    y = (o - mean) * lax.rsqrt(var + LNX_EPS) * ln_g.reshape(D_HEADS, HEAD_DIM) + ln_b.reshape(D_HEADS, HEAD_DIM)
    y = y + bonuses[0] + bonuses[1]
    return y.reshape(B, L, D_WIDTH) * g


def swiglu(h, w_gate, w_up, w_down):
    return (jax.nn.silu(h @ w_gate) * (h @ w_up)) @ w_down


def trunk(x, p):
    B, S, _ = x.shape
    L = S + N_META
    meta = jnp.broadcast_to(p['meta_tokens'].astype(x.dtype)[None], (B, N_META, D_MODEL))
    h = jnp.concatenate([meta, x], axis=1)
    ang_row, ang_col = axial_angles(S)
    ang_1d = partial_angles(L)
    for i in range(DEPTH):
        hn = rms_norm(h, p['pre_mix_g'][i])
        if i % 2 == 0:
            e = i // 2
            proj = hn @ p['even_w_in'][e]
            qa = proj[..., :A_Q].reshape(B, L, A_HEADS, HEAD_DIM)
            ka = proj[..., A_Q:A_Q + A_KV].reshape(B, L, A_KV_HEADS, HEAD_DIM)
            va = proj[..., A_Q + A_KV:A_Q + 2 * A_KV].reshape(B, L, A_KV_HEADS, HEAD_DIM)
            fb = proj[..., A_Q + 2 * A_KV:].reshape(B, L, B_GROUPS, B_DIM)
            ya = mixer_a(qa, ka, va, ang_row, ang_col, p['a_q_gain'][e], p['a_k_gain'][e])
            yb = mixer_b(fb, p['b_norm_g'][e], p['b_w'][e], p['b_b'][e])
            mix = jnp.concatenate([ya, yb], axis=-1) @ p['even_w_out'][e]
        else:
            o = i // 2
            proj = hn @ p['odd_w_in'][o]
            qc = proj[..., :C_Q].reshape(B, L, C_HEADS, HEAD_DIM)
            kc = proj[..., C_Q:C_Q + C_KV].reshape(B, L, C_KV_HEADS, HEAD_DIM)
            vc = proj[..., C_Q + C_KV:C_Q + 2 * C_KV].reshape(B, L, C_KV_HEADS, HEAD_DIM)
            yc = mixer_c(qc, kc, vc, ang_1d, p['c_sink'][o])
            yd = mixer_d(proj[..., C_Q + 2 * C_KV:], p['d_mu_prev'][o], p['d_mu_next'][o],
                         p['d_w0'][o], p['d_w_up'][o], p['d_a0'][o], p['d_a_up'][o], p['d_g_up'][o],
                         p['d_k_k'][o], p['d_k_a'][o], p['d_r_k'][o], p['d_ln_g'][o], p['d_ln_b'][o])
            mix = jnp.concatenate([yc, yd], axis=-1) @ p['odd_w_out'][o]
        h = h + rms_norm(mix, p['post_mix_g'][i]).astype(h.dtype)
        hn = rms_norm(h, p['pre_ffn_g'][i])
        f = swiglu(hn, p['ffn_w_gate'][i], p['ffn_w_up'][i], p['ffn_w_down'][i])
        h = h + rms_norm(f, p['post_ffn_g'][i]).astype(h.dtype)
    return h[:, N_META:]


def setup_inputs(seed: int = 0) -> dict:
    key = jax.random.key(seed)
    ks = jax.random.split(key, 32)

    def nrm(i, shape, scale):
        return jax.random.normal(ks[i], shape, jnp.float32) * scale

    return {
        'x_prompt': nrm(0, (BATCH, SEQ, D_MODEL), 1.0),
        'x_sample': nrm(1, (DEC_BATCH, DEC_SEQ, D_MODEL), 1.0),
        'meta_tokens': nrm(2, (N_META, D_MODEL), 1.0),
        'pre_mix_g': 1.0 + nrm(3, (DEPTH, D_MODEL), 0.05),
        'post_mix_g': 1.0 + nrm(4, (DEPTH, D_MODEL), 0.05),
        'pre_ffn_g': 1.0 + nrm(5, (DEPTH, D_MODEL), 0.05),
        'post_ffn_g': 1.0 + nrm(6, (DEPTH, D_MODEL), 0.05),
        'even_w_in': nrm(7, (N_EVEN, D_MODEL, EVEN_IN), D_MODEL ** -0.5),
        'even_w_out': nrm(8, (N_EVEN, EVEN_OUT, D_MODEL), EVEN_OUT ** -0.5),
        'a_q_gain': 1.0 + nrm(9, (N_EVEN, HEAD_DIM), 0.05),
        'a_k_gain': 1.0 + nrm(10, (N_EVEN, HEAD_DIM), 0.05),
        'b_norm_g': 1.0 + nrm(11, (N_EVEN, B_GROUPS, B_DIM), 0.05),
        'b_w': nrm(12, (N_EVEN, B_GROUPS, B_DIM, B_DIM), B_DIM ** -0.5),
        'b_b': nrm(13, (N_EVEN, B_GROUPS, B_DIM), 0.01),
        'odd_w_in': nrm(14, (N_ODD, D_MODEL, ODD_IN), D_MODEL ** -0.5),
        'odd_w_out': nrm(15, (N_ODD, ODD_OUT, D_MODEL), ODD_OUT ** -0.5),
        'c_sink': nrm(16, (N_ODD, C_HEADS), 0.5),
        'd_mu_prev': jax.random.uniform(ks[17], (N_ODD, D_IN), jnp.float32, 0.0, 0.5),
        'd_mu_next': jax.random.uniform(ks[18], (N_ODD, D_IN), jnp.float32, 0.0, 0.5),
        'd_w0': jnp.linspace(-6.5, -1.5, D_WIDTH, dtype=jnp.float32)[None, None] + nrm(19, (N_ODD, 2, D_WIDTH), 0.1),
        'd_w_up': nrm(20, (N_ODD, 2, DECAY_RANK, D_WIDTH), 0.1 * DECAY_RANK ** -0.5),
        'd_a0': nrm(21, (N_ODD, 2, D_WIDTH), 0.1),
        'd_a_up': nrm(22, (N_ODD, 2, ICLR_RANK, D_WIDTH), 0.1 * ICLR_RANK ** -0.5),
        'd_g_up': nrm(23, (N_ODD, GATE_RANK, D_WIDTH), GATE_RANK ** -0.5),
        'd_k_k': 0.85 + nrm(24, (N_ODD, D_WIDTH), 0.05),
        'd_k_a': 1.0 + nrm(25, (N_ODD, D_WIDTH), 0.05),
        'd_r_k': nrm(26, (N_ODD, D_HEADS, HEAD_DIM), 0.1),
        'd_ln_g': 1.0 + nrm(27, (N_ODD, D_WIDTH), 0.1),
        'd_ln_b': nrm(28, (N_ODD, D_WIDTH), 0.01),
        'ffn_w_gate': nrm(29, (DEPTH, D_MODEL, D_FF), D_MODEL ** -0.5),
        'ffn_w_up': nrm(30, (DEPTH, D_MODEL, D_FF), D_MODEL ** -0.5),
        'ffn_w_down': nrm(31, (DEPTH, D_FF, D_MODEL), D_FF ** -0.5),
    }


def reference(x_prompt, x_sample, meta_tokens, pre_mix_g, post_mix_g, pre_ffn_g, post_ffn_g,
              even_w_in, even_w_out, a_q_gain, a_k_gain, b_norm_g, b_w, b_b,
              odd_w_in, odd_w_out, c_sink, d_mu_prev, d_mu_next, d_w0, d_w_up, d_a0, d_a_up,
              d_g_up, d_k_k, d_k_a, d_r_k, d_ln_g, d_ln_b, ffn_w_gate, ffn_w_up, ffn_w_down):
    params = dict(meta_tokens=meta_tokens, pre_mix_g=pre_mix_g, post_mix_g=post_mix_g,
                  pre_ffn_g=pre_ffn_g, post_ffn_g=post_ffn_g,
                  even_w_in=even_w_in, even_w_out=even_w_out, a_q_gain=a_q_gain, a_k_gain=a_k_gain,
                  b_norm_g=b_norm_g, b_w=b_w, b_b=b_b,
                  odd_w_in=odd_w_in, odd_w_out=odd_w_out, c_sink=c_sink,
                  d_mu_prev=d_mu_prev, d_mu_next=d_mu_next, d_w0=d_w0, d_w_up=d_w_up,
                  d_a0=d_a0, d_a_up=d_a_up, d_g_up=d_g_up, d_k_k=d_k_k, d_k_a=d_k_a, d_r_k=d_r_k,
                  d_ln_g=d_ln_g, d_ln_b=d_ln_b,
                  ffn_w_gate=ffn_w_gate, ffn_w_up=ffn_w_up, ffn_w_down=ffn_w_down)
    y_prompt = trunk(x_prompt, params)
    y_sample = trunk(x_sample, params)
    return (y_prompt, y_sample)
```

```cpp
#include <hip/hip_runtime.h>
#include <hip/hip_cooperative_groups.h>
#include <cstdio>
namespace cg = cooperative_groups;

#ifndef FUSED
#define FUSED 1
#endif

typedef unsigned short bf16_t;
using bf16x8 = __attribute__((ext_vector_type(8))) short;
using s16x4 = __attribute__((ext_vector_type(4))) short;
using f32x16 = __attribute__((ext_vector_type(16))) float;
using u32x4 = __attribute__((ext_vector_type(4))) unsigned;
#define DI __device__ __forceinline__
#define MFMA32(a, b, c) __builtin_amdgcn_mfma_f32_32x32x16_bf16((a), (b), (c), 0, 0, 0)

constexpr int DM_ = 1024;
constexpr int T_ = 49296;
constexpr int TP_ = 49408;
constexpr int NT_ = TP_ / 128;
constexpr int DFF = 2816;
constexpr float EPS = 1e-6f;
constexpr float LOG2E = 1.4426950408889634f;

constexpr size_t SZ_ROW1024 = (size_t)TP_ * 1024 * 2;
constexpr size_t O_WIN0 = 0;
constexpr size_t O_WOUT0 = O_WIN0 + (size_t)1536 * 1024 * 2;
constexpr size_t O_WGU0 = O_WOUT0 + (size_t)1024 * 1024 * 2;
constexpr size_t O_WD0 = O_WGU0 + (size_t)5632 * 1024 * 2;
constexpr size_t O_DM257 = O_WD0 + (size_t)1024 * 2816 * 2;
constexpr size_t O_DM1025 = O_DM257 + (size_t)384 * 576 * 2;
constexpr size_t O_WIN1 = O_DM1025 + (size_t)1152 * 2112 * 2;
constexpr size_t O_WOUT1 = O_WIN1 + (size_t)2688 * 1024 * 2;
constexpr size_t O_WGU1 = O_WOUT1 + (size_t)1024 * 1024 * 2;
constexpr size_t O_WD1 = O_WGU1 + (size_t)5632 * 1024 * 2;
constexpr size_t O_GUP = O_WD1 + (size_t)1024 * 2816 * 2;
constexpr size_t O_RA = O_GUP + (size_t)512 * 128 * 2;
constexpr size_t O_RB = O_RA + SZ_ROW1024;
constexpr size_t O_RC = O_RB + (size_t)TP_ * 2816 * 2;
constexpr size_t O_META = O_RC + SZ_ROW1024;
constexpr size_t O_WC = O_META + (size_t)144 * 1024 * 4;
constexpr size_t O_END = O_WC + (size_t)4 * 64 * 128 * 4;
constexpr size_t O_HN = O_RA;
constexpr size_t O_VTA = O_RA;
constexpr size_t O_LR = O_RA;
constexpr size_t O_BONUS = O_RA + (size_t)TP_ * 384 * 2;
constexpr size_t O_VTC = O_BONUS + (size_t)T_ * 16 * 4;
constexpr size_t O_OB = O_RA + (size_t)TP_ * 512 * 2;
constexpr size_t O_PROJ0 = O_RB;
constexpr size_t O_ZB = O_PROJ0 + (size_t)TP_ * 1536 * 2;
constexpr size_t O_Y = O_ZB + (size_t)TP_ * 512 * 2;
constexpr size_t O_ACT = O_RB;
constexpr size_t O_PRKV = O_RB;
constexpr size_t O_PC = O_PRKV + (size_t)TP_ * 1536 * 2;
constexpr size_t O_PLOW = O_PC + (size_t)TP_ * 768 * 2;
constexpr size_t O_PQ = O_PC;
constexpr size_t O_G = O_PC;
constexpr size_t O_MIX = O_RC;
static_assert(O_VTC + (size_t)49728 * 128 * 2 <= O_RB, "vtc");
static_assert(O_Y + (size_t)(8 * 16 * 256 * 576 + 16 * 256 * 2112) * 2 <= O_RC, "y");
static_assert(O_PQ + (size_t)3216 * 32768 <= O_RC, "pq");
static_assert(O_END <= (size_t)536870912, "ws");

struct P {
  const float *x_prompt, *x_sample, *meta, *pre_mix_g, *post_mix_g, *pre_ffn_g, *post_ffn_g;
  const float *even_w_in, *even_w_out, *a_q_gain, *a_k_gain, *b_norm_g, *b_w, *b_b;
  const float *odd_w_in, *odd_w_out, *c_sink, *mu_prev, *mu_next, *d_w0, *d_w_up, *d_a0, *d_a_up, *d_g_up;
  const float *d_k_k, *d_k_a, *d_r_k, *d_ln_g, *d_ln_b, *ffn_gate, *ffn_up, *ffn_down;
  float* out;
  char* ws;
  int ph0, ph1;
};

DI bf16_t f2bf(float x) { unsigned u = __float_as_uint(x); u += 0x7fffu + ((u >> 16) & 1u); return (bf16_t)(u >> 16); }
DI float bf2f(bf16_t b) { return __uint_as_float(((unsigned)b) << 16); }
DI unsigned pack2(float a, float b) { return (unsigned)f2bf(a) | ((unsigned)f2bf(b) << 16); }
DI float lo2f(unsigned u) { return __uint_as_float(u << 16); }
DI float hi2f(unsigned u) { return __uint_as_float(u & 0xffff0000u); }
DI float wave_sum(float v) {
  for (int o = 32; o > 0; o >>= 1) v += __shfl_xor(v, o);
  return v;
}
DI int seq_of(int sr, int& pos) {
  if (sr < 32896) { int b = sr / 4112; pos = sr - b * 4112; return b; }
  pos = sr - 32896; return 8;
}
DI int seq_len(int b) { return b < 8 ? 4112 : 16400; }
DI int seq_base(int b) { return b < 8 ? b * 4112 : 32896; }
DI float* hrow(const P& p, int sr) {
  int pos; int b = seq_of(sr, pos);
  if (pos < 16) return (float*)(p.ws + O_META) + (size_t)(b * 16 + pos) * 1024;
  return p.out + ((size_t)(b < 8 ? b * 4096 : 32768) + (pos - 16)) * 1024;
}
DI float sigmoidf_(float x) { return 1.f / (1.f + expf(-x)); }

DI void transpose_w(const float* W, int K, int ldw, int N, bf16_t* Wt, int mode, const float* W2, int gtid, int gsz) {
  int nk8 = K / 8;
  long total = (long)N * nk8;
  for (long it = gtid; it < total; it += gsz) {
    int n = (int)(it % N), k8 = (int)(it / N);
    const float* src = W;
    int c = n;
    if (mode == 1) {
      int blk = n >> 6, w = n & 63;
      c = blk * 32 + (w & 31);
      if (w >= 32) src = W2;
    }
    unsigned r[4];
#pragma unroll
    for (int j = 0; j < 4; ++j) {
      float a = src[(size_t)(k8 * 8 + 2 * j) * ldw + c];
      float b = src[(size_t)(k8 * 8 + 2 * j + 1) * ldw + c];
      r[j] = pack2(a, b);
    }
    *(uint4*)(Wt + (size_t)n * K + k8 * 8) = make_uint4(r[0], r[1], r[2], r[3]);
  }
}

DI void phase_prep(const P& p) {
  const int gtid = blockIdx.x * 256 + threadIdx.x, gsz = gridDim.x * 256;
  char* ws = p.ws;
  transpose_w(p.even_w_in, 1024, 1536, 1536, (bf16_t*)(ws + O_WIN0), 0, nullptr, gtid, gsz);
  transpose_w(p.even_w_out, 1024, 1024, 1024, (bf16_t*)(ws + O_WOUT0), 0, nullptr, gtid, gsz);
  transpose_w(p.odd_w_in, 1024, 2688, 2688, (bf16_t*)(ws + O_WIN1), 0, nullptr, gtid, gsz);
  transpose_w(p.odd_w_out, 1024, 1024, 1024, (bf16_t*)(ws + O_WOUT1), 0, nullptr, gtid, gsz);
  transpose_w(p.ffn_gate, 1024, DFF, 5632, (bf16_t*)(ws + O_WGU0), 1, p.ffn_up, gtid, gsz);
  transpose_w(p.ffn_gate + (size_t)1024 * DFF, 1024, DFF, 5632, (bf16_t*)(ws + O_WGU1), 1, p.ffn_up + (size_t)1024 * DFF, gtid, gsz);
  transpose_w(p.ffn_down, DFF, 1024, 1024, (bf16_t*)(ws + O_WD0), 0, nullptr, gtid, gsz);
  transpose_w(p.ffn_down + (size_t)DFF * 1024, DFF, 1024, 1024, (bf16_t*)(ws + O_WD1), 0, nullptr, gtid, gsz);
  transpose_w(p.d_g_up, 128, 512, 512, (bf16_t*)(ws + O_GUP), 0, nullptr, gtid, gsz);
  for (int which = 0; which < 2; ++which) {
    const int M = which ? 1025 : 257, MP = which ? 1152 : 384, KP = which ? 2112 : 576;
    bf16_t* dm = (bf16_t*)(ws + (which ? O_DM1025 : O_DM257));
    for (int it = gtid; it < MP * KP; it += gsz) {
      int r = it / KP, c = it - r * KP;
      float v = 0.f;
      if (r < M && c < 2 * M) {
        int n2 = c < M ? c : c - M;
        int m = (r * n2) % M;
        float s, co;
        sincospif(2.0f * (float)m / (float)M, &s, &co);
        v = c < M ? co : s;
      }
      dm[it] = f2bf(v);
    }
  }
  for (int it = gtid; it < 4 * 64 * 128; it += gsz) {
    int o = it & 127, c = (it >> 7) & 63, g = it >> 13;
    int d = o & 63;
    float acc = 0.f;
    for (int c2 = 0; c2 < 64; ++c2) {
      float s, co;
      sincospif((float)((c * c2) & 63) / 32.f, &s, &co);
      float w = p.b_w[(g * 64 + c2) * 64 + d];
      acc += (o < 64 ? co : -s) * w;
    }
    ((float*)(ws + O_WC))[it] = acc;
  }
  const int lane = threadIdx.x & 63, gw = gtid >> 6, nw = gsz >> 6;
  bf16_t* HN = (bf16_t*)(ws + O_HN);
  for (int sr = gw; sr < TP_; sr += nw) {
    if (sr >= T_) {
#pragma unroll
      for (int q = 0; q < 2; ++q) *(uint4*)(HN + (size_t)sr * 1024 + q * 512 + lane * 8) = make_uint4(0, 0, 0, 0);
      continue;
    }
    int pos; int b = seq_of(sr, pos);
    const float* src = pos < 16 ? p.meta + pos * 1024
                                : (b < 8 ? p.x_prompt + ((size_t)b * 4096 + pos - 16) * 1024 : p.x_sample + (size_t)(pos - 16) * 1024);
    float* hr = hrow(p, sr);
    float4 v[4];
    float ss = 0.f;
#pragma unroll
    for (int q = 0; q < 4; ++q) {
      v[q] = *(const float4*)(src + q * 256 + lane * 4);
      ss += v[q].x * v[q].x + v[q].y * v[q].y + v[q].z * v[q].z + v[q].w * v[q].w;
      *(float4*)(hr + q * 256 + lane * 4) = v[q];
    }
    ss = wave_sum(ss);
    float rs = rsqrtf(ss * (1.f / 1024.f) + EPS);
#pragma unroll
    for (int q = 0; q < 4; ++q) {
      float4 g = *(const float4*)(p.pre_mix_g + q * 256 + lane * 4);
      uint2 o = make_uint2(pack2(v[q].x * rs * g.x, v[q].y * rs * g.y), pack2(v[q].z * rs * g.z, v[q].w * rs * g.w));
      *(uint2*)(HN + (size_t)sr * 1024 + q * 256 + lane * 4) = o;
    }
  }
}

DI void gemm_tile(const bf16_t* __restrict__ A, int lda, const bf16_t* __restrict__ B, int ldb, int K, char* lds, f32x16 (&acc)[2][2]) {
  const int tid = threadIdx.x, lane = tid & 63, wave = tid >> 6, wm = wave >> 1, wn = wave & 1;
  const int l31 = lane & 31, h = lane >> 5;
  bf16_t* As = (bf16_t*)lds;
  bf16_t* Bs = As + 128 * 72;
#pragma unroll
  for (int a = 0; a < 2; ++a)
#pragma unroll
    for (int b = 0; b < 2; ++b)
#pragma unroll
      for (int i = 0; i < 16; ++i) acc[a][b][i] = 0.f;
  const int lr = tid >> 3, lc = (tid & 7) * 8;
  const bf16_t* Ag = A + (size_t)lr * lda + lc;
  const bf16_t* Bg = B + (size_t)lr * ldb + lc;
  u32x4 ra[4], rb[4];
#pragma unroll
  for (int q = 0; q < 4; ++q) {
    ra[q] = *(const u32x4*)(Ag + (size_t)(32 * q) * lda);
    rb[q] = *(const u32x4*)(Bg + (size_t)(32 * q) * ldb);
  }
#pragma unroll
  for (int q = 0; q < 4; ++q) {
    *(u32x4*)(As + (lr + 32 * q) * 72 + lc) = ra[q];
    *(u32x4*)(Bs + (lr + 32 * q) * 72 + lc) = rb[q];
  }
  __syncthreads();
  const int nk = K >> 6;
  for (int kt = 0; kt < nk; ++kt) {
    if (kt + 1 < nk) {
#pragma unroll
      for (int q = 0; q < 4; ++q) {
        ra[q] = *(const u32x4*)(Ag + (size_t)(32 * q) * lda + (kt + 1) * 64);
        rb[q] = *(const u32x4*)(Bg + (size_t)(32 * q) * ldb + (kt + 1) * 64);
      }
    }
#pragma unroll
    for (int ks = 0; ks < 4; ++ks) {
      bf16x8 a[2], b[2];
#pragma unroll
      for (int t = 0; t < 2; ++t) {
        a[t] = *(const bf16x8*)(As + (wm * 64 + t * 32 + l31) * 72 + ks * 16 + 8 * h);
        b[t] = *(const bf16x8*)(Bs + (wn * 64 + t * 32 + l31) * 72 + ks * 16 + 8 * h);
      }
#pragma unroll
      for (int mt = 0; mt < 2; ++mt)
#pragma unroll
        for (int nt = 0; nt < 2; ++nt) acc[mt][nt] = MFMA32(a[mt], b[nt], acc[mt][nt]);
    }
    __syncthreads();
    if (kt + 1 < nk) {
#pragma unroll
      for (int q = 0; q < 4; ++q) {
        *(u32x4*)(As + (lr + 32 * q) * 72 + lc) = ra[q];
        *(u32x4*)(Bs + (lr + 32 * q) * 72 + lc) = rb[q];
      }
      __syncthreads();
    }
  }
}
#define ACC_ROW(mt, i) (wm * 64 + (mt) * 32 + ((i) & 3) + 8 * ((i) >> 2) + 4 * h)
#define ACC_COL(nt) (wn * 64 + (nt) * 32 + l31)
#define GEMM_IDS const int lane = threadIdx.x & 63, wave = threadIdx.x >> 6, wm = wave >> 1, wn = wave & 1, l31 = lane & 31, h = lane >> 5; (void)wm; (void)wn; (void)l31; (void)h;

DI void phase_gemm_plain(const bf16_t* A, int lda, const bf16_t* W, int N, int K, bf16_t* C, int ldc, char* lds, int route, char* ws) {
  GEMM_IDS
  const int ntn = N / 128;
  const int total = NT_ * ntn;
  for (int t = blockIdx.x; t < total; t += gridDim.x) {
    const int tm = t / ntn, tn = t - tm * ntn;
    f32x16 acc[2][2];
    gemm_tile(A + (size_t)tm * 128 * lda, lda, W + (size_t)tn * 128 * K, K, K, lds, acc);
    bf16_t* Cb = C; int ld = ldc; int cbase = tn * 128;
    if (route) {
      if (cbase < 768) { Cb = (bf16_t*)(ws + O_PC); ld = 768; }
      else if (cbase < 2304) { Cb = (bf16_t*)(ws + O_PRKV); ld = 1536; cbase -= 768; }
      else { Cb = (bf16_t*)(ws + O_PLOW); ld = 384; cbase -= 2304; }
    }
#pragma unroll
    for (int mt = 0; mt < 2; ++mt)
#pragma unroll
      for (int nt = 0; nt < 2; ++nt)
#pragma unroll
        for (int i = 0; i < 16; ++i) {
          int row = tm * 128 + ACC_ROW(mt, i), col = cbase + ACC_COL(nt);
          Cb[(size_t)row * ld + col] = f2bf(acc[mt][nt][i]);
        }
  }
}

DI void phase_gemm_gateup(const bf16_t* A, const bf16_t* W, bf16_t* ACT, char* lds) {
  GEMM_IDS
  const int ntn = 5632 / 128;
  const int total = NT_ * ntn;
  for (int t = blockIdx.x; t < total; t += gridDim.x) {
    const int tm = t / ntn, tn = t - tm * ntn;
    f32x16 acc[2][2];
    gemm_tile(A + (size_t)tm * 128 * 1024, 1024, W + (size_t)tn * 128 * 1024, 1024, 1024, lds, acc);
    const int col = (tn * 2 + wn) * 32 + l31;
#pragma unroll
    for (int mt = 0; mt < 2; ++mt)
#pragma unroll
      for (int i = 0; i < 16; ++i) {
        int row = tm * 128 + ACC_ROW(mt, i);
        float g = acc[mt][0][i], u = acc[mt][1][i];
        float v = g / (1.f + __expf(-g)) * u;
        ACT[(size_t)row * DFF + col] = f2bf(v);
      }
  }
}

DI void phase_resnorm(const P& p, const float* g1, const float* g2) {
  const int lane = threadIdx.x & 63, gw = (blockIdx.x * 256 + threadIdx.x) >> 6, nw = (gridDim.x * 256) >> 6;
  bf16_t* HN = (bf16_t*)(p.ws + O_HN);
  for (int sr = gw; sr < T_; sr += nw) {
    float* hr = hrow(p, sr);
    float x[16];
    uint4 u0 = *(const uint4*)(HN + (size_t)sr * 1024 + lane * 16);
    uint4 u1 = *(const uint4*)(HN + (size_t)sr * 1024 + lane * 16 + 8);
    unsigned uu[8] = {u0.x, u0.y, u0.z, u0.w, u1.x, u1.y, u1.z, u1.w};
    float ss = 0.f;
#pragma unroll
    for (int j = 0; j < 8; ++j) { x[2 * j] = lo2f(uu[j]); x[2 * j + 1] = hi2f(uu[j]); ss += x[2 * j] * x[2 * j] + x[2 * j + 1] * x[2 * j + 1]; }
    ss = wave_sum(ss);
    float rs = rsqrtf(ss * (1.f / 1024.f) + EPS);
    float hv[16];
    float ss2 = 0.f;
#pragma unroll
    for (int q = 0; q < 4; ++q) {
      float4 hh = *(const float4*)(hr + lane * 16 + q * 4);
      float4 g = *(const float4*)(g1 + lane * 16 + q * 4);
      hh.x += x[q * 4 + 0] * rs * g.x; hh.y += x[q * 4 + 1] * rs * g.y; hh.z += x[q * 4 + 2] * rs * g.z; hh.w += x[q * 4 + 3] * rs * g.w;
      *(float4*)(hr + lane * 16 + q * 4) = hh;
      hv[q * 4 + 0] = hh.x; hv[q * 4 + 1] = hh.y; hv[q * 4 + 2] = hh.z; hv[q * 4 + 3] = hh.w;
      ss2 += hh.x * hh.x + hh.y * hh.y + hh.z * hh.z + hh.w * hh.w;
    }
    if (g2) {
      ss2 = wave_sum(ss2);
      float rs2 = rsqrtf(ss2 * (1.f / 1024.f) + EPS);
      unsigned o[8];
#pragma unroll
      for (int q = 0; q < 4; ++q) {
        float4 g = *(const float4*)(g2 + lane * 16 + q * 4);
        o[2 * q] = pack2(hv[q * 4] * rs2 * g.x, hv[q * 4 + 1] * rs2 * g.y);
        o[2 * q + 1] = pack2(hv[q * 4 + 2] * rs2 * g.z, hv[q * 4 + 3] * rs2 * g.w);
      }
      *(uint4*)(HN + (size_t)sr * 1024 + lane * 16) = make_uint4(o[0], o[1], o[2], o[3]);
      *(uint4*)(HN + (size_t)sr * 1024 + lane * 16 + 8) = make_uint4(o[4], o[5], o[6], o[7]);
    }
  }
}

DI size_t vta_base(int seq) { return seq < 8 ? (size_t)seq * 256 * 4160 : (size_t)8 * 256 * 4160; }
DI void phase_prepA(const P& p, char* lds) {
  const int lane = threadIdx.x & 63, wave = threadIdx.x >> 6;
  bf16_t* PROJ = (bf16_t*)(p.ws + O_PROJ0);
  bf16_t* VT = (bf16_t*)(p.ws + O_VTA);
  bf16_t* ZB = (bf16_t*)(p.ws + O_ZB);
  const float* WC = (const float*)(p.ws + O_WC);
  float* fl = (float*)lds + wave * 256;
  const float inv = exp2f(-(float)(lane & 15) * (13.287712379549449f / 16.f));
  const float qg = p.a_q_gain[lane], kg = p.a_k_gain[lane];
  for (int it = (int)(blockIdx.x * 256 + threadIdx.x); it < 9 * 4 * 64 * 48; it += (int)(gridDim.x * 256)) {
    int k = it % 48, rowi = it / 48;
    int seq = rowi / 256, rr = rowi - seq * 256;
    size_t base = (seq < 8 ? (size_t)seq * 256 * 4160 : (size_t)8 * 256 * 4160) + (size_t)rr * (seq < 8 ? 4160 : 16448);
    VT[base + k] = 0;
  }
  for (int r0 = blockIdx.x * 4; r0 < TP_; r0 += gridDim.x * 4) {
    const int sr = r0 + wave;
    const bool valid = sr < T_;
    if (valid) {
      int pos; int b = seq_of(sr, pos);
      float rowf, colf;
      if (pos < 16) { rowf = colf = (float)(pos - 16); }
      else { int t = pos - 16; rowf = (float)(t >> 6); colf = (float)(t & 63); }
      float ang = (lane < 32 ? rowf : colf) * inv;
      float sn, cs;
      sincosf(ang, &sn, &cs);
      const float sgn = (lane & 16) ? sn : -sn;
      bf16_t* pr = PROJ + (size_t)sr * 1536;
      for (int hd = 0; hd < 16; ++hd) {
        float x = bf2f(pr[hd * 64 + lane]);
        float ss = wave_sum(x * x);
        float xn = x * rsqrtf(ss * (1.f / 64.f) + EPS) * (hd < 12 ? qg : kg);
        float pa = __shfl_xor(xn, 16);
        float o = xn * cs + pa * sgn;
        if (hd < 12) o *= 0.125f * LOG2E;
        pr[hd * 64 + lane] = f2bf(o);
      }
      const int L = seq_len(b);
      const int LP = L + 48;
      bf16_t* vt = VT + vta_base(b);
      for (int kv = 0; kv < 4; ++kv) vt[(size_t)(kv * 64 + lane) * LP + pos + 48] = pr[1024 + kv * 64 + lane];
      uint2 u = *(const uint2*)(pr + 1280 + lane * 4);
      float f0 = lo2f(u.x), f1 = hi2f(u.x), f2 = lo2f(u.y), f3 = hi2f(u.y);
      float ss = f0 * f0 + f1 * f1 + f2 * f2 + f3 * f3;
      ss += __shfl_xor(ss, 1); ss += __shfl_xor(ss, 2); ss += __shfl_xor(ss, 4); ss += __shfl_xor(ss, 8);
      float rs = rsqrtf(ss * (1.f / 64.f) + EPS);
      float4 g = *(const float4*)(p.b_norm_g + lane * 4);
      *(float4*)(fl + lane * 4) = make_float4(f0 * rs * g.x, f1 * rs * g.y, f2 * rs * g.z, f3 * rs * g.w);
    }
    __syncthreads();
    if (valid) {
      const int g = lane >> 4, o0 = (lane & 15) * 8;
      float acc[8];
#pragma unroll
      for (int j = 0; j < 8; ++j) acc[j] = 0.f;
      const float* wc = WC + (size_t)g * 64 * 128 + o0;
      for (int c = 0; c < 64; ++c) {
        float f = fl[g * 64 + c];
        float4 w0 = *(const float4*)(wc + c * 128), w1 = *(const float4*)(wc + c * 128 + 4);
        acc[0] += f * w0.x; acc[1] += f * w0.y; acc[2] += f * w0.z; acc[3] += f * w0.w;
        acc[4] += f * w1.x; acc[5] += f * w1.y; acc[6] += f * w1.z; acc[7] += f * w1.w;
      }
      *(uint4*)(ZB + (size_t)sr * 512 + g * 128 + o0) = make_uint4(pack2(acc[0], acc[1]), pack2(acc[2], acc[3]), pack2(acc[4], acc[5]), pack2(acc[6], acc[7]));
    }
    __syncthreads();
  }
}

template <int MODE>
DI void flash_item(const bf16_t* __restrict__ Q, int ldq, const bf16_t* __restrict__ Kb, int ldk, const bf16_t* __restrict__ Vt, int LP,
                   bf16_t* O, int ldo, int sbase, int S, int qt, float sinkl2, char* lds) {
  const int tid = threadIdx.x, lane = tid & 63, wave = tid >> 6, l31 = lane & 31, h = lane >> 5;
  bf16_t* Ks = (bf16_t*)lds;
  bf16_t* Vs = Ks + 2 * 64 * 72;
  const int rl = wave * 32 + l31;
  const int qpos = qt == 0 ? (rl < 16 ? rl : 15) : 16 + 128 * (qt - 1) + rl;
  const bool qvalid = qt > 0 || rl < 16;
  bf16x8 qf[4];
  {
    const bf16_t* qr = Q + (size_t)(sbase + qpos) * ldq;
#pragma unroll
    for (int s = 0; s < 4; ++s) qf[s] = *(const bf16x8*)(qr + 16 * s + 8 * h);
  }
  const int nkt_all = (S + 64) / 64;
  int klo = 1, n;
  if (MODE == 0) { n = nkt_all; }
  else {
    if (qt == 0) { klo = 1; n = 3; }
    else {
      int c = qt - 1;
      klo = 2 * c - 1; if (klo < 1) klo = 1;
      int khi = 2 * c + 4; if (khi > nkt_all - 1) khi = nkt_all - 1;
      n = 1 + (khi - klo + 1);
    }
  }
  const int ldr = tid >> 2, ldp = (tid & 3) * 16;
  u32x4 rk0, rk1, rv0, rv1;
  auto ktile = [&](int idx) { return idx == 0 ? 0 : klo + idx - 1; };
#define FL_GLOAD(idx)                                                                               \
  {                                                                                                 \
    int kt_ = ktile(idx);                                                                           \
    int pos_ = 64 * kt_ + ldr - 48;                                                                 \
    if (pos_ >= 0) {                                                                                \
      const bf16_t* kp_ = Kb + (size_t)(sbase + pos_) * ldk + ldp;                                  \
      rk0 = *(const u32x4*)kp_; rk1 = *(const u32x4*)(kp_ + 8);                                 \
    } else { rk0 = (u32x4)(0u); rk1 = rk0; }                                       \
    const bf16_t* vp_ = Vt + (size_t)ldr * LP + 64 * kt_ + ldp;                                     \
    rv0 = *(const u32x4*)vp_; rv1 = *(const u32x4*)(vp_ + 8);                                   \
  }
#define FL_SSTORE(buf)                                                                              \
  {                                                                                                 \
    *(u32x4*)(Ks + (buf) * 64 * 72 + ldr * 72 + ldp) = rk0; *(u32x4*)(Ks + (buf) * 64 * 72 + ldr * 72 + ldp + 8) = rk1; \
    *(u32x4*)(Vs + (buf) * 64 * 72 + ldr * 72 + ldp) = rv0; *(u32x4*)(Vs + (buf) * 64 * 72 + ldr * 72 + ldp + 8) = rv1; \
  }
  f32x16 oacc[2];
#pragma unroll
  for (int i = 0; i < 16; ++i) { oacc[0][i] = 0.f; oacc[1][i] = 0.f; }
  float m = -1e30f, l = 0.f;
  FL_GLOAD(0)
  FL_SSTORE(0)
  __syncthreads();
  for (int idx = 0; idx < n; ++idx) {
    const int cur = idx & 1;
    if (idx + 1 < n) FL_GLOAD(idx + 1)
    const int kt = ktile(idx);
    const bf16_t* ks = Ks + cur * 64 * 72;
    const bf16_t* vs = Vs + cur * 64 * 72;
    f32x16 sacc[2];
#pragma unroll
    for (int t = 0; t < 2; ++t) {
#pragma unroll
      for (int i = 0; i < 16; ++i) sacc[t][i] = 0.f;
#pragma unroll
      for (int s = 0; s < 4; ++s) {
        bf16x8 kf = *(const bf16x8*)(ks + (32 * t + l31) * 72 + 16 * s + 8 * h);
        sacc[t] = MFMA32(kf, qf[s], sacc[t]);
      }
    }
    if (kt == 0) {
#pragma unroll
      for (int t = 0; t < 2; ++t)
#pragma unroll
        for (int i = 0; i < 16; ++i) {
          int kl = 32 * t + (i & 3) + 8 * (i >> 2) + 4 * h;
          if (kl < 48) sacc[t][i] = -1e30f;
        }
    } else if (MODE == 1) {
#pragma unroll
      for (int t = 0; t < 2; ++t)
#pragma unroll
        for (int i = 0; i < 16; ++i) {
          int kl = 32 * t + (i & 3) + 8 * (i >> 2) + 4 * h;
          int tk = 64 * (kt - 1) + kl;
          bool vis;
          if (qt == 0) vis = tk <= 112 + qpos;
          else { int tq = qpos - 16; int d = tq - tk; vis = d <= 128 && d >= -128; }
          if (!vis) sacc[t][i] = -1e30f;
        }
    }
    float tmax = -1e30f;
#pragma unroll
    for (int t = 0; t < 2; ++t)
#pragma unroll
      for (int i = 0; i < 16; ++i) tmax = fmaxf(tmax, sacc[t][i]);
    tmax = fmaxf(tmax, __shfl_xor(tmax, 32));
    const float mn = fmaxf(m, tmax);
    const float alpha = __builtin_amdgcn_exp2f(m - mn);
    m = mn;
    float ls = 0.f;
#pragma unroll
    for (int t = 0; t < 2; ++t)
#pragma unroll
      for (int i = 0; i < 16; ++i) { float pv = __builtin_amdgcn_exp2f(sacc[t][i] - mn); sacc[t][i] = pv; ls += pv; }
    l = l * alpha + ls;
#pragma unroll
    for (int i = 0; i < 16; ++i) { oacc[0][i] *= alpha; oacc[1][i] *= alpha; }
#pragma unroll
    for (int t = 0; t < 2; ++t)
#pragma unroll
      for (int s2 = 0; s2 < 2; ++s2) {
        u32x4 pk4;
#pragma unroll
        for (int j = 0; j < 4; ++j) pk4[j] = pack2(sacc[t][8 * s2 + 2 * j], sacc[t][8 * s2 + 2 * j + 1]);
        bf16x8 pf = __builtin_bit_cast(bf16x8, pk4);
#pragma unroll
        for (int dt = 0; dt < 2; ++dt) {
          const bf16_t* vp = vs + (32 * dt + l31) * 72 + 32 * t + 16 * s2 + 4 * h;
          uint2 lo = *(const uint2*)vp, hi = *(const uint2*)(vp + 8);
          u32x4 v4 = {lo.x, lo.y, hi.x, hi.y};
          bf16x8 vf = __builtin_bit_cast(bf16x8, v4);
          oacc[dt] = MFMA32(vf, pf, oacc[dt]);
        }
      }
    if (idx + 1 < n) FL_SSTORE(cur ^ 1)
    __syncthreads();
  }
  l += __shfl_xor(l, 32);
  if (MODE == 1) l += __builtin_amdgcn_exp2f(sinkl2 - m);
  const float il = 1.f / l;
  if (qvalid) {
    bf16_t* orow = O + (size_t)(sbase + qpos) * ldo;
#pragma unroll
    for (int dt = 0; dt < 2; ++dt)
#pragma unroll
      for (int g = 0; g < 4; ++g) {
        int d = 32 * dt + 8 * g + 4 * h;
        uint2 o = make_uint2(pack2(oacc[dt][4 * g] * il, oacc[dt][4 * g + 1] * il), pack2(oacc[dt][4 * g + 2] * il, oacc[dt][4 * g + 3] * il));
        *(uint2*)(orow + d) = o;
      }
  }
#undef FL_GLOAD
#undef FL_SSTORE
}

DI size_t y_base(int seq) { return seq < 8 ? (size_t)seq * 16 * 256 * 576 : (size_t)8 * 16 * 256 * 576; }
DI void phase_attnA(const P& p, char* lds) {
  const bf16_t* PROJ = (const bf16_t*)(p.ws + O_PROJ0);
  const bf16_t* VT = (const bf16_t*)(p.ws + O_VTA);
  bf16_t* MIX = (bf16_t*)(p.ws + O_MIX);
  const int nS = 129 * 12, nP = 8 * 33 * 12;
  for (int it = blockIdx.x; it < nS + nP; it += gridDim.x) {
    int seq, qt, hq;
    if (it < nS) { seq = 8; hq = it % 12; qt = it / 12; }
    else { int j = it - nS; hq = j % 12; j /= 12; qt = j % 33; seq = j / 33; }
    const int kv = hq / 3;
    const int L = seq_len(seq), LP = L + 48;
    flash_item<0>(PROJ + hq * 64, 1536, PROJ + 768 + kv * 64, 1536, VT + vta_base(seq) + (size_t)kv * 64 * LP, LP,
                  MIX + hq * 64, 1024, seq_base(seq), L - 16, qt, 0.f, lds);
  }
  const bf16_t* ZB = (const bf16_t*)(p.ws + O_ZB);
  bf16_t* Y = (bf16_t*)(p.ws + O_Y);
  const int lane = threadIdx.x & 63, wave = threadIdx.x >> 6;
  const int nI_S = 17 * 32, nI_P = 8 * 5 * 32;
  for (int it = blockIdx.x; it < nI_S + nI_P; it += gridDim.x) {
    int seq, nb, cb;
    if (it < nI_S) { seq = 8; cb = it & 31; nb = it >> 5; }
    else { int j = it - nI_S; cb = j & 31; j >>= 5; nb = j % 5; seq = j / 5; }
    const int M = seq < 8 ? 257 : 1025, KP = seq < 8 ? 576 : 2112, L = 16 * M;
    const int n2 = nb * 64 + lane;
    const int ch = cb * 8 + wave * 2;
    const int g = ch >> 6, d = ch & 63;
    bf16_t* yb = Y + y_base(seq);
    if (n2 < M) {
      float zr[16][2], zi[16][2];
#pragma unroll
      for (int n1 = 0; n1 < 16; ++n1) {
        const bf16_t* zp = ZB + (size_t)(seq_base(seq) + M * n1 + n2) * 512 + g * 128 + d;
        unsigned re = *(const unsigned*)zp, im = *(const unsigned*)(zp + 64);
        zr[n1][0] = lo2f(re); zr[n1][1] = hi2f(re); zi[n1][0] = lo2f(im); zi[n1][1] = hi2f(im);
      }
      for (int k1 = 0; k1 < 16; ++k1) {
        float ws_, wc_;
        sincospif(-(float)k1 / 8.f, &ws_, &wc_);
        float ar0 = zr[15][0], ai0 = zi[15][0], ar1 = zr[15][1], ai1 = zi[15][1];
#pragma unroll
        for (int n1 = 14; n1 >= 0; --n1) {
          float t0 = ar0 * wc_ - ai0 * ws_ + zr[n1][0]; ai0 = ar0 * ws_ + ai0 * wc_ + zi[n1][0]; ar0 = t0;
          float t1 = ar1 * wc_ - ai1 * ws_ + zr[n1][1]; ai1 = ar1 * ws_ + ai1 * wc_ + zi[n1][1]; ar1 = t1;
        }
        float ts, tc;
        sincospif(-2.f * (float)(k1 * n2) / (float)L, &ts, &tc);
        float yr0 = ar0 * tc - ai0 * ts, yi0 = ar0 * ts + ai0 * tc;
        float yr1 = ar1 * tc - ai1 * ts, yi1 = ar1 * ts + ai1 * tc;
        bf16_t* y0 = yb + ((size_t)k1 * 256 + ch) * KP;
        y0[n2] = f2bf(yr0); y0[M + n2] = f2bf(yi0);
        y0[KP + n2] = f2bf(yr1); y0[KP + M + n2] = f2bf(yi1);
      }
    } else if (n2 < KP - M) {
      for (int k1 = 0; k1 < 16; ++k1) {
        bf16_t* y0 = yb + ((size_t)k1 * 256 + ch) * KP;
        y0[M + n2] = 0; y0[KP + M + n2] = 0;
      }
    }
  }
}

DI void phase_fnet_gemm(const P& p, char* lds) {
  GEMM_IDS
  bf16_t* MIX = (bf16_t*)(p.ws + O_MIX);
  const bf16_t* Y = (const bf16_t*)(p.ws + O_Y);
  const int nS = 16 * 9 * 2, nP = 8 * 16 * 3 * 2;
  for (int it = blockIdx.x; it < nS + nP; it += gridDim.x) {
    int seq, k1, tm, tn;
    if (it < nS) { seq = 8; tn = it & 1; int j = it >> 1; tm = j % 9; k1 = j / 9; }
    else { int j = it - nS; tn = j & 1; j >>= 1; tm = j % 3; j /= 3; k1 = j & 15; seq = j >> 4; }
    const int M = seq < 8 ? 257 : 1025, KP = seq < 8 ? 576 : 2112, L = 16 * M;
    const bf16_t* dm = (const bf16_t*)(p.ws + (seq < 8 ? O_DM257 : O_DM1025));
    f32x16 acc[2][2];
    gemm_tile(dm + (size_t)tm * 128 * KP, KP, Y + y_base(seq) + ((size_t)k1 * 256 + tn * 128) * KP, KP, KP, lds, acc);
    const float scale = rsqrtf(64.f * (float)L);
#pragma unroll
    for (int mt = 0; mt < 2; ++mt)
#pragma unroll
      for (int nt = 0; nt < 2; ++nt)
#pragma unroll
        for (int i = 0; i < 16; ++i) {
          int k2 = tm * 128 + ACC_ROW(mt, i), ch = tn * 128 + ACC_COL(nt);
          if (k2 < M) {
            int pos = k1 + 16 * k2;
            MIX[(size_t)(seq_base(seq) + pos) * 1024 + 768 + ch] = f2bf(acc[mt][nt][i] * scale + p.b_b[ch]);
          }
        }
  }
}

DI size_t vtc_base(int seq) { return seq < 8 ? (size_t)seq * 128 * 4160 : (size_t)8 * 128 * 4160; }
DI void phase_prepC(const P& p) {
  const int gtid = blockIdx.x * 256 + threadIdx.x, gsz = gridDim.x * 256;
  const int lane = threadIdx.x & 63, gw = gtid >> 6, nw = gsz >> 6;
  bf16_t* PC = (bf16_t*)(p.ws + O_PC);
  bf16_t* VT = (bf16_t*)(p.ws + O_VTC);
  const bf16_t* PLOW = (const bf16_t*)(p.ws + O_PLOW);
  bf16_t* LR = (bf16_t*)(p.ws + O_LR);
  for (int it = gtid; it < 9 * 2 * 64 * 48; it += gsz) {
    int k = it % 48, rowi = it / 48;
    int seq = rowi / 128, rr = rowi - seq * 128;
    VT[vtc_base(seq) + (size_t)rr * (seq < 8 ? 4160 : 16448) + k] = 0;
  }
  for (int sr = gw; sr < T_; sr += nw) {
    int pos; int b = seq_of(sr, pos);
    const int L = seq_len(b), LP = L + 48;
    bf16_t* pr = PC + (size_t)sr * 768;
    float cs[8], sn[8];
#pragma unroll
    for (int j = 0; j < 8; ++j) sincosf((float)pos * exp2f(-(float)j * (18.931568569324174f / 8.f)), &sn[j], &cs[j]);
#pragma unroll
    for (int part = 0; part < 2; ++part) {
      const bool act = part == 0 || lane < 16;
      const int col = part * 512 + (act ? lane : 0) * 8;
      uint4 u = *(const uint4*)(pr + col);
      float e[8] = {lo2f(u.x), hi2f(u.x), lo2f(u.y), hi2f(u.y), lo2f(u.z), hi2f(u.z), lo2f(u.w), hi2f(u.w)};
      float o[8];
#pragma unroll
      for (int j = 0; j < 8; ++j) {
        float pa = __shfl_xor(e[j], 1);
        float rot = e[j] * cs[j] + pa * ((lane & 1) ? sn[j] : -sn[j]);
        o[j] = (lane & 7) < 2 ? rot : e[j];
        if (part == 0) o[j] *= 0.125f * LOG2E;
      }
      if (act) *(uint4*)(pr + col) = make_uint4(pack2(o[0], o[1]), pack2(o[2], o[3]), pack2(o[4], o[5]), pack2(o[6], o[7]));
    }
    bf16_t* vt = VT + vtc_base(b);
    for (int kv = 0; kv < 2; ++kv) vt[(size_t)(kv * 64 + lane) * LP + pos + 48] = pr[640 + kv * 64 + lane];
#pragma unroll
    for (int q = 0; q < 6; ++q) {
      int c = q * 64 + lane;
      float u = bf2f(PLOW[(size_t)sr * 384 + c]);
      float up = pos > 0 ? bf2f(PLOW[(size_t)(sr - 1) * 384 + c]) : 0.f;
      float un = pos < L - 1 ? bf2f(PLOW[(size_t)(sr + 1) * 384 + c]) : 0.f;
      float us = u + p.mu_prev[1536 + c] * (up - u) + p.mu_next[1536 + c] * (un - u);
      float v = c < 128 ? tanhf(us) : (c < 256 ? us : sigmoidf_(us));
      LR[(size_t)sr * 384 + c] = f2bf(v);
    }
  }
}

DI void phase_attnC(const P& p, char* lds) {
  const bf16_t* PC = (const bf16_t*)(p.ws + O_PC);
  const bf16_t* VT = (const bf16_t*)(p.ws + O_VTC);
  bf16_t* MIX = (bf16_t*)(p.ws + O_MIX);
  const int nS = 129 * 8, nP = 8 * 33 * 8;
  for (int it = blockIdx.x; it < nS + nP; it += gridDim.x) {
    int seq, qt, hq;
    if (it < nS) { seq = 8; hq = it & 7; qt = it >> 3; }
    else { int j = it - nS; hq = j & 7; j >>= 3; qt = j % 33; seq = j / 33; }
    const int kv = hq >> 2;
    const int L = seq_len(seq), LP = L + 48;
    flash_item<1>(PC + hq * 64, 768, PC + 512 + kv * 64, 768, VT + vtc_base(seq) + (size_t)kv * 64 * LP, LP,
                  MIX + hq * 64, 1024, seq_base(seq), L - 16, qt, p.c_sink[hq] * LOG2E, lds);
  }
}

DI void chunk_decode(int cg_, int& seq, int& c) {
  if (cg_ < 136) { seq = cg_ / 17; c = cg_ - seq * 17; } else { seq = 8; c = cg_ - 136; }
}
DI float shiftv(const bf16_t* PRKV, int sr, int pos, int L, int col, float mp, float mn) {
  float u = bf2f(PRKV[(size_t)sr * 1536 + col]);
  float up = pos > 0 ? bf2f(PRKV[(size_t)(sr - 1) * 1536 + col]) : 0.f;
  float un = pos < L - 1 ? bf2f(PRKV[(size_t)(sr + 1) * 1536 + col]) : 0.f;
  return u + mp * (up - u) + mn * (un - u);
}
DI void scan_prologue(const P& p, int sbase, int L, int hd, int dir, int pos0, int nsteps, float* sv, bool write_bonus) {
  const int lane = threadIdx.x & 63, wave = threadIdx.x >> 6;
  const bf16_t* PRKV = (const bf16_t*)(p.ws + O_PRKV);
  const bf16_t* LR = (const bf16_t*)(p.ws + O_LR);
  float* bonus = (float*)(p.ws + O_BONUS);
  const int c = hd * 64 + lane;
  const float mpr = p.mu_prev[c], mnr = p.mu_next[c], mpk = p.mu_prev[512 + c], mnk = p.mu_next[512 + c], mpv = p.mu_prev[1024 + c], mnv = p.mu_next[1024 + c];
  float r[4], k[4], v[4], lw[4], la[4], wpre[4], apre[4];
#pragma unroll
  for (int q = 0; q < 4; ++q) {
    int s = wave * 4 + q;
    int ss = s < nsteps ? s : nsteps - 1;
    int pos = dir ? pos0 - ss : pos0 + ss;
    int sr = sbase + pos;
    r[q] = shiftv(PRKV, sr, pos, L, c, mpr, mnr);
    k[q] = shiftv(PRKV, sr, pos, L, 512 + c, mpk, mnk);
    v[q] = shiftv(PRKV, sr, pos, L, 1024 + c, mpv, mnv);
    lw[q] = bf2f(LR[(size_t)sr * 384 + dir * 64 + lane]);
    la[q] = bf2f(LR[(size_t)sr * 384 + 128 + dir * 64 + lane]);
    wpre[q] = p.d_w0[dir * 512 + c];
    apre[q] = p.d_a0[dir * 512 + c];
  }
  const float* wu = p.d_w_up + (size_t)dir * 64 * 512 + c;
  const float* au = p.d_a_up + (size_t)dir * 64 * 512 + c;
  for (int m = 0; m < 64; ++m) {
    float wv = wu[(size_t)m * 512], av = au[(size_t)m * 512];
#pragma unroll
    for (int q = 0; q < 4; ++q) {
      wpre[q] += __shfl(lw[q], m) * wv;
      apre[q] += __shfl(la[q], m) * av;
    }
  }
  const float kkc = p.d_k_k[c], kac = p.d_k_a[c], rkc = p.d_r_k[c];
#pragma unroll
  for (int q = 0; q < 4; ++q) {
    int s = wave * 4 + q;
    float x = -wpre[q];
    float sp = x > 20.f ? x : log1pf(expf(x));
    float wlog = -sp - 0.5f;
    float w = expf(-expf(wlog));
    float a = sigmoidf_(apre[q]);
    float kk = k[q] * kkc;
    float n2 = wave_sum(kk * kk);
    kk *= rsqrtf(fmaxf(n2, 1e-24f));
    float kd = k[q] * (1.f + (a - 1.f) * kac);
    sv[0 * 1024 + s * 64 + lane] = w;
    sv[1 * 1024 + s * 64 + lane] = -kk;
    sv[2 * 1024 + s * 64 + lane] = kk * a;
    sv[3 * 1024 + s * 64 + lane] = kd;
    sv[4 * 1024 + s * 64 + lane] = r[q];
    sv[5 * 1024 + s * 64 + lane] = v[q];
    float bn = wave_sum(r[q] * kd * rkc);
    if (write_bonus && s < nsteps && lane == 0) {
      int pos = dir ? pos0 - s : pos0 + s;
      bonus[((size_t)(sbase + pos) * 8 + hd) * 2 + dir] = bn;
    }
  }
}

DI void phase_scan1(const P& p, char* lds) {
  float* sv = (float*)lds;
  float* PQ = (float*)(p.ws + O_PQ);
  const int tid = threadIdx.x, row = tid >> 1, hf = tid & 1, j0 = hf * 32;
  for (int it = blockIdx.x; it < 3216; it += gridDim.x) {
    const int dir = it & 1, hd = (it >> 1) & 7, cgi = it >> 4;
    int seq, c; chunk_decode(cgi, seq, c);
    const int L = seq_len(seq), sbase = seq_base(seq);
    const int start = c * 256, end = min(L, start + 256), n = end - start;
    float S[32];
#pragma unroll
    for (int jj = 0; jj < 32; ++jj) S[jj] = (row < 64 && j0 + jj == row) ? 1.f : 0.f;
    for (int s0 = 0; s0 < n; s0 += 16) {
      const int ns = min(16, n - s0);
      const int pos0 = dir ? end - 1 - s0 : start + s0;
      __syncthreads();
      scan_prologue(p, sbase, L, hd, dir, pos0, ns, sv, false);
      __syncthreads();
      for (int s = 0; s < ns; ++s) {
        const float* wv = sv + s * 64 + j0;
        const float* av = sv + 1024 + s * 64 + j0;
        const float* bv = sv + 2048 + s * 64 + j0;
        const float* kv = sv + 3072 + s * 64 + j0;
        const float vi = row >= 64 ? sv[5 * 1024 + s * 64 + (row - 64)] : 0.f;
        float sa = 0.f;
#pragma unroll
        for (int jj = 0; jj < 32; ++jj) sa += S[jj] * av[jj];
        sa += __shfl_xor(sa, 1);
#pragma unroll
        for (int jj = 0; jj < 32; ++jj) S[jj] = S[jj] * wv[jj] + sa * bv[jj] + vi * kv[jj];
      }
    }
    float* dst = PQ + (size_t)it * 8192 + (size_t)row * 64 + j0;
#pragma unroll
    for (int q = 0; q < 8; ++q) *(float4*)(dst + q * 4) = make_float4(S[q * 4], S[q * 4 + 1], S[q * 4 + 2], S[q * 4 + 3]);
  }
}

DI void phase_scan2(const P& p, char* lds) {
  float* Ss = (float*)lds;
  float* Ps = Ss + 64 * 65;
  float* PQ = (float*)(p.ws + O_PQ);
  const int tid = threadIdx.x, i = tid >> 2, q = tid & 3, j0 = q * 16;
  for (int it = blockIdx.x; it < 144; it += gridDim.x) {
    const int dir = it & 1, hd = (it >> 1) & 7, seq = it >> 4;
    const int nch = seq < 8 ? 17 : 65, cg0 = seq < 8 ? seq * 17 : 136;
    float S[16];
#pragma unroll
    for (int jj = 0; jj < 16; ++jj) S[jj] = 0.f;
    for (int cc = 0; cc < nch; ++cc) {
      const int c = dir ? nch - 1 - cc : cc;
      float* Pg = PQ + (size_t)(((cg0 + c) * 8 + hd) * 2 + dir) * 8192;
      float* Qg = Pg + 4096;
      __syncthreads();
#pragma unroll
      for (int jj = 0; jj < 16; ++jj) Ss[i * 65 + j0 + jj] = S[jj];
#pragma unroll
      for (int r4 = 0; r4 < 4; ++r4) *(float4*)(Ps + (r4 * 256 + tid) * 4) = *(const float4*)(Pg + (r4 * 256 + tid) * 4);
      float acc[16];
#pragma unroll
      for (int r4 = 0; r4 < 4; ++r4) {
        float4 qv = *(const float4*)(Qg + i * 64 + j0 + r4 * 4);
        acc[r4 * 4] = qv.x; acc[r4 * 4 + 1] = qv.y; acc[r4 * 4 + 2] = qv.z; acc[r4 * 4 + 3] = qv.w;
      }
#pragma unroll
      for (int r4 = 0; r4 < 4; ++r4) *(float4*)(Qg + i * 64 + j0 + r4 * 4) = make_float4(S[r4 * 4], S[r4 * 4 + 1], S[r4 * 4 + 2], S[r4 * 4 + 3]);
      __syncthreads();
      for (int m = 0; m < 64; ++m) {
        const float sm = Ss[i * 65 + m];
        const float* pr = Ps + m * 64 + j0;
#pragma unroll
        for (int jj = 0; jj < 16; ++jj) acc[jj] += sm * pr[jj];
      }
#pragma unroll
      for (int jj = 0; jj < 16; ++jj) S[jj] = acc[jj];
    }
  }
}

DI void phase_scan3(const P& p, char* lds) {
  float* sv = (float*)lds;
  const float* PQ = (const float*)(p.ws + O_PQ);
  bf16_t* MIX = (bf16_t*)(p.ws + O_MIX);
  bf16_t* OB = (bf16_t*)(p.ws + O_OB);
  const int tid = threadIdx.x, row = tid >> 2, q = tid & 3, j0 = q * 16;
  for (int it = blockIdx.x; it < 3216; it += gridDim.x) {
    const int dir = it & 1, hd = (it >> 1) & 7, cgi = it >> 4;
    int seq, c; chunk_decode(cgi, seq, c);
    const int L = seq_len(seq), sbase = seq_base(seq);
    const int start = c * 256, end = min(L, start + 256), n = end - start;
    float S[16];
    {
      const float* src = PQ + (size_t)it * 8192 + 4096 + row * 64 + j0;
#pragma unroll
      for (int r4 = 0; r4 < 4; ++r4) { float4 t = *(const float4*)(src + r4 * 4); S[r4 * 4] = t.x; S[r4 * 4 + 1] = t.y; S[r4 * 4 + 2] = t.z; S[r4 * 4 + 3] = t.w; }
    }
    for (int s0 = 0; s0 < n; s0 += 16) {
      const int ns = min(16, n - s0);
      const int pos0 = dir ? end - 1 - s0 : start + s0;
      __syncthreads();
      scan_prologue(p, sbase, L, hd, dir, pos0, ns, sv, true);
      __syncthreads();
      for (int s = 0; s < ns; ++s) {
        const float* wv = sv + s * 64 + j0;
        const float* av = sv + 1024 + s * 64 + j0;
        const float* bv = sv + 2048 + s * 64 + j0;
        const float* kv = sv + 3072 + s * 64 + j0;
        const float* rv = sv + 4096 + s * 64 + j0;
        const float vi = sv[5 * 1024 + s * 64 + row];
        float sa = 0.f;
#pragma unroll
        for (int jj = 0; jj < 16; ++jj) sa += S[jj] * av[jj];
        sa += __shfl_xor(sa, 1);
        sa += __shfl_xor(sa, 2);
        float o = 0.f;
#pragma unroll
        for (int jj = 0; jj < 16; ++jj) { S[jj] = S[jj] * wv[jj] + sa * bv[jj] + vi * kv[jj]; o += S[jj] * rv[jj]; }
        o += __shfl_xor(o, 1);
        o += __shfl_xor(o, 2);
        if (q == 0) {
          const int pos = dir ? pos0 - s : pos0 + s;
          const size_t sr = (size_t)(sbase + pos);
          if (dir == 0) MIX[sr * 1024 + 512 + hd * 64 + row] = f2bf(o);
          else OB[sr * 512 + hd * 64 + row] = f2bf(o);
        }
      }
    }
  }
}

DI void phase_rwkv_final(const P& p) {
  const int lane = threadIdx.x & 63, gw = (blockIdx.x * 256 + threadIdx.x) >> 6, nw = (gridDim.x * 256) >> 6;
  bf16_t* MIX = (bf16_t*)(p.ws + O_MIX);
  const bf16_t* OB = (const bf16_t*)(p.ws + O_OB);
  const bf16_t* G = (const bf16_t*)(p.ws + O_G);
  const bf16_t* PRKV = (const bf16_t*)(p.ws + O_PRKV);
  const float* bonus = (const float*)(p.ws + O_BONUS);
  const int hd = lane >> 3, c0 = lane * 8;
  for (int sr = gw; sr < T_; sr += nw) {
    int pos; int b = seq_of(sr, pos);
    const int L = seq_len(b);
    uint4 uf = *(const uint4*)(MIX + (size_t)sr * 1024 + 512 + c0);
    uint4 ub = *(const uint4*)(OB + (size_t)sr * 512 + c0);
    uint4 ug = *(const uint4*)(G + (size_t)sr * 512 + c0);
    unsigned f_[4] = {uf.x, uf.y, uf.z, uf.w}, b_[4] = {ub.x, ub.y, ub.z, ub.w}, g_[4] = {ug.x, ug.y, ug.z, ug.w};
    float o[8], gg[8];
    float sm = 0.f;
#pragma unroll
    for (int j = 0; j < 4; ++j) {
      o[2 * j] = lo2f(f_[j]) + lo2f(b_[j]); o[2 * j + 1] = hi2f(f_[j]) + hi2f(b_[j]);
      gg[2 * j] = lo2f(g_[j]); gg[2 * j + 1] = hi2f(g_[j]);
      sm += o[2 * j] + o[2 * j + 1];
    }
    sm += __shfl_xor(sm, 1); sm += __shfl_xor(sm, 2); sm += __shfl_xor(sm, 4);
    const float mean = sm * (1.f / 64.f);
    float vs = 0.f;
#pragma unroll
    for (int j = 0; j < 8; ++j) { float dlt = o[j] - mean; vs += dlt * dlt; }
    vs += __shfl_xor(vs, 1); vs += __shfl_xor(vs, 2); vs += __shfl_xor(vs, 4);
    const float rstd = rsqrtf(vs * (1.f / 64.f) + 64e-5f);
    const float bsum = bonus[((size_t)sr * 8 + hd) * 2] + bonus[((size_t)sr * 8 + hd) * 2 + 1];
    float y[8];
#pragma unroll
    for (int j = 0; j < 8; ++j) {
      int c = c0 + j;
      float vsh = shiftv(PRKV, sr, pos, L, 1024 + c, p.mu_prev[1024 + c], p.mu_next[1024 + c]);
      y[j] = ((o[j] - mean) * rstd * p.d_ln_g[c] + p.d_ln_b[c] + bsum * vsh) * gg[j];
    }
    *(uint4*)(MIX + (size_t)sr * 1024 + 512 + c0) = make_uint4(pack2(y[0], y[1]), pack2(y[2], y[3]), pack2(y[4], y[5]), pack2(y[6], y[7]));
  }
}

constexpr int NPHASE = 23;
constexpr int LDS_BYTES = 40960;
__global__ void __launch_bounds__(256, 2) mega(P p) {
  __shared__ __attribute__((aligned(16))) char lds[LDS_BYTES];
  char* ws = p.ws;
  if (p.ph0 <= 0 && 0 < p.ph1) { phase_prep(p); if (0 + 1 < p.ph1) cg::this_grid().sync(); }
  if (p.ph0 <= 1 && 1 < p.ph1) { phase_gemm_plain((const bf16_t*)(ws + O_HN), 1024, (const bf16_t*)(ws + O_WIN0), 1536, 1024, (bf16_t*)(ws + O_PROJ0), 1536, lds, 0, ws); if (1 + 1 < p.ph1) cg::this_grid().sync(); }
  if (p.ph0 <= 2 && 2 < p.ph1) { phase_prepA(p, lds); if (2 + 1 < p.ph1) cg::this_grid().sync(); }
  if (p.ph0 <= 3 && 3 < p.ph1) { phase_attnA(p, lds); if (3 + 1 < p.ph1) cg::this_grid().sync(); }
  if (p.ph0 <= 4 && 4 < p.ph1) { phase_fnet_gemm(p, lds); if (4 + 1 < p.ph1) cg::this_grid().sync(); }
  if (p.ph0 <= 5 && 5 < p.ph1) { phase_gemm_plain((const bf16_t*)(ws + O_MIX), 1024, (const bf16_t*)(ws + O_WOUT0), 1024, 1024, (bf16_t*)(ws + O_HN), 1024, lds, 0, ws); if (5 + 1 < p.ph1) cg::this_grid().sync(); }
  if (p.ph0 <= 6 && 6 < p.ph1) { phase_resnorm(p, p.post_mix_g, p.pre_ffn_g); if (6 + 1 < p.ph1) cg::this_grid().sync(); }
  if (p.ph0 <= 7 && 7 < p.ph1) { phase_gemm_gateup((const bf16_t*)(ws + O_HN), (const bf16_t*)(ws + O_WGU0), (bf16_t*)(ws + O_ACT), lds); if (7 + 1 < p.ph1) cg::this_grid().sync(); }
  if (p.ph0 <= 8 && 8 < p.ph1) { phase_gemm_plain((const bf16_t*)(ws + O_ACT), DFF, (const bf16_t*)(ws + O_WD0), 1024, DFF, (bf16_t*)(ws + O_HN), 1024, lds, 0, ws); if (8 + 1 < p.ph1) cg::this_grid().sync(); }
  if (p.ph0 <= 9 && 9 < p.ph1) { phase_resnorm(p, p.post_ffn_g, p.pre_mix_g + 1024); if (9 + 1 < p.ph1) cg::this_grid().sync(); }
  if (p.ph0 <= 10 && 10 < p.ph1) { phase_gemm_plain((const bf16_t*)(ws + O_HN), 1024, (const bf16_t*)(ws + O_WIN1), 2688, 1024, nullptr, 0, lds, 1, ws); if (10 + 1 < p.ph1) cg::this_grid().sync(); }
  if (p.ph0 <= 11 && 11 < p.ph1) { phase_prepC(p); if (11 + 1 < p.ph1) cg::this_grid().sync(); }
  if (p.ph0 <= 12 && 12 < p.ph1) { phase_attnC(p, lds); if (12 + 1 < p.ph1) cg::this_grid().sync(); }
  if (p.ph0 <= 13 && 13 < p.ph1) { phase_scan1(p, lds); if (13 + 1 < p.ph1) cg::this_grid().sync(); }
  if (p.ph0 <= 14 && 14 < p.ph1) { phase_scan2(p, lds); if (14 + 1 < p.ph1) cg::this_grid().sync(); }
  if (p.ph0 <= 15 && 15 < p.ph1) { phase_scan3(p, lds); if (15 + 1 < p.ph1) cg::this_grid().sync(); }
  if (p.ph0 <= 16 && 16 < p.ph1) { phase_gemm_plain((const bf16_t*)(ws + O_LR) + 256, 384, (const bf16_t*)(ws + O_GUP), 512, 128, (bf16_t*)(ws + O_G), 512, lds, 0, ws); if (16 + 1 < p.ph1) cg::this_grid().sync(); }
  if (p.ph0 <= 17 && 17 < p.ph1) { phase_rwkv_final(p); if (17 + 1 < p.ph1) cg::this_grid().sync(); }
  if (p.ph0 <= 18 && 18 < p.ph1) { phase_gemm_plain((const bf16_t*)(ws + O_MIX), 1024, (const bf16_t*)(ws + O_WOUT1), 1024, 1024, (bf16_t*)(ws + O_HN), 1024, lds, 0, ws); if (18 + 1 < p.ph1) cg::this_grid().sync(); }
  if (p.ph0 <= 19 && 19 < p.ph1) { phase_resnorm(p, p.post_mix_g + 1024, p.pre_ffn_g + 1024); if (19 + 1 < p.ph1) cg::this_grid().sync(); }
  if (p.ph0 <= 20 && 20 < p.ph1) { phase_gemm_gateup((const bf16_t*)(ws + O_HN), (const bf16_t*)(ws + O_WGU1), (bf16_t*)(ws + O_ACT), lds); if (20 + 1 < p.ph1) cg::this_grid().sync(); }
  if (p.ph0 <= 21 && 21 < p.ph1) { phase_gemm_plain((const bf16_t*)(ws + O_ACT), DFF, (const bf16_t*)(ws + O_WD1), 1024, DFF, (bf16_t*)(ws + O_HN), 1024, lds, 0, ws); if (21 + 1 < p.ph1) cg::this_grid().sync(); }
  if (p.ph0 <= 22 && 22 < p.ph1) { phase_resnorm(p, p.post_ffn_g + 1024, nullptr); if (22 + 1 < p.ph1) cg::this_grid().sync(); }
}

extern "C" void kernel_launch(void* const* d_in, const int* in_sizes, int n_in, void* d_out, int out_size, void* d_ws, size_t ws_size,
                              hipStream_t stream) {
  static int grid_blocks = 0;
  if (!grid_blocks) {
    int dev = 0, cus = 0, per_cu = 0;
    hipGetDevice(&dev);
    hipDeviceGetAttribute(&cus, hipDeviceAttributeMultiprocessorCount, dev);
    hipOccupancyMaxActiveBlocksPerMultiprocessor(&per_cu, mega, 256, 0);
    if (per_cu > 2) per_cu = 2;
    if (per_cu < 1) per_cu = 1;
    grid_blocks = cus * per_cu;
  }
  if (ws_size < O_END) { fprintf(stderr, "workspace too small\n"); return; }
  P p{};
  const float** f = (const float**)&p;
  for (int i = 0; i < 32; ++i) f[i] = (const float*)d_in[i];
  p.out = (float*)d_out;
  p.ws = (char*)d_ws;
#if FUSED
  p.ph0 = 0; p.ph1 = NPHASE;
  void* args[] = {&p};
  hipError_t e = hipLaunchCooperativeKernel((void*)mega, dim3(grid_blocks), dim3(256), args, 0, stream);
  if (e != hipSuccess) fprintf(stderr, "cooperative launch failed: %s (grid %d)\n", hipGetErrorString(e), grid_blocks);
#else
  for (int ph = 0; ph < NPHASE; ++ph) {
    p.ph0 = ph; p.ph1 = ph + 1;
    hipLaunchKernelGGL(mega, dim3(grid_blocks), dim3(256), 0, stream, p);
  }
#endif
}
```

```cpp
#include <hip/hip_runtime.h>
#include <hip/hip_cooperative_groups.h>
#include <cstdio>
namespace cg = cooperative_groups;

#ifndef FUSED
#define FUSED 1
#endif

typedef unsigned short bf16_t;
using bf16x8 = __attribute__((ext_vector_type(8))) short;
using s16x4 = __attribute__((ext_vector_type(4))) short;
using f32x16 = __attribute__((ext_vector_type(16))) float;
using u32x4 = __attribute__((ext_vector_type(4))) unsigned;
#define DI __device__ __forceinline__
#define MFMA32(a, b, c) __builtin_amdgcn_mfma_f32_32x32x16_bf16((a), (b), (c), 0, 0, 0)
constexpr int NTH = 512;
constexpr int LDS_BYTES = 131072;

constexpr int DM_ = 1024;
constexpr int T_ = 49296;
constexpr int TP_ = 49408;
constexpr int NT_ = TP_ / 128;
constexpr int DFF = 2816;
constexpr float EPS = 1e-6f;
constexpr float LOG2E = 1.4426950408889634f;

constexpr size_t SZ_ROW1024 = (size_t)TP_ * 1024 * 2;
constexpr size_t O_WIN0 = 0;
constexpr size_t O_WOUT0 = O_WIN0 + (size_t)1536 * 1024 * 2;
constexpr size_t O_WGU0 = O_WOUT0 + (size_t)1024 * 1024 * 2;
constexpr size_t O_WD0 = O_WGU0 + (size_t)5632 * 1024 * 2;
constexpr size_t O_DM257 = O_WD0 + (size_t)1024 * 2816 * 2;
constexpr size_t O_DM1025 = O_DM257 + (size_t)384 * 576 * 2;
constexpr size_t O_WIN1 = O_DM1025 + (size_t)1152 * 2112 * 2;
constexpr size_t O_WOUT1 = O_WIN1 + (size_t)2816 * 1024 * 2;
constexpr size_t O_WGU1 = O_WOUT1 + (size_t)1024 * 1024 * 2;
constexpr size_t O_WD1 = O_WGU1 + (size_t)5632 * 1024 * 2;
constexpr size_t O_GUP = O_WD1 + (size_t)1024 * 2816 * 2;
constexpr size_t O_RA = O_GUP + (size_t)512 * 128 * 2;
constexpr size_t O_RB = O_RA + SZ_ROW1024;
constexpr size_t O_RC = O_RB + (size_t)TP_ * 2816 * 2;
constexpr size_t O_META = O_RC + SZ_ROW1024;
constexpr size_t O_WC = O_META + (size_t)144 * 1024 * 4;
constexpr size_t O_WUPT = O_WC + (size_t)4 * 64 * 128 * 4;
constexpr size_t O_AUPT = O_WUPT + (size_t)2 * 512 * 64 * 2;
constexpr size_t O_END = O_AUPT + (size_t)2 * 512 * 64 * 2;
constexpr size_t O_HN = O_RA;
constexpr size_t O_VTA = O_RA;
constexpr size_t O_LR = O_RA;
constexpr size_t O_BONUS = O_RA + (size_t)TP_ * 384 * 2;
constexpr size_t O_VTC = O_BONUS + (size_t)T_ * 16 * 4;
constexpr size_t O_OB = O_RA + (size_t)TP_ * 512 * 2;
constexpr size_t O_PROJ0 = O_RB;
constexpr size_t O_ZB = O_PROJ0 + (size_t)TP_ * 1536 * 2;
constexpr size_t O_Y = O_ZB + (size_t)TP_ * 512 * 2;
constexpr size_t O_ACT = O_RB;
constexpr size_t O_PRKV = O_RB;
constexpr size_t O_PC = O_PRKV + (size_t)TP_ * 1536 * 2;
constexpr size_t O_PLOW = O_PC + (size_t)TP_ * 768 * 2;
constexpr size_t O_PQ = O_PC;
constexpr size_t O_G = O_PC;
constexpr size_t O_MIX = O_RC;
static_assert(O_VTC + (size_t)49728 * 128 * 2 <= O_RB, "vtc");
static_assert(O_Y + (size_t)(8 * 16 * 256 * 576 + 16 * 256 * 2112) * 2 <= O_RC, "y");
static_assert(O_PQ + (size_t)3216 * 32768 <= O_RC, "pq");
static_assert(O_END <= (size_t)536870912, "ws");

struct P {
  const float *x_prompt, *x_sample, *meta, *pre_mix_g, *post_mix_g, *pre_ffn_g, *post_ffn_g;
  const float *even_w_in, *even_w_out, *a_q_gain, *a_k_gain, *b_norm_g, *b_w, *b_b;
  const float *odd_w_in, *odd_w_out, *c_sink, *mu_prev, *mu_next, *d_w0, *d_w_up, *d_a0, *d_a_up, *d_g_up;
  const float *d_k_k, *d_k_a, *d_r_k, *d_ln_g, *d_ln_b, *ffn_gate, *ffn_up, *ffn_down;
  float* out;
  char* ws;
  int ph0, ph1;
};

DI bf16_t f2bf(float x) { unsigned u = __float_as_uint(x); u += 0x7fffu + ((u >> 16) & 1u); return (bf16_t)(u >> 16); }
DI float bf2f(bf16_t b) { return __uint_as_float(((unsigned)b) << 16); }
DI unsigned pack2(float a, float b) { return (unsigned)f2bf(a) | ((unsigned)f2bf(b) << 16); }
DI float lo2f(unsigned u) { return __uint_as_float(u << 16); }
DI float hi2f(unsigned u) { return __uint_as_float(u & 0xffff0000u); }
DI float wave_sum(float v) {
  for (int o = 32; o > 0; o >>= 1) v += __shfl_xor(v, o);
  return v;
}
DI int seq_of(int sr, int& pos) {
  if (sr < 32896) { int b = sr / 4112; pos = sr - b * 4112; return b; }
  pos = sr - 32896; return 8;
}
DI int seq_len(int b) { return b < 8 ? 4112 : 16400; }
DI int seq_base(int b) { return b < 8 ? b * 4112 : 32896; }
DI float* hrow(const P& p, int sr) {
  int pos; int b = seq_of(sr, pos);
  if (pos < 16) return (float*)(p.ws + O_META) + (size_t)(b * 16 + pos) * 1024;
  return p.out + ((size_t)(b < 8 ? b * 4096 : 32768) + (pos - 16)) * 1024;
}
DI float sigmoidf_(float x) { return 1.f / (1.f + expf(-x)); }

DI void transpose_w(const float* W, int K, int ldw, int N, bf16_t* Wt, int mode, const float* W2, int gtid, int gsz) {
  int nk8 = K / 8;
  long total = (long)N * nk8;
  for (long it = gtid; it < total; it += gsz) {
    int n = (int)(it % N), k8 = (int)(it / N);
    const float* src = W;
    int c = n;
    if (mode == 1) {
      int blk = n >> 8, w = n & 255;
      c = blk * 128 + (w & 127);
      if (w >= 128) src = W2;
    }
    unsigned r[4];
#pragma unroll
    for (int j = 0; j < 4; ++j) {
      float a = src[(size_t)(k8 * 8 + 2 * j) * ldw + c];
      float b = src[(size_t)(k8 * 8 + 2 * j + 1) * ldw + c];
      r[j] = pack2(a, b);
    }
    *(uint4*)(Wt + (size_t)n * K + k8 * 8) = make_uint4(r[0], r[1], r[2], r[3]);
  }
}

DI void phase_prep(const P& p) {
  const int gtid = blockIdx.x * NTH + threadIdx.x, gsz = gridDim.x * NTH;
  char* ws = p.ws;
  transpose_w(p.even_w_in, 1024, 1536, 1536, (bf16_t*)(ws + O_WIN0), 0, nullptr, gtid, gsz);
  transpose_w(p.even_w_out, 1024, 1024, 1024, (bf16_t*)(ws + O_WOUT0), 0, nullptr, gtid, gsz);
  transpose_w(p.odd_w_in, 1024, 2688, 2688, (bf16_t*)(ws + O_WIN1), 0, nullptr, gtid, gsz);
  transpose_w(p.odd_w_out, 1024, 1024, 1024, (bf16_t*)(ws + O_WOUT1), 0, nullptr, gtid, gsz);
  transpose_w(p.ffn_gate, 1024, DFF, 5632, (bf16_t*)(ws + O_WGU0), 1, p.ffn_up, gtid, gsz);
  transpose_w(p.ffn_gate + (size_t)1024 * DFF, 1024, DFF, 5632, (bf16_t*)(ws + O_WGU1), 1, p.ffn_up + (size_t)1024 * DFF, gtid, gsz);
  transpose_w(p.ffn_down, DFF, 1024, 1024, (bf16_t*)(ws + O_WD0), 0, nullptr, gtid, gsz);
  transpose_w(p.ffn_down + (size_t)DFF * 1024, DFF, 1024, 1024, (bf16_t*)(ws + O_WD1), 0, nullptr, gtid, gsz);
  transpose_w(p.d_g_up, 128, 512, 512, (bf16_t*)(ws + O_GUP), 0, nullptr, gtid, gsz);
  for (int d = 0; d < 2; ++d) {
    transpose_w(p.d_w_up + (size_t)d * 64 * 512, 64, 512, 512, (bf16_t*)(ws + O_WUPT) + (size_t)d * 512 * 64, 0, nullptr, gtid, gsz);
    transpose_w(p.d_a_up + (size_t)d * 64 * 512, 64, 512, 512, (bf16_t*)(ws + O_AUPT) + (size_t)d * 512 * 64, 0, nullptr, gtid, gsz);
  }
  for (int it = gtid; it < 128 * 1024 / 8; it += gsz) *(uint4*)((bf16_t*)(ws + O_WIN1) + (size_t)2688 * 1024 + (size_t)it * 8) = make_uint4(0, 0, 0, 0);
  for (int which = 0; which < 2; ++which) {
    const int M = which ? 1025 : 257, MP = which ? 1152 : 384, KP = which ? 2112 : 576;
    bf16_t* dm = (bf16_t*)(ws + (which ? O_DM1025 : O_DM257));
    for (int it = gtid; it < MP * KP; it += gsz) {
      int r = it / KP, c = it - r * KP;
      float v = 0.f;
      if (r < M && c < 2 * M) {
        int n2 = c < M ? c : c - M;
        int m = (r * n2) % M;
        float s, co;
        sincospif(2.0f * (float)m / (float)M, &s, &co);
        v = c < M ? co : s;
      }
      dm[it] = f2bf(v);
    }
  }
  for (int it = gtid; it < 4 * 64 * 128; it += gsz) {
    int o = it & 127, c = (it >> 7) & 63, g = it >> 13;
    int d = o & 63;
    float acc = 0.f;
    for (int c2 = 0; c2 < 64; ++c2) {
      float s, co;
      sincospif((float)((c * c2) & 63) / 32.f, &s, &co);
      float w = p.b_w[(g * 64 + c2) * 64 + d];
      acc += (o < 64 ? co : -s) * w;
    }
    ((float*)(ws + O_WC))[it] = acc;
  }
  const int lane = threadIdx.x & 63, gw = gtid >> 6, nw = gsz >> 6;
  bf16_t* HN = (bf16_t*)(ws + O_HN);
  for (int sr = gw; sr < TP_; sr += nw) {
    if (sr >= T_) {
#pragma unroll
      for (int q = 0; q < 2; ++q) *(uint4*)(HN + (size_t)sr * 1024 + q * 512 + lane * 8) = make_uint4(0, 0, 0, 0);
      continue;
    }
    int pos; int b = seq_of(sr, pos);
    const float* src = pos < 16 ? p.meta + pos * 1024
                                : (b < 8 ? p.x_prompt + ((size_t)b * 4096 + pos - 16) * 1024 : p.x_sample + (size_t)(pos - 16) * 1024);
    float* hr = hrow(p, sr);
    float4 v[4];
    float ss = 0.f;
#pragma unroll
    for (int q = 0; q < 4; ++q) {
      v[q] = *(const float4*)(src + q * 256 + lane * 4);
      ss += v[q].x * v[q].x + v[q].y * v[q].y + v[q].z * v[q].z + v[q].w * v[q].w;
      *(float4*)(hr + q * 256 + lane * 4) = v[q];
    }
    ss = wave_sum(ss);
    float rs = rsqrtf(ss * (1.f / 1024.f) + EPS);
#pragma unroll
    for (int q = 0; q < 4; ++q) {
      float4 g = *(const float4*)(p.pre_mix_g + q * 256 + lane * 4);
      uint2 o = make_uint2(pack2(v[q].x * rs * g.x, v[q].y * rs * g.y), pack2(v[q].z * rs * g.z, v[q].w * rs * g.w));
      *(uint2*)(HN + (size_t)sr * 1024 + q * 256 + lane * 4) = o;
    }
  }
}

DI void gemm_tile(const bf16_t* __restrict__ A, int lda, const bf16_t* __restrict__ B, int ldb, int K, char* lds, f32x16 (&acc)[2][2]) {
  const int tid = threadIdx.x & 255, lane = tid & 63, wave = tid >> 6, wm = wave >> 1, wn = wave & 1;
  const int l31 = lane & 31, h = lane >> 5;
  bf16_t* As = (bf16_t*)lds;
  bf16_t* Bs = As + 128 * 72;
#pragma unroll
  for (int a = 0; a < 2; ++a)
#pragma unroll
    for (int b = 0; b < 2; ++b)
#pragma unroll
      for (int i = 0; i < 16; ++i) acc[a][b][i] = 0.f;
  const int lr = tid >> 3, lc = (tid & 7) * 8;
  const bf16_t* Ag = A + (size_t)lr * lda + lc;
  const bf16_t* Bg = B + (size_t)lr * ldb + lc;
  u32x4 ra[4], rb[4];
#pragma unroll
  for (int q = 0; q < 4; ++q) {
    ra[q] = *(const u32x4*)(Ag + (size_t)(32 * q) * lda);
    rb[q] = *(const u32x4*)(Bg + (size_t)(32 * q) * ldb);
  }
#pragma unroll
  for (int q = 0; q < 4; ++q) {
    *(u32x4*)(As + (lr + 32 * q) * 72 + lc) = ra[q];
    *(u32x4*)(Bs + (lr + 32 * q) * 72 + lc) = rb[q];
  }
  __syncthreads();
  const int nk = K >> 6;
  for (int kt = 0; kt < nk; ++kt) {
    if (kt + 1 < nk) {
#pragma unroll
      for (int q = 0; q < 4; ++q) {
        ra[q] = *(const u32x4*)(Ag + (size_t)(32 * q) * lda + (kt + 1) * 64);
        rb[q] = *(const u32x4*)(Bg + (size_t)(32 * q) * ldb + (kt + 1) * 64);
      }
    }
#pragma unroll
    for (int ks = 0; ks < 4; ++ks) {
      bf16x8 a[2], b[2];
#pragma unroll
      for (int t = 0; t < 2; ++t) {
        a[t] = *(const bf16x8*)(As + (wm * 64 + t * 32 + l31) * 72 + ks * 16 + 8 * h);
        b[t] = *(const bf16x8*)(Bs + (wn * 64 + t * 32 + l31) * 72 + ks * 16 + 8 * h);
      }
#pragma unroll
      for (int mt = 0; mt < 2; ++mt)
#pragma unroll
        for (int nt = 0; nt < 2; ++nt) acc[mt][nt] = MFMA32(a[mt], b[nt], acc[mt][nt]);
    }
    __syncthreads();
    if (kt + 1 < nk) {
#pragma unroll
      for (int q = 0; q < 4; ++q) {
        *(u32x4*)(As + (lr + 32 * q) * 72 + lc) = ra[q];
        *(u32x4*)(Bs + (lr + 32 * q) * 72 + lc) = rb[q];
      }
      __syncthreads();
    }
  }
}
#define ACC_ROW(mt, i) (wm * 64 + (mt) * 32 + ((i) & 3) + 8 * ((i) >> 2) + 4 * h)
#define ACC_COL(nt) (wn * 64 + (nt) * 32 + l31)
#define GEMM_IDS const int lane = threadIdx.x & 63, wave = (threadIdx.x & 255) >> 6, wm = wave >> 1, wn = wave & 1, l31 = lane & 31, h = lane >> 5; (void)wm; (void)wn; (void)l31; (void)h;

DI void phase_gemm_small(const bf16_t* A, int lda, const bf16_t* W, int N, int K, bf16_t* C, int ldc, char* lds) {
  GEMM_IDS
  const int sb = threadIdx.x >> 8;
  const int ntn = N / 128;
  const int total = NT_ * ntn;
  for (int t0 = blockIdx.x * 2; t0 < total; t0 += gridDim.x * 2) {
    const int t = t0 + sb;
    const int tm = t / ntn, tn = t - tm * ntn;
    f32x16 acc[2][2];
    gemm_tile(A + (size_t)tm * 128 * lda, lda, W + (size_t)tn * 128 * K, K, K, lds + sb * 36864, acc);
#pragma unroll
    for (int mt = 0; mt < 2; ++mt)
#pragma unroll
      for (int nt = 0; nt < 2; ++nt)
#pragma unroll
        for (int i = 0; i < 16; ++i) {
          int row = tm * 128 + ACC_ROW(mt, i), col = tn * 128 + ACC_COL(nt);
          C[(size_t)row * ldc + col] = f2bf(acc[mt][nt][i]);
        }
  }
}

namespace pg8 {
#define PG8_LAS __attribute__((address_space(3)))
typedef unsigned short bf16_t;
typedef short bf16x8 __attribute__((ext_vector_type(8)));
typedef float f32x4 __attribute__((ext_vector_type(4)));
typedef unsigned u32x4 __attribute__((ext_vector_type(4)));
constexpr int BM = 256, BK = 64, HALF = 128, HTB = HALF * BK * 2  , STAGE_BYTES = 8 * HTB, NXCD = 8, WGM = 8;

__host__ __device__ __forceinline__ int lds_byte(int r, int c) { const int st = (r >> 4) * 2 + (c >> 5), rr = r & 15, cc = c & 31, ob = rr * 64 + cc * 2; return st * 1024 + (ob ^ (((ob >> 9) & 1) << 5)); }
__host__ __device__ __forceinline__ void stage_rc(int b, int& R, int& C) { const int st = b / 1024, sb = b % 1024, swz = sb ^ (((sb >> 9) & 1) << 5); R = (st >> 1) * 16 + swz / 64; C = (st & 1) * 32 + (swz % 64) / 2; }
__host__ __device__ __forceinline__ int perm32(int rho) { const int n = rho >> 4, i = rho & 15; return 8 * (i >> 2) + 4 * n + (i & 3); }

struct Unit { int pm, pn; };
struct Gemm { const bf16_t* A; const bf16_t* Bt; int M, N, K; };

struct StaticOrder {
    int nM, nN, nwg, G, c;
    __host__ __device__ void init(int M, int N, int G_, int c_) { nM = M / BM; nN = N / BM; nwg = nM * nN; G = G_; c = c_; }
    __host__ __device__ bool next(int i, Unit& u) const {
        const long L = (long)i * G + c; if (L >= nwg) return false;
        int wgid = (int)L; { const int q = nwg / NXCD, r = nwg % NXCD, xcd = wgid % NXCD, off = wgid / NXCD; wgid = (xcd < r ? xcd * (q + 1) : r * (q + 1) + (xcd - r) * q) + off; }
        const int nig = WGM * nN, gid = wgid / nig, fm = gid * WGM, gsz = (nM - fm) < WGM ? (nM - fm) : WGM;
        u.pm = fm + ((wgid % nig) % gsz); u.pn = (wgid % nig) / gsz; return true;
    }
    __device__ __forceinline__ void a_ready(const Unit&) const {}
    __device__ __forceinline__ void done(const Unit&) const {}
};
__device__ __forceinline__ unsigned cvt_pk_bf16(float lo, float hi) { unsigned r; asm volatile("v_cvt_pk_bf16_f32 %0, %1, %2" : "=v"(r) : "v"(lo), "v"(hi)); return r; }

struct EpiRoute {
    static constexpr bool PERM = true, AFTER_DRAIN = false;
    bf16_t* O; int ldc; int route; bf16_t* pc; bf16_t* prkv; bf16_t* plow;
    __device__ __forceinline__ void operator()(const f32x4 (&acc)[2][2][4][2], const Unit& u, int wr, int wc, int fr, int fq) const {
        const int row0 = u.pm * BM + wr * 64 + fr;
#pragma unroll
        for (int bj = 0; bj < 2; ++bj) {
            int colh = u.pn * BM + bj * HALF; bf16_t* base = O; int ld = ldc;
            if (route) {
                if (colh < 768) { base = pc; ld = 768; }
                else if (colh < 2304) { base = prkv; ld = 1536; colh -= 768; }
                else if (colh < 2688) { base = plow; ld = 384; colh -= 2304; }
                else continue;
            }
            const int col0 = colh + wc * 32 + 8 * fq;
#pragma unroll
            for (int ai = 0; ai < 2; ++ai)
#pragma unroll
                for (int m = 0; m < 4; ++m) { bf16_t* rowp = base + (size_t)(row0 + ai * HALF + m * 16) * ld + col0;
                    const f32x4 v0 = acc[ai][bj][m][0], v1 = acc[ai][bj][m][1];
                    u32x4 w; w.x = cvt_pk_bf16(v0[0], v0[1]); w.y = cvt_pk_bf16(v0[2], v0[3]); w.z = cvt_pk_bf16(v1[0], v1[1]); w.w = cvt_pk_bf16(v1[2], v1[3]);
                    *(u32x4*)rowp = w; }
        }
    }
};
struct EpiGateUp {
    static constexpr bool PERM = true, AFTER_DRAIN = false;
    bf16_t* ACT;
    __device__ __forceinline__ void operator()(const f32x4 (&acc)[2][2][4][2], const Unit& u, int wr, int wc, int fr, int fq) const {
        const int row0 = u.pm * BM + wr * 64 + fr, col0 = u.pn * HALF + wc * 32 + 8 * fq;
#pragma unroll
        for (int ai = 0; ai < 2; ++ai)
#pragma unroll
            for (int m = 0; m < 4; ++m) { bf16_t* rowp = ACT + (size_t)(row0 + ai * HALF + m * 16) * 2816 + col0;
                float v[8];
#pragma unroll
                for (int n = 0; n < 2; ++n)
#pragma unroll
                    for (int j = 0; j < 4; ++j) { const float g = acc[ai][0][m][n][j], uu = acc[ai][1][m][n][j]; v[n * 4 + j] = g * __builtin_amdgcn_rcpf(1.f + __expf(-g)) * uu; }
                u32x4 w; w.x = cvt_pk_bf16(v[0], v[1]); w.y = cvt_pk_bf16(v[2], v[3]); w.z = cvt_pk_bf16(v[4], v[5]); w.w = cvt_pk_bf16(v[6], v[7]);
                *(u32x4*)rowp = w; }
    }
};
template <class Epi, class Sched, bool STAMP = false>
__device__ __forceinline__ void gemm_phase(PG8_LAS unsigned char* lds, const Gemm g, const Sched& S, const Epi& E, unsigned long long* stamps) {
    const int tid = threadIdx.x, wid = __builtin_amdgcn_readfirstlane(tid >> 6), lane = tid & 63, wr = wid >> 2, wc = wid & 3, fr = lane & 15, fq = lane >> 4;
    const int K = g.K, nt = K / BK;
    int ts_lo = 0, ts_hi = 0, nts = 0; const unsigned long long rt_entry = STAMP ? (unsigned long long)wall_clock64() : 0ull;
#define PG8_STAMP() do { if (STAMP && wid == 0 && nts < 64) { const unsigned long long _c = (unsigned long long)clock64(); \
        ts_lo = (lane == nts) ? (int)(unsigned)_c : ts_lo; ts_hi = (lane == nts) ? (int)(unsigned)(_c >> 32) : ts_hi; ++nts; } } while (0)
    PG8_STAMP();
    unsigned voffA[2], voffB[2];
#pragma unroll
    for (int i = 0; i < 2; ++i) { int R, C; stage_rc(tid * 16 + i * 8192, R, C); const int Rb = Epi::PERM ? ((R & ~31) + perm32(R & 31)) : R;
        voffA[i] = (unsigned)(R * K + C) * 2u; voffB[i] = (unsigned)(Rb * K + C) * 2u; }
    const size_t kstep = (size_t)(BK * 2);
    const size_t hstep = (size_t)HALF * K * 2;
    const size_t tstep = 2 * hstep;
    const unsigned ldsw = (unsigned)wid * 1024u;
    const int aoff = lds_byte(wr * 64 + fr, fq * 8), boff = lds_byte(wc * 32 + fr, fq * 8);
#define PG8_SA(b, h) (((b) * 2 + (h)) * HTB)
#define PG8_SB(b, h) ((4 + (b) * 2 + (h)) * HTB)
#define PG8_STAGE(bufoff, gbase, voff) do { _Pragma("unroll") for (int _i = 0; _i < 2; ++_i) \
        __builtin_amdgcn_global_load_lds((const unsigned*)((const char*)(gbase) + (voff)[_i]), (PG8_LAS unsigned*)(lds + (bufoff) + ldsw + _i * 8192), 16, 0, 0); } while (0)
#define PG8_LDA(dst, b, h) do { _Pragma("unroll") for (int m = 0; m < 4; ++m) _Pragma("unroll") for (int k = 0; k < 2; ++k) dst[m][k] = *(const PG8_LAS bf16x8*)(lds + PG8_SA(b, h) + aoff + m * 2048 + k * 1024); } while (0)
#define PG8_LDB(dst, b, h) do { _Pragma("unroll") for (int n = 0; n < 2; ++n) _Pragma("unroll") for (int k = 0; k < 2; ++k) dst[n][k] = *(const PG8_LAS bf16x8*)(lds + PG8_SB(b, h) + boff + n * 2048 + k * 1024); } while (0)
#define PG8_MMA(ai, bj, At, Bt) do { __builtin_amdgcn_s_setprio(1); _Pragma("unroll") for (int m = 0; m < 4; ++m) _Pragma("unroll") for (int n = 0; n < 2; ++n) _Pragma("unroll") for (int k = 0; k < 2; ++k) \
        acc[ai][bj][m][n] = __builtin_amdgcn_mfma_f32_16x16x32_bf16(Bt[n][k], At[m][k], acc[ai][bj][m][n], 0, 0, 0); __builtin_amdgcn_s_setprio(0); } while (0)
#define PG8_WAIT_V(n) asm volatile("s_waitcnt vmcnt(" #n ")" ::: "memory")
#define PG8_WAIT_L(n) asm volatile("s_waitcnt lgkmcnt(" #n ")" ::: "memory")
#define PG8_BAR __builtin_amdgcn_s_barrier()
#define PG8_SCHED __builtin_amdgcn_sched_barrier(0)
    Unit cur, nxt; int ui = 0;
    if (!S.next(0, cur)) return;
    f32x4 acc[2][2][4][2];
#pragma unroll
    for (int a = 0; a < 2; ++a)
#pragma unroll
        for (int b = 0; b < 2; ++b)
#pragma unroll
            for (int m = 0; m < 4; ++m)
#pragma unroll
                for (int n = 0; n < 2; ++n) acc[a][b][m][n] = (f32x4){0.f, 0.f, 0.f, 0.f};
    bf16x8 At[4][2], B0[2][2], B1[2][2];
    const char* cA = (const char*)g.A + (size_t)cur.pm * tstep; const char* cB = (const char*)g.Bt + (size_t)cur.pn * tstep;
    S.a_ready(cur);
    PG8_STAGE(PG8_SB(0, 0), cB, voffB); PG8_STAGE(PG8_SA(0, 0), cA, voffA); PG8_STAGE(PG8_SB(0, 1), cB + hstep, voffB); PG8_STAGE(PG8_SA(0, 1), cA + hstep, voffA);
    if (wr == 1) PG8_BAR;
    PG8_WAIT_V(4); PG8_BAR;
    PG8_STAGE(PG8_SB(1, 0), cB + kstep, voffB); PG8_STAGE(PG8_SA(1, 0), cA + kstep, voffA); PG8_STAGE(PG8_SB(1, 1), cB + hstep + kstep, voffB);
    PG8_WAIT_V(6); PG8_BAR;
    PG8_STAMP();
    for (;;) {
        const bool has_next = S.next(ui + 1, nxt);
        const char* nA = has_next ? (const char*)g.A + (size_t)nxt.pm * tstep : cA; const char* nB = has_next ? (const char*)g.Bt + (size_t)nxt.pn * tstep : cB;
        for (int t = 0; t < nt; t += 2) {
            const bool last = (t == nt - 2);
            const char* a1 = cA + (size_t)(t + 1) * kstep;
            const char* a2 = last ? nA : cA + (size_t)(t + 2) * kstep; const char* b2 = last ? nB : cB + (size_t)(t + 2) * kstep;
            const char* a3 = a2 + kstep; const char* b3 = b2 + kstep;
            if (last && has_next) S.a_ready(nxt);
            PG8_LDB(B0, 0, 0); PG8_SCHED; PG8_LDA(At, 0, 0); PG8_STAGE(PG8_SA(1, 1), a1 + hstep, voffA);
            PG8_WAIT_L(8); PG8_BAR; PG8_WAIT_L(0); PG8_MMA(0, 0, At, B0); PG8_BAR; PG8_SCHED;
            PG8_LDB(B1, 0, 1); PG8_STAGE(PG8_SB(0, 0), b2, voffB);
            PG8_BAR; PG8_WAIT_L(0); PG8_MMA(0, 1, At, B1); PG8_BAR;
            PG8_LDA(At, 0, 1); PG8_STAGE(PG8_SA(0, 0), a2, voffA);
            PG8_BAR; PG8_WAIT_L(0); PG8_MMA(1, 0, At, B0); PG8_BAR; PG8_SCHED;
            PG8_STAGE(PG8_SB(0, 1), b2 + hstep, voffB);
            PG8_WAIT_V(6); PG8_BAR; PG8_MMA(1, 1, At, B1); PG8_BAR;
            PG8_LDB(B0, 1, 0); PG8_SCHED; PG8_LDA(At, 1, 0); PG8_STAGE(PG8_SA(0, 1), a2 + hstep, voffA);
            PG8_WAIT_L(8); PG8_BAR; PG8_WAIT_L(0); PG8_MMA(0, 0, At, B0); PG8_BAR; PG8_SCHED;
            PG8_LDB(B1, 1, 1); PG8_STAGE(PG8_SB(1, 0), b3, voffB);
            PG8_BAR; PG8_WAIT_L(0); PG8_MMA(0, 1, At, B1); PG8_BAR;
            PG8_LDA(At, 1, 1); PG8_STAGE(PG8_SA(1, 0), a3, voffA);
            PG8_BAR; PG8_WAIT_L(0); PG8_MMA(1, 0, At, B0); PG8_BAR; PG8_SCHED;
            PG8_STAGE(PG8_SB(1, 1), b3 + hstep, voffB);
            PG8_WAIT_V(6); PG8_BAR; PG8_MMA(1, 1, At, B1); PG8_BAR;
        }
        PG8_STAMP();
        if constexpr (!Epi::AFTER_DRAIN) { E(acc, cur, wr, wc, fr, fq); S.done(cur); }
        PG8_STAMP();
        if (!has_next) break;
#pragma unroll
        for (int a = 0; a < 2; ++a)
#pragma unroll
            for (int b = 0; b < 2; ++b)
#pragma unroll
                for (int m = 0; m < 4; ++m)
#pragma unroll
                    for (int n = 0; n < 2; ++n) acc[a][b][m][n] = (f32x4){0.f, 0.f, 0.f, 0.f};
        cur = nxt; cA = nA; cB = nB; ++ui;
    }
    PG8_WAIT_V(0);
    if (wr == 0) PG8_BAR;
    PG8_BAR;
    if constexpr (Epi::AFTER_DRAIN) { E.fused(acc, cur, wr, wc, fr, fq, lds, wid, lane); S.done(cur); }
    PG8_STAMP();
    if (STAMP && wid == 0) { stamps[lane] = lane < nts ? (((unsigned long long)(unsigned)ts_hi << 32) | (unsigned)ts_lo) : 0ull;
        if (lane == 62) stamps[62] = rt_entry; if (lane == 63) stamps[63] = (unsigned long long)wall_clock64(); }
#undef PG8_STAMP
#undef PG8_SA
#undef PG8_SB
#undef PG8_STAGE
#undef PG8_LDA
#undef PG8_LDB
#undef PG8_MMA
#undef PG8_WAIT_V
#undef PG8_WAIT_L
#undef PG8_BAR
#undef PG8_SCHED
}
}

DI void phase_gemm_big(const bf16_t* A, const bf16_t* W, int N, int K, bf16_t* C, int ldc, int route, char* ws, unsigned char* lds) {
  pg8::Gemm g{A, W, TP_, N, K};
  pg8::StaticOrder S; S.init(TP_, N, gridDim.x, blockIdx.x);
  pg8::EpiRoute E{C, ldc, route, (bf16_t*)(ws + O_PC), (bf16_t*)(ws + O_PRKV), (bf16_t*)(ws + O_PLOW)};
  pg8::gemm_phase<pg8::EpiRoute, pg8::StaticOrder, false>((PG8_LAS unsigned char*)lds, g, S, E, nullptr);
}
DI void phase_gemm_gateup(const bf16_t* A, const bf16_t* W, bf16_t* ACT, unsigned char* lds) {
  pg8::Gemm g{A, W, TP_, 5632, 1024};
  pg8::StaticOrder S; S.init(TP_, 5632, gridDim.x, blockIdx.x);
  pg8::EpiGateUp E{ACT};
  pg8::gemm_phase<pg8::EpiGateUp, pg8::StaticOrder, false>((PG8_LAS unsigned char*)lds, g, S, E, nullptr);
}

DI void phase_resnorm(const P& p, const float* g1, const float* g2) {
  const int lane = threadIdx.x & 63, gw = (blockIdx.x * NTH + threadIdx.x) >> 6, nw = (gridDim.x * NTH) >> 6;
  bf16_t* HN = (bf16_t*)(p.ws + O_HN);
  for (int sr = gw; sr < T_; sr += nw) {
    float* hr = hrow(p, sr);
    float x[16];
    uint4 u0 = *(const uint4*)(HN + (size_t)sr * 1024 + lane * 16);
    uint4 u1 = *(const uint4*)(HN + (size_t)sr * 1024 + lane * 16 + 8);
    unsigned uu[8] = {u0.x, u0.y, u0.z, u0.w, u1.x, u1.y, u1.z, u1.w};
    float ss = 0.f;
#pragma unroll
    for (int j = 0; j < 8; ++j) { x[2 * j] = lo2f(uu[j]); x[2 * j + 1] = hi2f(uu[j]); ss += x[2 * j] * x[2 * j] + x[2 * j + 1] * x[2 * j + 1]; }
    ss = wave_sum(ss);
    float rs = rsqrtf(ss * (1.f / 1024.f) + EPS);
    float hv[16];
    float ss2 = 0.f;
#pragma unroll
    for (int q = 0; q < 4; ++q) {
      float4 hh = *(const float4*)(hr + lane * 16 + q * 4);
      float4 g = *(const float4*)(g1 + lane * 16 + q * 4);
      hh.x += x[q * 4 + 0] * rs * g.x; hh.y += x[q * 4 + 1] * rs * g.y; hh.z += x[q * 4 + 2] * rs * g.z; hh.w += x[q * 4 + 3] * rs * g.w;
      *(float4*)(hr + lane * 16 + q * 4) = hh;
      hv[q * 4 + 0] = hh.x; hv[q * 4 + 1] = hh.y; hv[q * 4 + 2] = hh.z; hv[q * 4 + 3] = hh.w;
      ss2 += hh.x * hh.x + hh.y * hh.y + hh.z * hh.z + hh.w * hh.w;
    }
    if (g2) {
      ss2 = wave_sum(ss2);
      float rs2 = rsqrtf(ss2 * (1.f / 1024.f) + EPS);
      unsigned o[8];
#pragma unroll
      for (int q = 0; q < 4; ++q) {
        float4 g = *(const float4*)(g2 + lane * 16 + q * 4);
        o[2 * q] = pack2(hv[q * 4] * rs2 * g.x, hv[q * 4 + 1] * rs2 * g.y);
        o[2 * q + 1] = pack2(hv[q * 4 + 2] * rs2 * g.z, hv[q * 4 + 3] * rs2 * g.w);
      }
      *(uint4*)(HN + (size_t)sr * 1024 + lane * 16) = make_uint4(o[0], o[1], o[2], o[3]);
      *(uint4*)(HN + (size_t)sr * 1024 + lane * 16 + 8) = make_uint4(o[4], o[5], o[6], o[7]);
    }
  }
}

DI size_t vta_base(int seq) { return seq < 8 ? (size_t)seq * 256 * 4160 : (size_t)8 * 256 * 4160; }
DI void phase_prepA(const P& p, char* lds) {
  const int lane = threadIdx.x & 63, wave = threadIdx.x >> 6;
  bf16_t* PROJ = (bf16_t*)(p.ws + O_PROJ0);
  bf16_t* VT = (bf16_t*)(p.ws + O_VTA);
  bf16_t* ZB = (bf16_t*)(p.ws + O_ZB);
  const float* WC = (const float*)(p.ws + O_WC);
  float* fl = (float*)lds + wave * 256;
  const float inv = exp2f(-(float)(lane & 15) * (13.287712379549449f / 16.f));
  const float qg = p.a_q_gain[lane], kg = p.a_k_gain[lane];
  for (int it = (int)(blockIdx.x * NTH + threadIdx.x); it < 9 * 4 * 64 * 48; it += (int)(gridDim.x * NTH)) {
    int k = it % 48, rowi = it / 48;
    int seq = rowi / 256, rr = rowi - seq * 256;
    size_t base = (seq < 8 ? (size_t)seq * 256 * 4160 : (size_t)8 * 256 * 4160) + (size_t)rr * (seq < 8 ? 4160 : 16448);
    VT[base + k] = 0;
  }
  for (int r0 = blockIdx.x * 8; r0 < TP_; r0 += gridDim.x * 8) {
    const int sr = r0 + wave;
    const bool valid = sr < T_;
    if (valid) {
      int pos; int b = seq_of(sr, pos);
      float rowf, colf;
      if (pos < 16) { rowf = colf = (float)(pos - 16); }
      else { int t = pos - 16; rowf = (float)(t >> 6); colf = (float)(t & 63); }
      float ang = (lane < 32 ? rowf : colf) * inv;
      float sn, cs;
      sincosf(ang, &sn, &cs);
      const float sgn = (lane & 16) ? sn : -sn;
      bf16_t* pr = PROJ + (size_t)sr * 1536;
      for (int hd = 0; hd < 16; ++hd) {
        float x = bf2f(pr[hd * 64 + lane]);
        float ss = wave_sum(x * x);
        float xn = x * rsqrtf(ss * (1.f / 64.f) + EPS) * (hd < 12 ? qg : kg);
        float pa = __shfl_xor(xn, 16);
        float o = xn * cs + pa * sgn;
        if (hd < 12) o *= 0.125f * LOG2E;
        pr[hd * 64 + lane] = f2bf(o);
      }
      const int L = seq_len(b);
      const int LP = L + 48;
      bf16_t* vt = VT + vta_base(b);
      for (int kv = 0; kv < 4; ++kv) vt[(size_t)(kv * 64 + lane) * LP + pos + 48] = pr[1024 + kv * 64 + lane];
      uint2 u = *(const uint2*)(pr + 1280 + lane * 4);
      float f0 = lo2f(u.x), f1 = hi2f(u.x), f2 = lo2f(u.y), f3 = hi2f(u.y);
      float ss = f0 * f0 + f1 * f1 + f2 * f2 + f3 * f3;
      ss += __shfl_xor(ss, 1); ss += __shfl_xor(ss, 2); ss += __shfl_xor(ss, 4); ss += __shfl_xor(ss, 8);
      float rs = rsqrtf(ss * (1.f / 64.f) + EPS);
      float4 g = *(const float4*)(p.b_norm_g + lane * 4);
      *(float4*)(fl + lane * 4) = make_float4(f0 * rs * g.x, f1 * rs * g.y, f2 * rs * g.z, f3 * rs * g.w);
    }
    __syncthreads();
    if (valid) {
      const int g = lane >> 4, o0 = (lane & 15) * 8;
      float acc[8];
#pragma unroll
      for (int j = 0; j < 8; ++j) acc[j] = 0.f;
      const float* wc = WC + (size_t)g * 64 * 128 + o0;
      for (int c = 0; c < 64; ++c) {
        float f = fl[g * 64 + c];
        float4 w0 = *(const float4*)(wc + c * 128), w1 = *(const float4*)(wc + c * 128 + 4);
        acc[0] += f * w0.x; acc[1] += f * w0.y; acc[2] += f * w0.z; acc[3] += f * w0.w;
        acc[4] += f * w1.x; acc[5] += f * w1.y; acc[6] += f * w1.z; acc[7] += f * w1.w;
      }
      *(uint4*)(ZB + (size_t)sr * 512 + g * 128 + o0) = make_uint4(pack2(acc[0], acc[1]), pack2(acc[2], acc[3]), pack2(acc[4], acc[5]), pack2(acc[6], acc[7]));
    }
    __syncthreads();
  }
}

template <int MODE>
DI void flash_item(const bf16_t* __restrict__ Q, int ldq, const bf16_t* __restrict__ Kb, int ldk, const bf16_t* __restrict__ Vt, int LP,
                   bf16_t* O, int ldo, int sbase, int S, int qt, float sinkl2, char* lds) {
  const int tid = threadIdx.x & 255, lane = tid & 63, wave = tid >> 6, l31 = lane & 31, h = lane >> 5;
  bf16_t* Ks = (bf16_t*)lds;
  bf16_t* Vs = Ks + 2 * 64 * 72;
  const int rl = wave * 32 + l31;
  const int qpos = qt == 0 ? (rl < 16 ? rl : 15) : 16 + 128 * (qt - 1) + rl;
  const bool qvalid = qt > 0 || rl < 16;
  bf16x8 qf[4];
  {
    const bf16_t* qr = Q + (size_t)(sbase + qpos) * ldq;
#pragma unroll
    for (int s = 0; s < 4; ++s) qf[s] = *(const bf16x8*)(qr + 16 * s + 8 * h);
  }
  const int nkt_all = (S + 64) / 64;
  int klo = 1, n;
  if (MODE == 0) { n = nkt_all; }
  else {
    if (qt == 0) { klo = 1; n = 3; }
    else {
      int c = qt - 1;
      klo = 2 * c - 1; if (klo < 1) klo = 1;
      int khi = 2 * c + 4; if (khi > nkt_all - 1) khi = nkt_all - 1;
      n = 1 + (khi - klo + 1);
    }
  }
  const int ldr = tid >> 2, ldp = (tid & 3) * 16;
  u32x4 rk0, rk1, rv0, rv1;
  auto ktile = [&](int idx) { return idx == 0 ? 0 : klo + idx - 1; };
#define FL_GLOAD(idx)                                                                               \
  {                                                                                                 \
    int kt_ = ktile(idx);                                                                           \
    int pos_ = 64 * kt_ + ldr - 48;                                                                 \
    if (pos_ >= 0) {                                                                                \
      const bf16_t* kp_ = Kb + (size_t)(sbase + pos_) * ldk + ldp;                                  \
      rk0 = *(const u32x4*)kp_; rk1 = *(const u32x4*)(kp_ + 8);                                 \
    } else { rk0 = (u32x4)(0u); rk1 = rk0; }                                       \
    const bf16_t* vp_ = Vt + (size_t)ldr * LP + 64 * kt_ + ldp;                                     \
    rv0 = *(const u32x4*)vp_; rv1 = *(const u32x4*)(vp_ + 8);                                   \
  }
#define FL_SSTORE(buf)                                                                              \
  {                                                                                                 \
    *(u32x4*)(Ks + (buf) * 64 * 72 + ldr * 72 + ldp) = rk0; *(u32x4*)(Ks + (buf) * 64 * 72 + ldr * 72 + ldp + 8) = rk1; \
    *(u32x4*)(Vs + (buf) * 64 * 72 + ldr * 72 + ldp) = rv0; *(u32x4*)(Vs + (buf) * 64 * 72 + ldr * 72 + ldp + 8) = rv1; \
  }
  f32x16 oacc[2];
#pragma unroll
  for (int i = 0; i < 16; ++i) { oacc[0][i] = 0.f; oacc[1][i] = 0.f; }
  float m = -1e30f, l = 0.f;
  FL_GLOAD(0)
  FL_SSTORE(0)
  __syncthreads();
  for (int idx = 0; idx < n; ++idx) {
    const int cur = idx & 1;
    if (idx + 1 < n) FL_GLOAD(idx + 1)
    const int kt = ktile(idx);
    const bf16_t* ks = Ks + cur * 64 * 72;
    const bf16_t* vs = Vs + cur * 64 * 72;
    f32x16 sacc[2];
#pragma unroll
    for (int t = 0; t < 2; ++t) {
#pragma unroll
      for (int i = 0; i < 16; ++i) sacc[t][i] = 0.f;
#pragma unroll
      for (int s = 0; s < 4; ++s) {
        bf16x8 kf = *(const bf16x8*)(ks + (32 * t + l31) * 72 + 16 * s + 8 * h);
        sacc[t] = MFMA32(kf, qf[s], sacc[t]);
      }
    }
    if (kt == 0) {
#pragma unroll
      for (int t = 0; t < 2; ++t)
#pragma unroll
        for (int i = 0; i < 16; ++i) {
          int kl = 32 * t + (i & 3) + 8 * (i >> 2) + 4 * h;
          if (kl < 48) sacc[t][i] = -1e30f;
        }
    } else if (MODE == 1) {
#pragma unroll
      for (int t = 0; t < 2; ++t)
#pragma unroll
        for (int i = 0; i < 16; ++i) {
          int kl = 32 * t + (i & 3) + 8 * (i >> 2) + 4 * h;
          int tk = 64 * (kt - 1) + kl;
          bool vis;
          if (qt == 0) vis = tk <= 112 + qpos;
          else { int tq = qpos - 16; int d = tq - tk; vis = d <= 128 && d >= -128; }
          if (!vis) sacc[t][i] = -1e30f;
        }
    }
    float tmax = -1e30f;
#pragma unroll
    for (int t = 0; t < 2; ++t)
#pragma unroll
      for (int i = 0; i < 16; ++i) tmax = fmaxf(tmax, sacc[t][i]);
    tmax = fmaxf(tmax, __shfl_xor(tmax, 32));
    const float mn = fmaxf(m, tmax);
    const float alpha = __builtin_amdgcn_exp2f(m - mn);
    m = mn;
    float ls = 0.f;
#pragma unroll
    for (int t = 0; t < 2; ++t)
#pragma unroll
      for (int i = 0; i < 16; ++i) { float pv = __builtin_amdgcn_exp2f(sacc[t][i] - mn); sacc[t][i] = pv; ls += pv; }
    l = l * alpha + ls;
#pragma unroll
    for (int i = 0; i < 16; ++i) { oacc[0][i] *= alpha; oacc[1][i] *= alpha; }
#pragma unroll
    for (int t = 0; t < 2; ++t)
#pragma unroll
      for (int s2 = 0; s2 < 2; ++s2) {
        u32x4 pk4;
#pragma unroll
        for (int j = 0; j < 4; ++j) pk4[j] = pack2(sacc[t][8 * s2 + 2 * j], sacc[t][8 * s2 + 2 * j + 1]);
        bf16x8 pf = __builtin_bit_cast(bf16x8, pk4);
#pragma unroll
        for (int dt = 0; dt < 2; ++dt) {
          const bf16_t* vp = vs + (32 * dt + l31) * 72 + 32 * t + 16 * s2 + 4 * h;
          uint2 lo = *(const uint2*)vp, hi = *(const uint2*)(vp + 8);
          u32x4 v4 = {lo.x, lo.y, hi.x, hi.y};
          bf16x8 vf = __builtin_bit_cast(bf16x8, v4);
          oacc[dt] = MFMA32(vf, pf, oacc[dt]);
        }
      }
    if (idx + 1 < n) FL_SSTORE(cur ^ 1)
    __syncthreads();
  }
  l += __shfl_xor(l, 32);
  if (MODE == 1) l += __builtin_amdgcn_exp2f(sinkl2 - m);
  const float il = 1.f / l;
  if (qvalid) {
    bf16_t* orow = O + (size_t)(sbase + qpos) * ldo;
#pragma unroll
    for (int dt = 0; dt < 2; ++dt)
#pragma unroll
      for (int g = 0; g < 4; ++g) {
        int d = 32 * dt + 8 * g + 4 * h;
        uint2 o = make_uint2(pack2(oacc[dt][4 * g] * il, oacc[dt][4 * g + 1] * il), pack2(oacc[dt][4 * g + 2] * il, oacc[dt][4 * g + 3] * il));
        *(uint2*)(orow + d) = o;
      }
  }
#undef FL_GLOAD
#undef FL_SSTORE
}

DI size_t y_base(int seq) { return seq < 8 ? (size_t)seq * 16 * 256 * 576 : (size_t)8 * 16 * 256 * 576; }
DI void phase_attnA(const P& p, char* lds) {
  const bf16_t* PROJ = (const bf16_t*)(p.ws + O_PROJ0);
  const bf16_t* VT = (const bf16_t*)(p.ws + O_VTA);
  bf16_t* MIX = (bf16_t*)(p.ws + O_MIX);
  const int nS = 129 * 6, nP = 8 * 33 * 6;
  const int sb = threadIdx.x >> 8;
  for (int it = blockIdx.x; it < nS + nP; it += gridDim.x) {
    int seq, qt, hq;
    if (it < nS) { seq = 8; hq = (it % 6) * 2 + sb; qt = it / 6; }
    else { int j = it - nS; hq = (j % 6) * 2 + sb; j /= 6; qt = j % 33; seq = j / 33; }
    const int kv = hq / 3;
    const int L = seq_len(seq), LP = L + 48;
    flash_item<0>(PROJ + hq * 64, 1536, PROJ + 768 + kv * 64, 1536, VT + vta_base(seq) + (size_t)kv * 64 * LP, LP,
                  MIX + hq * 64, 1024, seq_base(seq), L - 16, qt, 0.f, lds + sb * 36864);
  }
  const bf16_t* ZB = (const bf16_t*)(p.ws + O_ZB);
  bf16_t* Y = (bf16_t*)(p.ws + O_Y);
  const int lane = threadIdx.x & 63, wave = threadIdx.x >> 6;
  const int nI_S = 17 * 16, nI_P = 8 * 5 * 16;
  for (int it = blockIdx.x; it < nI_S + nI_P; it += gridDim.x) {
    int seq, nb, cb;
    if (it < nI_S) { seq = 8; cb = it & 15; nb = it >> 4; }
    else { int j = it - nI_S; cb = j & 15; j >>= 4; nb = j % 5; seq = j / 5; }
    const int M = seq < 8 ? 257 : 1025, KP = seq < 8 ? 576 : 2112, L = 16 * M;
    const int n2 = nb * 64 + lane;
    const int ch = cb * 16 + wave * 2;
    const int g = ch >> 6, d = ch & 63;
    bf16_t* yb = Y + y_base(seq);
    if (n2 < M) {
      float zr[16][2], zi[16][2];
#pragma unroll
      for (int n1 = 0; n1 < 16; ++n1) {
        const bf16_t* zp = ZB + (size_t)(seq_base(seq) + M * n1 + n2) * 512 + g * 128 + d;
        unsigned re = *(const unsigned*)zp, im = *(const unsigned*)(zp + 64);
        zr[n1][0] = lo2f(re); zr[n1][1] = hi2f(re); zi[n1][0] = lo2f(im); zi[n1][1] = hi2f(im);
      }
      for (int k1 = 0; k1 < 16; ++k1) {
        float ws_, wc_;
        sincospif(-(float)k1 / 8.f, &ws_, &wc_);
        float ar0 = zr[15][0], ai0 = zi[15][0], ar1 = zr[15][1], ai1 = zi[15][1];
#pragma unroll
        for (int n1 = 14; n1 >= 0; --n1) {
          float t0 = ar0 * wc_ - ai0 * ws_ + zr[n1][0]; ai0 = ar0 * ws_ + ai0 * wc_ + zi[n1][0]; ar0 = t0;
          float t1 = ar1 * wc_ - ai1 * ws_ + zr[n1][1]; ai1 = ar1 * ws_ + ai1 * wc_ + zi[n1][1]; ar1 = t1;
        }
        float ts, tc;
        sincospif(-2.f * (float)(k1 * n2) / (float)L, &ts, &tc);
        float yr0 = ar0 * tc - ai0 * ts, yi0 = ar0 * ts + ai0 * tc;
        float yr1 = ar1 * tc - ai1 * ts, yi1 = ar1 * ts + ai1 * tc;
        bf16_t* y0 = yb + ((size_t)k1 * 256 + ch) * KP;
        y0[n2] = f2bf(yr0); y0[M + n2] = f2bf(yi0);
        y0[KP + n2] = f2bf(yr1); y0[KP + M + n2] = f2bf(yi1);
      }
    } else if (n2 < KP - M) {
      for (int k1 = 0; k1 < 16; ++k1) {
        bf16_t* y0 = yb + ((size_t)k1 * 256 + ch) * KP;
        y0[M + n2] = 0; y0[KP + M + n2] = 0;
      }
    }
  }
}

DI void phase_fnet_gemm(const P& p, char* lds) {
  GEMM_IDS
  bf16_t* MIX = (bf16_t*)(p.ws + O_MIX);
  const bf16_t* Y = (const bf16_t*)(p.ws + O_Y);
  const int nS = 16 * 9 * 2, nP = 8 * 16 * 3 * 2;
  const int sb = threadIdx.x >> 8;
  for (int it0 = blockIdx.x * 2; it0 < nS + nP; it0 += gridDim.x * 2) {
    const int it = it0 + sb;
    int seq, k1, tm, tn;
    if (it < nS) { seq = 8; tn = it & 1; int j = it >> 1; tm = j % 9; k1 = j / 9; }
    else { int j = it - nS; tn = j & 1; j >>= 1; tm = j % 3; j /= 3; k1 = j & 15; seq = j >> 4; }
    const int M = seq < 8 ? 257 : 1025, KP = seq < 8 ? 576 : 2112, L = 16 * M;
    const bf16_t* dm = (const bf16_t*)(p.ws + (seq < 8 ? O_DM257 : O_DM1025));
    f32x16 acc[2][2];
    gemm_tile(dm + (size_t)tm * 128 * KP, KP, Y + y_base(seq) + ((size_t)k1 * 256 + tn * 128) * KP, KP, KP, lds + sb * 36864, acc);
    const float scale = rsqrtf(64.f * (float)L);
#pragma unroll
    for (int mt = 0; mt < 2; ++mt)
#pragma unroll
      for (int nt = 0; nt < 2; ++nt)
#pragma unroll
        for (int i = 0; i < 16; ++i) {
          int k2 = tm * 128 + ACC_ROW(mt, i), ch = tn * 128 + ACC_COL(nt);
          if (k2 < M) {
            int pos = k1 + 16 * k2;
            MIX[(size_t)(seq_base(seq) + pos) * 1024 + 768 + ch] = f2bf(acc[mt][nt][i] * scale + p.b_b[ch]);
          }
        }
  }
}

DI size_t vtc_base(int seq) { return seq < 8 ? (size_t)seq * 128 * 4160 : (size_t)8 * 128 * 4160; }
DI void phase_prepC(const P& p) {
  const int gtid = blockIdx.x * NTH + threadIdx.x, gsz = gridDim.x * NTH;
  const int lane = threadIdx.x & 63, gw = gtid >> 6, nw = gsz >> 6;
  bf16_t* PC = (bf16_t*)(p.ws + O_PC);
  bf16_t* VT = (bf16_t*)(p.ws + O_VTC);
  const bf16_t* PLOW = (const bf16_t*)(p.ws + O_PLOW);
  bf16_t* LR = (bf16_t*)(p.ws + O_LR);
  for (int it = gtid; it < 9 * 2 * 64 * 48; it += gsz) {
    int k = it % 48, rowi = it / 48;
    int seq = rowi / 128, rr = rowi - seq * 128;
    VT[vtc_base(seq) + (size_t)rr * (seq < 8 ? 4160 : 16448) + k] = 0;
  }
  for (int sr = gw; sr < T_; sr += nw) {
    int pos; int b = seq_of(sr, pos);
    const int L = seq_len(b), LP = L + 48;
    bf16_t* pr = PC + (size_t)sr * 768;
    float cs[8], sn[8];
#pragma unroll
    for (int j = 0; j < 8; ++j) sincosf((float)pos * exp2f(-(float)j * (18.931568569324174f / 8.f)), &sn[j], &cs[j]);
#pragma unroll
    for (int part = 0; part < 2; ++part) {
      const bool act = part == 0 || lane < 16;
      const int col = part * 512 + (act ? lane : 0) * 8;
      uint4 u = *(const uint4*)(pr + col);
      float e[8] = {lo2f(u.x), hi2f(u.x), lo2f(u.y), hi2f(u.y), lo2f(u.z), hi2f(u.z), lo2f(u.w), hi2f(u.w)};
      float o[8];
#pragma unroll
      for (int j = 0; j < 8; ++j) {
        float pa = __shfl_xor(e[j], 1);
        float rot = e[j] * cs[j] + pa * ((lane & 1) ? sn[j] : -sn[j]);
        o[j] = (lane & 7) < 2 ? rot : e[j];
        if (part == 0) o[j] *= 0.125f * LOG2E;
      }
      if (act) *(uint4*)(pr + col) = make_uint4(pack2(o[0], o[1]), pack2(o[2], o[3]), pack2(o[4], o[5]), pack2(o[6], o[7]));
    }
    bf16_t* vt = VT + vtc_base(b);
    for (int kv = 0; kv < 2; ++kv) vt[(size_t)(kv * 64 + lane) * LP + pos + 48] = pr[640 + kv * 64 + lane];
#pragma unroll
    for (int q = 0; q < 6; ++q) {
      int c = q * 64 + lane;
      float u = bf2f(PLOW[(size_t)sr * 384 + c]);
      float up = pos > 0 ? bf2f(PLOW[(size_t)(sr - 1) * 384 + c]) : 0.f;
      float un = pos < L - 1 ? bf2f(PLOW[(size_t)(sr + 1) * 384 + c]) : 0.f;
      float us = u + p.mu_prev[1536 + c] * (up - u) + p.mu_next[1536 + c] * (un - u);
      float v = c < 128 ? tanhf(us) : (c < 256 ? us : sigmoidf_(us));
      LR[(size_t)sr * 384 + c] = f2bf(v);
    }
  }
}

DI void phase_attnC(const P& p, char* lds) {
  const bf16_t* PC = (const bf16_t*)(p.ws + O_PC);
  const bf16_t* VT = (const bf16_t*)(p.ws + O_VTC);
  bf16_t* MIX = (bf16_t*)(p.ws + O_MIX);
  const int nS = 129 * 4, nP = 8 * 33 * 4;
  const int sb = threadIdx.x >> 8;
  for (int it = blockIdx.x; it < nS + nP; it += gridDim.x) {
    int seq, qt, hq;
    if (it < nS) { seq = 8; hq = (it & 3) * 2 + sb; qt = it >> 2; }
    else { int j = it - nS; hq = (j & 3) * 2 + sb; j >>= 2; qt = j % 33; seq = j / 33; }
    const int kv = hq >> 2;
    const int L = seq_len(seq), LP = L + 48;
    flash_item<1>(PC + hq * 64, 768, PC + 512 + kv * 64, 768, VT + vtc_base(seq) + (size_t)kv * 64 * LP, LP,
                  MIX + hq * 64, 1024, seq_base(seq), L - 16, qt, p.c_sink[hq] * LOG2E, lds + sb * 36864);
  }
}

DI void chunk_decode(int cg_, int& seq, int& c) {
  if (cg_ < 136) { seq = cg_ / 17; c = cg_ - seq * 17; } else { seq = 8; c = cg_ - 136; }
}
DI float shiftv(const bf16_t* PRKV, int sr, int pos, int L, int col, float mp, float mn) {
  float u = bf2f(PRKV[(size_t)sr * 1536 + col]);
  float up = pos > 0 ? bf2f(PRKV[(size_t)(sr - 1) * 1536 + col]) : 0.f;
  float un = pos < L - 1 ? bf2f(PRKV[(size_t)(sr + 1) * 1536 + col]) : 0.f;
  return u + mp * (up - u) + mn * (un - u);
}
template <int G, int N> DI void dpp_dot(float& acc, const float (&S)[64], float x) {
  asm("v_fmac_f32_dpp %0, %1, %2 row_newbcast:%3 row_mask:0xf bank_mask:0xf" : "+v"(acc) : "v"(x), "v"(S[16 * G + N]), "n"(N));
  if constexpr (N < 15) dpp_dot<G, N + 1>(acc, S, x);
}
template <int G, int N, bool HASV> DI void dpp_upd(float (&S)[64], float xw, float xb, float xk, float sa, float vi) {
  float s = S[16 * G + N];
  asm("v_mul_f32_dpp %0, %1, %0 row_newbcast:%2 row_mask:0xf bank_mask:0xf" : "+v"(s) : "v"(xw), "n"(N));
  asm("v_fmac_f32_dpp %0, %1, %2 row_newbcast:%3 row_mask:0xf bank_mask:0xf" : "+v"(s) : "v"(xb), "v"(sa), "n"(N));
  if (HASV) asm("v_fmac_f32_dpp %0, %1, %2 row_newbcast:%3 row_mask:0xf bank_mask:0xf" : "+v"(s) : "v"(xk), "v"(vi), "n"(N));
  S[16 * G + N] = s;
  if constexpr (N < 15) dpp_upd<G, N + 1, HASV>(S, xw, xb, xk, sa, vi);
}
DI int vperm(int j) { return (j & 15) * 4 + (j >> 4); }
enum { VW = 0, VA = 1, VB = 2, VK = 3, VV = 4, VR = 5 };

template <int NST, bool P3>
DI void scan_prologue8(const P& p, int sbase, int L, int hd, int dir, int pos0, int nsteps, int sb0, float* sv) {
  const int lane = threadIdx.x & 63, l31 = lane & 31, h = lane >> 5;
  const bf16_t* PRKV = (const bf16_t*)(p.ws + O_PRKV);
  const bf16_t* LR = (const bf16_t*)(p.ws + O_LR);
  const bf16_t* WUPT = (const bf16_t*)(p.ws + O_WUPT) + (size_t)(dir * 512 + hd * 64) * 64;
  const bf16_t* AUPT = (const bf16_t*)(p.ws + O_AUPT) + (size_t)(dir * 512 + hd * 64) * 64;
  float* bonus = (float*)(p.ws + O_BONUS);
  {
    int sl = sb0 + (l31 & 7); if (sl > nsteps - 1) sl = nsteps - 1;
    const int pos = dir ? pos0 - sl : pos0 + sl;
    const bf16_t* lrp = LR + (size_t)(sbase + pos) * 384 + dir * 64 + 8 * h;
#pragma unroll 1
    for (int mat = 0; mat < 2; ++mat) {
      const bf16_t* Wm = mat ? AUPT : WUPT;
      const float* bias = mat ? p.d_a0 : p.d_w0;
      f32x16 ac[2];
#pragma unroll
      for (int nt = 0; nt < 2; ++nt)
#pragma unroll
        for (int i = 0; i < 16; ++i) ac[nt][i] = 0.f;
#pragma unroll
      for (int ks = 0; ks < 4; ++ks) {
        const bf16x8 fa = *(const bf16x8*)(lrp + mat * 128 + 16 * ks);
#pragma unroll
        for (int nt = 0; nt < 2; ++nt) {
          const bf16x8 bw = *(const bf16x8*)(Wm + (size_t)(32 * nt + l31) * 64 + 16 * ks + 8 * h);
          ac[nt] = MFMA32(fa, bw, ac[nt]);
        }
      }
      float* dstv = sv + (mat ? VB : VW) * NST * 64;
#pragma unroll
      for (int nt = 0; nt < 2; ++nt) {
        const int j = 32 * nt + l31;
        const float b0 = bias[dir * 512 + hd * 64 + j];
#pragma unroll
        for (int i = 0; i < 4; ++i) {
          const int st = sb0 + i + 4 * h;
          const float sg = 1.f / (1.f + __expf(-(b0 + ac[nt][i])));
          dstv[st * 64 + vperm(j)] = mat ? sg : __expf(-0.6065306597126334f * sg);
        }
      }
    }
  }
  const int c = hd * 64 + lane;
  const float mpr = p.mu_prev[c], mnr = p.mu_next[c], mpk = p.mu_prev[512 + c], mnk = p.mu_next[512 + c], mpv = p.mu_prev[1024 + c], mnv = p.mu_next[1024 + c];
  const float kkc = p.d_k_k[c], kac = p.d_k_a[c], rkc = p.d_r_k[c];
  const int pj = vperm(lane);
#pragma unroll 2
  for (int q = 0; q < 8; ++q) {
    const int s = sb0 + q;
    const int ss = s < nsteps ? s : nsteps - 1;
    const int pos = dir ? pos0 - ss : pos0 + ss;
    const int sr = sbase + pos;
    const float k = shiftv(PRKV, sr, pos, L, 512 + c, mpk, mnk);
    const float v = shiftv(PRKV, sr, pos, L, 1024 + c, mpv, mnv);
    const float a = sv[VB * NST * 64 + s * 64 + pj];
    float kk = k * kkc;
    const float n2 = wave_sum(kk * kk);
    kk *= rsqrtf(fmaxf(n2, 1e-24f));
    const float kd = k * (1.f + (a - 1.f) * kac);
    sv[VA * NST * 64 + s * 64 + pj] = -kk;
    sv[VB * NST * 64 + s * 64 + pj] = kk * a;
    sv[VK * NST * 64 + s * 64 + pj] = kd;
    sv[VV * NST * 64 + s * 64 + lane] = v;
    if (P3) {
      const float r = shiftv(PRKV, sr, pos, L, c, mpr, mnr);
      sv[VR * NST * 64 + s * 64 + pj] = r;
      const float bn = wave_sum(r * kd * rkc);
      if (s < nsteps && lane == 0) bonus[((size_t)sr * 8 + hd) * 2 + dir] = bn;
    }
  }
}

DI void phase_scan1(const P& p, char* lds) {
  float* PQ = (float*)(p.ws + O_PQ);
  const int lane = threadIdx.x & 63, wave = __builtin_amdgcn_readfirstlane(threadIdx.x >> 6), slot = wave >> 1, half = wave & 1, l15 = lane & 15;
  float* sv = (float*)lds + slot * (6 * 16 * 64);
  for (int g = blockIdx.x; g < 804; g += gridDim.x) {
    const int it = g * 4 + slot;
    const int dir = it & 1, hd = (it >> 1) & 7, cgi = it >> 4;
    int seq, c; chunk_decode(cgi, seq, c);
    const int L = seq_len(seq), sbase = seq_base(seq);
    const int start = c * 256, end = min(L, start + 256), n = end - start;
    float S[64];
#pragma unroll
    for (int j = 0; j < 64; ++j) S[j] = (half == 0 && j == lane) ? 1.f : 0.f;
    for (int s0 = 0; s0 < n; s0 += 16) {
      const int ns = min(16, n - s0);
      const int pos0 = dir ? end - 1 - s0 : start + s0;
      __syncthreads();
      scan_prologue8<16, false>(p, sbase, L, hd, dir, pos0, ns, half * 8, sv);
      __syncthreads();
      for (int s = 0; s < ns; ++s) {
        const float4 xw = *(const float4*)(sv + VW * 1024 + s * 64 + l15 * 4);
        const float4 xa = *(const float4*)(sv + VA * 1024 + s * 64 + l15 * 4);
        const float4 xb = *(const float4*)(sv + VB * 1024 + s * 64 + l15 * 4);
        const float4 xk = *(const float4*)(sv + VK * 1024 + s * 64 + l15 * 4);
        const float vi = sv[VV * 1024 + s * 64 + lane];
        float sa0 = 0.f, sa1 = 0.f, sa2 = 0.f, sa3 = 0.f;
        dpp_dot<0, 0>(sa0, S, xa.x); dpp_dot<1, 0>(sa1, S, xa.y); dpp_dot<2, 0>(sa2, S, xa.z); dpp_dot<3, 0>(sa3, S, xa.w);
        const float sa = (sa0 + sa1) + (sa2 + sa3);
        if (half) {
          dpp_upd<0, 0, true>(S, xw.x, xb.x, xk.x, sa, vi); dpp_upd<1, 0, true>(S, xw.y, xb.y, xk.y, sa, vi);
          dpp_upd<2, 0, true>(S, xw.z, xb.z, xk.z, sa, vi); dpp_upd<3, 0, true>(S, xw.w, xb.w, xk.w, sa, vi);
        } else {
          dpp_upd<0, 0, false>(S, xw.x, xb.x, xk.x, sa, vi); dpp_upd<1, 0, false>(S, xw.y, xb.y, xk.y, sa, vi);
          dpp_upd<2, 0, false>(S, xw.z, xb.z, xk.z, sa, vi); dpp_upd<3, 0, false>(S, xw.w, xb.w, xk.w, sa, vi);
        }
      }
    }
    float* dst = PQ + (size_t)it * 8192 + (size_t)(half * 64 + lane) * 64;
#pragma unroll
    for (int q = 0; q < 16; ++q) *(float4*)(dst + q * 4) = make_float4(S[q * 4], S[q * 4 + 1], S[q * 4 + 2], S[q * 4 + 3]);
  }
}

DI void phase_scan2(const P& p, char* lds) {
  float* Ss = (float*)lds;
  float* Ps = Ss + 64 * 65;
  float* PQ = (float*)(p.ws + O_PQ);
  const int tid = threadIdx.x, i = tid >> 3, j0 = (tid & 7) * 8;
  for (int it = blockIdx.x; it < 144; it += gridDim.x) {
    const int dir = it & 1, hd = (it >> 1) & 7, seq = it >> 4;
    const int nch = seq < 8 ? 17 : 65, cg0 = seq < 8 ? seq * 17 : 136;
    float S[8];
#pragma unroll
    for (int jj = 0; jj < 8; ++jj) S[jj] = 0.f;
    for (int cc = 0; cc < nch; ++cc) {
      const int c = dir ? nch - 1 - cc : cc;
      float* Pg = PQ + (size_t)(((cg0 + c) * 8 + hd) * 2 + dir) * 8192;
      float* Qg = Pg + 4096;
      __syncthreads();
#pragma unroll
      for (int jj = 0; jj < 8; ++jj) Ss[i * 65 + j0 + jj] = S[jj];
#pragma unroll
      for (int r4 = 0; r4 < 2; ++r4) *(float4*)(Ps + (r4 * 512 + tid) * 4) = *(const float4*)(Pg + (r4 * 512 + tid) * 4);
      float acc[8];
#pragma unroll
      for (int r4 = 0; r4 < 2; ++r4) {
        float4 qv = *(const float4*)(Qg + i * 64 + j0 + r4 * 4);
        acc[r4 * 4] = qv.x; acc[r4 * 4 + 1] = qv.y; acc[r4 * 4 + 2] = qv.z; acc[r4 * 4 + 3] = qv.w;
      }
#pragma unroll
      for (int r4 = 0; r4 < 2; ++r4) *(float4*)(Qg + i * 64 + j0 + r4 * 4) = make_float4(S[r4 * 4], S[r4 * 4 + 1], S[r4 * 4 + 2], S[r4 * 4 + 3]);
      __syncthreads();
      for (int m = 0; m < 64; ++m) {
        const float sm = Ss[i * 65 + m];
        const float* pr = Ps + m * 64 + j0;
#pragma unroll
        for (int jj = 0; jj < 8; ++jj) acc[jj] += sm * pr[jj];
      }
#pragma unroll
      for (int jj = 0; jj < 8; ++jj) S[jj] = acc[jj];
    }
  }
}

DI void phase_scan3(const P& p, char* lds) {
  const float* PQ = (const float*)(p.ws + O_PQ);
  bf16_t* MIX = (bf16_t*)(p.ws + O_MIX);
  bf16_t* OB = (bf16_t*)(p.ws + O_OB);
  const int lane = threadIdx.x & 63, wave = __builtin_amdgcn_readfirstlane(threadIdx.x >> 6), l15 = lane & 15;
  float* sv = (float*)lds + wave * (6 * 8 * 64);
  for (int g = blockIdx.x; g < 402; g += gridDim.x) {
    const int it = g * 8 + wave;
    const int dir = it & 1, hd = (it >> 1) & 7, cgi = it >> 4;
    int seq, c; chunk_decode(cgi, seq, c);
    const int L = seq_len(seq), sbase = seq_base(seq);
    const int start = c * 256, end = min(L, start + 256), n = end - start;
    float S[64];
    {
      const float* src = PQ + (size_t)it * 8192 + 4096 + lane * 64;
#pragma unroll
      for (int q = 0; q < 16; ++q) { float4 t = *(const float4*)(src + q * 4); S[q * 4] = t.x; S[q * 4 + 1] = t.y; S[q * 4 + 2] = t.z; S[q * 4 + 3] = t.w; }
    }
    for (int s0 = 0; s0 < n; s0 += 8) {
      const int ns = min(8, n - s0);
      const int pos0 = dir ? end - 1 - s0 : start + s0;
      __syncthreads();
      scan_prologue8<8, true>(p, sbase, L, hd, dir, pos0, ns, 0, sv);
      __syncthreads();
      for (int s = 0; s < ns; ++s) {
        const float4 xw = *(const float4*)(sv + VW * 512 + s * 64 + l15 * 4);
        const float4 xa = *(const float4*)(sv + VA * 512 + s * 64 + l15 * 4);
        const float4 xb = *(const float4*)(sv + VB * 512 + s * 64 + l15 * 4);
        const float4 xk = *(const float4*)(sv + VK * 512 + s * 64 + l15 * 4);
        const float4 xr = *(const float4*)(sv + VR * 512 + s * 64 + l15 * 4);
        const float vi = sv[VV * 512 + s * 64 + lane];
        float sa0 = 0.f, sa1 = 0.f, sa2 = 0.f, sa3 = 0.f;
        dpp_dot<0, 0>(sa0, S, xa.x); dpp_dot<1, 0>(sa1, S, xa.y); dpp_dot<2, 0>(sa2, S, xa.z); dpp_dot<3, 0>(sa3, S, xa.w);
        const float sa = (sa0 + sa1) + (sa2 + sa3);
        dpp_upd<0, 0, true>(S, xw.x, xb.x, xk.x, sa, vi); dpp_upd<1, 0, true>(S, xw.y, xb.y, xk.y, sa, vi);
        dpp_upd<2, 0, true>(S, xw.z, xb.z, xk.z, sa, vi); dpp_upd<3, 0, true>(S, xw.w, xb.w, xk.w, sa, vi);
        float o0 = 0.f, o1 = 0.f, o2 = 0.f, o3 = 0.f;
        dpp_dot<0, 0>(o0, S, xr.x); dpp_dot<1, 0>(o1, S, xr.y); dpp_dot<2, 0>(o2, S, xr.z); dpp_dot<3, 0>(o3, S, xr.w);
        const float o = (o0 + o1) + (o2 + o3);
        const int pos = dir ? pos0 - s : pos0 + s;
        const size_t sr = (size_t)(sbase + pos);
        if (dir == 0) MIX[sr * 1024 + 512 + hd * 64 + lane] = f2bf(o);
        else OB[sr * 512 + hd * 64 + lane] = f2bf(o);
      }
    }
  }
}

DI void phase_rwkv_final(const P& p) {
  const int lane = threadIdx.x & 63, gw = (blockIdx.x * NTH + threadIdx.x) >> 6, nw = (gridDim.x * NTH) >> 6;
  bf16_t* MIX = (bf16_t*)(p.ws + O_MIX);
  const bf16_t* OB = (const bf16_t*)(p.ws + O_OB);
  const bf16_t* G = (const bf16_t*)(p.ws + O_G);
  const bf16_t* PRKV = (const bf16_t*)(p.ws + O_PRKV);
  const float* bonus = (const float*)(p.ws + O_BONUS);
  const int hd = lane >> 3, c0 = lane * 8;
  for (int sr = gw; sr < T_; sr += nw) {
    int pos; int b = seq_of(sr, pos);
    const int L = seq_len(b);
    uint4 uf = *(const uint4*)(MIX + (size_t)sr * 1024 + 512 + c0);
    uint4 ub = *(const uint4*)(OB + (size_t)sr * 512 + c0);
    uint4 ug = *(const uint4*)(G + (size_t)sr * 512 + c0);
    unsigned f_[4] = {uf.x, uf.y, uf.z, uf.w}, b_[4] = {ub.x, ub.y, ub.z, ub.w}, g_[4] = {ug.x, ug.y, ug.z, ug.w};
    float o[8], gg[8];
    float sm = 0.f;
#pragma unroll
    for (int j = 0; j < 4; ++j) {
      o[2 * j] = lo2f(f_[j]) + lo2f(b_[j]); o[2 * j + 1] = hi2f(f_[j]) + hi2f(b_[j]);
      gg[2 * j] = lo2f(g_[j]); gg[2 * j + 1] = hi2f(g_[j]);
      sm += o[2 * j] + o[2 * j + 1];
    }
    sm += __shfl_xor(sm, 1); sm += __shfl_xor(sm, 2); sm += __shfl_xor(sm, 4);
    const float mean = sm * (1.f / 64.f);
    float vs = 0.f;
#pragma unroll
    for (int j = 0; j < 8; ++j) { float dlt = o[j] - mean; vs += dlt * dlt; }
    vs += __shfl_xor(vs, 1); vs += __shfl_xor(vs, 2); vs += __shfl_xor(vs, 4);
    const float rstd = rsqrtf(vs * (1.f / 64.f) + 64e-5f);
    const float bsum = bonus[((size_t)sr * 8 + hd) * 2] + bonus[((size_t)sr * 8 + hd) * 2 + 1];
    float y[8];
#pragma unroll
    for (int j = 0; j < 8; ++j) {
      int c = c0 + j;
      float vsh = shiftv(PRKV, sr, pos, L, 1024 + c, p.mu_prev[1024 + c], p.mu_next[1024 + c]);
      y[j] = ((o[j] - mean) * rstd * p.d_ln_g[c] + p.d_ln_b[c] + bsum * vsh) * gg[j];
    }
    *(uint4*)(MIX + (size_t)sr * 1024 + 512 + c0) = make_uint4(pack2(y[0], y[1]), pack2(y[2], y[3]), pack2(y[4], y[5]), pack2(y[6], y[7]));
  }
}

constexpr int NPHASE = 23;
__global__ void __launch_bounds__(NTH, 2) mega(P p) {
  extern __shared__ __attribute__((aligned(16))) unsigned char shm[];
  char* lds = (char*)shm;
  char* ws = p.ws;
#ifndef DUP_MASK
#define DUP_MASK 0u
#endif
#define RUN(k, call) if (p.ph0 <= k && k < p.ph1) { call; if ((DUP_MASK >> k) & 1u) { cg::this_grid().sync(); call; } if (k + 1 < p.ph1) cg::this_grid().sync(); }
  RUN(0, phase_prep(p))
  RUN(1, phase_gemm_big((const bf16_t*)(ws + O_HN), (const bf16_t*)(ws + O_WIN0), 1536, 1024, (bf16_t*)(ws + O_PROJ0), 1536, 0, ws, shm))
  RUN(2, phase_prepA(p, lds))
  RUN(3, phase_attnA(p, lds))
  RUN(4, phase_fnet_gemm(p, lds))
  RUN(5, phase_gemm_big((const bf16_t*)(ws + O_MIX), (const bf16_t*)(ws + O_WOUT0), 1024, 1024, (bf16_t*)(ws + O_HN), 1024, 0, ws, shm))
  RUN(6, phase_resnorm(p, p.post_mix_g, p.pre_ffn_g))
  RUN(7, phase_gemm_gateup((const bf16_t*)(ws + O_HN), (const bf16_t*)(ws + O_WGU0), (bf16_t*)(ws + O_ACT), shm))
  RUN(8, phase_gemm_big((const bf16_t*)(ws + O_ACT), (const bf16_t*)(ws + O_WD0), 1024, DFF, (bf16_t*)(ws + O_HN), 1024, 0, ws, shm))
  RUN(9, phase_resnorm(p, p.post_ffn_g, p.pre_mix_g + 1024))
  RUN(10, phase_gemm_big((const bf16_t*)(ws + O_HN), (const bf16_t*)(ws + O_WIN1), 2816, 1024, nullptr, 0, 1, ws, shm))
  RUN(11, phase_prepC(p))
  RUN(12, phase_attnC(p, lds))
  RUN(13, phase_scan1(p, lds))
  RUN(14, phase_scan2(p, lds))
  RUN(15, phase_scan3(p, lds))
  RUN(16, phase_gemm_small((const bf16_t*)(ws + O_LR) + 256, 384, (const bf16_t*)(ws + O_GUP), 512, 128, (bf16_t*)(ws + O_G), 512, lds))
  RUN(17, phase_rwkv_final(p))
  RUN(18, phase_gemm_big((const bf16_t*)(ws + O_MIX), (const bf16_t*)(ws + O_WOUT1), 1024, 1024, (bf16_t*)(ws + O_HN), 1024, 0, ws, shm))
  RUN(19, phase_resnorm(p, p.post_mix_g + 1024, p.pre_ffn_g + 1024))
  RUN(20, phase_gemm_gateup((const bf16_t*)(ws + O_HN), (const bf16_t*)(ws + O_WGU1), (bf16_t*)(ws + O_ACT), shm))
  RUN(21, phase_gemm_big((const bf16_t*)(ws + O_ACT), (const bf16_t*)(ws + O_WD1), 1024, DFF, (bf16_t*)(ws + O_HN), 1024, 0, ws, shm))
  RUN(22, phase_resnorm(p, p.post_ffn_g + 1024, nullptr))
#undef RUN
}

extern "C" void kernel_launch(void* const* d_in, const int* in_sizes, int n_in, void* d_out, int out_size, void* d_ws, size_t ws_size,
                              hipStream_t stream) {
  static int grid_blocks = 0;
  if (!grid_blocks) {
    int dev = 0, cus = 0, per_cu = 0;
    (void)hipGetDevice(&dev);
    (void)hipDeviceGetAttribute(&cus, hipDeviceAttributeMultiprocessorCount, dev);
    if (hipFuncSetAttribute((const void*)mega, hipFuncAttributeMaxDynamicSharedMemorySize, LDS_BYTES) != hipSuccess) fprintf(stderr, "hipFuncSetAttribute failed\n");
    if (hipOccupancyMaxActiveBlocksPerMultiprocessor(&per_cu, (const void*)mega, NTH, LDS_BYTES) != hipSuccess || per_cu < 1) {
      fprintf(stderr, "occupancy query says %d\n", per_cu);
      (void)hipGetLastError();
    }
    grid_blocks = cus;
  }
  if (ws_size < O_END) { fprintf(stderr, "workspace too small\n"); return; }
  P p{};
  const float** f = (const float**)&p;
  for (int i = 0; i < 32; ++i) f[i] = (const float*)d_in[i];
  p.out = (float*)d_out;
  p.ws = (char*)d_ws;
#if FUSED
  p.ph0 = 0; p.ph1 = NPHASE;
  void* args[] = {&p};
  hipError_t e = hipLaunchCooperativeKernel((void*)mega, dim3(grid_blocks), dim3(NTH), args, LDS_BYTES, stream);
  if (e != hipSuccess) fprintf(stderr, "cooperative launch failed: %s (grid %d)\n", hipGetErrorString(e), grid_blocks);
#else
  for (int ph = 0; ph < NPHASE; ++ph) {
    p.ph0 = ph; p.ph1 = ph + 1;
    hipLaunchKernelGGL(mega, dim3(grid_blocks), dim3(NTH), LDS_BYTES, stream, p);
  }
#endif
}
```

```cpp
#include <hip/hip_runtime.h>
#include <hip/hip_cooperative_groups.h>
#include <cstdio>
namespace cg = cooperative_groups;

#ifndef FUSED
#define FUSED 1
#endif

typedef unsigned short bf16_t;
using bf16x8 = __attribute__((ext_vector_type(8))) short;
using s16x4 = __attribute__((ext_vector_type(4))) short;
using f32x16 = __attribute__((ext_vector_type(16))) float;
using u32x4 = __attribute__((ext_vector_type(4))) unsigned;
#define DI __device__ __forceinline__
#define MFMA32(a, b, c) __builtin_amdgcn_mfma_f32_32x32x16_bf16((a), (b), (c), 0, 0, 0)
constexpr int NTH = 512;
constexpr int LDS_BYTES = 131072;

constexpr int DM_ = 1024;
constexpr int T_ = 49296;
constexpr int TP_ = 49408;
constexpr int NT_ = TP_ / 128;
constexpr int DFF = 2816;
constexpr float EPS = 1e-6f;
constexpr float LOG2E = 1.4426950408889634f;

constexpr size_t SZ_ROW1024 = (size_t)TP_ * 1024 * 2;
constexpr size_t O_WIN0 = 0;
constexpr size_t O_WOUT0 = O_WIN0 + (size_t)1536 * 1024 * 2;
constexpr size_t O_WGU0 = O_WOUT0 + (size_t)1024 * 1024 * 2;
constexpr size_t O_WD0 = O_WGU0 + (size_t)5632 * 1024 * 2;
constexpr size_t O_DM257 = O_WD0 + (size_t)1024 * 2816 * 2;
constexpr size_t O_DM1025 = O_DM257 + (size_t)384 * 576 * 2;
constexpr size_t O_WIN1 = O_DM1025 + (size_t)1152 * 2112 * 2;
constexpr size_t O_WOUT1 = O_WIN1 + (size_t)2816 * 1024 * 2;
constexpr size_t O_WGU1 = O_WOUT1 + (size_t)1024 * 1024 * 2;
constexpr size_t O_WD1 = O_WGU1 + (size_t)5632 * 1024 * 2;
constexpr size_t O_GUP = O_WD1 + (size_t)1024 * 2816 * 2;
constexpr size_t O_RA = O_GUP + (size_t)512 * 128 * 2;
constexpr size_t O_RB = O_RA + SZ_ROW1024;
constexpr size_t O_RC = O_RB + (size_t)TP_ * 2816 * 2;
constexpr size_t O_META = O_RC + SZ_ROW1024;
constexpr size_t O_WC = O_META + (size_t)144 * 1024 * 4;
constexpr size_t O_WUPT = O_WC + (size_t)4 * 64 * 128 * 4;
constexpr size_t O_AUPT = O_WUPT + (size_t)2 * 512 * 64 * 2;
constexpr size_t O_END = O_AUPT + (size_t)2 * 512 * 64 * 2;
constexpr size_t O_HN = O_RA;
constexpr size_t O_VTA = O_RA;
constexpr size_t O_LR = O_RA;
constexpr size_t O_BONUS = O_RA + (size_t)TP_ * 384 * 2;
constexpr size_t O_VTC = O_BONUS + (size_t)T_ * 16 * 4;
constexpr size_t O_OB = O_RA + (size_t)TP_ * 512 * 2;
constexpr size_t O_PROJ0 = O_RB;
constexpr size_t O_ZB = O_PROJ0 + (size_t)TP_ * 1536 * 2;
constexpr size_t O_Y = O_ZB + (size_t)TP_ * 512 * 2;
constexpr size_t O_ACT = O_RB;
constexpr size_t O_PRKV = O_RB;
constexpr size_t O_PC = O_PRKV + (size_t)TP_ * 1536 * 2;
constexpr size_t O_PLOW = O_PC + (size_t)TP_ * 768 * 2;
constexpr size_t O_PQ = O_PC;
constexpr size_t O_G = O_PC;
constexpr size_t O_MIX = O_RC;
static_assert(O_VTC + (size_t)49728 * 128 * 2 <= O_RB, "vtc");
static_assert(O_Y + (size_t)(8 * 16 * 256 * 576 + 16 * 256 * 2112) * 2 <= O_RC, "y");
static_assert(O_PQ + (size_t)3216 * 32768 <= O_RC, "pq");
static_assert(O_END <= (size_t)536870912, "ws");

struct P {
  const float *x_prompt, *x_sample, *meta, *pre_mix_g, *post_mix_g, *pre_ffn_g, *post_ffn_g;
  const float *even_w_in, *even_w_out, *a_q_gain, *a_k_gain, *b_norm_g, *b_w, *b_b;
  const float *odd_w_in, *odd_w_out, *c_sink, *mu_prev, *mu_next, *d_w0, *d_w_up, *d_a0, *d_a_up, *d_g_up;
  const float *d_k_k, *d_k_a, *d_r_k, *d_ln_g, *d_ln_b, *ffn_gate, *ffn_up, *ffn_down;
  float* out;
  char* ws;
  int ph0, ph1;
};

DI bf16_t f2bf(float x) { unsigned u = __float_as_uint(x); u += 0x7fffu + ((u >> 16) & 1u); return (bf16_t)(u >> 16); }
DI float bf2f(bf16_t b) { return __uint_as_float(((unsigned)b) << 16); }
DI unsigned pack2(float a, float b) { return (unsigned)f2bf(a) | ((unsigned)f2bf(b) << 16); }
DI float lo2f(unsigned u) { return __uint_as_float(u << 16); }
DI float hi2f(unsigned u) { return __uint_as_float(u & 0xffff0000u); }
DI float wave_sum(float v) {
  for (int o = 32; o > 0; o >>= 1) v += __shfl_xor(v, o);
  return v;
}
DI int seq_of(int sr, int& pos) {
  if (sr < 32896) { int b = sr / 4112; pos = sr - b * 4112; return b; }
  pos = sr - 32896; return 8;
}
DI int seq_len(int b) { return b < 8 ? 4112 : 16400; }
DI int seq_base(int b) { return b < 8 ? b * 4112 : 32896; }
DI float* hrow(const P& p, int sr) {
  int pos; int b = seq_of(sr, pos);
  if (pos < 16) return (float*)(p.ws + O_META) + (size_t)(b * 16 + pos) * 1024;
  return p.out + ((size_t)(b < 8 ? b * 4096 : 32768) + (pos - 16)) * 1024;
}
DI float sigmoidf_(float x) { return 1.f / (1.f + expf(-x)); }

DI void transpose_w(const float* W, int K, int ldw, int N, bf16_t* Wt, int mode, const float* W2, int gtid, int gsz) {
  int nk8 = K / 8;
  long total = (long)N * nk8;
  for (long it = gtid; it < total; it += gsz) {
    int n = (int)(it % N), k8 = (int)(it / N);
    const float* src = W;
    int c = n;
    if (mode == 1) {
      int blk = n >> 8, w = n & 255;
      c = blk * 128 + (w & 127);
      if (w >= 128) src = W2;
    }
    unsigned r[4];
#pragma unroll
    for (int j = 0; j < 4; ++j) {
      float a = src[(size_t)(k8 * 8 + 2 * j) * ldw + c];
      float b = src[(size_t)(k8 * 8 + 2 * j + 1) * ldw + c];
      r[j] = pack2(a, b);
    }
    *(uint4*)(Wt + (size_t)n * K + k8 * 8) = make_uint4(r[0], r[1], r[2], r[3]);
  }
}

DI void phase_prep(const P& p) {
  const int gtid = blockIdx.x * NTH + threadIdx.x, gsz = gridDim.x * NTH;
  char* ws = p.ws;
  transpose_w(p.even_w_in, 1024, 1536, 1536, (bf16_t*)(ws + O_WIN0), 0, nullptr, gtid, gsz);
  transpose_w(p.even_w_out, 1024, 1024, 1024, (bf16_t*)(ws + O_WOUT0), 0, nullptr, gtid, gsz);
  transpose_w(p.odd_w_in, 1024, 2688, 2688, (bf16_t*)(ws + O_WIN1), 0, nullptr, gtid, gsz);
  transpose_w(p.odd_w_out, 1024, 1024, 1024, (bf16_t*)(ws + O_WOUT1), 0, nullptr, gtid, gsz);
  transpose_w(p.ffn_gate, 1024, DFF, 5632, (bf16_t*)(ws + O_WGU0), 1, p.ffn_up, gtid, gsz);
  transpose_w(p.ffn_gate + (size_t)1024 * DFF, 1024, DFF, 5632, (bf16_t*)(ws + O_WGU1), 1, p.ffn_up + (size_t)1024 * DFF, gtid, gsz);
  transpose_w(p.ffn_down, DFF, 1024, 1024, (bf16_t*)(ws + O_WD0), 0, nullptr, gtid, gsz);
  transpose_w(p.ffn_down + (size_t)DFF * 1024, DFF, 1024, 1024, (bf16_t*)(ws + O_WD1), 0, nullptr, gtid, gsz);
  transpose_w(p.d_g_up, 128, 512, 512, (bf16_t*)(ws + O_GUP), 0, nullptr, gtid, gsz);
  for (int d = 0; d < 2; ++d) {
    transpose_w(p.d_w_up + (size_t)d * 64 * 512, 64, 512, 512, (bf16_t*)(ws + O_WUPT) + (size_t)d * 512 * 64, 0, nullptr, gtid, gsz);
    transpose_w(p.d_a_up + (size_t)d * 64 * 512, 64, 512, 512, (bf16_t*)(ws + O_AUPT) + (size_t)d * 512 * 64, 0, nullptr, gtid, gsz);
  }
  for (int it = gtid; it < 128 * 1024 / 8; it += gsz) *(uint4*)((bf16_t*)(ws + O_WIN1) + (size_t)2688 * 1024 + (size_t)it * 8) = make_uint4(0, 0, 0, 0);
  for (int which = 0; which < 2; ++which) {
    const int M = which ? 1025 : 257, MP = which ? 1152 : 384, KP = which ? 2112 : 576;
    bf16_t* dm = (bf16_t*)(ws + (which ? O_DM1025 : O_DM257));
    for (int it = gtid; it < MP * KP; it += gsz) {
      int r = it / KP, c = it - r * KP;
      float v = 0.f;
      if (r < M && c < 2 * M) {
        int n2 = c < M ? c : c - M;
        int m = (r * n2) % M;
        float s, co;
        sincospif(2.0f * (float)m / (float)M, &s, &co);
        v = c < M ? co : s;
      }
      dm[it] = f2bf(v);
    }
  }
  for (int it = gtid; it < 4 * 64 * 128; it += gsz) {
    int o = it & 127, c = (it >> 7) & 63, g = it >> 13;
    int d = o & 63;
    float acc = 0.f;
    for (int c2 = 0; c2 < 64; ++c2) {
      float s, co;
      sincospif((float)((c * c2) & 63) / 32.f, &s, &co);
      float w = p.b_w[(g * 64 + c2) * 64 + d];
      acc += (o < 64 ? co : -s) * w;
    }
    ((float*)(ws + O_WC))[it] = acc;
  }
  const int lane = threadIdx.x & 63, gw = gtid >> 6, nw = gsz >> 6;
  bf16_t* HN = (bf16_t*)(ws + O_HN);
  for (int sr = gw; sr < TP_; sr += nw) {
    if (sr >= T_) {
#pragma unroll
      for (int q = 0; q < 2; ++q) *(uint4*)(HN + (size_t)sr * 1024 + q * 512 + lane * 8) = make_uint4(0, 0, 0, 0);
      continue;
    }
    int pos; int b = seq_of(sr, pos);
    const float* src = pos < 16 ? p.meta + pos * 1024
                                : (b < 8 ? p.x_prompt + ((size_t)b * 4096 + pos - 16) * 1024 : p.x_sample + (size_t)(pos - 16) * 1024);
    float* hr = hrow(p, sr);
    float4 v[4];
    float ss = 0.f;
#pragma unroll
    for (int q = 0; q < 4; ++q) {
      v[q] = *(const float4*)(src + q * 256 + lane * 4);
      ss += v[q].x * v[q].x + v[q].y * v[q].y + v[q].z * v[q].z + v[q].w * v[q].w;
      *(float4*)(hr + q * 256 + lane * 4) = v[q];
    }
    ss = wave_sum(ss);
    float rs = rsqrtf(ss * (1.f / 1024.f) + EPS);
#pragma unroll
    for (int q = 0; q < 4; ++q) {
      float4 g = *(const float4*)(p.pre_mix_g + q * 256 + lane * 4);
      uint2 o = make_uint2(pack2(v[q].x * rs * g.x, v[q].y * rs * g.y), pack2(v[q].z * rs * g.z, v[q].w * rs * g.w));
      *(uint2*)(HN + (size_t)sr * 1024 + q * 256 + lane * 4) = o;
    }
  }
}

DI void gemm_tile(const bf16_t* __restrict__ A, int lda, const bf16_t* __restrict__ B, int ldb, int K, char* lds, f32x16 (&acc)[2][2]) {
  const int tid = threadIdx.x & 255, lane = tid & 63, wave = tid >> 6, wm = wave >> 1, wn = wave & 1;
  const int l31 = lane & 31, h = lane >> 5;
  bf16_t* As = (bf16_t*)lds;
  bf16_t* Bs = As + 128 * 72;
#pragma unroll
  for (int a = 0; a < 2; ++a)
#pragma unroll
    for (int b = 0; b < 2; ++b)
#pragma unroll
      for (int i = 0; i < 16; ++i) acc[a][b][i] = 0.f;
  const int lr = tid >> 3, lc = (tid & 7) * 8;
  const bf16_t* Ag = A + (size_t)lr * lda + lc;
  const bf16_t* Bg = B + (size_t)lr * ldb + lc;
  u32x4 ra[4], rb[4];
#pragma unroll
  for (int q = 0; q < 4; ++q) {
    ra[q] = *(const u32x4*)(Ag + (size_t)(32 * q) * lda);
    rb[q] = *(const u32x4*)(Bg + (size_t)(32 * q) * ldb);
  }
#pragma unroll
  for (int q = 0; q < 4; ++q) {
    *(u32x4*)(As + (lr + 32 * q) * 72 + lc) = ra[q];
    *(u32x4*)(Bs + (lr + 32 * q) * 72 + lc) = rb[q];
  }
  __syncthreads();
  const int nk = K >> 6;
  for (int kt = 0; kt < nk; ++kt) {
    if (kt + 1 < nk) {
#pragma unroll
      for (int q = 0; q < 4; ++q) {
        ra[q] = *(const u32x4*)(Ag + (size_t)(32 * q) * lda + (kt + 1) * 64);
        rb[q] = *(const u32x4*)(Bg + (size_t)(32 * q) * ldb + (kt + 1) * 64);
      }
    }
#pragma unroll
    for (int ks = 0; ks < 4; ++ks) {
      bf16x8 a[2], b[2];
#pragma unroll
      for (int t = 0; t < 2; ++t) {
        a[t] = *(const bf16x8*)(As + (wm * 64 + t * 32 + l31) * 72 + ks * 16 + 8 * h);
        b[t] = *(const bf16x8*)(Bs + (wn * 64 + t * 32 + l31) * 72 + ks * 16 + 8 * h);
      }
#pragma unroll
      for (int mt = 0; mt < 2; ++mt)
#pragma unroll
        for (int nt = 0; nt < 2; ++nt) acc[mt][nt] = MFMA32(a[mt], b[nt], acc[mt][nt]);
    }
    __syncthreads();
    if (kt + 1 < nk) {
#pragma unroll
      for (int q = 0; q < 4; ++q) {
        *(u32x4*)(As + (lr + 32 * q) * 72 + lc) = ra[q];
        *(u32x4*)(Bs + (lr + 32 * q) * 72 + lc) = rb[q];
      }
      __syncthreads();
    }
  }
}
#define ACC_ROW(mt, i) (wm * 64 + (mt) * 32 + ((i) & 3) + 8 * ((i) >> 2) + 4 * h)
#define ACC_COL(nt) (wn * 64 + (nt) * 32 + l31)
#define GEMM_IDS const int lane = threadIdx.x & 63, wave = (threadIdx.x & 255) >> 6, wm = wave >> 1, wn = wave & 1, l31 = lane & 31, h = lane >> 5; (void)wm; (void)wn; (void)l31; (void)h;

DI void phase_gemm_small(const bf16_t* A, int lda, const bf16_t* W, int N, int K, bf16_t* C, int ldc, char* lds) {
  GEMM_IDS
  const int sb = threadIdx.x >> 8;
  const int ntn = N / 128;
  const int total = NT_ * ntn;
  for (int t0 = blockIdx.x * 2; t0 < total; t0 += gridDim.x * 2) {
    const int t = t0 + sb;
    const int tm = t / ntn, tn = t - tm * ntn;
    f32x16 acc[2][2];
    gemm_tile(A + (size_t)tm * 128 * lda, lda, W + (size_t)tn * 128 * K, K, K, lds + sb * 36864, acc);
#pragma unroll
    for (int mt = 0; mt < 2; ++mt)
#pragma unroll
      for (int nt = 0; nt < 2; ++nt)
#pragma unroll
        for (int i = 0; i < 16; ++i) {
          int row = tm * 128 + ACC_ROW(mt, i), col = tn * 128 + ACC_COL(nt);
          C[(size_t)row * ldc + col] = f2bf(acc[mt][nt][i]);
        }
  }
}

namespace pg8 {
#define PG8_LAS __attribute__((address_space(3)))
typedef unsigned short bf16_t;
typedef short bf16x8 __attribute__((ext_vector_type(8)));
typedef float f32x4 __attribute__((ext_vector_type(4)));
typedef unsigned u32x4 __attribute__((ext_vector_type(4)));
constexpr int BM = 256, BK = 64, HALF = 128, HTB = HALF * BK * 2  , STAGE_BYTES = 8 * HTB, NXCD = 8, WGM = 8;

__host__ __device__ __forceinline__ int lds_byte(int r, int c) { const int st = (r >> 4) * 2 + (c >> 5), rr = r & 15, cc = c & 31, ob = rr * 64 + cc * 2; return st * 1024 + (ob ^ (((ob >> 9) & 1) << 5)); }
__host__ __device__ __forceinline__ void stage_rc(int b, int& R, int& C) { const int st = b / 1024, sb = b % 1024, swz = sb ^ (((sb >> 9) & 1) << 5); R = (st >> 1) * 16 + swz / 64; C = (st & 1) * 32 + (swz % 64) / 2; }
__host__ __device__ __forceinline__ int perm32(int rho) { const int n = rho >> 4, i = rho & 15; return 8 * (i >> 2) + 4 * n + (i & 3); }

struct Unit { int pm, pn; };
struct Gemm { const bf16_t* A; const bf16_t* Bt; int M, N, K; };

struct StaticOrder {
    int nM, nN, nwg, G, c;
    __host__ __device__ void init(int M, int N, int G_, int c_) { nM = M / BM; nN = N / BM; nwg = nM * nN; G = G_; c = c_; }
    __host__ __device__ bool next(int i, Unit& u) const {
        const long L = (long)i * G + c; if (L >= nwg) return false;
        int wgid = (int)L; { const int q = nwg / NXCD, r = nwg % NXCD, xcd = wgid % NXCD, off = wgid / NXCD; wgid = (xcd < r ? xcd * (q + 1) : r * (q + 1) + (xcd - r) * q) + off; }
        const int nig = WGM * nN, gid = wgid / nig, fm = gid * WGM, gsz = (nM - fm) < WGM ? (nM - fm) : WGM;
        u.pm = fm + ((wgid % nig) % gsz); u.pn = (wgid % nig) / gsz; return true;
    }
    __device__ __forceinline__ void a_ready(const Unit&) const {}
    __device__ __forceinline__ void done(const Unit&) const {}
};
__device__ __forceinline__ unsigned cvt_pk_bf16(float lo, float hi) { unsigned r; asm volatile("v_cvt_pk_bf16_f32 %0, %1, %2" : "=v"(r) : "v"(lo), "v"(hi)); return r; }

struct EpiRoute {
    static constexpr bool PERM = true, AFTER_DRAIN = false;
    bf16_t* O; int ldc; int route; bf16_t* pc; bf16_t* prkv; bf16_t* plow;
    __device__ __forceinline__ void operator()(const f32x4 (&acc)[2][2][4][2], const Unit& u, int wr, int wc, int fr, int fq) const {
        const int row0 = u.pm * BM + wr * 64 + fr;
#pragma unroll
        for (int bj = 0; bj < 2; ++bj) {
            int colh = u.pn * BM + bj * HALF; bf16_t* base = O; int ld = ldc;
            if (route) {
                if (colh < 768) { base = pc; ld = 768; }
                else if (colh < 2304) { base = prkv; ld = 1536; colh -= 768; }
                else if (colh < 2688) { base = plow; ld = 384; colh -= 2304; }
                else continue;
            }
            const int col0 = colh + wc * 32 + 8 * fq;
#pragma unroll
            for (int ai = 0; ai < 2; ++ai)
#pragma unroll
                for (int m = 0; m < 4; ++m) { bf16_t* rowp = base + (size_t)(row0 + ai * HALF + m * 16) * ld + col0;
                    const f32x4 v0 = acc[ai][bj][m][0], v1 = acc[ai][bj][m][1];
                    u32x4 w; w.x = cvt_pk_bf16(v0[0], v0[1]); w.y = cvt_pk_bf16(v0[2], v0[3]); w.z = cvt_pk_bf16(v1[0], v1[1]); w.w = cvt_pk_bf16(v1[2], v1[3]);
                    *(u32x4*)rowp = w; }
        }
    }
};
struct EpiGateUp {
    static constexpr bool PERM = true, AFTER_DRAIN = false;
    bf16_t* ACT;
    __device__ __forceinline__ void operator()(const f32x4 (&acc)[2][2][4][2], const Unit& u, int wr, int wc, int fr, int fq) const {
        const int row0 = u.pm * BM + wr * 64 + fr, col0 = u.pn * HALF + wc * 32 + 8 * fq;
#pragma unroll
        for (int ai = 0; ai < 2; ++ai)
#pragma unroll
            for (int m = 0; m < 4; ++m) { bf16_t* rowp = ACT + (size_t)(row0 + ai * HALF + m * 16) * 2816 + col0;
                float v[8];
#pragma unroll
                for (int n = 0; n < 2; ++n)
#pragma unroll
                    for (int j = 0; j < 4; ++j) { const float g = acc[ai][0][m][n][j], uu = acc[ai][1][m][n][j]; v[n * 4 + j] = g * __builtin_amdgcn_rcpf(1.f + __expf(-g)) * uu; }
                u32x4 w; w.x = cvt_pk_bf16(v[0], v[1]); w.y = cvt_pk_bf16(v[2], v[3]); w.z = cvt_pk_bf16(v[4], v[5]); w.w = cvt_pk_bf16(v[6], v[7]);
                *(u32x4*)rowp = w; }
    }
};
template <class Epi, class Sched, bool STAMP = false>
__device__ __forceinline__ void gemm_phase(PG8_LAS unsigned char* lds, const Gemm g, const Sched& S, const Epi& E, unsigned long long* stamps) {
    const int tid = threadIdx.x, wid = __builtin_amdgcn_readfirstlane(tid >> 6), lane = tid & 63, wr = wid >> 2, wc = wid & 3, fr = lane & 15, fq = lane >> 4;
    const int K = g.K, nt = K / BK;
    int ts_lo = 0, ts_hi = 0, nts = 0; const unsigned long long rt_entry = STAMP ? (unsigned long long)wall_clock64() : 0ull;
#define PG8_STAMP() do { if (STAMP && wid == 0 && nts < 64) { const unsigned long long _c = (unsigned long long)clock64(); \
        ts_lo = (lane == nts) ? (int)(unsigned)_c : ts_lo; ts_hi = (lane == nts) ? (int)(unsigned)(_c >> 32) : ts_hi; ++nts; } } while (0)
    PG8_STAMP();
    unsigned voffA[2], voffB[2];
#pragma unroll
    for (int i = 0; i < 2; ++i) { int R, C; stage_rc(tid * 16 + i * 8192, R, C); const int Rb = Epi::PERM ? ((R & ~31) + perm32(R & 31)) : R;
        voffA[i] = (unsigned)(R * K + C) * 2u; voffB[i] = (unsigned)(Rb * K + C) * 2u; }
    const size_t kstep = (size_t)(BK * 2);
    const size_t hstep = (size_t)HALF * K * 2;
    const size_t tstep = 2 * hstep;
    const unsigned ldsw = (unsigned)wid * 1024u;
    const int aoff = lds_byte(wr * 64 + fr, fq * 8), boff = lds_byte(wc * 32 + fr, fq * 8);
#define PG8_SA(b, h) (((b) * 2 + (h)) * HTB)
#define PG8_SB(b, h) ((4 + (b) * 2 + (h)) * HTB)
#define PG8_STAGE(bufoff, gbase, voff) do { _Pragma("unroll") for (int _i = 0; _i < 2; ++_i) \
        __builtin_amdgcn_global_load_lds((const unsigned*)((const char*)(gbase) + (voff)[_i]), (PG8_LAS unsigned*)(lds + (bufoff) + ldsw + _i * 8192), 16, 0, 0); } while (0)
#define PG8_LDA(dst, b, h) do { _Pragma("unroll") for (int m = 0; m < 4; ++m) _Pragma("unroll") for (int k = 0; k < 2; ++k) dst[m][k] = *(const PG8_LAS bf16x8*)(lds + PG8_SA(b, h) + aoff + m * 2048 + k * 1024); } while (0)
#define PG8_LDB(dst, b, h) do { _Pragma("unroll") for (int n = 0; n < 2; ++n) _Pragma("unroll") for (int k = 0; k < 2; ++k) dst[n][k] = *(const PG8_LAS bf16x8*)(lds + PG8_SB(b, h) + boff + n * 2048 + k * 1024); } while (0)
#define PG8_MMA(ai, bj, At, Bt) do { __builtin_amdgcn_s_setprio(1); _Pragma("unroll") for (int m = 0; m < 4; ++m) _Pragma("unroll") for (int n = 0; n < 2; ++n) _Pragma("unroll") for (int k = 0; k < 2; ++k) \
        acc[ai][bj][m][n] = __builtin_amdgcn_mfma_f32_16x16x32_bf16(Bt[n][k], At[m][k], acc[ai][bj][m][n], 0, 0, 0); __builtin_amdgcn_s_setprio(0); } while (0)
#define PG8_WAIT_V(n) asm volatile("s_waitcnt vmcnt(" #n ")" ::: "memory")
#define PG8_WAIT_L(n) asm volatile("s_waitcnt lgkmcnt(" #n ")" ::: "memory")
#define PG8_BAR __builtin_amdgcn_s_barrier()
#define PG8_SCHED __builtin_amdgcn_sched_barrier(0)
    Unit cur, nxt; int ui = 0;
    if (!S.next(0, cur)) return;
    f32x4 acc[2][2][4][2];
#pragma unroll
    for (int a = 0; a < 2; ++a)
#pragma unroll
        for (int b = 0; b < 2; ++b)
#pragma unroll
            for (int m = 0; m < 4; ++m)
#pragma unroll
                for (int n = 0; n < 2; ++n) acc[a][b][m][n] = (f32x4){0.f, 0.f, 0.f, 0.f};
    bf16x8 At[4][2], B0[2][2], B1[2][2];
    const char* cA = (const char*)g.A + (size_t)cur.pm * tstep; const char* cB = (const char*)g.Bt + (size_t)cur.pn * tstep;
    S.a_ready(cur);
    PG8_STAGE(PG8_SB(0, 0), cB, voffB); PG8_STAGE(PG8_SA(0, 0), cA, voffA); PG8_STAGE(PG8_SB(0, 1), cB + hstep, voffB); PG8_STAGE(PG8_SA(0, 1), cA + hstep, voffA);
    if (wr == 1) PG8_BAR;
    PG8_WAIT_V(4); PG8_BAR;
    PG8_STAGE(PG8_SB(1, 0), cB + kstep, voffB); PG8_STAGE(PG8_SA(1, 0), cA + kstep, voffA); PG8_STAGE(PG8_SB(1, 1), cB + hstep + kstep, voffB);
    PG8_WAIT_V(6); PG8_BAR;
    PG8_STAMP();
    for (;;) {
        const bool has_next = S.next(ui + 1, nxt);
        const char* nA = has_next ? (const char*)g.A + (size_t)nxt.pm * tstep : cA; const char* nB = has_next ? (const char*)g.Bt + (size_t)nxt.pn * tstep : cB;
        for (int t = 0; t < nt; t += 2) {
            const bool last = (t == nt - 2);
            const char* a1 = cA + (size_t)(t + 1) * kstep;
            const char* a2 = last ? nA : cA + (size_t)(t + 2) * kstep; const char* b2 = last ? nB : cB + (size_t)(t + 2) * kstep;
            const char* a3 = a2 + kstep; const char* b3 = b2 + kstep;
            if (last && has_next) S.a_ready(nxt);
            PG8_LDB(B0, 0, 0); PG8_SCHED; PG8_LDA(At, 0, 0); PG8_STAGE(PG8_SA(1, 1), a1 + hstep, voffA);
            PG8_WAIT_L(8); PG8_BAR; PG8_WAIT_L(0); PG8_MMA(0, 0, At, B0); PG8_BAR; PG8_SCHED;
            PG8_LDB(B1, 0, 1); PG8_STAGE(PG8_SB(0, 0), b2, voffB);
            PG8_BAR; PG8_WAIT_L(0); PG8_MMA(0, 1, At, B1); PG8_BAR;
            PG8_LDA(At, 0, 1); PG8_STAGE(PG8_SA(0, 0), a2, voffA);
            PG8_BAR; PG8_WAIT_L(0); PG8_MMA(1, 0, At, B0); PG8_BAR; PG8_SCHED;
            PG8_STAGE(PG8_SB(0, 1), b2 + hstep, voffB);
            PG8_WAIT_V(6); PG8_BAR; PG8_MMA(1, 1, At, B1); PG8_BAR;
            PG8_LDB(B0, 1, 0); PG8_SCHED; PG8_LDA(At, 1, 0); PG8_STAGE(PG8_SA(0, 1), a2 + hstep, voffA);
            PG8_WAIT_L(8); PG8_BAR; PG8_WAIT_L(0); PG8_MMA(0, 0, At, B0); PG8_BAR; PG8_SCHED;
            PG8_LDB(B1, 1, 1); PG8_STAGE(PG8_SB(1, 0), b3, voffB);
            PG8_BAR; PG8_WAIT_L(0); PG8_MMA(0, 1, At, B1); PG8_BAR;
            PG8_LDA(At, 1, 1); PG8_STAGE(PG8_SA(1, 0), a3, voffA);
            PG8_BAR; PG8_WAIT_L(0); PG8_MMA(1, 0, At, B0); PG8_BAR; PG8_SCHED;
            PG8_STAGE(PG8_SB(1, 1), b3 + hstep, voffB);
            PG8_WAIT_V(6); PG8_BAR; PG8_MMA(1, 1, At, B1); PG8_BAR;
        }
        PG8_STAMP();
        if constexpr (!Epi::AFTER_DRAIN) { E(acc, cur, wr, wc, fr, fq); S.done(cur); }
        PG8_STAMP();
        if (!has_next) break;
#pragma unroll
        for (int a = 0; a < 2; ++a)
#pragma unroll
            for (int b = 0; b < 2; ++b)
#pragma unroll
                for (int m = 0; m < 4; ++m)
#pragma unroll
                    for (int n = 0; n < 2; ++n) acc[a][b][m][n] = (f32x4){0.f, 0.f, 0.f, 0.f};
        cur = nxt; cA = nA; cB = nB; ++ui;
    }
    PG8_WAIT_V(0);
    if (wr == 0) PG8_BAR;
    PG8_BAR;
    if constexpr (Epi::AFTER_DRAIN) { E.fused(acc, cur, wr, wc, fr, fq, lds, wid, lane); S.done(cur); }
    PG8_STAMP();
    if (STAMP && wid == 0) { stamps[lane] = lane < nts ? (((unsigned long long)(unsigned)ts_hi << 32) | (unsigned)ts_lo) : 0ull;
        if (lane == 62) stamps[62] = rt_entry; if (lane == 63) stamps[63] = (unsigned long long)wall_clock64(); }
#undef PG8_STAMP
#undef PG8_SA
#undef PG8_SB
#undef PG8_STAGE
#undef PG8_LDA
#undef PG8_LDB
#undef PG8_MMA
#undef PG8_WAIT_V
#undef PG8_WAIT_L
#undef PG8_BAR
#undef PG8_SCHED
}
}

DI void phase_gemm_big(const bf16_t* A, const bf16_t* W, int N, int K, bf16_t* C, int ldc, int route, char* ws, unsigned char* lds) {
  pg8::Gemm g{A, W, TP_, N, K};
  pg8::StaticOrder S; S.init(TP_, N, gridDim.x, blockIdx.x);
  pg8::EpiRoute E{C, ldc, route, (bf16_t*)(ws + O_PC), (bf16_t*)(ws + O_PRKV), (bf16_t*)(ws + O_PLOW)};
  pg8::gemm_phase<pg8::EpiRoute, pg8::StaticOrder, false>((PG8_LAS unsigned char*)lds, g, S, E, nullptr);
}
DI void phase_gemm_gateup(const bf16_t* A, const bf16_t* W, bf16_t* ACT, unsigned char* lds) {
  pg8::Gemm g{A, W, TP_, 5632, 1024};
  pg8::StaticOrder S; S.init(TP_, 5632, gridDim.x, blockIdx.x);
  pg8::EpiGateUp E{ACT};
  pg8::gemm_phase<pg8::EpiGateUp, pg8::StaticOrder, false>((PG8_LAS unsigned char*)lds, g, S, E, nullptr);
}

DI void phase_resnorm(const P& p, const float* g1, const float* g2) {
  const int lane = threadIdx.x & 63, gw = (blockIdx.x * NTH + threadIdx.x) >> 6, nw = (gridDim.x * NTH) >> 6;
  bf16_t* HN = (bf16_t*)(p.ws + O_HN);
  for (int sr = gw; sr < T_; sr += nw) {
    float* hr = hrow(p, sr);
    float x[16];
    uint4 u0 = *(const uint4*)(HN + (size_t)sr * 1024 + lane * 16);
    uint4 u1 = *(const uint4*)(HN + (size_t)sr * 1024 + lane * 16 + 8);
    unsigned uu[8] = {u0.x, u0.y, u0.z, u0.w, u1.x, u1.y, u1.z, u1.w};
    float ss = 0.f;
#pragma unroll
    for (int j = 0; j < 8; ++j) { x[2 * j] = lo2f(uu[j]); x[2 * j + 1] = hi2f(uu[j]); ss += x[2 * j] * x[2 * j] + x[2 * j + 1] * x[2 * j + 1]; }
    ss = wave_sum(ss);
    float rs = rsqrtf(ss * (1.f / 1024.f) + EPS);
    float hv[16];
    float ss2 = 0.f;
#pragma unroll
    for (int q = 0; q < 4; ++q) {
      float4 hh = *(const float4*)(hr + lane * 16 + q * 4);
      float4 g = *(const float4*)(g1 + lane * 16 + q * 4);
      hh.x += x[q * 4 + 0] * rs * g.x; hh.y += x[q * 4 + 1] * rs * g.y; hh.z += x[q * 4 + 2] * rs * g.z; hh.w += x[q * 4 + 3] * rs * g.w;
      *(float4*)(hr + lane * 16 + q * 4) = hh;
      hv[q * 4 + 0] = hh.x; hv[q * 4 + 1] = hh.y; hv[q * 4 + 2] = hh.z; hv[q * 4 + 3] = hh.w;
      ss2 += hh.x * hh.x + hh.y * hh.y + hh.z * hh.z + hh.w * hh.w;
    }
    if (g2) {
      ss2 = wave_sum(ss2);
      float rs2 = rsqrtf(ss2 * (1.f / 1024.f) + EPS);
      unsigned o[8];
#pragma unroll
      for (int q = 0; q < 4; ++q) {
        float4 g = *(const float4*)(g2 + lane * 16 + q * 4);
        o[2 * q] = pack2(hv[q * 4] * rs2 * g.x, hv[q * 4 + 1] * rs2 * g.y);
        o[2 * q + 1] = pack2(hv[q * 4 + 2] * rs2 * g.z, hv[q * 4 + 3] * rs2 * g.w);
      }
      *(uint4*)(HN + (size_t)sr * 1024 + lane * 16) = make_uint4(o[0], o[1], o[2], o[3]);
      *(uint4*)(HN + (size_t)sr * 1024 + lane * 16 + 8) = make_uint4(o[4], o[5], o[6], o[7]);
    }
  }
}

DI size_t vta_base(int seq) { return seq < 8 ? (size_t)seq * 256 * 4160 : (size_t)8 * 256 * 4160; }
DI void phase_prepA(const P& p, char* lds) {
  const int lane = threadIdx.x & 63, wave = threadIdx.x >> 6;
  bf16_t* PROJ = (bf16_t*)(p.ws + O_PROJ0);
  bf16_t* VT = (bf16_t*)(p.ws + O_VTA);
  bf16_t* ZB = (bf16_t*)(p.ws + O_ZB);
  const float* WC = (const float*)(p.ws + O_WC);
  float* fl = (float*)lds + wave * 256;
  const float inv = exp2f(-(float)(lane & 15) * (13.287712379549449f / 16.f));
  const float qg = p.a_q_gain[lane], kg = p.a_k_gain[lane];
  for (int it = (int)(blockIdx.x * NTH + threadIdx.x); it < 9 * 4 * 64 * 48; it += (int)(gridDim.x * NTH)) {
    int k = it % 48, rowi = it / 48;
    int seq = rowi / 256, rr = rowi - seq * 256;
    size_t base = (seq < 8 ? (size_t)seq * 256 * 4160 : (size_t)8 * 256 * 4160) + (size_t)rr * (seq < 8 ? 4160 : 16448);
    VT[base + k] = 0;
  }
  for (int r0 = blockIdx.x * 8; r0 < TP_; r0 += gridDim.x * 8) {
    const int sr = r0 + wave;
    const bool valid = sr < T_;
    if (valid) {
      int pos; int b = seq_of(sr, pos);
      float rowf, colf;
      if (pos < 16) { rowf = colf = (float)(pos - 16); }
      else { int t = pos - 16; rowf = (float)(t >> 6); colf = (float)(t & 63); }
      float ang = (lane < 32 ? rowf : colf) * inv;
      float sn, cs;
      sincosf(ang, &sn, &cs);
      const float sgn = (lane & 16) ? sn : -sn;
      bf16_t* pr = PROJ + (size_t)sr * 1536;
      for (int hd = 0; hd < 16; ++hd) {
        float x = bf2f(pr[hd * 64 + lane]);
        float ss = wave_sum(x * x);
        float xn = x * rsqrtf(ss * (1.f / 64.f) + EPS) * (hd < 12 ? qg : kg);
        float pa = __shfl_xor(xn, 16);
        float o = xn * cs + pa * sgn;
        if (hd < 12) o *= 0.125f * LOG2E;
        pr[hd * 64 + lane] = f2bf(o);
      }
      const int L = seq_len(b);
      const int LP = L + 48;
      bf16_t* vt = VT + vta_base(b);
      for (int kv = 0; kv < 4; ++kv) vt[(size_t)(kv * 64 + lane) * LP + pos + 48] = pr[1024 + kv * 64 + lane];
      uint2 u = *(const uint2*)(pr + 1280 + lane * 4);
      float f0 = lo2f(u.x), f1 = hi2f(u.x), f2 = lo2f(u.y), f3 = hi2f(u.y);
      float ss = f0 * f0 + f1 * f1 + f2 * f2 + f3 * f3;
      ss += __shfl_xor(ss, 1); ss += __shfl_xor(ss, 2); ss += __shfl_xor(ss, 4); ss += __shfl_xor(ss, 8);
      float rs = rsqrtf(ss * (1.f / 64.f) + EPS);
      float4 g = *(const float4*)(p.b_norm_g + lane * 4);
      *(float4*)(fl + lane * 4) = make_float4(f0 * rs * g.x, f1 * rs * g.y, f2 * rs * g.z, f3 * rs * g.w);
    }
    __syncthreads();
    if (valid) {
      const int g = lane >> 4, o0 = (lane & 15) * 8;
      float acc[8];
#pragma unroll
      for (int j = 0; j < 8; ++j) acc[j] = 0.f;
      const float* wc = WC + (size_t)g * 64 * 128 + o0;
      for (int c = 0; c < 64; ++c) {
        float f = fl[g * 64 + c];
        float4 w0 = *(const float4*)(wc + c * 128), w1 = *(const float4*)(wc + c * 128 + 4);
        acc[0] += f * w0.x; acc[1] += f * w0.y; acc[2] += f * w0.z; acc[3] += f * w0.w;
        acc[4] += f * w1.x; acc[5] += f * w1.y; acc[6] += f * w1.z; acc[7] += f * w1.w;
      }
      *(uint4*)(ZB + (size_t)sr * 512 + g * 128 + o0) = make_uint4(pack2(acc[0], acc[1]), pack2(acc[2], acc[3]), pack2(acc[4], acc[5]), pack2(acc[6], acc[7]));
    }
    __syncthreads();
  }
}

template <int MODE>
DI void flash_item(const bf16_t* __restrict__ Q, int ldq, const bf16_t* __restrict__ Kb, int ldk, const bf16_t* __restrict__ Vt, int LP,
                   bf16_t* O, int ldo, int sbase, int S, int qt, float sinkl2, char* lds) {
  const int tid = threadIdx.x & 255, lane = tid & 63, wave = tid >> 6, l31 = lane & 31, h = lane >> 5;
  bf16_t* Ks = (bf16_t*)lds;
  bf16_t* Vs = Ks + 2 * 64 * 72;
  const int rl = wave * 32 + l31;
  const int qpos = qt == 0 ? (rl < 16 ? rl : 15) : 16 + 128 * (qt - 1) + rl;
  const bool qvalid = qt > 0 || rl < 16;
  bf16x8 qf[4];
  {
    const bf16_t* qr = Q + (size_t)(sbase + qpos) * ldq;
#pragma unroll
    for (int s = 0; s < 4; ++s) qf[s] = *(const bf16x8*)(qr + 16 * s + 8 * h);
  }
  const int nkt_all = (S + 64) / 64;
  int klo = 1, n;
  if (MODE == 0) { n = nkt_all; }
  else {
    if (qt == 0) { klo = 1; n = 3; }
    else {
      int c = qt - 1;
      klo = 2 * c - 1; if (klo < 1) klo = 1;
      int khi = 2 * c + 4; if (khi > nkt_all - 1) khi = nkt_all - 1;
      n = 1 + (khi - klo + 1);
    }
  }
  const int ldr = tid >> 2, ldp = (tid & 3) * 16;
  u32x4 rk0, rk1, rv0, rv1;
  auto ktile = [&](int idx) { return idx == 0 ? 0 : klo + idx - 1; };
#define FL_GLOAD(idx)                                                                               \
  {                                                                                                 \
    int kt_ = ktile(idx);                                                                           \
    int pos_ = 64 * kt_ + ldr - 48;                                                                 \
    if (pos_ >= 0) {                                                                                \
      const bf16_t* kp_ = Kb + (size_t)(sbase + pos_) * ldk + ldp;                                  \
      rk0 = *(const u32x4*)kp_; rk1 = *(const u32x4*)(kp_ + 8);                                 \
    } else { rk0 = (u32x4)(0u); rk1 = rk0; }                                       \
    const bf16_t* vp_ = Vt + (size_t)ldr * LP + 64 * kt_ + ldp;                                     \
    rv0 = *(const u32x4*)vp_; rv1 = *(const u32x4*)(vp_ + 8);                                   \
  }
#define FL_SSTORE(buf)                                                                              \
  {                                                                                                 \
    *(u32x4*)(Ks + (buf) * 64 * 72 + ldr * 72 + ldp) = rk0; *(u32x4*)(Ks + (buf) * 64 * 72 + ldr * 72 + ldp + 8) = rk1; \
    *(u32x4*)(Vs + (buf) * 64 * 72 + ldr * 72 + ldp) = rv0; *(u32x4*)(Vs + (buf) * 64 * 72 + ldr * 72 + ldp + 8) = rv1; \
  }
  f32x16 oacc[2];
#pragma unroll
  for (int i = 0; i < 16; ++i) { oacc[0][i] = 0.f; oacc[1][i] = 0.f; }
  float m = -1e30f, l = 0.f;
  FL_GLOAD(0)
  FL_SSTORE(0)
  __syncthreads();
  for (int idx = 0; idx < n; ++idx) {
    const int cur = idx & 1;
    if (idx + 1 < n) FL_GLOAD(idx + 1)
    const int kt = ktile(idx);
    const bf16_t* ks = Ks + cur * 64 * 72;
    const bf16_t* vs = Vs + cur * 64 * 72;
    f32x16 sacc[2];
#pragma unroll
    for (int t = 0; t < 2; ++t) {
#pragma unroll
      for (int i = 0; i < 16; ++i) sacc[t][i] = 0.f;
#pragma unroll
      for (int s = 0; s < 4; ++s) {
        bf16x8 kf = *(const bf16x8*)(ks + (32 * t + l31) * 72 + 16 * s + 8 * h);
        sacc[t] = MFMA32(kf, qf[s], sacc[t]);
      }
    }
    if (kt == 0) {
#pragma unroll
      for (int t = 0; t < 2; ++t)
#pragma unroll
        for (int i = 0; i < 16; ++i) {
          int kl = 32 * t + (i & 3) + 8 * (i >> 2) + 4 * h;
          if (kl < 48) sacc[t][i] = -1e30f;
        }
    } else if (MODE == 1) {
#pragma unroll
      for (int t = 0; t < 2; ++t)
#pragma unroll
        for (int i = 0; i < 16; ++i) {
          int kl = 32 * t + (i & 3) + 8 * (i >> 2) + 4 * h;
          int tk = 64 * (kt - 1) + kl;
          bool vis;
          if (qt == 0) vis = tk <= 112 + qpos;
          else { int tq = qpos - 16; int d = tq - tk; vis = d <= 128 && d >= -128; }
          if (!vis) sacc[t][i] = -1e30f;
        }
    }
    float tmax = -1e30f;
#pragma unroll
    for (int t = 0; t < 2; ++t)
#pragma unroll
      for (int i = 0; i < 16; ++i) tmax = fmaxf(tmax, sacc[t][i]);
    tmax = fmaxf(tmax, __shfl_xor(tmax, 32));
    const float mn = fmaxf(m, tmax);
    const float alpha = __builtin_amdgcn_exp2f(m - mn);
    m = mn;
    float ls = 0.f;
#pragma unroll
    for (int t = 0; t < 2; ++t)
#pragma unroll
      for (int i = 0; i < 16; ++i) { float pv = __builtin_amdgcn_exp2f(sacc[t][i] - mn); sacc[t][i] = pv; ls += pv; }
    l = l * alpha + ls;
#pragma unroll
    for (int i = 0; i < 16; ++i) { oacc[0][i] *= alpha; oacc[1][i] *= alpha; }
#pragma unroll
    for (int t = 0; t < 2; ++t)
#pragma unroll
      for (int s2 = 0; s2 < 2; ++s2) {
        u32x4 pk4;
#pragma unroll
        for (int j = 0; j < 4; ++j) pk4[j] = pack2(sacc[t][8 * s2 + 2 * j], sacc[t][8 * s2 + 2 * j + 1]);
        bf16x8 pf = __builtin_bit_cast(bf16x8, pk4);
#pragma unroll
        for (int dt = 0; dt < 2; ++dt) {
          const bf16_t* vp = vs + (32 * dt + l31) * 72 + 32 * t + 16 * s2 + 4 * h;
          uint2 lo = *(const uint2*)vp, hi = *(const uint2*)(vp + 8);
          u32x4 v4 = {lo.x, lo.y, hi.x, hi.y};
          bf16x8 vf = __builtin_bit_cast(bf16x8, v4);
          oacc[dt] = MFMA32(vf, pf, oacc[dt]);
        }
      }
    if (idx + 1 < n) FL_SSTORE(cur ^ 1)
    __syncthreads();
  }
  l += __shfl_xor(l, 32);
  if (MODE == 1) l += __builtin_amdgcn_exp2f(sinkl2 - m);
  const float il = 1.f / l;
  if (qvalid) {
    bf16_t* orow = O + (size_t)(sbase + qpos) * ldo;
#pragma unroll
    for (int dt = 0; dt < 2; ++dt)
#pragma unroll
      for (int g = 0; g < 4; ++g) {
        int d = 32 * dt + 8 * g + 4 * h;
        uint2 o = make_uint2(pack2(oacc[dt][4 * g] * il, oacc[dt][4 * g + 1] * il), pack2(oacc[dt][4 * g + 2] * il, oacc[dt][4 * g + 3] * il));
        *(uint2*)(orow + d) = o;
      }
  }
#undef FL_GLOAD
#undef FL_SSTORE
}

DI size_t y_base(int seq) { return seq < 8 ? (size_t)seq * 16 * 256 * 576 : (size_t)8 * 16 * 256 * 576; }
DI void phase_attnA(const P& p, char* lds) {
  const bf16_t* PROJ = (const bf16_t*)(p.ws + O_PROJ0);
  const bf16_t* VT = (const bf16_t*)(p.ws + O_VTA);
  bf16_t* MIX = (bf16_t*)(p.ws + O_MIX);
  const int nS = 129 * 6, nP = 8 * 33 * 6;
  const int sb = threadIdx.x >> 8;
  for (int it = blockIdx.x; it < nS + nP; it += gridDim.x) {
    int seq, qt, hq;
    if (it < nS) { seq = 8; hq = (it % 6) * 2 + sb; qt = it / 6; }
    else { int j = it - nS; hq = (j % 6) * 2 + sb; j /= 6; qt = j % 33; seq = j / 33; }
    const int kv = hq / 3;
    const int L = seq_len(seq), LP = L + 48;
    flash_item<0>(PROJ + hq * 64, 1536, PROJ + 768 + kv * 64, 1536, VT + vta_base(seq) + (size_t)kv * 64 * LP, LP,
                  MIX + hq * 64, 1024, seq_base(seq), L - 16, qt, 0.f, lds + sb * 36864);
  }
  const bf16_t* ZB = (const bf16_t*)(p.ws + O_ZB);
  bf16_t* Y = (bf16_t*)(p.ws + O_Y);
  const int lane = threadIdx.x & 63, wave = threadIdx.x >> 6;
  const int nI_S = 17 * 16, nI_P = 8 * 5 * 16;
  for (int it = blockIdx.x; it < nI_S + nI_P; it += gridDim.x) {
    int seq, nb, cb;
    if (it < nI_S) { seq = 8; cb = it & 15; nb = it >> 4; }
    else { int j = it - nI_S; cb = j & 15; j >>= 4; nb = j % 5; seq = j / 5; }
    const int M = seq < 8 ? 257 : 1025, KP = seq < 8 ? 576 : 2112, L = 16 * M;
    const int n2 = nb * 64 + lane;
    const int ch = cb * 16 + wave * 2;
    const int g = ch >> 6, d = ch & 63;
    bf16_t* yb = Y + y_base(seq);
    if (n2 < M) {
      float zr[16][2], zi[16][2];
#pragma unroll
      for (int n1 = 0; n1 < 16; ++n1) {
        const bf16_t* zp = ZB + (size_t)(seq_base(seq) + M * n1 + n2) * 512 + g * 128 + d;
        unsigned re = *(const unsigned*)zp, im = *(const unsigned*)(zp + 64);
        zr[n1][0] = lo2f(re); zr[n1][1] = hi2f(re); zi[n1][0] = lo2f(im); zi[n1][1] = hi2f(im);
      }
      for (int k1 = 0; k1 < 16; ++k1) {
        float ws_, wc_;
        sincospif(-(float)k1 / 8.f, &ws_, &wc_);
        float ar0 = zr[15][0], ai0 = zi[15][0], ar1 = zr[15][1], ai1 = zi[15][1];
#pragma unroll
        for (int n1 = 14; n1 >= 0; --n1) {
          float t0 = ar0 * wc_ - ai0 * ws_ + zr[n1][0]; ai0 = ar0 * ws_ + ai0 * wc_ + zi[n1][0]; ar0 = t0;
          float t1 = ar1 * wc_ - ai1 * ws_ + zr[n1][1]; ai1 = ar1 * ws_ + ai1 * wc_ + zi[n1][1]; ar1 = t1;
        }
        float ts, tc;
        sincospif(-2.f * (float)(k1 * n2) / (float)L, &ts, &tc);
        float yr0 = ar0 * tc - ai0 * ts, yi0 = ar0 * ts + ai0 * tc;
        float yr1 = ar1 * tc - ai1 * ts, yi1 = ar1 * ts + ai1 * tc;
        bf16_t* y0 = yb + ((size_t)k1 * 256 + ch) * KP;
        y0[n2] = f2bf(yr0); y0[M + n2] = f2bf(yi0);
        y0[KP + n2] = f2bf(yr1); y0[KP + M + n2] = f2bf(yi1);
      }
    } else if (n2 < KP - M) {
      for (int k1 = 0; k1 < 16; ++k1) {
        bf16_t* y0 = yb + ((size_t)k1 * 256 + ch) * KP;
        y0[M + n2] = 0; y0[KP + M + n2] = 0;
      }
    }
  }
}

DI void phase_fnet_gemm(const P& p, char* lds) {
  GEMM_IDS
  bf16_t* MIX = (bf16_t*)(p.ws + O_MIX);
  const bf16_t* Y = (const bf16_t*)(p.ws + O_Y);
  const int nS = 16 * 9 * 2, nP = 8 * 16 * 3 * 2;
  const int sb = threadIdx.x >> 8;
  for (int it0 = blockIdx.x * 2; it0 < nS + nP; it0 += gridDim.x * 2) {
    const int it = it0 + sb;
    int seq, k1, tm, tn;
    if (it < nS) { seq = 8; tn = it & 1; int j = it >> 1; tm = j % 9; k1 = j / 9; }
    else { int j = it - nS; tn = j & 1; j >>= 1; tm = j % 3; j /= 3; k1 = j & 15; seq = j >> 4; }
    const int M = seq < 8 ? 257 : 1025, KP = seq < 8 ? 576 : 2112, L = 16 * M;
    const bf16_t* dm = (const bf16_t*)(p.ws + (seq < 8 ? O_DM257 : O_DM1025));
    f32x16 acc[2][2];
    gemm_tile(dm + (size_t)tm * 128 * KP, KP, Y + y_base(seq) + ((size_t)k1 * 256 + tn * 128) * KP, KP, KP, lds + sb * 36864, acc);
    const float scale = rsqrtf(64.f * (float)L);
#pragma unroll
    for (int mt = 0; mt < 2; ++mt)
#pragma unroll
      for (int nt = 0; nt < 2; ++nt)
#pragma unroll
        for (int i = 0; i < 16; ++i) {
          int k2 = tm * 128 + ACC_ROW(mt, i), ch = tn * 128 + ACC_COL(nt);
          if (k2 < M) {
            int pos = k1 + 16 * k2;
            MIX[(size_t)(seq_base(seq) + pos) * 1024 + 768 + ch] = f2bf(acc[mt][nt][i] * scale + p.b_b[ch]);
          }
        }
  }
}

DI size_t vtc_base(int seq) { return seq < 8 ? (size_t)seq * 128 * 4160 : (size_t)8 * 128 * 4160; }
DI void phase_prepC(const P& p) {
  const int gtid = blockIdx.x * NTH + threadIdx.x, gsz = gridDim.x * NTH;
  const int lane = threadIdx.x & 63, gw = gtid >> 6, nw = gsz >> 6;
  bf16_t* PC = (bf16_t*)(p.ws + O_PC);
  bf16_t* VT = (bf16_t*)(p.ws + O_VTC);
  const bf16_t* PLOW = (const bf16_t*)(p.ws + O_PLOW);
  bf16_t* LR = (bf16_t*)(p.ws + O_LR);
  for (int it = gtid; it < 9 * 2 * 64 * 48; it += gsz) {
    int k = it % 48, rowi = it / 48;
    int seq = rowi / 128, rr = rowi - seq * 128;
    VT[vtc_base(seq) + (size_t)rr * (seq < 8 ? 4160 : 16448) + k] = 0;
  }
  for (int sr = gw; sr < T_; sr += nw) {
    int pos; int b = seq_of(sr, pos);
    const int L = seq_len(b), LP = L + 48;
    bf16_t* pr = PC + (size_t)sr * 768;
    float cs[8], sn[8];
#pragma unroll
    for (int j = 0; j < 8; ++j) sincosf((float)pos * exp2f(-(float)j * (18.931568569324174f / 8.f)), &sn[j], &cs[j]);
#pragma unroll
    for (int part = 0; part < 2; ++part) {
      const bool act = part == 0 || lane < 16;
      const int col = part * 512 + (act ? lane : 0) * 8;
      uint4 u = *(const uint4*)(pr + col);
      float e[8] = {lo2f(u.x), hi2f(u.x), lo2f(u.y), hi2f(u.y), lo2f(u.z), hi2f(u.z), lo2f(u.w), hi2f(u.w)};
      float o[8];
#pragma unroll
      for (int j = 0; j < 8; ++j) {
        float pa = __shfl_xor(e[j], 1);
        float rot = e[j] * cs[j] + pa * ((lane & 1) ? sn[j] : -sn[j]);
        o[j] = (lane & 7) < 2 ? rot : e[j];
        if (part == 0) o[j] *= 0.125f * LOG2E;
      }
      if (act) *(uint4*)(pr + col) = make_uint4(pack2(o[0], o[1]), pack2(o[2], o[3]), pack2(o[4], o[5]), pack2(o[6], o[7]));
    }
    bf16_t* vt = VT + vtc_base(b);
    for (int kv = 0; kv < 2; ++kv) vt[(size_t)(kv * 64 + lane) * LP + pos + 48] = pr[640 + kv * 64 + lane];
#pragma unroll
    for (int q = 0; q < 6; ++q) {
      int c = q * 64 + lane;
      float u = bf2f(PLOW[(size_t)sr * 384 + c]);
      float up = pos > 0 ? bf2f(PLOW[(size_t)(sr - 1) * 384 + c]) : 0.f;
      float un = pos < L - 1 ? bf2f(PLOW[(size_t)(sr + 1) * 384 + c]) : 0.f;
      float us = u + p.mu_prev[1536 + c] * (up - u) + p.mu_next[1536 + c] * (un - u);
      float v = c < 128 ? tanhf(us) : (c < 256 ? us : sigmoidf_(us));
      LR[(size_t)sr * 384 + c] = f2bf(v);
    }
  }
}

DI void phase_attnC(const P& p, char* lds) {
  const bf16_t* PC = (const bf16_t*)(p.ws + O_PC);
  const bf16_t* VT = (const bf16_t*)(p.ws + O_VTC);
  bf16_t* MIX = (bf16_t*)(p.ws + O_MIX);
  const int nS = 129 * 4, nP = 8 * 33 * 4;
  const int sb = threadIdx.x >> 8;
  for (int it = blockIdx.x; it < nS + nP; it += gridDim.x) {
    int seq, qt, hq;
    if (it < nS) { seq = 8; hq = (it & 3) * 2 + sb; qt = it >> 2; }
    else { int j = it - nS; hq = (j & 3) * 2 + sb; j >>= 2; qt = j % 33; seq = j / 33; }
    const int kv = hq >> 2;
    const int L = seq_len(seq), LP = L + 48;
    flash_item<1>(PC + hq * 64, 768, PC + 512 + kv * 64, 768, VT + vtc_base(seq) + (size_t)kv * 64 * LP, LP,
                  MIX + hq * 64, 1024, seq_base(seq), L - 16, qt, p.c_sink[hq] * LOG2E, lds + sb * 36864);
  }
}

DI void chunk_decode(int cg_, int& seq, int& c) {
  if (cg_ < 136) { seq = cg_ / 17; c = cg_ - seq * 17; } else { seq = 8; c = cg_ - 136; }
}
DI float shiftv(const bf16_t* PRKV, int sr, int pos, int L, int col, float mp, float mn) {
  float u = bf2f(PRKV[(size_t)sr * 1536 + col]);
  float up = pos > 0 ? bf2f(PRKV[(size_t)(sr - 1) * 1536 + col]) : 0.f;
  float un = pos < L - 1 ? bf2f(PRKV[(size_t)(sr + 1) * 1536 + col]) : 0.f;
  return u + mp * (up - u) + mn * (un - u);
}
enum { VW = 0, VA = 1, VB = 2, VK = 3, VV = 4, VR = 5 };
#define DPP_FMAC(acc, x, y, N) asm("v_fmac_f32_dpp %0, %1, %2 row_newbcast:%3 row_mask:0xf bank_mask:0xf" : "+v"(acc) : "v"(x), "v"(y), "n"(N))
#define DPP_MUL(sv_, x, N) asm("v_mul_f32_dpp %0, %1, %0 row_newbcast:%2 row_mask:0xf bank_mask:0xf" : "+v"(sv_) : "v"(x), "n"(N))
template <int N> DI void dpp_dot4(float& a0, float& a1, float& a2, float& a3, const float (&S)[64], const float4& x) {
  DPP_FMAC(a0, x.x, S[N], N); DPP_FMAC(a1, x.y, S[16 + N], N); DPP_FMAC(a2, x.z, S[32 + N], N); DPP_FMAC(a3, x.w, S[48 + N], N);
  if constexpr (N < 15) dpp_dot4<N + 1>(a0, a1, a2, a3, S, x);
}
template <int N, bool HASV, bool OUT> DI void dpp_upd4(float (&S)[64], const float4& xw, const float4& xb, const float4& xk, const float4& xr, float sa, float vi,
                                                       float& o0, float& o1, float& o2, float& o3) {
  DPP_MUL(S[N], xw.x, N); DPP_MUL(S[16 + N], xw.y, N); DPP_MUL(S[32 + N], xw.z, N); DPP_MUL(S[48 + N], xw.w, N);
  DPP_FMAC(S[N], xb.x, sa, N); DPP_FMAC(S[16 + N], xb.y, sa, N); DPP_FMAC(S[32 + N], xb.z, sa, N); DPP_FMAC(S[48 + N], xb.w, sa, N);
  if (HASV) { DPP_FMAC(S[N], xk.x, vi, N); DPP_FMAC(S[16 + N], xk.y, vi, N); DPP_FMAC(S[32 + N], xk.z, vi, N); DPP_FMAC(S[48 + N], xk.w, vi, N); }
  if (OUT) { DPP_FMAC(o0, xr.x, S[N], N); DPP_FMAC(o1, xr.y, S[16 + N], N); DPP_FMAC(o2, xr.z, S[32 + N], N); DPP_FMAC(o3, xr.w, S[48 + N], N); }
  if constexpr (N < 15) dpp_upd4<N + 1, HASV, OUT>(S, xw, xb, xk, xr, sa, vi, o0, o1, o2, o3);
}
template <int NST, bool HASV, bool OUT, class F>
DI void scan_steps(float (&S)[64], const float* sv, int ns, int lane, F&& emit) {
  const int l15 = lane & 15;
  for (int s = 0; s < ns; ++s) {
    const float4 xw = *(const float4*)(sv + VW * NST * 64 + s * 64 + l15 * 4);
    const float4 xa = *(const float4*)(sv + VA * NST * 64 + s * 64 + l15 * 4);
    const float4 xb = *(const float4*)(sv + VB * NST * 64 + s * 64 + l15 * 4);
    float4 xk = xb, xr = xb;
    if (HASV) xk = *(const float4*)(sv + VK * NST * 64 + s * 64 + l15 * 4);
    if (OUT) xr = *(const float4*)(sv + VR * NST * 64 + s * 64 + l15 * 4);
    const float vi = HASV ? sv[VV * NST * 64 + s * 64 + lane] : 0.f;
    float sa0 = 0.f, sa1 = 0.f, sa2 = 0.f, sa3 = 0.f;
    dpp_dot4<0>(sa0, sa1, sa2, sa3, S, xa);
    const float sa = (sa0 + sa1) + (sa2 + sa3);
    float o0 = 0.f, o1 = 0.f, o2 = 0.f, o3 = 0.f;
    dpp_upd4<0, HASV, OUT>(S, xw, xb, xk, xr, sa, vi, o0, o1, o2, o3);
    if (OUT) emit(s, (o0 + o1) + (o2 + o3));
  }
}
DI int vperm(int j) { return (j & 15) * 4 + (j >> 4); }

template <int NST, bool P3>
DI void scan_prologue8(const P& p, int sbase, int L, int hd, int dir, int pos0, int nsteps, int sb0, float* sv) {
  const int lane = threadIdx.x & 63, l31 = lane & 31, h = lane >> 5;
  const bf16_t* PRKV = (const bf16_t*)(p.ws + O_PRKV);
  const bf16_t* LR = (const bf16_t*)(p.ws + O_LR);
  const bf16_t* WUPT = (const bf16_t*)(p.ws + O_WUPT) + (size_t)(dir * 512 + hd * 64) * 64;
  const bf16_t* AUPT = (const bf16_t*)(p.ws + O_AUPT) + (size_t)(dir * 512 + hd * 64) * 64;
  float* bonus = (float*)(p.ws + O_BONUS);
  const int c = hd * 64 + lane;
  float rk_[10], rv_[10], rr_[10];
  {
    const int p0w = dir ? pos0 - sb0 : pos0 + sb0;
#pragma unroll
    for (int i = 0; i < 10; ++i) {
      const int pi = dir ? p0w - (i - 1) : p0w + (i - 1);
      const bool inb = pi >= 0 && pi < L;
      const int pc = pi < 0 ? 0 : (pi > L - 1 ? L - 1 : pi);
      const bf16_t* rowp = PRKV + (size_t)(sbase + pc) * 1536 + c;
      const float kx = bf2f(rowp[512]), vx = bf2f(rowp[1024]);
      rk_[i] = inb ? kx : 0.f; rv_[i] = inb ? vx : 0.f;
      if (P3) { const float rx = bf2f(rowp[0]); rr_[i] = inb ? rx : 0.f; } else rr_[i] = 0.f;
    }
  }
  {
    int sl = sb0 + (l31 & 7); if (sl > nsteps - 1) sl = nsteps - 1;
    const int pos = dir ? pos0 - sl : pos0 + sl;
    const bf16_t* lrp = LR + (size_t)(sbase + pos) * 384 + dir * 64 + 8 * h;
#pragma unroll 1
    for (int mat = 0; mat < 2; ++mat) {
      const bf16_t* Wm = mat ? AUPT : WUPT;
      const float* bias = mat ? p.d_a0 : p.d_w0;
      f32x16 ac[2];
#pragma unroll
      for (int nt = 0; nt < 2; ++nt)
#pragma unroll
        for (int i = 0; i < 16; ++i) ac[nt][i] = 0.f;
#pragma unroll
      for (int ks = 0; ks < 4; ++ks) {
        const bf16x8 fa = *(const bf16x8*)(lrp + mat * 128 + 16 * ks);
#pragma unroll
        for (int nt = 0; nt < 2; ++nt) {
          const bf16x8 bw = *(const bf16x8*)(Wm + (size_t)(32 * nt + l31) * 64 + 16 * ks + 8 * h);
          ac[nt] = MFMA32(fa, bw, ac[nt]);
        }
      }
      float* dstv = sv + (mat ? VB : VW) * NST * 64;
#pragma unroll
      for (int nt = 0; nt < 2; ++nt) {
        const int j = 32 * nt + l31;
        const float b0 = bias[dir * 512 + hd * 64 + j];
#pragma unroll
        for (int i = 0; i < 4; ++i) {
          const int st = sb0 + i + 4 * h;
          const float sg = 1.f / (1.f + __expf(-(b0 + ac[nt][i])));
          dstv[st * 64 + vperm(j)] = mat ? sg : __expf(-0.6065306597126334f * sg);
        }
      }
    }
  }
  const float mpr = p.mu_prev[c], mnr = p.mu_next[c], mpk = p.mu_prev[512 + c], mnk = p.mu_next[512 + c], mpv = p.mu_prev[1024 + c], mnv = p.mu_next[1024 + c];
  const float kkc = p.d_k_k[c], kac = p.d_k_a[c], rkc = p.d_r_k[c];
  const int pj = vperm(lane);
#pragma unroll
  for (int q = 0; q < 8; ++q) {
    const int s = sb0 + q;
    const float kb = rk_[q], kc = rk_[q + 1], ka = rk_[q + 2];
    const float vb = rv_[q], vc = rv_[q + 1], va = rv_[q + 2];
    const float k = kc + mpk * ((dir ? ka : kb) - kc) + mnk * ((dir ? kb : ka) - kc);
    const float v = vc + mpv * ((dir ? va : vb) - vc) + mnv * ((dir ? vb : va) - vc);
    const float a = sv[VB * NST * 64 + s * 64 + pj];
    float kk = k * kkc;
    const float n2 = wave_sum(kk * kk);
    kk *= rsqrtf(fmaxf(n2, 1e-24f));
    const float kd = k * (1.f + (a - 1.f) * kac);
    sv[VA * NST * 64 + s * 64 + pj] = -kk;
    sv[VB * NST * 64 + s * 64 + pj] = kk * a;
    sv[VK * NST * 64 + s * 64 + pj] = kd;
    sv[VV * NST * 64 + s * 64 + lane] = v;
    if (P3) {
      const float rb = rr_[q], rc = rr_[q + 1], ra = rr_[q + 2];
      const float r = rc + mpr * ((dir ? ra : rb) - rc) + mnr * ((dir ? rb : ra) - rc);
      sv[VR * NST * 64 + s * 64 + pj] = r;
      const float bn = wave_sum(r * kd * rkc);
      if (s < nsteps && lane == 0) {
        const int pos = dir ? pos0 - s : pos0 + s;
        bonus[((size_t)(sbase + pos) * 8 + hd) * 2 + dir] = bn;
      }
    }
  }
}

template <bool HALF> DI void scan1_body(const P& p, char* lds) {
  float* PQ = (float*)(p.ws + O_PQ);
  const int lane = threadIdx.x & 63, wave = __builtin_amdgcn_readfirstlane(threadIdx.x >> 6), slot = wave >> 1;
  constexpr int half = HALF ? 1 : 0;
  float* sv = (float*)lds + slot * (6 * 16 * 64);
  for (int g = blockIdx.x; g < 804; g += gridDim.x) {
    const int it = g * 4 + slot;
    const int dir = it & 1, hd = (it >> 1) & 7, cgi = it >> 4;
    int seq, c; chunk_decode(cgi, seq, c);
    const int L = seq_len(seq), sbase = seq_base(seq);
    const int start = c * 256, end = min(L, start + 256), n = end - start;
    float S[64];
#pragma unroll
    for (int j = 0; j < 64; ++j) S[j] = (half == 0 && j == lane) ? 1.f : 0.f;
    for (int s0 = 0; s0 < n; s0 += 16) {
      const int ns = min(16, n - s0);
      const int pos0 = dir ? end - 1 - s0 : start + s0;
      __syncthreads();
      scan_prologue8<16, false>(p, sbase, L, hd, dir, pos0, ns, half * 8, sv);
      __syncthreads();
      scan_steps<16, HALF, false>(S, sv, ns, lane, [](int, float) {});
    }
    float* dst = PQ + (size_t)it * 8192 + (size_t)(half * 64 + lane) * 64;
#pragma unroll
    for (int q = 0; q < 16; ++q) *(float4*)(dst + q * 4) = make_float4(S[q * 4], S[q * 4 + 1], S[q * 4 + 2], S[q * 4 + 3]);
  }
}

DI void phase_scan1(const P& p, char* lds) {
  if (__builtin_amdgcn_readfirstlane(threadIdx.x >> 6) & 1) scan1_body<true>(p, lds); else scan1_body<false>(p, lds);
}

DI void phase_scan2(const P& p, char* lds) {
  float* Ss = (float*)lds;
  float* Ps = Ss + 64 * 65;
  float* PQ = (float*)(p.ws + O_PQ);
  const int tid = threadIdx.x, i = tid >> 3, j0 = (tid & 7) * 8;
  for (int it = blockIdx.x; it < 144; it += gridDim.x) {
    const int dir = it & 1, hd = (it >> 1) & 7, seq = it >> 4;
    const int nch = seq < 8 ? 17 : 65, cg0 = seq < 8 ? seq * 17 : 136;
    float S[8];
#pragma unroll
    for (int jj = 0; jj < 8; ++jj) S[jj] = 0.f;
    for (int cc = 0; cc < nch; ++cc) {
      const int c = dir ? nch - 1 - cc : cc;
      float* Pg = PQ + (size_t)(((cg0 + c) * 8 + hd) * 2 + dir) * 8192;
      float* Qg = Pg + 4096;
      __syncthreads();
#pragma unroll
      for (int jj = 0; jj < 8; ++jj) Ss[i * 65 + j0 + jj] = S[jj];
#pragma unroll
      for (int r4 = 0; r4 < 2; ++r4) *(float4*)(Ps + (r4 * 512 + tid) * 4) = *(const float4*)(Pg + (r4 * 512 + tid) * 4);
      float acc[8];
#pragma unroll
      for (int r4 = 0; r4 < 2; ++r4) {
        float4 qv = *(const float4*)(Qg + i * 64 + j0 + r4 * 4);
        acc[r4 * 4] = qv.x; acc[r4 * 4 + 1] = qv.y; acc[r4 * 4 + 2] = qv.z; acc[r4 * 4 + 3] = qv.w;
      }
#pragma unroll
      for (int r4 = 0; r4 < 2; ++r4) *(float4*)(Qg + i * 64 + j0 + r4 * 4) = make_float4(S[r4 * 4], S[r4 * 4 + 1], S[r4 * 4 + 2], S[r4 * 4 + 3]);
      __syncthreads();
      for (int m = 0; m < 64; ++m) {
        const float sm = Ss[i * 65 + m];
        const float* pr = Ps + m * 64 + j0;
#pragma unroll
        for (int jj = 0; jj < 8; ++jj) acc[jj] += sm * pr[jj];
      }
#pragma unroll
      for (int jj = 0; jj < 8; ++jj) S[jj] = acc[jj];
    }
  }
}

DI void phase_scan3(const P& p, char* lds) {
  const float* PQ = (const float*)(p.ws + O_PQ);
  bf16_t* MIX = (bf16_t*)(p.ws + O_MIX);
  bf16_t* OB = (bf16_t*)(p.ws + O_OB);
  const int lane = threadIdx.x & 63, wave = __builtin_amdgcn_readfirstlane(threadIdx.x >> 6);
  float* sv = (float*)lds + wave * (6 * 8 * 64);
  for (int g = blockIdx.x; g < 402; g += gridDim.x) {
    const int it = g * 8 + wave;
    const int dir = it & 1, hd = (it >> 1) & 7, cgi = it >> 4;
    int seq, c; chunk_decode(cgi, seq, c);
    const int L = seq_len(seq), sbase = seq_base(seq);
    const int start = c * 256, end = min(L, start + 256), n = end - start;
    float S[64];
    {
      const float* src = PQ + (size_t)it * 8192 + 4096 + lane * 64;
#pragma unroll
      for (int q = 0; q < 16; ++q) { float4 t = *(const float4*)(src + q * 4); S[q * 4] = t.x; S[q * 4 + 1] = t.y; S[q * 4 + 2] = t.z; S[q * 4 + 3] = t.w; }
    }
    for (int s0 = 0; s0 < n; s0 += 8) {
      const int ns = min(8, n - s0);
      const int pos0 = dir ? end - 1 - s0 : start + s0;
      scan_prologue8<8, true>(p, sbase, L, hd, dir, pos0, ns, 0, sv);
      scan_steps<8, true, true>(S, sv, ns, lane, [&](int st, float o) {
        const int pos = dir ? pos0 - st : pos0 + st;
        const size_t sr = (size_t)(sbase + pos);
        if (dir == 0) MIX[sr * 1024 + 512 + hd * 64 + lane] = f2bf(o);
        else OB[sr * 512 + hd * 64 + lane] = f2bf(o);
      });
    }
  }
}

DI void phase_rwkv_final(const P& p) {
  const int lane = threadIdx.x & 63, gw = (blockIdx.x * NTH + threadIdx.x) >> 6, nw = (gridDim.x * NTH) >> 6;
  bf16_t* MIX = (bf16_t*)(p.ws + O_MIX);
  const bf16_t* OB = (const bf16_t*)(p.ws + O_OB);
  const bf16_t* G = (const bf16_t*)(p.ws + O_G);
  const bf16_t* PRKV = (const bf16_t*)(p.ws + O_PRKV);
  const float* bonus = (const float*)(p.ws + O_BONUS);
  const int hd = lane >> 3, c0 = lane * 8;
  for (int sr = gw; sr < T_; sr += nw) {
    int pos; int b = seq_of(sr, pos);
    const int L = seq_len(b);
    uint4 uf = *(const uint4*)(MIX + (size_t)sr * 1024 + 512 + c0);
    uint4 ub = *(const uint4*)(OB + (size_t)sr * 512 + c0);
    uint4 ug = *(const uint4*)(G + (size_t)sr * 512 + c0);
    unsigned f_[4] = {uf.x, uf.y, uf.z, uf.w}, b_[4] = {ub.x, ub.y, ub.z, ub.w}, g_[4] = {ug.x, ug.y, ug.z, ug.w};
    float o[8], gg[8];
    float sm = 0.f;
#pragma unroll
    for (int j = 0; j < 4; ++j) {
      o[2 * j] = lo2f(f_[j]) + lo2f(b_[j]); o[2 * j + 1] = hi2f(f_[j]) + hi2f(b_[j]);
      gg[2 * j] = lo2f(g_[j]); gg[2 * j + 1] = hi2f(g_[j]);
      sm += o[2 * j] + o[2 * j + 1];
    }
    sm += __shfl_xor(sm, 1); sm += __shfl_xor(sm, 2); sm += __shfl_xor(sm, 4);
    const float mean = sm * (1.f / 64.f);
    float vs = 0.f;
#pragma unroll
    for (int j = 0; j < 8; ++j) { float dlt = o[j] - mean; vs += dlt * dlt; }
    vs += __shfl_xor(vs, 1); vs += __shfl_xor(vs, 2); vs += __shfl_xor(vs, 4);
    const float rstd = rsqrtf(vs * (1.f / 64.f) + 64e-5f);
    const float bsum = bonus[((size_t)sr * 8 + hd) * 2] + bonus[((size_t)sr * 8 + hd) * 2 + 1];
    float y[8];
#pragma unroll
    for (int j = 0; j < 8; ++j) {
      int c = c0 + j;
      float vsh = shiftv(PRKV, sr, pos, L, 1024 + c, p.mu_prev[1024 + c], p.mu_next[1024 + c]);
      y[j] = ((o[j] - mean) * rstd * p.d_ln_g[c] + p.d_ln_b[c] + bsum * vsh) * gg[j];
    }
    *(uint4*)(MIX + (size_t)sr * 1024 + 512 + c0) = make_uint4(pack2(y[0], y[1]), pack2(y[2], y[3]), pack2(y[4], y[5]), pack2(y[6], y[7]));
  }
}

constexpr int NPHASE = 23;
__global__ void __launch_bounds__(NTH, 2) mega(P p) {
  extern __shared__ __attribute__((aligned(16))) unsigned char shm[];
  char* lds = (char*)shm;
  char* ws = p.ws;
#ifndef DUP_MASK
#define DUP_MASK 0u
#endif
#define RUN(k, call) if (p.ph0 <= k && k < p.ph1) { call; if ((DUP_MASK >> k) & 1u) { cg::this_grid().sync(); call; } if (k + 1 < p.ph1) cg::this_grid().sync(); }
  RUN(0, phase_prep(p))
  RUN(1, phase_gemm_big((const bf16_t*)(ws + O_HN), (const bf16_t*)(ws + O_WIN0), 1536, 1024, (bf16_t*)(ws + O_PROJ0), 1536, 0, ws, shm))
  RUN(2, phase_prepA(p, lds))
  RUN(3, phase_attnA(p, lds))
  RUN(4, phase_fnet_gemm(p, lds))
  RUN(5, phase_gemm_big((const bf16_t*)(ws + O_MIX), (const bf16_t*)(ws + O_WOUT0), 1024, 1024, (bf16_t*)(ws + O_HN), 1024, 0, ws, shm))
  RUN(6, phase_resnorm(p, p.post_mix_g, p.pre_ffn_g))
  RUN(7, phase_gemm_gateup((const bf16_t*)(ws + O_HN), (const bf16_t*)(ws + O_WGU0), (bf16_t*)(ws + O_ACT), shm))
  RUN(8, phase_gemm_big((const bf16_t*)(ws + O_ACT), (const bf16_t*)(ws + O_WD0), 1024, DFF, (bf16_t*)(ws + O_HN), 1024, 0, ws, shm))
  RUN(9, phase_resnorm(p, p.post_ffn_g, p.pre_mix_g + 1024))
  RUN(10, phase_gemm_big((const bf16_t*)(ws + O_HN), (const bf16_t*)(ws + O_WIN1), 2816, 1024, nullptr, 0, 1, ws, shm))
  RUN(11, phase_prepC(p))
  RUN(12, phase_attnC(p, lds))
  RUN(13, phase_scan1(p, lds))
  RUN(14, phase_scan2(p, lds))
  RUN(15, phase_scan3(p, lds))
  RUN(16, phase_gemm_small((const bf16_t*)(ws + O_LR) + 256, 384, (const bf16_t*)(ws + O_GUP), 512, 128, (bf16_t*)(ws + O_G), 512, lds))
  RUN(17, phase_rwkv_final(p))
  RUN(18, phase_gemm_big((const bf16_t*)(ws + O_MIX), (const bf16_t*)(ws + O_WOUT1), 1024, 1024, (bf16_t*)(ws + O_HN), 1024, 0, ws, shm))
  RUN(19, phase_resnorm(p, p.post_mix_g + 1024, p.pre_ffn_g + 1024))
  RUN(20, phase_gemm_gateup((const bf16_t*)(ws + O_HN), (const bf16_t*)(ws + O_WGU1), (bf16_t*)(ws + O_ACT), shm))
  RUN(21, phase_gemm_big((const bf16_t*)(ws + O_ACT), (const bf16_t*)(ws + O_WD1), 1024, DFF, (bf16_t*)(ws + O_HN), 1024, 0, ws, shm))
  RUN(22, phase_resnorm(p, p.post_ffn_g + 1024, nullptr))
#undef RUN
}

extern "C" void kernel_launch(void* const* d_in, const int* in_sizes, int n_in, void* d_out, int out_size, void* d_ws, size_t ws_size,
                              hipStream_t stream) {
  static int grid_blocks = 0;
  if (!grid_blocks) {
    int dev = 0, cus = 0, per_cu = 0;
    (void)hipGetDevice(&dev);
    (void)hipDeviceGetAttribute(&cus, hipDeviceAttributeMultiprocessorCount, dev);
    if (hipFuncSetAttribute((const void*)mega, hipFuncAttributeMaxDynamicSharedMemorySize, LDS_BYTES) != hipSuccess) fprintf(stderr, "hipFuncSetAttribute failed\n");
    if (hipOccupancyMaxActiveBlocksPerMultiprocessor(&per_cu, (const void*)mega, NTH, LDS_BYTES) != hipSuccess || per_cu < 1) {
      fprintf(stderr, "occupancy query says %d\n", per_cu);
      (void)hipGetLastError();
    }
    grid_blocks = cus;
  }
  if (ws_size < O_END) { fprintf(stderr, "workspace too small\n"); return; }
  P p{};
  const float** f = (const float**)&p;
  for (int i = 0; i < 32; ++i) f[i] = (const float*)d_in[i];
  p.out = (float*)d_out;
  p.ws = (char*)d_ws;
#if FUSED
  p.ph0 = 0; p.ph1 = NPHASE;
  void* args[] = {&p};
  hipError_t e = hipLaunchCooperativeKernel((void*)mega, dim3(grid_blocks), dim3(NTH), args, LDS_BYTES, stream);
  if (e != hipSuccess) fprintf(stderr, "cooperative launch failed: %s (grid %d)\n", hipGetErrorString(e), grid_blocks);
#else
  for (int ph = 0; ph < NPHASE; ++ph) {
    p.ph0 = ph; p.ph1 = ph + 1;
    hipLaunchKernelGGL(mega, dim3(grid_blocks), dim3(NTH), LDS_BYTES, stream, p);
  }
#endif
}
```

```cpp
#include <hip/hip_runtime.h>
#include <hip/hip_cooperative_groups.h>
#include <cstdio>
namespace cg = cooperative_groups;

#ifndef FUSED
#define FUSED 1
#endif

typedef unsigned short bf16_t;
using bf16x8 = __attribute__((ext_vector_type(8))) short;
using s16x4 = __attribute__((ext_vector_type(4))) short;
using f32x16 = __attribute__((ext_vector_type(16))) float;
using u32x4 = __attribute__((ext_vector_type(4))) unsigned;
#define DI __device__ __forceinline__
#define MFMA32(a, b, c) __builtin_amdgcn_mfma_f32_32x32x16_bf16((a), (b), (c), 0, 0, 0)
constexpr int NTH = 512;
constexpr int LDS_BYTES = 131072 + 16;

constexpr int DM_ = 1024;
constexpr int T_ = 49296;
constexpr int TP_ = 49408;
constexpr int NT_ = TP_ / 128;
constexpr int DFF = 2816;
constexpr float EPS = 1e-6f;
constexpr float LOG2E = 1.4426950408889634f;

constexpr size_t SZ_ROW1024 = (size_t)TP_ * 1024 * 2;
constexpr size_t O_WIN0 = 0;
constexpr size_t O_WOUT0 = O_WIN0 + (size_t)1536 * 1024 * 2;
constexpr size_t O_WGU0 = O_WOUT0 + (size_t)1024 * 1024 * 2;
constexpr size_t O_WD0 = O_WGU0 + (size_t)5632 * 1024 * 2;
constexpr size_t O_DM257 = O_WD0 + (size_t)1024 * 2816 * 2;
constexpr size_t O_DM1025 = O_DM257 + (size_t)384 * 576 * 2;
constexpr size_t O_WIN1 = O_DM1025 + (size_t)1152 * 2112 * 2;
constexpr size_t O_WOUT1 = O_WIN1 + (size_t)2816 * 1024 * 2;
constexpr size_t O_WGU1 = O_WOUT1 + (size_t)1024 * 1024 * 2;
constexpr size_t O_WD1 = O_WGU1 + (size_t)5632 * 1024 * 2;
constexpr size_t O_GUP = O_WD1 + (size_t)1024 * 2816 * 2;
constexpr size_t O_RA = O_GUP + (size_t)512 * 128 * 2;
constexpr size_t O_RB = O_RA + SZ_ROW1024;
constexpr size_t O_RC = O_RB + (size_t)TP_ * 2816 * 2;
constexpr size_t O_META = O_RC + SZ_ROW1024;
constexpr size_t O_WC = O_META + (size_t)144 * 1024 * 4;
constexpr size_t O_WUPT = O_WC + (size_t)4 * 64 * 128 * 4;
constexpr size_t O_AUPT = O_WUPT + (size_t)2 * 512 * 64 * 2;
constexpr size_t O_END = O_AUPT + (size_t)2 * 512 * 64 * 2;
constexpr size_t O_HN = O_RA;
constexpr size_t O_VTA = O_RA;
constexpr size_t O_LR = O_RA;
constexpr size_t O_BONUS = O_RA + (size_t)TP_ * 384 * 2;
constexpr size_t O_VTC = O_BONUS + (size_t)T_ * 16 * 4;
constexpr size_t O_OB = O_RA + (size_t)TP_ * 512 * 2;
constexpr size_t O_PROJ0 = O_RB;
constexpr size_t O_ZB = O_PROJ0 + (size_t)TP_ * 1536 * 2;
constexpr size_t O_Y = O_ZB + (size_t)TP_ * 512 * 2;
constexpr size_t O_ACT = O_RB;
constexpr size_t O_PRKV = O_RB;
constexpr size_t O_PC = O_PRKV + (size_t)TP_ * 1536 * 2;
constexpr size_t O_PLOW = O_PC + (size_t)TP_ * 768 * 2;
constexpr size_t O_PQ = O_PC;
constexpr size_t O_G = O_PC;
constexpr size_t O_MIX = O_RC;
static_assert(O_VTC + (size_t)49728 * 128 * 2 <= O_RB, "vtc");
static_assert(O_Y + (size_t)(8 * 16 * 256 * 576 + 16 * 256 * 2112) * 2 <= O_RC, "y");
static_assert(O_PQ + (size_t)3216 * 32768 <= O_RC, "pq");
constexpr size_t O_BAR = (O_END + 255) / 256 * 256;
static_assert(O_BAR + 3456 * 4 <= (size_t)536870912, "ws");

struct P {
  const float *x_prompt, *x_sample, *meta, *pre_mix_g, *post_mix_g, *pre_ffn_g, *post_ffn_g;
  const float *even_w_in, *even_w_out, *a_q_gain, *a_k_gain, *b_norm_g, *b_w, *b_b;
  const float *odd_w_in, *odd_w_out, *c_sink, *mu_prev, *mu_next, *d_w0, *d_w_up, *d_a0, *d_a_up, *d_g_up;
  const float *d_k_k, *d_k_a, *d_r_k, *d_ln_g, *d_ln_b, *ffn_gate, *ffn_up, *ffn_down;
  float* out;
  char* ws;
  int ph0, ph1;
};

typedef float f32x2 __attribute__((ext_vector_type(2)));
typedef __bf16 bf16x2_t __attribute__((ext_vector_type(2)));
DI bf16_t f2bf(float x) { return __builtin_bit_cast(bf16_t, (__bf16)x); }
DI float bf2f(bf16_t b) { return __uint_as_float(((unsigned)b) << 16); }
DI unsigned pack2(float a, float b) { f32x2 v = {a, b}; return __builtin_bit_cast(unsigned, __builtin_convertvector(v, bf16x2_t)); }
DI float lo2f(unsigned u) { return __uint_as_float(u << 16); }
DI float hi2f(unsigned u) { return __uint_as_float(u & 0xffff0000u); }
DI float wave_sum(float v) {
  for (int o = 32; o > 0; o >>= 1) v += __shfl_xor(v, o);
  return v;
}
DI int seq_of(int sr, int& pos) {
  if (sr < 32896) { int b = sr / 4112; pos = sr - b * 4112; return b; }
  pos = sr - 32896; return 8;
}
DI int seq_len(int b) { return b < 8 ? 4112 : 16400; }
DI int seq_base(int b) { return b < 8 ? b * 4112 : 32896; }
DI float* hrow(const P& p, int sr) {
  int pos; int b = seq_of(sr, pos);
  if (pos < 16) return (float*)(p.ws + O_META) + (size_t)(b * 16 + pos) * 1024;
  return p.out + ((size_t)(b < 8 ? b * 4096 : 32768) + (pos - 16)) * 1024;
}
DI float sigmoidf_(float x) { return 1.f / (1.f + expf(-x)); }

DI void transpose_w(const float* W, int K, int ldw, int N, bf16_t* Wt, int mode, const float* W2, int gtid, int gsz) {
  int nk8 = K / 8;
  long total = (long)N * nk8;
  for (long it = gtid; it < total; it += gsz) {
    int n = (int)(it % N), k8 = (int)(it / N);
    const float* src = W;
    int c = n;
    if (mode == 1) {
      int blk = n >> 8, w = n & 255;
      c = blk * 128 + (w & 127);
      if (w >= 128) src = W2;
    }
    unsigned r[4];
#pragma unroll
    for (int j = 0; j < 4; ++j) {
      float a = src[(size_t)(k8 * 8 + 2 * j) * ldw + c];
      float b = src[(size_t)(k8 * 8 + 2 * j + 1) * ldw + c];
      r[j] = pack2(a, b);
    }
    *(uint4*)(Wt + (size_t)n * K + k8 * 8) = make_uint4(r[0], r[1], r[2], r[3]);
  }
}

DI void phase_prep(const P& p) {
  const int gtid = blockIdx.x * NTH + threadIdx.x, gsz = gridDim.x * NTH;
  char* ws = p.ws;
  transpose_w(p.even_w_in, 1024, 1536, 1536, (bf16_t*)(ws + O_WIN0), 0, nullptr, gtid, gsz);
  transpose_w(p.even_w_out, 1024, 1024, 1024, (bf16_t*)(ws + O_WOUT0), 0, nullptr, gtid, gsz);
  transpose_w(p.odd_w_in, 1024, 2688, 2688, (bf16_t*)(ws + O_WIN1), 0, nullptr, gtid, gsz);
  transpose_w(p.odd_w_out, 1024, 1024, 1024, (bf16_t*)(ws + O_WOUT1), 0, nullptr, gtid, gsz);
  transpose_w(p.ffn_gate, 1024, DFF, 5632, (bf16_t*)(ws + O_WGU0), 1, p.ffn_up, gtid, gsz);
  transpose_w(p.ffn_gate + (size_t)1024 * DFF, 1024, DFF, 5632, (bf16_t*)(ws + O_WGU1), 1, p.ffn_up + (size_t)1024 * DFF, gtid, gsz);
  transpose_w(p.ffn_down, DFF, 1024, 1024, (bf16_t*)(ws + O_WD0), 0, nullptr, gtid, gsz);
  transpose_w(p.ffn_down + (size_t)DFF * 1024, DFF, 1024, 1024, (bf16_t*)(ws + O_WD1), 0, nullptr, gtid, gsz);
  transpose_w(p.d_g_up, 128, 512, 512, (bf16_t*)(ws + O_GUP), 0, nullptr, gtid, gsz);
  for (int d = 0; d < 2; ++d) {
    transpose_w(p.d_w_up + (size_t)d * 64 * 512, 64, 512, 512, (bf16_t*)(ws + O_WUPT) + (size_t)d * 512 * 64, 0, nullptr, gtid, gsz);
    transpose_w(p.d_a_up + (size_t)d * 64 * 512, 64, 512, 512, (bf16_t*)(ws + O_AUPT) + (size_t)d * 512 * 64, 0, nullptr, gtid, gsz);
  }
  for (int it = gtid; it < 128 * 1024 / 8; it += gsz) *(uint4*)((bf16_t*)(ws + O_WIN1) + (size_t)2688 * 1024 + (size_t)it * 8) = make_uint4(0, 0, 0, 0);
  for (int which = 0; which < 2; ++which) {
    const int M = which ? 1025 : 257, MP = which ? 1152 : 384, KP = which ? 2112 : 576;
    bf16_t* dm = (bf16_t*)(ws + (which ? O_DM1025 : O_DM257));
    for (int it = gtid; it < MP * KP; it += gsz) {
      int r = it / KP, c = it - r * KP;
      float v = 0.f;
      if (r < M && c < 2 * M) {
        int n2 = c < M ? c : c - M;
        int m = (r * n2) % M;
        float s, co;
        sincospif(2.0f * (float)m / (float)M, &s, &co);
        v = c < M ? co : s;
      }
      dm[it] = f2bf(v);
    }
  }
  for (int it = gtid; it < 4 * 64 * 128; it += gsz) {
    int o = it & 127, c = (it >> 7) & 63, g = it >> 13;
    int d = o & 63;
    float acc = 0.f;
    for (int c2 = 0; c2 < 64; ++c2) {
      float s, co;
      sincospif((float)((c * c2) & 63) / 32.f, &s, &co);
      float w = p.b_w[(g * 64 + c2) * 64 + d];
      acc += (o < 64 ? co : -s) * w;
    }
    ((float*)(ws + O_WC))[it] = acc;
  }
  const int lane = threadIdx.x & 63, gw = gtid >> 6, nw = gsz >> 6;
  bf16_t* HN = (bf16_t*)(ws + O_HN);
  for (int sr = gw; sr < TP_; sr += nw) {
    if (sr >= T_) {
#pragma unroll
      for (int q = 0; q < 2; ++q) *(uint4*)(HN + (size_t)sr * 1024 + q * 512 + lane * 8) = make_uint4(0, 0, 0, 0);
      continue;
    }
    int pos; int b = seq_of(sr, pos);
    const float* src = pos < 16 ? p.meta + pos * 1024
                                : (b < 8 ? p.x_prompt + ((size_t)b * 4096 + pos - 16) * 1024 : p.x_sample + (size_t)(pos - 16) * 1024);
    float* hr = hrow(p, sr);
    float4 v[4];
    float ss = 0.f;
#pragma unroll
    for (int q = 0; q < 4; ++q) {
      v[q] = *(const float4*)(src + q * 256 + lane * 4);
      ss += v[q].x * v[q].x + v[q].y * v[q].y + v[q].z * v[q].z + v[q].w * v[q].w;
      *(float4*)(hr + q * 256 + lane * 4) = v[q];
    }
    ss = wave_sum(ss);
    float rs = rsqrtf(ss * (1.f / 1024.f) + EPS);
#pragma unroll
    for (int q = 0; q < 4; ++q) {
      float4 g = *(const float4*)(p.pre_mix_g + q * 256 + lane * 4);
      uint2 o = make_uint2(pack2(v[q].x * rs * g.x, v[q].y * rs * g.y), pack2(v[q].z * rs * g.z, v[q].w * rs * g.w));
      *(uint2*)(HN + (size_t)sr * 1024 + q * 256 + lane * 4) = o;
    }
  }
}

DI void gemm_tile(const bf16_t* __restrict__ A, int lda, const bf16_t* __restrict__ B, int ldb, int K, char* lds, f32x16 (&acc)[2][2]) {
  const int tid = threadIdx.x & 255, lane = tid & 63, wave = tid >> 6, wm = wave >> 1, wn = wave & 1;
  const int l31 = lane & 31, h = lane >> 5;
  bf16_t* As = (bf16_t*)lds;
  bf16_t* Bs = As + 128 * 72;
#pragma unroll
  for (int a = 0; a < 2; ++a)
#pragma unroll
    for (int b = 0; b < 2; ++b)
#pragma unroll
      for (int i = 0; i < 16; ++i) acc[a][b][i] = 0.f;
  const int lr = tid >> 3, lc = (tid & 7) * 8;
  const bf16_t* Ag = A + (size_t)lr * lda + lc;
  const bf16_t* Bg = B + (size_t)lr * ldb + lc;
  u32x4 ra[4], rb[4];
#pragma unroll
  for (int q = 0; q < 4; ++q) {
    ra[q] = *(const u32x4*)(Ag + (size_t)(32 * q) * lda);
    rb[q] = *(const u32x4*)(Bg + (size_t)(32 * q) * ldb);
  }
#pragma unroll
  for (int q = 0; q < 4; ++q) {
    *(u32x4*)(As + (lr + 32 * q) * 72 + lc) = ra[q];
    *(u32x4*)(Bs + (lr + 32 * q) * 72 + lc) = rb[q];
  }
  __syncthreads();
  const int nk = K >> 6;
  for (int kt = 0; kt < nk; ++kt) {
    if (kt + 1 < nk) {
#pragma unroll
      for (int q = 0; q < 4; ++q) {
        ra[q] = *(const u32x4*)(Ag + (size_t)(32 * q) * lda + (kt + 1) * 64);
        rb[q] = *(const u32x4*)(Bg + (size_t)(32 * q) * ldb + (kt + 1) * 64);
      }
    }
#pragma unroll
    for (int ks = 0; ks < 4; ++ks) {
      bf16x8 a[2], b[2];
#pragma unroll
      for (int t = 0; t < 2; ++t) {
        a[t] = *(const bf16x8*)(As + (wm * 64 + t * 32 + l31) * 72 + ks * 16 + 8 * h);
        b[t] = *(const bf16x8*)(Bs + (wn * 64 + t * 32 + l31) * 72 + ks * 16 + 8 * h);
      }
#pragma unroll
      for (int mt = 0; mt < 2; ++mt)
#pragma unroll
        for (int nt = 0; nt < 2; ++nt) acc[mt][nt] = MFMA32(a[mt], b[nt], acc[mt][nt]);
    }
    __syncthreads();
    if (kt + 1 < nk) {
#pragma unroll
      for (int q = 0; q < 4; ++q) {
        *(u32x4*)(As + (lr + 32 * q) * 72 + lc) = ra[q];
        *(u32x4*)(Bs + (lr + 32 * q) * 72 + lc) = rb[q];
      }
      __syncthreads();
    }
  }
}
#define ACC_ROW(mt, i) (wm * 64 + (mt) * 32 + ((i) & 3) + 8 * ((i) >> 2) + 4 * h)
#define ACC_COL(nt) (wn * 64 + (nt) * 32 + l31)
#define GEMM_IDS const int lane = threadIdx.x & 63, wave = (threadIdx.x & 255) >> 6, wm = wave >> 1, wn = wave & 1, l31 = lane & 31, h = lane >> 5; (void)wm; (void)wn; (void)l31; (void)h;

DI void phase_gemm_small(const bf16_t* A, int lda, const bf16_t* W, int N, int K, bf16_t* C, int ldc, char* lds) {
  GEMM_IDS
  const int sb = threadIdx.x >> 8;
  const int ntn = N / 128;
  const int total = NT_ * ntn;
  for (int t0 = blockIdx.x * 2; t0 < total; t0 += gridDim.x * 2) {
    const int t = t0 + sb;
    const int tm = t / ntn, tn = t - tm * ntn;
    f32x16 acc[2][2];
    gemm_tile(A + (size_t)tm * 128 * lda, lda, W + (size_t)tn * 128 * K, K, K, lds + sb * 36864, acc);
#pragma unroll
    for (int mt = 0; mt < 2; ++mt)
#pragma unroll
      for (int nt = 0; nt < 2; ++nt)
#pragma unroll
        for (int i = 0; i < 16; ++i) {
          int row = tm * 128 + ACC_ROW(mt, i), col = tn * 128 + ACC_COL(nt);
          C[(size_t)row * ldc + col] = f2bf(acc[mt][nt][i]);
        }
  }
}

namespace pg8 {
#define PG8_LAS __attribute__((address_space(3)))
typedef unsigned short bf16_t;
typedef short bf16x8 __attribute__((ext_vector_type(8)));
typedef float f32x4 __attribute__((ext_vector_type(4)));
typedef unsigned u32x4 __attribute__((ext_vector_type(4)));
constexpr int BM = 256, BK = 64, HALF = 128, HTB = HALF * BK * 2  , STAGE_BYTES = 8 * HTB, NXCD = 8, WGM = 8;

__host__ __device__ __forceinline__ int lds_byte(int r, int c) { const int st = (r >> 4) * 2 + (c >> 5), rr = r & 15, cc = c & 31, ob = rr * 64 + cc * 2; return st * 1024 + (ob ^ (((ob >> 9) & 1) << 5)); }
__host__ __device__ __forceinline__ void stage_rc(int b, int& R, int& C) { const int st = b / 1024, sb = b % 1024, swz = sb ^ (((sb >> 9) & 1) << 5); R = (st >> 1) * 16 + swz / 64; C = (st & 1) * 32 + (swz % 64) / 2; }
__host__ __device__ __forceinline__ int perm32(int rho) { const int n = rho >> 4, i = rho & 15; return 8 * (i >> 2) + 4 * n + (i & 3); }

struct Unit { int pm, pn; };
struct Gemm { const bf16_t* A; const bf16_t* Bt; int M, N, K; };

struct StaticOrder {
    int nM, nN, nwg, G, c;
    __host__ __device__ void init(int M, int N, int G_, int c_) { nM = M / BM; nN = N / BM; nwg = nM * nN; G = G_; c = c_; }
    __host__ __device__ bool next(int i, Unit& u) const {
        const long L = (long)i * G + c; if (L >= nwg) return false;
        int wgid = (int)L; { const int q = nwg / NXCD, r = nwg % NXCD, xcd = wgid % NXCD, off = wgid / NXCD; wgid = (xcd < r ? xcd * (q + 1) : r * (q + 1) + (xcd - r) * q) + off; }
        const int nig = WGM * nN, gid = wgid / nig, fm = gid * WGM, gsz = (nM - fm) < WGM ? (nM - fm) : WGM;
        u.pm = fm + ((wgid % nig) % gsz); u.pn = (wgid % nig) / gsz; return true;
    }
    __device__ __forceinline__ void a_ready(const Unit&) const {}
    __device__ __forceinline__ void done(const Unit&) const {}
};
__device__ __forceinline__ unsigned cvt_pk_bf16(float lo, float hi) { unsigned r; asm volatile("v_cvt_pk_bf16_f32 %0, %1, %2" : "=v"(r) : "v"(lo), "v"(hi)); return r; }

struct EpiRoute {
    static constexpr bool PERM = true, AFTER_DRAIN = false;
    bf16_t* O; int ldc; int route; bf16_t* pc; bf16_t* prkv; bf16_t* plow;
    __device__ __forceinline__ void operator()(const f32x4 (&acc)[2][2][4][2], const Unit& u, int wr, int wc, int fr, int fq) const {
        const int row0 = u.pm * BM + wr * 64 + fr;
#pragma unroll
        for (int bj = 0; bj < 2; ++bj) {
            int colh = u.pn * BM + bj * HALF; bf16_t* base = O; int ld = ldc;
            if (route) {
                if (colh < 768) { base = pc; ld = 768; }
                else if (colh < 2304) { base = prkv; ld = 1536; colh -= 768; }
                else if (colh < 2688) { base = plow; ld = 384; colh -= 2304; }
                else continue;
            }
            const int col0 = colh + wc * 32 + 8 * fq;
#pragma unroll
            for (int ai = 0; ai < 2; ++ai)
#pragma unroll
                for (int m = 0; m < 4; ++m) { bf16_t* rowp = base + (size_t)(row0 + ai * HALF + m * 16) * ld + col0;
                    const f32x4 v0 = acc[ai][bj][m][0], v1 = acc[ai][bj][m][1];
                    u32x4 w; w.x = cvt_pk_bf16(v0[0], v0[1]); w.y = cvt_pk_bf16(v0[2], v0[3]); w.z = cvt_pk_bf16(v1[0], v1[1]); w.w = cvt_pk_bf16(v1[2], v1[3]);
                    *(u32x4*)rowp = w; }
        }
    }
};
struct EpiGateUp {
    static constexpr bool PERM = true, AFTER_DRAIN = false;
    bf16_t* ACT;
    __device__ __forceinline__ void operator()(const f32x4 (&acc)[2][2][4][2], const Unit& u, int wr, int wc, int fr, int fq) const {
        const int row0 = u.pm * BM + wr * 64 + fr, col0 = u.pn * HALF + wc * 32 + 8 * fq;
#pragma unroll
        for (int ai = 0; ai < 2; ++ai)
#pragma unroll
            for (int m = 0; m < 4; ++m) { bf16_t* rowp = ACT + (size_t)(row0 + ai * HALF + m * 16) * 2816 + col0;
                float v[8];
#pragma unroll
                for (int n = 0; n < 2; ++n)
#pragma unroll
                    for (int j = 0; j < 4; ++j) { const float g = acc[ai][0][m][n][j], uu = acc[ai][1][m][n][j]; v[n * 4 + j] = g * __builtin_amdgcn_rcpf(1.f + __expf(-g)) * uu; }
                u32x4 w; w.x = cvt_pk_bf16(v[0], v[1]); w.y = cvt_pk_bf16(v[2], v[3]); w.z = cvt_pk_bf16(v[4], v[5]); w.w = cvt_pk_bf16(v[6], v[7]);
                *(u32x4*)rowp = w; }
    }
};
template <class Epi, class Sched, bool STAMP = false>
__device__ __forceinline__ void gemm_phase(PG8_LAS unsigned char* lds, const Gemm g, const Sched& S, const Epi& E, unsigned long long* stamps) {
    const int tid = threadIdx.x, wid = __builtin_amdgcn_readfirstlane(tid >> 6), lane = tid & 63, wr = wid >> 2, wc = wid & 3, fr = lane & 15, fq = lane >> 4;
    const int K = g.K, nt = K / BK;
    int ts_lo = 0, ts_hi = 0, nts = 0; const unsigned long long rt_entry = STAMP ? (unsigned long long)wall_clock64() : 0ull;
#define PG8_STAMP() do { if (STAMP && wid == 0 && nts < 64) { const unsigned long long _c = (unsigned long long)clock64(); \
        ts_lo = (lane == nts) ? (int)(unsigned)_c : ts_lo; ts_hi = (lane == nts) ? (int)(unsigned)(_c >> 32) : ts_hi; ++nts; } } while (0)
    PG8_STAMP();
    unsigned voffA[2], voffB[2];
#pragma unroll
    for (int i = 0; i < 2; ++i) { int R, C; stage_rc(tid * 16 + i * 8192, R, C); const int Rb = Epi::PERM ? ((R & ~31) + perm32(R & 31)) : R;
        voffA[i] = (unsigned)(R * K + C) * 2u; voffB[i] = (unsigned)(Rb * K + C) * 2u; }
    const size_t kstep = (size_t)(BK * 2);
    const size_t hstep = (size_t)HALF * K * 2;
    const size_t tstep = 2 * hstep;
    const unsigned ldsw = (unsigned)wid * 1024u;
    const int aoff = lds_byte(wr * 64 + fr, fq * 8), boff = lds_byte(wc * 32 + fr, fq * 8);
#define PG8_SA(b, h) (((b) * 2 + (h)) * HTB)
#define PG8_SB(b, h) ((4 + (b) * 2 + (h)) * HTB)
#define PG8_STAGE(bufoff, gbase, voff) do { _Pragma("unroll") for (int _i = 0; _i < 2; ++_i) \
        __builtin_amdgcn_global_load_lds((const unsigned*)((const char*)(gbase) + (voff)[_i]), (PG8_LAS unsigned*)(lds + (bufoff) + ldsw + _i * 8192), 16, 0, 0); } while (0)
#define PG8_LDA(dst, b, h) do { _Pragma("unroll") for (int m = 0; m < 4; ++m) _Pragma("unroll") for (int k = 0; k < 2; ++k) dst[m][k] = *(const PG8_LAS bf16x8*)(lds + PG8_SA(b, h) + aoff + m * 2048 + k * 1024); } while (0)
#define PG8_LDB(dst, b, h) do { _Pragma("unroll") for (int n = 0; n < 2; ++n) _Pragma("unroll") for (int k = 0; k < 2; ++k) dst[n][k] = *(const PG8_LAS bf16x8*)(lds + PG8_SB(b, h) + boff + n * 2048 + k * 1024); } while (0)
#define PG8_MMA(ai, bj, At, Bt) do { __builtin_amdgcn_s_setprio(1); _Pragma("unroll") for (int m = 0; m < 4; ++m) _Pragma("unroll") for (int n = 0; n < 2; ++n) _Pragma("unroll") for (int k = 0; k < 2; ++k) \
        acc[ai][bj][m][n] = __builtin_amdgcn_mfma_f32_16x16x32_bf16(Bt[n][k], At[m][k], acc[ai][bj][m][n], 0, 0, 0); __builtin_amdgcn_s_setprio(0); } while (0)
#define PG8_WAIT_V(n) asm volatile("s_waitcnt vmcnt(" #n ")" ::: "memory")
#define PG8_WAIT_L(n) asm volatile("s_waitcnt lgkmcnt(" #n ")" ::: "memory")
#define PG8_BAR __builtin_amdgcn_s_barrier()
#define PG8_SCHED __builtin_amdgcn_sched_barrier(0)
    Unit cur, nxt; int ui = 0;
    if (!S.next(0, cur)) return;
    f32x4 acc[2][2][4][2];
#pragma unroll
    for (int a = 0; a < 2; ++a)
#pragma unroll
        for (int b = 0; b < 2; ++b)
#pragma unroll
            for (int m = 0; m < 4; ++m)
#pragma unroll
                for (int n = 0; n < 2; ++n) acc[a][b][m][n] = (f32x4){0.f, 0.f, 0.f, 0.f};
    bf16x8 At[4][2], B0[2][2], B1[2][2];
    const char* cA = (const char*)g.A + (size_t)cur.pm * tstep; const char* cB = (const char*)g.Bt + (size_t)cur.pn * tstep;
    S.a_ready(cur);
    PG8_STAGE(PG8_SB(0, 0), cB, voffB); PG8_STAGE(PG8_SA(0, 0), cA, voffA); PG8_STAGE(PG8_SB(0, 1), cB + hstep, voffB); PG8_STAGE(PG8_SA(0, 1), cA + hstep, voffA);
    if (wr == 1) PG8_BAR;
    PG8_WAIT_V(4); PG8_BAR;
    PG8_STAGE(PG8_SB(1, 0), cB + kstep, voffB); PG8_STAGE(PG8_SA(1, 0), cA + kstep, voffA); PG8_STAGE(PG8_SB(1, 1), cB + hstep + kstep, voffB);
    PG8_WAIT_V(6); PG8_BAR;
    PG8_STAMP();
    for (;;) {
        const bool has_next = S.next(ui + 1, nxt);
        const char* nA = has_next ? (const char*)g.A + (size_t)nxt.pm * tstep : cA; const char* nB = has_next ? (const char*)g.Bt + (size_t)nxt.pn * tstep : cB;
        for (int t = 0; t < nt; t += 2) {
            const bool last = (t == nt - 2);
            const char* a1 = cA + (size_t)(t + 1) * kstep;
            const char* a2 = last ? nA : cA + (size_t)(t + 2) * kstep; const char* b2 = last ? nB : cB + (size_t)(t + 2) * kstep;
            const char* a3 = a2 + kstep; const char* b3 = b2 + kstep;
            if (last && has_next) S.a_ready(nxt);
            PG8_LDB(B0, 0, 0); PG8_SCHED; PG8_LDA(At, 0, 0); PG8_STAGE(PG8_SA(1, 1), a1 + hstep, voffA);
            PG8_WAIT_L(8); PG8_BAR; PG8_WAIT_L(0); PG8_MMA(0, 0, At, B0); PG8_BAR; PG8_SCHED;
            PG8_LDB(B1, 0, 1); PG8_STAGE(PG8_SB(0, 0), b2, voffB);
            PG8_BAR; PG8_WAIT_L(0); PG8_MMA(0, 1, At, B1); PG8_BAR;
            PG8_LDA(At, 0, 1); PG8_STAGE(PG8_SA(0, 0), a2, voffA);
            PG8_BAR; PG8_WAIT_L(0); PG8_MMA(1, 0, At, B0); PG8_BAR; PG8_SCHED;
            PG8_STAGE(PG8_SB(0, 1), b2 + hstep, voffB);
            PG8_WAIT_V(6); PG8_BAR; PG8_MMA(1, 1, At, B1); PG8_BAR;
            PG8_LDB(B0, 1, 0); PG8_SCHED; PG8_LDA(At, 1, 0); PG8_STAGE(PG8_SA(0, 1), a2 + hstep, voffA);
            PG8_WAIT_L(8); PG8_BAR; PG8_WAIT_L(0); PG8_MMA(0, 0, At, B0); PG8_BAR; PG8_SCHED;
            PG8_LDB(B1, 1, 1); PG8_STAGE(PG8_SB(1, 0), b3, voffB);
            PG8_BAR; PG8_WAIT_L(0); PG8_MMA(0, 1, At, B1); PG8_BAR;
            PG8_LDA(At, 1, 1); PG8_STAGE(PG8_SA(1, 0), a3, voffA);
            PG8_BAR; PG8_WAIT_L(0); PG8_MMA(1, 0, At, B0); PG8_BAR; PG8_SCHED;
            PG8_STAGE(PG8_SB(1, 1), b3 + hstep, voffB);
            PG8_WAIT_V(6); PG8_BAR; PG8_MMA(1, 1, At, B1); PG8_BAR;
        }
        PG8_STAMP();
        if constexpr (!Epi::AFTER_DRAIN) { E(acc, cur, wr, wc, fr, fq); S.done(cur); }
        PG8_STAMP();
        if (!has_next) break;
#pragma unroll
        for (int a = 0; a < 2; ++a)
#pragma unroll
            for (int b = 0; b < 2; ++b)
#pragma unroll
                for (int m = 0; m < 4; ++m)
#pragma unroll
                    for (int n = 0; n < 2; ++n) acc[a][b][m][n] = (f32x4){0.f, 0.f, 0.f, 0.f};
        cur = nxt; cA = nA; cB = nB; ++ui;
    }
    PG8_WAIT_V(0);
    if (wr == 0) PG8_BAR;
    PG8_BAR;
    if constexpr (Epi::AFTER_DRAIN) { E.fused(acc, cur, wr, wc, fr, fq, lds, wid, lane); S.done(cur); }
    PG8_STAMP();
    if (STAMP && wid == 0) { stamps[lane] = lane < nts ? (((unsigned long long)(unsigned)ts_hi << 32) | (unsigned)ts_lo) : 0ull;
        if (lane == 62) stamps[62] = rt_entry; if (lane == 63) stamps[63] = (unsigned long long)wall_clock64(); }
#undef PG8_STAMP
#undef PG8_SA
#undef PG8_SB
#undef PG8_STAGE
#undef PG8_LDA
#undef PG8_LDB
#undef PG8_MMA
#undef PG8_WAIT_V
#undef PG8_WAIT_L
#undef PG8_BAR
#undef PG8_SCHED
}
}

DI void phase_gemm_big(const bf16_t* A, const bf16_t* W, int N, int K, bf16_t* C, int ldc, int route, char* ws, unsigned char* lds) {
  pg8::Gemm g{A, W, TP_, N, K};
  pg8::StaticOrder S; S.init(TP_, N, gridDim.x, blockIdx.x);
  pg8::EpiRoute E{C, ldc, route, (bf16_t*)(ws + O_PC), (bf16_t*)(ws + O_PRKV), (bf16_t*)(ws + O_PLOW)};
  pg8::gemm_phase<pg8::EpiRoute, pg8::StaticOrder, false>((PG8_LAS unsigned char*)lds, g, S, E, nullptr);
}
DI void phase_gemm_gateup(const bf16_t* A, const bf16_t* W, bf16_t* ACT, unsigned char* lds) {
  pg8::Gemm g{A, W, TP_, 5632, 1024};
  pg8::StaticOrder S; S.init(TP_, 5632, gridDim.x, blockIdx.x);
  pg8::EpiGateUp E{ACT};
  pg8::gemm_phase<pg8::EpiGateUp, pg8::StaticOrder, false>((PG8_LAS unsigned char*)lds, g, S, E, nullptr);
}

DI void phase_resnorm(const P& p, const float* g1, const float* g2) {
  const int lane = threadIdx.x & 63, gw = (blockIdx.x * NTH + threadIdx.x) >> 6, nw = (gridDim.x * NTH) >> 6;
  bf16_t* HN = (bf16_t*)(p.ws + O_HN);
  for (int sr = gw; sr < T_; sr += nw) {
    float* hr = hrow(p, sr);
    float x[16];
    uint4 u0 = *(const uint4*)(HN + (size_t)sr * 1024 + lane * 16);
    uint4 u1 = *(const uint4*)(HN + (size_t)sr * 1024 + lane * 16 + 8);
    unsigned uu[8] = {u0.x, u0.y, u0.z, u0.w, u1.x, u1.y, u1.z, u1.w};
    float ss = 0.f;
#pragma unroll
    for (int j = 0; j < 8; ++j) { x[2 * j] = lo2f(uu[j]); x[2 * j + 1] = hi2f(uu[j]); ss += x[2 * j] * x[2 * j] + x[2 * j + 1] * x[2 * j + 1]; }
    ss = wave_sum(ss);
    float rs = rsqrtf(ss * (1.f / 1024.f) + EPS);
    float hv[16];
    float ss2 = 0.f;
#pragma unroll
    for (int q = 0; q < 4; ++q) {
      float4 hh = *(const float4*)(hr + lane * 16 + q * 4);
      float4 g = *(const float4*)(g1 + lane * 16 + q * 4);
      hh.x += x[q * 4 + 0] * rs * g.x; hh.y += x[q * 4 + 1] * rs * g.y; hh.z += x[q * 4 + 2] * rs * g.z; hh.w += x[q * 4 + 3] * rs * g.w;
      *(float4*)(hr + lane * 16 + q * 4) = hh;
      hv[q * 4 + 0] = hh.x; hv[q * 4 + 1] = hh.y; hv[q * 4 + 2] = hh.z; hv[q * 4 + 3] = hh.w;
      ss2 += hh.x * hh.x + hh.y * hh.y + hh.z * hh.z + hh.w * hh.w;
    }
    if (g2) {
      ss2 = wave_sum(ss2);
      float rs2 = rsqrtf(ss2 * (1.f / 1024.f) + EPS);
      unsigned o[8];
#pragma unroll
      for (int q = 0; q < 4; ++q) {
        float4 g = *(const float4*)(g2 + lane * 16 + q * 4);
        o[2 * q] = pack2(hv[q * 4] * rs2 * g.x, hv[q * 4 + 1] * rs2 * g.y);
        o[2 * q + 1] = pack2(hv[q * 4 + 2] * rs2 * g.z, hv[q * 4 + 3] * rs2 * g.w);
      }
      *(uint4*)(HN + (size_t)sr * 1024 + lane * 16) = make_uint4(o[0], o[1], o[2], o[3]);
      *(uint4*)(HN + (size_t)sr * 1024 + lane * 16 + 8) = make_uint4(o[4], o[5], o[6], o[7]);
    }
  }
}

DI size_t vta_base(int seq) { return seq < 8 ? (size_t)seq * 256 * 4160 : (size_t)8 * 256 * 4160; }
template <int NC> DI void vt_transpose(const bf16_t* src, int ld, int col0, bf16_t* VT, char* lds) {
  bf16_t* tl = (bf16_t*)lds;
  const int tid = threadIdx.x;
  constexpr int CPT = NC / 8, TPR = 512 / NC, PPT = 64 / TPR;
  for (int it = blockIdx.x; it < 257 + 8 * 65; it += gridDim.x) {
    int seq, kt;
    if (it < 257) { seq = 8; kt = it; } else { const int j = it - 257; seq = j / 65; kt = j - seq * 65; }
    const int L = seq_len(seq), LP = L + 48, sbase = seq_base(seq);
    const size_t vb = (seq < 8 ? (size_t)seq * NC * 4160 : (size_t)8 * NC * 4160);
    __syncthreads();
    const int pl = tid >> 3, part = tid & 7;
    const int pos = 64 * kt + pl - 48;
#pragma unroll
    for (int q = 0; q < CPT / 8; ++q) {
      u32x4 v = (u32x4)(0u);
      if (pos >= 0) v = *(const u32x4*)(src + (size_t)(sbase + pos) * ld + col0 + part * CPT + q * 8);
#pragma unroll
      for (int j = 0; j < 4; ++j) {
        tl[(part * CPT + q * 8 + 2 * j) * 72 + pl] = (bf16_t)(v[j] & 0xffffu);
        tl[(part * CPT + q * 8 + 2 * j + 1) * 72 + pl] = (bf16_t)(v[j] >> 16);
      }
    }
    __syncthreads();
    const int row = tid / TPR, seg = tid % TPR;
    bf16_t* dst = VT + vb + (size_t)row * LP + 64 * kt + seg * PPT;
#pragma unroll
    for (int q = 0; q < PPT / 8; ++q) *(u32x4*)(dst + q * 8) = *(const u32x4*)(tl + row * 72 + seg * PPT + q * 8);
  }
}

DI void phase_prepA(const P& p, char* lds) {
  const int lane = threadIdx.x & 63, wave = threadIdx.x >> 6;
  bf16_t* PROJ = (bf16_t*)(p.ws + O_PROJ0);
  bf16_t* ZB = (bf16_t*)(p.ws + O_ZB);
  const float* WC = (const float*)(p.ws + O_WC);
  vt_transpose<256>(PROJ, 1536, 1024, (bf16_t*)(p.ws + O_VTA), lds);
  __syncthreads();
  float* fl = (float*)lds + wave * 1024;
  const float inv = exp2f(-(float)(lane & 15) * (13.287712379549449f / 16.f));
  const float qg = p.a_q_gain[lane], kg = p.a_k_gain[lane];
  for (int r0 = blockIdx.x * 32; r0 < TP_; r0 += gridDim.x * 32) {
    const int srb = r0 + wave * 4;
#pragma unroll 1
    for (int rr = 0; rr < 4; ++rr) {
      const int sr = srb + rr;
      if (sr < T_) {
        int pos; seq_of(sr, pos);
        float rowf, colf;
        if (pos < 16) { rowf = colf = (float)(pos - 16); }
        else { int t = pos - 16; rowf = (float)(t >> 6); colf = (float)(t & 63); }
        float ang = (lane < 32 ? rowf : colf) * inv;
        float sn, cs;
        sincosf(ang, &sn, &cs);
        const float sgn = (lane & 16) ? sn : -sn;
        bf16_t* pr = PROJ + (size_t)sr * 1536;
        for (int hd = 0; hd < 16; ++hd) {
          float x = bf2f(pr[hd * 64 + lane]);
          float ss = wave_sum(x * x);
          float xn = x * rsqrtf(ss * (1.f / 64.f) + EPS) * (hd < 12 ? qg : kg);
          float pa = __shfl_xor(xn, 16);
          float o = xn * cs + pa * sgn;
          if (hd < 12) o *= 0.125f * LOG2E;
          pr[hd * 64 + lane] = f2bf(o);
        }
        uint2 u = *(const uint2*)(pr + 1280 + lane * 4);
        float f0 = lo2f(u.x), f1 = hi2f(u.x), f2 = lo2f(u.y), f3 = hi2f(u.y);
        float ss = f0 * f0 + f1 * f1 + f2 * f2 + f3 * f3;
        ss += __shfl_xor(ss, 1); ss += __shfl_xor(ss, 2); ss += __shfl_xor(ss, 4); ss += __shfl_xor(ss, 8);
        float rs = rsqrtf(ss * (1.f / 64.f) + EPS);
        float4 g = *(const float4*)(p.b_norm_g + lane * 4);
        *(float4*)(fl + rr * 256 + lane * 4) = make_float4(f0 * rs * g.x, f1 * rs * g.y, f2 * rs * g.z, f3 * rs * g.w);
      } else {
        *(float4*)(fl + rr * 256 + lane * 4) = make_float4(0.f, 0.f, 0.f, 0.f);
      }
    }
    __syncthreads();
    {
      const int g = lane >> 4, o0 = (lane & 15) * 8;
      float acc[4][8];
#pragma unroll
      for (int rr = 0; rr < 4; ++rr)
#pragma unroll
        for (int j = 0; j < 8; ++j) acc[rr][j] = 0.f;
      const float* wc = WC + (size_t)g * 64 * 128 + o0;
#pragma unroll 4
      for (int c = 0; c < 64; ++c) {
        const float4 w0 = *(const float4*)(wc + c * 128), w1 = *(const float4*)(wc + c * 128 + 4);
#pragma unroll
        for (int rr = 0; rr < 4; ++rr) {
          const float f = fl[rr * 256 + g * 64 + c];
          acc[rr][0] += f * w0.x; acc[rr][1] += f * w0.y; acc[rr][2] += f * w0.z; acc[rr][3] += f * w0.w;
          acc[rr][4] += f * w1.x; acc[rr][5] += f * w1.y; acc[rr][6] += f * w1.z; acc[rr][7] += f * w1.w;
        }
      }
#pragma unroll
      for (int rr = 0; rr < 4; ++rr)
        if (srb + rr < T_)
          *(uint4*)(ZB + (size_t)(srb + rr) * 512 + g * 128 + o0) = make_uint4(pack2(acc[rr][0], acc[rr][1]), pack2(acc[rr][2], acc[rr][3]), pack2(acc[rr][4], acc[rr][5]), pack2(acc[rr][6], acc[rr][7]));
    }
    __syncthreads();
  }
}

template <int MODE>
DI void flash_item(const bf16_t* __restrict__ Q, int ldq, const bf16_t* __restrict__ Kb, int ldk, const bf16_t* __restrict__ Vt, int LP,
                   bf16_t* O, int ldo, int sbase, int S, int qt, float sinkl2, char* lds) {
  const int tid = threadIdx.x & 255, lane = tid & 63, wave = tid >> 6, l31 = lane & 31, h = lane >> 5;
  bf16_t* Ks = (bf16_t*)lds;
  bf16_t* Vs = Ks + 2 * 64 * 72;
  const int rl = wave * 32 + l31;
  const int qpos = qt == 0 ? (rl < 16 ? rl : 15) : 16 + 128 * (qt - 1) + rl;
  const bool qvalid = qt > 0 || rl < 16;
  bf16x8 qf[4];
  {
    const bf16_t* qr = Q + (size_t)(sbase + qpos) * ldq;
#pragma unroll
    for (int s = 0; s < 4; ++s) qf[s] = *(const bf16x8*)(qr + 16 * s + 8 * h);
  }
  const int nkt_all = (S + 64) / 64;
  int klo = 1, n;
  if (MODE == 0) { n = nkt_all; }
  else {
    if (qt == 0) { klo = 1; n = 3; }
    else {
      int c = qt - 1;
      klo = 2 * c - 1; if (klo < 1) klo = 1;
      int khi = 2 * c + 4; if (khi > nkt_all - 1) khi = nkt_all - 1;
      n = 1 + (khi - klo + 1);
    }
  }
  const int ldr = tid >> 2, ldp = (tid & 3) * 16;
  u32x4 rk0, rk1, rv0, rv1;
  auto ktile = [&](int idx) { return idx == 0 ? 0 : klo + idx - 1; };
#define FL_GLOAD(idx)                                                                               \
  {                                                                                                 \
    int kt_ = ktile(idx);                                                                           \
    int pos_ = 64 * kt_ + ldr - 48;                                                                 \
    if (pos_ >= 0) {                                                                                \
      const bf16_t* kp_ = Kb + (size_t)(sbase + pos_) * ldk + ldp;                                  \
      rk0 = *(const u32x4*)kp_; rk1 = *(const u32x4*)(kp_ + 8);                                 \
    } else { rk0 = (u32x4)(0u); rk1 = rk0; }                                       \
    const bf16_t* vp_ = Vt + (size_t)ldr * LP + 64 * kt_ + ldp;                                     \
    rv0 = *(const u32x4*)vp_; rv1 = *(const u32x4*)(vp_ + 8);                                   \
  }
#define FL_SSTORE(buf)                                                                              \
  {                                                                                                 \
    *(u32x4*)(Ks + (buf) * 64 * 72 + ldr * 72 + ldp) = rk0; *(u32x4*)(Ks + (buf) * 64 * 72 + ldr * 72 + ldp + 8) = rk1; \
    *(u32x4*)(Vs + (buf) * 64 * 72 + ldr * 72 + ldp) = rv0; *(u32x4*)(Vs + (buf) * 64 * 72 + ldr * 72 + ldp + 8) = rv1; \
  }
  f32x16 oacc[2];
#pragma unroll
  for (int i = 0; i < 16; ++i) { oacc[0][i] = 0.f; oacc[1][i] = 0.f; }
  float m = -1e30f, l = 0.f;
  FL_GLOAD(0)
  FL_SSTORE(0)
  __syncthreads();
  for (int idx = 0; idx < n; ++idx) {
    const int cur = idx & 1;
    if (idx + 1 < n) FL_GLOAD(idx + 1)
    const int kt = ktile(idx);
    const bf16_t* ks = Ks + cur * 64 * 72;
    const bf16_t* vs = Vs + cur * 64 * 72;
    f32x16 sacc[2];
#pragma unroll
    for (int t = 0; t < 2; ++t) {
#pragma unroll
      for (int i = 0; i < 16; ++i) sacc[t][i] = 0.f;
#pragma unroll
      for (int s = 0; s < 4; ++s) {
        bf16x8 kf = *(const bf16x8*)(ks + (32 * t + l31) * 72 + 16 * s + 8 * h);
        sacc[t] = MFMA32(kf, qf[s], sacc[t]);
      }
    }
    if (kt == 0) {
#pragma unroll
      for (int t = 0; t < 2; ++t)
#pragma unroll
        for (int i = 0; i < 16; ++i) {
          int kl = 32 * t + (i & 3) + 8 * (i >> 2) + 4 * h;
          if (kl < 48) sacc[t][i] = -1e30f;
        }
    } else if (MODE == 1) {
#pragma unroll
      for (int t = 0; t < 2; ++t)
#pragma unroll
        for (int i = 0; i < 16; ++i) {
          int kl = 32 * t + (i & 3) + 8 * (i >> 2) + 4 * h;
          int tk = 64 * (kt - 1) + kl;
          bool vis;
          if (qt == 0) vis = tk <= 112 + qpos;
          else { int tq = qpos - 16; int d = tq - tk; vis = d <= 128 && d >= -128; }
          if (!vis) sacc[t][i] = -1e30f;
        }
    }
    float tmax = -1e30f;
#pragma unroll
    for (int t = 0; t < 2; ++t)
#pragma unroll
      for (int i = 0; i < 16; ++i) tmax = fmaxf(tmax, sacc[t][i]);
    tmax = fmaxf(tmax, __shfl_xor(tmax, 32));
    if (__builtin_amdgcn_ballot_w64(tmax > m) != 0ull) {
      const float mn = fmaxf(m, tmax);
      const float alpha = __builtin_amdgcn_exp2f(m - mn);
      m = mn;
      l *= alpha;
#pragma unroll
      for (int i = 0; i < 16; ++i) { oacc[0][i] *= alpha; oacc[1][i] *= alpha; }
    }
    const f32x2 m2 = {m, m};
    f32x2 ls2 = {0.f, 0.f};
    unsigned pk[2][8];
#pragma unroll
    for (int t = 0; t < 2; ++t)
#pragma unroll
      for (int i2 = 0; i2 < 8; ++i2) {
        f32x2 d = {sacc[t][2 * i2], sacc[t][2 * i2 + 1]};
        d = d - m2;
        f32x2 e = {__builtin_amdgcn_exp2f(d.x), __builtin_amdgcn_exp2f(d.y)};
        ls2 += e;
        pk[t][i2] = __builtin_bit_cast(unsigned, __builtin_convertvector(e, bf16x2_t));
      }
    l += ls2.x + ls2.y;
#pragma unroll
    for (int t = 0; t < 2; ++t)
#pragma unroll
      for (int s2 = 0; s2 < 2; ++s2) {
        u32x4 pk4 = {pk[t][4 * s2], pk[t][4 * s2 + 1], pk[t][4 * s2 + 2], pk[t][4 * s2 + 3]};
        bf16x8 pf = __builtin_bit_cast(bf16x8, pk4);
#pragma unroll
        for (int dt = 0; dt < 2; ++dt) {
          const bf16_t* vp = vs + (32 * dt + l31) * 72 + 32 * t + 16 * s2 + 4 * h;
          uint2 lo = *(const uint2*)vp, hi = *(const uint2*)(vp + 8);
          u32x4 v4 = {lo.x, lo.y, hi.x, hi.y};
          bf16x8 vf = __builtin_bit_cast(bf16x8, v4);
          oacc[dt] = MFMA32(vf, pf, oacc[dt]);
        }
      }
    if (idx + 1 < n) FL_SSTORE(cur ^ 1)
    __syncthreads();
  }
  l += __shfl_xor(l, 32);
  if (MODE == 1) l += __builtin_amdgcn_exp2f(sinkl2 - m);
  const float il = 1.f / l;
  if (qvalid) {
    bf16_t* orow = O + (size_t)(sbase + qpos) * ldo;
#pragma unroll
    for (int dt = 0; dt < 2; ++dt)
#pragma unroll
      for (int g = 0; g < 4; ++g) {
        int d = 32 * dt + 8 * g + 4 * h;
        uint2 o = make_uint2(pack2(oacc[dt][4 * g] * il, oacc[dt][4 * g + 1] * il), pack2(oacc[dt][4 * g + 2] * il, oacc[dt][4 * g + 3] * il));
        *(uint2*)(orow + d) = o;
      }
  }
#undef FL_GLOAD
#undef FL_SSTORE
}

DI size_t y_base(int seq) { return seq < 8 ? (size_t)seq * 16 * 256 * 576 : (size_t)8 * 16 * 256 * 576; }
DI void phase_attnA(const P& p, char* lds) {
  const bf16_t* PROJ = (const bf16_t*)(p.ws + O_PROJ0);
  const bf16_t* VT = (const bf16_t*)(p.ws + O_VTA);
  bf16_t* MIX = (bf16_t*)(p.ws + O_MIX);
  const int nS = 129 * 6, nP = 8 * 33 * 6;
  const int sb = threadIdx.x >> 8;
  for (int it = blockIdx.x; it < nS + nP; it += gridDim.x) {
    int seq, qt, hq;
    if (it < nS) { seq = 8; hq = (it % 6) * 2 + sb; qt = it / 6; }
    else { int j = it - nS; hq = (j % 6) * 2 + sb; j /= 6; qt = j % 33; seq = j / 33; }
    const int kv = hq / 3;
    const int L = seq_len(seq), LP = L + 48;
    flash_item<0>(PROJ + hq * 64, 1536, PROJ + 768 + kv * 64, 1536, VT + vta_base(seq) + (size_t)kv * 64 * LP, LP,
                  MIX + hq * 64, 1024, seq_base(seq), L - 16, qt, 0.f, lds + sb * 36864);
  }
  const bf16_t* ZB = (const bf16_t*)(p.ws + O_ZB);
  bf16_t* Y = (bf16_t*)(p.ws + O_Y);
  const int lane = threadIdx.x & 63, wave = threadIdx.x >> 6;
  const int nI_S = 17 * 16, nI_P = 8 * 5 * 16;
  for (int it = blockIdx.x; it < nI_S + nI_P; it += gridDim.x) {
    int seq, nb, cb;
    if (it < nI_S) { seq = 8; cb = it & 15; nb = it >> 4; }
    else { int j = it - nI_S; cb = j & 15; j >>= 4; nb = j % 5; seq = j / 5; }
    const int M = seq < 8 ? 257 : 1025, KP = seq < 8 ? 576 : 2112, L = 16 * M;
    const int n2 = nb * 64 + lane;
    const int ch = cb * 16 + wave * 2;
    const int g = ch >> 6, d = ch & 63;
    bf16_t* yb = Y + y_base(seq);
    if (n2 < M) {
      float zr[16][2], zi[16][2];
#pragma unroll
      for (int n1 = 0; n1 < 16; ++n1) {
        const bf16_t* zp = ZB + (size_t)(seq_base(seq) + M * n1 + n2) * 512 + g * 128 + d;
        unsigned re = *(const unsigned*)zp, im = *(const unsigned*)(zp + 64);
        zr[n1][0] = lo2f(re); zr[n1][1] = hi2f(re); zi[n1][0] = lo2f(im); zi[n1][1] = hi2f(im);
      }
      for (int k1 = 0; k1 < 16; ++k1) {
        float ws_, wc_;
        sincospif(-(float)k1 / 8.f, &ws_, &wc_);
        float ar0 = zr[15][0], ai0 = zi[15][0], ar1 = zr[15][1], ai1 = zi[15][1];
#pragma unroll
        for (int n1 = 14; n1 >= 0; --n1) {
          float t0 = ar0 * wc_ - ai0 * ws_ + zr[n1][0]; ai0 = ar0 * ws_ + ai0 * wc_ + zi[n1][0]; ar0 = t0;
          float t1 = ar1 * wc_ - ai1 * ws_ + zr[n1][1]; ai1 = ar1 * ws_ + ai1 * wc_ + zi[n1][1]; ar1 = t1;
        }
        float ts, tc;
        sincospif(-2.f * (float)(k1 * n2) / (float)L, &ts, &tc);
        float yr0 = ar0 * tc - ai0 * ts, yi0 = ar0 * ts + ai0 * tc;
        float yr1 = ar1 * tc - ai1 * ts, yi1 = ar1 * ts + ai1 * tc;
        bf16_t* y0 = yb + ((size_t)k1 * 256 + ch) * KP;
        y0[n2] = f2bf(yr0); y0[M + n2] = f2bf(yi0);
        y0[KP + n2] = f2bf(yr1); y0[KP + M + n2] = f2bf(yi1);
      }
    } else if (n2 < KP - M) {
      for (int k1 = 0; k1 < 16; ++k1) {
        bf16_t* y0 = yb + ((size_t)k1 * 256 + ch) * KP;
        y0[M + n2] = 0; y0[KP + M + n2] = 0;
      }
    }
  }
}

DI void phase_fnet_gemm(const P& p, char* lds) {
  GEMM_IDS
  bf16_t* MIX = (bf16_t*)(p.ws + O_MIX);
  const bf16_t* Y = (const bf16_t*)(p.ws + O_Y);
  const int nS = 16 * 9 * 2, nP = 8 * 16 * 3 * 2;
  const int sb = threadIdx.x >> 8;
  for (int it0 = blockIdx.x * 2; it0 < nS + nP; it0 += gridDim.x * 2) {
    const int it = it0 + sb;
    int seq, k1, tm, tn;
    if (it < nS) { seq = 8; tn = it & 1; int j = it >> 1; tm = j % 9; k1 = j / 9; }
    else { int j = it - nS; tn = j & 1; j >>= 1; tm = j % 3; j /= 3; k1 = j & 15; seq = j >> 4; }
    const int M = seq < 8 ? 257 : 1025, KP = seq < 8 ? 576 : 2112, L = 16 * M;
    const bf16_t* dm = (const bf16_t*)(p.ws + (seq < 8 ? O_DM257 : O_DM1025));
    f32x16 acc[2][2];
    gemm_tile(dm + (size_t)tm * 128 * KP, KP, Y + y_base(seq) + ((size_t)k1 * 256 + tn * 128) * KP, KP, KP, lds + sb * 36864, acc);
    const float scale = rsqrtf(64.f * (float)L);
#pragma unroll
    for (int mt = 0; mt < 2; ++mt)
#pragma unroll
      for (int nt = 0; nt < 2; ++nt)
#pragma unroll
        for (int i = 0; i < 16; ++i) {
          int k2 = tm * 128 + ACC_ROW(mt, i), ch = tn * 128 + ACC_COL(nt);
          if (k2 < M) {
            int pos = k1 + 16 * k2;
            MIX[(size_t)(seq_base(seq) + pos) * 1024 + 768 + ch] = f2bf(acc[mt][nt][i] * scale + p.b_b[ch]);
          }
        }
  }
}

DI size_t vtc_base(int seq) { return seq < 8 ? (size_t)seq * 128 * 4160 : (size_t)8 * 128 * 4160; }
DI void phase_prepC(const P& p, char* lds) {
  const int gtid = blockIdx.x * NTH + threadIdx.x, gsz = gridDim.x * NTH;
  const int lane = threadIdx.x & 63, gw = gtid >> 6, nw = gsz >> 6;
  bf16_t* PC = (bf16_t*)(p.ws + O_PC);
  bf16_t* VT = (bf16_t*)(p.ws + O_VTC);
  const bf16_t* PLOW = (const bf16_t*)(p.ws + O_PLOW);
  bf16_t* LR = (bf16_t*)(p.ws + O_LR);
  vt_transpose<128>(PC, 768, 640, VT, lds);
  for (int sr = gw; sr < T_; sr += nw) {
    int pos; int b = seq_of(sr, pos);
    const int L = seq_len(b), LP = L + 48;
    bf16_t* pr = PC + (size_t)sr * 768;
    float cs[8], sn[8];
#pragma unroll
    for (int j = 0; j < 8; ++j) sincosf((float)pos * exp2f(-(float)j * (18.931568569324174f / 8.f)), &sn[j], &cs[j]);
#pragma unroll
    for (int part = 0; part < 2; ++part) {
      const bool act = part == 0 || lane < 16;
      const int col = part * 512 + (act ? lane : 0) * 8;
      uint4 u = *(const uint4*)(pr + col);
      float e[8] = {lo2f(u.x), hi2f(u.x), lo2f(u.y), hi2f(u.y), lo2f(u.z), hi2f(u.z), lo2f(u.w), hi2f(u.w)};
      float o[8];
#pragma unroll
      for (int j = 0; j < 8; ++j) {
        float pa = __shfl_xor(e[j], 1);
        float rot = e[j] * cs[j] + pa * ((lane & 1) ? sn[j] : -sn[j]);
        o[j] = (lane & 7) < 2 ? rot : e[j];
        if (part == 0) o[j] *= 0.125f * LOG2E;
      }
      if (act) *(uint4*)(pr + col) = make_uint4(pack2(o[0], o[1]), pack2(o[2], o[3]), pack2(o[4], o[5]), pack2(o[6], o[7]));
    }
#pragma unroll
    for (int q = 0; q < 6; ++q) {
      int c = q * 64 + lane;
      float u = bf2f(PLOW[(size_t)sr * 384 + c]);
      float up = pos > 0 ? bf2f(PLOW[(size_t)(sr - 1) * 384 + c]) : 0.f;
      float un = pos < L - 1 ? bf2f(PLOW[(size_t)(sr + 1) * 384 + c]) : 0.f;
      float us = u + p.mu_prev[1536 + c] * (up - u) + p.mu_next[1536 + c] * (un - u);
      float v = c < 128 ? tanhf(us) : (c < 256 ? us : sigmoidf_(us));
      LR[(size_t)sr * 384 + c] = f2bf(v);
    }
  }
}

DI void phase_attnC(const P& p, char* lds) {
  const bf16_t* PC = (const bf16_t*)(p.ws + O_PC);
  const bf16_t* VT = (const bf16_t*)(p.ws + O_VTC);
  bf16_t* MIX = (bf16_t*)(p.ws + O_MIX);
  const int nS = 129 * 4, nP = 8 * 33 * 4;
  const int sb = threadIdx.x >> 8;
  for (int it = blockIdx.x; it < nS + nP; it += gridDim.x) {
    int seq, qt, hq;
    if (it < nS) { seq = 8; hq = (it & 3) * 2 + sb; qt = it >> 2; }
    else { int j = it - nS; hq = (j & 3) * 2 + sb; j >>= 2; qt = j % 33; seq = j / 33; }
    const int kv = hq >> 2;
    const int L = seq_len(seq), LP = L + 48;
    flash_item<1>(PC + hq * 64, 768, PC + 512 + kv * 64, 768, VT + vtc_base(seq) + (size_t)kv * 64 * LP, LP,
                  MIX + hq * 64, 1024, seq_base(seq), L - 16, qt, p.c_sink[hq] * LOG2E, lds + sb * 36864);
  }
}

DI void chunk_decode(int cg_, int& seq, int& c) {
  if (cg_ < 136) { seq = cg_ / 17; c = cg_ - seq * 17; } else { seq = 8; c = cg_ - 136; }
}
DI float shiftv(const bf16_t* PRKV, int sr, int pos, int L, int col, float mp, float mn) {
  float u = bf2f(PRKV[(size_t)sr * 1536 + col]);
  float up = pos > 0 ? bf2f(PRKV[(size_t)(sr - 1) * 1536 + col]) : 0.f;
  float un = pos < L - 1 ? bf2f(PRKV[(size_t)(sr + 1) * 1536 + col]) : 0.f;
  return u + mp * (up - u) + mn * (un - u);
}
enum { VW = 0, VA = 1, VB = 2, VK = 3, VV = 4, VR = 5 };
#define DPP_FMAC(acc, x, y, N) asm("v_fmac_f32_dpp %0, %1, %2 row_newbcast:%3 row_mask:0xf bank_mask:0xf" : "+v"(acc) : "v"(x), "v"(y), "n"(N))
#define DPP_MUL(sv_, x, N) asm("v_mul_f32_dpp %0, %1, %0 row_newbcast:%2 row_mask:0xf bank_mask:0xf" : "+v"(sv_) : "v"(x), "n"(N))
template <int N> DI void dpp_dot4(float& a0, float& a1, float& a2, float& a3, const float (&S)[64], const float4& x) {
  DPP_FMAC(a0, x.x, S[N], N); DPP_FMAC(a1, x.y, S[16 + N], N); DPP_FMAC(a2, x.z, S[32 + N], N); DPP_FMAC(a3, x.w, S[48 + N], N);
  if constexpr (N < 15) dpp_dot4<N + 1>(a0, a1, a2, a3, S, x);
}
template <int N, bool HASV, bool OUT> DI void dpp_upd4(float (&S)[64], const float4& xw, const float4& xb, const float4& xk, const float4& xr, float sa, float vi,
                                                       float& o0, float& o1, float& o2, float& o3) {
  DPP_MUL(S[N], xw.x, N); DPP_MUL(S[16 + N], xw.y, N); DPP_MUL(S[32 + N], xw.z, N); DPP_MUL(S[48 + N], xw.w, N);
  DPP_FMAC(S[N], xb.x, sa, N); DPP_FMAC(S[16 + N], xb.y, sa, N); DPP_FMAC(S[32 + N], xb.z, sa, N); DPP_FMAC(S[48 + N], xb.w, sa, N);
  if (HASV) { DPP_FMAC(S[N], xk.x, vi, N); DPP_FMAC(S[16 + N], xk.y, vi, N); DPP_FMAC(S[32 + N], xk.z, vi, N); DPP_FMAC(S[48 + N], xk.w, vi, N); }
  if (OUT) { DPP_FMAC(o0, xr.x, S[N], N); DPP_FMAC(o1, xr.y, S[16 + N], N); DPP_FMAC(o2, xr.z, S[32 + N], N); DPP_FMAC(o3, xr.w, S[48 + N], N); }
  if constexpr (N < 15) dpp_upd4<N + 1, HASV, OUT>(S, xw, xb, xk, xr, sa, vi, o0, o1, o2, o3);
}
template <int NST, bool HASV, bool OUT, class F>
DI void scan_steps(float (&S)[64], const float* sv, int ns, int lane, F&& emit) {
  const int l15 = lane & 15;
  for (int s = 0; s < ns; ++s) {
    const float4 xw = *(const float4*)(sv + VW * NST * 64 + s * 64 + l15 * 4);
    const float4 xa = *(const float4*)(sv + VA * NST * 64 + s * 64 + l15 * 4);
    const float4 xb = *(const float4*)(sv + VB * NST * 64 + s * 64 + l15 * 4);
    float4 xk = xb, xr = xb;
    if (HASV) xk = *(const float4*)(sv + VK * NST * 64 + s * 64 + l15 * 4);
    if (OUT) xr = *(const float4*)(sv + VR * NST * 64 + s * 64 + l15 * 4);
    const float vi = HASV ? sv[VV * NST * 64 + s * 64 + lane] : 0.f;
    float sa0 = 0.f, sa1 = 0.f, sa2 = 0.f, sa3 = 0.f;
    dpp_dot4<0>(sa0, sa1, sa2, sa3, S, xa);
    const float sa = (sa0 + sa1) + (sa2 + sa3);
    float o0 = 0.f, o1 = 0.f, o2 = 0.f, o3 = 0.f;
    dpp_upd4<0, HASV, OUT>(S, xw, xb, xk, xr, sa, vi, o0, o1, o2, o3);
    if (OUT) emit(s, (o0 + o1) + (o2 + o3));
  }
}
DI int vperm(int j) { return (j & 15) * 4 + (j >> 4); }

template <int NST, bool P3>
DI void scan_prologue8(const P& p, int sbase, int L, int hd, int dir, int pos0, int nsteps, int sb0, float* sv) {
  const int lane = threadIdx.x & 63, l31 = lane & 31, h = lane >> 5;
  const bf16_t* PRKV = (const bf16_t*)(p.ws + O_PRKV);
  const bf16_t* LR = (const bf16_t*)(p.ws + O_LR);
  const bf16_t* WUPT = (const bf16_t*)(p.ws + O_WUPT) + (size_t)(dir * 512 + hd * 64) * 64;
  const bf16_t* AUPT = (const bf16_t*)(p.ws + O_AUPT) + (size_t)(dir * 512 + hd * 64) * 64;
  float* bonus = (float*)(p.ws + O_BONUS);
  const int c = hd * 64 + lane;
  float rk_[10], rv_[10], rr_[10];
  {
    const int p0w = dir ? pos0 - sb0 : pos0 + sb0;
#pragma unroll
    for (int i = 0; i < 10; ++i) {
      const int pi = dir ? p0w - (i - 1) : p0w + (i - 1);
      const bool inb = pi >= 0 && pi < L;
      const int pc = pi < 0 ? 0 : (pi > L - 1 ? L - 1 : pi);
      const bf16_t* rowp = PRKV + (size_t)(sbase + pc) * 1536 + c;
      const float kx = bf2f(rowp[512]), vx = bf2f(rowp[1024]);
      rk_[i] = inb ? kx : 0.f; rv_[i] = inb ? vx : 0.f;
      if (P3) { const float rx = bf2f(rowp[0]); rr_[i] = inb ? rx : 0.f; } else rr_[i] = 0.f;
    }
  }
  {
    int sl = sb0 + (l31 & 7); if (sl > nsteps - 1) sl = nsteps - 1;
    const int pos = dir ? pos0 - sl : pos0 + sl;
    const bf16_t* lrp = LR + (size_t)(sbase + pos) * 384 + dir * 64 + 8 * h;
#pragma unroll 1
    for (int mat = 0; mat < 2; ++mat) {
      const bf16_t* Wm = mat ? AUPT : WUPT;
      const float* bias = mat ? p.d_a0 : p.d_w0;
      f32x16 ac[2];
#pragma unroll
      for (int nt = 0; nt < 2; ++nt)
#pragma unroll
        for (int i = 0; i < 16; ++i) ac[nt][i] = 0.f;
#pragma unroll
      for (int ks = 0; ks < 4; ++ks) {
        const bf16x8 fa = *(const bf16x8*)(lrp + mat * 128 + 16 * ks);
#pragma unroll
        for (int nt = 0; nt < 2; ++nt) {
          const bf16x8 bw = *(const bf16x8*)(Wm + (size_t)(32 * nt + l31) * 64 + 16 * ks + 8 * h);
          ac[nt] = MFMA32(fa, bw, ac[nt]);
        }
      }
      float* dstv = sv + (mat ? VB : VW) * NST * 64;
#pragma unroll
      for (int nt = 0; nt < 2; ++nt) {
        const int j = 32 * nt + l31;
        const float b0 = bias[dir * 512 + hd * 64 + j];
#pragma unroll
        for (int i = 0; i < 4; ++i) {
          const int st = sb0 + i + 4 * h;
          const float sg = 1.f / (1.f + __expf(-(b0 + ac[nt][i])));
          dstv[st * 64 + vperm(j)] = mat ? sg : __expf(-0.6065306597126334f * sg);
        }
      }
    }
  }
  const float mpr = p.mu_prev[c], mnr = p.mu_next[c], mpk = p.mu_prev[512 + c], mnk = p.mu_next[512 + c], mpv = p.mu_prev[1024 + c], mnv = p.mu_next[1024 + c];
  const float kkc = p.d_k_k[c], kac = p.d_k_a[c], rkc = p.d_r_k[c];
  const int pj = vperm(lane);
#pragma unroll
  for (int q = 0; q < 8; ++q) {
    const int s = sb0 + q;
    const float kb = rk_[q], kc = rk_[q + 1], ka = rk_[q + 2];
    const float vb = rv_[q], vc = rv_[q + 1], va = rv_[q + 2];
    const float k = kc + mpk * ((dir ? ka : kb) - kc) + mnk * ((dir ? kb : ka) - kc);
    const float v = vc + mpv * ((dir ? va : vb) - vc) + mnv * ((dir ? vb : va) - vc);
    const float a = sv[VB * NST * 64 + s * 64 + pj];
    float kk = k * kkc;
    const float n2 = wave_sum(kk * kk);
    kk *= rsqrtf(fmaxf(n2, 1e-24f));
    const float kd = k * (1.f + (a - 1.f) * kac);
    sv[VA * NST * 64 + s * 64 + pj] = -kk;
    sv[VB * NST * 64 + s * 64 + pj] = kk * a;
    sv[VK * NST * 64 + s * 64 + pj] = kd;
    sv[VV * NST * 64 + s * 64 + lane] = v;
    if (P3) {
      const float rb = rr_[q], rc = rr_[q + 1], ra = rr_[q + 2];
      const float r = rc + mpr * ((dir ? ra : rb) - rc) + mnr * ((dir ? rb : ra) - rc);
      sv[VR * NST * 64 + s * 64 + pj] = r;
      const float bn = wave_sum(r * kd * rkc);
      if (s < nsteps && lane == 0) {
        const int pos = dir ? pos0 - s : pos0 + s;
        bonus[((size_t)(sbase + pos) * 8 + hd) * 2 + dir] = bn;
      }
    }
  }
}

template <bool HALF> DI void scan1_body(const P& p, char* lds) {
  float* PQ = (float*)(p.ws + O_PQ);
  const int lane = threadIdx.x & 63, wave = __builtin_amdgcn_readfirstlane(threadIdx.x >> 6), slot = wave >> 1;
  constexpr int half = HALF ? 1 : 0;
  float* sv = (float*)lds + slot * (6 * 16 * 64);
  for (int g = blockIdx.x; g < 804; g += gridDim.x) {
    const int it = g * 4 + slot;
    const int dir = it & 1, hd = (it >> 1) & 7, cgi = it >> 4;
    int seq, c; chunk_decode(cgi, seq, c);
    const int L = seq_len(seq), sbase = seq_base(seq);
    const int start = c * 256, end = min(L, start + 256), n = end - start;
    float S[64];
#pragma unroll
    for (int j = 0; j < 64; ++j) S[j] = (half == 0 && j == lane) ? 1.f : 0.f;
    for (int s0 = 0; s0 < n; s0 += 16) {
      const int ns = min(16, n - s0);
      const int pos0 = dir ? end - 1 - s0 : start + s0;
      __syncthreads();
      scan_prologue8<16, false>(p, sbase, L, hd, dir, pos0, ns, half * 8, sv);
      __syncthreads();
      scan_steps<16, HALF, false>(S, sv, ns, lane, [](int, float) {});
    }
    float* dst = PQ + (size_t)it * 8192 + (size_t)(half * 64 + lane) * 64;
#pragma unroll
    for (int q = 0; q < 16; ++q) *(float4*)(dst + q * 4) = make_float4(S[q * 4], S[q * 4 + 1], S[q * 4 + 2], S[q * 4 + 3]);
  }
}

DI void phase_scan1(const P& p, char* lds) {
  if (__builtin_amdgcn_readfirstlane(threadIdx.x >> 6) & 1) scan1_body<true>(p, lds); else scan1_body<false>(p, lds);
}

DI void phase_scan2(const P& p, char* lds) {
  float* Ss = (float*)lds;
  float* Ps = Ss + 64 * 65;
  float* PQ = (float*)(p.ws + O_PQ);
  const int tid = threadIdx.x, i = tid >> 3, j0 = (tid & 7) * 8;
  for (int it = blockIdx.x; it < 144; it += gridDim.x) {
    const int dir = it & 1, hd = (it >> 1) & 7, seq = it >> 4;
    const int nch = seq < 8 ? 17 : 65, cg0 = seq < 8 ? seq * 17 : 136;
    float S[8];
#pragma unroll
    for (int jj = 0; jj < 8; ++jj) S[jj] = 0.f;
    for (int cc = 0; cc < nch; ++cc) {
      const int c = dir ? nch - 1 - cc : cc;
      float* Pg = PQ + (size_t)(((cg0 + c) * 8 + hd) * 2 + dir) * 8192;
      float* Qg = Pg + 4096;
      __syncthreads();
#pragma unroll
      for (int jj = 0; jj < 8; ++jj) Ss[i * 65 + j0 + jj] = S[jj];
#pragma unroll
      for (int r4 = 0; r4 < 2; ++r4) *(float4*)(Ps + (r4 * 512 + tid) * 4) = *(const float4*)(Pg + (r4 * 512 + tid) * 4);
      float acc[8];
#pragma unroll
      for (int r4 = 0; r4 < 2; ++r4) {
        float4 qv = *(const float4*)(Qg + i * 64 + j0 + r4 * 4);
        acc[r4 * 4] = qv.x; acc[r4 * 4 + 1] = qv.y; acc[r4 * 4 + 2] = qv.z; acc[r4 * 4 + 3] = qv.w;
      }
#pragma unroll
      for (int r4 = 0; r4 < 2; ++r4) *(float4*)(Qg + i * 64 + j0 + r4 * 4) = make_float4(S[r4 * 4], S[r4 * 4 + 1], S[r4 * 4 + 2], S[r4 * 4 + 3]);
      __syncthreads();
      for (int m = 0; m < 64; ++m) {
        const float sm = Ss[i * 65 + m];
        const float* pr = Ps + m * 64 + j0;
#pragma unroll
        for (int jj = 0; jj < 8; ++jj) acc[jj] += sm * pr[jj];
      }
#pragma unroll
      for (int jj = 0; jj < 8; ++jj) S[jj] = acc[jj];
    }
  }
}

DI void phase_scan3(const P& p, char* lds) {
  const float* PQ = (const float*)(p.ws + O_PQ);
  bf16_t* MIX = (bf16_t*)(p.ws + O_MIX);
  bf16_t* OB = (bf16_t*)(p.ws + O_OB);
  const int lane = threadIdx.x & 63, wave = __builtin_amdgcn_readfirstlane(threadIdx.x >> 6);
  float* sv = (float*)lds + wave * (6 * 8 * 64);
  for (int g = blockIdx.x; g < 402; g += gridDim.x) {
    const int it = g * 8 + wave;
    const int dir = it & 1, hd = (it >> 1) & 7, cgi = it >> 4;
    int seq, c; chunk_decode(cgi, seq, c);
    const int L = seq_len(seq), sbase = seq_base(seq);
    const int start = c * 256, end = min(L, start + 256), n = end - start;
    float S[64];
    {
      const float* src = PQ + (size_t)it * 8192 + 4096 + lane * 64;
#pragma unroll
      for (int q = 0; q < 16; ++q) { float4 t = *(const float4*)(src + q * 4); S[q * 4] = t.x; S[q * 4 + 1] = t.y; S[q * 4 + 2] = t.z; S[q * 4 + 3] = t.w; }
    }
    for (int s0 = 0; s0 < n; s0 += 8) {
      const int ns = min(8, n - s0);
      const int pos0 = dir ? end - 1 - s0 : start + s0;
      scan_prologue8<8, true>(p, sbase, L, hd, dir, pos0, ns, 0, sv);
      scan_steps<8, true, true>(S, sv, ns, lane, [&](int st, float o) {
        const int pos = dir ? pos0 - st : pos0 + st;
        const size_t sr = (size_t)(sbase + pos);
        if (dir == 0) MIX[sr * 1024 + 512 + hd * 64 + lane] = f2bf(o);
        else OB[sr * 512 + hd * 64 + lane] = f2bf(o);
      });
    }
  }
}

DI void phase_rwkv_final(const P& p) {
  const int lane = threadIdx.x & 63, gw = (blockIdx.x * NTH + threadIdx.x) >> 6, nw = (gridDim.x * NTH) >> 6;
  bf16_t* MIX = (bf16_t*)(p.ws + O_MIX);
  const bf16_t* OB = (const bf16_t*)(p.ws + O_OB);
  const bf16_t* G = (const bf16_t*)(p.ws + O_G);
  const bf16_t* PRKV = (const bf16_t*)(p.ws + O_PRKV);
  const float* bonus = (const float*)(p.ws + O_BONUS);
  const int hd = lane >> 3, c0 = lane * 8;
  for (int sr = gw; sr < T_; sr += nw) {
    int pos; int b = seq_of(sr, pos);
    const int L = seq_len(b);
    uint4 uf = *(const uint4*)(MIX + (size_t)sr * 1024 + 512 + c0);
    uint4 ub = *(const uint4*)(OB + (size_t)sr * 512 + c0);
    uint4 ug = *(const uint4*)(G + (size_t)sr * 512 + c0);
    unsigned f_[4] = {uf.x, uf.y, uf.z, uf.w}, b_[4] = {ub.x, ub.y, ub.z, ub.w}, g_[4] = {ug.x, ug.y, ug.z, ug.w};
    float o[8], gg[8];
    float sm = 0.f;
#pragma unroll
    for (int j = 0; j < 4; ++j) {
      o[2 * j] = lo2f(f_[j]) + lo2f(b_[j]); o[2 * j + 1] = hi2f(f_[j]) + hi2f(b_[j]);
      gg[2 * j] = lo2f(g_[j]); gg[2 * j + 1] = hi2f(g_[j]);
      sm += o[2 * j] + o[2 * j + 1];
    }
    sm += __shfl_xor(sm, 1); sm += __shfl_xor(sm, 2); sm += __shfl_xor(sm, 4);
    const float mean = sm * (1.f / 64.f);
    float vs = 0.f;
#pragma unroll
    for (int j = 0; j < 8; ++j) { float dlt = o[j] - mean; vs += dlt * dlt; }
    vs += __shfl_xor(vs, 1); vs += __shfl_xor(vs, 2); vs += __shfl_xor(vs, 4);
    const float rstd = rsqrtf(vs * (1.f / 64.f) + 64e-5f);
    const float bsum = bonus[((size_t)sr * 8 + hd) * 2] + bonus[((size_t)sr * 8 + hd) * 2 + 1];
    float y[8];
#pragma unroll
    for (int j = 0; j < 8; ++j) {
      int c = c0 + j;
      float vsh = shiftv(PRKV, sr, pos, L, 1024 + c, p.mu_prev[1024 + c], p.mu_next[1024 + c]);
      y[j] = ((o[j] - mean) * rstd * p.d_ln_g[c] + p.d_ln_b[c] + bsum * vsh) * gg[j];
    }
    *(uint4*)(MIX + (size_t)sr * 1024 + 512 + c0) = make_uint4(pack2(y[0], y[1]), pack2(y[2], y[3]), pack2(y[4], y[5]), pack2(y[6], y[7]));
  }
}

#define XB_TMO      128
#define XB_XCNT(j)  (256  + 64 * (j))
#define XB_XSUB(j)  (1280 + 64 * (j))
#define XB_XGEN(j)  (2304 + 64 * (j))
#define XB_TOP      3328
#define XB_TOPGEN   3392
#define XCD_BAR_WORDS 3456
#define XB_SPIN_CAP (1u << 18)
#define LAS __attribute__((address_space(3)))

__device__ __forceinline__ unsigned xb_ld(unsigned* p)              { return __hip_atomic_load(p, __ATOMIC_RELAXED, __HIP_MEMORY_SCOPE_AGENT); }
__device__ __forceinline__ unsigned xb_add(unsigned* p, unsigned v) { return __hip_atomic_fetch_add(p, v, __ATOMIC_RELAXED, __HIP_MEMORY_SCOPE_AGENT); }
__device__ __forceinline__ unsigned xb_xcc_id() { return (unsigned)__builtin_amdgcn_s_getreg((3 << 11) | 20) & 0xFu; }
#define XB_SPIN(cond, bar) do { unsigned _sp = 0; while (cond) { __builtin_amdgcn_s_sleep(1); \
    if ((++_sp & 255u) == 0u) { if (xb_ld(&(bar)[XB_TMO])) break; if (_sp > XB_SPIN_CAP) { atomicAdd(&(bar)[XB_TMO], 1u); break; } } } } while (0)

struct XcdBarrier {
    unsigned* bar; unsigned x;
    volatile LAS unsigned* st;
};

__device__ __forceinline__ XcdBarrier xcd_barrier_post(unsigned* bar, volatile LAS unsigned* st) {
    XcdBarrier b; b.bar = bar; b.x = xb_xcc_id(); b.st = st;
    if (threadIdx.x == 0) (void)xb_add(&bar[XB_XCNT(b.x)], 1u);
    return b;
}
__device__ __forceinline__ void xcd_barrier_complete(unsigned* bar, unsigned x, unsigned& nloc, unsigned& nx) {
    const unsigned G = gridDim.x * gridDim.y * gridDim.z;
    unsigned sum, cnt, mine, sp = 0u;
    for (;;) {
        sum = 0u; cnt = 0u; mine = 0u;
#pragma unroll
        for (unsigned j = 0; j < 16; ++j) { const unsigned c = xb_ld(&bar[XB_XCNT(j)]); sum += c; cnt += (c > 0u) ? 1u : 0u; mine = (j == x) ? c : mine; }
        if (sum == G) break;
        __builtin_amdgcn_s_sleep(1);
        if ((++sp & 255u) == 0u) { if (xb_ld(&bar[XB_TMO])) break; if (sp > XB_SPIN_CAP) { atomicAdd(&bar[XB_TMO], 1u); break; } }
    }
    nloc = mine > 0u ? mine : 1u; nx = cnt > 0u ? cnt : 1u;
}

__device__ __forceinline__ void xcd_barrier(const XcdBarrier& b) {
    asm volatile("s_waitcnt vmcnt(0)" ::: "memory");
    __syncthreads();
    if (threadIdx.x == 0) {
        unsigned* bar = b.bar;
        __builtin_amdgcn_s_waitcnt(0);
        unsigned nloc = b.st[0], nx = b.st[1];
        if (nloc == 0u) { xcd_barrier_complete(bar, b.x, nloc, nx); b.st[0] = nloc; b.st[1] = nx; }
        const unsigned old = xb_add(&bar[XB_XSUB(b.x)], 1u);
        const unsigned gen = old / nloc;
        if (old + 1u == (gen + 1u) * nloc) {
            __builtin_amdgcn_fence(__ATOMIC_RELEASE, "agent");
            asm volatile("s_waitcnt vmcnt(0)" ::: "memory");
            const unsigned og = xb_add(&bar[XB_TOP], 1u);
            const unsigned tg = og / nx;
            if (og + 1u == (tg + 1u) * nx) xb_add(&bar[XB_TOPGEN], 1u);
            else XB_SPIN(xb_ld(&bar[XB_TOPGEN]) == tg, bar);
            __builtin_amdgcn_fence(__ATOMIC_ACQUIRE, "agent");
            xb_add(&bar[XB_XGEN(b.x)], 1u);
            asm volatile("s_waitcnt vmcnt(0)" ::: "memory");
        } else {
            XB_SPIN(xb_ld(&bar[XB_XGEN(b.x)]) == gen, bar);
            __builtin_amdgcn_fence(__ATOMIC_ACQUIRE, "agent");
            asm volatile("s_waitcnt vmcnt(0)" ::: "memory");
        }
    }
    __syncthreads();
}

constexpr int NPHASE = 23;
__global__ void __launch_bounds__(NTH, 2) mega(P p) {
  extern __shared__ __attribute__((aligned(16))) unsigned char shm[];
  char* lds = (char*)shm;
  char* ws = p.ws;
  if (threadIdx.x == 0) *(uint4*)(shm + 131072) = make_uint4(0u, 0u, 0u, 0u);
  __syncthreads();
  const XcdBarrier xb = xcd_barrier_post((unsigned*)(ws + O_BAR), (volatile LAS unsigned*)(shm + 131072));
#ifndef DUP_MASK
#define DUP_MASK 0u
#endif
#define RUN(k, call) if (p.ph0 <= k && k < p.ph1) { call; if (k + 1 < p.ph1) { if (k == 0) cg::this_grid().sync(); else xcd_barrier(xb); } }
  RUN(0, phase_prep(p))
  RUN(1, phase_gemm_big((const bf16_t*)(ws + O_HN), (const bf16_t*)(ws + O_WIN0), 1536, 1024, (bf16_t*)(ws + O_PROJ0), 1536, 0, ws, shm))
  RUN(2, phase_prepA(p, lds))
  RUN(3, phase_attnA(p, lds))
  RUN(4, phase_fnet_gemm(p, lds))
  RUN(5, phase_gemm_big((const bf16_t*)(ws + O_MIX), (const bf16_t*)(ws + O_WOUT0), 1024, 1024, (bf16_t*)(ws + O_HN), 1024, 0, ws, shm))
  RUN(6, phase_resnorm(p, p.post_mix_g, p.pre_ffn_g))
  RUN(7, phase_gemm_gateup((const bf16_t*)(ws + O_HN), (const bf16_t*)(ws + O_WGU0), (bf16_t*)(ws + O_ACT), shm))
  RUN(8, phase_gemm_big((const bf16_t*)(ws + O_ACT), (const bf16_t*)(ws + O_WD0), 1024, DFF, (bf16_t*)(ws + O_HN), 1024, 0, ws, shm))
  RUN(9, phase_resnorm(p, p.post_ffn_g, p.pre_mix_g + 1024))
  RUN(10, phase_gemm_big((const bf16_t*)(ws + O_HN), (const bf16_t*)(ws + O_WIN1), 2816, 1024, nullptr, 0, 1, ws, shm))
  RUN(11, phase_prepC(p, lds))
  RUN(12, phase_attnC(p, lds))
  RUN(13, phase_scan1(p, lds))
  RUN(14, phase_scan2(p, lds))
  RUN(15, phase_scan3(p, lds))
  RUN(16, phase_gemm_small((const bf16_t*)(ws + O_LR) + 256, 384, (const bf16_t*)(ws + O_GUP), 512, 128, (bf16_t*)(ws + O_G), 512, lds))
  RUN(17, phase_rwkv_final(p))
  RUN(18, phase_gemm_big((const bf16_t*)(ws + O_MIX), (const bf16_t*)(ws + O_WOUT1), 1024, 1024, (bf16_t*)(ws + O_HN), 1024, 0, ws, shm))
  RUN(19, phase_resnorm(p, p.post_mix_g + 1024, p.pre_ffn_g + 1024))
  RUN(20, phase_gemm_gateup((const bf16_t*)(ws + O_HN), (const bf16_t*)(ws + O_WGU1), (bf16_t*)(ws + O_ACT), shm))
  RUN(21, phase_gemm_big((const bf16_t*)(ws + O_ACT), (const bf16_t*)(ws + O_WD1), 1024, DFF, (bf16_t*)(ws + O_HN), 1024, 0, ws, shm))
  RUN(22, phase_resnorm(p, p.post_ffn_g + 1024, nullptr))
#undef RUN
}

extern "C" void kernel_launch(void* const* d_in, const int* in_sizes, int n_in, void* d_out, int out_size, void* d_ws, size_t ws_size,
                              hipStream_t stream) {
  static int grid_blocks = 0;
  if (!grid_blocks) {
    int dev = 0, cus = 0, per_cu = 0;
    (void)hipGetDevice(&dev);
    (void)hipDeviceGetAttribute(&cus, hipDeviceAttributeMultiprocessorCount, dev);
    if (hipFuncSetAttribute((const void*)mega, hipFuncAttributeMaxDynamicSharedMemorySize, LDS_BYTES) != hipSuccess) fprintf(stderr, "hipFuncSetAttribute failed\n");
    if (hipOccupancyMaxActiveBlocksPerMultiprocessor(&per_cu, (const void*)mega, NTH, LDS_BYTES) != hipSuccess || per_cu < 1) {
      fprintf(stderr, "occupancy query says %d\n", per_cu);
      (void)hipGetLastError();
    }
    grid_blocks = cus;
  }
  if (ws_size < O_BAR + 3456 * 4) { fprintf(stderr, "workspace too small\n"); return; }
  if (hipMemsetAsync((char*)d_ws + O_BAR, 0, 3456 * 4, stream) != hipSuccess) { fprintf(stderr, "memset failed\n"); return; }
  P p{};
  const float** f = (const float**)&p;
  for (int i = 0; i < 32; ++i) f[i] = (const float*)d_in[i];
  p.out = (float*)d_out;
  p.ws = (char*)d_ws;
#if FUSED
  p.ph0 = 0; p.ph1 = NPHASE;
  void* args[] = {&p};
  hipError_t e = hipLaunchCooperativeKernel((void*)mega, dim3(grid_blocks), dim3(NTH), args, LDS_BYTES, stream);
  if (e != hipSuccess) fprintf(stderr, "cooperative launch failed: %s (grid %d)\n", hipGetErrorString(e), grid_blocks);
#else
  for (int ph = 0; ph < NPHASE; ++ph) {
    p.ph0 = ph; p.ph1 = ph + 1;
    hipLaunchKernelGGL(mega, dim3(grid_blocks), dim3(NTH), LDS_BYTES, stream, p);
  }
#endif
}
```

```cpp
#include <hip/hip_runtime.h>
#include <hip/hip_cooperative_groups.h>
#include <cstdio>
namespace cg = cooperative_groups;

#ifndef FUSED
#define FUSED 1
#endif

typedef unsigned short bf16_t;
using bf16x8 = __attribute__((ext_vector_type(8))) short;
using s16x4 = __attribute__((ext_vector_type(4))) short;
using f32x16 = __attribute__((ext_vector_type(16))) float;
using u32x4 = __attribute__((ext_vector_type(4))) unsigned;
#define DI __device__ __forceinline__
#define MFMA32(a, b, c) __builtin_amdgcn_mfma_f32_32x32x16_bf16((a), (b), (c), 0, 0, 0)
constexpr int NTH = 512;
constexpr int LDS_BYTES = 131072 + 16;

constexpr int DM_ = 1024;
constexpr int T_ = 49296;
constexpr int TP_ = 49408;
constexpr int NT_ = TP_ / 128;
constexpr int DFF = 2816;
constexpr float EPS = 1e-6f;
constexpr float LOG2E = 1.4426950408889634f;

constexpr size_t SZ_ROW1024 = (size_t)TP_ * 1024 * 2;
constexpr size_t O_WIN0 = 0;
constexpr size_t O_WOUT0 = O_WIN0 + (size_t)1536 * 1024 * 2;
constexpr size_t O_WGU0 = O_WOUT0 + (size_t)1024 * 1024 * 2;
constexpr size_t O_WD0 = O_WGU0 + (size_t)5632 * 1024 * 2;
constexpr size_t O_DM257 = O_WD0 + (size_t)1024 * 2816 * 2;
constexpr size_t O_DM1025 = O_DM257 + (size_t)384 * 576 * 2;
constexpr size_t O_WIN1 = O_DM1025 + (size_t)1152 * 2112 * 2;
constexpr size_t O_WOUT1 = O_WIN1 + (size_t)2816 * 1024 * 2;
constexpr size_t O_WGU1 = O_WOUT1 + (size_t)1024 * 1024 * 2;
constexpr size_t O_WD1 = O_WGU1 + (size_t)5632 * 1024 * 2;
constexpr size_t O_GUP = O_WD1 + (size_t)1024 * 2816 * 2;
constexpr size_t O_RA = O_GUP + (size_t)512 * 128 * 2;
constexpr size_t O_RB = O_RA + SZ_ROW1024;
constexpr size_t O_RC = O_RB + (size_t)TP_ * 2816 * 2;
constexpr size_t O_META = O_RC + SZ_ROW1024;
constexpr size_t O_WC = O_META + (size_t)144 * 1024 * 4;
constexpr size_t O_WUPT = O_WC + (size_t)4 * 64 * 128 * 4;
constexpr size_t O_AUPT = O_WUPT + (size_t)2 * 512 * 64 * 2;
constexpr size_t O_END = O_AUPT + (size_t)2 * 512 * 64 * 2;
constexpr size_t O_HN = O_RA;
constexpr size_t O_VTA = O_RA;
constexpr size_t O_LR = O_RA;
constexpr size_t O_BONUS = O_RA + (size_t)TP_ * 384 * 2;
constexpr size_t O_VTC = O_BONUS + (size_t)T_ * 16 * 4;
constexpr size_t O_OB = O_RA + (size_t)TP_ * 512 * 2;
constexpr size_t O_PROJ0 = O_RB;
constexpr size_t O_ZB = O_PROJ0 + (size_t)TP_ * 1536 * 2;
constexpr size_t O_Y = O_ZB + (size_t)TP_ * 512 * 2;
constexpr size_t O_ACT = O_RB;
constexpr size_t O_PRKV = O_RB;
constexpr size_t O_PC = O_PRKV + (size_t)TP_ * 1536 * 2;
constexpr size_t O_PLOW = O_PC + (size_t)TP_ * 768 * 2;
constexpr size_t O_PQ = O_PC;
constexpr size_t O_G = O_PC;
constexpr size_t O_MIX = O_RC;
static_assert(O_VTC + (size_t)49728 * 128 * 2 <= O_RB, "vtc");
static_assert(O_Y + (size_t)(8 * 16 * 256 * 576 + 16 * 256 * 2112) * 2 <= O_RC, "y");
static_assert(O_PQ + (size_t)3216 * 32768 <= O_RC, "pq");
constexpr size_t O_BAR = (O_END + 255) / 256 * 256;
constexpr size_t O_CNT = O_BAR + 3456 * 4;
constexpr size_t CTL_BYTES = 3456 * 4 + 4 * 256;
static_assert(O_BAR + CTL_BYTES <= (size_t)536870912, "ws");

struct P {
  const float *x_prompt, *x_sample, *meta, *pre_mix_g, *post_mix_g, *pre_ffn_g, *post_ffn_g;
  const float *even_w_in, *even_w_out, *a_q_gain, *a_k_gain, *b_norm_g, *b_w, *b_b;
  const float *odd_w_in, *odd_w_out, *c_sink, *mu_prev, *mu_next, *d_w0, *d_w_up, *d_a0, *d_a_up, *d_g_up;
  const float *d_k_k, *d_k_a, *d_r_k, *d_ln_g, *d_ln_b, *ffn_gate, *ffn_up, *ffn_down;
  float* out;
  char* ws;
  int ph0, ph1;
};

typedef float f32x2 __attribute__((ext_vector_type(2)));
typedef __bf16 bf16x2_t __attribute__((ext_vector_type(2)));
DI bf16_t f2bf(float x) { return __builtin_bit_cast(bf16_t, (__bf16)x); }
DI float bf2f(bf16_t b) { return __uint_as_float(((unsigned)b) << 16); }
DI unsigned pack2(float a, float b) { f32x2 v = {a, b}; return __builtin_bit_cast(unsigned, __builtin_convertvector(v, bf16x2_t)); }
DI float lo2f(unsigned u) { return __uint_as_float(u << 16); }
DI float hi2f(unsigned u) { return __uint_as_float(u & 0xffff0000u); }
DI float wave_sum(float v) {
  for (int o = 32; o > 0; o >>= 1) v += __shfl_xor(v, o);
  return v;
}
DI int seq_of(int sr, int& pos) {
  if (sr < 32896) { int b = sr / 4112; pos = sr - b * 4112; return b; }
  pos = sr - 32896; return 8;
}
DI int seq_len(int b) { return b < 8 ? 4112 : 16400; }
DI int seq_base(int b) { return b < 8 ? b * 4112 : 32896; }
DI float* hrow(const P& p, int sr) {
  int pos; int b = seq_of(sr, pos);
  if (pos < 16) return (float*)(p.ws + O_META) + (size_t)(b * 16 + pos) * 1024;
  return p.out + ((size_t)(b < 8 ? b * 4096 : 32768) + (pos - 16)) * 1024;
}
DI float sigmoidf_(float x) { return 1.f / (1.f + expf(-x)); }

DI void transpose_w(const float* W, int K, int ldw, int N, bf16_t* Wt, int mode, const float* W2, int gtid, int gsz) {
  int nk8 = K / 8;
  long total = (long)N * nk8;
  for (long it = gtid; it < total; it += gsz) {
    int n = (int)(it % N), k8 = (int)(it / N);
    const float* src = W;
    int c = n;
    if (mode == 1) {
      int blk = n >> 8, w = n & 255;
      c = blk * 128 + (w & 127);
      if (w >= 128) src = W2;
    }
    unsigned r[4];
#pragma unroll
    for (int j = 0; j < 4; ++j) {
      float a = src[(size_t)(k8 * 8 + 2 * j) * ldw + c];
      float b = src[(size_t)(k8 * 8 + 2 * j + 1) * ldw + c];
      r[j] = pack2(a, b);
    }
    *(uint4*)(Wt + (size_t)n * K + k8 * 8) = make_uint4(r[0], r[1], r[2], r[3]);
  }
}

DI void phase_prep(const P& p) {
  const int gtid = blockIdx.x * NTH + threadIdx.x, gsz = gridDim.x * NTH;
  char* ws = p.ws;
  transpose_w(p.even_w_in, 1024, 1536, 1536, (bf16_t*)(ws + O_WIN0), 0, nullptr, gtid, gsz);
  transpose_w(p.even_w_out, 1024, 1024, 1024, (bf16_t*)(ws + O_WOUT0), 0, nullptr, gtid, gsz);
  transpose_w(p.odd_w_in, 1024, 2688, 2688, (bf16_t*)(ws + O_WIN1), 0, nullptr, gtid, gsz);
  transpose_w(p.odd_w_out, 1024, 1024, 1024, (bf16_t*)(ws + O_WOUT1), 0, nullptr, gtid, gsz);
  transpose_w(p.ffn_gate, 1024, DFF, 5632, (bf16_t*)(ws + O_WGU0), 1, p.ffn_up, gtid, gsz);
  transpose_w(p.ffn_gate + (size_t)1024 * DFF, 1024, DFF, 5632, (bf16_t*)(ws + O_WGU1), 1, p.ffn_up + (size_t)1024 * DFF, gtid, gsz);
  transpose_w(p.ffn_down, DFF, 1024, 1024, (bf16_t*)(ws + O_WD0), 0, nullptr, gtid, gsz);
  transpose_w(p.ffn_down + (size_t)DFF * 1024, DFF, 1024, 1024, (bf16_t*)(ws + O_WD1), 0, nullptr, gtid, gsz);
  transpose_w(p.d_g_up, 128, 512, 512, (bf16_t*)(ws + O_GUP), 0, nullptr, gtid, gsz);
  for (int d = 0; d < 2; ++d) {
    transpose_w(p.d_w_up + (size_t)d * 64 * 512, 64, 512, 512, (bf16_t*)(ws + O_WUPT) + (size_t)d * 512 * 64, 0, nullptr, gtid, gsz);
    transpose_w(p.d_a_up + (size_t)d * 64 * 512, 64, 512, 512, (bf16_t*)(ws + O_AUPT) + (size_t)d * 512 * 64, 0, nullptr, gtid, gsz);
  }
  for (int it = gtid; it < 128 * 1024 / 8; it += gsz) *(uint4*)((bf16_t*)(ws + O_WIN1) + (size_t)2688 * 1024 + (size_t)it * 8) = make_uint4(0, 0, 0, 0);
  for (int which = 0; which < 2; ++which) {
    const int M = which ? 1025 : 257, MP = which ? 1152 : 384, KP = which ? 2112 : 576;
    bf16_t* dm = (bf16_t*)(ws + (which ? O_DM1025 : O_DM257));
    for (int it = gtid; it < MP * KP; it += gsz) {
      int r = it / KP, c = it - r * KP;
      float v = 0.f;
      if (r < M && c < 2 * M) {
        int n2 = c < M ? c : c - M;
        int m = (r * n2) % M;
        float s, co;
        sincospif(2.0f * (float)m / (float)M, &s, &co);
        v = c < M ? co : s;
      }
      dm[it] = f2bf(v);
    }
  }
  for (int it = gtid; it < 4 * 64 * 128; it += gsz) {
    int o = it & 127, c = (it >> 7) & 63, g = it >> 13;
    int d = o & 63;
    float acc = 0.f;
    for (int c2 = 0; c2 < 64; ++c2) {
      float s, co;
      sincospif((float)((c * c2) & 63) / 32.f, &s, &co);
      float w = p.b_w[(g * 64 + c2) * 64 + d];
      acc += (o < 64 ? co : -s) * w;
    }
    ((float*)(ws + O_WC))[it] = acc;
  }
  const int lane = threadIdx.x & 63, gw = gtid >> 6, nw = gsz >> 6;
  bf16_t* HN = (bf16_t*)(ws + O_HN);
  for (int sr = gw; sr < TP_; sr += nw) {
    if (sr >= T_) {
#pragma unroll
      for (int q = 0; q < 2; ++q) *(uint4*)(HN + (size_t)sr * 1024 + q * 512 + lane * 8) = make_uint4(0, 0, 0, 0);
      continue;
    }
    int pos; int b = seq_of(sr, pos);
    const float* src = pos < 16 ? p.meta + pos * 1024
                                : (b < 8 ? p.x_prompt + ((size_t)b * 4096 + pos - 16) * 1024 : p.x_sample + (size_t)(pos - 16) * 1024);
    float* hr = hrow(p, sr);
    float4 v[4];
    float ss = 0.f;
#pragma unroll
    for (int q = 0; q < 4; ++q) {
      v[q] = *(const float4*)(src + q * 256 + lane * 4);
      ss += v[q].x * v[q].x + v[q].y * v[q].y + v[q].z * v[q].z + v[q].w * v[q].w;
      *(float4*)(hr + q * 256 + lane * 4) = v[q];
    }
    ss = wave_sum(ss);
    float rs = rsqrtf(ss * (1.f / 1024.f) + EPS);
#pragma unroll
    for (int q = 0; q < 4; ++q) {
      float4 g = *(const float4*)(p.pre_mix_g + q * 256 + lane * 4);
      uint2 o = make_uint2(pack2(v[q].x * rs * g.x, v[q].y * rs * g.y), pack2(v[q].z * rs * g.z, v[q].w * rs * g.w));
      *(uint2*)(HN + (size_t)sr * 1024 + q * 256 + lane * 4) = o;
    }
  }
}

DI void gemm_tile(const bf16_t* __restrict__ A, int lda, const bf16_t* __restrict__ B, int ldb, int K, char* lds, f32x16 (&acc)[2][2]) {
  const int tid = threadIdx.x & 255, lane = tid & 63, wave = tid >> 6, wm = wave >> 1, wn = wave & 1;
  const int l31 = lane & 31, h = lane >> 5;
  bf16_t* As = (bf16_t*)lds;
  bf16_t* Bs = As + 128 * 72;
#pragma unroll
  for (int a = 0; a < 2; ++a)
#pragma unroll
    for (int b = 0; b < 2; ++b)
#pragma unroll
      for (int i = 0; i < 16; ++i) acc[a][b][i] = 0.f;
  const int lr = tid >> 3, lc = (tid & 7) * 8;
  const bf16_t* Ag = A + (size_t)lr * lda + lc;
  const bf16_t* Bg = B + (size_t)lr * ldb + lc;
  u32x4 ra[4], rb[4];
#pragma unroll
  for (int q = 0; q < 4; ++q) {
    ra[q] = *(const u32x4*)(Ag + (size_t)(32 * q) * lda);
    rb[q] = *(const u32x4*)(Bg + (size_t)(32 * q) * ldb);
  }
#pragma unroll
  for (int q = 0; q < 4; ++q) {
    *(u32x4*)(As + (lr + 32 * q) * 72 + lc) = ra[q];
    *(u32x4*)(Bs + (lr + 32 * q) * 72 + lc) = rb[q];
  }
  __syncthreads();
  const int nk = K >> 6;
  for (int kt = 0; kt < nk; ++kt) {
    if (kt + 1 < nk) {
#pragma unroll
      for (int q = 0; q < 4; ++q) {
        ra[q] = *(const u32x4*)(Ag + (size_t)(32 * q) * lda + (kt + 1) * 64);
        rb[q] = *(const u32x4*)(Bg + (size_t)(32 * q) * ldb + (kt + 1) * 64);
      }
    }
#pragma unroll
    for (int ks = 0; ks < 4; ++ks) {
      bf16x8 a[2], b[2];
#pragma unroll
      for (int t = 0; t < 2; ++t) {
        a[t] = *(const bf16x8*)(As + (wm * 64 + t * 32 + l31) * 72 + ks * 16 + 8 * h);
        b[t] = *(const bf16x8*)(Bs + (wn * 64 + t * 32 + l31) * 72 + ks * 16 + 8 * h);
      }
#pragma unroll
      for (int mt = 0; mt < 2; ++mt)
#pragma unroll
        for (int nt = 0; nt < 2; ++nt) acc[mt][nt] = MFMA32(a[mt], b[nt], acc[mt][nt]);
    }
    __syncthreads();
    if (kt + 1 < nk) {
#pragma unroll
      for (int q = 0; q < 4; ++q) {
        *(u32x4*)(As + (lr + 32 * q) * 72 + lc) = ra[q];
        *(u32x4*)(Bs + (lr + 32 * q) * 72 + lc) = rb[q];
      }
      __syncthreads();
    }
  }
}
#define ACC_ROW(mt, i) (wm * 64 + (mt) * 32 + ((i) & 3) + 8 * ((i) >> 2) + 4 * h)
#define ACC_COL(nt) (wn * 64 + (nt) * 32 + l31)
#define GEMM_IDS const int lane = threadIdx.x & 63, wave = (threadIdx.x & 255) >> 6, wm = wave >> 1, wn = wave & 1, l31 = lane & 31, h = lane >> 5; (void)wm; (void)wn; (void)l31; (void)h;

DI void phase_gemm_small(const bf16_t* A, int lda, const bf16_t* W, int N, int K, bf16_t* C, int ldc, char* lds) {
  GEMM_IDS
  const int sb = threadIdx.x >> 8;
  const int ntn = N / 128;
  const int total = NT_ * ntn;
  for (int t0 = blockIdx.x * 2; t0 < total; t0 += gridDim.x * 2) {
    const int t = t0 + sb;
    const int tm = t / ntn, tn = t - tm * ntn;
    f32x16 acc[2][2];
    gemm_tile(A + (size_t)tm * 128 * lda, lda, W + (size_t)tn * 128 * K, K, K, lds + sb * 36864, acc);
#pragma unroll
    for (int mt = 0; mt < 2; ++mt)
#pragma unroll
      for (int nt = 0; nt < 2; ++nt)
#pragma unroll
        for (int i = 0; i < 16; ++i) {
          int row = tm * 128 + ACC_ROW(mt, i), col = tn * 128 + ACC_COL(nt);
          C[(size_t)row * ldc + col] = f2bf(acc[mt][nt][i]);
        }
  }
}

namespace pg8 {
#define PG8_LAS __attribute__((address_space(3)))
typedef unsigned short bf16_t;
typedef short bf16x8 __attribute__((ext_vector_type(8)));
typedef float f32x4 __attribute__((ext_vector_type(4)));
typedef unsigned u32x4 __attribute__((ext_vector_type(4)));
constexpr int BM = 256, BK = 64, HALF = 128, HTB = HALF * BK * 2  , STAGE_BYTES = 8 * HTB, NXCD = 8, WGM = 8;

__host__ __device__ __forceinline__ int lds_byte(int r, int c) { const int st = (r >> 4) * 2 + (c >> 5), rr = r & 15, cc = c & 31, ob = rr * 64 + cc * 2; return st * 1024 + (ob ^ (((ob >> 9) & 1) << 5)); }
__host__ __device__ __forceinline__ void stage_rc(int b, int& R, int& C) { const int st = b / 1024, sb = b % 1024, swz = sb ^ (((sb >> 9) & 1) << 5); R = (st >> 1) * 16 + swz / 64; C = (st & 1) * 32 + (swz % 64) / 2; }
__host__ __device__ __forceinline__ int perm32(int rho) { const int n = rho >> 4, i = rho & 15; return 8 * (i >> 2) + 4 * n + (i & 3); }

struct Unit { int pm, pn; };
struct Gemm { const bf16_t* A; const bf16_t* Bt; int M, N, K; };

struct StaticOrder {
    int nM, nN, nwg, G, c;
    __host__ __device__ void init(int M, int N, int G_, int c_) { nM = M / BM; nN = N / BM; nwg = nM * nN; G = G_; c = c_; }
    __host__ __device__ bool next(int i, Unit& u) const {
        const long L = (long)i * G + c; if (L >= nwg) return false;
        int wgid = (int)L; { const int q = nwg / NXCD, r = nwg % NXCD, xcd = wgid % NXCD, off = wgid / NXCD; wgid = (xcd < r ? xcd * (q + 1) : r * (q + 1) + (xcd - r) * q) + off; }
        const int nig = WGM * nN, gid = wgid / nig, fm = gid * WGM, gsz = (nM - fm) < WGM ? (nM - fm) : WGM;
        u.pm = fm + ((wgid % nig) % gsz); u.pn = (wgid % nig) / gsz; return true;
    }
    __device__ __forceinline__ void a_ready(const Unit&) const {}
    __device__ __forceinline__ void done(const Unit&) const {}
};
__device__ __forceinline__ unsigned cvt_pk_bf16(float lo, float hi) { unsigned r; asm volatile("v_cvt_pk_bf16_f32 %0, %1, %2" : "=v"(r) : "v"(lo), "v"(hi)); return r; }

struct EpiRoute {
    static constexpr bool PERM = true, AFTER_DRAIN = false;
    bf16_t* O; int ldc; int route; bf16_t* pc; bf16_t* prkv; bf16_t* plow;
    __device__ __forceinline__ void operator()(const f32x4 (&acc)[2][2][4][2], const Unit& u, int wr, int wc, int fr, int fq) const {
        const int row0 = u.pm * BM + wr * 64 + fr;
#pragma unroll
        for (int bj = 0; bj < 2; ++bj) {
            int colh = u.pn * BM + bj * HALF; bf16_t* base = O; int ld = ldc;
            if (route) {
                if (colh < 768) { base = pc; ld = 768; }
                else if (colh < 2304) { base = prkv; ld = 1536; colh -= 768; }
                else if (colh < 2688) { base = plow; ld = 384; colh -= 2304; }
                else continue;
            }
            const int col0 = colh + wc * 32 + 8 * fq;
#pragma unroll
            for (int ai = 0; ai < 2; ++ai)
#pragma unroll
                for (int m = 0; m < 4; ++m) { bf16_t* rowp = base + (size_t)(row0 + ai * HALF + m * 16) * ld + col0;
                    const f32x4 v0 = acc[ai][bj][m][0], v1 = acc[ai][bj][m][1];
                    u32x4 w; w.x = cvt_pk_bf16(v0[0], v0[1]); w.y = cvt_pk_bf16(v0[2], v0[3]); w.z = cvt_pk_bf16(v1[0], v1[1]); w.w = cvt_pk_bf16(v1[2], v1[3]);
                    *(u32x4*)rowp = w; }
        }
    }
};
struct EpiGateUp {
    static constexpr bool PERM = true, AFTER_DRAIN = false;
    bf16_t* ACT;
    __device__ __forceinline__ void operator()(const f32x4 (&acc)[2][2][4][2], const Unit& u, int wr, int wc, int fr, int fq) const {
        const int row0 = u.pm * BM + wr * 64 + fr, col0 = u.pn * HALF + wc * 32 + 8 * fq;
#pragma unroll
        for (int ai = 0; ai < 2; ++ai)
#pragma unroll
            for (int m = 0; m < 4; ++m) { bf16_t* rowp = ACT + (size_t)(row0 + ai * HALF + m * 16) * 2816 + col0;
                float v[8];
#pragma unroll
                for (int n = 0; n < 2; ++n)
#pragma unroll
                    for (int j = 0; j < 4; ++j) { const float g = acc[ai][0][m][n][j], uu = acc[ai][1][m][n][j]; v[n * 4 + j] = g * __builtin_amdgcn_rcpf(1.f + __expf(-g)) * uu; }
                u32x4 w; w.x = cvt_pk_bf16(v[0], v[1]); w.y = cvt_pk_bf16(v[2], v[3]); w.z = cvt_pk_bf16(v[4], v[5]); w.w = cvt_pk_bf16(v[6], v[7]);
                *(u32x4*)rowp = w; }
    }
};
template <class Epi, class Sched, bool STAMP = false>
__device__ __forceinline__ void gemm_phase(PG8_LAS unsigned char* lds, const Gemm g, const Sched& S, const Epi& E, unsigned long long* stamps) {
    const int tid = threadIdx.x, wid = __builtin_amdgcn_readfirstlane(tid >> 6), lane = tid & 63, wr = wid >> 2, wc = wid & 3, fr = lane & 15, fq = lane >> 4;
    const int K = g.K, nt = K / BK;
    int ts_lo = 0, ts_hi = 0, nts = 0; const unsigned long long rt_entry = STAMP ? (unsigned long long)wall_clock64() : 0ull;
#define PG8_STAMP() do { if (STAMP && wid == 0 && nts < 64) { const unsigned long long _c = (unsigned long long)clock64(); \
        ts_lo = (lane == nts) ? (int)(unsigned)_c : ts_lo; ts_hi = (lane == nts) ? (int)(unsigned)(_c >> 32) : ts_hi; ++nts; } } while (0)
    PG8_STAMP();
    unsigned voffA[2], voffB[2];
#pragma unroll
    for (int i = 0; i < 2; ++i) { int R, C; stage_rc(tid * 16 + i * 8192, R, C); const int Rb = Epi::PERM ? ((R & ~31) + perm32(R & 31)) : R;
        voffA[i] = (unsigned)(R * K + C) * 2u; voffB[i] = (unsigned)(Rb * K + C) * 2u; }
    const size_t kstep = (size_t)(BK * 2);
    const size_t hstep = (size_t)HALF * K * 2;
    const size_t tstep = 2 * hstep;
    const unsigned ldsw = (unsigned)wid * 1024u;
    const int aoff = lds_byte(wr * 64 + fr, fq * 8), boff = lds_byte(wc * 32 + fr, fq * 8);
#define PG8_SA(b, h) (((b) * 2 + (h)) * HTB)
#define PG8_SB(b, h) ((4 + (b) * 2 + (h)) * HTB)
#define PG8_STAGE(bufoff, gbase, voff) do { _Pragma("unroll") for (int _i = 0; _i < 2; ++_i) \
        __builtin_amdgcn_global_load_lds((const unsigned*)((const char*)(gbase) + (voff)[_i]), (PG8_LAS unsigned*)(lds + (bufoff) + ldsw + _i * 8192), 16, 0, 0); } while (0)
#define PG8_LDA(dst, b, h) do { _Pragma("unroll") for (int m = 0; m < 4; ++m) _Pragma("unroll") for (int k = 0; k < 2; ++k) dst[m][k] = *(const PG8_LAS bf16x8*)(lds + PG8_SA(b, h) + aoff + m * 2048 + k * 1024); } while (0)
#define PG8_LDB(dst, b, h) do { _Pragma("unroll") for (int n = 0; n < 2; ++n) _Pragma("unroll") for (int k = 0; k < 2; ++k) dst[n][k] = *(const PG8_LAS bf16x8*)(lds + PG8_SB(b, h) + boff + n * 2048 + k * 1024); } while (0)
#define PG8_MMA(ai, bj, At, Bt) do { __builtin_amdgcn_s_setprio(1); _Pragma("unroll") for (int m = 0; m < 4; ++m) _Pragma("unroll") for (int n = 0; n < 2; ++n) _Pragma("unroll") for (int k = 0; k < 2; ++k) \
        acc[ai][bj][m][n] = __builtin_amdgcn_mfma_f32_16x16x32_bf16(Bt[n][k], At[m][k], acc[ai][bj][m][n], 0, 0, 0); __builtin_amdgcn_s_setprio(0); } while (0)
#define PG8_WAIT_V(n) asm volatile("s_waitcnt vmcnt(" #n ")" ::: "memory")
#define PG8_WAIT_L(n) asm volatile("s_waitcnt lgkmcnt(" #n ")" ::: "memory")
#define PG8_BAR __builtin_amdgcn_s_barrier()
#define PG8_SCHED __builtin_amdgcn_sched_barrier(0)
    Unit cur, nxt; int ui = 0;
    if (!S.next(0, cur)) return;
    f32x4 acc[2][2][4][2];
#pragma unroll
    for (int a = 0; a < 2; ++a)
#pragma unroll
        for (int b = 0; b < 2; ++b)
#pragma unroll
            for (int m = 0; m < 4; ++m)
#pragma unroll
                for (int n = 0; n < 2; ++n) acc[a][b][m][n] = (f32x4){0.f, 0.f, 0.f, 0.f};
    bf16x8 At[4][2], B0[2][2], B1[2][2];
    const char* cA = (const char*)g.A + (size_t)cur.pm * tstep; const char* cB = (const char*)g.Bt + (size_t)cur.pn * tstep;
    S.a_ready(cur);
    PG8_STAGE(PG8_SB(0, 0), cB, voffB); PG8_STAGE(PG8_SA(0, 0), cA, voffA); PG8_STAGE(PG8_SB(0, 1), cB + hstep, voffB); PG8_STAGE(PG8_SA(0, 1), cA + hstep, voffA);
    if (wr == 1) PG8_BAR;
    PG8_WAIT_V(4); PG8_BAR;
    PG8_STAGE(PG8_SB(1, 0), cB + kstep, voffB); PG8_STAGE(PG8_SA(1, 0), cA + kstep, voffA); PG8_STAGE(PG8_SB(1, 1), cB + hstep + kstep, voffB);
    PG8_WAIT_V(6); PG8_BAR;
    PG8_STAMP();
    for (;;) {
        const bool has_next = S.next(ui + 1, nxt);
        const char* nA = has_next ? (const char*)g.A + (size_t)nxt.pm * tstep : cA; const char* nB = has_next ? (const char*)g.Bt + (size_t)nxt.pn * tstep : cB;
        for (int t = 0; t < nt; t += 2) {
            const bool last = (t == nt - 2);
            const char* a1 = cA + (size_t)(t + 1) * kstep;
            const char* a2 = last ? nA : cA + (size_t)(t + 2) * kstep; const char* b2 = last ? nB : cB + (size_t)(t + 2) * kstep;
            const char* a3 = a2 + kstep; const char* b3 = b2 + kstep;
            if (last && has_next) S.a_ready(nxt);
            PG8_LDB(B0, 0, 0); PG8_SCHED; PG8_LDA(At, 0, 0); PG8_STAGE(PG8_SA(1, 1), a1 + hstep, voffA);
            PG8_WAIT_L(8); PG8_BAR; PG8_WAIT_L(0); PG8_MMA(0, 0, At, B0); PG8_BAR; PG8_SCHED;
            PG8_LDB(B1, 0, 1); PG8_STAGE(PG8_SB(0, 0), b2, voffB);
            PG8_BAR; PG8_WAIT_L(0); PG8_MMA(0, 1, At, B1); PG8_BAR;
            PG8_LDA(At, 0, 1); PG8_STAGE(PG8_SA(0, 0), a2, voffA);
            PG8_BAR; PG8_WAIT_L(0); PG8_MMA(1, 0, At, B0); PG8_BAR; PG8_SCHED;
            PG8_STAGE(PG8_SB(0, 1), b2 + hstep, voffB);
            PG8_WAIT_V(6); PG8_BAR; PG8_MMA(1, 1, At, B1); PG8_BAR;
            PG8_LDB(B0, 1, 0); PG8_SCHED; PG8_LDA(At, 1, 0); PG8_STAGE(PG8_SA(0, 1), a2 + hstep, voffA);
            PG8_WAIT_L(8); PG8_BAR; PG8_WAIT_L(0); PG8_MMA(0, 0, At, B0); PG8_BAR; PG8_SCHED;
            PG8_LDB(B1, 1, 1); PG8_STAGE(PG8_SB(1, 0), b3, voffB);
            PG8_BAR; PG8_WAIT_L(0); PG8_MMA(0, 1, At, B1); PG8_BAR;
            PG8_LDA(At, 1, 1); PG8_STAGE(PG8_SA(1, 0), a3, voffA);
            PG8_BAR; PG8_WAIT_L(0); PG8_MMA(1, 0, At, B0); PG8_BAR; PG8_SCHED;
            PG8_STAGE(PG8_SB(1, 1), b3 + hstep, voffB);
            PG8_WAIT_V(6); PG8_BAR; PG8_MMA(1, 1, At, B1); PG8_BAR;
        }
        PG8_STAMP();
        if constexpr (!Epi::AFTER_DRAIN) { E(acc, cur, wr, wc, fr, fq); S.done(cur); }
        PG8_STAMP();
        if (!has_next) break;
#pragma unroll
        for (int a = 0; a < 2; ++a)
#pragma unroll
            for (int b = 0; b < 2; ++b)
#pragma unroll
                for (int m = 0; m < 4; ++m)
#pragma unroll
                    for (int n = 0; n < 2; ++n) acc[a][b][m][n] = (f32x4){0.f, 0.f, 0.f, 0.f};
        cur = nxt; cA = nA; cB = nB; ++ui;
    }
    PG8_WAIT_V(0);
    if (wr == 0) PG8_BAR;
    PG8_BAR;
    if constexpr (Epi::AFTER_DRAIN) { E.fused(acc, cur, wr, wc, fr, fq, lds, wid, lane); S.done(cur); }
    PG8_STAMP();
    if (STAMP && wid == 0) { stamps[lane] = lane < nts ? (((unsigned long long)(unsigned)ts_hi << 32) | (unsigned)ts_lo) : 0ull;
        if (lane == 62) stamps[62] = rt_entry; if (lane == 63) stamps[63] = (unsigned long long)wall_clock64(); }
#undef PG8_STAMP
#undef PG8_SA
#undef PG8_SB
#undef PG8_STAGE
#undef PG8_LDA
#undef PG8_LDB
#undef PG8_MMA
#undef PG8_WAIT_V
#undef PG8_WAIT_L
#undef PG8_BAR
#undef PG8_SCHED
}
}

DI void phase_gemm_big(const bf16_t* A, const bf16_t* W, int N, int K, bf16_t* C, int ldc, int route, char* ws, unsigned char* lds) {
  pg8::Gemm g{A, W, TP_, N, K};
  pg8::StaticOrder S; S.init(TP_, N, gridDim.x, blockIdx.x);
  pg8::EpiRoute E{C, ldc, route, (bf16_t*)(ws + O_PC), (bf16_t*)(ws + O_PRKV), (bf16_t*)(ws + O_PLOW)};
  pg8::gemm_phase<pg8::EpiRoute, pg8::StaticOrder, false>((PG8_LAS unsigned char*)lds, g, S, E, nullptr);
}
DI void phase_gemm_gateup(const bf16_t* A, const bf16_t* W, bf16_t* ACT, unsigned char* lds) {
  pg8::Gemm g{A, W, TP_, 5632, 1024};
  pg8::StaticOrder S; S.init(TP_, 5632, gridDim.x, blockIdx.x);
  pg8::EpiGateUp E{ACT};
  pg8::gemm_phase<pg8::EpiGateUp, pg8::StaticOrder, false>((PG8_LAS unsigned char*)lds, g, S, E, nullptr);
}

DI void phase_resnorm(const P& p, const float* g1, const float* g2) {
  const int lane = threadIdx.x & 63, gw = (blockIdx.x * NTH + threadIdx.x) >> 6, nw = (gridDim.x * NTH) >> 6;
  bf16_t* HN = (bf16_t*)(p.ws + O_HN);
  for (int sr = gw; sr < T_; sr += nw) {
    float* hr = hrow(p, sr);
    float x[16];
    uint4 u0 = *(const uint4*)(HN + (size_t)sr * 1024 + lane * 16);
    uint4 u1 = *(const uint4*)(HN + (size_t)sr * 1024 + lane * 16 + 8);
    unsigned uu[8] = {u0.x, u0.y, u0.z, u0.w, u1.x, u1.y, u1.z, u1.w};
    float ss = 0.f;
#pragma unroll
    for (int j = 0; j < 8; ++j) { x[2 * j] = lo2f(uu[j]); x[2 * j + 1] = hi2f(uu[j]); ss += x[2 * j] * x[2 * j] + x[2 * j + 1] * x[2 * j + 1]; }
    ss = wave_sum(ss);
    float rs = rsqrtf(ss * (1.f / 1024.f) + EPS);
    float hv[16];
    float ss2 = 0.f;
#pragma unroll
    for (int q = 0; q < 4; ++q) {
      float4 hh = *(const float4*)(hr + lane * 16 + q * 4);
      float4 g = *(const float4*)(g1 + lane * 16 + q * 4);
      hh.x += x[q * 4 + 0] * rs * g.x; hh.y += x[q * 4 + 1] * rs * g.y; hh.z += x[q * 4 + 2] * rs * g.z; hh.w += x[q * 4 + 3] * rs * g.w;
      *(float4*)(hr + lane * 16 + q * 4) = hh;
      hv[q * 4 + 0] = hh.x; hv[q * 4 + 1] = hh.y; hv[q * 4 + 2] = hh.z; hv[q * 4 + 3] = hh.w;
      ss2 += hh.x * hh.x + hh.y * hh.y + hh.z * hh.z + hh.w * hh.w;
    }
    if (g2) {
      ss2 = wave_sum(ss2);
      float rs2 = rsqrtf(ss2 * (1.f / 1024.f) + EPS);
      unsigned o[8];
#pragma unroll
      for (int q = 0; q < 4; ++q) {
        float4 g = *(const float4*)(g2 + lane * 16 + q * 4);
        o[2 * q] = pack2(hv[q * 4] * rs2 * g.x, hv[q * 4 + 1] * rs2 * g.y);
        o[2 * q + 1] = pack2(hv[q * 4 + 2] * rs2 * g.z, hv[q * 4 + 3] * rs2 * g.w);
      }
      *(uint4*)(HN + (size_t)sr * 1024 + lane * 16) = make_uint4(o[0], o[1], o[2], o[3]);
      *(uint4*)(HN + (size_t)sr * 1024 + lane * 16 + 8) = make_uint4(o[4], o[5], o[6], o[7]);
    }
  }
}

DI size_t vta_base(int seq) { return seq < 8 ? (size_t)seq * 256 * 4160 : (size_t)8 * 256 * 4160; }
template <int NC> DI void vt_transpose(const bf16_t* src, int ld, int col0, bf16_t* VT, char* lds) {
  bf16_t* tl = (bf16_t*)lds;
  const int tid = threadIdx.x;
  constexpr int CPT = NC / 8, TPR = 512 / NC, PPT = 64 / TPR;
  for (int it = blockIdx.x; it < 257 + 8 * 65; it += gridDim.x) {
    int seq, kt;
    if (it < 257) { seq = 8; kt = it; } else { const int j = it - 257; seq = j / 65; kt = j - seq * 65; }
    const int L = seq_len(seq), LP = L + 48, sbase = seq_base(seq);
    const size_t vb = (seq < 8 ? (size_t)seq * NC * 4160 : (size_t)8 * NC * 4160);
    __syncthreads();
    const int pl = tid >> 3, part = tid & 7;
    const int pos = 64 * kt + pl - 48;
#pragma unroll
    for (int q = 0; q < CPT / 8; ++q) {
      u32x4 v = (u32x4)(0u);
      if (pos >= 0) v = *(const u32x4*)(src + (size_t)(sbase + pos) * ld + col0 + part * CPT + q * 8);
#pragma unroll
      for (int j = 0; j < 4; ++j) {
        tl[(part * CPT + q * 8 + 2 * j) * 72 + pl] = (bf16_t)(v[j] & 0xffffu);
        tl[(part * CPT + q * 8 + 2 * j + 1) * 72 + pl] = (bf16_t)(v[j] >> 16);
      }
    }
    __syncthreads();
    const int row = tid / TPR, seg = tid % TPR;
    bf16_t* dst = VT + vb + (size_t)row * LP + 64 * kt + seg * PPT;
#pragma unroll
    for (int q = 0; q < PPT / 8; ++q) *(u32x4*)(dst + q * 8) = *(const u32x4*)(tl + row * 72 + seg * PPT + q * 8);
  }
}

DI void phase_prepA(const P& p, char* lds) {
  const int lane = threadIdx.x & 63, wave = threadIdx.x >> 6;
  bf16_t* PROJ = (bf16_t*)(p.ws + O_PROJ0);
  bf16_t* ZB = (bf16_t*)(p.ws + O_ZB);
  const float* WC = (const float*)(p.ws + O_WC);
  vt_transpose<256>(PROJ, 1536, 1024, (bf16_t*)(p.ws + O_VTA), lds);
  __syncthreads();
  float* fl = (float*)lds + wave * 1024;
  const float inv = exp2f(-(float)(lane & 15) * (13.287712379549449f / 16.f));
  const float qg = p.a_q_gain[lane], kg = p.a_k_gain[lane];
  for (int r0 = blockIdx.x * 32; r0 < TP_; r0 += gridDim.x * 32) {
    const int srb = r0 + wave * 4;
#pragma unroll 1
    for (int rr = 0; rr < 4; ++rr) {
      const int sr = srb + rr;
      if (sr < T_) {
        int pos; seq_of(sr, pos);
        float rowf, colf;
        if (pos < 16) { rowf = colf = (float)(pos - 16); }
        else { int t = pos - 16; rowf = (float)(t >> 6); colf = (float)(t & 63); }
        float ang = (lane < 32 ? rowf : colf) * inv;
        float sn, cs;
        sincosf(ang, &sn, &cs);
        const float sgn = (lane & 16) ? sn : -sn;
        bf16_t* pr = PROJ + (size_t)sr * 1536;
        for (int hd = 0; hd < 16; ++hd) {
          float x = bf2f(pr[hd * 64 + lane]);
          float ss = wave_sum(x * x);
          float xn = x * rsqrtf(ss * (1.f / 64.f) + EPS) * (hd < 12 ? qg : kg);
          float pa = __shfl_xor(xn, 16);
          float o = xn * cs + pa * sgn;
          if (hd < 12) o *= 0.125f * LOG2E;
          pr[hd * 64 + lane] = f2bf(o);
        }
        uint2 u = *(const uint2*)(pr + 1280 + lane * 4);
        float f0 = lo2f(u.x), f1 = hi2f(u.x), f2 = lo2f(u.y), f3 = hi2f(u.y);
        float ss = f0 * f0 + f1 * f1 + f2 * f2 + f3 * f3;
        ss += __shfl_xor(ss, 1); ss += __shfl_xor(ss, 2); ss += __shfl_xor(ss, 4); ss += __shfl_xor(ss, 8);
        float rs = rsqrtf(ss * (1.f / 64.f) + EPS);
        float4 g = *(const float4*)(p.b_norm_g + lane * 4);
        *(float4*)(fl + rr * 256 + lane * 4) = make_float4(f0 * rs * g.x, f1 * rs * g.y, f2 * rs * g.z, f3 * rs * g.w);
      } else {
        *(float4*)(fl + rr * 256 + lane * 4) = make_float4(0.f, 0.f, 0.f, 0.f);
      }
    }
    __syncthreads();
    {
      const int g = lane >> 4, o0 = (lane & 15) * 8;
      float acc[4][8];
#pragma unroll
      for (int rr = 0; rr < 4; ++rr)
#pragma unroll
        for (int j = 0; j < 8; ++j) acc[rr][j] = 0.f;
      const float* wc = WC + (size_t)g * 64 * 128 + o0;
#pragma unroll 4
      for (int c = 0; c < 64; ++c) {
        const float4 w0 = *(const float4*)(wc + c * 128), w1 = *(const float4*)(wc + c * 128 + 4);
#pragma unroll
        for (int rr = 0; rr < 4; ++rr) {
          const float f = fl[rr * 256 + g * 64 + c];
          acc[rr][0] += f * w0.x; acc[rr][1] += f * w0.y; acc[rr][2] += f * w0.z; acc[rr][3] += f * w0.w;
          acc[rr][4] += f * w1.x; acc[rr][5] += f * w1.y; acc[rr][6] += f * w1.z; acc[rr][7] += f * w1.w;
        }
      }
#pragma unroll
      for (int rr = 0; rr < 4; ++rr)
        if (srb + rr < T_)
          *(uint4*)(ZB + (size_t)(srb + rr) * 512 + g * 128 + o0) = make_uint4(pack2(acc[rr][0], acc[rr][1]), pack2(acc[rr][2], acc[rr][3]), pack2(acc[rr][4], acc[rr][5]), pack2(acc[rr][6], acc[rr][7]));
    }
    __syncthreads();
  }
}

template <int MODE>
DI void flash_item(const bf16_t* __restrict__ Q, int ldq, const bf16_t* __restrict__ Kb, int ldk, const bf16_t* __restrict__ Vt, int LP,
                   bf16_t* O, int ldo, int sbase, int S, int qt, float sinkl2, char* lds) {
  const int tid = threadIdx.x & 255, lane = tid & 63, wave = tid >> 6, l31 = lane & 31, h = lane >> 5;
  bf16_t* Ks = (bf16_t*)lds;
  bf16_t* Vs = Ks + 2 * 64 * 72;
  const int rl = wave * 32 + l31;
  const int qpos = qt == 0 ? (rl < 16 ? rl : 15) : 16 + 128 * (qt - 1) + rl;
  const bool qvalid = qt > 0 || rl < 16;
  bf16x8 qf[4];
  {
    const bf16_t* qr = Q + (size_t)(sbase + qpos) * ldq;
#pragma unroll
    for (int s = 0; s < 4; ++s) qf[s] = *(const bf16x8*)(qr + 16 * s + 8 * h);
  }
  const int nkt_all = (S + 64) / 64;
  int klo = 1, n;
  if (MODE == 0) { n = nkt_all; }
  else {
    if (qt == 0) { klo = 1; n = 3; }
    else {
      int c = qt - 1;
      klo = 2 * c - 1; if (klo < 1) klo = 1;
      int khi = 2 * c + 4; if (khi > nkt_all - 1) khi = nkt_all - 1;
      n = 1 + (khi - klo + 1);
    }
  }
  const int ldr = tid >> 2, ldp = (tid & 3) * 16;
  u32x4 rk0, rk1, rv0, rv1;
  auto ktile = [&](int idx) { return idx == 0 ? 0 : klo + idx - 1; };
#define FL_GLOAD(idx)                                                                               \
  {                                                                                                 \
    int kt_ = ktile(idx);                                                                           \
    int pos_ = 64 * kt_ + ldr - 48;                                                                 \
    if (pos_ >= 0) {                                                                                \
      const bf16_t* kp_ = Kb + (size_t)(sbase + pos_) * ldk + ldp;                                  \
      rk0 = *(const u32x4*)kp_; rk1 = *(const u32x4*)(kp_ + 8);                                 \
    } else { rk0 = (u32x4)(0u); rk1 = rk0; }                                       \
    const bf16_t* vp_ = Vt + (size_t)ldr * LP + 64 * kt_ + ldp;                                     \
    rv0 = *(const u32x4*)vp_; rv1 = *(const u32x4*)(vp_ + 8);                                   \
  }
#define FL_SSTORE(buf)                                                                              \
  {                                                                                                 \
    *(u32x4*)(Ks + (buf) * 64 * 72 + ldr * 72 + ldp) = rk0; *(u32x4*)(Ks + (buf) * 64 * 72 + ldr * 72 + ldp + 8) = rk1; \
    *(u32x4*)(Vs + (buf) * 64 * 72 + ldr * 72 + ldp) = rv0; *(u32x4*)(Vs + (buf) * 64 * 72 + ldr * 72 + ldp + 8) = rv1; \
  }
  f32x16 oacc[2];
#pragma unroll
  for (int i = 0; i < 16; ++i) { oacc[0][i] = 0.f; oacc[1][i] = 0.f; }
  float m = -1e30f, l = 0.f;
  FL_GLOAD(0)
  FL_SSTORE(0)
  __syncthreads();
  for (int idx = 0; idx < n; ++idx) {
    const int cur = idx & 1;
    if (idx + 1 < n) FL_GLOAD(idx + 1)
    const int kt = ktile(idx);
    const bf16_t* ks = Ks + cur * 64 * 72;
    const bf16_t* vs = Vs + cur * 64 * 72;
    f32x16 sacc[2];
#pragma unroll
    for (int t = 0; t < 2; ++t) {
#pragma unroll
      for (int i = 0; i < 16; ++i) sacc[t][i] = 0.f;
#pragma unroll
      for (int s = 0; s < 4; ++s) {
        bf16x8 kf = *(const bf16x8*)(ks + (32 * t + l31) * 72 + 16 * s + 8 * h);
        sacc[t] = MFMA32(kf, qf[s], sacc[t]);
      }
    }
    if (kt == 0) {
#pragma unroll
      for (int t = 0; t < 2; ++t)
#pragma unroll
        for (int i = 0; i < 16; ++i) {
          int kl = 32 * t + (i & 3) + 8 * (i >> 2) + 4 * h;
          if (kl < 48) sacc[t][i] = -1e30f;
        }
    } else if (MODE == 1) {
#pragma unroll
      for (int t = 0; t < 2; ++t)
#pragma unroll
        for (int i = 0; i < 16; ++i) {
          int kl = 32 * t + (i & 3) + 8 * (i >> 2) + 4 * h;
          int tk = 64 * (kt - 1) + kl;
          bool vis;
          if (qt == 0) vis = tk <= 112 + qpos;
          else { int tq = qpos - 16; int d = tq - tk; vis = d <= 128 && d >= -128; }
          if (!vis) sacc[t][i] = -1e30f;
        }
    }
    float tmax = -1e30f;
#pragma unroll
    for (int t = 0; t < 2; ++t)
#pragma unroll
      for (int i = 0; i < 16; ++i) tmax = fmaxf(tmax, sacc[t][i]);
    tmax = fmaxf(tmax, __shfl_xor(tmax, 32));
    if (__builtin_amdgcn_ballot_w64(tmax > m) != 0ull) {
      const float mn = fmaxf(m, tmax);
      const float alpha = __builtin_amdgcn_exp2f(m - mn);
      m = mn;
      l *= alpha;
#pragma unroll
      for (int i = 0; i < 16; ++i) { oacc[0][i] *= alpha; oacc[1][i] *= alpha; }
    }
    const f32x2 m2 = {m, m};
    f32x2 ls2 = {0.f, 0.f};
    unsigned pk[2][8];
#pragma unroll
    for (int t = 0; t < 2; ++t)
#pragma unroll
      for (int i2 = 0; i2 < 8; ++i2) {
        f32x2 d = {sacc[t][2 * i2], sacc[t][2 * i2 + 1]};
        d = d - m2;
        f32x2 e = {__builtin_amdgcn_exp2f(d.x), __builtin_amdgcn_exp2f(d.y)};
        ls2 += e;
        pk[t][i2] = __builtin_bit_cast(unsigned, __builtin_convertvector(e, bf16x2_t));
      }
    l += ls2.x + ls2.y;
#pragma unroll
    for (int t = 0; t < 2; ++t)
#pragma unroll
      for (int s2 = 0; s2 < 2; ++s2) {
        u32x4 pk4 = {pk[t][4 * s2], pk[t][4 * s2 + 1], pk[t][4 * s2 + 2], pk[t][4 * s2 + 3]};
        bf16x8 pf = __builtin_bit_cast(bf16x8, pk4);
#pragma unroll
        for (int dt = 0; dt < 2; ++dt) {
          const bf16_t* vp = vs + (32 * dt + l31) * 72 + 32 * t + 16 * s2 + 4 * h;
          uint2 lo = *(const uint2*)vp, hi = *(const uint2*)(vp + 8);
          u32x4 v4 = {lo.x, lo.y, hi.x, hi.y};
          bf16x8 vf = __builtin_bit_cast(bf16x8, v4);
          oacc[dt] = MFMA32(vf, pf, oacc[dt]);
        }
      }
    if (idx + 1 < n) FL_SSTORE(cur ^ 1)
    __syncthreads();
  }
  l += __shfl_xor(l, 32);
  if (MODE == 1) l += __builtin_amdgcn_exp2f(sinkl2 - m);
  const float il = 1.f / l;
  if (qvalid) {
    bf16_t* orow = O + (size_t)(sbase + qpos) * ldo;
#pragma unroll
    for (int dt = 0; dt < 2; ++dt)
#pragma unroll
      for (int g = 0; g < 4; ++g) {
        int d = 32 * dt + 8 * g + 4 * h;
        uint2 o = make_uint2(pack2(oacc[dt][4 * g] * il, oacc[dt][4 * g + 1] * il), pack2(oacc[dt][4 * g + 2] * il, oacc[dt][4 * g + 3] * il));
        *(uint2*)(orow + d) = o;
      }
  }
#undef FL_GLOAD
#undef FL_SSTORE
}

DI size_t y_base(int seq) { return seq < 8 ? (size_t)seq * 16 * 256 * 576 : (size_t)8 * 16 * 256 * 576; }
DI void phase_attnA(const P& p, char* lds) {
  const bf16_t* PROJ = (const bf16_t*)(p.ws + O_PROJ0);
  const bf16_t* VT = (const bf16_t*)(p.ws + O_VTA);
  bf16_t* MIX = (bf16_t*)(p.ws + O_MIX);
  const int nS = 129 * 6, nP = 8 * 33 * 6;
  const int sb = threadIdx.x >> 8;
  unsigned* head = (unsigned*)(p.ws + O_CNT);
  for (;;) {
    if (threadIdx.x == 0) *(volatile int*)(lds + 2 * 36864) = (int)__hip_atomic_fetch_add(head, 1u, __ATOMIC_RELAXED, __HIP_MEMORY_SCOPE_AGENT);
    __syncthreads();
    const int it = *(volatile int*)(lds + 2 * 36864);
    __syncthreads();
    if (it >= nS + nP) break;
    int seq, qt, hq;
    if (it < nS) { seq = 8; hq = (it % 6) * 2 + sb; qt = it / 6; }
    else { int j = it - nS; hq = (j % 6) * 2 + sb; j /= 6; qt = j % 33; seq = j / 33; }
    const int kv = hq / 3;
    const int L = seq_len(seq), LP = L + 48;
    flash_item<0>(PROJ + hq * 64, 1536, PROJ + 768 + kv * 64, 1536, VT + vta_base(seq) + (size_t)kv * 64 * LP, LP,
                  MIX + hq * 64, 1024, seq_base(seq), L - 16, qt, 0.f, lds + sb * 36864);
  }
  const bf16_t* ZB = (const bf16_t*)(p.ws + O_ZB);
  bf16_t* Y = (bf16_t*)(p.ws + O_Y);
  const int lane = threadIdx.x & 63, wave = threadIdx.x >> 6;
  const int nI_S = 17 * 16, nI_P = 8 * 5 * 16;
  for (int it = blockIdx.x; it < nI_S + nI_P; it += gridDim.x) {
    int seq, nb, cb;
    if (it < nI_S) { seq = 8; cb = it & 15; nb = it >> 4; }
    else { int j = it - nI_S; cb = j & 15; j >>= 4; nb = j % 5; seq = j / 5; }
    const int M = seq < 8 ? 257 : 1025, KP = seq < 8 ? 576 : 2112, L = 16 * M;
    const int n2 = nb * 64 + lane;
    const int ch = cb * 16 + wave * 2;
    const int g = ch >> 6, d = ch & 63;
    bf16_t* yb = Y + y_base(seq);
    if (n2 < M) {
      float zr[16][2], zi[16][2];
#pragma unroll
      for (int n1 = 0; n1 < 16; ++n1) {
        const bf16_t* zp = ZB + (size_t)(seq_base(seq) + M * n1 + n2) * 512 + g * 128 + d;
        unsigned re = *(const unsigned*)zp, im = *(const unsigned*)(zp + 64);
        zr[n1][0] = lo2f(re); zr[n1][1] = hi2f(re); zi[n1][0] = lo2f(im); zi[n1][1] = hi2f(im);
      }
      for (int k1 = 0; k1 < 16; ++k1) {
        float ws_, wc_;
        sincospif(-(float)k1 / 8.f, &ws_, &wc_);
        float ar0 = zr[15][0], ai0 = zi[15][0], ar1 = zr[15][1], ai1 = zi[15][1];
#pragma unroll
        for (int n1 = 14; n1 >= 0; --n1) {
          float t0 = ar0 * wc_ - ai0 * ws_ + zr[n1][0]; ai0 = ar0 * ws_ + ai0 * wc_ + zi[n1][0]; ar0 = t0;
          float t1 = ar1 * wc_ - ai1 * ws_ + zr[n1][1]; ai1 = ar1 * ws_ + ai1 * wc_ + zi[n1][1]; ar1 = t1;
        }
        float ts, tc;
        sincospif(-2.f * (float)(k1 * n2) / (float)L, &ts, &tc);
        float yr0 = ar0 * tc - ai0 * ts, yi0 = ar0 * ts + ai0 * tc;
        float yr1 = ar1 * tc - ai1 * ts, yi1 = ar1 * ts + ai1 * tc;
        bf16_t* y0 = yb + ((size_t)k1 * 256 + ch) * KP;
        y0[n2] = f2bf(yr0); y0[M + n2] = f2bf(yi0);
        y0[KP + n2] = f2bf(yr1); y0[KP + M + n2] = f2bf(yi1);
      }
    } else if (n2 < KP - M) {
      for (int k1 = 0; k1 < 16; ++k1) {
        bf16_t* y0 = yb + ((size_t)k1 * 256 + ch) * KP;
        y0[M + n2] = 0; y0[KP + M + n2] = 0;
      }
    }
  }
}

DI void phase_fnet_gemm(const P& p, char* lds) {
  GEMM_IDS
  bf16_t* MIX = (bf16_t*)(p.ws + O_MIX);
  const bf16_t* Y = (const bf16_t*)(p.ws + O_Y);
  const int nS = 16 * 9 * 2, nP = 8 * 16 * 3 * 2;
  const int sb = threadIdx.x >> 8;
  for (int it0 = blockIdx.x * 2; it0 < nS + nP; it0 += gridDim.x * 2) {
    const int it = it0 + sb;
    int seq, k1, tm, tn;
    if (it < nS) { seq = 8; tn = it & 1; int j = it >> 1; tm = j % 9; k1 = j / 9; }
    else { int j = it - nS; tn = j & 1; j >>= 1; tm = j % 3; j /= 3; k1 = j & 15; seq = j >> 4; }
    const int M = seq < 8 ? 257 : 1025, KP = seq < 8 ? 576 : 2112, L = 16 * M;
    const bf16_t* dm = (const bf16_t*)(p.ws + (seq < 8 ? O_DM257 : O_DM1025));
    f32x16 acc[2][2];
    gemm_tile(dm + (size_t)tm * 128 * KP, KP, Y + y_base(seq) + ((size_t)k1 * 256 + tn * 128) * KP, KP, KP, lds + sb * 36864, acc);
    const float scale = rsqrtf(64.f * (float)L);
#pragma unroll
    for (int mt = 0; mt < 2; ++mt)
#pragma unroll
      for (int nt = 0; nt < 2; ++nt)
#pragma unroll
        for (int i = 0; i < 16; ++i) {
          int k2 = tm * 128 + ACC_ROW(mt, i), ch = tn * 128 + ACC_COL(nt);
          if (k2 < M) {
            int pos = k1 + 16 * k2;
            MIX[(size_t)(seq_base(seq) + pos) * 1024 + 768 + ch] = f2bf(acc[mt][nt][i] * scale + p.b_b[ch]);
          }
        }
  }
}

DI size_t vtc_base(int seq) { return seq < 8 ? (size_t)seq * 128 * 4160 : (size_t)8 * 128 * 4160; }
DI void phase_prepC(const P& p, char* lds) {
  const int gtid = blockIdx.x * NTH + threadIdx.x, gsz = gridDim.x * NTH;
  const int lane = threadIdx.x & 63, gw = gtid >> 6, nw = gsz >> 6;
  bf16_t* PC = (bf16_t*)(p.ws + O_PC);
  bf16_t* VT = (bf16_t*)(p.ws + O_VTC);
  const bf16_t* PLOW = (const bf16_t*)(p.ws + O_PLOW);
  bf16_t* LR = (bf16_t*)(p.ws + O_LR);
  vt_transpose<128>(PC, 768, 640, VT, lds);
  for (int sr = gw; sr < T_; sr += nw) {
    int pos; int b = seq_of(sr, pos);
    const int L = seq_len(b), LP = L + 48;
    bf16_t* pr = PC + (size_t)sr * 768;
    float cs[8], sn[8];
#pragma unroll
    for (int j = 0; j < 8; ++j) sincosf((float)pos * exp2f(-(float)j * (18.931568569324174f / 8.f)), &sn[j], &cs[j]);
#pragma unroll
    for (int part = 0; part < 2; ++part) {
      const bool act = part == 0 || lane < 16;
      const int col = part * 512 + (act ? lane : 0) * 8;
      uint4 u = *(const uint4*)(pr + col);
      float e[8] = {lo2f(u.x), hi2f(u.x), lo2f(u.y), hi2f(u.y), lo2f(u.z), hi2f(u.z), lo2f(u.w), hi2f(u.w)};
      float o[8];
#pragma unroll
      for (int j = 0; j < 8; ++j) {
        float pa = __shfl_xor(e[j], 1);
        float rot = e[j] * cs[j] + pa * ((lane & 1) ? sn[j] : -sn[j]);
        o[j] = (lane & 7) < 2 ? rot : e[j];
        if (part == 0) o[j] *= 0.125f * LOG2E;
      }
      if (act) *(uint4*)(pr + col) = make_uint4(pack2(o[0], o[1]), pack2(o[2], o[3]), pack2(o[4], o[5]), pack2(o[6], o[7]));
    }
#pragma unroll
    for (int q = 0; q < 6; ++q) {
      int c = q * 64 + lane;
      float u = bf2f(PLOW[(size_t)sr * 384 + c]);
      float up = pos > 0 ? bf2f(PLOW[(size_t)(sr - 1) * 384 + c]) : 0.f;
      float un = pos < L - 1 ? bf2f(PLOW[(size_t)(sr + 1) * 384 + c]) : 0.f;
      float us = u + p.mu_prev[1536 + c] * (up - u) + p.mu_next[1536 + c] * (un - u);
      float v = c < 128 ? tanhf(us) : (c < 256 ? us : sigmoidf_(us));
      LR[(size_t)sr * 384 + c] = f2bf(v);
    }
  }
}

DI void phase_attnC(const P& p, char* lds) {
  const bf16_t* PC = (const bf16_t*)(p.ws + O_PC);
  const bf16_t* VT = (const bf16_t*)(p.ws + O_VTC);
  bf16_t* MIX = (bf16_t*)(p.ws + O_MIX);
  const int nS = 129 * 4, nP = 8 * 33 * 4;
  const int sb = threadIdx.x >> 8;
  for (int it = blockIdx.x; it < nS + nP; it += gridDim.x) {
    int seq, qt, hq;
    if (it < nS) { seq = 8; hq = (it & 3) * 2 + sb; qt = it >> 2; }
    else { int j = it - nS; hq = (j & 3) * 2 + sb; j >>= 2; qt = j % 33; seq = j / 33; }
    const int kv = hq >> 2;
    const int L = seq_len(seq), LP = L + 48;
    flash_item<1>(PC + hq * 64, 768, PC + 512 + kv * 64, 768, VT + vtc_base(seq) + (size_t)kv * 64 * LP, LP,
                  MIX + hq * 64, 1024, seq_base(seq), L - 16, qt, p.c_sink[hq] * LOG2E, lds + sb * 36864);
  }
}

DI void chunk_decode(int cg_, int& seq, int& c) {
  if (cg_ < 136) { seq = cg_ / 17; c = cg_ - seq * 17; } else { seq = 8; c = cg_ - 136; }
}
DI float shiftv(const bf16_t* PRKV, int sr, int pos, int L, int col, float mp, float mn) {
  float u = bf2f(PRKV[(size_t)sr * 1536 + col]);
  float up = pos > 0 ? bf2f(PRKV[(size_t)(sr - 1) * 1536 + col]) : 0.f;
  float un = pos < L - 1 ? bf2f(PRKV[(size_t)(sr + 1) * 1536 + col]) : 0.f;
  return u + mp * (up - u) + mn * (un - u);
}
enum { VW = 0, VA = 1, VB = 2, VK = 3, VV = 4, VR = 5 };
#define DPP_FMAC(acc, x, y, N) asm("v_fmac_f32_dpp %0, %1, %2 row_newbcast:%3 row_mask:0xf bank_mask:0xf" : "+v"(acc) : "v"(x), "v"(y), "n"(N))
#define DPP_MUL(sv_, x, N) asm("v_mul_f32_dpp %0, %1, %0 row_newbcast:%2 row_mask:0xf bank_mask:0xf" : "+v"(sv_) : "v"(x), "n"(N))
template <int N> DI void dpp_dot4(float& a0, float& a1, float& a2, float& a3, const float (&S)[64], const float4& x) {
  DPP_FMAC(a0, x.x, S[N], N); DPP_FMAC(a1, x.y, S[16 + N], N); DPP_FMAC(a2, x.z, S[32 + N], N); DPP_FMAC(a3, x.w, S[48 + N], N);
  if constexpr (N < 15) dpp_dot4<N + 1>(a0, a1, a2, a3, S, x);
}
template <int N, bool HASV, bool OUT> DI void dpp_upd4(float (&S)[64], const float4& xw, const float4& xb, const float4& xk, const float4& xr, float sa, float vi,
                                                       float& o0, float& o1, float& o2, float& o3) {
  DPP_MUL(S[N], xw.x, N); DPP_MUL(S[16 + N], xw.y, N); DPP_MUL(S[32 + N], xw.z, N); DPP_MUL(S[48 + N], xw.w, N);
  DPP_FMAC(S[N], xb.x, sa, N); DPP_FMAC(S[16 + N], xb.y, sa, N); DPP_FMAC(S[32 + N], xb.z, sa, N); DPP_FMAC(S[48 + N], xb.w, sa, N);
  if (HASV) { DPP_FMAC(S[N], xk.x, vi, N); DPP_FMAC(S[16 + N], xk.y, vi, N); DPP_FMAC(S[32 + N], xk.z, vi, N); DPP_FMAC(S[48 + N], xk.w, vi, N); }
  if (OUT) { DPP_FMAC(o0, xr.x, S[N], N); DPP_FMAC(o1, xr.y, S[16 + N], N); DPP_FMAC(o2, xr.z, S[32 + N], N); DPP_FMAC(o3, xr.w, S[48 + N], N); }
  if constexpr (N < 15) dpp_upd4<N + 1, HASV, OUT>(S, xw, xb, xk, xr, sa, vi, o0, o1, o2, o3);
}
template <int NST, bool HASV, bool OUT, class F>
DI void scan_steps(float (&S)[64], const float* sv, int ns, int lane, F&& emit) {
  const int l15 = lane & 15;
  for (int s = 0; s < ns; ++s) {
    const float4 xw = *(const float4*)(sv + VW * NST * 64 + s * 64 + l15 * 4);
    const float4 xa = *(const float4*)(sv + VA * NST * 64 + s * 64 + l15 * 4);
    const float4 xb = *(const float4*)(sv + VB * NST * 64 + s * 64 + l15 * 4);
    float4 xk = xb, xr = xb;
    if (HASV) xk = *(const float4*)(sv + VK * NST * 64 + s * 64 + l15 * 4);
    if (OUT) xr = *(const float4*)(sv + VR * NST * 64 + s * 64 + l15 * 4);
    const float vi = HASV ? sv[VV * NST * 64 + s * 64 + lane] : 0.f;
    float sa0 = 0.f, sa1 = 0.f, sa2 = 0.f, sa3 = 0.f;
    dpp_dot4<0>(sa0, sa1, sa2, sa3, S, xa);
    const float sa = (sa0 + sa1) + (sa2 + sa3);
    float o0 = 0.f, o1 = 0.f, o2 = 0.f, o3 = 0.f;
    dpp_upd4<0, HASV, OUT>(S, xw, xb, xk, xr, sa, vi, o0, o1, o2, o3);
    if (OUT) emit(s, (o0 + o1) + (o2 + o3));
  }
}
DI int vperm(int j) { return (j & 15) * 4 + (j >> 4); }

template <int NST, bool P3>
DI void scan_prologue8(const P& p, int sbase, int L, int hd, int dir, int pos0, int nsteps, int sb0, float* sv) {
  const int lane = threadIdx.x & 63, l31 = lane & 31, h = lane >> 5;
  const bf16_t* PRKV = (const bf16_t*)(p.ws + O_PRKV);
  const bf16_t* LR = (const bf16_t*)(p.ws + O_LR);
  const bf16_t* WUPT = (const bf16_t*)(p.ws + O_WUPT) + (size_t)(dir * 512 + hd * 64) * 64;
  const bf16_t* AUPT = (const bf16_t*)(p.ws + O_AUPT) + (size_t)(dir * 512 + hd * 64) * 64;
  float* bonus = (float*)(p.ws + O_BONUS);
  const int c = hd * 64 + lane;
  float rk_[10], rv_[10], rr_[10];
  {
    const int p0w = dir ? pos0 - sb0 : pos0 + sb0;
#pragma unroll
    for (int i = 0; i < 10; ++i) {
      const int pi = dir ? p0w - (i - 1) : p0w + (i - 1);
      const bool inb = pi >= 0 && pi < L;
      const int pc = pi < 0 ? 0 : (pi > L - 1 ? L - 1 : pi);
      const bf16_t* rowp = PRKV + (size_t)(sbase + pc) * 1536 + c;
      const float kx = bf2f(rowp[512]), vx = bf2f(rowp[1024]);
      rk_[i] = inb ? kx : 0.f; rv_[i] = inb ? vx : 0.f;
      if (P3) { const float rx = bf2f(rowp[0]); rr_[i] = inb ? rx : 0.f; } else rr_[i] = 0.f;
    }
  }
  {
    int sl = sb0 + (l31 & 7); if (sl > nsteps - 1) sl = nsteps - 1;
    const int pos = dir ? pos0 - sl : pos0 + sl;
    const bf16_t* lrp = LR + (size_t)(sbase + pos) * 384 + dir * 64 + 8 * h;
#pragma unroll 1
    for (int mat = 0; mat < 2; ++mat) {
      const bf16_t* Wm = mat ? AUPT : WUPT;
      const float* bias = mat ? p.d_a0 : p.d_w0;
      f32x16 ac[2];
#pragma unroll
      for (int nt = 0; nt < 2; ++nt)
#pragma unroll
        for (int i = 0; i < 16; ++i) ac[nt][i] = 0.f;
#pragma unroll
      for (int ks = 0; ks < 4; ++ks) {
        const bf16x8 fa = *(const bf16x8*)(lrp + mat * 128 + 16 * ks);
#pragma unroll
        for (int nt = 0; nt < 2; ++nt) {
          const bf16x8 bw = *(const bf16x8*)(Wm + (size_t)(32 * nt + l31) * 64 + 16 * ks + 8 * h);
          ac[nt] = MFMA32(fa, bw, ac[nt]);
        }
      }
      float* dstv = sv + (mat ? VB : VW) * NST * 64;
#pragma unroll
      for (int nt = 0; nt < 2; ++nt) {
        const int j = 32 * nt + l31;
        const float b0 = bias[dir * 512 + hd * 64 + j];
#pragma unroll
        for (int i = 0; i < 4; ++i) {
          const int st = sb0 + i + 4 * h;
          const float sg = 1.f / (1.f + __expf(-(b0 + ac[nt][i])));
          dstv[st * 64 + vperm(j)] = mat ? sg : __expf(-0.6065306597126334f * sg);
        }
      }
    }
  }
  const float mpr = p.mu_prev[c], mnr = p.mu_next[c], mpk = p.mu_prev[512 + c], mnk = p.mu_next[512 + c], mpv = p.mu_prev[1024 + c], mnv = p.mu_next[1024 + c];
  const float kkc = p.d_k_k[c], kac = p.d_k_a[c], rkc = p.d_r_k[c];
  const int pj = vperm(lane);
#pragma unroll
  for (int q = 0; q < 8; ++q) {
    const int s = sb0 + q;
    const float kb = rk_[q], kc = rk_[q + 1], ka = rk_[q + 2];
    const float vb = rv_[q], vc = rv_[q + 1], va = rv_[q + 2];
    const float k = kc + mpk * ((dir ? ka : kb) - kc) + mnk * ((dir ? kb : ka) - kc);
    const float v = vc + mpv * ((dir ? va : vb) - vc) + mnv * ((dir ? vb : va) - vc);
    const float a = sv[VB * NST * 64 + s * 64 + pj];
    float kk = k * kkc;
    const float n2 = wave_sum(kk * kk);
    kk *= rsqrtf(fmaxf(n2, 1e-24f));
    const float kd = k * (1.f + (a - 1.f) * kac);
    sv[VA * NST * 64 + s * 64 + pj] = -kk;
    sv[VB * NST * 64 + s * 64 + pj] = kk * a;
    sv[VK * NST * 64 + s * 64 + pj] = kd;
    sv[VV * NST * 64 + s * 64 + lane] = v;
    if (P3) {
      const float rb = rr_[q], rc = rr_[q + 1], ra = rr_[q + 2];
      const float r = rc + mpr * ((dir ? ra : rb) - rc) + mnr * ((dir ? rb : ra) - rc);
      sv[VR * NST * 64 + s * 64 + pj] = r;
      const float bn = wave_sum(r * kd * rkc);
      if (s < nsteps && lane == 0) {
        const int pos = dir ? pos0 - s : pos0 + s;
        bonus[((size_t)(sbase + pos) * 8 + hd) * 2 + dir] = bn;
      }
    }
  }
}

template <bool HALF> DI void scan1_body(const P& p, char* lds) {
  float* PQ = (float*)(p.ws + O_PQ);
  const int lane = threadIdx.x & 63, wave = __builtin_amdgcn_readfirstlane(threadIdx.x >> 6), slot = wave >> 1;
  constexpr int half = HALF ? 1 : 0;
  float* sv = (float*)lds + slot * (6 * 16 * 64);
  for (int g = blockIdx.x; g < 804; g += gridDim.x) {
    int seq, c, hp;
    if (g < 768) { const int lc = g >> 2; hp = g & 3; if (lc < 128) { seq = lc >> 4; c = lc & 15; } else { seq = 8; c = lc - 128; } }
    else { const int j = g - 768; hp = j & 3; seq = j >> 2; c = seq < 8 ? 16 : 64; }
    const int cgi = seq < 8 ? seq * 17 + c : 136 + c;
    const int hd = hp * 2 + (slot >> 1), dir = slot & 1;
    const int it = (cgi * 8 + hd) * 2 + dir;
    const int L = seq_len(seq), sbase = seq_base(seq);
    const int start = c * 256, end = min(L, start + 256), n = end - start;
    float S[64];
#pragma unroll
    for (int j = 0; j < 64; ++j) S[j] = (half == 0 && j == lane) ? 1.f : 0.f;
    for (int s0 = 0; s0 < n; s0 += 16) {
      const int ns = min(16, n - s0);
      const int pos0 = dir ? end - 1 - s0 : start + s0;
      __syncthreads();
      scan_prologue8<16, false>(p, sbase, L, hd, dir, pos0, ns, half * 8, sv);
      __syncthreads();
      scan_steps<16, HALF, false>(S, sv, ns, lane, [](int, float) {});
    }
    float* dst = PQ + (size_t)it * 8192 + (size_t)(half * 64 + lane) * 64;
#pragma unroll
    for (int q = 0; q < 16; ++q) *(float4*)(dst + q * 4) = make_float4(S[q * 4], S[q * 4 + 1], S[q * 4 + 2], S[q * 4 + 3]);
  }
}

DI void phase_scan1(const P& p, char* lds) {
  if (__builtin_amdgcn_readfirstlane(threadIdx.x >> 6) & 1) scan1_body<true>(p, lds); else scan1_body<false>(p, lds);
}

DI void phase_scan2(const P& p, char* lds) {
  float* Ss = (float*)lds;
  float* Ps = Ss + 64 * 65;
  float* PQ = (float*)(p.ws + O_PQ);
  const int tid = threadIdx.x, i = tid >> 3, j0 = (tid & 7) * 8;
  for (int it = blockIdx.x; it < 144; it += gridDim.x) {
    const int dir = it & 1, hd = (it >> 1) & 7, seq = it >> 4;
    const int nch = seq < 8 ? 17 : 65, cg0 = seq < 8 ? seq * 17 : 136;
    float S[8];
#pragma unroll
    for (int jj = 0; jj < 8; ++jj) S[jj] = 0.f;
    for (int cc = 0; cc < nch; ++cc) {
      const int c = dir ? nch - 1 - cc : cc;
      float* Pg = PQ + (size_t)(((cg0 + c) * 8 + hd) * 2 + dir) * 8192;
      float* Qg = Pg + 4096;
      __syncthreads();
#pragma unroll
      for (int jj = 0; jj < 8; ++jj) Ss[i * 65 + j0 + jj] = S[jj];
#pragma unroll
      for (int r4 = 0; r4 < 2; ++r4) *(float4*)(Ps + (r4 * 512 + tid) * 4) = *(const float4*)(Pg + (r4 * 512 + tid) * 4);
      float acc[8];
#pragma unroll
      for (int r4 = 0; r4 < 2; ++r4) {
        float4 qv = *(const float4*)(Qg + i * 64 + j0 + r4 * 4);
        acc[r4 * 4] = qv.x; acc[r4 * 4 + 1] = qv.y; acc[r4 * 4 + 2] = qv.z; acc[r4 * 4 + 3] = qv.w;
      }
#pragma unroll
      for (int r4 = 0; r4 < 2; ++r4) *(float4*)(Qg + i * 64 + j0 + r4 * 4) = make_float4(S[r4 * 4], S[r4 * 4 + 1], S[r4 * 4 + 2], S[r4 * 4 + 3]);
      __syncthreads();
      for (int m = 0; m < 64; ++m) {
        const float sm = Ss[i * 65 + m];
        const float* pr = Ps + m * 64 + j0;
#pragma unroll
        for (int jj = 0; jj < 8; ++jj) acc[jj] += sm * pr[jj];
      }
#pragma unroll
      for (int jj = 0; jj < 8; ++jj) S[jj] = acc[jj];
    }
  }
}

DI void phase_scan3(const P& p, char* lds) {
  const float* PQ = (const float*)(p.ws + O_PQ);
  bf16_t* MIX = (bf16_t*)(p.ws + O_MIX);
  bf16_t* OB = (bf16_t*)(p.ws + O_OB);
  const int lane = threadIdx.x & 63, wave = __builtin_amdgcn_readfirstlane(threadIdx.x >> 6);
  float* sv = (float*)lds + wave * (6 * 8 * 64);
  const bool bal = gridDim.x == 256;
  const int NW = gridDim.x * 8, gw = blockIdx.x * 8 + wave;
  for (int k = 0; ; ++k) {
    int oi;
    if (bal) {
      if (k == 0) oi = gw;
      else if (k == 1) { if (wave >= 4) continue; oi = 2048 + blockIdx.x * 4 + wave; }
      else if (k == 2) { if (wave != 7 || blockIdx.x >= 144) break; oi = 3072 + blockIdx.x; }
      else break;
    } else { oi = gw + k * NW; if (oi >= 3216) break; }
    int seq, c, hd, dir;
    if (oi < 3072) { const int lc = oi >> 4; hd = (oi >> 1) & 7; dir = oi & 1; if (lc < 128) { seq = lc >> 4; c = lc & 15; } else { seq = 8; c = lc - 128; } }
    else { const int j = oi - 3072; hd = (j >> 1) & 7; dir = j & 1; seq = j >> 4; c = seq < 8 ? 16 : 64; }
    const int it = ((seq < 8 ? seq * 17 + c : 136 + c) * 8 + hd) * 2 + dir;
    const int L = seq_len(seq), sbase = seq_base(seq);
    const int start = c * 256, end = min(L, start + 256), n = end - start;
    float S[64];
    {
      const float* src = PQ + (size_t)it * 8192 + 4096 + lane * 64;
#pragma unroll
      for (int q = 0; q < 16; ++q) { float4 t = *(const float4*)(src + q * 4); S[q * 4] = t.x; S[q * 4 + 1] = t.y; S[q * 4 + 2] = t.z; S[q * 4 + 3] = t.w; }
    }
    for (int s0 = 0; s0 < n; s0 += 8) {
      const int ns = min(8, n - s0);
      const int pos0 = dir ? end - 1 - s0 : start + s0;
      scan_prologue8<8, true>(p, sbase, L, hd, dir, pos0, ns, 0, sv);
      scan_steps<8, true, true>(S, sv, ns, lane, [&](int st, float o) {
        const int pos = dir ? pos0 - st : pos0 + st;
        const size_t sr = (size_t)(sbase + pos);
        if (dir == 0) MIX[sr * 1024 + 512 + hd * 64 + lane] = f2bf(o);
        else OB[sr * 512 + hd * 64 + lane] = f2bf(o);
      });
    }
  }
}

DI void phase_rwkv_final(const P& p) {
  const int lane = threadIdx.x & 63, gw = (blockIdx.x * NTH + threadIdx.x) >> 6, nw = (gridDim.x * NTH) >> 6;
  bf16_t* MIX = (bf16_t*)(p.ws + O_MIX);
  const bf16_t* OB = (const bf16_t*)(p.ws + O_OB);
  const bf16_t* G = (const bf16_t*)(p.ws + O_G);
  const bf16_t* PRKV = (const bf16_t*)(p.ws + O_PRKV);
  const float* bonus = (const float*)(p.ws + O_BONUS);
  const int hd = lane >> 3, c0 = lane * 8;
  for (int sr = gw; sr < T_; sr += nw) {
    int pos; int b = seq_of(sr, pos);
    const int L = seq_len(b);
    uint4 uf = *(const uint4*)(MIX + (size_t)sr * 1024 + 512 + c0);
    uint4 ub = *(const uint4*)(OB + (size_t)sr * 512 + c0);
    uint4 ug = *(const uint4*)(G + (size_t)sr * 512 + c0);
    unsigned f_[4] = {uf.x, uf.y, uf.z, uf.w}, b_[4] = {ub.x, ub.y, ub.z, ub.w}, g_[4] = {ug.x, ug.y, ug.z, ug.w};
    float o[8], gg[8];
    float sm = 0.f;
#pragma unroll
    for (int j = 0; j < 4; ++j) {
      o[2 * j] = lo2f(f_[j]) + lo2f(b_[j]); o[2 * j + 1] = hi2f(f_[j]) + hi2f(b_[j]);
      gg[2 * j] = lo2f(g_[j]); gg[2 * j + 1] = hi2f(g_[j]);
      sm += o[2 * j] + o[2 * j + 1];
    }
    sm += __shfl_xor(sm, 1); sm += __shfl_xor(sm, 2); sm += __shfl_xor(sm, 4);
    const float mean = sm * (1.f / 64.f);
    float vs = 0.f;
#pragma unroll
    for (int j = 0; j < 8; ++j) { float dlt = o[j] - mean; vs += dlt * dlt; }
    vs += __shfl_xor(vs, 1); vs += __shfl_xor(vs, 2); vs += __shfl_xor(vs, 4);
    const float rstd = rsqrtf(vs * (1.f / 64.f) + 64e-5f);
    const float bsum = bonus[((size_t)sr * 8 + hd) * 2] + bonus[((size_t)sr * 8 + hd) * 2 + 1];
    float y[8];
#pragma unroll
    for (int j = 0; j < 8; ++j) {
      int c = c0 + j;
      float vsh = shiftv(PRKV, sr, pos, L, 1024 + c, p.mu_prev[1024 + c], p.mu_next[1024 + c]);
      y[j] = ((o[j] - mean) * rstd * p.d_ln_g[c] + p.d_ln_b[c] + bsum * vsh) * gg[j];
    }
    *(uint4*)(MIX + (size_t)sr * 1024 + 512 + c0) = make_uint4(pack2(y[0], y[1]), pack2(y[2], y[3]), pack2(y[4], y[5]), pack2(y[6], y[7]));
  }
}

#define XB_TMO      128
#define XB_XCNT(j)  (256  + 64 * (j))
#define XB_XSUB(j)  (1280 + 64 * (j))
#define XB_XGEN(j)  (2304 + 64 * (j))
#define XB_TOP      3328
#define XB_TOPGEN   3392
#define XCD_BAR_WORDS 3456
#define XB_SPIN_CAP (1u << 18)
#define LAS __attribute__((address_space(3)))

__device__ __forceinline__ unsigned xb_ld(unsigned* p)              { return __hip_atomic_load(p, __ATOMIC_RELAXED, __HIP_MEMORY_SCOPE_AGENT); }
__device__ __forceinline__ unsigned xb_add(unsigned* p, unsigned v) { return __hip_atomic_fetch_add(p, v, __ATOMIC_RELAXED, __HIP_MEMORY_SCOPE_AGENT); }
__device__ __forceinline__ unsigned xb_xcc_id() { return (unsigned)__builtin_amdgcn_s_getreg((3 << 11) | 20) & 0xFu; }
#define XB_SPIN(cond, bar) do { unsigned _sp = 0; while (cond) { __builtin_amdgcn_s_sleep(1); \
    if ((++_sp & 255u) == 0u) { if (xb_ld(&(bar)[XB_TMO])) break; if (_sp > XB_SPIN_CAP) { atomicAdd(&(bar)[XB_TMO], 1u); break; } } } } while (0)

struct XcdBarrier {
    unsigned* bar; unsigned x;
    volatile LAS unsigned* st;
};

__device__ __forceinline__ XcdBarrier xcd_barrier_post(unsigned* bar, volatile LAS unsigned* st) {
    XcdBarrier b; b.bar = bar; b.x = xb_xcc_id(); b.st = st;
    if (threadIdx.x == 0) (void)xb_add(&bar[XB_XCNT(b.x)], 1u);
    return b;
}
__device__ __forceinline__ void xcd_barrier_complete(unsigned* bar, unsigned x, unsigned& nloc, unsigned& nx) {
    const unsigned G = gridDim.x * gridDim.y * gridDim.z;
    unsigned sum, cnt, mine, sp = 0u;
    for (;;) {
        sum = 0u; cnt = 0u; mine = 0u;
#pragma unroll
        for (unsigned j = 0; j < 16; ++j) { const unsigned c = xb_ld(&bar[XB_XCNT(j)]); sum += c; cnt += (c > 0u) ? 1u : 0u; mine = (j == x) ? c : mine; }
        if (sum == G) break;
        __builtin_amdgcn_s_sleep(1);
        if ((++sp & 255u) == 0u) { if (xb_ld(&bar[XB_TMO])) break; if (sp > XB_SPIN_CAP) { atomicAdd(&bar[XB_TMO], 1u); break; } }
    }
    nloc = mine > 0u ? mine : 1u; nx = cnt > 0u ? cnt : 1u;
}

__device__ __forceinline__ void xcd_barrier(const XcdBarrier& b) {
    asm volatile("s_waitcnt vmcnt(0)" ::: "memory");
    __syncthreads();
    if (threadIdx.x == 0) {
        unsigned* bar = b.bar;
        __builtin_amdgcn_s_waitcnt(0);
        unsigned nloc = b.st[0], nx = b.st[1];
        if (nloc == 0u) { xcd_barrier_complete(bar, b.x, nloc, nx); b.st[0] = nloc; b.st[1] = nx; }
        const unsigned old = xb_add(&bar[XB_XSUB(b.x)], 1u);
        const unsigned gen = old / nloc;
        if (old + 1u == (gen + 1u) * nloc) {
            __builtin_amdgcn_fence(__ATOMIC_RELEASE, "agent");
            asm volatile("s_waitcnt vmcnt(0)" ::: "memory");
            const unsigned og = xb_add(&bar[XB_TOP], 1u);
            const unsigned tg = og / nx;
            if (og + 1u == (tg + 1u) * nx) xb_add(&bar[XB_TOPGEN], 1u);
            else XB_SPIN(xb_ld(&bar[XB_TOPGEN]) == tg, bar);
            __builtin_amdgcn_fence(__ATOMIC_ACQUIRE, "agent");
            xb_add(&bar[XB_XGEN(b.x)], 1u);
            asm volatile("s_waitcnt vmcnt(0)" ::: "memory");
        } else {
            XB_SPIN(xb_ld(&bar[XB_XGEN(b.x)]) == gen, bar);
            __builtin_amdgcn_fence(__ATOMIC_ACQUIRE, "agent");
            asm volatile("s_waitcnt vmcnt(0)" ::: "memory");
        }
    }
    __syncthreads();
}

constexpr int NPHASE = 23;
__global__ void __launch_bounds__(NTH, 2) mega(P p) {
  extern __shared__ __attribute__((aligned(16))) unsigned char shm[];
  char* lds = (char*)shm;
  char* ws = p.ws;
  if (threadIdx.x == 0) *(uint4*)(shm + 131072) = make_uint4(0u, 0u, 0u, 0u);
  __syncthreads();
  const XcdBarrier xb = xcd_barrier_post((unsigned*)(ws + O_BAR), (volatile LAS unsigned*)(shm + 131072));
#ifndef DUP_MASK
#define DUP_MASK 0u
#endif
#define RUN(k, call) if (p.ph0 <= k && k < p.ph1) { call; if (k + 1 < p.ph1) { if (k == 0) cg::this_grid().sync(); else xcd_barrier(xb); } }
  RUN(0, phase_prep(p))
  RUN(1, phase_gemm_big((const bf16_t*)(ws + O_HN), (const bf16_t*)(ws + O_WIN0), 1536, 1024, (bf16_t*)(ws + O_PROJ0), 1536, 0, ws, shm))
  RUN(2, phase_prepA(p, lds))
  RUN(3, phase_attnA(p, lds))
  RUN(4, phase_fnet_gemm(p, lds))
  RUN(5, phase_gemm_big((const bf16_t*)(ws + O_MIX), (const bf16_t*)(ws + O_WOUT0), 1024, 1024, (bf16_t*)(ws + O_HN), 1024, 0, ws, shm))
  RUN(6, phase_resnorm(p, p.post_mix_g, p.pre_ffn_g))
  RUN(7, phase_gemm_gateup((const bf16_t*)(ws + O_HN), (const bf16_t*)(ws + O_WGU0), (bf16_t*)(ws + O_ACT), shm))
  RUN(8, phase_gemm_big((const bf16_t*)(ws + O_ACT), (const bf16_t*)(ws + O_WD0), 1024, DFF, (bf16_t*)(ws + O_HN), 1024, 0, ws, shm))
  RUN(9, phase_resnorm(p, p.post_ffn_g, p.pre_mix_g + 1024))
  RUN(10, phase_gemm_big((const bf16_t*)(ws + O_HN), (const bf16_t*)(ws + O_WIN1), 2816, 1024, nullptr, 0, 1, ws, shm))
  RUN(11, phase_prepC(p, lds))
  RUN(12, phase_attnC(p, lds))
  RUN(13, phase_scan1(p, lds))
  RUN(14, phase_scan2(p, lds))
  RUN(15, phase_scan3(p, lds))
  RUN(16, phase_gemm_small((const bf16_t*)(ws + O_LR) + 256, 384, (const bf16_t*)(ws + O_GUP), 512, 128, (bf16_t*)(ws + O_G), 512, lds))
  RUN(17, phase_rwkv_final(p))
  RUN(18, phase_gemm_big((const bf16_t*)(ws + O_MIX), (const bf16_t*)(ws + O_WOUT1), 1024, 1024, (bf16_t*)(ws + O_HN), 1024, 0, ws, shm))
  RUN(19, phase_resnorm(p, p.post_mix_g + 1024, p.pre_ffn_g + 1024))
  RUN(20, phase_gemm_gateup((const bf16_t*)(ws + O_HN), (const bf16_t*)(ws + O_WGU1), (bf16_t*)(ws + O_ACT), shm))
  RUN(21, phase_gemm_big((const bf16_t*)(ws + O_ACT), (const bf16_t*)(ws + O_WD1), 1024, DFF, (bf16_t*)(ws + O_HN), 1024, 0, ws, shm))
  RUN(22, phase_resnorm(p, p.post_ffn_g + 1024, nullptr))
#undef RUN
}

extern "C" void kernel_launch(void* const* d_in, const int* in_sizes, int n_in, void* d_out, int out_size, void* d_ws, size_t ws_size,
                              hipStream_t stream) {
  static int grid_blocks = 0;
  if (!grid_blocks) {
    int dev = 0, cus = 0, per_cu = 0;
    (void)hipGetDevice(&dev);
    (void)hipDeviceGetAttribute(&cus, hipDeviceAttributeMultiprocessorCount, dev);
    if (hipFuncSetAttribute((const void*)mega, hipFuncAttributeMaxDynamicSharedMemorySize, LDS_BYTES) != hipSuccess) fprintf(stderr, "hipFuncSetAttribute failed\n");
    if (hipOccupancyMaxActiveBlocksPerMultiprocessor(&per_cu, (const void*)mega, NTH, LDS_BYTES) != hipSuccess || per_cu < 1) {
      fprintf(stderr, "occupancy query says %d\n", per_cu);
      (void)hipGetLastError();
    }
    grid_blocks = cus;
  }
  if (ws_size < O_BAR + CTL_BYTES) { fprintf(stderr, "workspace too small\n"); return; }
  if (hipMemsetAsync((char*)d_ws + O_BAR, 0, CTL_BYTES, stream) != hipSuccess) { fprintf(stderr, "memset failed\n"); return; }
  P p{};
  const float** f = (const float**)&p;
  for (int i = 0; i < 32; ++i) f[i] = (const float*)d_in[i];
  p.out = (float*)d_out;
  p.ws = (char*)d_ws;
#if FUSED
  p.ph0 = 0; p.ph1 = NPHASE;
  void* args[] = {&p};
  hipError_t e = hipLaunchCooperativeKernel((void*)mega, dim3(grid_blocks), dim3(NTH), args, LDS_BYTES, stream);
  if (e != hipSuccess) fprintf(stderr, "cooperative launch failed: %s (grid %d)\n", hipGetErrorString(e), grid_blocks);
#else
  for (int ph = 0; ph < NPHASE; ++ph) {
    p.ph0 = ph; p.ph1 = ph + 1;
    hipLaunchKernelGGL(mega, dim3(grid_blocks), dim3(NTH), LDS_BYTES, stream, p);
  }
#endif
}
```

```cpp
#include <hip/hip_runtime.h>
#include <hip/hip_cooperative_groups.h>
#include <cstdio>
namespace cg = cooperative_groups;

#ifndef FUSED
#define FUSED 1
#endif

typedef unsigned short bf16_t;
using bf16x8 = __attribute__((ext_vector_type(8))) short;
using s16x4 = __attribute__((ext_vector_type(4))) short;
using f32x16 = __attribute__((ext_vector_type(16))) float;
using u32x4 = __attribute__((ext_vector_type(4))) unsigned;
using f32x4v = __attribute__((ext_vector_type(4))) float;
#define DI __device__ __forceinline__
#define MFMA32(a, b, c) __builtin_amdgcn_mfma_f32_32x32x16_bf16((a), (b), (c), 0, 0, 0)
constexpr int NTH = 512;
constexpr int LDS_BYTES = 131072 + 16;

constexpr int DM_ = 1024;
constexpr int T_ = 49296;
constexpr int TP_ = 49408;
constexpr int NT_ = TP_ / 128;
constexpr int DFF = 2816;
constexpr float EPS = 1e-6f;
constexpr float LOG2E = 1.4426950408889634f;

constexpr size_t SZ_ROW1024 = (size_t)TP_ * 1024 * 2;
constexpr size_t O_WIN0 = 0;
constexpr size_t O_WOUT0 = O_WIN0 + (size_t)1536 * 1024 * 2;
constexpr size_t O_WGU0 = O_WOUT0 + (size_t)1024 * 1024 * 2;
constexpr size_t O_WD0 = O_WGU0 + (size_t)5632 * 1024 * 2;
constexpr size_t O_DM257 = O_WD0 + (size_t)1024 * 2816 * 2;
constexpr size_t O_DM1025 = O_DM257 + (size_t)384 * 576 * 2;
constexpr size_t O_WIN1 = O_DM1025 + (size_t)1152 * 2112 * 2;
constexpr size_t O_WOUT1 = O_WIN1 + (size_t)2816 * 1024 * 2;
constexpr size_t O_WGU1 = O_WOUT1 + (size_t)1024 * 1024 * 2;
constexpr size_t O_WD1 = O_WGU1 + (size_t)5632 * 1024 * 2;
constexpr size_t O_GUP = O_WD1 + (size_t)1024 * 2816 * 2;
constexpr size_t O_RA = O_GUP + (size_t)512 * 128 * 2;
constexpr size_t O_RB = O_RA + SZ_ROW1024;
constexpr size_t O_RC = O_RB + (size_t)TP_ * 2816 * 2;
constexpr size_t O_META = O_RC + SZ_ROW1024;
constexpr size_t O_WC = O_META + (size_t)144 * 1024 * 4;
constexpr size_t O_WUPT = O_WC + (size_t)4 * 64 * 128 * 4;
constexpr size_t O_AUPT = O_WUPT + (size_t)2 * 512 * 64 * 2;
constexpr size_t O_END = O_AUPT + (size_t)2 * 512 * 64 * 2;
constexpr size_t O_HN = O_RA;
constexpr size_t O_VTA = O_RA;
constexpr size_t O_LR = O_RA;
constexpr size_t O_BONUS = O_RA + (size_t)TP_ * 384 * 2;
constexpr size_t O_VTC = O_BONUS + (size_t)T_ * 16 * 4;
constexpr size_t O_OB = O_RA + (size_t)TP_ * 512 * 2;
constexpr size_t O_PROJ0 = O_RB;
constexpr size_t O_ZB = O_PROJ0 + (size_t)TP_ * 1536 * 2;
constexpr size_t O_Y = O_ZB + (size_t)TP_ * 512 * 2;
constexpr size_t O_ACT = O_RB;
constexpr size_t O_PRKV = O_RB;
constexpr size_t O_PC = O_PRKV + (size_t)TP_ * 1536 * 2;
constexpr size_t O_PLOW = O_PC + (size_t)TP_ * 768 * 2;
constexpr size_t O_PQ = O_PC;
constexpr size_t O_G = O_PC;
constexpr size_t O_MIX = O_RC;
static_assert(O_VTC + (size_t)49728 * 128 * 2 <= O_RB, "vtc");
static_assert(O_Y + (size_t)(8 * 16 * 256 * 576 + 16 * 256 * 2112) * 2 <= O_RC, "y");
static_assert(O_PQ + (size_t)3216 * 32768 <= O_RC, "pq");
constexpr size_t O_BAR = (O_END + 255) / 256 * 256;
constexpr size_t O_CNT = O_BAR + 3456 * 4;
constexpr size_t CTL_BYTES = 3456 * 4 + 4 * 256;
static_assert(O_BAR + CTL_BYTES <= (size_t)536870912, "ws");

struct P {
  const float *x_prompt, *x_sample, *meta, *pre_mix_g, *post_mix_g, *pre_ffn_g, *post_ffn_g;
  const float *even_w_in, *even_w_out, *a_q_gain, *a_k_gain, *b_norm_g, *b_w, *b_b;
  const float *odd_w_in, *odd_w_out, *c_sink, *mu_prev, *mu_next, *d_w0, *d_w_up, *d_a0, *d_a_up, *d_g_up;
  const float *d_k_k, *d_k_a, *d_r_k, *d_ln_g, *d_ln_b, *ffn_gate, *ffn_up, *ffn_down;
  float* out;
  char* ws;
  int ph0, ph1;
};

typedef float f32x2 __attribute__((ext_vector_type(2)));
typedef __bf16 bf16x2_t __attribute__((ext_vector_type(2)));
DI bf16_t f2bf(float x) { return __builtin_bit_cast(bf16_t, (__bf16)x); }
DI float bf2f(bf16_t b) { return __uint_as_float(((unsigned)b) << 16); }
DI unsigned pack2(float a, float b) { f32x2 v = {a, b}; return __builtin_bit_cast(unsigned, __builtin_convertvector(v, bf16x2_t)); }
DI float lo2f(unsigned u) { return __uint_as_float(u << 16); }
DI float hi2f(unsigned u) { return __uint_as_float(u & 0xffff0000u); }
DI float wave_sum(float v) {
  for (int o = 32; o > 0; o >>= 1) v += __shfl_xor(v, o);
  return v;
}
DI int seq_of(int sr, int& pos) {
  if (sr < 32896) { int b = sr / 4112; pos = sr - b * 4112; return b; }
  pos = sr - 32896; return 8;
}
DI int seq_len(int b) { return b < 8 ? 4112 : 16400; }
DI int seq_base(int b) { return b < 8 ? b * 4112 : 32896; }
DI float* hrow(const P& p, int sr) {
  int pos; int b = seq_of(sr, pos);
  if (pos < 16) return (float*)(p.ws + O_META) + (size_t)(b * 16 + pos) * 1024;
  return p.out + ((size_t)(b < 8 ? b * 4096 : 32768) + (pos - 16)) * 1024;
}
DI float sigmoidf_(float x) { return 1.f / (1.f + expf(-x)); }

DI void transpose_w(const float* W, int K, int ldw, int N, bf16_t* Wt, int mode, const float* W2, int gtid, int gsz) {
  int nk8 = K / 8;
  long total = (long)N * nk8;
  for (long it = gtid; it < total; it += gsz) {
    int n = (int)(it % N), k8 = (int)(it / N);
    const float* src = W;
    int c = n;
    if (mode == 1) {
      int blk = n >> 8, w = n & 255;
      c = blk * 128 + (w & 127);
      if (w >= 128) src = W2;
    }
    unsigned r[4];
#pragma unroll
    for (int j = 0; j < 4; ++j) {
      float a = src[(size_t)(k8 * 8 + 2 * j) * ldw + c];
      float b = src[(size_t)(k8 * 8 + 2 * j + 1) * ldw + c];
      r[j] = pack2(a, b);
    }
    *(uint4*)(Wt + (size_t)n * K + k8 * 8) = make_uint4(r[0], r[1], r[2], r[3]);
  }
}

DI void phase_prep(const P& p) {
  const int gtid = blockIdx.x * NTH + threadIdx.x, gsz = gridDim.x * NTH;
  char* ws = p.ws;
  transpose_w(p.even_w_in, 1024, 1536, 1536, (bf16_t*)(ws + O_WIN0), 0, nullptr, gtid, gsz);
  transpose_w(p.even_w_out, 1024, 1024, 1024, (bf16_t*)(ws + O_WOUT0), 0, nullptr, gtid, gsz);
  transpose_w(p.odd_w_in, 1024, 2688, 2688, (bf16_t*)(ws + O_WIN1), 0, nullptr, gtid, gsz);
  transpose_w(p.odd_w_out, 1024, 1024, 1024, (bf16_t*)(ws + O_WOUT1), 0, nullptr, gtid, gsz);
  transpose_w(p.ffn_gate, 1024, DFF, 5632, (bf16_t*)(ws + O_WGU0), 1, p.ffn_up, gtid, gsz);
  transpose_w(p.ffn_gate + (size_t)1024 * DFF, 1024, DFF, 5632, (bf16_t*)(ws + O_WGU1), 1, p.ffn_up + (size_t)1024 * DFF, gtid, gsz);
  transpose_w(p.ffn_down, DFF, 1024, 1024, (bf16_t*)(ws + O_WD0), 0, nullptr, gtid, gsz);
  transpose_w(p.ffn_down + (size_t)DFF * 1024, DFF, 1024, 1024, (bf16_t*)(ws + O_WD1), 0, nullptr, gtid, gsz);
  transpose_w(p.d_g_up, 128, 512, 512, (bf16_t*)(ws + O_GUP), 0, nullptr, gtid, gsz);
  for (int d = 0; d < 2; ++d) {
    transpose_w(p.d_w_up + (size_t)d * 64 * 512, 64, 512, 512, (bf16_t*)(ws + O_WUPT) + (size_t)d * 512 * 64, 0, nullptr, gtid, gsz);
    transpose_w(p.d_a_up + (size_t)d * 64 * 512, 64, 512, 512, (bf16_t*)(ws + O_AUPT) + (size_t)d * 512 * 64, 0, nullptr, gtid, gsz);
  }
  for (int it = gtid; it < 128 * 1024 / 8; it += gsz) *(uint4*)((bf16_t*)(ws + O_WIN1) + (size_t)2688 * 1024 + (size_t)it * 8) = make_uint4(0, 0, 0, 0);
  for (int which = 0; which < 2; ++which) {
    const int M = which ? 1025 : 257, MP = which ? 1152 : 384, KP = which ? 2112 : 576;
    bf16_t* dm = (bf16_t*)(ws + (which ? O_DM1025 : O_DM257));
    for (int it = gtid; it < MP * KP; it += gsz) {
      int r = it / KP, c = it - r * KP;
      float v = 0.f;
      if (r < M && c < 2 * M) {
        int n2 = c < M ? c : c - M;
        int m = (r * n2) % M;
        float s, co;
        sincospif(2.0f * (float)m / (float)M, &s, &co);
        v = c < M ? co : s;
      }
      dm[it] = f2bf(v);
    }
  }
  for (int it = gtid; it < 4 * 64 * 128; it += gsz) {
    int o = it & 127, c = (it >> 7) & 63, g = it >> 13;
    int d = o & 63;
    float acc = 0.f;
    for (int c2 = 0; c2 < 64; ++c2) {
      float s, co;
      sincospif((float)((c * c2) & 63) / 32.f, &s, &co);
      float w = p.b_w[(g * 64 + c2) * 64 + d];
      acc += (o < 64 ? co : -s) * w;
    }
    ((float*)(ws + O_WC))[it] = acc;
  }
  const int lane = threadIdx.x & 63, gw = gtid >> 6, nw = gsz >> 6;
  bf16_t* HN = (bf16_t*)(ws + O_HN);
  for (int sr = gw; sr < TP_; sr += nw) {
    if (sr >= T_) {
#pragma unroll
      for (int q = 0; q < 2; ++q) *(uint4*)(HN + (size_t)sr * 1024 + q * 512 + lane * 8) = make_uint4(0, 0, 0, 0);
      continue;
    }
    int pos; int b = seq_of(sr, pos);
    const float* src = pos < 16 ? p.meta + pos * 1024
                                : (b < 8 ? p.x_prompt + ((size_t)b * 4096 + pos - 16) * 1024 : p.x_sample + (size_t)(pos - 16) * 1024);
    float* hr = hrow(p, sr);
    float4 v[4];
    float ss = 0.f;
#pragma unroll
    for (int q = 0; q < 4; ++q) {
      v[q] = *(const float4*)(src + q * 256 + lane * 4);
      ss += v[q].x * v[q].x + v[q].y * v[q].y + v[q].z * v[q].z + v[q].w * v[q].w;
      *(float4*)(hr + q * 256 + lane * 4) = v[q];
    }
    ss = wave_sum(ss);
    float rs = rsqrtf(ss * (1.f / 1024.f) + EPS);
#pragma unroll
    for (int q = 0; q < 4; ++q) {
      float4 g = *(const float4*)(p.pre_mix_g + q * 256 + lane * 4);
      uint2 o = make_uint2(pack2(v[q].x * rs * g.x, v[q].y * rs * g.y), pack2(v[q].z * rs * g.z, v[q].w * rs * g.w));
      *(uint2*)(HN + (size_t)sr * 1024 + q * 256 + lane * 4) = o;
    }
  }
}

DI void gemm_tile(const bf16_t* __restrict__ A, int lda, const bf16_t* __restrict__ B, int ldb, int K, char* lds, f32x16 (&acc)[2][2]) {
  const int tid = threadIdx.x & 255, lane = tid & 63, wave = tid >> 6, wm = wave >> 1, wn = wave & 1;
  const int l31 = lane & 31, h = lane >> 5;
  bf16_t* As = (bf16_t*)lds;
  bf16_t* Bs = As + 128 * 72;
#pragma unroll
  for (int a = 0; a < 2; ++a)
#pragma unroll
    for (int b = 0; b < 2; ++b)
#pragma unroll
      for (int i = 0; i < 16; ++i) acc[a][b][i] = 0.f;
  const int lr = tid >> 3, lc = (tid & 7) * 8;
  const bf16_t* Ag = A + (size_t)lr * lda + lc;
  const bf16_t* Bg = B + (size_t)lr * ldb + lc;
  u32x4 ra[4], rb[4];
#pragma unroll
  for (int q = 0; q < 4; ++q) {
    ra[q] = *(const u32x4*)(Ag + (size_t)(32 * q) * lda);
    rb[q] = *(const u32x4*)(Bg + (size_t)(32 * q) * ldb);
  }
#pragma unroll
  for (int q = 0; q < 4; ++q) {
    *(u32x4*)(As + (lr + 32 * q) * 72 + lc) = ra[q];
    *(u32x4*)(Bs + (lr + 32 * q) * 72 + lc) = rb[q];
  }
  __syncthreads();
  const int nk = K >> 6;
  for (int kt = 0; kt < nk; ++kt) {
    if (kt + 1 < nk) {
#pragma unroll
      for (int q = 0; q < 4; ++q) {
        ra[q] = *(const u32x4*)(Ag + (size_t)(32 * q) * lda + (kt + 1) * 64);
        rb[q] = *(const u32x4*)(Bg + (size_t)(32 * q) * ldb + (kt + 1) * 64);
      }
    }
#pragma unroll
    for (int ks = 0; ks < 4; ++ks) {
      bf16x8 a[2], b[2];
#pragma unroll
      for (int t = 0; t < 2; ++t) {
        a[t] = *(const bf16x8*)(As + (wm * 64 + t * 32 + l31) * 72 + ks * 16 + 8 * h);
        b[t] = *(const bf16x8*)(Bs + (wn * 64 + t * 32 + l31) * 72 + ks * 16 + 8 * h);
      }
#pragma unroll
      for (int mt = 0; mt < 2; ++mt)
#pragma unroll
        for (int nt = 0; nt < 2; ++nt) acc[mt][nt] = MFMA32(a[mt], b[nt], acc[mt][nt]);
    }
    __syncthreads();
    if (kt + 1 < nk) {
#pragma unroll
      for (int q = 0; q < 4; ++q) {
        *(u32x4*)(As + (lr + 32 * q) * 72 + lc) = ra[q];
        *(u32x4*)(Bs + (lr + 32 * q) * 72 + lc) = rb[q];
      }
      __syncthreads();
    }
  }
}
#define ACC_ROW(mt, i) (wm * 64 + (mt) * 32 + ((i) & 3) + 8 * ((i) >> 2) + 4 * h)
#define ACC_COL(nt) (wn * 64 + (nt) * 32 + l31)
#define GEMM_IDS const int lane = threadIdx.x & 63, wave = (threadIdx.x & 255) >> 6, wm = wave >> 1, wn = wave & 1, l31 = lane & 31, h = lane >> 5; (void)wm; (void)wn; (void)l31; (void)h;

DI void phase_gemm_small(const bf16_t* A, int lda, const bf16_t* W, int N, int K, bf16_t* C, int ldc, char* lds) {
  GEMM_IDS
  const int sb = threadIdx.x >> 8;
  const int ntn = N / 128;
  const int total = NT_ * ntn;
  for (int t0 = blockIdx.x * 2; t0 < total; t0 += gridDim.x * 2) {
    const int t = t0 + sb;
    const int tm = t / ntn, tn = t - tm * ntn;
    f32x16 acc[2][2];
    gemm_tile(A + (size_t)tm * 128 * lda, lda, W + (size_t)tn * 128 * K, K, K, lds + sb * 36864, acc);
#pragma unroll
    for (int mt = 0; mt < 2; ++mt)
#pragma unroll
      for (int nt = 0; nt < 2; ++nt)
#pragma unroll
        for (int i = 0; i < 16; ++i) {
          int row = tm * 128 + ACC_ROW(mt, i), col = tn * 128 + ACC_COL(nt);
          C[(size_t)row * ldc + col] = f2bf(acc[mt][nt][i]);
        }
  }
}

namespace pg8 {
#define PG8_LAS __attribute__((address_space(3)))
typedef unsigned short bf16_t;
typedef short bf16x8 __attribute__((ext_vector_type(8)));
typedef float f32x4 __attribute__((ext_vector_type(4)));
typedef unsigned u32x4 __attribute__((ext_vector_type(4)));
constexpr int BM = 256, BK = 64, HALF = 128, HTB = HALF * BK * 2  , STAGE_BYTES = 8 * HTB, NXCD = 8, WGM = 8;

__host__ __device__ __forceinline__ int lds_byte(int r, int c) { const int st = (r >> 4) * 2 + (c >> 5), rr = r & 15, cc = c & 31, ob = rr * 64 + cc * 2; return st * 1024 + (ob ^ (((ob >> 9) & 1) << 5)); }
__host__ __device__ __forceinline__ void stage_rc(int b, int& R, int& C) { const int st = b / 1024, sb = b % 1024, swz = sb ^ (((sb >> 9) & 1) << 5); R = (st >> 1) * 16 + swz / 64; C = (st & 1) * 32 + (swz % 64) / 2; }
__host__ __device__ __forceinline__ int perm32(int rho) { const int n = rho >> 4, i = rho & 15; return 8 * (i >> 2) + 4 * n + (i & 3); }

struct Unit { int pm, pn; };
struct Gemm { const bf16_t* A; const bf16_t* Bt; int M, N, K; };

struct StaticOrder {
    int nM, nN, nwg, G, c;
    __host__ __device__ void init(int M, int N, int G_, int c_) { nM = M / BM; nN = N / BM; nwg = nM * nN; G = G_; c = c_; }
    __host__ __device__ bool next(int i, Unit& u) const {
        const long L = (long)i * G + c; if (L >= nwg) return false;
        int wgid = (int)L; { const int q = nwg / NXCD, r = nwg % NXCD, xcd = wgid % NXCD, off = wgid / NXCD; wgid = (xcd < r ? xcd * (q + 1) : r * (q + 1) + (xcd - r) * q) + off; }
        const int nig = WGM * nN, gid = wgid / nig, fm = gid * WGM, gsz = (nM - fm) < WGM ? (nM - fm) : WGM;
        u.pm = fm + ((wgid % nig) % gsz); u.pn = (wgid % nig) / gsz; return true;
    }
    __device__ __forceinline__ void a_ready(const Unit&) const {}
    __device__ __forceinline__ void done(const Unit&) const {}
};
__device__ __forceinline__ unsigned cvt_pk_bf16(float lo, float hi) { unsigned r; asm volatile("v_cvt_pk_bf16_f32 %0, %1, %2" : "=v"(r) : "v"(lo), "v"(hi)); return r; }

struct EpiRoute {
    static constexpr bool PERM = true, AFTER_DRAIN = false;
    bf16_t* O; int ldc; int route; bf16_t* pc; bf16_t* prkv; bf16_t* plow;
    __device__ __forceinline__ void operator()(const f32x4 (&acc)[2][2][4][2], const Unit& u, int wr, int wc, int fr, int fq) const {
        const int row0 = u.pm * BM + wr * 64 + fr;
#pragma unroll
        for (int bj = 0; bj < 2; ++bj) {
            int colh = u.pn * BM + bj * HALF; bf16_t* base = O; int ld = ldc;
            if (route) {
                if (colh < 768) { base = pc; ld = 768; }
                else if (colh < 2304) { base = prkv; ld = 1536; colh -= 768; }
                else if (colh < 2688) { base = plow; ld = 384; colh -= 2304; }
                else continue;
            }
            const int col0 = colh + wc * 32 + 8 * fq;
#pragma unroll
            for (int ai = 0; ai < 2; ++ai)
#pragma unroll
                for (int m = 0; m < 4; ++m) { bf16_t* rowp = base + (size_t)(row0 + ai * HALF + m * 16) * ld + col0;
                    const f32x4 v0 = acc[ai][bj][m][0], v1 = acc[ai][bj][m][1];
                    u32x4 w; w.x = cvt_pk_bf16(v0[0], v0[1]); w.y = cvt_pk_bf16(v0[2], v0[3]); w.z = cvt_pk_bf16(v1[0], v1[1]); w.w = cvt_pk_bf16(v1[2], v1[3]);
                    *(u32x4*)rowp = w; }
        }
    }
};
struct EpiGateUp {
    static constexpr bool PERM = true, AFTER_DRAIN = false;
    bf16_t* ACT;
    __device__ __forceinline__ void operator()(const f32x4 (&acc)[2][2][4][2], const Unit& u, int wr, int wc, int fr, int fq) const {
        const int row0 = u.pm * BM + wr * 64 + fr, col0 = u.pn * HALF + wc * 32 + 8 * fq;
#pragma unroll
        for (int ai = 0; ai < 2; ++ai)
#pragma unroll
            for (int m = 0; m < 4; ++m) { bf16_t* rowp = ACT + (size_t)(row0 + ai * HALF + m * 16) * 2816 + col0;
                float v[8];
#pragma unroll
                for (int n = 0; n < 2; ++n)
#pragma unroll
                    for (int j = 0; j < 4; ++j) { const float g = acc[ai][0][m][n][j], uu = acc[ai][1][m][n][j]; v[n * 4 + j] = g * __builtin_amdgcn_rcpf(1.f + __expf(-g)) * uu; }
                u32x4 w; w.x = cvt_pk_bf16(v[0], v[1]); w.y = cvt_pk_bf16(v[2], v[3]); w.z = cvt_pk_bf16(v[4], v[5]); w.w = cvt_pk_bf16(v[6], v[7]);
                *(u32x4*)rowp = w; }
    }
};
template <class Epi, class Sched, bool STAMP = false>
__device__ __forceinline__ void gemm_phase(PG8_LAS unsigned char* lds, const Gemm g, const Sched& S, const Epi& E, unsigned long long* stamps) {
    const int tid = threadIdx.x, wid = __builtin_amdgcn_readfirstlane(tid >> 6), lane = tid & 63, wr = wid >> 2, wc = wid & 3, fr = lane & 15, fq = lane >> 4;
    const int K = g.K, nt = K / BK;
    int ts_lo = 0, ts_hi = 0, nts = 0; const unsigned long long rt_entry = STAMP ? (unsigned long long)wall_clock64() : 0ull;
#define PG8_STAMP() do { if (STAMP && wid == 0 && nts < 64) { const unsigned long long _c = (unsigned long long)clock64(); \
        ts_lo = (lane == nts) ? (int)(unsigned)_c : ts_lo; ts_hi = (lane == nts) ? (int)(unsigned)(_c >> 32) : ts_hi; ++nts; } } while (0)
    PG8_STAMP();
    unsigned voffA[2], voffB[2];
#pragma unroll
    for (int i = 0; i < 2; ++i) { int R, C; stage_rc(tid * 16 + i * 8192, R, C); const int Rb = Epi::PERM ? ((R & ~31) + perm32(R & 31)) : R;
        voffA[i] = (unsigned)(R * K + C) * 2u; voffB[i] = (unsigned)(Rb * K + C) * 2u; }
    const size_t kstep = (size_t)(BK * 2);
    const size_t hstep = (size_t)HALF * K * 2;
    const size_t tstep = 2 * hstep;
    const unsigned ldsw = (unsigned)wid * 1024u;
    const int aoff = lds_byte(wr * 64 + fr, fq * 8), boff = lds_byte(wc * 32 + fr, fq * 8);
#define PG8_SA(b, h) (((b) * 2 + (h)) * HTB)
#define PG8_SB(b, h) ((4 + (b) * 2 + (h)) * HTB)
#define PG8_STAGE(bufoff, gbase, voff) do { _Pragma("unroll") for (int _i = 0; _i < 2; ++_i) \
        __builtin_amdgcn_global_load_lds((const unsigned*)((const char*)(gbase) + (voff)[_i]), (PG8_LAS unsigned*)(lds + (bufoff) + ldsw + _i * 8192), 16, 0, 0); } while (0)
#define PG8_LDA(dst, b, h) do { _Pragma("unroll") for (int m = 0; m < 4; ++m) _Pragma("unroll") for (int k = 0; k < 2; ++k) dst[m][k] = *(const PG8_LAS bf16x8*)(lds + PG8_SA(b, h) + aoff + m * 2048 + k * 1024); } while (0)
#define PG8_LDB(dst, b, h) do { _Pragma("unroll") for (int n = 0; n < 2; ++n) _Pragma("unroll") for (int k = 0; k < 2; ++k) dst[n][k] = *(const PG8_LAS bf16x8*)(lds + PG8_SB(b, h) + boff + n * 2048 + k * 1024); } while (0)
#define PG8_MMA(ai, bj, At, Bt) do { __builtin_amdgcn_s_setprio(1); _Pragma("unroll") for (int m = 0; m < 4; ++m) _Pragma("unroll") for (int n = 0; n < 2; ++n) _Pragma("unroll") for (int k = 0; k < 2; ++k) \
        acc[ai][bj][m][n] = __builtin_amdgcn_mfma_f32_16x16x32_bf16(Bt[n][k], At[m][k], acc[ai][bj][m][n], 0, 0, 0); __builtin_amdgcn_s_setprio(0); } while (0)
#define PG8_WAIT_V(n) asm volatile("s_waitcnt vmcnt(" #n ")" ::: "memory")
#define PG8_WAIT_L(n) asm volatile("s_waitcnt lgkmcnt(" #n ")" ::: "memory")
#define PG8_BAR __builtin_amdgcn_s_barrier()
#define PG8_SCHED __builtin_amdgcn_sched_barrier(0)
    Unit cur, nxt; int ui = 0;
    if (!S.next(0, cur)) return;
    f32x4 acc[2][2][4][2];
#pragma unroll
    for (int a = 0; a < 2; ++a)
#pragma unroll
        for (int b = 0; b < 2; ++b)
#pragma unroll
            for (int m = 0; m < 4; ++m)
#pragma unroll
                for (int n = 0; n < 2; ++n) acc[a][b][m][n] = (f32x4){0.f, 0.f, 0.f, 0.f};
    bf16x8 At[4][2], B0[2][2], B1[2][2];
    const char* cA = (const char*)g.A + (size_t)cur.pm * tstep; const char* cB = (const char*)g.Bt + (size_t)cur.pn * tstep;
    S.a_ready(cur);
    PG8_STAGE(PG8_SB(0, 0), cB, voffB); PG8_STAGE(PG8_SA(0, 0), cA, voffA); PG8_STAGE(PG8_SB(0, 1), cB + hstep, voffB); PG8_STAGE(PG8_SA(0, 1), cA + hstep, voffA);
    if (wr == 1) PG8_BAR;
    PG8_WAIT_V(4); PG8_BAR;
    PG8_STAGE(PG8_SB(1, 0), cB + kstep, voffB); PG8_STAGE(PG8_SA(1, 0), cA + kstep, voffA); PG8_STAGE(PG8_SB(1, 1), cB + hstep + kstep, voffB);
    PG8_WAIT_V(6); PG8_BAR;
    PG8_STAMP();
    for (;;) {
        const bool has_next = S.next(ui + 1, nxt);
        const char* nA = has_next ? (const char*)g.A + (size_t)nxt.pm * tstep : cA; const char* nB = has_next ? (const char*)g.Bt + (size_t)nxt.pn * tstep : cB;
        for (int t = 0; t < nt; t += 2) {
            const bool last = (t == nt - 2);
            const char* a1 = cA + (size_t)(t + 1) * kstep;
            const char* a2 = last ? nA : cA + (size_t)(t + 2) * kstep; const char* b2 = last ? nB : cB + (size_t)(t + 2) * kstep;
            const char* a3 = a2 + kstep; const char* b3 = b2 + kstep;
            if (last && has_next) S.a_ready(nxt);
            PG8_LDB(B0, 0, 0); PG8_SCHED; PG8_LDA(At, 0, 0); PG8_STAGE(PG8_SA(1, 1), a1 + hstep, voffA);
            PG8_WAIT_L(8); PG8_BAR; PG8_WAIT_L(0); PG8_MMA(0, 0, At, B0); PG8_BAR; PG8_SCHED;
            PG8_LDB(B1, 0, 1); PG8_STAGE(PG8_SB(0, 0), b2, voffB);
            PG8_BAR; PG8_WAIT_L(0); PG8_MMA(0, 1, At, B1); PG8_BAR;
            PG8_LDA(At, 0, 1); PG8_STAGE(PG8_SA(0, 0), a2, voffA);
            PG8_BAR; PG8_WAIT_L(0); PG8_MMA(1, 0, At, B0); PG8_BAR; PG8_SCHED;
            PG8_STAGE(PG8_SB(0, 1), b2 + hstep, voffB);
            PG8_WAIT_V(6); PG8_BAR; PG8_MMA(1, 1, At, B1); PG8_BAR;
            PG8_LDB(B0, 1, 0); PG8_SCHED; PG8_LDA(At, 1, 0); PG8_STAGE(PG8_SA(0, 1), a2 + hstep, voffA);
            PG8_WAIT_L(8); PG8_BAR; PG8_WAIT_L(0); PG8_MMA(0, 0, At, B0); PG8_BAR; PG8_SCHED;
            PG8_LDB(B1, 1, 1); PG8_STAGE(PG8_SB(1, 0), b3, voffB);
            PG8_BAR; PG8_WAIT_L(0); PG8_MMA(0, 1, At, B1); PG8_BAR;
            PG8_LDA(At, 1, 1); PG8_STAGE(PG8_SA(1, 0), a3, voffA);
            PG8_BAR; PG8_WAIT_L(0); PG8_MMA(1, 0, At, B0); PG8_BAR; PG8_SCHED;
            PG8_STAGE(PG8_SB(1, 1), b3 + hstep, voffB);
            PG8_WAIT_V(6); PG8_BAR; PG8_MMA(1, 1, At, B1); PG8_BAR;
        }
        PG8_STAMP();
        if constexpr (!Epi::AFTER_DRAIN) { E(acc, cur, wr, wc, fr, fq); S.done(cur); }
        PG8_STAMP();
        if (!has_next) break;
#pragma unroll
        for (int a = 0; a < 2; ++a)
#pragma unroll
            for (int b = 0; b < 2; ++b)
#pragma unroll
                for (int m = 0; m < 4; ++m)
#pragma unroll
                    for (int n = 0; n < 2; ++n) acc[a][b][m][n] = (f32x4){0.f, 0.f, 0.f, 0.f};
        cur = nxt; cA = nA; cB = nB; ++ui;
    }
    PG8_WAIT_V(0);
    if (wr == 0) PG8_BAR;
    PG8_BAR;
    if constexpr (Epi::AFTER_DRAIN) { E.fused(acc, cur, wr, wc, fr, fq, lds, wid, lane); S.done(cur); }
    PG8_STAMP();
    if (STAMP && wid == 0) { stamps[lane] = lane < nts ? (((unsigned long long)(unsigned)ts_hi << 32) | (unsigned)ts_lo) : 0ull;
        if (lane == 62) stamps[62] = rt_entry; if (lane == 63) stamps[63] = (unsigned long long)wall_clock64(); }
#undef PG8_STAMP
#undef PG8_SA
#undef PG8_SB
#undef PG8_STAGE
#undef PG8_LDA
#undef PG8_LDB
#undef PG8_MMA
#undef PG8_WAIT_V
#undef PG8_WAIT_L
#undef PG8_BAR
#undef PG8_SCHED
}
}

DI void phase_gemm_big(const bf16_t* A, const bf16_t* W, int N, int K, bf16_t* C, int ldc, int route, char* ws, unsigned char* lds) {
  pg8::Gemm g{A, W, TP_, N, K};
  pg8::StaticOrder S; S.init(TP_, N, gridDim.x, blockIdx.x);
  pg8::EpiRoute E{C, ldc, route, (bf16_t*)(ws + O_PC), (bf16_t*)(ws + O_PRKV), (bf16_t*)(ws + O_PLOW)};
  pg8::gemm_phase<pg8::EpiRoute, pg8::StaticOrder, false>((PG8_LAS unsigned char*)lds, g, S, E, nullptr);
}
DI void phase_gemm_gateup(const bf16_t* A, const bf16_t* W, bf16_t* ACT, unsigned char* lds) {
  pg8::Gemm g{A, W, TP_, 5632, 1024};
  pg8::StaticOrder S; S.init(TP_, 5632, gridDim.x, blockIdx.x);
  pg8::EpiGateUp E{ACT};
  pg8::gemm_phase<pg8::EpiGateUp, pg8::StaticOrder, false>((PG8_LAS unsigned char*)lds, g, S, E, nullptr);
}

DI void phase_resnorm(const P& p, const float* g1, const float* g2) {
  const int lane = threadIdx.x & 63, gw = (blockIdx.x * NTH + threadIdx.x) >> 6, nw = (gridDim.x * NTH) >> 6;
  bf16_t* HN = (bf16_t*)(p.ws + O_HN);
  for (int sr = gw; sr < T_; sr += nw) {
    float* hr = hrow(p, sr);
    float x[16];
    float ss = 0.f;
#pragma unroll
    for (int q = 0; q < 4; ++q) {
      const uint2 u = *(const uint2*)(HN + (size_t)sr * 1024 + q * 256 + lane * 4);
      x[q * 4] = lo2f(u.x); x[q * 4 + 1] = hi2f(u.x); x[q * 4 + 2] = lo2f(u.y); x[q * 4 + 3] = hi2f(u.y);
      ss += x[q * 4] * x[q * 4] + x[q * 4 + 1] * x[q * 4 + 1] + x[q * 4 + 2] * x[q * 4 + 2] + x[q * 4 + 3] * x[q * 4 + 3];
    }
    f32x4v hh[4];
#pragma unroll
    for (int q = 0; q < 4; ++q) hh[q] = *(const f32x4v*)(hr + q * 256 + lane * 4);
    ss = wave_sum(ss);
    const float rs = rsqrtf(ss * (1.f / 1024.f) + EPS);
    float ss2 = 0.f;
#pragma unroll
    for (int q = 0; q < 4; ++q) {
      const float4 g = *(const float4*)(g1 + q * 256 + lane * 4);
      hh[q].x += x[q * 4 + 0] * rs * g.x; hh[q].y += x[q * 4 + 1] * rs * g.y; hh[q].z += x[q * 4 + 2] * rs * g.z; hh[q].w += x[q * 4 + 3] * rs * g.w;
      *(f32x4v*)(hr + q * 256 + lane * 4) = hh[q];
      ss2 += hh[q].x * hh[q].x + hh[q].y * hh[q].y + hh[q].z * hh[q].z + hh[q].w * hh[q].w;
    }
    if (g2) {
      ss2 = wave_sum(ss2);
      const float rs2 = rsqrtf(ss2 * (1.f / 1024.f) + EPS);
#pragma unroll
      for (int q = 0; q < 4; ++q) {
        const float4 g = *(const float4*)(g2 + q * 256 + lane * 4);
        *(uint2*)(HN + (size_t)sr * 1024 + q * 256 + lane * 4) = make_uint2(pack2(hh[q].x * rs2 * g.x, hh[q].y * rs2 * g.y), pack2(hh[q].z * rs2 * g.z, hh[q].w * rs2 * g.w));
      }
    }
  }
}

DI size_t vta_base(int seq) { return seq < 8 ? (size_t)seq * 256 * 4160 : (size_t)8 * 256 * 4160; }
template <int NC> DI void vt_transpose(const bf16_t* src, int ld, int col0, bf16_t* VT, char* lds) {
  bf16_t* tl = (bf16_t*)lds;
  const int tid = threadIdx.x;
  constexpr int CPT = NC / 8, TPR = 512 / NC, PPT = 64 / TPR;
  for (int it = blockIdx.x; it < 257 + 8 * 65; it += gridDim.x) {
    int seq, kt;
    if (it < 257) { seq = 8; kt = it; } else { const int j = it - 257; seq = j / 65; kt = j - seq * 65; }
    const int L = seq_len(seq), LP = L + 48, sbase = seq_base(seq);
    const size_t vb = (seq < 8 ? (size_t)seq * NC * 4160 : (size_t)8 * NC * 4160);
    __syncthreads();
    const int pl = tid >> 3, part = tid & 7;
    const int pos = 64 * kt + pl - 48;
#pragma unroll
    for (int q = 0; q < CPT / 8; ++q) {
      u32x4 v = (u32x4)(0u);
      if (pos >= 0) v = *(const u32x4*)(src + (size_t)(sbase + pos) * ld + col0 + part * CPT + q * 8);
#pragma unroll
      for (int j = 0; j < 4; ++j) {
        tl[(part * CPT + q * 8 + 2 * j) * 72 + pl] = (bf16_t)(v[j] & 0xffffu);
        tl[(part * CPT + q * 8 + 2 * j + 1) * 72 + pl] = (bf16_t)(v[j] >> 16);
      }
    }
    __syncthreads();
    const int row = tid / TPR, seg = tid % TPR;
    bf16_t* dst = VT + vb + (size_t)row * LP + 64 * kt + seg * PPT;
#pragma unroll
    for (int q = 0; q < PPT / 8; ++q) *(u32x4*)(dst + q * 8) = *(const u32x4*)(tl + row * 72 + seg * PPT + q * 8);
  }
}

DI void phase_prepA(const P& p, char* lds) {
  const int lane = threadIdx.x & 63, wave = threadIdx.x >> 6;
  bf16_t* PROJ = (bf16_t*)(p.ws + O_PROJ0);
  bf16_t* ZB = (bf16_t*)(p.ws + O_ZB);
  const float* WC = (const float*)(p.ws + O_WC);
  vt_transpose<256>(PROJ, 1536, 1024, (bf16_t*)(p.ws + O_VTA), lds);
  __syncthreads();
  float* fl = (float*)lds + wave * 1024;
  const float inv = exp2f(-(float)(lane & 15) * (13.287712379549449f / 16.f));
  const float qg = p.a_q_gain[lane], kg = p.a_k_gain[lane];
  for (int r0 = blockIdx.x * 32; r0 < TP_; r0 += gridDim.x * 32) {
    const int srb = r0 + wave * 4;
#pragma unroll 1
    for (int rr = 0; rr < 4; ++rr) {
      const int sr = srb + rr;
      if (sr < T_) {
        int pos; seq_of(sr, pos);
        float rowf, colf;
        if (pos < 16) { rowf = colf = (float)(pos - 16); }
        else { int t = pos - 16; rowf = (float)(t >> 6); colf = (float)(t & 63); }
        float ang = (lane < 32 ? rowf : colf) * inv;
        float sn, cs;
        sincosf(ang, &sn, &cs);
        const float sgn = (lane & 16) ? sn : -sn;
        bf16_t* pr = PROJ + (size_t)sr * 1536;
        for (int hd = 0; hd < 16; ++hd) {
          float x = bf2f(pr[hd * 64 + lane]);
          float ss = wave_sum(x * x);
          float xn = x * rsqrtf(ss * (1.f / 64.f) + EPS) * (hd < 12 ? qg : kg);
          float pa = __shfl_xor(xn, 16);
          float o = xn * cs + pa * sgn;
          if (hd < 12) o *= 0.125f * LOG2E;
          pr[hd * 64 + lane] = f2bf(o);
        }
        uint2 u = *(const uint2*)(pr + 1280 + lane * 4);
        float f0 = lo2f(u.x), f1 = hi2f(u.x), f2 = lo2f(u.y), f3 = hi2f(u.y);
        float ss = f0 * f0 + f1 * f1 + f2 * f2 + f3 * f3;
        ss += __shfl_xor(ss, 1); ss += __shfl_xor(ss, 2); ss += __shfl_xor(ss, 4); ss += __shfl_xor(ss, 8);
        float rs = rsqrtf(ss * (1.f / 64.f) + EPS);
        float4 g = *(const float4*)(p.b_norm_g + lane * 4);
        *(float4*)(fl + rr * 256 + lane * 4) = make_float4(f0 * rs * g.x, f1 * rs * g.y, f2 * rs * g.z, f3 * rs * g.w);
      } else {
        *(float4*)(fl + rr * 256 + lane * 4) = make_float4(0.f, 0.f, 0.f, 0.f);
      }
    }
    __syncthreads();
    {
      const int g = lane >> 4, o0 = (lane & 15) * 8;
      float acc[4][8];
#pragma unroll
      for (int rr = 0; rr < 4; ++rr)
#pragma unroll
        for (int j = 0; j < 8; ++j) acc[rr][j] = 0.f;
      const float* wc = WC + (size_t)g * 64 * 128 + o0;
#pragma unroll 4
      for (int c = 0; c < 64; ++c) {
        const float4 w0 = *(const float4*)(wc + c * 128), w1 = *(const float4*)(wc + c * 128 + 4);
#pragma unroll
        for (int rr = 0; rr < 4; ++rr) {
          const float f = fl[rr * 256 + g * 64 + c];
          acc[rr][0] += f * w0.x; acc[rr][1] += f * w0.y; acc[rr][2] += f * w0.z; acc[rr][3] += f * w0.w;
          acc[rr][4] += f * w1.x; acc[rr][5] += f * w1.y; acc[rr][6] += f * w1.z; acc[rr][7] += f * w1.w;
        }
      }
#pragma unroll
      for (int rr = 0; rr < 4; ++rr)
        if (srb + rr < T_)
          *(uint4*)(ZB + (size_t)(srb + rr) * 512 + g * 128 + o0) = make_uint4(pack2(acc[rr][0], acc[rr][1]), pack2(acc[rr][2], acc[rr][3]), pack2(acc[rr][4], acc[rr][5]), pack2(acc[rr][6], acc[rr][7]));
    }
    __syncthreads();
  }
}

template <int MODE>
DI void flash_item(const bf16_t* __restrict__ Q, int ldq, const bf16_t* __restrict__ Kb, int ldk, const bf16_t* __restrict__ Vt, int LP,
                   bf16_t* O, int ldo, int sbase, int S, int qt, float sinkl2, char* lds) {
  const int tid = threadIdx.x & 255, lane = tid & 63, wave = tid >> 6, l31 = lane & 31, h = lane >> 5;
  bf16_t* Ks = (bf16_t*)lds;
  bf16_t* Vs = Ks + 2 * 64 * 72;
  const int rl = wave * 32 + l31;
  const int qpos = qt == 0 ? (rl < 16 ? rl : 15) : 16 + 128 * (qt - 1) + rl;
  const bool qvalid = qt > 0 || rl < 16;
  bf16x8 qf[4];
  {
    const bf16_t* qr = Q + (size_t)(sbase + qpos) * ldq;
#pragma unroll
    for (int s = 0; s < 4; ++s) qf[s] = *(const bf16x8*)(qr + 16 * s + 8 * h);
  }
  const int nkt_all = (S + 64) / 64;
  int klo = 1, n;
  if (MODE == 0) { n = nkt_all; }
  else {
    if (qt == 0) { klo = 1; n = 3; }
    else {
      int c = qt - 1;
      klo = 2 * c - 1; if (klo < 1) klo = 1;
      int khi = 2 * c + 4; if (khi > nkt_all - 1) khi = nkt_all - 1;
      n = 1 + (khi - klo + 1);
    }
  }
  const int ldr = tid >> 2, ldp = (tid & 3) * 16;
  u32x4 rk0, rk1, rv0, rv1;
  auto ktile = [&](int idx) { return idx == 0 ? 0 : klo + idx - 1; };
#define FL_GLOAD(idx)                                                                               \
  {                                                                                                 \
    int kt_ = ktile(idx);                                                                           \
    int pos_ = 64 * kt_ + ldr - 48;                                                                 \
    if (pos_ >= 0) {                                                                                \
      const bf16_t* kp_ = Kb + (size_t)(sbase + pos_) * ldk + ldp;                                  \
      rk0 = *(const u32x4*)kp_; rk1 = *(const u32x4*)(kp_ + 8);                                 \
    } else { rk0 = (u32x4)(0u); rk1 = rk0; }                                       \
    const bf16_t* vp_ = Vt + (size_t)ldr * LP + 64 * kt_ + ldp;                                     \
    rv0 = *(const u32x4*)vp_; rv1 = *(const u32x4*)(vp_ + 8);                                   \
  }
#define FL_SSTORE(buf)                                                                              \
  {                                                                                                 \
    *(u32x4*)(Ks + (buf) * 64 * 72 + ldr * 72 + ldp) = rk0; *(u32x4*)(Ks + (buf) * 64 * 72 + ldr * 72 + ldp + 8) = rk1; \
    { bf16_t* vd_ = Vs + (buf) * 64 * 68 + ldr * 68 + ldp; *(uint2*)vd_ = make_uint2(rv0.x, rv0.y); *(uint2*)(vd_ + 4) = make_uint2(rv0.z, rv0.w); *(uint2*)(vd_ + 8) = make_uint2(rv1.x, rv1.y); *(uint2*)(vd_ + 12) = make_uint2(rv1.z, rv1.w); } \
  }
  f32x16 oacc[2];
#pragma unroll
  for (int i = 0; i < 16; ++i) { oacc[0][i] = 0.f; oacc[1][i] = 0.f; }
  float m = -1e30f, l = 0.f;
  FL_GLOAD(0)
  FL_SSTORE(0)
  __syncthreads();
  for (int idx = 0; idx < n; ++idx) {
    const int cur = idx & 1;
    if (idx + 1 < n) FL_GLOAD(idx + 1)
    const int kt = ktile(idx);
    const bf16_t* ks = Ks + cur * 64 * 72;
    const bf16_t* vs = Vs + cur * 64 * 68;
    f32x16 sacc[2];
#pragma unroll
    for (int t = 0; t < 2; ++t) {
#pragma unroll
      for (int i = 0; i < 16; ++i) sacc[t][i] = 0.f;
#pragma unroll
      for (int s = 0; s < 4; ++s) {
        bf16x8 kf = *(const bf16x8*)(ks + (32 * t + l31) * 72 + 16 * s + 8 * h);
        sacc[t] = MFMA32(kf, qf[s], sacc[t]);
      }
    }
    if (kt == 0) {
#pragma unroll
      for (int t = 0; t < 2; ++t)
#pragma unroll
        for (int i = 0; i < 16; ++i) {
          int kl = 32 * t + (i & 3) + 8 * (i >> 2) + 4 * h;
          if (kl < 48) sacc[t][i] = -1e30f;
        }
    } else if (MODE == 1) {
#pragma unroll
      for (int t = 0; t < 2; ++t)
#pragma unroll
        for (int i = 0; i < 16; ++i) {
          int kl = 32 * t + (i & 3) + 8 * (i >> 2) + 4 * h;
          int tk = 64 * (kt - 1) + kl;
          bool vis;
          if (qt == 0) vis = tk <= 112 + qpos;
          else { int tq = qpos - 16; int d = tq - tk; vis = d <= 128 && d >= -128; }
          if (!vis) sacc[t][i] = -1e30f;
        }
    }
    float tmax = -1e30f;
#pragma unroll
    for (int t = 0; t < 2; ++t)
#pragma unroll
      for (int i = 0; i < 16; ++i) tmax = fmaxf(tmax, sacc[t][i]);
    tmax = fmaxf(tmax, __shfl_xor(tmax, 32));
    if (__builtin_amdgcn_ballot_w64(tmax > m) != 0ull) {
      const float mn = fmaxf(m, tmax);
      const float alpha = __builtin_amdgcn_exp2f(m - mn);
      m = mn;
      l *= alpha;
#pragma unroll
      for (int i = 0; i < 16; ++i) { oacc[0][i] *= alpha; oacc[1][i] *= alpha; }
    }
    const f32x2 m2 = {m, m};
    f32x2 ls2 = {0.f, 0.f};
    unsigned pk[2][8];
#pragma unroll
    for (int t = 0; t < 2; ++t)
#pragma unroll
      for (int i2 = 0; i2 < 8; ++i2) {
        f32x2 d = {sacc[t][2 * i2], sacc[t][2 * i2 + 1]};
        d = d - m2;
        f32x2 e = {__builtin_amdgcn_exp2f(d.x), __builtin_amdgcn_exp2f(d.y)};
        ls2 += e;
        pk[t][i2] = __builtin_bit_cast(unsigned, __builtin_convertvector(e, bf16x2_t));
      }
    l += ls2.x + ls2.y;
#pragma unroll
    for (int t = 0; t < 2; ++t)
#pragma unroll
      for (int s2 = 0; s2 < 2; ++s2) {
        u32x4 pk4 = {pk[t][4 * s2], pk[t][4 * s2 + 1], pk[t][4 * s2 + 2], pk[t][4 * s2 + 3]};
        bf16x8 pf = __builtin_bit_cast(bf16x8, pk4);
#pragma unroll
        for (int dt = 0; dt < 2; ++dt) {
          const bf16_t* vp = vs + (32 * dt + l31) * 68 + 32 * t + 16 * s2 + 4 * h;
          uint2 lo = *(const uint2*)vp, hi = *(const uint2*)(vp + 8);
          u32x4 v4 = {lo.x, lo.y, hi.x, hi.y};
          bf16x8 vf = __builtin_bit_cast(bf16x8, v4);
          oacc[dt] = MFMA32(vf, pf, oacc[dt]);
        }
      }
    if (idx + 1 < n) FL_SSTORE(cur ^ 1)
    __syncthreads();
  }
  l += __shfl_xor(l, 32);
  if (MODE == 1) l += __builtin_amdgcn_exp2f(sinkl2 - m);
  const float il = 1.f / l;
  if (qvalid) {
    bf16_t* orow = O + (size_t)(sbase + qpos) * ldo;
#pragma unroll
    for (int dt = 0; dt < 2; ++dt)
#pragma unroll
      for (int g = 0; g < 4; ++g) {
        int d = 32 * dt + 8 * g + 4 * h;
        uint2 o = make_uint2(pack2(oacc[dt][4 * g] * il, oacc[dt][4 * g + 1] * il), pack2(oacc[dt][4 * g + 2] * il, oacc[dt][4 * g + 3] * il));
        *(uint2*)(orow + d) = o;
      }
  }
#undef FL_GLOAD
#undef FL_SSTORE
}

DI size_t y_base(int seq) { return seq < 8 ? (size_t)seq * 16 * 256 * 576 : (size_t)8 * 16 * 256 * 576; }
DI void phase_attnA(const P& p, char* lds) {
  const bf16_t* PROJ = (const bf16_t*)(p.ws + O_PROJ0);
  const bf16_t* VT = (const bf16_t*)(p.ws + O_VTA);
  bf16_t* MIX = (bf16_t*)(p.ws + O_MIX);
  const int nS = 129 * 6, nP = 8 * 33 * 6;
  const int sb = threadIdx.x >> 8;
  unsigned* head = (unsigned*)(p.ws + O_CNT);
  for (;;) {
    if (threadIdx.x == 0) *(volatile int*)(lds + 2 * 36864) = (int)__hip_atomic_fetch_add(head, 1u, __ATOMIC_RELAXED, __HIP_MEMORY_SCOPE_AGENT);
    __syncthreads();
    const int it = *(volatile int*)(lds + 2 * 36864);
    __syncthreads();
    if (it >= nS + nP) break;
    int seq, qt, hq;
    if (it < nS) { seq = 8; hq = (it % 6) * 2 + sb; qt = it / 6; }
    else { int j = it - nS; hq = (j % 6) * 2 + sb; j /= 6; qt = j % 33; seq = j / 33; }
    const int kv = hq / 3;
    const int L = seq_len(seq), LP = L + 48;
    flash_item<0>(PROJ + hq * 64, 1536, PROJ + 768 + kv * 64, 1536, VT + vta_base(seq) + (size_t)kv * 64 * LP, LP,
                  MIX + hq * 64, 1024, seq_base(seq), L - 16, qt, 0.f, lds + sb * 36864);
  }
  const bf16_t* ZB = (const bf16_t*)(p.ws + O_ZB);
  bf16_t* Y = (bf16_t*)(p.ws + O_Y);
  const int lane = threadIdx.x & 63, wave = threadIdx.x >> 6;
  const int nI_S = 17 * 16, nI_P = 8 * 5 * 16;
  for (int it = blockIdx.x; it < nI_S + nI_P; it += gridDim.x) {
    int seq, nb, cb;
    if (it < nI_S) { seq = 8; cb = it & 15; nb = it >> 4; }
    else { int j = it - nI_S; cb = j & 15; j >>= 4; nb = j % 5; seq = j / 5; }
    const int M = seq < 8 ? 257 : 1025, KP = seq < 8 ? 576 : 2112, L = 16 * M;
    const int n2 = nb * 64 + lane;
    const int ch = cb * 16 + wave * 2;
    const int g = ch >> 6, d = ch & 63;
    bf16_t* yb = Y + y_base(seq);
    if (n2 < M) {
      float zr[16][2], zi[16][2];
#pragma unroll
      for (int n1 = 0; n1 < 16; ++n1) {
        const bf16_t* zp = ZB + (size_t)(seq_base(seq) + M * n1 + n2) * 512 + g * 128 + d;
        unsigned re = *(const unsigned*)zp, im = *(const unsigned*)(zp + 64);
        zr[n1][0] = lo2f(re); zr[n1][1] = hi2f(re); zi[n1][0] = lo2f(im); zi[n1][1] = hi2f(im);
      }
      for (int k1 = 0; k1 < 16; ++k1) {
        float ws_, wc_;
        sincospif(-(float)k1 / 8.f, &ws_, &wc_);
        float ar0 = zr[15][0], ai0 = zi[15][0], ar1 = zr[15][1], ai1 = zi[15][1];
#pragma unroll
        for (int n1 = 14; n1 >= 0; --n1) {
          float t0 = ar0 * wc_ - ai0 * ws_ + zr[n1][0]; ai0 = ar0 * ws_ + ai0 * wc_ + zi[n1][0]; ar0 = t0;
          float t1 = ar1 * wc_ - ai1 * ws_ + zr[n1][1]; ai1 = ar1 * ws_ + ai1 * wc_ + zi[n1][1]; ar1 = t1;
        }
        float ts, tc;
        sincospif(-2.f * (float)(k1 * n2) / (float)L, &ts, &tc);
        float yr0 = ar0 * tc - ai0 * ts, yi0 = ar0 * ts + ai0 * tc;
        float yr1 = ar1 * tc - ai1 * ts, yi1 = ar1 * ts + ai1 * tc;
        bf16_t* y0 = yb + ((size_t)k1 * 256 + ch) * KP;
        y0[n2] = f2bf(yr0); y0[M + n2] = f2bf(yi0);
        y0[KP + n2] = f2bf(yr1); y0[KP + M + n2] = f2bf(yi1);
      }
    } else if (n2 < KP - M) {
      for (int k1 = 0; k1 < 16; ++k1) {
        bf16_t* y0 = yb + ((size_t)k1 * 256 + ch) * KP;
        y0[M + n2] = 0; y0[KP + M + n2] = 0;
      }
    }
  }
}

DI void phase_fnet_gemm(const P& p, char* lds) {
  GEMM_IDS
  bf16_t* MIX = (bf16_t*)(p.ws + O_MIX);
  const bf16_t* Y = (const bf16_t*)(p.ws + O_Y);
  const int nS = 16 * 9 * 2, nP = 8 * 16 * 3 * 2;
  const int sb = threadIdx.x >> 8;
  for (int it0 = blockIdx.x * 2; it0 < nS + nP; it0 += gridDim.x * 2) {
    const int it = it0 + sb;
    int seq, k1, tm, tn;
    if (it < nS) { seq = 8; tn = it & 1; int j = it >> 1; tm = j % 9; k1 = j / 9; }
    else { int j = it - nS; tn = j & 1; j >>= 1; tm = j % 3; j /= 3; k1 = j & 15; seq = j >> 4; }
    const int M = seq < 8 ? 257 : 1025, KP = seq < 8 ? 576 : 2112, L = 16 * M;
    const bf16_t* dm = (const bf16_t*)(p.ws + (seq < 8 ? O_DM257 : O_DM1025));
    f32x16 acc[2][2];
    gemm_tile(dm + (size_t)tm * 128 * KP, KP, Y + y_base(seq) + ((size_t)k1 * 256 + tn * 128) * KP, KP, KP, lds + sb * 36864, acc);
    const float scale = rsqrtf(64.f * (float)L);
#pragma unroll
    for (int mt = 0; mt < 2; ++mt)
#pragma unroll
      for (int nt = 0; nt < 2; ++nt)
#pragma unroll
        for (int i = 0; i < 16; ++i) {
          int k2 = tm * 128 + ACC_ROW(mt, i), ch = tn * 128 + ACC_COL(nt);
          if (k2 < M) {
            int pos = k1 + 16 * k2;
            MIX[(size_t)(seq_base(seq) + pos) * 1024 + 768 + ch] = f2bf(acc[mt][nt][i] * scale + p.b_b[ch]);
          }
        }
  }
}

DI size_t vtc_base(int seq) { return seq < 8 ? (size_t)seq * 128 * 4160 : (size_t)8 * 128 * 4160; }
DI void phase_prepC(const P& p, char* lds) {
  const int gtid = blockIdx.x * NTH + threadIdx.x, gsz = gridDim.x * NTH;
  const int lane = threadIdx.x & 63, gw = gtid >> 6, nw = gsz >> 6;
  bf16_t* PC = (bf16_t*)(p.ws + O_PC);
  bf16_t* VT = (bf16_t*)(p.ws + O_VTC);
  const bf16_t* PLOW = (const bf16_t*)(p.ws + O_PLOW);
  bf16_t* LR = (bf16_t*)(p.ws + O_LR);
  vt_transpose<128>(PC, 768, 640, VT, lds);
  for (int sr = gw; sr < T_; sr += nw) {
    int pos; int b = seq_of(sr, pos);
    const int L = seq_len(b), LP = L + 48;
    bf16_t* pr = PC + (size_t)sr * 768;
    float cs[8], sn[8];
#pragma unroll
    for (int j = 0; j < 8; ++j) sincosf((float)pos * exp2f(-(float)j * (18.931568569324174f / 8.f)), &sn[j], &cs[j]);
#pragma unroll
    for (int part = 0; part < 2; ++part) {
      const bool act = part == 0 || lane < 16;
      const int col = part * 512 + (act ? lane : 0) * 8;
      uint4 u = *(const uint4*)(pr + col);
      float e[8] = {lo2f(u.x), hi2f(u.x), lo2f(u.y), hi2f(u.y), lo2f(u.z), hi2f(u.z), lo2f(u.w), hi2f(u.w)};
      float o[8];
#pragma unroll
      for (int j = 0; j < 8; ++j) {
        float pa = __shfl_xor(e[j], 1);
        float rot = e[j] * cs[j] + pa * ((lane & 1) ? sn[j] : -sn[j]);
        o[j] = (lane & 7) < 2 ? rot : e[j];
        if (part == 0) o[j] *= 0.125f * LOG2E;
      }
      if (act) *(uint4*)(pr + col) = make_uint4(pack2(o[0], o[1]), pack2(o[2], o[3]), pack2(o[4], o[5]), pack2(o[6], o[7]));
    }
#pragma unroll
    for (int q = 0; q < 6; ++q) {
      int c = q * 64 + lane;
      float u = bf2f(PLOW[(size_t)sr * 384 + c]);
      float up = pos > 0 ? bf2f(PLOW[(size_t)(sr - 1) * 384 + c]) : 0.f;
      float un = pos < L - 1 ? bf2f(PLOW[(size_t)(sr + 1) * 384 + c]) : 0.f;
      float us = u + p.mu_prev[1536 + c] * (up - u) + p.mu_next[1536 + c] * (un - u);
      float v = c < 128 ? tanhf(us) : (c < 256 ? us : sigmoidf_(us));
      LR[(size_t)sr * 384 + c] = f2bf(v);
    }
  }
}

DI void phase_attnC(const P& p, char* lds) {
  const bf16_t* PC = (const bf16_t*)(p.ws + O_PC);
  const bf16_t* VT = (const bf16_t*)(p.ws + O_VTC);
  bf16_t* MIX = (bf16_t*)(p.ws + O_MIX);
  const int nS = 129 * 4, nP = 8 * 33 * 4;
  const int sb = threadIdx.x >> 8;
  for (int it = blockIdx.x; it < nS + nP; it += gridDim.x) {
    int seq, qt, hq;
    if (it < nS) { seq = 8; hq = (it & 3) * 2 + sb; qt = it >> 2; }
    else { int j = it - nS; hq = (j & 3) * 2 + sb; j >>= 2; qt = j % 33; seq = j / 33; }
    const int kv = hq >> 2;
    const int L = seq_len(seq), LP = L + 48;
    flash_item<1>(PC + hq * 64, 768, PC + 512 + kv * 64, 768, VT + vtc_base(seq) + (size_t)kv * 64 * LP, LP,
                  MIX + hq * 64, 1024, seq_base(seq), L - 16, qt, p.c_sink[hq] * LOG2E, lds + sb * 36864);
  }
}

DI void chunk_decode(int cg_, int& seq, int& c) {
  if (cg_ < 136) { seq = cg_ / 17; c = cg_ - seq * 17; } else { seq = 8; c = cg_ - 136; }
}
DI float shiftv(const bf16_t* PRKV, int sr, int pos, int L, int col, float mp, float mn) {
  float u = bf2f(PRKV[(size_t)sr * 1536 + col]);
  float up = pos > 0 ? bf2f(PRKV[(size_t)(sr - 1) * 1536 + col]) : 0.f;
  float un = pos < L - 1 ? bf2f(PRKV[(size_t)(sr + 1) * 1536 + col]) : 0.f;
  return u + mp * (up - u) + mn * (un - u);
}
enum { VW = 0, VA = 1, VB = 2, VK = 3, VV = 4, VR = 5 };
#define DPP_FMAC(acc, x, y, N) asm("v_fmac_f32_dpp %0, %1, %2 row_newbcast:%3 row_mask:0xf bank_mask:0xf" : "+v"(acc) : "v"(x), "v"(y), "n"(N))
#define DPP_MUL(sv_, x, N) asm("v_mul_f32_dpp %0, %1, %0 row_newbcast:%2 row_mask:0xf bank_mask:0xf" : "+v"(sv_) : "v"(x), "n"(N))
template <int N> DI void dpp_dot4(float& a0, float& a1, float& a2, float& a3, const float (&S)[64], const float4& x) {
  DPP_FMAC(a0, x.x, S[N], N); DPP_FMAC(a1, x.y, S[16 + N], N); DPP_FMAC(a2, x.z, S[32 + N], N); DPP_FMAC(a3, x.w, S[48 + N], N);
  if constexpr (N < 15) dpp_dot4<N + 1>(a0, a1, a2, a3, S, x);
}
template <int N, bool HASV, bool OUT> DI void dpp_upd4(float (&S)[64], const float4& xw, const float4& xb, const float4& xk, const float4& xr, float sa, float vi,
                                                       float& o0, float& o1, float& o2, float& o3) {
  DPP_MUL(S[N], xw.x, N); DPP_MUL(S[16 + N], xw.y, N); DPP_MUL(S[32 + N], xw.z, N); DPP_MUL(S[48 + N], xw.w, N);
  DPP_FMAC(S[N], xb.x, sa, N); DPP_FMAC(S[16 + N], xb.y, sa, N); DPP_FMAC(S[32 + N], xb.z, sa, N); DPP_FMAC(S[48 + N], xb.w, sa, N);
  if (HASV) { DPP_FMAC(S[N], xk.x, vi, N); DPP_FMAC(S[16 + N], xk.y, vi, N); DPP_FMAC(S[32 + N], xk.z, vi, N); DPP_FMAC(S[48 + N], xk.w, vi, N); }
  if (OUT) { DPP_FMAC(o0, xr.x, S[N], N); DPP_FMAC(o1, xr.y, S[16 + N], N); DPP_FMAC(o2, xr.z, S[32 + N], N); DPP_FMAC(o3, xr.w, S[48 + N], N); }
  if constexpr (N < 15) dpp_upd4<N + 1, HASV, OUT>(S, xw, xb, xk, xr, sa, vi, o0, o1, o2, o3);
}
template <int NST, bool HASV, bool OUT, class F>
DI void scan_steps(float (&S)[64], const float* sv, int ns, int lane, F&& emit) {
  const int l15 = lane & 15;
  for (int s = 0; s < ns; ++s) {
    const float4 xw = *(const float4*)(sv + VW * NST * 64 + s * 64 + l15 * 4);
    const float4 xa = *(const float4*)(sv + VA * NST * 64 + s * 64 + l15 * 4);
    const float4 xb = *(const float4*)(sv + VB * NST * 64 + s * 64 + l15 * 4);
    float4 xk = xb, xr = xb;
    if (HASV) xk = *(const float4*)(sv + VK * NST * 64 + s * 64 + l15 * 4);
    if (OUT) xr = *(const float4*)(sv + VR * NST * 64 + s * 64 + l15 * 4);
    const float vi = HASV ? sv[VV * NST * 64 + s * 64 + lane] : 0.f;
    float sa0 = 0.f, sa1 = 0.f, sa2 = 0.f, sa3 = 0.f;
    dpp_dot4<0>(sa0, sa1, sa2, sa3, S, xa);
    const float sa = (sa0 + sa1) + (sa2 + sa3);
    float o0 = 0.f, o1 = 0.f, o2 = 0.f, o3 = 0.f;
    dpp_upd4<0, HASV, OUT>(S, xw, xb, xk, xr, sa, vi, o0, o1, o2, o3);
    if (OUT) emit(s, (o0 + o1) + (o2 + o3));
  }
}
DI int vperm(int j) { return (j & 15) * 4 + (j >> 4); }

template <int NST, bool P3>
DI void scan_prologue8(const P& p, int sbase, int L, int hd, int dir, int pos0, int nsteps, int sb0, float* sv) {
  const int lane = threadIdx.x & 63, l31 = lane & 31, h = lane >> 5;
  const bf16_t* PRKV = (const bf16_t*)(p.ws + O_PRKV);
  const bf16_t* LR = (const bf16_t*)(p.ws + O_LR);
  const bf16_t* WUPT = (const bf16_t*)(p.ws + O_WUPT) + (size_t)(dir * 512 + hd * 64) * 64;
  const bf16_t* AUPT = (const bf16_t*)(p.ws + O_AUPT) + (size_t)(dir * 512 + hd * 64) * 64;
  float* bonus = (float*)(p.ws + O_BONUS);
  const int c = hd * 64 + lane;
  float rk_[10], rv_[10], rr_[10];
  {
    const int p0w = dir ? pos0 - sb0 : pos0 + sb0;
#pragma unroll
    for (int i = 0; i < 10; ++i) {
      const int pi = dir ? p0w - (i - 1) : p0w + (i - 1);
      const bool inb = pi >= 0 && pi < L;
      const int pc = pi < 0 ? 0 : (pi > L - 1 ? L - 1 : pi);
      const bf16_t* rowp = PRKV + (size_t)(sbase + pc) * 1536 + c;
      const float kx = bf2f(rowp[512]), vx = bf2f(rowp[1024]);
      rk_[i] = inb ? kx : 0.f; rv_[i] = inb ? vx : 0.f;
      if (P3) { const float rx = bf2f(rowp[0]); rr_[i] = inb ? rx : 0.f; } else rr_[i] = 0.f;
    }
  }
  {
    int sl = sb0 + (l31 & 7); if (sl > nsteps - 1) sl = nsteps - 1;
    const int pos = dir ? pos0 - sl : pos0 + sl;
    const bf16_t* lrp = LR + (size_t)(sbase + pos) * 384 + dir * 64 + 8 * h;
#pragma unroll 1
    for (int mat = 0; mat < 2; ++mat) {
      const bf16_t* Wm = mat ? AUPT : WUPT;
      const float* bias = mat ? p.d_a0 : p.d_w0;
      f32x16 ac[2];
#pragma unroll
      for (int nt = 0; nt < 2; ++nt)
#pragma unroll
        for (int i = 0; i < 16; ++i) ac[nt][i] = 0.f;
#pragma unroll
      for (int ks = 0; ks < 4; ++ks) {
        const bf16x8 fa = *(const bf16x8*)(lrp + mat * 128 + 16 * ks);
#pragma unroll
        for (int nt = 0; nt < 2; ++nt) {
          const bf16x8 bw = *(const bf16x8*)(Wm + (size_t)(32 * nt + l31) * 64 + 16 * ks + 8 * h);
          ac[nt] = MFMA32(fa, bw, ac[nt]);
        }
      }
      float* dstv = sv + (mat ? VB : VW) * NST * 64;
#pragma unroll
      for (int nt = 0; nt < 2; ++nt) {
        const int j = 32 * nt + l31;
        const float b0 = bias[dir * 512 + hd * 64 + j];
#pragma unroll
        for (int i = 0; i < 4; ++i) {
          const int st = sb0 + i + 4 * h;
          const float sg = 1.f / (1.f + __expf(-(b0 + ac[nt][i])));
          dstv[st * 64 + vperm(j)] = mat ? sg : __expf(-0.6065306597126334f * sg);
        }
      }
    }
  }
  const float mpr = p.mu_prev[c], mnr = p.mu_next[c], mpk = p.mu_prev[512 + c], mnk = p.mu_next[512 + c], mpv = p.mu_prev[1024 + c], mnv = p.mu_next[1024 + c];
  const float kkc = p.d_k_k[c], kac = p.d_k_a[c], rkc = p.d_r_k[c];
  const int pj = vperm(lane);
#pragma unroll
  for (int q = 0; q < 8; ++q) {
    const int s = sb0 + q;
    const float kb = rk_[q], kc = rk_[q + 1], ka = rk_[q + 2];
    const float vb = rv_[q], vc = rv_[q + 1], va = rv_[q + 2];
    const float k = kc + mpk * ((dir ? ka : kb) - kc) + mnk * ((dir ? kb : ka) - kc);
    const float v = vc + mpv * ((dir ? va : vb) - vc) + mnv * ((dir ? vb : va) - vc);
    const float a = sv[VB * NST * 64 + s * 64 + pj];
    float kk = k * kkc;
    const float n2 = wave_sum(kk * kk);
    kk *= rsqrtf(fmaxf(n2, 1e-24f));
    const float kd = k * (1.f + (a - 1.f) * kac);
    sv[VA * NST * 64 + s * 64 + pj] = -kk;
    sv[VB * NST * 64 + s * 64 + pj] = kk * a;
    sv[VK * NST * 64 + s * 64 + pj] = kd;
    sv[VV * NST * 64 + s * 64 + lane] = v;
    if (P3) {
      const float rb = rr_[q], rc = rr_[q + 1], ra = rr_[q + 2];
      const float r = rc + mpr * ((dir ? ra : rb) - rc) + mnr * ((dir ? rb : ra) - rc);
      sv[VR * NST * 64 + s * 64 + pj] = r;
      const float bn = wave_sum(r * kd * rkc);
      if (s < nsteps && lane == 0) {
        const int pos = dir ? pos0 - s : pos0 + s;
        bonus[((size_t)(sbase + pos) * 8 + hd) * 2 + dir] = bn;
      }
    }
  }
}

template <bool HALF> DI void scan1_body(const P& p, char* lds) {
  float* PQ = (float*)(p.ws + O_PQ);
  const int lane = threadIdx.x & 63, wave = __builtin_amdgcn_readfirstlane(threadIdx.x >> 6), slot = wave >> 1;
  constexpr int half = HALF ? 1 : 0;
  float* sv = (float*)lds + slot * (6 * 16 * 64);
  for (int g = blockIdx.x; g < 804; g += gridDim.x) {
    int seq, c, hp;
    if (g < 768) { const int lc = g >> 2; hp = g & 3; if (lc < 128) { seq = lc >> 4; c = lc & 15; } else { seq = 8; c = lc - 128; } }
    else { const int j = g - 768; hp = j & 3; seq = j >> 2; c = seq < 8 ? 16 : 64; }
    const int cgi = seq < 8 ? seq * 17 + c : 136 + c;
    const int hd = hp * 2 + (slot >> 1), dir = slot & 1;
    const int it = (cgi * 8 + hd) * 2 + dir;
    const int L = seq_len(seq), sbase = seq_base(seq);
    const int start = c * 256, end = min(L, start + 256), n = end - start;
    float S[64];
#pragma unroll
    for (int j = 0; j < 64; ++j) S[j] = (half == 0 && j == lane) ? 1.f : 0.f;
    for (int s0 = 0; s0 < n; s0 += 16) {
      const int ns = min(16, n - s0);
      const int pos0 = dir ? end - 1 - s0 : start + s0;
      __syncthreads();
      scan_prologue8<16, false>(p, sbase, L, hd, dir, pos0, ns, half * 8, sv);
      __syncthreads();
      scan_steps<16, HALF, false>(S, sv, ns, lane, [](int, float) {});
    }
    float* dst = PQ + (size_t)it * 8192 + (size_t)(half * 64 + lane) * 64;
#pragma unroll
    for (int q = 0; q < 16; ++q) *(float4*)(dst + q * 4) = make_float4(S[q * 4], S[q * 4 + 1], S[q * 4 + 2], S[q * 4 + 3]);
  }
}

DI void phase_scan1(const P& p, char* lds) {
  const int w_ = __builtin_amdgcn_readfirstlane(threadIdx.x >> 6);
  if ((w_ ^ (w_ >> 2)) & 1) scan1_body<true>(p, lds); else scan1_body<false>(p, lds);
}

DI void phase_scan2(const P& p, char* lds) {
  float* Ss = (float*)lds;
  float* Ps = Ss + 64 * 65;
  float* PQ = (float*)(p.ws + O_PQ);
  const int tid = threadIdx.x, i = tid >> 3, j0 = (tid & 7) * 8;
  for (int it = blockIdx.x; it < 144; it += gridDim.x) {
    const int dir = it & 1, hd = (it >> 1) & 7, seq = it >> 4;
    const int nch = seq < 8 ? 17 : 65, cg0 = seq < 8 ? seq * 17 : 136;
    float S[8];
#pragma unroll
    for (int jj = 0; jj < 8; ++jj) S[jj] = 0.f;
    f32x4v pn0, pn1, qn0, qn1;
    {
      const int c = dir ? nch - 1 : 0;
      const float* Pg = PQ + (size_t)(((cg0 + c) * 8 + hd) * 2 + dir) * 8192;
#pragma unroll
      for (int r4 = 0; r4 < 1; ++r4) { pn0 = *(const f32x4v*)(Pg + tid * 4); pn1 = *(const f32x4v*)(Pg + (512 + tid) * 4); qn0 = *(const f32x4v*)(Pg + 4096 + i * 64 + j0); qn1 = *(const f32x4v*)(Pg + 4096 + i * 64 + j0 + 4); }
    }
    for (int cc = 0; cc < nch; ++cc) {
      const int c = dir ? nch - 1 - cc : cc;
      float* Qg = PQ + (size_t)(((cg0 + c) * 8 + hd) * 2 + dir) * 8192 + 4096;
      __syncthreads();
#pragma unroll
      for (int jj = 0; jj < 8; ++jj) Ss[i * 65 + j0 + jj] = S[jj];
#pragma unroll
      for (int r4 = 0; r4 < 1; ++r4) { *(f32x4v*)(Ps + tid * 4) = pn0; *(f32x4v*)(Ps + (512 + tid) * 4) = pn1; }
      float acc[8];
#pragma unroll
      for (int jj = 0; jj < 4; ++jj) { acc[jj] = qn0[jj]; acc[4 + jj] = qn1[jj]; }
#pragma unroll
      for (int r4 = 0; r4 < 2; ++r4) *(float4*)(Qg + i * 64 + j0 + r4 * 4) = make_float4(S[r4 * 4], S[r4 * 4 + 1], S[r4 * 4 + 2], S[r4 * 4 + 3]);
      if (cc + 1 < nch) {
        const int c2 = dir ? nch - 2 - cc : cc + 1;
        const float* Pg2 = PQ + (size_t)(((cg0 + c2) * 8 + hd) * 2 + dir) * 8192;
#pragma unroll
        for (int r4 = 0; r4 < 1; ++r4) { pn0 = *(const f32x4v*)(Pg2 + tid * 4); pn1 = *(const f32x4v*)(Pg2 + (512 + tid) * 4); qn0 = *(const f32x4v*)(Pg2 + 4096 + i * 64 + j0); qn1 = *(const f32x4v*)(Pg2 + 4096 + i * 64 + j0 + 4); }
      }
      __syncthreads();
#pragma unroll 8
      for (int m = 0; m < 64; ++m) {
        const float sm = Ss[i * 65 + m];
        const float* pr = Ps + m * 64 + j0;
#pragma unroll
        for (int jj = 0; jj < 8; ++jj) acc[jj] += sm * pr[jj];
      }
#pragma unroll
      for (int jj = 0; jj < 8; ++jj) S[jj] = acc[jj];
    }
  }
}

DI void phase_scan3(const P& p, char* lds) {
  const float* PQ = (const float*)(p.ws + O_PQ);
  bf16_t* MIX = (bf16_t*)(p.ws + O_MIX);
  bf16_t* OB = (bf16_t*)(p.ws + O_OB);
  const int lane = threadIdx.x & 63, wave = __builtin_amdgcn_readfirstlane(threadIdx.x >> 6);
  float* sv = (float*)lds + wave * (6 * 8 * 64);
  const bool bal = gridDim.x == 256;
  const int NW = gridDim.x * 8, gw = blockIdx.x * 8 + wave;
  for (int k = 0; ; ++k) {
    int oi;
    if (bal) {
      if (k == 0) oi = gw;
      else if (k == 1) { if (wave >= 4) continue; oi = 2048 + blockIdx.x * 4 + wave; }
      else if (k == 2) { if (wave != 7 || blockIdx.x >= 144) break; oi = 3072 + blockIdx.x; }
      else break;
    } else { oi = gw + k * NW; if (oi >= 3216) break; }
    int seq, c, hd, dir;
    if (oi < 3072) { const int lc = oi >> 4; hd = (oi >> 1) & 7; dir = oi & 1; if (lc < 128) { seq = lc >> 4; c = lc & 15; } else { seq = 8; c = lc - 128; } }
    else { const int j = oi - 3072; hd = (j >> 1) & 7; dir = j & 1; seq = j >> 4; c = seq < 8 ? 16 : 64; }
    const int it = ((seq < 8 ? seq * 17 + c : 136 + c) * 8 + hd) * 2 + dir;
    const int L = seq_len(seq), sbase = seq_base(seq);
    const int start = c * 256, end = min(L, start + 256), n = end - start;
    float S[64];
    {
      const float* src = PQ + (size_t)it * 8192 + 4096 + lane * 64;
#pragma unroll
      for (int q = 0; q < 16; ++q) { float4 t = *(const float4*)(src + q * 4); S[q * 4] = t.x; S[q * 4 + 1] = t.y; S[q * 4 + 2] = t.z; S[q * 4 + 3] = t.w; }
    }
    for (int s0 = 0; s0 < n; s0 += 8) {
      const int ns = min(8, n - s0);
      const int pos0 = dir ? end - 1 - s0 : start + s0;
      scan_prologue8<8, true>(p, sbase, L, hd, dir, pos0, ns, 0, sv);
      scan_steps<8, true, true>(S, sv, ns, lane, [&](int st, float o) {
        const int pos = dir ? pos0 - st : pos0 + st;
        const size_t sr = (size_t)(sbase + pos);
        if (dir == 0) MIX[sr * 1024 + 512 + hd * 64 + lane] = f2bf(o);
        else OB[sr * 512 + hd * 64 + lane] = f2bf(o);
      });
    }
  }
}

DI void phase_rwkv_final(const P& p) {
  const int lane = threadIdx.x & 63, gw = (blockIdx.x * NTH + threadIdx.x) >> 6, nw = (gridDim.x * NTH) >> 6;
  bf16_t* MIX = (bf16_t*)(p.ws + O_MIX);
  const bf16_t* OB = (const bf16_t*)(p.ws + O_OB);
  const bf16_t* G = (const bf16_t*)(p.ws + O_G);
  const bf16_t* PRKV = (const bf16_t*)(p.ws + O_PRKV);
  const float* bonus = (const float*)(p.ws + O_BONUS);
  const int hd = lane >> 3, c0 = lane * 8;
  for (int sr = gw; sr < T_; sr += nw) {
    int pos; int b = seq_of(sr, pos);
    const int L = seq_len(b);
    uint4 uf = *(const uint4*)(MIX + (size_t)sr * 1024 + 512 + c0);
    uint4 ub = *(const uint4*)(OB + (size_t)sr * 512 + c0);
    uint4 ug = *(const uint4*)(G + (size_t)sr * 512 + c0);
    unsigned f_[4] = {uf.x, uf.y, uf.z, uf.w}, b_[4] = {ub.x, ub.y, ub.z, ub.w}, g_[4] = {ug.x, ug.y, ug.z, ug.w};
    float o[8], gg[8];
    float sm = 0.f;
#pragma unroll
    for (int j = 0; j < 4; ++j) {
      o[2 * j] = lo2f(f_[j]) + lo2f(b_[j]); o[2 * j + 1] = hi2f(f_[j]) + hi2f(b_[j]);
      gg[2 * j] = lo2f(g_[j]); gg[2 * j + 1] = hi2f(g_[j]);
      sm += o[2 * j] + o[2 * j + 1];
    }
    sm += __shfl_xor(sm, 1); sm += __shfl_xor(sm, 2); sm += __shfl_xor(sm, 4);
    const float mean = sm * (1.f / 64.f);
    float vs = 0.f;
#pragma unroll
    for (int j = 0; j < 8; ++j) { float dlt = o[j] - mean; vs += dlt * dlt; }
    vs += __shfl_xor(vs, 1); vs += __shfl_xor(vs, 2); vs += __shfl_xor(vs, 4);
    const float rstd = rsqrtf(vs * (1.f / 64.f) + 64e-5f);
    const float bsum = bonus[((size_t)sr * 8 + hd) * 2] + bonus[((size_t)sr * 8 + hd) * 2 + 1];
    float y[8];
#pragma unroll
    for (int j = 0; j < 8; ++j) {
      int c = c0 + j;
      float vsh = shiftv(PRKV, sr, pos, L, 1024 + c, p.mu_prev[1024 + c], p.mu_next[1024 + c]);
      y[j] = ((o[j] - mean) * rstd * p.d_ln_g[c] + p.d_ln_b[c] + bsum * vsh) * gg[j];
    }
    *(uint4*)(MIX + (size_t)sr * 1024 + 512 + c0) = make_uint4(pack2(y[0], y[1]), pack2(y[2], y[3]), pack2(y[4], y[5]), pack2(y[6], y[7]));
  }
}

#define XB_TMO      128
#define XB_XCNT(j)  (256  + 64 * (j))
#define XB_XSUB(j)  (1280 + 64 * (j))
#define XB_XGEN(j)  (2304 + 64 * (j))
#define XB_TOP      3328
#define XB_TOPGEN   3392
#define XCD_BAR_WORDS 3456
#define XB_SPIN_CAP (1u << 23)
#define LAS __attribute__((address_space(3)))

__device__ __forceinline__ unsigned xb_ld(unsigned* p)              { return __hip_atomic_load(p, __ATOMIC_RELAXED, __HIP_MEMORY_SCOPE_AGENT); }
__device__ __forceinline__ unsigned xb_add(unsigned* p, unsigned v) { return __hip_atomic_fetch_add(p, v, __ATOMIC_RELAXED, __HIP_MEMORY_SCOPE_AGENT); }
__device__ __forceinline__ unsigned xb_xcc_id() { return (unsigned)__builtin_amdgcn_s_getreg((3 << 11) | 20) & 0xFu; }
#define XB_SPIN(cond, bar) do { unsigned _sp = 0; while (cond) { __builtin_amdgcn_s_sleep(1); \
    if ((++_sp & 255u) == 0u) { if (xb_ld(&(bar)[XB_TMO])) break; if (_sp > XB_SPIN_CAP) { atomicAdd(&(bar)[XB_TMO], 1u); break; } } } } while (0)

struct XcdBarrier {
    unsigned* bar; unsigned x;
    volatile LAS unsigned* st;
};

__device__ __forceinline__ XcdBarrier xcd_barrier_post(unsigned* bar, volatile LAS unsigned* st) {
    XcdBarrier b; b.bar = bar; b.x = xb_xcc_id(); b.st = st;
    if (threadIdx.x == 0) (void)xb_add(&bar[XB_XCNT(b.x)], 1u);
    return b;
}
__device__ __forceinline__ void xcd_barrier_complete(unsigned* bar, unsigned x, unsigned& nloc, unsigned& nx) {
    const unsigned G = gridDim.x * gridDim.y * gridDim.z;
    unsigned sum, cnt, mine, sp = 0u;
    for (;;) {
        sum = 0u; cnt = 0u; mine = 0u;
#pragma unroll
        for (unsigned j = 0; j < 16; ++j) { const unsigned c = xb_ld(&bar[XB_XCNT(j)]); sum += c; cnt += (c > 0u) ? 1u : 0u; mine = (j == x) ? c : mine; }
        if (sum == G) break;
        __builtin_amdgcn_s_sleep(1);
        if ((++sp & 255u) == 0u) { if (xb_ld(&bar[XB_TMO])) break; if (sp > XB_SPIN_CAP) { atomicAdd(&bar[XB_TMO], 1u); break; } }
    }
    nloc = mine > 0u ? mine : 1u; nx = cnt > 0u ? cnt : 1u;
}

__device__ __forceinline__ void xcd_barrier(const XcdBarrier& b) {
    asm volatile("s_waitcnt vmcnt(0)" ::: "memory");
    __syncthreads();
    if (threadIdx.x == 0) {
        unsigned* bar = b.bar;
        __builtin_amdgcn_s_waitcnt(0);
        unsigned nloc = b.st[0], nx = b.st[1];
        if (nloc == 0u) { xcd_barrier_complete(bar, b.x, nloc, nx); b.st[0] = nloc; b.st[1] = nx; }
        const unsigned old = xb_add(&bar[XB_XSUB(b.x)], 1u);
        const unsigned gen = old / nloc;
        if (old + 1u == (gen + 1u) * nloc) {
            __builtin_amdgcn_fence(__ATOMIC_RELEASE, "agent");
            asm volatile("s_waitcnt vmcnt(0)" ::: "memory");
            const unsigned og = xb_add(&bar[XB_TOP], 1u);
            const unsigned tg = og / nx;
            if (og + 1u == (tg + 1u) * nx) xb_add(&bar[XB_TOPGEN], 1u);
            else XB_SPIN(xb_ld(&bar[XB_TOPGEN]) == tg, bar);
            __builtin_amdgcn_fence(__ATOMIC_ACQUIRE, "agent");
            xb_add(&bar[XB_XGEN(b.x)], 1u);
            asm volatile("s_waitcnt vmcnt(0)" ::: "memory");
        } else {
            XB_SPIN(xb_ld(&bar[XB_XGEN(b.x)]) == gen, bar);
            __builtin_amdgcn_fence(__ATOMIC_ACQUIRE, "agent");
            asm volatile("s_waitcnt vmcnt(0)" ::: "memory");
        }
    }
    __syncthreads();
}

constexpr int NPHASE = 23;
__global__ void __launch_bounds__(NTH, 2) mega(P p) {
  extern __shared__ __attribute__((aligned(16))) unsigned char shm[];
  char* lds = (char*)shm;
  char* ws = p.ws;
  if (threadIdx.x == 0) *(uint4*)(shm + 131072) = make_uint4(0u, 0u, 0u, 0u);
  __syncthreads();
  const XcdBarrier xb = xcd_barrier_post((unsigned*)(ws + O_BAR), (volatile LAS unsigned*)(shm + 131072));
#ifndef DUP_MASK
#define DUP_MASK 0u
#endif
#define RUN(k, call) if (p.ph0 <= k && k < p.ph1) { call; if (k + 1 < p.ph1) { if (k == 0) cg::this_grid().sync(); else xcd_barrier(xb); } }
  RUN(0, phase_prep(p))
  RUN(1, phase_gemm_big((const bf16_t*)(ws + O_HN), (const bf16_t*)(ws + O_WIN0), 1536, 1024, (bf16_t*)(ws + O_PROJ0), 1536, 0, ws, shm))
  RUN(2, phase_prepA(p, lds))
  RUN(3, phase_attnA(p, lds))
  RUN(4, phase_fnet_gemm(p, lds))
  RUN(5, phase_gemm_big((const bf16_t*)(ws + O_MIX), (const bf16_t*)(ws + O_WOUT0), 1024, 1024, (bf16_t*)(ws + O_HN), 1024, 0, ws, shm))
  RUN(6, phase_resnorm(p, p.post_mix_g, p.pre_ffn_g))
  RUN(7, phase_gemm_gateup((const bf16_t*)(ws + O_HN), (const bf16_t*)(ws + O_WGU0), (bf16_t*)(ws + O_ACT), shm))
  RUN(8, phase_gemm_big((const bf16_t*)(ws + O_ACT), (const bf16_t*)(ws + O_WD0), 1024, DFF, (bf16_t*)(ws + O_HN), 1024, 0, ws, shm))
  RUN(9, phase_resnorm(p, p.post_ffn_g, p.pre_mix_g + 1024))
  RUN(10, phase_gemm_big((const bf16_t*)(ws + O_HN), (const bf16_t*)(ws + O_WIN1), 2816, 1024, nullptr, 0, 1, ws, shm))
  RUN(11, phase_prepC(p, lds))
  RUN(12, phase_attnC(p, lds))
  RUN(13, phase_scan1(p, lds))
  RUN(14, phase_scan2(p, lds))
  RUN(15, phase_scan3(p, lds))
  RUN(16, phase_gemm_small((const bf16_t*)(ws + O_LR) + 256, 384, (const bf16_t*)(ws + O_GUP), 512, 128, (bf16_t*)(ws + O_G), 512, lds))
  RUN(17, phase_rwkv_final(p))
  RUN(18, phase_gemm_big((const bf16_t*)(ws + O_MIX), (const bf16_t*)(ws + O_WOUT1), 1024, 1024, (bf16_t*)(ws + O_HN), 1024, 0, ws, shm))
  RUN(19, phase_resnorm(p, p.post_mix_g + 1024, p.pre_ffn_g + 1024))
  RUN(20, phase_gemm_gateup((const bf16_t*)(ws + O_HN), (const bf16_t*)(ws + O_WGU1), (bf16_t*)(ws + O_ACT), shm))
  RUN(21, phase_gemm_big((const bf16_t*)(ws + O_ACT), (const bf16_t*)(ws + O_WD1), 1024, DFF, (bf16_t*)(ws + O_HN), 1024, 0, ws, shm))
  RUN(22, phase_resnorm(p, p.post_ffn_g + 1024, nullptr))
#undef RUN
}

extern "C" void kernel_launch(void* const* d_in, const int* in_sizes, int n_in, void* d_out, int out_size, void* d_ws, size_t ws_size,
                              hipStream_t stream) {
  static int grid_blocks = 0;
  if (!grid_blocks) {
    int dev = 0, cus = 0, per_cu = 0;
    (void)hipGetDevice(&dev);
    (void)hipDeviceGetAttribute(&cus, hipDeviceAttributeMultiprocessorCount, dev);
    if (hipFuncSetAttribute((const void*)mega, hipFuncAttributeMaxDynamicSharedMemorySize, LDS_BYTES) != hipSuccess) fprintf(stderr, "hipFuncSetAttribute failed\n");
    if (hipOccupancyMaxActiveBlocksPerMultiprocessor(&per_cu, (const void*)mega, NTH, LDS_BYTES) != hipSuccess || per_cu < 1) {
      fprintf(stderr, "occupancy query says %d\n", per_cu);
      (void)hipGetLastError();
    }
    grid_blocks = cus;
  }
  if (ws_size < O_BAR + CTL_BYTES) { fprintf(stderr, "workspace too small\n"); return; }
  if (hipMemsetAsync((char*)d_ws + O_BAR, 0, CTL_BYTES, stream) != hipSuccess) { fprintf(stderr, "memset failed\n"); return; }
  P p{};
  const float** f = (const float**)&p;
  for (int i = 0; i < 32; ++i) f[i] = (const float*)d_in[i];
  p.out = (float*)d_out;
  p.ws = (char*)d_ws;
#if FUSED
  p.ph0 = 0; p.ph1 = NPHASE;
  void* args[] = {&p};
  hipError_t e = hipLaunchCooperativeKernel((void*)mega, dim3(grid_blocks), dim3(NTH), args, LDS_BYTES, stream);
  if (e != hipSuccess) fprintf(stderr, "cooperative launch failed: %s (grid %d)\n", hipGetErrorString(e), grid_blocks);
#else
  for (int ph = 0; ph < NPHASE; ++ph) {
    p.ph0 = ph; p.ph1 = ph + 1;
    hipLaunchKernelGGL(mega, dim3(grid_blocks), dim3(NTH), LDS_BYTES, stream, p);
  }
#endif
}
```

```cpp
#include <hip/hip_runtime.h>
#include <hip/hip_cooperative_groups.h>
#include <cstdio>
namespace cg = cooperative_groups;

#ifndef FUSED
#define FUSED 1
#endif

typedef unsigned short bf16_t;
using bf16x8 = __attribute__((ext_vector_type(8))) short;
using s16x4 = __attribute__((ext_vector_type(4))) short;
using f32x16 = __attribute__((ext_vector_type(16))) float;
using u32x4 = __attribute__((ext_vector_type(4))) unsigned;
using f32x4v = __attribute__((ext_vector_type(4))) float;
#define DI __device__ __forceinline__
#define MFMA32(a, b, c) __builtin_amdgcn_mfma_f32_32x32x16_bf16((a), (b), (c), 0, 0, 0)
constexpr int NTH = 512;
constexpr int LDS_BYTES = 131072 + 16;

constexpr int DM_ = 1024;
constexpr int T_ = 49296;
constexpr int TP_ = 49408;
constexpr int NT_ = TP_ / 128;
constexpr int DFF = 2816;
constexpr float EPS = 1e-6f;
constexpr float LOG2E = 1.4426950408889634f;

constexpr size_t SZ_ROW1024 = (size_t)TP_ * 1024 * 2;
constexpr size_t O_WIN0 = 0;
constexpr size_t O_WOUT0 = O_WIN0 + (size_t)1536 * 1024 * 2;
constexpr size_t O_WGU0 = O_WOUT0 + (size_t)1024 * 1024 * 2;
constexpr size_t O_WD0 = O_WGU0 + (size_t)5632 * 1024 * 2;
constexpr size_t O_DM257 = O_WD0 + (size_t)1024 * 2816 * 2;
constexpr size_t O_DM1025 = O_DM257 + (size_t)384 * 576 * 2;
constexpr size_t O_WIN1 = O_DM1025 + (size_t)1152 * 2112 * 2;
constexpr size_t O_WOUT1 = O_WIN1 + (size_t)2816 * 1024 * 2;
constexpr size_t O_WGU1 = O_WOUT1 + (size_t)1024 * 1024 * 2;
constexpr size_t O_WD1 = O_WGU1 + (size_t)5632 * 1024 * 2;
constexpr size_t O_GUP = O_WD1 + (size_t)1024 * 2816 * 2;
constexpr size_t O_RA = O_GUP + (size_t)512 * 128 * 2;
constexpr size_t O_RB = O_RA + SZ_ROW1024;
constexpr size_t O_RC = O_RB + (size_t)TP_ * 2816 * 2;
constexpr size_t O_META = O_RC + SZ_ROW1024;
constexpr size_t O_WC = O_META + (size_t)144 * 1024 * 4;
constexpr size_t O_WUPT = O_WC + (size_t)4 * 64 * 128 * 4;
constexpr size_t O_AUPT = O_WUPT + (size_t)2 * 512 * 64 * 2;
constexpr size_t O_END = O_AUPT + (size_t)2 * 512 * 64 * 2;
constexpr size_t O_HN = O_RA;
constexpr size_t O_VTA = O_RA;
constexpr size_t O_LR = O_RA;
constexpr size_t O_BONUS = O_RA + (size_t)TP_ * 384 * 2;
constexpr size_t O_VTC = O_BONUS + (size_t)T_ * 16 * 4;
constexpr size_t O_OB = O_RA + (size_t)TP_ * 512 * 2;
constexpr size_t O_PROJ0 = O_RB;
constexpr size_t O_ZB = O_PROJ0 + (size_t)TP_ * 1536 * 2;
constexpr size_t O_Y = O_ZB + (size_t)TP_ * 512 * 2;
constexpr size_t O_ACT = O_RB;
constexpr size_t O_PRKV = O_RB;
constexpr size_t O_PC = O_PRKV + (size_t)TP_ * 1536 * 2;
constexpr size_t O_PLOW = O_PC + (size_t)TP_ * 768 * 2;
constexpr size_t O_PQ = O_PC;
constexpr size_t O_G = O_PC;
constexpr size_t O_MIX = O_RC;
static_assert(O_VTC + (size_t)49728 * 128 * 2 <= O_RB, "vtc");
static_assert(O_Y + (size_t)(8 * 16 * 256 * 576 + 16 * 256 * 2112) * 2 <= O_RC, "y");
static_assert(O_PQ + (size_t)3216 * 32768 <= O_RC, "pq");
constexpr size_t O_BAR = (O_END + 255) / 256 * 256;
constexpr size_t O_CNT = O_BAR + 3456 * 4;
constexpr size_t CTL_BYTES = 3456 * 4 + 4 * 256;
static_assert(O_BAR + CTL_BYTES <= (size_t)536870912, "ws");

struct P {
  const float *x_prompt, *x_sample, *meta, *pre_mix_g, *post_mix_g, *pre_ffn_g, *post_ffn_g;
  const float *even_w_in, *even_w_out, *a_q_gain, *a_k_gain, *b_norm_g, *b_w, *b_b;
  const float *odd_w_in, *odd_w_out, *c_sink, *mu_prev, *mu_next, *d_w0, *d_w_up, *d_a0, *d_a_up, *d_g_up;
  const float *d_k_k, *d_k_a, *d_r_k, *d_ln_g, *d_ln_b, *ffn_gate, *ffn_up, *ffn_down;
  float* out;
  char* ws;
  int ph0, ph1;
};

typedef float f32x2 __attribute__((ext_vector_type(2)));
typedef __bf16 bf16x2_t __attribute__((ext_vector_type(2)));
DI bf16_t f2bf(float x) { return __builtin_bit_cast(bf16_t, (__bf16)x); }
DI float bf2f(bf16_t b) { return __uint_as_float(((unsigned)b) << 16); }
DI unsigned pack2(float a, float b) { f32x2 v = {a, b}; return __builtin_bit_cast(unsigned, __builtin_convertvector(v, bf16x2_t)); }
DI float lo2f(unsigned u) { return __uint_as_float(u << 16); }
DI float hi2f(unsigned u) { return __uint_as_float(u & 0xffff0000u); }
DI float wave_sum(float v) {
  for (int o = 32; o > 0; o >>= 1) v += __shfl_xor(v, o);
  return v;
}
DI int seq_of(int sr, int& pos) {
  if (sr < 32896) { int b = sr / 4112; pos = sr - b * 4112; return b; }
  pos = sr - 32896; return 8;
}
DI int seq_len(int b) { return b < 8 ? 4112 : 16400; }
DI int seq_base(int b) { return b < 8 ? b * 4112 : 32896; }
DI float* hrow(const P& p, int sr) {
  int pos; int b = seq_of(sr, pos);
  if (pos < 16) return (float*)(p.ws + O_META) + (size_t)(b * 16 + pos) * 1024;
  return p.out + ((size_t)(b < 8 ? b * 4096 : 32768) + (pos - 16)) * 1024;
}
DI float sigmoidf_(float x) { return 1.f / (1.f + expf(-x)); }

DI void transpose_w(const float* W, int K, int ldw, int N, bf16_t* Wt, int mode, const float* W2, int gtid, int gsz) {
  int nk8 = K / 8;
  long total = (long)N * nk8;
  for (long it = gtid; it < total; it += gsz) {
    int n = (int)(it % N), k8 = (int)(it / N);
    const float* src = W;
    int c = n;
    if (mode == 1) {
      int blk = n >> 8, w = n & 255;
      c = blk * 128 + (w & 127);
      if (w >= 128) src = W2;
    }
    unsigned r[4];
#pragma unroll
    for (int j = 0; j < 4; ++j) {
      float a = src[(size_t)(k8 * 8 + 2 * j) * ldw + c];
      float b = src[(size_t)(k8 * 8 + 2 * j + 1) * ldw + c];
      r[j] = pack2(a, b);
    }
    *(uint4*)(Wt + (size_t)n * K + k8 * 8) = make_uint4(r[0], r[1], r[2], r[3]);
  }
}

DI void phase_prep(const P& p) {
  const int gtid = blockIdx.x * NTH + threadIdx.x, gsz = gridDim.x * NTH;
  char* ws = p.ws;
  transpose_w(p.even_w_in, 1024, 1536, 1536, (bf16_t*)(ws + O_WIN0), 0, nullptr, gtid, gsz);
  transpose_w(p.even_w_out, 1024, 1024, 1024, (bf16_t*)(ws + O_WOUT0), 0, nullptr, gtid, gsz);
  transpose_w(p.odd_w_in, 1024, 2688, 2688, (bf16_t*)(ws + O_WIN1), 0, nullptr, gtid, gsz);
  transpose_w(p.odd_w_out, 1024, 1024, 1024, (bf16_t*)(ws + O_WOUT1), 0, nullptr, gtid, gsz);
  transpose_w(p.ffn_gate, 1024, DFF, 5632, (bf16_t*)(ws + O_WGU0), 1, p.ffn_up, gtid, gsz);
  transpose_w(p.ffn_gate + (size_t)1024 * DFF, 1024, DFF, 5632, (bf16_t*)(ws + O_WGU1), 1, p.ffn_up + (size_t)1024 * DFF, gtid, gsz);
  transpose_w(p.ffn_down, DFF, 1024, 1024, (bf16_t*)(ws + O_WD0), 0, nullptr, gtid, gsz);
  transpose_w(p.ffn_down + (size_t)DFF * 1024, DFF, 1024, 1024, (bf16_t*)(ws + O_WD1), 0, nullptr, gtid, gsz);
  transpose_w(p.d_g_up, 128, 512, 512, (bf16_t*)(ws + O_GUP), 0, nullptr, gtid, gsz);
  for (int d = 0; d < 2; ++d) {
    transpose_w(p.d_w_up + (size_t)d * 64 * 512, 64, 512, 512, (bf16_t*)(ws + O_WUPT) + (size_t)d * 512 * 64, 0, nullptr, gtid, gsz);
    transpose_w(p.d_a_up + (size_t)d * 64 * 512, 64, 512, 512, (bf16_t*)(ws + O_AUPT) + (size_t)d * 512 * 64, 0, nullptr, gtid, gsz);
  }
  for (int it = gtid; it < 128 * 1024 / 8; it += gsz) *(uint4*)((bf16_t*)(ws + O_WIN1) + (size_t)2688 * 1024 + (size_t)it * 8) = make_uint4(0, 0, 0, 0);
  for (int which = 0; which < 2; ++which) {
    const int M = which ? 1025 : 257, MP = which ? 1152 : 384, KP = which ? 2112 : 576;
    bf16_t* dm = (bf16_t*)(ws + (which ? O_DM1025 : O_DM257));
    for (int it = gtid; it < MP * KP; it += gsz) {
      int r = it / KP, c = it - r * KP;
      float v = 0.f;
      if (r < M && c < 2 * M) {
        int n2 = c < M ? c : c - M;
        int m = (r * n2) % M;
        float s, co;
        sincospif(2.0f * (float)m / (float)M, &s, &co);
        v = c < M ? co : s;
      }
      dm[it] = f2bf(v);
    }
  }
  for (int it = gtid; it < 4 * 64 * 128; it += gsz) {
    int o = it & 127, c = (it >> 7) & 63, g = it >> 13;
    int d = o & 63;
    float acc = 0.f;
    for (int c2 = 0; c2 < 64; ++c2) {
      float s, co;
      sincospif((float)((c * c2) & 63) / 32.f, &s, &co);
      float w = p.b_w[(g * 64 + c2) * 64 + d];
      acc += (o < 64 ? co : -s) * w;
    }
    ((float*)(ws + O_WC))[it] = acc;
  }
  const int lane = threadIdx.x & 63, gw = gtid >> 6, nw = gsz >> 6;
  bf16_t* HN = (bf16_t*)(ws + O_HN);
  for (int sr = gw; sr < TP_; sr += nw) {
    if (sr >= T_) {
#pragma unroll
      for (int q = 0; q < 2; ++q) *(uint4*)(HN + (size_t)sr * 1024 + q * 512 + lane * 8) = make_uint4(0, 0, 0, 0);
      continue;
    }
    int pos; int b = seq_of(sr, pos);
    const float* src = pos < 16 ? p.meta + pos * 1024
                                : (b < 8 ? p.x_prompt + ((size_t)b * 4096 + pos - 16) * 1024 : p.x_sample + (size_t)(pos - 16) * 1024);
    float* hr = hrow(p, sr);
    float4 v[4];
    float ss = 0.f;
#pragma unroll
    for (int q = 0; q < 4; ++q) {
      v[q] = *(const float4*)(src + q * 256 + lane * 4);
      ss += v[q].x * v[q].x + v[q].y * v[q].y + v[q].z * v[q].z + v[q].w * v[q].w;
      *(float4*)(hr + q * 256 + lane * 4) = v[q];
    }
    ss = wave_sum(ss);
    float rs = rsqrtf(ss * (1.f / 1024.f) + EPS);
#pragma unroll
    for (int q = 0; q < 4; ++q) {
      float4 g = *(const float4*)(p.pre_mix_g + q * 256 + lane * 4);
      uint2 o = make_uint2(pack2(v[q].x * rs * g.x, v[q].y * rs * g.y), pack2(v[q].z * rs * g.z, v[q].w * rs * g.w));
      *(uint2*)(HN + (size_t)sr * 1024 + q * 256 + lane * 4) = o;
    }
  }
}

DI void gemm_tile(const bf16_t* __restrict__ A, int lda, const bf16_t* __restrict__ B, int ldb, int K, char* lds, f32x16 (&acc)[2][2]) {
  const int tid = threadIdx.x & 255, lane = tid & 63, wave = tid >> 6, wm = wave >> 1, wn = wave & 1;
  const int l31 = lane & 31, h = lane >> 5;
  bf16_t* As = (bf16_t*)lds;
  bf16_t* Bs = As + 128 * 72;
#pragma unroll
  for (int a = 0; a < 2; ++a)
#pragma unroll
    for (int b = 0; b < 2; ++b)
#pragma unroll
      for (int i = 0; i < 16; ++i) acc[a][b][i] = 0.f;
  const int lr = tid >> 3, lc = (tid & 7) * 8;
  const bf16_t* Ag = A + (size_t)lr * lda + lc;
  const bf16_t* Bg = B + (size_t)lr * ldb + lc;
  u32x4 ra[4], rb[4];
#pragma unroll
  for (int q = 0; q < 4; ++q) {
    ra[q] = *(const u32x4*)(Ag + (size_t)(32 * q) * lda);
    rb[q] = *(const u32x4*)(Bg + (size_t)(32 * q) * ldb);
  }
#pragma unroll
  for (int q = 0; q < 4; ++q) {
    *(u32x4*)(As + (lr + 32 * q) * 72 + lc) = ra[q];
    *(u32x4*)(Bs + (lr + 32 * q) * 72 + lc) = rb[q];
  }
  __syncthreads();
  const int nk = K >> 6;
  for (int kt = 0; kt < nk; ++kt) {
    if (kt + 1 < nk) {
#pragma unroll
      for (int q = 0; q < 4; ++q) {
        ra[q] = *(const u32x4*)(Ag + (size_t)(32 * q) * lda + (kt + 1) * 64);
        rb[q] = *(const u32x4*)(Bg + (size_t)(32 * q) * ldb + (kt + 1) * 64);
      }
    }
#pragma unroll
    for (int ks = 0; ks < 4; ++ks) {
      bf16x8 a[2], b[2];
#pragma unroll
      for (int t = 0; t < 2; ++t) {
        a[t] = *(const bf16x8*)(As + (wm * 64 + t * 32 + l31) * 72 + ks * 16 + 8 * h);
        b[t] = *(const bf16x8*)(Bs + (wn * 64 + t * 32 + l31) * 72 + ks * 16 + 8 * h);
      }
#pragma unroll
      for (int mt = 0; mt < 2; ++mt)
#pragma unroll
        for (int nt = 0; nt < 2; ++nt) acc[mt][nt] = MFMA32(a[mt], b[nt], acc[mt][nt]);
    }
    __syncthreads();
    if (kt + 1 < nk) {
#pragma unroll
      for (int q = 0; q < 4; ++q) {
        *(u32x4*)(As + (lr + 32 * q) * 72 + lc) = ra[q];
        *(u32x4*)(Bs + (lr + 32 * q) * 72 + lc) = rb[q];
      }
      __syncthreads();
    }
  }
}
#define ACC_ROW(mt, i) (wm * 64 + (mt) * 32 + ((i) & 3) + 8 * ((i) >> 2) + 4 * h)
#define ACC_COL(nt) (wn * 64 + (nt) * 32 + l31)
#define GEMM_IDS const int lane = threadIdx.x & 63, wave = (threadIdx.x & 255) >> 6, wm = wave >> 1, wn = wave & 1, l31 = lane & 31, h = lane >> 5; (void)wm; (void)wn; (void)l31; (void)h;

DI void phase_gemm_small(const bf16_t* A, int lda, const bf16_t* W, int N, int K, bf16_t* C, int ldc, char* lds) {
  GEMM_IDS
  const int sb = threadIdx.x >> 8;
  const int ntn = N / 128;
  const int total = NT_ * ntn;
  for (int t0 = blockIdx.x * 2; t0 < total; t0 += gridDim.x * 2) {
    const int t = t0 + sb;
    const int tm = t / ntn, tn = t - tm * ntn;
    f32x16 acc[2][2];
    gemm_tile(A + (size_t)tm * 128 * lda, lda, W + (size_t)tn * 128 * K, K, K, lds + sb * 36864, acc);
#pragma unroll
    for (int mt = 0; mt < 2; ++mt)
#pragma unroll
      for (int nt = 0; nt < 2; ++nt)
#pragma unroll
        for (int i = 0; i < 16; ++i) {
          int row = tm * 128 + ACC_ROW(mt, i), col = tn * 128 + ACC_COL(nt);
          C[(size_t)row * ldc + col] = f2bf(acc[mt][nt][i]);
        }
  }
}

namespace pg8 {
#define PG8_LAS __attribute__((address_space(3)))
typedef unsigned short bf16_t;
typedef short bf16x8 __attribute__((ext_vector_type(8)));
typedef float f32x4 __attribute__((ext_vector_type(4)));
typedef unsigned u32x4 __attribute__((ext_vector_type(4)));
constexpr int BM = 256, BK = 64, HALF = 128, HTB = HALF * BK * 2  , STAGE_BYTES = 8 * HTB, NXCD = 8, WGM = 8;

__host__ __device__ __forceinline__ int lds_byte(int r, int c) { const int st = (r >> 4) * 2 + (c >> 5), rr = r & 15, cc = c & 31, ob = rr * 64 + cc * 2; return st * 1024 + (ob ^ (((ob >> 9) & 1) << 5)); }
__host__ __device__ __forceinline__ void stage_rc(int b, int& R, int& C) { const int st = b / 1024, sb = b % 1024, swz = sb ^ (((sb >> 9) & 1) << 5); R = (st >> 1) * 16 + swz / 64; C = (st & 1) * 32 + (swz % 64) / 2; }
__host__ __device__ __forceinline__ int perm32(int rho) { const int n = rho >> 4, i = rho & 15; return 8 * (i >> 2) + 4 * n + (i & 3); }

struct Unit { int pm, pn; };
struct Gemm { const bf16_t* A; const bf16_t* Bt; int M, N, K; };

struct StaticOrder {
    int nM, nN, nwg, G, c;
    __host__ __device__ void init(int M, int N, int G_, int c_) { nM = M / BM; nN = N / BM; nwg = nM * nN; G = G_; c = c_; }
    __host__ __device__ bool next(int i, Unit& u) const {
        const long L = (long)i * G + c; if (L >= nwg) return false;
        int wgid = (int)L; { const int q = nwg / NXCD, r = nwg % NXCD, xcd = wgid % NXCD, off = wgid / NXCD; wgid = (xcd < r ? xcd * (q + 1) : r * (q + 1) + (xcd - r) * q) + off; }
        const int nig = WGM * nN, gid = wgid / nig, fm = gid * WGM, gsz = (nM - fm) < WGM ? (nM - fm) : WGM;
        u.pm = fm + ((wgid % nig) % gsz); u.pn = (wgid % nig) / gsz; return true;
    }
    __device__ __forceinline__ void a_ready(const Unit&) const {}
    __device__ __forceinline__ void done(const Unit&) const {}
};
__device__ __forceinline__ unsigned cvt_pk_bf16(float lo, float hi) { unsigned r; asm volatile("v_cvt_pk_bf16_f32 %0, %1, %2" : "=v"(r) : "v"(lo), "v"(hi)); return r; }

struct EpiRoute {
    static constexpr bool PERM = true, AFTER_DRAIN = false;
    bf16_t* O; int ldc; int route; bf16_t* pc; bf16_t* prkv; bf16_t* plow;
    __device__ __forceinline__ void operator()(const f32x4 (&acc)[2][2][4][2], const Unit& u, int wr, int wc, int fr, int fq) const {
        const int row0 = u.pm * BM + wr * 64 + fr;
#pragma unroll
        for (int bj = 0; bj < 2; ++bj) {
            int colh = u.pn * BM + bj * HALF; bf16_t* base = O; int ld = ldc;
            if (route) {
                if (colh < 768) { base = pc; ld = 768; }
                else if (colh < 2304) { base = prkv; ld = 1536; colh -= 768; }
                else if (colh < 2688) { base = plow; ld = 384; colh -= 2304; }
                else continue;
            }
            const int col0 = colh + wc * 32 + 8 * fq;
#pragma unroll
            for (int ai = 0; ai < 2; ++ai)
#pragma unroll
                for (int m = 0; m < 4; ++m) { bf16_t* rowp = base + (size_t)(row0 + ai * HALF + m * 16) * ld + col0;
                    const f32x4 v0 = acc[ai][bj][m][0], v1 = acc[ai][bj][m][1];
                    u32x4 w; w.x = cvt_pk_bf16(v0[0], v0[1]); w.y = cvt_pk_bf16(v0[2], v0[3]); w.z = cvt_pk_bf16(v1[0], v1[1]); w.w = cvt_pk_bf16(v1[2], v1[3]);
                    *(u32x4*)rowp = w; }
        }
    }
};
struct EpiGateUp {
    static constexpr bool PERM = true, AFTER_DRAIN = false;
    bf16_t* ACT;
    __device__ __forceinline__ void operator()(const f32x4 (&acc)[2][2][4][2], const Unit& u, int wr, int wc, int fr, int fq) const {
        const int row0 = u.pm * BM + wr * 64 + fr, col0 = u.pn * HALF + wc * 32 + 8 * fq;
#pragma unroll
        for (int ai = 0; ai < 2; ++ai)
#pragma unroll
            for (int m = 0; m < 4; ++m) { bf16_t* rowp = ACT + (size_t)(row0 + ai * HALF + m * 16) * 2816 + col0;
                float v[8];
#pragma unroll
                for (int n = 0; n < 2; ++n)
#pragma unroll
                    for (int j = 0; j < 4; ++j) { const float g = acc[ai][0][m][n][j], uu = acc[ai][1][m][n][j]; v[n * 4 + j] = g * __builtin_amdgcn_rcpf(1.f + __expf(-g)) * uu; }
                u32x4 w; w.x = cvt_pk_bf16(v[0], v[1]); w.y = cvt_pk_bf16(v[2], v[3]); w.z = cvt_pk_bf16(v[4], v[5]); w.w = cvt_pk_bf16(v[6], v[7]);
                *(u32x4*)rowp = w; }
    }
};
template <class Epi, class Sched, bool STAMP = false>
__device__ __forceinline__ void gemm_phase(PG8_LAS unsigned char* lds, const Gemm g, const Sched& S, const Epi& E, unsigned long long* stamps) {
    const int tid = threadIdx.x, wid = __builtin_amdgcn_readfirstlane(tid >> 6), lane = tid & 63, wr = wid >> 2, wc = wid & 3, fr = lane & 15, fq = lane >> 4;
    const int K = g.K, nt = K / BK;
    int ts_lo = 0, ts_hi = 0, nts = 0; const unsigned long long rt_entry = STAMP ? (unsigned long long)wall_clock64() : 0ull;
#define PG8_STAMP() do { if (STAMP && wid == 0 && nts < 64) { const unsigned long long _c = (unsigned long long)clock64(); \
        ts_lo = (lane == nts) ? (int)(unsigned)_c : ts_lo; ts_hi = (lane == nts) ? (int)(unsigned)(_c >> 32) : ts_hi; ++nts; } } while (0)
    PG8_STAMP();
    unsigned voffA[2], voffB[2];
#pragma unroll
    for (int i = 0; i < 2; ++i) { int R, C; stage_rc(tid * 16 + i * 8192, R, C); const int Rb = Epi::PERM ? ((R & ~31) + perm32(R & 31)) : R;
        voffA[i] = (unsigned)(R * K + C) * 2u; voffB[i] = (unsigned)(Rb * K + C) * 2u; }
    const size_t kstep = (size_t)(BK * 2);
    const size_t hstep = (size_t)HALF * K * 2;
    const size_t tstep = 2 * hstep;
    const unsigned ldsw = (unsigned)wid * 1024u;
    const int aoff = lds_byte(wr * 64 + fr, fq * 8), boff = lds_byte(wc * 32 + fr, fq * 8);
#define PG8_SA(b, h) (((b) * 2 + (h)) * HTB)
#define PG8_SB(b, h) ((4 + (b) * 2 + (h)) * HTB)
#define PG8_STAGE(bufoff, gbase, voff) do { _Pragma("unroll") for (int _i = 0; _i < 2; ++_i) \
        __builtin_amdgcn_global_load_lds((const unsigned*)((const char*)(gbase) + (voff)[_i]), (PG8_LAS unsigned*)(lds + (bufoff) + ldsw + _i * 8192), 16, 0, 0); } while (0)
#define PG8_LDA(dst, b, h) do { _Pragma("unroll") for (int m = 0; m < 4; ++m) _Pragma("unroll") for (int k = 0; k < 2; ++k) dst[m][k] = *(const PG8_LAS bf16x8*)(lds + PG8_SA(b, h) + aoff + m * 2048 + k * 1024); } while (0)
#define PG8_LDB(dst, b, h) do { _Pragma("unroll") for (int n = 0; n < 2; ++n) _Pragma("unroll") for (int k = 0; k < 2; ++k) dst[n][k] = *(const PG8_LAS bf16x8*)(lds + PG8_SB(b, h) + boff + n * 2048 + k * 1024); } while (0)
#define PG8_MMA(ai, bj, At, Bt) do { __builtin_amdgcn_s_setprio(1); _Pragma("unroll") for (int m = 0; m < 4; ++m) _Pragma("unroll") for (int n = 0; n < 2; ++n) _Pragma("unroll") for (int k = 0; k < 2; ++k) \
        acc[ai][bj][m][n] = __builtin_amdgcn_mfma_f32_16x16x32_bf16(Bt[n][k], At[m][k], acc[ai][bj][m][n], 0, 0, 0); __builtin_amdgcn_s_setprio(0); } while (0)
#define PG8_WAIT_V(n) asm volatile("s_waitcnt vmcnt(" #n ")" ::: "memory")
#define PG8_WAIT_L(n) asm volatile("s_waitcnt lgkmcnt(" #n ")" ::: "memory")
#define PG8_BAR __builtin_amdgcn_s_barrier()
#define PG8_SCHED __builtin_amdgcn_sched_barrier(0)
    Unit cur, nxt; int ui = 0;
    if (!S.next(0, cur)) return;
    f32x4 acc[2][2][4][2];
#pragma unroll
    for (int a = 0; a < 2; ++a)
#pragma unroll
        for (int b = 0; b < 2; ++b)
#pragma unroll
            for (int m = 0; m < 4; ++m)
#pragma unroll
                for (int n = 0; n < 2; ++n) acc[a][b][m][n] = (f32x4){0.f, 0.f, 0.f, 0.f};
    bf16x8 At[4][2], B0[2][2], B1[2][2];
    const char* cA = (const char*)g.A + (size_t)cur.pm * tstep; const char* cB = (const char*)g.Bt + (size_t)cur.pn * tstep;
    S.a_ready(cur);
    PG8_STAGE(PG8_SB(0, 0), cB, voffB); PG8_STAGE(PG8_SA(0, 0), cA, voffA); PG8_STAGE(PG8_SB(0, 1), cB + hstep, voffB); PG8_STAGE(PG8_SA(0, 1), cA + hstep, voffA);
    if (wr == 1) PG8_BAR;
    PG8_WAIT_V(4); PG8_BAR;
    PG8_STAGE(PG8_SB(1, 0), cB + kstep, voffB); PG8_STAGE(PG8_SA(1, 0), cA + kstep, voffA); PG8_STAGE(PG8_SB(1, 1), cB + hstep + kstep, voffB);
    PG8_WAIT_V(6); PG8_BAR;
    PG8_STAMP();
    for (;;) {
        const bool has_next = S.next(ui + 1, nxt);
        const char* nA = has_next ? (const char*)g.A + (size_t)nxt.pm * tstep : cA; const char* nB = has_next ? (const char*)g.Bt + (size_t)nxt.pn * tstep : cB;
        for (int t = 0; t < nt; t += 2) {
            const bool last = (t == nt - 2);
            const char* a1 = cA + (size_t)(t + 1) * kstep;
            const char* a2 = last ? nA : cA + (size_t)(t + 2) * kstep; const char* b2 = last ? nB : cB + (size_t)(t + 2) * kstep;
            const char* a3 = a2 + kstep; const char* b3 = b2 + kstep;
            if (last && has_next) S.a_ready(nxt);
            PG8_LDB(B0, 0, 0); PG8_SCHED; PG8_LDA(At, 0, 0); PG8_STAGE(PG8_SA(1, 1), a1 + hstep, voffA);
            PG8_WAIT_L(8); PG8_BAR; PG8_WAIT_L(0); PG8_MMA(0, 0, At, B0); PG8_BAR; PG8_SCHED;
            PG8_LDB(B1, 0, 1); PG8_STAGE(PG8_SB(0, 0), b2, voffB);
            PG8_BAR; PG8_WAIT_L(0); PG8_MMA(0, 1, At, B1); PG8_BAR;
            PG8_LDA(At, 0, 1); PG8_STAGE(PG8_SA(0, 0), a2, voffA);
            PG8_BAR; PG8_WAIT_L(0); PG8_MMA(1, 0, At, B0); PG8_BAR; PG8_SCHED;
            PG8_STAGE(PG8_SB(0, 1), b2 + hstep, voffB);
            PG8_WAIT_V(6); PG8_BAR; PG8_MMA(1, 1, At, B1); PG8_BAR;
            PG8_LDB(B0, 1, 0); PG8_SCHED; PG8_LDA(At, 1, 0); PG8_STAGE(PG8_SA(0, 1), a2 + hstep, voffA);
            PG8_WAIT_L(8); PG8_BAR; PG8_WAIT_L(0); PG8_MMA(0, 0, At, B0); PG8_BAR; PG8_SCHED;
            PG8_LDB(B1, 1, 1); PG8_STAGE(PG8_SB(1, 0), b3, voffB);
            PG8_BAR; PG8_WAIT_L(0); PG8_MMA(0, 1, At, B1); PG8_BAR;
            PG8_LDA(At, 1, 1); PG8_STAGE(PG8_SA(1, 0), a3, voffA);
            PG8_BAR; PG8_WAIT_L(0); PG8_MMA(1, 0, At, B0); PG8_BAR; PG8_SCHED;
            PG8_STAGE(PG8_SB(1, 1), b3 + hstep, voffB);
            PG8_WAIT_V(6); PG8_BAR; PG8_MMA(1, 1, At, B1); PG8_BAR;
        }
        PG8_STAMP();
        if constexpr (!Epi::AFTER_DRAIN) { E(acc, cur, wr, wc, fr, fq); S.done(cur); }
        PG8_STAMP();
        if (!has_next) break;
#pragma unroll
        for (int a = 0; a < 2; ++a)
#pragma unroll
            for (int b = 0; b < 2; ++b)
#pragma unroll
                for (int m = 0; m < 4; ++m)
#pragma unroll
                    for (int n = 0; n < 2; ++n) acc[a][b][m][n] = (f32x4){0.f, 0.f, 0.f, 0.f};
        cur = nxt; cA = nA; cB = nB; ++ui;
    }
    PG8_WAIT_V(0);
    if (wr == 0) PG8_BAR;
    PG8_BAR;
    if constexpr (Epi::AFTER_DRAIN) { E.fused(acc, cur, wr, wc, fr, fq, lds, wid, lane); S.done(cur); }
    PG8_STAMP();
    if (STAMP && wid == 0) { stamps[lane] = lane < nts ? (((unsigned long long)(unsigned)ts_hi << 32) | (unsigned)ts_lo) : 0ull;
        if (lane == 62) stamps[62] = rt_entry; if (lane == 63) stamps[63] = (unsigned long long)wall_clock64(); }
#undef PG8_STAMP
#undef PG8_SA
#undef PG8_SB
#undef PG8_STAGE
#undef PG8_LDA
#undef PG8_LDB
#undef PG8_MMA
#undef PG8_WAIT_V
#undef PG8_WAIT_L
#undef PG8_BAR
#undef PG8_SCHED
}
}

DI void phase_gemm_big(const bf16_t* A, const bf16_t* W, int N, int K, bf16_t* C, int ldc, int route, char* ws, unsigned char* lds) {
  pg8::Gemm g{A, W, TP_, N, K};
  pg8::StaticOrder S; S.init(TP_, N, gridDim.x, blockIdx.x);
  pg8::EpiRoute E{C, ldc, route, (bf16_t*)(ws + O_PC), (bf16_t*)(ws + O_PRKV), (bf16_t*)(ws + O_PLOW)};
  pg8::gemm_phase<pg8::EpiRoute, pg8::StaticOrder, false>((PG8_LAS unsigned char*)lds, g, S, E, nullptr);
}
DI void phase_gemm_gateup(const bf16_t* A, const bf16_t* W, bf16_t* ACT, unsigned char* lds) {
  pg8::Gemm g{A, W, TP_, 5632, 1024};
  pg8::StaticOrder S; S.init(TP_, 5632, gridDim.x, blockIdx.x);
  pg8::EpiGateUp E{ACT};
  pg8::gemm_phase<pg8::EpiGateUp, pg8::StaticOrder, false>((PG8_LAS unsigned char*)lds, g, S, E, nullptr);
}

DI void phase_resnorm(const P& p, const float* g1, const float* g2) {
  const int lane = threadIdx.x & 63, gw = (blockIdx.x * NTH + threadIdx.x) >> 6, nw = (gridDim.x * NTH) >> 6;
  bf16_t* HN = (bf16_t*)(p.ws + O_HN);
  for (int sr = gw; sr < T_; sr += nw) {
    float* hr = hrow(p, sr);
    float x[16];
    float ss = 0.f;
#pragma unroll
    for (int q = 0; q < 4; ++q) {
      const uint2 u = *(const uint2*)(HN + (size_t)sr * 1024 + q * 256 + lane * 4);
      x[q * 4] = lo2f(u.x); x[q * 4 + 1] = hi2f(u.x); x[q * 4 + 2] = lo2f(u.y); x[q * 4 + 3] = hi2f(u.y);
      ss += x[q * 4] * x[q * 4] + x[q * 4 + 1] * x[q * 4 + 1] + x[q * 4 + 2] * x[q * 4 + 2] + x[q * 4 + 3] * x[q * 4 + 3];
    }
    f32x4v hh[4];
#pragma unroll
    for (int q = 0; q < 4; ++q) hh[q] = *(const f32x4v*)(hr + q * 256 + lane * 4);
    ss = wave_sum(ss);
    const float rs = rsqrtf(ss * (1.f / 1024.f) + EPS);
    float ss2 = 0.f;
#pragma unroll
    for (int q = 0; q < 4; ++q) {
      const float4 g = *(const float4*)(g1 + q * 256 + lane * 4);
      hh[q].x += x[q * 4 + 0] * rs * g.x; hh[q].y += x[q * 4 + 1] * rs * g.y; hh[q].z += x[q * 4 + 2] * rs * g.z; hh[q].w += x[q * 4 + 3] * rs * g.w;
      *(f32x4v*)(hr + q * 256 + lane * 4) = hh[q];
      ss2 += hh[q].x * hh[q].x + hh[q].y * hh[q].y + hh[q].z * hh[q].z + hh[q].w * hh[q].w;
    }
    if (g2) {
      ss2 = wave_sum(ss2);
      const float rs2 = rsqrtf(ss2 * (1.f / 1024.f) + EPS);
#pragma unroll
      for (int q = 0; q < 4; ++q) {
        const float4 g = *(const float4*)(g2 + q * 256 + lane * 4);
        *(uint2*)(HN + (size_t)sr * 1024 + q * 256 + lane * 4) = make_uint2(pack2(hh[q].x * rs2 * g.x, hh[q].y * rs2 * g.y), pack2(hh[q].z * rs2 * g.z, hh[q].w * rs2 * g.w));
      }
    }
  }
}

DI size_t vta_base(int seq) { return seq < 8 ? (size_t)seq * 256 * 4160 : (size_t)8 * 256 * 4160; }
template <int NC> DI void vt_transpose(const bf16_t* src, int ld, int col0, bf16_t* VT, char* lds) {
  bf16_t* tl = (bf16_t*)lds;
  const int tid = threadIdx.x;
  constexpr int CPT = NC / 8, TPR = 512 / NC, PPT = 64 / TPR;
  for (int it = blockIdx.x; it < 257 + 8 * 65; it += gridDim.x) {
    int seq, kt;
    if (it < 257) { seq = 8; kt = it; } else { const int j = it - 257; seq = j / 65; kt = j - seq * 65; }
    const int L = seq_len(seq), LP = L + 48, sbase = seq_base(seq);
    const size_t vb = (seq < 8 ? (size_t)seq * NC * 4160 : (size_t)8 * NC * 4160);
    __syncthreads();
    const int pl = tid >> 3, part = tid & 7;
    const int pos = 64 * kt + pl - 48;
#pragma unroll
    for (int q = 0; q < CPT / 8; ++q) {
      u32x4 v = (u32x4)(0u);
      if (pos >= 0) v = *(const u32x4*)(src + (size_t)(sbase + pos) * ld + col0 + part * CPT + q * 8);
#pragma unroll
      for (int j = 0; j < 4; ++j) {
        tl[(part * CPT + q * 8 + 2 * j) * 72 + pl] = (bf16_t)(v[j] & 0xffffu);
        tl[(part * CPT + q * 8 + 2 * j + 1) * 72 + pl] = (bf16_t)(v[j] >> 16);
      }
    }
    __syncthreads();
    const int row = tid / TPR, seg = tid % TPR;
    bf16_t* dst = VT + vb + (size_t)row * LP + 64 * kt + seg * PPT;
#pragma unroll
    for (int q = 0; q < PPT / 8; ++q) *(u32x4*)(dst + q * 8) = *(const u32x4*)(tl + row * 72 + seg * PPT + q * 8);
  }
}

DI void phase_prepA(const P& p, char* lds) {
  const int lane = threadIdx.x & 63, wave = threadIdx.x >> 6;
  bf16_t* PROJ = (bf16_t*)(p.ws + O_PROJ0);
  bf16_t* ZB = (bf16_t*)(p.ws + O_ZB);
  const float* WC = (const float*)(p.ws + O_WC);
  vt_transpose<256>(PROJ, 1536, 1024, (bf16_t*)(p.ws + O_VTA), lds);
  __syncthreads();
  float* fl = (float*)lds + wave * 1024;
  const float inv = exp2f(-(float)(lane & 15) * (13.287712379549449f / 16.f));
  const float qg = p.a_q_gain[lane], kg = p.a_k_gain[lane];
  for (int r0 = blockIdx.x * 32; r0 < TP_; r0 += gridDim.x * 32) {
    const int srb = r0 + wave * 4;
#pragma unroll 1
    for (int rr = 0; rr < 4; ++rr) {
      const int sr = srb + rr;
      if (sr < T_) {
        int pos; seq_of(sr, pos);
        float rowf, colf;
        if (pos < 16) { rowf = colf = (float)(pos - 16); }
        else { int t = pos - 16; rowf = (float)(t >> 6); colf = (float)(t & 63); }
        float ang = (lane < 32 ? rowf : colf) * inv;
        float sn, cs;
        sincosf(ang, &sn, &cs);
        const float sgn = (lane & 16) ? sn : -sn;
        bf16_t* pr = PROJ + (size_t)sr * 1536;
        for (int hd = 0; hd < 16; ++hd) {
          float x = bf2f(pr[hd * 64 + lane]);
          float ss = wave_sum(x * x);
          float xn = x * rsqrtf(ss * (1.f / 64.f) + EPS) * (hd < 12 ? qg : kg);
          float pa = __shfl_xor(xn, 16);
          float o = xn * cs + pa * sgn;
          if (hd < 12) o *= 0.125f * LOG2E;
          pr[hd * 64 + lane] = f2bf(o);
        }
        uint2 u = *(const uint2*)(pr + 1280 + lane * 4);
        float f0 = lo2f(u.x), f1 = hi2f(u.x), f2 = lo2f(u.y), f3 = hi2f(u.y);
        float ss = f0 * f0 + f1 * f1 + f2 * f2 + f3 * f3;
        ss += __shfl_xor(ss, 1); ss += __shfl_xor(ss, 2); ss += __shfl_xor(ss, 4); ss += __shfl_xor(ss, 8);
        float rs = rsqrtf(ss * (1.f / 64.f) + EPS);
        float4 g = *(const float4*)(p.b_norm_g + lane * 4);
        *(float4*)(fl + rr * 256 + lane * 4) = make_float4(f0 * rs * g.x, f1 * rs * g.y, f2 * rs * g.z, f3 * rs * g.w);
      } else {
        *(float4*)(fl + rr * 256 + lane * 4) = make_float4(0.f, 0.f, 0.f, 0.f);
      }
    }
    __syncthreads();
    {
      const int g = lane >> 4, o0 = (lane & 15) * 8;
      float acc[4][8];
#pragma unroll
      for (int rr = 0; rr < 4; ++rr)
#pragma unroll
        for (int j = 0; j < 8; ++j) acc[rr][j] = 0.f;
      const float* wc = WC + (size_t)g * 64 * 128 + o0;
#pragma unroll 4
      for (int c = 0; c < 64; ++c) {
        const float4 w0 = *(const float4*)(wc + c * 128), w1 = *(const float4*)(wc + c * 128 + 4);
#pragma unroll
        for (int rr = 0; rr < 4; ++rr) {
          const float f = fl[rr * 256 + g * 64 + c];
          acc[rr][0] += f * w0.x; acc[rr][1] += f * w0.y; acc[rr][2] += f * w0.z; acc[rr][3] += f * w0.w;
          acc[rr][4] += f * w1.x; acc[rr][5] += f * w1.y; acc[rr][6] += f * w1.z; acc[rr][7] += f * w1.w;
        }
      }
#pragma unroll
      for (int rr = 0; rr < 4; ++rr)
        if (srb + rr < T_)
          *(uint4*)(ZB + (size_t)(srb + rr) * 512 + g * 128 + o0) = make_uint4(pack2(acc[rr][0], acc[rr][1]), pack2(acc[rr][2], acc[rr][3]), pack2(acc[rr][4], acc[rr][5]), pack2(acc[rr][6], acc[rr][7]));
    }
    __syncthreads();
  }
}

template <int MODE>
DI void flash_item(const bf16_t* __restrict__ Q, int ldq, const bf16_t* __restrict__ Kb, int ldk, const bf16_t* __restrict__ Vt, int LP,
                   bf16_t* O, int ldo, int sbase, int S, int qt, float sinkl2, char* lds) {
  const int tid = threadIdx.x & 255, lane = tid & 63, wave = tid >> 6, l31 = lane & 31, h = lane >> 5;
  bf16_t* Ks = (bf16_t*)lds;
  bf16_t* Vs = Ks + 2 * 64 * 72;
  const int rl = wave * 32 + l31;
  const int qpos = qt == 0 ? (rl < 16 ? rl : 15) : 16 + 128 * (qt - 1) + rl;
  const bool qvalid = qt > 0 || rl < 16;
  bf16x8 qf[4];
  {
    const bf16_t* qr = Q + (size_t)(sbase + qpos) * ldq;
#pragma unroll
    for (int s = 0; s < 4; ++s) qf[s] = *(const bf16x8*)(qr + 16 * s + 8 * h);
  }
  const int nkt_all = (S + 64) / 64;
  int klo = 1, n;
  if (MODE == 0) { n = nkt_all; }
  else {
    if (qt == 0) { klo = 1; n = 3; }
    else {
      int c = qt - 1;
      klo = 2 * c - 1; if (klo < 1) klo = 1;
      int khi = 2 * c + 4; if (khi > nkt_all - 1) khi = nkt_all - 1;
      n = 1 + (khi - klo + 1);
    }
  }
  const int ldr = tid >> 2, ldp = (tid & 3) * 16;
  u32x4 rk0, rk1, rv0, rv1;
  auto ktile = [&](int idx) { return idx == 0 ? 0 : klo + idx - 1; };
#define FL_GLOAD(idx)                                                                               \
  {                                                                                                 \
    int kt_ = ktile(idx);                                                                           \
    int pos_ = 64 * kt_ + ldr - 48;                                                                 \
    if (pos_ >= 0) {                                                                                \
      const bf16_t* kp_ = Kb + (size_t)(sbase + pos_) * ldk + ldp;                                  \
      rk0 = *(const u32x4*)kp_; rk1 = *(const u32x4*)(kp_ + 8);                                 \
    } else { rk0 = (u32x4)(0u); rk1 = rk0; }                                       \
    const bf16_t* vp_ = Vt + (size_t)ldr * LP + 64 * kt_ + ldp;                                     \
    rv0 = *(const u32x4*)vp_; rv1 = *(const u32x4*)(vp_ + 8);                                   \
  }
#define FL_SSTORE(buf)                                                                              \
  {                                                                                                 \
    *(u32x4*)(Ks + (buf) * 64 * 72 + ldr * 72 + ldp) = rk0; *(u32x4*)(Ks + (buf) * 64 * 72 + ldr * 72 + ldp + 8) = rk1; \
    { bf16_t* vd_ = Vs + (buf) * 64 * 68 + ldr * 68 + ldp; *(uint2*)vd_ = make_uint2(rv0.x, rv0.y); *(uint2*)(vd_ + 4) = make_uint2(rv0.z, rv0.w); *(uint2*)(vd_ + 8) = make_uint2(rv1.x, rv1.y); *(uint2*)(vd_ + 12) = make_uint2(rv1.z, rv1.w); } \
  }
  f32x16 oacc[2];
#pragma unroll
  for (int i = 0; i < 16; ++i) { oacc[0][i] = 0.f; oacc[1][i] = 0.f; }
  float m = -1e30f, l = 0.f;
  FL_GLOAD(0)
  FL_SSTORE(0)
  __syncthreads();
  for (int idx = 0; idx < n; ++idx) {
    const int cur = idx & 1;
    if (idx + 1 < n) FL_GLOAD(idx + 1)
    const int kt = ktile(idx);
    const bf16_t* ks = Ks + cur * 64 * 72;
    const bf16_t* vs = Vs + cur * 64 * 68;
    f32x16 sacc[2];
#pragma unroll
    for (int t = 0; t < 2; ++t) {
#pragma unroll
      for (int i = 0; i < 16; ++i) sacc[t][i] = 0.f;
#pragma unroll
      for (int s = 0; s < 4; ++s) {
        bf16x8 kf = *(const bf16x8*)(ks + (32 * t + l31) * 72 + 16 * s + 8 * h);
        sacc[t] = MFMA32(kf, qf[s], sacc[t]);
      }
    }
    if (kt == 0) {
#pragma unroll
      for (int t = 0; t < 2; ++t)
#pragma unroll
        for (int i = 0; i < 16; ++i) {
          int kl = 32 * t + (i & 3) + 8 * (i >> 2) + 4 * h;
          if (kl < 48) sacc[t][i] = -1e30f;
        }
    } else if (MODE == 1) {
#pragma unroll
      for (int t = 0; t < 2; ++t)
#pragma unroll
        for (int i = 0; i < 16; ++i) {
          int kl = 32 * t + (i & 3) + 8 * (i >> 2) + 4 * h;
          int tk = 64 * (kt - 1) + kl;
          bool vis;
          if (qt == 0) vis = tk <= 112 + qpos;
          else { int tq = qpos - 16; int d = tq - tk; vis = d <= 128 && d >= -128; }
          if (!vis) sacc[t][i] = -1e30f;
        }
    }
    float tmax = -1e30f;
#pragma unroll
    for (int t = 0; t < 2; ++t)
#pragma unroll
      for (int i = 0; i < 16; ++i) tmax = fmaxf(tmax, sacc[t][i]);
    tmax = fmaxf(tmax, __shfl_xor(tmax, 32));
    if (__builtin_amdgcn_ballot_w64(tmax > m) != 0ull) {
      const float mn = fmaxf(m, tmax);
      const float alpha = __builtin_amdgcn_exp2f(m - mn);
      m = mn;
      l *= alpha;
#pragma unroll
      for (int i = 0; i < 16; ++i) { oacc[0][i] *= alpha; oacc[1][i] *= alpha; }
    }
    const f32x2 m2 = {m, m};
    f32x2 ls2 = {0.f, 0.f};
    unsigned pk[2][8];
#pragma unroll
    for (int t = 0; t < 2; ++t)
#pragma unroll
      for (int i2 = 0; i2 < 8; ++i2) {
        f32x2 d = {sacc[t][2 * i2], sacc[t][2 * i2 + 1]};
        d = d - m2;
        f32x2 e = {__builtin_amdgcn_exp2f(d.x), __builtin_amdgcn_exp2f(d.y)};
        ls2 += e;
        pk[t][i2] = __builtin_bit_cast(unsigned, __builtin_convertvector(e, bf16x2_t));
      }
    l += ls2.x + ls2.y;
#pragma unroll
    for (int t = 0; t < 2; ++t)
#pragma unroll
      for (int s2 = 0; s2 < 2; ++s2) {
        u32x4 pk4 = {pk[t][4 * s2], pk[t][4 * s2 + 1], pk[t][4 * s2 + 2], pk[t][4 * s2 + 3]};
        bf16x8 pf = __builtin_bit_cast(bf16x8, pk4);
#pragma unroll
        for (int dt = 0; dt < 2; ++dt) {
          const bf16_t* vp = vs + (32 * dt + l31) * 68 + 32 * t + 16 * s2 + 4 * h;
          uint2 lo = *(const uint2*)vp, hi = *(const uint2*)(vp + 8);
          u32x4 v4 = {lo.x, lo.y, hi.x, hi.y};
          bf16x8 vf = __builtin_bit_cast(bf16x8, v4);
          oacc[dt] = MFMA32(vf, pf, oacc[dt]);
        }
      }
    if (idx + 1 < n) FL_SSTORE(cur ^ 1)
    __syncthreads();
  }
  l += __shfl_xor(l, 32);
  if (MODE == 1) l += __builtin_amdgcn_exp2f(sinkl2 - m);
  const float il = 1.f / l;
  if (qvalid) {
    bf16_t* orow = O + (size_t)(sbase + qpos) * ldo;
#pragma unroll
    for (int dt = 0; dt < 2; ++dt)
#pragma unroll
      for (int g = 0; g < 4; ++g) {
        int d = 32 * dt + 8 * g + 4 * h;
        uint2 o = make_uint2(pack2(oacc[dt][4 * g] * il, oacc[dt][4 * g + 1] * il), pack2(oacc[dt][4 * g + 2] * il, oacc[dt][4 * g + 3] * il));
        *(uint2*)(orow + d) = o;
      }
  }
#undef FL_GLOAD
#undef FL_SSTORE
}

DI size_t y_base(int seq) { return seq < 8 ? (size_t)seq * 16 * 256 * 576 : (size_t)8 * 16 * 256 * 576; }
DI void phase_attnA(const P& p, char* lds) {
  const bf16_t* PROJ = (const bf16_t*)(p.ws + O_PROJ0);
  const bf16_t* VT = (const bf16_t*)(p.ws + O_VTA);
  bf16_t* MIX = (bf16_t*)(p.ws + O_MIX);
  const int nS = 129 * 6, nP = 8 * 33 * 6;
  const int sb = threadIdx.x >> 8;
  unsigned* head = (unsigned*)(p.ws + O_CNT);
  for (;;) {
    if (threadIdx.x == 0) *(volatile int*)(lds + 2 * 36864) = (int)__hip_atomic_fetch_add(head, 1u, __ATOMIC_RELAXED, __HIP_MEMORY_SCOPE_AGENT);
    __syncthreads();
    const int it = *(volatile int*)(lds + 2 * 36864);
    __syncthreads();
    if (it >= nS + nP) break;
    int seq, qt, hq;
    if (it < nS) { seq = 8; hq = (it % 6) * 2 + sb; qt = it / 6; }
    else { int j = it - nS; hq = (j % 6) * 2 + sb; j /= 6; qt = j % 33; seq = j / 33; }
    const int kv = hq / 3;
    const int L = seq_len(seq), LP = L + 48;
    flash_item<0>(PROJ + hq * 64, 1536, PROJ + 768 + kv * 64, 1536, VT + vta_base(seq) + (size_t)kv * 64 * LP, LP,
                  MIX + hq * 64, 1024, seq_base(seq), L - 16, qt, 0.f, lds + sb * 36864);
  }
  const bf16_t* ZB = (const bf16_t*)(p.ws + O_ZB);
  bf16_t* Y = (bf16_t*)(p.ws + O_Y);
  const int lane = threadIdx.x & 63, wave = threadIdx.x >> 6;
  const int nI_S = 17 * 16, nI_P = 8 * 5 * 16;
  for (int it = blockIdx.x; it < nI_S + nI_P; it += gridDim.x) {
    int seq, nb, cb;
    if (it < nI_S) { seq = 8; cb = it & 15; nb = it >> 4; }
    else { int j = it - nI_S; cb = j & 15; j >>= 4; nb = j % 5; seq = j / 5; }
    const int M = seq < 8 ? 257 : 1025, KP = seq < 8 ? 576 : 2112, L = 16 * M;
    const int n2 = nb * 64 + lane;
    const int ch = cb * 16 + wave * 2;
    const int g = ch >> 6, d = ch & 63;
    bf16_t* yb = Y + y_base(seq);
    if (n2 < M) {
      float zr[16][2], zi[16][2];
#pragma unroll
      for (int n1 = 0; n1 < 16; ++n1) {
        const bf16_t* zp = ZB + (size_t)(seq_base(seq) + M * n1 + n2) * 512 + g * 128 + d;
        unsigned re = *(const unsigned*)zp, im = *(const unsigned*)(zp + 64);
        zr[n1][0] = lo2f(re); zr[n1][1] = hi2f(re); zi[n1][0] = lo2f(im); zi[n1][1] = hi2f(im);
      }
      for (int k1 = 0; k1 < 16; ++k1) {
        float ws_, wc_;
        sincospif(-(float)k1 / 8.f, &ws_, &wc_);
        float ar0 = zr[15][0], ai0 = zi[15][0], ar1 = zr[15][1], ai1 = zi[15][1];
#pragma unroll
        for (int n1 = 14; n1 >= 0; --n1) {
          float t0 = ar0 * wc_ - ai0 * ws_ + zr[n1][0]; ai0 = ar0 * ws_ + ai0 * wc_ + zi[n1][0]; ar0 = t0;
          float t1 = ar1 * wc_ - ai1 * ws_ + zr[n1][1]; ai1 = ar1 * ws_ + ai1 * wc_ + zi[n1][1]; ar1 = t1;
        }
        float ts, tc;
        sincospif(-2.f * (float)(k1 * n2) / (float)L, &ts, &tc);
        float yr0 = ar0 * tc - ai0 * ts, yi0 = ar0 * ts + ai0 * tc;
        float yr1 = ar1 * tc - ai1 * ts, yi1 = ar1 * ts + ai1 * tc;
        bf16_t* y0 = yb + ((size_t)k1 * 256 + ch) * KP;
        y0[n2] = f2bf(yr0); y0[M + n2] = f2bf(yi0);
        y0[KP + n2] = f2bf(yr1); y0[KP + M + n2] = f2bf(yi1);
      }
    } else if (n2 < KP - M) {
      for (int k1 = 0; k1 < 16; ++k1) {
        bf16_t* y0 = yb + ((size_t)k1 * 256 + ch) * KP;
        y0[M + n2] = 0; y0[KP + M + n2] = 0;
      }
    }
  }
}

DI void phase_fnet_gemm(const P& p, char* lds) {
  GEMM_IDS
  bf16_t* MIX = (bf16_t*)(p.ws + O_MIX);
  const bf16_t* Y = (const bf16_t*)(p.ws + O_Y);
  const int nS = 16 * 9 * 2, nP = 8 * 16 * 3 * 2;
  const int sb = threadIdx.x >> 8;
  for (int it0 = blockIdx.x * 2; it0 < nS + nP; it0 += gridDim.x * 2) {
    const int it = it0 + sb;
    int seq, k1, tm, tn;
    if (it < nS) { seq = 8; tn = it & 1; int j = it >> 1; tm = j % 9; k1 = j / 9; }
    else { int j = it - nS; tn = j & 1; j >>= 1; tm = j % 3; j /= 3; k1 = j & 15; seq = j >> 4; }
    const int M = seq < 8 ? 257 : 1025, KP = seq < 8 ? 576 : 2112, L = 16 * M;
    const bf16_t* dm = (const bf16_t*)(p.ws + (seq < 8 ? O_DM257 : O_DM1025));
    f32x16 acc[2][2];
    gemm_tile(dm + (size_t)tm * 128 * KP, KP, Y + y_base(seq) + ((size_t)k1 * 256 + tn * 128) * KP, KP, KP, lds + sb * 36864, acc);
    const float scale = rsqrtf(64.f * (float)L);
#pragma unroll
    for (int mt = 0; mt < 2; ++mt)
#pragma unroll
      for (int nt = 0; nt < 2; ++nt)
#pragma unroll
        for (int i = 0; i < 16; ++i) {
          int k2 = tm * 128 + ACC_ROW(mt, i), ch = tn * 128 + ACC_COL(nt);
          if (k2 < M) {
            int pos = k1 + 16 * k2;
            MIX[(size_t)(seq_base(seq) + pos) * 1024 + 768 + ch] = f2bf(acc[mt][nt][i] * scale + p.b_b[ch]);
          }
        }
  }
}

DI size_t vtc_base(int seq) { return seq < 8 ? (size_t)seq * 128 * 4160 : (size_t)8 * 128 * 4160; }
DI void phase_prepC(const P& p, char* lds) {
  const int gtid = blockIdx.x * NTH + threadIdx.x, gsz = gridDim.x * NTH;
  const int lane = threadIdx.x & 63, gw = gtid >> 6, nw = gsz >> 6;
  bf16_t* PC = (bf16_t*)(p.ws + O_PC);
  bf16_t* VT = (bf16_t*)(p.ws + O_VTC);
  const bf16_t* PLOW = (const bf16_t*)(p.ws + O_PLOW);
  bf16_t* LR = (bf16_t*)(p.ws + O_LR);
  vt_transpose<128>(PC, 768, 640, VT, lds);
  for (int sr = gw; sr < T_; sr += nw) {
    int pos; int b = seq_of(sr, pos);
    const int L = seq_len(b), LP = L + 48;
    bf16_t* pr = PC + (size_t)sr * 768;
    float cs[8], sn[8];
#pragma unroll
    for (int j = 0; j < 8; ++j) sincosf((float)pos * exp2f(-(float)j * (18.931568569324174f / 8.f)), &sn[j], &cs[j]);
#pragma unroll
    for (int part = 0; part < 2; ++part) {
      const bool act = part == 0 || lane < 16;
      const int col = part * 512 + (act ? lane : 0) * 8;
      uint4 u = *(const uint4*)(pr + col);
      float e[8] = {lo2f(u.x), hi2f(u.x), lo2f(u.y), hi2f(u.y), lo2f(u.z), hi2f(u.z), lo2f(u.w), hi2f(u.w)};
      float o[8];
#pragma unroll
      for (int j = 0; j < 8; ++j) {
        float pa = __shfl_xor(e[j], 1);
        float rot = e[j] * cs[j] + pa * ((lane & 1) ? sn[j] : -sn[j]);
        o[j] = (lane & 7) < 2 ? rot : e[j];
        if (part == 0) o[j] *= 0.125f * LOG2E;
      }
      if (act) *(uint4*)(pr + col) = make_uint4(pack2(o[0], o[1]), pack2(o[2], o[3]), pack2(o[4], o[5]), pack2(o[6], o[7]));
    }
#pragma unroll
    for (int q = 0; q < 6; ++q) {
      int c = q * 64 + lane;
      float u = bf2f(PLOW[(size_t)sr * 384 + c]);
      float up = pos > 0 ? bf2f(PLOW[(size_t)(sr - 1) * 384 + c]) : 0.f;
      float un = pos < L - 1 ? bf2f(PLOW[(size_t)(sr + 1) * 384 + c]) : 0.f;
      float us = u + p.mu_prev[1536 + c] * (up - u) + p.mu_next[1536 + c] * (un - u);
      float v = c < 128 ? tanhf(us) : (c < 256 ? us : sigmoidf_(us));
      LR[(size_t)sr * 384 + c] = f2bf(v);
    }
  }
}

DI void phase_attnC(const P& p, char* lds) {
  const bf16_t* PC = (const bf16_t*)(p.ws + O_PC);
  const bf16_t* VT = (const bf16_t*)(p.ws + O_VTC);
  bf16_t* MIX = (bf16_t*)(p.ws + O_MIX);
  const int nS = 129 * 4, nP = 8 * 33 * 4;
  const int sb = threadIdx.x >> 8;
  for (int it = blockIdx.x; it < nS + nP; it += gridDim.x) {
    int seq, qt, hq;
    if (it < nS) { seq = 8; hq = (it & 3) * 2 + sb; qt = it >> 2; }
    else { int j = it - nS; hq = (j & 3) * 2 + sb; j >>= 2; qt = j % 33; seq = j / 33; }
    const int kv = hq >> 2;
    const int L = seq_len(seq), LP = L + 48;
    flash_item<1>(PC + hq * 64, 768, PC + 512 + kv * 64, 768, VT + vtc_base(seq) + (size_t)kv * 64 * LP, LP,
                  MIX + hq * 64, 1024, seq_base(seq), L - 16, qt, p.c_sink[hq] * LOG2E, lds + sb * 36864);
  }
}

DI void chunk_decode(int cg_, int& seq, int& c) {
  if (cg_ < 136) { seq = cg_ / 17; c = cg_ - seq * 17; } else { seq = 8; c = cg_ - 136; }
}
DI float shiftv(const bf16_t* PRKV, int sr, int pos, int L, int col, float mp, float mn) {
  float u = bf2f(PRKV[(size_t)sr * 1536 + col]);
  float up = pos > 0 ? bf2f(PRKV[(size_t)(sr - 1) * 1536 + col]) : 0.f;
  float un = pos < L - 1 ? bf2f(PRKV[(size_t)(sr + 1) * 1536 + col]) : 0.f;
  return u + mp * (up - u) + mn * (un - u);
}
enum { VW = 0, VA = 1, VB = 2, VK = 3, VV = 4, VR = 5 };
#define DPP_FMAC(acc, x, y, N) asm("v_fmac_f32_dpp %0, %1, %2 row_newbcast:%3 row_mask:0xf bank_mask:0xf" : "+v"(acc) : "v"(x), "v"(y), "n"(N))
#define DPP_MUL(sv_, x, N) asm("v_mul_f32_dpp %0, %1, %0 row_newbcast:%2 row_mask:0xf bank_mask:0xf" : "+v"(sv_) : "v"(x), "n"(N))
template <int N> DI void dpp_dot4(float& a0, float& a1, float& a2, float& a3, const float (&S)[64], const float4& x) {
  DPP_FMAC(a0, x.x, S[N], N); DPP_FMAC(a1, x.y, S[16 + N], N); DPP_FMAC(a2, x.z, S[32 + N], N); DPP_FMAC(a3, x.w, S[48 + N], N);
  if constexpr (N < 15) dpp_dot4<N + 1>(a0, a1, a2, a3, S, x);
}
template <int N, bool HASV, bool OUT> DI void dpp_upd4(float (&S)[64], const float4& xw, const float4& xb, const float4& xk, const float4& xr, float sa, float vi,
                                                       float& o0, float& o1, float& o2, float& o3) {
  DPP_MUL(S[N], xw.x, N); DPP_MUL(S[16 + N], xw.y, N); DPP_MUL(S[32 + N], xw.z, N); DPP_MUL(S[48 + N], xw.w, N);
  DPP_FMAC(S[N], xb.x, sa, N); DPP_FMAC(S[16 + N], xb.y, sa, N); DPP_FMAC(S[32 + N], xb.z, sa, N); DPP_FMAC(S[48 + N], xb.w, sa, N);
  if (HASV) { DPP_FMAC(S[N], xk.x, vi, N); DPP_FMAC(S[16 + N], xk.y, vi, N); DPP_FMAC(S[32 + N], xk.z, vi, N); DPP_FMAC(S[48 + N], xk.w, vi, N); }
  if (OUT) { DPP_FMAC(o0, xr.x, S[N], N); DPP_FMAC(o1, xr.y, S[16 + N], N); DPP_FMAC(o2, xr.z, S[32 + N], N); DPP_FMAC(o3, xr.w, S[48 + N], N); }
  if constexpr (N < 15) dpp_upd4<N + 1, HASV, OUT>(S, xw, xb, xk, xr, sa, vi, o0, o1, o2, o3);
}
template <int NST, bool HASV, bool OUT, class F>
DI void scan_steps(float (&S)[64], const float* sv, int ns, int lane, F&& emit) {
  const int l15 = lane & 15;
  for (int s = 0; s < ns; ++s) {
    const float4 xw = *(const float4*)(sv + VW * NST * 64 + s * 64 + l15 * 4);
    const float4 xa = *(const float4*)(sv + VA * NST * 64 + s * 64 + l15 * 4);
    const float4 xb = *(const float4*)(sv + VB * NST * 64 + s * 64 + l15 * 4);
    float4 xk = xb, xr = xb;
    if (HASV) xk = *(const float4*)(sv + VK * NST * 64 + s * 64 + l15 * 4);
    if (OUT) xr = *(const float4*)(sv + VR * NST * 64 + s * 64 + l15 * 4);
    const float vi = HASV ? sv[VV * NST * 64 + s * 64 + lane] : 0.f;
    float sa0 = 0.f, sa1 = 0.f, sa2 = 0.f, sa3 = 0.f;
    dpp_dot4<0>(sa0, sa1, sa2, sa3, S, xa);
    const float sa = (sa0 + sa1) + (sa2 + sa3);
    float o0 = 0.f, o1 = 0.f, o2 = 0.f, o3 = 0.f;
    dpp_upd4<0, HASV, OUT>(S, xw, xb, xk, xr, sa, vi, o0, o1, o2, o3);
    if (OUT) emit(s, (o0 + o1) + (o2 + o3));
  }
}
DI int vperm(int j) { return (j & 15) * 4 + (j >> 4); }

DI void shift8(const bf16_t* PRKV, const P& p, int sbase, int pos, int L, int off, int c0, float (&out)[8]) {
  const bf16_t* rp = PRKV + (size_t)(sbase + pos) * 1536 + off + c0;
  const u32x4 uc = *(const u32x4*)rp;
  u32x4 up = (u32x4)(0u), un = (u32x4)(0u);
  if (pos > 0) up = *(const u32x4*)(rp - 1536);
  if (pos < L - 1) un = *(const u32x4*)(rp + 1536);
  const f32x4v mp0 = *(const f32x4v*)(p.mu_prev + off + c0), mp1 = *(const f32x4v*)(p.mu_prev + off + c0 + 4);
  const f32x4v mn0 = *(const f32x4v*)(p.mu_next + off + c0), mn1 = *(const f32x4v*)(p.mu_next + off + c0 + 4);
#pragma unroll
  for (int e2 = 0; e2 < 4; ++e2) {
    const float c_lo = lo2f(uc[e2]), c_hi = hi2f(uc[e2]);
    const float mpl = e2 < 2 ? mp0[2 * e2] : mp1[2 * e2 - 4], mph = e2 < 2 ? mp0[2 * e2 + 1] : mp1[2 * e2 - 3];
    const float mnl = e2 < 2 ? mn0[2 * e2] : mn1[2 * e2 - 4], mnh = e2 < 2 ? mn0[2 * e2 + 1] : mn1[2 * e2 - 3];
    out[2 * e2] = c_lo + mpl * (lo2f(up[e2]) - c_lo) + mnl * (lo2f(un[e2]) - c_lo);
    out[2 * e2 + 1] = c_hi + mph * (hi2f(up[e2]) - c_hi) + mnh * (hi2f(un[e2]) - c_hi);
  }
}

template <int NST, bool P3>
DI void scan_prologue8(const P& p, int sbase, int L, int hd, int dir, int pos0, int nsteps, int sb0, float* sv) {
  const int lane = threadIdx.x & 63, l31 = lane & 31, h = lane >> 5;
  const bf16_t* PRKV = (const bf16_t*)(p.ws + O_PRKV);
  const bf16_t* LR = (const bf16_t*)(p.ws + O_LR);
  const bf16_t* WUPT = (const bf16_t*)(p.ws + O_WUPT) + (size_t)(dir * 512 + hd * 64) * 64;
  const bf16_t* AUPT = (const bf16_t*)(p.ws + O_AUPT) + (size_t)(dir * 512 + hd * 64) * 64;
  float* bonus = (float*)(p.ws + O_BONUS);
  {
    int sl = sb0 + (l31 & 7); if (sl > nsteps - 1) sl = nsteps - 1;
    const int pos = dir ? pos0 - sl : pos0 + sl;
    const bf16_t* lrp = LR + (size_t)(sbase + pos) * 384 + dir * 64 + 8 * h;
#pragma unroll 1
    for (int mat = 0; mat < 2; ++mat) {
      const bf16_t* Wm = mat ? AUPT : WUPT;
      const float* bias = mat ? p.d_a0 : p.d_w0;
      f32x16 ac[2];
#pragma unroll
      for (int nt = 0; nt < 2; ++nt)
#pragma unroll
        for (int i = 0; i < 16; ++i) ac[nt][i] = 0.f;
#pragma unroll
      for (int ks = 0; ks < 4; ++ks) {
        const bf16x8 fa = *(const bf16x8*)(lrp + mat * 128 + 16 * ks);
#pragma unroll
        for (int nt = 0; nt < 2; ++nt) {
          const bf16x8 bw = *(const bf16x8*)(Wm + (size_t)(32 * nt + l31) * 64 + 16 * ks + 8 * h);
          ac[nt] = MFMA32(fa, bw, ac[nt]);
        }
      }
#pragma unroll
      for (int nt = 0; nt < 2; ++nt) {
        const int j = 32 * nt + l31;
        const float b0 = bias[dir * 512 + hd * 64 + j];
#pragma unroll
        for (int i = 0; i < 4; ++i) {
          const int st = sb0 + i + 4 * h;
          const float sg = 1.f / (1.f + __expf(-(b0 + ac[nt][i])));
          if (mat) sv[VK * NST * 64 + st * 64 + j] = sg;
          else sv[VW * NST * 64 + st * 64 + vperm(j)] = __expf(-0.6065306597126334f * sg);
        }
      }
    }
  }
  const int stp = lane >> 3, seg = lane & 7, c0 = hd * 64 + 8 * seg;
  const int s = sb0 + stp;
  const int ss = s < nsteps ? s : nsteps - 1;
  const int pos = dir ? pos0 - ss : pos0 + ss;
  float k[8], a[8];
  shift8(PRKV, p, sbase, pos, L, 512, c0, k);
  {
    const f32x4v a0 = *(const f32x4v*)(sv + VK * NST * 64 + s * 64 + 8 * seg), a1 = *(const f32x4v*)(sv + VK * NST * 64 + s * 64 + 8 * seg + 4);
#pragma unroll
    for (int e = 0; e < 4; ++e) { a[e] = a0[e]; a[4 + e] = a1[e]; }
  }
  const f32x4v kk0 = *(const f32x4v*)(p.d_k_k + c0), kk1 = *(const f32x4v*)(p.d_k_k + c0 + 4);
  const f32x4v ka0 = *(const f32x4v*)(p.d_k_a + c0), ka1 = *(const f32x4v*)(p.d_k_a + c0 + 4);
  float kk[8], kd[8];
  float n2 = 0.f;
#pragma unroll
  for (int e = 0; e < 8; ++e) {
    kk[e] = k[e] * (e < 4 ? kk0[e] : kk1[e - 4]);
    n2 += kk[e] * kk[e];
    kd[e] = k[e] * (1.f + (a[e] - 1.f) * (e < 4 ? ka0[e] : ka1[e - 4]));
  }
  n2 += __shfl_xor(n2, 1); n2 += __shfl_xor(n2, 2); n2 += __shfl_xor(n2, 4);
  const float rn = rsqrtf(fmaxf(n2, 1e-24f));
#pragma unroll
  for (int e = 0; e < 8; ++e) {
    const int ix = s * 64 + vperm(8 * seg + e);
    const float kn = kk[e] * rn;
    sv[VA * NST * 64 + ix] = -kn;
    sv[VB * NST * 64 + ix] = kn * a[e];
    sv[VK * NST * 64 + ix] = kd[e];
  }
  {
    float v[8];
    shift8(PRKV, p, sbase, pos, L, 1024, c0, v);
    *(f32x4v*)(sv + VV * NST * 64 + s * 64 + 8 * seg) = (f32x4v){v[0], v[1], v[2], v[3]};
    *(f32x4v*)(sv + VV * NST * 64 + s * 64 + 8 * seg + 4) = (f32x4v){v[4], v[5], v[6], v[7]};
  }
  if (P3) {
    float r[8];
    shift8(PRKV, p, sbase, pos, L, 0, c0, r);
    const f32x4v rk0 = *(const f32x4v*)(p.d_r_k + c0), rk1 = *(const f32x4v*)(p.d_r_k + c0 + 4);
    float bn = 0.f;
#pragma unroll
    for (int e = 0; e < 8; ++e) {
      sv[VR * NST * 64 + s * 64 + vperm(8 * seg + e)] = r[e];
      bn += r[e] * kd[e] * (e < 4 ? rk0[e] : rk1[e - 4]);
    }
    bn += __shfl_xor(bn, 1); bn += __shfl_xor(bn, 2); bn += __shfl_xor(bn, 4);
    if (s < nsteps && seg == 0) bonus[((size_t)(sbase + pos) * 8 + hd) * 2 + dir] = bn;
  }
}

template <bool HALF> DI void scan1_body(const P& p, char* lds) {
  float* PQ = (float*)(p.ws + O_PQ);
  const int lane = threadIdx.x & 63, wave = __builtin_amdgcn_readfirstlane(threadIdx.x >> 6), slot = wave >> 1;
  constexpr int half = HALF ? 1 : 0;
  float* sv = (float*)lds + slot * (6 * 16 * 64);
  for (int g = blockIdx.x; g < 804; g += gridDim.x) {
    int seq, c, hp;
    if (g < 768) { const int lc = g >> 2; hp = g & 3; if (lc < 128) { seq = lc >> 4; c = lc & 15; } else { seq = 8; c = lc - 128; } }
    else { const int j = g - 768; hp = j & 3; seq = j >> 2; c = seq < 8 ? 16 : 64; }
    const int cgi = seq < 8 ? seq * 17 + c : 136 + c;
    const int hd = hp * 2 + (slot >> 1), dir = slot & 1;
    const int it = (cgi * 8 + hd) * 2 + dir;
    const int L = seq_len(seq), sbase = seq_base(seq);
    const int start = c * 256, end = min(L, start + 256), n = end - start;
    float S[64];
#pragma unroll
    for (int j = 0; j < 64; ++j) S[j] = (half == 0 && j == lane) ? 1.f : 0.f;
    for (int s0 = 0; s0 < n; s0 += 16) {
      const int ns = min(16, n - s0);
      const int pos0 = dir ? end - 1 - s0 : start + s0;
      __syncthreads();
      scan_prologue8<16, false>(p, sbase, L, hd, dir, pos0, ns, half * 8, sv);
      __syncthreads();
      scan_steps<16, HALF, false>(S, sv, ns, lane, [](int, float) {});
    }
    float* dst = PQ + (size_t)it * 8192 + (size_t)(half * 64 + lane) * 64;
#pragma unroll
    for (int q = 0; q < 16; ++q) *(float4*)(dst + q * 4) = make_float4(S[q * 4], S[q * 4 + 1], S[q * 4 + 2], S[q * 4 + 3]);
  }
}

DI void phase_scan1(const P& p, char* lds) {
  const int w_ = __builtin_amdgcn_readfirstlane(threadIdx.x >> 6);
  if ((w_ ^ (w_ >> 2)) & 1) scan1_body<true>(p, lds); else scan1_body<false>(p, lds);
}

DI void phase_scan2(const P& p, char* lds) {
  float* Ss = (float*)lds;
  float* Ps = Ss + 64 * 65;
  float* PQ = (float*)(p.ws + O_PQ);
  const int tid = threadIdx.x, i = tid >> 3, j0 = (tid & 7) * 8;
  for (int it = blockIdx.x; it < 144; it += gridDim.x) {
    const int dir = it & 1, hd = (it >> 1) & 7, seq = it >> 4;
    const int nch = seq < 8 ? 17 : 65, cg0 = seq < 8 ? seq * 17 : 136;
    float S[8];
#pragma unroll
    for (int jj = 0; jj < 8; ++jj) S[jj] = 0.f;
    f32x4v pn0, pn1, qn0, qn1;
    {
      const int c = dir ? nch - 1 : 0;
      const float* Pg = PQ + (size_t)(((cg0 + c) * 8 + hd) * 2 + dir) * 8192;
#pragma unroll
      for (int r4 = 0; r4 < 1; ++r4) { pn0 = *(const f32x4v*)(Pg + tid * 4); pn1 = *(const f32x4v*)(Pg + (512 + tid) * 4); qn0 = *(const f32x4v*)(Pg + 4096 + i * 64 + j0); qn1 = *(const f32x4v*)(Pg + 4096 + i * 64 + j0 + 4); }
    }
    for (int cc = 0; cc < nch; ++cc) {
      const int c = dir ? nch - 1 - cc : cc;
      float* Qg = PQ + (size_t)(((cg0 + c) * 8 + hd) * 2 + dir) * 8192 + 4096;
      __syncthreads();
#pragma unroll
      for (int jj = 0; jj < 8; ++jj) Ss[i * 65 + j0 + jj] = S[jj];
#pragma unroll
      for (int r4 = 0; r4 < 1; ++r4) { *(f32x4v*)(Ps + tid * 4) = pn0; *(f32x4v*)(Ps + (512 + tid) * 4) = pn1; }
      float acc[8];
#pragma unroll
      for (int jj = 0; jj < 4; ++jj) { acc[jj] = qn0[jj]; acc[4 + jj] = qn1[jj]; }
#pragma unroll
      for (int r4 = 0; r4 < 2; ++r4) *(float4*)(Qg + i * 64 + j0 + r4 * 4) = make_float4(S[r4 * 4], S[r4 * 4 + 1], S[r4 * 4 + 2], S[r4 * 4 + 3]);
      if (cc + 1 < nch) {
        const int c2 = dir ? nch - 2 - cc : cc + 1;
        const float* Pg2 = PQ + (size_t)(((cg0 + c2) * 8 + hd) * 2 + dir) * 8192;
#pragma unroll
        for (int r4 = 0; r4 < 1; ++r4) { pn0 = *(const f32x4v*)(Pg2 + tid * 4); pn1 = *(const f32x4v*)(Pg2 + (512 + tid) * 4); qn0 = *(const f32x4v*)(Pg2 + 4096 + i * 64 + j0); qn1 = *(const f32x4v*)(Pg2 + 4096 + i * 64 + j0 + 4); }
      }
      __syncthreads();
#pragma unroll 8
      for (int m = 0; m < 64; ++m) {
        const float sm = Ss[i * 65 + m];
        const float* pr = Ps + m * 64 + j0;
#pragma unroll
        for (int jj = 0; jj < 8; ++jj) acc[jj] += sm * pr[jj];
      }
#pragma unroll
      for (int jj = 0; jj < 8; ++jj) S[jj] = acc[jj];
    }
  }
}

DI void phase_scan3(const P& p, char* lds) {
  const float* PQ = (const float*)(p.ws + O_PQ);
  bf16_t* MIX = (bf16_t*)(p.ws + O_MIX);
  bf16_t* OB = (bf16_t*)(p.ws + O_OB);
  const int lane = threadIdx.x & 63, wave = __builtin_amdgcn_readfirstlane(threadIdx.x >> 6);
  float* sv = (float*)lds + wave * (6 * 8 * 64);
  const bool bal = gridDim.x == 256;
  const int NW = gridDim.x * 8, gw = blockIdx.x * 8 + wave;
  for (int k = 0; ; ++k) {
    int oi;
    if (bal) {
      if (k == 0) oi = gw;
      else if (k == 1) { if (wave >= 4) continue; oi = 2048 + blockIdx.x * 4 + wave; }
      else if (k == 2) { if (wave != 7 || blockIdx.x >= 144) break; oi = 3072 + blockIdx.x; }
      else break;
    } else { oi = gw + k * NW; if (oi >= 3216) break; }
    int seq, c, hd, dir;
    if (oi < 3072) { const int lc = oi >> 4; hd = (oi >> 1) & 7; dir = oi & 1; if (lc < 128) { seq = lc >> 4; c = lc & 15; } else { seq = 8; c = lc - 128; } }
    else { const int j = oi - 3072; hd = (j >> 1) & 7; dir = j & 1; seq = j >> 4; c = seq < 8 ? 16 : 64; }
    const int it = ((seq < 8 ? seq * 17 + c : 136 + c) * 8 + hd) * 2 + dir;
    const int L = seq_len(seq), sbase = seq_base(seq);
    const int start = c * 256, end = min(L, start + 256), n = end - start;
    float S[64];
    {
      const float* src = PQ + (size_t)it * 8192 + 4096 + lane * 64;
#pragma unroll
      for (int q = 0; q < 16; ++q) { float4 t = *(const float4*)(src + q * 4); S[q * 4] = t.x; S[q * 4 + 1] = t.y; S[q * 4 + 2] = t.z; S[q * 4 + 3] = t.w; }
    }
    for (int s0 = 0; s0 < n; s0 += 8) {
      const int ns = min(8, n - s0);
      const int pos0 = dir ? end - 1 - s0 : start + s0;
      scan_prologue8<8, true>(p, sbase, L, hd, dir, pos0, ns, 0, sv);
      scan_steps<8, true, true>(S, sv, ns, lane, [&](int st, float o) {
        const int pos = dir ? pos0 - st : pos0 + st;
        const size_t sr = (size_t)(sbase + pos);
        if (dir == 0) MIX[sr * 1024 + 512 + hd * 64 + lane] = f2bf(o);
        else OB[sr * 512 + hd * 64 + lane] = f2bf(o);
      });
    }
  }
}

DI void phase_rwkv_final(const P& p) {
  const int lane = threadIdx.x & 63, gw = (blockIdx.x * NTH + threadIdx.x) >> 6, nw = (gridDim.x * NTH) >> 6;
  bf16_t* MIX = (bf16_t*)(p.ws + O_MIX);
  const bf16_t* OB = (const bf16_t*)(p.ws + O_OB);
  const bf16_t* G = (const bf16_t*)(p.ws + O_G);
  const bf16_t* PRKV = (const bf16_t*)(p.ws + O_PRKV);
  const float* bonus = (const float*)(p.ws + O_BONUS);
  const int hd = lane >> 3, c0 = lane * 8;
  for (int sr = gw; sr < T_; sr += nw) {
    int pos; int b = seq_of(sr, pos);
    const int L = seq_len(b);
    uint4 uf = *(const uint4*)(MIX + (size_t)sr * 1024 + 512 + c0);
    uint4 ub = *(const uint4*)(OB + (size_t)sr * 512 + c0);
    uint4 ug = *(const uint4*)(G + (size_t)sr * 512 + c0);
    unsigned f_[4] = {uf.x, uf.y, uf.z, uf.w}, b_[4] = {ub.x, ub.y, ub.z, ub.w}, g_[4] = {ug.x, ug.y, ug.z, ug.w};
    float o[8], gg[8];
    float sm = 0.f;
#pragma unroll
    for (int j = 0; j < 4; ++j) {
      o[2 * j] = lo2f(f_[j]) + lo2f(b_[j]); o[2 * j + 1] = hi2f(f_[j]) + hi2f(b_[j]);
      gg[2 * j] = lo2f(g_[j]); gg[2 * j + 1] = hi2f(g_[j]);
      sm += o[2 * j] + o[2 * j + 1];
    }
    sm += __shfl_xor(sm, 1); sm += __shfl_xor(sm, 2); sm += __shfl_xor(sm, 4);
    const float mean = sm * (1.f / 64.f);
    float vs = 0.f;
#pragma unroll
    for (int j = 0; j < 8; ++j) { float dlt = o[j] - mean; vs += dlt * dlt; }
    vs += __shfl_xor(vs, 1); vs += __shfl_xor(vs, 2); vs += __shfl_xor(vs, 4);
    const float rstd = rsqrtf(vs * (1.f / 64.f) + 64e-5f);
    const float bsum = bonus[((size_t)sr * 8 + hd) * 2] + bonus[((size_t)sr * 8 + hd) * 2 + 1];
    float y[8];
#pragma unroll
    for (int j = 0; j < 8; ++j) {
      int c = c0 + j;
      float vsh = shiftv(PRKV, sr, pos, L, 1024 + c, p.mu_prev[1024 + c], p.mu_next[1024 + c]);
      y[j] = ((o[j] - mean) * rstd * p.d_ln_g[c] + p.d_ln_b[c] + bsum * vsh) * gg[j];
    }
    *(uint4*)(MIX + (size_t)sr * 1024 + 512 + c0) = make_uint4(pack2(y[0], y[1]), pack2(y[2], y[3]), pack2(y[4], y[5]), pack2(y[6], y[7]));
  }
}

#define XB_TMO      128
#define XB_XCNT(j)  (256  + 64 * (j))
#define XB_XSUB(j)  (1280 + 64 * (j))
#define XB_XGEN(j)  (2304 + 64 * (j))
#define XB_TOP      3328
#define XB_TOPGEN   3392
#define XCD_BAR_WORDS 3456
#define XB_SPIN_CAP (1u << 23)
#define LAS __attribute__((address_space(3)))

__device__ __forceinline__ unsigned xb_ld(unsigned* p)              { return __hip_atomic_load(p, __ATOMIC_RELAXED, __HIP_MEMORY_SCOPE_AGENT); }
__device__ __forceinline__ unsigned xb_add(unsigned* p, unsigned v) { return __hip_atomic_fetch_add(p, v, __ATOMIC_RELAXED, __HIP_MEMORY_SCOPE_AGENT); }
__device__ __forceinline__ unsigned xb_xcc_id() { return (unsigned)__builtin_amdgcn_s_getreg((3 << 11) | 20) & 0xFu; }
#define XB_SPIN(cond, bar) do { unsigned _sp = 0; while (cond) { __builtin_amdgcn_s_sleep(1); \
    if ((++_sp & 255u) == 0u) { if (xb_ld(&(bar)[XB_TMO])) break; if (_sp > XB_SPIN_CAP) { atomicAdd(&(bar)[XB_TMO], 1u); break; } } } } while (0)

struct XcdBarrier {
    unsigned* bar; unsigned x;
    volatile LAS unsigned* st;
};

__device__ __forceinline__ XcdBarrier xcd_barrier_post(unsigned* bar, volatile LAS unsigned* st) {
    XcdBarrier b; b.bar = bar; b.x = xb_xcc_id(); b.st = st;
    if (threadIdx.x == 0) (void)xb_add(&bar[XB_XCNT(b.x)], 1u);
    return b;
}
__device__ __forceinline__ void xcd_barrier_complete(unsigned* bar, unsigned x, unsigned& nloc, unsigned& nx) {
    const unsigned G = gridDim.x * gridDim.y * gridDim.z;
    unsigned sum, cnt, mine, sp = 0u;
    for (;;) {
        sum = 0u; cnt = 0u; mine = 0u;
#pragma unroll
        for (unsigned j = 0; j < 16; ++j) { const unsigned c = xb_ld(&bar[XB_XCNT(j)]); sum += c; cnt += (c > 0u) ? 1u : 0u; mine = (j == x) ? c : mine; }
        if (sum == G) break;
        __builtin_amdgcn_s_sleep(1);
        if ((++sp & 255u) == 0u) { if (xb_ld(&bar[XB_TMO])) break; if (sp > XB_SPIN_CAP) { atomicAdd(&bar[XB_TMO], 1u); break; } }
    }
    nloc = mine > 0u ? mine : 1u; nx = cnt > 0u ? cnt : 1u;
}

__device__ __forceinline__ void xcd_barrier(const XcdBarrier& b) {
    asm volatile("s_waitcnt vmcnt(0)" ::: "memory");
    __syncthreads();
    if (threadIdx.x == 0) {
        unsigned* bar = b.bar;
        __builtin_amdgcn_s_waitcnt(0);
        unsigned nloc = b.st[0], nx = b.st[1];
        if (nloc == 0u) { xcd_barrier_complete(bar, b.x, nloc, nx); b.st[0] = nloc; b.st[1] = nx; }
        const unsigned old = xb_add(&bar[XB_XSUB(b.x)], 1u);
        const unsigned gen = old / nloc;
        if (old + 1u == (gen + 1u) * nloc) {
            __builtin_amdgcn_fence(__ATOMIC_RELEASE, "agent");
            asm volatile("s_waitcnt vmcnt(0)" ::: "memory");
            const unsigned og = xb_add(&bar[XB_TOP], 1u);
            const unsigned tg = og / nx;
            if (og + 1u == (tg + 1u) * nx) xb_add(&bar[XB_TOPGEN], 1u);
            else XB_SPIN(xb_ld(&bar[XB_TOPGEN]) == tg, bar);
            __builtin_amdgcn_fence(__ATOMIC_ACQUIRE, "agent");
            xb_add(&bar[XB_XGEN(b.x)], 1u);
            asm volatile("s_waitcnt vmcnt(0)" ::: "memory");
        } else {
            XB_SPIN(xb_ld(&bar[XB_XGEN(b.x)]) == gen, bar);
            __builtin_amdgcn_fence(__ATOMIC_ACQUIRE, "agent");
            asm volatile("s_waitcnt vmcnt(0)" ::: "memory");
        }
    }
    __syncthreads();
}

constexpr int NPHASE = 23;
__global__ void __launch_bounds__(NTH, 2) mega(P p) {
  extern __shared__ __attribute__((aligned(16))) unsigned char shm[];
  char* lds = (char*)shm;
  char* ws = p.ws;
  if (threadIdx.x == 0) *(uint4*)(shm + 131072) = make_uint4(0u, 0u, 0u, 0u);
  __syncthreads();
  const XcdBarrier xb = xcd_barrier_post((unsigned*)(ws + O_BAR), (volatile LAS unsigned*)(shm + 131072));
#ifndef DUP_MASK
#define DUP_MASK 0u
#endif
#define RUN(k, call) if (p.ph0 <= k && k < p.ph1) { call; if (k + 1 < p.ph1) { if (k == 0) cg::this_grid().sync(); else xcd_barrier(xb); } }
  RUN(0, phase_prep(p))
  RUN(1, phase_gemm_big((const bf16_t*)(ws + O_HN), (const bf16_t*)(ws + O_WIN0), 1536, 1024, (bf16_t*)(ws + O_PROJ0), 1536, 0, ws, shm))
  RUN(2, phase_prepA(p, lds))
  RUN(3, phase_attnA(p, lds))
  RUN(4, phase_fnet_gemm(p, lds))
  RUN(5, phase_gemm_big((const bf16_t*)(ws + O_MIX), (const bf16_t*)(ws + O_WOUT0), 1024, 1024, (bf16_t*)(ws + O_HN), 1024, 0, ws, shm))
  RUN(6, phase_resnorm(p, p.post_mix_g, p.pre_ffn_g))
  RUN(7, phase_gemm_gateup((const bf16_t*)(ws + O_HN), (const bf16_t*)(ws + O_WGU0), (bf16_t*)(ws + O_ACT), shm))
  RUN(8, phase_gemm_big((const bf16_t*)(ws + O_ACT), (const bf16_t*)(ws + O_WD0), 1024, DFF, (bf16_t*)(ws + O_HN), 1024, 0, ws, shm))
  RUN(9, phase_resnorm(p, p.post_ffn_g, p.pre_mix_g + 1024))
  RUN(10, phase_gemm_big((const bf16_t*)(ws + O_HN), (const bf16_t*)(ws + O_WIN1), 2816, 1024, nullptr, 0, 1, ws, shm))
  RUN(11, phase_prepC(p, lds))
  RUN(12, phase_attnC(p, lds))
  RUN(13, phase_scan1(p, lds))
  RUN(14, phase_scan2(p, lds))
  RUN(15, phase_scan3(p, lds))
  RUN(16, phase_gemm_small((const bf16_t*)(ws + O_LR) + 256, 384, (const bf16_t*)(ws + O_GUP), 512, 128, (bf16_t*)(ws + O_G), 512, lds))
  RUN(17, phase_rwkv_final(p))
  RUN(18, phase_gemm_big((const bf16_t*)(ws + O_MIX), (const bf16_t*)(ws + O_WOUT1), 1024, 1024, (bf16_t*)(ws + O_HN), 1024, 0, ws, shm))
  RUN(19, phase_resnorm(p, p.post_mix_g + 1024, p.pre_ffn_g + 1024))
  RUN(20, phase_gemm_gateup((const bf16_t*)(ws + O_HN), (const bf16_t*)(ws + O_WGU1), (bf16_t*)(ws + O_ACT), shm))
  RUN(21, phase_gemm_big((const bf16_t*)(ws + O_ACT), (const bf16_t*)(ws + O_WD1), 1024, DFF, (bf16_t*)(ws + O_HN), 1024, 0, ws, shm))
  RUN(22, phase_resnorm(p, p.post_ffn_g + 1024, nullptr))
#undef RUN
}

extern "C" void kernel_launch(void* const* d_in, const int* in_sizes, int n_in, void* d_out, int out_size, void* d_ws, size_t ws_size,
                              hipStream_t stream) {
  static int grid_blocks = 0;
  if (!grid_blocks) {
    int dev = 0, cus = 0, per_cu = 0;
    (void)hipGetDevice(&dev);
    (void)hipDeviceGetAttribute(&cus, hipDeviceAttributeMultiprocessorCount, dev);
    if (hipFuncSetAttribute((const void*)mega, hipFuncAttributeMaxDynamicSharedMemorySize, LDS_BYTES) != hipSuccess) fprintf(stderr, "hipFuncSetAttribute failed\n");
    if (hipOccupancyMaxActiveBlocksPerMultiprocessor(&per_cu, (const void*)mega, NTH, LDS_BYTES) != hipSuccess || per_cu < 1) {
      fprintf(stderr, "occupancy query says %d\n", per_cu);
      (void)hipGetLastError();
    }
    grid_blocks = cus;
  }
  if (ws_size < O_BAR + CTL_BYTES) { fprintf(stderr, "workspace too small\n"); return; }
  if (hipMemsetAsync((char*)d_ws + O_BAR, 0, CTL_BYTES, stream) != hipSuccess) { fprintf(stderr, "memset failed\n"); return; }
  P p{};
  const float** f = (const float**)&p;
  for (int i = 0; i < 32; ++i) f[i] = (const float*)d_in[i];
  p.out = (float*)d_out;
  p.ws = (char*)d_ws;
#if FUSED
  p.ph0 = 0; p.ph1 = NPHASE;
  void* args[] = {&p};
  hipError_t e = hipLaunchCooperativeKernel((void*)mega, dim3(grid_blocks), dim3(NTH), args, LDS_BYTES, stream);
  if (e != hipSuccess) fprintf(stderr, "cooperative launch failed: %s (grid %d)\n", hipGetErrorString(e), grid_blocks);
#else
  for (int ph = 0; ph < NPHASE; ++ph) {
    p.ph0 = ph; p.ph1 = ph + 1;
    hipLaunchKernelGGL(mega, dim3(grid_blocks), dim3(NTH), LDS_BYTES, stream, p);
  }
#endif
}
```

```cpp
#include <hip/hip_runtime.h>
#include <hip/hip_cooperative_groups.h>
#include <cstdio>
namespace cg = cooperative_groups;

#ifndef FUSED
#define FUSED 1
#endif

typedef unsigned short bf16_t;
using bf16x8 = __attribute__((ext_vector_type(8))) short;
using s16x4 = __attribute__((ext_vector_type(4))) short;
using f32x16 = __attribute__((ext_vector_type(16))) float;
using u32x4 = __attribute__((ext_vector_type(4))) unsigned;
using f32x4v = __attribute__((ext_vector_type(4))) float;
#define DI __device__ __forceinline__
#define MFMA32(a, b, c) __builtin_amdgcn_mfma_f32_32x32x16_bf16((a), (b), (c), 0, 0, 0)
constexpr int NTH = 512;
constexpr int LDS_BYTES = 131072 + 16;

constexpr int DM_ = 1024;
constexpr int T_ = 49296;
constexpr int TP_ = 49408;
constexpr int NT_ = TP_ / 128;
constexpr int DFF = 2816;
constexpr float EPS = 1e-6f;
constexpr float LOG2E = 1.4426950408889634f;

constexpr size_t SZ_ROW1024 = (size_t)TP_ * 1024 * 2;
constexpr size_t O_WIN0 = 0;
constexpr size_t O_WOUT0 = O_WIN0 + (size_t)1536 * 1024 * 2;
constexpr size_t O_WGU0 = O_WOUT0 + (size_t)1024 * 1024 * 2;
constexpr size_t O_WD0 = O_WGU0 + (size_t)5632 * 1024 * 2;
constexpr size_t O_DM257 = O_WD0 + (size_t)1024 * 2816 * 2;
constexpr size_t O_DM1025 = O_DM257 + (size_t)384 * 576 * 2;
constexpr size_t O_WIN1 = O_DM1025 + (size_t)1152 * 2112 * 2;
constexpr size_t O_WOUT1 = O_WIN1 + (size_t)2816 * 1024 * 2;
constexpr size_t O_WGU1 = O_WOUT1 + (size_t)1024 * 1024 * 2;
constexpr size_t O_WD1 = O_WGU1 + (size_t)5632 * 1024 * 2;
constexpr size_t O_GUP = O_WD1 + (size_t)1024 * 2816 * 2;
constexpr size_t O_RA = O_GUP + (size_t)512 * 128 * 2;
constexpr size_t O_RB = O_RA + SZ_ROW1024;
constexpr size_t O_RC = O_RB + (size_t)TP_ * 2816 * 2;
constexpr size_t O_META = O_RC + SZ_ROW1024;
constexpr size_t O_WC = O_META + (size_t)144 * 1024 * 4;
constexpr size_t O_WUPT = O_WC + (size_t)4 * 64 * 128 * 4;
constexpr size_t O_AUPT = O_WUPT + (size_t)2 * 512 * 64 * 2;
constexpr size_t O_END = O_AUPT + (size_t)2 * 512 * 64 * 2;
constexpr size_t O_HN = O_RA;
constexpr size_t O_VTA = O_RA;
constexpr size_t O_LR = O_RA;
constexpr size_t O_BONUS = O_RA + (size_t)TP_ * 384 * 2;
constexpr size_t O_VTC = O_BONUS + (size_t)T_ * 16 * 4;
constexpr size_t O_OB = O_RA + (size_t)TP_ * 512 * 2;
constexpr size_t O_PROJ0 = O_RB;
constexpr size_t O_ZB = O_PROJ0 + (size_t)TP_ * 1536 * 2;
constexpr size_t O_Y = O_ZB + (size_t)TP_ * 512 * 2;
constexpr size_t O_ACT = O_RB;
constexpr size_t O_PRKV = O_RB;
constexpr size_t O_PC = O_PRKV + (size_t)TP_ * 1536 * 2;
constexpr size_t O_PLOW = O_PC + (size_t)TP_ * 768 * 2;
constexpr size_t O_PQ = O_PC;
constexpr size_t O_G = O_PC;
constexpr size_t O_MIX = O_RC;
static_assert(O_VTC + (size_t)49728 * 128 * 2 <= O_RB, "vtc");
static_assert(O_Y + (size_t)(8 * 16 * 256 * 576 + 16 * 256 * 2112) * 2 <= O_RC, "y");
static_assert(O_PQ + (size_t)3216 * 32768 <= O_RC, "pq");
constexpr size_t O_BAR = (O_END + 255) / 256 * 256;
constexpr size_t O_CNT = O_BAR + 3456 * 4;
constexpr size_t CTL_BYTES = 3456 * 4 + 4 * 256;
static_assert(O_BAR + CTL_BYTES <= (size_t)536870912, "ws");

struct P {
  const float *x_prompt, *x_sample, *meta, *pre_mix_g, *post_mix_g, *pre_ffn_g, *post_ffn_g;
  const float *even_w_in, *even_w_out, *a_q_gain, *a_k_gain, *b_norm_g, *b_w, *b_b;
  const float *odd_w_in, *odd_w_out, *c_sink, *mu_prev, *mu_next, *d_w0, *d_w_up, *d_a0, *d_a_up, *d_g_up;
  const float *d_k_k, *d_k_a, *d_r_k, *d_ln_g, *d_ln_b, *ffn_gate, *ffn_up, *ffn_down;
  float* out;
  char* ws;
  int ph0, ph1;
};

typedef float f32x2 __attribute__((ext_vector_type(2)));
typedef __bf16 bf16x2_t __attribute__((ext_vector_type(2)));
DI bf16_t f2bf(float x) { return __builtin_bit_cast(bf16_t, (__bf16)x); }
DI float bf2f(bf16_t b) { return __uint_as_float(((unsigned)b) << 16); }
DI unsigned pack2(float a, float b) { f32x2 v = {a, b}; return __builtin_bit_cast(unsigned, __builtin_convertvector(v, bf16x2_t)); }
DI float lo2f(unsigned u) { return __uint_as_float(u << 16); }
DI float hi2f(unsigned u) { return __uint_as_float(u & 0xffff0000u); }
DI float wave_sum(float v) {
  for (int o = 32; o > 0; o >>= 1) v += __shfl_xor(v, o);
  return v;
}
DI int seq_of(int sr, int& pos) {
  if (sr < 32896) { int b = sr / 4112; pos = sr - b * 4112; return b; }
  pos = sr - 32896; return 8;
}
DI int seq_len(int b) { return b < 8 ? 4112 : 16400; }
DI int seq_base(int b) { return b < 8 ? b * 4112 : 32896; }
DI float* hrow(const P& p, int sr) {
  int pos; int b = seq_of(sr, pos);
  if (pos < 16) return (float*)(p.ws + O_META) + (size_t)(b * 16 + pos) * 1024;
  return p.out + ((size_t)(b < 8 ? b * 4096 : 32768) + (pos - 16)) * 1024;
}
DI float sigmoidf_(float x) { return 1.f / (1.f + expf(-x)); }

DI void transpose_w(const float* W, int K, int ldw, int N, bf16_t* Wt, int mode, const float* W2, int gtid, int gsz) {
  int nk8 = K / 8;
  long total = (long)N * nk8;
  for (long it = gtid; it < total; it += gsz) {
    int n = (int)(it % N), k8 = (int)(it / N);
    const float* src = W;
    int c = n;
    if (mode == 1) {
      int blk = n >> 8, w = n & 255;
      c = blk * 128 + (w & 127);
      if (w >= 128) src = W2;
    }
    unsigned r[4];
#pragma unroll
    for (int j = 0; j < 4; ++j) {
      float a = src[(size_t)(k8 * 8 + 2 * j) * ldw + c];
      float b = src[(size_t)(k8 * 8 + 2 * j + 1) * ldw + c];
      r[j] = pack2(a, b);
    }
    *(uint4*)(Wt + (size_t)n * K + k8 * 8) = make_uint4(r[0], r[1], r[2], r[3]);
  }
}

DI void phase_prep(const P& p) {
  const int gtid = blockIdx.x * NTH + threadIdx.x, gsz = gridDim.x * NTH;
  char* ws = p.ws;
  transpose_w(p.even_w_in, 1024, 1536, 1536, (bf16_t*)(ws + O_WIN0), 0, nullptr, gtid, gsz);
  transpose_w(p.even_w_out, 1024, 1024, 1024, (bf16_t*)(ws + O_WOUT0), 0, nullptr, gtid, gsz);
  transpose_w(p.odd_w_in, 1024, 2688, 2688, (bf16_t*)(ws + O_WIN1), 0, nullptr, gtid, gsz);
  transpose_w(p.odd_w_out, 1024, 1024, 1024, (bf16_t*)(ws + O_WOUT1), 0, nullptr, gtid, gsz);
  transpose_w(p.ffn_gate, 1024, DFF, 5632, (bf16_t*)(ws + O_WGU0), 1, p.ffn_up, gtid, gsz);
  transpose_w(p.ffn_gate + (size_t)1024 * DFF, 1024, DFF, 5632, (bf16_t*)(ws + O_WGU1), 1, p.ffn_up + (size_t)1024 * DFF, gtid, gsz);
  transpose_w(p.ffn_down, DFF, 1024, 1024, (bf16_t*)(ws + O_WD0), 0, nullptr, gtid, gsz);
  transpose_w(p.ffn_down + (size_t)DFF * 1024, DFF, 1024, 1024, (bf16_t*)(ws + O_WD1), 0, nullptr, gtid, gsz);
  transpose_w(p.d_g_up, 128, 512, 512, (bf16_t*)(ws + O_GUP), 0, nullptr, gtid, gsz);
  for (int d = 0; d < 2; ++d) {
    transpose_w(p.d_w_up + (size_t)d * 64 * 512, 64, 512, 512, (bf16_t*)(ws + O_WUPT) + (size_t)d * 512 * 64, 0, nullptr, gtid, gsz);
    transpose_w(p.d_a_up + (size_t)d * 64 * 512, 64, 512, 512, (bf16_t*)(ws + O_AUPT) + (size_t)d * 512 * 64, 0, nullptr, gtid, gsz);
  }
  for (int it = gtid; it < 128 * 1024 / 8; it += gsz) *(uint4*)((bf16_t*)(ws + O_WIN1) + (size_t)2688 * 1024 + (size_t)it * 8) = make_uint4(0, 0, 0, 0);
  for (int which = 0; which < 2; ++which) {
    const int M = which ? 1025 : 257, MP = which ? 1152 : 384, KP = which ? 2112 : 576;
    bf16_t* dm = (bf16_t*)(ws + (which ? O_DM1025 : O_DM257));
    for (int it = gtid; it < MP * KP; it += gsz) {
      int r = it / KP, c = it - r * KP;
      float v = 0.f;
      if (r < M && c < 2 * M) {
        int n2 = c < M ? c : c - M;
        int m = (r * n2) % M;
        float s, co;
        sincospif(2.0f * (float)m / (float)M, &s, &co);
        v = c < M ? co : s;
      }
      dm[it] = f2bf(v);
    }
  }
  for (int it = gtid; it < 4 * 64 * 128; it += gsz) {
    int o = it & 127, c = (it >> 7) & 63, g = it >> 13;
    int d = o & 63;
    float acc = 0.f;
    for (int c2 = 0; c2 < 64; ++c2) {
      float s, co;
      sincospif((float)((c * c2) & 63) / 32.f, &s, &co);
      float w = p.b_w[(g * 64 + c2) * 64 + d];
      acc += (o < 64 ? co : -s) * w;
    }
    ((float*)(ws + O_WC))[it] = acc;
  }
  const int lane = threadIdx.x & 63, gw = gtid >> 6, nw = gsz >> 6;
  bf16_t* HN = (bf16_t*)(ws + O_HN);
  for (int sr = gw; sr < TP_; sr += nw) {
    if (sr >= T_) {
#pragma unroll
      for (int q = 0; q < 2; ++q) *(uint4*)(HN + (size_t)sr * 1024 + q * 512 + lane * 8) = make_uint4(0, 0, 0, 0);
      continue;
    }
    int pos; int b = seq_of(sr, pos);
    const float* src = pos < 16 ? p.meta + pos * 1024
                                : (b < 8 ? p.x_prompt + ((size_t)b * 4096 + pos - 16) * 1024 : p.x_sample + (size_t)(pos - 16) * 1024);
    float* hr = hrow(p, sr);
    float4 v[4];
    float ss = 0.f;
#pragma unroll
    for (int q = 0; q < 4; ++q) {
      v[q] = *(const float4*)(src + q * 256 + lane * 4);
      ss += v[q].x * v[q].x + v[q].y * v[q].y + v[q].z * v[q].z + v[q].w * v[q].w;
      *(float4*)(hr + q * 256 + lane * 4) = v[q];
    }
    ss = wave_sum(ss);
    float rs = rsqrtf(ss * (1.f / 1024.f) + EPS);
#pragma unroll
    for (int q = 0; q < 4; ++q) {
      float4 g = *(const float4*)(p.pre_mix_g + q * 256 + lane * 4);
      uint2 o = make_uint2(pack2(v[q].x * rs * g.x, v[q].y * rs * g.y), pack2(v[q].z * rs * g.z, v[q].w * rs * g.w));
      *(uint2*)(HN + (size_t)sr * 1024 + q * 256 + lane * 4) = o;
    }
  }
}

DI void gemm_tile(const bf16_t* __restrict__ A, int lda, const bf16_t* __restrict__ B, int ldb, int K, char* lds, f32x16 (&acc)[2][2]) {
  const int tid = threadIdx.x & 255, lane = tid & 63, wave = tid >> 6, wm = wave >> 1, wn = wave & 1;
  const int l31 = lane & 31, h = lane >> 5;
  bf16_t* As = (bf16_t*)lds;
  bf16_t* Bs = As + 128 * 72;
#pragma unroll
  for (int a = 0; a < 2; ++a)
#pragma unroll
    for (int b = 0; b < 2; ++b)
#pragma unroll
      for (int i = 0; i < 16; ++i) acc[a][b][i] = 0.f;
  const int lr = tid >> 3, lc = (tid & 7) * 8;
  const bf16_t* Ag = A + (size_t)lr * lda + lc;
  const bf16_t* Bg = B + (size_t)lr * ldb + lc;
  u32x4 ra[4], rb[4];
#pragma unroll
  for (int q = 0; q < 4; ++q) {
    ra[q] = *(const u32x4*)(Ag + (size_t)(32 * q) * lda);
    rb[q] = *(const u32x4*)(Bg + (size_t)(32 * q) * ldb);
  }
#pragma unroll
  for (int q = 0; q < 4; ++q) {
    *(u32x4*)(As + (lr + 32 * q) * 72 + lc) = ra[q];
    *(u32x4*)(Bs + (lr + 32 * q) * 72 + lc) = rb[q];
  }
  __syncthreads();
  const int nk = K >> 6;
  for (int kt = 0; kt < nk; ++kt) {
    if (kt + 1 < nk) {
#pragma unroll
      for (int q = 0; q < 4; ++q) {
        ra[q] = *(const u32x4*)(Ag + (size_t)(32 * q) * lda + (kt + 1) * 64);
        rb[q] = *(const u32x4*)(Bg + (size_t)(32 * q) * ldb + (kt + 1) * 64);
      }
    }
#pragma unroll
    for (int ks = 0; ks < 4; ++ks) {
      bf16x8 a[2], b[2];
#pragma unroll
      for (int t = 0; t < 2; ++t) {
        a[t] = *(const bf16x8*)(As + (wm * 64 + t * 32 + l31) * 72 + ks * 16 + 8 * h);
        b[t] = *(const bf16x8*)(Bs + (wn * 64 + t * 32 + l31) * 72 + ks * 16 + 8 * h);
      }
#pragma unroll
      for (int mt = 0; mt < 2; ++mt)
#pragma unroll
        for (int nt = 0; nt < 2; ++nt) acc[mt][nt] = MFMA32(a[mt], b[nt], acc[mt][nt]);
    }
    __syncthreads();
    if (kt + 1 < nk) {
#pragma unroll
      for (int q = 0; q < 4; ++q) {
        *(u32x4*)(As + (lr + 32 * q) * 72 + lc) = ra[q];
        *(u32x4*)(Bs + (lr + 32 * q) * 72 + lc) = rb[q];
      }
      __syncthreads();
    }
  }
}
#define ACC_ROW(mt, i) (wm * 64 + (mt) * 32 + ((i) & 3) + 8 * ((i) >> 2) + 4 * h)
#define ACC_COL(nt) (wn * 64 + (nt) * 32 + l31)
#define GEMM_IDS const int lane = threadIdx.x & 63, wave = (threadIdx.x & 255) >> 6, wm = wave >> 1, wn = wave & 1, l31 = lane & 31, h = lane >> 5; (void)wm; (void)wn; (void)l31; (void)h;

DI void phase_gemm_small(const bf16_t* A, int lda, const bf16_t* W, int N, int K, bf16_t* C, int ldc, char* lds) {
  GEMM_IDS
  const int sb = threadIdx.x >> 8;
  const int ntn = N / 128;
  const int total = NT_ * ntn;
  for (int t0 = blockIdx.x * 2; t0 < total; t0 += gridDim.x * 2) {
    const int t = t0 + sb;
    const int tm = t / ntn, tn = t - tm * ntn;
    f32x16 acc[2][2];
    gemm_tile(A + (size_t)tm * 128 * lda, lda, W + (size_t)tn * 128 * K, K, K, lds + sb * 36864, acc);
#pragma unroll
    for (int mt = 0; mt < 2; ++mt)
#pragma unroll
      for (int nt = 0; nt < 2; ++nt)
#pragma unroll
        for (int i = 0; i < 16; ++i) {
          int row = tm * 128 + ACC_ROW(mt, i), col = tn * 128 + ACC_COL(nt);
          C[(size_t)row * ldc + col] = f2bf(acc[mt][nt][i]);
        }
  }
}

namespace pg8 {
#define PG8_LAS __attribute__((address_space(3)))
typedef unsigned short bf16_t;
typedef short bf16x8 __attribute__((ext_vector_type(8)));
typedef float f32x4 __attribute__((ext_vector_type(4)));
typedef unsigned u32x4 __attribute__((ext_vector_type(4)));
constexpr int BM = 256, BK = 64, HALF = 128, HTB = HALF * BK * 2  , STAGE_BYTES = 8 * HTB, NXCD = 8, WGM = 8;

__host__ __device__ __forceinline__ int lds_byte(int r, int c) { const int st = (r >> 4) * 2 + (c >> 5), rr = r & 15, cc = c & 31, ob = rr * 64 + cc * 2; return st * 1024 + (ob ^ (((ob >> 9) & 1) << 5)); }
__host__ __device__ __forceinline__ void stage_rc(int b, int& R, int& C) { const int st = b / 1024, sb = b % 1024, swz = sb ^ (((sb >> 9) & 1) << 5); R = (st >> 1) * 16 + swz / 64; C = (st & 1) * 32 + (swz % 64) / 2; }
__host__ __device__ __forceinline__ int perm32(int rho) { const int n = rho >> 4, i = rho & 15; return 8 * (i >> 2) + 4 * n + (i & 3); }

struct Unit { int pm, pn; };
struct Gemm { const bf16_t* A; const bf16_t* Bt; int M, N, K; };

struct StaticOrder {
    int nM, nN, nwg, G, c;
    __host__ __device__ void init(int M, int N, int G_, int c_) { nM = M / BM; nN = N / BM; nwg = nM * nN; G = G_; c = c_; }
    __host__ __device__ bool next(int i, Unit& u) const {
        const long L = (long)i * G + c; if (L >= nwg) return false;
        int wgid = (int)L; { const int q = nwg / NXCD, r = nwg % NXCD, xcd = wgid % NXCD, off = wgid / NXCD; wgid = (xcd < r ? xcd * (q + 1) : r * (q + 1) + (xcd - r) * q) + off; }
        const int nig = WGM * nN, gid = wgid / nig, fm = gid * WGM, gsz = (nM - fm) < WGM ? (nM - fm) : WGM;
        u.pm = fm + ((wgid % nig) % gsz); u.pn = (wgid % nig) / gsz; return true;
    }
    __device__ __forceinline__ void a_ready(const Unit&) const {}
    __device__ __forceinline__ void done(const Unit&) const {}
};
__device__ __forceinline__ unsigned cvt_pk_bf16(float lo, float hi) { unsigned r; asm volatile("v_cvt_pk_bf16_f32 %0, %1, %2" : "=v"(r) : "v"(lo), "v"(hi)); return r; }

struct EpiRoute {
    static constexpr bool PERM = true, AFTER_DRAIN = false;
    bf16_t* O; int ldc; int route; bf16_t* pc; bf16_t* prkv; bf16_t* plow;
    __device__ __forceinline__ void operator()(const f32x4 (&acc)[2][2][4][2], const Unit& u, int wr, int wc, int fr, int fq) const {
        const int row0 = u.pm * BM + wr * 64 + fr;
#pragma unroll
        for (int bj = 0; bj < 2; ++bj) {
            int colh = u.pn * BM + bj * HALF; bf16_t* base = O; int ld = ldc;
            if (route) {
                if (colh < 768) { base = pc; ld = 768; }
                else if (colh < 2304) { base = prkv; ld = 1536; colh -= 768; }
                else if (colh < 2688) { base = plow; ld = 384; colh -= 2304; }
                else continue;
            }
            const int col0 = colh + wc * 32 + 8 * fq;
#pragma unroll
            for (int ai = 0; ai < 2; ++ai)
#pragma unroll
                for (int m = 0; m < 4; ++m) { bf16_t* rowp = base + (size_t)(row0 + ai * HALF + m * 16) * ld + col0;
                    const f32x4 v0 = acc[ai][bj][m][0], v1 = acc[ai][bj][m][1];
                    u32x4 w; w.x = cvt_pk_bf16(v0[0], v0[1]); w.y = cvt_pk_bf16(v0[2], v0[3]); w.z = cvt_pk_bf16(v1[0], v1[1]); w.w = cvt_pk_bf16(v1[2], v1[3]);
                    *(u32x4*)rowp = w; }
        }
    }
};
struct EpiGateUp {
    static constexpr bool PERM = true, AFTER_DRAIN = false;
    bf16_t* ACT;
    __device__ __forceinline__ void operator()(const f32x4 (&acc)[2][2][4][2], const Unit& u, int wr, int wc, int fr, int fq) const {
        const int row0 = u.pm * BM + wr * 64 + fr, col0 = u.pn * HALF + wc * 32 + 8 * fq;
#pragma unroll
        for (int ai = 0; ai < 2; ++ai)
#pragma unroll
            for (int m = 0; m < 4; ++m) { bf16_t* rowp = ACT + (size_t)(row0 + ai * HALF + m * 16) * 2816 + col0;
                float v[8];
#pragma unroll
                for (int n = 0; n < 2; ++n)
#pragma unroll
                    for (int j = 0; j < 4; ++j) { const float g = acc[ai][0][m][n][j], uu = acc[ai][1][m][n][j]; v[n * 4 + j] = g * __builtin_amdgcn_rcpf(1.f + __expf(-g)) * uu; }
                u32x4 w; w.x = cvt_pk_bf16(v[0], v[1]); w.y = cvt_pk_bf16(v[2], v[3]); w.z = cvt_pk_bf16(v[4], v[5]); w.w = cvt_pk_bf16(v[6], v[7]);
                *(u32x4*)rowp = w; }
    }
};
template <class Epi, class Sched, bool STAMP = false>
__device__ __forceinline__ void gemm_phase(PG8_LAS unsigned char* lds, const Gemm g, const Sched& S, const Epi& E, unsigned long long* stamps) {
    const int tid = threadIdx.x, wid = __builtin_amdgcn_readfirstlane(tid >> 6), lane = tid & 63, wr = wid >> 2, wc = wid & 3, fr = lane & 15, fq = lane >> 4;
    const int K = g.K, nt = K / BK;
    int ts_lo = 0, ts_hi = 0, nts = 0; const unsigned long long rt_entry = STAMP ? (unsigned long long)wall_clock64() : 0ull;
#define PG8_STAMP() do { if (STAMP && wid == 0 && nts < 64) { const unsigned long long _c = (unsigned long long)clock64(); \
        ts_lo = (lane == nts) ? (int)(unsigned)_c : ts_lo; ts_hi = (lane == nts) ? (int)(unsigned)(_c >> 32) : ts_hi; ++nts; } } while (0)
    PG8_STAMP();
    unsigned voffA[2], voffB[2];
#pragma unroll
    for (int i = 0; i < 2; ++i) { int R, C; stage_rc(tid * 16 + i * 8192, R, C); const int Rb = Epi::PERM ? ((R & ~31) + perm32(R & 31)) : R;
        voffA[i] = (unsigned)(R * K + C) * 2u; voffB[i] = (unsigned)(Rb * K + C) * 2u; }
    const size_t kstep = (size_t)(BK * 2);
    const size_t hstep = (size_t)HALF * K * 2;
    const size_t tstep = 2 * hstep;
    const unsigned ldsw = (unsigned)wid * 1024u;
    const int aoff = lds_byte(wr * 64 + fr, fq * 8), boff = lds_byte(wc * 32 + fr, fq * 8);
#define PG8_SA(b, h) (((b) * 2 + (h)) * HTB)
#define PG8_SB(b, h) ((4 + (b) * 2 + (h)) * HTB)
#define PG8_STAGE(bufoff, gbase, voff) do { _Pragma("unroll") for (int _i = 0; _i < 2; ++_i) \
        __builtin_amdgcn_global_load_lds((const unsigned*)((const char*)(gbase) + (voff)[_i]), (PG8_LAS unsigned*)(lds + (bufoff) + ldsw + _i * 8192), 16, 0, 0); } while (0)
#define PG8_LDA(dst, b, h) do { _Pragma("unroll") for (int m = 0; m < 4; ++m) _Pragma("unroll") for (int k = 0; k < 2; ++k) dst[m][k] = *(const PG8_LAS bf16x8*)(lds + PG8_SA(b, h) + aoff + m * 2048 + k * 1024); } while (0)
#define PG8_LDB(dst, b, h) do { _Pragma("unroll") for (int n = 0; n < 2; ++n) _Pragma("unroll") for (int k = 0; k < 2; ++k) dst[n][k] = *(const PG8_LAS bf16x8*)(lds + PG8_SB(b, h) + boff + n * 2048 + k * 1024); } while (0)
#define PG8_MMA(ai, bj, At, Bt) do { __builtin_amdgcn_s_setprio(1); _Pragma("unroll") for (int m = 0; m < 4; ++m) _Pragma("unroll") for (int n = 0; n < 2; ++n) _Pragma("unroll") for (int k = 0; k < 2; ++k) \
        acc[ai][bj][m][n] = __builtin_amdgcn_mfma_f32_16x16x32_bf16(Bt[n][k], At[m][k], acc[ai][bj][m][n], 0, 0, 0); __builtin_amdgcn_s_setprio(0); } while (0)
#define PG8_WAIT_V(n) asm volatile("s_waitcnt vmcnt(" #n ")" ::: "memory")
#define PG8_WAIT_L(n) asm volatile("s_waitcnt lgkmcnt(" #n ")" ::: "memory")
#define PG8_BAR __builtin_amdgcn_s_barrier()
#define PG8_SCHED __builtin_amdgcn_sched_barrier(0)
    Unit cur, nxt; int ui = 0;
    if (!S.next(0, cur)) return;
    f32x4 acc[2][2][4][2];
#pragma unroll
    for (int a = 0; a < 2; ++a)
#pragma unroll
        for (int b = 0; b < 2; ++b)
#pragma unroll
            for (int m = 0; m < 4; ++m)
#pragma unroll
                for (int n = 0; n < 2; ++n) acc[a][b][m][n] = (f32x4){0.f, 0.f, 0.f, 0.f};
    bf16x8 At[4][2], B0[2][2], B1[2][2];
    const char* cA = (const char*)g.A + (size_t)cur.pm * tstep; const char* cB = (const char*)g.Bt + (size_t)cur.pn * tstep;
    S.a_ready(cur);
    PG8_STAGE(PG8_SB(0, 0), cB, voffB); PG8_STAGE(PG8_SA(0, 0), cA, voffA); PG8_STAGE(PG8_SB(0, 1), cB + hstep, voffB); PG8_STAGE(PG8_SA(0, 1), cA + hstep, voffA);
    if (wr == 1) PG8_BAR;
    PG8_WAIT_V(4); PG8_BAR;
    PG8_STAGE(PG8_SB(1, 0), cB + kstep, voffB); PG8_STAGE(PG8_SA(1, 0), cA + kstep, voffA); PG8_STAGE(PG8_SB(1, 1), cB + hstep + kstep, voffB);
    PG8_WAIT_V(6); PG8_BAR;
    PG8_STAMP();
    for (;;) {
        const bool has_next = S.next(ui + 1, nxt);
        const char* nA = has_next ? (const char*)g.A + (size_t)nxt.pm * tstep : cA; const char* nB = has_next ? (const char*)g.Bt + (size_t)nxt.pn * tstep : cB;
        for (int t = 0; t < nt; t += 2) {
            const bool last = (t == nt - 2);
            const char* a1 = cA + (size_t)(t + 1) * kstep;
            const char* a2 = last ? nA : cA + (size_t)(t + 2) * kstep; const char* b2 = last ? nB : cB + (size_t)(t + 2) * kstep;
            const char* a3 = a2 + kstep; const char* b3 = b2 + kstep;
            if (last && has_next) S.a_ready(nxt);
            PG8_LDB(B0, 0, 0); PG8_SCHED; PG8_LDA(At, 0, 0); PG8_STAGE(PG8_SA(1, 1), a1 + hstep, voffA);
            PG8_WAIT_L(8); PG8_BAR; PG8_WAIT_L(0); PG8_MMA(0, 0, At, B0); PG8_BAR; PG8_SCHED;
            PG8_LDB(B1, 0, 1); PG8_STAGE(PG8_SB(0, 0), b2, voffB);
            PG8_BAR; PG8_WAIT_L(0); PG8_MMA(0, 1, At, B1); PG8_BAR;
            PG8_LDA(At, 0, 1); PG8_STAGE(PG8_SA(0, 0), a2, voffA);
            PG8_BAR; PG8_WAIT_L(0); PG8_MMA(1, 0, At, B0); PG8_BAR; PG8_SCHED;
            PG8_STAGE(PG8_SB(0, 1), b2 + hstep, voffB);
            PG8_WAIT_V(6); PG8_BAR; PG8_MMA(1, 1, At, B1); PG8_BAR;
            PG8_LDB(B0, 1, 0); PG8_SCHED; PG8_LDA(At, 1, 0); PG8_STAGE(PG8_SA(0, 1), a2 + hstep, voffA);
            PG8_WAIT_L(8); PG8_BAR; PG8_WAIT_L(0); PG8_MMA(0, 0, At, B0); PG8_BAR; PG8_SCHED;
            PG8_LDB(B1, 1, 1); PG8_STAGE(PG8_SB(1, 0), b3, voffB);
            PG8_BAR; PG8_WAIT_L(0); PG8_MMA(0, 1, At, B1); PG8_BAR;
            PG8_LDA(At, 1, 1); PG8_STAGE(PG8_SA(1, 0), a3, voffA);
            PG8_BAR; PG8_WAIT_L(0); PG8_MMA(1, 0, At, B0); PG8_BAR; PG8_SCHED;
            PG8_STAGE(PG8_SB(1, 1), b3 + hstep, voffB);
            PG8_WAIT_V(6); PG8_BAR; PG8_MMA(1, 1, At, B1); PG8_BAR;
        }
        PG8_STAMP();
        if constexpr (!Epi::AFTER_DRAIN) { E(acc, cur, wr, wc, fr, fq); S.done(cur); }
        PG8_STAMP();
        if (!has_next) break;
#pragma unroll
        for (int a = 0; a < 2; ++a)
#pragma unroll
            for (int b = 0; b < 2; ++b)
#pragma unroll
                for (int m = 0; m < 4; ++m)
#pragma unroll
                    for (int n = 0; n < 2; ++n) acc[a][b][m][n] = (f32x4){0.f, 0.f, 0.f, 0.f};
        cur = nxt; cA = nA; cB = nB; ++ui;
    }
    PG8_WAIT_V(0);
    if (wr == 0) PG8_BAR;
    PG8_BAR;
    if constexpr (Epi::AFTER_DRAIN) { E.fused(acc, cur, wr, wc, fr, fq, lds, wid, lane); S.done(cur); }
    PG8_STAMP();
    if (STAMP && wid == 0) { stamps[lane] = lane < nts ? (((unsigned long long)(unsigned)ts_hi << 32) | (unsigned)ts_lo) : 0ull;
        if (lane == 62) stamps[62] = rt_entry; if (lane == 63) stamps[63] = (unsigned long long)wall_clock64(); }
#undef PG8_STAMP
#undef PG8_SA
#undef PG8_SB
#undef PG8_STAGE
#undef PG8_LDA
#undef PG8_LDB
#undef PG8_MMA
#undef PG8_WAIT_V
#undef PG8_WAIT_L
#undef PG8_BAR
#undef PG8_SCHED
}
}

DI void phase_gemm_big(const bf16_t* A, const bf16_t* W, int N, int K, bf16_t* C, int ldc, int route, char* ws, unsigned char* lds) {
  pg8::Gemm g{A, W, TP_, N, K};
  pg8::StaticOrder S; S.init(TP_, N, gridDim.x, blockIdx.x);
  pg8::EpiRoute E{C, ldc, route, (bf16_t*)(ws + O_PC), (bf16_t*)(ws + O_PRKV), (bf16_t*)(ws + O_PLOW)};
  pg8::gemm_phase<pg8::EpiRoute, pg8::StaticOrder, false>((PG8_LAS unsigned char*)lds, g, S, E, nullptr);
}
DI void phase_gemm_gateup(const bf16_t* A, const bf16_t* W, bf16_t* ACT, unsigned char* lds) {
  pg8::Gemm g{A, W, TP_, 5632, 1024};
  pg8::StaticOrder S; S.init(TP_, 5632, gridDim.x, blockIdx.x);
  pg8::EpiGateUp E{ACT};
  pg8::gemm_phase<pg8::EpiGateUp, pg8::StaticOrder, false>((PG8_LAS unsigned char*)lds, g, S, E, nullptr);
}

DI void phase_resnorm(const P& p, const float* g1, const float* g2) {
  const int lane = threadIdx.x & 63, gw = (blockIdx.x * NTH + threadIdx.x) >> 6, nw = (gridDim.x * NTH) >> 6;
  bf16_t* HN = (bf16_t*)(p.ws + O_HN);
  for (int sr = gw; sr < T_; sr += nw) {
    float* hr = hrow(p, sr);
    float x[16];
    float ss = 0.f;
#pragma unroll
    for (int q = 0; q < 4; ++q) {
      const uint2 u = *(const uint2*)(HN + (size_t)sr * 1024 + q * 256 + lane * 4);
      x[q * 4] = lo2f(u.x); x[q * 4 + 1] = hi2f(u.x); x[q * 4 + 2] = lo2f(u.y); x[q * 4 + 3] = hi2f(u.y);
      ss += x[q * 4] * x[q * 4] + x[q * 4 + 1] * x[q * 4 + 1] + x[q * 4 + 2] * x[q * 4 + 2] + x[q * 4 + 3] * x[q * 4 + 3];
    }
    f32x4v hh[4];
#pragma unroll
    for (int q = 0; q < 4; ++q) hh[q] = *(const f32x4v*)(hr + q * 256 + lane * 4);
    ss = wave_sum(ss);
    const float rs = rsqrtf(ss * (1.f / 1024.f) + EPS);
    float ss2 = 0.f;
#pragma unroll
    for (int q = 0; q < 4; ++q) {
      const float4 g = *(const float4*)(g1 + q * 256 + lane * 4);
      hh[q].x += x[q * 4 + 0] * rs * g.x; hh[q].y += x[q * 4 + 1] * rs * g.y; hh[q].z += x[q * 4 + 2] * rs * g.z; hh[q].w += x[q * 4 + 3] * rs * g.w;
      *(f32x4v*)(hr + q * 256 + lane * 4) = hh[q];
      ss2 += hh[q].x * hh[q].x + hh[q].y * hh[q].y + hh[q].z * hh[q].z + hh[q].w * hh[q].w;
    }
    if (g2) {
      ss2 = wave_sum(ss2);
      const float rs2 = rsqrtf(ss2 * (1.f / 1024.f) + EPS);
#pragma unroll
      for (int q = 0; q < 4; ++q) {
        const float4 g = *(const float4*)(g2 + q * 256 + lane * 4);
        *(uint2*)(HN + (size_t)sr * 1024 + q * 256 + lane * 4) = make_uint2(pack2(hh[q].x * rs2 * g.x, hh[q].y * rs2 * g.y), pack2(hh[q].z * rs2 * g.z, hh[q].w * rs2 * g.w));
      }
    }
  }
}

DI size_t vta_base(int seq) { return seq < 8 ? (size_t)seq * 256 * 4160 : (size_t)8 * 256 * 4160; }
template <int NC> DI void vt_transpose(const bf16_t* src, int ld, int col0, bf16_t* VT, char* lds) {
  bf16_t* tl = (bf16_t*)lds;
  const int tid = threadIdx.x;
  constexpr int CPT = NC / 8, TPR = 512 / NC, PPT = 64 / TPR;
  for (int it = blockIdx.x; it < 257 + 8 * 65; it += gridDim.x) {
    int seq, kt;
    if (it < 257) { seq = 8; kt = it; } else { const int j = it - 257; seq = j / 65; kt = j - seq * 65; }
    const int L = seq_len(seq), LP = L + 48, sbase = seq_base(seq);
    const size_t vb = (seq < 8 ? (size_t)seq * NC * 4160 : (size_t)8 * NC * 4160);
    __syncthreads();
    const int pl = tid >> 3, part = tid & 7;
    const int pos = 64 * kt + pl - 48;
#pragma unroll
    for (int q = 0; q < CPT / 8; ++q) {
      u32x4 v = (u32x4)(0u);
      if (pos >= 0) v = *(const u32x4*)(src + (size_t)(sbase + pos) * ld + col0 + part * CPT + q * 8);
#pragma unroll
      for (int j = 0; j < 4; ++j) {
        tl[(part * CPT + q * 8 + 2 * j) * 72 + pl] = (bf16_t)(v[j] & 0xffffu);
        tl[(part * CPT + q * 8 + 2 * j + 1) * 72 + pl] = (bf16_t)(v[j] >> 16);
      }
    }
    __syncthreads();
    const int row = tid / TPR, seg = tid % TPR;
    bf16_t* dst = VT + vb + (size_t)row * LP + 64 * kt + seg * PPT;
#pragma unroll
    for (int q = 0; q < PPT / 8; ++q) *(u32x4*)(dst + q * 8) = *(const u32x4*)(tl + row * 72 + seg * PPT + q * 8);
  }
}

DI void phase_prepA(const P& p, char* lds) {
  const int lane = threadIdx.x & 63, wave = threadIdx.x >> 6;
  bf16_t* PROJ = (bf16_t*)(p.ws + O_PROJ0);
  bf16_t* ZB = (bf16_t*)(p.ws + O_ZB);
  const float* WC = (const float*)(p.ws + O_WC);
  vt_transpose<256>(PROJ, 1536, 1024, (bf16_t*)(p.ws + O_VTA), lds);
  __syncthreads();
  float* fl = (float*)lds + wave * 1024;
  const float inv = exp2f(-(float)(lane & 15) * (13.287712379549449f / 16.f));
  const float qg = p.a_q_gain[lane], kg = p.a_k_gain[lane];
  for (int r0 = blockIdx.x * 32; r0 < TP_; r0 += gridDim.x * 32) {
    const int srb = r0 + wave * 4;
#pragma unroll 1
    for (int rr = 0; rr < 4; ++rr) {
      const int sr = srb + rr;
      if (sr < T_) {
        int pos; seq_of(sr, pos);
        float rowf, colf;
        if (pos < 16) { rowf = colf = (float)(pos - 16); }
        else { int t = pos - 16; rowf = (float)(t >> 6); colf = (float)(t & 63); }
        float ang = (lane < 32 ? rowf : colf) * inv;
        float sn, cs;
        sincosf(ang, &sn, &cs);
        const float sgn = (lane & 16) ? sn : -sn;
        bf16_t* pr = PROJ + (size_t)sr * 1536;
        for (int hd = 0; hd < 16; ++hd) {
          float x = bf2f(pr[hd * 64 + lane]);
          float ss = wave_sum(x * x);
          float xn = x * rsqrtf(ss * (1.f / 64.f) + EPS) * (hd < 12 ? qg : kg);
          float pa = __shfl_xor(xn, 16);
          float o = xn * cs + pa * sgn;
          if (hd < 12) o *= 0.125f * LOG2E;
          pr[hd * 64 + lane] = f2bf(o);
        }
        uint2 u = *(const uint2*)(pr + 1280 + lane * 4);
        float f0 = lo2f(u.x), f1 = hi2f(u.x), f2 = lo2f(u.y), f3 = hi2f(u.y);
        float ss = f0 * f0 + f1 * f1 + f2 * f2 + f3 * f3;
        ss += __shfl_xor(ss, 1); ss += __shfl_xor(ss, 2); ss += __shfl_xor(ss, 4); ss += __shfl_xor(ss, 8);
        float rs = rsqrtf(ss * (1.f / 64.f) + EPS);
        float4 g = *(const float4*)(p.b_norm_g + lane * 4);
        *(float4*)(fl + rr * 256 + lane * 4) = make_float4(f0 * rs * g.x, f1 * rs * g.y, f2 * rs * g.z, f3 * rs * g.w);
      } else {
        *(float4*)(fl + rr * 256 + lane * 4) = make_float4(0.f, 0.f, 0.f, 0.f);
      }
    }
    __syncthreads();
    {
      const int g = lane >> 4, o0 = (lane & 15) * 8;
      float acc[4][8];
#pragma unroll
      for (int rr = 0; rr < 4; ++rr)
#pragma unroll
        for (int j = 0; j < 8; ++j) acc[rr][j] = 0.f;
      const float* wc = WC + (size_t)g * 64 * 128 + o0;
#pragma unroll 4
      for (int c = 0; c < 64; ++c) {
        const float4 w0 = *(const float4*)(wc + c * 128), w1 = *(const float4*)(wc + c * 128 + 4);
#pragma unroll
        for (int rr = 0; rr < 4; ++rr) {
          const float f = fl[rr * 256 + g * 64 + c];
          acc[rr][0] += f * w0.x; acc[rr][1] += f * w0.y; acc[rr][2] += f * w0.z; acc[rr][3] += f * w0.w;
          acc[rr][4] += f * w1.x; acc[rr][5] += f * w1.y; acc[rr][6] += f * w1.z; acc[rr][7] += f * w1.w;
        }
      }
#pragma unroll
      for (int rr = 0; rr < 4; ++rr)
        if (srb + rr < T_)
          *(uint4*)(ZB + (size_t)(srb + rr) * 512 + g * 128 + o0) = make_uint4(pack2(acc[rr][0], acc[rr][1]), pack2(acc[rr][2], acc[rr][3]), pack2(acc[rr][4], acc[rr][5]), pack2(acc[rr][6], acc[rr][7]));
    }
    __syncthreads();
  }
}

template <int MODE>
DI void flash_item(const bf16_t* __restrict__ Q, int ldq, const bf16_t* __restrict__ Kb, int ldk, const bf16_t* __restrict__ Vt, int LP,
                   bf16_t* O, int ldo, int sbase, int S, int qt, float sinkl2, char* lds) {
  const int tid = threadIdx.x & 255, lane = tid & 63, wave = tid >> 6, l31 = lane & 31, h = lane >> 5;
  bf16_t* Ks = (bf16_t*)lds;
  bf16_t* Vs = Ks + 2 * 64 * 72;
  const int rl = wave * 32 + l31;
  const int qpos = qt == 0 ? (rl < 16 ? rl : 15) : 16 + 128 * (qt - 1) + rl;
  const bool qvalid = qt > 0 || rl < 16;
  bf16x8 qf[4];
  {
    const bf16_t* qr = Q + (size_t)(sbase + qpos) * ldq;
#pragma unroll
    for (int s = 0; s < 4; ++s) qf[s] = *(const bf16x8*)(qr + 16 * s + 8 * h);
  }
  const int nkt_all = (S + 64) / 64;
  int klo = 1, n;
  if (MODE == 0) { n = nkt_all; }
  else {
    if (qt == 0) { klo = 1; n = 3; }
    else {
      int c = qt - 1;
      klo = 2 * c - 1; if (klo < 1) klo = 1;
      int khi = 2 * c + 4; if (khi > nkt_all - 1) khi = nkt_all - 1;
      n = 1 + (khi - klo + 1);
    }
  }
  const int ldr = tid >> 2, ldp = (tid & 3) * 16;
  u32x4 rk0, rk1, rv0, rv1;
  auto ktile = [&](int idx) { return idx == 0 ? 0 : klo + idx - 1; };
#define FL_GLOAD(idx)                                                                               \
  {                                                                                                 \
    int kt_ = ktile(idx);                                                                           \
    int pos_ = 64 * kt_ + ldr - 48;                                                                 \
    if (pos_ >= 0) {                                                                                \
      const bf16_t* kp_ = Kb + (size_t)(sbase + pos_) * ldk + ldp;                                  \
      rk0 = *(const u32x4*)kp_; rk1 = *(const u32x4*)(kp_ + 8);                                 \
    } else { rk0 = (u32x4)(0u); rk1 = rk0; }                                       \
    const bf16_t* vp_ = Vt + (size_t)ldr * LP + 64 * kt_ + ldp;                                     \
    rv0 = *(const u32x4*)vp_; rv1 = *(const u32x4*)(vp_ + 8);                                   \
  }
#define FL_SSTORE(buf)                                                                              \
  {                                                                                                 \
    *(u32x4*)(Ks + (buf) * 64 * 72 + ldr * 72 + ldp) = rk0; *(u32x4*)(Ks + (buf) * 64 * 72 + ldr * 72 + ldp + 8) = rk1; \
    { bf16_t* vd_ = Vs + (buf) * 64 * 68 + ldr * 68 + ldp; *(uint2*)vd_ = make_uint2(rv0.x, rv0.y); *(uint2*)(vd_ + 4) = make_uint2(rv0.z, rv0.w); *(uint2*)(vd_ + 8) = make_uint2(rv1.x, rv1.y); *(uint2*)(vd_ + 12) = make_uint2(rv1.z, rv1.w); } \
  }
  f32x16 oacc[2];
#pragma unroll
  for (int i = 0; i < 16; ++i) { oacc[0][i] = 0.f; oacc[1][i] = 0.f; }
  float m = -1e30f, l = 0.f;
  FL_GLOAD(0)
  FL_SSTORE(0)
  __syncthreads();
  for (int idx = 0; idx < n; ++idx) {
    const int cur = idx & 1;
    if (idx + 1 < n) FL_GLOAD(idx + 1)
    const int kt = ktile(idx);
    const bf16_t* ks = Ks + cur * 64 * 72;
    const bf16_t* vs = Vs + cur * 64 * 68;
    f32x16 sacc[2];
#pragma unroll
    for (int t = 0; t < 2; ++t) {
#pragma unroll
      for (int i = 0; i < 16; ++i) sacc[t][i] = 0.f;
#pragma unroll
      for (int s = 0; s < 4; ++s) {
        bf16x8 kf = *(const bf16x8*)(ks + (32 * t + l31) * 72 + 16 * s + 8 * h);
        sacc[t] = MFMA32(kf, qf[s], sacc[t]);
      }
    }
    if (kt == 0) {
#pragma unroll
      for (int t = 0; t < 2; ++t)
#pragma unroll
        for (int i = 0; i < 16; ++i) {
          int kl = 32 * t + (i & 3) + 8 * (i >> 2) + 4 * h;
          if (kl < 48) sacc[t][i] = -1e30f;
        }
    } else if (MODE == 1) {
#pragma unroll
      for (int t = 0; t < 2; ++t)
#pragma unroll
        for (int i = 0; i < 16; ++i) {
          int kl = 32 * t + (i & 3) + 8 * (i >> 2) + 4 * h;
          int tk = 64 * (kt - 1) + kl;
          bool vis;
          if (qt == 0) vis = tk <= 112 + qpos;
          else { int tq = qpos - 16; int d = tq - tk; vis = d <= 128 && d >= -128; }
          if (!vis) sacc[t][i] = -1e30f;
        }
    }
    float tmax = -1e30f;
#pragma unroll
    for (int t = 0; t < 2; ++t)
#pragma unroll
      for (int i = 0; i < 16; ++i) tmax = fmaxf(tmax, sacc[t][i]);
    tmax = fmaxf(tmax, __shfl_xor(tmax, 32));
    if (__builtin_amdgcn_ballot_w64(tmax > m) != 0ull) {
      const float mn = fmaxf(m, tmax);
      const float alpha = __builtin_amdgcn_exp2f(m - mn);
      m = mn;
      l *= alpha;
#pragma unroll
      for (int i = 0; i < 16; ++i) { oacc[0][i] *= alpha; oacc[1][i] *= alpha; }
    }
    const f32x2 m2 = {m, m};
    f32x2 ls2 = {0.f, 0.f};
    unsigned pk[2][8];
#pragma unroll
    for (int t = 0; t < 2; ++t)
#pragma unroll
      for (int i2 = 0; i2 < 8; ++i2) {
        f32x2 d = {sacc[t][2 * i2], sacc[t][2 * i2 + 1]};
        d = d - m2;
        f32x2 e = {__builtin_amdgcn_exp2f(d.x), __builtin_amdgcn_exp2f(d.y)};
        ls2 += e;
        pk[t][i2] = __builtin_bit_cast(unsigned, __builtin_convertvector(e, bf16x2_t));
      }
    l += ls2.x + ls2.y;
#pragma unroll
    for (int t = 0; t < 2; ++t)
#pragma unroll
      for (int s2 = 0; s2 < 2; ++s2) {
        u32x4 pk4 = {pk[t][4 * s2], pk[t][4 * s2 + 1], pk[t][4 * s2 + 2], pk[t][4 * s2 + 3]};
        bf16x8 pf = __builtin_bit_cast(bf16x8, pk4);
#pragma unroll
        for (int dt = 0; dt < 2; ++dt) {
          const bf16_t* vp = vs + (32 * dt + l31) * 68 + 32 * t + 16 * s2 + 4 * h;
          uint2 lo = *(const uint2*)vp, hi = *(const uint2*)(vp + 8);
          u32x4 v4 = {lo.x, lo.y, hi.x, hi.y};
          bf16x8 vf = __builtin_bit_cast(bf16x8, v4);
          oacc[dt] = MFMA32(vf, pf, oacc[dt]);
        }
      }
    if (idx + 1 < n) FL_SSTORE(cur ^ 1)
    __syncthreads();
  }
  l += __shfl_xor(l, 32);
  if (MODE == 1) l += __builtin_amdgcn_exp2f(sinkl2 - m);
  const float il = 1.f / l;
  if (qvalid) {
    bf16_t* orow = O + (size_t)(sbase + qpos) * ldo;
#pragma unroll
    for (int dt = 0; dt < 2; ++dt)
#pragma unroll
      for (int g = 0; g < 4; ++g) {
        int d = 32 * dt + 8 * g + 4 * h;
        uint2 o = make_uint2(pack2(oacc[dt][4 * g] * il, oacc[dt][4 * g + 1] * il), pack2(oacc[dt][4 * g + 2] * il, oacc[dt][4 * g + 3] * il));
        *(uint2*)(orow + d) = o;
      }
  }
#undef FL_GLOAD
#undef FL_SSTORE
}

DI size_t y_base(int seq) { return seq < 8 ? (size_t)seq * 16 * 256 * 576 : (size_t)8 * 16 * 256 * 576; }
DI void phase_attnA(const P& p, char* lds) {
  const bf16_t* PROJ = (const bf16_t*)(p.ws + O_PROJ0);
  const bf16_t* VT = (const bf16_t*)(p.ws + O_VTA);
  bf16_t* MIX = (bf16_t*)(p.ws + O_MIX);
  const int nS = 129 * 6, nP = 8 * 33 * 6;
  const int sb = threadIdx.x >> 8;
  unsigned* head = (unsigned*)(p.ws + O_CNT);
  for (;;) {
    if (threadIdx.x == 0) *(volatile int*)(lds + 2 * 36864) = (int)__hip_atomic_fetch_add(head, 1u, __ATOMIC_RELAXED, __HIP_MEMORY_SCOPE_AGENT);
    __syncthreads();
    const int it = *(volatile int*)(lds + 2 * 36864);
    __syncthreads();
    if (it >= nS + nP) break;
    int seq, qt, hq;
    if (it < nS) { seq = 8; hq = (it % 6) * 2 + sb; qt = it / 6; }
    else { int j = it - nS; hq = (j % 6) * 2 + sb; j /= 6; qt = j % 33; seq = j / 33; }
    const int kv = hq / 3;
    const int L = seq_len(seq), LP = L + 48;
    flash_item<0>(PROJ + hq * 64, 1536, PROJ + 768 + kv * 64, 1536, VT + vta_base(seq) + (size_t)kv * 64 * LP, LP,
                  MIX + hq * 64, 1024, seq_base(seq), L - 16, qt, 0.f, lds + sb * 36864);
  }
  const bf16_t* ZB = (const bf16_t*)(p.ws + O_ZB);
  bf16_t* Y = (bf16_t*)(p.ws + O_Y);
  const int lane = threadIdx.x & 63, wave = threadIdx.x >> 6;
  const int nI_S = 17 * 16, nI_P = 8 * 5 * 16;
  for (int it = blockIdx.x; it < nI_S + nI_P; it += gridDim.x) {
    int seq, nb, cb;
    if (it < nI_S) { seq = 8; cb = it & 15; nb = it >> 4; }
    else { int j = it - nI_S; cb = j & 15; j >>= 4; nb = j % 5; seq = j / 5; }
    const int M = seq < 8 ? 257 : 1025, KP = seq < 8 ? 576 : 2112, L = 16 * M;
    const int n2 = nb * 64 + lane;
    const int ch = cb * 16 + wave * 2;
    const int g = ch >> 6, d = ch & 63;
    bf16_t* yb = Y + y_base(seq);
    if (n2 < M) {
      float zr[16][2], zi[16][2];
#pragma unroll
      for (int n1 = 0; n1 < 16; ++n1) {
        const bf16_t* zp = ZB + (size_t)(seq_base(seq) + M * n1 + n2) * 512 + g * 128 + d;
        unsigned re = *(const unsigned*)zp, im = *(const unsigned*)(zp + 64);
        zr[n1][0] = lo2f(re); zr[n1][1] = hi2f(re); zi[n1][0] = lo2f(im); zi[n1][1] = hi2f(im);
      }
      for (int k1 = 0; k1 < 16; ++k1) {
        float ws_, wc_;
        sincospif(-(float)k1 / 8.f, &ws_, &wc_);
        float ar0 = zr[15][0], ai0 = zi[15][0], ar1 = zr[15][1], ai1 = zi[15][1];
#pragma unroll
        for (int n1 = 14; n1 >= 0; --n1) {
          float t0 = ar0 * wc_ - ai0 * ws_ + zr[n1][0]; ai0 = ar0 * ws_ + ai0 * wc_ + zi[n1][0]; ar0 = t0;
          float t1 = ar1 * wc_ - ai1 * ws_ + zr[n1][1]; ai1 = ar1 * ws_ + ai1 * wc_ + zi[n1][1]; ar1 = t1;
        }
        float ts, tc;
        sincospif(-2.f * (float)(k1 * n2) / (float)L, &ts, &tc);
        float yr0 = ar0 * tc - ai0 * ts, yi0 = ar0 * ts + ai0 * tc;
        float yr1 = ar1 * tc - ai1 * ts, yi1 = ar1 * ts + ai1 * tc;
        bf16_t* y0 = yb + ((size_t)k1 * 256 + ch) * KP;
        y0[n2] = f2bf(yr0); y0[M + n2] = f2bf(yi0);
        y0[KP + n2] = f2bf(yr1); y0[KP + M + n2] = f2bf(yi1);
      }
    } else if (n2 < KP - M) {
      for (int k1 = 0; k1 < 16; ++k1) {
        bf16_t* y0 = yb + ((size_t)k1 * 256 + ch) * KP;
        y0[M + n2] = 0; y0[KP + M + n2] = 0;
      }
    }
  }
}

DI void phase_fnet_gemm(const P& p, char* lds) {
  GEMM_IDS
  bf16_t* MIX = (bf16_t*)(p.ws + O_MIX);
  const bf16_t* Y = (const bf16_t*)(p.ws + O_Y);
  const int nS = 16 * 9 * 2, nP = 8 * 16 * 3 * 2;
  const int sb = threadIdx.x >> 8;
  for (int it0 = blockIdx.x * 2; it0 < nS + nP; it0 += gridDim.x * 2) {
    const int it = it0 + sb;
    int seq, k1, tm, tn;
    if (it < nS) { seq = 8; tn = it & 1; int j = it >> 1; tm = j % 9; k1 = j / 9; }
    else { int j = it - nS; tn = j & 1; j >>= 1; tm = j % 3; j /= 3; k1 = j & 15; seq = j >> 4; }
    const int M = seq < 8 ? 257 : 1025, KP = seq < 8 ? 576 : 2112, L = 16 * M;
    const bf16_t* dm = (const bf16_t*)(p.ws + (seq < 8 ? O_DM257 : O_DM1025));
    f32x16 acc[2][2];
    gemm_tile(dm + (size_t)tm * 128 * KP, KP, Y + y_base(seq) + ((size_t)k1 * 256 + tn * 128) * KP, KP, KP, lds + sb * 36864, acc);
    const float scale = rsqrtf(64.f * (float)L);
#pragma unroll
    for (int mt = 0; mt < 2; ++mt)
#pragma unroll
      for (int nt = 0; nt < 2; ++nt)
#pragma unroll
        for (int i = 0; i < 16; ++i) {
          int k2 = tm * 128 + ACC_ROW(mt, i), ch = tn * 128 + ACC_COL(nt);
          if (k2 < M) {
            int pos = k1 + 16 * k2;
            MIX[(size_t)(seq_base(seq) + pos) * 1024 + 768 + ch] = f2bf(acc[mt][nt][i] * scale + p.b_b[ch]);
          }
        }
  }
}

DI size_t vtc_base(int seq) { return seq < 8 ? (size_t)seq * 128 * 4160 : (size_t)8 * 128 * 4160; }
DI void phase_prepC(const P& p, char* lds) {
  const int gtid = blockIdx.x * NTH + threadIdx.x, gsz = gridDim.x * NTH;
  const int lane = threadIdx.x & 63, gw = gtid >> 6, nw = gsz >> 6;
  bf16_t* PC = (bf16_t*)(p.ws + O_PC);
  bf16_t* VT = (bf16_t*)(p.ws + O_VTC);
  const bf16_t* PLOW = (const bf16_t*)(p.ws + O_PLOW);
  bf16_t* LR = (bf16_t*)(p.ws + O_LR);
  vt_transpose<128>(PC, 768, 640, VT, lds);
  for (int sr = gw; sr < T_; sr += nw) {
    int pos; int b = seq_of(sr, pos);
    const int L = seq_len(b), LP = L + 48;
    bf16_t* pr = PC + (size_t)sr * 768;
    float cs[8], sn[8];
#pragma unroll
    for (int j = 0; j < 8; ++j) sincosf((float)pos * exp2f(-(float)j * (18.931568569324174f / 8.f)), &sn[j], &cs[j]);
#pragma unroll
    for (int part = 0; part < 2; ++part) {
      const bool act = part == 0 || lane < 16;
      const int col = part * 512 + (act ? lane : 0) * 8;
      uint4 u = *(const uint4*)(pr + col);
      float e[8] = {lo2f(u.x), hi2f(u.x), lo2f(u.y), hi2f(u.y), lo2f(u.z), hi2f(u.z), lo2f(u.w), hi2f(u.w)};
      float o[8];
#pragma unroll
      for (int j = 0; j < 8; ++j) {
        float pa = __shfl_xor(e[j], 1);
        float rot = e[j] * cs[j] + pa * ((lane & 1) ? sn[j] : -sn[j]);
        o[j] = (lane & 7) < 2 ? rot : e[j];
        if (part == 0) o[j] *= 0.125f * LOG2E;
      }
      if (act) *(uint4*)(pr + col) = make_uint4(pack2(o[0], o[1]), pack2(o[2], o[3]), pack2(o[4], o[5]), pack2(o[6], o[7]));
    }
#pragma unroll
    for (int q = 0; q < 6; ++q) {
      int c = q * 64 + lane;
      float u = bf2f(PLOW[(size_t)sr * 384 + c]);
      float up = pos > 0 ? bf2f(PLOW[(size_t)(sr - 1) * 384 + c]) : 0.f;
      float un = pos < L - 1 ? bf2f(PLOW[(size_t)(sr + 1) * 384 + c]) : 0.f;
      float us = u + p.mu_prev[1536 + c] * (up - u) + p.mu_next[1536 + c] * (un - u);
      float v = c < 128 ? tanhf(us) : (c < 256 ? us : sigmoidf_(us));
      LR[(size_t)sr * 384 + c] = f2bf(v);
    }
  }
}

DI void phase_attnC(const P& p, char* lds) {
  const bf16_t* PC = (const bf16_t*)(p.ws + O_PC);
  const bf16_t* VT = (const bf16_t*)(p.ws + O_VTC);
  bf16_t* MIX = (bf16_t*)(p.ws + O_MIX);
  const int nS = 129 * 4, nP = 8 * 33 * 4;
  const int sb = threadIdx.x >> 8;
  for (int it = blockIdx.x; it < nS + nP; it += gridDim.x) {
    int seq, qt, hq;
    if (it < nS) { seq = 8; hq = (it & 3) * 2 + sb; qt = it >> 2; }
    else { int j = it - nS; hq = (j & 3) * 2 + sb; j >>= 2; qt = j % 33; seq = j / 33; }
    const int kv = hq >> 2;
    const int L = seq_len(seq), LP = L + 48;
    flash_item<1>(PC + hq * 64, 768, PC + 512 + kv * 64, 768, VT + vtc_base(seq) + (size_t)kv * 64 * LP, LP,
                  MIX + hq * 64, 1024, seq_base(seq), L - 16, qt, p.c_sink[hq] * LOG2E, lds + sb * 36864);
  }
}

DI void chunk_decode(int cg_, int& seq, int& c) {
  if (cg_ < 136) { seq = cg_ / 17; c = cg_ - seq * 17; } else { seq = 8; c = cg_ - 136; }
}
DI float shiftv(const bf16_t* PRKV, int sr, int pos, int L, int col, float mp, float mn) {
  float u = bf2f(PRKV[(size_t)sr * 1536 + col]);
  float up = pos > 0 ? bf2f(PRKV[(size_t)(sr - 1) * 1536 + col]) : 0.f;
  float un = pos < L - 1 ? bf2f(PRKV[(size_t)(sr + 1) * 1536 + col]) : 0.f;
  return u + mp * (up - u) + mn * (un - u);
}
enum { VW = 0, VA = 1, VB = 2, VK = 3, VV = 4, VR = 5 };
#define DPP_FMAC(acc, x, y, N) asm("v_fmac_f32_dpp %0, %1, %2 row_newbcast:%3 row_mask:0xf bank_mask:0xf" : "+v"(acc) : "v"(x), "v"(y), "n"(N))
#define DPP_MUL(sv_, x, N) asm("v_mul_f32_dpp %0, %1, %0 row_newbcast:%2 row_mask:0xf bank_mask:0xf" : "+v"(sv_) : "v"(x), "n"(N))
template <int N> DI void dpp_dot4(float& a0, float& a1, float& a2, float& a3, const float (&S)[64], const float4& x) {
  DPP_FMAC(a0, x.x, S[N], N); DPP_FMAC(a1, x.y, S[16 + N], N); DPP_FMAC(a2, x.z, S[32 + N], N); DPP_FMAC(a3, x.w, S[48 + N], N);
  if constexpr (N < 15) dpp_dot4<N + 1>(a0, a1, a2, a3, S, x);
}
template <int N, bool HASV, bool OUT> DI void dpp_upd4(float (&S)[64], const float4& xb, const float4& xk, const float4& xr, float sa, float vi,
                                                       float& o0, float& o1, float& o2, float& o3) {
  DPP_FMAC(S[N], xb.x, sa, N); DPP_FMAC(S[16 + N], xb.y, sa, N); DPP_FMAC(S[32 + N], xb.z, sa, N); DPP_FMAC(S[48 + N], xb.w, sa, N);
  if (HASV) { DPP_FMAC(S[N], xk.x, vi, N); DPP_FMAC(S[16 + N], xk.y, vi, N); DPP_FMAC(S[32 + N], xk.z, vi, N); DPP_FMAC(S[48 + N], xk.w, vi, N); }
  if (OUT) { DPP_FMAC(o0, xr.x, S[N], N); DPP_FMAC(o1, xr.y, S[16 + N], N); DPP_FMAC(o2, xr.z, S[32 + N], N); DPP_FMAC(o3, xr.w, S[48 + N], N); }
  if constexpr (N < 15) dpp_upd4<N + 1, HASV, OUT>(S, xb, xk, xr, sa, vi, o0, o1, o2, o3);
}
template <int N> DI void dpp_scale4(float (&S)[64], const float4& xg) {
  DPP_MUL(S[N], xg.x, N); DPP_MUL(S[16 + N], xg.y, N); DPP_MUL(S[32 + N], xg.z, N); DPP_MUL(S[48 + N], xg.w, N);
  if constexpr (N < 15) dpp_scale4<N + 1>(S, xg);
}
template <int NST, bool HASV, bool OUT, class F>
DI void scan_steps(float (&S)[64], const float* sv, int ns, int lane, F&& emit) {
  const int l15 = lane & 15;
  for (int s = 0; s < ns; ++s) {
    const float4 xa = *(const float4*)(sv + VA * NST * 64 + s * 64 + l15 * 4);
    const float4 xb = *(const float4*)(sv + VB * NST * 64 + s * 64 + l15 * 4);
    float4 xk = xb, xr = xb;
    if (HASV) xk = *(const float4*)(sv + VK * NST * 64 + s * 64 + l15 * 4);
    if (OUT) xr = *(const float4*)(sv + VR * NST * 64 + s * 64 + l15 * 4);
    const float vi = HASV ? sv[VV * NST * 64 + s * 64 + lane] : 0.f;
    float sa0 = 0.f, sa1 = 0.f, sa2 = 0.f, sa3 = 0.f;
    dpp_dot4<0>(sa0, sa1, sa2, sa3, S, xa);
    const float sa = (sa0 + sa1) + (sa2 + sa3);
    float o0 = 0.f, o1 = 0.f, o2 = 0.f, o3 = 0.f;
    dpp_upd4<0, HASV, OUT>(S, xb, xk, xr, sa, vi, o0, o1, o2, o3);
    if (OUT) emit(s, (o0 + o1) + (o2 + o3));
    if ((s & 7) == 7) {
      const float4 xg = *(const float4*)(sv + VW * NST * 64 + (s >> 3) * 64 + l15 * 4);
      dpp_scale4<0>(S, xg);
    }
  }
}
DI int vperm(int j) { return (j & 15) * 4 + (j >> 4); }

DI void shift8(const bf16_t* PRKV, const P& p, int sbase, int pos, int L, int off, int c0, float (&out)[8]) {
  const bf16_t* rp = PRKV + (size_t)(sbase + pos) * 1536 + off + c0;
  const u32x4 uc = *(const u32x4*)rp;
  u32x4 up = (u32x4)(0u), un = (u32x4)(0u);
  if (pos > 0) up = *(const u32x4*)(rp - 1536);
  if (pos < L - 1) un = *(const u32x4*)(rp + 1536);
  const f32x4v mp0 = *(const f32x4v*)(p.mu_prev + off + c0), mp1 = *(const f32x4v*)(p.mu_prev + off + c0 + 4);
  const f32x4v mn0 = *(const f32x4v*)(p.mu_next + off + c0), mn1 = *(const f32x4v*)(p.mu_next + off + c0 + 4);
#pragma unroll
  for (int e2 = 0; e2 < 4; ++e2) {
    const float c_lo = lo2f(uc[e2]), c_hi = hi2f(uc[e2]);
    const float mpl = e2 < 2 ? mp0[2 * e2] : mp1[2 * e2 - 4], mph = e2 < 2 ? mp0[2 * e2 + 1] : mp1[2 * e2 - 3];
    const float mnl = e2 < 2 ? mn0[2 * e2] : mn1[2 * e2 - 4], mnh = e2 < 2 ? mn0[2 * e2 + 1] : mn1[2 * e2 - 3];
    out[2 * e2] = c_lo + mpl * (lo2f(up[e2]) - c_lo) + mnl * (lo2f(un[e2]) - c_lo);
    out[2 * e2 + 1] = c_hi + mph * (hi2f(up[e2]) - c_hi) + mnh * (hi2f(un[e2]) - c_hi);
  }
}

template <int NST, bool P3>
DI void scan_prologue8(const P& p, int sbase, int L, int hd, int dir, int pos0, int nsteps, int sb0, float* sv) {
  const int lane = threadIdx.x & 63, l31 = lane & 31, h = lane >> 5;
  const bf16_t* PRKV = (const bf16_t*)(p.ws + O_PRKV);
  const bf16_t* LR = (const bf16_t*)(p.ws + O_LR);
  const bf16_t* WUPT = (const bf16_t*)(p.ws + O_WUPT) + (size_t)(dir * 512 + hd * 64) * 64;
  const bf16_t* AUPT = (const bf16_t*)(p.ws + O_AUPT) + (size_t)(dir * 512 + hd * 64) * 64;
  float* bonus = (float*)(p.ws + O_BONUS);
  {
    int sl = sb0 + (l31 & 7); if (sl > nsteps - 1) sl = nsteps - 1;
    const int pos = dir ? pos0 - sl : pos0 + sl;
    const bf16_t* lrp = LR + (size_t)(sbase + pos) * 384 + dir * 64 + 8 * h;
#pragma unroll 1
    for (int mat = 0; mat < 2; ++mat) {
      const bf16_t* Wm = mat ? AUPT : WUPT;
      const float* bias = mat ? p.d_a0 : p.d_w0;
      f32x16 ac[2];
#pragma unroll
      for (int nt = 0; nt < 2; ++nt)
#pragma unroll
        for (int i = 0; i < 16; ++i) ac[nt][i] = 0.f;
#pragma unroll
      for (int ks = 0; ks < 4; ++ks) {
        const bf16x8 fa = *(const bf16x8*)(lrp + mat * 128 + 16 * ks);
#pragma unroll
        for (int nt = 0; nt < 2; ++nt) {
          const bf16x8 bw = *(const bf16x8*)(Wm + (size_t)(32 * nt + l31) * 64 + 16 * ks + 8 * h);
          ac[nt] = MFMA32(fa, bw, ac[nt]);
        }
      }
#pragma unroll
      for (int nt = 0; nt < 2; ++nt) {
        const int j = 32 * nt + l31;
        const float b0 = bias[dir * 512 + hd * 64 + j];
#pragma unroll
        for (int i = 0; i < 4; ++i) {
          const int st = sb0 + i + 4 * h;
          const float sg = 1.f / (1.f + __expf(-(b0 + ac[nt][i])));
          if (mat) sv[VK * NST * 64 + st * 64 + j] = sg;
          else ac[nt][i] = __expf(-0.6065306597126334f * sg);
        }
        if (!mat) {
          float g0 = ac[nt][0], g1 = g0 * ac[nt][1], g2 = g1 * ac[nt][2], g3 = g2 * ac[nt][3];
          const float tot_lo = __shfl(g3, l31);
          if (h) { g0 *= tot_lo; g1 *= tot_lo; g2 *= tot_lo; g3 *= tot_lo; }
          float* gd = sv + VA * NST * 64 + (sb0 + 4 * h) * 64 + j;
          gd[0] = g0; gd[64] = g1; gd[128] = g2; gd[192] = g3;
          if (h) sv[VW * NST * 64 + (sb0 >> 3) * 64 + vperm(j)] = g3;
        }
      }
    }
  }
  const int stp = lane >> 3, seg = lane & 7, c0 = hd * 64 + 8 * seg;
  const int s = sb0 + stp;
  const int ss = s < nsteps ? s : nsteps - 1;
  const int pos = dir ? pos0 - ss : pos0 + ss;
  float k[8], a[8], gam[8], gpr[8];
  shift8(PRKV, p, sbase, pos, L, 512, c0, k);
  {
    const f32x4v a0 = *(const f32x4v*)(sv + VK * NST * 64 + s * 64 + 8 * seg), a1 = *(const f32x4v*)(sv + VK * NST * 64 + s * 64 + 8 * seg + 4);
    const f32x4v g0 = *(const f32x4v*)(sv + VA * NST * 64 + s * 64 + 8 * seg), g1 = *(const f32x4v*)(sv + VA * NST * 64 + s * 64 + 8 * seg + 4);
    const int sp = stp > 0 ? s - 1 : s;
    const f32x4v q0 = *(const f32x4v*)(sv + VA * NST * 64 + sp * 64 + 8 * seg), q1 = *(const f32x4v*)(sv + VA * NST * 64 + sp * 64 + 8 * seg + 4);
#pragma unroll
    for (int e = 0; e < 4; ++e) {
      a[e] = a0[e]; a[4 + e] = a1[e]; gam[e] = g0[e]; gam[4 + e] = g1[e];
      gpr[e] = stp > 0 ? q0[e] : 1.f; gpr[4 + e] = stp > 0 ? q1[e] : 1.f;
    }
  }
  const f32x4v kk0 = *(const f32x4v*)(p.d_k_k + c0), kk1 = *(const f32x4v*)(p.d_k_k + c0 + 4);
  const f32x4v ka0 = *(const f32x4v*)(p.d_k_a + c0), ka1 = *(const f32x4v*)(p.d_k_a + c0 + 4);
  float kk[8], kd[8];
  float n2 = 0.f;
#pragma unroll
  for (int e = 0; e < 8; ++e) {
    kk[e] = k[e] * (e < 4 ? kk0[e] : kk1[e - 4]);
    n2 += kk[e] * kk[e];
    kd[e] = k[e] * (1.f + (a[e] - 1.f) * (e < 4 ? ka0[e] : ka1[e - 4]));
  }
  n2 += __shfl_xor(n2, 1); n2 += __shfl_xor(n2, 2); n2 += __shfl_xor(n2, 4);
  const float rn = rsqrtf(fmaxf(n2, 1e-24f));
#pragma unroll
  for (int e = 0; e < 8; ++e) {
    const int ix = s * 64 + vperm(8 * seg + e);
    const float kn = kk[e] * rn;
    const float ig = __builtin_amdgcn_rcpf(gam[e]);
    sv[VA * NST * 64 + ix] = -kn * gpr[e];
    sv[VB * NST * 64 + ix] = kn * a[e] * ig;
    sv[VK * NST * 64 + ix] = kd[e] * ig;
  }
  {
    float v[8];
    shift8(PRKV, p, sbase, pos, L, 1024, c0, v);
    *(f32x4v*)(sv + VV * NST * 64 + s * 64 + 8 * seg) = (f32x4v){v[0], v[1], v[2], v[3]};
    *(f32x4v*)(sv + VV * NST * 64 + s * 64 + 8 * seg + 4) = (f32x4v){v[4], v[5], v[6], v[7]};
  }
  if (P3) {
    float r[8];
    shift8(PRKV, p, sbase, pos, L, 0, c0, r);
    const f32x4v rk0 = *(const f32x4v*)(p.d_r_k + c0), rk1 = *(const f32x4v*)(p.d_r_k + c0 + 4);
    float bn = 0.f;
#pragma unroll
    for (int e = 0; e < 8; ++e) {
      sv[VR * NST * 64 + s * 64 + vperm(8 * seg + e)] = r[e] * gam[e];
      bn += r[e] * kd[e] * (e < 4 ? rk0[e] : rk1[e - 4]);
    }
    bn += __shfl_xor(bn, 1); bn += __shfl_xor(bn, 2); bn += __shfl_xor(bn, 4);
    if (s < nsteps && seg == 0) bonus[((size_t)(sbase + pos) * 8 + hd) * 2 + dir] = bn;
  }
}

DI unsigned scan_touch(const P& p, int sbase, int L, int hd, int dir, int posf  ) {
  const int lane = threadIdx.x & 63;
  const bf16_t* PRKV = (const bf16_t*)(p.ws + O_PRKV);
  const bf16_t* LR = (const bf16_t*)(p.ws + O_LR);
  const int lo = dir ? posf - 8 : posf - 1;
  const unsigned* ptr;
  if (lane < 30) { int row = lo + lane / 3; row = row < 0 ? 0 : (row > L - 1 ? L - 1 : row); ptr = (const unsigned*)(PRKV + (size_t)(sbase + row) * 1536 + (lane % 3) * 512 + hd * 64); }
  else { const int i2 = (lane - 30) & 15; int row = dir ? posf - (i2 >> 1) : posf + (i2 >> 1); row = row < 0 ? 0 : (row > L - 1 ? L - 1 : row); ptr = (const unsigned*)(LR + (size_t)(sbase + row) * 384 + (i2 & 1) * 128 + dir * 64); }
  return *ptr;
}

template <bool HALF> DI void scan1_body(const P& p, char* lds) {
  float* PQ = (float*)(p.ws + O_PQ);
  const int lane = threadIdx.x & 63, wave = __builtin_amdgcn_readfirstlane(threadIdx.x >> 6), slot = wave >> 1;
  constexpr int half = HALF ? 1 : 0;
  float* sv = (float*)lds + slot * (6 * 16 * 64);
  for (int g = blockIdx.x; g < 804; g += gridDim.x) {
    int seq, c, hp;
    if (g < 768) { const int lc = g >> 2; hp = g & 3; if (lc < 128) { seq = lc >> 4; c = lc & 15; } else { seq = 8; c = lc - 128; } }
    else { const int j = g - 768; hp = j & 3; seq = j >> 2; c = seq < 8 ? 16 : 64; }
    const int cgi = seq < 8 ? seq * 17 + c : 136 + c;
    const int hd = hp * 2 + (slot >> 1), dir = slot & 1;
    const int it = (cgi * 8 + hd) * 2 + dir;
    const int L = seq_len(seq), sbase = seq_base(seq);
    const int start = c * 256, end = min(L, start + 256), n = end - start;
    float S[64];
#pragma unroll
    for (int j = 0; j < 64; ++j) S[j] = (half == 0 && j == lane) ? 1.f : 0.f;
    for (int s0 = 0; s0 < n; s0 += 16) {
      const int ns = min(16, n - s0);
      const int pos0 = dir ? end - 1 - s0 : start + s0;
      __syncthreads();
      scan_prologue8<16, false>(p, sbase, L, hd, dir, pos0, ns, half * 8, sv);
      __syncthreads();
      unsigned tch = 0u;
      if (s0 + 16 < n) tch = scan_touch(p, sbase, L, hd, dir, dir ? pos0 - 16 - half * 8 : pos0 + 16 + half * 8);
      scan_steps<16, HALF, false>(S, sv, ns, lane, [](int, float) {});
      asm volatile("" :: "v"(tch));
    }
    float* dst = PQ + (size_t)it * 8192 + (size_t)(half * 64 + lane) * 64;
#pragma unroll
    for (int q = 0; q < 16; ++q) *(float4*)(dst + q * 4) = make_float4(S[q * 4], S[q * 4 + 1], S[q * 4 + 2], S[q * 4 + 3]);
  }
}

DI void phase_scan1(const P& p, char* lds) {
  const int w_ = __builtin_amdgcn_readfirstlane(threadIdx.x >> 6);
  if ((w_ ^ (w_ >> 2)) & 1) scan1_body<true>(p, lds); else scan1_body<false>(p, lds);
}

DI void phase_scan2(const P& p, char* lds) {
  float* Ss = (float*)lds;
  float* Ps = Ss + 64 * 65;
  float* PQ = (float*)(p.ws + O_PQ);
  const int tid = threadIdx.x, lane = tid & 63, wave = __builtin_amdgcn_readfirstlane(tid >> 6), l31 = lane & 31, h = lane >> 5;
  const int r0 = 32 * (wave >> 1), c0 = 32 * (wave & 1);
  for (int it = blockIdx.x; it < 144; it += gridDim.x) {
    const int dir = it & 1, hd = (it >> 1) & 7, seq = it >> 4;
    const int nch = seq < 8 ? 17 : 65, cg0 = seq < 8 ? seq * 17 : 136;
    f32x16 S;
#pragma unroll
    for (int i = 0; i < 16; ++i) S[i] = 0.f;
    f32x4v pn0, pn1;
    {
      const int c = dir ? nch - 1 : 0;
      const float* Pg = PQ + (size_t)(((cg0 + c) * 8 + hd) * 2 + dir) * 8192;
      pn0 = *(const f32x4v*)(Pg + tid * 4); pn1 = *(const f32x4v*)(Pg + (512 + tid) * 4);
    }
    for (int cc = 0; cc < nch; ++cc) {
      const int c = dir ? nch - 1 - cc : cc;
      float* Qg = PQ + (size_t)(((cg0 + c) * 8 + hd) * 2 + dir) * 8192 + 4096;
      __syncthreads();
      { const int m = tid >> 4, cq = (tid & 15) * 4; *(f32x4v*)(Ps + m * 68 + cq) = pn0; *(f32x4v*)(Ps + (m + 32) * 68 + cq) = pn1; }
      f32x16 acc;
      if (wave < 4) {
#pragma unroll
        for (int i = 0; i < 16; ++i) {
          const int row = r0 + (i & 3) + 8 * (i >> 2) + 4 * h;
          Ss[row * 65 + c0 + l31] = S[i];
          float* qp = Qg + row * 64 + c0 + l31;
          acc[i] = *qp;
          *qp = S[i];
        }
      }
      if (cc + 1 < nch) {
        const int c2 = dir ? nch - 2 - cc : cc + 1;
        const float* Pg2 = PQ + (size_t)(((cg0 + c2) * 8 + hd) * 2 + dir) * 8192;
        pn0 = *(const f32x4v*)(Pg2 + tid * 4); pn1 = *(const f32x4v*)(Pg2 + (512 + tid) * 4);
      }
      __syncthreads();
      if (wave < 4) {
#pragma unroll 8
        for (int kk = 0; kk < 32; ++kk) {
          const float av = Ss[(r0 + l31) * 65 + 2 * kk + h];
          const float bv = Ps[(2 * kk + h) * 68 + c0 + l31];
          acc = __builtin_amdgcn_mfma_f32_32x32x2f32(av, bv, acc, 0, 0, 0);
        }
        S = acc;
      }
    }
  }
}

DI void phase_scan3(const P& p, char* lds) {
  const float* PQ = (const float*)(p.ws + O_PQ);
  bf16_t* MIX = (bf16_t*)(p.ws + O_MIX);
  bf16_t* OB = (bf16_t*)(p.ws + O_OB);
  const int lane = threadIdx.x & 63, wave = __builtin_amdgcn_readfirstlane(threadIdx.x >> 6);
  float* sv = (float*)lds + wave * (6 * 8 * 64);
  const bool bal = gridDim.x == 256;
  const int NW = gridDim.x * 8, gw = blockIdx.x * 8 + wave;
  for (int k = 0; ; ++k) {
    int oi;
    if (bal) {
      if (k == 0) oi = gw;
      else if (k == 1) { if (wave >= 4) continue; oi = 2048 + blockIdx.x * 4 + wave; }
      else if (k == 2) { if (wave != 7 || blockIdx.x >= 144) break; oi = 3072 + blockIdx.x; }
      else break;
    } else { oi = gw + k * NW; if (oi >= 3216) break; }
    int seq, c, hd, dir;
    if (oi < 3072) { const int lc = oi >> 4; hd = (oi >> 1) & 7; dir = oi & 1; if (lc < 128) { seq = lc >> 4; c = lc & 15; } else { seq = 8; c = lc - 128; } }
    else { const int j = oi - 3072; hd = (j >> 1) & 7; dir = j & 1; seq = j >> 4; c = seq < 8 ? 16 : 64; }
    const int it = ((seq < 8 ? seq * 17 + c : 136 + c) * 8 + hd) * 2 + dir;
    const int L = seq_len(seq), sbase = seq_base(seq);
    const int start = c * 256, end = min(L, start + 256), n = end - start;
    float S[64];
    {
      const float* src = PQ + (size_t)it * 8192 + 4096 + lane * 64;
#pragma unroll
      for (int q = 0; q < 16; ++q) { float4 t = *(const float4*)(src + q * 4); S[q * 4] = t.x; S[q * 4 + 1] = t.y; S[q * 4 + 2] = t.z; S[q * 4 + 3] = t.w; }
    }
    for (int s0 = 0; s0 < n; s0 += 8) {
      const int ns = min(8, n - s0);
      const int pos0 = dir ? end - 1 - s0 : start + s0;
      scan_prologue8<8, true>(p, sbase, L, hd, dir, pos0, ns, 0, sv);
      unsigned tch = 0u;
      if (s0 + 8 < n) tch = scan_touch(p, sbase, L, hd, dir, dir ? pos0 - 8 : pos0 + 8);
      scan_steps<8, true, true>(S, sv, ns, lane, [&](int st, float o) {
        const int pos = dir ? pos0 - st : pos0 + st;
        const size_t sr = (size_t)(sbase + pos);
        if (dir == 0) MIX[sr * 1024 + 512 + hd * 64 + lane] = f2bf(o);
        else OB[sr * 512 + hd * 64 + lane] = f2bf(o);
      });
      asm volatile("" :: "v"(tch));
    }
  }
}

DI void phase_rwkv_final(const P& p) {
  const int lane = threadIdx.x & 63, gw = (blockIdx.x * NTH + threadIdx.x) >> 6, nw = (gridDim.x * NTH) >> 6;
  bf16_t* MIX = (bf16_t*)(p.ws + O_MIX);
  const bf16_t* OB = (const bf16_t*)(p.ws + O_OB);
  const bf16_t* G = (const bf16_t*)(p.ws + O_G);
  const bf16_t* PRKV = (const bf16_t*)(p.ws + O_PRKV);
  const float* bonus = (const float*)(p.ws + O_BONUS);
  const int hd = lane >> 3, c0 = lane * 8;
  for (int sr = gw; sr < T_; sr += nw) {
    int pos; int b = seq_of(sr, pos);
    const int L = seq_len(b);
    uint4 uf = *(const uint4*)(MIX + (size_t)sr * 1024 + 512 + c0);
    uint4 ub = *(const uint4*)(OB + (size_t)sr * 512 + c0);
    uint4 ug = *(const uint4*)(G + (size_t)sr * 512 + c0);
    unsigned f_[4] = {uf.x, uf.y, uf.z, uf.w}, b_[4] = {ub.x, ub.y, ub.z, ub.w}, g_[4] = {ug.x, ug.y, ug.z, ug.w};
    float o[8], gg[8];
    float sm = 0.f;
#pragma unroll
    for (int j = 0; j < 4; ++j) {
      o[2 * j] = lo2f(f_[j]) + lo2f(b_[j]); o[2 * j + 1] = hi2f(f_[j]) + hi2f(b_[j]);
      gg[2 * j] = lo2f(g_[j]); gg[2 * j + 1] = hi2f(g_[j]);
      sm += o[2 * j] + o[2 * j + 1];
    }
    sm += __shfl_xor(sm, 1); sm += __shfl_xor(sm, 2); sm += __shfl_xor(sm, 4);
    const float mean = sm * (1.f / 64.f);
    float vs = 0.f;
#pragma unroll
    for (int j = 0; j < 8; ++j) { float dlt = o[j] - mean; vs += dlt * dlt; }
    vs += __shfl_xor(vs, 1); vs += __shfl_xor(vs, 2); vs += __shfl_xor(vs, 4);
    const float rstd = rsqrtf(vs * (1.f / 64.f) + 64e-5f);
    const float bsum = bonus[((size_t)sr * 8 + hd) * 2] + bonus[((size_t)sr * 8 + hd) * 2 + 1];
    float y[8];
#pragma unroll
    for (int j = 0; j < 8; ++j) {
      int c = c0 + j;
      float vsh = shiftv(PRKV, sr, pos, L, 1024 + c, p.mu_prev[1024 + c], p.mu_next[1024 + c]);
      y[j] = ((o[j] - mean) * rstd * p.d_ln_g[c] + p.d_ln_b[c] + bsum * vsh) * gg[j];
    }
    *(uint4*)(MIX + (size_t)sr * 1024 + 512 + c0) = make_uint4(pack2(y[0], y[1]), pack2(y[2], y[3]), pack2(y[4], y[5]), pack2(y[6], y[7]));
  }
}

#define XB_TMO      128
#define XB_XCNT(j)  (256  + 64 * (j))
#define XB_XSUB(j)  (1280 + 64 * (j))
#define XB_XGEN(j)  (2304 + 64 * (j))
#define XB_TOP      3328
#define XB_TOPGEN   3392
#define XCD_BAR_WORDS 3456
#define XB_SPIN_CAP (1u << 23)
#define LAS __attribute__((address_space(3)))

__device__ __forceinline__ unsigned xb_ld(unsigned* p)              { return __hip_atomic_load(p, __ATOMIC_RELAXED, __HIP_MEMORY_SCOPE_AGENT); }
__device__ __forceinline__ unsigned xb_add(unsigned* p, unsigned v) { return __hip_atomic_fetch_add(p, v, __ATOMIC_RELAXED, __HIP_MEMORY_SCOPE_AGENT); }
__device__ __forceinline__ unsigned xb_xcc_id() { return (unsigned)__builtin_amdgcn_s_getreg((3 << 11) | 20) & 0xFu; }
#define XB_SPIN(cond, bar) do { unsigned _sp = 0; while (cond) { __builtin_amdgcn_s_sleep(1); \
    if ((++_sp & 255u) == 0u) { if (xb_ld(&(bar)[XB_TMO])) break; if (_sp > XB_SPIN_CAP) { atomicAdd(&(bar)[XB_TMO], 1u); break; } } } } while (0)

struct XcdBarrier {
    unsigned* bar; unsigned x;
    volatile LAS unsigned* st;
};

__device__ __forceinline__ XcdBarrier xcd_barrier_post(unsigned* bar, volatile LAS unsigned* st) {
    XcdBarrier b; b.bar = bar; b.x = xb_xcc_id(); b.st = st;
    if (threadIdx.x == 0) (void)xb_add(&bar[XB_XCNT(b.x)], 1u);
    return b;
}
__device__ __forceinline__ void xcd_barrier_complete(unsigned* bar, unsigned x, unsigned& nloc, unsigned& nx) {
    const unsigned G = gridDim.x * gridDim.y * gridDim.z;
    unsigned sum, cnt, mine, sp = 0u;
    for (;;) {
        sum = 0u; cnt = 0u; mine = 0u;
#pragma unroll
        for (unsigned j = 0; j < 16; ++j) { const unsigned c = xb_ld(&bar[XB_XCNT(j)]); sum += c; cnt += (c > 0u) ? 1u : 0u; mine = (j == x) ? c : mine; }
        if (sum == G) break;
        __builtin_amdgcn_s_sleep(1);
        if ((++sp & 255u) == 0u) { if (xb_ld(&bar[XB_TMO])) break; if (sp > XB_SPIN_CAP) { atomicAdd(&bar[XB_TMO], 1u); break; } }
    }
    nloc = mine > 0u ? mine : 1u; nx = cnt > 0u ? cnt : 1u;
}

__device__ __forceinline__ void xcd_barrier(const XcdBarrier& b) {
    asm volatile("s_waitcnt vmcnt(0)" ::: "memory");
    __syncthreads();
    if (threadIdx.x == 0) {
        unsigned* bar = b.bar;
        __builtin_amdgcn_s_waitcnt(0);
        unsigned nloc = b.st[0], nx = b.st[1];
        if (nloc == 0u) { xcd_barrier_complete(bar, b.x, nloc, nx); b.st[0] = nloc; b.st[1] = nx; }
        const unsigned old = xb_add(&bar[XB_XSUB(b.x)], 1u);
        const unsigned gen = old / nloc;
        if (old + 1u == (gen + 1u) * nloc) {
            __builtin_amdgcn_fence(__ATOMIC_RELEASE, "agent");
            asm volatile("s_waitcnt vmcnt(0)" ::: "memory");
            const unsigned og = xb_add(&bar[XB_TOP], 1u);
            const unsigned tg = og / nx;
            if (og + 1u == (tg + 1u) * nx) xb_add(&bar[XB_TOPGEN], 1u);
            else XB_SPIN(xb_ld(&bar[XB_TOPGEN]) == tg, bar);
            __builtin_amdgcn_fence(__ATOMIC_ACQUIRE, "agent");
            xb_add(&bar[XB_XGEN(b.x)], 1u);
            asm volatile("s_waitcnt vmcnt(0)" ::: "memory");
        } else {
            XB_SPIN(xb_ld(&bar[XB_XGEN(b.x)]) == gen, bar);
            __builtin_amdgcn_fence(__ATOMIC_ACQUIRE, "agent");
            asm volatile("s_waitcnt vmcnt(0)" ::: "memory");
        }
    }
    __syncthreads();
}

constexpr int NPHASE = 23;
__global__ void __launch_bounds__(NTH, 2) mega(P p) {
  extern __shared__ __attribute__((aligned(16))) unsigned char shm[];
  char* lds = (char*)shm;
  char* ws = p.ws;
  if (threadIdx.x == 0) *(uint4*)(shm + 131072) = make_uint4(0u, 0u, 0u, 0u);
  __syncthreads();
  const XcdBarrier xb = xcd_barrier_post((unsigned*)(ws + O_BAR), (volatile LAS unsigned*)(shm + 131072));
#ifndef DUP_MASK
#define DUP_MASK 0u
#endif
#define RUN(k, call) if (p.ph0 <= k && k < p.ph1) { call; if (k + 1 < p.ph1) { if (k == 0) cg::this_grid().sync(); else xcd_barrier(xb); } }
  RUN(0, phase_prep(p))
  RUN(1, phase_gemm_big((const bf16_t*)(ws + O_HN), (const bf16_t*)(ws + O_WIN0), 1536, 1024, (bf16_t*)(ws + O_PROJ0), 1536, 0, ws, shm))
  RUN(2, phase_prepA(p, lds))
  RUN(3, phase_attnA(p, lds))
  RUN(4, phase_fnet_gemm(p, lds))
  RUN(5, phase_gemm_big((const bf16_t*)(ws + O_MIX), (const bf16_t*)(ws + O_WOUT0), 1024, 1024, (bf16_t*)(ws + O_HN), 1024, 0, ws, shm))
  RUN(6, phase_resnorm(p, p.post_mix_g, p.pre_ffn_g))
  RUN(7, phase_gemm_gateup((const bf16_t*)(ws + O_HN), (const bf16_t*)(ws + O_WGU0), (bf16_t*)(ws + O_ACT), shm))
  RUN(8, phase_gemm_big((const bf16_t*)(ws + O_ACT), (const bf16_t*)(ws + O_WD0), 1024, DFF, (bf16_t*)(ws + O_HN), 1024, 0, ws, shm))
  RUN(9, phase_resnorm(p, p.post_ffn_g, p.pre_mix_g + 1024))
  RUN(10, phase_gemm_big((const bf16_t*)(ws + O_HN), (const bf16_t*)(ws + O_WIN1), 2816, 1024, nullptr, 0, 1, ws, shm))
  RUN(11, phase_prepC(p, lds))
  RUN(12, phase_attnC(p, lds))
  RUN(13, phase_scan1(p, lds))
  RUN(14, phase_scan2(p, lds))
  RUN(15, phase_scan3(p, lds))
  RUN(16, phase_gemm_small((const bf16_t*)(ws + O_LR) + 256, 384, (const bf16_t*)(ws + O_GUP), 512, 128, (bf16_t*)(ws + O_G), 512, lds))
  RUN(17, phase_rwkv_final(p))
  RUN(18, phase_gemm_big((const bf16_t*)(ws + O_MIX), (const bf16_t*)(ws + O_WOUT1), 1024, 1024, (bf16_t*)(ws + O_HN), 1024, 0, ws, shm))
  RUN(19, phase_resnorm(p, p.post_mix_g + 1024, p.pre_ffn_g + 1024))
  RUN(20, phase_gemm_gateup((const bf16_t*)(ws + O_HN), (const bf16_t*)(ws + O_WGU1), (bf16_t*)(ws + O_ACT), shm))
  RUN(21, phase_gemm_big((const bf16_t*)(ws + O_ACT), (const bf16_t*)(ws + O_WD1), 1024, DFF, (bf16_t*)(ws + O_HN), 1024, 0, ws, shm))
  RUN(22, phase_resnorm(p, p.post_ffn_g + 1024, nullptr))
#undef RUN
}

extern "C" void kernel_launch(void* const* d_in, const int* in_sizes, int n_in, void* d_out, int out_size, void* d_ws, size_t ws_size,
                              hipStream_t stream) {
  static int grid_blocks = 0;
  if (!grid_blocks) {
    int dev = 0, cus = 0, per_cu = 0;
    (void)hipGetDevice(&dev);
    (void)hipDeviceGetAttribute(&cus, hipDeviceAttributeMultiprocessorCount, dev);
    if (hipFuncSetAttribute((const void*)mega, hipFuncAttributeMaxDynamicSharedMemorySize, LDS_BYTES) != hipSuccess) fprintf(stderr, "hipFuncSetAttribute failed\n");
    if (hipOccupancyMaxActiveBlocksPerMultiprocessor(&per_cu, (const void*)mega, NTH, LDS_BYTES) != hipSuccess || per_cu < 1) {
      fprintf(stderr, "occupancy query says %d\n", per_cu);
      (void)hipGetLastError();
    }
    grid_blocks = cus;
  }
  if (ws_size < O_BAR + CTL_BYTES) { fprintf(stderr, "workspace too small\n"); return; }
  if (hipMemsetAsync((char*)d_ws + O_BAR, 0, CTL_BYTES, stream) != hipSuccess) { fprintf(stderr, "memset failed\n"); return; }
  P p{};
  const float** f = (const float**)&p;
  for (int i = 0; i < 32; ++i) f[i] = (const float*)d_in[i];
  p.out = (float*)d_out;
  p.ws = (char*)d_ws;
#if FUSED
  p.ph0 = 0; p.ph1 = NPHASE;
  void* args[] = {&p};
  hipError_t e = hipLaunchCooperativeKernel((void*)mega, dim3(grid_blocks), dim3(NTH), args, LDS_BYTES, stream);
  if (e != hipSuccess) fprintf(stderr, "cooperative launch failed: %s (grid %d)\n", hipGetErrorString(e), grid_blocks);
#else
  for (int ph = 0; ph < NPHASE; ++ph) {
    p.ph0 = ph; p.ph1 = ph + 1;
    hipLaunchKernelGGL(mega, dim3(grid_blocks), dim3(NTH), LDS_BYTES, stream, p);
  }
#endif
}
```

```cpp
#include <hip/hip_runtime.h>
#include <hip/hip_cooperative_groups.h>
#include <cstdio>
namespace cg = cooperative_groups;

#ifndef FUSED
#define FUSED 1
#endif

typedef unsigned short bf16_t;
using bf16x8 = __attribute__((ext_vector_type(8))) short;
using s16x4 = __attribute__((ext_vector_type(4))) short;
using f32x16 = __attribute__((ext_vector_type(16))) float;
using u32x4 = __attribute__((ext_vector_type(4))) unsigned;
using f32x4v = __attribute__((ext_vector_type(4))) float;
#define DI __device__ __forceinline__
#define MFMA32(a, b, c) __builtin_amdgcn_mfma_f32_32x32x16_bf16((a), (b), (c), 0, 0, 0)
constexpr int NTH = 512;
constexpr int LDS_BYTES = 131072 + 16;

constexpr int DM_ = 1024;
constexpr int T_ = 49296;
constexpr int TP_ = 49408;
constexpr int NT_ = TP_ / 128;
constexpr int DFF = 2816;
constexpr float EPS = 1e-6f;
constexpr float LOG2E = 1.4426950408889634f;

constexpr size_t SZ_ROW1024 = (size_t)TP_ * 1024 * 2;
constexpr size_t O_WIN0 = 0;
constexpr size_t O_WOUT0 = O_WIN0 + (size_t)1536 * 1024 * 2;
constexpr size_t O_WGU0 = O_WOUT0 + (size_t)1024 * 1024 * 2;
constexpr size_t O_WD0 = O_WGU0 + (size_t)5632 * 1024 * 2;
constexpr size_t O_DM257 = O_WD0 + (size_t)1024 * 2816 * 2;
constexpr size_t O_DM1025 = O_DM257 + (size_t)384 * 576 * 2;
constexpr size_t O_WIN1 = O_DM1025 + (size_t)1152 * 2112 * 2;
constexpr size_t O_WOUT1 = O_WIN1 + (size_t)2816 * 1024 * 2;
constexpr size_t O_WGU1 = O_WOUT1 + (size_t)1024 * 1024 * 2;
constexpr size_t O_WD1 = O_WGU1 + (size_t)5632 * 1024 * 2;
constexpr size_t O_GUP = O_WD1 + (size_t)1024 * 2816 * 2;
constexpr size_t O_RA = O_GUP + (size_t)512 * 128 * 2;
constexpr size_t O_RB = O_RA + SZ_ROW1024;
constexpr size_t O_RC = O_RB + (size_t)TP_ * 2816 * 2;
constexpr size_t O_META = O_RC + SZ_ROW1024;
constexpr size_t O_WC = O_META + (size_t)144 * 1024 * 4;
constexpr size_t O_WUPT = O_WC + (size_t)4 * 64 * 128 * 4;
constexpr size_t O_AUPT = O_WUPT + (size_t)2 * 512 * 64 * 2;
constexpr size_t O_END = O_AUPT + (size_t)2 * 512 * 64 * 2;
constexpr size_t O_HN = O_RA;
constexpr size_t O_VTA = O_RA;
constexpr size_t O_LR = O_RA;
constexpr size_t O_BONUS = O_RA + (size_t)TP_ * 384 * 2;
constexpr size_t O_VTC = O_BONUS + (size_t)T_ * 16 * 4;
constexpr size_t O_OB = O_RA + (size_t)TP_ * 512 * 2;
constexpr size_t O_PROJ0 = O_RB;
constexpr size_t O_ZB = O_PROJ0 + (size_t)TP_ * 1536 * 2;
constexpr size_t O_Y = O_ZB + (size_t)TP_ * 512 * 2;
constexpr size_t O_ACT = O_RB;
constexpr size_t O_PRKV = O_RB;
constexpr size_t O_PC = O_PRKV + (size_t)TP_ * 1536 * 2;
constexpr size_t O_PLOW = O_PC + (size_t)TP_ * 768 * 2;
constexpr size_t O_PQ = O_PC;
constexpr size_t O_G = O_PC;
constexpr size_t O_MIX = O_RC;
static_assert(O_VTC + (size_t)49728 * 128 * 2 <= O_RB, "vtc");
static_assert(O_Y + (size_t)(8 * 16 * 256 * 576 + 16 * 256 * 2112) * 2 <= O_RC, "y");
static_assert(O_PQ + (size_t)3216 * 32768 <= O_RC, "pq");
constexpr size_t O_BAR = (O_END + 255) / 256 * 256;
constexpr size_t O_CNT = O_BAR + 3456 * 4;
constexpr size_t CTL_BYTES = 3456 * 4 + 4 * 256;
static_assert(O_BAR + CTL_BYTES <= (size_t)536870912, "ws");

struct P {
  const float *x_prompt, *x_sample, *meta, *pre_mix_g, *post_mix_g, *pre_ffn_g, *post_ffn_g;
  const float *even_w_in, *even_w_out, *a_q_gain, *a_k_gain, *b_norm_g, *b_w, *b_b;
  const float *odd_w_in, *odd_w_out, *c_sink, *mu_prev, *mu_next, *d_w0, *d_w_up, *d_a0, *d_a_up, *d_g_up;
  const float *d_k_k, *d_k_a, *d_r_k, *d_ln_g, *d_ln_b, *ffn_gate, *ffn_up, *ffn_down;
  float* out;
  char* ws;
  int ph0, ph1;
};

typedef float f32x2 __attribute__((ext_vector_type(2)));
typedef __bf16 bf16x2_t __attribute__((ext_vector_type(2)));
DI bf16_t f2bf(float x) { return __builtin_bit_cast(bf16_t, (__bf16)x); }
DI float bf2f(bf16_t b) { return __uint_as_float(((unsigned)b) << 16); }
DI unsigned pack2(float a, float b) { f32x2 v = {a, b}; return __builtin_bit_cast(unsigned, __builtin_convertvector(v, bf16x2_t)); }
DI float lo2f(unsigned u) { return __uint_as_float(u << 16); }
DI float hi2f(unsigned u) { return __uint_as_float(u & 0xffff0000u); }
DI float wave_sum(float v) {
  for (int o = 32; o > 0; o >>= 1) v += __shfl_xor(v, o);
  return v;
}
DI int seq_of(int sr, int& pos) {
  if (sr < 32896) { int b = sr / 4112; pos = sr - b * 4112; return b; }
  pos = sr - 32896; return 8;
}
DI int seq_len(int b) { return b < 8 ? 4112 : 16400; }
DI int seq_base(int b) { return b < 8 ? b * 4112 : 32896; }
DI float* hrow(const P& p, int sr) {
  int pos; int b = seq_of(sr, pos);
  if (pos < 16) return (float*)(p.ws + O_META) + (size_t)(b * 16 + pos) * 1024;
  return p.out + ((size_t)(b < 8 ? b * 4096 : 32768) + (pos - 16)) * 1024;
}
DI float sigmoidf_(float x) { return 1.f / (1.f + expf(-x)); }

DI void transpose_w(const float* W, int K, int ldw, int N, bf16_t* Wt, int mode, const float* W2, int gtid, int gsz) {
  int nk8 = K / 8;
  long total = (long)N * nk8;
  for (long it = gtid; it < total; it += gsz) {
    int n = (int)(it % N), k8 = (int)(it / N);
    const float* src = W;
    int c = n;
    if (mode == 1) {
      int blk = n >> 8, w = n & 255;
      c = blk * 128 + (w & 127);
      if (w >= 128) src = W2;
    }
    unsigned r[4];
#pragma unroll
    for (int j = 0; j < 4; ++j) {
      float a = src[(size_t)(k8 * 8 + 2 * j) * ldw + c];
      float b = src[(size_t)(k8 * 8 + 2 * j + 1) * ldw + c];
      r[j] = pack2(a, b);
    }
    *(uint4*)(Wt + (size_t)n * K + k8 * 8) = make_uint4(r[0], r[1], r[2], r[3]);
  }
}

DI void phase_prep(const P& p) {
  const int gtid = blockIdx.x * NTH + threadIdx.x, gsz = gridDim.x * NTH;
  char* ws = p.ws;
  transpose_w(p.even_w_in, 1024, 1536, 1536, (bf16_t*)(ws + O_WIN0), 0, nullptr, gtid, gsz);
  transpose_w(p.even_w_out, 1024, 1024, 1024, (bf16_t*)(ws + O_WOUT0), 0, nullptr, gtid, gsz);
  transpose_w(p.odd_w_in, 1024, 2688, 2688, (bf16_t*)(ws + O_WIN1), 0, nullptr, gtid, gsz);
  transpose_w(p.odd_w_out, 1024, 1024, 1024, (bf16_t*)(ws + O_WOUT1), 0, nullptr, gtid, gsz);
  transpose_w(p.ffn_gate, 1024, DFF, 5632, (bf16_t*)(ws + O_WGU0), 1, p.ffn_up, gtid, gsz);
  transpose_w(p.ffn_gate + (size_t)1024 * DFF, 1024, DFF, 5632, (bf16_t*)(ws + O_WGU1), 1, p.ffn_up + (size_t)1024 * DFF, gtid, gsz);
  transpose_w(p.ffn_down, DFF, 1024, 1024, (bf16_t*)(ws + O_WD0), 0, nullptr, gtid, gsz);
  transpose_w(p.ffn_down + (size_t)DFF * 1024, DFF, 1024, 1024, (bf16_t*)(ws + O_WD1), 0, nullptr, gtid, gsz);
  transpose_w(p.d_g_up, 128, 512, 512, (bf16_t*)(ws + O_GUP), 0, nullptr, gtid, gsz);
  for (int d = 0; d < 2; ++d) {
    transpose_w(p.d_w_up + (size_t)d * 64 * 512, 64, 512, 512, (bf16_t*)(ws + O_WUPT) + (size_t)d * 512 * 64, 0, nullptr, gtid, gsz);
    transpose_w(p.d_a_up + (size_t)d * 64 * 512, 64, 512, 512, (bf16_t*)(ws + O_AUPT) + (size_t)d * 512 * 64, 0, nullptr, gtid, gsz);
  }
  for (int it = gtid; it < 128 * 1024 / 8; it += gsz) *(uint4*)((bf16_t*)(ws + O_WIN1) + (size_t)2688 * 1024 + (size_t)it * 8) = make_uint4(0, 0, 0, 0);
  for (int which = 0; which < 2; ++which) {
    const int M = which ? 1025 : 257, MP = which ? 1152 : 384, KP = which ? 2112 : 576;
    bf16_t* dm = (bf16_t*)(ws + (which ? O_DM1025 : O_DM257));
    for (int it = gtid; it < MP * KP; it += gsz) {
      int r = it / KP, c = it - r * KP;
      float v = 0.f;
      if (r < M && c < 2 * M) {
        int n2 = c < M ? c : c - M;
        int m = (r * n2) % M;
        float s, co;
        sincospif(2.0f * (float)m / (float)M, &s, &co);
        v = c < M ? co : s;
      }
      dm[it] = f2bf(v);
    }
  }
  for (int it = gtid; it < 4 * 64 * 128; it += gsz) {
    int o = it & 127, c = (it >> 7) & 63, g = it >> 13;
    int d = o & 63;
    float acc = 0.f;
    for (int c2 = 0; c2 < 64; ++c2) {
      float s, co;
      sincospif((float)((c * c2) & 63) / 32.f, &s, &co);
      float w = p.b_w[(g * 64 + c2) * 64 + d];
      acc += (o < 64 ? co : -s) * w;
    }
    ((float*)(ws + O_WC))[it] = acc;
  }
  const int lane = threadIdx.x & 63, gw = gtid >> 6, nw = gsz >> 6;
  bf16_t* HN = (bf16_t*)(ws + O_HN);
  for (int sr = gw; sr < TP_; sr += nw) {
    if (sr >= T_) {
#pragma unroll
      for (int q = 0; q < 2; ++q) *(uint4*)(HN + (size_t)sr * 1024 + q * 512 + lane * 8) = make_uint4(0, 0, 0, 0);
      continue;
    }
    int pos; int b = seq_of(sr, pos);
    const float* src = pos < 16 ? p.meta + pos * 1024
                                : (b < 8 ? p.x_prompt + ((size_t)b * 4096 + pos - 16) * 1024 : p.x_sample + (size_t)(pos - 16) * 1024);
    float* hr = hrow(p, sr);
    float4 v[4];
    float ss = 0.f;
#pragma unroll
    for (int q = 0; q < 4; ++q) {
      v[q] = *(const float4*)(src + q * 256 + lane * 4);
      ss += v[q].x * v[q].x + v[q].y * v[q].y + v[q].z * v[q].z + v[q].w * v[q].w;
      *(float4*)(hr + q * 256 + lane * 4) = v[q];
    }
    ss = wave_sum(ss);
    float rs = rsqrtf(ss * (1.f / 1024.f) + EPS);
#pragma unroll
    for (int q = 0; q < 4; ++q) {
      float4 g = *(const float4*)(p.pre_mix_g + q * 256 + lane * 4);
      uint2 o = make_uint2(pack2(v[q].x * rs * g.x, v[q].y * rs * g.y), pack2(v[q].z * rs * g.z, v[q].w * rs * g.w));
      *(uint2*)(HN + (size_t)sr * 1024 + q * 256 + lane * 4) = o;
    }
  }
}

DI void gemm_tile(const bf16_t* __restrict__ A, int lda, const bf16_t* __restrict__ B, int ldb, int K, char* lds, f32x16 (&acc)[2][2]) {
  const int tid = threadIdx.x & 255, lane = tid & 63, wave = tid >> 6, wm = wave >> 1, wn = wave & 1;
  const int l31 = lane & 31, h = lane >> 5;
  bf16_t* As = (bf16_t*)lds;
  bf16_t* Bs = As + 128 * 72;
#pragma unroll
  for (int a = 0; a < 2; ++a)
#pragma unroll
    for (int b = 0; b < 2; ++b)
#pragma unroll
      for (int i = 0; i < 16; ++i) acc[a][b][i] = 0.f;
  const int lr = tid >> 3, lc = (tid & 7) * 8;
  const bf16_t* Ag = A + (size_t)lr * lda + lc;
  const bf16_t* Bg = B + (size_t)lr * ldb + lc;
  u32x4 ra[4], rb[4];
#pragma unroll
  for (int q = 0; q < 4; ++q) {
    ra[q] = *(const u32x4*)(Ag + (size_t)(32 * q) * lda);
    rb[q] = *(const u32x4*)(Bg + (size_t)(32 * q) * ldb);
  }
#pragma unroll
  for (int q = 0; q < 4; ++q) {
    *(u32x4*)(As + (lr + 32 * q) * 72 + lc) = ra[q];
    *(u32x4*)(Bs + (lr + 32 * q) * 72 + lc) = rb[q];
  }
  __syncthreads();
  const int nk = K >> 6;
  for (int kt = 0; kt < nk; ++kt) {
    if (kt + 1 < nk) {
#pragma unroll
      for (int q = 0; q < 4; ++q) {
        ra[q] = *(const u32x4*)(Ag + (size_t)(32 * q) * lda + (kt + 1) * 64);
        rb[q] = *(const u32x4*)(Bg + (size_t)(32 * q) * ldb + (kt + 1) * 64);
      }
    }
#pragma unroll
    for (int ks = 0; ks < 4; ++ks) {
      bf16x8 a[2], b[2];
#pragma unroll
      for (int t = 0; t < 2; ++t) {
        a[t] = *(const bf16x8*)(As + (wm * 64 + t * 32 + l31) * 72 + ks * 16 + 8 * h);
        b[t] = *(const bf16x8*)(Bs + (wn * 64 + t * 32 + l31) * 72 + ks * 16 + 8 * h);
      }
#pragma unroll
      for (int mt = 0; mt < 2; ++mt)
#pragma unroll
        for (int nt = 0; nt < 2; ++nt) acc[mt][nt] = MFMA32(a[mt], b[nt], acc[mt][nt]);
    }
    __syncthreads();
    if (kt + 1 < nk) {
#pragma unroll
      for (int q = 0; q < 4; ++q) {
        *(u32x4*)(As + (lr + 32 * q) * 72 + lc) = ra[q];
        *(u32x4*)(Bs + (lr + 32 * q) * 72 + lc) = rb[q];
      }
      __syncthreads();
    }
  }
}
#define ACC_ROW(mt, i) (wm * 64 + (mt) * 32 + ((i) & 3) + 8 * ((i) >> 2) + 4 * h)
#define ACC_COL(nt) (wn * 64 + (nt) * 32 + l31)
#define GEMM_IDS const int lane = threadIdx.x & 63, wave = (threadIdx.x & 255) >> 6, wm = wave >> 1, wn = wave & 1, l31 = lane & 31, h = lane >> 5; (void)wm; (void)wn; (void)l31; (void)h;

DI void phase_gemm_small(const bf16_t* A, int lda, const bf16_t* W, int N, int K, bf16_t* C, int ldc, char* lds) {
  GEMM_IDS
  const int sb = threadIdx.x >> 8;
  const int ntn = N / 128;
  const int total = NT_ * ntn;
  for (int t0 = blockIdx.x * 2; t0 < total; t0 += gridDim.x * 2) {
    const int t = t0 + sb;
    const int tm = t / ntn, tn = t - tm * ntn;
    f32x16 acc[2][2];
    gemm_tile(A + (size_t)tm * 128 * lda, lda, W + (size_t)tn * 128 * K, K, K, lds + sb * 36864, acc);
#pragma unroll
    for (int mt = 0; mt < 2; ++mt)
#pragma unroll
      for (int nt = 0; nt < 2; ++nt)
#pragma unroll
        for (int i = 0; i < 16; ++i) {
          int row = tm * 128 + ACC_ROW(mt, i), col = tn * 128 + ACC_COL(nt);
          C[(size_t)row * ldc + col] = f2bf(acc[mt][nt][i]);
        }
  }
}

namespace pg8 {
#define PG8_LAS __attribute__((address_space(3)))
typedef unsigned short bf16_t;
typedef short bf16x8 __attribute__((ext_vector_type(8)));
typedef float f32x4 __attribute__((ext_vector_type(4)));
typedef unsigned u32x4 __attribute__((ext_vector_type(4)));
constexpr int BM = 256, BK = 64, HALF = 128, HTB = HALF * BK * 2  , STAGE_BYTES = 8 * HTB, NXCD = 8, WGM = 8;

__host__ __device__ __forceinline__ int lds_byte(int r, int c) { const int st = (r >> 4) * 2 + (c >> 5), rr = r & 15, cc = c & 31, ob = rr * 64 + cc * 2; return st * 1024 + (ob ^ (((ob >> 9) & 1) << 5)); }
__host__ __device__ __forceinline__ void stage_rc(int b, int& R, int& C) { const int st = b / 1024, sb = b % 1024, swz = sb ^ (((sb >> 9) & 1) << 5); R = (st >> 1) * 16 + swz / 64; C = (st & 1) * 32 + (swz % 64) / 2; }
__host__ __device__ __forceinline__ int perm32(int rho) { const int n = rho >> 4, i = rho & 15; return 8 * (i >> 2) + 4 * n + (i & 3); }

struct Unit { int pm, pn; };
struct Gemm { const bf16_t* A; const bf16_t* Bt; int M, N, K; };

struct StaticOrder {
    int nM, nN, nwg, G, c;
    __host__ __device__ void init(int M, int N, int G_, int c_) { nM = M / BM; nN = N / BM; nwg = nM * nN; G = G_; c = c_; }
    __host__ __device__ bool next(int i, Unit& u) const {
        const long L = (long)i * G + c; if (L >= nwg) return false;
        int wgid = (int)L; { const int q = nwg / NXCD, r = nwg % NXCD, xcd = wgid % NXCD, off = wgid / NXCD; wgid = (xcd < r ? xcd * (q + 1) : r * (q + 1) + (xcd - r) * q) + off; }
        const int nig = WGM * nN, gid = wgid / nig, fm = gid * WGM, gsz = (nM - fm) < WGM ? (nM - fm) : WGM;
        u.pm = fm + ((wgid % nig) % gsz); u.pn = (wgid % nig) / gsz; return true;
    }
    __device__ __forceinline__ void a_ready(const Unit&) const {}
    __device__ __forceinline__ void done(const Unit&) const {}
};
__device__ __forceinline__ unsigned cvt_pk_bf16(float lo, float hi) { unsigned r; asm volatile("v_cvt_pk_bf16_f32 %0, %1, %2" : "=v"(r) : "v"(lo), "v"(hi)); return r; }

struct EpiRoute {
    static constexpr bool PERM = true, AFTER_DRAIN = false;
    bf16_t* O; int ldc; int route; bf16_t* pc; bf16_t* prkv; bf16_t* plow;
    __device__ __forceinline__ void operator()(const f32x4 (&acc)[2][2][4][2], const Unit& u, int wr, int wc, int fr, int fq) const {
        const int row0 = u.pm * BM + wr * 64 + fr;
#pragma unroll
        for (int bj = 0; bj < 2; ++bj) {
            int colh = u.pn * BM + bj * HALF; bf16_t* base = O; int ld = ldc;
            if (route) {
                if (colh < 768) { base = pc; ld = 768; }
                else if (colh < 2304) { base = prkv; ld = 1536; colh -= 768; }
                else if (colh < 2688) { base = plow; ld = 384; colh -= 2304; }
                else continue;
            }
            const int col0 = colh + wc * 32 + 8 * fq;
#pragma unroll
            for (int ai = 0; ai < 2; ++ai)
#pragma unroll
                for (int m = 0; m < 4; ++m) { bf16_t* rowp = base + (size_t)(row0 + ai * HALF + m * 16) * ld + col0;
                    const f32x4 v0 = acc[ai][bj][m][0], v1 = acc[ai][bj][m][1];
                    u32x4 w; w.x = cvt_pk_bf16(v0[0], v0[1]); w.y = cvt_pk_bf16(v0[2], v0[3]); w.z = cvt_pk_bf16(v1[0], v1[1]); w.w = cvt_pk_bf16(v1[2], v1[3]);
                    *(u32x4*)rowp = w; }
        }
    }
};
struct EpiGateUp {
    static constexpr bool PERM = true, AFTER_DRAIN = false;
    bf16_t* ACT;
    __device__ __forceinline__ void operator()(const f32x4 (&acc)[2][2][4][2], const Unit& u, int wr, int wc, int fr, int fq) const {
        const int row0 = u.pm * BM + wr * 64 + fr, col0 = u.pn * HALF + wc * 32 + 8 * fq;
#pragma unroll
        for (int ai = 0; ai < 2; ++ai)
#pragma unroll
            for (int m = 0; m < 4; ++m) { bf16_t* rowp = ACT + (size_t)(row0 + ai * HALF + m * 16) * 2816 + col0;
                float v[8];
#pragma unroll
                for (int n = 0; n < 2; ++n)
#pragma unroll
                    for (int j = 0; j < 4; ++j) { const float g = acc[ai][0][m][n][j], uu = acc[ai][1][m][n][j]; v[n * 4 + j] = g * __builtin_amdgcn_rcpf(1.f + __expf(-g)) * uu; }
                u32x4 w; w.x = cvt_pk_bf16(v[0], v[1]); w.y = cvt_pk_bf16(v[2], v[3]); w.z = cvt_pk_bf16(v[4], v[5]); w.w = cvt_pk_bf16(v[6], v[7]);
                *(u32x4*)rowp = w; }
    }
};
template <class Epi, class Sched, bool STAMP = false>
__device__ __forceinline__ void gemm_phase(PG8_LAS unsigned char* lds, const Gemm g, const Sched& S, const Epi& E, unsigned long long* stamps) {
    const int tid = threadIdx.x, wid = __builtin_amdgcn_readfirstlane(tid >> 6), lane = tid & 63, wr = wid >> 2, wc = wid & 3, fr = lane & 15, fq = lane >> 4;
    const int K = g.K, nt = K / BK;
    int ts_lo = 0, ts_hi = 0, nts = 0; const unsigned long long rt_entry = STAMP ? (unsigned long long)wall_clock64() : 0ull;
#define PG8_STAMP() do { if (STAMP && wid == 0 && nts < 64) { const unsigned long long _c = (unsigned long long)clock64(); \
        ts_lo = (lane == nts) ? (int)(unsigned)_c : ts_lo; ts_hi = (lane == nts) ? (int)(unsigned)(_c >> 32) : ts_hi; ++nts; } } while (0)
    PG8_STAMP();
    unsigned voffA[2], voffB[2];
#pragma unroll
    for (int i = 0; i < 2; ++i) { int R, C; stage_rc(tid * 16 + i * 8192, R, C); const int Rb = Epi::PERM ? ((R & ~31) + perm32(R & 31)) : R;
        voffA[i] = (unsigned)(R * K + C) * 2u; voffB[i] = (unsigned)(Rb * K + C) * 2u; }
    const size_t kstep = (size_t)(BK * 2);
    const size_t hstep = (size_t)HALF * K * 2;
    const size_t tstep = 2 * hstep;
    const unsigned ldsw = (unsigned)wid * 1024u;
    const int aoff = lds_byte(wr * 64 + fr, fq * 8), boff = lds_byte(wc * 32 + fr, fq * 8);
#define PG8_SA(b, h) (((b) * 2 + (h)) * HTB)
#define PG8_SB(b, h) ((4 + (b) * 2 + (h)) * HTB)
#define PG8_STAGE(bufoff, gbase, voff) do { _Pragma("unroll") for (int _i = 0; _i < 2; ++_i) \
        __builtin_amdgcn_global_load_lds((const unsigned*)((const char*)(gbase) + (voff)[_i]), (PG8_LAS unsigned*)(lds + (bufoff) + ldsw + _i * 8192), 16, 0, 0); } while (0)
#define PG8_LDA(dst, b, h) do { _Pragma("unroll") for (int m = 0; m < 4; ++m) _Pragma("unroll") for (int k = 0; k < 2; ++k) dst[m][k] = *(const PG8_LAS bf16x8*)(lds + PG8_SA(b, h) + aoff + m * 2048 + k * 1024); } while (0)
#define PG8_LDB(dst, b, h) do { _Pragma("unroll") for (int n = 0; n < 2; ++n) _Pragma("unroll") for (int k = 0; k < 2; ++k) dst[n][k] = *(const PG8_LAS bf16x8*)(lds + PG8_SB(b, h) + boff + n * 2048 + k * 1024); } while (0)
#define PG8_MMA(ai, bj, At, Bt) do { __builtin_amdgcn_s_setprio(1); _Pragma("unroll") for (int m = 0; m < 4; ++m) _Pragma("unroll") for (int n = 0; n < 2; ++n) _Pragma("unroll") for (int k = 0; k < 2; ++k) \
        acc[ai][bj][m][n] = __builtin_amdgcn_mfma_f32_16x16x32_bf16(Bt[n][k], At[m][k], acc[ai][bj][m][n], 0, 0, 0); __builtin_amdgcn_s_setprio(0); } while (0)
#define PG8_WAIT_V(n) asm volatile("s_waitcnt vmcnt(" #n ")" ::: "memory")
#define PG8_WAIT_L(n) asm volatile("s_waitcnt lgkmcnt(" #n ")" ::: "memory")
#define PG8_BAR __builtin_amdgcn_s_barrier()
#define PG8_SCHED __builtin_amdgcn_sched_barrier(0)
    Unit cur, nxt; int ui = 0;
    if (!S.next(0, cur)) return;
    f32x4 acc[2][2][4][2];
#pragma unroll
    for (int a = 0; a < 2; ++a)
#pragma unroll
        for (int b = 0; b < 2; ++b)
#pragma unroll
            for (int m = 0; m < 4; ++m)
#pragma unroll
                for (int n = 0; n < 2; ++n) acc[a][b][m][n] = (f32x4){0.f, 0.f, 0.f, 0.f};
    bf16x8 At[4][2], B0[2][2], B1[2][2];
    const char* cA = (const char*)g.A + (size_t)cur.pm * tstep; const char* cB = (const char*)g.Bt + (size_t)cur.pn * tstep;
    S.a_ready(cur);
    PG8_STAGE(PG8_SB(0, 0), cB, voffB); PG8_STAGE(PG8_SA(0, 0), cA, voffA); PG8_STAGE(PG8_SB(0, 1), cB + hstep, voffB); PG8_STAGE(PG8_SA(0, 1), cA + hstep, voffA);
    if (wr == 1) PG8_BAR;
    PG8_WAIT_V(4); PG8_BAR;
    PG8_STAGE(PG8_SB(1, 0), cB + kstep, voffB); PG8_STAGE(PG8_SA(1, 0), cA + kstep, voffA); PG8_STAGE(PG8_SB(1, 1), cB + hstep + kstep, voffB);
    PG8_WAIT_V(6); PG8_BAR;
    PG8_STAMP();
    for (;;) {
        const bool has_next = S.next(ui + 1, nxt);
        const char* nA = has_next ? (const char*)g.A + (size_t)nxt.pm * tstep : cA; const char* nB = has_next ? (const char*)g.Bt + (size_t)nxt.pn * tstep : cB;
        for (int t = 0; t < nt; t += 2) {
            const bool last = (t == nt - 2);
            const char* a1 = cA + (size_t)(t + 1) * kstep;
            const char* a2 = last ? nA : cA + (size_t)(t + 2) * kstep; const char* b2 = last ? nB : cB + (size_t)(t + 2) * kstep;
            const char* a3 = a2 + kstep; const char* b3 = b2 + kstep;
            if (last && has_next) S.a_ready(nxt);
            PG8_LDB(B0, 0, 0); PG8_SCHED; PG8_LDA(At, 0, 0); PG8_STAGE(PG8_SA(1, 1), a1 + hstep, voffA);
            PG8_WAIT_L(8); PG8_BAR; PG8_WAIT_L(0); PG8_MMA(0, 0, At, B0); PG8_BAR; PG8_SCHED;
            PG8_LDB(B1, 0, 1); PG8_STAGE(PG8_SB(0, 0), b2, voffB);
            PG8_BAR; PG8_WAIT_L(0); PG8_MMA(0, 1, At, B1); PG8_BAR;
            PG8_LDA(At, 0, 1); PG8_STAGE(PG8_SA(0, 0), a2, voffA);
            PG8_BAR; PG8_WAIT_L(0); PG8_MMA(1, 0, At, B0); PG8_BAR; PG8_SCHED;
            PG8_STAGE(PG8_SB(0, 1), b2 + hstep, voffB);
            PG8_WAIT_V(6); PG8_BAR; PG8_MMA(1, 1, At, B1); PG8_BAR;
            PG8_LDB(B0, 1, 0); PG8_SCHED; PG8_LDA(At, 1, 0); PG8_STAGE(PG8_SA(0, 1), a2 + hstep, voffA);
            PG8_WAIT_L(8); PG8_BAR; PG8_WAIT_L(0); PG8_MMA(0, 0, At, B0); PG8_BAR; PG8_SCHED;
            PG8_LDB(B1, 1, 1); PG8_STAGE(PG8_SB(1, 0), b3, voffB);
            PG8_BAR; PG8_WAIT_L(0); PG8_MMA(0, 1, At, B1); PG8_BAR;
            PG8_LDA(At, 1, 1); PG8_STAGE(PG8_SA(1, 0), a3, voffA);
            PG8_BAR; PG8_WAIT_L(0); PG8_MMA(1, 0, At, B0); PG8_BAR; PG8_SCHED;
            PG8_STAGE(PG8_SB(1, 1), b3 + hstep, voffB);
            PG8_WAIT_V(6); PG8_BAR; PG8_MMA(1, 1, At, B1); PG8_BAR;
        }
        PG8_STAMP();
        if constexpr (!Epi::AFTER_DRAIN) { E(acc, cur, wr, wc, fr, fq); S.done(cur); }
        PG8_STAMP();
        if (!has_next) break;
#pragma unroll
        for (int a = 0; a < 2; ++a)
#pragma unroll
            for (int b = 0; b < 2; ++b)
#pragma unroll
                for (int m = 0; m < 4; ++m)
#pragma unroll
                    for (int n = 0; n < 2; ++n) acc[a][b][m][n] = (f32x4){0.f, 0.f, 0.f, 0.f};
        cur = nxt; cA = nA; cB = nB; ++ui;
    }
    PG8_WAIT_V(0);
    if (wr == 0) PG8_BAR;
    PG8_BAR;
    if constexpr (Epi::AFTER_DRAIN) { E.fused(acc, cur, wr, wc, fr, fq, lds, wid, lane); S.done(cur); }
    PG8_STAMP();
    if (STAMP && wid == 0) { stamps[lane] = lane < nts ? (((unsigned long long)(unsigned)ts_hi << 32) | (unsigned)ts_lo) : 0ull;
        if (lane == 62) stamps[62] = rt_entry; if (lane == 63) stamps[63] = (unsigned long long)wall_clock64(); }
#undef PG8_STAMP
#undef PG8_SA
#undef PG8_SB
#undef PG8_STAGE
#undef PG8_LDA
#undef PG8_LDB
#undef PG8_MMA
#undef PG8_WAIT_V
#undef PG8_WAIT_L
#undef PG8_BAR
#undef PG8_SCHED
}
}

DI void phase_gemm_big(const bf16_t* A, const bf16_t* W, int N, int K, bf16_t* C, int ldc, int route, char* ws, unsigned char* lds) {
  pg8::Gemm g{A, W, TP_, N, K};
  pg8::StaticOrder S; S.init(TP_, N, gridDim.x, blockIdx.x);
  pg8::EpiRoute E{C, ldc, route, (bf16_t*)(ws + O_PC), (bf16_t*)(ws + O_PRKV), (bf16_t*)(ws + O_PLOW)};
  pg8::gemm_phase<pg8::EpiRoute, pg8::StaticOrder, false>((PG8_LAS unsigned char*)lds, g, S, E, nullptr);
}
DI void phase_gemm_gateup(const bf16_t* A, const bf16_t* W, bf16_t* ACT, unsigned char* lds) {
  pg8::Gemm g{A, W, TP_, 5632, 1024};
  pg8::StaticOrder S; S.init(TP_, 5632, gridDim.x, blockIdx.x);
  pg8::EpiGateUp E{ACT};
  pg8::gemm_phase<pg8::EpiGateUp, pg8::StaticOrder, false>((PG8_LAS unsigned char*)lds, g, S, E, nullptr);
}

DI void phase_resnorm(const P& p, const float* g1, const float* g2) {
  const int lane = threadIdx.x & 63, gw = (blockIdx.x * NTH + threadIdx.x) >> 6, nw = (gridDim.x * NTH) >> 6;
  bf16_t* HN = (bf16_t*)(p.ws + O_HN);
  for (int sr = gw; sr < T_; sr += nw) {
    float* hr = hrow(p, sr);
    float x[16];
    float ss = 0.f;
#pragma unroll
    for (int q = 0; q < 4; ++q) {
      const uint2 u = *(const uint2*)(HN + (size_t)sr * 1024 + q * 256 + lane * 4);
      x[q * 4] = lo2f(u.x); x[q * 4 + 1] = hi2f(u.x); x[q * 4 + 2] = lo2f(u.y); x[q * 4 + 3] = hi2f(u.y);
      ss += x[q * 4] * x[q * 4] + x[q * 4 + 1] * x[q * 4 + 1] + x[q * 4 + 2] * x[q * 4 + 2] + x[q * 4 + 3] * x[q * 4 + 3];
    }
    f32x4v hh[4];
#pragma unroll
    for (int q = 0; q < 4; ++q) hh[q] = *(const f32x4v*)(hr + q * 256 + lane * 4);
    ss = wave_sum(ss);
    const float rs = rsqrtf(ss * (1.f / 1024.f) + EPS);
    float ss2 = 0.f;
#pragma unroll
    for (int q = 0; q < 4; ++q) {
      const float4 g = *(const float4*)(g1 + q * 256 + lane * 4);
      hh[q].x += x[q * 4 + 0] * rs * g.x; hh[q].y += x[q * 4 + 1] * rs * g.y; hh[q].z += x[q * 4 + 2] * rs * g.z; hh[q].w += x[q * 4 + 3] * rs * g.w;
      *(f32x4v*)(hr + q * 256 + lane * 4) = hh[q];
      ss2 += hh[q].x * hh[q].x + hh[q].y * hh[q].y + hh[q].z * hh[q].z + hh[q].w * hh[q].w;
    }
    if (g2) {
      ss2 = wave_sum(ss2);
      const float rs2 = rsqrtf(ss2 * (1.f / 1024.f) + EPS);
#pragma unroll
      for (int q = 0; q < 4; ++q) {
        const float4 g = *(const float4*)(g2 + q * 256 + lane * 4);
        *(uint2*)(HN + (size_t)sr * 1024 + q * 256 + lane * 4) = make_uint2(pack2(hh[q].x * rs2 * g.x, hh[q].y * rs2 * g.y), pack2(hh[q].z * rs2 * g.z, hh[q].w * rs2 * g.w));
      }
    }
  }
}

DI size_t vta_base(int seq) { return seq < 8 ? (size_t)seq * 256 * 4160 : (size_t)8 * 256 * 4160; }
template <int NC> DI void vt_transpose(const bf16_t* src, int ld, int col0, bf16_t* VT, char* lds) {
  bf16_t* tl = (bf16_t*)lds;
  const int tid = threadIdx.x;
  constexpr int CPT = NC / 8, TPR = 512 / NC, PPT = 64 / TPR;
  for (int it = blockIdx.x; it < 257 + 8 * 65; it += gridDim.x) {
    int seq, kt;
    if (it < 257) { seq = 8; kt = it; } else { const int j = it - 257; seq = j / 65; kt = j - seq * 65; }
    const int L = seq_len(seq), LP = L + 48, sbase = seq_base(seq);
    const size_t vb = (seq < 8 ? (size_t)seq * NC * 4160 : (size_t)8 * NC * 4160);
    __syncthreads();
    const int pl = tid >> 3, part = tid & 7;
    const int pos = 64 * kt + pl - 48;
#pragma unroll
    for (int q = 0; q < CPT / 8; ++q) {
      u32x4 v = (u32x4)(0u);
      if (pos >= 0) v = *(const u32x4*)(src + (size_t)(sbase + pos) * ld + col0 + part * CPT + q * 8);
#pragma unroll
      for (int j = 0; j < 4; ++j) {
        tl[(part * CPT + q * 8 + 2 * j) * 72 + pl] = (bf16_t)(v[j] & 0xffffu);
        tl[(part * CPT + q * 8 + 2 * j + 1) * 72 + pl] = (bf16_t)(v[j] >> 16);
      }
    }
    __syncthreads();
    const int row = tid / TPR, seg = tid % TPR;
    bf16_t* dst = VT + vb + (size_t)row * LP + 64 * kt + seg * PPT;
#pragma unroll
    for (int q = 0; q < PPT / 8; ++q) *(u32x4*)(dst + q * 8) = *(const u32x4*)(tl + row * 72 + seg * PPT + q * 8);
  }
}

DI void phase_prepA(const P& p, char* lds) {
  const int lane = threadIdx.x & 63, wave = threadIdx.x >> 6;
  bf16_t* PROJ = (bf16_t*)(p.ws + O_PROJ0);
  bf16_t* ZB = (bf16_t*)(p.ws + O_ZB);
  const float* WC = (const float*)(p.ws + O_WC);
  vt_transpose<256>(PROJ, 1536, 1024, (bf16_t*)(p.ws + O_VTA), lds);
  __syncthreads();
  float* fl = (float*)lds + wave * 1024;
  const float inv = exp2f(-(float)(lane & 15) * (13.287712379549449f / 16.f));
  const float qg = p.a_q_gain[lane], kg = p.a_k_gain[lane];
  for (int r0 = blockIdx.x * 32; r0 < TP_; r0 += gridDim.x * 32) {
    const int srb = r0 + wave * 4;
#pragma unroll 1
    for (int rr = 0; rr < 4; ++rr) {
      const int sr = srb + rr;
      if (sr < T_) {
        int pos; seq_of(sr, pos);
        float rowf, colf;
        if (pos < 16) { rowf = colf = (float)(pos - 16); }
        else { int t = pos - 16; rowf = (float)(t >> 6); colf = (float)(t & 63); }
        float ang = (lane < 32 ? rowf : colf) * inv;
        float sn, cs;
        sincosf(ang, &sn, &cs);
        const float sgn = (lane & 16) ? sn : -sn;
        bf16_t* pr = PROJ + (size_t)sr * 1536;
        for (int hd = 0; hd < 16; ++hd) {
          float x = bf2f(pr[hd * 64 + lane]);
          float ss = wave_sum(x * x);
          float xn = x * rsqrtf(ss * (1.f / 64.f) + EPS) * (hd < 12 ? qg : kg);
          float pa = __shfl_xor(xn, 16);
          float o = xn * cs + pa * sgn;
          if (hd < 12) o *= 0.125f * LOG2E;
          pr[hd * 64 + lane] = f2bf(o);
        }
        uint2 u = *(const uint2*)(pr + 1280 + lane * 4);
        float f0 = lo2f(u.x), f1 = hi2f(u.x), f2 = lo2f(u.y), f3 = hi2f(u.y);
        float ss = f0 * f0 + f1 * f1 + f2 * f2 + f3 * f3;
        ss += __shfl_xor(ss, 1); ss += __shfl_xor(ss, 2); ss += __shfl_xor(ss, 4); ss += __shfl_xor(ss, 8);
        float rs = rsqrtf(ss * (1.f / 64.f) + EPS);
        float4 g = *(const float4*)(p.b_norm_g + lane * 4);
        *(float4*)(fl + rr * 256 + lane * 4) = make_float4(f0 * rs * g.x, f1 * rs * g.y, f2 * rs * g.z, f3 * rs * g.w);
      } else {
        *(float4*)(fl + rr * 256 + lane * 4) = make_float4(0.f, 0.f, 0.f, 0.f);
      }
    }
    __syncthreads();
    {
      const int g = lane >> 4, o0 = (lane & 15) * 8;
      float acc[4][8];
#pragma unroll
      for (int rr = 0; rr < 4; ++rr)
#pragma unroll
        for (int j = 0; j < 8; ++j) acc[rr][j] = 0.f;
      const float* wc = WC + (size_t)g * 64 * 128 + o0;
#pragma unroll 4
      for (int c = 0; c < 64; ++c) {
        const float4 w0 = *(const float4*)(wc + c * 128), w1 = *(const float4*)(wc + c * 128 + 4);
#pragma unroll
        for (int rr = 0; rr < 4; ++rr) {
          const float f = fl[rr * 256 + g * 64 + c];
          acc[rr][0] += f * w0.x; acc[rr][1] += f * w0.y; acc[rr][2] += f * w0.z; acc[rr][3] += f * w0.w;
          acc[rr][4] += f * w1.x; acc[rr][5] += f * w1.y; acc[rr][6] += f * w1.z; acc[rr][7] += f * w1.w;
        }
      }
#pragma unroll
      for (int rr = 0; rr < 4; ++rr)
        if (srb + rr < T_)
          *(uint4*)(ZB + (size_t)(srb + rr) * 512 + g * 128 + o0) = make_uint4(pack2(acc[rr][0], acc[rr][1]), pack2(acc[rr][2], acc[rr][3]), pack2(acc[rr][4], acc[rr][5]), pack2(acc[rr][6], acc[rr][7]));
    }
    __syncthreads();
  }
}

template <int MODE>
DI void flash_item(const bf16_t* __restrict__ Q, int ldq, const bf16_t* __restrict__ Kb, int ldk, const bf16_t* __restrict__ Vt, int LP,
                   bf16_t* O, int ldo, int sbase, int S, int qt, float sinkl2, char* lds) {
  const int tid = threadIdx.x & 255, lane = tid & 63, wave = tid >> 6, l31 = lane & 31, h = lane >> 5;
  bf16_t* Ks = (bf16_t*)lds;
  bf16_t* Vs = Ks + 2 * 64 * 72;
  const int rl = wave * 32 + l31;
  const int qpos = qt == 0 ? (rl < 16 ? rl : 15) : 16 + 128 * (qt - 1) + rl;
  const bool qvalid = qt > 0 || rl < 16;
  bf16x8 qf[4];
  {
    const bf16_t* qr = Q + (size_t)(sbase + qpos) * ldq;
#pragma unroll
    for (int s = 0; s < 4; ++s) qf[s] = *(const bf16x8*)(qr + 16 * s + 8 * h);
  }
  const int nkt_all = (S + 64) / 64;
  int klo = 1, n;
  if (MODE == 0) { n = nkt_all; }
  else {
    if (qt == 0) { klo = 1; n = 3; }
    else {
      int c = qt - 1;
      klo = 2 * c - 1; if (klo < 1) klo = 1;
      int khi = 2 * c + 4; if (khi > nkt_all - 1) khi = nkt_all - 1;
      n = 1 + (khi - klo + 1);
    }
  }
  const int ldr = tid >> 2, ldp = (tid & 3) * 16;
  u32x4 rk0, rk1, rv0, rv1;
  auto ktile = [&](int idx) { return idx == 0 ? 0 : klo + idx - 1; };
#define FL_GLOAD(idx)                                                                               \
  {                                                                                                 \
    int kt_ = ktile(idx);                                                                           \
    int pos_ = 64 * kt_ + ldr - 48;                                                                 \
    if (pos_ >= 0) {                                                                                \
      const bf16_t* kp_ = Kb + (size_t)(sbase + pos_) * ldk + ldp;                                  \
      rk0 = *(const u32x4*)kp_; rk1 = *(const u32x4*)(kp_ + 8);                                 \
    } else { rk0 = (u32x4)(0u); rk1 = rk0; }                                       \
    const bf16_t* vp_ = Vt + (size_t)ldr * LP + 64 * kt_ + ldp;                                     \
    rv0 = *(const u32x4*)vp_; rv1 = *(const u32x4*)(vp_ + 8);                                   \
  }
#define FL_SSTORE(buf)                                                                              \
  {                                                                                                 \
    *(u32x4*)(Ks + (buf) * 64 * 72 + ldr * 72 + ldp) = rk0; *(u32x4*)(Ks + (buf) * 64 * 72 + ldr * 72 + ldp + 8) = rk1; \
    { bf16_t* vd_ = Vs + (buf) * 64 * 68 + ldr * 68 + ldp; *(uint2*)vd_ = make_uint2(rv0.x, rv0.y); *(uint2*)(vd_ + 4) = make_uint2(rv0.z, rv0.w); *(uint2*)(vd_ + 8) = make_uint2(rv1.x, rv1.y); *(uint2*)(vd_ + 12) = make_uint2(rv1.z, rv1.w); } \
  }
  f32x16 oacc[2];
#pragma unroll
  for (int i = 0; i < 16; ++i) { oacc[0][i] = 0.f; oacc[1][i] = 0.f; }
  float m = MODE == 1 ? -1e30f : 0.f, l = 0.f;
  FL_GLOAD(0)
  FL_SSTORE(0)
  __syncthreads();
  for (int idx = 0; idx < n; ++idx) {
    const int cur = idx & 1;
    if (idx + 1 < n) FL_GLOAD(idx + 1)
    const int kt = ktile(idx);
    const bf16_t* ks = Ks + cur * 64 * 72;
    const bf16_t* vs = Vs + cur * 64 * 68;
    f32x16 sacc[2];
    {
      bf16x8 kf[2][4];
#pragma unroll
      for (int t = 0; t < 2; ++t)
#pragma unroll
        for (int s = 0; s < 4; ++s) kf[t][s] = *(const bf16x8*)(ks + (32 * t + l31) * 72 + 16 * s + 8 * h);
#pragma unroll
      for (int t = 0; t < 2; ++t)
#pragma unroll
        for (int i = 0; i < 16; ++i) sacc[t][i] = 0.f;
      __builtin_amdgcn_sched_barrier(0);
#pragma unroll
      for (int s = 0; s < 4; ++s)
#pragma unroll
        for (int t = 0; t < 2; ++t) sacc[t] = MFMA32(kf[t][s], qf[s], sacc[t]);
    }
    bf16x8 vfr[2][2][2];
#pragma unroll
    for (int t = 0; t < 2; ++t)
#pragma unroll
      for (int s2 = 0; s2 < 2; ++s2)
#pragma unroll
        for (int dt = 0; dt < 2; ++dt) {
          const bf16_t* vp = vs + (32 * dt + l31) * 68 + 32 * t + 16 * s2 + 4 * h;
          uint2 lo = *(const uint2*)vp, hi = *(const uint2*)(vp + 8);
          u32x4 v4 = {lo.x, lo.y, hi.x, hi.y};
          vfr[t][s2][dt] = __builtin_bit_cast(bf16x8, v4);
        }
    __builtin_amdgcn_sched_barrier(0);
    if (kt == 0) {
#pragma unroll
      for (int t = 0; t < 2; ++t)
#pragma unroll
        for (int i = 0; i < 16; ++i) {
          int kl = 32 * t + (i & 3) + 8 * (i >> 2) + 4 * h;
          if (kl < 48) sacc[t][i] = -1e30f;
        }
    } else if (MODE == 1) {
#pragma unroll
      for (int t = 0; t < 2; ++t)
#pragma unroll
        for (int i = 0; i < 16; ++i) {
          int kl = 32 * t + (i & 3) + 8 * (i >> 2) + 4 * h;
          int tk = 64 * (kt - 1) + kl;
          bool vis;
          if (qt == 0) vis = tk <= 112 + qpos;
          else { int tq = qpos - 16; int d = tq - tk; vis = d <= 128 && d >= -128; }
          if (!vis) sacc[t][i] = -1e30f;
        }
    }
    float tmax = -1e30f;
    if (MODE == 1) {
#pragma unroll
      for (int t = 0; t < 2; ++t)
#pragma unroll
        for (int i = 0; i < 16; ++i) tmax = fmaxf(tmax, sacc[t][i]);
      tmax = fmaxf(tmax, __shfl_xor(tmax, 32));
    }
    if (MODE == 1 && __builtin_amdgcn_ballot_w64(tmax > m) != 0ull) {
      const float mn = fmaxf(m, tmax);
      const float alpha = __builtin_amdgcn_exp2f(m - mn);
      m = mn;
      l *= alpha;
#pragma unroll
      for (int i = 0; i < 16; ++i) { oacc[0][i] *= alpha; oacc[1][i] *= alpha; }
    }
    const f32x2 m2 = {m, m};
    f32x2 ls2 = {0.f, 0.f};
    unsigned pk[2][8];
#pragma unroll
    for (int t = 0; t < 2; ++t)
#pragma unroll
      for (int i2 = 0; i2 < 8; ++i2) {
        f32x2 d = {sacc[t][2 * i2], sacc[t][2 * i2 + 1]};
        if (MODE == 1) d = d - m2;
        f32x2 e = {__builtin_amdgcn_exp2f(d.x), __builtin_amdgcn_exp2f(d.y)};
        ls2 += e;
        pk[t][i2] = __builtin_bit_cast(unsigned, __builtin_convertvector(e, bf16x2_t));
      }
    l += ls2.x + ls2.y;
#pragma unroll
    for (int t = 0; t < 2; ++t)
#pragma unroll
      for (int s2 = 0; s2 < 2; ++s2) {
        u32x4 pk4 = {pk[t][4 * s2], pk[t][4 * s2 + 1], pk[t][4 * s2 + 2], pk[t][4 * s2 + 3]};
        bf16x8 pf = __builtin_bit_cast(bf16x8, pk4);
#pragma unroll
        for (int dt = 0; dt < 2; ++dt) oacc[dt] = MFMA32(vfr[t][s2][dt], pf, oacc[dt]);
      }
    if (idx + 1 < n) FL_SSTORE(cur ^ 1)
    __syncthreads();
  }
  l += __shfl_xor(l, 32);
  if (MODE == 1) l += __builtin_amdgcn_exp2f(sinkl2 - m);
  const float il = 1.f / l;
  if (qvalid) {
    bf16_t* orow = O + (size_t)(sbase + qpos) * ldo;
#pragma unroll
    for (int dt = 0; dt < 2; ++dt)
#pragma unroll
      for (int g = 0; g < 4; ++g) {
        int d = 32 * dt + 8 * g + 4 * h;
        uint2 o = make_uint2(pack2(oacc[dt][4 * g] * il, oacc[dt][4 * g + 1] * il), pack2(oacc[dt][4 * g + 2] * il, oacc[dt][4 * g + 3] * il));
        *(uint2*)(orow + d) = o;
      }
  }
#undef FL_GLOAD
#undef FL_SSTORE
}

DI size_t y_base(int seq) { return seq < 8 ? (size_t)seq * 16 * 256 * 576 : (size_t)8 * 16 * 256 * 576; }
DI void phase_attnA(const P& p, char* lds) {
  const bf16_t* PROJ = (const bf16_t*)(p.ws + O_PROJ0);
  const bf16_t* VT = (const bf16_t*)(p.ws + O_VTA);
  bf16_t* MIX = (bf16_t*)(p.ws + O_MIX);
  const int nS = 129 * 6, nP = 8 * 33 * 6;
  const int sb = threadIdx.x >> 8;
  unsigned* head = (unsigned*)(p.ws + O_CNT);
  for (;;) {
    if (threadIdx.x == 0) *(volatile int*)(lds + 2 * 36864) = (int)__hip_atomic_fetch_add(head, 1u, __ATOMIC_RELAXED, __HIP_MEMORY_SCOPE_AGENT);
    __syncthreads();
    const int it = *(volatile int*)(lds + 2 * 36864);
    __syncthreads();
    if (it >= nS + nP) break;
    int seq, qt, hq;
    if (it < nS) { seq = 8; hq = (it % 6) * 2 + sb; qt = it / 6; }
    else { int j = it - nS; hq = (j % 6) * 2 + sb; j /= 6; qt = j % 33; seq = j / 33; }
    const int kv = hq / 3;
    const int L = seq_len(seq), LP = L + 48;
    flash_item<0>(PROJ + hq * 64, 1536, PROJ + 768 + kv * 64, 1536, VT + vta_base(seq) + (size_t)kv * 64 * LP, LP,
                  MIX + hq * 64, 1024, seq_base(seq), L - 16, qt, 0.f, lds + sb * 36864);
  }
  const bf16_t* ZB = (const bf16_t*)(p.ws + O_ZB);
  bf16_t* Y = (bf16_t*)(p.ws + O_Y);
  const int lane = threadIdx.x & 63, wave = threadIdx.x >> 6;
  const int nI_S = 17 * 16, nI_P = 8 * 5 * 16;
  for (int it = blockIdx.x; it < nI_S + nI_P; it += gridDim.x) {
    int seq, nb, cb;
    if (it < nI_S) { seq = 8; cb = it & 15; nb = it >> 4; }
    else { int j = it - nI_S; cb = j & 15; j >>= 4; nb = j % 5; seq = j / 5; }
    const int M = seq < 8 ? 257 : 1025, KP = seq < 8 ? 576 : 2112, L = 16 * M;
    const int n2 = nb * 64 + lane;
    const int ch = cb * 16 + wave * 2;
    const int g = ch >> 6, d = ch & 63;
    bf16_t* yb = Y + y_base(seq);
    if (n2 < M) {
      float zr[16][2], zi[16][2];
#pragma unroll
      for (int n1 = 0; n1 < 16; ++n1) {
        const bf16_t* zp = ZB + (size_t)(seq_base(seq) + M * n1 + n2) * 512 + g * 128 + d;
        unsigned re = *(const unsigned*)zp, im = *(const unsigned*)(zp + 64);
        zr[n1][0] = lo2f(re); zr[n1][1] = hi2f(re); zi[n1][0] = lo2f(im); zi[n1][1] = hi2f(im);
      }
      for (int k1 = 0; k1 < 16; ++k1) {
        float ws_, wc_;
        sincospif(-(float)k1 / 8.f, &ws_, &wc_);
        float ar0 = zr[15][0], ai0 = zi[15][0], ar1 = zr[15][1], ai1 = zi[15][1];
#pragma unroll
        for (int n1 = 14; n1 >= 0; --n1) {
          float t0 = ar0 * wc_ - ai0 * ws_ + zr[n1][0]; ai0 = ar0 * ws_ + ai0 * wc_ + zi[n1][0]; ar0 = t0;
          float t1 = ar1 * wc_ - ai1 * ws_ + zr[n1][1]; ai1 = ar1 * ws_ + ai1 * wc_ + zi[n1][1]; ar1 = t1;
        }
        float ts, tc;
        sincospif(-2.f * (float)(k1 * n2) / (float)L, &ts, &tc);
        float yr0 = ar0 * tc - ai0 * ts, yi0 = ar0 * ts + ai0 * tc;
        float yr1 = ar1 * tc - ai1 * ts, yi1 = ar1 * ts + ai1 * tc;
        bf16_t* y0 = yb + ((size_t)k1 * 256 + ch) * KP;
        y0[n2] = f2bf(yr0); y0[M + n2] = f2bf(yi0);
        y0[KP + n2] = f2bf(yr1); y0[KP + M + n2] = f2bf(yi1);
      }
    } else if (n2 < KP - M) {
      for (int k1 = 0; k1 < 16; ++k1) {
        bf16_t* y0 = yb + ((size_t)k1 * 256 + ch) * KP;
        y0[M + n2] = 0; y0[KP + M + n2] = 0;
      }
    }
  }
}

DI void phase_fnet_gemm(const P& p, char* lds) {
  GEMM_IDS
  bf16_t* MIX = (bf16_t*)(p.ws + O_MIX);
  const bf16_t* Y = (const bf16_t*)(p.ws + O_Y);
  const int nS = 16 * 9 * 2, nP = 8 * 16 * 3 * 2;
  const int sb = threadIdx.x >> 8;
  for (int it0 = blockIdx.x * 2; it0 < nS + nP; it0 += gridDim.x * 2) {
    const int it = it0 + sb;
    int seq, k1, tm, tn;
    if (it < nS) { seq = 8; tn = it & 1; int j = it >> 1; tm = j % 9; k1 = j / 9; }
    else { int j = it - nS; tn = j & 1; j >>= 1; tm = j % 3; j /= 3; k1 = j & 15; seq = j >> 4; }
    const int M = seq < 8 ? 257 : 1025, KP = seq < 8 ? 576 : 2112, L = 16 * M;
    const bf16_t* dm = (const bf16_t*)(p.ws + (seq < 8 ? O_DM257 : O_DM1025));
    f32x16 acc[2][2];
    gemm_tile(dm + (size_t)tm * 128 * KP, KP, Y + y_base(seq) + ((size_t)k1 * 256 + tn * 128) * KP, KP, KP, lds + sb * 36864, acc);
    const float scale = rsqrtf(64.f * (float)L);
#pragma unroll
    for (int mt = 0; mt < 2; ++mt)
#pragma unroll
      for (int nt = 0; nt < 2; ++nt)
#pragma unroll
        for (int i = 0; i < 16; ++i) {
          int k2 = tm * 128 + ACC_ROW(mt, i), ch = tn * 128 + ACC_COL(nt);
          if (k2 < M) {
            int pos = k1 + 16 * k2;
            MIX[(size_t)(seq_base(seq) + pos) * 1024 + 768 + ch] = f2bf(acc[mt][nt][i] * scale + p.b_b[ch]);
          }
        }
  }
}

DI size_t vtc_base(int seq) { return seq < 8 ? (size_t)seq * 128 * 4160 : (size_t)8 * 128 * 4160; }
DI void phase_prepC(const P& p, char* lds) {
  const int gtid = blockIdx.x * NTH + threadIdx.x, gsz = gridDim.x * NTH;
  const int lane = threadIdx.x & 63, gw = gtid >> 6, nw = gsz >> 6;
  bf16_t* PC = (bf16_t*)(p.ws + O_PC);
  bf16_t* VT = (bf16_t*)(p.ws + O_VTC);
  const bf16_t* PLOW = (const bf16_t*)(p.ws + O_PLOW);
  bf16_t* LR = (bf16_t*)(p.ws + O_LR);
  vt_transpose<128>(PC, 768, 640, VT, lds);
  for (int sr = gw; sr < T_; sr += nw) {
    int pos; int b = seq_of(sr, pos);
    const int L = seq_len(b), LP = L + 48;
    bf16_t* pr = PC + (size_t)sr * 768;
    float cs[8], sn[8];
#pragma unroll
    for (int j = 0; j < 8; ++j) sincosf((float)pos * exp2f(-(float)j * (18.931568569324174f / 8.f)), &sn[j], &cs[j]);
#pragma unroll
    for (int part = 0; part < 2; ++part) {
      const bool act = part == 0 || lane < 16;
      const int col = part * 512 + (act ? lane : 0) * 8;
      uint4 u = *(const uint4*)(pr + col);
      float e[8] = {lo2f(u.x), hi2f(u.x), lo2f(u.y), hi2f(u.y), lo2f(u.z), hi2f(u.z), lo2f(u.w), hi2f(u.w)};
      float o[8];
#pragma unroll
      for (int j = 0; j < 8; ++j) {
        float pa = __shfl_xor(e[j], 1);
        float rot = e[j] * cs[j] + pa * ((lane & 1) ? sn[j] : -sn[j]);
        o[j] = (lane & 7) < 2 ? rot : e[j];
        if (part == 0) o[j] *= 0.125f * LOG2E;
      }
      if (act) *(uint4*)(pr + col) = make_uint4(pack2(o[0], o[1]), pack2(o[2], o[3]), pack2(o[4], o[5]), pack2(o[6], o[7]));
    }
#pragma unroll
    for (int q = 0; q < 6; ++q) {
      int c = q * 64 + lane;
      float u = bf2f(PLOW[(size_t)sr * 384 + c]);
      float up = pos > 0 ? bf2f(PLOW[(size_t)(sr - 1) * 384 + c]) : 0.f;
      float un = pos < L - 1 ? bf2f(PLOW[(size_t)(sr + 1) * 384 + c]) : 0.f;
      float us = u + p.mu_prev[1536 + c] * (up - u) + p.mu_next[1536 + c] * (un - u);
      float v = c < 128 ? tanhf(us) : (c < 256 ? us : sigmoidf_(us));
      LR[(size_t)sr * 384 + c] = f2bf(v);
    }
  }
}

DI void phase_attnC(const P& p, char* lds) {
  const bf16_t* PC = (const bf16_t*)(p.ws + O_PC);
  const bf16_t* VT = (const bf16_t*)(p.ws + O_VTC);
  bf16_t* MIX = (bf16_t*)(p.ws + O_MIX);
  const int nS = 129 * 4, nP = 8 * 33 * 4;
  const int sb = threadIdx.x >> 8;
  for (int it = blockIdx.x; it < nS + nP; it += gridDim.x) {
    int seq, qt, hq;
    if (it < nS) { seq = 8; hq = (it & 3) * 2 + sb; qt = it >> 2; }
    else { int j = it - nS; hq = (j & 3) * 2 + sb; j >>= 2; qt = j % 33; seq = j / 33; }
    const int kv = hq >> 2;
    const int L = seq_len(seq), LP = L + 48;
    flash_item<1>(PC + hq * 64, 768, PC + 512 + kv * 64, 768, VT + vtc_base(seq) + (size_t)kv * 64 * LP, LP,
                  MIX + hq * 64, 1024, seq_base(seq), L - 16, qt, p.c_sink[hq] * LOG2E, lds + sb * 36864);
  }
}

DI void chunk_decode(int cg_, int& seq, int& c) {
  if (cg_ < 136) { seq = cg_ / 17; c = cg_ - seq * 17; } else { seq = 8; c = cg_ - 136; }
}
DI float shiftv(const bf16_t* PRKV, int sr, int pos, int L, int col, float mp, float mn) {
  float u = bf2f(PRKV[(size_t)sr * 1536 + col]);
  float up = pos > 0 ? bf2f(PRKV[(size_t)(sr - 1) * 1536 + col]) : 0.f;
  float un = pos < L - 1 ? bf2f(PRKV[(size_t)(sr + 1) * 1536 + col]) : 0.f;
  return u + mp * (up - u) + mn * (un - u);
}
enum { VW = 0, VA = 1, VB = 2, VK = 3, VV = 4, VR = 5 };
#define DPP_FMAC(acc, x, y, N) asm("v_fmac_f32_dpp %0, %1, %2 row_newbcast:%3 row_mask:0xf bank_mask:0xf" : "+v"(acc) : "v"(x), "v"(y), "n"(N))
#define DPP_MUL(sv_, x, N) asm("v_mul_f32_dpp %0, %1, %0 row_newbcast:%2 row_mask:0xf bank_mask:0xf" : "+v"(sv_) : "v"(x), "n"(N))
template <int N> DI void dpp_dot4(float& a0, float& a1, float& a2, float& a3, const float (&S)[64], const float4& x) {
  DPP_FMAC(a0, x.x, S[N], N); DPP_FMAC(a1, x.y, S[16 + N], N); DPP_FMAC(a2, x.z, S[32 + N], N); DPP_FMAC(a3, x.w, S[48 + N], N);
  if constexpr (N < 15) dpp_dot4<N + 1>(a0, a1, a2, a3, S, x);
}
template <int N, bool HASV, bool OUT> DI void dpp_upd4(float (&S)[64], const float4& xb, const float4& xk, const float4& xr, float sa, float vi,
                                                       float& o0, float& o1, float& o2, float& o3) {
  DPP_FMAC(S[N], xb.x, sa, N); DPP_FMAC(S[16 + N], xb.y, sa, N); DPP_FMAC(S[32 + N], xb.z, sa, N); DPP_FMAC(S[48 + N], xb.w, sa, N);
  if (HASV) { DPP_FMAC(S[N], xk.x, vi, N); DPP_FMAC(S[16 + N], xk.y, vi, N); DPP_FMAC(S[32 + N], xk.z, vi, N); DPP_FMAC(S[48 + N], xk.w, vi, N); }
  if (OUT) { DPP_FMAC(o0, xr.x, S[N], N); DPP_FMAC(o1, xr.y, S[16 + N], N); DPP_FMAC(o2, xr.z, S[32 + N], N); DPP_FMAC(o3, xr.w, S[48 + N], N); }
  if constexpr (N < 15) dpp_upd4<N + 1, HASV, OUT>(S, xb, xk, xr, sa, vi, o0, o1, o2, o3);
}
template <int N> DI void dpp_scale4(float (&S)[64], const float4& xg) {
  DPP_MUL(S[N], xg.x, N); DPP_MUL(S[16 + N], xg.y, N); DPP_MUL(S[32 + N], xg.z, N); DPP_MUL(S[48 + N], xg.w, N);
  if constexpr (N < 15) dpp_scale4<N + 1>(S, xg);
}
template <int NST, bool HASV, bool OUT, class F>
DI void scan_steps(float (&S)[64], const float* sv, int ns, int lane, F&& emit) {
  const int l15 = lane & 15;
  for (int s = 0; s < ns; ++s) {
    const float4 xa = *(const float4*)(sv + VA * NST * 64 + s * 64 + l15 * 4);
    const float4 xb = *(const float4*)(sv + VB * NST * 64 + s * 64 + l15 * 4);
    float4 xk = xb, xr = xb;
    if (HASV) xk = *(const float4*)(sv + VK * NST * 64 + s * 64 + l15 * 4);
    if (OUT) xr = *(const float4*)(sv + VR * NST * 64 + s * 64 + l15 * 4);
    const float vi = HASV ? sv[VV * NST * 64 + s * 64 + lane] : 0.f;
    float sa0 = 0.f, sa1 = 0.f, sa2 = 0.f, sa3 = 0.f;
    dpp_dot4<0>(sa0, sa1, sa2, sa3, S, xa);
    const float sa = (sa0 + sa1) + (sa2 + sa3);
    float o0 = 0.f, o1 = 0.f, o2 = 0.f, o3 = 0.f;
    dpp_upd4<0, HASV, OUT>(S, xb, xk, xr, sa, vi, o0, o1, o2, o3);
    if (OUT) emit(s, (o0 + o1) + (o2 + o3));
    if ((s & 7) == 7) {
      const float4 xg = *(const float4*)(sv + VW * NST * 64 + (s >> 3) * 64 + l15 * 4);
      dpp_scale4<0>(S, xg);
    }
  }
}
DI int vperm(int j) { return (j & 15) * 4 + (j >> 4); }

DI void shift8(const bf16_t* PRKV, const P& p, int sbase, int pos, int L, int off, int c0, float (&out)[8]) {
  const bf16_t* rp = PRKV + (size_t)(sbase + pos) * 1536 + off + c0;
  const u32x4 uc = *(const u32x4*)rp;
  u32x4 up = (u32x4)(0u), un = (u32x4)(0u);
  if (pos > 0) up = *(const u32x4*)(rp - 1536);
  if (pos < L - 1) un = *(const u32x4*)(rp + 1536);
  const f32x4v mp0 = *(const f32x4v*)(p.mu_prev + off + c0), mp1 = *(const f32x4v*)(p.mu_prev + off + c0 + 4);
  const f32x4v mn0 = *(const f32x4v*)(p.mu_next + off + c0), mn1 = *(const f32x4v*)(p.mu_next + off + c0 + 4);
#pragma unroll
  for (int e2 = 0; e2 < 4; ++e2) {
    const float c_lo = lo2f(uc[e2]), c_hi = hi2f(uc[e2]);
    const float mpl = e2 < 2 ? mp0[2 * e2] : mp1[2 * e2 - 4], mph = e2 < 2 ? mp0[2 * e2 + 1] : mp1[2 * e2 - 3];
    const float mnl = e2 < 2 ? mn0[2 * e2] : mn1[2 * e2 - 4], mnh = e2 < 2 ? mn0[2 * e2 + 1] : mn1[2 * e2 - 3];
    out[2 * e2] = c_lo + mpl * (lo2f(up[e2]) - c_lo) + mnl * (lo2f(un[e2]) - c_lo);
    out[2 * e2 + 1] = c_hi + mph * (hi2f(up[e2]) - c_hi) + mnh * (hi2f(un[e2]) - c_hi);
  }
}

template <int NST, bool P3>
DI void scan_prologue8(const P& p, int sbase, int L, int hd, int dir, int pos0, int nsteps, int sb0, float* sv) {
  const int lane = threadIdx.x & 63, l31 = lane & 31, h = lane >> 5;
  const bf16_t* PRKV = (const bf16_t*)(p.ws + O_PRKV);
  const bf16_t* LR = (const bf16_t*)(p.ws + O_LR);
  const bf16_t* WUPT = (const bf16_t*)(p.ws + O_WUPT) + (size_t)(dir * 512 + hd * 64) * 64;
  const bf16_t* AUPT = (const bf16_t*)(p.ws + O_AUPT) + (size_t)(dir * 512 + hd * 64) * 64;
  float* bonus = (float*)(p.ws + O_BONUS);
  {
    int sl = sb0 + (l31 & 7); if (sl > nsteps - 1) sl = nsteps - 1;
    const int pos = dir ? pos0 - sl : pos0 + sl;
    const bf16_t* lrp = LR + (size_t)(sbase + pos) * 384 + dir * 64 + 8 * h;
#pragma unroll 1
    for (int mat = 0; mat < 2; ++mat) {
      const bf16_t* Wm = mat ? AUPT : WUPT;
      const float* bias = mat ? p.d_a0 : p.d_w0;
      f32x16 ac[2];
#pragma unroll
      for (int nt = 0; nt < 2; ++nt)
#pragma unroll
        for (int i = 0; i < 16; ++i) ac[nt][i] = 0.f;
#pragma unroll
      for (int ks = 0; ks < 4; ++ks) {
        const bf16x8 fa = *(const bf16x8*)(lrp + mat * 128 + 16 * ks);
#pragma unroll
        for (int nt = 0; nt < 2; ++nt) {
          const bf16x8 bw = *(const bf16x8*)(Wm + (size_t)(32 * nt + l31) * 64 + 16 * ks + 8 * h);
          ac[nt] = MFMA32(fa, bw, ac[nt]);
        }
      }
#pragma unroll
      for (int nt = 0; nt < 2; ++nt) {
        const int j = 32 * nt + l31;
        const float b0 = bias[dir * 512 + hd * 64 + j];
#pragma unroll
        for (int i = 0; i < 4; ++i) {
          const int st = sb0 + i + 4 * h;
          const float sg = 1.f / (1.f + __expf(-(b0 + ac[nt][i])));
          if (mat) sv[VK * NST * 64 + st * 64 + j] = sg;
          else ac[nt][i] = __expf(-0.6065306597126334f * sg);
        }
        if (!mat) {
          float g0 = ac[nt][0], g1 = g0 * ac[nt][1], g2 = g1 * ac[nt][2], g3 = g2 * ac[nt][3];
          const float tot_lo = __shfl(g3, l31);
          if (h) { g0 *= tot_lo; g1 *= tot_lo; g2 *= tot_lo; g3 *= tot_lo; }
          float* gd = sv + VA * NST * 64 + (sb0 + 4 * h) * 64 + j;
          gd[0] = g0; gd[64] = g1; gd[128] = g2; gd[192] = g3;
          if (h) sv[VW * NST * 64 + (sb0 >> 3) * 64 + vperm(j)] = g3;
        }
      }
    }
  }
  const int stp = lane >> 3, seg = lane & 7, c0 = hd * 64 + 8 * seg;
  const int s = sb0 + stp;
  const int ss = s < nsteps ? s : nsteps - 1;
  const int pos = dir ? pos0 - ss : pos0 + ss;
  float k[8], a[8], gam[8], gpr[8];
  shift8(PRKV, p, sbase, pos, L, 512, c0, k);
  {
    const f32x4v a0 = *(const f32x4v*)(sv + VK * NST * 64 + s * 64 + 8 * seg), a1 = *(const f32x4v*)(sv + VK * NST * 64 + s * 64 + 8 * seg + 4);
    const f32x4v g0 = *(const f32x4v*)(sv + VA * NST * 64 + s * 64 + 8 * seg), g1 = *(const f32x4v*)(sv + VA * NST * 64 + s * 64 + 8 * seg + 4);
    const int sp = stp > 0 ? s - 1 : s;
    const f32x4v q0 = *(const f32x4v*)(sv + VA * NST * 64 + sp * 64 + 8 * seg), q1 = *(const f32x4v*)(sv + VA * NST * 64 + sp * 64 + 8 * seg + 4);
#pragma unroll
    for (int e = 0; e < 4; ++e) {
      a[e] = a0[e]; a[4 + e] = a1[e]; gam[e] = g0[e]; gam[4 + e] = g1[e];
      gpr[e] = stp > 0 ? q0[e] : 1.f; gpr[4 + e] = stp > 0 ? q1[e] : 1.f;
    }
  }
  const f32x4v kk0 = *(const f32x4v*)(p.d_k_k + c0), kk1 = *(const f32x4v*)(p.d_k_k + c0 + 4);
  const f32x4v ka0 = *(const f32x4v*)(p.d_k_a + c0), ka1 = *(const f32x4v*)(p.d_k_a + c0 + 4);
  float kk[8], kd[8];
  float n2 = 0.f;
#pragma unroll
  for (int e = 0; e < 8; ++e) {
    kk[e] = k[e] * (e < 4 ? kk0[e] : kk1[e - 4]);
    n2 += kk[e] * kk[e];
    kd[e] = k[e] * (1.f + (a[e] - 1.f) * (e < 4 ? ka0[e] : ka1[e - 4]));
  }
  n2 += __shfl_xor(n2, 1); n2 += __shfl_xor(n2, 2); n2 += __shfl_xor(n2, 4);
  const float rn = rsqrtf(fmaxf(n2, 1e-24f));
#pragma unroll
  for (int e = 0; e < 8; ++e) {
    const int ix = s * 64 + vperm(8 * seg + e);
    const float kn = kk[e] * rn;
    const float ig = __builtin_amdgcn_rcpf(gam[e]);
    sv[VA * NST * 64 + ix] = -kn * gpr[e];
    sv[VB * NST * 64 + ix] = kn * a[e] * ig;
    sv[VK * NST * 64 + ix] = kd[e] * ig;
  }
  {
    float v[8];
    shift8(PRKV, p, sbase, pos, L, 1024, c0, v);
    *(f32x4v*)(sv + VV * NST * 64 + s * 64 + 8 * seg) = (f32x4v){v[0], v[1], v[2], v[3]};
    *(f32x4v*)(sv + VV * NST * 64 + s * 64 + 8 * seg + 4) = (f32x4v){v[4], v[5], v[6], v[7]};
  }
  if (P3) {
    float r[8];
    shift8(PRKV, p, sbase, pos, L, 0, c0, r);
    const f32x4v rk0 = *(const f32x4v*)(p.d_r_k + c0), rk1 = *(const f32x4v*)(p.d_r_k + c0 + 4);
    float bn = 0.f;
#pragma unroll
    for (int e = 0; e < 8; ++e) {
      sv[VR * NST * 64 + s * 64 + vperm(8 * seg + e)] = r[e] * gam[e];
      bn += r[e] * kd[e] * (e < 4 ? rk0[e] : rk1[e - 4]);
    }
    bn += __shfl_xor(bn, 1); bn += __shfl_xor(bn, 2); bn += __shfl_xor(bn, 4);
    if (s < nsteps && seg == 0) bonus[((size_t)(sbase + pos) * 8 + hd) * 2 + dir] = bn;
  }
}

DI unsigned scan_touch(const P& p, int sbase, int L, int hd, int dir, int posf  ) {
  const int lane = threadIdx.x & 63;
  const bf16_t* PRKV = (const bf16_t*)(p.ws + O_PRKV);
  const bf16_t* LR = (const bf16_t*)(p.ws + O_LR);
  const int lo = dir ? posf - 8 : posf - 1;
  const unsigned* ptr;
  if (lane < 30) { int row = lo + lane / 3; row = row < 0 ? 0 : (row > L - 1 ? L - 1 : row); ptr = (const unsigned*)(PRKV + (size_t)(sbase + row) * 1536 + (lane % 3) * 512 + hd * 64); }
  else { const int i2 = (lane - 30) & 15; int row = dir ? posf - (i2 >> 1) : posf + (i2 >> 1); row = row < 0 ? 0 : (row > L - 1 ? L - 1 : row); ptr = (const unsigned*)(LR + (size_t)(sbase + row) * 384 + (i2 & 1) * 128 + dir * 64); }
  return *ptr;
}

template <bool HALF> DI void scan1_body(const P& p, char* lds) {
  float* PQ = (float*)(p.ws + O_PQ);
  const int lane = threadIdx.x & 63, wave = __builtin_amdgcn_readfirstlane(threadIdx.x >> 6), slot = wave >> 1;
  constexpr int half = HALF ? 1 : 0;
  float* sv = (float*)lds + slot * (6 * 16 * 64);
  for (int g = blockIdx.x; g < 804; g += gridDim.x) {
    int seq, c, hp;
    if (g < 768) { const int lc = g >> 2; hp = g & 3; if (lc < 128) { seq = lc >> 4; c = lc & 15; } else { seq = 8; c = lc - 128; } }
    else { const int j = g - 768; hp = j & 3; seq = j >> 2; c = seq < 8 ? 16 : 64; }
    const int cgi = seq < 8 ? seq * 17 + c : 136 + c;
    const int hd = hp * 2 + (slot >> 1), dir = slot & 1;
    const int it = (cgi * 8 + hd) * 2 + dir;
    const int L = seq_len(seq), sbase = seq_base(seq);
    const int start = c * 256, end = min(L, start + 256), n = end - start;
    float S[64];
#pragma unroll
    for (int j = 0; j < 64; ++j) S[j] = (half == 0 && j == lane) ? 1.f : 0.f;
    for (int s0 = 0; s0 < n; s0 += 16) {
      const int ns = min(16, n - s0);
      const int pos0 = dir ? end - 1 - s0 : start + s0;
      __syncthreads();
      scan_prologue8<16, false>(p, sbase, L, hd, dir, pos0, ns, half * 8, sv);
      __syncthreads();
      unsigned tch = 0u;
      if (s0 + 16 < n) tch = scan_touch(p, sbase, L, hd, dir, dir ? pos0 - 16 - half * 8 : pos0 + 16 + half * 8);
      scan_steps<16, HALF, false>(S, sv, ns, lane, [](int, float) {});
      asm volatile("" :: "v"(tch));
    }
    float* dst = PQ + (size_t)it * 8192 + (size_t)(half * 64 + lane) * 64;
#pragma unroll
    for (int q = 0; q < 16; ++q) *(float4*)(dst + q * 4) = make_float4(S[q * 4], S[q * 4 + 1], S[q * 4 + 2], S[q * 4 + 3]);
  }
}

DI void phase_scan1(const P& p, char* lds) {
  const int w_ = __builtin_amdgcn_readfirstlane(threadIdx.x >> 6);
  if ((w_ ^ (w_ >> 2)) & 1) scan1_body<true>(p, lds); else scan1_body<false>(p, lds);
}

DI void phase_scan2(const P& p, char* lds) {
  float* Ss = (float*)lds;
  float* Ps = Ss + 64 * 65;
  float* PQ = (float*)(p.ws + O_PQ);
  const int tid = threadIdx.x, lane = tid & 63, wave = __builtin_amdgcn_readfirstlane(tid >> 6), l31 = lane & 31, h = lane >> 5;
  const int r0 = 32 * (wave >> 1), c0 = 32 * (wave & 1);
  for (int it = blockIdx.x; it < 144; it += gridDim.x) {
    const int dir = it & 1, hd = (it >> 1) & 7, seq = it >> 4;
    const int nch = seq < 8 ? 17 : 65, cg0 = seq < 8 ? seq * 17 : 136;
    f32x16 S;
#pragma unroll
    for (int i = 0; i < 16; ++i) S[i] = 0.f;
    f32x4v pn0, pn1;
    {
      const int c = dir ? nch - 1 : 0;
      const float* Pg = PQ + (size_t)(((cg0 + c) * 8 + hd) * 2 + dir) * 8192;
      pn0 = *(const f32x4v*)(Pg + tid * 4); pn1 = *(const f32x4v*)(Pg + (512 + tid) * 4);
    }
    for (int cc = 0; cc < nch; ++cc) {
      const int c = dir ? nch - 1 - cc : cc;
      float* Qg = PQ + (size_t)(((cg0 + c) * 8 + hd) * 2 + dir) * 8192 + 4096;
      __syncthreads();
      { const int m = tid >> 4, cq = (tid & 15) * 4; *(f32x4v*)(Ps + m * 68 + cq) = pn0; *(f32x4v*)(Ps + (m + 32) * 68 + cq) = pn1; }
      f32x16 acc;
      if (wave < 4) {
#pragma unroll
        for (int i = 0; i < 16; ++i) {
          const int row = r0 + (i & 3) + 8 * (i >> 2) + 4 * h;
          Ss[row * 65 + c0 + l31] = S[i];
          float* qp = Qg + row * 64 + c0 + l31;
          acc[i] = *qp;
          *qp = S[i];
        }
      }
      if (cc + 1 < nch) {
        const int c2 = dir ? nch - 2 - cc : cc + 1;
        const float* Pg2 = PQ + (size_t)(((cg0 + c2) * 8 + hd) * 2 + dir) * 8192;
        pn0 = *(const f32x4v*)(Pg2 + tid * 4); pn1 = *(const f32x4v*)(Pg2 + (512 + tid) * 4);
      }
      __syncthreads();
      if (wave < 4) {
#pragma unroll 8
        for (int kk = 0; kk < 32; ++kk) {
          const float av = Ss[(r0 + l31) * 65 + 2 * kk + h];
          const float bv = Ps[(2 * kk + h) * 68 + c0 + l31];
          acc = __builtin_amdgcn_mfma_f32_32x32x2f32(av, bv, acc, 0, 0, 0);
        }
        S = acc;
      }
    }
  }
}

DI void phase_scan3(const P& p, char* lds) {
  const float* PQ = (const float*)(p.ws + O_PQ);
  bf16_t* MIX = (bf16_t*)(p.ws + O_MIX);
  bf16_t* OB = (bf16_t*)(p.ws + O_OB);
  const int lane = threadIdx.x & 63, wave = __builtin_amdgcn_readfirstlane(threadIdx.x >> 6);
  float* sv = (float*)lds + wave * (6 * 8 * 64);
  const bool bal = gridDim.x == 256;
  const int NW = gridDim.x * 8, gw = blockIdx.x * 8 + wave;
  for (int k = 0; ; ++k) {
    int oi;
    if (bal) {
      if (k == 0) oi = gw;
      else if (k == 1) { if (wave >= 4) continue; oi = 2048 + blockIdx.x * 4 + wave; }
      else if (k == 2) { if (wave != 7 || blockIdx.x >= 144) break; oi = 3072 + blockIdx.x; }
      else break;
    } else { oi = gw + k * NW; if (oi >= 3216) break; }
    int seq, c, hd, dir;
    if (oi < 3072) { const int lc = oi >> 4; hd = (oi >> 1) & 7; dir = oi & 1; if (lc < 128) { seq = lc >> 4; c = lc & 15; } else { seq = 8; c = lc - 128; } }
    else { const int j = oi - 3072; hd = (j >> 1) & 7; dir = j & 1; seq = j >> 4; c = seq < 8 ? 16 : 64; }
    const int it = ((seq < 8 ? seq * 17 + c : 136 + c) * 8 + hd) * 2 + dir;
    const int L = seq_len(seq), sbase = seq_base(seq);
    const int start = c * 256, end = min(L, start + 256), n = end - start;
    float S[64];
    {
      const float* src = PQ + (size_t)it * 8192 + 4096 + lane * 64;
#pragma unroll
      for (int q = 0; q < 16; ++q) { float4 t = *(const float4*)(src + q * 4); S[q * 4] = t.x; S[q * 4 + 1] = t.y; S[q * 4 + 2] = t.z; S[q * 4 + 3] = t.w; }
    }
    for (int s0 = 0; s0 < n; s0 += 8) {
      const int ns = min(8, n - s0);
      const int pos0 = dir ? end - 1 - s0 : start + s0;
      scan_prologue8<8, true>(p, sbase, L, hd, dir, pos0, ns, 0, sv);
      unsigned tch = 0u;
      if (s0 + 8 < n) tch = scan_touch(p, sbase, L, hd, dir, dir ? pos0 - 8 : pos0 + 8);
      scan_steps<8, true, true>(S, sv, ns, lane, [&](int st, float o) {
        const int pos = dir ? pos0 - st : pos0 + st;
        const size_t sr = (size_t)(sbase + pos);
        if (dir == 0) MIX[sr * 1024 + 512 + hd * 64 + lane] = f2bf(o);
        else OB[sr * 512 + hd * 64 + lane] = f2bf(o);
      });
      asm volatile("" :: "v"(tch));
    }
  }
}

DI void phase_rwkv_final(const P& p) {
  const int lane = threadIdx.x & 63, gw = (blockIdx.x * NTH + threadIdx.x) >> 6, nw = (gridDim.x * NTH) >> 6;
  bf16_t* MIX = (bf16_t*)(p.ws + O_MIX);
  const bf16_t* OB = (const bf16_t*)(p.ws + O_OB);
  const bf16_t* G = (const bf16_t*)(p.ws + O_G);
  const bf16_t* PRKV = (const bf16_t*)(p.ws + O_PRKV);
  const float* bonus = (const float*)(p.ws + O_BONUS);
  const int hd = lane >> 3, c0 = lane * 8;
  for (int sr = gw; sr < T_; sr += nw) {
    int pos; int b = seq_of(sr, pos);
    const int L = seq_len(b);
    uint4 uf = *(const uint4*)(MIX + (size_t)sr * 1024 + 512 + c0);
    uint4 ub = *(const uint4*)(OB + (size_t)sr * 512 + c0);
    uint4 ug = *(const uint4*)(G + (size_t)sr * 512 + c0);
    unsigned f_[4] = {uf.x, uf.y, uf.z, uf.w}, b_[4] = {ub.x, ub.y, ub.z, ub.w}, g_[4] = {ug.x, ug.y, ug.z, ug.w};
    float o[8], gg[8];
    float sm = 0.f;
#pragma unroll
    for (int j = 0; j < 4; ++j) {
      o[2 * j] = lo2f(f_[j]) + lo2f(b_[j]); o[2 * j + 1] = hi2f(f_[j]) + hi2f(b_[j]);
      gg[2 * j] = lo2f(g_[j]); gg[2 * j + 1] = hi2f(g_[j]);
      sm += o[2 * j] + o[2 * j + 1];
    }
    sm += __shfl_xor(sm, 1); sm += __shfl_xor(sm, 2); sm += __shfl_xor(sm, 4);
    const float mean = sm * (1.f / 64.f);
    float vs = 0.f;
#pragma unroll
    for (int j = 0; j < 8; ++j) { float dlt = o[j] - mean; vs += dlt * dlt; }
    vs += __shfl_xor(vs, 1); vs += __shfl_xor(vs, 2); vs += __shfl_xor(vs, 4);
    const float rstd = rsqrtf(vs * (1.f / 64.f) + 64e-5f);
    const float bsum = bonus[((size_t)sr * 8 + hd) * 2] + bonus[((size_t)sr * 8 + hd) * 2 + 1];
    float y[8];
#pragma unroll
    for (int j = 0; j < 8; ++j) {
      int c = c0 + j;
      float vsh = shiftv(PRKV, sr, pos, L, 1024 + c, p.mu_prev[1024 + c], p.mu_next[1024 + c]);
      y[j] = ((o[j] - mean) * rstd * p.d_ln_g[c] + p.d_ln_b[c] + bsum * vsh) * gg[j];
    }
    *(uint4*)(MIX + (size_t)sr * 1024 + 512 + c0) = make_uint4(pack2(y[0], y[1]), pack2(y[2], y[3]), pack2(y[4], y[5]), pack2(y[6], y[7]));
  }
}

#define XB_TMO      128
#define XB_XCNT(j)  (256  + 64 * (j))
#define XB_XSUB(j)  (1280 + 64 * (j))
#define XB_XGEN(j)  (2304 + 64 * (j))
#define XB_TOP      3328
#define XB_TOPGEN   3392
#define XCD_BAR_WORDS 3456
#define XB_SPIN_CAP (1u << 23)
#define LAS __attribute__((address_space(3)))

__device__ __forceinline__ unsigned xb_ld(unsigned* p)              { return __hip_atomic_load(p, __ATOMIC_RELAXED, __HIP_MEMORY_SCOPE_AGENT); }
__device__ __forceinline__ unsigned xb_add(unsigned* p, unsigned v) { return __hip_atomic_fetch_add(p, v, __ATOMIC_RELAXED, __HIP_MEMORY_SCOPE_AGENT); }
__device__ __forceinline__ unsigned xb_xcc_id() { return (unsigned)__builtin_amdgcn_s_getreg((3 << 11) | 20) & 0xFu; }
#define XB_SPIN(cond, bar) do { unsigned _sp = 0; while (cond) { __builtin_amdgcn_s_sleep(1); \
    if ((++_sp & 255u) == 0u) { if (xb_ld(&(bar)[XB_TMO])) break; if (_sp > XB_SPIN_CAP) { atomicAdd(&(bar)[XB_TMO], 1u); break; } } } } while (0)

struct XcdBarrier {
    unsigned* bar; unsigned x;
    volatile LAS unsigned* st;
};

__device__ __forceinline__ XcdBarrier xcd_barrier_post(unsigned* bar, volatile LAS unsigned* st) {
    XcdBarrier b; b.bar = bar; b.x = xb_xcc_id(); b.st = st;
    if (threadIdx.x == 0) (void)xb_add(&bar[XB_XCNT(b.x)], 1u);
    return b;
}
__device__ __forceinline__ void xcd_barrier_complete(unsigned* bar, unsigned x, unsigned& nloc, unsigned& nx) {
    const unsigned G = gridDim.x * gridDim.y * gridDim.z;
    unsigned sum, cnt, mine, sp = 0u;
    for (;;) {
        sum = 0u; cnt = 0u; mine = 0u;
#pragma unroll
        for (unsigned j = 0; j < 16; ++j) { const unsigned c = xb_ld(&bar[XB_XCNT(j)]); sum += c; cnt += (c > 0u) ? 1u : 0u; mine = (j == x) ? c : mine; }
        if (sum == G) break;
        __builtin_amdgcn_s_sleep(1);
        if ((++sp & 255u) == 0u) { if (xb_ld(&bar[XB_TMO])) break; if (sp > XB_SPIN_CAP) { atomicAdd(&bar[XB_TMO], 1u); break; } }
    }
    nloc = mine > 0u ? mine : 1u; nx = cnt > 0u ? cnt : 1u;
}

__device__ __forceinline__ void xcd_barrier(const XcdBarrier& b) {
    asm volatile("s_waitcnt vmcnt(0)" ::: "memory");
    __syncthreads();
    if (threadIdx.x == 0) {
        unsigned* bar = b.bar;
        __builtin_amdgcn_s_waitcnt(0);
        unsigned nloc = b.st[0], nx = b.st[1];
        if (nloc == 0u) { xcd_barrier_complete(bar, b.x, nloc, nx); b.st[0] = nloc; b.st[1] = nx; }
        const unsigned old = xb_add(&bar[XB_XSUB(b.x)], 1u);
        const unsigned gen = old / nloc;
        if (old + 1u == (gen + 1u) * nloc) {
            __builtin_amdgcn_fence(__ATOMIC_RELEASE, "agent");
            asm volatile("s_waitcnt vmcnt(0)" ::: "memory");
            const unsigned og = xb_add(&bar[XB_TOP], 1u);
            const unsigned tg = og / nx;
            if (og + 1u == (tg + 1u) * nx) xb_add(&bar[XB_TOPGEN], 1u);
            else XB_SPIN(xb_ld(&bar[XB_TOPGEN]) == tg, bar);
            __builtin_amdgcn_fence(__ATOMIC_ACQUIRE, "agent");
            xb_add(&bar[XB_XGEN(b.x)], 1u);
            asm volatile("s_waitcnt vmcnt(0)" ::: "memory");
        } else {
            XB_SPIN(xb_ld(&bar[XB_XGEN(b.x)]) == gen, bar);
            __builtin_amdgcn_fence(__ATOMIC_ACQUIRE, "agent");
            asm volatile("s_waitcnt vmcnt(0)" ::: "memory");
        }
    }
    __syncthreads();
}

constexpr int NPHASE = 23;
__global__ void __launch_bounds__(NTH, 2) mega(P p) {
  extern __shared__ __attribute__((aligned(16))) unsigned char shm[];
  char* lds = (char*)shm;
  char* ws = p.ws;
  if (threadIdx.x == 0) *(uint4*)(shm + 131072) = make_uint4(0u, 0u, 0u, 0u);
  __syncthreads();
  const XcdBarrier xb = xcd_barrier_post((unsigned*)(ws + O_BAR), (volatile LAS unsigned*)(shm + 131072));
#ifndef DUP_MASK
#define DUP_MASK 0u
#endif
#define RUN(k, call) if (p.ph0 <= k && k < p.ph1) { call; if (k + 1 < p.ph1) { if (k == 0) cg::this_grid().sync(); else xcd_barrier(xb); } }
  RUN(0, phase_prep(p))
  RUN(1, phase_gemm_big((const bf16_t*)(ws + O_HN), (const bf16_t*)(ws + O_WIN0), 1536, 1024, (bf16_t*)(ws + O_PROJ0), 1536, 0, ws, shm))
  RUN(2, phase_prepA(p, lds))
  RUN(3, phase_attnA(p, lds))
  RUN(4, phase_fnet_gemm(p, lds))
  RUN(5, phase_gemm_big((const bf16_t*)(ws + O_MIX), (const bf16_t*)(ws + O_WOUT0), 1024, 1024, (bf16_t*)(ws + O_HN), 1024, 0, ws, shm))
  RUN(6, phase_resnorm(p, p.post_mix_g, p.pre_ffn_g))
  RUN(7, phase_gemm_gateup((const bf16_t*)(ws + O_HN), (const bf16_t*)(ws + O_WGU0), (bf16_t*)(ws + O_ACT), shm))
  RUN(8, phase_gemm_big((const bf16_t*)(ws + O_ACT), (const bf16_t*)(ws + O_WD0), 1024, DFF, (bf16_t*)(ws + O_HN), 1024, 0, ws, shm))
  RUN(9, phase_resnorm(p, p.post_ffn_g, p.pre_mix_g + 1024))
  RUN(10, phase_gemm_big((const bf16_t*)(ws + O_HN), (const bf16_t*)(ws + O_WIN1), 2816, 1024, nullptr, 0, 1, ws, shm))
  RUN(11, phase_prepC(p, lds))
  RUN(12, phase_attnC(p, lds))
  RUN(13, phase_scan1(p, lds))
  RUN(14, phase_scan2(p, lds))
  RUN(15, phase_scan3(p, lds))
  RUN(16, phase_gemm_small((const bf16_t*)(ws + O_LR) + 256, 384, (const bf16_t*)(ws + O_GUP), 512, 128, (bf16_t*)(ws + O_G), 512, lds))
  RUN(17, phase_rwkv_final(p))
  RUN(18, phase_gemm_big((const bf16_t*)(ws + O_MIX), (const bf16_t*)(ws + O_WOUT1), 1024, 1024, (bf16_t*)(ws + O_HN), 1024, 0, ws, shm))
  RUN(19, phase_resnorm(p, p.post_mix_g + 1024, p.pre_ffn_g + 1024))
  RUN(20, phase_gemm_gateup((const bf16_t*)(ws + O_HN), (const bf16_t*)(ws + O_WGU1), (bf16_t*)(ws + O_ACT), shm))
  RUN(21, phase_gemm_big((const bf16_t*)(ws + O_ACT), (const bf16_t*)(ws + O_WD1), 1024, DFF, (bf16_t*)(ws + O_HN), 1024, 0, ws, shm))
  RUN(22, phase_resnorm(p, p.post_ffn_g + 1024, nullptr))
#undef RUN
}

extern "C" void kernel_launch(void* const* d_in, const int* in_sizes, int n_in, void* d_out, int out_size, void* d_ws, size_t ws_size,
                              hipStream_t stream) {
  static int grid_blocks = 0;
  if (!grid_blocks) {
    int dev = 0, cus = 0, per_cu = 0;
    (void)hipGetDevice(&dev);
    (void)hipDeviceGetAttribute(&cus, hipDeviceAttributeMultiprocessorCount, dev);
    if (hipFuncSetAttribute((const void*)mega, hipFuncAttributeMaxDynamicSharedMemorySize, LDS_BYTES) != hipSuccess) fprintf(stderr, "hipFuncSetAttribute failed\n");
    if (hipOccupancyMaxActiveBlocksPerMultiprocessor(&per_cu, (const void*)mega, NTH, LDS_BYTES) != hipSuccess || per_cu < 1) {
      fprintf(stderr, "occupancy query says %d\n", per_cu);
      (void)hipGetLastError();
    }
    grid_blocks = cus;
  }
  if (ws_size < O_BAR + CTL_BYTES) { fprintf(stderr, "workspace too small\n"); return; }
  if (hipMemsetAsync((char*)d_ws + O_BAR, 0, CTL_BYTES, stream) != hipSuccess) { fprintf(stderr, "memset failed\n"); return; }
  P p{};
  const float** f = (const float**)&p;
  for (int i = 0; i < 32; ++i) f[i] = (const float*)d_in[i];
  p.out = (float*)d_out;
  p.ws = (char*)d_ws;
#if FUSED
  p.ph0 = 0; p.ph1 = NPHASE;
  void* args[] = {&p};
  hipError_t e = hipLaunchCooperativeKernel((void*)mega, dim3(grid_blocks), dim3(NTH), args, LDS_BYTES, stream);
  if (e != hipSuccess) fprintf(stderr, "cooperative launch failed: %s (grid %d)\n", hipGetErrorString(e), grid_blocks);
#else
  for (int ph = 0; ph < NPHASE; ++ph) {
    p.ph0 = ph; p.ph1 = ph + 1;
    hipLaunchKernelGGL(mega, dim3(grid_blocks), dim3(NTH), LDS_BYTES, stream, p);
  }
#endif
}
```

```cpp
#include <hip/hip_runtime.h>
#include <hip/hip_cooperative_groups.h>
#include <cstdio>
namespace cg = cooperative_groups;

#ifndef FUSED
#define FUSED 1
#endif

typedef unsigned short bf16_t;
using bf16x8 = __attribute__((ext_vector_type(8))) short;
using s16x4 = __attribute__((ext_vector_type(4))) short;
using f32x16 = __attribute__((ext_vector_type(16))) float;
using u32x4 = __attribute__((ext_vector_type(4))) unsigned;
using f32x4v = __attribute__((ext_vector_type(4))) float;
#define DI __device__ __forceinline__
#define MFMA32(a, b, c) __builtin_amdgcn_mfma_f32_32x32x16_bf16((a), (b), (c), 0, 0, 0)
constexpr int NTH = 512;
constexpr int LDS_BYTES = 131072 + 16;

constexpr int DM_ = 1024;
constexpr int T_ = 49296;
constexpr int TP_ = 49408;
constexpr int NT_ = TP_ / 128;
constexpr int DFF = 2816;
constexpr float EPS = 1e-6f;
constexpr float LOG2E = 1.4426950408889634f;

constexpr size_t SZ_ROW1024 = (size_t)TP_ * 1024 * 2;
constexpr size_t O_WIN0 = 0;
constexpr size_t O_WOUT0 = O_WIN0 + (size_t)1536 * 1024 * 2;
constexpr size_t O_WGU0 = O_WOUT0 + (size_t)1024 * 1024 * 2;
constexpr size_t O_WD0 = O_WGU0 + (size_t)5632 * 1024 * 2;
constexpr size_t O_DM257 = O_WD0 + (size_t)1024 * 2816 * 2;
constexpr size_t O_DM1025 = O_DM257 + (size_t)384 * 576 * 2;
constexpr size_t O_WIN1 = O_DM1025 + (size_t)1152 * 2112 * 2;
constexpr size_t O_WOUT1 = O_WIN1 + (size_t)2816 * 1024 * 2;
constexpr size_t O_WGU1 = O_WOUT1 + (size_t)1024 * 1024 * 2;
constexpr size_t O_WD1 = O_WGU1 + (size_t)5632 * 1024 * 2;
constexpr size_t O_GUP = O_WD1 + (size_t)1024 * 2816 * 2;
constexpr size_t O_RA = O_GUP + (size_t)512 * 128 * 2;
constexpr size_t O_RB = O_RA + SZ_ROW1024;
constexpr size_t O_RC = O_RB + (size_t)TP_ * 2816 * 2;
constexpr size_t O_META = O_RC + SZ_ROW1024;
constexpr size_t O_WC = O_META + (size_t)144 * 1024 * 4;
constexpr size_t O_WUPT = O_WC + (size_t)4 * 64 * 128 * 4;
constexpr size_t O_AUPT = O_WUPT + (size_t)2 * 512 * 64 * 2;
constexpr size_t O_END = O_AUPT + (size_t)2 * 512 * 64 * 2;
constexpr size_t O_HN = O_RA;
constexpr size_t O_VTA = O_RA;
constexpr size_t O_LR = O_RA;
constexpr size_t O_BONUS = O_RA + (size_t)TP_ * 384 * 2;
constexpr size_t O_VTC = O_BONUS + (size_t)T_ * 16 * 4;
constexpr size_t O_OB = O_RA + (size_t)TP_ * 512 * 2;
constexpr size_t O_PROJ0 = O_RB;
constexpr size_t O_ZB = O_PROJ0 + (size_t)TP_ * 1536 * 2;
constexpr size_t O_Y = O_ZB + (size_t)TP_ * 512 * 2;
constexpr size_t O_ACT = O_RB;
constexpr size_t O_PRKV = O_RB;
constexpr size_t O_PC = O_PRKV + (size_t)TP_ * 1536 * 2;
constexpr size_t O_PLOW = O_PC + (size_t)TP_ * 768 * 2;
constexpr size_t O_PQ = O_PC;
constexpr size_t O_G = O_PC;
constexpr size_t O_MIX = O_RC;
static_assert(O_VTC + (size_t)49728 * 128 * 2 <= O_RB, "vtc");
static_assert(O_Y + (size_t)(8 * 16 * 256 * 576 + 16 * 256 * 2112) * 2 <= O_RC, "y");
static_assert(O_PQ + (size_t)3216 * 32768 <= O_RC, "pq");
constexpr size_t O_BAR = (O_END + 255) / 256 * 256;
constexpr size_t O_CNT = O_BAR + 3456 * 4;
constexpr size_t CTL_BYTES = 3456 * 4 + 4 * 256;
static_assert(O_BAR + CTL_BYTES <= (size_t)536870912, "ws");

struct P {
  const float *x_prompt, *x_sample, *meta, *pre_mix_g, *post_mix_g, *pre_ffn_g, *post_ffn_g;
  const float *even_w_in, *even_w_out, *a_q_gain, *a_k_gain, *b_norm_g, *b_w, *b_b;
  const float *odd_w_in, *odd_w_out, *c_sink, *mu_prev, *mu_next, *d_w0, *d_w_up, *d_a0, *d_a_up, *d_g_up;
  const float *d_k_k, *d_k_a, *d_r_k, *d_ln_g, *d_ln_b, *ffn_gate, *ffn_up, *ffn_down;
  float* out;
  char* ws;
  int ph0, ph1;
};

typedef float f32x2 __attribute__((ext_vector_type(2)));
typedef __bf16 bf16x2_t __attribute__((ext_vector_type(2)));
DI bf16_t f2bf(float x) { return __builtin_bit_cast(bf16_t, (__bf16)x); }
DI float bf2f(bf16_t b) { return __uint_as_float(((unsigned)b) << 16); }
DI unsigned pack2(float a, float b) { f32x2 v = {a, b}; return __builtin_bit_cast(unsigned, __builtin_convertvector(v, bf16x2_t)); }
DI float lo2f(unsigned u) { return __uint_as_float(u << 16); }
DI float hi2f(unsigned u) { return __uint_as_float(u & 0xffff0000u); }
DI float wave_sum(float v) {
  for (int o = 32; o > 0; o >>= 1) v += __shfl_xor(v, o);
  return v;
}
DI int seq_of(int sr, int& pos) {
  if (sr < 32896) { int b = sr / 4112; pos = sr - b * 4112; return b; }
  pos = sr - 32896; return 8;
}
DI int seq_len(int b) { return b < 8 ? 4112 : 16400; }
DI int seq_base(int b) { return b < 8 ? b * 4112 : 32896; }
DI float* hrow(const P& p, int sr) {
  int pos; int b = seq_of(sr, pos);
  if (pos < 16) return (float*)(p.ws + O_META) + (size_t)(b * 16 + pos) * 1024;
  return p.out + ((size_t)(b < 8 ? b * 4096 : 32768) + (pos - 16)) * 1024;
}
DI float sigmoidf_(float x) { return 1.f / (1.f + expf(-x)); }

DI void transpose_w(const float* W, int K, int ldw, int N, bf16_t* Wt, int mode, const float* W2, int gtid, int gsz) {
  int nk8 = K / 8;
  long total = (long)N * nk8;
  for (long it = gtid; it < total; it += gsz) {
    int n = (int)(it % N), k8 = (int)(it / N);
    const float* src = W;
    int c = n;
    if (mode == 1) {
      int blk = n >> 8, w = n & 255;
      c = blk * 128 + (w & 127);
      if (w >= 128) src = W2;
    }
    unsigned r[4];
#pragma unroll
    for (int j = 0; j < 4; ++j) {
      float a = src[(size_t)(k8 * 8 + 2 * j) * ldw + c];
      float b = src[(size_t)(k8 * 8 + 2 * j + 1) * ldw + c];
      r[j] = pack2(a, b);
    }
    *(uint4*)(Wt + (size_t)n * K + k8 * 8) = make_uint4(r[0], r[1], r[2], r[3]);
  }
}

DI void phase_prep(const P& p) {
  const int gtid = blockIdx.x * NTH + threadIdx.x, gsz = gridDim.x * NTH;
  char* ws = p.ws;
  transpose_w(p.even_w_in, 1024, 1536, 1536, (bf16_t*)(ws + O_WIN0), 0, nullptr, gtid, gsz);
  transpose_w(p.even_w_out, 1024, 1024, 1024, (bf16_t*)(ws + O_WOUT0), 0, nullptr, gtid, gsz);
  transpose_w(p.odd_w_in, 1024, 2688, 2688, (bf16_t*)(ws + O_WIN1), 0, nullptr, gtid, gsz);
  transpose_w(p.odd_w_out, 1024, 1024, 1024, (bf16_t*)(ws + O_WOUT1), 0, nullptr, gtid, gsz);
  transpose_w(p.ffn_gate, 1024, DFF, 5632, (bf16_t*)(ws + O_WGU0), 1, p.ffn_up, gtid, gsz);
  transpose_w(p.ffn_gate + (size_t)1024 * DFF, 1024, DFF, 5632, (bf16_t*)(ws + O_WGU1), 1, p.ffn_up + (size_t)1024 * DFF, gtid, gsz);
  transpose_w(p.ffn_down, DFF, 1024, 1024, (bf16_t*)(ws + O_WD0), 0, nullptr, gtid, gsz);
  transpose_w(p.ffn_down + (size_t)DFF * 1024, DFF, 1024, 1024, (bf16_t*)(ws + O_WD1), 0, nullptr, gtid, gsz);
  transpose_w(p.d_g_up, 128, 512, 512, (bf16_t*)(ws + O_GUP), 0, nullptr, gtid, gsz);
  for (int d = 0; d < 2; ++d) {
    transpose_w(p.d_w_up + (size_t)d * 64 * 512, 64, 512, 512, (bf16_t*)(ws + O_WUPT) + (size_t)d * 512 * 64, 0, nullptr, gtid, gsz);
    transpose_w(p.d_a_up + (size_t)d * 64 * 512, 64, 512, 512, (bf16_t*)(ws + O_AUPT) + (size_t)d * 512 * 64, 0, nullptr, gtid, gsz);
  }
  for (int it = gtid; it < 128 * 1024 / 8; it += gsz) *(uint4*)((bf16_t*)(ws + O_WIN1) + (size_t)2688 * 1024 + (size_t)it * 8) = make_uint4(0, 0, 0, 0);
  for (int which = 0; which < 2; ++which) {
    const int M = which ? 1025 : 257, MP = which ? 1152 : 384, KP = which ? 2112 : 576;
    bf16_t* dm = (bf16_t*)(ws + (which ? O_DM1025 : O_DM257));
    for (int it = gtid; it < MP * KP; it += gsz) {
      int r = it / KP, c = it - r * KP;
      float v = 0.f;
      if (r < M && c < 2 * M) {
        int n2 = c < M ? c : c - M;
        int m = (r * n2) % M;
        float s, co;
        sincospif(2.0f * (float)m / (float)M, &s, &co);
        v = c < M ? co : s;
      }
      dm[it] = f2bf(v);
    }
  }
  for (int it = gtid; it < 4 * 64 * 128; it += gsz) {
    int o = it & 127, c = (it >> 7) & 63, g = it >> 13;
    int d = o & 63;
    float acc = 0.f;
    for (int c2 = 0; c2 < 64; ++c2) {
      float s, co;
      sincospif((float)((c * c2) & 63) / 32.f, &s, &co);
      float w = p.b_w[(g * 64 + c2) * 64 + d];
      acc += (o < 64 ? co : -s) * w;
    }
    ((float*)(ws + O_WC))[it] = acc;
  }
  const int lane = threadIdx.x & 63, gw = gtid >> 6, nw = gsz >> 6;
  bf16_t* HN = (bf16_t*)(ws + O_HN);
  for (int sr = gw; sr < TP_; sr += nw) {
    if (sr >= T_) {
#pragma unroll
      for (int q = 0; q < 2; ++q) *(uint4*)(HN + (size_t)sr * 1024 + q * 512 + lane * 8) = make_uint4(0, 0, 0, 0);
      continue;
    }
    int pos; int b = seq_of(sr, pos);
    const float* src = pos < 16 ? p.meta + pos * 1024
                                : (b < 8 ? p.x_prompt + ((size_t)b * 4096 + pos - 16) * 1024 : p.x_sample + (size_t)(pos - 16) * 1024);
    float* hr = hrow(p, sr);
    float4 v[4];
    float ss = 0.f;
#pragma unroll
    for (int q = 0; q < 4; ++q) {
      v[q] = *(const float4*)(src + q * 256 + lane * 4);
      ss += v[q].x * v[q].x + v[q].y * v[q].y + v[q].z * v[q].z + v[q].w * v[q].w;
      *(float4*)(hr + q * 256 + lane * 4) = v[q];
    }
    ss = wave_sum(ss);
    float rs = rsqrtf(ss * (1.f / 1024.f) + EPS);
#pragma unroll
    for (int q = 0; q < 4; ++q) {
      float4 g = *(const float4*)(p.pre_mix_g + q * 256 + lane * 4);
      uint2 o = make_uint2(pack2(v[q].x * rs * g.x, v[q].y * rs * g.y), pack2(v[q].z * rs * g.z, v[q].w * rs * g.w));
      *(uint2*)(HN + (size_t)sr * 1024 + q * 256 + lane * 4) = o;
    }
  }
}

DI void gemm_tile(const bf16_t* __restrict__ A, int lda, const bf16_t* __restrict__ B, int ldb, int K, char* lds, f32x16 (&acc)[2][2]) {
  const int tid = threadIdx.x & 255, lane = tid & 63, wave = tid >> 6, wm = wave >> 1, wn = wave & 1;
  const int l31 = lane & 31, h = lane >> 5;
  bf16_t* As = (bf16_t*)lds;
  bf16_t* Bs = As + 128 * 72;
#pragma unroll
  for (int a = 0; a < 2; ++a)
#pragma unroll
    for (int b = 0; b < 2; ++b)
#pragma unroll
      for (int i = 0; i < 16; ++i) acc[a][b][i] = 0.f;
  const int lr = tid >> 3, lc = (tid & 7) * 8;
  const bf16_t* Ag = A + (size_t)lr * lda + lc;
  const bf16_t* Bg = B + (size_t)lr * ldb + lc;
  u32x4 ra[4], rb[4];
#pragma unroll
  for (int q = 0; q < 4; ++q) {
    ra[q] = *(const u32x4*)(Ag + (size_t)(32 * q) * lda);
    rb[q] = *(const u32x4*)(Bg + (size_t)(32 * q) * ldb);
  }
#pragma unroll
  for (int q = 0; q < 4; ++q) {
    *(u32x4*)(As + (lr + 32 * q) * 72 + lc) = ra[q];
    *(u32x4*)(Bs + (lr + 32 * q) * 72 + lc) = rb[q];
  }
  __syncthreads();
  const int nk = K >> 6;
  for (int kt = 0; kt < nk; ++kt) {
    if (kt + 1 < nk) {
#pragma unroll
      for (int q = 0; q < 4; ++q) {
        ra[q] = *(const u32x4*)(Ag + (size_t)(32 * q) * lda + (kt + 1) * 64);
        rb[q] = *(const u32x4*)(Bg + (size_t)(32 * q) * ldb + (kt + 1) * 64);
      }
    }
#pragma unroll
    for (int ks = 0; ks < 4; ++ks) {
      bf16x8 a[2], b[2];
#pragma unroll
      for (int t = 0; t < 2; ++t) {
        a[t] = *(const bf16x8*)(As + (wm * 64 + t * 32 + l31) * 72 + ks * 16 + 8 * h);
        b[t] = *(const bf16x8*)(Bs + (wn * 64 + t * 32 + l31) * 72 + ks * 16 + 8 * h);
      }
#pragma unroll
      for (int mt = 0; mt < 2; ++mt)
#pragma unroll
        for (int nt = 0; nt < 2; ++nt) acc[mt][nt] = MFMA32(a[mt], b[nt], acc[mt][nt]);
    }
    __syncthreads();
    if (kt + 1 < nk) {
#pragma unroll
      for (int q = 0; q < 4; ++q) {
        *(u32x4*)(As + (lr + 32 * q) * 72 + lc) = ra[q];
        *(u32x4*)(Bs + (lr + 32 * q) * 72 + lc) = rb[q];
      }
      __syncthreads();
    }
  }
}
#define ACC_ROW(mt, i) (wm * 64 + (mt) * 32 + ((i) & 3) + 8 * ((i) >> 2) + 4 * h)
#define ACC_COL(nt) (wn * 64 + (nt) * 32 + l31)
#define GEMM_IDS const int lane = threadIdx.x & 63, wave = (threadIdx.x & 255) >> 6, wm = wave >> 1, wn = wave & 1, l31 = lane & 31, h = lane >> 5; (void)wm; (void)wn; (void)l31; (void)h;

DI void phase_gemm_small(const bf16_t* A, int lda, const bf16_t* W, int N, int K, bf16_t* C, int ldc, char* lds) {
  GEMM_IDS
  const int sb = threadIdx.x >> 8;
  const int ntn = N / 128;
  const int total = NT_ * ntn;
  for (int t0 = blockIdx.x * 2; t0 < total; t0 += gridDim.x * 2) {
    const int t = t0 + sb;
    const int tm = t / ntn, tn = t - tm * ntn;
    f32x16 acc[2][2];
    gemm_tile(A + (size_t)tm * 128 * lda, lda, W + (size_t)tn * 128 * K, K, K, lds + sb * 36864, acc);
#pragma unroll
    for (int mt = 0; mt < 2; ++mt)
#pragma unroll
      for (int nt = 0; nt < 2; ++nt)
#pragma unroll
        for (int i = 0; i < 16; ++i) {
          int row = tm * 128 + ACC_ROW(mt, i), col = tn * 128 + ACC_COL(nt);
          C[(size_t)row * ldc + col] = f2bf(acc[mt][nt][i]);
        }
  }
}

namespace pg8 {
#define PG8_LAS __attribute__((address_space(3)))
typedef unsigned short bf16_t;
typedef short bf16x8 __attribute__((ext_vector_type(8)));
typedef float f32x4 __attribute__((ext_vector_type(4)));
typedef unsigned u32x4 __attribute__((ext_vector_type(4)));
constexpr int BM = 256, BK = 64, HALF = 128, HTB = HALF * BK * 2  , STAGE_BYTES = 8 * HTB, NXCD = 8, WGM = 8;

__host__ __device__ __forceinline__ int lds_byte(int r, int c) { const int st = (r >> 4) * 2 + (c >> 5), rr = r & 15, cc = c & 31, ob = rr * 64 + cc * 2; return st * 1024 + (ob ^ (((ob >> 9) & 1) << 5)); }
__host__ __device__ __forceinline__ void stage_rc(int b, int& R, int& C) { const int st = b / 1024, sb = b % 1024, swz = sb ^ (((sb >> 9) & 1) << 5); R = (st >> 1) * 16 + swz / 64; C = (st & 1) * 32 + (swz % 64) / 2; }
__host__ __device__ __forceinline__ int perm32(int rho) { const int n = rho >> 4, i = rho & 15; return 8 * (i >> 2) + 4 * n + (i & 3); }

struct Unit { int pm, pn; };
struct Gemm { const bf16_t* A; const bf16_t* Bt; int M, N, K; };

struct StaticOrder {
    int nM, nN, nwg, G, c;
    __host__ __device__ void init(int M, int N, int G_, int c_) { nM = M / BM; nN = N / BM; nwg = nM * nN; G = G_; c = c_; }
    __host__ __device__ bool next(int i, Unit& u) const {
        const long L = (long)i * G + c; if (L >= nwg) return false;
        int wgid = (int)L; { const int q = nwg / NXCD, r = nwg % NXCD, xcd = wgid % NXCD, off = wgid / NXCD; wgid = (xcd < r ? xcd * (q + 1) : r * (q + 1) + (xcd - r) * q) + off; }
        const int nig = WGM * nN, gid = wgid / nig, fm = gid * WGM, gsz = (nM - fm) < WGM ? (nM - fm) : WGM;
        u.pm = fm + ((wgid % nig) % gsz); u.pn = (wgid % nig) / gsz; return true;
    }
    __device__ __forceinline__ void a_ready(const Unit&) const {}
    __device__ __forceinline__ void done(const Unit&) const {}
};
__device__ __forceinline__ unsigned cvt_pk_bf16(float lo, float hi) { unsigned r; asm volatile("v_cvt_pk_bf16_f32 %0, %1, %2" : "=v"(r) : "v"(lo), "v"(hi)); return r; }

struct EpiRoute {
    static constexpr bool PERM = true, AFTER_DRAIN = false;
    bf16_t* O; int ldc; int route; bf16_t* pc; bf16_t* prkv; bf16_t* plow;
    __device__ __forceinline__ void operator()(const f32x4 (&acc)[2][2][4][2], const Unit& u, int wr, int wc, int fr, int fq) const {
        const int row0 = u.pm * BM + wr * 64 + fr;
#pragma unroll
        for (int bj = 0; bj < 2; ++bj) {
            int colh = u.pn * BM + bj * HALF; bf16_t* base = O; int ld = ldc;
            if (route) {
                if (colh < 768) { base = pc; ld = 768; }
                else if (colh < 2304) { base = prkv; ld = 1536; colh -= 768; }
                else if (colh < 2688) { base = plow; ld = 384; colh -= 2304; }
                else continue;
            }
            const int col0 = colh + wc * 32 + 8 * fq;
#pragma unroll
            for (int ai = 0; ai < 2; ++ai)
#pragma unroll
                for (int m = 0; m < 4; ++m) { bf16_t* rowp = base + (size_t)(row0 + ai * HALF + m * 16) * ld + col0;
                    const f32x4 v0 = acc[ai][bj][m][0], v1 = acc[ai][bj][m][1];
                    u32x4 w; w.x = cvt_pk_bf16(v0[0], v0[1]); w.y = cvt_pk_bf16(v0[2], v0[3]); w.z = cvt_pk_bf16(v1[0], v1[1]); w.w = cvt_pk_bf16(v1[2], v1[3]);
                    *(u32x4*)rowp = w; }
        }
    }
};
struct EpiGateUp {
    static constexpr bool PERM = true, AFTER_DRAIN = false;
    bf16_t* ACT;
    __device__ __forceinline__ void operator()(const f32x4 (&acc)[2][2][4][2], const Unit& u, int wr, int wc, int fr, int fq) const {
        const int row0 = u.pm * BM + wr * 64 + fr, col0 = u.pn * HALF + wc * 32 + 8 * fq;
#pragma unroll
        for (int ai = 0; ai < 2; ++ai)
#pragma unroll
            for (int m = 0; m < 4; ++m) { bf16_t* rowp = ACT + (size_t)(row0 + ai * HALF + m * 16) * 2816 + col0;
                float v[8];
#pragma unroll
                for (int n = 0; n < 2; ++n)
#pragma unroll
                    for (int j = 0; j < 4; ++j) { const float g = acc[ai][0][m][n][j], uu = acc[ai][1][m][n][j]; v[n * 4 + j] = g * __builtin_amdgcn_rcpf(1.f + __expf(-g)) * uu; }
                u32x4 w; w.x = cvt_pk_bf16(v[0], v[1]); w.y = cvt_pk_bf16(v[2], v[3]); w.z = cvt_pk_bf16(v[4], v[5]); w.w = cvt_pk_bf16(v[6], v[7]);
                *(u32x4*)rowp = w; }
    }
};
template <class Epi, class Sched, bool STAMP = false>
__device__ __forceinline__ void gemm_phase(PG8_LAS unsigned char* lds, const Gemm g, const Sched& S, const Epi& E, unsigned long long* stamps) {
    const int tid = threadIdx.x, wid = __builtin_amdgcn_readfirstlane(tid >> 6), lane = tid & 63, wr = wid >> 2, wc = wid & 3, fr = lane & 15, fq = lane >> 4;
    const int K = g.K, nt = K / BK;
    int ts_lo = 0, ts_hi = 0, nts = 0; const unsigned long long rt_entry = STAMP ? (unsigned long long)wall_clock64() : 0ull;
#define PG8_STAMP() do { if (STAMP && wid == 0 && nts < 64) { const unsigned long long _c = (unsigned long long)clock64(); \
        ts_lo = (lane == nts) ? (int)(unsigned)_c : ts_lo; ts_hi = (lane == nts) ? (int)(unsigned)(_c >> 32) : ts_hi; ++nts; } } while (0)
    PG8_STAMP();
    unsigned voffA[2], voffB[2];
#pragma unroll
    for (int i = 0; i < 2; ++i) { int R, C; stage_rc(tid * 16 + i * 8192, R, C); const int Rb = Epi::PERM ? ((R & ~31) + perm32(R & 31)) : R;
        voffA[i] = (unsigned)(R * K + C) * 2u; voffB[i] = (unsigned)(Rb * K + C) * 2u; }
    const size_t kstep = (size_t)(BK * 2);
    const size_t hstep = (size_t)HALF * K * 2;
    const size_t tstep = 2 * hstep;
    const unsigned ldsw = (unsigned)wid * 1024u;
    const int aoff = lds_byte(wr * 64 + fr, fq * 8), boff = lds_byte(wc * 32 + fr, fq * 8);
#define PG8_SA(b, h) (((b) * 2 + (h)) * HTB)
#define PG8_SB(b, h) ((4 + (b) * 2 + (h)) * HTB)
#define PG8_STAGE(bufoff, gbase, voff) do { _Pragma("unroll") for (int _i = 0; _i < 2; ++_i) \
        __builtin_amdgcn_global_load_lds((const unsigned*)((const char*)(gbase) + (voff)[_i]), (PG8_LAS unsigned*)(lds + (bufoff) + ldsw + _i * 8192), 16, 0, 0); } while (0)
#define PG8_LDA(dst, b, h) do { _Pragma("unroll") for (int m = 0; m < 4; ++m) _Pragma("unroll") for (int k = 0; k < 2; ++k) dst[m][k] = *(const PG8_LAS bf16x8*)(lds + PG8_SA(b, h) + aoff + m * 2048 + k * 1024); } while (0)
#define PG8_LDB(dst, b, h) do { _Pragma("unroll") for (int n = 0; n < 2; ++n) _Pragma("unroll") for (int k = 0; k < 2; ++k) dst[n][k] = *(const PG8_LAS bf16x8*)(lds + PG8_SB(b, h) + boff + n * 2048 + k * 1024); } while (0)
#define PG8_MMA(ai, bj, At, Bt) do { __builtin_amdgcn_s_setprio(1); _Pragma("unroll") for (int m = 0; m < 4; ++m) _Pragma("unroll") for (int n = 0; n < 2; ++n) _Pragma("unroll") for (int k = 0; k < 2; ++k) \
        acc[ai][bj][m][n] = __builtin_amdgcn_mfma_f32_16x16x32_bf16(Bt[n][k], At[m][k], acc[ai][bj][m][n], 0, 0, 0); __builtin_amdgcn_s_setprio(0); } while (0)
#define PG8_WAIT_V(n) asm volatile("s_waitcnt vmcnt(" #n ")" ::: "memory")
#define PG8_WAIT_L(n) asm volatile("s_waitcnt lgkmcnt(" #n ")" ::: "memory")
#define PG8_BAR __builtin_amdgcn_s_barrier()
#define PG8_SCHED __builtin_amdgcn_sched_barrier(0)
    Unit cur, nxt; int ui = 0;
    if (!S.next(0, cur)) return;
    f32x4 acc[2][2][4][2];
#pragma unroll
    for (int a = 0; a < 2; ++a)
#pragma unroll
        for (int b = 0; b < 2; ++b)
#pragma unroll
            for (int m = 0; m < 4; ++m)
#pragma unroll
                for (int n = 0; n < 2; ++n) acc[a][b][m][n] = (f32x4){0.f, 0.f, 0.f, 0.f};
    bf16x8 At[4][2], B0[2][2], B1[2][2];
    const char* cA = (const char*)g.A + (size_t)cur.pm * tstep; const char* cB = (const char*)g.Bt + (size_t)cur.pn * tstep;
    S.a_ready(cur);
    PG8_STAGE(PG8_SB(0, 0), cB, voffB); PG8_STAGE(PG8_SA(0, 0), cA, voffA); PG8_STAGE(PG8_SB(0, 1), cB + hstep, voffB); PG8_STAGE(PG8_SA(0, 1), cA + hstep, voffA);
    if (wr == 1) PG8_BAR;
    PG8_WAIT_V(4); PG8_BAR;
    PG8_STAGE(PG8_SB(1, 0), cB + kstep, voffB); PG8_STAGE(PG8_SA(1, 0), cA + kstep, voffA); PG8_STAGE(PG8_SB(1, 1), cB + hstep + kstep, voffB);
    PG8_WAIT_V(6); PG8_BAR;
    PG8_STAMP();
    for (;;) {
        const bool has_next = S.next(ui + 1, nxt);
        const char* nA = has_next ? (const char*)g.A + (size_t)nxt.pm * tstep : cA; const char* nB = has_next ? (const char*)g.Bt + (size_t)nxt.pn * tstep : cB;
        for (int t = 0; t < nt; t += 2) {
            const bool last = (t == nt - 2);
            const char* a1 = cA + (size_t)(t + 1) * kstep;
            const char* a2 = last ? nA : cA + (size_t)(t + 2) * kstep; const char* b2 = last ? nB : cB + (size_t)(t + 2) * kstep;
            const char* a3 = a2 + kstep; const char* b3 = b2 + kstep;
            if (last && has_next) S.a_ready(nxt);
            PG8_LDB(B0, 0, 0); PG8_SCHED; PG8_LDA(At, 0, 0); PG8_STAGE(PG8_SA(1, 1), a1 + hstep, voffA);
            PG8_WAIT_L(8); PG8_BAR; PG8_WAIT_L(0); PG8_MMA(0, 0, At, B0); PG8_BAR; PG8_SCHED;
            PG8_LDB(B1, 0, 1); PG8_STAGE(PG8_SB(0, 0), b2, voffB);
            PG8_BAR; PG8_WAIT_L(0); PG8_MMA(0, 1, At, B1); PG8_BAR;
            PG8_LDA(At, 0, 1); PG8_STAGE(PG8_SA(0, 0), a2, voffA);
            PG8_BAR; PG8_WAIT_L(0); PG8_MMA(1, 0, At, B0); PG8_BAR; PG8_SCHED;
            PG8_STAGE(PG8_SB(0, 1), b2 + hstep, voffB);
            PG8_WAIT_V(6); PG8_BAR; PG8_MMA(1, 1, At, B1); PG8_BAR;
            PG8_LDB(B0, 1, 0); PG8_SCHED; PG8_LDA(At, 1, 0); PG8_STAGE(PG8_SA(0, 1), a2 + hstep, voffA);
            PG8_WAIT_L(8); PG8_BAR; PG8_WAIT_L(0); PG8_MMA(0, 0, At, B0); PG8_BAR; PG8_SCHED;
            PG8_LDB(B1, 1, 1); PG8_STAGE(PG8_SB(1, 0), b3, voffB);
            PG8_BAR; PG8_WAIT_L(0); PG8_MMA(0, 1, At, B1); PG8_BAR;
            PG8_LDA(At, 1, 1); PG8_STAGE(PG8_SA(1, 0), a3, voffA);
            PG8_BAR; PG8_WAIT_L(0); PG8_MMA(1, 0, At, B0); PG8_BAR; PG8_SCHED;
            PG8_STAGE(PG8_SB(1, 1), b3 + hstep, voffB);
            PG8_WAIT_V(6); PG8_BAR; PG8_MMA(1, 1, At, B1); PG8_BAR;
        }
        PG8_STAMP();
        if constexpr (!Epi::AFTER_DRAIN) { E(acc, cur, wr, wc, fr, fq); S.done(cur); }
        PG8_STAMP();
        if (!has_next) break;
#pragma unroll
        for (int a = 0; a < 2; ++a)
#pragma unroll
            for (int b = 0; b < 2; ++b)
#pragma unroll
                for (int m = 0; m < 4; ++m)
#pragma unroll
                    for (int n = 0; n < 2; ++n) acc[a][b][m][n] = (f32x4){0.f, 0.f, 0.f, 0.f};
        cur = nxt; cA = nA; cB = nB; ++ui;
    }
    PG8_WAIT_V(0);
    if (wr == 0) PG8_BAR;
    PG8_BAR;
    if constexpr (Epi::AFTER_DRAIN) { E.fused(acc, cur, wr, wc, fr, fq, lds, wid, lane); S.done(cur); }
    PG8_STAMP();
    if (STAMP && wid == 0) { stamps[lane] = lane < nts ? (((unsigned long long)(unsigned)ts_hi << 32) | (unsigned)ts_lo) : 0ull;
        if (lane == 62) stamps[62] = rt_entry; if (lane == 63) stamps[63] = (unsigned long long)wall_clock64(); }
#undef PG8_STAMP
#undef PG8_SA
#undef PG8_SB
#undef PG8_STAGE
#undef PG8_LDA
#undef PG8_LDB
#undef PG8_MMA
#undef PG8_WAIT_V
#undef PG8_WAIT_L
#undef PG8_BAR
#undef PG8_SCHED
}
}

DI void phase_gemm_big(const bf16_t* A, const bf16_t* W, int N, int K, bf16_t* C, int ldc, int route, char* ws, unsigned char* lds) {
  pg8::Gemm g{A, W, TP_, N, K};
  pg8::StaticOrder S; S.init(TP_, N, gridDim.x, blockIdx.x);
  pg8::EpiRoute E{C, ldc, route, (bf16_t*)(ws + O_PC), (bf16_t*)(ws + O_PRKV), (bf16_t*)(ws + O_PLOW)};
  pg8::gemm_phase<pg8::EpiRoute, pg8::StaticOrder, false>((PG8_LAS unsigned char*)lds, g, S, E, nullptr);
}
DI void phase_gemm_gateup(const bf16_t* A, const bf16_t* W, bf16_t* ACT, unsigned char* lds) {
  pg8::Gemm g{A, W, TP_, 5632, 1024};
  pg8::StaticOrder S; S.init(TP_, 5632, gridDim.x, blockIdx.x);
  pg8::EpiGateUp E{ACT};
  pg8::gemm_phase<pg8::EpiGateUp, pg8::StaticOrder, false>((PG8_LAS unsigned char*)lds, g, S, E, nullptr);
}

DI void phase_resnorm(const P& p, const float* g1, const float* g2) {
  const int lane = threadIdx.x & 63, gw = (blockIdx.x * NTH + threadIdx.x) >> 6, nw = (gridDim.x * NTH) >> 6;
  bf16_t* HN = (bf16_t*)(p.ws + O_HN);
  for (int sr = gw; sr < T_; sr += nw) {
    float* hr = hrow(p, sr);
    float x[16];
    float ss = 0.f;
#pragma unroll
    for (int q = 0; q < 4; ++q) {
      const uint2 u = *(const uint2*)(HN + (size_t)sr * 1024 + q * 256 + lane * 4);
      x[q * 4] = lo2f(u.x); x[q * 4 + 1] = hi2f(u.x); x[q * 4 + 2] = lo2f(u.y); x[q * 4 + 3] = hi2f(u.y);
      ss += x[q * 4] * x[q * 4] + x[q * 4 + 1] * x[q * 4 + 1] + x[q * 4 + 2] * x[q * 4 + 2] + x[q * 4 + 3] * x[q * 4 + 3];
    }
    f32x4v hh[4];
#pragma unroll
    for (int q = 0; q < 4; ++q) hh[q] = *(const f32x4v*)(hr + q * 256 + lane * 4);
    ss = wave_sum(ss);
    const float rs = rsqrtf(ss * (1.f / 1024.f) + EPS);
    float ss2 = 0.f;
#pragma unroll
    for (int q = 0; q < 4; ++q) {
      const float4 g = *(const float4*)(g1 + q * 256 + lane * 4);
      hh[q].x += x[q * 4 + 0] * rs * g.x; hh[q].y += x[q * 4 + 1] * rs * g.y; hh[q].z += x[q * 4 + 2] * rs * g.z; hh[q].w += x[q * 4 + 3] * rs * g.w;
      *(f32x4v*)(hr + q * 256 + lane * 4) = hh[q];
      ss2 += hh[q].x * hh[q].x + hh[q].y * hh[q].y + hh[q].z * hh[q].z + hh[q].w * hh[q].w;
    }
    if (g2) {
      ss2 = wave_sum(ss2);
      const float rs2 = rsqrtf(ss2 * (1.f / 1024.f) + EPS);
#pragma unroll
      for (int q = 0; q < 4; ++q) {
        const float4 g = *(const float4*)(g2 + q * 256 + lane * 4);
        *(uint2*)(HN + (size_t)sr * 1024 + q * 256 + lane * 4) = make_uint2(pack2(hh[q].x * rs2 * g.x, hh[q].y * rs2 * g.y), pack2(hh[q].z * rs2 * g.z, hh[q].w * rs2 * g.w));
      }
    }
  }
}

DI size_t vta_base(int seq) { return seq < 8 ? (size_t)seq * 256 * 4160 : (size_t)8 * 256 * 4160; }
template <int NC> DI void vt_transpose(const bf16_t* src, int ld, int col0, bf16_t* VT, char* lds) {
  bf16_t* tl = (bf16_t*)lds;
  const int tid = threadIdx.x;
  constexpr int CPT = NC / 8, TPR = 512 / NC, PPT = 64 / TPR;
  for (int it = blockIdx.x; it < 257 + 8 * 65; it += gridDim.x) {
    int seq, kt;
    if (it < 257) { seq = 8; kt = it; } else { const int j = it - 257; seq = j / 65; kt = j - seq * 65; }
    const int L = seq_len(seq), LP = L + 48, sbase = seq_base(seq);
    const size_t vb = (seq < 8 ? (size_t)seq * NC * 4160 : (size_t)8 * NC * 4160);
    __syncthreads();
    const int pl = tid >> 3, part = tid & 7;
    const int pos = 64 * kt + pl - 48;
#pragma unroll
    for (int q = 0; q < CPT / 8; ++q) {
      u32x4 v = (u32x4)(0u);
      if (pos >= 0) v = *(const u32x4*)(src + (size_t)(sbase + pos) * ld + col0 + part * CPT + q * 8);
#pragma unroll
      for (int j = 0; j < 4; ++j) {
        tl[(part * CPT + q * 8 + 2 * j) * 72 + pl] = (bf16_t)(v[j] & 0xffffu);
        tl[(part * CPT + q * 8 + 2 * j + 1) * 72 + pl] = (bf16_t)(v[j] >> 16);
      }
    }
    __syncthreads();
    const int row = tid / TPR, seg = tid % TPR;
    bf16_t* dst = VT + vb + (size_t)row * LP + 64 * kt + seg * PPT;
#pragma unroll
    for (int q = 0; q < PPT / 8; ++q) *(u32x4*)(dst + q * 8) = *(const u32x4*)(tl + row * 72 + seg * PPT + q * 8);
  }
}

DI void phase_prepA(const P& p, char* lds) {
  const int lane = threadIdx.x & 63, wave = threadIdx.x >> 6;
  bf16_t* PROJ = (bf16_t*)(p.ws + O_PROJ0);
  bf16_t* ZB = (bf16_t*)(p.ws + O_ZB);
  const float* WC = (const float*)(p.ws + O_WC);
  vt_transpose<256>(PROJ, 1536, 1024, (bf16_t*)(p.ws + O_VTA), lds);
  __syncthreads();
  float* fl = (float*)lds + wave * 1024;
  const float inv = exp2f(-(float)(lane & 15) * (13.287712379549449f / 16.f));
  const float qg = p.a_q_gain[lane], kg = p.a_k_gain[lane];
  for (int r0 = blockIdx.x * 32; r0 < TP_; r0 += gridDim.x * 32) {
    const int srb = r0 + wave * 4;
#pragma unroll 1
    for (int rr = 0; rr < 4; ++rr) {
      const int sr = srb + rr;
      if (sr < T_) {
        int pos; seq_of(sr, pos);
        float rowf, colf;
        if (pos < 16) { rowf = colf = (float)(pos - 16); }
        else { int t = pos - 16; rowf = (float)(t >> 6); colf = (float)(t & 63); }
        float ang = (lane < 32 ? rowf : colf) * inv;
        float sn, cs;
        sincosf(ang, &sn, &cs);
        const float sgn = (lane & 16) ? sn : -sn;
        bf16_t* pr = PROJ + (size_t)sr * 1536;
        for (int hd = 0; hd < 16; ++hd) {
          float x = bf2f(pr[hd * 64 + lane]);
          float ss = wave_sum(x * x);
          float xn = x * rsqrtf(ss * (1.f / 64.f) + EPS) * (hd < 12 ? qg : kg);
          float pa = __shfl_xor(xn, 16);
          float o = xn * cs + pa * sgn;
          if (hd < 12) o *= 0.125f * LOG2E;
          pr[hd * 64 + lane] = f2bf(o);
        }
        uint2 u = *(const uint2*)(pr + 1280 + lane * 4);
        float f0 = lo2f(u.x), f1 = hi2f(u.x), f2 = lo2f(u.y), f3 = hi2f(u.y);
        float ss = f0 * f0 + f1 * f1 + f2 * f2 + f3 * f3;
        ss += __shfl_xor(ss, 1); ss += __shfl_xor(ss, 2); ss += __shfl_xor(ss, 4); ss += __shfl_xor(ss, 8);
        float rs = rsqrtf(ss * (1.f / 64.f) + EPS);
        float4 g = *(const float4*)(p.b_norm_g + lane * 4);
        *(float4*)(fl + rr * 256 + lane * 4) = make_float4(f0 * rs * g.x, f1 * rs * g.y, f2 * rs * g.z, f3 * rs * g.w);
      } else {
        *(float4*)(fl + rr * 256 + lane * 4) = make_float4(0.f, 0.f, 0.f, 0.f);
      }
    }
    __syncthreads();
    {
      const int g = lane >> 4, o0 = (lane & 15) * 8;
      float acc[4][8];
#pragma unroll
      for (int rr = 0; rr < 4; ++rr)
#pragma unroll
        for (int j = 0; j < 8; ++j) acc[rr][j] = 0.f;
      const float* wc = WC + (size_t)g * 64 * 128 + o0;
#pragma unroll 4
      for (int c = 0; c < 64; ++c) {
        const float4 w0 = *(const float4*)(wc + c * 128), w1 = *(const float4*)(wc + c * 128 + 4);
#pragma unroll
        for (int rr = 0; rr < 4; ++rr) {
          const float f = fl[rr * 256 + g * 64 + c];
          acc[rr][0] += f * w0.x; acc[rr][1] += f * w0.y; acc[rr][2] += f * w0.z; acc[rr][3] += f * w0.w;
          acc[rr][4] += f * w1.x; acc[rr][5] += f * w1.y; acc[rr][6] += f * w1.z; acc[rr][7] += f * w1.w;
        }
      }
#pragma unroll
      for (int rr = 0; rr < 4; ++rr)
        if (srb + rr < T_)
          *(uint4*)(ZB + (size_t)(srb + rr) * 512 + g * 128 + o0) = make_uint4(pack2(acc[rr][0], acc[rr][1]), pack2(acc[rr][2], acc[rr][3]), pack2(acc[rr][4], acc[rr][5]), pack2(acc[rr][6], acc[rr][7]));
    }
    __syncthreads();
  }
}

template <int MODE>
DI void flash_item(const bf16_t* __restrict__ Q, int ldq, const bf16_t* __restrict__ Kb, int ldk, const bf16_t* __restrict__ Vt, int LP,
                   bf16_t* O, int ldo, int sbase, int S, int qt, float sinkl2, char* lds) {
  const int tid = threadIdx.x & 255, lane = tid & 63, wave = tid >> 6, l31 = lane & 31, h = lane >> 5;
  bf16_t* Ks = (bf16_t*)lds;
  bf16_t* Vs = Ks + 2 * 64 * 72;
  const int rl = wave * 32 + l31;
  const int qpos = qt == 0 ? (rl < 16 ? rl : 15) : 16 + 128 * (qt - 1) + rl;
  const bool qvalid = qt > 0 || rl < 16;
  bf16x8 qf[4];
  {
    const bf16_t* qr = Q + (size_t)(sbase + qpos) * ldq;
#pragma unroll
    for (int s = 0; s < 4; ++s) qf[s] = *(const bf16x8*)(qr + 16 * s + 8 * h);
  }
  const int nkt_all = (S + 64) / 64;
  int klo = 1, n;
  if (MODE == 0) { n = nkt_all; }
  else {
    if (qt == 0) { klo = 1; n = 3; }
    else {
      int c = qt - 1;
      klo = 2 * c - 1; if (klo < 1) klo = 1;
      int khi = 2 * c + 4; if (khi > nkt_all - 1) khi = nkt_all - 1;
      n = 1 + (khi - klo + 1);
    }
  }
  const int ldr = tid >> 2, ldp = (tid & 3) * 16;
  u32x4 rk0, rk1, rv0, rv1;
  auto ktile = [&](int idx) { return idx == 0 ? 0 : klo + idx - 1; };
#define FL_GLOAD(idx)                                                                               \
  {                                                                                                 \
    int kt_ = ktile(idx);                                                                           \
    int pos_ = 64 * kt_ + ldr - 48;                                                                 \
    if (pos_ >= 0) {                                                                                \
      const bf16_t* kp_ = Kb + (size_t)(sbase + pos_) * ldk + ldp;                                  \
      rk0 = *(const u32x4*)kp_; rk1 = *(const u32x4*)(kp_ + 8);                                 \
    } else { rk0 = (u32x4)(0u); rk1 = rk0; }                                       \
    const bf16_t* vp_ = Vt + (size_t)ldr * LP + 64 * kt_ + ldp;                                     \
    rv0 = *(const u32x4*)vp_; rv1 = *(const u32x4*)(vp_ + 8);                                   \
  }
#define FL_SSTORE(buf)                                                                              \
  {                                                                                                 \
    *(u32x4*)(Ks + (buf) * 64 * 72 + ldr * 72 + ldp) = rk0; *(u32x4*)(Ks + (buf) * 64 * 72 + ldr * 72 + ldp + 8) = rk1; \
    { bf16_t* vd_ = Vs + (buf) * 64 * 68 + ldr * 68 + ldp; *(uint2*)vd_ = make_uint2(rv0.x, rv0.y); *(uint2*)(vd_ + 4) = make_uint2(rv0.z, rv0.w); *(uint2*)(vd_ + 8) = make_uint2(rv1.x, rv1.y); *(uint2*)(vd_ + 12) = make_uint2(rv1.z, rv1.w); } \
  }
  f32x16 oacc[2];
#pragma unroll
  for (int i = 0; i < 16; ++i) { oacc[0][i] = 0.f; oacc[1][i] = 0.f; }
  float m = MODE == 1 ? -1e30f : 0.f, l = 0.f;
  FL_GLOAD(0)
  FL_SSTORE(0)
  __syncthreads();
  for (int idx = 0; idx < n; ++idx) {
    const int cur = idx & 1;
    if (idx + 1 < n) FL_GLOAD(idx + 1)
    const int kt = ktile(idx);
    const bf16_t* ks = Ks + cur * 64 * 72;
    const bf16_t* vs = Vs + cur * 64 * 68;
    f32x16 sacc[2];
    {
      bf16x8 kf[2][4];
#pragma unroll
      for (int t = 0; t < 2; ++t)
#pragma unroll
        for (int s = 0; s < 4; ++s) kf[t][s] = *(const bf16x8*)(ks + (32 * t + l31) * 72 + 16 * s + 8 * h);
#pragma unroll
      for (int t = 0; t < 2; ++t)
#pragma unroll
        for (int i = 0; i < 16; ++i) sacc[t][i] = 0.f;
      __builtin_amdgcn_sched_barrier(0);
#pragma unroll
      for (int s = 0; s < 4; ++s)
#pragma unroll
        for (int t = 0; t < 2; ++t) sacc[t] = MFMA32(kf[t][s], qf[s], sacc[t]);
    }
    bf16x8 vfr[2][2][2];
#pragma unroll
    for (int t = 0; t < 2; ++t)
#pragma unroll
      for (int s2 = 0; s2 < 2; ++s2)
#pragma unroll
        for (int dt = 0; dt < 2; ++dt) {
          const bf16_t* vp = vs + (32 * dt + l31) * 68 + 32 * t + 16 * s2 + 4 * h;
          uint2 lo = *(const uint2*)vp, hi = *(const uint2*)(vp + 8);
          u32x4 v4 = {lo.x, lo.y, hi.x, hi.y};
          vfr[t][s2][dt] = __builtin_bit_cast(bf16x8, v4);
        }
    __builtin_amdgcn_sched_barrier(0);
    if (kt == 0) {
#pragma unroll
      for (int t = 0; t < 2; ++t)
#pragma unroll
        for (int i = 0; i < 16; ++i) {
          int kl = 32 * t + (i & 3) + 8 * (i >> 2) + 4 * h;
          if (kl < 48) sacc[t][i] = -1e30f;
        }
    } else if (MODE == 1) {
#pragma unroll
      for (int t = 0; t < 2; ++t)
#pragma unroll
        for (int i = 0; i < 16; ++i) {
          int kl = 32 * t + (i & 3) + 8 * (i >> 2) + 4 * h;
          int tk = 64 * (kt - 1) + kl;
          bool vis;
          if (qt == 0) vis = tk <= 112 + qpos;
          else { int tq = qpos - 16; int d = tq - tk; vis = d <= 128 && d >= -128; }
          if (!vis) sacc[t][i] = -1e30f;
        }
    }
    float tmax = -1e30f;
    if (MODE == 1) {
#pragma unroll
      for (int t = 0; t < 2; ++t)
#pragma unroll
        for (int i = 0; i < 16; ++i) tmax = fmaxf(tmax, sacc[t][i]);
      tmax = fmaxf(tmax, __shfl_xor(tmax, 32));
    }
    if (MODE == 1 && __builtin_amdgcn_ballot_w64(tmax > m) != 0ull) {
      const float mn = fmaxf(m, tmax);
      const float alpha = __builtin_amdgcn_exp2f(m - mn);
      m = mn;
      l *= alpha;
#pragma unroll
      for (int i = 0; i < 16; ++i) { oacc[0][i] *= alpha; oacc[1][i] *= alpha; }
    }
    const f32x2 m2 = {m, m};
    f32x2 ls2 = {0.f, 0.f};
    unsigned pk[2][8];
#pragma unroll
    for (int t = 0; t < 2; ++t)
#pragma unroll
      for (int i2 = 0; i2 < 8; ++i2) {
        f32x2 d = {sacc[t][2 * i2], sacc[t][2 * i2 + 1]};
        if (MODE == 1) d = d - m2;
        f32x2 e = {__builtin_amdgcn_exp2f(d.x), __builtin_amdgcn_exp2f(d.y)};
        ls2 += e;
        pk[t][i2] = __builtin_bit_cast(unsigned, __builtin_convertvector(e, bf16x2_t));
      }
    l += ls2.x + ls2.y;
#pragma unroll
    for (int t = 0; t < 2; ++t)
#pragma unroll
      for (int s2 = 0; s2 < 2; ++s2) {
        u32x4 pk4 = {pk[t][4 * s2], pk[t][4 * s2 + 1], pk[t][4 * s2 + 2], pk[t][4 * s2 + 3]};
        bf16x8 pf = __builtin_bit_cast(bf16x8, pk4);
#pragma unroll
        for (int dt = 0; dt < 2; ++dt) oacc[dt] = MFMA32(vfr[t][s2][dt], pf, oacc[dt]);
      }
    if (idx + 1 < n) FL_SSTORE(cur ^ 1)
    __syncthreads();
  }
  l += __shfl_xor(l, 32);
  if (MODE == 1) l += __builtin_amdgcn_exp2f(sinkl2 - m);
  const float il = 1.f / l;
  if (qvalid) {
    bf16_t* orow = O + (size_t)(sbase + qpos) * ldo;
#pragma unroll
    for (int dt = 0; dt < 2; ++dt)
#pragma unroll
      for (int g = 0; g < 4; ++g) {
        int d = 32 * dt + 8 * g + 4 * h;
        uint2 o = make_uint2(pack2(oacc[dt][4 * g] * il, oacc[dt][4 * g + 1] * il), pack2(oacc[dt][4 * g + 2] * il, oacc[dt][4 * g + 3] * il));
        *(uint2*)(orow + d) = o;
      }
  }
#undef FL_GLOAD
#undef FL_SSTORE
}

DI void dft4(float& r0, float& i0, float& r1, float& i1, float& r2, float& i2, float& r3, float& i3) {
  const float t0r = r0 + r2, t0i = i0 + i2, t1r = r0 - r2, t1i = i0 - i2;
  const float t2r = r1 + r3, t2i = i1 + i3, t3r = i1 - i3, t3i = r3 - r1;
  r0 = t0r + t2r; i0 = t0i + t2i; r1 = t1r + t3r; i1 = t1i + t3i; r2 = t0r - t2r; i2 = t0i - t2i; r3 = t1r - t3r; i3 = t1i - t3i;
}
DI void dft16(float (&zr)[16], float (&zi)[16]) {
#pragma unroll
  for (int b = 0; b < 4; ++b) dft4(zr[b], zi[b], zr[4 + b], zi[4 + b], zr[8 + b], zi[8 + b], zr[12 + b], zi[12 + b]);
  constexpr float C1 = 0.9238795325112867f, S1 = 0.3826834323650898f, C2 = 0.7071067811865476f;
  const float wr[10] = {1.f, C1, C2, S1, 0.f, 0.f, -C2, 0.f, 0.f, -C1};
  const float wi[10] = {0.f, -S1, -C2, -C1, -1.f, 0.f, -C2, 0.f, 0.f, S1};
#pragma unroll
  for (int q = 1; q < 4; ++q)
#pragma unroll
    for (int b = 1; b < 4; ++b) {
      const float c = wr[b * q], d = wi[b * q];
      const float xr = zr[4 * q + b], xi = zi[4 * q + b];
      zr[4 * q + b] = xr * c - xi * d; zi[4 * q + b] = xr * d + xi * c;
    }
#pragma unroll
  for (int q = 0; q < 4; ++q) dft4(zr[4 * q], zi[4 * q], zr[4 * q + 1], zi[4 * q + 1], zr[4 * q + 2], zi[4 * q + 2], zr[4 * q + 3], zi[4 * q + 3]);
}

DI size_t y_base(int seq) { return seq < 8 ? (size_t)seq * 16 * 256 * 576 : (size_t)8 * 16 * 256 * 576; }
DI void phase_attnA(const P& p, char* lds) {
  const bf16_t* PROJ = (const bf16_t*)(p.ws + O_PROJ0);
  const bf16_t* VT = (const bf16_t*)(p.ws + O_VTA);
  bf16_t* MIX = (bf16_t*)(p.ws + O_MIX);
  const int nS = 129 * 6, nP = 8 * 33 * 6;
  const int sb = threadIdx.x >> 8;
  unsigned* head = (unsigned*)(p.ws + O_CNT);
  for (;;) {
    if (threadIdx.x == 0) *(volatile int*)(lds + 2 * 36864) = (int)__hip_atomic_fetch_add(head, 1u, __ATOMIC_RELAXED, __HIP_MEMORY_SCOPE_AGENT);
    __syncthreads();
    const int it = *(volatile int*)(lds + 2 * 36864);
    __syncthreads();
    if (it >= nS + nP) break;
    int seq, qt, hq;
    if (it < nS) { seq = 8; hq = (it % 6) * 2 + sb; qt = it / 6; }
    else { int j = it - nS; hq = (j % 6) * 2 + sb; j /= 6; qt = j % 33; seq = j / 33; }
    const int kv = hq / 3;
    const int L = seq_len(seq), LP = L + 48;
    flash_item<0>(PROJ + hq * 64, 1536, PROJ + 768 + kv * 64, 1536, VT + vta_base(seq) + (size_t)kv * 64 * LP, LP,
                  MIX + hq * 64, 1024, seq_base(seq), L - 16, qt, 0.f, lds + sb * 36864);
  }
  const bf16_t* ZB = (const bf16_t*)(p.ws + O_ZB);
  bf16_t* Y = (bf16_t*)(p.ws + O_Y);
  const int lane = threadIdx.x & 63, wave = threadIdx.x >> 6;
  const int nI_S = 17 * 16, nI_P = 8 * 5 * 16;
  for (int it = blockIdx.x; it < nI_S + nI_P; it += gridDim.x) {
    int seq, nb, cb;
    if (it < nI_S) { seq = 8; cb = it & 15; nb = it >> 4; }
    else { int j = it - nI_S; cb = j & 15; j >>= 4; nb = j % 5; seq = j / 5; }
    const int M = seq < 8 ? 257 : 1025, KP = seq < 8 ? 576 : 2112, L = 16 * M;
    const int n2 = nb * 64 + lane;
    const int ch = cb * 16 + wave * 2;
    const int g = ch >> 6, d = ch & 63;
    bf16_t* yb = Y + y_base(seq);
    if (n2 < M) {
      float ar[16], ai[16], br[16], bi[16];
#pragma unroll
      for (int n1 = 0; n1 < 16; ++n1) {
        const bf16_t* zp = ZB + (size_t)(seq_base(seq) + M * n1 + n2) * 512 + g * 128 + d;
        unsigned re = *(const unsigned*)zp, im = *(const unsigned*)(zp + 64);
        ar[n1] = lo2f(re); br[n1] = hi2f(re); ai[n1] = lo2f(im); bi[n1] = hi2f(im);
      }
      dft16(ar, ai);
      dft16(br, bi);
      float t1s, t1c;
      sincospif(-2.f * (float)n2 / (float)L, &t1s, &t1c);
      float tc = 1.f, ts = 0.f;
#pragma unroll
      for (int k1 = 0; k1 < 16; ++k1) {
        const int ix = 4 * (k1 & 3) + (k1 >> 2);
        const float yr0 = ar[ix] * tc - ai[ix] * ts, yi0 = ar[ix] * ts + ai[ix] * tc;
        const float yr1 = br[ix] * tc - bi[ix] * ts, yi1 = br[ix] * ts + bi[ix] * tc;
        bf16_t* y0 = yb + ((size_t)k1 * 256 + ch) * KP;
        y0[n2] = f2bf(yr0); y0[M + n2] = f2bf(yi0);
        y0[KP + n2] = f2bf(yr1); y0[KP + M + n2] = f2bf(yi1);
        const float nc = tc * t1c - ts * t1s; ts = tc * t1s + ts * t1c; tc = nc;
      }
    } else if (n2 < KP - M) {
      for (int k1 = 0; k1 < 16; ++k1) {
        bf16_t* y0 = yb + ((size_t)k1 * 256 + ch) * KP;
        y0[M + n2] = 0; y0[KP + M + n2] = 0;
      }
    }
  }
}

DI void phase_fnet_gemm(const P& p, char* lds) {
  GEMM_IDS
  bf16_t* MIX = (bf16_t*)(p.ws + O_MIX);
  const bf16_t* Y = (const bf16_t*)(p.ws + O_Y);
  const int nS = 16 * 9 * 2, nP = 8 * 16 * 3 * 2;
  const int sb = threadIdx.x >> 8;
  for (int it0 = blockIdx.x * 2; it0 < nS + nP; it0 += gridDim.x * 2) {
    const int it = it0 + sb;
    int seq, k1, tm, tn;
    if (it < nS) { seq = 8; tn = it & 1; int j = it >> 1; tm = j % 9; k1 = j / 9; }
    else { int j = it - nS; tn = j & 1; j >>= 1; tm = j % 3; j /= 3; k1 = j & 15; seq = j >> 4; }
    const int M = seq < 8 ? 257 : 1025, KP = seq < 8 ? 576 : 2112, L = 16 * M;
    const bf16_t* dm = (const bf16_t*)(p.ws + (seq < 8 ? O_DM257 : O_DM1025));
    f32x16 acc[2][2];
    gemm_tile(dm + (size_t)tm * 128 * KP, KP, Y + y_base(seq) + ((size_t)k1 * 256 + tn * 128) * KP, KP, KP, lds + sb * 36864, acc);
    const float scale = rsqrtf(64.f * (float)L);
#pragma unroll
    for (int mt = 0; mt < 2; ++mt)
#pragma unroll
      for (int nt = 0; nt < 2; ++nt)
#pragma unroll
        for (int i = 0; i < 16; ++i) {
          int k2 = tm * 128 + ACC_ROW(mt, i), ch = tn * 128 + ACC_COL(nt);
          if (k2 < M) {
            int pos = k1 + 16 * k2;
            MIX[(size_t)(seq_base(seq) + pos) * 1024 + 768 + ch] = f2bf(acc[mt][nt][i] * scale + p.b_b[ch]);
          }
        }
  }
}

DI size_t vtc_base(int seq) { return seq < 8 ? (size_t)seq * 128 * 4160 : (size_t)8 * 128 * 4160; }
DI void phase_prepC(const P& p, char* lds) {
  const int gtid = blockIdx.x * NTH + threadIdx.x, gsz = gridDim.x * NTH;
  const int lane = threadIdx.x & 63, gw = gtid >> 6, nw = gsz >> 6;
  bf16_t* PC = (bf16_t*)(p.ws + O_PC);
  bf16_t* VT = (bf16_t*)(p.ws + O_VTC);
  const bf16_t* PLOW = (const bf16_t*)(p.ws + O_PLOW);
  bf16_t* LR = (bf16_t*)(p.ws + O_LR);
  vt_transpose<128>(PC, 768, 640, VT, lds);
  for (int sr = gw; sr < T_; sr += nw) {
    int pos; int b = seq_of(sr, pos);
    const int L = seq_len(b), LP = L + 48;
    bf16_t* pr = PC + (size_t)sr * 768;
    float cs[8], sn[8];
#pragma unroll
    for (int j = 0; j < 8; ++j) sincosf((float)pos * exp2f(-(float)j * (18.931568569324174f / 8.f)), &sn[j], &cs[j]);
#pragma unroll
    for (int part = 0; part < 2; ++part) {
      const bool act = part == 0 || lane < 16;
      const int col = part * 512 + (act ? lane : 0) * 8;
      uint4 u = *(const uint4*)(pr + col);
      float e[8] = {lo2f(u.x), hi2f(u.x), lo2f(u.y), hi2f(u.y), lo2f(u.z), hi2f(u.z), lo2f(u.w), hi2f(u.w)};
      float o[8];
#pragma unroll
      for (int j = 0; j < 8; ++j) {
        float pa = __shfl_xor(e[j], 1);
        float rot = e[j] * cs[j] + pa * ((lane & 1) ? sn[j] : -sn[j]);
        o[j] = (lane & 7) < 2 ? rot : e[j];
        if (part == 0) o[j] *= 0.125f * LOG2E;
      }
      if (act) *(uint4*)(pr + col) = make_uint4(pack2(o[0], o[1]), pack2(o[2], o[3]), pack2(o[4], o[5]), pack2(o[6], o[7]));
    }
#pragma unroll
    for (int q = 0; q < 6; ++q) {
      int c = q * 64 + lane;
      float u = bf2f(PLOW[(size_t)sr * 384 + c]);
      float up = pos > 0 ? bf2f(PLOW[(size_t)(sr - 1) * 384 + c]) : 0.f;
      float un = pos < L - 1 ? bf2f(PLOW[(size_t)(sr + 1) * 384 + c]) : 0.f;
      float us = u + p.mu_prev[1536 + c] * (up - u) + p.mu_next[1536 + c] * (un - u);
      float v = c < 128 ? tanhf(us) : (c < 256 ? us : sigmoidf_(us));
      LR[(size_t)sr * 384 + c] = f2bf(v);
    }
  }
}

DI void phase_attnC(const P& p, char* lds) {
  const bf16_t* PC = (const bf16_t*)(p.ws + O_PC);
  const bf16_t* VT = (const bf16_t*)(p.ws + O_VTC);
  bf16_t* MIX = (bf16_t*)(p.ws + O_MIX);
  const int nS = 129 * 4, nP = 8 * 33 * 4;
  const int sb = threadIdx.x >> 8;
  for (int it = blockIdx.x; it < nS + nP; it += gridDim.x) {
    int seq, qt, hq;
    if (it < nS) { seq = 8; hq = (it & 3) * 2 + sb; qt = it >> 2; }
    else { int j = it - nS; hq = (j & 3) * 2 + sb; j >>= 2; qt = j % 33; seq = j / 33; }
    const int kv = hq >> 2;
    const int L = seq_len(seq), LP = L + 48;
    flash_item<1>(PC + hq * 64, 768, PC + 512 + kv * 64, 768, VT + vtc_base(seq) + (size_t)kv * 64 * LP, LP,
                  MIX + hq * 64, 1024, seq_base(seq), L - 16, qt, p.c_sink[hq] * LOG2E, lds + sb * 36864);
  }
}

DI void chunk_decode(int cg_, int& seq, int& c) {
  if (cg_ < 136) { seq = cg_ / 17; c = cg_ - seq * 17; } else { seq = 8; c = cg_ - 136; }
}
DI float shiftv(const bf16_t* PRKV, int sr, int pos, int L, int col, float mp, float mn) {
  float u = bf2f(PRKV[(size_t)sr * 1536 + col]);
  float up = pos > 0 ? bf2f(PRKV[(size_t)(sr - 1) * 1536 + col]) : 0.f;
  float un = pos < L - 1 ? bf2f(PRKV[(size_t)(sr + 1) * 1536 + col]) : 0.f;
  return u + mp * (up - u) + mn * (un - u);
}
enum { VW = 0, VA = 1, VB = 2, VK = 3, VV = 4, VR = 5 };
#define DPP_FMAC(acc, x, y, N) asm("v_fmac_f32_dpp %0, %1, %2 row_newbcast:%3 row_mask:0xf bank_mask:0xf" : "+v"(acc) : "v"(x), "v"(y), "n"(N))
#define DPP_MUL(sv_, x, N) asm("v_mul_f32_dpp %0, %1, %0 row_newbcast:%2 row_mask:0xf bank_mask:0xf" : "+v"(sv_) : "v"(x), "n"(N))
template <int N> DI void dpp_dot4(float& a0, float& a1, float& a2, float& a3, const float (&S)[64], const float4& x) {
  DPP_FMAC(a0, x.x, S[N], N); DPP_FMAC(a1, x.y, S[16 + N], N); DPP_FMAC(a2, x.z, S[32 + N], N); DPP_FMAC(a3, x.w, S[48 + N], N);
  if constexpr (N < 15) dpp_dot4<N + 1>(a0, a1, a2, a3, S, x);
}
template <int N, bool HASV, bool OUT> DI void dpp_upd4(float (&S)[64], const float4& xb, const float4& xk, const float4& xr, float sa, float vi,
                                                       float& o0, float& o1, float& o2, float& o3) {
  DPP_FMAC(S[N], xb.x, sa, N); DPP_FMAC(S[16 + N], xb.y, sa, N); DPP_FMAC(S[32 + N], xb.z, sa, N); DPP_FMAC(S[48 + N], xb.w, sa, N);
  if (HASV) { DPP_FMAC(S[N], xk.x, vi, N); DPP_FMAC(S[16 + N], xk.y, vi, N); DPP_FMAC(S[32 + N], xk.z, vi, N); DPP_FMAC(S[48 + N], xk.w, vi, N); }
  if (OUT) { DPP_FMAC(o0, xr.x, S[N], N); DPP_FMAC(o1, xr.y, S[16 + N], N); DPP_FMAC(o2, xr.z, S[32 + N], N); DPP_FMAC(o3, xr.w, S[48 + N], N); }
  if constexpr (N < 15) dpp_upd4<N + 1, HASV, OUT>(S, xb, xk, xr, sa, vi, o0, o1, o2, o3);
}
template <int N> DI void dpp_scale4(float (&S)[64], const float4& xg) {
  DPP_MUL(S[N], xg.x, N); DPP_MUL(S[16 + N], xg.y, N); DPP_MUL(S[32 + N], xg.z, N); DPP_MUL(S[48 + N], xg.w, N);
  if constexpr (N < 15) dpp_scale4<N + 1>(S, xg);
}
template <int NST, bool HASV, bool OUT, class F>
DI void scan_steps(float (&S)[64], const float* sv, int ns, int lane, F&& emit) {
  const int l15 = lane & 15;
  (void)ns;
#pragma unroll 4
  for (int s = 0; s < NST; ++s) {
    const float4 xa = *(const float4*)(sv + VA * NST * 64 + s * 64 + l15 * 4);
    const float4 xb = *(const float4*)(sv + VB * NST * 64 + s * 64 + l15 * 4);
    float4 xk = xb, xr = xb;
    if (HASV) xk = *(const float4*)(sv + VK * NST * 64 + s * 64 + l15 * 4);
    if (OUT) xr = *(const float4*)(sv + VR * NST * 64 + s * 64 + l15 * 4);
    const float vi = HASV ? sv[VV * NST * 64 + s * 64 + lane] : 0.f;
    float sa0 = 0.f, sa1 = 0.f, sa2 = 0.f, sa3 = 0.f;
    dpp_dot4<0>(sa0, sa1, sa2, sa3, S, xa);
    const float sa = (sa0 + sa1) + (sa2 + sa3);
    float o0 = 0.f, o1 = 0.f, o2 = 0.f, o3 = 0.f;
    dpp_upd4<0, HASV, OUT>(S, xb, xk, xr, sa, vi, o0, o1, o2, o3);
    if (OUT) emit(s, (o0 + o1) + (o2 + o3));
    if ((s & 7) == 7) {
      const float4 xg = *(const float4*)(sv + VW * NST * 64 + (s >> 3) * 64 + l15 * 4);
      dpp_scale4<0>(S, xg);
    }
  }
}
DI int vperm(int j) { return (j & 15) * 4 + (j >> 4); }

DI void shift8(const bf16_t* PRKV, const P& p, int sbase, int pos, int L, int off, int c0, float (&out)[8]) {
  const bf16_t* rp = PRKV + (size_t)(sbase + pos) * 1536 + off + c0;
  const u32x4 uc = *(const u32x4*)rp;
  u32x4 up = (u32x4)(0u), un = (u32x4)(0u);
  if (pos > 0) up = *(const u32x4*)(rp - 1536);
  if (pos < L - 1) un = *(const u32x4*)(rp + 1536);
  const f32x4v mp0 = *(const f32x4v*)(p.mu_prev + off + c0), mp1 = *(const f32x4v*)(p.mu_prev + off + c0 + 4);
  const f32x4v mn0 = *(const f32x4v*)(p.mu_next + off + c0), mn1 = *(const f32x4v*)(p.mu_next + off + c0 + 4);
#pragma unroll
  for (int e2 = 0; e2 < 4; ++e2) {
    const float c_lo = lo2f(uc[e2]), c_hi = hi2f(uc[e2]);
    const float mpl = e2 < 2 ? mp0[2 * e2] : mp1[2 * e2 - 4], mph = e2 < 2 ? mp0[2 * e2 + 1] : mp1[2 * e2 - 3];
    const float mnl = e2 < 2 ? mn0[2 * e2] : mn1[2 * e2 - 4], mnh = e2 < 2 ? mn0[2 * e2 + 1] : mn1[2 * e2 - 3];
    out[2 * e2] = c_lo + mpl * (lo2f(up[e2]) - c_lo) + mnl * (lo2f(un[e2]) - c_lo);
    out[2 * e2 + 1] = c_hi + mph * (hi2f(up[e2]) - c_hi) + mnh * (hi2f(un[e2]) - c_hi);
  }
}

template <int NST, bool P3>
DI void scan_prologue8(const P& p, int sbase, int L, int hd, int dir, int pos0, int nsteps, int sb0, float* sv) {
  const int lane = threadIdx.x & 63, l31 = lane & 31, h = lane >> 5;
  const bf16_t* PRKV = (const bf16_t*)(p.ws + O_PRKV);
  const bf16_t* LR = (const bf16_t*)(p.ws + O_LR);
  const bf16_t* WUPT = (const bf16_t*)(p.ws + O_WUPT) + (size_t)(dir * 512 + hd * 64) * 64;
  const bf16_t* AUPT = (const bf16_t*)(p.ws + O_AUPT) + (size_t)(dir * 512 + hd * 64) * 64;
  float* bonus = (float*)(p.ws + O_BONUS);
  {
    int sl = sb0 + (l31 & 7); if (sl > nsteps - 1) sl = nsteps - 1;
    const int pos = dir ? pos0 - sl : pos0 + sl;
    const bf16_t* lrp = LR + (size_t)(sbase + pos) * 384 + dir * 64 + 8 * h;
#pragma unroll 1
    for (int mat = 0; mat < 2; ++mat) {
      const bf16_t* Wm = mat ? AUPT : WUPT;
      const float* bias = mat ? p.d_a0 : p.d_w0;
      f32x16 ac[2];
#pragma unroll
      for (int nt = 0; nt < 2; ++nt)
#pragma unroll
        for (int i = 0; i < 16; ++i) ac[nt][i] = 0.f;
#pragma unroll
      for (int ks = 0; ks < 4; ++ks) {
        const bf16x8 fa = *(const bf16x8*)(lrp + mat * 128 + 16 * ks);
#pragma unroll
        for (int nt = 0; nt < 2; ++nt) {
          const bf16x8 bw = *(const bf16x8*)(Wm + (size_t)(32 * nt + l31) * 64 + 16 * ks + 8 * h);
          ac[nt] = MFMA32(fa, bw, ac[nt]);
        }
      }
#pragma unroll
      for (int nt = 0; nt < 2; ++nt) {
        const int j = 32 * nt + l31;
        const float b0 = bias[dir * 512 + hd * 64 + j];
#pragma unroll
        for (int i = 0; i < 4; ++i) {
          const int st = sb0 + i + 4 * h;
          const float sg = 1.f / (1.f + __expf(-(b0 + ac[nt][i])));
          if (mat) sv[VK * NST * 64 + st * 64 + j] = sg;
          else ac[nt][i] = __expf(-0.6065306597126334f * sg);
        }
        if (!mat) {
          float g0 = ac[nt][0], g1 = g0 * ac[nt][1], g2 = g1 * ac[nt][2], g3 = g2 * ac[nt][3];
          const float tot_lo = __shfl(g3, l31);
          if (h) { g0 *= tot_lo; g1 *= tot_lo; g2 *= tot_lo; g3 *= tot_lo; }
          float* gd = sv + VA * NST * 64 + (sb0 + 4 * h) * 64 + j;
          gd[0] = g0; gd[64] = g1; gd[128] = g2; gd[192] = g3;
          if (h) sv[VW * NST * 64 + (sb0 >> 3) * 64 + vperm(j)] = g3;
        }
      }
    }
  }
  const int stp = lane >> 3, seg = lane & 7, c0 = hd * 64 + 8 * seg;
  const int s = sb0 + stp;
  const int ss = s < nsteps ? s : nsteps - 1;
  const int pos = dir ? pos0 - ss : pos0 + ss;
  float k[8], a[8], gam[8], gpr[8];
  shift8(PRKV, p, sbase, pos, L, 512, c0, k);
  {
    const f32x4v a0 = *(const f32x4v*)(sv + VK * NST * 64 + s * 64 + 8 * seg), a1 = *(const f32x4v*)(sv + VK * NST * 64 + s * 64 + 8 * seg + 4);
    const f32x4v g0 = *(const f32x4v*)(sv + VA * NST * 64 + s * 64 + 8 * seg), g1 = *(const f32x4v*)(sv + VA * NST * 64 + s * 64 + 8 * seg + 4);
    const int sp = stp > 0 ? s - 1 : s;
    const f32x4v q0 = *(const f32x4v*)(sv + VA * NST * 64 + sp * 64 + 8 * seg), q1 = *(const f32x4v*)(sv + VA * NST * 64 + sp * 64 + 8 * seg + 4);
#pragma unroll
    for (int e = 0; e < 4; ++e) {
      a[e] = a0[e]; a[4 + e] = a1[e]; gam[e] = g0[e]; gam[4 + e] = g1[e];
      gpr[e] = stp > 0 ? q0[e] : 1.f; gpr[4 + e] = stp > 0 ? q1[e] : 1.f;
    }
  }
  const f32x4v kk0 = *(const f32x4v*)(p.d_k_k + c0), kk1 = *(const f32x4v*)(p.d_k_k + c0 + 4);
  const f32x4v ka0 = *(const f32x4v*)(p.d_k_a + c0), ka1 = *(const f32x4v*)(p.d_k_a + c0 + 4);
  float kk[8], kd[8];
  float n2 = 0.f;
#pragma unroll
  for (int e = 0; e < 8; ++e) {
    kk[e] = k[e] * (e < 4 ? kk0[e] : kk1[e - 4]);
    n2 += kk[e] * kk[e];
    kd[e] = k[e] * (1.f + (a[e] - 1.f) * (e < 4 ? ka0[e] : ka1[e - 4]));
  }
  n2 += __shfl_xor(n2, 1); n2 += __shfl_xor(n2, 2); n2 += __shfl_xor(n2, 4);
  const float rn = rsqrtf(fmaxf(n2, 1e-24f));
#pragma unroll
  for (int e = 0; e < 8; ++e) {
    const int ix = s * 64 + vperm(8 * seg + e);
    const float kn = kk[e] * rn;
    const float ig = __builtin_amdgcn_rcpf(gam[e]);
    sv[VA * NST * 64 + ix] = -kn * gpr[e];
    sv[VB * NST * 64 + ix] = kn * a[e] * ig;
    sv[VK * NST * 64 + ix] = kd[e] * ig;
  }
  {
    float v[8];
    shift8(PRKV, p, sbase, pos, L, 1024, c0, v);
    *(f32x4v*)(sv + VV * NST * 64 + s * 64 + 8 * seg) = (f32x4v){v[0], v[1], v[2], v[3]};
    *(f32x4v*)(sv + VV * NST * 64 + s * 64 + 8 * seg + 4) = (f32x4v){v[4], v[5], v[6], v[7]};
  }
  if (P3) {
    float r[8];
    shift8(PRKV, p, sbase, pos, L, 0, c0, r);
    const f32x4v rk0 = *(const f32x4v*)(p.d_r_k + c0), rk1 = *(const f32x4v*)(p.d_r_k + c0 + 4);
    float bn = 0.f;
#pragma unroll
    for (int e = 0; e < 8; ++e) {
      sv[VR * NST * 64 + s * 64 + vperm(8 * seg + e)] = r[e] * gam[e];
      bn += r[e] * kd[e] * (e < 4 ? rk0[e] : rk1[e - 4]);
    }
    bn += __shfl_xor(bn, 1); bn += __shfl_xor(bn, 2); bn += __shfl_xor(bn, 4);
    if (s < nsteps && seg == 0) bonus[((size_t)(sbase + pos) * 8 + hd) * 2 + dir] = bn;
  }
}

DI unsigned scan_touch(const P& p, int sbase, int L, int hd, int dir, int posf  ) {
  const int lane = threadIdx.x & 63;
  const bf16_t* PRKV = (const bf16_t*)(p.ws + O_PRKV);
  const bf16_t* LR = (const bf16_t*)(p.ws + O_LR);
  const int lo = dir ? posf - 8 : posf - 1;
  const unsigned* ptr;
  if (lane < 30) { int row = lo + lane / 3; row = row < 0 ? 0 : (row > L - 1 ? L - 1 : row); ptr = (const unsigned*)(PRKV + (size_t)(sbase + row) * 1536 + (lane % 3) * 512 + hd * 64); }
  else { const int i2 = (lane - 30) & 15; int row = dir ? posf - (i2 >> 1) : posf + (i2 >> 1); row = row < 0 ? 0 : (row > L - 1 ? L - 1 : row); ptr = (const unsigned*)(LR + (size_t)(sbase + row) * 384 + (i2 & 1) * 128 + dir * 64); }
  return *ptr;
}

template <bool HALF> DI void scan1_body(const P& p, char* lds) {
  float* PQ = (float*)(p.ws + O_PQ);
  const int lane = threadIdx.x & 63, wave = __builtin_amdgcn_readfirstlane(threadIdx.x >> 6), slot = wave >> 1;
  constexpr int half = HALF ? 1 : 0;
  float* sv = (float*)lds + slot * (6 * 16 * 64);
  for (int g = blockIdx.x; g < 804; g += gridDim.x) {
    int seq, c, hp;
    if (g < 768) { const int lc = g >> 2; hp = g & 3; if (lc < 128) { seq = lc >> 4; c = lc & 15; } else { seq = 8; c = lc - 128; } }
    else { const int j = g - 768; hp = j & 3; seq = j >> 2; c = seq < 8 ? 16 : 64; }
    const int cgi = seq < 8 ? seq * 17 + c : 136 + c;
    const int hd = hp * 2 + (slot >> 1), dir = slot & 1;
    const int it = (cgi * 8 + hd) * 2 + dir;
    const int L = seq_len(seq), sbase = seq_base(seq);
    const int start = c * 256, end = min(L, start + 256), n = end - start;
    float S[64];
#pragma unroll
    for (int j = 0; j < 64; ++j) S[j] = (half == 0 && j == lane) ? 1.f : 0.f;
    for (int s0 = 0; s0 < n; s0 += 16) {
      const int ns = min(16, n - s0);
      const int pos0 = dir ? end - 1 - s0 : start + s0;
      __syncthreads();
      scan_prologue8<16, false>(p, sbase, L, hd, dir, pos0, ns, half * 8, sv);
      __syncthreads();
      unsigned tch = 0u;
      if (s0 + 16 < n) tch = scan_touch(p, sbase, L, hd, dir, dir ? pos0 - 16 - half * 8 : pos0 + 16 + half * 8);
      scan_steps<16, HALF, false>(S, sv, ns, lane, [](int, float) {});
      asm volatile("" :: "v"(tch));
    }
    float* dst = PQ + (size_t)it * 8192 + (size_t)(half * 64 + lane) * 64;
#pragma unroll
    for (int q = 0; q < 16; ++q) *(float4*)(dst + q * 4) = make_float4(S[q * 4], S[q * 4 + 1], S[q * 4 + 2], S[q * 4 + 3]);
  }
}

DI void phase_scan1(const P& p, char* lds) {
  const int w_ = __builtin_amdgcn_readfirstlane(threadIdx.x >> 6);
  if ((w_ ^ (w_ >> 2)) & 1) scan1_body<true>(p, lds); else scan1_body<false>(p, lds);
}

DI void phase_scan2(const P& p, char* lds) {
  float* Ss = (float*)lds;
  float* Ps = Ss + 64 * 65;
  float* PQ = (float*)(p.ws + O_PQ);
  const int tid = threadIdx.x, lane = tid & 63, wave = __builtin_amdgcn_readfirstlane(tid >> 6), l31 = lane & 31, h = lane >> 5;
  const int r0 = 32 * (wave >> 1), c0 = 32 * (wave & 1);
  for (int it = blockIdx.x; it < 144; it += gridDim.x) {
    const int dir = it & 1, hd = (it >> 1) & 7, seq = it >> 4;
    const int nch = seq < 8 ? 17 : 65, cg0 = seq < 8 ? seq * 17 : 136;
    f32x16 S;
#pragma unroll
    for (int i = 0; i < 16; ++i) S[i] = 0.f;
    f32x4v pn0, pn1;
    {
      const int c = dir ? nch - 1 : 0;
      const float* Pg = PQ + (size_t)(((cg0 + c) * 8 + hd) * 2 + dir) * 8192;
      pn0 = *(const f32x4v*)(Pg + tid * 4); pn1 = *(const f32x4v*)(Pg + (512 + tid) * 4);
    }
    for (int cc = 0; cc < nch; ++cc) {
      const int c = dir ? nch - 1 - cc : cc;
      float* Qg = PQ + (size_t)(((cg0 + c) * 8 + hd) * 2 + dir) * 8192 + 4096;
      __syncthreads();
      { const int m = tid >> 4, cq = (tid & 15) * 4; *(f32x4v*)(Ps + m * 68 + cq) = pn0; *(f32x4v*)(Ps + (m + 32) * 68 + cq) = pn1; }
      f32x16 acc;
      if (wave < 4) {
#pragma unroll
        for (int i = 0; i < 16; ++i) {
          const int row = r0 + (i & 3) + 8 * (i >> 2) + 4 * h;
          Ss[row * 65 + c0 + l31] = S[i];
          float* qp = Qg + row * 64 + c0 + l31;
          acc[i] = *qp;
          *qp = S[i];
        }
      }
      if (cc + 1 < nch) {
        const int c2 = dir ? nch - 2 - cc : cc + 1;
        const float* Pg2 = PQ + (size_t)(((cg0 + c2) * 8 + hd) * 2 + dir) * 8192;
        pn0 = *(const f32x4v*)(Pg2 + tid * 4); pn1 = *(const f32x4v*)(Pg2 + (512 + tid) * 4);
      }
      __syncthreads();
      if (wave < 4) {
#pragma unroll 8
        for (int kk = 0; kk < 32; ++kk) {
          const float av = Ss[(r0 + l31) * 65 + 2 * kk + h];
          const float bv = Ps[(2 * kk + h) * 68 + c0 + l31];
          acc = __builtin_amdgcn_mfma_f32_32x32x2f32(av, bv, acc, 0, 0, 0);
        }
        S = acc;
      }
    }
  }
}

DI void phase_scan3(const P& p, char* lds) {
  const float* PQ = (const float*)(p.ws + O_PQ);
  bf16_t* MIX = (bf16_t*)(p.ws + O_MIX);
  bf16_t* OB = (bf16_t*)(p.ws + O_OB);
  const int lane = threadIdx.x & 63, wave = __builtin_amdgcn_readfirstlane(threadIdx.x >> 6);
  float* sv = (float*)lds + wave * (6 * 8 * 64);
  const bool bal = gridDim.x == 256;
  const int NW = gridDim.x * 8, gw = blockIdx.x * 8 + wave;
  for (int k = 0; ; ++k) {
    int oi;
    if (bal) {
      if (k == 0) oi = gw;
      else if (k == 1) { if (wave >= 4) continue; oi = 2048 + blockIdx.x * 4 + wave; }
      else if (k == 2) { if (wave != 7 || blockIdx.x >= 144) break; oi = 3072 + blockIdx.x; }
      else break;
    } else { oi = gw + k * NW; if (oi >= 3216) break; }
    int seq, c, hd, dir;
    if (oi < 3072) { const int lc = oi >> 4; hd = (oi >> 1) & 7; dir = oi & 1; if (lc < 128) { seq = lc >> 4; c = lc & 15; } else { seq = 8; c = lc - 128; } }
    else { const int j = oi - 3072; hd = (j >> 1) & 7; dir = j & 1; seq = j >> 4; c = seq < 8 ? 16 : 64; }
    const int it = ((seq < 8 ? seq * 17 + c : 136 + c) * 8 + hd) * 2 + dir;
    const int L = seq_len(seq), sbase = seq_base(seq);
    const int start = c * 256, end = min(L, start + 256), n = end - start;
    float S[64];
    {
      const float* src = PQ + (size_t)it * 8192 + 4096 + lane * 64;
#pragma unroll
      for (int q = 0; q < 16; ++q) { float4 t = *(const float4*)(src + q * 4); S[q * 4] = t.x; S[q * 4 + 1] = t.y; S[q * 4 + 2] = t.z; S[q * 4 + 3] = t.w; }
    }
    for (int s0 = 0; s0 < n; s0 += 8) {
      const int ns = min(8, n - s0);
      const int pos0 = dir ? end - 1 - s0 : start + s0;
      scan_prologue8<8, true>(p, sbase, L, hd, dir, pos0, ns, 0, sv);
      unsigned tch = 0u;
      if (s0 + 8 < n) tch = scan_touch(p, sbase, L, hd, dir, dir ? pos0 - 8 : pos0 + 8);
      scan_steps<8, true, true>(S, sv, ns, lane, [&](int st, float o) {
        const int pos = dir ? pos0 - st : pos0 + st;
        const size_t sr = (size_t)(sbase + pos);
        if (dir == 0) MIX[sr * 1024 + 512 + hd * 64 + lane] = f2bf(o);
        else OB[sr * 512 + hd * 64 + lane] = f2bf(o);
      });
      asm volatile("" :: "v"(tch));
    }
  }
}

DI void phase_rwkv_final(const P& p) {
  const int lane = threadIdx.x & 63, gw = (blockIdx.x * NTH + threadIdx.x) >> 6, nw = (gridDim.x * NTH) >> 6;
  bf16_t* MIX = (bf16_t*)(p.ws + O_MIX);
  const bf16_t* OB = (const bf16_t*)(p.ws + O_OB);
  const bf16_t* G = (const bf16_t*)(p.ws + O_G);
  const bf16_t* PRKV = (const bf16_t*)(p.ws + O_PRKV);
  const float* bonus = (const float*)(p.ws + O_BONUS);
  const int hd = lane >> 3, c0 = lane * 8;
  for (int sr = gw; sr < T_; sr += nw) {
    int pos; int b = seq_of(sr, pos);
    const int L = seq_len(b);
    uint4 uf = *(const uint4*)(MIX + (size_t)sr * 1024 + 512 + c0);
    uint4 ub = *(const uint4*)(OB + (size_t)sr * 512 + c0);
    uint4 ug = *(const uint4*)(G + (size_t)sr * 512 + c0);
    unsigned f_[4] = {uf.x, uf.y, uf.z, uf.w}, b_[4] = {ub.x, ub.y, ub.z, ub.w}, g_[4] = {ug.x, ug.y, ug.z, ug.w};
    float o[8], gg[8];
    float sm = 0.f;
#pragma unroll
    for (int j = 0; j < 4; ++j) {
      o[2 * j] = lo2f(f_[j]) + lo2f(b_[j]); o[2 * j + 1] = hi2f(f_[j]) + hi2f(b_[j]);
      gg[2 * j] = lo2f(g_[j]); gg[2 * j + 1] = hi2f(g_[j]);
      sm += o[2 * j] + o[2 * j + 1];
    }
    sm += __shfl_xor(sm, 1); sm += __shfl_xor(sm, 2); sm += __shfl_xor(sm, 4);
    const float mean = sm * (1.f / 64.f);
    float vs = 0.f;
#pragma unroll
    for (int j = 0; j < 8; ++j) { float dlt = o[j] - mean; vs += dlt * dlt; }
    vs += __shfl_xor(vs, 1); vs += __shfl_xor(vs, 2); vs += __shfl_xor(vs, 4);
    const float rstd = rsqrtf(vs * (1.f / 64.f) + 64e-5f);
    const float bsum = bonus[((size_t)sr * 8 + hd) * 2] + bonus[((size_t)sr * 8 + hd) * 2 + 1];
    float y[8];
#pragma unroll
    for (int j = 0; j < 8; ++j) {
      int c = c0 + j;
      float vsh = shiftv(PRKV, sr, pos, L, 1024 + c, p.mu_prev[1024 + c], p.mu_next[1024 + c]);
      y[j] = ((o[j] - mean) * rstd * p.d_ln_g[c] + p.d_ln_b[c] + bsum * vsh) * gg[j];
    }
    *(uint4*)(MIX + (size_t)sr * 1024 + 512 + c0) = make_uint4(pack2(y[0], y[1]), pack2(y[2], y[3]), pack2(y[4], y[5]), pack2(y[6], y[7]));
  }
}

#define XB_TMO      128
#define XB_XCNT(j)  (256  + 64 * (j))
#define XB_XSUB(j)  (1280 + 64 * (j))
#define XB_XGEN(j)  (2304 + 64 * (j))
#define XB_TOP      3328
#define XB_TOPGEN   3392
#define XCD_BAR_WORDS 3456
#define XB_SPIN_CAP (1u << 23)
#define LAS __attribute__((address_space(3)))

__device__ __forceinline__ unsigned xb_ld(unsigned* p)              { return __hip_atomic_load(p, __ATOMIC_RELAXED, __HIP_MEMORY_SCOPE_AGENT); }
__device__ __forceinline__ unsigned xb_add(unsigned* p, unsigned v) { return __hip_atomic_fetch_add(p, v, __ATOMIC_RELAXED, __HIP_MEMORY_SCOPE_AGENT); }
__device__ __forceinline__ unsigned xb_xcc_id() { return (unsigned)__builtin_amdgcn_s_getreg((3 << 11) | 20) & 0xFu; }
#define XB_SPIN(cond, bar) do { unsigned _sp = 0; while (cond) { __builtin_amdgcn_s_sleep(1); \
    if ((++_sp & 255u) == 0u) { if (xb_ld(&(bar)[XB_TMO])) break; if (_sp > XB_SPIN_CAP) { atomicAdd(&(bar)[XB_TMO], 1u); break; } } } } while (0)

struct XcdBarrier {
    unsigned* bar; unsigned x;
    volatile LAS unsigned* st;
};

__device__ __forceinline__ XcdBarrier xcd_barrier_post(unsigned* bar, volatile LAS unsigned* st) {
    XcdBarrier b; b.bar = bar; b.x = xb_xcc_id(); b.st = st;
    if (threadIdx.x == 0) (void)xb_add(&bar[XB_XCNT(b.x)], 1u);
    return b;
}
__device__ __forceinline__ void xcd_barrier_complete(unsigned* bar, unsigned x, unsigned& nloc, unsigned& nx) {
    const unsigned G = gridDim.x * gridDim.y * gridDim.z;
    unsigned sum, cnt, mine, sp = 0u;
    for (;;) {
        sum = 0u; cnt = 0u; mine = 0u;
#pragma unroll
        for (unsigned j = 0; j < 16; ++j) { const unsigned c = xb_ld(&bar[XB_XCNT(j)]); sum += c; cnt += (c > 0u) ? 1u : 0u; mine = (j == x) ? c : mine; }
        if (sum == G) break;
        __builtin_amdgcn_s_sleep(1);
        if ((++sp & 255u) == 0u) { if (xb_ld(&bar[XB_TMO])) break; if (sp > XB_SPIN_CAP) { atomicAdd(&bar[XB_TMO], 1u); break; } }
    }
    nloc = mine > 0u ? mine : 1u; nx = cnt > 0u ? cnt : 1u;
}

__device__ __forceinline__ void xcd_barrier(const XcdBarrier& b) {
    asm volatile("s_waitcnt vmcnt(0)" ::: "memory");
    __syncthreads();
    if (threadIdx.x == 0) {
        unsigned* bar = b.bar;
        __builtin_amdgcn_s_waitcnt(0);
        unsigned nloc = b.st[0], nx = b.st[1];
        if (nloc == 0u) { xcd_barrier_complete(bar, b.x, nloc, nx); b.st[0] = nloc; b.st[1] = nx; }
        const unsigned old = xb_add(&bar[XB_XSUB(b.x)], 1u);
        const unsigned gen = old / nloc;
        if (old + 1u == (gen + 1u) * nloc) {
            __builtin_amdgcn_fence(__ATOMIC_RELEASE, "agent");
            asm volatile("s_waitcnt vmcnt(0)" ::: "memory");
            const unsigned og = xb_add(&bar[XB_TOP], 1u);
            const unsigned tg = og / nx;
            if (og + 1u == (tg + 1u) * nx) xb_add(&bar[XB_TOPGEN], 1u);
            else XB_SPIN(xb_ld(&bar[XB_TOPGEN]) == tg, bar);
            __builtin_amdgcn_fence(__ATOMIC_ACQUIRE, "agent");
            xb_add(&bar[XB_XGEN(b.x)], 1u);
            asm volatile("s_waitcnt vmcnt(0)" ::: "memory");
        } else {
            XB_SPIN(xb_ld(&bar[XB_XGEN(b.x)]) == gen, bar);
            __builtin_amdgcn_fence(__ATOMIC_ACQUIRE, "agent");
            asm volatile("s_waitcnt vmcnt(0)" ::: "memory");
        }
    }
    __syncthreads();
}

constexpr int NPHASE = 23;
__global__ void __launch_bounds__(NTH, 2) mega(P p) {
  extern __shared__ __attribute__((aligned(16))) unsigned char shm[];
  char* lds = (char*)shm;
  char* ws = p.ws;
  if (threadIdx.x == 0) *(uint4*)(shm + 131072) = make_uint4(0u, 0u, 0u, 0u);
  __syncthreads();
  const XcdBarrier xb = xcd_barrier_post((unsigned*)(ws + O_BAR), (volatile LAS unsigned*)(shm + 131072));
#ifndef DUP_MASK
#define DUP_MASK 0u
#endif
#define RUN(k, call) if (p.ph0 <= k && k < p.ph1) { call; if (k + 1 < p.ph1) { if (k == 0) cg::this_grid().sync(); else xcd_barrier(xb); } }
  RUN(0, phase_prep(p))
  RUN(1, phase_gemm_big((const bf16_t*)(ws + O_HN), (const bf16_t*)(ws + O_WIN0), 1536, 1024, (bf16_t*)(ws + O_PROJ0), 1536, 0, ws, shm))
  RUN(2, phase_prepA(p, lds))
  RUN(3, phase_attnA(p, lds))
  RUN(4, phase_fnet_gemm(p, lds))
  RUN(5, phase_gemm_big((const bf16_t*)(ws + O_MIX), (const bf16_t*)(ws + O_WOUT0), 1024, 1024, (bf16_t*)(ws + O_HN), 1024, 0, ws, shm))
  RUN(6, phase_resnorm(p, p.post_mix_g, p.pre_ffn_g))
  RUN(7, phase_gemm_gateup((const bf16_t*)(ws + O_HN), (const bf16_t*)(ws + O_WGU0), (bf16_t*)(ws + O_ACT), shm))
  RUN(8, phase_gemm_big((const bf16_t*)(ws + O_ACT), (const bf16_t*)(ws + O_WD0), 1024, DFF, (bf16_t*)(ws + O_HN), 1024, 0, ws, shm))
  RUN(9, phase_resnorm(p, p.post_ffn_g, p.pre_mix_g + 1024))
  RUN(10, phase_gemm_big((const bf16_t*)(ws + O_HN), (const bf16_t*)(ws + O_WIN1), 2816, 1024, nullptr, 0, 1, ws, shm))
  RUN(11, phase_prepC(p, lds))
  RUN(12, phase_attnC(p, lds))
  RUN(13, phase_scan1(p, lds))
  RUN(14, phase_scan2(p, lds))
  RUN(15, phase_scan3(p, lds))
  RUN(16, phase_gemm_small((const bf16_t*)(ws + O_LR) + 256, 384, (const bf16_t*)(ws + O_GUP), 512, 128, (bf16_t*)(ws + O_G), 512, lds))
  RUN(17, phase_rwkv_final(p))
  RUN(18, phase_gemm_big((const bf16_t*)(ws + O_MIX), (const bf16_t*)(ws + O_WOUT1), 1024, 1024, (bf16_t*)(ws + O_HN), 1024, 0, ws, shm))
  RUN(19, phase_resnorm(p, p.post_mix_g + 1024, p.pre_ffn_g + 1024))
  RUN(20, phase_gemm_gateup((const bf16_t*)(ws + O_HN), (const bf16_t*)(ws + O_WGU1), (bf16_t*)(ws + O_ACT), shm))
  RUN(21, phase_gemm_big((const bf16_t*)(ws + O_ACT), (const bf16_t*)(ws + O_WD1), 1024, DFF, (bf16_t*)(ws + O_HN), 1024, 0, ws, shm))
  RUN(22, phase_resnorm(p, p.post_ffn_g + 1024, nullptr))
#undef RUN
}

extern "C" void kernel_launch(void* const* d_in, const int* in_sizes, int n_in, void* d_out, int out_size, void* d_ws, size_t ws_size,
                              hipStream_t stream) {
  static int grid_blocks = 0;
  if (!grid_blocks) {
    int dev = 0, cus = 0, per_cu = 0;
    (void)hipGetDevice(&dev);
    (void)hipDeviceGetAttribute(&cus, hipDeviceAttributeMultiprocessorCount, dev);
    if (hipFuncSetAttribute((const void*)mega, hipFuncAttributeMaxDynamicSharedMemorySize, LDS_BYTES) != hipSuccess) fprintf(stderr, "hipFuncSetAttribute failed\n");
    if (hipOccupancyMaxActiveBlocksPerMultiprocessor(&per_cu, (const void*)mega, NTH, LDS_BYTES) != hipSuccess || per_cu < 1) {
      fprintf(stderr, "occupancy query says %d\n", per_cu);
      (void)hipGetLastError();
    }
    grid_blocks = cus;
  }
  if (ws_size < O_BAR + CTL_BYTES) { fprintf(stderr, "workspace too small\n"); return; }
  if (hipMemsetAsync((char*)d_ws + O_BAR, 0, CTL_BYTES, stream) != hipSuccess) { fprintf(stderr, "memset failed\n"); return; }
  P p{};
  const float** f = (const float**)&p;
  for (int i = 0; i < 32; ++i) f[i] = (const float*)d_in[i];
  p.out = (float*)d_out;
  p.ws = (char*)d_ws;
#if FUSED
  p.ph0 = 0; p.ph1 = NPHASE;
  void* args[] = {&p};
  hipError_t e = hipLaunchCooperativeKernel((void*)mega, dim3(grid_blocks), dim3(NTH), args, LDS_BYTES, stream);
  if (e != hipSuccess) fprintf(stderr, "cooperative launch failed: %s (grid %d)\n", hipGetErrorString(e), grid_blocks);
#else
  for (int ph = 0; ph < NPHASE; ++ph) {
    p.ph0 = ph; p.ph1 = ph + 1;
    hipLaunchKernelGGL(mega, dim3(grid_blocks), dim3(NTH), LDS_BYTES, stream, p);
  }
#endif
}
```

```cpp
#include <hip/hip_runtime.h>
#include <hip/hip_cooperative_groups.h>
#include <cstdio>
namespace cg = cooperative_groups;

#ifndef FUSED
#define FUSED 1
#endif

typedef unsigned short bf16_t;
using bf16x8 = __attribute__((ext_vector_type(8))) short;
using s16x4 = __attribute__((ext_vector_type(4))) short;
using f32x16 = __attribute__((ext_vector_type(16))) float;
using u32x4 = __attribute__((ext_vector_type(4))) unsigned;
using f32x4v = __attribute__((ext_vector_type(4))) float;
#define DI __device__ __forceinline__
#define MFMA32(a, b, c) __builtin_amdgcn_mfma_f32_32x32x16_bf16((a), (b), (c), 0, 0, 0)
constexpr int NTH = 512;
constexpr int LDS_BYTES = 131072 + 16;

constexpr int DM_ = 1024;
constexpr int T_ = 49296;
constexpr int TP_ = 49408;
constexpr int NT_ = TP_ / 128;
constexpr int DFF = 2816;
constexpr float EPS = 1e-6f;
constexpr float LOG2E = 1.4426950408889634f;

constexpr size_t SZ_ROW1024 = (size_t)TP_ * 1024 * 2;
constexpr size_t O_WIN0 = 0;
constexpr size_t O_WOUT0 = O_WIN0 + (size_t)1536 * 1024 * 2;
constexpr size_t O_WGU0 = O_WOUT0 + (size_t)1024 * 1024 * 2;
constexpr size_t O_WD0 = O_WGU0 + (size_t)5632 * 1024 * 2;
constexpr size_t O_DM257 = O_WD0 + (size_t)1024 * 2816 * 2;
constexpr size_t O_DM1025 = O_DM257 + (size_t)384 * 576 * 2;
constexpr size_t O_WIN1 = O_DM1025 + (size_t)1152 * 2112 * 2;
constexpr size_t O_WOUT1 = O_WIN1 + (size_t)2816 * 1024 * 2;
constexpr size_t O_WGU1 = O_WOUT1 + (size_t)1024 * 1024 * 2;
constexpr size_t O_WD1 = O_WGU1 + (size_t)5632 * 1024 * 2;
constexpr size_t O_GUP = O_WD1 + (size_t)1024 * 2816 * 2;
constexpr size_t O_RA = O_GUP + (size_t)512 * 128 * 2;
constexpr size_t O_RB = O_RA + SZ_ROW1024;
constexpr size_t O_RC = O_RB + (size_t)TP_ * 2816 * 2;
constexpr size_t O_META = O_RC + SZ_ROW1024;
constexpr size_t O_WC = O_META + (size_t)144 * 1024 * 4;
constexpr size_t O_WUPT = O_WC + (size_t)4 * 64 * 128 * 4;
constexpr size_t O_AUPT = O_WUPT + (size_t)2 * 512 * 64 * 2;
constexpr size_t O_END = O_AUPT + (size_t)2 * 512 * 64 * 2;
constexpr size_t O_HN = O_RA;
constexpr size_t O_VTA = O_RA;
constexpr size_t O_LR = O_RA;
constexpr size_t O_BONUS = O_RA + (size_t)TP_ * 384 * 2;
constexpr size_t O_VTC = O_BONUS + (size_t)T_ * 16 * 4;
constexpr size_t O_OB = O_RA + (size_t)TP_ * 512 * 2;
constexpr size_t O_PROJ0 = O_RB;
constexpr size_t O_ZB = O_PROJ0 + (size_t)TP_ * 1536 * 2;
constexpr size_t O_Y = O_ZB + (size_t)TP_ * 512 * 2;
constexpr size_t O_ACT = O_RB;
constexpr size_t O_PRKV = O_RB;
constexpr size_t O_PC = O_PRKV + (size_t)TP_ * 1536 * 2;
constexpr size_t O_PLOW = O_PC + (size_t)TP_ * 768 * 2;
constexpr size_t O_PQ = O_PC;
constexpr size_t O_G = O_PC;
constexpr size_t O_MIX = O_RC;
static_assert(O_VTC + (size_t)49728 * 128 * 2 <= O_RB, "vtc");
static_assert(O_Y + (size_t)(8 * 16 * 256 * 576 + 16 * 256 * 2112) * 2 <= O_RC, "y");
static_assert(O_PQ + (size_t)3216 * 32768 <= O_RC, "pq");
constexpr size_t O_BAR = (O_END + 255) / 256 * 256;
constexpr size_t O_CNT = O_BAR + 3456 * 4;
constexpr size_t CTL_BYTES = 3456 * 4 + 4 * 256;
static_assert(O_BAR + CTL_BYTES <= (size_t)536870912, "ws");

struct P {
  const float *x_prompt, *x_sample, *meta, *pre_mix_g, *post_mix_g, *pre_ffn_g, *post_ffn_g;
  const float *even_w_in, *even_w_out, *a_q_gain, *a_k_gain, *b_norm_g, *b_w, *b_b;
  const float *odd_w_in, *odd_w_out, *c_sink, *mu_prev, *mu_next, *d_w0, *d_w_up, *d_a0, *d_a_up, *d_g_up;
  const float *d_k_k, *d_k_a, *d_r_k, *d_ln_g, *d_ln_b, *ffn_gate, *ffn_up, *ffn_down;
  float* out;
  char* ws;
  int ph0, ph1;
};

typedef float f32x2 __attribute__((ext_vector_type(2)));
typedef __bf16 bf16x2_t __attribute__((ext_vector_type(2)));
DI bf16_t f2bf(float x) { return __builtin_bit_cast(bf16_t, (__bf16)x); }
DI float bf2f(bf16_t b) { return __uint_as_float(((unsigned)b) << 16); }
DI unsigned pack2(float a, float b) { f32x2 v = {a, b}; return __builtin_bit_cast(unsigned, __builtin_convertvector(v, bf16x2_t)); }
DI float lo2f(unsigned u) { return __uint_as_float(u << 16); }
DI float hi2f(unsigned u) { return __uint_as_float(u & 0xffff0000u); }
DI float wave_sum(float v) {
  for (int o = 32; o > 0; o >>= 1) v += __shfl_xor(v, o);
  return v;
}
DI int seq_of(int sr, int& pos) {
  if (sr < 32896) { int b = sr / 4112; pos = sr - b * 4112; return b; }
  pos = sr - 32896; return 8;
}
DI int seq_len(int b) { return b < 8 ? 4112 : 16400; }
DI int seq_base(int b) { return b < 8 ? b * 4112 : 32896; }
DI float* hrow(const P& p, int sr) {
  int pos; int b = seq_of(sr, pos);
  if (pos < 16) return (float*)(p.ws + O_META) + (size_t)(b * 16 + pos) * 1024;
  return p.out + ((size_t)(b < 8 ? b * 4096 : 32768) + (pos - 16)) * 1024;
}
DI float sigmoidf_(float x) { return 1.f / (1.f + expf(-x)); }

DI void transpose_w(const float* W, int K, int ldw, int N, bf16_t* Wt, int mode, const float* W2, int gtid, int gsz) {
  int nk8 = K / 8;
  long total = (long)N * nk8;
  for (long it = gtid; it < total; it += gsz) {
    int n = (int)(it % N), k8 = (int)(it / N);
    const float* src = W;
    int c = n;
    if (mode == 1) {
      int blk = n >> 8, w = n & 255;
      c = blk * 128 + (w & 127);
      if (w >= 128) src = W2;
    }
    unsigned r[4];
#pragma unroll
    for (int j = 0; j < 4; ++j) {
      float a = src[(size_t)(k8 * 8 + 2 * j) * ldw + c];
      float b = src[(size_t)(k8 * 8 + 2 * j + 1) * ldw + c];
      r[j] = pack2(a, b);
    }
    *(uint4*)(Wt + (size_t)n * K + k8 * 8) = make_uint4(r[0], r[1], r[2], r[3]);
  }
}

DI void phase_prep(const P& p) {
  const int gtid = blockIdx.x * NTH + threadIdx.x, gsz = gridDim.x * NTH;
  char* ws = p.ws;
  transpose_w(p.even_w_in, 1024, 1536, 1536, (bf16_t*)(ws + O_WIN0), 0, nullptr, gtid, gsz);
  transpose_w(p.even_w_out, 1024, 1024, 1024, (bf16_t*)(ws + O_WOUT0), 0, nullptr, gtid, gsz);
  transpose_w(p.odd_w_in, 1024, 2688, 2688, (bf16_t*)(ws + O_WIN1), 0, nullptr, gtid, gsz);
  transpose_w(p.odd_w_out, 1024, 1024, 1024, (bf16_t*)(ws + O_WOUT1), 0, nullptr, gtid, gsz);
  transpose_w(p.ffn_gate, 1024, DFF, 5632, (bf16_t*)(ws + O_WGU0), 1, p.ffn_up, gtid, gsz);
  transpose_w(p.ffn_gate + (size_t)1024 * DFF, 1024, DFF, 5632, (bf16_t*)(ws + O_WGU1), 1, p.ffn_up + (size_t)1024 * DFF, gtid, gsz);
  transpose_w(p.ffn_down, DFF, 1024, 1024, (bf16_t*)(ws + O_WD0), 0, nullptr, gtid, gsz);
  transpose_w(p.ffn_down + (size_t)DFF * 1024, DFF, 1024, 1024, (bf16_t*)(ws + O_WD1), 0, nullptr, gtid, gsz);
  transpose_w(p.d_g_up, 128, 512, 512, (bf16_t*)(ws + O_GUP), 0, nullptr, gtid, gsz);
  for (int d = 0; d < 2; ++d) {
    transpose_w(p.d_w_up + (size_t)d * 64 * 512, 64, 512, 512, (bf16_t*)(ws + O_WUPT) + (size_t)d * 512 * 64, 0, nullptr, gtid, gsz);
    transpose_w(p.d_a_up + (size_t)d * 64 * 512, 64, 512, 512, (bf16_t*)(ws + O_AUPT) + (size_t)d * 512 * 64, 0, nullptr, gtid, gsz);
  }
  for (int it = gtid; it < 128 * 1024 / 8; it += gsz) *(uint4*)((bf16_t*)(ws + O_WIN1) + (size_t)2688 * 1024 + (size_t)it * 8) = make_uint4(0, 0, 0, 0);
  for (int which = 0; which < 2; ++which) {
    const int M = which ? 1025 : 257, MP = which ? 1152 : 384, KP = which ? 2112 : 576;
    bf16_t* dm = (bf16_t*)(ws + (which ? O_DM1025 : O_DM257));
    for (int it = gtid; it < MP * KP; it += gsz) {
      int r = it / KP, c = it - r * KP;
      float v = 0.f;
      if (r < M && c < 2 * M) {
        int n2 = c < M ? c : c - M;
        int m = (r * n2) % M;
        float s, co;
        sincospif(2.0f * (float)m / (float)M, &s, &co);
        v = c < M ? co : s;
      }
      dm[it] = f2bf(v);
    }
  }
  for (int it = gtid; it < 4 * 64 * 128; it += gsz) {
    int o = it & 127, c = (it >> 7) & 63, g = it >> 13;
    int d = o & 63;
    float acc = 0.f;
    for (int c2 = 0; c2 < 64; ++c2) {
      float s, co;
      sincospif((float)((c * c2) & 63) / 32.f, &s, &co);
      float w = p.b_w[(g * 64 + c2) * 64 + d];
      acc += (o < 64 ? co : -s) * w;
    }
    ((float*)(ws + O_WC))[it] = acc;
  }
  const int lane = threadIdx.x & 63, gw = gtid >> 6, nw = gsz >> 6;
  bf16_t* HN = (bf16_t*)(ws + O_HN);
  for (int sr = gw; sr < TP_; sr += nw) {
    if (sr >= T_) {
#pragma unroll
      for (int q = 0; q < 2; ++q) *(uint4*)(HN + (size_t)sr * 1024 + q * 512 + lane * 8) = make_uint4(0, 0, 0, 0);
      continue;
    }
    int pos; int b = seq_of(sr, pos);
    const float* src = pos < 16 ? p.meta + pos * 1024
                                : (b < 8 ? p.x_prompt + ((size_t)b * 4096 + pos - 16) * 1024 : p.x_sample + (size_t)(pos - 16) * 1024);
    float* hr = hrow(p, sr);
    float4 v[4];
    float ss = 0.f;
#pragma unroll
    for (int q = 0; q < 4; ++q) {
      v[q] = *(const float4*)(src + q * 256 + lane * 4);
      ss += v[q].x * v[q].x + v[q].y * v[q].y + v[q].z * v[q].z + v[q].w * v[q].w;
      *(float4*)(hr + q * 256 + lane * 4) = v[q];
    }
    ss = wave_sum(ss);
    float rs = rsqrtf(ss * (1.f / 1024.f) + EPS);
#pragma unroll
    for (int q = 0; q < 4; ++q) {
      float4 g = *(const float4*)(p.pre_mix_g + q * 256 + lane * 4);
      uint2 o = make_uint2(pack2(v[q].x * rs * g.x, v[q].y * rs * g.y), pack2(v[q].z * rs * g.z, v[q].w * rs * g.w));
      *(uint2*)(HN + (size_t)sr * 1024 + q * 256 + lane * 4) = o;
    }
  }
}

DI void gemm_tile(const bf16_t* __restrict__ A, int lda, const bf16_t* __restrict__ B, int ldb, int K, char* lds, f32x16 (&acc)[2][2]) {
  const int tid = threadIdx.x & 255, lane = tid & 63, wave = tid >> 6, wm = wave >> 1, wn = wave & 1;
  const int l31 = lane & 31, h = lane >> 5;
  bf16_t* As = (bf16_t*)lds;
  bf16_t* Bs = As + 128 * 72;
#pragma unroll
  for (int a = 0; a < 2; ++a)
#pragma unroll
    for (int b = 0; b < 2; ++b)
#pragma unroll
      for (int i = 0; i < 16; ++i) acc[a][b][i] = 0.f;
  const int lr = tid >> 3, lc = (tid & 7) * 8;
  const bf16_t* Ag = A + (size_t)lr * lda + lc;
  const bf16_t* Bg = B + (size_t)lr * ldb + lc;
  u32x4 ra[4], rb[4];
#pragma unroll
  for (int q = 0; q < 4; ++q) {
    ra[q] = *(const u32x4*)(Ag + (size_t)(32 * q) * lda);
    rb[q] = *(const u32x4*)(Bg + (size_t)(32 * q) * ldb);
  }
#pragma unroll
  for (int q = 0; q < 4; ++q) {
    *(u32x4*)(As + (lr + 32 * q) * 72 + lc) = ra[q];
    *(u32x4*)(Bs + (lr + 32 * q) * 72 + lc) = rb[q];
  }
  __syncthreads();
  const int nk = K >> 6;
  for (int kt = 0; kt < nk; ++kt) {
    if (kt + 1 < nk) {
#pragma unroll
      for (int q = 0; q < 4; ++q) {
        ra[q] = *(const u32x4*)(Ag + (size_t)(32 * q) * lda + (kt + 1) * 64);
        rb[q] = *(const u32x4*)(Bg + (size_t)(32 * q) * ldb + (kt + 1) * 64);
      }
    }
#pragma unroll
    for (int ks = 0; ks < 4; ++ks) {
      bf16x8 a[2], b[2];
#pragma unroll
      for (int t = 0; t < 2; ++t) {
        a[t] = *(const bf16x8*)(As + (wm * 64 + t * 32 + l31) * 72 + ks * 16 + 8 * h);
        b[t] = *(const bf16x8*)(Bs + (wn * 64 + t * 32 + l31) * 72 + ks * 16 + 8 * h);
      }
#pragma unroll
      for (int mt = 0; mt < 2; ++mt)
#pragma unroll
        for (int nt = 0; nt < 2; ++nt) acc[mt][nt] = MFMA32(a[mt], b[nt], acc[mt][nt]);
    }
    __syncthreads();
    if (kt + 1 < nk) {
#pragma unroll
      for (int q = 0; q < 4; ++q) {
        *(u32x4*)(As + (lr + 32 * q) * 72 + lc) = ra[q];
        *(u32x4*)(Bs + (lr + 32 * q) * 72 + lc) = rb[q];
      }
      __syncthreads();
    }
  }
}
#define ACC_ROW(mt, i) (wm * 64 + (mt) * 32 + ((i) & 3) + 8 * ((i) >> 2) + 4 * h)
#define ACC_COL(nt) (wn * 64 + (nt) * 32 + l31)
#define GEMM_IDS const int lane = threadIdx.x & 63, wave = (threadIdx.x & 255) >> 6, wm = wave >> 1, wn = wave & 1, l31 = lane & 31, h = lane >> 5; (void)wm; (void)wn; (void)l31; (void)h;

DI void phase_gemm_small(const bf16_t* A, int lda, const bf16_t* W, int N, int K, bf16_t* C, int ldc, char* lds) {
  GEMM_IDS
  const int sb = threadIdx.x >> 8;
  const int ntn = N / 128;
  const int total = NT_ * ntn;
  for (int t0 = blockIdx.x * 2; t0 < total; t0 += gridDim.x * 2) {
    const int t = t0 + sb;
    const int tm = t / ntn, tn = t - tm * ntn;
    f32x16 acc[2][2];
    gemm_tile(A + (size_t)tm * 128 * lda, lda, W + (size_t)tn * 128 * K, K, K, lds + sb * 36864, acc);
#pragma unroll
    for (int mt = 0; mt < 2; ++mt)
#pragma unroll
      for (int nt = 0; nt < 2; ++nt)
#pragma unroll
        for (int i = 0; i < 16; ++i) {
          int row = tm * 128 + ACC_ROW(mt, i), col = tn * 128 + ACC_COL(nt);
          C[(size_t)row * ldc + col] = f2bf(acc[mt][nt][i]);
        }
  }
}

namespace pg8 {
#define PG8_LAS __attribute__((address_space(3)))
typedef unsigned short bf16_t;
typedef short bf16x8 __attribute__((ext_vector_type(8)));
typedef float f32x4 __attribute__((ext_vector_type(4)));
typedef unsigned u32x4 __attribute__((ext_vector_type(4)));
constexpr int BM = 256, BK = 64, HALF = 128, HTB = HALF * BK * 2  , STAGE_BYTES = 8 * HTB, NXCD = 8, WGM = 8;

__host__ __device__ __forceinline__ int lds_byte(int r, int c) { const int st = (r >> 4) * 2 + (c >> 5), rr = r & 15, cc = c & 31, ob = rr * 64 + cc * 2; return st * 1024 + (ob ^ (((ob >> 9) & 1) << 5)); }
__host__ __device__ __forceinline__ void stage_rc(int b, int& R, int& C) { const int st = b / 1024, sb = b % 1024, swz = sb ^ (((sb >> 9) & 1) << 5); R = (st >> 1) * 16 + swz / 64; C = (st & 1) * 32 + (swz % 64) / 2; }
__host__ __device__ __forceinline__ int perm32(int rho) { const int n = rho >> 4, i = rho & 15; return 8 * (i >> 2) + 4 * n + (i & 3); }

struct Unit { int pm, pn; };
struct Gemm { const bf16_t* A; const bf16_t* Bt; int M, N, K; };

struct StaticOrder {
    int nM, nN, nwg, G, c;
    __host__ __device__ void init(int M, int N, int G_, int c_) { nM = M / BM; nN = N / BM; nwg = nM * nN; G = G_; c = c_; }
    __host__ __device__ bool next(int i, Unit& u) const {
        const long L = (long)i * G + c; if (L >= nwg) return false;
        int wgid = (int)L; { const int q = nwg / NXCD, r = nwg % NXCD, xcd = wgid % NXCD, off = wgid / NXCD; wgid = (xcd < r ? xcd * (q + 1) : r * (q + 1) + (xcd - r) * q) + off; }
        const int nig = WGM * nN, gid = wgid / nig, fm = gid * WGM, gsz = (nM - fm) < WGM ? (nM - fm) : WGM;
        u.pm = fm + ((wgid % nig) % gsz); u.pn = (wgid % nig) / gsz; return true;
    }
    __device__ __forceinline__ void a_ready(const Unit&) const {}
    __device__ __forceinline__ void done(const Unit&) const {}
};
__device__ __forceinline__ unsigned cvt_pk_bf16(float lo, float hi) { unsigned r; asm volatile("v_cvt_pk_bf16_f32 %0, %1, %2" : "=v"(r) : "v"(lo), "v"(hi)); return r; }

struct EpiRoute {
    static constexpr bool PERM = true, AFTER_DRAIN = false;
    bf16_t* O; int ldc; int route; bf16_t* pc; bf16_t* prkv; bf16_t* plow;
    __device__ __forceinline__ void operator()(const f32x4 (&acc)[2][2][4][2], const Unit& u, int wr, int wc, int fr, int fq) const {
        const int row0 = u.pm * BM + wr * 64 + fr;
#pragma unroll
        for (int bj = 0; bj < 2; ++bj) {
            int colh = u.pn * BM + bj * HALF; bf16_t* base = O; int ld = ldc;
            if (route) {
                if (colh < 768) { base = pc; ld = 768; }
                else if (colh < 2304) { base = prkv; ld = 1536; colh -= 768; }
                else if (colh < 2688) { base = plow; ld = 384; colh -= 2304; }
                else continue;
            }
            const int col0 = colh + wc * 32 + 8 * fq;
#pragma unroll
            for (int ai = 0; ai < 2; ++ai)
#pragma unroll
                for (int m = 0; m < 4; ++m) { bf16_t* rowp = base + (size_t)(row0 + ai * HALF + m * 16) * ld + col0;
                    const f32x4 v0 = acc[ai][bj][m][0], v1 = acc[ai][bj][m][1];
                    u32x4 w; w.x = cvt_pk_bf16(v0[0], v0[1]); w.y = cvt_pk_bf16(v0[2], v0[3]); w.z = cvt_pk_bf16(v1[0], v1[1]); w.w = cvt_pk_bf16(v1[2], v1[3]);
                    *(u32x4*)rowp = w; }
        }
    }
};
struct EpiGateUp {
    static constexpr bool PERM = true, AFTER_DRAIN = false;
    bf16_t* ACT;
    __device__ __forceinline__ void operator()(const f32x4 (&acc)[2][2][4][2], const Unit& u, int wr, int wc, int fr, int fq) const {
        const int row0 = u.pm * BM + wr * 64 + fr, col0 = u.pn * HALF + wc * 32 + 8 * fq;
#pragma unroll
        for (int ai = 0; ai < 2; ++ai)
#pragma unroll
            for (int m = 0; m < 4; ++m) { bf16_t* rowp = ACT + (size_t)(row0 + ai * HALF + m * 16) * 2816 + col0;
                float v[8];
#pragma unroll
                for (int n = 0; n < 2; ++n)
#pragma unroll
                    for (int j = 0; j < 4; ++j) { const float g = acc[ai][0][m][n][j], uu = acc[ai][1][m][n][j]; v[n * 4 + j] = g * __builtin_amdgcn_rcpf(1.f + __expf(-g)) * uu; }
                u32x4 w; w.x = cvt_pk_bf16(v[0], v[1]); w.y = cvt_pk_bf16(v[2], v[3]); w.z = cvt_pk_bf16(v[4], v[5]); w.w = cvt_pk_bf16(v[6], v[7]);
                *(u32x4*)rowp = w; }
    }
};
template <class Epi, class Sched, bool STAMP = false>
__device__ __forceinline__ void gemm_phase(PG8_LAS unsigned char* lds, const Gemm g, const Sched& S, const Epi& E, unsigned long long* stamps) {
    const int tid = threadIdx.x, wid = __builtin_amdgcn_readfirstlane(tid >> 6), lane = tid & 63, wr = wid >> 2, wc = wid & 3, fr = lane & 15, fq = lane >> 4;
    const int K = g.K, nt = K / BK;
    int ts_lo = 0, ts_hi = 0, nts = 0; const unsigned long long rt_entry = STAMP ? (unsigned long long)wall_clock64() : 0ull;
#define PG8_STAMP() do { if (STAMP && wid == 0 && nts < 64) { const unsigned long long _c = (unsigned long long)clock64(); \
        ts_lo = (lane == nts) ? (int)(unsigned)_c : ts_lo; ts_hi = (lane == nts) ? (int)(unsigned)(_c >> 32) : ts_hi; ++nts; } } while (0)
    PG8_STAMP();
    unsigned voffA[2], voffB[2];
#pragma unroll
    for (int i = 0; i < 2; ++i) { int R, C; stage_rc(tid * 16 + i * 8192, R, C); const int Rb = Epi::PERM ? ((R & ~31) + perm32(R & 31)) : R;
        voffA[i] = (unsigned)(R * K + C) * 2u; voffB[i] = (unsigned)(Rb * K + C) * 2u; }
    const size_t kstep = (size_t)(BK * 2);
    const size_t hstep = (size_t)HALF * K * 2;
    const size_t tstep = 2 * hstep;
    const unsigned ldsw = (unsigned)wid * 1024u;
    const int aoff = lds_byte(wr * 64 + fr, fq * 8), boff = lds_byte(wc * 32 + fr, fq * 8);
#define PG8_SA(b, h) (((b) * 2 + (h)) * HTB)
#define PG8_SB(b, h) ((4 + (b) * 2 + (h)) * HTB)
#define PG8_STAGE(bufoff, gbase, voff) do { _Pragma("unroll") for (int _i = 0; _i < 2; ++_i) \
        __builtin_amdgcn_global_load_lds((const unsigned*)((const char*)(gbase) + (voff)[_i]), (PG8_LAS unsigned*)(lds + (bufoff) + ldsw + _i * 8192), 16, 0, 0); } while (0)
#define PG8_LDA(dst, b, h) do { _Pragma("unroll") for (int m = 0; m < 4; ++m) _Pragma("unroll") for (int k = 0; k < 2; ++k) dst[m][k] = *(const PG8_LAS bf16x8*)(lds + PG8_SA(b, h) + aoff + m * 2048 + k * 1024); } while (0)
#define PG8_LDB(dst, b, h) do { _Pragma("unroll") for (int n = 0; n < 2; ++n) _Pragma("unroll") for (int k = 0; k < 2; ++k) dst[n][k] = *(const PG8_LAS bf16x8*)(lds + PG8_SB(b, h) + boff + n * 2048 + k * 1024); } while (0)
#define PG8_MMA(ai, bj, At, Bt) do { __builtin_amdgcn_s_setprio(1); _Pragma("unroll") for (int m = 0; m < 4; ++m) _Pragma("unroll") for (int n = 0; n < 2; ++n) _Pragma("unroll") for (int k = 0; k < 2; ++k) \
        acc[ai][bj][m][n] = __builtin_amdgcn_mfma_f32_16x16x32_bf16(Bt[n][k], At[m][k], acc[ai][bj][m][n], 0, 0, 0); __builtin_amdgcn_s_setprio(0); } while (0)
#define PG8_WAIT_V(n) asm volatile("s_waitcnt vmcnt(" #n ")" ::: "memory")
#define PG8_WAIT_L(n) asm volatile("s_waitcnt lgkmcnt(" #n ")" ::: "memory")
#define PG8_BAR __builtin_amdgcn_s_barrier()
#define PG8_SCHED __builtin_amdgcn_sched_barrier(0)
    Unit cur, nxt; int ui = 0;
    if (!S.next(0, cur)) return;
    f32x4 acc[2][2][4][2];
#pragma unroll
    for (int a = 0; a < 2; ++a)
#pragma unroll
        for (int b = 0; b < 2; ++b)
#pragma unroll
            for (int m = 0; m < 4; ++m)
#pragma unroll
                for (int n = 0; n < 2; ++n) acc[a][b][m][n] = (f32x4){0.f, 0.f, 0.f, 0.f};
    bf16x8 At[4][2], B0[2][2], B1[2][2];
    const char* cA = (const char*)g.A + (size_t)cur.pm * tstep; const char* cB = (const char*)g.Bt + (size_t)cur.pn * tstep;
    S.a_ready(cur);
    PG8_STAGE(PG8_SB(0, 0), cB, voffB); PG8_STAGE(PG8_SA(0, 0), cA, voffA); PG8_STAGE(PG8_SB(0, 1), cB + hstep, voffB); PG8_STAGE(PG8_SA(0, 1), cA + hstep, voffA);
    if (wr == 1) PG8_BAR;
    PG8_WAIT_V(4); PG8_BAR;
    PG8_STAGE(PG8_SB(1, 0), cB + kstep, voffB); PG8_STAGE(PG8_SA(1, 0), cA + kstep, voffA); PG8_STAGE(PG8_SB(1, 1), cB + hstep + kstep, voffB);
    PG8_WAIT_V(6); PG8_BAR;
    PG8_STAMP();
    for (;;) {
        const bool has_next = S.next(ui + 1, nxt);
        const char* nA = has_next ? (const char*)g.A + (size_t)nxt.pm * tstep : cA; const char* nB = has_next ? (const char*)g.Bt + (size_t)nxt.pn * tstep : cB;
        for (int t = 0; t < nt; t += 2) {
            const bool last = (t == nt - 2);
            const char* a1 = cA + (size_t)(t + 1) * kstep;
            const char* a2 = last ? nA : cA + (size_t)(t + 2) * kstep; const char* b2 = last ? nB : cB + (size_t)(t + 2) * kstep;
            const char* a3 = a2 + kstep; const char* b3 = b2 + kstep;
            if (last && has_next) S.a_ready(nxt);
            PG8_LDB(B0, 0, 0); PG8_SCHED; PG8_LDA(At, 0, 0); PG8_STAGE(PG8_SA(1, 1), a1 + hstep, voffA);
            PG8_WAIT_L(8); PG8_BAR; PG8_WAIT_L(0); PG8_MMA(0, 0, At, B0); PG8_BAR; PG8_SCHED;
            PG8_LDB(B1, 0, 1); PG8_STAGE(PG8_SB(0, 0), b2, voffB);
            PG8_BAR; PG8_WAIT_L(0); PG8_MMA(0, 1, At, B1); PG8_BAR;
            PG8_LDA(At, 0, 1); PG8_STAGE(PG8_SA(0, 0), a2, voffA);
            PG8_BAR; PG8_WAIT_L(0); PG8_MMA(1, 0, At, B0); PG8_BAR; PG8_SCHED;
            PG8_STAGE(PG8_SB(0, 1), b2 + hstep, voffB);
            PG8_WAIT_V(6); PG8_BAR; PG8_MMA(1, 1, At, B1); PG8_BAR;
            PG8_LDB(B0, 1, 0); PG8_SCHED; PG8_LDA(At, 1, 0); PG8_STAGE(PG8_SA(0, 1), a2 + hstep, voffA);
            PG8_WAIT_L(8); PG8_BAR; PG8_WAIT_L(0); PG8_MMA(0, 0, At, B0); PG8_BAR; PG8_SCHED;
            PG8_LDB(B1, 1, 1); PG8_STAGE(PG8_SB(1, 0), b3, voffB);
            PG8_BAR; PG8_WAIT_L(0); PG8_MMA(0, 1, At, B1); PG8_BAR;
            PG8_LDA(At, 1, 1); PG8_STAGE(PG8_SA(1, 0), a3, voffA);
            PG8_BAR; PG8_WAIT_L(0); PG8_MMA(1, 0, At, B0); PG8_BAR; PG8_SCHED;
            PG8_STAGE(PG8_SB(1, 1), b3 + hstep, voffB);
            PG8_WAIT_V(6); PG8_BAR; PG8_MMA(1, 1, At, B1); PG8_BAR;
        }
        PG8_STAMP();
        if constexpr (!Epi::AFTER_DRAIN) { E(acc, cur, wr, wc, fr, fq); S.done(cur); }
        PG8_STAMP();
        if (!has_next) break;
#pragma unroll
        for (int a = 0; a < 2; ++a)
#pragma unroll
            for (int b = 0; b < 2; ++b)
#pragma unroll
                for (int m = 0; m < 4; ++m)
#pragma unroll
                    for (int n = 0; n < 2; ++n) acc[a][b][m][n] = (f32x4){0.f, 0.f, 0.f, 0.f};
        cur = nxt; cA = nA; cB = nB; ++ui;
    }
    PG8_WAIT_V(0);
    if (wr == 0) PG8_BAR;
    PG8_BAR;
    if constexpr (Epi::AFTER_DRAIN) { E.fused(acc, cur, wr, wc, fr, fq, lds, wid, lane); S.done(cur); }
    PG8_STAMP();
    if (STAMP && wid == 0) { stamps[lane] = lane < nts ? (((unsigned long long)(unsigned)ts_hi << 32) | (unsigned)ts_lo) : 0ull;
        if (lane == 62) stamps[62] = rt_entry; if (lane == 63) stamps[63] = (unsigned long long)wall_clock64(); }
#undef PG8_STAMP
#undef PG8_SA
#undef PG8_SB
#undef PG8_STAGE
#undef PG8_LDA
#undef PG8_LDB
#undef PG8_MMA
#undef PG8_WAIT_V
#undef PG8_WAIT_L
#undef PG8_BAR
#undef PG8_SCHED
}
}

DI void phase_gemm_big(const bf16_t* A, const bf16_t* W, int N, int K, bf16_t* C, int ldc, int route, char* ws, unsigned char* lds) {
  pg8::Gemm g{A, W, TP_, N, K};
  pg8::StaticOrder S; S.init(TP_, N, gridDim.x, blockIdx.x);
  pg8::EpiRoute E{C, ldc, route, (bf16_t*)(ws + O_PC), (bf16_t*)(ws + O_PRKV), (bf16_t*)(ws + O_PLOW)};
  pg8::gemm_phase<pg8::EpiRoute, pg8::StaticOrder, false>((PG8_LAS unsigned char*)lds, g, S, E, nullptr);
}
DI void phase_gemm_gateup(const bf16_t* A, const bf16_t* W, bf16_t* ACT, unsigned char* lds) {
  pg8::Gemm g{A, W, TP_, 5632, 1024};
  pg8::StaticOrder S; S.init(TP_, 5632, gridDim.x, blockIdx.x);
  pg8::EpiGateUp E{ACT};
  pg8::gemm_phase<pg8::EpiGateUp, pg8::StaticOrder, false>((PG8_LAS unsigned char*)lds, g, S, E, nullptr);
}

DI void phase_resnorm(const P& p, const float* g1, const float* g2) {
  const int lane = threadIdx.x & 63, gw = (blockIdx.x * NTH + threadIdx.x) >> 6, nw = (gridDim.x * NTH) >> 6;
  bf16_t* HN = (bf16_t*)(p.ws + O_HN);
  for (int sr = gw; sr < T_; sr += nw) {
    float* hr = hrow(p, sr);
    float x[16];
    float ss = 0.f;
#pragma unroll
    for (int q = 0; q < 4; ++q) {
      const uint2 u = *(const uint2*)(HN + (size_t)sr * 1024 + q * 256 + lane * 4);
      x[q * 4] = lo2f(u.x); x[q * 4 + 1] = hi2f(u.x); x[q * 4 + 2] = lo2f(u.y); x[q * 4 + 3] = hi2f(u.y);
      ss += x[q * 4] * x[q * 4] + x[q * 4 + 1] * x[q * 4 + 1] + x[q * 4 + 2] * x[q * 4 + 2] + x[q * 4 + 3] * x[q * 4 + 3];
    }
    f32x4v hh[4];
#pragma unroll
    for (int q = 0; q < 4; ++q) hh[q] = *(const f32x4v*)(hr + q * 256 + lane * 4);
    ss = wave_sum(ss);
    const float rs = rsqrtf(ss * (1.f / 1024.f) + EPS);
    float ss2 = 0.f;
#pragma unroll
    for (int q = 0; q < 4; ++q) {
      const float4 g = *(const float4*)(g1 + q * 256 + lane * 4);
      hh[q].x += x[q * 4 + 0] * rs * g.x; hh[q].y += x[q * 4 + 1] * rs * g.y; hh[q].z += x[q * 4 + 2] * rs * g.z; hh[q].w += x[q * 4 + 3] * rs * g.w;
      *(f32x4v*)(hr + q * 256 + lane * 4) = hh[q];
      ss2 += hh[q].x * hh[q].x + hh[q].y * hh[q].y + hh[q].z * hh[q].z + hh[q].w * hh[q].w;
    }
    if (g2) {
      ss2 = wave_sum(ss2);
      const float rs2 = rsqrtf(ss2 * (1.f / 1024.f) + EPS);
#pragma unroll
      for (int q = 0; q < 4; ++q) {
        const float4 g = *(const float4*)(g2 + q * 256 + lane * 4);
        *(uint2*)(HN + (size_t)sr * 1024 + q * 256 + lane * 4) = make_uint2(pack2(hh[q].x * rs2 * g.x, hh[q].y * rs2 * g.y), pack2(hh[q].z * rs2 * g.z, hh[q].w * rs2 * g.w));
      }
    }
  }
}

DI size_t vta_base(int seq) { return seq < 8 ? (size_t)seq * 256 * 4160 : (size_t)8 * 256 * 4160; }
template <int NC> DI void vt_transpose(const bf16_t* src, int ld, int col0, bf16_t* VT, char* lds) {
  bf16_t* tl = (bf16_t*)lds;
  const int tid = threadIdx.x;
  constexpr int CPT = NC / 8, TPR = 512 / NC, PPT = 64 / TPR;
  for (int it = blockIdx.x; it < 257 + 8 * 65; it += gridDim.x) {
    int seq, kt;
    if (it < 257) { seq = 8; kt = it; } else { const int j = it - 257; seq = j / 65; kt = j - seq * 65; }
    const int L = seq_len(seq), LP = L + 48, sbase = seq_base(seq);
    const size_t vb = (seq < 8 ? (size_t)seq * NC * 4160 : (size_t)8 * NC * 4160);
    __syncthreads();
    const int pl = tid >> 3, part = tid & 7;
    const int pos = 64 * kt + pl - 48;
#pragma unroll
    for (int q = 0; q < CPT / 8; ++q) {
      u32x4 v = (u32x4)(0u);
      if (pos >= 0) v = *(const u32x4*)(src + (size_t)(sbase + pos) * ld + col0 + part * CPT + q * 8);
#pragma unroll
      for (int j = 0; j < 4; ++j) {
        tl[(part * CPT + q * 8 + 2 * j) * 72 + pl] = (bf16_t)(v[j] & 0xffffu);
        tl[(part * CPT + q * 8 + 2 * j + 1) * 72 + pl] = (bf16_t)(v[j] >> 16);
      }
    }
    __syncthreads();
    const int row = tid / TPR, seg = tid % TPR;
    bf16_t* dst = VT + vb + (size_t)row * LP + 64 * kt + seg * PPT;
#pragma unroll
    for (int q = 0; q < PPT / 8; ++q) *(u32x4*)(dst + q * 8) = *(const u32x4*)(tl + row * 72 + seg * PPT + q * 8);
  }
}

DI void phase_prepA(const P& p, char* lds) {
  const int lane = threadIdx.x & 63, wave = threadIdx.x >> 6;
  bf16_t* PROJ = (bf16_t*)(p.ws + O_PROJ0);
  bf16_t* ZB = (bf16_t*)(p.ws + O_ZB);
  const float* WC = (const float*)(p.ws + O_WC);
  vt_transpose<256>(PROJ, 1536, 1024, (bf16_t*)(p.ws + O_VTA), lds);
  __syncthreads();
  float* fl = (float*)lds + wave * 1024;
  const float inv = exp2f(-(float)(lane & 15) * (13.287712379549449f / 16.f));
  const float qg = p.a_q_gain[lane], kg = p.a_k_gain[lane];
  for (int r0 = blockIdx.x * 32; r0 < TP_; r0 += gridDim.x * 32) {
    const int srb = r0 + wave * 4;
#pragma unroll 1
    for (int rr = 0; rr < 4; ++rr) {
      const int sr = srb + rr;
      if (sr < T_) {
        int pos; seq_of(sr, pos);
        float rowf, colf;
        if (pos < 16) { rowf = colf = (float)(pos - 16); }
        else { int t = pos - 16; rowf = (float)(t >> 6); colf = (float)(t & 63); }
        float ang = (lane < 32 ? rowf : colf) * inv;
        float sn, cs;
        sincosf(ang, &sn, &cs);
        const float sgn = (lane & 16) ? sn : -sn;
        bf16_t* pr = PROJ + (size_t)sr * 1536;
        for (int hd = 0; hd < 16; ++hd) {
          float x = bf2f(pr[hd * 64 + lane]);
          float ss = wave_sum(x * x);
          float xn = x * rsqrtf(ss * (1.f / 64.f) + EPS) * (hd < 12 ? qg : kg);
          float pa = __shfl_xor(xn, 16);
          float o = xn * cs + pa * sgn;
          if (hd < 12) o *= 0.125f * LOG2E;
          pr[hd * 64 + lane] = f2bf(o);
        }
        uint2 u = *(const uint2*)(pr + 1280 + lane * 4);
        float f0 = lo2f(u.x), f1 = hi2f(u.x), f2 = lo2f(u.y), f3 = hi2f(u.y);
        float ss = f0 * f0 + f1 * f1 + f2 * f2 + f3 * f3;
        ss += __shfl_xor(ss, 1); ss += __shfl_xor(ss, 2); ss += __shfl_xor(ss, 4); ss += __shfl_xor(ss, 8);
        float rs = rsqrtf(ss * (1.f / 64.f) + EPS);
        float4 g = *(const float4*)(p.b_norm_g + lane * 4);
        *(float4*)(fl + rr * 256 + lane * 4) = make_float4(f0 * rs * g.x, f1 * rs * g.y, f2 * rs * g.z, f3 * rs * g.w);
      } else {
        *(float4*)(fl + rr * 256 + lane * 4) = make_float4(0.f, 0.f, 0.f, 0.f);
      }
    }
    __syncthreads();
    {
      const int g = lane >> 4, o0 = (lane & 15) * 8;
      float acc[4][8];
#pragma unroll
      for (int rr = 0; rr < 4; ++rr)
#pragma unroll
        for (int j = 0; j < 8; ++j) acc[rr][j] = 0.f;
      const float* wc = WC + (size_t)g * 64 * 128 + o0;
#pragma unroll 4
      for (int c = 0; c < 64; ++c) {
        const float4 w0 = *(const float4*)(wc + c * 128), w1 = *(const float4*)(wc + c * 128 + 4);
#pragma unroll
        for (int rr = 0; rr < 4; ++rr) {
          const float f = fl[rr * 256 + g * 64 + c];
          acc[rr][0] += f * w0.x; acc[rr][1] += f * w0.y; acc[rr][2] += f * w0.z; acc[rr][3] += f * w0.w;
          acc[rr][4] += f * w1.x; acc[rr][5] += f * w1.y; acc[rr][6] += f * w1.z; acc[rr][7] += f * w1.w;
        }
      }
#pragma unroll
      for (int rr = 0; rr < 4; ++rr)
        if (srb + rr < T_)
          *(uint4*)(ZB + (size_t)(srb + rr) * 512 + g * 128 + o0) = make_uint4(pack2(acc[rr][0], acc[rr][1]), pack2(acc[rr][2], acc[rr][3]), pack2(acc[rr][4], acc[rr][5]), pack2(acc[rr][6], acc[rr][7]));
    }
    __syncthreads();
  }
}

template <int MODE>
DI void flash_item(const bf16_t* __restrict__ Q, int ldq, const bf16_t* __restrict__ Kb, int ldk, const bf16_t* __restrict__ Vt, int LP,
                   bf16_t* O, int ldo, int sbase, int S, int qt, float sinkl2, char* lds) {
  const int tid = threadIdx.x & 255, lane = tid & 63, wave = tid >> 6, l31 = lane & 31, h = lane >> 5;
  bf16_t* Ks = (bf16_t*)lds;
  bf16_t* Vs = Ks + 2 * 64 * 72;
  const int rl = wave * 32 + l31;
  const int qpos = qt == 0 ? (rl < 16 ? rl : 15) : 16 + 128 * (qt - 1) + rl;
  const bool qvalid = qt > 0 || rl < 16;
  bf16x8 qf[4];
  {
    const bf16_t* qr = Q + (size_t)(sbase + qpos) * ldq;
#pragma unroll
    for (int s = 0; s < 4; ++s) qf[s] = *(const bf16x8*)(qr + 16 * s + 8 * h);
  }
  const int nkt_all = (S + 64) / 64;
  int klo = 1, n;
  if (MODE == 0) { n = nkt_all; }
  else {
    if (qt == 0) { klo = 1; n = 3; }
    else {
      int c = qt - 1;
      klo = 2 * c - 1; if (klo < 1) klo = 1;
      int khi = 2 * c + 4; if (khi > nkt_all - 1) khi = nkt_all - 1;
      n = 1 + (khi - klo + 1);
    }
  }
  const int ldr = tid >> 2, ldp = (tid & 3) * 16;
  u32x4 rk0, rk1, rv0, rv1;
  auto ktile = [&](int idx) { return idx == 0 ? 0 : klo + idx - 1; };
#define FL_GLOAD(idx)                                                                               \
  {                                                                                                 \
    int kt_ = ktile(idx);                                                                           \
    int pos_ = 64 * kt_ + ldr - 48;                                                                 \
    if (pos_ >= 0) {                                                                                \
      const bf16_t* kp_ = Kb + (size_t)(sbase + pos_) * ldk + ldp;                                  \
      rk0 = *(const u32x4*)kp_; rk1 = *(const u32x4*)(kp_ + 8);                                 \
    } else { rk0 = (u32x4)(0u); rk1 = rk0; }                                       \
    const bf16_t* vp_ = Vt + (size_t)ldr * LP + 64 * kt_ + ldp;                                     \
    rv0 = *(const u32x4*)vp_; rv1 = *(const u32x4*)(vp_ + 8);                                   \
  }
#define FL_SSTORE(buf)                                                                              \
  {                                                                                                 \
    *(u32x4*)(Ks + (buf) * 64 * 72 + ldr * 72 + ldp) = rk0; *(u32x4*)(Ks + (buf) * 64 * 72 + ldr * 72 + ldp + 8) = rk1; \
    { bf16_t* vd_ = Vs + (buf) * 64 * 68 + ldr * 68 + ldp; *(uint2*)vd_ = make_uint2(rv0.x, rv0.y); *(uint2*)(vd_ + 4) = make_uint2(rv0.z, rv0.w); *(uint2*)(vd_ + 8) = make_uint2(rv1.x, rv1.y); *(uint2*)(vd_ + 12) = make_uint2(rv1.z, rv1.w); } \
  }
  f32x16 oacc[2];
#pragma unroll
  for (int i = 0; i < 16; ++i) { oacc[0][i] = 0.f; oacc[1][i] = 0.f; }
  float m = MODE == 1 ? -1e30f : 0.f, l = 0.f;
  FL_GLOAD(0)
  FL_SSTORE(0)
  __syncthreads();
  for (int idx = 0; idx < n; ++idx) {
    const int cur = idx & 1;
    if (idx + 1 < n) FL_GLOAD(idx + 1)
    const int kt = ktile(idx);
    const bf16_t* ks = Ks + cur * 64 * 72;
    const bf16_t* vs = Vs + cur * 64 * 68;
    f32x16 sacc[2];
    {
      bf16x8 kf[2][4];
#pragma unroll
      for (int t = 0; t < 2; ++t)
#pragma unroll
        for (int s = 0; s < 4; ++s) kf[t][s] = *(const bf16x8*)(ks + (32 * t + l31) * 72 + 16 * s + 8 * h);
#pragma unroll
      for (int t = 0; t < 2; ++t)
#pragma unroll
        for (int i = 0; i < 16; ++i) sacc[t][i] = 0.f;
      __builtin_amdgcn_sched_barrier(0);
#pragma unroll
      for (int s = 0; s < 4; ++s)
#pragma unroll
        for (int t = 0; t < 2; ++t) sacc[t] = MFMA32(kf[t][s], qf[s], sacc[t]);
    }
    bf16x8 vfr[2][2][2];
#pragma unroll
    for (int t = 0; t < 2; ++t)
#pragma unroll
      for (int s2 = 0; s2 < 2; ++s2)
#pragma unroll
        for (int dt = 0; dt < 2; ++dt) {
          const bf16_t* vp = vs + (32 * dt + l31) * 68 + 32 * t + 16 * s2 + 4 * h;
          uint2 lo = *(const uint2*)vp, hi = *(const uint2*)(vp + 8);
          u32x4 v4 = {lo.x, lo.y, hi.x, hi.y};
          vfr[t][s2][dt] = __builtin_bit_cast(bf16x8, v4);
        }
    __builtin_amdgcn_sched_barrier(0);
    if (kt == 0) {
#pragma unroll
      for (int t = 0; t < 2; ++t)
#pragma unroll
        for (int i = 0; i < 16; ++i) {
          int kl = 32 * t + (i & 3) + 8 * (i >> 2) + 4 * h;
          if (kl < 48) sacc[t][i] = -1e30f;
        }
    } else if (MODE == 1) {
#pragma unroll
      for (int t = 0; t < 2; ++t)
#pragma unroll
        for (int i = 0; i < 16; ++i) {
          int kl = 32 * t + (i & 3) + 8 * (i >> 2) + 4 * h;
          int tk = 64 * (kt - 1) + kl;
          bool vis;
          if (qt == 0) vis = tk <= 112 + qpos;
          else { int tq = qpos - 16; int d = tq - tk; vis = d <= 128 && d >= -128; }
          if (!vis) sacc[t][i] = -1e30f;
        }
    }
    float tmax = -1e30f;
    if (MODE == 1) {
#pragma unroll
      for (int t = 0; t < 2; ++t)
#pragma unroll
        for (int i = 0; i < 16; ++i) tmax = fmaxf(tmax, sacc[t][i]);
      tmax = fmaxf(tmax, __shfl_xor(tmax, 32));
    }
    if (MODE == 1 && __builtin_amdgcn_ballot_w64(tmax > m) != 0ull) {
      const float mn = fmaxf(m, tmax);
      const float alpha = __builtin_amdgcn_exp2f(m - mn);
      m = mn;
      l *= alpha;
#pragma unroll
      for (int i = 0; i < 16; ++i) { oacc[0][i] *= alpha; oacc[1][i] *= alpha; }
    }
    const f32x2 m2 = {m, m};
    f32x2 ls2 = {0.f, 0.f};
    unsigned pk[2][8];
#pragma unroll
    for (int t = 0; t < 2; ++t)
#pragma unroll
      for (int i2 = 0; i2 < 8; ++i2) {
        f32x2 d = {sacc[t][2 * i2], sacc[t][2 * i2 + 1]};
        if (MODE == 1) d = d - m2;
        f32x2 e = {__builtin_amdgcn_exp2f(d.x), __builtin_amdgcn_exp2f(d.y)};
        ls2 += e;
        pk[t][i2] = __builtin_bit_cast(unsigned, __builtin_convertvector(e, bf16x2_t));
      }
    l += ls2.x + ls2.y;
#pragma unroll
    for (int t = 0; t < 2; ++t)
#pragma unroll
      for (int s2 = 0; s2 < 2; ++s2) {
        u32x4 pk4 = {pk[t][4 * s2], pk[t][4 * s2 + 1], pk[t][4 * s2 + 2], pk[t][4 * s2 + 3]};
        bf16x8 pf = __builtin_bit_cast(bf16x8, pk4);
#pragma unroll
        for (int dt = 0; dt < 2; ++dt) oacc[dt] = MFMA32(vfr[t][s2][dt], pf, oacc[dt]);
      }
    if (idx + 1 < n) FL_SSTORE(cur ^ 1)
    __syncthreads();
  }
  l += __shfl_xor(l, 32);
  if (MODE == 1) l += __builtin_amdgcn_exp2f(sinkl2 - m);
  const float il = 1.f / l;
  if (qvalid) {
    bf16_t* orow = O + (size_t)(sbase + qpos) * ldo;
#pragma unroll
    for (int dt = 0; dt < 2; ++dt)
#pragma unroll
      for (int g = 0; g < 4; ++g) {
        int d = 32 * dt + 8 * g + 4 * h;
        uint2 o = make_uint2(pack2(oacc[dt][4 * g] * il, oacc[dt][4 * g + 1] * il), pack2(oacc[dt][4 * g + 2] * il, oacc[dt][4 * g + 3] * il));
        *(uint2*)(orow + d) = o;
      }
  }
#undef FL_GLOAD
#undef FL_SSTORE
}

DI void dft4(float& r0, float& i0, float& r1, float& i1, float& r2, float& i2, float& r3, float& i3) {
  const float t0r = r0 + r2, t0i = i0 + i2, t1r = r0 - r2, t1i = i0 - i2;
  const float t2r = r1 + r3, t2i = i1 + i3, t3r = i1 - i3, t3i = r3 - r1;
  r0 = t0r + t2r; i0 = t0i + t2i; r1 = t1r + t3r; i1 = t1i + t3i; r2 = t0r - t2r; i2 = t0i - t2i; r3 = t1r - t3r; i3 = t1i - t3i;
}
DI void dft16(float (&zr)[16], float (&zi)[16]) {
#pragma unroll
  for (int b = 0; b < 4; ++b) dft4(zr[b], zi[b], zr[4 + b], zi[4 + b], zr[8 + b], zi[8 + b], zr[12 + b], zi[12 + b]);
  constexpr float C1 = 0.9238795325112867f, S1 = 0.3826834323650898f, C2 = 0.7071067811865476f;
  const float wr[10] = {1.f, C1, C2, S1, 0.f, 0.f, -C2, 0.f, 0.f, -C1};
  const float wi[10] = {0.f, -S1, -C2, -C1, -1.f, 0.f, -C2, 0.f, 0.f, S1};
#pragma unroll
  for (int q = 1; q < 4; ++q)
#pragma unroll
    for (int b = 1; b < 4; ++b) {
      const float c = wr[b * q], d = wi[b * q];
      const float xr = zr[4 * q + b], xi = zi[4 * q + b];
      zr[4 * q + b] = xr * c - xi * d; zi[4 * q + b] = xr * d + xi * c;
    }
#pragma unroll
  for (int q = 0; q < 4; ++q) dft4(zr[4 * q], zi[4 * q], zr[4 * q + 1], zi[4 * q + 1], zr[4 * q + 2], zi[4 * q + 2], zr[4 * q + 3], zi[4 * q + 3]);
}

DI size_t y_base(int seq) { return seq < 8 ? (size_t)seq * 16 * 256 * 576 : (size_t)8 * 16 * 256 * 576; }
DI void phase_attnA(const P& p, char* lds) {
  const bf16_t* PROJ = (const bf16_t*)(p.ws + O_PROJ0);
  const bf16_t* VT = (const bf16_t*)(p.ws + O_VTA);
  bf16_t* MIX = (bf16_t*)(p.ws + O_MIX);
  const int nS = 129 * 6, nP = 8 * 33 * 6;
  const int sb = threadIdx.x >> 8;
  unsigned* head = (unsigned*)(p.ws + O_CNT);
  for (;;) {
    if (threadIdx.x == 0) *(volatile int*)(lds + 2 * 36864) = (int)__hip_atomic_fetch_add(head, 1u, __ATOMIC_RELAXED, __HIP_MEMORY_SCOPE_AGENT);
    __syncthreads();
    const int it = *(volatile int*)(lds + 2 * 36864);
    __syncthreads();
    if (it >= nS + nP) break;
    int seq, qt, hq;
    if (it < nS) { seq = 8; hq = (it % 6) * 2 + sb; qt = it / 6; }
    else { int j = it - nS; hq = (j % 6) * 2 + sb; j /= 6; qt = j % 33; seq = j / 33; }
    const int kv = hq / 3;
    const int L = seq_len(seq), LP = L + 48;
    flash_item<0>(PROJ + hq * 64, 1536, PROJ + 768 + kv * 64, 1536, VT + vta_base(seq) + (size_t)kv * 64 * LP, LP,
                  MIX + hq * 64, 1024, seq_base(seq), L - 16, qt, 0.f, lds + sb * 36864);
  }
  const bf16_t* ZB = (const bf16_t*)(p.ws + O_ZB);
  bf16_t* Y = (bf16_t*)(p.ws + O_Y);
  const int lane = threadIdx.x & 63, wave = threadIdx.x >> 6;
  const int nI_S = 17 * 16, nI_P = 8 * 5 * 16;
  for (int it = blockIdx.x; it < nI_S + nI_P; it += gridDim.x) {
    int seq, nb, cb;
    if (it < nI_S) { seq = 8; cb = it & 15; nb = it >> 4; }
    else { int j = it - nI_S; cb = j & 15; j >>= 4; nb = j % 5; seq = j / 5; }
    const int M = seq < 8 ? 257 : 1025, KP = seq < 8 ? 576 : 2112, L = 16 * M;
    const int n2 = nb * 64 + lane;
    const int ch = cb * 16 + wave * 2;
    const int g = ch >> 6, d = ch & 63;
    bf16_t* yb = Y + y_base(seq);
    if (n2 < M) {
      float ar[16], ai[16], br[16], bi[16];
#pragma unroll
      for (int n1 = 0; n1 < 16; ++n1) {
        const bf16_t* zp = ZB + (size_t)(seq_base(seq) + M * n1 + n2) * 512 + g * 128 + d;
        unsigned re = *(const unsigned*)zp, im = *(const unsigned*)(zp + 64);
        ar[n1] = lo2f(re); br[n1] = hi2f(re); ai[n1] = lo2f(im); bi[n1] = hi2f(im);
      }
      dft16(ar, ai);
      dft16(br, bi);
      float t1s, t1c;
      sincospif(-2.f * (float)n2 / (float)L, &t1s, &t1c);
      float tc = 1.f, ts = 0.f;
#pragma unroll
      for (int k1 = 0; k1 < 16; ++k1) {
        const int ix = 4 * (k1 & 3) + (k1 >> 2);
        const float yr0 = ar[ix] * tc - ai[ix] * ts, yi0 = ar[ix] * ts + ai[ix] * tc;
        const float yr1 = br[ix] * tc - bi[ix] * ts, yi1 = br[ix] * ts + bi[ix] * tc;
        bf16_t* y0 = yb + ((size_t)k1 * 256 + ch) * KP;
        y0[n2] = f2bf(yr0); y0[M + n2] = f2bf(yi0);
        y0[KP + n2] = f2bf(yr1); y0[KP + M + n2] = f2bf(yi1);
        const float nc = tc * t1c - ts * t1s; ts = tc * t1s + ts * t1c; tc = nc;
      }
    } else if (n2 < KP - M) {
      for (int k1 = 0; k1 < 16; ++k1) {
        bf16_t* y0 = yb + ((size_t)k1 * 256 + ch) * KP;
        y0[M + n2] = 0; y0[KP + M + n2] = 0;
      }
    }
  }
}

DI void phase_fnet_gemm(const P& p, char* lds) {
  GEMM_IDS
  bf16_t* MIX = (bf16_t*)(p.ws + O_MIX);
  const bf16_t* Y = (const bf16_t*)(p.ws + O_Y);
  const int nS = 16 * 9 * 2, nP = 8 * 16 * 3 * 2;
  const int sb = threadIdx.x >> 8;
  for (int it0 = blockIdx.x * 2; it0 < nS + nP; it0 += gridDim.x * 2) {
    const int it = it0 + sb;
    int seq, k1, tm, tn;
    if (it < nS) { seq = 8; tn = it & 1; int j = it >> 1; tm = j % 9; k1 = j / 9; }
    else { int j = it - nS; tn = j & 1; j >>= 1; tm = j % 3; j /= 3; k1 = j & 15; seq = j >> 4; }
    const int M = seq < 8 ? 257 : 1025, KP = seq < 8 ? 576 : 2112, L = 16 * M;
    const bf16_t* dm = (const bf16_t*)(p.ws + (seq < 8 ? O_DM257 : O_DM1025));
    f32x16 acc[2][2];
    gemm_tile(dm + (size_t)tm * 128 * KP, KP, Y + y_base(seq) + ((size_t)k1 * 256 + tn * 128) * KP, KP, KP, lds + sb * 36864, acc);
    const float scale = rsqrtf(64.f * (float)L);
#pragma unroll
    for (int mt = 0; mt < 2; ++mt)
#pragma unroll
      for (int nt = 0; nt < 2; ++nt)
#pragma unroll
        for (int i = 0; i < 16; ++i) {
          int k2 = tm * 128 + ACC_ROW(mt, i), ch = tn * 128 + ACC_COL(nt);
          if (k2 < M) {
            int pos = k1 + 16 * k2;
            MIX[(size_t)(seq_base(seq) + pos) * 1024 + 768 + ch] = f2bf(acc[mt][nt][i] * scale + p.b_b[ch]);
          }
        }
  }
}

DI size_t vtc_base(int seq) { return seq < 8 ? (size_t)seq * 128 * 4160 : (size_t)8 * 128 * 4160; }
DI void phase_prepC(const P& p, char* lds) {
  const int gtid = blockIdx.x * NTH + threadIdx.x, gsz = gridDim.x * NTH;
  const int lane = threadIdx.x & 63, gw = gtid >> 6, nw = gsz >> 6;
  bf16_t* PC = (bf16_t*)(p.ws + O_PC);
  bf16_t* VT = (bf16_t*)(p.ws + O_VTC);
  const bf16_t* PLOW = (const bf16_t*)(p.ws + O_PLOW);
  bf16_t* LR = (bf16_t*)(p.ws + O_LR);
  vt_transpose<128>(PC, 768, 640, VT, lds);
  for (int sr = gw; sr < T_; sr += nw) {
    int pos; int b = seq_of(sr, pos);
    const int L = seq_len(b), LP = L + 48;
    bf16_t* pr = PC + (size_t)sr * 768;
    float cs[8], sn[8];
    {
      float s1, c1;
      sincosf((float)pos * exp2f(-(float)(lane & 7) * (18.931568569324174f / 8.f)), &s1, &c1);
#pragma unroll
      for (int j = 0; j < 8; ++j) { sn[j] = __shfl(s1, j); cs[j] = __shfl(c1, j); }
    }
#pragma unroll
    for (int part = 0; part < 2; ++part) {
      const bool act = part == 0 || lane < 16;
      const int col = part * 512 + (act ? lane : 0) * 8;
      uint4 u = *(const uint4*)(pr + col);
      float e[8] = {lo2f(u.x), hi2f(u.x), lo2f(u.y), hi2f(u.y), lo2f(u.z), hi2f(u.z), lo2f(u.w), hi2f(u.w)};
      float o[8];
#pragma unroll
      for (int j = 0; j < 8; ++j) {
        float pa = __shfl_xor(e[j], 1);
        float rot = e[j] * cs[j] + pa * ((lane & 1) ? sn[j] : -sn[j]);
        o[j] = (lane & 7) < 2 ? rot : e[j];
        if (part == 0) o[j] *= 0.125f * LOG2E;
      }
      if (act) *(uint4*)(pr + col) = make_uint4(pack2(o[0], o[1]), pack2(o[2], o[3]), pack2(o[4], o[5]), pack2(o[6], o[7]));
    }
#pragma unroll
    for (int q = 0; q < 6; ++q) {
      int c = q * 64 + lane;
      float u = bf2f(PLOW[(size_t)sr * 384 + c]);
      float up = pos > 0 ? bf2f(PLOW[(size_t)(sr - 1) * 384 + c]) : 0.f;
      float un = pos < L - 1 ? bf2f(PLOW[(size_t)(sr + 1) * 384 + c]) : 0.f;
      float us = u + p.mu_prev[1536 + c] * (up - u) + p.mu_next[1536 + c] * (un - u);
      float v = c < 128 ? tanhf(us) : (c < 256 ? us : sigmoidf_(us));
      LR[(size_t)sr * 384 + c] = f2bf(v);
    }
  }
}

DI void phase_attnC(const P& p, char* lds) {
  const bf16_t* PC = (const bf16_t*)(p.ws + O_PC);
  const bf16_t* VT = (const bf16_t*)(p.ws + O_VTC);
  bf16_t* MIX = (bf16_t*)(p.ws + O_MIX);
  const int nS = 129 * 4, nP = 8 * 33 * 4;
  const int sb = threadIdx.x >> 8;
  for (int it = blockIdx.x; it < nS + nP; it += gridDim.x) {
    int seq, qt, hq;
    if (it < nS) { seq = 8; hq = (it & 3) * 2 + sb; qt = it >> 2; }
    else { int j = it - nS; hq = (j & 3) * 2 + sb; j >>= 2; qt = j % 33; seq = j / 33; }
    const int kv = hq >> 2;
    const int L = seq_len(seq), LP = L + 48;
    flash_item<1>(PC + hq * 64, 768, PC + 512 + kv * 64, 768, VT + vtc_base(seq) + (size_t)kv * 64 * LP, LP,
                  MIX + hq * 64, 1024, seq_base(seq), L - 16, qt, p.c_sink[hq] * LOG2E, lds + sb * 36864);
  }
}

DI void chunk_decode(int cg_, int& seq, int& c) {
  if (cg_ < 136) { seq = cg_ / 17; c = cg_ - seq * 17; } else { seq = 8; c = cg_ - 136; }
}
DI float shiftv(const bf16_t* PRKV, int sr, int pos, int L, int col, float mp, float mn) {
  float u = bf2f(PRKV[(size_t)sr * 1536 + col]);
  float up = pos > 0 ? bf2f(PRKV[(size_t)(sr - 1) * 1536 + col]) : 0.f;
  float un = pos < L - 1 ? bf2f(PRKV[(size_t)(sr + 1) * 1536 + col]) : 0.f;
  return u + mp * (up - u) + mn * (un - u);
}
enum { VW = 0, VA = 1, VB = 2, VK = 3, VV = 4, VR = 5 };
#define DPP_FMAC(acc, x, y, N) asm("v_fmac_f32_dpp %0, %1, %2 row_newbcast:%3 row_mask:0xf bank_mask:0xf" : "+v"(acc) : "v"(x), "v"(y), "n"(N))
#define DPP_MUL(sv_, x, N) asm("v_mul_f32_dpp %0, %1, %0 row_newbcast:%2 row_mask:0xf bank_mask:0xf" : "+v"(sv_) : "v"(x), "n"(N))
template <int N> DI void dpp_dot4(float& a0, float& a1, float& a2, float& a3, const float (&S)[64], const float4& x) {
  DPP_FMAC(a0, x.x, S[N], N); DPP_FMAC(a1, x.y, S[16 + N], N); DPP_FMAC(a2, x.z, S[32 + N], N); DPP_FMAC(a3, x.w, S[48 + N], N);
  if constexpr (N < 15) dpp_dot4<N + 1>(a0, a1, a2, a3, S, x);
}
template <int N, bool HASV, bool OUT> DI void dpp_upd4(float (&S)[64], const float4& xb, const float4& xk, const float4& xr, float sa, float vi,
                                                       float& o0, float& o1, float& o2, float& o3) {
  DPP_FMAC(S[N], xb.x, sa, N); DPP_FMAC(S[16 + N], xb.y, sa, N); DPP_FMAC(S[32 + N], xb.z, sa, N); DPP_FMAC(S[48 + N], xb.w, sa, N);
  if (HASV) { DPP_FMAC(S[N], xk.x, vi, N); DPP_FMAC(S[16 + N], xk.y, vi, N); DPP_FMAC(S[32 + N], xk.z, vi, N); DPP_FMAC(S[48 + N], xk.w, vi, N); }
  if (OUT) { DPP_FMAC(o0, xr.x, S[N], N); DPP_FMAC(o1, xr.y, S[16 + N], N); DPP_FMAC(o2, xr.z, S[32 + N], N); DPP_FMAC(o3, xr.w, S[48 + N], N); }
  if constexpr (N < 15) dpp_upd4<N + 1, HASV, OUT>(S, xb, xk, xr, sa, vi, o0, o1, o2, o3);
}
template <int N> DI void dpp_scale4(float (&S)[64], const float4& xg) {
  DPP_MUL(S[N], xg.x, N); DPP_MUL(S[16 + N], xg.y, N); DPP_MUL(S[32 + N], xg.z, N); DPP_MUL(S[48 + N], xg.w, N);
  if constexpr (N < 15) dpp_scale4<N + 1>(S, xg);
}
template <int NST, bool HASV, bool OUT, class F>
DI void scan_steps(float (&S)[64], const float* sv, int ns, int lane, F&& emit) {
  const int l15 = lane & 15;
  (void)ns;
#pragma unroll 4
  for (int s = 0; s < NST; ++s) {
    const float4 xa = *(const float4*)(sv + VA * NST * 64 + s * 64 + l15 * 4);
    const float4 xb = *(const float4*)(sv + VB * NST * 64 + s * 64 + l15 * 4);
    float4 xk = xb, xr = xb;
    if (HASV) xk = *(const float4*)(sv + VK * NST * 64 + s * 64 + l15 * 4);
    if (OUT) xr = *(const float4*)(sv + VR * NST * 64 + s * 64 + l15 * 4);
    const float vi = HASV ? sv[VV * NST * 64 + s * 64 + lane] : 0.f;
    float sa0 = 0.f, sa1 = 0.f, sa2 = 0.f, sa3 = 0.f;
    dpp_dot4<0>(sa0, sa1, sa2, sa3, S, xa);
    const float sa = (sa0 + sa1) + (sa2 + sa3);
    float o0 = 0.f, o1 = 0.f, o2 = 0.f, o3 = 0.f;
    dpp_upd4<0, HASV, OUT>(S, xb, xk, xr, sa, vi, o0, o1, o2, o3);
    if (OUT) emit(s, (o0 + o1) + (o2 + o3));
    if ((s & 7) == 7) {
      const float4 xg = *(const float4*)(sv + VW * NST * 64 + (s >> 3) * 64 + l15 * 4);
      dpp_scale4<0>(S, xg);
    }
  }
}
DI int vperm(int j) { return (j & 15) * 4 + (j >> 4); }

DI void shift8(const bf16_t* PRKV, const P& p, int sbase, int pos, int L, int off, int c0, float (&out)[8]) {
  const bf16_t* rp = PRKV + (size_t)(sbase + pos) * 1536 + off + c0;
  const u32x4 uc = *(const u32x4*)rp;
  u32x4 up = (u32x4)(0u), un = (u32x4)(0u);
  if (pos > 0) up = *(const u32x4*)(rp - 1536);
  if (pos < L - 1) un = *(const u32x4*)(rp + 1536);
  const f32x4v mp0 = *(const f32x4v*)(p.mu_prev + off + c0), mp1 = *(const f32x4v*)(p.mu_prev + off + c0 + 4);
  const f32x4v mn0 = *(const f32x4v*)(p.mu_next + off + c0), mn1 = *(const f32x4v*)(p.mu_next + off + c0 + 4);
#pragma unroll
  for (int e2 = 0; e2 < 4; ++e2) {
    const float c_lo = lo2f(uc[e2]), c_hi = hi2f(uc[e2]);
    const float mpl = e2 < 2 ? mp0[2 * e2] : mp1[2 * e2 - 4], mph = e2 < 2 ? mp0[2 * e2 + 1] : mp1[2 * e2 - 3];
    const float mnl = e2 < 2 ? mn0[2 * e2] : mn1[2 * e2 - 4], mnh = e2 < 2 ? mn0[2 * e2 + 1] : mn1[2 * e2 - 3];
    out[2 * e2] = c_lo + mpl * (lo2f(up[e2]) - c_lo) + mnl * (lo2f(un[e2]) - c_lo);
    out[2 * e2 + 1] = c_hi + mph * (hi2f(up[e2]) - c_hi) + mnh * (hi2f(un[e2]) - c_hi);
  }
}

template <int NST, bool P3>
DI void scan_prologue8(const P& p, int sbase, int L, int hd, int dir, int pos0, int nsteps, int sb0, float* sv) {
  const int lane = threadIdx.x & 63, l31 = lane & 31, h = lane >> 5;
  const bf16_t* PRKV = (const bf16_t*)(p.ws + O_PRKV);
  const bf16_t* LR = (const bf16_t*)(p.ws + O_LR);
  const bf16_t* WUPT = (const bf16_t*)(p.ws + O_WUPT) + (size_t)(dir * 512 + hd * 64) * 64;
  const bf16_t* AUPT = (const bf16_t*)(p.ws + O_AUPT) + (size_t)(dir * 512 + hd * 64) * 64;
  float* bonus = (float*)(p.ws + O_BONUS);
  {
    int sl = sb0 + (l31 & 7); if (sl > nsteps - 1) sl = nsteps - 1;
    const int pos = dir ? pos0 - sl : pos0 + sl;
    const bf16_t* lrp = LR + (size_t)(sbase + pos) * 384 + dir * 64 + 8 * h;
#pragma unroll 1
    for (int mat = 0; mat < 2; ++mat) {
      const bf16_t* Wm = mat ? AUPT : WUPT;
      const float* bias = mat ? p.d_a0 : p.d_w0;
      f32x16 ac[2];
#pragma unroll
      for (int nt = 0; nt < 2; ++nt)
#pragma unroll
        for (int i = 0; i < 16; ++i) ac[nt][i] = 0.f;
#pragma unroll
      for (int ks = 0; ks < 4; ++ks) {
        const bf16x8 fa = *(const bf16x8*)(lrp + mat * 128 + 16 * ks);
#pragma unroll
        for (int nt = 0; nt < 2; ++nt) {
          const bf16x8 bw = *(const bf16x8*)(Wm + (size_t)(32 * nt + l31) * 64 + 16 * ks + 8 * h);
          ac[nt] = MFMA32(fa, bw, ac[nt]);
        }
      }
#pragma unroll
      for (int nt = 0; nt < 2; ++nt) {
        const int j = 32 * nt + l31;
        const float b0 = bias[dir * 512 + hd * 64 + j];
#pragma unroll
        for (int i = 0; i < 4; ++i) {
          const int st = sb0 + i + 4 * h;
          const float sg = 1.f / (1.f + __expf(-(b0 + ac[nt][i])));
          if (mat) sv[VK * NST * 64 + st * 64 + j] = sg;
          else ac[nt][i] = __expf(-0.6065306597126334f * sg);
        }
        if (!mat) {
          float g0 = ac[nt][0], g1 = g0 * ac[nt][1], g2 = g1 * ac[nt][2], g3 = g2 * ac[nt][3];
          const float tot_lo = __shfl(g3, l31);
          if (h) { g0 *= tot_lo; g1 *= tot_lo; g2 *= tot_lo; g3 *= tot_lo; }
          float* gd = sv + VA * NST * 64 + (sb0 + 4 * h) * 64 + j;
          gd[0] = g0; gd[64] = g1; gd[128] = g2; gd[192] = g3;
          if (h) sv[VW * NST * 64 + (sb0 >> 3) * 64 + vperm(j)] = g3;
        }
      }
    }
  }
  const int stp = lane >> 3, seg = lane & 7, c0 = hd * 64 + 8 * seg;
  const int s = sb0 + stp;
  const int ss = s < nsteps ? s : nsteps - 1;
  const int pos = dir ? pos0 - ss : pos0 + ss;
  float k[8], a[8], gam[8], gpr[8];
  shift8(PRKV, p, sbase, pos, L, 512, c0, k);
  {
    const f32x4v a0 = *(const f32x4v*)(sv + VK * NST * 64 + s * 64 + 8 * seg), a1 = *(const f32x4v*)(sv + VK * NST * 64 + s * 64 + 8 * seg + 4);
    const f32x4v g0 = *(const f32x4v*)(sv + VA * NST * 64 + s * 64 + 8 * seg), g1 = *(const f32x4v*)(sv + VA * NST * 64 + s * 64 + 8 * seg + 4);
    const int sp = stp > 0 ? s - 1 : s;
    const f32x4v q0 = *(const f32x4v*)(sv + VA * NST * 64 + sp * 64 + 8 * seg), q1 = *(const f32x4v*)(sv + VA * NST * 64 + sp * 64 + 8 * seg + 4);
#pragma unroll
    for (int e = 0; e < 4; ++e) {
      a[e] = a0[e]; a[4 + e] = a1[e]; gam[e] = g0[e]; gam[4 + e] = g1[e];
      gpr[e] = stp > 0 ? q0[e] : 1.f; gpr[4 + e] = stp > 0 ? q1[e] : 1.f;
    }
  }
  const f32x4v kk0 = *(const f32x4v*)(p.d_k_k + c0), kk1 = *(const f32x4v*)(p.d_k_k + c0 + 4);
  const f32x4v ka0 = *(const f32x4v*)(p.d_k_a + c0), ka1 = *(const f32x4v*)(p.d_k_a + c0 + 4);
  float kk[8], kd[8];
  float n2 = 0.f;
#pragma unroll
  for (int e = 0; e < 8; ++e) {
    kk[e] = k[e] * (e < 4 ? kk0[e] : kk1[e - 4]);
    n2 += kk[e] * kk[e];
    kd[e] = k[e] * (1.f + (a[e] - 1.f) * (e < 4 ? ka0[e] : ka1[e - 4]));
  }
  n2 += __shfl_xor(n2, 1); n2 += __shfl_xor(n2, 2); n2 += __shfl_xor(n2, 4);
  const float rn = rsqrtf(fmaxf(n2, 1e-24f));
#pragma unroll
  for (int e = 0; e < 8; ++e) {
    const int ix = s * 64 + vperm(8 * seg + e);
    const float kn = kk[e] * rn;
    const float ig = __builtin_amdgcn_rcpf(gam[e]);
    sv[VA * NST * 64 + ix] = -kn * gpr[e];
    sv[VB * NST * 64 + ix] = kn * a[e] * ig;
    sv[VK * NST * 64 + ix] = kd[e] * ig;
  }
  {
    float v[8];
    shift8(PRKV, p, sbase, pos, L, 1024, c0, v);
    *(f32x4v*)(sv + VV * NST * 64 + s * 64 + 8 * seg) = (f32x4v){v[0], v[1], v[2], v[3]};
    *(f32x4v*)(sv + VV * NST * 64 + s * 64 + 8 * seg + 4) = (f32x4v){v[4], v[5], v[6], v[7]};
  }
  if (P3) {
    float r[8];
    shift8(PRKV, p, sbase, pos, L, 0, c0, r);
    const f32x4v rk0 = *(const f32x4v*)(p.d_r_k + c0), rk1 = *(const f32x4v*)(p.d_r_k + c0 + 4);
    float bn = 0.f;
#pragma unroll
    for (int e = 0; e < 8; ++e) {
      sv[VR * NST * 64 + s * 64 + vperm(8 * seg + e)] = r[e] * gam[e];
      bn += r[e] * kd[e] * (e < 4 ? rk0[e] : rk1[e - 4]);
    }
    bn += __shfl_xor(bn, 1); bn += __shfl_xor(bn, 2); bn += __shfl_xor(bn, 4);
    if (s < nsteps && seg == 0) bonus[((size_t)(sbase + pos) * 8 + hd) * 2 + dir] = bn;
  }
}

DI unsigned scan_touch(const P& p, int sbase, int L, int hd, int dir, int posf  ) {
  const int lane = threadIdx.x & 63;
  const bf16_t* PRKV = (const bf16_t*)(p.ws + O_PRKV);
  const bf16_t* LR = (const bf16_t*)(p.ws + O_LR);
  const int lo = dir ? posf - 8 : posf - 1;
  const unsigned* ptr;
  if (lane < 30) { int row = lo + lane / 3; row = row < 0 ? 0 : (row > L - 1 ? L - 1 : row); ptr = (const unsigned*)(PRKV + (size_t)(sbase + row) * 1536 + (lane % 3) * 512 + hd * 64); }
  else { const int i2 = (lane - 30) & 15; int row = dir ? posf - (i2 >> 1) : posf + (i2 >> 1); row = row < 0 ? 0 : (row > L - 1 ? L - 1 : row); ptr = (const unsigned*)(LR + (size_t)(sbase + row) * 384 + (i2 & 1) * 128 + dir * 64); }
  return *ptr;
}

template <bool HALF> DI void scan1_body(const P& p, char* lds) {
  float* PQ = (float*)(p.ws + O_PQ);
  const int lane = threadIdx.x & 63, wave = __builtin_amdgcn_readfirstlane(threadIdx.x >> 6), slot = wave >> 1;
  constexpr int half = HALF ? 1 : 0;
  float* sv = (float*)lds + slot * (6 * 16 * 64);
  for (int g = blockIdx.x; g < 804; g += gridDim.x) {
    int seq, c, hp;
    if (g < 768) { const int lc = g >> 2; hp = g & 3; if (lc < 128) { seq = lc >> 4; c = lc & 15; } else { seq = 8; c = lc - 128; } }
    else { const int j = g - 768; hp = j & 3; seq = j >> 2; c = seq < 8 ? 16 : 64; }
    const int cgi = seq < 8 ? seq * 17 + c : 136 + c;
    const int hd = hp * 2 + (slot >> 1), dir = slot & 1;
    const int it = (cgi * 8 + hd) * 2 + dir;
    const int L = seq_len(seq), sbase = seq_base(seq);
    const int start = c * 256, end = min(L, start + 256), n = end - start;
    float S[64];
#pragma unroll
    for (int j = 0; j < 64; ++j) S[j] = (half == 0 && j == lane) ? 1.f : 0.f;
    for (int s0 = 0; s0 < n; s0 += 16) {
      const int ns = min(16, n - s0);
      const int pos0 = dir ? end - 1 - s0 : start + s0;
      __syncthreads();
      scan_prologue8<16, false>(p, sbase, L, hd, dir, pos0, ns, half * 8, sv);
      __syncthreads();
      unsigned tch = 0u;
      if (s0 + 16 < n) tch = scan_touch(p, sbase, L, hd, dir, dir ? pos0 - 16 - half * 8 : pos0 + 16 + half * 8);
      scan_steps<16, HALF, false>(S, sv, ns, lane, [](int, float) {});
      asm volatile("" :: "v"(tch));
    }
    float* dst = PQ + (size_t)it * 8192 + (size_t)(half * 64 + lane) * 64;
#pragma unroll
    for (int q = 0; q < 16; ++q) *(float4*)(dst + q * 4) = make_float4(S[q * 4], S[q * 4 + 1], S[q * 4 + 2], S[q * 4 + 3]);
  }
}

DI void phase_scan1(const P& p, char* lds) {
  const int w_ = __builtin_amdgcn_readfirstlane(threadIdx.x >> 6);
  if ((w_ ^ (w_ >> 2)) & 1) scan1_body<true>(p, lds); else scan1_body<false>(p, lds);
}

DI void phase_scan2(const P& p, char* lds) {
  float* Ss = (float*)lds;
  float* Ps = Ss + 64 * 65;
  float* PQ = (float*)(p.ws + O_PQ);
  const int tid = threadIdx.x, lane = tid & 63, wave = __builtin_amdgcn_readfirstlane(tid >> 6), l31 = lane & 31, h = lane >> 5;
  const int r0 = 32 * (wave >> 1), c0 = 32 * (wave & 1);
  for (int it = blockIdx.x; it < 144; it += gridDim.x) {
    const int dir = it & 1, hd = (it >> 1) & 7, seq = it >> 4;
    const int nch = seq < 8 ? 17 : 65, cg0 = seq < 8 ? seq * 17 : 136;
    f32x16 S;
#pragma unroll
    for (int i = 0; i < 16; ++i) S[i] = 0.f;
    f32x4v pn0, pn1;
    {
      const int c = dir ? nch - 1 : 0;
      const float* Pg = PQ + (size_t)(((cg0 + c) * 8 + hd) * 2 + dir) * 8192;
      pn0 = *(const f32x4v*)(Pg + tid * 4); pn1 = *(const f32x4v*)(Pg + (512 + tid) * 4);
    }
    for (int cc = 0; cc < nch; ++cc) {
      const int c = dir ? nch - 1 - cc : cc;
      float* Qg = PQ + (size_t)(((cg0 + c) * 8 + hd) * 2 + dir) * 8192 + 4096;
      __syncthreads();
      { const int m = tid >> 4, cq = (tid & 15) * 4; *(f32x4v*)(Ps + m * 68 + cq) = pn0; *(f32x4v*)(Ps + (m + 32) * 68 + cq) = pn1; }
      f32x16 acc;
      if (wave < 4) {
#pragma unroll
        for (int i = 0; i < 16; ++i) {
          const int row = r0 + (i & 3) + 8 * (i >> 2) + 4 * h;
          Ss[row * 65 + c0 + l31] = S[i];
          float* qp = Qg + row * 64 + c0 + l31;
          acc[i] = *qp;
          *qp = S[i];
        }
      }
      if (cc + 1 < nch) {
        const int c2 = dir ? nch - 2 - cc : cc + 1;
        const float* Pg2 = PQ + (size_t)(((cg0 + c2) * 8 + hd) * 2 + dir) * 8192;
        pn0 = *(const f32x4v*)(Pg2 + tid * 4); pn1 = *(const f32x4v*)(Pg2 + (512 + tid) * 4);
      }
      __syncthreads();
      if (wave < 4) {
#pragma unroll 8
        for (int kk = 0; kk < 32; ++kk) {
          const float av = Ss[(r0 + l31) * 65 + 2 * kk + h];
          const float bv = Ps[(2 * kk + h) * 68 + c0 + l31];
          acc = __builtin_amdgcn_mfma_f32_32x32x2f32(av, bv, acc, 0, 0, 0);
        }
        S = acc;
      }
    }
  }
}

DI void phase_scan3(const P& p, char* lds) {
  const float* PQ = (const float*)(p.ws + O_PQ);
  bf16_t* MIX = (bf16_t*)(p.ws + O_MIX);
  bf16_t* OB = (bf16_t*)(p.ws + O_OB);
  const int lane = threadIdx.x & 63, wave = __builtin_amdgcn_readfirstlane(threadIdx.x >> 6);
  float* sv = (float*)lds + wave * (6 * 8 * 64);
  const bool bal = gridDim.x == 256;
  const int NW = gridDim.x * 8, gw = blockIdx.x * 8 + wave;
  for (int k = 0; ; ++k) {
    int oi;
    if (bal) {
      if (k == 0) oi = gw;
      else if (k == 1) { if (wave >= 4) continue; oi = 2048 + blockIdx.x * 4 + wave; }
      else if (k == 2) { if (wave != 7 || blockIdx.x >= 144) break; oi = 3072 + blockIdx.x; }
      else break;
    } else { oi = gw + k * NW; if (oi >= 3216) break; }
    int seq, c, hd, dir;
    if (oi < 3072) { const int lc = oi >> 4; hd = (oi >> 1) & 7; dir = oi & 1; if (lc < 128) { seq = lc >> 4; c = lc & 15; } else { seq = 8; c = lc - 128; } }
    else { const int j = oi - 3072; hd = (j >> 1) & 7; dir = j & 1; seq = j >> 4; c = seq < 8 ? 16 : 64; }
    const int it = ((seq < 8 ? seq * 17 + c : 136 + c) * 8 + hd) * 2 + dir;
    const int L = seq_len(seq), sbase = seq_base(seq);
    const int start = c * 256, end = min(L, start + 256), n = end - start;
    float S[64];
    {
      const float* src = PQ + (size_t)it * 8192 + 4096 + lane * 64;
#pragma unroll
      for (int q = 0; q < 16; ++q) { float4 t = *(const float4*)(src + q * 4); S[q * 4] = t.x; S[q * 4 + 1] = t.y; S[q * 4 + 2] = t.z; S[q * 4 + 3] = t.w; }
    }
    for (int s0 = 0; s0 < n; s0 += 8) {
      const int ns = min(8, n - s0);
      const int pos0 = dir ? end - 1 - s0 : start + s0;
      scan_prologue8<8, true>(p, sbase, L, hd, dir, pos0, ns, 0, sv);
      unsigned tch = 0u;
      if (s0 + 8 < n) tch = scan_touch(p, sbase, L, hd, dir, dir ? pos0 - 8 : pos0 + 8);
      scan_steps<8, true, true>(S, sv, ns, lane, [&](int st, float o) {
        const int pos = dir ? pos0 - st : pos0 + st;
        const size_t sr = (size_t)(sbase + pos);
        if (dir == 0) MIX[sr * 1024 + 512 + hd * 64 + lane] = f2bf(o);
        else OB[sr * 512 + hd * 64 + lane] = f2bf(o);
      });
      asm volatile("" :: "v"(tch));
    }
  }
}

DI void phase_rwkv_final(const P& p) {
  const int lane = threadIdx.x & 63, gw = (blockIdx.x * NTH + threadIdx.x) >> 6, nw = (gridDim.x * NTH) >> 6;
  bf16_t* MIX = (bf16_t*)(p.ws + O_MIX);
  const bf16_t* OB = (const bf16_t*)(p.ws + O_OB);
  const bf16_t* G = (const bf16_t*)(p.ws + O_G);
  const bf16_t* PRKV = (const bf16_t*)(p.ws + O_PRKV);
  const float* bonus = (const float*)(p.ws + O_BONUS);
  const int hd = lane >> 3, c0 = lane * 8;
  float mp[8], mn[8], lg[8], lb[8];
#pragma unroll
  for (int j = 0; j < 8; ++j) { mp[j] = p.mu_prev[1024 + c0 + j]; mn[j] = p.mu_next[1024 + c0 + j]; lg[j] = p.d_ln_g[c0 + j]; lb[j] = p.d_ln_b[c0 + j]; }
  for (int sr = gw; sr < T_; sr += nw) {
    int pos; int b = seq_of(sr, pos);
    const int L = seq_len(b);
    const u32x4 uf = *(const u32x4*)(MIX + (size_t)sr * 1024 + 512 + c0);
    const u32x4 ub = *(const u32x4*)(OB + (size_t)sr * 512 + c0);
    const u32x4 ug = *(const u32x4*)(G + (size_t)sr * 512 + c0);
    const bf16_t* vr = PRKV + (size_t)sr * 1536 + 1024 + c0;
    const u32x4 vc = *(const u32x4*)vr;
    const u32x4 vp = *(const u32x4*)(pos > 0 ? vr - 1536 : vr);
    const u32x4 vn = *(const u32x4*)(pos < L - 1 ? vr + 1536 : vr);
    const float2 bn = *(const float2*)(bonus + ((size_t)sr * 8 + hd) * 2);
    const bool hp = pos > 0, hn = pos < L - 1;
    float o[8], gg[8], vsh[8];
    float sm = 0.f;
#pragma unroll
    for (int j = 0; j < 4; ++j) {
      o[2 * j] = lo2f(uf[j]) + lo2f(ub[j]); o[2 * j + 1] = hi2f(uf[j]) + hi2f(ub[j]);
      gg[2 * j] = lo2f(ug[j]); gg[2 * j + 1] = hi2f(ug[j]);
      sm += o[2 * j] + o[2 * j + 1];
      const float c_lo = lo2f(vc[j]), c_hi = hi2f(vc[j]);
      const float p_lo = hp ? lo2f(vp[j]) : 0.f, p_hi = hp ? hi2f(vp[j]) : 0.f;
      const float n_lo = hn ? lo2f(vn[j]) : 0.f, n_hi = hn ? hi2f(vn[j]) : 0.f;
      vsh[2 * j] = c_lo + mp[2 * j] * (p_lo - c_lo) + mn[2 * j] * (n_lo - c_lo);
      vsh[2 * j + 1] = c_hi + mp[2 * j + 1] * (p_hi - c_hi) + mn[2 * j + 1] * (n_hi - c_hi);
    }
    sm += __shfl_xor(sm, 1); sm += __shfl_xor(sm, 2); sm += __shfl_xor(sm, 4);
    const float mean = sm * (1.f / 64.f);
    float vs = 0.f;
#pragma unroll
    for (int j = 0; j < 8; ++j) { float dlt = o[j] - mean; vs += dlt * dlt; }
    vs += __shfl_xor(vs, 1); vs += __shfl_xor(vs, 2); vs += __shfl_xor(vs, 4);
    const float rstd = rsqrtf(vs * (1.f / 64.f) + 64e-5f);
    const float bsum = bn.x + bn.y;
    float y[8];
#pragma unroll
    for (int j = 0; j < 8; ++j) y[j] = ((o[j] - mean) * rstd * lg[j] + lb[j] + bsum * vsh[j]) * gg[j];
    *(uint4*)(MIX + (size_t)sr * 1024 + 512 + c0) = make_uint4(pack2(y[0], y[1]), pack2(y[2], y[3]), pack2(y[4], y[5]), pack2(y[6], y[7]));
  }
}

#define XB_TMO      128
#define XB_XCNT(j)  (256  + 64 * (j))
#define XB_XSUB(j)  (1280 + 64 * (j))
#define XB_XGEN(j)  (2304 + 64 * (j))
#define XB_TOP      3328
#define XB_TOPGEN   3392
#define XCD_BAR_WORDS 3456
#define XB_SPIN_CAP (1u << 23)
#define LAS __attribute__((address_space(3)))

__device__ __forceinline__ unsigned xb_ld(unsigned* p)              { return __hip_atomic_load(p, __ATOMIC_RELAXED, __HIP_MEMORY_SCOPE_AGENT); }
__device__ __forceinline__ unsigned xb_add(unsigned* p, unsigned v) { return __hip_atomic_fetch_add(p, v, __ATOMIC_RELAXED, __HIP_MEMORY_SCOPE_AGENT); }
__device__ __forceinline__ unsigned xb_xcc_id() { return (unsigned)__builtin_amdgcn_s_getreg((3 << 11) | 20) & 0xFu; }
#define XB_SPIN(cond, bar) do { unsigned _sp = 0; while (cond) { __builtin_amdgcn_s_sleep(1); \
    if ((++_sp & 255u) == 0u) { if (xb_ld(&(bar)[XB_TMO])) break; if (_sp > XB_SPIN_CAP) { atomicAdd(&(bar)[XB_TMO], 1u); break; } } } } while (0)

struct XcdBarrier {
    unsigned* bar; unsigned x;
    volatile LAS unsigned* st;
};

__device__ __forceinline__ XcdBarrier xcd_barrier_post(unsigned* bar, volatile LAS unsigned* st) {
    XcdBarrier b; b.bar = bar; b.x = xb_xcc_id(); b.st = st;
    if (threadIdx.x == 0) (void)xb_add(&bar[XB_XCNT(b.x)], 1u);
    return b;
}
__device__ __forceinline__ void xcd_barrier_complete(unsigned* bar, unsigned x, unsigned& nloc, unsigned& nx) {
    const unsigned G = gridDim.x * gridDim.y * gridDim.z;
    unsigned sum, cnt, mine, sp = 0u;
    for (;;) {
        sum = 0u; cnt = 0u; mine = 0u;
#pragma unroll
        for (unsigned j = 0; j < 16; ++j) { const unsigned c = xb_ld(&bar[XB_XCNT(j)]); sum += c; cnt += (c > 0u) ? 1u : 0u; mine = (j == x) ? c : mine; }
        if (sum == G) break;
        __builtin_amdgcn_s_sleep(1);
        if ((++sp & 255u) == 0u) { if (xb_ld(&bar[XB_TMO])) break; if (sp > XB_SPIN_CAP) { atomicAdd(&bar[XB_TMO], 1u); break; } }
    }
    nloc = mine > 0u ? mine : 1u; nx = cnt > 0u ? cnt : 1u;
}

__device__ __forceinline__ void xcd_barrier(const XcdBarrier& b) {
    asm volatile("s_waitcnt vmcnt(0)" ::: "memory");
    __syncthreads();
    if (threadIdx.x == 0) {
        unsigned* bar = b.bar;
        __builtin_amdgcn_s_waitcnt(0);
        unsigned nloc = b.st[0], nx = b.st[1];
        if (nloc == 0u) { xcd_barrier_complete(bar, b.x, nloc, nx); b.st[0] = nloc; b.st[1] = nx; }
        const unsigned old = xb_add(&bar[XB_XSUB(b.x)], 1u);
        const unsigned gen = old / nloc;
        if (old + 1u == (gen + 1u) * nloc) {
            __builtin_amdgcn_fence(__ATOMIC_RELEASE, "agent");
            asm volatile("s_waitcnt vmcnt(0)" ::: "memory");
            const unsigned og = xb_add(&bar[XB_TOP], 1u);
            const unsigned tg = og / nx;
            if (og + 1u == (tg + 1u) * nx) xb_add(&bar[XB_TOPGEN], 1u);
            else XB_SPIN(xb_ld(&bar[XB_TOPGEN]) == tg, bar);
            __builtin_amdgcn_fence(__ATOMIC_ACQUIRE, "agent");
            xb_add(&bar[XB_XGEN(b.x)], 1u);
            asm volatile("s_waitcnt vmcnt(0)" ::: "memory");
        } else {
            XB_SPIN(xb_ld(&bar[XB_XGEN(b.x)]) == gen, bar);
            __builtin_amdgcn_fence(__ATOMIC_ACQUIRE, "agent");
            asm volatile("s_waitcnt vmcnt(0)" ::: "memory");
        }
    }
    __syncthreads();
}

constexpr int NPHASE = 23;
__global__ void __launch_bounds__(NTH, 2) mega(P p) {
  extern __shared__ __attribute__((aligned(16))) unsigned char shm[];
  char* lds = (char*)shm;
  char* ws = p.ws;
  if (threadIdx.x == 0) *(uint4*)(shm + 131072) = make_uint4(0u, 0u, 0u, 0u);
  __syncthreads();
  const XcdBarrier xb = xcd_barrier_post((unsigned*)(ws + O_BAR), (volatile LAS unsigned*)(shm + 131072));
#ifndef DUP_MASK
#define DUP_MASK 0u
#endif
#define RUN(k, call) if (p.ph0 <= k && k < p.ph1) { call; if (k + 1 < p.ph1) { if (k == 0) cg::this_grid().sync(); else xcd_barrier(xb); } }
  RUN(0, phase_prep(p))
  RUN(1, phase_gemm_big((const bf16_t*)(ws + O_HN), (const bf16_t*)(ws + O_WIN0), 1536, 1024, (bf16_t*)(ws + O_PROJ0), 1536, 0, ws, shm))
  RUN(2, phase_prepA(p, lds))
  RUN(3, phase_attnA(p, lds))
  RUN(4, phase_fnet_gemm(p, lds))
  RUN(5, phase_gemm_big((const bf16_t*)(ws + O_MIX), (const bf16_t*)(ws + O_WOUT0), 1024, 1024, (bf16_t*)(ws + O_HN), 1024, 0, ws, shm))
  RUN(6, phase_resnorm(p, p.post_mix_g, p.pre_ffn_g))
  RUN(7, phase_gemm_gateup((const bf16_t*)(ws + O_HN), (const bf16_t*)(ws + O_WGU0), (bf16_t*)(ws + O_ACT), shm))
  RUN(8, phase_gemm_big((const bf16_t*)(ws + O_ACT), (const bf16_t*)(ws + O_WD0), 1024, DFF, (bf16_t*)(ws + O_HN), 1024, 0, ws, shm))
  RUN(9, phase_resnorm(p, p.post_ffn_g, p.pre_mix_g + 1024))
  RUN(10, phase_gemm_big((const bf16_t*)(ws + O_HN), (const bf16_t*)(ws + O_WIN1), 2816, 1024, nullptr, 0, 1, ws, shm))
  RUN(11, phase_prepC(p, lds))
  RUN(12, phase_attnC(p, lds))
  RUN(13, phase_scan1(p, lds))
  RUN(14, phase_scan2(p, lds))
  RUN(15, phase_scan3(p, lds))
  RUN(16, phase_gemm_small((const bf16_t*)(ws + O_LR) + 256, 384, (const bf16_t*)(ws + O_GUP), 512, 128, (bf16_t*)(ws + O_G), 512, lds))
  RUN(17, phase_rwkv_final(p))
  RUN(18, phase_gemm_big((const bf16_t*)(ws + O_MIX), (const bf16_t*)(ws + O_WOUT1), 1024, 1024, (bf16_t*)(ws + O_HN), 1024, 0, ws, shm))
  RUN(19, phase_resnorm(p, p.post_mix_g + 1024, p.pre_ffn_g + 1024))
  RUN(20, phase_gemm_gateup((const bf16_t*)(ws + O_HN), (const bf16_t*)(ws + O_WGU1), (bf16_t*)(ws + O_ACT), shm))
  RUN(21, phase_gemm_big((const bf16_t*)(ws + O_ACT), (const bf16_t*)(ws + O_WD1), 1024, DFF, (bf16_t*)(ws + O_HN), 1024, 0, ws, shm))
  RUN(22, phase_resnorm(p, p.post_ffn_g + 1024, nullptr))
#undef RUN
}

extern "C" void kernel_launch(void* const* d_in, const int* in_sizes, int n_in, void* d_out, int out_size, void* d_ws, size_t ws_size,
                              hipStream_t stream) {
  static int grid_blocks = 0;
  if (!grid_blocks) {
    int dev = 0, cus = 0, per_cu = 0;
    (void)hipGetDevice(&dev);
    (void)hipDeviceGetAttribute(&cus, hipDeviceAttributeMultiprocessorCount, dev);
    if (hipFuncSetAttribute((const void*)mega, hipFuncAttributeMaxDynamicSharedMemorySize, LDS_BYTES) != hipSuccess) fprintf(stderr, "hipFuncSetAttribute failed\n");
    if (hipOccupancyMaxActiveBlocksPerMultiprocessor(&per_cu, (const void*)mega, NTH, LDS_BYTES) != hipSuccess || per_cu < 1) {
      fprintf(stderr, "occupancy query says %d\n", per_cu);
      (void)hipGetLastError();
    }
    grid_blocks = cus;
  }
  if (ws_size < O_BAR + CTL_BYTES) { fprintf(stderr, "workspace too small\n"); return; }
  if (hipMemsetAsync((char*)d_ws + O_BAR, 0, CTL_BYTES, stream) != hipSuccess) { fprintf(stderr, "memset failed\n"); return; }
  P p{};
  const float** f = (const float**)&p;
  for (int i = 0; i < 32; ++i) f[i] = (const float*)d_in[i];
  p.out = (float*)d_out;
  p.ws = (char*)d_ws;
#if FUSED
  p.ph0 = 0; p.ph1 = NPHASE;
  void* args[] = {&p};
  hipError_t e = hipLaunchCooperativeKernel((void*)mega, dim3(grid_blocks), dim3(NTH), args, LDS_BYTES, stream);
  if (e != hipSuccess) fprintf(stderr, "cooperative launch failed: %s (grid %d)\n", hipGetErrorString(e), grid_blocks);
#else
  for (int ph = 0; ph < NPHASE; ++ph) {
    p.ph0 = ph; p.ph1 = ph + 1;
    hipLaunchKernelGGL(mega, dim3(grid_blocks), dim3(NTH), LDS_BYTES, stream, p);
  }
#endif
}
```

```cpp
#include <hip/hip_runtime.h>
#include <hip/hip_cooperative_groups.h>
#include <cstdio>
namespace cg = cooperative_groups;

#ifndef FUSED
#define FUSED 1
#endif

typedef unsigned short bf16_t;
using bf16x8 = __attribute__((ext_vector_type(8))) short;
using s16x4 = __attribute__((ext_vector_type(4))) short;
using f32x16 = __attribute__((ext_vector_type(16))) float;
using u32x4 = __attribute__((ext_vector_type(4))) unsigned;
using f32x4v = __attribute__((ext_vector_type(4))) float;
#define DI __device__ __forceinline__
#define MFMA32(a, b, c) __builtin_amdgcn_mfma_f32_32x32x16_bf16((a), (b), (c), 0, 0, 0)
constexpr int NTH = 512;
constexpr int LDS_BYTES = 131072 + 16;

constexpr int DM_ = 1024;
constexpr int T_ = 49296;
constexpr int TP_ = 49408;
constexpr int NT_ = TP_ / 128;
constexpr int DFF = 2816;
constexpr float EPS = 1e-6f;
constexpr float LOG2E = 1.4426950408889634f;

constexpr size_t SZ_ROW1024 = (size_t)TP_ * 1024 * 2;
constexpr size_t O_WIN0 = 0;
constexpr size_t O_WOUT0 = O_WIN0 + (size_t)1536 * 1024 * 2;
constexpr size_t O_WGU0 = O_WOUT0 + (size_t)1024 * 1024 * 2;
constexpr size_t O_WD0 = O_WGU0 + (size_t)5632 * 1024 * 2;
constexpr size_t O_DM257 = O_WD0 + (size_t)1024 * 2816 * 2;
constexpr size_t O_DM1025 = O_DM257 + (size_t)384 * 576 * 2;
constexpr size_t O_WIN1 = O_DM1025 + (size_t)1152 * 2112 * 2;
constexpr size_t O_WOUT1 = O_WIN1 + (size_t)2816 * 1024 * 2;
constexpr size_t O_WGU1 = O_WOUT1 + (size_t)1024 * 1024 * 2;
constexpr size_t O_WD1 = O_WGU1 + (size_t)5632 * 1024 * 2;
constexpr size_t O_GUP = O_WD1 + (size_t)1024 * 2816 * 2;
constexpr size_t O_RA = O_GUP + (size_t)512 * 128 * 2;
constexpr size_t O_RB = O_RA + SZ_ROW1024;
constexpr size_t O_RC = O_RB + (size_t)TP_ * 2816 * 2;
constexpr size_t O_META = O_RC + SZ_ROW1024;
constexpr size_t O_WC = O_META + (size_t)144 * 1024 * 4;
constexpr size_t O_WUPT = O_WC + (size_t)4 * 64 * 128 * 4;
constexpr size_t O_AUPT = O_WUPT + (size_t)2 * 512 * 64 * 2;
constexpr size_t O_END = O_AUPT + (size_t)2 * 512 * 64 * 2;
constexpr size_t O_HN = O_RA;
constexpr size_t O_VTA = O_RA;
constexpr size_t O_LR = O_RA;
constexpr size_t O_BONUS = O_RA + (size_t)TP_ * 384 * 2;
constexpr size_t O_VTC = O_BONUS + (size_t)T_ * 16 * 4;
constexpr size_t O_OB = O_RA + (size_t)TP_ * 512 * 2;
constexpr size_t O_PROJ0 = O_RB;
constexpr size_t O_ZB = O_PROJ0 + (size_t)TP_ * 1536 * 2;
constexpr size_t O_Y = O_ZB + (size_t)TP_ * 512 * 2;
constexpr size_t O_ACT = O_RB;
constexpr size_t O_PRKV = O_RB;
constexpr size_t O_PC = O_PRKV + (size_t)TP_ * 1536 * 2;
constexpr size_t O_PLOW = O_PC + (size_t)TP_ * 768 * 2;
constexpr size_t O_PQ = O_PC;
constexpr size_t O_G = O_PC;
constexpr size_t O_MIX = O_RC;
static_assert(O_VTC + (size_t)49728 * 128 * 2 <= O_RB, "vtc");
static_assert(O_Y + (size_t)(8 * 16 * 256 * 576 + 16 * 256 * 2112) * 2 <= O_RC, "y");
static_assert(O_PQ + (size_t)3216 * 32768 <= O_RC, "pq");
constexpr size_t O_BAR = (O_END + 255) / 256 * 256;
constexpr size_t O_CNT = O_BAR + 3456 * 4;
constexpr size_t CTL_BYTES = 3456 * 4 + 4 * 256;
static_assert(O_BAR + CTL_BYTES <= (size_t)536870912, "ws");

struct P {
  const float *x_prompt, *x_sample, *meta, *pre_mix_g, *post_mix_g, *pre_ffn_g, *post_ffn_g;
  const float *even_w_in, *even_w_out, *a_q_gain, *a_k_gain, *b_norm_g, *b_w, *b_b;
  const float *odd_w_in, *odd_w_out, *c_sink, *mu_prev, *mu_next, *d_w0, *d_w_up, *d_a0, *d_a_up, *d_g_up;
  const float *d_k_k, *d_k_a, *d_r_k, *d_ln_g, *d_ln_b, *ffn_gate, *ffn_up, *ffn_down;
  float* out;
  char* ws;
  int ph0, ph1;
};

typedef float f32x2 __attribute__((ext_vector_type(2)));
typedef __bf16 bf16x2_t __attribute__((ext_vector_type(2)));
DI bf16_t f2bf(float x) { return __builtin_bit_cast(bf16_t, (__bf16)x); }
DI float bf2f(bf16_t b) { return __uint_as_float(((unsigned)b) << 16); }
DI unsigned pack2(float a, float b) { f32x2 v = {a, b}; return __builtin_bit_cast(unsigned, __builtin_convertvector(v, bf16x2_t)); }
DI float lo2f(unsigned u) { return __uint_as_float(u << 16); }
DI float hi2f(unsigned u) { return __uint_as_float(u & 0xffff0000u); }
DI float wave_sum(float v) {
  for (int o = 32; o > 0; o >>= 1) v += __shfl_xor(v, o);
  return v;
}
DI int seq_of(int sr, int& pos) {
  if (sr < 32896) { int b = sr / 4112; pos = sr - b * 4112; return b; }
  pos = sr - 32896; return 8;
}
DI int seq_len(int b) { return b < 8 ? 4112 : 16400; }
DI int seq_base(int b) { return b < 8 ? b * 4112 : 32896; }
DI float* hrow(const P& p, int sr) {
  int pos; int b = seq_of(sr, pos);
  if (pos < 16) return (float*)(p.ws + O_META) + (size_t)(b * 16 + pos) * 1024;
  return p.out + ((size_t)(b < 8 ? b * 4096 : 32768) + (pos - 16)) * 1024;
}
DI float sigmoidf_(float x) { return 1.f / (1.f + expf(-x)); }

DI void transpose_w(const float* W, int K, int ldw, int N, bf16_t* Wt, int mode, const float* W2, int gtid, int gsz) {
  int nk8 = K / 8;
  long total = (long)N * nk8;
  for (long it = gtid; it < total; it += gsz) {
    int n = (int)(it % N), k8 = (int)(it / N);
    const float* src = W;
    int c = n;
    if (mode == 1) {
      int blk = n >> 8, w = n & 255;
      c = blk * 128 + (w & 127);
      if (w >= 128) src = W2;
    }
    unsigned r[4];
#pragma unroll
    for (int j = 0; j < 4; ++j) {
      float a = src[(size_t)(k8 * 8 + 2 * j) * ldw + c];
      float b = src[(size_t)(k8 * 8 + 2 * j + 1) * ldw + c];
      r[j] = pack2(a, b);
    }
    *(uint4*)(Wt + (size_t)n * K + k8 * 8) = make_uint4(r[0], r[1], r[2], r[3]);
  }
}

DI void phase_prep(const P& p) {
  const int gtid = blockIdx.x * NTH + threadIdx.x, gsz = gridDim.x * NTH;
  char* ws = p.ws;
  transpose_w(p.even_w_in, 1024, 1536, 1536, (bf16_t*)(ws + O_WIN0), 0, nullptr, gtid, gsz);
  transpose_w(p.even_w_out, 1024, 1024, 1024, (bf16_t*)(ws + O_WOUT0), 0, nullptr, gtid, gsz);
  transpose_w(p.odd_w_in, 1024, 2688, 2688, (bf16_t*)(ws + O_WIN1), 0, nullptr, gtid, gsz);
  transpose_w(p.odd_w_out, 1024, 1024, 1024, (bf16_t*)(ws + O_WOUT1), 0, nullptr, gtid, gsz);
  transpose_w(p.ffn_gate, 1024, DFF, 5632, (bf16_t*)(ws + O_WGU0), 1, p.ffn_up, gtid, gsz);
  transpose_w(p.ffn_gate + (size_t)1024 * DFF, 1024, DFF, 5632, (bf16_t*)(ws + O_WGU1), 1, p.ffn_up + (size_t)1024 * DFF, gtid, gsz);
  transpose_w(p.ffn_down, DFF, 1024, 1024, (bf16_t*)(ws + O_WD0), 0, nullptr, gtid, gsz);
  transpose_w(p.ffn_down + (size_t)DFF * 1024, DFF, 1024, 1024, (bf16_t*)(ws + O_WD1), 0, nullptr, gtid, gsz);
  transpose_w(p.d_g_up, 128, 512, 512, (bf16_t*)(ws + O_GUP), 0, nullptr, gtid, gsz);
  for (int d = 0; d < 2; ++d) {
    transpose_w(p.d_w_up + (size_t)d * 64 * 512, 64, 512, 512, (bf16_t*)(ws + O_WUPT) + (size_t)d * 512 * 64, 0, nullptr, gtid, gsz);
    transpose_w(p.d_a_up + (size_t)d * 64 * 512, 64, 512, 512, (bf16_t*)(ws + O_AUPT) + (size_t)d * 512 * 64, 0, nullptr, gtid, gsz);
  }
  for (int it = gtid; it < 128 * 1024 / 8; it += gsz) *(uint4*)((bf16_t*)(ws + O_WIN1) + (size_t)2688 * 1024 + (size_t)it * 8) = make_uint4(0, 0, 0, 0);
  for (int which = 0; which < 2; ++which) {
    const int M = which ? 1025 : 257, MP = which ? 1152 : 384, KP = which ? 2112 : 576;
    bf16_t* dm = (bf16_t*)(ws + (which ? O_DM1025 : O_DM257));
    for (int it = gtid; it < MP * KP; it += gsz) {
      int r = it / KP, c = it - r * KP;
      float v = 0.f;
      if (r < M && c < 2 * M) {
        int n2 = c < M ? c : c - M;
        int m = (r * n2) % M;
        float s, co;
        sincospif(2.0f * (float)m / (float)M, &s, &co);
        v = c < M ? co : s;
      }
      dm[it] = f2bf(v);
    }
  }
  for (int it = gtid; it < 4 * 64 * 128; it += gsz) {
    int o = it & 127, c = (it >> 7) & 63, g = it >> 13;
    int d = o & 63;
    float acc = 0.f;
    for (int c2 = 0; c2 < 64; ++c2) {
      float s, co;
      sincospif((float)((c * c2) & 63) / 32.f, &s, &co);
      float w = p.b_w[(g * 64 + c2) * 64 + d];
      acc += (o < 64 ? co : -s) * w;
    }
    ((float*)(ws + O_WC))[it] = acc;
  }
  const int lane = threadIdx.x & 63, gw = gtid >> 6, nw = gsz >> 6;
  bf16_t* HN = (bf16_t*)(ws + O_HN);
  for (int sr = gw; sr < TP_; sr += nw) {
    if (sr >= T_) {
#pragma unroll
      for (int q = 0; q < 2; ++q) *(uint4*)(HN + (size_t)sr * 1024 + q * 512 + lane * 8) = make_uint4(0, 0, 0, 0);
      continue;
    }
    int pos; int b = seq_of(sr, pos);
    const float* src = pos < 16 ? p.meta + pos * 1024
                                : (b < 8 ? p.x_prompt + ((size_t)b * 4096 + pos - 16) * 1024 : p.x_sample + (size_t)(pos - 16) * 1024);
    float* hr = hrow(p, sr);
    float4 v[4];
    float ss = 0.f;
#pragma unroll
    for (int q = 0; q < 4; ++q) {
      v[q] = *(const float4*)(src + q * 256 + lane * 4);
      ss += v[q].x * v[q].x + v[q].y * v[q].y + v[q].z * v[q].z + v[q].w * v[q].w;
      *(float4*)(hr + q * 256 + lane * 4) = v[q];
    }
    ss = wave_sum(ss);
    float rs = rsqrtf(ss * (1.f / 1024.f) + EPS);
#pragma unroll
    for (int q = 0; q < 4; ++q) {
      float4 g = *(const float4*)(p.pre_mix_g + q * 256 + lane * 4);
      uint2 o = make_uint2(pack2(v[q].x * rs * g.x, v[q].y * rs * g.y), pack2(v[q].z * rs * g.z, v[q].w * rs * g.w));
      *(uint2*)(HN + (size_t)sr * 1024 + q * 256 + lane * 4) = o;
    }
  }
}

DI void gemm_tile(const bf16_t* __restrict__ A, int lda, const bf16_t* __restrict__ B, int ldb, int K, char* lds, f32x16 (&acc)[2][2]) {
  const int tid = threadIdx.x & 255, lane = tid & 63, wave = tid >> 6, wm = wave >> 1, wn = wave & 1;
  const int l31 = lane & 31, h = lane >> 5;
  bf16_t* As = (bf16_t*)lds;
  bf16_t* Bs = As + 128 * 72;
#pragma unroll
  for (int a = 0; a < 2; ++a)
#pragma unroll
    for (int b = 0; b < 2; ++b)
#pragma unroll
      for (int i = 0; i < 16; ++i) acc[a][b][i] = 0.f;
  const int lr = tid >> 3, lc = (tid & 7) * 8;
  const bf16_t* Ag = A + (size_t)lr * lda + lc;
  const bf16_t* Bg = B + (size_t)lr * ldb + lc;
  u32x4 ra[4], rb[4];
#pragma unroll
  for (int q = 0; q < 4; ++q) {
    ra[q] = *(const u32x4*)(Ag + (size_t)(32 * q) * lda);
    rb[q] = *(const u32x4*)(Bg + (size_t)(32 * q) * ldb);
  }
#pragma unroll
  for (int q = 0; q < 4; ++q) {
    *(u32x4*)(As + (lr + 32 * q) * 72 + lc) = ra[q];
    *(u32x4*)(Bs + (lr + 32 * q) * 72 + lc) = rb[q];
  }
  __syncthreads();
  const int nk = K >> 6;
  for (int kt = 0; kt < nk; ++kt) {
    if (kt + 1 < nk) {
#pragma unroll
      for (int q = 0; q < 4; ++q) {
        ra[q] = *(const u32x4*)(Ag + (size_t)(32 * q) * lda + (kt + 1) * 64);
        rb[q] = *(const u32x4*)(Bg + (size_t)(32 * q) * ldb + (kt + 1) * 64);
      }
    }
#pragma unroll
    for (int ks = 0; ks < 4; ++ks) {
      bf16x8 a[2], b[2];
#pragma unroll
      for (int t = 0; t < 2; ++t) {
        a[t] = *(const bf16x8*)(As + (wm * 64 + t * 32 + l31) * 72 + ks * 16 + 8 * h);
        b[t] = *(const bf16x8*)(Bs + (wn * 64 + t * 32 + l31) * 72 + ks * 16 + 8 * h);
      }
#pragma unroll
      for (int mt = 0; mt < 2; ++mt)
#pragma unroll
        for (int nt = 0; nt < 2; ++nt) acc[mt][nt] = MFMA32(a[mt], b[nt], acc[mt][nt]);
    }
    __syncthreads();
    if (kt + 1 < nk) {
#pragma unroll
      for (int q = 0; q < 4; ++q) {
        *(u32x4*)(As + (lr + 32 * q) * 72 + lc) = ra[q];
        *(u32x4*)(Bs + (lr + 32 * q) * 72 + lc) = rb[q];
      }
      __syncthreads();
    }
  }
}
#define ACC_ROW(mt, i) (wm * 64 + (mt) * 32 + ((i) & 3) + 8 * ((i) >> 2) + 4 * h)
#define ACC_COL(nt) (wn * 64 + (nt) * 32 + l31)
#define GEMM_IDS const int lane = threadIdx.x & 63, wave = (threadIdx.x & 255) >> 6, wm = wave >> 1, wn = wave & 1, l31 = lane & 31, h = lane >> 5; (void)wm; (void)wn; (void)l31; (void)h;

DI void phase_gemm_small(const bf16_t* A, int lda, const bf16_t* W, int N, int K, bf16_t* C, int ldc, char* lds) {
  GEMM_IDS
  const int sb = threadIdx.x >> 8;
  const int ntn = N / 128;
  const int total = NT_ * ntn;
  for (int t0 = blockIdx.x * 2; t0 < total; t0 += gridDim.x * 2) {
    const int t = t0 + sb;
    const int tm = t / ntn, tn = t - tm * ntn;
    f32x16 acc[2][2];
    gemm_tile(A + (size_t)tm * 128 * lda, lda, W + (size_t)tn * 128 * K, K, K, lds + sb * 36864, acc);
#pragma unroll
    for (int mt = 0; mt < 2; ++mt)
#pragma unroll
      for (int nt = 0; nt < 2; ++nt)
#pragma unroll
        for (int i = 0; i < 16; ++i) {
          int row = tm * 128 + ACC_ROW(mt, i), col = tn * 128 + ACC_COL(nt);
          C[(size_t)row * ldc + col] = f2bf(acc[mt][nt][i]);
        }
  }
}

namespace pg8 {
#define PG8_LAS __attribute__((address_space(3)))
typedef unsigned short bf16_t;
typedef short bf16x8 __attribute__((ext_vector_type(8)));
typedef float f32x4 __attribute__((ext_vector_type(4)));
typedef unsigned u32x4 __attribute__((ext_vector_type(4)));
constexpr int BM = 256, BK = 64, HALF = 128, HTB = HALF * BK * 2  , STAGE_BYTES = 8 * HTB, NXCD = 8, WGM = 8;

__host__ __device__ __forceinline__ int lds_byte(int r, int c) { const int st = (r >> 4) * 2 + (c >> 5), rr = r & 15, cc = c & 31, ob = rr * 64 + cc * 2; return st * 1024 + (ob ^ (((ob >> 9) & 1) << 5)); }
__host__ __device__ __forceinline__ void stage_rc(int b, int& R, int& C) { const int st = b / 1024, sb = b % 1024, swz = sb ^ (((sb >> 9) & 1) << 5); R = (st >> 1) * 16 + swz / 64; C = (st & 1) * 32 + (swz % 64) / 2; }
__host__ __device__ __forceinline__ int perm32(int rho) { const int n = rho >> 4, i = rho & 15; return 8 * (i >> 2) + 4 * n + (i & 3); }

struct Unit { int pm, pn; };
struct Gemm { const bf16_t* A; const bf16_t* Bt; int M, N, K; };

struct StaticOrder {
    int nM, nN, nwg, G, c;
    __host__ __device__ void init(int M, int N, int G_, int c_) { nM = M / BM; nN = N / BM; nwg = nM * nN; G = G_; c = c_; }
    __host__ __device__ bool next(int i, Unit& u) const {
        const long L = (long)i * G + c; if (L >= nwg) return false;
        int wgid = (int)L; { const int q = nwg / NXCD, r = nwg % NXCD, xcd = wgid % NXCD, off = wgid / NXCD; wgid = (xcd < r ? xcd * (q + 1) : r * (q + 1) + (xcd - r) * q) + off; }
        const int nig = WGM * nN, gid = wgid / nig, fm = gid * WGM, gsz = (nM - fm) < WGM ? (nM - fm) : WGM;
        u.pm = fm + ((wgid % nig) % gsz); u.pn = (wgid % nig) / gsz; return true;
    }
    __device__ __forceinline__ void a_ready(const Unit&) const {}
    __device__ __forceinline__ void done(const Unit&) const {}
};
__device__ __forceinline__ unsigned cvt_pk_bf16(float lo, float hi) { unsigned r; asm volatile("v_cvt_pk_bf16_f32 %0, %1, %2" : "=v"(r) : "v"(lo), "v"(hi)); return r; }

struct EpiRoute {
    static constexpr bool PERM = true, AFTER_DRAIN = false;
    bf16_t* O; int ldc; int route; bf16_t* pc; bf16_t* prkv; bf16_t* plow;
    __device__ __forceinline__ void operator()(const f32x4 (&acc)[2][2][4][2], const Unit& u, int wr, int wc, int fr, int fq) const {
        const int row0 = u.pm * BM + wr * 64 + fr;
#pragma unroll
        for (int bj = 0; bj < 2; ++bj) {
            int colh = u.pn * BM + bj * HALF; bf16_t* base = O; int ld = ldc;
            if (route) {
                if (colh < 768) { base = pc; ld = 768; }
                else if (colh < 2304) { base = prkv; ld = 1536; colh -= 768; }
                else if (colh < 2688) { base = plow; ld = 384; colh -= 2304; }
                else continue;
            }
            const int col0 = colh + wc * 32 + 8 * fq;
#pragma unroll
            for (int ai = 0; ai < 2; ++ai)
#pragma unroll
                for (int m = 0; m < 4; ++m) { bf16_t* rowp = base + (size_t)(row0 + ai * HALF + m * 16) * ld + col0;
                    const f32x4 v0 = acc[ai][bj][m][0], v1 = acc[ai][bj][m][1];
                    u32x4 w; w.x = cvt_pk_bf16(v0[0], v0[1]); w.y = cvt_pk_bf16(v0[2], v0[3]); w.z = cvt_pk_bf16(v1[0], v1[1]); w.w = cvt_pk_bf16(v1[2], v1[3]);
                    *(u32x4*)rowp = w; }
        }
    }
};
struct EpiGateUp {
    static constexpr bool PERM = true, AFTER_DRAIN = false;
    bf16_t* ACT;
    __device__ __forceinline__ void operator()(const f32x4 (&acc)[2][2][4][2], const Unit& u, int wr, int wc, int fr, int fq) const {
        const int row0 = u.pm * BM + wr * 64 + fr, col0 = u.pn * HALF + wc * 32 + 8 * fq;
#pragma unroll
        for (int ai = 0; ai < 2; ++ai)
#pragma unroll
            for (int m = 0; m < 4; ++m) { bf16_t* rowp = ACT + (size_t)(row0 + ai * HALF + m * 16) * 2816 + col0;
                float v[8];
#pragma unroll
                for (int n = 0; n < 2; ++n)
#pragma unroll
                    for (int j = 0; j < 4; ++j) { const float g = acc[ai][0][m][n][j], uu = acc[ai][1][m][n][j]; v[n * 4 + j] = g * __builtin_amdgcn_rcpf(1.f + __expf(-g)) * uu; }
                u32x4 w; w.x = cvt_pk_bf16(v[0], v[1]); w.y = cvt_pk_bf16(v[2], v[3]); w.z = cvt_pk_bf16(v[4], v[5]); w.w = cvt_pk_bf16(v[6], v[7]);
                *(u32x4*)rowp = w; }
    }
};
template <class Epi, class Sched, bool STAMP = false>
__device__ __forceinline__ void gemm_phase(PG8_LAS unsigned char* lds, const Gemm g, const Sched& S, const Epi& E, unsigned long long* stamps) {
    const int tid = threadIdx.x, wid = __builtin_amdgcn_readfirstlane(tid >> 6), lane = tid & 63, wr = wid >> 2, wc = wid & 3, fr = lane & 15, fq = lane >> 4;
    const int K = g.K, nt = K / BK;
    int ts_lo = 0, ts_hi = 0, nts = 0; const unsigned long long rt_entry = STAMP ? (unsigned long long)wall_clock64() : 0ull;
#define PG8_STAMP() do { if (STAMP && wid == 0 && nts < 64) { const unsigned long long _c = (unsigned long long)clock64(); \
        ts_lo = (lane == nts) ? (int)(unsigned)_c : ts_lo; ts_hi = (lane == nts) ? (int)(unsigned)(_c >> 32) : ts_hi; ++nts; } } while (0)
    PG8_STAMP();
    unsigned voffA[2], voffB[2];
#pragma unroll
    for (int i = 0; i < 2; ++i) { int R, C; stage_rc(tid * 16 + i * 8192, R, C); const int Rb = Epi::PERM ? ((R & ~31) + perm32(R & 31)) : R;
        voffA[i] = (unsigned)(R * K + C) * 2u; voffB[i] = (unsigned)(Rb * K + C) * 2u; }
    const size_t kstep = (size_t)(BK * 2);
    const size_t hstep = (size_t)HALF * K * 2;
    const size_t tstep = 2 * hstep;
    const unsigned ldsw = (unsigned)wid * 1024u;
    const int aoff = lds_byte(wr * 64 + fr, fq * 8), boff = lds_byte(wc * 32 + fr, fq * 8);
#define PG8_SA(b, h) (((b) * 2 + (h)) * HTB)
#define PG8_SB(b, h) ((4 + (b) * 2 + (h)) * HTB)
#define PG8_STAGE(bufoff, gbase, voff) do { _Pragma("unroll") for (int _i = 0; _i < 2; ++_i) \
        __builtin_amdgcn_global_load_lds((const unsigned*)((const char*)(gbase) + (voff)[_i]), (PG8_LAS unsigned*)(lds + (bufoff) + ldsw + _i * 8192), 16, 0, 0); } while (0)
#define PG8_LDA(dst, b, h) do { _Pragma("unroll") for (int m = 0; m < 4; ++m) _Pragma("unroll") for (int k = 0; k < 2; ++k) dst[m][k] = *(const PG8_LAS bf16x8*)(lds + PG8_SA(b, h) + aoff + m * 2048 + k * 1024); } while (0)
#define PG8_LDB(dst, b, h) do { _Pragma("unroll") for (int n = 0; n < 2; ++n) _Pragma("unroll") for (int k = 0; k < 2; ++k) dst[n][k] = *(const PG8_LAS bf16x8*)(lds + PG8_SB(b, h) + boff + n * 2048 + k * 1024); } while (0)
#define PG8_MMA(ai, bj, At, Bt) do { __builtin_amdgcn_s_setprio(1); _Pragma("unroll") for (int m = 0; m < 4; ++m) _Pragma("unroll") for (int n = 0; n < 2; ++n) _Pragma("unroll") for (int k = 0; k < 2; ++k) \
        acc[ai][bj][m][n] = __builtin_amdgcn_mfma_f32_16x16x32_bf16(Bt[n][k], At[m][k], acc[ai][bj][m][n], 0, 0, 0); __builtin_amdgcn_s_setprio(0); } while (0)
#define PG8_WAIT_V(n) asm volatile("s_waitcnt vmcnt(" #n ")" ::: "memory")
#define PG8_WAIT_L(n) asm volatile("s_waitcnt lgkmcnt(" #n ")" ::: "memory")
#define PG8_BAR __builtin_amdgcn_s_barrier()
#define PG8_SCHED __builtin_amdgcn_sched_barrier(0)
    Unit cur, nxt; int ui = 0;
    if (!S.next(0, cur)) return;
    f32x4 acc[2][2][4][2];
#pragma unroll
    for (int a = 0; a < 2; ++a)
#pragma unroll
        for (int b = 0; b < 2; ++b)
#pragma unroll
            for (int m = 0; m < 4; ++m)
#pragma unroll
                for (int n = 0; n < 2; ++n) acc[a][b][m][n] = (f32x4){0.f, 0.f, 0.f, 0.f};
    bf16x8 At[4][2], B0[2][2], B1[2][2];
    const char* cA = (const char*)g.A + (size_t)cur.pm * tstep; const char* cB = (const char*)g.Bt + (size_t)cur.pn * tstep;
    S.a_ready(cur);
    PG8_STAGE(PG8_SB(0, 0), cB, voffB); PG8_STAGE(PG8_SA(0, 0), cA, voffA); PG8_STAGE(PG8_SB(0, 1), cB + hstep, voffB); PG8_STAGE(PG8_SA(0, 1), cA + hstep, voffA);
    if (wr == 1) PG8_BAR;
    PG8_WAIT_V(4); PG8_BAR;
    PG8_STAGE(PG8_SB(1, 0), cB + kstep, voffB); PG8_STAGE(PG8_SA(1, 0), cA + kstep, voffA); PG8_STAGE(PG8_SB(1, 1), cB + hstep + kstep, voffB);
    PG8_WAIT_V(6); PG8_BAR;
    PG8_STAMP();
    for (;;) {
        const bool has_next = S.next(ui + 1, nxt);
        const char* nA = has_next ? (const char*)g.A + (size_t)nxt.pm * tstep : cA; const char* nB = has_next ? (const char*)g.Bt + (size_t)nxt.pn * tstep : cB;
        for (int t = 0; t < nt; t += 2) {
            const bool last = (t == nt - 2);
            const char* a1 = cA + (size_t)(t + 1) * kstep;
            const char* a2 = last ? nA : cA + (size_t)(t + 2) * kstep; const char* b2 = last ? nB : cB + (size_t)(t + 2) * kstep;
            const char* a3 = a2 + kstep; const char* b3 = b2 + kstep;
            if (last && has_next) S.a_ready(nxt);
            PG8_LDB(B0, 0, 0); PG8_SCHED; PG8_LDA(At, 0, 0); PG8_STAGE(PG8_SA(1, 1), a1 + hstep, voffA);
            PG8_WAIT_L(8); PG8_BAR; PG8_WAIT_L(0); PG8_MMA(0, 0, At, B0); PG8_BAR; PG8_SCHED;
            PG8_LDB(B1, 0, 1); PG8_STAGE(PG8_SB(0, 0), b2, voffB);
            PG8_BAR; PG8_WAIT_L(0); PG8_MMA(0, 1, At, B1); PG8_BAR;
            PG8_LDA(At, 0, 1); PG8_STAGE(PG8_SA(0, 0), a2, voffA);
            PG8_BAR; PG8_WAIT_L(0); PG8_MMA(1, 0, At, B0); PG8_BAR; PG8_SCHED;
            PG8_STAGE(PG8_SB(0, 1), b2 + hstep, voffB);
            PG8_WAIT_V(6); PG8_BAR; PG8_MMA(1, 1, At, B1); PG8_BAR;
            PG8_LDB(B0, 1, 0); PG8_SCHED; PG8_LDA(At, 1, 0); PG8_STAGE(PG8_SA(0, 1), a2 + hstep, voffA);
            PG8_WAIT_L(8); PG8_BAR; PG8_WAIT_L(0); PG8_MMA(0, 0, At, B0); PG8_BAR; PG8_SCHED;
            PG8_LDB(B1, 1, 1); PG8_STAGE(PG8_SB(1, 0), b3, voffB);
            PG8_BAR; PG8_WAIT_L(0); PG8_MMA(0, 1, At, B1); PG8_BAR;
            PG8_LDA(At, 1, 1); PG8_STAGE(PG8_SA(1, 0), a3, voffA);
            PG8_BAR; PG8_WAIT_L(0); PG8_MMA(1, 0, At, B0); PG8_BAR; PG8_SCHED;
            PG8_STAGE(PG8_SB(1, 1), b3 + hstep, voffB);
            PG8_WAIT_V(6); PG8_BAR; PG8_MMA(1, 1, At, B1); PG8_BAR;
        }
        PG8_STAMP();
        if constexpr (!Epi::AFTER_DRAIN) { E(acc, cur, wr, wc, fr, fq); S.done(cur); }
        PG8_STAMP();
        if (!has_next) break;
#pragma unroll
        for (int a = 0; a < 2; ++a)
#pragma unroll
            for (int b = 0; b < 2; ++b)
#pragma unroll
                for (int m = 0; m < 4; ++m)
#pragma unroll
                    for (int n = 0; n < 2; ++n) acc[a][b][m][n] = (f32x4){0.f, 0.f, 0.f, 0.f};
        cur = nxt; cA = nA; cB = nB; ++ui;
    }
    PG8_WAIT_V(0);
    if (wr == 0) PG8_BAR;
    PG8_BAR;
    if constexpr (Epi::AFTER_DRAIN) { E.fused(acc, cur, wr, wc, fr, fq, lds, wid, lane); S.done(cur); }
    PG8_STAMP();
    if (STAMP && wid == 0) { stamps[lane] = lane < nts ? (((unsigned long long)(unsigned)ts_hi << 32) | (unsigned)ts_lo) : 0ull;
        if (lane == 62) stamps[62] = rt_entry; if (lane == 63) stamps[63] = (unsigned long long)wall_clock64(); }
#undef PG8_STAMP
#undef PG8_SA
#undef PG8_SB
#undef PG8_STAGE
#undef PG8_LDA
#undef PG8_LDB
#undef PG8_MMA
#undef PG8_WAIT_V
#undef PG8_WAIT_L
#undef PG8_BAR
#undef PG8_SCHED
}
}

DI void phase_gemm_big(const bf16_t* A, const bf16_t* W, int N, int K, bf16_t* C, int ldc, int route, char* ws, unsigned char* lds) {
  pg8::Gemm g{A, W, TP_, N, K};
  pg8::StaticOrder S; S.init(TP_, N, gridDim.x, blockIdx.x);
  pg8::EpiRoute E{C, ldc, route, (bf16_t*)(ws + O_PC), (bf16_t*)(ws + O_PRKV), (bf16_t*)(ws + O_PLOW)};
  pg8::gemm_phase<pg8::EpiRoute, pg8::StaticOrder, false>((PG8_LAS unsigned char*)lds, g, S, E, nullptr);
}
DI void phase_gemm_gateup(const bf16_t* A, const bf16_t* W, bf16_t* ACT, unsigned char* lds) {
  pg8::Gemm g{A, W, TP_, 5632, 1024};
  pg8::StaticOrder S; S.init(TP_, 5632, gridDim.x, blockIdx.x);
  pg8::EpiGateUp E{ACT};
  pg8::gemm_phase<pg8::EpiGateUp, pg8::StaticOrder, false>((PG8_LAS unsigned char*)lds, g, S, E, nullptr);
}

DI void phase_resnorm(const P& p, const float* g1, const float* g2) {
  const int lane = threadIdx.x & 63, gw = (blockIdx.x * NTH + threadIdx.x) >> 6, nw = (gridDim.x * NTH) >> 6;
  bf16_t* HN = (bf16_t*)(p.ws + O_HN);
  for (int sr = gw; sr < T_; sr += nw) {
    float* hr = hrow(p, sr);
    float x[16];
    float ss = 0.f;
#pragma unroll
    for (int q = 0; q < 4; ++q) {
      const uint2 u = *(const uint2*)(HN + (size_t)sr * 1024 + q * 256 + lane * 4);
      x[q * 4] = lo2f(u.x); x[q * 4 + 1] = hi2f(u.x); x[q * 4 + 2] = lo2f(u.y); x[q * 4 + 3] = hi2f(u.y);
      ss += x[q * 4] * x[q * 4] + x[q * 4 + 1] * x[q * 4 + 1] + x[q * 4 + 2] * x[q * 4 + 2] + x[q * 4 + 3] * x[q * 4 + 3];
    }
    f32x4v hh[4];
#pragma unroll
    for (int q = 0; q < 4; ++q) hh[q] = *(const f32x4v*)(hr + q * 256 + lane * 4);
    ss = wave_sum(ss);
    const float rs = rsqrtf(ss * (1.f / 1024.f) + EPS);
    float ss2 = 0.f;
#pragma unroll
    for (int q = 0; q < 4; ++q) {
      const float4 g = *(const float4*)(g1 + q * 256 + lane * 4);
      hh[q].x += x[q * 4 + 0] * rs * g.x; hh[q].y += x[q * 4 + 1] * rs * g.y; hh[q].z += x[q * 4 + 2] * rs * g.z; hh[q].w += x[q * 4 + 3] * rs * g.w;
      *(f32x4v*)(hr + q * 256 + lane * 4) = hh[q];
      ss2 += hh[q].x * hh[q].x + hh[q].y * hh[q].y + hh[q].z * hh[q].z + hh[q].w * hh[q].w;
    }
    if (g2) {
      ss2 = wave_sum(ss2);
      const float rs2 = rsqrtf(ss2 * (1.f / 1024.f) + EPS);
#pragma unroll
      for (int q = 0; q < 4; ++q) {
        const float4 g = *(const float4*)(g2 + q * 256 + lane * 4);
        *(uint2*)(HN + (size_t)sr * 1024 + q * 256 + lane * 4) = make_uint2(pack2(hh[q].x * rs2 * g.x, hh[q].y * rs2 * g.y), pack2(hh[q].z * rs2 * g.z, hh[q].w * rs2 * g.w));
      }
    }
  }
}

DI size_t vta_base(int seq) { return seq < 8 ? (size_t)seq * 256 * 4160 : (size_t)8 * 256 * 4160; }
template <int NC> DI void vt_transpose(const bf16_t* src, int ld, int col0, bf16_t* VT, char* lds) {
  bf16_t* tl = (bf16_t*)lds;
  const int tid = threadIdx.x;
  constexpr int CPT = NC / 8, TPR = 512 / NC, PPT = 64 / TPR;
  for (int it = blockIdx.x; it < 257 + 8 * 65; it += gridDim.x) {
    int seq, kt;
    if (it < 257) { seq = 8; kt = it; } else { const int j = it - 257; seq = j / 65; kt = j - seq * 65; }
    const int L = seq_len(seq), LP = L + 48, sbase = seq_base(seq);
    const size_t vb = (seq < 8 ? (size_t)seq * NC * 4160 : (size_t)8 * NC * 4160);
    __syncthreads();
    const int pl = tid >> 3, part = tid & 7;
    const int pos = 64 * kt + pl - 48;
#pragma unroll
    for (int q = 0; q < CPT / 8; ++q) {
      u32x4 v = (u32x4)(0u);
      if (pos >= 0) v = *(const u32x4*)(src + (size_t)(sbase + pos) * ld + col0 + part * CPT + q * 8);
#pragma unroll
      for (int j = 0; j < 4; ++j) {
        tl[(part * CPT + q * 8 + 2 * j) * 72 + pl] = (bf16_t)(v[j] & 0xffffu);
        tl[(part * CPT + q * 8 + 2 * j + 1) * 72 + pl] = (bf16_t)(v[j] >> 16);
      }
    }
    __syncthreads();
    const int row = tid / TPR, seg = tid % TPR;
    bf16_t* dst = VT + vb + (size_t)row * LP + 64 * kt + seg * PPT;
#pragma unroll
    for (int q = 0; q < PPT / 8; ++q) *(u32x4*)(dst + q * 8) = *(const u32x4*)(tl + row * 72 + seg * PPT + q * 8);
  }
}

DI void phase_prepA(const P& p, char* lds) {
  const int lane = threadIdx.x & 63, wave = threadIdx.x >> 6;
  bf16_t* PROJ = (bf16_t*)(p.ws + O_PROJ0);
  bf16_t* ZB = (bf16_t*)(p.ws + O_ZB);
  const float* WC = (const float*)(p.ws + O_WC);
  vt_transpose<256>(PROJ, 1536, 1024, (bf16_t*)(p.ws + O_VTA), lds);
  __syncthreads();
  float* fl = (float*)lds + wave * 1024;
  float* csl = (float*)lds + 8 * 1024 + wave * 64;
  const float inv = exp2f(-(float)(lane & 15) * (13.287712379549449f / 16.f));
  const int qr = lane & 3;
  float gn[16];
#pragma unroll
  for (int j = 0; j < 16; ++j) gn[j] = (lane < 48 ? p.a_q_gain : p.a_k_gain)[16 * qr + j] * (lane < 48 ? 0.125f * LOG2E : 1.f);
  for (int r0 = blockIdx.x * 32; r0 < TP_; r0 += gridDim.x * 32) {
    const int srb = r0 + wave * 4;
#pragma unroll 1
    for (int rr = 0; rr < 4; ++rr) {
      const int sr = srb + rr;
      if (sr < T_) {
        int pos; seq_of(sr, pos);
        float rowf, colf;
        if (pos < 16) { rowf = colf = (float)(pos - 16); }
        else { int t = pos - 16; rowf = (float)(t >> 6); colf = (float)(t & 63); }
        {
          float sn1, cs1;
          sincosf(((lane & 16) ? colf : rowf) * inv, &sn1, &cs1);
          if (lane < 32) { csl[lane] = cs1; csl[32 + lane] = sn1; }
        }
        bf16_t* pr = PROJ + (size_t)sr * 1536;
        {
        const u32x4 u0 = *(const u32x4*)(pr + 16 * lane), u1 = *(const u32x4*)(pr + 16 * lane + 8);
        float x[16];
        float ss = 0.f;
#pragma unroll
        for (int j = 0; j < 4; ++j) {
          x[2 * j] = lo2f(u0[j]); x[2 * j + 1] = hi2f(u0[j]); x[8 + 2 * j] = lo2f(u1[j]); x[8 + 2 * j + 1] = hi2f(u1[j]);
        }
#pragma unroll
        for (int j = 0; j < 16; ++j) ss += x[j] * x[j];
        ss += __shfl_xor(ss, 1); ss += __shfl_xor(ss, 2);
        const float rs = rsqrtf(ss * (1.f / 64.f) + EPS);
        const float* cp = csl + 16 * (qr >> 1);
        float o[16];
#pragma unroll
        for (int j4 = 0; j4 < 4; ++j4) {
          const f32x4v c4 = *(const f32x4v*)(cp + 4 * j4), s4 = *(const f32x4v*)(cp + 32 + 4 * j4);
#pragma unroll
          for (int e = 0; e < 4; ++e) {
            const int j = 4 * j4 + e;
            const float xn = x[j] * rs * gn[j];
            const float pa = __shfl_xor(xn, 1);
            o[j] = xn * c4[e] + pa * ((qr & 1) ? s4[e] : -s4[e]);
          }
        }
        *(u32x4*)(pr + 16 * lane) = (u32x4){pack2(o[0], o[1]), pack2(o[2], o[3]), pack2(o[4], o[5]), pack2(o[6], o[7])};
        *(u32x4*)(pr + 16 * lane + 8) = (u32x4){pack2(o[8], o[9]), pack2(o[10], o[11]), pack2(o[12], o[13]), pack2(o[14], o[15])};
        }
        uint2 u = *(const uint2*)(pr + 1280 + lane * 4);
        float f0 = lo2f(u.x), f1 = hi2f(u.x), f2 = lo2f(u.y), f3 = hi2f(u.y);
        float ss = f0 * f0 + f1 * f1 + f2 * f2 + f3 * f3;
        ss += __shfl_xor(ss, 1); ss += __shfl_xor(ss, 2); ss += __shfl_xor(ss, 4); ss += __shfl_xor(ss, 8);
        float rs = rsqrtf(ss * (1.f / 64.f) + EPS);
        float4 g = *(const float4*)(p.b_norm_g + lane * 4);
        *(float4*)(fl + rr * 256 + lane * 4) = make_float4(f0 * rs * g.x, f1 * rs * g.y, f2 * rs * g.z, f3 * rs * g.w);
      } else {
        *(float4*)(fl + rr * 256 + lane * 4) = make_float4(0.f, 0.f, 0.f, 0.f);
      }
    }
    __syncthreads();
    {
      const int g = lane >> 4, o0 = (lane & 15) * 8;
      float acc[4][8];
#pragma unroll
      for (int rr = 0; rr < 4; ++rr)
#pragma unroll
        for (int j = 0; j < 8; ++j) acc[rr][j] = 0.f;
      const float* wc = WC + (size_t)g * 64 * 128 + o0;
#pragma unroll 4
      for (int c = 0; c < 64; ++c) {
        const float4 w0 = *(const float4*)(wc + c * 128), w1 = *(const float4*)(wc + c * 128 + 4);
#pragma unroll
        for (int rr = 0; rr < 4; ++rr) {
          const float f = fl[rr * 256 + g * 64 + c];
          acc[rr][0] += f * w0.x; acc[rr][1] += f * w0.y; acc[rr][2] += f * w0.z; acc[rr][3] += f * w0.w;
          acc[rr][4] += f * w1.x; acc[rr][5] += f * w1.y; acc[rr][6] += f * w1.z; acc[rr][7] += f * w1.w;
        }
      }
#pragma unroll
      for (int rr = 0; rr < 4; ++rr)
        if (srb + rr < T_)
          *(uint4*)(ZB + (size_t)(srb + rr) * 512 + g * 128 + o0) = make_uint4(pack2(acc[rr][0], acc[rr][1]), pack2(acc[rr][2], acc[rr][3]), pack2(acc[rr][4], acc[rr][5]), pack2(acc[rr][6], acc[rr][7]));
    }
    __syncthreads();
  }
}

template <int MODE>
DI void flash_item(const bf16_t* __restrict__ Q, int ldq, const bf16_t* __restrict__ Kb, int ldk, const bf16_t* __restrict__ Vt, int LP,
                   bf16_t* O, int ldo, int sbase, int S, int qt, float sinkl2, char* lds) {
  const int tid = threadIdx.x & 255, lane = tid & 63, wave = tid >> 6, l31 = lane & 31, h = lane >> 5;
  bf16_t* Ks = (bf16_t*)lds;
  bf16_t* Vs = Ks + 2 * 64 * 72;
  const int rl = wave * 32 + l31;
  const int qpos = qt == 0 ? (rl < 16 ? rl : 15) : 16 + 128 * (qt - 1) + rl;
  const bool qvalid = qt > 0 || rl < 16;
  bf16x8 qf[4];
  {
    const bf16_t* qr = Q + (size_t)(sbase + qpos) * ldq;
#pragma unroll
    for (int s = 0; s < 4; ++s) qf[s] = *(const bf16x8*)(qr + 16 * s + 8 * h);
  }
  const int nkt_all = (S + 64) / 64;
  int klo = 1, n;
  if (MODE == 0) { n = nkt_all; }
  else {
    if (qt == 0) { klo = 1; n = 3; }
    else {
      int c = qt - 1;
      klo = 2 * c - 1; if (klo < 1) klo = 1;
      int khi = 2 * c + 4; if (khi > nkt_all - 1) khi = nkt_all - 1;
      n = 1 + (khi - klo + 1);
    }
  }
  const int ldr = tid >> 2, ldp = (tid & 3) * 16;
  u32x4 rk0, rk1, rv0, rv1;
  auto ktile = [&](int idx) { return idx == 0 ? 0 : klo + idx - 1; };
#define FL_GLOAD(idx)                                                                               \
  {                                                                                                 \
    int kt_ = ktile(idx);                                                                           \
    int pos_ = 64 * kt_ + ldr - 48;                                                                 \
    if (pos_ >= 0) {                                                                                \
      const bf16_t* kp_ = Kb + (size_t)(sbase + pos_) * ldk + ldp;                                  \
      rk0 = *(const u32x4*)kp_; rk1 = *(const u32x4*)(kp_ + 8);                                 \
    } else { rk0 = (u32x4)(0u); rk1 = rk0; }                                       \
    const bf16_t* vp_ = Vt + (size_t)ldr * LP + 64 * kt_ + ldp;                                     \
    rv0 = *(const u32x4*)vp_; rv1 = *(const u32x4*)(vp_ + 8);                                   \
  }
#define FL_SSTORE(buf)                                                                              \
  {                                                                                                 \
    *(u32x4*)(Ks + (buf) * 64 * 72 + ldr * 72 + ldp) = rk0; *(u32x4*)(Ks + (buf) * 64 * 72 + ldr * 72 + ldp + 8) = rk1; \
    { bf16_t* vd_ = Vs + (buf) * 64 * 68 + ldr * 68 + ldp; *(uint2*)vd_ = make_uint2(rv0.x, rv0.y); *(uint2*)(vd_ + 4) = make_uint2(rv0.z, rv0.w); *(uint2*)(vd_ + 8) = make_uint2(rv1.x, rv1.y); *(uint2*)(vd_ + 12) = make_uint2(rv1.z, rv1.w); } \
  }
  f32x16 oacc[2];
#pragma unroll
  for (int i = 0; i < 16; ++i) { oacc[0][i] = 0.f; oacc[1][i] = 0.f; }
  float m = MODE == 1 ? -1e30f : 0.f, l = 0.f;
  FL_GLOAD(0)
  FL_SSTORE(0)
  __syncthreads();
  for (int idx = 0; idx < n; ++idx) {
    const int cur = idx & 1;
    if (idx + 1 < n) FL_GLOAD(idx + 1)
    const int kt = ktile(idx);
    const bf16_t* ks = Ks + cur * 64 * 72;
    const bf16_t* vs = Vs + cur * 64 * 68;
    f32x16 sacc[2];
    {
      bf16x8 kf[2][4];
#pragma unroll
      for (int t = 0; t < 2; ++t)
#pragma unroll
        for (int s = 0; s < 4; ++s) kf[t][s] = *(const bf16x8*)(ks + (32 * t + l31) * 72 + 16 * s + 8 * h);
#pragma unroll
      for (int t = 0; t < 2; ++t)
#pragma unroll
        for (int i = 0; i < 16; ++i) sacc[t][i] = 0.f;
      __builtin_amdgcn_sched_barrier(0);
#pragma unroll
      for (int s = 0; s < 4; ++s)
#pragma unroll
        for (int t = 0; t < 2; ++t) sacc[t] = MFMA32(kf[t][s], qf[s], sacc[t]);
    }
    bf16x8 vfr[2][2][2];
#pragma unroll
    for (int t = 0; t < 2; ++t)
#pragma unroll
      for (int s2 = 0; s2 < 2; ++s2)
#pragma unroll
        for (int dt = 0; dt < 2; ++dt) {
          const bf16_t* vp = vs + (32 * dt + l31) * 68 + 32 * t + 16 * s2 + 4 * h;
          uint2 lo = *(const uint2*)vp, hi = *(const uint2*)(vp + 8);
          u32x4 v4 = {lo.x, lo.y, hi.x, hi.y};
          vfr[t][s2][dt] = __builtin_bit_cast(bf16x8, v4);
        }
    __builtin_amdgcn_sched_barrier(0);
    if (kt == 0) {
#pragma unroll
      for (int t = 0; t < 2; ++t)
#pragma unroll
        for (int i = 0; i < 16; ++i) {
          int kl = 32 * t + (i & 3) + 8 * (i >> 2) + 4 * h;
          if (kl < 48) sacc[t][i] = -1e30f;
        }
    } else if (MODE == 1) {
#pragma unroll
      for (int t = 0; t < 2; ++t)
#pragma unroll
        for (int i = 0; i < 16; ++i) {
          int kl = 32 * t + (i & 3) + 8 * (i >> 2) + 4 * h;
          int tk = 64 * (kt - 1) + kl;
          bool vis;
          if (qt == 0) vis = tk <= 112 + qpos;
          else { int tq = qpos - 16; int d = tq - tk; vis = d <= 128 && d >= -128; }
          if (!vis) sacc[t][i] = -1e30f;
        }
    }
    float tmax = -1e30f;
    if (MODE == 1) {
#pragma unroll
      for (int t = 0; t < 2; ++t)
#pragma unroll
        for (int i = 0; i < 16; ++i) tmax = fmaxf(tmax, sacc[t][i]);
      tmax = fmaxf(tmax, __shfl_xor(tmax, 32));
    }
    if (MODE == 1 && __builtin_amdgcn_ballot_w64(tmax > m) != 0ull) {
      const float mn = fmaxf(m, tmax);
      const float alpha = __builtin_amdgcn_exp2f(m - mn);
      m = mn;
      l *= alpha;
#pragma unroll
      for (int i = 0; i < 16; ++i) { oacc[0][i] *= alpha; oacc[1][i] *= alpha; }
    }
    const f32x2 m2 = {m, m};
    f32x2 ls2 = {0.f, 0.f};
    unsigned pk[2][8];
#pragma unroll
    for (int t = 0; t < 2; ++t)
#pragma unroll
      for (int i2 = 0; i2 < 8; ++i2) {
        f32x2 d = {sacc[t][2 * i2], sacc[t][2 * i2 + 1]};
        if (MODE == 1) d = d - m2;
        f32x2 e = {__builtin_amdgcn_exp2f(d.x), __builtin_amdgcn_exp2f(d.y)};
        ls2 += e;
        pk[t][i2] = __builtin_bit_cast(unsigned, __builtin_convertvector(e, bf16x2_t));
      }
    l += ls2.x + ls2.y;
#pragma unroll
    for (int t = 0; t < 2; ++t)
#pragma unroll
      for (int s2 = 0; s2 < 2; ++s2) {
        u32x4 pk4 = {pk[t][4 * s2], pk[t][4 * s2 + 1], pk[t][4 * s2 + 2], pk[t][4 * s2 + 3]};
        bf16x8 pf = __builtin_bit_cast(bf16x8, pk4);
#pragma unroll
        for (int dt = 0; dt < 2; ++dt) oacc[dt] = MFMA32(vfr[t][s2][dt], pf, oacc[dt]);
      }
    if (idx + 1 < n) FL_SSTORE(cur ^ 1)
    __syncthreads();
  }
  l += __shfl_xor(l, 32);
  if (MODE == 1) l += __builtin_amdgcn_exp2f(sinkl2 - m);
  const float il = 1.f / l;
  if (qvalid) {
    bf16_t* orow = O + (size_t)(sbase + qpos) * ldo;
#pragma unroll
    for (int dt = 0; dt < 2; ++dt)
#pragma unroll
      for (int g = 0; g < 4; ++g) {
        int d = 32 * dt + 8 * g + 4 * h;
        uint2 o = make_uint2(pack2(oacc[dt][4 * g] * il, oacc[dt][4 * g + 1] * il), pack2(oacc[dt][4 * g + 2] * il, oacc[dt][4 * g + 3] * il));
        *(uint2*)(orow + d) = o;
      }
  }
#undef FL_GLOAD
#undef FL_SSTORE
}

DI void dft4(float& r0, float& i0, float& r1, float& i1, float& r2, float& i2, float& r3, float& i3) {
  const float t0r = r0 + r2, t0i = i0 + i2, t1r = r0 - r2, t1i = i0 - i2;
  const float t2r = r1 + r3, t2i = i1 + i3, t3r = i1 - i3, t3i = r3 - r1;
  r0 = t0r + t2r; i0 = t0i + t2i; r1 = t1r + t3r; i1 = t1i + t3i; r2 = t0r - t2r; i2 = t0i - t2i; r3 = t1r - t3r; i3 = t1i - t3i;
}
DI void dft16(float (&zr)[16], float (&zi)[16]) {
#pragma unroll
  for (int b = 0; b < 4; ++b) dft4(zr[b], zi[b], zr[4 + b], zi[4 + b], zr[8 + b], zi[8 + b], zr[12 + b], zi[12 + b]);
  constexpr float C1 = 0.9238795325112867f, S1 = 0.3826834323650898f, C2 = 0.7071067811865476f;
  const float wr[10] = {1.f, C1, C2, S1, 0.f, 0.f, -C2, 0.f, 0.f, -C1};
  const float wi[10] = {0.f, -S1, -C2, -C1, -1.f, 0.f, -C2, 0.f, 0.f, S1};
#pragma unroll
  for (int q = 1; q < 4; ++q)
#pragma unroll
    for (int b = 1; b < 4; ++b) {
      const float c = wr[b * q], d = wi[b * q];
      const float xr = zr[4 * q + b], xi = zi[4 * q + b];
      zr[4 * q + b] = xr * c - xi * d; zi[4 * q + b] = xr * d + xi * c;
    }
#pragma unroll
  for (int q = 0; q < 4; ++q) dft4(zr[4 * q], zi[4 * q], zr[4 * q + 1], zi[4 * q + 1], zr[4 * q + 2], zi[4 * q + 2], zr[4 * q + 3], zi[4 * q + 3]);
}

DI size_t y_base(int seq) { return seq < 8 ? (size_t)seq * 16 * 256 * 576 : (size_t)8 * 16 * 256 * 576; }
DI void phase_attnA(const P& p, char* lds) {
  const bf16_t* PROJ = (const bf16_t*)(p.ws + O_PROJ0);
  const bf16_t* VT = (const bf16_t*)(p.ws + O_VTA);
  bf16_t* MIX = (bf16_t*)(p.ws + O_MIX);
  const int nS = 129 * 6, nP = 8 * 33 * 6;
  const int sb = threadIdx.x >> 8;
  unsigned* head = (unsigned*)(p.ws + O_CNT);
  for (;;) {
    if (threadIdx.x == 0) *(volatile int*)(lds + 2 * 36864) = (int)__hip_atomic_fetch_add(head, 1u, __ATOMIC_RELAXED, __HIP_MEMORY_SCOPE_AGENT);
    __syncthreads();
    const int it = *(volatile int*)(lds + 2 * 36864);
    __syncthreads();
    if (it >= nS + nP) break;
    int seq, qt, hq;
    if (it < nS) { seq = 8; hq = (it % 6) * 2 + sb; qt = it / 6; }
    else { int j = it - nS; hq = (j % 6) * 2 + sb; j /= 6; qt = j % 33; seq = j / 33; }
    const int kv = hq / 3;
    const int L = seq_len(seq), LP = L + 48;
    flash_item<0>(PROJ + hq * 64, 1536, PROJ + 768 + kv * 64, 1536, VT + vta_base(seq) + (size_t)kv * 64 * LP, LP,
                  MIX + hq * 64, 1024, seq_base(seq), L - 16, qt, 0.f, lds + sb * 36864);
  }
  const bf16_t* ZB = (const bf16_t*)(p.ws + O_ZB);
  bf16_t* Y = (bf16_t*)(p.ws + O_Y);
  const int lane = threadIdx.x & 63, wave = threadIdx.x >> 6;
  const int nI_S = 17 * 16, nI_P = 8 * 5 * 16;
  for (int it = blockIdx.x; it < nI_S + nI_P; it += gridDim.x) {
    int seq, nb, cb;
    if (it < nI_S) { seq = 8; cb = it & 15; nb = it >> 4; }
    else { int j = it - nI_S; cb = j & 15; j >>= 4; nb = j % 5; seq = j / 5; }
    const int M = seq < 8 ? 257 : 1025, KP = seq < 8 ? 576 : 2112, L = 16 * M;
    const int n2 = nb * 64 + lane;
    const int ch = cb * 16 + wave * 2;
    const int g = ch >> 6, d = ch & 63;
    bf16_t* yb = Y + y_base(seq);
    if (n2 < M) {
      float ar[16], ai[16], br[16], bi[16];
#pragma unroll
      for (int n1 = 0; n1 < 16; ++n1) {
        const bf16_t* zp = ZB + (size_t)(seq_base(seq) + M * n1 + n2) * 512 + g * 128 + d;
        unsigned re = *(const unsigned*)zp, im = *(const unsigned*)(zp + 64);
        ar[n1] = lo2f(re); br[n1] = hi2f(re); ai[n1] = lo2f(im); bi[n1] = hi2f(im);
      }
      dft16(ar, ai);
      dft16(br, bi);
      float t1s, t1c;
      sincospif(-2.f * (float)n2 / (float)L, &t1s, &t1c);
      float tc = 1.f, ts = 0.f;
#pragma unroll
      for (int k1 = 0; k1 < 16; ++k1) {
        const int ix = 4 * (k1 & 3) + (k1 >> 2);
        const float yr0 = ar[ix] * tc - ai[ix] * ts, yi0 = ar[ix] * ts + ai[ix] * tc;
        const float yr1 = br[ix] * tc - bi[ix] * ts, yi1 = br[ix] * ts + bi[ix] * tc;
        bf16_t* y0 = yb + ((size_t)k1 * 256 + ch) * KP;
        y0[n2] = f2bf(yr0); y0[M + n2] = f2bf(yi0);
        y0[KP + n2] = f2bf(yr1); y0[KP + M + n2] = f2bf(yi1);
        const float nc = tc * t1c - ts * t1s; ts = tc * t1s + ts * t1c; tc = nc;
      }
    } else if (n2 < KP - M) {
      for (int k1 = 0; k1 < 16; ++k1) {
        bf16_t* y0 = yb + ((size_t)k1 * 256 + ch) * KP;
        y0[M + n2] = 0; y0[KP + M + n2] = 0;
      }
    }
  }
}

DI void phase_fnet_gemm(const P& p, char* lds) {
  GEMM_IDS
  bf16_t* MIX = (bf16_t*)(p.ws + O_MIX);
  const bf16_t* Y = (const bf16_t*)(p.ws + O_Y);
  const int nS = 16 * 9 * 2, nP = 8 * 16 * 3 * 2;
  const int sb = threadIdx.x >> 8;
  for (int it0 = blockIdx.x * 2; it0 < nS + nP; it0 += gridDim.x * 2) {
    const int it = it0 + sb;
    int seq, k1, tm, tn;
    if (it < nS) { seq = 8; tn = it & 1; int j = it >> 1; tm = j % 9; k1 = j / 9; }
    else { int j = it - nS; tn = j & 1; j >>= 1; tm = j % 3; j /= 3; k1 = j & 15; seq = j >> 4; }
    const int M = seq < 8 ? 257 : 1025, KP = seq < 8 ? 576 : 2112, L = 16 * M;
    const bf16_t* dm = (const bf16_t*)(p.ws + (seq < 8 ? O_DM257 : O_DM1025));
    f32x16 acc[2][2];
    gemm_tile(dm + (size_t)tm * 128 * KP, KP, Y + y_base(seq) + ((size_t)k1 * 256 + tn * 128) * KP, KP, KP, lds + sb * 36864, acc);
    const float scale = rsqrtf(64.f * (float)L);
#pragma unroll
    for (int mt = 0; mt < 2; ++mt)
#pragma unroll
      for (int nt = 0; nt < 2; ++nt)
#pragma unroll
        for (int i = 0; i < 16; ++i) {
          int k2 = tm * 128 + ACC_ROW(mt, i), ch = tn * 128 + ACC_COL(nt);
          if (k2 < M) {
            int pos = k1 + 16 * k2;
            MIX[(size_t)(seq_base(seq) + pos) * 1024 + 768 + ch] = f2bf(acc[mt][nt][i] * scale + p.b_b[ch]);
          }
        }
  }
}

DI size_t vtc_base(int seq) { return seq < 8 ? (size_t)seq * 128 * 4160 : (size_t)8 * 128 * 4160; }
DI void phase_prepC(const P& p, char* lds) {
  const int gtid = blockIdx.x * NTH + threadIdx.x, gsz = gridDim.x * NTH;
  const int lane = threadIdx.x & 63, gw = gtid >> 6, nw = gsz >> 6;
  bf16_t* PC = (bf16_t*)(p.ws + O_PC);
  bf16_t* VT = (bf16_t*)(p.ws + O_VTC);
  const bf16_t* PLOW = (const bf16_t*)(p.ws + O_PLOW);
  bf16_t* LR = (bf16_t*)(p.ws + O_LR);
  vt_transpose<128>(PC, 768, 640, VT, lds);
  for (int sr = gw; sr < T_; sr += nw) {
    int pos; int b = seq_of(sr, pos);
    const int L = seq_len(b), LP = L + 48;
    bf16_t* pr = PC + (size_t)sr * 768;
    float cs[8], sn[8];
    {
      float s1, c1;
      sincosf((float)pos * exp2f(-(float)(lane & 7) * (18.931568569324174f / 8.f)), &s1, &c1);
#pragma unroll
      for (int j = 0; j < 8; ++j) { sn[j] = __shfl(s1, j); cs[j] = __shfl(c1, j); }
    }
#pragma unroll
    for (int part = 0; part < 2; ++part) {
      const bool act = part == 0 || lane < 16;
      const int col = part * 512 + (act ? lane : 0) * 8;
      uint4 u = *(const uint4*)(pr + col);
      float e[8] = {lo2f(u.x), hi2f(u.x), lo2f(u.y), hi2f(u.y), lo2f(u.z), hi2f(u.z), lo2f(u.w), hi2f(u.w)};
      float o[8];
#pragma unroll
      for (int j = 0; j < 8; ++j) {
        float pa = __shfl_xor(e[j], 1);
        float rot = e[j] * cs[j] + pa * ((lane & 1) ? sn[j] : -sn[j]);
        o[j] = (lane & 7) < 2 ? rot : e[j];
        if (part == 0) o[j] *= 0.125f * LOG2E;
      }
      if (act) *(uint4*)(pr + col) = make_uint4(pack2(o[0], o[1]), pack2(o[2], o[3]), pack2(o[4], o[5]), pack2(o[6], o[7]));
    }
#pragma unroll
    for (int q = 0; q < 6; ++q) {
      int c = q * 64 + lane;
      float u = bf2f(PLOW[(size_t)sr * 384 + c]);
      float up = pos > 0 ? bf2f(PLOW[(size_t)(sr - 1) * 384 + c]) : 0.f;
      float un = pos < L - 1 ? bf2f(PLOW[(size_t)(sr + 1) * 384 + c]) : 0.f;
      float us = u + p.mu_prev[1536 + c] * (up - u) + p.mu_next[1536 + c] * (un - u);
      float v = c < 128 ? tanhf(us) : (c < 256 ? us : sigmoidf_(us));
      LR[(size_t)sr * 384 + c] = f2bf(v);
    }
  }
}

DI void phase_attnC(const P& p, char* lds) {
  const bf16_t* PC = (const bf16_t*)(p.ws + O_PC);
  const bf16_t* VT = (const bf16_t*)(p.ws + O_VTC);
  bf16_t* MIX = (bf16_t*)(p.ws + O_MIX);
  const int nS = 129 * 4, nP = 8 * 33 * 4;
  const int sb = threadIdx.x >> 8;
  for (int it = blockIdx.x; it < nS + nP; it += gridDim.x) {
    int seq, qt, hq;
    if (it < nS) { seq = 8; hq = (it & 3) * 2 + sb; qt = it >> 2; }
    else { int j = it - nS; hq = (j & 3) * 2 + sb; j >>= 2; qt = j % 33; seq = j / 33; }
    const int kv = hq >> 2;
    const int L = seq_len(seq), LP = L + 48;
    flash_item<1>(PC + hq * 64, 768, PC + 512 + kv * 64, 768, VT + vtc_base(seq) + (size_t)kv * 64 * LP, LP,
                  MIX + hq * 64, 1024, seq_base(seq), L - 16, qt, p.c_sink[hq] * LOG2E, lds + sb * 36864);
  }
}

DI void chunk_decode(int cg_, int& seq, int& c) {
  if (cg_ < 136) { seq = cg_ / 17; c = cg_ - seq * 17; } else { seq = 8; c = cg_ - 136; }
}
DI float shiftv(const bf16_t* PRKV, int sr, int pos, int L, int col, float mp, float mn) {
  float u = bf2f(PRKV[(size_t)sr * 1536 + col]);
  float up = pos > 0 ? bf2f(PRKV[(size_t)(sr - 1) * 1536 + col]) : 0.f;
  float un = pos < L - 1 ? bf2f(PRKV[(size_t)(sr + 1) * 1536 + col]) : 0.f;
  return u + mp * (up - u) + mn * (un - u);
}
enum { VW = 0, VA = 1, VB = 2, VK = 3, VV = 4, VR = 5 };
#define DPP_FMAC(acc, x, y, N) asm("v_fmac_f32_dpp %0, %1, %2 row_newbcast:%3 row_mask:0xf bank_mask:0xf" : "+v"(acc) : "v"(x), "v"(y), "n"(N))
#define DPP_MUL(sv_, x, N) asm("v_mul_f32_dpp %0, %1, %0 row_newbcast:%2 row_mask:0xf bank_mask:0xf" : "+v"(sv_) : "v"(x), "n"(N))
template <int N> DI void dpp_dot4(float& a0, float& a1, float& a2, float& a3, const float (&S)[64], const float4& x) {
  DPP_FMAC(a0, x.x, S[N], N); DPP_FMAC(a1, x.y, S[16 + N], N); DPP_FMAC(a2, x.z, S[32 + N], N); DPP_FMAC(a3, x.w, S[48 + N], N);
  if constexpr (N < 15) dpp_dot4<N + 1>(a0, a1, a2, a3, S, x);
}
template <int N, bool HASV, bool OUT> DI void dpp_upd4(float (&S)[64], const float4& xb, const float4& xk, const float4& xr, float sa, float vi,
                                                       float& o0, float& o1, float& o2, float& o3) {
  DPP_FMAC(S[N], xb.x, sa, N); DPP_FMAC(S[16 + N], xb.y, sa, N); DPP_FMAC(S[32 + N], xb.z, sa, N); DPP_FMAC(S[48 + N], xb.w, sa, N);
  if (HASV) { DPP_FMAC(S[N], xk.x, vi, N); DPP_FMAC(S[16 + N], xk.y, vi, N); DPP_FMAC(S[32 + N], xk.z, vi, N); DPP_FMAC(S[48 + N], xk.w, vi, N); }
  if (OUT) { DPP_FMAC(o0, xr.x, S[N], N); DPP_FMAC(o1, xr.y, S[16 + N], N); DPP_FMAC(o2, xr.z, S[32 + N], N); DPP_FMAC(o3, xr.w, S[48 + N], N); }
  if constexpr (N < 15) dpp_upd4<N + 1, HASV, OUT>(S, xb, xk, xr, sa, vi, o0, o1, o2, o3);
}
template <int N> DI void dpp_scale4(float (&S)[64], const float4& xg) {
  DPP_MUL(S[N], xg.x, N); DPP_MUL(S[16 + N], xg.y, N); DPP_MUL(S[32 + N], xg.z, N); DPP_MUL(S[48 + N], xg.w, N);
  if constexpr (N < 15) dpp_scale4<N + 1>(S, xg);
}
template <int NST, bool HASV, bool OUT, class F>
DI void scan_steps(float (&S)[64], const float* sv, int ns, int lane, F&& emit) {
  const int l15 = lane & 15;
  (void)ns;
#pragma unroll 4
  for (int s = 0; s < NST; ++s) {
    const float4 xa = *(const float4*)(sv + VA * NST * 64 + s * 64 + l15 * 4);
    const float4 xb = *(const float4*)(sv + VB * NST * 64 + s * 64 + l15 * 4);
    float4 xk = xb, xr = xb;
    if (HASV) xk = *(const float4*)(sv + VK * NST * 64 + s * 64 + l15 * 4);
    if (OUT) xr = *(const float4*)(sv + VR * NST * 64 + s * 64 + l15 * 4);
    const float vi = HASV ? sv[VV * NST * 64 + s * 64 + lane] : 0.f;
    float sa0 = 0.f, sa1 = 0.f, sa2 = 0.f, sa3 = 0.f;
    dpp_dot4<0>(sa0, sa1, sa2, sa3, S, xa);
    const float sa = (sa0 + sa1) + (sa2 + sa3);
    float o0 = 0.f, o1 = 0.f, o2 = 0.f, o3 = 0.f;
    dpp_upd4<0, HASV, OUT>(S, xb, xk, xr, sa, vi, o0, o1, o2, o3);
    if (OUT) emit(s, (o0 + o1) + (o2 + o3));
    if ((s & 7) == 7) {
      const float4 xg = *(const float4*)(sv + VW * NST * 64 + (s >> 3) * 64 + l15 * 4);
      dpp_scale4<0>(S, xg);
    }
  }
}
DI int vperm(int j) { return (j & 15) * 4 + (j >> 4); }

DI void shift8(const bf16_t* PRKV, const P& p, int sbase, int pos, int L, int off, int c0, float (&out)[8]) {
  const bf16_t* rp = PRKV + (size_t)(sbase + pos) * 1536 + off + c0;
  const u32x4 uc = *(const u32x4*)rp;
  u32x4 up = (u32x4)(0u), un = (u32x4)(0u);
  if (pos > 0) up = *(const u32x4*)(rp - 1536);
  if (pos < L - 1) un = *(const u32x4*)(rp + 1536);
  const f32x4v mp0 = *(const f32x4v*)(p.mu_prev + off + c0), mp1 = *(const f32x4v*)(p.mu_prev + off + c0 + 4);
  const f32x4v mn0 = *(const f32x4v*)(p.mu_next + off + c0), mn1 = *(const f32x4v*)(p.mu_next + off + c0 + 4);
#pragma unroll
  for (int e2 = 0; e2 < 4; ++e2) {
    const float c_lo = lo2f(uc[e2]), c_hi = hi2f(uc[e2]);
    const float mpl = e2 < 2 ? mp0[2 * e2] : mp1[2 * e2 - 4], mph = e2 < 2 ? mp0[2 * e2 + 1] : mp1[2 * e2 - 3];
    const float mnl = e2 < 2 ? mn0[2 * e2] : mn1[2 * e2 - 4], mnh = e2 < 2 ? mn0[2 * e2 + 1] : mn1[2 * e2 - 3];
    out[2 * e2] = c_lo + mpl * (lo2f(up[e2]) - c_lo) + mnl * (lo2f(un[e2]) - c_lo);
    out[2 * e2 + 1] = c_hi + mph * (hi2f(up[e2]) - c_hi) + mnh * (hi2f(un[e2]) - c_hi);
  }
}

template <int NST, bool P3>
DI void scan_prologue8(const P& p, int sbase, int L, int hd, int dir, int pos0, int nsteps, int sb0, float* sv) {
  const int lane = threadIdx.x & 63, l31 = lane & 31, h = lane >> 5;
  const bf16_t* PRKV = (const bf16_t*)(p.ws + O_PRKV);
  const bf16_t* LR = (const bf16_t*)(p.ws + O_LR);
  const bf16_t* WUPT = (const bf16_t*)(p.ws + O_WUPT) + (size_t)(dir * 512 + hd * 64) * 64;
  const bf16_t* AUPT = (const bf16_t*)(p.ws + O_AUPT) + (size_t)(dir * 512 + hd * 64) * 64;
  float* bonus = (float*)(p.ws + O_BONUS);
  {
    int sl = sb0 + (l31 & 7); if (sl > nsteps - 1) sl = nsteps - 1;
    const int pos = dir ? pos0 - sl : pos0 + sl;
    const bf16_t* lrp = LR + (size_t)(sbase + pos) * 384 + dir * 64 + 8 * h;
#pragma unroll 1
    for (int mat = 0; mat < 2; ++mat) {
      const bf16_t* Wm = mat ? AUPT : WUPT;
      const float* bias = mat ? p.d_a0 : p.d_w0;
      f32x16 ac[2];
#pragma unroll
      for (int nt = 0; nt < 2; ++nt)
#pragma unroll
        for (int i = 0; i < 16; ++i) ac[nt][i] = 0.f;
#pragma unroll
      for (int ks = 0; ks < 4; ++ks) {
        const bf16x8 fa = *(const bf16x8*)(lrp + mat * 128 + 16 * ks);
#pragma unroll
        for (int nt = 0; nt < 2; ++nt) {
          const bf16x8 bw = *(const bf16x8*)(Wm + (size_t)(32 * nt + l31) * 64 + 16 * ks + 8 * h);
          ac[nt] = MFMA32(fa, bw, ac[nt]);
        }
      }
#pragma unroll
      for (int nt = 0; nt < 2; ++nt) {
        const int j = 32 * nt + l31;
        const float b0 = bias[dir * 512 + hd * 64 + j];
#pragma unroll
        for (int i = 0; i < 4; ++i) {
          const int st = sb0 + i + 4 * h;
          const float sg = 1.f / (1.f + __expf(-(b0 + ac[nt][i])));
          if (mat) sv[VK * NST * 64 + st * 64 + j] = sg;
          else ac[nt][i] = __expf(-0.6065306597126334f * sg);
        }
        if (!mat) {
          float g0 = ac[nt][0], g1 = g0 * ac[nt][1], g2 = g1 * ac[nt][2], g3 = g2 * ac[nt][3];
          const float tot_lo = __shfl(g3, l31);
          if (h) { g0 *= tot_lo; g1 *= tot_lo; g2 *= tot_lo; g3 *= tot_lo; }
          float* gd = sv + VA * NST * 64 + (sb0 + 4 * h) * 64 + j;
          gd[0] = g0; gd[64] = g1; gd[128] = g2; gd[192] = g3;
          if (h) sv[VW * NST * 64 + (sb0 >> 3) * 64 + vperm(j)] = g3;
        }
      }
    }
  }
  const int stp = lane >> 3, seg = lane & 7, c0 = hd * 64 + 8 * seg;
  const int s = sb0 + stp;
  const int ss = s < nsteps ? s : nsteps - 1;
  const int pos = dir ? pos0 - ss : pos0 + ss;
  float k[8], a[8], gam[8], gpr[8];
  shift8(PRKV, p, sbase, pos, L, 512, c0, k);
  {
    const f32x4v a0 = *(const f32x4v*)(sv + VK * NST * 64 + s * 64 + 8 * seg), a1 = *(const f32x4v*)(sv + VK * NST * 64 + s * 64 + 8 * seg + 4);
    const f32x4v g0 = *(const f32x4v*)(sv + VA * NST * 64 + s * 64 + 8 * seg), g1 = *(const f32x4v*)(sv + VA * NST * 64 + s * 64 + 8 * seg + 4);
    const int sp = stp > 0 ? s - 1 : s;
    const f32x4v q0 = *(const f32x4v*)(sv + VA * NST * 64 + sp * 64 + 8 * seg), q1 = *(const f32x4v*)(sv + VA * NST * 64 + sp * 64 + 8 * seg + 4);
#pragma unroll
    for (int e = 0; e < 4; ++e) {
      a[e] = a0[e]; a[4 + e] = a1[e]; gam[e] = g0[e]; gam[4 + e] = g1[e];
      gpr[e] = stp > 0 ? q0[e] : 1.f; gpr[4 + e] = stp > 0 ? q1[e] : 1.f;
    }
  }
  const f32x4v kk0 = *(const f32x4v*)(p.d_k_k + c0), kk1 = *(const f32x4v*)(p.d_k_k + c0 + 4);
  const f32x4v ka0 = *(const f32x4v*)(p.d_k_a + c0), ka1 = *(const f32x4v*)(p.d_k_a + c0 + 4);
  float kk[8], kd[8];
  float n2 = 0.f;
#pragma unroll
  for (int e = 0; e < 8; ++e) {
    kk[e] = k[e] * (e < 4 ? kk0[e] : kk1[e - 4]);
    n2 += kk[e] * kk[e];
    kd[e] = k[e] * (1.f + (a[e] - 1.f) * (e < 4 ? ka0[e] : ka1[e - 4]));
  }
  n2 += __shfl_xor(n2, 1); n2 += __shfl_xor(n2, 2); n2 += __shfl_xor(n2, 4);
  const float rn = rsqrtf(fmaxf(n2, 1e-24f));
#pragma unroll
  for (int e = 0; e < 8; ++e) {
    const int ix = s * 64 + vperm(8 * seg + e);
    const float kn = kk[e] * rn;
    const float ig = __builtin_amdgcn_rcpf(gam[e]);
    sv[VA * NST * 64 + ix] = -kn * gpr[e];
    sv[VB * NST * 64 + ix] = kn * a[e] * ig;
    sv[VK * NST * 64 + ix] = kd[e] * ig;
  }
  {
    float v[8];
    shift8(PRKV, p, sbase, pos, L, 1024, c0, v);
    *(f32x4v*)(sv + VV * NST * 64 + s * 64 + 8 * seg) = (f32x4v){v[0], v[1], v[2], v[3]};
    *(f32x4v*)(sv + VV * NST * 64 + s * 64 + 8 * seg + 4) = (f32x4v){v[4], v[5], v[6], v[7]};
  }
  if (P3) {
    float r[8];
    shift8(PRKV, p, sbase, pos, L, 0, c0, r);
    const f32x4v rk0 = *(const f32x4v*)(p.d_r_k + c0), rk1 = *(const f32x4v*)(p.d_r_k + c0 + 4);
    float bn = 0.f;
#pragma unroll
    for (int e = 0; e < 8; ++e) {
      sv[VR * NST * 64 + s * 64 + vperm(8 * seg + e)] = r[e] * gam[e];
      bn += r[e] * kd[e] * (e < 4 ? rk0[e] : rk1[e - 4]);
    }
    bn += __shfl_xor(bn, 1); bn += __shfl_xor(bn, 2); bn += __shfl_xor(bn, 4);
    if (s < nsteps && seg == 0) bonus[((size_t)(sbase + pos) * 8 + hd) * 2 + dir] = bn;
  }
}

DI unsigned scan_touch(const P& p, int sbase, int L, int hd, int dir, int posf  ) {
  const int lane = threadIdx.x & 63;
  const bf16_t* PRKV = (const bf16_t*)(p.ws + O_PRKV);
  const bf16_t* LR = (const bf16_t*)(p.ws + O_LR);
  const int lo = dir ? posf - 8 : posf - 1;
  const unsigned* ptr;
  if (lane < 30) { int row = lo + lane / 3; row = row < 0 ? 0 : (row > L - 1 ? L - 1 : row); ptr = (const unsigned*)(PRKV + (size_t)(sbase + row) * 1536 + (lane % 3) * 512 + hd * 64); }
  else { const int i2 = (lane - 30) & 15; int row = dir ? posf - (i2 >> 1) : posf + (i2 >> 1); row = row < 0 ? 0 : (row > L - 1 ? L - 1 : row); ptr = (const unsigned*)(LR + (size_t)(sbase + row) * 384 + (i2 & 1) * 128 + dir * 64); }
  return *ptr;
}

template <bool HALF> DI void scan1_body(const P& p, char* lds) {
  float* PQ = (float*)(p.ws + O_PQ);
  const int lane = threadIdx.x & 63, wave = __builtin_amdgcn_readfirstlane(threadIdx.x >> 6), slot = wave >> 1;
  constexpr int half = HALF ? 1 : 0;
  float* sv = (float*)lds + slot * (6 * 16 * 64);
  for (int g = blockIdx.x; g < 804; g += gridDim.x) {
    int seq, c, hp;
    if (g < 768) { const int lc = g >> 2; hp = g & 3; if (lc < 128) { seq = lc >> 4; c = lc & 15; } else { seq = 8; c = lc - 128; } }
    else { const int j = g - 768; hp = j & 3; seq = j >> 2; c = seq < 8 ? 16 : 64; }
    const int cgi = seq < 8 ? seq * 17 + c : 136 + c;
    const int hd = hp * 2 + (slot >> 1), dir = slot & 1;
    const int it = (cgi * 8 + hd) * 2 + dir;
    const int L = seq_len(seq), sbase = seq_base(seq);
    const int start = c * 256, end = min(L, start + 256), n = end - start;
    float S[64];
#pragma unroll
    for (int j = 0; j < 64; ++j) S[j] = (half == 0 && j == lane) ? 1.f : 0.f;
    for (int s0 = 0; s0 < n; s0 += 16) {
      const int ns = min(16, n - s0);
      const int pos0 = dir ? end - 1 - s0 : start + s0;
      __syncthreads();
      scan_prologue8<16, false>(p, sbase, L, hd, dir, pos0, ns, half * 8, sv);
      __syncthreads();
      unsigned tch = 0u;
      if (s0 + 16 < n) tch = scan_touch(p, sbase, L, hd, dir, dir ? pos0 - 16 - half * 8 : pos0 + 16 + half * 8);
      scan_steps<16, HALF, false>(S, sv, ns, lane, [](int, float) {});
      asm volatile("" :: "v"(tch));
    }
    float* dst = PQ + (size_t)it * 8192 + (size_t)(half * 64 + lane) * 64;
#pragma unroll
    for (int q = 0; q < 16; ++q) *(float4*)(dst + q * 4) = make_float4(S[q * 4], S[q * 4 + 1], S[q * 4 + 2], S[q * 4 + 3]);
  }
}

DI void phase_scan1(const P& p, char* lds) {
  const int w_ = __builtin_amdgcn_readfirstlane(threadIdx.x >> 6);
  if ((w_ ^ (w_ >> 2)) & 1) scan1_body<true>(p, lds); else scan1_body<false>(p, lds);
}

DI void phase_scan2(const P& p, char* lds) {
  float* Ss = (float*)lds;
  float* Ps = Ss + 64 * 65;
  float* PQ = (float*)(p.ws + O_PQ);
  const int tid = threadIdx.x, lane = tid & 63, wave = __builtin_amdgcn_readfirstlane(tid >> 6), l31 = lane & 31, h = lane >> 5;
  const int r0 = 32 * (wave >> 1), c0 = 32 * (wave & 1);
  for (int it = blockIdx.x; it < 144; it += gridDim.x) {
    const int dir = it & 1, hd = (it >> 1) & 7, seq = it >> 4;
    const int nch = seq < 8 ? 17 : 65, cg0 = seq < 8 ? seq * 17 : 136;
    f32x16 S;
#pragma unroll
    for (int i = 0; i < 16; ++i) S[i] = 0.f;
    f32x4v pn0, pn1;
    {
      const int c = dir ? nch - 1 : 0;
      const float* Pg = PQ + (size_t)(((cg0 + c) * 8 + hd) * 2 + dir) * 8192;
      pn0 = *(const f32x4v*)(Pg + tid * 4); pn1 = *(const f32x4v*)(Pg + (512 + tid) * 4);
    }
    for (int cc = 0; cc < nch; ++cc) {
      const int c = dir ? nch - 1 - cc : cc;
      float* Qg = PQ + (size_t)(((cg0 + c) * 8 + hd) * 2 + dir) * 8192 + 4096;
      __syncthreads();
      { const int m = tid >> 4, cq = (tid & 15) * 4; *(f32x4v*)(Ps + m * 68 + cq) = pn0; *(f32x4v*)(Ps + (m + 32) * 68 + cq) = pn1; }
      f32x16 acc;
      if (wave < 4) {
#pragma unroll
        for (int i = 0; i < 16; ++i) {
          const int row = r0 + (i & 3) + 8 * (i >> 2) + 4 * h;
          Ss[row * 65 + c0 + l31] = S[i];
          float* qp = Qg + row * 64 + c0 + l31;
          acc[i] = *qp;
          *qp = S[i];
        }
      }
      if (cc + 1 < nch) {
        const int c2 = dir ? nch - 2 - cc : cc + 1;
        const float* Pg2 = PQ + (size_t)(((cg0 + c2) * 8 + hd) * 2 + dir) * 8192;
        pn0 = *(const f32x4v*)(Pg2 + tid * 4); pn1 = *(const f32x4v*)(Pg2 + (512 + tid) * 4);
      }
      __syncthreads();
      if (wave < 4) {
#pragma unroll 8
        for (int kk = 0; kk < 32; ++kk) {
          const float av = Ss[(r0 + l31) * 65 + 2 * kk + h];
          const float bv = Ps[(2 * kk + h) * 68 + c0 + l31];
          acc = __builtin_amdgcn_mfma_f32_32x32x2f32(av, bv, acc, 0, 0, 0);
        }
        S = acc;
      }
    }
  }
}

DI void phase_scan3(const P& p, char* lds) {
  const float* PQ = (const float*)(p.ws + O_PQ);
  bf16_t* MIX = (bf16_t*)(p.ws + O_MIX);
  bf16_t* OB = (bf16_t*)(p.ws + O_OB);
  const int lane = threadIdx.x & 63, wave = __builtin_amdgcn_readfirstlane(threadIdx.x >> 6);
  float* sv = (float*)lds + wave * (6 * 8 * 64);
  const bool bal = gridDim.x == 256;
  const int NW = gridDim.x * 8, gw = blockIdx.x * 8 + wave;
  for (int k = 0; ; ++k) {
    int oi;
    if (bal) {
      if (k == 0) oi = gw;
      else if (k == 1) { if (wave >= 4) continue; oi = 2048 + blockIdx.x * 4 + wave; }
      else if (k == 2) { if (wave != 7 || blockIdx.x >= 144) break; oi = 3072 + blockIdx.x; }
      else break;
    } else { oi = gw + k * NW; if (oi >= 3216) break; }
    int seq, c, hd, dir;
    if (oi < 3072) { const int lc = oi >> 4; hd = (oi >> 1) & 7; dir = oi & 1; if (lc < 128) { seq = lc >> 4; c = lc & 15; } else { seq = 8; c = lc - 128; } }
    else { const int j = oi - 3072; hd = (j >> 1) & 7; dir = j & 1; seq = j >> 4; c = seq < 8 ? 16 : 64; }
    const int it = ((seq < 8 ? seq * 17 + c : 136 + c) * 8 + hd) * 2 + dir;
    const int L = seq_len(seq), sbase = seq_base(seq);
    const int start = c * 256, end = min(L, start + 256), n = end - start;
    float S[64];
    {
      const float* src = PQ + (size_t)it * 8192 + 4096 + lane * 64;
#pragma unroll
      for (int q = 0; q < 16; ++q) { float4 t = *(const float4*)(src + q * 4); S[q * 4] = t.x; S[q * 4 + 1] = t.y; S[q * 4 + 2] = t.z; S[q * 4 + 3] = t.w; }
    }
    for (int s0 = 0; s0 < n; s0 += 8) {
      const int ns = min(8, n - s0);
      const int pos0 = dir ? end - 1 - s0 : start + s0;
      scan_prologue8<8, true>(p, sbase, L, hd, dir, pos0, ns, 0, sv);
      unsigned tch = 0u;
      if (s0 + 8 < n) tch = scan_touch(p, sbase, L, hd, dir, dir ? pos0 - 8 : pos0 + 8);
      scan_steps<8, true, true>(S, sv, ns, lane, [&](int st, float o) {
        const int pos = dir ? pos0 - st : pos0 + st;
        const size_t sr = (size_t)(sbase + pos);
        if (dir == 0) MIX[sr * 1024 + 512 + hd * 64 + lane] = f2bf(o);
        else OB[sr * 512 + hd * 64 + lane] = f2bf(o);
      });
      asm volatile("" :: "v"(tch));
    }
  }
}

DI void phase_rwkv_final(const P& p) {
  const int lane = threadIdx.x & 63, gw = (blockIdx.x * NTH + threadIdx.x) >> 6, nw = (gridDim.x * NTH) >> 6;
  bf16_t* MIX = (bf16_t*)(p.ws + O_MIX);
  const bf16_t* OB = (const bf16_t*)(p.ws + O_OB);
  const bf16_t* G = (const bf16_t*)(p.ws + O_G);
  const bf16_t* PRKV = (const bf16_t*)(p.ws + O_PRKV);
  const float* bonus = (const float*)(p.ws + O_BONUS);
  const int hd = lane >> 3, c0 = lane * 8;
  float mp[8], mn[8], lg[8], lb[8];
#pragma unroll
  for (int j = 0; j < 8; ++j) { mp[j] = p.mu_prev[1024 + c0 + j]; mn[j] = p.mu_next[1024 + c0 + j]; lg[j] = p.d_ln_g[c0 + j]; lb[j] = p.d_ln_b[c0 + j]; }
  for (int sr = gw; sr < T_; sr += nw) {
    int pos; int b = seq_of(sr, pos);
    const int L = seq_len(b);
    const u32x4 uf = *(const u32x4*)(MIX + (size_t)sr * 1024 + 512 + c0);
    const u32x4 ub = *(const u32x4*)(OB + (size_t)sr * 512 + c0);
    const u32x4 ug = *(const u32x4*)(G + (size_t)sr * 512 + c0);
    const bf16_t* vr = PRKV + (size_t)sr * 1536 + 1024 + c0;
    const u32x4 vc = *(const u32x4*)vr;
    const u32x4 vp = *(const u32x4*)(pos > 0 ? vr - 1536 : vr);
    const u32x4 vn = *(const u32x4*)(pos < L - 1 ? vr + 1536 : vr);
    const float2 bn = *(const float2*)(bonus + ((size_t)sr * 8 + hd) * 2);
    const bool hp = pos > 0, hn = pos < L - 1;
    float o[8], gg[8], vsh[8];
    float sm = 0.f;
#pragma unroll
    for (int j = 0; j < 4; ++j) {
      o[2 * j] = lo2f(uf[j]) + lo2f(ub[j]); o[2 * j + 1] = hi2f(uf[j]) + hi2f(ub[j]);
      gg[2 * j] = lo2f(ug[j]); gg[2 * j + 1] = hi2f(ug[j]);
      sm += o[2 * j] + o[2 * j + 1];
      const float c_lo = lo2f(vc[j]), c_hi = hi2f(vc[j]);
      const float p_lo = hp ? lo2f(vp[j]) : 0.f, p_hi = hp ? hi2f(vp[j]) : 0.f;
      const float n_lo = hn ? lo2f(vn[j]) : 0.f, n_hi = hn ? hi2f(vn[j]) : 0.f;
      vsh[2 * j] = c_lo + mp[2 * j] * (p_lo - c_lo) + mn[2 * j] * (n_lo - c_lo);
      vsh[2 * j + 1] = c_hi + mp[2 * j + 1] * (p_hi - c_hi) + mn[2 * j + 1] * (n_hi - c_hi);
    }
    sm += __shfl_xor(sm, 1); sm += __shfl_xor(sm, 2); sm += __shfl_xor(sm, 4);
    const float mean = sm * (1.f / 64.f);
    float vs = 0.f;
#pragma unroll
    for (int j = 0; j < 8; ++j) { float dlt = o[j] - mean; vs += dlt * dlt; }
    vs += __shfl_xor(vs, 1); vs += __shfl_xor(vs, 2); vs += __shfl_xor(vs, 4);
    const float rstd = rsqrtf(vs * (1.f / 64.f) + 64e-5f);
    const float bsum = bn.x + bn.y;
    float y[8];
#pragma unroll
    for (int j = 0; j < 8; ++j) y[j] = ((o[j] - mean) * rstd * lg[j] + lb[j] + bsum * vsh[j]) * gg[j];
    *(uint4*)(MIX + (size_t)sr * 1024 + 512 + c0) = make_uint4(pack2(y[0], y[1]), pack2(y[2], y[3]), pack2(y[4], y[5]), pack2(y[6], y[7]));
  }
}

#define XB_TMO      128
#define XB_XCNT(j)  (256  + 64 * (j))
#define XB_XSUB(j)  (1280 + 64 * (j))
#define XB_XGEN(j)  (2304 + 64 * (j))
#define XB_TOP      3328
#define XB_TOPGEN   3392
#define XCD_BAR_WORDS 3456
#define XB_SPIN_CAP (1u << 23)
#define LAS __attribute__((address_space(3)))

__device__ __forceinline__ unsigned xb_ld(unsigned* p)              { return __hip_atomic_load(p, __ATOMIC_RELAXED, __HIP_MEMORY_SCOPE_AGENT); }
__device__ __forceinline__ unsigned xb_add(unsigned* p, unsigned v) { return __hip_atomic_fetch_add(p, v, __ATOMIC_RELAXED, __HIP_MEMORY_SCOPE_AGENT); }
__device__ __forceinline__ unsigned xb_xcc_id() { return (unsigned)__builtin_amdgcn_s_getreg((3 << 11) | 20) & 0xFu; }
#define XB_SPIN(cond, bar) do { unsigned _sp = 0; while (cond) { __builtin_amdgcn_s_sleep(1); \
    if ((++_sp & 255u) == 0u) { if (xb_ld(&(bar)[XB_TMO])) break; if (_sp > XB_SPIN_CAP) { atomicAdd(&(bar)[XB_TMO], 1u); break; } } } } while (0)

struct XcdBarrier {
    unsigned* bar; unsigned x;
    volatile LAS unsigned* st;
};

__device__ __forceinline__ XcdBarrier xcd_barrier_post(unsigned* bar, volatile LAS unsigned* st) {
    XcdBarrier b; b.bar = bar; b.x = xb_xcc_id(); b.st = st;
    if (threadIdx.x == 0) (void)xb_add(&bar[XB_XCNT(b.x)], 1u);
    return b;
}
__device__ __forceinline__ void xcd_barrier_complete(unsigned* bar, unsigned x, unsigned& nloc, unsigned& nx) {
    const unsigned G = gridDim.x * gridDim.y * gridDim.z;
    unsigned sum, cnt, mine, sp = 0u;
    for (;;) {
        sum = 0u; cnt = 0u; mine = 0u;
#pragma unroll
        for (unsigned j = 0; j < 16; ++j) { const unsigned c = xb_ld(&bar[XB_XCNT(j)]); sum += c; cnt += (c > 0u) ? 1u : 0u; mine = (j == x) ? c : mine; }
        if (sum == G) break;
        __builtin_amdgcn_s_sleep(1);
        if ((++sp & 255u) == 0u) { if (xb_ld(&bar[XB_TMO])) break; if (sp > XB_SPIN_CAP) { atomicAdd(&bar[XB_TMO], 1u); break; } }
    }
    nloc = mine > 0u ? mine : 1u; nx = cnt > 0u ? cnt : 1u;
}

__device__ __forceinline__ void xcd_barrier(const XcdBarrier& b) {
    asm volatile("s_waitcnt vmcnt(0)" ::: "memory");
    __syncthreads();
    if (threadIdx.x == 0) {
        unsigned* bar = b.bar;
        __builtin_amdgcn_s_waitcnt(0);
        unsigned nloc = b.st[0], nx = b.st[1];
        if (nloc == 0u) { xcd_barrier_complete(bar, b.x, nloc, nx); b.st[0] = nloc; b.st[1] = nx; }
        const unsigned old = xb_add(&bar[XB_XSUB(b.x)], 1u);
        const unsigned gen = old / nloc;
        if (old + 1u == (gen + 1u) * nloc) {
            __builtin_amdgcn_fence(__ATOMIC_RELEASE, "agent");
            asm volatile("s_waitcnt vmcnt(0)" ::: "memory");
            const unsigned og = xb_add(&bar[XB_TOP], 1u);
            const unsigned tg = og / nx;
            if (og + 1u == (tg + 1u) * nx) xb_add(&bar[XB_TOPGEN], 1u);
            else XB_SPIN(xb_ld(&bar[XB_TOPGEN]) == tg, bar);
            __builtin_amdgcn_fence(__ATOMIC_ACQUIRE, "agent");
            xb_add(&bar[XB_XGEN(b.x)], 1u);
            asm volatile("s_waitcnt vmcnt(0)" ::: "memory");
        } else {
            XB_SPIN(xb_ld(&bar[XB_XGEN(b.x)]) == gen, bar);
            __builtin_amdgcn_fence(__ATOMIC_ACQUIRE, "agent");
            asm volatile("s_waitcnt vmcnt(0)" ::: "memory");
        }
    }
    __syncthreads();
}

constexpr int NPHASE = 23;
__global__ void __launch_bounds__(NTH, 2) mega(P p) {
  extern __shared__ __attribute__((aligned(16))) unsigned char shm[];
  char* lds = (char*)shm;
  char* ws = p.ws;
  if (threadIdx.x == 0) *(uint4*)(shm + 131072) = make_uint4(0u, 0u, 0u, 0u);
  __syncthreads();
  const XcdBarrier xb = xcd_barrier_post((unsigned*)(ws + O_BAR), (volatile LAS unsigned*)(shm + 131072));
#ifndef DUP_MASK
#define DUP_MASK 0u
#endif
#define RUN(k, call) if (p.ph0 <= k && k < p.ph1) { call; if (k + 1 < p.ph1) { if (k == 0) cg::this_grid().sync(); else xcd_barrier(xb); } }
  RUN(0, phase_prep(p))
  RUN(1, phase_gemm_big((const bf16_t*)(ws + O_HN), (const bf16_t*)(ws + O_WIN0), 1536, 1024, (bf16_t*)(ws + O_PROJ0), 1536, 0, ws, shm))
  RUN(2, phase_prepA(p, lds))
  RUN(3, phase_attnA(p, lds))
  RUN(4, phase_fnet_gemm(p, lds))
  RUN(5, phase_gemm_big((const bf16_t*)(ws + O_MIX), (const bf16_t*)(ws + O_WOUT0), 1024, 1024, (bf16_t*)(ws + O_HN), 1024, 0, ws, shm))
  RUN(6, phase_resnorm(p, p.post_mix_g, p.pre_ffn_g))
  RUN(7, phase_gemm_gateup((const bf16_t*)(ws + O_HN), (const bf16_t*)(ws + O_WGU0), (bf16_t*)(ws + O_ACT), shm))
  RUN(8, phase_gemm_big((const bf16_t*)(ws + O_ACT), (const bf16_t*)(ws + O_WD0), 1024, DFF, (bf16_t*)(ws + O_HN), 1024, 0, ws, shm))
  RUN(9, phase_resnorm(p, p.post_ffn_g, p.pre_mix_g + 1024))
  RUN(10, phase_gemm_big((const bf16_t*)(ws + O_HN), (const bf16_t*)(ws + O_WIN1), 2816, 1024, nullptr, 0, 1, ws, shm))
  RUN(11, phase_prepC(p, lds))
  RUN(12, phase_attnC(p, lds))
  RUN(13, phase_scan1(p, lds))
  RUN(14, phase_scan2(p, lds))
  RUN(15, phase_scan3(p, lds))
  RUN(16, phase_gemm_small((const bf16_t*)(ws + O_LR) + 256, 384, (const bf16_t*)(ws + O_GUP), 512, 128, (bf16_t*)(ws + O_G), 512, lds))
  RUN(17, phase_rwkv_final(p))
  RUN(18, phase_gemm_big((const bf16_t*)(ws + O_MIX), (const bf16_t*)(ws + O_WOUT1), 1024, 1024, (bf16_t*)(ws + O_HN), 1024, 0, ws, shm))
  RUN(19, phase_resnorm(p, p.post_mix_g + 1024, p.pre_ffn_g + 1024))
  RUN(20, phase_gemm_gateup((const bf16_t*)(ws + O_HN), (const bf16_t*)(ws + O_WGU1), (bf16_t*)(ws + O_ACT), shm))
  RUN(21, phase_gemm_big((const bf16_t*)(ws + O_ACT), (const bf16_t*)(ws + O_WD1), 1024, DFF, (bf16_t*)(ws + O_HN), 1024, 0, ws, shm))
  RUN(22, phase_resnorm(p, p.post_ffn_g + 1024, nullptr))
#undef RUN
}

extern "C" void kernel_launch(void* const* d_in, const int* in_sizes, int n_in, void* d_out, int out_size, void* d_ws, size_t ws_size,
                              hipStream_t stream) {
  static int grid_blocks = 0;
  if (!grid_blocks) {
    int dev = 0, cus = 0, per_cu = 0;
    (void)hipGetDevice(&dev);
    (void)hipDeviceGetAttribute(&cus, hipDeviceAttributeMultiprocessorCount, dev);
    if (hipFuncSetAttribute((const void*)mega, hipFuncAttributeMaxDynamicSharedMemorySize, LDS_BYTES) != hipSuccess) fprintf(stderr, "hipFuncSetAttribute failed\n");
    if (hipOccupancyMaxActiveBlocksPerMultiprocessor(&per_cu, (const void*)mega, NTH, LDS_BYTES) != hipSuccess || per_cu < 1) {
      fprintf(stderr, "occupancy query says %d\n", per_cu);
      (void)hipGetLastError();
    }
    grid_blocks = cus;
  }
  if (ws_size < O_BAR + CTL_BYTES) { fprintf(stderr, "workspace too small\n"); return; }
  if (hipMemsetAsync((char*)d_ws + O_BAR, 0, CTL_BYTES, stream) != hipSuccess) { fprintf(stderr, "memset failed\n"); return; }
  P p{};
  const float** f = (const float**)&p;
  for (int i = 0; i < 32; ++i) f[i] = (const float*)d_in[i];
  p.out = (float*)d_out;
  p.ws = (char*)d_ws;
#if FUSED
  p.ph0 = 0; p.ph1 = NPHASE;
  void* args[] = {&p};
  hipError_t e = hipLaunchCooperativeKernel((void*)mega, dim3(grid_blocks), dim3(NTH), args, LDS_BYTES, stream);
  if (e != hipSuccess) fprintf(stderr, "cooperative launch failed: %s (grid %d)\n", hipGetErrorString(e), grid_blocks);
#else
  for (int ph = 0; ph < NPHASE; ++ph) {
    p.ph0 = ph; p.ph1 = ph + 1;
    hipLaunchKernelGGL(mega, dim3(grid_blocks), dim3(NTH), LDS_BYTES, stream, p);
  }
#endif
}
```

```cpp
#include <hip/hip_runtime.h>
#include <hip/hip_cooperative_groups.h>
#include <cstdio>
namespace cg = cooperative_groups;

#ifndef FUSED
#define FUSED 1
#endif

typedef unsigned short bf16_t;
using bf16x8 = __attribute__((ext_vector_type(8))) short;
using s16x4 = __attribute__((ext_vector_type(4))) short;
using f32x16 = __attribute__((ext_vector_type(16))) float;
using u32x4 = __attribute__((ext_vector_type(4))) unsigned;
using f32x4v = __attribute__((ext_vector_type(4))) float;
#define DI __device__ __forceinline__
#define MFMA32(a, b, c) __builtin_amdgcn_mfma_f32_32x32x16_bf16((a), (b), (c), 0, 0, 0)
constexpr int NTH = 512;
constexpr int LDS_BYTES = 131072 + 16;

constexpr int DM_ = 1024;
constexpr int T_ = 49296;
constexpr int TP_ = 49408;
constexpr int NT_ = TP_ / 128;
constexpr int DFF = 2816;
constexpr float EPS = 1e-6f;
constexpr float LOG2E = 1.4426950408889634f;

constexpr size_t SZ_ROW1024 = (size_t)TP_ * 1024 * 2;
constexpr size_t O_WIN0 = 0;
constexpr size_t O_WOUT0 = O_WIN0 + (size_t)1536 * 1024 * 2;
constexpr size_t O_WGU0 = O_WOUT0 + (size_t)1024 * 1024 * 2;
constexpr size_t O_WD0 = O_WGU0 + (size_t)5632 * 1024 * 2;
constexpr size_t O_DM257 = O_WD0 + (size_t)1024 * 2816 * 2;
constexpr size_t O_DM1025 = O_DM257 + (size_t)384 * 576 * 2;
constexpr size_t O_WIN1 = O_DM1025 + (size_t)1152 * 2112 * 2;
constexpr size_t O_WOUT1 = O_WIN1 + (size_t)2816 * 1024 * 2;
constexpr size_t O_WGU1 = O_WOUT1 + (size_t)1024 * 1024 * 2;
constexpr size_t O_WD1 = O_WGU1 + (size_t)5632 * 1024 * 2;
constexpr size_t O_GUP = O_WD1 + (size_t)1024 * 2816 * 2;
constexpr size_t O_RA = O_GUP + (size_t)512 * 128 * 2;
constexpr size_t O_RB = O_RA + SZ_ROW1024;
constexpr size_t O_RC = O_RB + (size_t)TP_ * 2816 * 2;
constexpr size_t O_META = O_RC + SZ_ROW1024;
constexpr size_t O_WC = O_META + (size_t)144 * 1024 * 4;
constexpr size_t O_WUPT = O_WC + (size_t)4 * 64 * 128 * 4;
constexpr size_t O_AUPT = O_WUPT + (size_t)2 * 512 * 64 * 2;
constexpr size_t O_END = O_AUPT + (size_t)2 * 512 * 64 * 2;
constexpr size_t O_HN = O_RA;
constexpr size_t O_VTA = O_RA;
constexpr size_t O_LR = O_RA;
constexpr size_t O_BONUS = O_RA + (size_t)TP_ * 384 * 2;
constexpr size_t O_VTC = O_BONUS + (size_t)T_ * 16 * 4;
constexpr size_t O_OB = O_RA + (size_t)TP_ * 512 * 2;
constexpr size_t O_PROJ0 = O_RB;
constexpr size_t O_ZB = O_PROJ0 + (size_t)TP_ * 1536 * 2;
constexpr size_t O_Y = O_ZB + (size_t)TP_ * 512 * 2;
constexpr size_t O_ACT = O_RB;
constexpr size_t O_PRKV = O_RB;
constexpr size_t O_PC = O_PRKV + (size_t)TP_ * 1536 * 2;
constexpr size_t O_PLOW = O_PC + (size_t)TP_ * 768 * 2;
constexpr size_t O_PQ = O_PC;
constexpr size_t O_G = O_PC;
constexpr size_t O_MIX = O_RC;
static_assert(O_VTC + (size_t)49728 * 128 * 2 <= O_RB, "vtc");
static_assert(O_Y + (size_t)(8 * 16 * 256 * 576 + 16 * 256 * 2112) * 2 <= O_RC, "y");
static_assert(O_PQ + (size_t)3216 * 32768 <= O_RC, "pq");
constexpr size_t O_BAR = (O_END + 255) / 256 * 256;
constexpr size_t O_CNT = O_BAR + 3456 * 4;
constexpr size_t CTL_BYTES = 3456 * 4 + 4 * 256;
static_assert(O_BAR + CTL_BYTES <= (size_t)536870912, "ws");

struct P {
  const float *x_prompt, *x_sample, *meta, *pre_mix_g, *post_mix_g, *pre_ffn_g, *post_ffn_g;
  const float *even_w_in, *even_w_out, *a_q_gain, *a_k_gain, *b_norm_g, *b_w, *b_b;
  const float *odd_w_in, *odd_w_out, *c_sink, *mu_prev, *mu_next, *d_w0, *d_w_up, *d_a0, *d_a_up, *d_g_up;
  const float *d_k_k, *d_k_a, *d_r_k, *d_ln_g, *d_ln_b, *ffn_gate, *ffn_up, *ffn_down;
  float* out;
  char* ws;
  int ph0, ph1;
};

typedef float f32x2 __attribute__((ext_vector_type(2)));
typedef __bf16 bf16x2_t __attribute__((ext_vector_type(2)));
DI bf16_t f2bf(float x) { return __builtin_bit_cast(bf16_t, (__bf16)x); }
DI float bf2f(bf16_t b) { return __uint_as_float(((unsigned)b) << 16); }
DI unsigned pack2(float a, float b) { f32x2 v = {a, b}; return __builtin_bit_cast(unsigned, __builtin_convertvector(v, bf16x2_t)); }
DI float lo2f(unsigned u) { return __uint_as_float(u << 16); }
DI float hi2f(unsigned u) { return __uint_as_float(u & 0xffff0000u); }
DI float wave_sum(float v) {
  for (int o = 32; o > 0; o >>= 1) v += __shfl_xor(v, o);
  return v;
}
DI int seq_of(int sr, int& pos) {
  if (sr < 32896) { int b = sr / 4112; pos = sr - b * 4112; return b; }
  pos = sr - 32896; return 8;
}
DI int seq_len(int b) { return b < 8 ? 4112 : 16400; }
DI int seq_base(int b) { return b < 8 ? b * 4112 : 32896; }
DI float* hrow(const P& p, int sr) {
  int pos; int b = seq_of(sr, pos);
  if (pos < 16) return (float*)(p.ws + O_META) + (size_t)(b * 16 + pos) * 1024;
  return p.out + ((size_t)(b < 8 ? b * 4096 : 32768) + (pos - 16)) * 1024;
}
DI float sigmoidf_(float x) { return 1.f / (1.f + expf(-x)); }

DI void transpose_w(const float* W, int K, int ldw, int N, bf16_t* Wt, int mode, const float* W2, int gtid, int gsz) {
  int nk8 = K / 8;
  long total = (long)N * nk8;
  for (long it = gtid; it < total; it += gsz) {
    int n = (int)(it % N), k8 = (int)(it / N);
    const float* src = W;
    int c = n;
    if (mode == 1) {
      int blk = n >> 8, w = n & 255;
      c = blk * 128 + (w & 127);
      if (w >= 128) src = W2;
    }
    unsigned r[4];
#pragma unroll
    for (int j = 0; j < 4; ++j) {
      float a = src[(size_t)(k8 * 8 + 2 * j) * ldw + c];
      float b = src[(size_t)(k8 * 8 + 2 * j + 1) * ldw + c];
      r[j] = pack2(a, b);
    }
    *(uint4*)(Wt + (size_t)n * K + k8 * 8) = make_uint4(r[0], r[1], r[2], r[3]);
  }
}

DI void phase_prep(const P& p) {
  const int gtid = blockIdx.x * NTH + threadIdx.x, gsz = gridDim.x * NTH;
  char* ws = p.ws;
  transpose_w(p.even_w_in, 1024, 1536, 1536, (bf16_t*)(ws + O_WIN0), 0, nullptr, gtid, gsz);
  transpose_w(p.even_w_out, 1024, 1024, 1024, (bf16_t*)(ws + O_WOUT0), 0, nullptr, gtid, gsz);
  transpose_w(p.odd_w_in, 1024, 2688, 2688, (bf16_t*)(ws + O_WIN1), 0, nullptr, gtid, gsz);
  transpose_w(p.odd_w_out, 1024, 1024, 1024, (bf16_t*)(ws + O_WOUT1), 0, nullptr, gtid, gsz);
  transpose_w(p.ffn_gate, 1024, DFF, 5632, (bf16_t*)(ws + O_WGU0), 1, p.ffn_up, gtid, gsz);
  transpose_w(p.ffn_gate + (size_t)1024 * DFF, 1024, DFF, 5632, (bf16_t*)(ws + O_WGU1), 1, p.ffn_up + (size_t)1024 * DFF, gtid, gsz);
  transpose_w(p.ffn_down, DFF, 1024, 1024, (bf16_t*)(ws + O_WD0), 0, nullptr, gtid, gsz);
  transpose_w(p.ffn_down + (size_t)DFF * 1024, DFF, 1024, 1024, (bf16_t*)(ws + O_WD1), 0, nullptr, gtid, gsz);
  transpose_w(p.d_g_up, 128, 512, 512, (bf16_t*)(ws + O_GUP), 0, nullptr, gtid, gsz);
  for (int d = 0; d < 2; ++d) {
    transpose_w(p.d_w_up + (size_t)d * 64 * 512, 64, 512, 512, (bf16_t*)(ws + O_WUPT) + (size_t)d * 512 * 64, 0, nullptr, gtid, gsz);
    transpose_w(p.d_a_up + (size_t)d * 64 * 512, 64, 512, 512, (bf16_t*)(ws + O_AUPT) + (size_t)d * 512 * 64, 0, nullptr, gtid, gsz);
  }
  for (int it = gtid; it < 128 * 1024 / 8; it += gsz) *(uint4*)((bf16_t*)(ws + O_WIN1) + (size_t)2688 * 1024 + (size_t)it * 8) = make_uint4(0, 0, 0, 0);
  for (int which = 0; which < 2; ++which) {
    const int M = which ? 1025 : 257, MP = which ? 1152 : 384, KP = which ? 2112 : 576;
    bf16_t* dm = (bf16_t*)(ws + (which ? O_DM1025 : O_DM257));
    for (int it = gtid; it < MP * KP; it += gsz) {
      int r = it / KP, c = it - r * KP;
      float v = 0.f;
      if (r < M && c < 2 * M) {
        int n2 = c < M ? c : c - M;
        int m = (r * n2) % M;
        float s, co;
        sincospif(2.0f * (float)m / (float)M, &s, &co);
        v = c < M ? co : s;
      }
      dm[it] = f2bf(v);
    }
  }
  for (int it = gtid; it < 4 * 64 * 128; it += gsz) {
    int o = it & 127, c = (it >> 7) & 63, g = it >> 13;
    int d = o & 63;
    float acc = 0.f;
    for (int c2 = 0; c2 < 64; ++c2) {
      float s, co;
      sincospif((float)((c * c2) & 63) / 32.f, &s, &co);
      float w = p.b_w[(g * 64 + c2) * 64 + d];
      acc += (o < 64 ? co : -s) * w;
    }
    ((float*)(ws + O_WC))[it] = acc;
  }
  const int lane = threadIdx.x & 63, gw = gtid >> 6, nw = gsz >> 6;
  bf16_t* HN = (bf16_t*)(ws + O_HN);
  for (int sr = gw; sr < TP_; sr += nw) {
    if (sr >= T_) {
#pragma unroll
      for (int q = 0; q < 2; ++q) *(uint4*)(HN + (size_t)sr * 1024 + q * 512 + lane * 8) = make_uint4(0, 0, 0, 0);
      continue;
    }
    int pos; int b = seq_of(sr, pos);
    const float* src = pos < 16 ? p.meta + pos * 1024
                                : (b < 8 ? p.x_prompt + ((size_t)b * 4096 + pos - 16) * 1024 : p.x_sample + (size_t)(pos - 16) * 1024);
    float4 v[4];
    float ss = 0.f;
#pragma unroll
    for (int q = 0; q < 4; ++q) {
      v[q] = *(const float4*)(src + q * 256 + lane * 4);
      ss += v[q].x * v[q].x + v[q].y * v[q].y + v[q].z * v[q].z + v[q].w * v[q].w;
    }
    ss = wave_sum(ss);
    float rs = rsqrtf(ss * (1.f / 1024.f) + EPS);
#pragma unroll
    for (int q = 0; q < 4; ++q) {
      float4 g = *(const float4*)(p.pre_mix_g + q * 256 + lane * 4);
      uint2 o = make_uint2(pack2(v[q].x * rs * g.x, v[q].y * rs * g.y), pack2(v[q].z * rs * g.z, v[q].w * rs * g.w));
      *(uint2*)(HN + (size_t)sr * 1024 + q * 256 + lane * 4) = o;
    }
  }
}

DI void gemm_tile(const bf16_t* __restrict__ A, int lda, const bf16_t* __restrict__ B, int ldb, int K, char* lds, f32x16 (&acc)[2][2]) {
  const int tid = threadIdx.x & 255, lane = tid & 63, wave = tid >> 6, wm = wave >> 1, wn = wave & 1;
  const int l31 = lane & 31, h = lane >> 5;
  bf16_t* As = (bf16_t*)lds;
  bf16_t* Bs = As + 128 * 72;
#pragma unroll
  for (int a = 0; a < 2; ++a)
#pragma unroll
    for (int b = 0; b < 2; ++b)
#pragma unroll
      for (int i = 0; i < 16; ++i) acc[a][b][i] = 0.f;
  const int lr = tid >> 3, lc = (tid & 7) * 8;
  const bf16_t* Ag = A + (size_t)lr * lda + lc;
  const bf16_t* Bg = B + (size_t)lr * ldb + lc;
  u32x4 ra[4], rb[4];
#pragma unroll
  for (int q = 0; q < 4; ++q) {
    ra[q] = *(const u32x4*)(Ag + (size_t)(32 * q) * lda);
    rb[q] = *(const u32x4*)(Bg + (size_t)(32 * q) * ldb);
  }
#pragma unroll
  for (int q = 0; q < 4; ++q) {
    *(u32x4*)(As + (lr + 32 * q) * 72 + lc) = ra[q];
    *(u32x4*)(Bs + (lr + 32 * q) * 72 + lc) = rb[q];
  }
  __syncthreads();
  const int nk = K >> 6;
  for (int kt = 0; kt < nk; ++kt) {
    if (kt + 1 < nk) {
#pragma unroll
      for (int q = 0; q < 4; ++q) {
        ra[q] = *(const u32x4*)(Ag + (size_t)(32 * q) * lda + (kt + 1) * 64);
        rb[q] = *(const u32x4*)(Bg + (size_t)(32 * q) * ldb + (kt + 1) * 64);
      }
    }
#pragma unroll
    for (int ks = 0; ks < 4; ++ks) {
      bf16x8 a[2], b[2];
#pragma unroll
      for (int t = 0; t < 2; ++t) {
        a[t] = *(const bf16x8*)(As + (wm * 64 + t * 32 + l31) * 72 + ks * 16 + 8 * h);
        b[t] = *(const bf16x8*)(Bs + (wn * 64 + t * 32 + l31) * 72 + ks * 16 + 8 * h);
      }
#pragma unroll
      for (int mt = 0; mt < 2; ++mt)
#pragma unroll
        for (int nt = 0; nt < 2; ++nt) acc[mt][nt] = MFMA32(a[mt], b[nt], acc[mt][nt]);
    }
    __syncthreads();
    if (kt + 1 < nk) {
#pragma unroll
      for (int q = 0; q < 4; ++q) {
        *(u32x4*)(As + (lr + 32 * q) * 72 + lc) = ra[q];
        *(u32x4*)(Bs + (lr + 32 * q) * 72 + lc) = rb[q];
      }
      __syncthreads();
    }
  }
}
#define ACC_ROW(mt, i) (wm * 64 + (mt) * 32 + ((i) & 3) + 8 * ((i) >> 2) + 4 * h)
#define ACC_COL(nt) (wn * 64 + (nt) * 32 + l31)
#define GEMM_IDS const int lane = threadIdx.x & 63, wave = (threadIdx.x & 255) >> 6, wm = wave >> 1, wn = wave & 1, l31 = lane & 31, h = lane >> 5; (void)wm; (void)wn; (void)l31; (void)h;

DI void phase_gemm_small(const bf16_t* A, int lda, const bf16_t* W, int N, int K, bf16_t* C, int ldc, char* lds) {
  GEMM_IDS
  const int sb = threadIdx.x >> 8;
  const int ntn = N / 128;
  const int total = NT_ * ntn;
  for (int t0 = blockIdx.x * 2; t0 < total; t0 += gridDim.x * 2) {
    const int t = t0 + sb;
    const int tm = t / ntn, tn = t - tm * ntn;
    f32x16 acc[2][2];
    gemm_tile(A + (size_t)tm * 128 * lda, lda, W + (size_t)tn * 128 * K, K, K, lds + sb * 36864, acc);
#pragma unroll
    for (int mt = 0; mt < 2; ++mt)
#pragma unroll
      for (int nt = 0; nt < 2; ++nt)
#pragma unroll
        for (int i = 0; i < 16; ++i) {
          int row = tm * 128 + ACC_ROW(mt, i), col = tn * 128 + ACC_COL(nt);
          C[(size_t)row * ldc + col] = f2bf(acc[mt][nt][i]);
        }
  }
}

namespace pg8 {
#define PG8_LAS __attribute__((address_space(3)))
typedef unsigned short bf16_t;
typedef short bf16x8 __attribute__((ext_vector_type(8)));
typedef float f32x4 __attribute__((ext_vector_type(4)));
typedef unsigned u32x4 __attribute__((ext_vector_type(4)));
constexpr int BM = 256, BK = 64, HALF = 128, HTB = HALF * BK * 2  , STAGE_BYTES = 8 * HTB, NXCD = 8, WGM = 8;

__host__ __device__ __forceinline__ int lds_byte(int r, int c) { const int st = (r >> 4) * 2 + (c >> 5), rr = r & 15, cc = c & 31, ob = rr * 64 + cc * 2; return st * 1024 + (ob ^ (((ob >> 9) & 1) << 5)); }
__host__ __device__ __forceinline__ void stage_rc(int b, int& R, int& C) { const int st = b / 1024, sb = b % 1024, swz = sb ^ (((sb >> 9) & 1) << 5); R = (st >> 1) * 16 + swz / 64; C = (st & 1) * 32 + (swz % 64) / 2; }
__host__ __device__ __forceinline__ int perm32(int rho) { const int n = rho >> 4, i = rho & 15; return 8 * (i >> 2) + 4 * n + (i & 3); }

struct Unit { int pm, pn; };
struct Gemm { const bf16_t* A; const bf16_t* Bt; int M, N, K; };

struct StaticOrder {
    int nM, nN, nwg, G, c;
    __host__ __device__ void init(int M, int N, int G_, int c_) { nM = M / BM; nN = N / BM; nwg = nM * nN; G = G_; c = c_; }
    __host__ __device__ bool next(int i, Unit& u) const {
        const long L = (long)i * G + c; if (L >= nwg) return false;
        int wgid = (int)L; { const int q = nwg / NXCD, r = nwg % NXCD, xcd = wgid % NXCD, off = wgid / NXCD; wgid = (xcd < r ? xcd * (q + 1) : r * (q + 1) + (xcd - r) * q) + off; }
        const int nig = WGM * nN, gid = wgid / nig, fm = gid * WGM, gsz = (nM - fm) < WGM ? (nM - fm) : WGM;
        u.pm = fm + ((wgid % nig) % gsz); u.pn = (wgid % nig) / gsz; return true;
    }
    __device__ __forceinline__ void a_ready(const Unit&) const {}
    __device__ __forceinline__ void done(const Unit&) const {}
};
__device__ __forceinline__ unsigned cvt_pk_bf16(float lo, float hi) { unsigned r; asm volatile("v_cvt_pk_bf16_f32 %0, %1, %2" : "=v"(r) : "v"(lo), "v"(hi)); return r; }

struct EpiRoute {
    static constexpr bool PERM = true, AFTER_DRAIN = false;
    bf16_t* O; int ldc; int route; bf16_t* pc; bf16_t* prkv; bf16_t* plow;
    __device__ __forceinline__ void operator()(const f32x4 (&acc)[2][2][4][2], const Unit& u, int wr, int wc, int fr, int fq) const {
        const int row0 = u.pm * BM + wr * 64 + fr;
#pragma unroll
        for (int bj = 0; bj < 2; ++bj) {
            int colh = u.pn * BM + bj * HALF; bf16_t* base = O; int ld = ldc;
            if (route) {
                if (colh < 768) { base = pc; ld = 768; }
                else if (colh < 2304) { base = prkv; ld = 1536; colh -= 768; }
                else if (colh < 2688) { base = plow; ld = 384; colh -= 2304; }
                else continue;
            }
            const int col0 = colh + wc * 32 + 8 * fq;
#pragma unroll
            for (int ai = 0; ai < 2; ++ai)
#pragma unroll
                for (int m = 0; m < 4; ++m) { bf16_t* rowp = base + (size_t)(row0 + ai * HALF + m * 16) * ld + col0;
                    const f32x4 v0 = acc[ai][bj][m][0], v1 = acc[ai][bj][m][1];
                    u32x4 w; w.x = cvt_pk_bf16(v0[0], v0[1]); w.y = cvt_pk_bf16(v0[2], v0[3]); w.z = cvt_pk_bf16(v1[0], v1[1]); w.w = cvt_pk_bf16(v1[2], v1[3]);
                    *(u32x4*)rowp = w; }
        }
    }
};
struct EpiGateUp {
    static constexpr bool PERM = true, AFTER_DRAIN = false;
    bf16_t* ACT;
    __device__ __forceinline__ void operator()(const f32x4 (&acc)[2][2][4][2], const Unit& u, int wr, int wc, int fr, int fq) const {
        const int row0 = u.pm * BM + wr * 64 + fr, col0 = u.pn * HALF + wc * 32 + 8 * fq;
#pragma unroll
        for (int ai = 0; ai < 2; ++ai)
#pragma unroll
            for (int m = 0; m < 4; ++m) { bf16_t* rowp = ACT + (size_t)(row0 + ai * HALF + m * 16) * 2816 + col0;
                float v[8];
#pragma unroll
                for (int n = 0; n < 2; ++n)
#pragma unroll
                    for (int j = 0; j < 4; ++j) { const float g = acc[ai][0][m][n][j], uu = acc[ai][1][m][n][j]; v[n * 4 + j] = g * __builtin_amdgcn_rcpf(1.f + __expf(-g)) * uu; }
                u32x4 w; w.x = cvt_pk_bf16(v[0], v[1]); w.y = cvt_pk_bf16(v[2], v[3]); w.z = cvt_pk_bf16(v[4], v[5]); w.w = cvt_pk_bf16(v[6], v[7]);
                *(u32x4*)rowp = w; }
    }
};
template <class Epi, class Sched, bool STAMP = false>
__device__ __forceinline__ void gemm_phase(PG8_LAS unsigned char* lds, const Gemm g, const Sched& S, const Epi& E, unsigned long long* stamps) {
    const int tid = threadIdx.x, wid = __builtin_amdgcn_readfirstlane(tid >> 6), lane = tid & 63, wr = wid >> 2, wc = wid & 3, fr = lane & 15, fq = lane >> 4;
    const int K = g.K, nt = K / BK;
    int ts_lo = 0, ts_hi = 0, nts = 0; const unsigned long long rt_entry = STAMP ? (unsigned long long)wall_clock64() : 0ull;
#define PG8_STAMP() do { if (STAMP && wid == 0 && nts < 64) { const unsigned long long _c = (unsigned long long)clock64(); \
        ts_lo = (lane == nts) ? (int)(unsigned)_c : ts_lo; ts_hi = (lane == nts) ? (int)(unsigned)(_c >> 32) : ts_hi; ++nts; } } while (0)
    PG8_STAMP();
    unsigned voffA[2], voffB[2];
#pragma unroll
    for (int i = 0; i < 2; ++i) { int R, C; stage_rc(tid * 16 + i * 8192, R, C); const int Rb = Epi::PERM ? ((R & ~31) + perm32(R & 31)) : R;
        voffA[i] = (unsigned)(R * K + C) * 2u; voffB[i] = (unsigned)(Rb * K + C) * 2u; }
    const size_t kstep = (size_t)(BK * 2);
    const size_t hstep = (size_t)HALF * K * 2;
    const size_t tstep = 2 * hstep;
    const unsigned ldsw = (unsigned)wid * 1024u;
    const int aoff = lds_byte(wr * 64 + fr, fq * 8), boff = lds_byte(wc * 32 + fr, fq * 8);
#define PG8_SA(b, h) (((b) * 2 + (h)) * HTB)
#define PG8_SB(b, h) ((4 + (b) * 2 + (h)) * HTB)
#define PG8_STAGE(bufoff, gbase, voff) do { _Pragma("unroll") for (int _i = 0; _i < 2; ++_i) \
        __builtin_amdgcn_global_load_lds((const unsigned*)((const char*)(gbase) + (voff)[_i]), (PG8_LAS unsigned*)(lds + (bufoff) + ldsw + _i * 8192), 16, 0, 0); } while (0)
#define PG8_LDA(dst, b, h) do { _Pragma("unroll") for (int m = 0; m < 4; ++m) _Pragma("unroll") for (int k = 0; k < 2; ++k) dst[m][k] = *(const PG8_LAS bf16x8*)(lds + PG8_SA(b, h) + aoff + m * 2048 + k * 1024); } while (0)
#define PG8_LDB(dst, b, h) do { _Pragma("unroll") for (int n = 0; n < 2; ++n) _Pragma("unroll") for (int k = 0; k < 2; ++k) dst[n][k] = *(const PG8_LAS bf16x8*)(lds + PG8_SB(b, h) + boff + n * 2048 + k * 1024); } while (0)
#define PG8_MMA(ai, bj, At, Bt) do { __builtin_amdgcn_s_setprio(1); _Pragma("unroll") for (int m = 0; m < 4; ++m) _Pragma("unroll") for (int n = 0; n < 2; ++n) _Pragma("unroll") for (int k = 0; k < 2; ++k) \
        acc[ai][bj][m][n] = __builtin_amdgcn_mfma_f32_16x16x32_bf16(Bt[n][k], At[m][k], acc[ai][bj][m][n], 0, 0, 0); __builtin_amdgcn_s_setprio(0); } while (0)
#define PG8_WAIT_V(n) asm volatile("s_waitcnt vmcnt(" #n ")" ::: "memory")
#define PG8_WAIT_L(n) asm volatile("s_waitcnt lgkmcnt(" #n ")" ::: "memory")
#define PG8_BAR __builtin_amdgcn_s_barrier()
#define PG8_SCHED __builtin_amdgcn_sched_barrier(0)
    Unit cur, nxt; int ui = 0;
    if (!S.next(0, cur)) return;
    f32x4 acc[2][2][4][2];
#pragma unroll
    for (int a = 0; a < 2; ++a)
#pragma unroll
        for (int b = 0; b < 2; ++b)
#pragma unroll
            for (int m = 0; m < 4; ++m)
#pragma unroll
                for (int n = 0; n < 2; ++n) acc[a][b][m][n] = (f32x4){0.f, 0.f, 0.f, 0.f};
    bf16x8 At[4][2], B0[2][2], B1[2][2];
    const char* cA = (const char*)g.A + (size_t)cur.pm * tstep; const char* cB = (const char*)g.Bt + (size_t)cur.pn * tstep;
    S.a_ready(cur);
    PG8_STAGE(PG8_SB(0, 0), cB, voffB); PG8_STAGE(PG8_SA(0, 0), cA, voffA); PG8_STAGE(PG8_SB(0, 1), cB + hstep, voffB); PG8_STAGE(PG8_SA(0, 1), cA + hstep, voffA);
    if (wr == 1) PG8_BAR;
    PG8_WAIT_V(4); PG8_BAR;
    PG8_STAGE(PG8_SB(1, 0), cB + kstep, voffB); PG8_STAGE(PG8_SA(1, 0), cA + kstep, voffA); PG8_STAGE(PG8_SB(1, 1), cB + hstep + kstep, voffB);
    PG8_WAIT_V(6); PG8_BAR;
    PG8_STAMP();
    for (;;) {
        const bool has_next = S.next(ui + 1, nxt);
        const char* nA = has_next ? (const char*)g.A + (size_t)nxt.pm * tstep : cA; const char* nB = has_next ? (const char*)g.Bt + (size_t)nxt.pn * tstep : cB;
        for (int t = 0; t < nt; t += 2) {
            const bool last = (t == nt - 2);
            const char* a1 = cA + (size_t)(t + 1) * kstep;
            const char* a2 = last ? nA : cA + (size_t)(t + 2) * kstep; const char* b2 = last ? nB : cB + (size_t)(t + 2) * kstep;
            const char* a3 = a2 + kstep; const char* b3 = b2 + kstep;
            if (last && has_next) S.a_ready(nxt);
            PG8_LDB(B0, 0, 0); PG8_SCHED; PG8_LDA(At, 0, 0); PG8_STAGE(PG8_SA(1, 1), a1 + hstep, voffA);
            PG8_WAIT_L(8); PG8_BAR; PG8_WAIT_L(0); PG8_MMA(0, 0, At, B0); PG8_BAR; PG8_SCHED;
            PG8_LDB(B1, 0, 1); PG8_STAGE(PG8_SB(0, 0), b2, voffB);
            PG8_BAR; PG8_WAIT_L(0); PG8_MMA(0, 1, At, B1); PG8_BAR;
            PG8_LDA(At, 0, 1); PG8_STAGE(PG8_SA(0, 0), a2, voffA);
            PG8_BAR; PG8_WAIT_L(0); PG8_MMA(1, 0, At, B0); PG8_BAR; PG8_SCHED;
            PG8_STAGE(PG8_SB(0, 1), b2 + hstep, voffB);
            PG8_WAIT_V(6); PG8_BAR; PG8_MMA(1, 1, At, B1); PG8_BAR;
            PG8_LDB(B0, 1, 0); PG8_SCHED; PG8_LDA(At, 1, 0); PG8_STAGE(PG8_SA(0, 1), a2 + hstep, voffA);
            PG8_WAIT_L(8); PG8_BAR; PG8_WAIT_L(0); PG8_MMA(0, 0, At, B0); PG8_BAR; PG8_SCHED;
            PG8_LDB(B1, 1, 1); PG8_STAGE(PG8_SB(1, 0), b3, voffB);
            PG8_BAR; PG8_WAIT_L(0); PG8_MMA(0, 1, At, B1); PG8_BAR;
            PG8_LDA(At, 1, 1); PG8_STAGE(PG8_SA(1, 0), a3, voffA);
            PG8_BAR; PG8_WAIT_L(0); PG8_MMA(1, 0, At, B0); PG8_BAR; PG8_SCHED;
            PG8_STAGE(PG8_SB(1, 1), b3 + hstep, voffB);
            PG8_WAIT_V(6); PG8_BAR; PG8_MMA(1, 1, At, B1); PG8_BAR;
        }
        PG8_STAMP();
        if constexpr (!Epi::AFTER_DRAIN) { E(acc, cur, wr, wc, fr, fq); S.done(cur); }
        PG8_STAMP();
        if (!has_next) break;
#pragma unroll
        for (int a = 0; a < 2; ++a)
#pragma unroll
            for (int b = 0; b < 2; ++b)
#pragma unroll
                for (int m = 0; m < 4; ++m)
#pragma unroll
                    for (int n = 0; n < 2; ++n) acc[a][b][m][n] = (f32x4){0.f, 0.f, 0.f, 0.f};
        cur = nxt; cA = nA; cB = nB; ++ui;
    }
    PG8_WAIT_V(0);
    if (wr == 0) PG8_BAR;
    PG8_BAR;
    if constexpr (Epi::AFTER_DRAIN) { E.fused(acc, cur, wr, wc, fr, fq, lds, wid, lane); S.done(cur); }
    PG8_STAMP();
    if (STAMP && wid == 0) { stamps[lane] = lane < nts ? (((unsigned long long)(unsigned)ts_hi << 32) | (unsigned)ts_lo) : 0ull;
        if (lane == 62) stamps[62] = rt_entry; if (lane == 63) stamps[63] = (unsigned long long)wall_clock64(); }
#undef PG8_STAMP
#undef PG8_SA
#undef PG8_SB
#undef PG8_STAGE
#undef PG8_LDA
#undef PG8_LDB
#undef PG8_MMA
#undef PG8_WAIT_V
#undef PG8_WAIT_L
#undef PG8_BAR
#undef PG8_SCHED
}
}

DI void phase_gemm_big(const bf16_t* A, const bf16_t* W, int N, int K, bf16_t* C, int ldc, int route, char* ws, unsigned char* lds) {
  pg8::Gemm g{A, W, TP_, N, K};
  pg8::StaticOrder S; S.init(TP_, N, gridDim.x, blockIdx.x);
  pg8::EpiRoute E{C, ldc, route, (bf16_t*)(ws + O_PC), (bf16_t*)(ws + O_PRKV), (bf16_t*)(ws + O_PLOW)};
  pg8::gemm_phase<pg8::EpiRoute, pg8::StaticOrder, false>((PG8_LAS unsigned char*)lds, g, S, E, nullptr);
}
DI void phase_gemm_gateup(const bf16_t* A, const bf16_t* W, bf16_t* ACT, unsigned char* lds) {
  pg8::Gemm g{A, W, TP_, 5632, 1024};
  pg8::StaticOrder S; S.init(TP_, 5632, gridDim.x, blockIdx.x);
  pg8::EpiGateUp E{ACT};
  pg8::gemm_phase<pg8::EpiGateUp, pg8::StaticOrder, false>((PG8_LAS unsigned char*)lds, g, S, E, nullptr);
}

DI void phase_resnorm(const P& p, const float* g1, const float* g2, bool first = false) {
  const int lane = threadIdx.x & 63, gw = (blockIdx.x * NTH + threadIdx.x) >> 6, nw = (gridDim.x * NTH) >> 6;
  bf16_t* HN = (bf16_t*)(p.ws + O_HN);
  for (int sr = gw; sr < T_; sr += nw) {
    float* hr = hrow(p, sr);
    const float* hsrc = hr;
    if (first) {
      int pos; const int b = seq_of(sr, pos);
      hsrc = pos < 16 ? p.meta + pos * 1024 : (b < 8 ? p.x_prompt + ((size_t)b * 4096 + pos - 16) * 1024 : p.x_sample + (size_t)(pos - 16) * 1024);
    }
    float x[16];
    float ss = 0.f;
#pragma unroll
    for (int q = 0; q < 4; ++q) {
      const uint2 u = *(const uint2*)(HN + (size_t)sr * 1024 + q * 256 + lane * 4);
      x[q * 4] = lo2f(u.x); x[q * 4 + 1] = hi2f(u.x); x[q * 4 + 2] = lo2f(u.y); x[q * 4 + 3] = hi2f(u.y);
      ss += x[q * 4] * x[q * 4] + x[q * 4 + 1] * x[q * 4 + 1] + x[q * 4 + 2] * x[q * 4 + 2] + x[q * 4 + 3] * x[q * 4 + 3];
    }
    f32x4v hh[4];
#pragma unroll
    for (int q = 0; q < 4; ++q) hh[q] = *(const f32x4v*)(hsrc + q * 256 + lane * 4);
    ss = wave_sum(ss);
    const float rs = rsqrtf(ss * (1.f / 1024.f) + EPS);
    float ss2 = 0.f;
#pragma unroll
    for (int q = 0; q < 4; ++q) {
      const float4 g = *(const float4*)(g1 + q * 256 + lane * 4);
      hh[q].x += x[q * 4 + 0] * rs * g.x; hh[q].y += x[q * 4 + 1] * rs * g.y; hh[q].z += x[q * 4 + 2] * rs * g.z; hh[q].w += x[q * 4 + 3] * rs * g.w;
      *(f32x4v*)(hr + q * 256 + lane * 4) = hh[q];
      ss2 += hh[q].x * hh[q].x + hh[q].y * hh[q].y + hh[q].z * hh[q].z + hh[q].w * hh[q].w;
    }
    if (g2) {
      ss2 = wave_sum(ss2);
      const float rs2 = rsqrtf(ss2 * (1.f / 1024.f) + EPS);
#pragma unroll
      for (int q = 0; q < 4; ++q) {
        const float4 g = *(const float4*)(g2 + q * 256 + lane * 4);
        *(uint2*)(HN + (size_t)sr * 1024 + q * 256 + lane * 4) = make_uint2(pack2(hh[q].x * rs2 * g.x, hh[q].y * rs2 * g.y), pack2(hh[q].z * rs2 * g.z, hh[q].w * rs2 * g.w));
      }
    }
  }
}

DI size_t vta_base(int seq) { return seq < 8 ? (size_t)seq * 256 * 4160 : (size_t)8 * 256 * 4160; }
template <int NC> DI void vt_transpose(const bf16_t* src, int ld, int col0, bf16_t* VT, char* lds) {
  bf16_t* tl = (bf16_t*)lds;
  const int tid = threadIdx.x;
  constexpr int CPT = NC / 8, TPR = 512 / NC, PPT = 64 / TPR;
  for (int it = blockIdx.x; it < 257 + 8 * 65; it += gridDim.x) {
    int seq, kt;
    if (it < 257) { seq = 8; kt = it; } else { const int j = it - 257; seq = j / 65; kt = j - seq * 65; }
    const int L = seq_len(seq), LP = L + 48, sbase = seq_base(seq);
    const size_t vb = (seq < 8 ? (size_t)seq * NC * 4160 : (size_t)8 * NC * 4160);
    __syncthreads();
    const int pl = tid >> 3, part = tid & 7;
    const int pos = 64 * kt + pl - 48;
#pragma unroll
    for (int q = 0; q < CPT / 8; ++q) {
      u32x4 v = (u32x4)(0u);
      if (pos >= 0) v = *(const u32x4*)(src + (size_t)(sbase + pos) * ld + col0 + part * CPT + q * 8);
#pragma unroll
      for (int j = 0; j < 4; ++j) {
        tl[(part * CPT + q * 8 + 2 * j) * 72 + pl] = (bf16_t)(v[j] & 0xffffu);
        tl[(part * CPT + q * 8 + 2 * j + 1) * 72 + pl] = (bf16_t)(v[j] >> 16);
      }
    }
    __syncthreads();
    const int row = tid / TPR, seg = tid % TPR;
    bf16_t* dst = VT + vb + (size_t)row * LP + 64 * kt + seg * PPT;
#pragma unroll
    for (int q = 0; q < PPT / 8; ++q) *(u32x4*)(dst + q * 8) = *(const u32x4*)(tl + row * 72 + seg * PPT + q * 8);
  }
}

DI void phase_prepA(const P& p, char* lds) {
  const int lane = threadIdx.x & 63, wave = threadIdx.x >> 6;
  bf16_t* PROJ = (bf16_t*)(p.ws + O_PROJ0);
  bf16_t* ZB = (bf16_t*)(p.ws + O_ZB);
  const float* WC = (const float*)(p.ws + O_WC);
  vt_transpose<256>(PROJ, 1536, 1024, (bf16_t*)(p.ws + O_VTA), lds);
  __syncthreads();
  float* fl = (float*)lds + wave * 1024;
  float* csl = (float*)lds + 8 * 1024 + wave * 64;
  const float inv = exp2f(-(float)(lane & 15) * (13.287712379549449f / 16.f));
  const int qr = lane & 3;
  float gn[16];
#pragma unroll
  for (int j = 0; j < 16; ++j) gn[j] = (lane < 48 ? p.a_q_gain : p.a_k_gain)[16 * qr + j] * (lane < 48 ? 0.125f * LOG2E : 1.f);
  for (int r0 = blockIdx.x * 32; r0 < TP_; r0 += gridDim.x * 32) {
    const int srb = r0 + wave * 4;
#pragma unroll 1
    for (int rr = 0; rr < 4; ++rr) {
      const int sr = srb + rr;
      if (sr < T_) {
        int pos; seq_of(sr, pos);
        float rowf, colf;
        if (pos < 16) { rowf = colf = (float)(pos - 16); }
        else { int t = pos - 16; rowf = (float)(t >> 6); colf = (float)(t & 63); }
        {
          float sn1, cs1;
          sincosf(((lane & 16) ? colf : rowf) * inv, &sn1, &cs1);
          if (lane < 32) { csl[lane] = cs1; csl[32 + lane] = sn1; }
        }
        bf16_t* pr = PROJ + (size_t)sr * 1536;
        {
        const u32x4 u0 = *(const u32x4*)(pr + 16 * lane), u1 = *(const u32x4*)(pr + 16 * lane + 8);
        float x[16];
        float ss = 0.f;
#pragma unroll
        for (int j = 0; j < 4; ++j) {
          x[2 * j] = lo2f(u0[j]); x[2 * j + 1] = hi2f(u0[j]); x[8 + 2 * j] = lo2f(u1[j]); x[8 + 2 * j + 1] = hi2f(u1[j]);
        }
#pragma unroll
        for (int j = 0; j < 16; ++j) ss += x[j] * x[j];
        ss += __shfl_xor(ss, 1); ss += __shfl_xor(ss, 2);
        const float rs = rsqrtf(ss * (1.f / 64.f) + EPS);
        const float* cp = csl + 16 * (qr >> 1);
        float o[16];
#pragma unroll
        for (int j4 = 0; j4 < 4; ++j4) {
          const f32x4v c4 = *(const f32x4v*)(cp + 4 * j4), s4 = *(const f32x4v*)(cp + 32 + 4 * j4);
#pragma unroll
          for (int e = 0; e < 4; ++e) {
            const int j = 4 * j4 + e;
            const float xn = x[j] * rs * gn[j];
            const float pa = __shfl_xor(xn, 1);
            o[j] = xn * c4[e] + pa * ((qr & 1) ? s4[e] : -s4[e]);
          }
        }
        *(u32x4*)(pr + 16 * lane) = (u32x4){pack2(o[0], o[1]), pack2(o[2], o[3]), pack2(o[4], o[5]), pack2(o[6], o[7])};
        *(u32x4*)(pr + 16 * lane + 8) = (u32x4){pack2(o[8], o[9]), pack2(o[10], o[11]), pack2(o[12], o[13]), pack2(o[14], o[15])};
        }
        uint2 u = *(const uint2*)(pr + 1280 + lane * 4);
        float f0 = lo2f(u.x), f1 = hi2f(u.x), f2 = lo2f(u.y), f3 = hi2f(u.y);
        float ss = f0 * f0 + f1 * f1 + f2 * f2 + f3 * f3;
        ss += __shfl_xor(ss, 1); ss += __shfl_xor(ss, 2); ss += __shfl_xor(ss, 4); ss += __shfl_xor(ss, 8);
        float rs = rsqrtf(ss * (1.f / 64.f) + EPS);
        float4 g = *(const float4*)(p.b_norm_g + lane * 4);
        *(float4*)(fl + rr * 256 + lane * 4) = make_float4(f0 * rs * g.x, f1 * rs * g.y, f2 * rs * g.z, f3 * rs * g.w);
      } else {
        *(float4*)(fl + rr * 256 + lane * 4) = make_float4(0.f, 0.f, 0.f, 0.f);
      }
    }
    __syncthreads();
    {
      const int g = lane >> 4, o0 = (lane & 15) * 8;
      float acc[4][8];
#pragma unroll
      for (int rr = 0; rr < 4; ++rr)
#pragma unroll
        for (int j = 0; j < 8; ++j) acc[rr][j] = 0.f;
      const float* wc = WC + (size_t)g * 64 * 128 + o0;
#pragma unroll 4
      for (int c = 0; c < 64; ++c) {
        const float4 w0 = *(const float4*)(wc + c * 128), w1 = *(const float4*)(wc + c * 128 + 4);
#pragma unroll
        for (int rr = 0; rr < 4; ++rr) {
          const float f = fl[rr * 256 + g * 64 + c];
          acc[rr][0] += f * w0.x; acc[rr][1] += f * w0.y; acc[rr][2] += f * w0.z; acc[rr][3] += f * w0.w;
          acc[rr][4] += f * w1.x; acc[rr][5] += f * w1.y; acc[rr][6] += f * w1.z; acc[rr][7] += f * w1.w;
        }
      }
#pragma unroll
      for (int rr = 0; rr < 4; ++rr)
        if (srb + rr < T_)
          *(uint4*)(ZB + (size_t)(srb + rr) * 512 + g * 128 + o0) = make_uint4(pack2(acc[rr][0], acc[rr][1]), pack2(acc[rr][2], acc[rr][3]), pack2(acc[rr][4], acc[rr][5]), pack2(acc[rr][6], acc[rr][7]));
    }
    __syncthreads();
  }
}

template <int MODE>
DI void flash_item(const bf16_t* __restrict__ Q, int ldq, const bf16_t* __restrict__ Kb, int ldk, const bf16_t* __restrict__ Vt, int LP,
                   bf16_t* O, int ldo, int sbase, int S, int qt, float sinkl2, char* lds) {
  const int tid = threadIdx.x & 255, lane = tid & 63, wave = tid >> 6, l31 = lane & 31, h = lane >> 5;
  bf16_t* Ks = (bf16_t*)lds;
  bf16_t* Vs = Ks + 2 * 64 * 72;
  const int rl = wave * 32 + l31;
  const int qpos = qt == 0 ? (rl < 16 ? rl : 15) : 16 + 128 * (qt - 1) + rl;
  const bool qvalid = qt > 0 || rl < 16;
  bf16x8 qf[4];
  {
    const bf16_t* qr = Q + (size_t)(sbase + qpos) * ldq;
#pragma unroll
    for (int s = 0; s < 4; ++s) qf[s] = *(const bf16x8*)(qr + 16 * s + 8 * h);
  }
  const int nkt_all = (S + 64) / 64;
  int klo = 1, n;
  if (MODE == 0) { n = nkt_all; }
  else {
    if (qt == 0) { klo = 1; n = 3; }
    else {
      int c = qt - 1;
      klo = 2 * c - 1; if (klo < 1) klo = 1;
      int khi = 2 * c + 4; if (khi > nkt_all - 1) khi = nkt_all - 1;
      n = 1 + (khi - klo + 1);
    }
  }
  const int ldr = tid >> 2, ldp = (tid & 3) * 16;
  u32x4 rk0, rk1, rv0, rv1;
  auto ktile = [&](int idx) { return idx == 0 ? 0 : klo + idx - 1; };
#define FL_GLOAD(idx)                                                                               \
  {                                                                                                 \
    int kt_ = ktile(idx);                                                                           \
    int pos_ = 64 * kt_ + ldr - 48;                                                                 \
    if (pos_ >= 0) {                                                                                \
      const bf16_t* kp_ = Kb + (size_t)(sbase + pos_) * ldk + ldp;                                  \
      rk0 = *(const u32x4*)kp_; rk1 = *(const u32x4*)(kp_ + 8);                                 \
    } else { rk0 = (u32x4)(0u); rk1 = rk0; }                                       \
    const bf16_t* vp_ = Vt + (size_t)ldr * LP + 64 * kt_ + ldp;                                     \
    rv0 = *(const u32x4*)vp_; rv1 = *(const u32x4*)(vp_ + 8);                                   \
  }
#define FL_SSTORE(buf)                                                                              \
  {                                                                                                 \
    *(u32x4*)(Ks + (buf) * 64 * 72 + ldr * 72 + ldp) = rk0; *(u32x4*)(Ks + (buf) * 64 * 72 + ldr * 72 + ldp + 8) = rk1; \
    { bf16_t* vd_ = Vs + (buf) * 64 * 68 + ldr * 68 + ldp; *(uint2*)vd_ = make_uint2(rv0.x, rv0.y); *(uint2*)(vd_ + 4) = make_uint2(rv0.z, rv0.w); *(uint2*)(vd_ + 8) = make_uint2(rv1.x, rv1.y); *(uint2*)(vd_ + 12) = make_uint2(rv1.z, rv1.w); } \
  }
  f32x16 oacc[2];
#pragma unroll
  for (int i = 0; i < 16; ++i) { oacc[0][i] = 0.f; oacc[1][i] = 0.f; }
  float m = MODE == 1 ? -1e30f : 0.f, l = 0.f;
  FL_GLOAD(0)
  FL_SSTORE(0)
  __syncthreads();
  for (int idx = 0; idx < n; ++idx) {
    const int cur = idx & 1;
    if (idx + 1 < n) FL_GLOAD(idx + 1)
    const int kt = ktile(idx);
    const bf16_t* ks = Ks + cur * 64 * 72;
    const bf16_t* vs = Vs + cur * 64 * 68;
    f32x16 sacc[2];
    {
      bf16x8 kf[2][4];
#pragma unroll
      for (int t = 0; t < 2; ++t)
#pragma unroll
        for (int s = 0; s < 4; ++s) kf[t][s] = *(const bf16x8*)(ks + (32 * t + l31) * 72 + 16 * s + 8 * h);
#pragma unroll
      for (int t = 0; t < 2; ++t)
#pragma unroll
        for (int i = 0; i < 16; ++i) sacc[t][i] = 0.f;
      __builtin_amdgcn_sched_barrier(0);
#pragma unroll
      for (int s = 0; s < 4; ++s)
#pragma unroll
        for (int t = 0; t < 2; ++t) sacc[t] = MFMA32(kf[t][s], qf[s], sacc[t]);
    }
    bf16x8 vfr[2][2][2];
#pragma unroll
    for (int t = 0; t < 2; ++t)
#pragma unroll
      for (int s2 = 0; s2 < 2; ++s2)
#pragma unroll
        for (int dt = 0; dt < 2; ++dt) {
          const bf16_t* vp = vs + (32 * dt + l31) * 68 + 32 * t + 16 * s2 + 4 * h;
          uint2 lo = *(const uint2*)vp, hi = *(const uint2*)(vp + 8);
          u32x4 v4 = {lo.x, lo.y, hi.x, hi.y};
          vfr[t][s2][dt] = __builtin_bit_cast(bf16x8, v4);
        }
    __builtin_amdgcn_sched_barrier(0);
    if (kt == 0) {
#pragma unroll
      for (int t = 0; t < 2; ++t)
#pragma unroll
        for (int i = 0; i < 16; ++i) {
          int kl = 32 * t + (i & 3) + 8 * (i >> 2) + 4 * h;
          if (kl < 48) sacc[t][i] = -1e30f;
        }
    } else if (MODE == 1) {
#pragma unroll
      for (int t = 0; t < 2; ++t)
#pragma unroll
        for (int i = 0; i < 16; ++i) {
          int kl = 32 * t + (i & 3) + 8 * (i >> 2) + 4 * h;
          int tk = 64 * (kt - 1) + kl;
          bool vis;
          if (qt == 0) vis = tk <= 112 + qpos;
          else { int tq = qpos - 16; int d = tq - tk; vis = d <= 128 && d >= -128; }
          if (!vis) sacc[t][i] = -1e30f;
        }
    }
    float tmax = -1e30f;
    if (MODE == 1) {
#pragma unroll
      for (int t = 0; t < 2; ++t)
#pragma unroll
        for (int i = 0; i < 16; ++i) tmax = fmaxf(tmax, sacc[t][i]);
      tmax = fmaxf(tmax, __shfl_xor(tmax, 32));
    }
    if (MODE == 1 && __builtin_amdgcn_ballot_w64(tmax > m) != 0ull) {
      const float mn = fmaxf(m, tmax);
      const float alpha = __builtin_amdgcn_exp2f(m - mn);
      m = mn;
      l *= alpha;
#pragma unroll
      for (int i = 0; i < 16; ++i) { oacc[0][i] *= alpha; oacc[1][i] *= alpha; }
    }
    const f32x2 m2 = {m, m};
    f32x2 ls2 = {0.f, 0.f};
    unsigned pk[2][8];
#pragma unroll
    for (int t = 0; t < 2; ++t)
#pragma unroll
      for (int i2 = 0; i2 < 8; ++i2) {
        f32x2 d = {sacc[t][2 * i2], sacc[t][2 * i2 + 1]};
        if (MODE == 1) d = d - m2;
        f32x2 e = {__builtin_amdgcn_exp2f(d.x), __builtin_amdgcn_exp2f(d.y)};
        ls2 += e;
        pk[t][i2] = __builtin_bit_cast(unsigned, __builtin_convertvector(e, bf16x2_t));
      }
    l += ls2.x + ls2.y;
#pragma unroll
    for (int t = 0; t < 2; ++t)
#pragma unroll
      for (int s2 = 0; s2 < 2; ++s2) {
        u32x4 pk4 = {pk[t][4 * s2], pk[t][4 * s2 + 1], pk[t][4 * s2 + 2], pk[t][4 * s2 + 3]};
        bf16x8 pf = __builtin_bit_cast(bf16x8, pk4);
#pragma unroll
        for (int dt = 0; dt < 2; ++dt) oacc[dt] = MFMA32(vfr[t][s2][dt], pf, oacc[dt]);
      }
    if (idx + 1 < n) FL_SSTORE(cur ^ 1)
    __syncthreads();
  }
  l += __shfl_xor(l, 32);
  if (MODE == 1) l += __builtin_amdgcn_exp2f(sinkl2 - m);
  const float il = 1.f / l;
  if (qvalid) {
    bf16_t* orow = O + (size_t)(sbase + qpos) * ldo;
#pragma unroll
    for (int dt = 0; dt < 2; ++dt)
#pragma unroll
      for (int g = 0; g < 4; ++g) {
        int d = 32 * dt + 8 * g + 4 * h;
        uint2 o = make_uint2(pack2(oacc[dt][4 * g] * il, oacc[dt][4 * g + 1] * il), pack2(oacc[dt][4 * g + 2] * il, oacc[dt][4 * g + 3] * il));
        *(uint2*)(orow + d) = o;
      }
  }
#undef FL_GLOAD
#undef FL_SSTORE
}

DI void dft4(float& r0, float& i0, float& r1, float& i1, float& r2, float& i2, float& r3, float& i3) {
  const float t0r = r0 + r2, t0i = i0 + i2, t1r = r0 - r2, t1i = i0 - i2;
  const float t2r = r1 + r3, t2i = i1 + i3, t3r = i1 - i3, t3i = r3 - r1;
  r0 = t0r + t2r; i0 = t0i + t2i; r1 = t1r + t3r; i1 = t1i + t3i; r2 = t0r - t2r; i2 = t0i - t2i; r3 = t1r - t3r; i3 = t1i - t3i;
}
DI void dft16(float (&zr)[16], float (&zi)[16]) {
#pragma unroll
  for (int b = 0; b < 4; ++b) dft4(zr[b], zi[b], zr[4 + b], zi[4 + b], zr[8 + b], zi[8 + b], zr[12 + b], zi[12 + b]);
  constexpr float C1 = 0.9238795325112867f, S1 = 0.3826834323650898f, C2 = 0.7071067811865476f;
  const float wr[10] = {1.f, C1, C2, S1, 0.f, 0.f, -C2, 0.f, 0.f, -C1};
  const float wi[10] = {0.f, -S1, -C2, -C1, -1.f, 0.f, -C2, 0.f, 0.f, S1};
#pragma unroll
  for (int q = 1; q < 4; ++q)
#pragma unroll
    for (int b = 1; b < 4; ++b) {
      const float c = wr[b * q], d = wi[b * q];
      const float xr = zr[4 * q + b], xi = zi[4 * q + b];
      zr[4 * q + b] = xr * c - xi * d; zi[4 * q + b] = xr * d + xi * c;
    }
#pragma unroll
  for (int q = 0; q < 4; ++q) dft4(zr[4 * q], zi[4 * q], zr[4 * q + 1], zi[4 * q + 1], zr[4 * q + 2], zi[4 * q + 2], zr[4 * q + 3], zi[4 * q + 3]);
}

DI size_t y_base(int seq) { return seq < 8 ? (size_t)seq * 16 * 256 * 576 : (size_t)8 * 16 * 256 * 576; }
DI void phase_attnA(const P& p, char* lds) {
  const bf16_t* PROJ = (const bf16_t*)(p.ws + O_PROJ0);
  const bf16_t* VT = (const bf16_t*)(p.ws + O_VTA);
  bf16_t* MIX = (bf16_t*)(p.ws + O_MIX);
  const int nS = 129 * 6, nP = 8 * 33 * 6;
  const int sb = threadIdx.x >> 8;
  unsigned* head = (unsigned*)(p.ws + O_CNT);
  for (;;) {
    if (threadIdx.x == 0) *(volatile int*)(lds + 2 * 36864) = (int)__hip_atomic_fetch_add(head, 1u, __ATOMIC_RELAXED, __HIP_MEMORY_SCOPE_AGENT);
    __syncthreads();
    const int it = *(volatile int*)(lds + 2 * 36864);
    __syncthreads();
    if (it >= nS + nP) break;
    int seq, qt, hq;
    if (it < nS) { seq = 8; hq = (it % 6) * 2 + sb; qt = it / 6; }
    else { int j = it - nS; hq = (j % 6) * 2 + sb; j /= 6; qt = j % 33; seq = j / 33; }
    const int kv = hq / 3;
    const int L = seq_len(seq), LP = L + 48;
    flash_item<0>(PROJ + hq * 64, 1536, PROJ + 768 + kv * 64, 1536, VT + vta_base(seq) + (size_t)kv * 64 * LP, LP,
                  MIX + hq * 64, 1024, seq_base(seq), L - 16, qt, 0.f, lds + sb * 36864);
  }
  const bf16_t* ZB = (const bf16_t*)(p.ws + O_ZB);
  bf16_t* Y = (bf16_t*)(p.ws + O_Y);
  const int lane = threadIdx.x & 63, wave = threadIdx.x >> 6;
  const int nI_S = 17 * 16, nI_P = 8 * 5 * 16;
  for (;;) {
    if (threadIdx.x == 0) *(volatile int*)(lds + 2 * 36864) = (int)__hip_atomic_fetch_add(head + 64, 1u, __ATOMIC_RELAXED, __HIP_MEMORY_SCOPE_AGENT);
    __syncthreads();
    const int it = *(volatile int*)(lds + 2 * 36864);
    __syncthreads();
    if (it >= nI_S + nI_P) break;
    int seq, nb, cb;
    if (it < nI_S) { seq = 8; cb = it & 15; nb = it >> 4; }
    else { int j = it - nI_S; cb = j & 15; j >>= 4; nb = j % 5; seq = j / 5; }
    const int M = seq < 8 ? 257 : 1025, KP = seq < 8 ? 576 : 2112, L = 16 * M;
    const int n2 = nb * 64 + lane;
    const int ch = cb * 16 + wave * 2;
    const int g = ch >> 6, d = ch & 63;
    bf16_t* yb = Y + y_base(seq);
    if (n2 < M) {
      float ar[16], ai[16], br[16], bi[16];
#pragma unroll
      for (int n1 = 0; n1 < 16; ++n1) {
        const bf16_t* zp = ZB + (size_t)(seq_base(seq) + M * n1 + n2) * 512 + g * 128 + d;
        unsigned re = *(const unsigned*)zp, im = *(const unsigned*)(zp + 64);
        ar[n1] = lo2f(re); br[n1] = hi2f(re); ai[n1] = lo2f(im); bi[n1] = hi2f(im);
      }
      dft16(ar, ai);
      dft16(br, bi);
      float t1s, t1c;
      sincospif(-2.f * (float)n2 / (float)L, &t1s, &t1c);
      float tc = 1.f, ts = 0.f;
#pragma unroll
      for (int k1 = 0; k1 < 16; ++k1) {
        const int ix = 4 * (k1 & 3) + (k1 >> 2);
        const float yr0 = ar[ix] * tc - ai[ix] * ts, yi0 = ar[ix] * ts + ai[ix] * tc;
        const float yr1 = br[ix] * tc - bi[ix] * ts, yi1 = br[ix] * ts + bi[ix] * tc;
        bf16_t* y0 = yb + ((size_t)k1 * 256 + ch) * KP;
        y0[n2] = f2bf(yr0); y0[M + n2] = f2bf(yi0);
        y0[KP + n2] = f2bf(yr1); y0[KP + M + n2] = f2bf(yi1);
        const float nc = tc * t1c - ts * t1s; ts = tc * t1s + ts * t1c; tc = nc;
      }
    } else if (n2 < KP - M) {
      for (int k1 = 0; k1 < 16; ++k1) {
        bf16_t* y0 = yb + ((size_t)k1 * 256 + ch) * KP;
        y0[M + n2] = 0; y0[KP + M + n2] = 0;
      }
    }
  }
}

DI void phase_fnet_gemm(const P& p, char* lds) {
  GEMM_IDS
  bf16_t* MIX = (bf16_t*)(p.ws + O_MIX);
  const bf16_t* Y = (const bf16_t*)(p.ws + O_Y);
  const int nS = 16 * 9 * 2, nP = 8 * 16 * 3 * 2;
  const int sb = threadIdx.x >> 8;
  for (int it0 = blockIdx.x * 2; it0 < nS + nP; it0 += gridDim.x * 2) {
    const int it = it0 + sb;
    int seq, k1, tm, tn;
    if (it < nS) { seq = 8; tn = it & 1; int j = it >> 1; tm = j % 9; k1 = j / 9; }
    else { int j = it - nS; tn = j & 1; j >>= 1; tm = j % 3; j /= 3; k1 = j & 15; seq = j >> 4; }
    const int M = seq < 8 ? 257 : 1025, KP = seq < 8 ? 576 : 2112, L = 16 * M;
    const bf16_t* dm = (const bf16_t*)(p.ws + (seq < 8 ? O_DM257 : O_DM1025));
    f32x16 acc[2][2];
    gemm_tile(dm + (size_t)tm * 128 * KP, KP, Y + y_base(seq) + ((size_t)k1 * 256 + tn * 128) * KP, KP, KP, lds + sb * 36864, acc);
    const float scale = rsqrtf(64.f * (float)L);
#pragma unroll
    for (int mt = 0; mt < 2; ++mt)
#pragma unroll
      for (int nt = 0; nt < 2; ++nt)
#pragma unroll
        for (int i = 0; i < 16; ++i) {
          int k2 = tm * 128 + ACC_ROW(mt, i), ch = tn * 128 + ACC_COL(nt);
          if (k2 < M) {
            int pos = k1 + 16 * k2;
            MIX[(size_t)(seq_base(seq) + pos) * 1024 + 768 + ch] = f2bf(acc[mt][nt][i] * scale + p.b_b[ch]);
          }
        }
  }
}

DI size_t vtc_base(int seq) { return seq < 8 ? (size_t)seq * 128 * 4160 : (size_t)8 * 128 * 4160; }
DI void phase_prepC(const P& p, char* lds) {
  const int gtid = blockIdx.x * NTH + threadIdx.x, gsz = gridDim.x * NTH;
  const int lane = threadIdx.x & 63, gw = gtid >> 6, nw = gsz >> 6;
  bf16_t* PC = (bf16_t*)(p.ws + O_PC);
  bf16_t* VT = (bf16_t*)(p.ws + O_VTC);
  const bf16_t* PLOW = (const bf16_t*)(p.ws + O_PLOW);
  bf16_t* LR = (bf16_t*)(p.ws + O_LR);
  vt_transpose<128>(PC, 768, 640, VT, lds);
  for (int sr = gw; sr < T_; sr += nw) {
    int pos; int b = seq_of(sr, pos);
    const int L = seq_len(b), LP = L + 48;
    bf16_t* pr = PC + (size_t)sr * 768;
    float cs[8], sn[8];
    {
      float s1, c1;
      sincosf((float)pos * exp2f(-(float)(lane & 7) * (18.931568569324174f / 8.f)), &s1, &c1);
#pragma unroll
      for (int j = 0; j < 8; ++j) { sn[j] = __shfl(s1, j); cs[j] = __shfl(c1, j); }
    }
#pragma unroll
    for (int part = 0; part < 2; ++part) {
      const bool act = part == 0 || lane < 16;
      const int col = part * 512 + (act ? lane : 0) * 8;
      uint4 u = *(const uint4*)(pr + col);
      float e[8] = {lo2f(u.x), hi2f(u.x), lo2f(u.y), hi2f(u.y), lo2f(u.z), hi2f(u.z), lo2f(u.w), hi2f(u.w)};
      float o[8];
#pragma unroll
      for (int j = 0; j < 8; ++j) {
        float pa = __shfl_xor(e[j], 1);
        float rot = e[j] * cs[j] + pa * ((lane & 1) ? sn[j] : -sn[j]);
        o[j] = (lane & 7) < 2 ? rot : e[j];
        if (part == 0) o[j] *= 0.125f * LOG2E;
      }
      if (act) *(uint4*)(pr + col) = make_uint4(pack2(o[0], o[1]), pack2(o[2], o[3]), pack2(o[4], o[5]), pack2(o[6], o[7]));
    }
#pragma unroll
    for (int q = 0; q < 6; ++q) {
      int c = q * 64 + lane;
      float u = bf2f(PLOW[(size_t)sr * 384 + c]);
      float up = pos > 0 ? bf2f(PLOW[(size_t)(sr - 1) * 384 + c]) : 0.f;
      float un = pos < L - 1 ? bf2f(PLOW[(size_t)(sr + 1) * 384 + c]) : 0.f;
      float us = u + p.mu_prev[1536 + c] * (up - u) + p.mu_next[1536 + c] * (un - u);
      float v = c < 128 ? tanhf(us) : (c < 256 ? us : sigmoidf_(us));
      LR[(size_t)sr * 384 + c] = f2bf(v);
    }
  }
}

DI void phase_attnC(const P& p, char* lds) {
  const bf16_t* PC = (const bf16_t*)(p.ws + O_PC);
  const bf16_t* VT = (const bf16_t*)(p.ws + O_VTC);
  bf16_t* MIX = (bf16_t*)(p.ws + O_MIX);
  const int nS = 129 * 4, nP = 8 * 33 * 4;
  const int sb = threadIdx.x >> 8;
  for (int it = blockIdx.x; it < nS + nP; it += gridDim.x) {
    int seq, qt, hq;
    if (it < nS) { seq = 8; hq = (it & 3) * 2 + sb; qt = it >> 2; }
    else { int j = it - nS; hq = (j & 3) * 2 + sb; j >>= 2; qt = j % 33; seq = j / 33; }
    const int kv = hq >> 2;
    const int L = seq_len(seq), LP = L + 48;
    flash_item<1>(PC + hq * 64, 768, PC + 512 + kv * 64, 768, VT + vtc_base(seq) + (size_t)kv * 64 * LP, LP,
                  MIX + hq * 64, 1024, seq_base(seq), L - 16, qt, p.c_sink[hq] * LOG2E, lds + sb * 36864);
  }
}

DI void chunk_decode(int cg_, int& seq, int& c) {
  if (cg_ < 136) { seq = cg_ / 17; c = cg_ - seq * 17; } else { seq = 8; c = cg_ - 136; }
}
DI float shiftv(const bf16_t* PRKV, int sr, int pos, int L, int col, float mp, float mn) {
  float u = bf2f(PRKV[(size_t)sr * 1536 + col]);
  float up = pos > 0 ? bf2f(PRKV[(size_t)(sr - 1) * 1536 + col]) : 0.f;
  float un = pos < L - 1 ? bf2f(PRKV[(size_t)(sr + 1) * 1536 + col]) : 0.f;
  return u + mp * (up - u) + mn * (un - u);
}
enum { VW = 0, VA = 1, VB = 2, VK = 3, VV = 4, VR = 5 };
#define DPP_FMAC(acc, x, y, N) asm("v_fmac_f32_dpp %0, %1, %2 row_newbcast:%3 row_mask:0xf bank_mask:0xf" : "+v"(acc) : "v"(x), "v"(y), "n"(N))
#define DPP_MUL(sv_, x, N) asm("v_mul_f32_dpp %0, %1, %0 row_newbcast:%2 row_mask:0xf bank_mask:0xf" : "+v"(sv_) : "v"(x), "n"(N))
template <int N> DI void dpp_dot4(float& a0, float& a1, float& a2, float& a3, const float (&S)[64], const float4& x) {
  DPP_FMAC(a0, x.x, S[N], N); DPP_FMAC(a1, x.y, S[16 + N], N); DPP_FMAC(a2, x.z, S[32 + N], N); DPP_FMAC(a3, x.w, S[48 + N], N);
  if constexpr (N < 15) dpp_dot4<N + 1>(a0, a1, a2, a3, S, x);
}
template <int N, bool HASV, bool OUT> DI void dpp_upd4(float (&S)[64], const float4& xb, const float4& xk, const float4& xr, float sa, float vi,
                                                       float& o0, float& o1, float& o2, float& o3) {
  DPP_FMAC(S[N], xb.x, sa, N); DPP_FMAC(S[16 + N], xb.y, sa, N); DPP_FMAC(S[32 + N], xb.z, sa, N); DPP_FMAC(S[48 + N], xb.w, sa, N);
  if (HASV) { DPP_FMAC(S[N], xk.x, vi, N); DPP_FMAC(S[16 + N], xk.y, vi, N); DPP_FMAC(S[32 + N], xk.z, vi, N); DPP_FMAC(S[48 + N], xk.w, vi, N); }
  if (OUT) { DPP_FMAC(o0, xr.x, S[N], N); DPP_FMAC(o1, xr.y, S[16 + N], N); DPP_FMAC(o2, xr.z, S[32 + N], N); DPP_FMAC(o3, xr.w, S[48 + N], N); }
  if constexpr (N < 15) dpp_upd4<N + 1, HASV, OUT>(S, xb, xk, xr, sa, vi, o0, o1, o2, o3);
}
template <int N> DI void dpp_scale4(float (&S)[64], const float4& xg) {
  DPP_MUL(S[N], xg.x, N); DPP_MUL(S[16 + N], xg.y, N); DPP_MUL(S[32 + N], xg.z, N); DPP_MUL(S[48 + N], xg.w, N);
  if constexpr (N < 15) dpp_scale4<N + 1>(S, xg);
}
template <int NST, bool HASV, bool OUT, class F>
DI void scan_steps(float (&S)[64], const float* sv, int ns, int lane, F&& emit) {
  const int l15 = lane & 15;
  (void)ns;
#pragma unroll 4
  for (int s = 0; s < NST; ++s) {
    const float4 xa = *(const float4*)(sv + VA * NST * 64 + s * 64 + l15 * 4);
    const float4 xb = *(const float4*)(sv + VB * NST * 64 + s * 64 + l15 * 4);
    float4 xk = xb, xr = xb;
    if (HASV) xk = *(const float4*)(sv + VK * NST * 64 + s * 64 + l15 * 4);
    if (OUT) xr = *(const float4*)(sv + VR * NST * 64 + s * 64 + l15 * 4);
    const float vi = HASV ? sv[VV * NST * 64 + s * 64 + lane] : 0.f;
    float sa0 = 0.f, sa1 = 0.f, sa2 = 0.f, sa3 = 0.f;
    dpp_dot4<0>(sa0, sa1, sa2, sa3, S, xa);
    const float sa = (sa0 + sa1) + (sa2 + sa3);
    float o0 = 0.f, o1 = 0.f, o2 = 0.f, o3 = 0.f;
    dpp_upd4<0, HASV, OUT>(S, xb, xk, xr, sa, vi, o0, o1, o2, o3);
    if (OUT) emit(s, (o0 + o1) + (o2 + o3));
    if ((s & 7) == 7) {
      const float4 xg = *(const float4*)(sv + VW * NST * 64 + (s >> 3) * 64 + l15 * 4);
      dpp_scale4<0>(S, xg);
    }
  }
}
DI int vperm(int j) { return (j & 15) * 4 + (j >> 4); }

DI void shift8(const bf16_t* PRKV, const P& p, int sbase, int pos, int L, int off, int c0, float (&out)[8]) {
  const bf16_t* rp = PRKV + (size_t)(sbase + pos) * 1536 + off + c0;
  const u32x4 uc = *(const u32x4*)rp;
  u32x4 up = (u32x4)(0u), un = (u32x4)(0u);
  if (pos > 0) up = *(const u32x4*)(rp - 1536);
  if (pos < L - 1) un = *(const u32x4*)(rp + 1536);
  const f32x4v mp0 = *(const f32x4v*)(p.mu_prev + off + c0), mp1 = *(const f32x4v*)(p.mu_prev + off + c0 + 4);
  const f32x4v mn0 = *(const f32x4v*)(p.mu_next + off + c0), mn1 = *(const f32x4v*)(p.mu_next + off + c0 + 4);
#pragma unroll
  for (int e2 = 0; e2 < 4; ++e2) {
    const float c_lo = lo2f(uc[e2]), c_hi = hi2f(uc[e2]);
    const float mpl = e2 < 2 ? mp0[2 * e2] : mp1[2 * e2 - 4], mph = e2 < 2 ? mp0[2 * e2 + 1] : mp1[2 * e2 - 3];
    const float mnl = e2 < 2 ? mn0[2 * e2] : mn1[2 * e2 - 4], mnh = e2 < 2 ? mn0[2 * e2 + 1] : mn1[2 * e2 - 3];
    out[2 * e2] = c_lo + mpl * (lo2f(up[e2]) - c_lo) + mnl * (lo2f(un[e2]) - c_lo);
    out[2 * e2 + 1] = c_hi + mph * (hi2f(up[e2]) - c_hi) + mnh * (hi2f(un[e2]) - c_hi);
  }
}

template <int NST, bool P3>
DI void scan_prologue8(const P& p, int sbase, int L, int hd, int dir, int pos0, int nsteps, int sb0, float* sv) {
  const int lane = threadIdx.x & 63, l31 = lane & 31, h = lane >> 5;
  const bf16_t* PRKV = (const bf16_t*)(p.ws + O_PRKV);
  const bf16_t* LR = (const bf16_t*)(p.ws + O_LR);
  const bf16_t* WUPT = (const bf16_t*)(p.ws + O_WUPT) + (size_t)(dir * 512 + hd * 64) * 64;
  const bf16_t* AUPT = (const bf16_t*)(p.ws + O_AUPT) + (size_t)(dir * 512 + hd * 64) * 64;
  float* bonus = (float*)(p.ws + O_BONUS);
  {
    int sl = sb0 + (l31 & 7); if (sl > nsteps - 1) sl = nsteps - 1;
    const int pos = dir ? pos0 - sl : pos0 + sl;
    const bf16_t* lrp = LR + (size_t)(sbase + pos) * 384 + dir * 64 + 8 * h;
#pragma unroll 1
    for (int mat = 0; mat < 2; ++mat) {
      const bf16_t* Wm = mat ? AUPT : WUPT;
      const float* bias = mat ? p.d_a0 : p.d_w0;
      f32x16 ac[2];
#pragma unroll
      for (int nt = 0; nt < 2; ++nt)
#pragma unroll
        for (int i = 0; i < 16; ++i) ac[nt][i] = 0.f;
#pragma unroll
      for (int ks = 0; ks < 4; ++ks) {
        const bf16x8 fa = *(const bf16x8*)(lrp + mat * 128 + 16 * ks);
#pragma unroll
        for (int nt = 0; nt < 2; ++nt) {
          const bf16x8 bw = *(const bf16x8*)(Wm + (size_t)(32 * nt + l31) * 64 + 16 * ks + 8 * h);
          ac[nt] = MFMA32(fa, bw, ac[nt]);
        }
      }
#pragma unroll
      for (int nt = 0; nt < 2; ++nt) {
        const int j = 32 * nt + l31;
        const float b0 = bias[dir * 512 + hd * 64 + j];
#pragma unroll
        for (int i = 0; i < 4; ++i) {
          const int st = sb0 + i + 4 * h;
          const float sg = 1.f / (1.f + __expf(-(b0 + ac[nt][i])));
          if (mat) sv[VK * NST * 64 + st * 64 + j] = sg;
          else ac[nt][i] = __expf(-0.6065306597126334f * sg);
        }
        if (!mat) {
          float g0 = ac[nt][0], g1 = g0 * ac[nt][1], g2 = g1 * ac[nt][2], g3 = g2 * ac[nt][3];
          const float tot_lo = __shfl(g3, l31);
          if (h) { g0 *= tot_lo; g1 *= tot_lo; g2 *= tot_lo; g3 *= tot_lo; }
          float* gd = sv + VA * NST * 64 + (sb0 + 4 * h) * 64 + j;
          gd[0] = g0; gd[64] = g1; gd[128] = g2; gd[192] = g3;
          if (h) sv[VW * NST * 64 + (sb0 >> 3) * 64 + vperm(j)] = g3;
        }
      }
    }
  }
  const int stp = lane >> 3, seg = lane & 7, c0 = hd * 64 + 8 * seg;
  const int s = sb0 + stp;
  const int ss = s < nsteps ? s : nsteps - 1;
  const int pos = dir ? pos0 - ss : pos0 + ss;
  float k[8], a[8], gam[8], gpr[8];
  shift8(PRKV, p, sbase, pos, L, 512, c0, k);
  {
    const f32x4v a0 = *(const f32x4v*)(sv + VK * NST * 64 + s * 64 + 8 * seg), a1 = *(const f32x4v*)(sv + VK * NST * 64 + s * 64 + 8 * seg + 4);
    const f32x4v g0 = *(const f32x4v*)(sv + VA * NST * 64 + s * 64 + 8 * seg), g1 = *(const f32x4v*)(sv + VA * NST * 64 + s * 64 + 8 * seg + 4);
    const int sp = stp > 0 ? s - 1 : s;
    const f32x4v q0 = *(const f32x4v*)(sv + VA * NST * 64 + sp * 64 + 8 * seg), q1 = *(const f32x4v*)(sv + VA * NST * 64 + sp * 64 + 8 * seg + 4);
#pragma unroll
    for (int e = 0; e < 4; ++e) {
      a[e] = a0[e]; a[4 + e] = a1[e]; gam[e] = g0[e]; gam[4 + e] = g1[e];
      gpr[e] = stp > 0 ? q0[e] : 1.f; gpr[4 + e] = stp > 0 ? q1[e] : 1.f;
    }
  }
  const f32x4v kk0 = *(const f32x4v*)(p.d_k_k + c0), kk1 = *(const f32x4v*)(p.d_k_k + c0 + 4);
  const f32x4v ka0 = *(const f32x4v*)(p.d_k_a + c0), ka1 = *(const f32x4v*)(p.d_k_a + c0 + 4);
  float kk[8], kd[8];
  float n2 = 0.f;
#pragma unroll
  for (int e = 0; e < 8; ++e) {
    kk[e] = k[e] * (e < 4 ? kk0[e] : kk1[e - 4]);
    n2 += kk[e] * kk[e];
    kd[e] = k[e] * (1.f + (a[e] - 1.f) * (e < 4 ? ka0[e] : ka1[e - 4]));
  }
  n2 += __shfl_xor(n2, 1); n2 += __shfl_xor(n2, 2); n2 += __shfl_xor(n2, 4);
  const float rn = rsqrtf(fmaxf(n2, 1e-24f));
#pragma unroll
  for (int e = 0; e < 8; ++e) {
    const int ix = s * 64 + vperm(8 * seg + e);
    const float kn = kk[e] * rn;
    const float ig = __builtin_amdgcn_rcpf(gam[e]);
    sv[VA * NST * 64 + ix] = -kn * gpr[e];
    sv[VB * NST * 64 + ix] = kn * a[e] * ig;
    sv[VK * NST * 64 + ix] = kd[e] * ig;
  }
  {
    float v[8];
    shift8(PRKV, p, sbase, pos, L, 1024, c0, v);
    *(f32x4v*)(sv + VV * NST * 64 + s * 64 + 8 * seg) = (f32x4v){v[0], v[1], v[2], v[3]};
    *(f32x4v*)(sv + VV * NST * 64 + s * 64 + 8 * seg + 4) = (f32x4v){v[4], v[5], v[6], v[7]};
  }
  if (P3) {
    float r[8];
    shift8(PRKV, p, sbase, pos, L, 0, c0, r);
    const f32x4v rk0 = *(const f32x4v*)(p.d_r_k + c0), rk1 = *(const f32x4v*)(p.d_r_k + c0 + 4);
    float bn = 0.f;
#pragma unroll
    for (int e = 0; e < 8; ++e) {
      sv[VR * NST * 64 + s * 64 + vperm(8 * seg + e)] = r[e] * gam[e];
      bn += r[e] * kd[e] * (e < 4 ? rk0[e] : rk1[e - 4]);
    }
    bn += __shfl_xor(bn, 1); bn += __shfl_xor(bn, 2); bn += __shfl_xor(bn, 4);
    if (s < nsteps && seg == 0) bonus[((size_t)(sbase + pos) * 8 + hd) * 2 + dir] = bn;
  }
}

DI unsigned scan_touch(const P& p, int sbase, int L, int hd, int dir, int posf  ) {
  const int lane = threadIdx.x & 63;
  const bf16_t* PRKV = (const bf16_t*)(p.ws + O_PRKV);
  const bf16_t* LR = (const bf16_t*)(p.ws + O_LR);
  const int lo = dir ? posf - 8 : posf - 1;
  const unsigned* ptr;
  if (lane < 30) { int row = lo + lane / 3; row = row < 0 ? 0 : (row > L - 1 ? L - 1 : row); ptr = (const unsigned*)(PRKV + (size_t)(sbase + row) * 1536 + (lane % 3) * 512 + hd * 64); }
  else { const int i2 = (lane - 30) & 15; int row = dir ? posf - (i2 >> 1) : posf + (i2 >> 1); row = row < 0 ? 0 : (row > L - 1 ? L - 1 : row); ptr = (const unsigned*)(LR + (size_t)(sbase + row) * 384 + (i2 & 1) * 128 + dir * 64); }
  return *ptr;
}

template <bool HALF> DI void scan1_body(const P& p, char* lds) {
  float* PQ = (float*)(p.ws + O_PQ);
  const int lane = threadIdx.x & 63, wave = __builtin_amdgcn_readfirstlane(threadIdx.x >> 6), slot = wave >> 1;
  constexpr int half = HALF ? 1 : 0;
  float* sv = (float*)lds + slot * (6 * 16 * 64);
  for (int g = blockIdx.x; g < 804; g += gridDim.x) {
    int seq, c, hp;
    if (g < 768) { const int lc = g >> 2; hp = g & 3; if (lc < 128) { seq = lc >> 4; c = lc & 15; } else { seq = 8; c = lc - 128; } }
    else { const int j = g - 768; hp = j & 3; seq = j >> 2; c = seq < 8 ? 16 : 64; }
    const int cgi = seq < 8 ? seq * 17 + c : 136 + c;
    const int hd = hp * 2 + (slot >> 1), dir = slot & 1;
    const int it = (cgi * 8 + hd) * 2 + dir;
    const int L = seq_len(seq), sbase = seq_base(seq);
    const int start = c * 256, end = min(L, start + 256), n = end - start;
    float S[64];
#pragma unroll
    for (int j = 0; j < 64; ++j) S[j] = (half == 0 && j == lane) ? 1.f : 0.f;
    for (int s0 = 0; s0 < n; s0 += 16) {
      const int ns = min(16, n - s0);
      const int pos0 = dir ? end - 1 - s0 : start + s0;
      __syncthreads();
      scan_prologue8<16, false>(p, sbase, L, hd, dir, pos0, ns, half * 8, sv);
      __syncthreads();
      unsigned tch = 0u;
      if (s0 + 16 < n) tch = scan_touch(p, sbase, L, hd, dir, dir ? pos0 - 16 - half * 8 : pos0 + 16 + half * 8);
      scan_steps<16, HALF, false>(S, sv, ns, lane, [](int, float) {});
      asm volatile("" :: "v"(tch));
    }
    float* dst = PQ + (size_t)it * 8192 + (size_t)(half * 64 + lane) * 64;
#pragma unroll
    for (int q = 0; q < 16; ++q) *(float4*)(dst + q * 4) = make_float4(S[q * 4], S[q * 4 + 1], S[q * 4 + 2], S[q * 4 + 3]);
  }
}

DI void phase_scan1(const P& p, char* lds) {
  const int w_ = __builtin_amdgcn_readfirstlane(threadIdx.x >> 6);
  if ((w_ ^ (w_ >> 2)) & 1) scan1_body<true>(p, lds); else scan1_body<false>(p, lds);
}

DI void phase_scan2(const P& p, char* lds) {
  float* Ss = (float*)lds;
  float* Ps = Ss + 64 * 65;
  float* PQ = (float*)(p.ws + O_PQ);
  const int tid = threadIdx.x, lane = tid & 63, wave = __builtin_amdgcn_readfirstlane(tid >> 6), l31 = lane & 31, h = lane >> 5;
  const int r0 = 32 * (wave >> 1), c0 = 32 * (wave & 1);
  for (int it = blockIdx.x; it < 144; it += gridDim.x) {
    const int dir = it & 1, hd = (it >> 1) & 7, seq = it >> 4;
    const int nch = seq < 8 ? 17 : 65, cg0 = seq < 8 ? seq * 17 : 136;
    f32x16 S;
#pragma unroll
    for (int i = 0; i < 16; ++i) S[i] = 0.f;
    f32x4v pn0, pn1;
    {
      const int c = dir ? nch - 1 : 0;
      const float* Pg = PQ + (size_t)(((cg0 + c) * 8 + hd) * 2 + dir) * 8192;
      pn0 = *(const f32x4v*)(Pg + tid * 4); pn1 = *(const f32x4v*)(Pg + (512 + tid) * 4);
    }
    for (int cc = 0; cc < nch; ++cc) {
      const int c = dir ? nch - 1 - cc : cc;
      float* Qg = PQ + (size_t)(((cg0 + c) * 8 + hd) * 2 + dir) * 8192 + 4096;
      __syncthreads();
      { const int m = tid >> 4, cq = (tid & 15) * 4; *(f32x4v*)(Ps + m * 68 + cq) = pn0; *(f32x4v*)(Ps + (m + 32) * 68 + cq) = pn1; }
      f32x16 acc;
      if (wave < 4) {
#pragma unroll
        for (int i = 0; i < 16; ++i) {
          const int row = r0 + (i & 3) + 8 * (i >> 2) + 4 * h;
          Ss[row * 65 + c0 + l31] = S[i];
          float* qp = Qg + row * 64 + c0 + l31;
          acc[i] = *qp;
          *qp = S[i];
        }
      }
      if (cc + 1 < nch) {
        const int c2 = dir ? nch - 2 - cc : cc + 1;
        const float* Pg2 = PQ + (size_t)(((cg0 + c2) * 8 + hd) * 2 + dir) * 8192;
        pn0 = *(const f32x4v*)(Pg2 + tid * 4); pn1 = *(const f32x4v*)(Pg2 + (512 + tid) * 4);
      }
      __syncthreads();
      if (wave < 4) {
#pragma unroll 8
        for (int kk = 0; kk < 32; ++kk) {
          const float av = Ss[(r0 + l31) * 65 + 2 * kk + h];
          const float bv = Ps[(2 * kk + h) * 68 + c0 + l31];
          acc = __builtin_amdgcn_mfma_f32_32x32x2f32(av, bv, acc, 0, 0, 0);
        }
        S = acc;
      }
    }
  }
}

DI void phase_scan3(const P& p, char* lds) {
  const float* PQ = (const float*)(p.ws + O_PQ);
  bf16_t* MIX = (bf16_t*)(p.ws + O_MIX);
  bf16_t* OB = (bf16_t*)(p.ws + O_OB);
  const int lane = threadIdx.x & 63, wave = __builtin_amdgcn_readfirstlane(threadIdx.x >> 6);
  float* sv = (float*)lds + wave * (6 * 8 * 64);
  const bool bal = gridDim.x == 256;
  const int NW = gridDim.x * 8, gw = blockIdx.x * 8 + wave;
  for (int k = 0; ; ++k) {
    int oi;
    if (bal) {
      if (k == 0) oi = gw;
      else if (k == 1) { if (wave >= 4) continue; oi = 2048 + blockIdx.x * 4 + wave; }
      else if (k == 2) { if (wave != 7 || blockIdx.x >= 144) break; oi = 3072 + blockIdx.x; }
      else break;
    } else { oi = gw + k * NW; if (oi >= 3216) break; }
    int seq, c, hd, dir;
    if (oi < 3072) { const int lc = oi >> 4; hd = (oi >> 1) & 7; dir = oi & 1; if (lc < 128) { seq = lc >> 4; c = lc & 15; } else { seq = 8; c = lc - 128; } }
    else { const int j = oi - 3072; hd = (j >> 1) & 7; dir = j & 1; seq = j >> 4; c = seq < 8 ? 16 : 64; }
    const int it = ((seq < 8 ? seq * 17 + c : 136 + c) * 8 + hd) * 2 + dir;
    const int L = seq_len(seq), sbase = seq_base(seq);
    const int start = c * 256, end = min(L, start + 256), n = end - start;
    float S[64];
    {
      const float* src = PQ + (size_t)it * 8192 + 4096 + lane * 64;
#pragma unroll
      for (int q = 0; q < 16; ++q) { float4 t = *(const float4*)(src + q * 4); S[q * 4] = t.x; S[q * 4 + 1] = t.y; S[q * 4 + 2] = t.z; S[q * 4 + 3] = t.w; }
    }
    for (int s0 = 0; s0 < n; s0 += 8) {
      const int ns = min(8, n - s0);
      const int pos0 = dir ? end - 1 - s0 : start + s0;
      scan_prologue8<8, true>(p, sbase, L, hd, dir, pos0, ns, 0, sv);
      unsigned tch = 0u;
      if (s0 + 8 < n) tch = scan_touch(p, sbase, L, hd, dir, dir ? pos0 - 8 : pos0 + 8);
      scan_steps<8, true, true>(S, sv, ns, lane, [&](int st, float o) {
        const int pos = dir ? pos0 - st : pos0 + st;
        const size_t sr = (size_t)(sbase + pos);
        if (dir == 0) MIX[sr * 1024 + 512 + hd * 64 + lane] = f2bf(o);
        else OB[sr * 512 + hd * 64 + lane] = f2bf(o);
      });
      asm volatile("" :: "v"(tch));
    }
  }
}

DI void phase_rwkv_final(const P& p) {
  const int lane = threadIdx.x & 63, gw = (blockIdx.x * NTH + threadIdx.x) >> 6, nw = (gridDim.x * NTH) >> 6;
  bf16_t* MIX = (bf16_t*)(p.ws + O_MIX);
  const bf16_t* OB = (const bf16_t*)(p.ws + O_OB);
  const bf16_t* G = (const bf16_t*)(p.ws + O_G);
  const bf16_t* PRKV = (const bf16_t*)(p.ws + O_PRKV);
  const float* bonus = (const float*)(p.ws + O_BONUS);
  const int hd = lane >> 3, c0 = lane * 8;
  float mp[8], mn[8], lg[8], lb[8];
#pragma unroll
  for (int j = 0; j < 8; ++j) { mp[j] = p.mu_prev[1024 + c0 + j]; mn[j] = p.mu_next[1024 + c0 + j]; lg[j] = p.d_ln_g[c0 + j]; lb[j] = p.d_ln_b[c0 + j]; }
  for (int sr = gw; sr < T_; sr += nw) {
    int pos; int b = seq_of(sr, pos);
    const int L = seq_len(b);
    const u32x4 uf = *(const u32x4*)(MIX + (size_t)sr * 1024 + 512 + c0);
    const u32x4 ub = *(const u32x4*)(OB + (size_t)sr * 512 + c0);
    const u32x4 ug = *(const u32x4*)(G + (size_t)sr * 512 + c0);
    const bf16_t* vr = PRKV + (size_t)sr * 1536 + 1024 + c0;
    const u32x4 vc = *(const u32x4*)vr;
    const u32x4 vp = *(const u32x4*)(pos > 0 ? vr - 1536 : vr);
    const u32x4 vn = *(const u32x4*)(pos < L - 1 ? vr + 1536 : vr);
    const float2 bn = *(const float2*)(bonus + ((size_t)sr * 8 + hd) * 2);
    const bool hp = pos > 0, hn = pos < L - 1;
    float o[8], gg[8], vsh[8];
    float sm = 0.f;
#pragma unroll
    for (int j = 0; j < 4; ++j) {
      o[2 * j] = lo2f(uf[j]) + lo2f(ub[j]); o[2 * j + 1] = hi2f(uf[j]) + hi2f(ub[j]);
      gg[2 * j] = lo2f(ug[j]); gg[2 * j + 1] = hi2f(ug[j]);
      sm += o[2 * j] + o[2 * j + 1];
      const float c_lo = lo2f(vc[j]), c_hi = hi2f(vc[j]);
      const float p_lo = hp ? lo2f(vp[j]) : 0.f, p_hi = hp ? hi2f(vp[j]) : 0.f;
      const float n_lo = hn ? lo2f(vn[j]) : 0.f, n_hi = hn ? hi2f(vn[j]) : 0.f;
      vsh[2 * j] = c_lo + mp[2 * j] * (p_lo - c_lo) + mn[2 * j] * (n_lo - c_lo);
      vsh[2 * j + 1] = c_hi + mp[2 * j + 1] * (p_hi - c_hi) + mn[2 * j + 1] * (n_hi - c_hi);
    }
    sm += __shfl_xor(sm, 1); sm += __shfl_xor(sm, 2); sm += __shfl_xor(sm, 4);
    const float mean = sm * (1.f / 64.f);
    float vs = 0.f;
#pragma unroll
    for (int j = 0; j < 8; ++j) { float dlt = o[j] - mean; vs += dlt * dlt; }
    vs += __shfl_xor(vs, 1); vs += __shfl_xor(vs, 2); vs += __shfl_xor(vs, 4);
    const float rstd = rsqrtf(vs * (1.f / 64.f) + 64e-5f);
    const float bsum = bn.x + bn.y;
    float y[8];
#pragma unroll
    for (int j = 0; j < 8; ++j) y[j] = ((o[j] - mean) * rstd * lg[j] + lb[j] + bsum * vsh[j]) * gg[j];
    *(uint4*)(MIX + (size_t)sr * 1024 + 512 + c0) = make_uint4(pack2(y[0], y[1]), pack2(y[2], y[3]), pack2(y[4], y[5]), pack2(y[6], y[7]));
  }
}

#define XB_TMO      128
#define XB_XCNT(j)  (256  + 64 * (j))
#define XB_XSUB(j)  (1280 + 64 * (j))
#define XB_XGEN(j)  (2304 + 64 * (j))
#define XB_TOP      3328
#define XB_TOPGEN   3392
#define XCD_BAR_WORDS 3456
#define XB_SPIN_CAP (1u << 23)
#define LAS __attribute__((address_space(3)))

__device__ __forceinline__ unsigned xb_ld(unsigned* p)              { return __hip_atomic_load(p, __ATOMIC_RELAXED, __HIP_MEMORY_SCOPE_AGENT); }
__device__ __forceinline__ unsigned xb_add(unsigned* p, unsigned v) { return __hip_atomic_fetch_add(p, v, __ATOMIC_RELAXED, __HIP_MEMORY_SCOPE_AGENT); }
__device__ __forceinline__ unsigned xb_xcc_id() { return (unsigned)__builtin_amdgcn_s_getreg((3 << 11) | 20) & 0xFu; }
#define XB_SPIN(cond, bar) do { unsigned _sp = 0; while (cond) { __builtin_amdgcn_s_sleep(1); \
    if ((++_sp & 255u) == 0u) { if (xb_ld(&(bar)[XB_TMO])) break; if (_sp > XB_SPIN_CAP) { atomicAdd(&(bar)[XB_TMO], 1u); break; } } } } while (0)

struct XcdBarrier {
    unsigned* bar; unsigned x;
    volatile LAS unsigned* st;
};

__device__ __forceinline__ XcdBarrier xcd_barrier_post(unsigned* bar, volatile LAS unsigned* st) {
    XcdBarrier b; b.bar = bar; b.x = xb_xcc_id(); b.st = st;
    if (threadIdx.x == 0) (void)xb_add(&bar[XB_XCNT(b.x)], 1u);
    return b;
}
__device__ __forceinline__ void xcd_barrier_complete(unsigned* bar, unsigned x, unsigned& nloc, unsigned& nx) {
    const unsigned G = gridDim.x * gridDim.y * gridDim.z;
    unsigned sum, cnt, mine, sp = 0u;
    for (;;) {
        sum = 0u; cnt = 0u; mine = 0u;
#pragma unroll
        for (unsigned j = 0; j < 16; ++j) { const unsigned c = xb_ld(&bar[XB_XCNT(j)]); sum += c; cnt += (c > 0u) ? 1u : 0u; mine = (j == x) ? c : mine; }
        if (sum == G) break;
        __builtin_amdgcn_s_sleep(1);
        if ((++sp & 255u) == 0u) { if (xb_ld(&bar[XB_TMO])) break; if (sp > XB_SPIN_CAP) { atomicAdd(&bar[XB_TMO], 1u); break; } }
    }
    nloc = mine > 0u ? mine : 1u; nx = cnt > 0u ? cnt : 1u;
}

__device__ __forceinline__ void xcd_barrier(const XcdBarrier& b) {
    asm volatile("s_waitcnt vmcnt(0)" ::: "memory");
    __syncthreads();
    if (threadIdx.x == 0) {
        unsigned* bar = b.bar;
        __builtin_amdgcn_s_waitcnt(0);
        unsigned nloc = b.st[0], nx = b.st[1];
        if (nloc == 0u) { xcd_barrier_complete(bar, b.x, nloc, nx); b.st[0] = nloc; b.st[1] = nx; }
        const unsigned old = xb_add(&bar[XB_XSUB(b.x)], 1u);
        const unsigned gen = old / nloc;
        if (old + 1u == (gen + 1u) * nloc) {
            __builtin_amdgcn_fence(__ATOMIC_RELEASE, "agent");
            asm volatile("s_waitcnt vmcnt(0)" ::: "memory");
            const unsigned og = xb_add(&bar[XB_TOP], 1u);
            const unsigned tg = og / nx;
            if (og + 1u == (tg + 1u) * nx) xb_add(&bar[XB_TOPGEN], 1u);
            else XB_SPIN(xb_ld(&bar[XB_TOPGEN]) == tg, bar);
            __builtin_amdgcn_fence(__ATOMIC_ACQUIRE, "agent");
            xb_add(&bar[XB_XGEN(b.x)], 1u);
            asm volatile("s_waitcnt vmcnt(0)" ::: "memory");
        } else {
            XB_SPIN(xb_ld(&bar[XB_XGEN(b.x)]) == gen, bar);
            __builtin_amdgcn_fence(__ATOMIC_ACQUIRE, "agent");
            asm volatile("s_waitcnt vmcnt(0)" ::: "memory");
        }
    }
    __syncthreads();
}

constexpr int NPHASE = 23;
__global__ void __launch_bounds__(NTH, 2) mega(P p) {
  extern __shared__ __attribute__((aligned(16))) unsigned char shm[];
  char* lds = (char*)shm;
  char* ws = p.ws;
  if (threadIdx.x == 0) *(uint4*)(shm + 131072) = make_uint4(0u, 0u, 0u, 0u);
  __syncthreads();
  const XcdBarrier xb = xcd_barrier_post((unsigned*)(ws + O_BAR), (volatile LAS unsigned*)(shm + 131072));
#ifndef DUP_MASK
#define DUP_MASK 0u
#endif
#define RUN(k, call) if (p.ph0 <= k && k < p.ph1) { call; if (k + 1 < p.ph1) { if (k == 0) cg::this_grid().sync(); else xcd_barrier(xb); } }
  RUN(0, phase_prep(p))
  RUN(1, phase_gemm_big((const bf16_t*)(ws + O_HN), (const bf16_t*)(ws + O_WIN0), 1536, 1024, (bf16_t*)(ws + O_PROJ0), 1536, 0, ws, shm))
  RUN(2, phase_prepA(p, lds))
  RUN(3, phase_attnA(p, lds))
  RUN(4, phase_fnet_gemm(p, lds))
  RUN(5, phase_gemm_big((const bf16_t*)(ws + O_MIX), (const bf16_t*)(ws + O_WOUT0), 1024, 1024, (bf16_t*)(ws + O_HN), 1024, 0, ws, shm))
  RUN(6, phase_resnorm(p, p.post_mix_g, p.pre_ffn_g, true))
  RUN(7, phase_gemm_gateup((const bf16_t*)(ws + O_HN), (const bf16_t*)(ws + O_WGU0), (bf16_t*)(ws + O_ACT), shm))
  RUN(8, phase_gemm_big((const bf16_t*)(ws + O_ACT), (const bf16_t*)(ws + O_WD0), 1024, DFF, (bf16_t*)(ws + O_HN), 1024, 0, ws, shm))
  RUN(9, phase_resnorm(p, p.post_ffn_g, p.pre_mix_g + 1024))
  RUN(10, phase_gemm_big((const bf16_t*)(ws + O_HN), (const bf16_t*)(ws + O_WIN1), 2816, 1024, nullptr, 0, 1, ws, shm))
  RUN(11, phase_prepC(p, lds))
  RUN(12, phase_attnC(p, lds))
  RUN(13, phase_scan1(p, lds))
  RUN(14, phase_scan2(p, lds))
  RUN(15, phase_scan3(p, lds))
  RUN(16, phase_gemm_small((const bf16_t*)(ws + O_LR) + 256, 384, (const bf16_t*)(ws + O_GUP), 512, 128, (bf16_t*)(ws + O_G), 512, lds))
  RUN(17, phase_rwkv_final(p))
  RUN(18, phase_gemm_big((const bf16_t*)(ws + O_MIX), (const bf16_t*)(ws + O_WOUT1), 1024, 1024, (bf16_t*)(ws + O_HN), 1024, 0, ws, shm))
  RUN(19, phase_resnorm(p, p.post_mix_g + 1024, p.pre_ffn_g + 1024))
  RUN(20, phase_gemm_gateup((const bf16_t*)(ws + O_HN), (const bf16_t*)(ws + O_WGU1), (bf16_t*)(ws + O_ACT), shm))
  RUN(21, phase_gemm_big((const bf16_t*)(ws + O_ACT), (const bf16_t*)(ws + O_WD1), 1024, DFF, (bf16_t*)(ws + O_HN), 1024, 0, ws, shm))
  RUN(22, phase_resnorm(p, p.post_ffn_g + 1024, nullptr))
#undef RUN
}

extern "C" void kernel_launch(void* const* d_in, const int* in_sizes, int n_in, void* d_out, int out_size, void* d_ws, size_t ws_size,
                              hipStream_t stream) {
  static int grid_blocks = 0;
  if (!grid_blocks) {
    int dev = 0, cus = 0, per_cu = 0;
    (void)hipGetDevice(&dev);
    (void)hipDeviceGetAttribute(&cus, hipDeviceAttributeMultiprocessorCount, dev);
    if (hipFuncSetAttribute((const void*)mega, hipFuncAttributeMaxDynamicSharedMemorySize, LDS_BYTES) != hipSuccess) fprintf(stderr, "hipFuncSetAttribute failed\n");
    if (hipOccupancyMaxActiveBlocksPerMultiprocessor(&per_cu, (const void*)mega, NTH, LDS_BYTES) != hipSuccess || per_cu < 1) {
      fprintf(stderr, "occupancy query says %d\n", per_cu);
      (void)hipGetLastError();
    }
    grid_blocks = cus;
  }
  if (ws_size < O_BAR + CTL_BYTES) { fprintf(stderr, "workspace too small\n"); return; }
  if (hipMemsetAsync((char*)d_ws + O_BAR, 0, CTL_BYTES, stream) != hipSuccess) { fprintf(stderr, "memset failed\n"); return; }
  P p{};
  const float** f = (const float**)&p;
  for (int i = 0; i < 32; ++i) f[i] = (const float*)d_in[i];
  p.out = (float*)d_out;
  p.ws = (char*)d_ws;
#if FUSED
  p.ph0 = 0; p.ph1 = NPHASE;
  void* args[] = {&p};
  hipError_t e = hipLaunchCooperativeKernel((void*)mega, dim3(grid_blocks), dim3(NTH), args, LDS_BYTES, stream);
  if (e != hipSuccess) fprintf(stderr, "cooperative launch failed: %s (grid %d)\n", hipGetErrorString(e), grid_blocks);
#else
  for (int ph = 0; ph < NPHASE; ++ph) {
    p.ph0 = ph; p.ph1 = ph + 1;
    hipLaunchKernelGGL(mega, dim3(grid_blocks), dim3(NTH), LDS_BYTES, stream, p);
  }
#endif
}
```

```cpp
#include <hip/hip_runtime.h>
#include <hip/hip_cooperative_groups.h>
#include <cstdio>
namespace cg = cooperative_groups;

#ifndef FUSED
#define FUSED 1
#endif

typedef unsigned short bf16_t;
using bf16x8 = __attribute__((ext_vector_type(8))) short;
using s16x4 = __attribute__((ext_vector_type(4))) short;
using f32x16 = __attribute__((ext_vector_type(16))) float;
using u32x4 = __attribute__((ext_vector_type(4))) unsigned;
using f32x4v = __attribute__((ext_vector_type(4))) float;
#define DI __device__ __forceinline__
#define MFMA32(a, b, c) __builtin_amdgcn_mfma_f32_32x32x16_bf16((a), (b), (c), 0, 0, 0)
constexpr int NTH = 512;
constexpr int LDS_BYTES = 131072 + 16;

constexpr int DM_ = 1024;
constexpr int T_ = 49296;
constexpr int TP_ = 49408;
constexpr int NT_ = TP_ / 128;
constexpr int DFF = 2816;
constexpr float EPS = 1e-6f;
constexpr float LOG2E = 1.4426950408889634f;

constexpr size_t SZ_ROW1024 = (size_t)TP_ * 1024 * 2;
constexpr size_t O_WIN0 = 0;
constexpr size_t O_WOUT0 = O_WIN0 + (size_t)1536 * 1024 * 2;
constexpr size_t O_WGU0 = O_WOUT0 + (size_t)1024 * 1024 * 2;
constexpr size_t O_WD0 = O_WGU0 + (size_t)5632 * 1024 * 2;
constexpr size_t O_DM257 = O_WD0 + (size_t)1024 * 2816 * 2;
constexpr size_t O_DM1025 = O_DM257 + (size_t)384 * 576 * 2;
constexpr size_t O_WIN1 = O_DM1025 + (size_t)1152 * 2112 * 2;
constexpr size_t O_WOUT1 = O_WIN1 + (size_t)2816 * 1024 * 2;
constexpr size_t O_WGU1 = O_WOUT1 + (size_t)1024 * 1024 * 2;
constexpr size_t O_WD1 = O_WGU1 + (size_t)5632 * 1024 * 2;
constexpr size_t O_GUP = O_WD1 + (size_t)1024 * 2816 * 2;
constexpr size_t O_RA = O_GUP + (size_t)512 * 128 * 2;
constexpr size_t O_RB = O_RA + SZ_ROW1024;
constexpr size_t O_RC = O_RB + (size_t)TP_ * 2816 * 2;
constexpr size_t O_META = O_RC + SZ_ROW1024;
constexpr size_t O_WC = O_META + (size_t)144 * 1024 * 4;
constexpr size_t O_WUPT = O_WC + (size_t)4 * 64 * 128 * 4;
constexpr size_t O_AUPT = O_WUPT + (size_t)2 * 512 * 64 * 2;
constexpr size_t O_END = O_AUPT + (size_t)2 * 512 * 64 * 2;
constexpr size_t O_HN = O_RA;
constexpr size_t O_VTA = O_RA;
constexpr size_t O_LR = O_RA;
constexpr size_t O_BONUS = O_RA + (size_t)TP_ * 384 * 2;
constexpr size_t O_VTC = O_BONUS + (size_t)T_ * 16 * 4;
constexpr size_t O_OB = O_RA + (size_t)TP_ * 512 * 2;
constexpr size_t O_PROJ0 = O_RB;
constexpr size_t O_ZB = O_PROJ0 + (size_t)TP_ * 1536 * 2;
constexpr size_t O_Y = O_ZB + (size_t)TP_ * 512 * 2;
constexpr size_t O_ACT = O_RB;
constexpr size_t O_PRKV = O_RB;
constexpr size_t O_PC = O_PRKV + (size_t)TP_ * 1536 * 2;
constexpr size_t O_PLOW = O_PC + (size_t)TP_ * 768 * 2;
constexpr size_t O_PQ = O_PC;
constexpr size_t O_G = O_PC;
constexpr size_t O_MIX = O_RC;
static_assert(O_VTC + (size_t)49728 * 128 * 2 <= O_RB, "vtc");
static_assert(O_Y + (size_t)(8 * 16 * 256 * 576 + 16 * 256 * 2112) * 2 <= O_RC, "y");
static_assert(O_PQ + (size_t)3216 * 32768 <= O_RC, "pq");
constexpr size_t O_BAR = (O_END + 255) / 256 * 256;
constexpr size_t O_CNT = O_BAR + 3456 * 4;
constexpr size_t CTL_BYTES = 3456 * 4 + 4 * 256;
static_assert(O_BAR + CTL_BYTES <= (size_t)536870912, "ws");

struct P {
  const float *x_prompt, *x_sample, *meta, *pre_mix_g, *post_mix_g, *pre_ffn_g, *post_ffn_g;
  const float *even_w_in, *even_w_out, *a_q_gain, *a_k_gain, *b_norm_g, *b_w, *b_b;
  const float *odd_w_in, *odd_w_out, *c_sink, *mu_prev, *mu_next, *d_w0, *d_w_up, *d_a0, *d_a_up, *d_g_up;
  const float *d_k_k, *d_k_a, *d_r_k, *d_ln_g, *d_ln_b, *ffn_gate, *ffn_up, *ffn_down;
  float* out;
  char* ws;
  int ph0, ph1;
};

typedef float f32x2 __attribute__((ext_vector_type(2)));
typedef __bf16 bf16x2_t __attribute__((ext_vector_type(2)));
DI bf16_t f2bf(float x) { return __builtin_bit_cast(bf16_t, (__bf16)x); }
DI float bf2f(bf16_t b) { return __uint_as_float(((unsigned)b) << 16); }
DI unsigned pack2(float a, float b) { f32x2 v = {a, b}; return __builtin_bit_cast(unsigned, __builtin_convertvector(v, bf16x2_t)); }
DI float lo2f(unsigned u) { return __uint_as_float(u << 16); }
DI float hi2f(unsigned u) { return __uint_as_float(u & 0xffff0000u); }
DI float wave_sum(float v) {
  for (int o = 32; o > 0; o >>= 1) v += __shfl_xor(v, o);
  return v;
}
DI int seq_of(int sr, int& pos) {
  if (sr < 32896) { int b = sr / 4112; pos = sr - b * 4112; return b; }
  pos = sr - 32896; return 8;
}
DI int seq_len(int b) { return b < 8 ? 4112 : 16400; }
DI int seq_base(int b) { return b < 8 ? b * 4112 : 32896; }
DI float* hrow(const P& p, int sr) {
  int pos; int b = seq_of(sr, pos);
  if (pos < 16) return (float*)(p.ws + O_META) + (size_t)(b * 16 + pos) * 1024;
  return p.out + ((size_t)(b < 8 ? b * 4096 : 32768) + (pos - 16)) * 1024;
}
DI float sigmoidf_(float x) { return 1.f / (1.f + expf(-x)); }

DI void transpose_w(const float* W, int K, int ldw, int N, bf16_t* Wt, int mode, const float* W2, int gtid, int gsz) {
  int nk8 = K / 8;
  long total = (long)N * nk8;
  for (long it = gtid; it < total; it += gsz) {
    int n = (int)(it % N), k8 = (int)(it / N);
    const float* src = W;
    int c = n;
    if (mode == 1) {
      int blk = n >> 8, w = n & 255;
      c = blk * 128 + (w & 127);
      if (w >= 128) src = W2;
    }
    unsigned r[4];
#pragma unroll
    for (int j = 0; j < 4; ++j) {
      float a = src[(size_t)(k8 * 8 + 2 * j) * ldw + c];
      float b = src[(size_t)(k8 * 8 + 2 * j + 1) * ldw + c];
      r[j] = pack2(a, b);
    }
    *(uint4*)(Wt + (size_t)n * K + k8 * 8) = make_uint4(r[0], r[1], r[2], r[3]);
  }
}

DI void late_weights(const P& p) {
  char* ws = p.ws;
  int gtid, gsz;
  if (gridDim.x > 144 + 16) { if (blockIdx.x < 144) return; gtid = (blockIdx.x - 144) * NTH + threadIdx.x; gsz = (gridDim.x - 144) * NTH; }
  else { gtid = blockIdx.x * NTH + threadIdx.x; gsz = gridDim.x * NTH; }
  transpose_w(p.odd_w_out, 1024, 1024, 1024, (bf16_t*)(ws + O_WOUT1), 0, nullptr, gtid, gsz);
  transpose_w(p.ffn_gate + (size_t)1024 * DFF, 1024, DFF, 5632, (bf16_t*)(ws + O_WGU1), 1, p.ffn_up + (size_t)1024 * DFF, gtid, gsz);
  transpose_w(p.ffn_down + (size_t)DFF * 1024, DFF, 1024, 1024, (bf16_t*)(ws + O_WD1), 0, nullptr, gtid, gsz);
}

DI void phase_prep(const P& p) {
  const int gtid = blockIdx.x * NTH + threadIdx.x, gsz = gridDim.x * NTH;
  char* ws = p.ws;
  transpose_w(p.even_w_in, 1024, 1536, 1536, (bf16_t*)(ws + O_WIN0), 0, nullptr, gtid, gsz);
  transpose_w(p.even_w_out, 1024, 1024, 1024, (bf16_t*)(ws + O_WOUT0), 0, nullptr, gtid, gsz);
  transpose_w(p.odd_w_in, 1024, 2688, 2688, (bf16_t*)(ws + O_WIN1), 0, nullptr, gtid, gsz);
  transpose_w(p.ffn_gate, 1024, DFF, 5632, (bf16_t*)(ws + O_WGU0), 1, p.ffn_up, gtid, gsz);
  transpose_w(p.ffn_down, DFF, 1024, 1024, (bf16_t*)(ws + O_WD0), 0, nullptr, gtid, gsz);
  transpose_w(p.d_g_up, 128, 512, 512, (bf16_t*)(ws + O_GUP), 0, nullptr, gtid, gsz);
  for (int d = 0; d < 2; ++d) {
    transpose_w(p.d_w_up + (size_t)d * 64 * 512, 64, 512, 512, (bf16_t*)(ws + O_WUPT) + (size_t)d * 512 * 64, 0, nullptr, gtid, gsz);
    transpose_w(p.d_a_up + (size_t)d * 64 * 512, 64, 512, 512, (bf16_t*)(ws + O_AUPT) + (size_t)d * 512 * 64, 0, nullptr, gtid, gsz);
  }
  for (int it = gtid; it < 128 * 1024 / 8; it += gsz) *(uint4*)((bf16_t*)(ws + O_WIN1) + (size_t)2688 * 1024 + (size_t)it * 8) = make_uint4(0, 0, 0, 0);
  for (int which = 0; which < 2; ++which) {
    const int M = which ? 1025 : 257, MP = which ? 1152 : 384, KP = which ? 2112 : 576;
    bf16_t* dm = (bf16_t*)(ws + (which ? O_DM1025 : O_DM257));
    for (int it = gtid; it < MP * KP; it += gsz) {
      int r = it / KP, c = it - r * KP;
      float v = 0.f;
      if (r < M && c < 2 * M) {
        int n2 = c < M ? c : c - M;
        int m = (r * n2) % M;
        float s, co;
        sincospif(2.0f * (float)m / (float)M, &s, &co);
        v = c < M ? co : s;
      }
      dm[it] = f2bf(v);
    }
  }
  for (int it = gtid; it < 4 * 64 * 128; it += gsz) {
    int o = it & 127, c = (it >> 7) & 63, g = it >> 13;
    int d = o & 63;
    float acc = 0.f;
    for (int c2 = 0; c2 < 64; ++c2) {
      float s, co;
      sincospif((float)((c * c2) & 63) / 32.f, &s, &co);
      float w = p.b_w[(g * 64 + c2) * 64 + d];
      acc += (o < 64 ? co : -s) * w;
    }
    ((float*)(ws + O_WC))[it] = acc;
  }
  const int lane = threadIdx.x & 63, gw = gtid >> 6, nw = gsz >> 6;
  bf16_t* HN = (bf16_t*)(ws + O_HN);
  for (int sr = gw; sr < TP_; sr += nw) {
    if (sr >= T_) {
#pragma unroll
      for (int q = 0; q < 2; ++q) *(uint4*)(HN + (size_t)sr * 1024 + q * 512 + lane * 8) = make_uint4(0, 0, 0, 0);
      continue;
    }
    int pos; int b = seq_of(sr, pos);
    const float* src = pos < 16 ? p.meta + pos * 1024
                                : (b < 8 ? p.x_prompt + ((size_t)b * 4096 + pos - 16) * 1024 : p.x_sample + (size_t)(pos - 16) * 1024);
    float4 v[4];
    float ss = 0.f;
#pragma unroll
    for (int q = 0; q < 4; ++q) {
      v[q] = *(const float4*)(src + q * 256 + lane * 4);
      ss += v[q].x * v[q].x + v[q].y * v[q].y + v[q].z * v[q].z + v[q].w * v[q].w;
    }
    ss = wave_sum(ss);
    float rs = rsqrtf(ss * (1.f / 1024.f) + EPS);
#pragma unroll
    for (int q = 0; q < 4; ++q) {
      float4 g = *(const float4*)(p.pre_mix_g + q * 256 + lane * 4);
      uint2 o = make_uint2(pack2(v[q].x * rs * g.x, v[q].y * rs * g.y), pack2(v[q].z * rs * g.z, v[q].w * rs * g.w));
      *(uint2*)(HN + (size_t)sr * 1024 + q * 256 + lane * 4) = o;
    }
  }
}

DI void gemm_tile(const bf16_t* __restrict__ A, int lda, const bf16_t* __restrict__ B, int ldb, int K, char* lds, f32x16 (&acc)[2][2]) {
  const int tid = threadIdx.x & 255, lane = tid & 63, wave = tid >> 6, wm = wave >> 1, wn = wave & 1;
  const int l31 = lane & 31, h = lane >> 5;
  bf16_t* As = (bf16_t*)lds;
  bf16_t* Bs = As + 128 * 72;
#pragma unroll
  for (int a = 0; a < 2; ++a)
#pragma unroll
    for (int b = 0; b < 2; ++b)
#pragma unroll
      for (int i = 0; i < 16; ++i) acc[a][b][i] = 0.f;
  const int lr = tid >> 3, lc = (tid & 7) * 8;
  const bf16_t* Ag = A + (size_t)lr * lda + lc;
  const bf16_t* Bg = B + (size_t)lr * ldb + lc;
  u32x4 ra[4], rb[4];
#pragma unroll
  for (int q = 0; q < 4; ++q) {
    ra[q] = *(const u32x4*)(Ag + (size_t)(32 * q) * lda);
    rb[q] = *(const u32x4*)(Bg + (size_t)(32 * q) * ldb);
  }
#pragma unroll
  for (int q = 0; q < 4; ++q) {
    *(u32x4*)(As + (lr + 32 * q) * 72 + lc) = ra[q];
    *(u32x4*)(Bs + (lr + 32 * q) * 72 + lc) = rb[q];
  }
  __syncthreads();
  const int nk = K >> 6;
  for (int kt = 0; kt < nk; ++kt) {
    if (kt + 1 < nk) {
#pragma unroll
      for (int q = 0; q < 4; ++q) {
        ra[q] = *(const u32x4*)(Ag + (size_t)(32 * q) * lda + (kt + 1) * 64);
        rb[q] = *(const u32x4*)(Bg + (size_t)(32 * q) * ldb + (kt + 1) * 64);
      }
    }
#pragma unroll
    for (int ks = 0; ks < 4; ++ks) {
      bf16x8 a[2], b[2];
#pragma unroll
      for (int t = 0; t < 2; ++t) {
        a[t] = *(const bf16x8*)(As + (wm * 64 + t * 32 + l31) * 72 + ks * 16 + 8 * h);
        b[t] = *(const bf16x8*)(Bs + (wn * 64 + t * 32 + l31) * 72 + ks * 16 + 8 * h);
      }
#pragma unroll
      for (int mt = 0; mt < 2; ++mt)
#pragma unroll
        for (int nt = 0; nt < 2; ++nt) acc[mt][nt] = MFMA32(a[mt], b[nt], acc[mt][nt]);
    }
    __syncthreads();
    if (kt + 1 < nk) {
#pragma unroll
      for (int q = 0; q < 4; ++q) {
        *(u32x4*)(As + (lr + 32 * q) * 72 + lc) = ra[q];
        *(u32x4*)(Bs + (lr + 32 * q) * 72 + lc) = rb[q];
      }
      __syncthreads();
    }
  }
}
#define ACC_ROW(mt, i) (wm * 64 + (mt) * 32 + ((i) & 3) + 8 * ((i) >> 2) + 4 * h)
#define ACC_COL(nt) (wn * 64 + (nt) * 32 + l31)
#define GEMM_IDS const int lane = threadIdx.x & 63, wave = (threadIdx.x & 255) >> 6, wm = wave >> 1, wn = wave & 1, l31 = lane & 31, h = lane >> 5; (void)wm; (void)wn; (void)l31; (void)h;

DI void phase_gemm_small(const bf16_t* A, int lda, const bf16_t* W, int N, int K, bf16_t* C, int ldc, char* lds) {
  GEMM_IDS
  const int sb = threadIdx.x >> 8;
  const int ntn = N / 128;
  const int total = NT_ * ntn;
  for (int t0 = blockIdx.x * 2; t0 < total; t0 += gridDim.x * 2) {
    const int t = t0 + sb;
    const int tm = t / ntn, tn = t - tm * ntn;
    f32x16 acc[2][2];
    gemm_tile(A + (size_t)tm * 128 * lda, lda, W + (size_t)tn * 128 * K, K, K, lds + sb * 36864, acc);
#pragma unroll
    for (int mt = 0; mt < 2; ++mt)
#pragma unroll
      for (int nt = 0; nt < 2; ++nt)
#pragma unroll
        for (int i = 0; i < 16; ++i) {
          int row = tm * 128 + ACC_ROW(mt, i), col = tn * 128 + ACC_COL(nt);
          C[(size_t)row * ldc + col] = f2bf(acc[mt][nt][i]);
        }
  }
}

namespace pg8 {
#define PG8_LAS __attribute__((address_space(3)))
typedef unsigned short bf16_t;
typedef short bf16x8 __attribute__((ext_vector_type(8)));
typedef float f32x4 __attribute__((ext_vector_type(4)));
typedef unsigned u32x4 __attribute__((ext_vector_type(4)));
constexpr int BM = 256, BK = 64, HALF = 128, HTB = HALF * BK * 2  , STAGE_BYTES = 8 * HTB, NXCD = 8, WGM = 8;

__host__ __device__ __forceinline__ int lds_byte(int r, int c) { const int st = (r >> 4) * 2 + (c >> 5), rr = r & 15, cc = c & 31, ob = rr * 64 + cc * 2; return st * 1024 + (ob ^ (((ob >> 9) & 1) << 5)); }
__host__ __device__ __forceinline__ void stage_rc(int b, int& R, int& C) { const int st = b / 1024, sb = b % 1024, swz = sb ^ (((sb >> 9) & 1) << 5); R = (st >> 1) * 16 + swz / 64; C = (st & 1) * 32 + (swz % 64) / 2; }
__host__ __device__ __forceinline__ int perm32(int rho) { const int n = rho >> 4, i = rho & 15; return 8 * (i >> 2) + 4 * n + (i & 3); }

struct Unit { int pm, pn; };
struct Gemm { const bf16_t* A; const bf16_t* Bt; int M, N, K; };

struct StaticOrder {
    int nM, nN, nwg, G, c;
    __host__ __device__ void init(int M, int N, int G_, int c_) { nM = M / BM; nN = N / BM; nwg = nM * nN; G = G_; c = c_; }
    __host__ __device__ bool next(int i, Unit& u) const {
        const long L = (long)i * G + c; if (L >= nwg) return false;
        int wgid = (int)L; { const int q = nwg / NXCD, r = nwg % NXCD, xcd = wgid % NXCD, off = wgid / NXCD; wgid = (xcd < r ? xcd * (q + 1) : r * (q + 1) + (xcd - r) * q) + off; }
        const int nig = WGM * nN, gid = wgid / nig, fm = gid * WGM, gsz = (nM - fm) < WGM ? (nM - fm) : WGM;
        u.pm = fm + ((wgid % nig) % gsz); u.pn = (wgid % nig) / gsz; return true;
    }
    __device__ __forceinline__ void a_ready(const Unit&) const {}
    __device__ __forceinline__ void done(const Unit&) const {}
};
__device__ __forceinline__ unsigned cvt_pk_bf16(float lo, float hi) { unsigned r; asm volatile("v_cvt_pk_bf16_f32 %0, %1, %2" : "=v"(r) : "v"(lo), "v"(hi)); return r; }

struct EpiRoute {
    static constexpr bool PERM = true, AFTER_DRAIN = false;
    bf16_t* O; int ldc; int route; bf16_t* pc; bf16_t* prkv; bf16_t* plow;
    __device__ __forceinline__ void operator()(const f32x4 (&acc)[2][2][4][2], const Unit& u, int wr, int wc, int fr, int fq) const {
        const int row0 = u.pm * BM + wr * 64 + fr;
#pragma unroll
        for (int bj = 0; bj < 2; ++bj) {
            int colh = u.pn * BM + bj * HALF; bf16_t* base = O; int ld = ldc;
            if (route) {
                if (colh < 768) { base = pc; ld = 768; }
                else if (colh < 2304) { base = prkv; ld = 1536; colh -= 768; }
                else if (colh < 2688) { base = plow; ld = 384; colh -= 2304; }
                else continue;
            }
            const int col0 = colh + wc * 32 + 8 * fq;
#pragma unroll
            for (int ai = 0; ai < 2; ++ai)
#pragma unroll
                for (int m = 0; m < 4; ++m) { bf16_t* rowp = base + (size_t)(row0 + ai * HALF + m * 16) * ld + col0;
                    const f32x4 v0 = acc[ai][bj][m][0], v1 = acc[ai][bj][m][1];
                    u32x4 w; w.x = cvt_pk_bf16(v0[0], v0[1]); w.y = cvt_pk_bf16(v0[2], v0[3]); w.z = cvt_pk_bf16(v1[0], v1[1]); w.w = cvt_pk_bf16(v1[2], v1[3]);
                    *(u32x4*)rowp = w; }
        }
    }
};
struct EpiGateUp {
    static constexpr bool PERM = true, AFTER_DRAIN = false;
    bf16_t* ACT;
    __device__ __forceinline__ void operator()(const f32x4 (&acc)[2][2][4][2], const Unit& u, int wr, int wc, int fr, int fq) const {
        const int row0 = u.pm * BM + wr * 64 + fr, col0 = u.pn * HALF + wc * 32 + 8 * fq;
#pragma unroll
        for (int ai = 0; ai < 2; ++ai)
#pragma unroll
            for (int m = 0; m < 4; ++m) { bf16_t* rowp = ACT + (size_t)(row0 + ai * HALF + m * 16) * 2816 + col0;
                float v[8];
#pragma unroll
                for (int n = 0; n < 2; ++n)
#pragma unroll
                    for (int j = 0; j < 4; ++j) { const float g = acc[ai][0][m][n][j], uu = acc[ai][1][m][n][j]; v[n * 4 + j] = g * __builtin_amdgcn_rcpf(1.f + __expf(-g)) * uu; }
                u32x4 w; w.x = cvt_pk_bf16(v[0], v[1]); w.y = cvt_pk_bf16(v[2], v[3]); w.z = cvt_pk_bf16(v[4], v[5]); w.w = cvt_pk_bf16(v[6], v[7]);
                *(u32x4*)rowp = w; }
    }
};
template <class Epi, class Sched, bool STAMP = false>
__device__ __forceinline__ void gemm_phase(PG8_LAS unsigned char* lds, const Gemm g, const Sched& S, const Epi& E, unsigned long long* stamps) {
    const int tid = threadIdx.x, wid = __builtin_amdgcn_readfirstlane(tid >> 6), lane = tid & 63, wr = wid >> 2, wc = wid & 3, fr = lane & 15, fq = lane >> 4;
    const int K = g.K, nt = K / BK;
    int ts_lo = 0, ts_hi = 0, nts = 0; const unsigned long long rt_entry = STAMP ? (unsigned long long)wall_clock64() : 0ull;
#define PG8_STAMP() do { if (STAMP && wid == 0 && nts < 64) { const unsigned long long _c = (unsigned long long)clock64(); \
        ts_lo = (lane == nts) ? (int)(unsigned)_c : ts_lo; ts_hi = (lane == nts) ? (int)(unsigned)(_c >> 32) : ts_hi; ++nts; } } while (0)
    PG8_STAMP();
    unsigned voffA[2], voffB[2];
#pragma unroll
    for (int i = 0; i < 2; ++i) { int R, C; stage_rc(tid * 16 + i * 8192, R, C); const int Rb = Epi::PERM ? ((R & ~31) + perm32(R & 31)) : R;
        voffA[i] = (unsigned)(R * K + C) * 2u; voffB[i] = (unsigned)(Rb * K + C) * 2u; }
    const size_t kstep = (size_t)(BK * 2);
    const size_t hstep = (size_t)HALF * K * 2;
    const size_t tstep = 2 * hstep;
    const unsigned ldsw = (unsigned)wid * 1024u;
    const int aoff = lds_byte(wr * 64 + fr, fq * 8), boff = lds_byte(wc * 32 + fr, fq * 8);
#define PG8_SA(b, h) (((b) * 2 + (h)) * HTB)
#define PG8_SB(b, h) ((4 + (b) * 2 + (h)) * HTB)
#define PG8_STAGE(bufoff, gbase, voff) do { _Pragma("unroll") for (int _i = 0; _i < 2; ++_i) \
        __builtin_amdgcn_global_load_lds((const unsigned*)((const char*)(gbase) + (voff)[_i]), (PG8_LAS unsigned*)(lds + (bufoff) + ldsw + _i * 8192), 16, 0, 0); } while (0)
#define PG8_LDA(dst, b, h) do { _Pragma("unroll") for (int m = 0; m < 4; ++m) _Pragma("unroll") for (int k = 0; k < 2; ++k) dst[m][k] = *(const PG8_LAS bf16x8*)(lds + PG8_SA(b, h) + aoff + m * 2048 + k * 1024); } while (0)
#define PG8_LDB(dst, b, h) do { _Pragma("unroll") for (int n = 0; n < 2; ++n) _Pragma("unroll") for (int k = 0; k < 2; ++k) dst[n][k] = *(const PG8_LAS bf16x8*)(lds + PG8_SB(b, h) + boff + n * 2048 + k * 1024); } while (0)
#define PG8_MMA(ai, bj, At, Bt) do { __builtin_amdgcn_s_setprio(1); _Pragma("unroll") for (int m = 0; m < 4; ++m) _Pragma("unroll") for (int n = 0; n < 2; ++n) _Pragma("unroll") for (int k = 0; k < 2; ++k) \
        acc[ai][bj][m][n] = __builtin_amdgcn_mfma_f32_16x16x32_bf16(Bt[n][k], At[m][k], acc[ai][bj][m][n], 0, 0, 0); __builtin_amdgcn_s_setprio(0); } while (0)
#define PG8_WAIT_V(n) asm volatile("s_waitcnt vmcnt(" #n ")" ::: "memory")
#define PG8_WAIT_L(n) asm volatile("s_waitcnt lgkmcnt(" #n ")" ::: "memory")
#define PG8_BAR __builtin_amdgcn_s_barrier()
#define PG8_SCHED __builtin_amdgcn_sched_barrier(0)
    Unit cur, nxt; int ui = 0;
    if (!S.next(0, cur)) return;
    f32x4 acc[2][2][4][2];
#pragma unroll
    for (int a = 0; a < 2; ++a)
#pragma unroll
        for (int b = 0; b < 2; ++b)
#pragma unroll
            for (int m = 0; m < 4; ++m)
#pragma unroll
                for (int n = 0; n < 2; ++n) acc[a][b][m][n] = (f32x4){0.f, 0.f, 0.f, 0.f};
    bf16x8 At[4][2], B0[2][2], B1[2][2];
    const char* cA = (const char*)g.A + (size_t)cur.pm * tstep; const char* cB = (const char*)g.Bt + (size_t)cur.pn * tstep;
    S.a_ready(cur);
    PG8_STAGE(PG8_SB(0, 0), cB, voffB); PG8_STAGE(PG8_SA(0, 0), cA, voffA); PG8_STAGE(PG8_SB(0, 1), cB + hstep, voffB); PG8_STAGE(PG8_SA(0, 1), cA + hstep, voffA);
    if (wr == 1) PG8_BAR;
    PG8_WAIT_V(4); PG8_BAR;
    PG8_STAGE(PG8_SB(1, 0), cB + kstep, voffB); PG8_STAGE(PG8_SA(1, 0), cA + kstep, voffA); PG8_STAGE(PG8_SB(1, 1), cB + hstep + kstep, voffB);
    PG8_WAIT_V(6); PG8_BAR;
    PG8_STAMP();
    for (;;) {
        const bool has_next = S.next(ui + 1, nxt);
        const char* nA = has_next ? (const char*)g.A + (size_t)nxt.pm * tstep : cA; const char* nB = has_next ? (const char*)g.Bt + (size_t)nxt.pn * tstep : cB;
        for (int t = 0; t < nt; t += 2) {
            const bool last = (t == nt - 2);
            const char* a1 = cA + (size_t)(t + 1) * kstep;
            const char* a2 = last ? nA : cA + (size_t)(t + 2) * kstep; const char* b2 = last ? nB : cB + (size_t)(t + 2) * kstep;
            const char* a3 = a2 + kstep; const char* b3 = b2 + kstep;
            if (last && has_next) S.a_ready(nxt);
            PG8_LDB(B0, 0, 0); PG8_SCHED; PG8_LDA(At, 0, 0); PG8_STAGE(PG8_SA(1, 1), a1 + hstep, voffA);
            PG8_WAIT_L(8); PG8_BAR; PG8_WAIT_L(0); PG8_MMA(0, 0, At, B0); PG8_BAR; PG8_SCHED;
            PG8_LDB(B1, 0, 1); PG8_STAGE(PG8_SB(0, 0), b2, voffB);
            PG8_BAR; PG8_WAIT_L(0); PG8_MMA(0, 1, At, B1); PG8_BAR;
            PG8_LDA(At, 0, 1); PG8_STAGE(PG8_SA(0, 0), a2, voffA);
            PG8_BAR; PG8_WAIT_L(0); PG8_MMA(1, 0, At, B0); PG8_BAR; PG8_SCHED;
            PG8_STAGE(PG8_SB(0, 1), b2 + hstep, voffB);
            PG8_WAIT_V(6); PG8_BAR; PG8_MMA(1, 1, At, B1); PG8_BAR;
            PG8_LDB(B0, 1, 0); PG8_SCHED; PG8_LDA(At, 1, 0); PG8_STAGE(PG8_SA(0, 1), a2 + hstep, voffA);
            PG8_WAIT_L(8); PG8_BAR; PG8_WAIT_L(0); PG8_MMA(0, 0, At, B0); PG8_BAR; PG8_SCHED;
            PG8_LDB(B1, 1, 1); PG8_STAGE(PG8_SB(1, 0), b3, voffB);
            PG8_BAR; PG8_WAIT_L(0); PG8_MMA(0, 1, At, B1); PG8_BAR;
            PG8_LDA(At, 1, 1); PG8_STAGE(PG8_SA(1, 0), a3, voffA);
            PG8_BAR; PG8_WAIT_L(0); PG8_MMA(1, 0, At, B0); PG8_BAR; PG8_SCHED;
            PG8_STAGE(PG8_SB(1, 1), b3 + hstep, voffB);
            PG8_WAIT_V(6); PG8_BAR; PG8_MMA(1, 1, At, B1); PG8_BAR;
        }
        PG8_STAMP();
        if constexpr (!Epi::AFTER_DRAIN) { E(acc, cur, wr, wc, fr, fq); S.done(cur); }
        PG8_STAMP();
        if (!has_next) break;
#pragma unroll
        for (int a = 0; a < 2; ++a)
#pragma unroll
            for (int b = 0; b < 2; ++b)
#pragma unroll
                for (int m = 0; m < 4; ++m)
#pragma unroll
                    for (int n = 0; n < 2; ++n) acc[a][b][m][n] = (f32x4){0.f, 0.f, 0.f, 0.f};
        cur = nxt; cA = nA; cB = nB; ++ui;
    }
    PG8_WAIT_V(0);
    if (wr == 0) PG8_BAR;
    PG8_BAR;
    if constexpr (Epi::AFTER_DRAIN) { E.fused(acc, cur, wr, wc, fr, fq, lds, wid, lane); S.done(cur); }
    PG8_STAMP();
    if (STAMP && wid == 0) { stamps[lane] = lane < nts ? (((unsigned long long)(unsigned)ts_hi << 32) | (unsigned)ts_lo) : 0ull;
        if (lane == 62) stamps[62] = rt_entry; if (lane == 63) stamps[63] = (unsigned long long)wall_clock64(); }
#undef PG8_STAMP
#undef PG8_SA
#undef PG8_SB
#undef PG8_STAGE
#undef PG8_LDA
#undef PG8_LDB
#undef PG8_MMA
#undef PG8_WAIT_V
#undef PG8_WAIT_L
#undef PG8_BAR
#undef PG8_SCHED
}
}

DI void phase_gemm_big(const bf16_t* A, const bf16_t* W, int N, int K, bf16_t* C, int ldc, int route, char* ws, unsigned char* lds) {
  pg8::Gemm g{A, W, TP_, N, K};
  pg8::StaticOrder S; S.init(TP_, N, gridDim.x, blockIdx.x);
  pg8::EpiRoute E{C, ldc, route, (bf16_t*)(ws + O_PC), (bf16_t*)(ws + O_PRKV), (bf16_t*)(ws + O_PLOW)};
  pg8::gemm_phase<pg8::EpiRoute, pg8::StaticOrder, false>((PG8_LAS unsigned char*)lds, g, S, E, nullptr);
}
DI void phase_gemm_gateup(const bf16_t* A, const bf16_t* W, bf16_t* ACT, unsigned char* lds) {
  pg8::Gemm g{A, W, TP_, 5632, 1024};
  pg8::StaticOrder S; S.init(TP_, 5632, gridDim.x, blockIdx.x);
  pg8::EpiGateUp E{ACT};
  pg8::gemm_phase<pg8::EpiGateUp, pg8::StaticOrder, false>((PG8_LAS unsigned char*)lds, g, S, E, nullptr);
}

DI void phase_resnorm(const P& p, const float* g1, const float* g2, bool first = false) {
  const int lane = threadIdx.x & 63, gw = (blockIdx.x * NTH + threadIdx.x) >> 6, nw = (gridDim.x * NTH) >> 6;
  bf16_t* HN = (bf16_t*)(p.ws + O_HN);
  for (int sr = gw; sr < T_; sr += nw) {
    float* hr = hrow(p, sr);
    const float* hsrc = hr;
    if (first) {
      int pos; const int b = seq_of(sr, pos);
      hsrc = pos < 16 ? p.meta + pos * 1024 : (b < 8 ? p.x_prompt + ((size_t)b * 4096 + pos - 16) * 1024 : p.x_sample + (size_t)(pos - 16) * 1024);
    }
    float x[16];
    float ss = 0.f;
#pragma unroll
    for (int q = 0; q < 4; ++q) {
      const uint2 u = *(const uint2*)(HN + (size_t)sr * 1024 + q * 256 + lane * 4);
      x[q * 4] = lo2f(u.x); x[q * 4 + 1] = hi2f(u.x); x[q * 4 + 2] = lo2f(u.y); x[q * 4 + 3] = hi2f(u.y);
      ss += x[q * 4] * x[q * 4] + x[q * 4 + 1] * x[q * 4 + 1] + x[q * 4 + 2] * x[q * 4 + 2] + x[q * 4 + 3] * x[q * 4 + 3];
    }
    f32x4v hh[4];
#pragma unroll
    for (int q = 0; q < 4; ++q) hh[q] = *(const f32x4v*)(hsrc + q * 256 + lane * 4);
    ss = wave_sum(ss);
    const float rs = rsqrtf(ss * (1.f / 1024.f) + EPS);
    float ss2 = 0.f;
#pragma unroll
    for (int q = 0; q < 4; ++q) {
      const float4 g = *(const float4*)(g1 + q * 256 + lane * 4);
      hh[q].x += x[q * 4 + 0] * rs * g.x; hh[q].y += x[q * 4 + 1] * rs * g.y; hh[q].z += x[q * 4 + 2] * rs * g.z; hh[q].w += x[q * 4 + 3] * rs * g.w;
      *(f32x4v*)(hr + q * 256 + lane * 4) = hh[q];
      ss2 += hh[q].x * hh[q].x + hh[q].y * hh[q].y + hh[q].z * hh[q].z + hh[q].w * hh[q].w;
    }
    if (g2) {
      ss2 = wave_sum(ss2);
      const float rs2 = rsqrtf(ss2 * (1.f / 1024.f) + EPS);
#pragma unroll
      for (int q = 0; q < 4; ++q) {
        const float4 g = *(const float4*)(g2 + q * 256 + lane * 4);
        *(uint2*)(HN + (size_t)sr * 1024 + q * 256 + lane * 4) = make_uint2(pack2(hh[q].x * rs2 * g.x, hh[q].y * rs2 * g.y), pack2(hh[q].z * rs2 * g.z, hh[q].w * rs2 * g.w));
      }
    }
  }
}

DI size_t vta_base(int seq) { return seq < 8 ? (size_t)seq * 256 * 4160 : (size_t)8 * 256 * 4160; }
template <int NC> DI void vt_transpose(const bf16_t* src, int ld, int col0, bf16_t* VT, char* lds) {
  bf16_t* tl = (bf16_t*)lds;
  const int tid = threadIdx.x;
  constexpr int CPT = NC / 8, TPR = 512 / NC, PPT = 64 / TPR;
  for (int it = blockIdx.x; it < 257 + 8 * 65; it += gridDim.x) {
    int seq, kt;
    if (it < 257) { seq = 8; kt = it; } else { const int j = it - 257; seq = j / 65; kt = j - seq * 65; }
    const int L = seq_len(seq), LP = L + 48, sbase = seq_base(seq);
    const size_t vb = (seq < 8 ? (size_t)seq * NC * 4160 : (size_t)8 * NC * 4160);
    __syncthreads();
    const int pl = tid >> 3, part = tid & 7;
    const int pos = 64 * kt + pl - 48;
#pragma unroll
    for (int q = 0; q < CPT / 8; ++q) {
      u32x4 v = (u32x4)(0u);
      if (pos >= 0) v = *(const u32x4*)(src + (size_t)(sbase + pos) * ld + col0 + part * CPT + q * 8);
#pragma unroll
      for (int j = 0; j < 4; ++j) {
        tl[(part * CPT + q * 8 + 2 * j) * 72 + pl] = (bf16_t)(v[j] & 0xffffu);
        tl[(part * CPT + q * 8 + 2 * j + 1) * 72 + pl] = (bf16_t)(v[j] >> 16);
      }
    }
    __syncthreads();
    const int row = tid / TPR, seg = tid % TPR;
    bf16_t* dst = VT + vb + (size_t)row * LP + 64 * kt + seg * PPT;
#pragma unroll
    for (int q = 0; q < PPT / 8; ++q) *(u32x4*)(dst + q * 8) = *(const u32x4*)(tl + row * 72 + seg * PPT + q * 8);
  }
}

DI void phase_prepA(const P& p, char* lds) {
  const int lane = threadIdx.x & 63, wave = threadIdx.x >> 6;
  bf16_t* PROJ = (bf16_t*)(p.ws + O_PROJ0);
  bf16_t* ZB = (bf16_t*)(p.ws + O_ZB);
  const float* WC = (const float*)(p.ws + O_WC);
  vt_transpose<256>(PROJ, 1536, 1024, (bf16_t*)(p.ws + O_VTA), lds);
  __syncthreads();
  float* fl = (float*)lds + wave * 1024;
  float* csl = (float*)lds + 8 * 1024 + wave * 64;
  const float inv = exp2f(-(float)(lane & 15) * (13.287712379549449f / 16.f));
  const int qr = lane & 3;
  float gn[16];
#pragma unroll
  for (int j = 0; j < 16; ++j) gn[j] = (lane < 48 ? p.a_q_gain : p.a_k_gain)[16 * qr + j] * (lane < 48 ? 0.125f * LOG2E : 1.f);
  for (int r0 = blockIdx.x * 32; r0 < TP_; r0 += gridDim.x * 32) {
    const int srb = r0 + wave * 4;
#pragma unroll 1
    for (int rr = 0; rr < 4; ++rr) {
      const int sr = srb + rr;
      if (sr < T_) {
        int pos; seq_of(sr, pos);
        float rowf, colf;
        if (pos < 16) { rowf = colf = (float)(pos - 16); }
        else { int t = pos - 16; rowf = (float)(t >> 6); colf = (float)(t & 63); }
        {
          float sn1, cs1;
          sincosf(((lane & 16) ? colf : rowf) * inv, &sn1, &cs1);
          if (lane < 32) { csl[lane] = cs1; csl[32 + lane] = sn1; }
        }
        bf16_t* pr = PROJ + (size_t)sr * 1536;
        {
        const u32x4 u0 = *(const u32x4*)(pr + 16 * lane), u1 = *(const u32x4*)(pr + 16 * lane + 8);
        float x[16];
        float ss = 0.f;
#pragma unroll
        for (int j = 0; j < 4; ++j) {
          x[2 * j] = lo2f(u0[j]); x[2 * j + 1] = hi2f(u0[j]); x[8 + 2 * j] = lo2f(u1[j]); x[8 + 2 * j + 1] = hi2f(u1[j]);
        }
#pragma unroll
        for (int j = 0; j < 16; ++j) ss += x[j] * x[j];
        ss += __shfl_xor(ss, 1); ss += __shfl_xor(ss, 2);
        const float rs = rsqrtf(ss * (1.f / 64.f) + EPS);
        const float* cp = csl + 16 * (qr >> 1);
        float o[16];
#pragma unroll
        for (int j4 = 0; j4 < 4; ++j4) {
          const f32x4v c4 = *(const f32x4v*)(cp + 4 * j4), s4 = *(const f32x4v*)(cp + 32 + 4 * j4);
#pragma unroll
          for (int e = 0; e < 4; ++e) {
            const int j = 4 * j4 + e;
            const float xn = x[j] * rs * gn[j];
            const float pa = __shfl_xor(xn, 1);
            o[j] = xn * c4[e] + pa * ((qr & 1) ? s4[e] : -s4[e]);
          }
        }
        *(u32x4*)(pr + 16 * lane) = (u32x4){pack2(o[0], o[1]), pack2(o[2], o[3]), pack2(o[4], o[5]), pack2(o[6], o[7])};
        *(u32x4*)(pr + 16 * lane + 8) = (u32x4){pack2(o[8], o[9]), pack2(o[10], o[11]), pack2(o[12], o[13]), pack2(o[14], o[15])};
        }
        uint2 u = *(const uint2*)(pr + 1280 + lane * 4);
        float f0 = lo2f(u.x), f1 = hi2f(u.x), f2 = lo2f(u.y), f3 = hi2f(u.y);
        float ss = f0 * f0 + f1 * f1 + f2 * f2 + f3 * f3;
        ss += __shfl_xor(ss, 1); ss += __shfl_xor(ss, 2); ss += __shfl_xor(ss, 4); ss += __shfl_xor(ss, 8);
        float rs = rsqrtf(ss * (1.f / 64.f) + EPS);
        float4 g = *(const float4*)(p.b_norm_g + lane * 4);
        *(float4*)(fl + rr * 256 + lane * 4) = make_float4(f0 * rs * g.x, f1 * rs * g.y, f2 * rs * g.z, f3 * rs * g.w);
      } else {
        *(float4*)(fl + rr * 256 + lane * 4) = make_float4(0.f, 0.f, 0.f, 0.f);
      }
    }
    __syncthreads();
    {
      const int g = lane >> 4, o0 = (lane & 15) * 8;
      float acc[4][8];
#pragma unroll
      for (int rr = 0; rr < 4; ++rr)
#pragma unroll
        for (int j = 0; j < 8; ++j) acc[rr][j] = 0.f;
      const float* wc = WC + (size_t)g * 64 * 128 + o0;
#pragma unroll 4
      for (int c = 0; c < 64; ++c) {
        const float4 w0 = *(const float4*)(wc + c * 128), w1 = *(const float4*)(wc + c * 128 + 4);
#pragma unroll
        for (int rr = 0; rr < 4; ++rr) {
          const float f = fl[rr * 256 + g * 64 + c];
          acc[rr][0] += f * w0.x; acc[rr][1] += f * w0.y; acc[rr][2] += f * w0.z; acc[rr][3] += f * w0.w;
          acc[rr][4] += f * w1.x; acc[rr][5] += f * w1.y; acc[rr][6] += f * w1.z; acc[rr][7] += f * w1.w;
        }
      }
#pragma unroll
      for (int rr = 0; rr < 4; ++rr)
        if (srb + rr < T_)
          *(uint4*)(ZB + (size_t)(srb + rr) * 512 + g * 128 + o0) = make_uint4(pack2(acc[rr][0], acc[rr][1]), pack2(acc[rr][2], acc[rr][3]), pack2(acc[rr][4], acc[rr][5]), pack2(acc[rr][6], acc[rr][7]));
    }
    __syncthreads();
  }
}

template <int MODE>
DI void flash_item(const bf16_t* __restrict__ Q, int ldq, const bf16_t* __restrict__ Kb, int ldk, const bf16_t* __restrict__ Vt, int LP,
                   bf16_t* O, int ldo, int sbase, int S, int qt, float sinkl2, char* lds) {
  const int tid = threadIdx.x & 255, lane = tid & 63, wave = tid >> 6, l31 = lane & 31, h = lane >> 5;
  bf16_t* Ks = (bf16_t*)lds;
  bf16_t* Vs = Ks + 2 * 64 * 72;
  const int rl = wave * 32 + l31;
  const int qpos = qt == 0 ? (rl < 16 ? rl : 15) : 16 + 128 * (qt - 1) + rl;
  const bool qvalid = qt > 0 || rl < 16;
  bf16x8 qf[4];
  {
    const bf16_t* qr = Q + (size_t)(sbase + qpos) * ldq;
#pragma unroll
    for (int s = 0; s < 4; ++s) qf[s] = *(const bf16x8*)(qr + 16 * s + 8 * h);
  }
  const int nkt_all = (S + 64) / 64;
  int klo = 1, n;
  if (MODE == 0) { n = nkt_all; }
  else {
    if (qt == 0) { klo = 1; n = 3; }
    else {
      int c = qt - 1;
      klo = 2 * c - 1; if (klo < 1) klo = 1;
      int khi = 2 * c + 4; if (khi > nkt_all - 1) khi = nkt_all - 1;
      n = 1 + (khi - klo + 1);
    }
  }
  const int ldr = tid >> 2, ldp = (tid & 3) * 16;
  u32x4 rk0, rk1, rv0, rv1;
  auto ktile = [&](int idx) { return idx == 0 ? 0 : klo + idx - 1; };
#define FL_GLOAD(idx)                                                                               \
  {                                                                                                 \
    int kt_ = ktile(idx);                                                                           \
    int pos_ = 64 * kt_ + ldr - 48;                                                                 \
    if (pos_ >= 0) {                                                                                \
      const bf16_t* kp_ = Kb + (size_t)(sbase + pos_) * ldk + ldp;                                  \
      rk0 = *(const u32x4*)kp_; rk1 = *(const u32x4*)(kp_ + 8);                                 \
    } else { rk0 = (u32x4)(0u); rk1 = rk0; }                                       \
    const bf16_t* vp_ = Vt + (size_t)ldr * LP + 64 * kt_ + ldp;                                     \
    rv0 = *(const u32x4*)vp_; rv1 = *(const u32x4*)(vp_ + 8);                                   \
  }
#define FL_SSTORE(buf)                                                                              \
  {                                                                                                 \
    *(u32x4*)(Ks + (buf) * 64 * 72 + ldr * 72 + ldp) = rk0; *(u32x4*)(Ks + (buf) * 64 * 72 + ldr * 72 + ldp + 8) = rk1; \
    { bf16_t* vd_ = Vs + (buf) * 64 * 68 + ldr * 68 + ldp; *(uint2*)vd_ = make_uint2(rv0.x, rv0.y); *(uint2*)(vd_ + 4) = make_uint2(rv0.z, rv0.w); *(uint2*)(vd_ + 8) = make_uint2(rv1.x, rv1.y); *(uint2*)(vd_ + 12) = make_uint2(rv1.z, rv1.w); } \
  }
  f32x16 oacc[2];
#pragma unroll
  for (int i = 0; i < 16; ++i) { oacc[0][i] = 0.f; oacc[1][i] = 0.f; }
  float m = MODE == 1 ? -1e30f : 0.f, l = 0.f;
  FL_GLOAD(0)
  FL_SSTORE(0)
  __syncthreads();
  for (int idx = 0; idx < n; ++idx) {
    const int cur = idx & 1;
    if (idx + 1 < n) FL_GLOAD(idx + 1)
    const int kt = ktile(idx);
    const bf16_t* ks = Ks + cur * 64 * 72;
    const bf16_t* vs = Vs + cur * 64 * 68;
    f32x16 sacc[2];
    {
      bf16x8 kf[2][4];
#pragma unroll
      for (int t = 0; t < 2; ++t)
#pragma unroll
        for (int s = 0; s < 4; ++s) kf[t][s] = *(const bf16x8*)(ks + (32 * t + l31) * 72 + 16 * s + 8 * h);
#pragma unroll
      for (int t = 0; t < 2; ++t)
#pragma unroll
        for (int i = 0; i < 16; ++i) sacc[t][i] = 0.f;
      __builtin_amdgcn_sched_barrier(0);
#pragma unroll
      for (int s = 0; s < 4; ++s)
#pragma unroll
        for (int t = 0; t < 2; ++t) sacc[t] = MFMA32(kf[t][s], qf[s], sacc[t]);
    }
    bf16x8 vfr[2][2][2];
#pragma unroll
    for (int t = 0; t < 2; ++t)
#pragma unroll
      for (int s2 = 0; s2 < 2; ++s2)
#pragma unroll
        for (int dt = 0; dt < 2; ++dt) {
          const bf16_t* vp = vs + (32 * dt + l31) * 68 + 32 * t + 16 * s2 + 4 * h;
          uint2 lo = *(const uint2*)vp, hi = *(const uint2*)(vp + 8);
          u32x4 v4 = {lo.x, lo.y, hi.x, hi.y};
          vfr[t][s2][dt] = __builtin_bit_cast(bf16x8, v4);
        }
    __builtin_amdgcn_sched_barrier(0);
    if (kt == 0) {
#pragma unroll
      for (int t = 0; t < 2; ++t)
#pragma unroll
        for (int i = 0; i < 16; ++i) {
          int kl = 32 * t + (i & 3) + 8 * (i >> 2) + 4 * h;
          if (kl < 48) sacc[t][i] = -1e30f;
        }
    } else if (MODE == 1) {
#pragma unroll
      for (int t = 0; t < 2; ++t)
#pragma unroll
        for (int i = 0; i < 16; ++i) {
          int kl = 32 * t + (i & 3) + 8 * (i >> 2) + 4 * h;
          int tk = 64 * (kt - 1) + kl;
          bool vis;
          if (qt == 0) vis = tk <= 112 + qpos;
          else { int tq = qpos - 16; int d = tq - tk; vis = d <= 128 && d >= -128; }
          if (!vis) sacc[t][i] = -1e30f;
        }
    }
    float tmax = -1e30f;
    if (MODE == 1) {
#pragma unroll
      for (int t = 0; t < 2; ++t)
#pragma unroll
        for (int i = 0; i < 16; ++i) tmax = fmaxf(tmax, sacc[t][i]);
      tmax = fmaxf(tmax, __shfl_xor(tmax, 32));
    }
    if (MODE == 1 && __builtin_amdgcn_ballot_w64(tmax > m) != 0ull) {
      const float mn = fmaxf(m, tmax);
      const float alpha = __builtin_amdgcn_exp2f(m - mn);
      m = mn;
      l *= alpha;
#pragma unroll
      for (int i = 0; i < 16; ++i) { oacc[0][i] *= alpha; oacc[1][i] *= alpha; }
    }
    const f32x2 m2 = {m, m};
    f32x2 ls2 = {0.f, 0.f};
    unsigned pk[2][8];
#pragma unroll
    for (int t = 0; t < 2; ++t)
#pragma unroll
      for (int i2 = 0; i2 < 8; ++i2) {
        f32x2 d = {sacc[t][2 * i2], sacc[t][2 * i2 + 1]};
        if (MODE == 1) d = d - m2;
        f32x2 e = {__builtin_amdgcn_exp2f(d.x), __builtin_amdgcn_exp2f(d.y)};
        ls2 += e;
        pk[t][i2] = __builtin_bit_cast(unsigned, __builtin_convertvector(e, bf16x2_t));
      }
    l += ls2.x + ls2.y;
#pragma unroll
    for (int t = 0; t < 2; ++t)
#pragma unroll
      for (int s2 = 0; s2 < 2; ++s2) {
        u32x4 pk4 = {pk[t][4 * s2], pk[t][4 * s2 + 1], pk[t][4 * s2 + 2], pk[t][4 * s2 + 3]};
        bf16x8 pf = __builtin_bit_cast(bf16x8, pk4);
#pragma unroll
        for (int dt = 0; dt < 2; ++dt) oacc[dt] = MFMA32(vfr[t][s2][dt], pf, oacc[dt]);
      }
    if (idx + 1 < n) FL_SSTORE(cur ^ 1)
    __syncthreads();
  }
  l += __shfl_xor(l, 32);
  if (MODE == 1) l += __builtin_amdgcn_exp2f(sinkl2 - m);
  const float il = 1.f / l;
  if (qvalid) {
    bf16_t* orow = O + (size_t)(sbase + qpos) * ldo;
#pragma unroll
    for (int dt = 0; dt < 2; ++dt)
#pragma unroll
      for (int g = 0; g < 4; ++g) {
        int d = 32 * dt + 8 * g + 4 * h;
        uint2 o = make_uint2(pack2(oacc[dt][4 * g] * il, oacc[dt][4 * g + 1] * il), pack2(oacc[dt][4 * g + 2] * il, oacc[dt][4 * g + 3] * il));
        *(uint2*)(orow + d) = o;
      }
  }
#undef FL_GLOAD
#undef FL_SSTORE
}

DI void dft4(float& r0, float& i0, float& r1, float& i1, float& r2, float& i2, float& r3, float& i3) {
  const float t0r = r0 + r2, t0i = i0 + i2, t1r = r0 - r2, t1i = i0 - i2;
  const float t2r = r1 + r3, t2i = i1 + i3, t3r = i1 - i3, t3i = r3 - r1;
  r0 = t0r + t2r; i0 = t0i + t2i; r1 = t1r + t3r; i1 = t1i + t3i; r2 = t0r - t2r; i2 = t0i - t2i; r3 = t1r - t3r; i3 = t1i - t3i;
}
DI void dft16(float (&zr)[16], float (&zi)[16]) {
#pragma unroll
  for (int b = 0; b < 4; ++b) dft4(zr[b], zi[b], zr[4 + b], zi[4 + b], zr[8 + b], zi[8 + b], zr[12 + b], zi[12 + b]);
  constexpr float C1 = 0.9238795325112867f, S1 = 0.3826834323650898f, C2 = 0.7071067811865476f;
  const float wr[10] = {1.f, C1, C2, S1, 0.f, 0.f, -C2, 0.f, 0.f, -C1};
  const float wi[10] = {0.f, -S1, -C2, -C1, -1.f, 0.f, -C2, 0.f, 0.f, S1};
#pragma unroll
  for (int q = 1; q < 4; ++q)
#pragma unroll
    for (int b = 1; b < 4; ++b) {
      const float c = wr[b * q], d = wi[b * q];
      const float xr = zr[4 * q + b], xi = zi[4 * q + b];
      zr[4 * q + b] = xr * c - xi * d; zi[4 * q + b] = xr * d + xi * c;
    }
#pragma unroll
  for (int q = 0; q < 4; ++q) dft4(zr[4 * q], zi[4 * q], zr[4 * q + 1], zi[4 * q + 1], zr[4 * q + 2], zi[4 * q + 2], zr[4 * q + 3], zi[4 * q + 3]);
}

DI size_t y_base(int seq) { return seq < 8 ? (size_t)seq * 16 * 256 * 576 : (size_t)8 * 16 * 256 * 576; }
DI void phase_attnA(const P& p, char* lds) {
  const bf16_t* PROJ = (const bf16_t*)(p.ws + O_PROJ0);
  const bf16_t* VT = (const bf16_t*)(p.ws + O_VTA);
  bf16_t* MIX = (bf16_t*)(p.ws + O_MIX);
  const int nS = 129 * 6, nP = 8 * 33 * 6;
  const int sb = threadIdx.x >> 8;
  unsigned* head = (unsigned*)(p.ws + O_CNT);
  for (;;) {
    if (threadIdx.x == 0) *(volatile int*)(lds + 2 * 36864) = (int)__hip_atomic_fetch_add(head, 1u, __ATOMIC_RELAXED, __HIP_MEMORY_SCOPE_AGENT);
    __syncthreads();
    const int it = *(volatile int*)(lds + 2 * 36864);
    __syncthreads();
    if (it >= nS + nP) break;
    int seq, qt, hq;
    if (it < nS) { seq = 8; hq = (it % 6) * 2 + sb; qt = it / 6; }
    else { int j = it - nS; hq = (j % 6) * 2 + sb; j /= 6; qt = j % 33; seq = j / 33; }
    const int kv = hq / 3;
    const int L = seq_len(seq), LP = L + 48;
    flash_item<0>(PROJ + hq * 64, 1536, PROJ + 768 + kv * 64, 1536, VT + vta_base(seq) + (size_t)kv * 64 * LP, LP,
                  MIX + hq * 64, 1024, seq_base(seq), L - 16, qt, 0.f, lds + sb * 36864);
  }
  const bf16_t* ZB = (const bf16_t*)(p.ws + O_ZB);
  bf16_t* Y = (bf16_t*)(p.ws + O_Y);
  const int lane = threadIdx.x & 63, wave = threadIdx.x >> 6;
  const int nI_S = 17 * 16, nI_P = 8 * 5 * 16;
  for (;;) {
    if (threadIdx.x == 0) *(volatile int*)(lds + 2 * 36864) = (int)__hip_atomic_fetch_add(head + 64, 1u, __ATOMIC_RELAXED, __HIP_MEMORY_SCOPE_AGENT);
    __syncthreads();
    const int it = *(volatile int*)(lds + 2 * 36864);
    __syncthreads();
    if (it >= nI_S + nI_P) break;
    int seq, nb, cb;
    if (it < nI_S) { seq = 8; cb = it & 15; nb = it >> 4; }
    else { int j = it - nI_S; cb = j & 15; j >>= 4; nb = j % 5; seq = j / 5; }
    const int M = seq < 8 ? 257 : 1025, KP = seq < 8 ? 576 : 2112, L = 16 * M;
    const int n2 = nb * 64 + lane;
    const int ch = cb * 16 + wave * 2;
    const int g = ch >> 6, d = ch & 63;
    bf16_t* yb = Y + y_base(seq);
    if (n2 < M) {
      float ar[16], ai[16], br[16], bi[16];
#pragma unroll
      for (int n1 = 0; n1 < 16; ++n1) {
        const bf16_t* zp = ZB + (size_t)(seq_base(seq) + M * n1 + n2) * 512 + g * 128 + d;
        unsigned re = *(const unsigned*)zp, im = *(const unsigned*)(zp + 64);
        ar[n1] = lo2f(re); br[n1] = hi2f(re); ai[n1] = lo2f(im); bi[n1] = hi2f(im);
      }
      dft16(ar, ai);
      dft16(br, bi);
      float t1s, t1c;
      sincospif(-2.f * (float)n2 / (float)L, &t1s, &t1c);
      float tc = 1.f, ts = 0.f;
#pragma unroll
      for (int k1 = 0; k1 < 16; ++k1) {
        const int ix = 4 * (k1 & 3) + (k1 >> 2);
        const float yr0 = ar[ix] * tc - ai[ix] * ts, yi0 = ar[ix] * ts + ai[ix] * tc;
        const float yr1 = br[ix] * tc - bi[ix] * ts, yi1 = br[ix] * ts + bi[ix] * tc;
        bf16_t* y0 = yb + ((size_t)k1 * 256 + ch) * KP;
        y0[n2] = f2bf(yr0); y0[M + n2] = f2bf(yi0);
        y0[KP + n2] = f2bf(yr1); y0[KP + M + n2] = f2bf(yi1);
        const float nc = tc * t1c - ts * t1s; ts = tc * t1s + ts * t1c; tc = nc;
      }
    } else if (n2 < KP - M) {
      for (int k1 = 0; k1 < 16; ++k1) {
        bf16_t* y0 = yb + ((size_t)k1 * 256 + ch) * KP;
        y0[M + n2] = 0; y0[KP + M + n2] = 0;
      }
    }
  }
}

DI void phase_fnet_gemm(const P& p, char* lds) {
  GEMM_IDS
  bf16_t* MIX = (bf16_t*)(p.ws + O_MIX);
  const bf16_t* Y = (const bf16_t*)(p.ws + O_Y);
  const int nS = 16 * 9 * 2, nP = 8 * 16 * 3 * 2;
  const int sb = threadIdx.x >> 8;
  for (int it0 = blockIdx.x * 2; it0 < nS + nP; it0 += gridDim.x * 2) {
    const int it = it0 + sb;
    int seq, k1, tm, tn;
    if (it < nS) { seq = 8; tn = it & 1; int j = it >> 1; tm = j % 9; k1 = j / 9; }
    else { int j = it - nS; tn = j & 1; j >>= 1; tm = j % 3; j /= 3; k1 = j & 15; seq = j >> 4; }
    const int M = seq < 8 ? 257 : 1025, KP = seq < 8 ? 576 : 2112, L = 16 * M;
    const bf16_t* dm = (const bf16_t*)(p.ws + (seq < 8 ? O_DM257 : O_DM1025));
    f32x16 acc[2][2];
    gemm_tile(dm + (size_t)tm * 128 * KP, KP, Y + y_base(seq) + ((size_t)k1 * 256 + tn * 128) * KP, KP, KP, lds + sb * 36864, acc);
    const float scale = rsqrtf(64.f * (float)L);
#pragma unroll
    for (int mt = 0; mt < 2; ++mt)
#pragma unroll
      for (int nt = 0; nt < 2; ++nt)
#pragma unroll
        for (int i = 0; i < 16; ++i) {
          int k2 = tm * 128 + ACC_ROW(mt, i), ch = tn * 128 + ACC_COL(nt);
          if (k2 < M) {
            int pos = k1 + 16 * k2;
            MIX[(size_t)(seq_base(seq) + pos) * 1024 + 768 + ch] = f2bf(acc[mt][nt][i] * scale + p.b_b[ch]);
          }
        }
  }
}

DI size_t vtc_base(int seq) { return seq < 8 ? (size_t)seq * 128 * 4160 : (size_t)8 * 128 * 4160; }
DI void phase_prepC(const P& p, char* lds) {
  const int gtid = blockIdx.x * NTH + threadIdx.x, gsz = gridDim.x * NTH;
  const int lane = threadIdx.x & 63, gw = gtid >> 6, nw = gsz >> 6;
  bf16_t* PC = (bf16_t*)(p.ws + O_PC);
  bf16_t* VT = (bf16_t*)(p.ws + O_VTC);
  const bf16_t* PLOW = (const bf16_t*)(p.ws + O_PLOW);
  bf16_t* LR = (bf16_t*)(p.ws + O_LR);
  vt_transpose<128>(PC, 768, 640, VT, lds);
  for (int sr = gw; sr < T_; sr += nw) {
    int pos; int b = seq_of(sr, pos);
    const int L = seq_len(b), LP = L + 48;
    bf16_t* pr = PC + (size_t)sr * 768;
    float cs[8], sn[8];
    {
      float s1, c1;
      sincosf((float)pos * exp2f(-(float)(lane & 7) * (18.931568569324174f / 8.f)), &s1, &c1);
#pragma unroll
      for (int j = 0; j < 8; ++j) { sn[j] = __shfl(s1, j); cs[j] = __shfl(c1, j); }
    }
#pragma unroll
    for (int part = 0; part < 2; ++part) {
      const bool act = part == 0 || lane < 16;
      const int col = part * 512 + (act ? lane : 0) * 8;
      uint4 u = *(const uint4*)(pr + col);
      float e[8] = {lo2f(u.x), hi2f(u.x), lo2f(u.y), hi2f(u.y), lo2f(u.z), hi2f(u.z), lo2f(u.w), hi2f(u.w)};
      float o[8];
#pragma unroll
      for (int j = 0; j < 8; ++j) {
        float pa = __shfl_xor(e[j], 1);
        float rot = e[j] * cs[j] + pa * ((lane & 1) ? sn[j] : -sn[j]);
        o[j] = (lane & 7) < 2 ? rot : e[j];
        if (part == 0) o[j] *= 0.125f * LOG2E;
      }
      if (act) *(uint4*)(pr + col) = make_uint4(pack2(o[0], o[1]), pack2(o[2], o[3]), pack2(o[4], o[5]), pack2(o[6], o[7]));
    }
#pragma unroll
    for (int q = 0; q < 6; ++q) {
      int c = q * 64 + lane;
      float u = bf2f(PLOW[(size_t)sr * 384 + c]);
      float up = pos > 0 ? bf2f(PLOW[(size_t)(sr - 1) * 384 + c]) : 0.f;
      float un = pos < L - 1 ? bf2f(PLOW[(size_t)(sr + 1) * 384 + c]) : 0.f;
      float us = u + p.mu_prev[1536 + c] * (up - u) + p.mu_next[1536 + c] * (un - u);
      float v = c < 128 ? tanhf(us) : (c < 256 ? us : sigmoidf_(us));
      LR[(size_t)sr * 384 + c] = f2bf(v);
    }
  }
}

DI void phase_attnC(const P& p, char* lds) {
  const bf16_t* PC = (const bf16_t*)(p.ws + O_PC);
  const bf16_t* VT = (const bf16_t*)(p.ws + O_VTC);
  bf16_t* MIX = (bf16_t*)(p.ws + O_MIX);
  const int nS = 129 * 4, nP = 8 * 33 * 4;
  const int sb = threadIdx.x >> 8;
  for (int it = blockIdx.x; it < nS + nP; it += gridDim.x) {
    int seq, qt, hq;
    if (it < nS) { seq = 8; hq = (it & 3) * 2 + sb; qt = it >> 2; }
    else { int j = it - nS; hq = (j & 3) * 2 + sb; j >>= 2; qt = j % 33; seq = j / 33; }
    const int kv = hq >> 2;
    const int L = seq_len(seq), LP = L + 48;
    flash_item<1>(PC + hq * 64, 768, PC + 512 + kv * 64, 768, VT + vtc_base(seq) + (size_t)kv * 64 * LP, LP,
                  MIX + hq * 64, 1024, seq_base(seq), L - 16, qt, p.c_sink[hq] * LOG2E, lds + sb * 36864);
  }
}

DI void chunk_decode(int cg_, int& seq, int& c) {
  if (cg_ < 136) { seq = cg_ / 17; c = cg_ - seq * 17; } else { seq = 8; c = cg_ - 136; }
}
DI float shiftv(const bf16_t* PRKV, int sr, int pos, int L, int col, float mp, float mn) {
  float u = bf2f(PRKV[(size_t)sr * 1536 + col]);
  float up = pos > 0 ? bf2f(PRKV[(size_t)(sr - 1) * 1536 + col]) : 0.f;
  float un = pos < L - 1 ? bf2f(PRKV[(size_t)(sr + 1) * 1536 + col]) : 0.f;
  return u + mp * (up - u) + mn * (un - u);
}
enum { VW = 0, VA = 1, VB = 2, VK = 3, VV = 4, VR = 5 };
#define DPP_FMAC(acc, x, y, N) asm("v_fmac_f32_dpp %0, %1, %2 row_newbcast:%3 row_mask:0xf bank_mask:0xf" : "+v"(acc) : "v"(x), "v"(y), "n"(N))
#define DPP_MUL(sv_, x, N) asm("v_mul_f32_dpp %0, %1, %0 row_newbcast:%2 row_mask:0xf bank_mask:0xf" : "+v"(sv_) : "v"(x), "n"(N))
template <int N> DI void dpp_dot4(float& a0, float& a1, float& a2, float& a3, const float (&S)[64], const float4& x) {
  DPP_FMAC(a0, x.x, S[N], N); DPP_FMAC(a1, x.y, S[16 + N], N); DPP_FMAC(a2, x.z, S[32 + N], N); DPP_FMAC(a3, x.w, S[48 + N], N);
  if constexpr (N < 15) dpp_dot4<N + 1>(a0, a1, a2, a3, S, x);
}
template <int N, bool HASV, bool OUT> DI void dpp_upd4(float (&S)[64], const float4& xb, const float4& xk, const float4& xr, float sa, float vi,
                                                       float& o0, float& o1, float& o2, float& o3) {
  DPP_FMAC(S[N], xb.x, sa, N); DPP_FMAC(S[16 + N], xb.y, sa, N); DPP_FMAC(S[32 + N], xb.z, sa, N); DPP_FMAC(S[48 + N], xb.w, sa, N);
  if (HASV) { DPP_FMAC(S[N], xk.x, vi, N); DPP_FMAC(S[16 + N], xk.y, vi, N); DPP_FMAC(S[32 + N], xk.z, vi, N); DPP_FMAC(S[48 + N], xk.w, vi, N); }
  if (OUT) { DPP_FMAC(o0, xr.x, S[N], N); DPP_FMAC(o1, xr.y, S[16 + N], N); DPP_FMAC(o2, xr.z, S[32 + N], N); DPP_FMAC(o3, xr.w, S[48 + N], N); }
  if constexpr (N < 15) dpp_upd4<N + 1, HASV, OUT>(S, xb, xk, xr, sa, vi, o0, o1, o2, o3);
}
template <int N> DI void dpp_scale4(float (&S)[64], const float4& xg) {
  DPP_MUL(S[N], xg.x, N); DPP_MUL(S[16 + N], xg.y, N); DPP_MUL(S[32 + N], xg.z, N); DPP_MUL(S[48 + N], xg.w, N);
  if constexpr (N < 15) dpp_scale4<N + 1>(S, xg);
}
template <int NST, bool HASV, bool OUT, class F>
DI void scan_steps(float (&S)[64], const float* sv, int ns, int lane, F&& emit) {
  const int l15 = lane & 15;
  (void)ns;
#pragma unroll 4
  for (int s = 0; s < NST; ++s) {
    const float4 xa = *(const float4*)(sv + VA * NST * 64 + s * 64 + l15 * 4);
    const float4 xb = *(const float4*)(sv + VB * NST * 64 + s * 64 + l15 * 4);
    float4 xk = xb, xr = xb;
    if (HASV) xk = *(const float4*)(sv + VK * NST * 64 + s * 64 + l15 * 4);
    if (OUT) xr = *(const float4*)(sv + VR * NST * 64 + s * 64 + l15 * 4);
    const float vi = HASV ? sv[VV * NST * 64 + s * 64 + lane] : 0.f;
    float sa0 = 0.f, sa1 = 0.f, sa2 = 0.f, sa3 = 0.f;
    dpp_dot4<0>(sa0, sa1, sa2, sa3, S, xa);
    const float sa = (sa0 + sa1) + (sa2 + sa3);
    float o0 = 0.f, o1 = 0.f, o2 = 0.f, o3 = 0.f;
    dpp_upd4<0, HASV, OUT>(S, xb, xk, xr, sa, vi, o0, o1, o2, o3);
    if (OUT) emit(s, (o0 + o1) + (o2 + o3));
    if ((s & 7) == 7) {
      const float4 xg = *(const float4*)(sv + VW * NST * 64 + (s >> 3) * 64 + l15 * 4);
      dpp_scale4<0>(S, xg);
    }
  }
}
DI int vperm(int j) { return (j & 15) * 4 + (j >> 4); }

DI void shift8(const bf16_t* PRKV, const P& p, int sbase, int pos, int L, int off, int c0, float (&out)[8]) {
  const bf16_t* rp = PRKV + (size_t)(sbase + pos) * 1536 + off + c0;
  const u32x4 uc = *(const u32x4*)rp;
  u32x4 up = (u32x4)(0u), un = (u32x4)(0u);
  if (pos > 0) up = *(const u32x4*)(rp - 1536);
  if (pos < L - 1) un = *(const u32x4*)(rp + 1536);
  const f32x4v mp0 = *(const f32x4v*)(p.mu_prev + off + c0), mp1 = *(const f32x4v*)(p.mu_prev + off + c0 + 4);
  const f32x4v mn0 = *(const f32x4v*)(p.mu_next + off + c0), mn1 = *(const f32x4v*)(p.mu_next + off + c0 + 4);
#pragma unroll
  for (int e2 = 0; e2 < 4; ++e2) {
    const float c_lo = lo2f(uc[e2]), c_hi = hi2f(uc[e2]);
    const float mpl = e2 < 2 ? mp0[2 * e2] : mp1[2 * e2 - 4], mph = e2 < 2 ? mp0[2 * e2 + 1] : mp1[2 * e2 - 3];
    const float mnl = e2 < 2 ? mn0[2 * e2] : mn1[2 * e2 - 4], mnh = e2 < 2 ? mn0[2 * e2 + 1] : mn1[2 * e2 - 3];
    out[2 * e2] = c_lo + mpl * (lo2f(up[e2]) - c_lo) + mnl * (lo2f(un[e2]) - c_lo);
    out[2 * e2 + 1] = c_hi + mph * (hi2f(up[e2]) - c_hi) + mnh * (hi2f(un[e2]) - c_hi);
  }
}

template <int NST, bool P3>
DI void scan_prologue8(const P& p, int sbase, int L, int hd, int dir, int pos0, int nsteps, int sb0, float* sv) {
  const int lane = threadIdx.x & 63, l31 = lane & 31, h = lane >> 5;
  const bf16_t* PRKV = (const bf16_t*)(p.ws + O_PRKV);
  const bf16_t* LR = (const bf16_t*)(p.ws + O_LR);
  const bf16_t* WUPT = (const bf16_t*)(p.ws + O_WUPT) + (size_t)(dir * 512 + hd * 64) * 64;
  const bf16_t* AUPT = (const bf16_t*)(p.ws + O_AUPT) + (size_t)(dir * 512 + hd * 64) * 64;
  float* bonus = (float*)(p.ws + O_BONUS);
  {
    int sl = sb0 + (l31 & 7); if (sl > nsteps - 1) sl = nsteps - 1;
    const int pos = dir ? pos0 - sl : pos0 + sl;
    const bf16_t* lrp = LR + (size_t)(sbase + pos) * 384 + dir * 64 + 8 * h;
#pragma unroll 1
    for (int mat = 0; mat < 2; ++mat) {
      const bf16_t* Wm = mat ? AUPT : WUPT;
      const float* bias = mat ? p.d_a0 : p.d_w0;
      f32x16 ac[2];
#pragma unroll
      for (int nt = 0; nt < 2; ++nt)
#pragma unroll
        for (int i = 0; i < 16; ++i) ac[nt][i] = 0.f;
#pragma unroll
      for (int ks = 0; ks < 4; ++ks) {
        const bf16x8 fa = *(const bf16x8*)(lrp + mat * 128 + 16 * ks);
#pragma unroll
        for (int nt = 0; nt < 2; ++nt) {
          const bf16x8 bw = *(const bf16x8*)(Wm + (size_t)(32 * nt + l31) * 64 + 16 * ks + 8 * h);
          ac[nt] = MFMA32(fa, bw, ac[nt]);
        }
      }
#pragma unroll
      for (int nt = 0; nt < 2; ++nt) {
        const int j = 32 * nt + l31;
        const float b0 = bias[dir * 512 + hd * 64 + j];
#pragma unroll
        for (int i = 0; i < 4; ++i) {
          const int st = sb0 + i + 4 * h;
          const float sg = 1.f / (1.f + __expf(-(b0 + ac[nt][i])));
          if (mat) sv[VK * NST * 64 + st * 64 + j] = sg;
          else ac[nt][i] = __expf(-0.6065306597126334f * sg);
        }
        if (!mat) {
          float g0 = ac[nt][0], g1 = g0 * ac[nt][1], g2 = g1 * ac[nt][2], g3 = g2 * ac[nt][3];
          const float tot_lo = __shfl(g3, l31);
          if (h) { g0 *= tot_lo; g1 *= tot_lo; g2 *= tot_lo; g3 *= tot_lo; }
          float* gd = sv + VA * NST * 64 + (sb0 + 4 * h) * 64 + j;
          gd[0] = g0; gd[64] = g1; gd[128] = g2; gd[192] = g3;
          if (h) sv[VW * NST * 64 + (sb0 >> 3) * 64 + vperm(j)] = g3;
        }
      }
    }
  }
  const int stp = lane >> 3, seg = lane & 7, c0 = hd * 64 + 8 * seg;
  const int s = sb0 + stp;
  const int ss = s < nsteps ? s : nsteps - 1;
  const int pos = dir ? pos0 - ss : pos0 + ss;
  float k[8], a[8], gam[8], gpr[8];
  shift8(PRKV, p, sbase, pos, L, 512, c0, k);
  {
    const f32x4v a0 = *(const f32x4v*)(sv + VK * NST * 64 + s * 64 + 8 * seg), a1 = *(const f32x4v*)(sv + VK * NST * 64 + s * 64 + 8 * seg + 4);
    const f32x4v g0 = *(const f32x4v*)(sv + VA * NST * 64 + s * 64 + 8 * seg), g1 = *(const f32x4v*)(sv + VA * NST * 64 + s * 64 + 8 * seg + 4);
    const int sp = stp > 0 ? s - 1 : s;
    const f32x4v q0 = *(const f32x4v*)(sv + VA * NST * 64 + sp * 64 + 8 * seg), q1 = *(const f32x4v*)(sv + VA * NST * 64 + sp * 64 + 8 * seg + 4);
#pragma unroll
    for (int e = 0; e < 4; ++e) {
      a[e] = a0[e]; a[4 + e] = a1[e]; gam[e] = g0[e]; gam[4 + e] = g1[e];
      gpr[e] = stp > 0 ? q0[e] : 1.f; gpr[4 + e] = stp > 0 ? q1[e] : 1.f;
    }
  }
  const f32x4v kk0 = *(const f32x4v*)(p.d_k_k + c0), kk1 = *(const f32x4v*)(p.d_k_k + c0 + 4);
  const f32x4v ka0 = *(const f32x4v*)(p.d_k_a + c0), ka1 = *(const f32x4v*)(p.d_k_a + c0 + 4);
  float kk[8], kd[8];
  float n2 = 0.f;
#pragma unroll
  for (int e = 0; e < 8; ++e) {
    kk[e] = k[e] * (e < 4 ? kk0[e] : kk1[e - 4]);
    n2 += kk[e] * kk[e];
    kd[e] = k[e] * (1.f + (a[e] - 1.f) * (e < 4 ? ka0[e] : ka1[e - 4]));
  }
  n2 += __shfl_xor(n2, 1); n2 += __shfl_xor(n2, 2); n2 += __shfl_xor(n2, 4);
  const float rn = rsqrtf(fmaxf(n2, 1e-24f));
#pragma unroll
  for (int e = 0; e < 8; ++e) {
    const int ix = s * 64 + vperm(8 * seg + e);
    const float kn = kk[e] * rn;
    const float ig = __builtin_amdgcn_rcpf(gam[e]);
    sv[VA * NST * 64 + ix] = -kn * gpr[e];
    sv[VB * NST * 64 + ix] = kn * a[e] * ig;
    sv[VK * NST * 64 + ix] = kd[e] * ig;
  }
  {
    float v[8];
    shift8(PRKV, p, sbase, pos, L, 1024, c0, v);
    *(f32x4v*)(sv + VV * NST * 64 + s * 64 + 8 * seg) = (f32x4v){v[0], v[1], v[2], v[3]};
    *(f32x4v*)(sv + VV * NST * 64 + s * 64 + 8 * seg + 4) = (f32x4v){v[4], v[5], v[6], v[7]};
  }
  if (P3) {
    float r[8];
    shift8(PRKV, p, sbase, pos, L, 0, c0, r);
    const f32x4v rk0 = *(const f32x4v*)(p.d_r_k + c0), rk1 = *(const f32x4v*)(p.d_r_k + c0 + 4);
    float bn = 0.f;
#pragma unroll
    for (int e = 0; e < 8; ++e) {
      sv[VR * NST * 64 + s * 64 + vperm(8 * seg + e)] = r[e] * gam[e];
      bn += r[e] * kd[e] * (e < 4 ? rk0[e] : rk1[e - 4]);
    }
    bn += __shfl_xor(bn, 1); bn += __shfl_xor(bn, 2); bn += __shfl_xor(bn, 4);
    if (s < nsteps && seg == 0) bonus[((size_t)(sbase + pos) * 8 + hd) * 2 + dir] = bn;
  }
}

DI unsigned scan_touch(const P& p, int sbase, int L, int hd, int dir, int posf  ) {
  const int lane = threadIdx.x & 63;
  const bf16_t* PRKV = (const bf16_t*)(p.ws + O_PRKV);
  const bf16_t* LR = (const bf16_t*)(p.ws + O_LR);
  const int lo = dir ? posf - 8 : posf - 1;
  const unsigned* ptr;
  if (lane < 30) { int row = lo + lane / 3; row = row < 0 ? 0 : (row > L - 1 ? L - 1 : row); ptr = (const unsigned*)(PRKV + (size_t)(sbase + row) * 1536 + (lane % 3) * 512 + hd * 64); }
  else { const int i2 = (lane - 30) & 15; int row = dir ? posf - (i2 >> 1) : posf + (i2 >> 1); row = row < 0 ? 0 : (row > L - 1 ? L - 1 : row); ptr = (const unsigned*)(LR + (size_t)(sbase + row) * 384 + (i2 & 1) * 128 + dir * 64); }
  return *ptr;
}

template <bool HALF> DI void scan1_body(const P& p, char* lds) {
  float* PQ = (float*)(p.ws + O_PQ);
  const int lane = threadIdx.x & 63, wave = __builtin_amdgcn_readfirstlane(threadIdx.x >> 6), slot = wave >> 1;
  constexpr int half = HALF ? 1 : 0;
  float* sv = (float*)lds + slot * (6 * 16 * 64);
  for (int g = blockIdx.x; g < 804; g += gridDim.x) {
    int seq, c, hp;
    if (g < 768) { const int lc = g >> 2; hp = g & 3; if (lc < 128) { seq = lc >> 4; c = lc & 15; } else { seq = 8; c = lc - 128; } }
    else { const int j = g - 768; hp = j & 3; seq = j >> 2; c = seq < 8 ? 16 : 64; }
    const int cgi = seq < 8 ? seq * 17 + c : 136 + c;
    const int hd = hp * 2 + (slot >> 1), dir = slot & 1;
    const int it = (cgi * 8 + hd) * 2 + dir;
    const int L = seq_len(seq), sbase = seq_base(seq);
    const int start = c * 256, end = min(L, start + 256), n = end - start;
    float S[64];
#pragma unroll
    for (int j = 0; j < 64; ++j) S[j] = (half == 0 && j == lane) ? 1.f : 0.f;
    for (int s0 = 0; s0 < n; s0 += 16) {
      const int ns = min(16, n - s0);
      const int pos0 = dir ? end - 1 - s0 : start + s0;
      __syncthreads();
      scan_prologue8<16, false>(p, sbase, L, hd, dir, pos0, ns, half * 8, sv);
      __syncthreads();
      unsigned tch = 0u;
      if (s0 + 16 < n) tch = scan_touch(p, sbase, L, hd, dir, dir ? pos0 - 16 - half * 8 : pos0 + 16 + half * 8);
      scan_steps<16, HALF, false>(S, sv, ns, lane, [](int, float) {});
      asm volatile("" :: "v"(tch));
    }
    float* dst = PQ + (size_t)it * 8192 + (size_t)(half * 64 + lane) * 64;
#pragma unroll
    for (int q = 0; q < 16; ++q) *(float4*)(dst + q * 4) = make_float4(S[q * 4], S[q * 4 + 1], S[q * 4 + 2], S[q * 4 + 3]);
  }
}

DI void phase_scan1(const P& p, char* lds) {
  const int w_ = __builtin_amdgcn_readfirstlane(threadIdx.x >> 6);
  if ((w_ ^ (w_ >> 2)) & 1) scan1_body<true>(p, lds); else scan1_body<false>(p, lds);
}

DI void phase_scan2(const P& p, char* lds) {
  float* Ss = (float*)lds;
  float* Ps = Ss + 64 * 65;
  float* PQ = (float*)(p.ws + O_PQ);
  const int tid = threadIdx.x, lane = tid & 63, wave = __builtin_amdgcn_readfirstlane(tid >> 6), l31 = lane & 31, h = lane >> 5;
  const int r0 = 32 * (wave >> 1), c0 = 32 * (wave & 1);
  for (int it = blockIdx.x; it < 144; it += gridDim.x) {
    const int dir = it & 1, hd = (it >> 1) & 7, seq = it >> 4;
    const int nch = seq < 8 ? 17 : 65, cg0 = seq < 8 ? seq * 17 : 136;
    f32x16 S;
#pragma unroll
    for (int i = 0; i < 16; ++i) S[i] = 0.f;
    f32x4v pn0, pn1;
    {
      const int c = dir ? nch - 1 : 0;
      const float* Pg = PQ + (size_t)(((cg0 + c) * 8 + hd) * 2 + dir) * 8192;
      pn0 = *(const f32x4v*)(Pg + tid * 4); pn1 = *(const f32x4v*)(Pg + (512 + tid) * 4);
    }
    for (int cc = 0; cc < nch; ++cc) {
      const int c = dir ? nch - 1 - cc : cc;
      float* Qg = PQ + (size_t)(((cg0 + c) * 8 + hd) * 2 + dir) * 8192 + 4096;
      __syncthreads();
      { const int m = tid >> 4, cq = (tid & 15) * 4; *(f32x4v*)(Ps + m * 68 + cq) = pn0; *(f32x4v*)(Ps + (m + 32) * 68 + cq) = pn1; }
      f32x16 acc;
      if (wave < 4) {
#pragma unroll
        for (int i = 0; i < 16; ++i) {
          const int row = r0 + (i & 3) + 8 * (i >> 2) + 4 * h;
          Ss[row * 65 + c0 + l31] = S[i];
          float* qp = Qg + row * 64 + c0 + l31;
          acc[i] = *qp;
          *qp = S[i];
        }
      }
      if (cc + 1 < nch) {
        const int c2 = dir ? nch - 2 - cc : cc + 1;
        const float* Pg2 = PQ + (size_t)(((cg0 + c2) * 8 + hd) * 2 + dir) * 8192;
        pn0 = *(const f32x4v*)(Pg2 + tid * 4); pn1 = *(const f32x4v*)(Pg2 + (512 + tid) * 4);
      }
      __syncthreads();
      if (wave < 4) {
#pragma unroll 8
        for (int kk = 0; kk < 32; ++kk) {
          const float av = Ss[(r0 + l31) * 65 + 2 * kk + h];
          const float bv = Ps[(2 * kk + h) * 68 + c0 + l31];
          acc = __builtin_amdgcn_mfma_f32_32x32x2f32(av, bv, acc, 0, 0, 0);
        }
        S = acc;
      }
    }
  }
}

DI void phase_scan3(const P& p, char* lds) {
  const float* PQ = (const float*)(p.ws + O_PQ);
  bf16_t* MIX = (bf16_t*)(p.ws + O_MIX);
  bf16_t* OB = (bf16_t*)(p.ws + O_OB);
  const int lane = threadIdx.x & 63, wave = __builtin_amdgcn_readfirstlane(threadIdx.x >> 6);
  float* sv = (float*)lds + wave * (6 * 8 * 64);
  const bool bal = gridDim.x == 256;
  const int NW = gridDim.x * 8, gw = blockIdx.x * 8 + wave;
  for (int k = 0; ; ++k) {
    int oi;
    if (bal) {
      if (k == 0) oi = gw;
      else if (k == 1) { if (wave >= 4) continue; oi = 2048 + blockIdx.x * 4 + wave; }
      else if (k == 2) { if (wave != 7 || blockIdx.x >= 144) break; oi = 3072 + blockIdx.x; }
      else break;
    } else { oi = gw + k * NW; if (oi >= 3216) break; }
    int seq, c, hd, dir;
    if (oi < 3072) { const int lc = oi >> 4; hd = (oi >> 1) & 7; dir = oi & 1; if (lc < 128) { seq = lc >> 4; c = lc & 15; } else { seq = 8; c = lc - 128; } }
    else { const int j = oi - 3072; hd = (j >> 1) & 7; dir = j & 1; seq = j >> 4; c = seq < 8 ? 16 : 64; }
    const int it = ((seq < 8 ? seq * 17 + c : 136 + c) * 8 + hd) * 2 + dir;
    const int L = seq_len(seq), sbase = seq_base(seq);
    const int start = c * 256, end = min(L, start + 256), n = end - start;
    float S[64];
    {
      const float* src = PQ + (size_t)it * 8192 + 4096 + lane * 64;
#pragma unroll
      for (int q = 0; q < 16; ++q) { float4 t = *(const float4*)(src + q * 4); S[q * 4] = t.x; S[q * 4 + 1] = t.y; S[q * 4 + 2] = t.z; S[q * 4 + 3] = t.w; }
    }
    for (int s0 = 0; s0 < n; s0 += 8) {
      const int ns = min(8, n - s0);
      const int pos0 = dir ? end - 1 - s0 : start + s0;
      scan_prologue8<8, true>(p, sbase, L, hd, dir, pos0, ns, 0, sv);
      unsigned tch = 0u;
      if (s0 + 8 < n) tch = scan_touch(p, sbase, L, hd, dir, dir ? pos0 - 8 : pos0 + 8);
      scan_steps<8, true, true>(S, sv, ns, lane, [&](int st, float o) {
        const int pos = dir ? pos0 - st : pos0 + st;
        const size_t sr = (size_t)(sbase + pos);
        if (dir == 0) MIX[sr * 1024 + 512 + hd * 64 + lane] = f2bf(o);
        else OB[sr * 512 + hd * 64 + lane] = f2bf(o);
      });
      asm volatile("" :: "v"(tch));
    }
  }
}

DI void phase_rwkv_final(const P& p) {
  const int lane = threadIdx.x & 63, gw = (blockIdx.x * NTH + threadIdx.x) >> 6, nw = (gridDim.x * NTH) >> 6;
  bf16_t* MIX = (bf16_t*)(p.ws + O_MIX);
  const bf16_t* OB = (const bf16_t*)(p.ws + O_OB);
  const bf16_t* G = (const bf16_t*)(p.ws + O_G);
  const bf16_t* PRKV = (const bf16_t*)(p.ws + O_PRKV);
  const float* bonus = (const float*)(p.ws + O_BONUS);
  const int hd = lane >> 3, c0 = lane * 8;
  float mp[8], mn[8], lg[8], lb[8];
#pragma unroll
  for (int j = 0; j < 8; ++j) { mp[j] = p.mu_prev[1024 + c0 + j]; mn[j] = p.mu_next[1024 + c0 + j]; lg[j] = p.d_ln_g[c0 + j]; lb[j] = p.d_ln_b[c0 + j]; }
  for (int sr = gw; sr < T_; sr += nw) {
    int pos; int b = seq_of(sr, pos);
    const int L = seq_len(b);
    const u32x4 uf = *(const u32x4*)(MIX + (size_t)sr * 1024 + 512 + c0);
    const u32x4 ub = *(const u32x4*)(OB + (size_t)sr * 512 + c0);
    const u32x4 ug = *(const u32x4*)(G + (size_t)sr * 512 + c0);
    const bf16_t* vr = PRKV + (size_t)sr * 1536 + 1024 + c0;
    const u32x4 vc = *(const u32x4*)vr;
    const u32x4 vp = *(const u32x4*)(pos > 0 ? vr - 1536 : vr);
    const u32x4 vn = *(const u32x4*)(pos < L - 1 ? vr + 1536 : vr);
    const float2 bn = *(const float2*)(bonus + ((size_t)sr * 8 + hd) * 2);
    const bool hp = pos > 0, hn = pos < L - 1;
    float o[8], gg[8], vsh[8];
    float sm = 0.f;
#pragma unroll
    for (int j = 0; j < 4; ++j) {
      o[2 * j] = lo2f(uf[j]) + lo2f(ub[j]); o[2 * j + 1] = hi2f(uf[j]) + hi2f(ub[j]);
      gg[2 * j] = lo2f(ug[j]); gg[2 * j + 1] = hi2f(ug[j]);
      sm += o[2 * j] + o[2 * j + 1];
      const float c_lo = lo2f(vc[j]), c_hi = hi2f(vc[j]);
      const float p_lo = hp ? lo2f(vp[j]) : 0.f, p_hi = hp ? hi2f(vp[j]) : 0.f;
      const float n_lo = hn ? lo2f(vn[j]) : 0.f, n_hi = hn ? hi2f(vn[j]) : 0.f;
      vsh[2 * j] = c_lo + mp[2 * j] * (p_lo - c_lo) + mn[2 * j] * (n_lo - c_lo);
      vsh[2 * j + 1] = c_hi + mp[2 * j + 1] * (p_hi - c_hi) + mn[2 * j + 1] * (n_hi - c_hi);
    }
    sm += __shfl_xor(sm, 1); sm += __shfl_xor(sm, 2); sm += __shfl_xor(sm, 4);
    const float mean = sm * (1.f / 64.f);
    float vs = 0.f;
#pragma unroll
    for (int j = 0; j < 8; ++j) { float dlt = o[j] - mean; vs += dlt * dlt; }
    vs += __shfl_xor(vs, 1); vs += __shfl_xor(vs, 2); vs += __shfl_xor(vs, 4);
    const float rstd = rsqrtf(vs * (1.f / 64.f) + 64e-5f);
    const float bsum = bn.x + bn.y;
    float y[8];
#pragma unroll
    for (int j = 0; j < 8; ++j) y[j] = ((o[j] - mean) * rstd * lg[j] + lb[j] + bsum * vsh[j]) * gg[j];
    *(uint4*)(MIX + (size_t)sr * 1024 + 512 + c0) = make_uint4(pack2(y[0], y[1]), pack2(y[2], y[3]), pack2(y[4], y[5]), pack2(y[6], y[7]));
  }
}

#define XB_TMO      128
#define XB_XCNT(j)  (256  + 64 * (j))
#define XB_XSUB(j)  (1280 + 64 * (j))
#define XB_XGEN(j)  (2304 + 64 * (j))
#define XB_TOP      3328
#define XB_TOPGEN   3392
#define XCD_BAR_WORDS 3456
#define XB_SPIN_CAP (1u << 23)
#define LAS __attribute__((address_space(3)))

__device__ __forceinline__ unsigned xb_ld(unsigned* p)              { return __hip_atomic_load(p, __ATOMIC_RELAXED, __HIP_MEMORY_SCOPE_AGENT); }
__device__ __forceinline__ unsigned xb_add(unsigned* p, unsigned v) { return __hip_atomic_fetch_add(p, v, __ATOMIC_RELAXED, __HIP_MEMORY_SCOPE_AGENT); }
__device__ __forceinline__ unsigned xb_xcc_id() { return (unsigned)__builtin_amdgcn_s_getreg((3 << 11) | 20) & 0xFu; }
#define XB_SPIN(cond, bar) do { unsigned _sp = 0; while (cond) { __builtin_amdgcn_s_sleep(1); \
    if ((++_sp & 255u) == 0u) { if (xb_ld(&(bar)[XB_TMO])) break; if (_sp > XB_SPIN_CAP) { atomicAdd(&(bar)[XB_TMO], 1u); break; } } } } while (0)

struct XcdBarrier {
    unsigned* bar; unsigned x;
    volatile LAS unsigned* st;
};

__device__ __forceinline__ XcdBarrier xcd_barrier_post(unsigned* bar, volatile LAS unsigned* st) {
    XcdBarrier b; b.bar = bar; b.x = xb_xcc_id(); b.st = st;
    if (threadIdx.x == 0) (void)xb_add(&bar[XB_XCNT(b.x)], 1u);
    return b;
}
__device__ __forceinline__ void xcd_barrier_complete(unsigned* bar, unsigned x, unsigned& nloc, unsigned& nx) {
    const unsigned G = gridDim.x * gridDim.y * gridDim.z;
    unsigned sum, cnt, mine, sp = 0u;
    for (;;) {
        sum = 0u; cnt = 0u; mine = 0u;
#pragma unroll
        for (unsigned j = 0; j < 16; ++j) { const unsigned c = xb_ld(&bar[XB_XCNT(j)]); sum += c; cnt += (c > 0u) ? 1u : 0u; mine = (j == x) ? c : mine; }
        if (sum == G) break;
        __builtin_amdgcn_s_sleep(1);
        if ((++sp & 255u) == 0u) { if (xb_ld(&bar[XB_TMO])) break; if (sp > XB_SPIN_CAP) { atomicAdd(&bar[XB_TMO], 1u); break; } }
    }
    nloc = mine > 0u ? mine : 1u; nx = cnt > 0u ? cnt : 1u;
}

__device__ __forceinline__ void xcd_barrier(const XcdBarrier& b) {
    asm volatile("s_waitcnt vmcnt(0)" ::: "memory");
    __syncthreads();
    if (threadIdx.x == 0) {
        unsigned* bar = b.bar;
        __builtin_amdgcn_s_waitcnt(0);
        unsigned nloc = b.st[0], nx = b.st[1];
        if (nloc == 0u) { xcd_barrier_complete(bar, b.x, nloc, nx); b.st[0] = nloc; b.st[1] = nx; }
        const unsigned old = xb_add(&bar[XB_XSUB(b.x)], 1u);
        const unsigned gen = old / nloc;
        if (old + 1u == (gen + 1u) * nloc) {
            __builtin_amdgcn_fence(__ATOMIC_RELEASE, "agent");
            asm volatile("s_waitcnt vmcnt(0)" ::: "memory");
            const unsigned og = xb_add(&bar[XB_TOP], 1u);
            const unsigned tg = og / nx;
            if (og + 1u == (tg + 1u) * nx) xb_add(&bar[XB_TOPGEN], 1u);
            else XB_SPIN(xb_ld(&bar[XB_TOPGEN]) == tg, bar);
            __builtin_amdgcn_fence(__ATOMIC_ACQUIRE, "agent");
            xb_add(&bar[XB_XGEN(b.x)], 1u);
            asm volatile("s_waitcnt vmcnt(0)" ::: "memory");
        } else {
            XB_SPIN(xb_ld(&bar[XB_XGEN(b.x)]) == gen, bar);
            __builtin_amdgcn_fence(__ATOMIC_ACQUIRE, "agent");
            asm volatile("s_waitcnt vmcnt(0)" ::: "memory");
        }
    }
    __syncthreads();
}

constexpr int NPHASE = 23;
__global__ void __launch_bounds__(NTH, 2) mega(P p) {
  extern __shared__ __attribute__((aligned(16))) unsigned char shm[];
  char* lds = (char*)shm;
  char* ws = p.ws;
  if (threadIdx.x == 0) *(uint4*)(shm + 131072) = make_uint4(0u, 0u, 0u, 0u);
  __syncthreads();
  const XcdBarrier xb = xcd_barrier_post((unsigned*)(ws + O_BAR), (volatile LAS unsigned*)(shm + 131072));
#ifndef DUP_MASK
#define DUP_MASK 0u
#endif
#define RUN(k, call) if (p.ph0 <= k && k < p.ph1) { call; if (k + 1 < p.ph1) { if (k == 0) cg::this_grid().sync(); else xcd_barrier(xb); } }
  RUN(0, phase_prep(p))
  RUN(1, phase_gemm_big((const bf16_t*)(ws + O_HN), (const bf16_t*)(ws + O_WIN0), 1536, 1024, (bf16_t*)(ws + O_PROJ0), 1536, 0, ws, shm))
  RUN(2, phase_prepA(p, lds))
  RUN(3, phase_attnA(p, lds))
  RUN(4, phase_fnet_gemm(p, lds))
  RUN(5, phase_gemm_big((const bf16_t*)(ws + O_MIX), (const bf16_t*)(ws + O_WOUT0), 1024, 1024, (bf16_t*)(ws + O_HN), 1024, 0, ws, shm))
  RUN(6, phase_resnorm(p, p.post_mix_g, p.pre_ffn_g, true))
  RUN(7, phase_gemm_gateup((const bf16_t*)(ws + O_HN), (const bf16_t*)(ws + O_WGU0), (bf16_t*)(ws + O_ACT), shm))
  RUN(8, phase_gemm_big((const bf16_t*)(ws + O_ACT), (const bf16_t*)(ws + O_WD0), 1024, DFF, (bf16_t*)(ws + O_HN), 1024, 0, ws, shm))
  RUN(9, phase_resnorm(p, p.post_ffn_g, p.pre_mix_g + 1024))
  RUN(10, phase_gemm_big((const bf16_t*)(ws + O_HN), (const bf16_t*)(ws + O_WIN1), 2816, 1024, nullptr, 0, 1, ws, shm))
  RUN(11, phase_prepC(p, lds))
  RUN(12, phase_attnC(p, lds))
  RUN(13, phase_scan1(p, lds))
  RUN(14, (phase_scan2(p, lds), late_weights(p)))
  RUN(15, phase_scan3(p, lds))
  RUN(16, phase_gemm_small((const bf16_t*)(ws + O_LR) + 256, 384, (const bf16_t*)(ws + O_GUP), 512, 128, (bf16_t*)(ws + O_G), 512, lds))
  RUN(17, phase_rwkv_final(p))
  RUN(18, phase_gemm_big((const bf16_t*)(ws + O_MIX), (const bf16_t*)(ws + O_WOUT1), 1024, 1024, (bf16_t*)(ws + O_HN), 1024, 0, ws, shm))
  RUN(19, phase_resnorm(p, p.post_mix_g + 1024, p.pre_ffn_g + 1024))
  RUN(20, phase_gemm_gateup((const bf16_t*)(ws + O_HN), (const bf16_t*)(ws + O_WGU1), (bf16_t*)(ws + O_ACT), shm))
  RUN(21, phase_gemm_big((const bf16_t*)(ws + O_ACT), (const bf16_t*)(ws + O_WD1), 1024, DFF, (bf16_t*)(ws + O_HN), 1024, 0, ws, shm))
  RUN(22, phase_resnorm(p, p.post_ffn_g + 1024, nullptr))
#undef RUN
}

extern "C" void kernel_launch(void* const* d_in, const int* in_sizes, int n_in, void* d_out, int out_size, void* d_ws, size_t ws_size,
                              hipStream_t stream) {
  static int grid_blocks = 0;
  if (!grid_blocks) {
    int dev = 0, cus = 0, per_cu = 0;
    (void)hipGetDevice(&dev);
    (void)hipDeviceGetAttribute(&cus, hipDeviceAttributeMultiprocessorCount, dev);
    if (hipFuncSetAttribute((const void*)mega, hipFuncAttributeMaxDynamicSharedMemorySize, LDS_BYTES) != hipSuccess) fprintf(stderr, "hipFuncSetAttribute failed\n");
    if (hipOccupancyMaxActiveBlocksPerMultiprocessor(&per_cu, (const void*)mega, NTH, LDS_BYTES) != hipSuccess || per_cu < 1) {
      fprintf(stderr, "occupancy query says %d\n", per_cu);
      (void)hipGetLastError();
    }
    grid_blocks = cus;
  }
  if (ws_size < O_BAR + CTL_BYTES) { fprintf(stderr, "workspace too small\n"); return; }
  if (hipMemsetAsync((char*)d_ws + O_BAR, 0, CTL_BYTES, stream) != hipSuccess) { fprintf(stderr, "memset failed\n"); return; }
  P p{};
  const float** f = (const float**)&p;
  for (int i = 0; i < 32; ++i) f[i] = (const float*)d_in[i];
  p.out = (float*)d_out;
  p.ws = (char*)d_ws;
#if FUSED
  p.ph0 = 0; p.ph1 = NPHASE;
  void* args[] = {&p};
  hipError_t e = hipLaunchCooperativeKernel((void*)mega, dim3(grid_blocks), dim3(NTH), args, LDS_BYTES, stream);
  if (e != hipSuccess) fprintf(stderr, "cooperative launch failed: %s (grid %d)\n", hipGetErrorString(e), grid_blocks);
#else
  for (int ph = 0; ph < NPHASE; ++ph) {
    p.ph0 = ph; p.ph1 = ph + 1;
    hipLaunchKernelGGL(mega, dim3(grid_blocks), dim3(NTH), LDS_BYTES, stream, p);
  }
#endif
}
```

```cpp
#include <hip/hip_runtime.h>
#include <hip/hip_cooperative_groups.h>
#include <cstdio>
namespace cg = cooperative_groups;

#ifndef FUSED
#define FUSED 1
#endif

typedef unsigned short bf16_t;
using bf16x8 = __attribute__((ext_vector_type(8))) short;
using s16x4 = __attribute__((ext_vector_type(4))) short;
using f32x16 = __attribute__((ext_vector_type(16))) float;
using u32x4 = __attribute__((ext_vector_type(4))) unsigned;
using f32x4v = __attribute__((ext_vector_type(4))) float;
#define DI __device__ __forceinline__
#define MFMA32(a, b, c) __builtin_amdgcn_mfma_f32_32x32x16_bf16((a), (b), (c), 0, 0, 0)
constexpr int NTH = 512;
constexpr int LDS_BYTES = 131072 + 16;

constexpr int DM_ = 1024;
constexpr int T_ = 49296;
constexpr int TP_ = 49408;
constexpr int NT_ = TP_ / 128;
constexpr int DFF = 2816;
constexpr float EPS = 1e-6f;
constexpr float LOG2E = 1.4426950408889634f;

constexpr size_t SZ_ROW1024 = (size_t)TP_ * 1024 * 2;
constexpr size_t O_WIN0 = 0;
constexpr size_t O_WOUT0 = O_WIN0 + (size_t)1536 * 1024 * 2;
constexpr size_t O_WGU0 = O_WOUT0 + (size_t)1024 * 1024 * 2;
constexpr size_t O_WD0 = O_WGU0 + (size_t)5632 * 1024 * 2;
constexpr size_t O_DM257 = O_WD0 + (size_t)1024 * 2816 * 2;
constexpr size_t O_DM1025 = O_DM257 + (size_t)384 * 576 * 2;
constexpr size_t O_WIN1 = O_DM1025 + (size_t)1152 * 2112 * 2;
constexpr size_t O_WOUT1 = O_WIN1 + (size_t)2816 * 1024 * 2;
constexpr size_t O_WGU1 = O_WOUT1 + (size_t)1024 * 1024 * 2;
constexpr size_t O_WD1 = O_WGU1 + (size_t)5632 * 1024 * 2;
constexpr size_t O_GUP = O_WD1 + (size_t)1024 * 2816 * 2;
constexpr size_t O_RA = O_GUP + (size_t)512 * 128 * 2;
constexpr size_t O_RB = O_RA + SZ_ROW1024;
constexpr size_t O_RC = O_RB + (size_t)TP_ * 2816 * 2;
constexpr size_t O_META = O_RC + SZ_ROW1024;
constexpr size_t O_WC = O_META + (size_t)144 * 1024 * 4;
constexpr size_t O_WUPT = O_WC + (size_t)4 * 64 * 128 * 4;
constexpr size_t O_AUPT = O_WUPT + (size_t)2 * 512 * 64 * 2;
constexpr size_t O_END = O_AUPT + (size_t)2 * 512 * 64 * 2;
constexpr size_t O_HN = O_RA;
constexpr size_t O_VTA = O_RA;
constexpr size_t O_LR = O_RA;
constexpr size_t O_BONUS = O_RA + (size_t)TP_ * 384 * 2;
constexpr size_t O_VTC = O_BONUS + (size_t)T_ * 16 * 4;
constexpr size_t O_OB = O_RA + (size_t)TP_ * 512 * 2;
constexpr size_t O_PROJ0 = O_RB;
constexpr size_t O_ZB = O_PROJ0 + (size_t)TP_ * 1536 * 2;
constexpr size_t O_Y = O_ZB + (size_t)TP_ * 512 * 2;
constexpr size_t O_ACT = O_RB;
constexpr size_t O_PRKV = O_RB;
constexpr size_t O_PC = O_PRKV + (size_t)TP_ * 1536 * 2;
constexpr size_t O_PLOW = O_PC + (size_t)TP_ * 768 * 2;
constexpr size_t O_PQ = O_PC;
constexpr size_t O_G = O_PC;
constexpr size_t O_MIX = O_RC;
static_assert(O_VTC + (size_t)49728 * 128 * 2 <= O_RB, "vtc");
static_assert(O_Y + (size_t)(8 * 16 * 256 * 576 + 16 * 256 * 2112) * 2 <= O_RC, "y");
static_assert(O_PQ + (size_t)3216 * 32768 <= O_RC, "pq");
constexpr size_t O_BAR = (O_END + 255) / 256 * 256;
constexpr size_t O_CNT = O_BAR + 3456 * 4;
constexpr size_t CTL_BYTES = 3456 * 4 + 4 * 256;
static_assert(O_BAR + CTL_BYTES <= (size_t)536870912, "ws");

struct P {
  const float *x_prompt, *x_sample, *meta, *pre_mix_g, *post_mix_g, *pre_ffn_g, *post_ffn_g;
  const float *even_w_in, *even_w_out, *a_q_gain, *a_k_gain, *b_norm_g, *b_w, *b_b;
  const float *odd_w_in, *odd_w_out, *c_sink, *mu_prev, *mu_next, *d_w0, *d_w_up, *d_a0, *d_a_up, *d_g_up;
  const float *d_k_k, *d_k_a, *d_r_k, *d_ln_g, *d_ln_b, *ffn_gate, *ffn_up, *ffn_down;
  float* out;
  char* ws;
  int ph0, ph1;
};

typedef float f32x2 __attribute__((ext_vector_type(2)));
typedef __bf16 bf16x2_t __attribute__((ext_vector_type(2)));
DI bf16_t f2bf(float x) { return __builtin_bit_cast(bf16_t, (__bf16)x); }
DI float bf2f(bf16_t b) { return __uint_as_float(((unsigned)b) << 16); }
DI unsigned pack2(float a, float b) { f32x2 v = {a, b}; return __builtin_bit_cast(unsigned, __builtin_convertvector(v, bf16x2_t)); }
DI float lo2f(unsigned u) { return __uint_as_float(u << 16); }
DI float hi2f(unsigned u) { return __uint_as_float(u & 0xffff0000u); }
DI float wave_sum(float v) {
  for (int o = 32; o > 0; o >>= 1) v += __shfl_xor(v, o);
  return v;
}
DI int seq_of(int sr, int& pos) {
  if (sr < 32896) { int b = sr / 4112; pos = sr - b * 4112; return b; }
  pos = sr - 32896; return 8;
}
DI int seq_len(int b) { return b < 8 ? 4112 : 16400; }
DI int seq_base(int b) { return b < 8 ? b * 4112 : 32896; }
DI float* hrow(const P& p, int sr) {
  int pos; int b = seq_of(sr, pos);
  if (pos < 16) return (float*)(p.ws + O_META) + (size_t)(b * 16 + pos) * 1024;
  return p.out + ((size_t)(b < 8 ? b * 4096 : 32768) + (pos - 16)) * 1024;
}
DI float sigmoidf_(float x) { return 1.f / (1.f + expf(-x)); }

DI void transpose_w(const float* W, int K, int ldw, int N, bf16_t* Wt, int mode, const float* W2, int gtid, int gsz) {
  int nk8 = K / 8;
  long total = (long)N * nk8;
  for (long it = gtid; it < total; it += gsz) {
    int n = (int)(it % N), k8 = (int)(it / N);
    const float* src = W;
    int c = n;
    if (mode == 1) {
      int blk = n >> 8, w = n & 255;
      c = blk * 128 + (w & 127);
      if (w >= 128) src = W2;
    }
    unsigned r[4];
#pragma unroll
    for (int j = 0; j < 4; ++j) {
      float a = src[(size_t)(k8 * 8 + 2 * j) * ldw + c];
      float b = src[(size_t)(k8 * 8 + 2 * j + 1) * ldw + c];
      r[j] = pack2(a, b);
    }
    *(uint4*)(Wt + (size_t)n * K + k8 * 8) = make_uint4(r[0], r[1], r[2], r[3]);
  }
}

DI void late_weights(const P& p) {
  char* ws = p.ws;
  int gtid, gsz;
  if (gridDim.x > 144 + 16) { if (blockIdx.x < 144) return; gtid = (blockIdx.x - 144) * NTH + threadIdx.x; gsz = (gridDim.x - 144) * NTH; }
  else { gtid = blockIdx.x * NTH + threadIdx.x; gsz = gridDim.x * NTH; }
  transpose_w(p.odd_w_out, 1024, 1024, 1024, (bf16_t*)(ws + O_WOUT1), 0, nullptr, gtid, gsz);
  transpose_w(p.ffn_gate + (size_t)1024 * DFF, 1024, DFF, 5632, (bf16_t*)(ws + O_WGU1), 1, p.ffn_up + (size_t)1024 * DFF, gtid, gsz);
  transpose_w(p.ffn_down + (size_t)DFF * 1024, DFF, 1024, 1024, (bf16_t*)(ws + O_WD1), 0, nullptr, gtid, gsz);
}

DI void phase_prep(const P& p) {
  const int gtid = blockIdx.x * NTH + threadIdx.x, gsz = gridDim.x * NTH;
  char* ws = p.ws;
  transpose_w(p.even_w_in, 1024, 1536, 1536, (bf16_t*)(ws + O_WIN0), 0, nullptr, gtid, gsz);
  transpose_w(p.even_w_out, 1024, 1024, 1024, (bf16_t*)(ws + O_WOUT0), 0, nullptr, gtid, gsz);
  transpose_w(p.odd_w_in, 1024, 2688, 2688, (bf16_t*)(ws + O_WIN1), 0, nullptr, gtid, gsz);
  transpose_w(p.ffn_gate, 1024, DFF, 5632, (bf16_t*)(ws + O_WGU0), 1, p.ffn_up, gtid, gsz);
  transpose_w(p.ffn_down, DFF, 1024, 1024, (bf16_t*)(ws + O_WD0), 0, nullptr, gtid, gsz);
  transpose_w(p.d_g_up, 128, 512, 512, (bf16_t*)(ws + O_GUP), 0, nullptr, gtid, gsz);
  for (int d = 0; d < 2; ++d) {
    transpose_w(p.d_w_up + (size_t)d * 64 * 512, 64, 512, 512, (bf16_t*)(ws + O_WUPT) + (size_t)d * 512 * 64, 0, nullptr, gtid, gsz);
    transpose_w(p.d_a_up + (size_t)d * 64 * 512, 64, 512, 512, (bf16_t*)(ws + O_AUPT) + (size_t)d * 512 * 64, 0, nullptr, gtid, gsz);
  }
  for (int it = gtid; it < 128 * 1024 / 8; it += gsz) *(uint4*)((bf16_t*)(ws + O_WIN1) + (size_t)2688 * 1024 + (size_t)it * 8) = make_uint4(0, 0, 0, 0);
  for (int which = 0; which < 2; ++which) {
    const int M = which ? 1025 : 257, MP = which ? 1152 : 384, KP = which ? 2112 : 576;
    bf16_t* dm = (bf16_t*)(ws + (which ? O_DM1025 : O_DM257));
    for (int it = gtid; it < MP * KP; it += gsz) {
      int r = it / KP, c = it - r * KP;
      float v = 0.f;
      if (r < M && c < 2 * M) {
        int n2 = c < M ? c : c - M;
        int m = (r * n2) % M;
        float s, co;
        sincospif(2.0f * (float)m / (float)M, &s, &co);
        v = c < M ? co : s;
      }
      dm[it] = f2bf(v);
    }
  }
  for (int it = gtid; it < 4 * 64 * 128; it += gsz) {
    int o = it & 127, c = (it >> 7) & 63, g = it >> 13;
    int d = o & 63;
    float acc = 0.f;
    for (int c2 = 0; c2 < 64; ++c2) {
      float s, co;
      sincospif((float)((c * c2) & 63) / 32.f, &s, &co);
      float w = p.b_w[(g * 64 + c2) * 64 + d];
      acc += (o < 64 ? co : -s) * w;
    }
    ((float*)(ws + O_WC))[it] = acc;
  }
  const int lane = threadIdx.x & 63, gw = gtid >> 6, nw = gsz >> 6;
  bf16_t* HN = (bf16_t*)(ws + O_HN);
  for (int sr = gw; sr < TP_; sr += nw) {
    if (sr >= T_) {
#pragma unroll
      for (int q = 0; q < 2; ++q) *(uint4*)(HN + (size_t)sr * 1024 + q * 512 + lane * 8) = make_uint4(0, 0, 0, 0);
      continue;
    }
    int pos; int b = seq_of(sr, pos);
    const float* src = pos < 16 ? p.meta + pos * 1024
                                : (b < 8 ? p.x_prompt + ((size_t)b * 4096 + pos - 16) * 1024 : p.x_sample + (size_t)(pos - 16) * 1024);
    float4 v[4];
    float ss = 0.f;
#pragma unroll
    for (int q = 0; q < 4; ++q) {
      v[q] = *(const float4*)(src + q * 256 + lane * 4);
      ss += v[q].x * v[q].x + v[q].y * v[q].y + v[q].z * v[q].z + v[q].w * v[q].w;
    }
    ss = wave_sum(ss);
    float rs = rsqrtf(ss * (1.f / 1024.f) + EPS);
#pragma unroll
    for (int q = 0; q < 4; ++q) {
      float4 g = *(const float4*)(p.pre_mix_g + q * 256 + lane * 4);
      uint2 o = make_uint2(pack2(v[q].x * rs * g.x, v[q].y * rs * g.y), pack2(v[q].z * rs * g.z, v[q].w * rs * g.w));
      *(uint2*)(HN + (size_t)sr * 1024 + q * 256 + lane * 4) = o;
    }
  }
}

DI void gemm_tile(const bf16_t* __restrict__ A, int lda, const bf16_t* __restrict__ B, int ldb, int K, char* lds, f32x16 (&acc)[2][2]) {
  const int tid = threadIdx.x & 255, lane = tid & 63, wave = tid >> 6, wm = wave >> 1, wn = wave & 1;
  const int l31 = lane & 31, h = lane >> 5;
  bf16_t* As = (bf16_t*)lds;
  bf16_t* Bs = As + 128 * 72;
#pragma unroll
  for (int a = 0; a < 2; ++a)
#pragma unroll
    for (int b = 0; b < 2; ++b)
#pragma unroll
      for (int i = 0; i < 16; ++i) acc[a][b][i] = 0.f;
  const int lr = tid >> 3, lc = (tid & 7) * 8;
  const bf16_t* Ag = A + (size_t)lr * lda + lc;
  const bf16_t* Bg = B + (size_t)lr * ldb + lc;
  u32x4 ra[4], rb[4];
#pragma unroll
  for (int q = 0; q < 4; ++q) {
    ra[q] = *(const u32x4*)(Ag + (size_t)(32 * q) * lda);
    rb[q] = *(const u32x4*)(Bg + (size_t)(32 * q) * ldb);
  }
#pragma unroll
  for (int q = 0; q < 4; ++q) {
    *(u32x4*)(As + (lr + 32 * q) * 72 + lc) = ra[q];
    *(u32x4*)(Bs + (lr + 32 * q) * 72 + lc) = rb[q];
  }
  __syncthreads();
  const int nk = K >> 6;
  for (int kt = 0; kt < nk; ++kt) {
    if (kt + 1 < nk) {
#pragma unroll
      for (int q = 0; q < 4; ++q) {
        ra[q] = *(const u32x4*)(Ag + (size_t)(32 * q) * lda + (kt + 1) * 64);
        rb[q] = *(const u32x4*)(Bg + (size_t)(32 * q) * ldb + (kt + 1) * 64);
      }
    }
#pragma unroll
    for (int ks = 0; ks < 4; ++ks) {
      bf16x8 a[2], b[2];
#pragma unroll
      for (int t = 0; t < 2; ++t) {
        a[t] = *(const bf16x8*)(As + (wm * 64 + t * 32 + l31) * 72 + ks * 16 + 8 * h);
        b[t] = *(const bf16x8*)(Bs + (wn * 64 + t * 32 + l31) * 72 + ks * 16 + 8 * h);
      }
#pragma unroll
      for (int mt = 0; mt < 2; ++mt)
#pragma unroll
        for (int nt = 0; nt < 2; ++nt) acc[mt][nt] = MFMA32(a[mt], b[nt], acc[mt][nt]);
    }
    __syncthreads();
    if (kt + 1 < nk) {
#pragma unroll
      for (int q = 0; q < 4; ++q) {
        *(u32x4*)(As + (lr + 32 * q) * 72 + lc) = ra[q];
        *(u32x4*)(Bs + (lr + 32 * q) * 72 + lc) = rb[q];
      }
      __syncthreads();
    }
  }
}
#define ACC_ROW(mt, i) (wm * 64 + (mt) * 32 + ((i) & 3) + 8 * ((i) >> 2) + 4 * h)
#define ACC_COL(nt) (wn * 64 + (nt) * 32 + l31)
#define GEMM_IDS const int lane = threadIdx.x & 63, wave = (threadIdx.x & 255) >> 6, wm = wave >> 1, wn = wave & 1, l31 = lane & 31, h = lane >> 5; (void)wm; (void)wn; (void)l31; (void)h;

DI void phase_gemm_small(const bf16_t* A, int lda, const bf16_t* W, int N, int K, bf16_t* C, int ldc, char* lds) {
  GEMM_IDS
  const int sb = threadIdx.x >> 8;
  const int ntn = N / 128;
  const int total = NT_ * ntn;
  for (int t0 = blockIdx.x * 2; t0 < total; t0 += gridDim.x * 2) {
    const int t = t0 + sb;
    const int tm = t / ntn, tn = t - tm * ntn;
    f32x16 acc[2][2];
    gemm_tile(A + (size_t)tm * 128 * lda, lda, W + (size_t)tn * 128 * K, K, K, lds + sb * 36864, acc);
#pragma unroll
    for (int mt = 0; mt < 2; ++mt)
#pragma unroll
      for (int nt = 0; nt < 2; ++nt)
#pragma unroll
        for (int i = 0; i < 16; ++i) {
          int row = tm * 128 + ACC_ROW(mt, i), col = tn * 128 + ACC_COL(nt);
          C[(size_t)row * ldc + col] = f2bf(acc[mt][nt][i]);
        }
  }
}

namespace pg8 {
#define PG8_LAS __attribute__((address_space(3)))
typedef unsigned short bf16_t;
typedef short bf16x8 __attribute__((ext_vector_type(8)));
typedef float f32x4 __attribute__((ext_vector_type(4)));
typedef unsigned u32x4 __attribute__((ext_vector_type(4)));
constexpr int BM = 256, BK = 64, HALF = 128, HTB = HALF * BK * 2  , STAGE_BYTES = 8 * HTB, NXCD = 8, WGM = 8;

__host__ __device__ __forceinline__ int lds_byte(int r, int c) { const int st = (r >> 4) * 2 + (c >> 5), rr = r & 15, cc = c & 31, ob = rr * 64 + cc * 2; return st * 1024 + (ob ^ (((ob >> 9) & 1) << 5)); }
__host__ __device__ __forceinline__ void stage_rc(int b, int& R, int& C) { const int st = b / 1024, sb = b % 1024, swz = sb ^ (((sb >> 9) & 1) << 5); R = (st >> 1) * 16 + swz / 64; C = (st & 1) * 32 + (swz % 64) / 2; }
__host__ __device__ __forceinline__ int perm32(int rho) { const int n = rho >> 4, i = rho & 15; return 8 * (i >> 2) + 4 * n + (i & 3); }

struct Unit { int pm, pn; };
struct Gemm { const bf16_t* A; const bf16_t* Bt; int M, N, K; };

struct StaticOrder {
    int nM, nN, nwg, G, c;
    __host__ __device__ void init(int M, int N, int G_, int c_) { nM = M / BM; nN = N / BM; nwg = nM * nN; G = G_; c = c_; }
    __host__ __device__ bool next(int i, Unit& u) const {
        const long L = (long)i * G + c; if (L >= nwg) return false;
        int wgid = (int)L; { const int q = nwg / NXCD, r = nwg % NXCD, xcd = wgid % NXCD, off = wgid / NXCD; wgid = (xcd < r ? xcd * (q + 1) : r * (q + 1) + (xcd - r) * q) + off; }
        const int nig = WGM * nN, gid = wgid / nig, fm = gid * WGM, gsz = (nM - fm) < WGM ? (nM - fm) : WGM;
        u.pm = fm + ((wgid % nig) % gsz); u.pn = (wgid % nig) / gsz; return true;
    }
    __device__ __forceinline__ void a_ready(const Unit&) const {}
    __device__ __forceinline__ void done(const Unit&) const {}
};
__device__ __forceinline__ unsigned cvt_pk_bf16(float lo, float hi) { unsigned r; asm volatile("v_cvt_pk_bf16_f32 %0, %1, %2" : "=v"(r) : "v"(lo), "v"(hi)); return r; }

struct EpiRoute {
    static constexpr bool PERM = true, AFTER_DRAIN = false;
    bf16_t* O; int ldc; int route; bf16_t* pc; bf16_t* prkv; bf16_t* plow;
    __device__ __forceinline__ void operator()(const f32x4 (&acc)[2][2][4][2], const Unit& u, int wr, int wc, int fr, int fq) const {
        const int row0 = u.pm * BM + wr * 64 + fr;
#pragma unroll
        for (int bj = 0; bj < 2; ++bj) {
            int colh = u.pn * BM + bj * HALF; bf16_t* base = O; int ld = ldc;
            if (route) {
                if (colh < 768) { base = pc; ld = 768; }
                else if (colh < 2304) { base = prkv; ld = 1536; colh -= 768; }
                else if (colh < 2688) { base = plow; ld = 384; colh -= 2304; }
                else continue;
            }
            const int col0 = colh + wc * 32 + 8 * fq;
#pragma unroll
            for (int ai = 0; ai < 2; ++ai)
#pragma unroll
                for (int m = 0; m < 4; ++m) { bf16_t* rowp = base + (size_t)(row0 + ai * HALF + m * 16) * ld + col0;
                    const f32x4 v0 = acc[ai][bj][m][0], v1 = acc[ai][bj][m][1];
                    u32x4 w; w.x = cvt_pk_bf16(v0[0], v0[1]); w.y = cvt_pk_bf16(v0[2], v0[3]); w.z = cvt_pk_bf16(v1[0], v1[1]); w.w = cvt_pk_bf16(v1[2], v1[3]);
                    *(u32x4*)rowp = w; }
        }
    }
};
struct EpiGateUp {
    static constexpr bool PERM = true, AFTER_DRAIN = false;
    bf16_t* ACT;
    __device__ __forceinline__ void operator()(const f32x4 (&acc)[2][2][4][2], const Unit& u, int wr, int wc, int fr, int fq) const {
        const int row0 = u.pm * BM + wr * 64 + fr, col0 = u.pn * HALF + wc * 32 + 8 * fq;
#pragma unroll
        for (int ai = 0; ai < 2; ++ai)
#pragma unroll
            for (int m = 0; m < 4; ++m) { bf16_t* rowp = ACT + (size_t)(row0 + ai * HALF + m * 16) * 2816 + col0;
                float v[8];
#pragma unroll
                for (int n = 0; n < 2; ++n)
#pragma unroll
                    for (int j = 0; j < 4; ++j) { const float g = acc[ai][0][m][n][j], uu = acc[ai][1][m][n][j]; v[n * 4 + j] = g * __builtin_amdgcn_rcpf(1.f + __expf(-g)) * uu; }
                u32x4 w; w.x = cvt_pk_bf16(v[0], v[1]); w.y = cvt_pk_bf16(v[2], v[3]); w.z = cvt_pk_bf16(v[4], v[5]); w.w = cvt_pk_bf16(v[6], v[7]);
                *(u32x4*)rowp = w; }
    }
};
template <class Epi, class Sched, bool STAMP = false>
__device__ __forceinline__ void gemm_phase(PG8_LAS unsigned char* lds, const Gemm g, const Sched& S, const Epi& E, unsigned long long* stamps) {
    const int tid = threadIdx.x, wid = __builtin_amdgcn_readfirstlane(tid >> 6), lane = tid & 63, wr = wid >> 2, wc = wid & 3, fr = lane & 15, fq = lane >> 4;
    const int K = g.K, nt = K / BK;
    int ts_lo = 0, ts_hi = 0, nts = 0; const unsigned long long rt_entry = STAMP ? (unsigned long long)wall_clock64() : 0ull;
#define PG8_STAMP() do { if (STAMP && wid == 0 && nts < 64) { const unsigned long long _c = (unsigned long long)clock64(); \
        ts_lo = (lane == nts) ? (int)(unsigned)_c : ts_lo; ts_hi = (lane == nts) ? (int)(unsigned)(_c >> 32) : ts_hi; ++nts; } } while (0)
    PG8_STAMP();
    unsigned voffA[2], voffB[2];
#pragma unroll
    for (int i = 0; i < 2; ++i) { int R, C; stage_rc(tid * 16 + i * 8192, R, C); const int Rb = Epi::PERM ? ((R & ~31) + perm32(R & 31)) : R;
        voffA[i] = (unsigned)(R * K + C) * 2u; voffB[i] = (unsigned)(Rb * K + C) * 2u; }
    const size_t kstep = (size_t)(BK * 2);
    const size_t hstep = (size_t)HALF * K * 2;
    const size_t tstep = 2 * hstep;
    const unsigned ldsw = (unsigned)wid * 1024u;
    const int aoff = lds_byte(wr * 64 + fr, fq * 8), boff = lds_byte(wc * 32 + fr, fq * 8);
#define PG8_SA(b, h) (((b) * 2 + (h)) * HTB)
#define PG8_SB(b, h) ((4 + (b) * 2 + (h)) * HTB)
#define PG8_STAGE(bufoff, gbase, voff) do { _Pragma("unroll") for (int _i = 0; _i < 2; ++_i) \
        __builtin_amdgcn_global_load_lds((const unsigned*)((const char*)(gbase) + (voff)[_i]), (PG8_LAS unsigned*)(lds + (bufoff) + ldsw + _i * 8192), 16, 0, 0); } while (0)
#define PG8_LDA(dst, b, h) do { _Pragma("unroll") for (int m = 0; m < 4; ++m) _Pragma("unroll") for (int k = 0; k < 2; ++k) dst[m][k] = *(const PG8_LAS bf16x8*)(lds + PG8_SA(b, h) + aoff + m * 2048 + k * 1024); } while (0)
#define PG8_LDB(dst, b, h) do { _Pragma("unroll") for (int n = 0; n < 2; ++n) _Pragma("unroll") for (int k = 0; k < 2; ++k) dst[n][k] = *(const PG8_LAS bf16x8*)(lds + PG8_SB(b, h) + boff + n * 2048 + k * 1024); } while (0)
#define PG8_MMA(ai, bj, At, Bt) do { __builtin_amdgcn_s_setprio(1); _Pragma("unroll") for (int m = 0; m < 4; ++m) _Pragma("unroll") for (int n = 0; n < 2; ++n) _Pragma("unroll") for (int k = 0; k < 2; ++k) \
        acc[ai][bj][m][n] = __builtin_amdgcn_mfma_f32_16x16x32_bf16(Bt[n][k], At[m][k], acc[ai][bj][m][n], 0, 0, 0); __builtin_amdgcn_s_setprio(0); } while (0)
#define PG8_WAIT_V(n) asm volatile("s_waitcnt vmcnt(" #n ")" ::: "memory")
#define PG8_WAIT_L(n) asm volatile("s_waitcnt lgkmcnt(" #n ")" ::: "memory")
#define PG8_BAR __builtin_amdgcn_s_barrier()
#define PG8_SCHED __builtin_amdgcn_sched_barrier(0)
    Unit cur, nxt; int ui = 0;
    if (!S.next(0, cur)) return;
    f32x4 acc[2][2][4][2];
#pragma unroll
    for (int a = 0; a < 2; ++a)
#pragma unroll
        for (int b = 0; b < 2; ++b)
#pragma unroll
            for (int m = 0; m < 4; ++m)
#pragma unroll
                for (int n = 0; n < 2; ++n) acc[a][b][m][n] = (f32x4){0.f, 0.f, 0.f, 0.f};
    bf16x8 At[4][2], B0[2][2], B1[2][2];
    const char* cA = (const char*)g.A + (size_t)cur.pm * tstep; const char* cB = (const char*)g.Bt + (size_t)cur.pn * tstep;
    S.a_ready(cur);
    PG8_STAGE(PG8_SB(0, 0), cB, voffB); PG8_STAGE(PG8_SA(0, 0), cA, voffA); PG8_STAGE(PG8_SB(0, 1), cB + hstep, voffB); PG8_STAGE(PG8_SA(0, 1), cA + hstep, voffA);
    if (wr == 1) PG8_BAR;
    PG8_WAIT_V(4); PG8_BAR;
    PG8_STAGE(PG8_SB(1, 0), cB + kstep, voffB); PG8_STAGE(PG8_SA(1, 0), cA + kstep, voffA); PG8_STAGE(PG8_SB(1, 1), cB + hstep + kstep, voffB);
    PG8_WAIT_V(6); PG8_BAR;
    PG8_STAMP();
    for (;;) {
        const bool has_next = S.next(ui + 1, nxt);
        const char* nA = has_next ? (const char*)g.A + (size_t)nxt.pm * tstep : cA; const char* nB = has_next ? (const char*)g.Bt + (size_t)nxt.pn * tstep : cB;
        for (int t = 0; t < nt; t += 2) {
            const bool last = (t == nt - 2);
            const char* a1 = cA + (size_t)(t + 1) * kstep;
            const char* a2 = last ? nA : cA + (size_t)(t + 2) * kstep; const char* b2 = last ? nB : cB + (size_t)(t + 2) * kstep;
            const char* a3 = a2 + kstep; const char* b3 = b2 + kstep;
            if (last && has_next) S.a_ready(nxt);
            PG8_LDB(B0, 0, 0); PG8_SCHED; PG8_LDA(At, 0, 0); PG8_STAGE(PG8_SA(1, 1), a1 + hstep, voffA);
            PG8_WAIT_L(8); PG8_BAR; PG8_WAIT_L(0); PG8_MMA(0, 0, At, B0); PG8_BAR; PG8_SCHED;
            PG8_LDB(B1, 0, 1); PG8_STAGE(PG8_SB(0, 0), b2, voffB);
            PG8_BAR; PG8_WAIT_L(0); PG8_MMA(0, 1, At, B1); PG8_BAR;
            PG8_LDA(At, 0, 1); PG8_STAGE(PG8_SA(0, 0), a2, voffA);
            PG8_BAR; PG8_WAIT_L(0); PG8_MMA(1, 0, At, B0); PG8_BAR; PG8_SCHED;
            PG8_STAGE(PG8_SB(0, 1), b2 + hstep, voffB);
            PG8_WAIT_V(6); PG8_BAR; PG8_MMA(1, 1, At, B1); PG8_BAR;
            PG8_LDB(B0, 1, 0); PG8_SCHED; PG8_LDA(At, 1, 0); PG8_STAGE(PG8_SA(0, 1), a2 + hstep, voffA);
            PG8_WAIT_L(8); PG8_BAR; PG8_WAIT_L(0); PG8_MMA(0, 0, At, B0); PG8_BAR; PG8_SCHED;
            PG8_LDB(B1, 1, 1); PG8_STAGE(PG8_SB(1, 0), b3, voffB);
            PG8_BAR; PG8_WAIT_L(0); PG8_MMA(0, 1, At, B1); PG8_BAR;
            PG8_LDA(At, 1, 1); PG8_STAGE(PG8_SA(1, 0), a3, voffA);
            PG8_BAR; PG8_WAIT_L(0); PG8_MMA(1, 0, At, B0); PG8_BAR; PG8_SCHED;
            PG8_STAGE(PG8_SB(1, 1), b3 + hstep, voffB);
            PG8_WAIT_V(6); PG8_BAR; PG8_MMA(1, 1, At, B1); PG8_BAR;
        }
        PG8_STAMP();
        if constexpr (!Epi::AFTER_DRAIN) { E(acc, cur, wr, wc, fr, fq); S.done(cur); }
        PG8_STAMP();
        if (!has_next) break;
#pragma unroll
        for (int a = 0; a < 2; ++a)
#pragma unroll
            for (int b = 0; b < 2; ++b)
#pragma unroll
                for (int m = 0; m < 4; ++m)
#pragma unroll
                    for (int n = 0; n < 2; ++n) acc[a][b][m][n] = (f32x4){0.f, 0.f, 0.f, 0.f};
        cur = nxt; cA = nA; cB = nB; ++ui;
    }
    PG8_WAIT_V(0);
    if (wr == 0) PG8_BAR;
    PG8_BAR;
    if constexpr (Epi::AFTER_DRAIN) { E.fused(acc, cur, wr, wc, fr, fq, lds, wid, lane); S.done(cur); }
    PG8_STAMP();
    if (STAMP && wid == 0) { stamps[lane] = lane < nts ? (((unsigned long long)(unsigned)ts_hi << 32) | (unsigned)ts_lo) : 0ull;
        if (lane == 62) stamps[62] = rt_entry; if (lane == 63) stamps[63] = (unsigned long long)wall_clock64(); }
#undef PG8_STAMP
#undef PG8_SA
#undef PG8_SB
#undef PG8_STAGE
#undef PG8_LDA
#undef PG8_LDB
#undef PG8_MMA
#undef PG8_WAIT_V
#undef PG8_WAIT_L
#undef PG8_BAR
#undef PG8_SCHED
}
}

DI void phase_gemm_big(const bf16_t* A, const bf16_t* W, int N, int K, bf16_t* C, int ldc, int route, char* ws, unsigned char* lds) {
  pg8::Gemm g{A, W, TP_, N, K};
  pg8::StaticOrder S; S.init(TP_, N, gridDim.x, blockIdx.x);
  pg8::EpiRoute E{C, ldc, route, (bf16_t*)(ws + O_PC), (bf16_t*)(ws + O_PRKV), (bf16_t*)(ws + O_PLOW)};
  pg8::gemm_phase<pg8::EpiRoute, pg8::StaticOrder, false>((PG8_LAS unsigned char*)lds, g, S, E, nullptr);
}
DI void phase_gemm_gateup(const bf16_t* A, const bf16_t* W, bf16_t* ACT, unsigned char* lds) {
  pg8::Gemm g{A, W, TP_, 5632, 1024};
  pg8::StaticOrder S; S.init(TP_, 5632, gridDim.x, blockIdx.x);
  pg8::EpiGateUp E{ACT};
  pg8::gemm_phase<pg8::EpiGateUp, pg8::StaticOrder, false>((PG8_LAS unsigned char*)lds, g, S, E, nullptr);
}

DI void phase_resnorm(const P& p, const float* g1, const float* g2, bool first = false) {
  const int lane = threadIdx.x & 63, gw = (blockIdx.x * NTH + threadIdx.x) >> 6, nw = (gridDim.x * NTH) >> 6;
  bf16_t* HN = (bf16_t*)(p.ws + O_HN);
  for (int sr = gw; sr < T_; sr += nw) {
    float* hr = hrow(p, sr);
    const float* hsrc = hr;
    if (first) {
      int pos; const int b = seq_of(sr, pos);
      hsrc = pos < 16 ? p.meta + pos * 1024 : (b < 8 ? p.x_prompt + ((size_t)b * 4096 + pos - 16) * 1024 : p.x_sample + (size_t)(pos - 16) * 1024);
    }
    float x[16];
    float ss = 0.f;
#pragma unroll
    for (int q = 0; q < 4; ++q) {
      const uint2 u = *(const uint2*)(HN + (size_t)sr * 1024 + q * 256 + lane * 4);
      x[q * 4] = lo2f(u.x); x[q * 4 + 1] = hi2f(u.x); x[q * 4 + 2] = lo2f(u.y); x[q * 4 + 3] = hi2f(u.y);
      ss += x[q * 4] * x[q * 4] + x[q * 4 + 1] * x[q * 4 + 1] + x[q * 4 + 2] * x[q * 4 + 2] + x[q * 4 + 3] * x[q * 4 + 3];
    }
    f32x4v hh[4];
#pragma unroll
    for (int q = 0; q < 4; ++q) {
      if (first) hh[q] = *(const f32x4v*)(hsrc + q * 256 + lane * 4);
      else { const uint2 hu = *(const uint2*)((const bf16_t*)hsrc + q * 256 + lane * 4); hh[q] = (f32x4v){lo2f(hu.x), hi2f(hu.x), lo2f(hu.y), hi2f(hu.y)}; }
    }
    ss = wave_sum(ss);
    const float rs = rsqrtf(ss * (1.f / 1024.f) + EPS);
    float ss2 = 0.f;
#pragma unroll
    for (int q = 0; q < 4; ++q) {
      const float4 g = *(const float4*)(g1 + q * 256 + lane * 4);
      hh[q].x += x[q * 4 + 0] * rs * g.x; hh[q].y += x[q * 4 + 1] * rs * g.y; hh[q].z += x[q * 4 + 2] * rs * g.z; hh[q].w += x[q * 4 + 3] * rs * g.w;
      if (g2) *(uint2*)((bf16_t*)hr + q * 256 + lane * 4) = make_uint2(pack2(hh[q].x, hh[q].y), pack2(hh[q].z, hh[q].w));
      else *(f32x4v*)(hr + q * 256 + lane * 4) = hh[q];
      ss2 += hh[q].x * hh[q].x + hh[q].y * hh[q].y + hh[q].z * hh[q].z + hh[q].w * hh[q].w;
    }
    if (g2) {
      ss2 = wave_sum(ss2);
      const float rs2 = rsqrtf(ss2 * (1.f / 1024.f) + EPS);
#pragma unroll
      for (int q = 0; q < 4; ++q) {
        const float4 g = *(const float4*)(g2 + q * 256 + lane * 4);
        *(uint2*)(HN + (size_t)sr * 1024 + q * 256 + lane * 4) = make_uint2(pack2(hh[q].x * rs2 * g.x, hh[q].y * rs2 * g.y), pack2(hh[q].z * rs2 * g.z, hh[q].w * rs2 * g.w));
      }
    }
  }
}

DI size_t vta_base(int seq) { return seq < 8 ? (size_t)seq * 256 * 4160 : (size_t)8 * 256 * 4160; }
template <int NC> DI void vt_transpose(const bf16_t* src, int ld, int col0, bf16_t* VT, char* lds) {
  bf16_t* tl = (bf16_t*)lds;
  const int tid = threadIdx.x;
  constexpr int CPT = NC / 8, TPR = 512 / NC, PPT = 64 / TPR;
  for (int it = blockIdx.x; it < 257 + 8 * 65; it += gridDim.x) {
    int seq, kt;
    if (it < 257) { seq = 8; kt = it; } else { const int j = it - 257; seq = j / 65; kt = j - seq * 65; }
    const int L = seq_len(seq), LP = L + 48, sbase = seq_base(seq);
    const size_t vb = (seq < 8 ? (size_t)seq * NC * 4160 : (size_t)8 * NC * 4160);
    __syncthreads();
    const int pl = tid >> 3, part = tid & 7;
    const int pos = 64 * kt + pl - 48;
#pragma unroll
    for (int q = 0; q < CPT / 8; ++q) {
      u32x4 v = (u32x4)(0u);
      if (pos >= 0) v = *(const u32x4*)(src + (size_t)(sbase + pos) * ld + col0 + part * CPT + q * 8);
#pragma unroll
      for (int j = 0; j < 4; ++j) {
        tl[(part * CPT + q * 8 + 2 * j) * 72 + pl] = (bf16_t)(v[j] & 0xffffu);
        tl[(part * CPT + q * 8 + 2 * j + 1) * 72 + pl] = (bf16_t)(v[j] >> 16);
      }
    }
    __syncthreads();
    const int row = tid / TPR, seg = tid % TPR;
    bf16_t* dst = VT + vb + (size_t)row * LP + 64 * kt + seg * PPT;
#pragma unroll
    for (int q = 0; q < PPT / 8; ++q) *(u32x4*)(dst + q * 8) = *(const u32x4*)(tl + row * 72 + seg * PPT + q * 8);
  }
}

DI void phase_prepA(const P& p, char* lds) {
  const int lane = threadIdx.x & 63, wave = threadIdx.x >> 6;
  bf16_t* PROJ = (bf16_t*)(p.ws + O_PROJ0);
  bf16_t* ZB = (bf16_t*)(p.ws + O_ZB);
  const float* WC = (const float*)(p.ws + O_WC);
  vt_transpose<256>(PROJ, 1536, 1024, (bf16_t*)(p.ws + O_VTA), lds);
  __syncthreads();
  float* fl = (float*)lds + wave * 1024;
  float* csl = (float*)lds + 8 * 1024 + wave * 64;
  const float inv = exp2f(-(float)(lane & 15) * (13.287712379549449f / 16.f));
  const int qr = lane & 3;
  float gn[16];
#pragma unroll
  for (int j = 0; j < 16; ++j) gn[j] = (lane < 48 ? p.a_q_gain : p.a_k_gain)[16 * qr + j] * (lane < 48 ? 0.125f * LOG2E : 1.f);
  for (int r0 = blockIdx.x * 32; r0 < TP_; r0 += gridDim.x * 32) {
    const int srb = r0 + wave * 4;
#pragma unroll 1
    for (int rr = 0; rr < 4; ++rr) {
      const int sr = srb + rr;
      if (sr < T_) {
        int pos; seq_of(sr, pos);
        float rowf, colf;
        if (pos < 16) { rowf = colf = (float)(pos - 16); }
        else { int t = pos - 16; rowf = (float)(t >> 6); colf = (float)(t & 63); }
        {
          float sn1, cs1;
          sincosf(((lane & 16) ? colf : rowf) * inv, &sn1, &cs1);
          if (lane < 32) { csl[lane] = cs1; csl[32 + lane] = sn1; }
        }
        bf16_t* pr = PROJ + (size_t)sr * 1536;
        {
        const u32x4 u0 = *(const u32x4*)(pr + 16 * lane), u1 = *(const u32x4*)(pr + 16 * lane + 8);
        float x[16];
        float ss = 0.f;
#pragma unroll
        for (int j = 0; j < 4; ++j) {
          x[2 * j] = lo2f(u0[j]); x[2 * j + 1] = hi2f(u0[j]); x[8 + 2 * j] = lo2f(u1[j]); x[8 + 2 * j + 1] = hi2f(u1[j]);
        }
#pragma unroll
        for (int j = 0; j < 16; ++j) ss += x[j] * x[j];
        ss += __shfl_xor(ss, 1); ss += __shfl_xor(ss, 2);
        const float rs = rsqrtf(ss * (1.f / 64.f) + EPS);
        const float* cp = csl + 16 * (qr >> 1);
        float o[16];
#pragma unroll
        for (int j4 = 0; j4 < 4; ++j4) {
          const f32x4v c4 = *(const f32x4v*)(cp + 4 * j4), s4 = *(const f32x4v*)(cp + 32 + 4 * j4);
#pragma unroll
          for (int e = 0; e < 4; ++e) {
            const int j = 4 * j4 + e;
            const float xn = x[j] * rs * gn[j];
            const float pa = __shfl_xor(xn, 1);
            o[j] = xn * c4[e] + pa * ((qr & 1) ? s4[e] : -s4[e]);
          }
        }
        *(u32x4*)(pr + 16 * lane) = (u32x4){pack2(o[0], o[1]), pack2(o[2], o[3]), pack2(o[4], o[5]), pack2(o[6], o[7])};
        *(u32x4*)(pr + 16 * lane + 8) = (u32x4){pack2(o[8], o[9]), pack2(o[10], o[11]), pack2(o[12], o[13]), pack2(o[14], o[15])};
        }
        uint2 u = *(const uint2*)(pr + 1280 + lane * 4);
        float f0 = lo2f(u.x), f1 = hi2f(u.x), f2 = lo2f(u.y), f3 = hi2f(u.y);
        float ss = f0 * f0 + f1 * f1 + f2 * f2 + f3 * f3;
        ss += __shfl_xor(ss, 1); ss += __shfl_xor(ss, 2); ss += __shfl_xor(ss, 4); ss += __shfl_xor(ss, 8);
        float rs = rsqrtf(ss * (1.f / 64.f) + EPS);
        float4 g = *(const float4*)(p.b_norm_g + lane * 4);
        *(float4*)(fl + rr * 256 + lane * 4) = make_float4(f0 * rs * g.x, f1 * rs * g.y, f2 * rs * g.z, f3 * rs * g.w);
      } else {
        *(float4*)(fl + rr * 256 + lane * 4) = make_float4(0.f, 0.f, 0.f, 0.f);
      }
    }
    __syncthreads();
    {
      const int g = lane >> 4, o0 = (lane & 15) * 8;
      float acc[4][8];
#pragma unroll
      for (int rr = 0; rr < 4; ++rr)
#pragma unroll
        for (int j = 0; j < 8; ++j) acc[rr][j] = 0.f;
      const float* wc = WC + (size_t)g * 64 * 128 + o0;
#pragma unroll 4
      for (int c = 0; c < 64; ++c) {
        const float4 w0 = *(const float4*)(wc + c * 128), w1 = *(const float4*)(wc + c * 128 + 4);
#pragma unroll
        for (int rr = 0; rr < 4; ++rr) {
          const float f = fl[rr * 256 + g * 64 + c];
          acc[rr][0] += f * w0.x; acc[rr][1] += f * w0.y; acc[rr][2] += f * w0.z; acc[rr][3] += f * w0.w;
          acc[rr][4] += f * w1.x; acc[rr][5] += f * w1.y; acc[rr][6] += f * w1.z; acc[rr][7] += f * w1.w;
        }
      }
#pragma unroll
      for (int rr = 0; rr < 4; ++rr)
        if (srb + rr < T_)
          *(uint4*)(ZB + (size_t)(srb + rr) * 512 + g * 128 + o0) = make_uint4(pack2(acc[rr][0], acc[rr][1]), pack2(acc[rr][2], acc[rr][3]), pack2(acc[rr][4], acc[rr][5]), pack2(acc[rr][6], acc[rr][7]));
    }
    __syncthreads();
  }
}

template <int MODE>
DI void flash_item(const bf16_t* __restrict__ Q, int ldq, const bf16_t* __restrict__ Kb, int ldk, const bf16_t* __restrict__ Vt, int LP,
                   bf16_t* O, int ldo, int sbase, int S, int qt, float sinkl2, char* lds) {
  const int tid = threadIdx.x & 255, lane = tid & 63, wave = tid >> 6, l31 = lane & 31, h = lane >> 5;
  bf16_t* Ks = (bf16_t*)lds;
  bf16_t* Vs = Ks + 2 * 64 * 72;
  const int rl = wave * 32 + l31;
  const int qpos = qt == 0 ? (rl < 16 ? rl : 15) : 16 + 128 * (qt - 1) + rl;
  const bool qvalid = qt > 0 || rl < 16;
  bf16x8 qf[4];
  {
    const bf16_t* qr = Q + (size_t)(sbase + qpos) * ldq;
#pragma unroll
    for (int s = 0; s < 4; ++s) qf[s] = *(const bf16x8*)(qr + 16 * s + 8 * h);
  }
  const int nkt_all = (S + 64) / 64;
  int klo = 1, n;
  if (MODE == 0) { n = nkt_all; }
  else {
    if (qt == 0) { klo = 1; n = 3; }
    else {
      int c = qt - 1;
      klo = 2 * c - 1; if (klo < 1) klo = 1;
      int khi = 2 * c + 4; if (khi > nkt_all - 1) khi = nkt_all - 1;
      n = 1 + (khi - klo + 1);
    }
  }
  const int ldr = tid >> 2, ldp = (tid & 3) * 16;
  u32x4 rk0, rk1, rv0, rv1;
  auto ktile = [&](int idx) { return idx == 0 ? 0 : klo + idx - 1; };
#define FL_GLOAD(idx)                                                                               \
  {                                                                                                 \
    int kt_ = ktile(idx);                                                                           \
    int pos_ = 64 * kt_ + ldr - 48;                                                                 \
    if (pos_ >= 0) {                                                                                \
      const bf16_t* kp_ = Kb + (size_t)(sbase + pos_) * ldk + ldp;                                  \
      rk0 = *(const u32x4*)kp_; rk1 = *(const u32x4*)(kp_ + 8);                                 \
    } else { rk0 = (u32x4)(0u); rk1 = rk0; }                                       \
    const bf16_t* vp_ = Vt + (size_t)ldr * LP + 64 * kt_ + ldp;                                     \
    rv0 = *(const u32x4*)vp_; rv1 = *(const u32x4*)(vp_ + 8);                                   \
  }
#define FL_SSTORE(buf)                                                                              \
  {                                                                                                 \
    *(u32x4*)(Ks + (buf) * 64 * 72 + ldr * 72 + ldp) = rk0; *(u32x4*)(Ks + (buf) * 64 * 72 + ldr * 72 + ldp + 8) = rk1; \
    { bf16_t* vd_ = Vs + (buf) * 64 * 68 + ldr * 68 + ldp; *(uint2*)vd_ = make_uint2(rv0.x, rv0.y); *(uint2*)(vd_ + 4) = make_uint2(rv0.z, rv0.w); *(uint2*)(vd_ + 8) = make_uint2(rv1.x, rv1.y); *(uint2*)(vd_ + 12) = make_uint2(rv1.z, rv1.w); } \
  }
  f32x16 oacc[2];
#pragma unroll
  for (int i = 0; i < 16; ++i) { oacc[0][i] = 0.f; oacc[1][i] = 0.f; }
  float m = MODE == 1 ? -1e30f : 0.f, l = 0.f;
  FL_GLOAD(0)
  FL_SSTORE(0)
  __syncthreads();
  for (int idx = 0; idx < n; ++idx) {
    const int cur = idx & 1;
    if (idx + 1 < n) FL_GLOAD(idx + 1)
    const int kt = ktile(idx);
    const bf16_t* ks = Ks + cur * 64 * 72;
    const bf16_t* vs = Vs + cur * 64 * 68;
    f32x16 sacc[2];
    {
      bf16x8 kf[2][4];
#pragma unroll
      for (int t = 0; t < 2; ++t)
#pragma unroll
        for (int s = 0; s < 4; ++s) kf[t][s] = *(const bf16x8*)(ks + (32 * t + l31) * 72 + 16 * s + 8 * h);
#pragma unroll
      for (int t = 0; t < 2; ++t)
#pragma unroll
        for (int i = 0; i < 16; ++i) sacc[t][i] = 0.f;
      __builtin_amdgcn_sched_barrier(0);
#pragma unroll
      for (int s = 0; s < 4; ++s)
#pragma unroll
        for (int t = 0; t < 2; ++t) sacc[t] = MFMA32(kf[t][s], qf[s], sacc[t]);
    }
    bf16x8 vfr[2][2][2];
#pragma unroll
    for (int t = 0; t < 2; ++t)
#pragma unroll
      for (int s2 = 0; s2 < 2; ++s2)
#pragma unroll
        for (int dt = 0; dt < 2; ++dt) {
          const bf16_t* vp = vs + (32 * dt + l31) * 68 + 32 * t + 16 * s2 + 4 * h;
          uint2 lo = *(const uint2*)vp, hi = *(const uint2*)(vp + 8);
          u32x4 v4 = {lo.x, lo.y, hi.x, hi.y};
          vfr[t][s2][dt] = __builtin_bit_cast(bf16x8, v4);
        }
    __builtin_amdgcn_sched_barrier(0);
    if (kt == 0) {
#pragma unroll
      for (int t = 0; t < 2; ++t)
#pragma unroll
        for (int i = 0; i < 16; ++i) {
          int kl = 32 * t + (i & 3) + 8 * (i >> 2) + 4 * h;
          if (kl < 48) sacc[t][i] = -1e30f;
        }
    } else if (MODE == 1) {
#pragma unroll
      for (int t = 0; t < 2; ++t)
#pragma unroll
        for (int i = 0; i < 16; ++i) {
          int kl = 32 * t + (i & 3) + 8 * (i >> 2) + 4 * h;
          int tk = 64 * (kt - 1) + kl;
          bool vis;
          if (qt == 0) vis = tk <= 112 + qpos;
          else { int tq = qpos - 16; int d = tq - tk; vis = d <= 128 && d >= -128; }
          if (!vis) sacc[t][i] = -1e30f;
        }
    }
    float tmax = -1e30f;
    if (MODE == 1) {
#pragma unroll
      for (int t = 0; t < 2; ++t)
#pragma unroll
        for (int i = 0; i < 16; ++i) tmax = fmaxf(tmax, sacc[t][i]);
      tmax = fmaxf(tmax, __shfl_xor(tmax, 32));
    }
    if (MODE == 1 && __builtin_amdgcn_ballot_w64(tmax > m) != 0ull) {
      const float mn = fmaxf(m, tmax);
      const float alpha = __builtin_amdgcn_exp2f(m - mn);
      m = mn;
      l *= alpha;
#pragma unroll
      for (int i = 0; i < 16; ++i) { oacc[0][i] *= alpha; oacc[1][i] *= alpha; }
    }
    const f32x2 m2 = {m, m};
    f32x2 ls2 = {0.f, 0.f};
    unsigned pk[2][8];
#pragma unroll
    for (int t = 0; t < 2; ++t)
#pragma unroll
      for (int i2 = 0; i2 < 8; ++i2) {
        f32x2 d = {sacc[t][2 * i2], sacc[t][2 * i2 + 1]};
        if (MODE == 1) d = d - m2;
        f32x2 e = {__builtin_amdgcn_exp2f(d.x), __builtin_amdgcn_exp2f(d.y)};
        ls2 += e;
        pk[t][i2] = __builtin_bit_cast(unsigned, __builtin_convertvector(e, bf16x2_t));
      }
    l += ls2.x + ls2.y;
#pragma unroll
    for (int t = 0; t < 2; ++t)
#pragma unroll
      for (int s2 = 0; s2 < 2; ++s2) {
        u32x4 pk4 = {pk[t][4 * s2], pk[t][4 * s2 + 1], pk[t][4 * s2 + 2], pk[t][4 * s2 + 3]};
        bf16x8 pf = __builtin_bit_cast(bf16x8, pk4);
#pragma unroll
        for (int dt = 0; dt < 2; ++dt) oacc[dt] = MFMA32(vfr[t][s2][dt], pf, oacc[dt]);
      }
    if (idx + 1 < n) FL_SSTORE(cur ^ 1)
    __syncthreads();
  }
  l += __shfl_xor(l, 32);
  if (MODE == 1) l += __builtin_amdgcn_exp2f(sinkl2 - m);
  const float il = 1.f / l;
  if (qvalid) {
    bf16_t* orow = O + (size_t)(sbase + qpos) * ldo;
#pragma unroll
    for (int dt = 0; dt < 2; ++dt)
#pragma unroll
      for (int g = 0; g < 4; ++g) {
        int d = 32 * dt + 8 * g + 4 * h;
        uint2 o = make_uint2(pack2(oacc[dt][4 * g] * il, oacc[dt][4 * g + 1] * il), pack2(oacc[dt][4 * g + 2] * il, oacc[dt][4 * g + 3] * il));
        *(uint2*)(orow + d) = o;
      }
  }
#undef FL_GLOAD
#undef FL_SSTORE
}

DI void dft4(float& r0, float& i0, float& r1, float& i1, float& r2, float& i2, float& r3, float& i3) {
  const float t0r = r0 + r2, t0i = i0 + i2, t1r = r0 - r2, t1i = i0 - i2;
  const float t2r = r1 + r3, t2i = i1 + i3, t3r = i1 - i3, t3i = r3 - r1;
  r0 = t0r + t2r; i0 = t0i + t2i; r1 = t1r + t3r; i1 = t1i + t3i; r2 = t0r - t2r; i2 = t0i - t2i; r3 = t1r - t3r; i3 = t1i - t3i;
}
DI void dft16(float (&zr)[16], float (&zi)[16]) {
#pragma unroll
  for (int b = 0; b < 4; ++b) dft4(zr[b], zi[b], zr[4 + b], zi[4 + b], zr[8 + b], zi[8 + b], zr[12 + b], zi[12 + b]);
  constexpr float C1 = 0.9238795325112867f, S1 = 0.3826834323650898f, C2 = 0.7071067811865476f;
  const float wr[10] = {1.f, C1, C2, S1, 0.f, 0.f, -C2, 0.f, 0.f, -C1};
  const float wi[10] = {0.f, -S1, -C2, -C1, -1.f, 0.f, -C2, 0.f, 0.f, S1};
#pragma unroll
  for (int q = 1; q < 4; ++q)
#pragma unroll
    for (int b = 1; b < 4; ++b) {
      const float c = wr[b * q], d = wi[b * q];
      const float xr = zr[4 * q + b], xi = zi[4 * q + b];
      zr[4 * q + b] = xr * c - xi * d; zi[4 * q + b] = xr * d + xi * c;
    }
#pragma unroll
  for (int q = 0; q < 4; ++q) dft4(zr[4 * q], zi[4 * q], zr[4 * q + 1], zi[4 * q + 1], zr[4 * q + 2], zi[4 * q + 2], zr[4 * q + 3], zi[4 * q + 3]);
}

DI size_t y_base(int seq) { return seq < 8 ? (size_t)seq * 16 * 256 * 576 : (size_t)8 * 16 * 256 * 576; }
DI void phase_attnA(const P& p, char* lds) {
  const bf16_t* PROJ = (const bf16_t*)(p.ws + O_PROJ0);
  const bf16_t* VT = (const bf16_t*)(p.ws + O_VTA);
  bf16_t* MIX = (bf16_t*)(p.ws + O_MIX);
  const int nS = 129 * 6, nP = 8 * 33 * 6;
  const int sb = threadIdx.x >> 8;
  unsigned* head = (unsigned*)(p.ws + O_CNT);
  for (;;) {
    if (threadIdx.x == 0) *(volatile int*)(lds + 2 * 36864) = (int)__hip_atomic_fetch_add(head, 1u, __ATOMIC_RELAXED, __HIP_MEMORY_SCOPE_AGENT);
    __syncthreads();
    const int it = *(volatile int*)(lds + 2 * 36864);
    __syncthreads();
    if (it >= nS + nP) break;
    int seq, qt, hq;
    if (it < nS) { seq = 8; hq = (it % 6) * 2 + sb; qt = it / 6; }
    else { int j = it - nS; hq = (j % 6) * 2 + sb; j /= 6; qt = j % 33; seq = j / 33; }
    const int kv = hq / 3;
    const int L = seq_len(seq), LP = L + 48;
    flash_item<0>(PROJ + hq * 64, 1536, PROJ + 768 + kv * 64, 1536, VT + vta_base(seq) + (size_t)kv * 64 * LP, LP,
                  MIX + hq * 64, 1024, seq_base(seq), L - 16, qt, 0.f, lds + sb * 36864);
  }
  const bf16_t* ZB = (const bf16_t*)(p.ws + O_ZB);
  bf16_t* Y = (bf16_t*)(p.ws + O_Y);
  const int lane = threadIdx.x & 63, wave = threadIdx.x >> 6;
  const int nI_S = 17 * 16, nI_P = 8 * 5 * 16;
  for (;;) {
    if (threadIdx.x == 0) *(volatile int*)(lds + 2 * 36864) = (int)__hip_atomic_fetch_add(head + 64, 1u, __ATOMIC_RELAXED, __HIP_MEMORY_SCOPE_AGENT);
    __syncthreads();
    const int it = *(volatile int*)(lds + 2 * 36864);
    __syncthreads();
    if (it >= nI_S + nI_P) break;
    int seq, nb, cb;
    if (it < nI_S) { seq = 8; cb = it & 15; nb = it >> 4; }
    else { int j = it - nI_S; cb = j & 15; j >>= 4; nb = j % 5; seq = j / 5; }
    const int M = seq < 8 ? 257 : 1025, KP = seq < 8 ? 576 : 2112, L = 16 * M;
    const int n2 = nb * 64 + lane;
    const int ch = cb * 16 + wave * 2;
    const int g = ch >> 6, d = ch & 63;
    bf16_t* yb = Y + y_base(seq);
    if (n2 < M) {
      float ar[16], ai[16], br[16], bi[16];
#pragma unroll
      for (int n1 = 0; n1 < 16; ++n1) {
        const bf16_t* zp = ZB + (size_t)(seq_base(seq) + M * n1 + n2) * 512 + g * 128 + d;
        unsigned re = *(const unsigned*)zp, im = *(const unsigned*)(zp + 64);
        ar[n1] = lo2f(re); br[n1] = hi2f(re); ai[n1] = lo2f(im); bi[n1] = hi2f(im);
      }
      dft16(ar, ai);
      dft16(br, bi);
      float t1s, t1c;
      sincospif(-2.f * (float)n2 / (float)L, &t1s, &t1c);
      float tc = 1.f, ts = 0.f;
#pragma unroll
      for (int k1 = 0; k1 < 16; ++k1) {
        const int ix = 4 * (k1 & 3) + (k1 >> 2);
        const float yr0 = ar[ix] * tc - ai[ix] * ts, yi0 = ar[ix] * ts + ai[ix] * tc;
        const float yr1 = br[ix] * tc - bi[ix] * ts, yi1 = br[ix] * ts + bi[ix] * tc;
        bf16_t* y0 = yb + ((size_t)k1 * 256 + ch) * KP;
        y0[n2] = f2bf(yr0); y0[M + n2] = f2bf(yi0);
        y0[KP + n2] = f2bf(yr1); y0[KP + M + n2] = f2bf(yi1);
        const float nc = tc * t1c - ts * t1s; ts = tc * t1s + ts * t1c; tc = nc;
      }
    } else if (n2 < KP - M) {
      for (int k1 = 0; k1 < 16; ++k1) {
        bf16_t* y0 = yb + ((size_t)k1 * 256 + ch) * KP;
        y0[M + n2] = 0; y0[KP + M + n2] = 0;
      }
    }
  }
}

DI void phase_fnet_gemm(const P& p, char* lds) {
  GEMM_IDS
  bf16_t* MIX = (bf16_t*)(p.ws + O_MIX);
  const bf16_t* Y = (const bf16_t*)(p.ws + O_Y);
  const int nS = 16 * 9 * 2, nP = 8 * 16 * 3 * 2;
  const int sb = threadIdx.x >> 8;
  for (int it0 = blockIdx.x * 2; it0 < nS + nP; it0 += gridDim.x * 2) {
    const int it = it0 + sb;
    int seq, k1, tm, tn;
    if (it < nS) { seq = 8; tn = it & 1; int j = it >> 1; tm = j % 9; k1 = j / 9; }
    else { int j = it - nS; tn = j & 1; j >>= 1; tm = j % 3; j /= 3; k1 = j & 15; seq = j >> 4; }
    const int M = seq < 8 ? 257 : 1025, KP = seq < 8 ? 576 : 2112, L = 16 * M;
    const bf16_t* dm = (const bf16_t*)(p.ws + (seq < 8 ? O_DM257 : O_DM1025));
    f32x16 acc[2][2];
    gemm_tile(dm + (size_t)tm * 128 * KP, KP, Y + y_base(seq) + ((size_t)k1 * 256 + tn * 128) * KP, KP, KP, lds + sb * 36864, acc);
    const float scale = rsqrtf(64.f * (float)L);
#pragma unroll
    for (int mt = 0; mt < 2; ++mt)
#pragma unroll
      for (int nt = 0; nt < 2; ++nt)
#pragma unroll
        for (int i = 0; i < 16; ++i) {
          int k2 = tm * 128 + ACC_ROW(mt, i), ch = tn * 128 + ACC_COL(nt);
          if (k2 < M) {
            int pos = k1 + 16 * k2;
            MIX[(size_t)(seq_base(seq) + pos) * 1024 + 768 + ch] = f2bf(acc[mt][nt][i] * scale + p.b_b[ch]);
          }
        }
  }
}

DI size_t vtc_base(int seq) { return seq < 8 ? (size_t)seq * 128 * 4160 : (size_t)8 * 128 * 4160; }
DI void phase_prepC(const P& p, char* lds) {
  const int gtid = blockIdx.x * NTH + threadIdx.x, gsz = gridDim.x * NTH;
  const int lane = threadIdx.x & 63, gw = gtid >> 6, nw = gsz >> 6;
  bf16_t* PC = (bf16_t*)(p.ws + O_PC);
  bf16_t* VT = (bf16_t*)(p.ws + O_VTC);
  const bf16_t* PLOW = (const bf16_t*)(p.ws + O_PLOW);
  bf16_t* LR = (bf16_t*)(p.ws + O_LR);
  vt_transpose<128>(PC, 768, 640, VT, lds);
  for (int sr = gw; sr < T_; sr += nw) {
    int pos; int b = seq_of(sr, pos);
    const int L = seq_len(b), LP = L + 48;
    bf16_t* pr = PC + (size_t)sr * 768;
    float cs[8], sn[8];
    {
      float s1, c1;
      sincosf((float)pos * exp2f(-(float)(lane & 7) * (18.931568569324174f / 8.f)), &s1, &c1);
#pragma unroll
      for (int j = 0; j < 8; ++j) { sn[j] = __shfl(s1, j); cs[j] = __shfl(c1, j); }
    }
#pragma unroll
    for (int part = 0; part < 2; ++part) {
      const bool act = part == 0 || lane < 16;
      const int col = part * 512 + (act ? lane : 0) * 8;
      uint4 u = *(const uint4*)(pr + col);
      float e[8] = {lo2f(u.x), hi2f(u.x), lo2f(u.y), hi2f(u.y), lo2f(u.z), hi2f(u.z), lo2f(u.w), hi2f(u.w)};
      float o[8];
#pragma unroll
      for (int j = 0; j < 8; ++j) {
        float pa = __shfl_xor(e[j], 1);
        float rot = e[j] * cs[j] + pa * ((lane & 1) ? sn[j] : -sn[j]);
        o[j] = (lane & 7) < 2 ? rot : e[j];
        if (part == 0) o[j] *= 0.125f * LOG2E;
      }
      if (act) *(uint4*)(pr + col) = make_uint4(pack2(o[0], o[1]), pack2(o[2], o[3]), pack2(o[4], o[5]), pack2(o[6], o[7]));
    }
#pragma unroll
    for (int q = 0; q < 6; ++q) {
      int c = q * 64 + lane;
      float u = bf2f(PLOW[(size_t)sr * 384 + c]);
      float up = pos > 0 ? bf2f(PLOW[(size_t)(sr - 1) * 384 + c]) : 0.f;
      float un = pos < L - 1 ? bf2f(PLOW[(size_t)(sr + 1) * 384 + c]) : 0.f;
      float us = u + p.mu_prev[1536 + c] * (up - u) + p.mu_next[1536 + c] * (un - u);
      float v = c < 128 ? tanhf(us) : (c < 256 ? us : sigmoidf_(us));
      LR[(size_t)sr * 384 + c] = f2bf(v);
    }
  }
}

DI void phase_attnC(const P& p, char* lds) {
  const bf16_t* PC = (const bf16_t*)(p.ws + O_PC);
  const bf16_t* VT = (const bf16_t*)(p.ws + O_VTC);
  bf16_t* MIX = (bf16_t*)(p.ws + O_MIX);
  const int nS = 129 * 4, nP = 8 * 33 * 4;
  const int sb = threadIdx.x >> 8;
  for (int it = blockIdx.x; it < nS + nP; it += gridDim.x) {
    int seq, qt, hq;
    if (it < nS) { seq = 8; hq = (it & 3) * 2 + sb; qt = it >> 2; }
    else { int j = it - nS; hq = (j & 3) * 2 + sb; j >>= 2; qt = j % 33; seq = j / 33; }
    const int kv = hq >> 2;
    const int L = seq_len(seq), LP = L + 48;
    flash_item<1>(PC + hq * 64, 768, PC + 512 + kv * 64, 768, VT + vtc_base(seq) + (size_t)kv * 64 * LP, LP,
                  MIX + hq * 64, 1024, seq_base(seq), L - 16, qt, p.c_sink[hq] * LOG2E, lds + sb * 36864);
  }
}

DI void chunk_decode(int cg_, int& seq, int& c) {
  if (cg_ < 136) { seq = cg_ / 17; c = cg_ - seq * 17; } else { seq = 8; c = cg_ - 136; }
}
DI float shiftv(const bf16_t* PRKV, int sr, int pos, int L, int col, float mp, float mn) {
  float u = bf2f(PRKV[(size_t)sr * 1536 + col]);
  float up = pos > 0 ? bf2f(PRKV[(size_t)(sr - 1) * 1536 + col]) : 0.f;
  float un = pos < L - 1 ? bf2f(PRKV[(size_t)(sr + 1) * 1536 + col]) : 0.f;
  return u + mp * (up - u) + mn * (un - u);
}
enum { VW = 0, VA = 1, VB = 2, VK = 3, VV = 4, VR = 5 };
#define DPP_FMAC(acc, x, y, N) asm("v_fmac_f32_dpp %0, %1, %2 row_newbcast:%3 row_mask:0xf bank_mask:0xf" : "+v"(acc) : "v"(x), "v"(y), "n"(N))
#define DPP_MUL(sv_, x, N) asm("v_mul_f32_dpp %0, %1, %0 row_newbcast:%2 row_mask:0xf bank_mask:0xf" : "+v"(sv_) : "v"(x), "n"(N))
template <int N> DI void dpp_dot4(float& a0, float& a1, float& a2, float& a3, const float (&S)[64], const float4& x) {
  DPP_FMAC(a0, x.x, S[N], N); DPP_FMAC(a1, x.y, S[16 + N], N); DPP_FMAC(a2, x.z, S[32 + N], N); DPP_FMAC(a3, x.w, S[48 + N], N);
  if constexpr (N < 15) dpp_dot4<N + 1>(a0, a1, a2, a3, S, x);
}
template <int N, bool HASV, bool OUT> DI void dpp_upd4(float (&S)[64], const float4& xb, const float4& xk, const float4& xr, float sa, float vi,
                                                       float& o0, float& o1, float& o2, float& o3) {
  DPP_FMAC(S[N], xb.x, sa, N); DPP_FMAC(S[16 + N], xb.y, sa, N); DPP_FMAC(S[32 + N], xb.z, sa, N); DPP_FMAC(S[48 + N], xb.w, sa, N);
  if (HASV) { DPP_FMAC(S[N], xk.x, vi, N); DPP_FMAC(S[16 + N], xk.y, vi, N); DPP_FMAC(S[32 + N], xk.z, vi, N); DPP_FMAC(S[48 + N], xk.w, vi, N); }
  if (OUT) { DPP_FMAC(o0, xr.x, S[N], N); DPP_FMAC(o1, xr.y, S[16 + N], N); DPP_FMAC(o2, xr.z, S[32 + N], N); DPP_FMAC(o3, xr.w, S[48 + N], N); }
  if constexpr (N < 15) dpp_upd4<N + 1, HASV, OUT>(S, xb, xk, xr, sa, vi, o0, o1, o2, o3);
}
template <int N> DI void dpp_scale4(float (&S)[64], const float4& xg) {
  DPP_MUL(S[N], xg.x, N); DPP_MUL(S[16 + N], xg.y, N); DPP_MUL(S[32 + N], xg.z, N); DPP_MUL(S[48 + N], xg.w, N);
  if constexpr (N < 15) dpp_scale4<N + 1>(S, xg);
}
template <int NST, bool HASV, bool OUT, class F>
DI void scan_steps(float (&S)[64], const float* sv, int ns, int lane, F&& emit) {
  const int l15 = lane & 15;
  (void)ns;
#pragma unroll 4
  for (int s = 0; s < NST; ++s) {
    const float4 xa = *(const float4*)(sv + VA * NST * 64 + s * 64 + l15 * 4);
    const float4 xb = *(const float4*)(sv + VB * NST * 64 + s * 64 + l15 * 4);
    float4 xk = xb, xr = xb;
    if (HASV) xk = *(const float4*)(sv + VK * NST * 64 + s * 64 + l15 * 4);
    if (OUT) xr = *(const float4*)(sv + VR * NST * 64 + s * 64 + l15 * 4);
    const float vi = HASV ? sv[VV * NST * 64 + s * 64 + lane] : 0.f;
    float sa0 = 0.f, sa1 = 0.f, sa2 = 0.f, sa3 = 0.f;
    dpp_dot4<0>(sa0, sa1, sa2, sa3, S, xa);
    const float sa = (sa0 + sa1) + (sa2 + sa3);
    float o0 = 0.f, o1 = 0.f, o2 = 0.f, o3 = 0.f;
    dpp_upd4<0, HASV, OUT>(S, xb, xk, xr, sa, vi, o0, o1, o2, o3);
    if (OUT) emit(s, (o0 + o1) + (o2 + o3));
    if ((s & 7) == 7) {
      const float4 xg = *(const float4*)(sv + VW * NST * 64 + (s >> 3) * 64 + l15 * 4);
      dpp_scale4<0>(S, xg);
    }
  }
}
DI int vperm(int j) { return (j & 15) * 4 + (j >> 4); }

DI void shift8(const bf16_t* PRKV, const P& p, int sbase, int pos, int L, int off, int c0, float (&out)[8]) {
  const bf16_t* rp = PRKV + (size_t)(sbase + pos) * 1536 + off + c0;
  const u32x4 uc = *(const u32x4*)rp;
  u32x4 up = (u32x4)(0u), un = (u32x4)(0u);
  if (pos > 0) up = *(const u32x4*)(rp - 1536);
  if (pos < L - 1) un = *(const u32x4*)(rp + 1536);
  const f32x4v mp0 = *(const f32x4v*)(p.mu_prev + off + c0), mp1 = *(const f32x4v*)(p.mu_prev + off + c0 + 4);
  const f32x4v mn0 = *(const f32x4v*)(p.mu_next + off + c0), mn1 = *(const f32x4v*)(p.mu_next + off + c0 + 4);
#pragma unroll
  for (int e2 = 0; e2 < 4; ++e2) {
    const float c_lo = lo2f(uc[e2]), c_hi = hi2f(uc[e2]);
    const float mpl = e2 < 2 ? mp0[2 * e2] : mp1[2 * e2 - 4], mph = e2 < 2 ? mp0[2 * e2 + 1] : mp1[2 * e2 - 3];
    const float mnl = e2 < 2 ? mn0[2 * e2] : mn1[2 * e2 - 4], mnh = e2 < 2 ? mn0[2 * e2 + 1] : mn1[2 * e2 - 3];
    out[2 * e2] = c_lo + mpl * (lo2f(up[e2]) - c_lo) + mnl * (lo2f(un[e2]) - c_lo);
    out[2 * e2 + 1] = c_hi + mph * (hi2f(up[e2]) - c_hi) + mnh * (hi2f(un[e2]) - c_hi);
  }
}

template <int NST, bool P3>
DI void scan_prologue8(const P& p, int sbase, int L, int hd, int dir, int pos0, int nsteps, int sb0, float* sv) {
  const int lane = threadIdx.x & 63, l31 = lane & 31, h = lane >> 5;
  const bf16_t* PRKV = (const bf16_t*)(p.ws + O_PRKV);
  const bf16_t* LR = (const bf16_t*)(p.ws + O_LR);
  const bf16_t* WUPT = (const bf16_t*)(p.ws + O_WUPT) + (size_t)(dir * 512 + hd * 64) * 64;
  const bf16_t* AUPT = (const bf16_t*)(p.ws + O_AUPT) + (size_t)(dir * 512 + hd * 64) * 64;
  float* bonus = (float*)(p.ws + O_BONUS);
  {
    int sl = sb0 + (l31 & 7); if (sl > nsteps - 1) sl = nsteps - 1;
    const int pos = dir ? pos0 - sl : pos0 + sl;
    const bf16_t* lrp = LR + (size_t)(sbase + pos) * 384 + dir * 64 + 8 * h;
#pragma unroll 1
    for (int mat = 0; mat < 2; ++mat) {
      const bf16_t* Wm = mat ? AUPT : WUPT;
      const float* bias = mat ? p.d_a0 : p.d_w0;
      f32x16 ac[2];
#pragma unroll
      for (int nt = 0; nt < 2; ++nt)
#pragma unroll
        for (int i = 0; i < 16; ++i) ac[nt][i] = 0.f;
#pragma unroll
      for (int ks = 0; ks < 4; ++ks) {
        const bf16x8 fa = *(const bf16x8*)(lrp + mat * 128 + 16 * ks);
#pragma unroll
        for (int nt = 0; nt < 2; ++nt) {
          const bf16x8 bw = *(const bf16x8*)(Wm + (size_t)(32 * nt + l31) * 64 + 16 * ks + 8 * h);
          ac[nt] = MFMA32(fa, bw, ac[nt]);
        }
      }
#pragma unroll
      for (int nt = 0; nt < 2; ++nt) {
        const int j = 32 * nt + l31;
        const float b0 = bias[dir * 512 + hd * 64 + j];
#pragma unroll
        for (int i = 0; i < 4; ++i) {
          const int st = sb0 + i + 4 * h;
          const float sg = 1.f / (1.f + __expf(-(b0 + ac[nt][i])));
          if (mat) sv[VK * NST * 64 + st * 64 + j] = sg;
          else ac[nt][i] = __expf(-0.6065306597126334f * sg);
        }
        if (!mat) {
          float g0 = ac[nt][0], g1 = g0 * ac[nt][1], g2 = g1 * ac[nt][2], g3 = g2 * ac[nt][3];
          const float tot_lo = __shfl(g3, l31);
          if (h) { g0 *= tot_lo; g1 *= tot_lo; g2 *= tot_lo; g3 *= tot_lo; }
          float* gd = sv + VA * NST * 64 + (sb0 + 4 * h) * 64 + j;
          gd[0] = g0; gd[64] = g1; gd[128] = g2; gd[192] = g3;
          if (h) sv[VW * NST * 64 + (sb0 >> 3) * 64 + vperm(j)] = g3;
        }
      }
    }
  }
  const int stp = lane >> 3, seg = lane & 7, c0 = hd * 64 + 8 * seg;
  const int s = sb0 + stp;
  const int ss = s < nsteps ? s : nsteps - 1;
  const int pos = dir ? pos0 - ss : pos0 + ss;
  float k[8], a[8], gam[8], gpr[8];
  shift8(PRKV, p, sbase, pos, L, 512, c0, k);
  {
    const f32x4v a0 = *(const f32x4v*)(sv + VK * NST * 64 + s * 64 + 8 * seg), a1 = *(const f32x4v*)(sv + VK * NST * 64 + s * 64 + 8 * seg + 4);
    const f32x4v g0 = *(const f32x4v*)(sv + VA * NST * 64 + s * 64 + 8 * seg), g1 = *(const f32x4v*)(sv + VA * NST * 64 + s * 64 + 8 * seg + 4);
    const int sp = stp > 0 ? s - 1 : s;
    const f32x4v q0 = *(const f32x4v*)(sv + VA * NST * 64 + sp * 64 + 8 * seg), q1 = *(const f32x4v*)(sv + VA * NST * 64 + sp * 64 + 8 * seg + 4);
#pragma unroll
    for (int e = 0; e < 4; ++e) {
      a[e] = a0[e]; a[4 + e] = a1[e]; gam[e] = g0[e]; gam[4 + e] = g1[e];
      gpr[e] = stp > 0 ? q0[e] : 1.f; gpr[4 + e] = stp > 0 ? q1[e] : 1.f;
    }
  }
  const f32x4v kk0 = *(const f32x4v*)(p.d_k_k + c0), kk1 = *(const f32x4v*)(p.d_k_k + c0 + 4);
  const f32x4v ka0 = *(const f32x4v*)(p.d_k_a + c0), ka1 = *(const f32x4v*)(p.d_k_a + c0 + 4);
  float kk[8], kd[8];
  float n2 = 0.f;
#pragma unroll
  for (int e = 0; e < 8; ++e) {
    kk[e] = k[e] * (e < 4 ? kk0[e] : kk1[e - 4]);
    n2 += kk[e] * kk[e];
    kd[e] = k[e] * (1.f + (a[e] - 1.f) * (e < 4 ? ka0[e] : ka1[e - 4]));
  }
  n2 += __shfl_xor(n2, 1); n2 += __shfl_xor(n2, 2); n2 += __shfl_xor(n2, 4);
  const float rn = rsqrtf(fmaxf(n2, 1e-24f));
#pragma unroll
  for (int e = 0; e < 8; ++e) {
    const int ix = s * 64 + vperm(8 * seg + e);
    const float kn = kk[e] * rn;
    const float ig = __builtin_amdgcn_rcpf(gam[e]);
    sv[VA * NST * 64 + ix] = -kn * gpr[e];
    sv[VB * NST * 64 + ix] = kn * a[e] * ig;
    sv[VK * NST * 64 + ix] = kd[e] * ig;
  }
  {
    float v[8];
    shift8(PRKV, p, sbase, pos, L, 1024, c0, v);
    *(f32x4v*)(sv + VV * NST * 64 + s * 64 + 8 * seg) = (f32x4v){v[0], v[1], v[2], v[3]};
    *(f32x4v*)(sv + VV * NST * 64 + s * 64 + 8 * seg + 4) = (f32x4v){v[4], v[5], v[6], v[7]};
  }
  if (P3) {
    float r[8];
    shift8(PRKV, p, sbase, pos, L, 0, c0, r);
    const f32x4v rk0 = *(const f32x4v*)(p.d_r_k + c0), rk1 = *(const f32x4v*)(p.d_r_k + c0 + 4);
    float bn = 0.f;
#pragma unroll
    for (int e = 0; e < 8; ++e) {
      sv[VR * NST * 64 + s * 64 + vperm(8 * seg + e)] = r[e] * gam[e];
      bn += r[e] * kd[e] * (e < 4 ? rk0[e] : rk1[e - 4]);
    }
    bn += __shfl_xor(bn, 1); bn += __shfl_xor(bn, 2); bn += __shfl_xor(bn, 4);
    if (s < nsteps && seg == 0) bonus[((size_t)(sbase + pos) * 8 + hd) * 2 + dir] = bn;
  }
}

DI unsigned scan_touch(const P& p, int sbase, int L, int hd, int dir, int posf  ) {
  const int lane = threadIdx.x & 63;
  const bf16_t* PRKV = (const bf16_t*)(p.ws + O_PRKV);
  const bf16_t* LR = (const bf16_t*)(p.ws + O_LR);
  const int lo = dir ? posf - 8 : posf - 1;
  const unsigned* ptr;
  if (lane < 30) { int row = lo + lane / 3; row = row < 0 ? 0 : (row > L - 1 ? L - 1 : row); ptr = (const unsigned*)(PRKV + (size_t)(sbase + row) * 1536 + (lane % 3) * 512 + hd * 64); }
  else { const int i2 = (lane - 30) & 15; int row = dir ? posf - (i2 >> 1) : posf + (i2 >> 1); row = row < 0 ? 0 : (row > L - 1 ? L - 1 : row); ptr = (const unsigned*)(LR + (size_t)(sbase + row) * 384 + (i2 & 1) * 128 + dir * 64); }
  return *ptr;
}

template <bool HALF> DI void scan1_body(const P& p, char* lds) {
  float* PQ = (float*)(p.ws + O_PQ);
  const int lane = threadIdx.x & 63, wave = __builtin_amdgcn_readfirstlane(threadIdx.x >> 6), slot = wave >> 1;
  constexpr int half = HALF ? 1 : 0;
  float* sv = (float*)lds + slot * (6 * 16 * 64);
  for (int g = blockIdx.x; g < 804; g += gridDim.x) {
    int seq, c, hp;
    if (g < 768) { const int lc = g >> 2; hp = g & 3; if (lc < 128) { seq = lc >> 4; c = lc & 15; } else { seq = 8; c = lc - 128; } }
    else { const int j = g - 768; hp = j & 3; seq = j >> 2; c = seq < 8 ? 16 : 64; }
    const int cgi = seq < 8 ? seq * 17 + c : 136 + c;
    const int hd = hp * 2 + (slot >> 1), dir = slot & 1;
    const int it = (cgi * 8 + hd) * 2 + dir;
    const int L = seq_len(seq), sbase = seq_base(seq);
    const int start = c * 256, end = min(L, start + 256), n = end - start;
    float S[64];
#pragma unroll
    for (int j = 0; j < 64; ++j) S[j] = (half == 0 && j == lane) ? 1.f : 0.f;
    for (int s0 = 0; s0 < n; s0 += 16) {
      const int ns = min(16, n - s0);
      const int pos0 = dir ? end - 1 - s0 : start + s0;
      __syncthreads();
      scan_prologue8<16, false>(p, sbase, L, hd, dir, pos0, ns, half * 8, sv);
      __syncthreads();
      unsigned tch = 0u;
      if (s0 + 16 < n) tch = scan_touch(p, sbase, L, hd, dir, dir ? pos0 - 16 - half * 8 : pos0 + 16 + half * 8);
      scan_steps<16, HALF, false>(S, sv, ns, lane, [](int, float) {});
      asm volatile("" :: "v"(tch));
    }
    float* dst = PQ + (size_t)it * 8192 + (size_t)(half * 64 + lane) * 64;
#pragma unroll
    for (int q = 0; q < 16; ++q) *(float4*)(dst + q * 4) = make_float4(S[q * 4], S[q * 4 + 1], S[q * 4 + 2], S[q * 4 + 3]);
  }
}

DI void phase_scan1(const P& p, char* lds) {
  const int w_ = __builtin_amdgcn_readfirstlane(threadIdx.x >> 6);
  if ((w_ ^ (w_ >> 2)) & 1) scan1_body<true>(p, lds); else scan1_body<false>(p, lds);
}

DI void phase_scan2(const P& p, char* lds) {
  float* Ss = (float*)lds;
  float* Ps = Ss + 64 * 65;
  float* PQ = (float*)(p.ws + O_PQ);
  const int tid = threadIdx.x, lane = tid & 63, wave = __builtin_amdgcn_readfirstlane(tid >> 6), l31 = lane & 31, h = lane >> 5;
  const int r0 = 32 * (wave >> 1), c0 = 32 * (wave & 1);
  for (int it = blockIdx.x; it < 144; it += gridDim.x) {
    const int dir = it & 1, hd = (it >> 1) & 7, seq = it >> 4;
    const int nch = seq < 8 ? 17 : 65, cg0 = seq < 8 ? seq * 17 : 136;
    f32x16 S;
#pragma unroll
    for (int i = 0; i < 16; ++i) S[i] = 0.f;
    f32x4v pn0, pn1;
    {
      const int c = dir ? nch - 1 : 0;
      const float* Pg = PQ + (size_t)(((cg0 + c) * 8 + hd) * 2 + dir) * 8192;
      pn0 = *(const f32x4v*)(Pg + tid * 4); pn1 = *(const f32x4v*)(Pg + (512 + tid) * 4);
    }
    for (int cc = 0; cc < nch; ++cc) {
      const int c = dir ? nch - 1 - cc : cc;
      float* Qg = PQ + (size_t)(((cg0 + c) * 8 + hd) * 2 + dir) * 8192 + 4096;
      __syncthreads();
      { const int m = tid >> 4, cq = (tid & 15) * 4; *(f32x4v*)(Ps + m * 68 + cq) = pn0; *(f32x4v*)(Ps + (m + 32) * 68 + cq) = pn1; }
      f32x16 acc;
      if (wave < 4) {
#pragma unroll
        for (int i = 0; i < 16; ++i) {
          const int row = r0 + (i & 3) + 8 * (i >> 2) + 4 * h;
          Ss[row * 65 + c0 + l31] = S[i];
          float* qp = Qg + row * 64 + c0 + l31;
          acc[i] = *qp;
          *qp = S[i];
        }
      }
      if (cc + 1 < nch) {
        const int c2 = dir ? nch - 2 - cc : cc + 1;
        const float* Pg2 = PQ + (size_t)(((cg0 + c2) * 8 + hd) * 2 + dir) * 8192;
        pn0 = *(const f32x4v*)(Pg2 + tid * 4); pn1 = *(const f32x4v*)(Pg2 + (512 + tid) * 4);
      }
      __syncthreads();
      if (wave < 4) {
#pragma unroll 8
        for (int kk = 0; kk < 32; ++kk) {
          const float av = Ss[(r0 + l31) * 65 + 2 * kk + h];
          const float bv = Ps[(2 * kk + h) * 68 + c0 + l31];
          acc = __builtin_amdgcn_mfma_f32_32x32x2f32(av, bv, acc, 0, 0, 0);
        }
        S = acc;
      }
    }
  }
}

DI void phase_scan3(const P& p, char* lds) {
  const float* PQ = (const float*)(p.ws + O_PQ);
  bf16_t* MIX = (bf16_t*)(p.ws + O_MIX);
  bf16_t* OB = (bf16_t*)(p.ws + O_OB);
  const int lane = threadIdx.x & 63, wave = __builtin_amdgcn_readfirstlane(threadIdx.x >> 6);
  float* sv = (float*)lds + wave * (6 * 8 * 64);
  const bool bal = gridDim.x == 256;
  const int NW = gridDim.x * 8, gw = blockIdx.x * 8 + wave;
  for (int k = 0; ; ++k) {
    int oi;
    if (bal) {
      if (k == 0) oi = gw;
      else if (k == 1) { if (wave >= 4) continue; oi = 2048 + blockIdx.x * 4 + wave; }
      else if (k == 2) { if (wave != 7 || blockIdx.x >= 144) break; oi = 3072 + blockIdx.x; }
      else break;
    } else { oi = gw + k * NW; if (oi >= 3216) break; }
    int seq, c, hd, dir;
    if (oi < 3072) { const int lc = oi >> 4; hd = (oi >> 1) & 7; dir = oi & 1; if (lc < 128) { seq = lc >> 4; c = lc & 15; } else { seq = 8; c = lc - 128; } }
    else { const int j = oi - 3072; hd = (j >> 1) & 7; dir = j & 1; seq = j >> 4; c = seq < 8 ? 16 : 64; }
    const int it = ((seq < 8 ? seq * 17 + c : 136 + c) * 8 + hd) * 2 + dir;
    const int L = seq_len(seq), sbase = seq_base(seq);
    const int start = c * 256, end = min(L, start + 256), n = end - start;
    float S[64];
    {
      const float* src = PQ + (size_t)it * 8192 + 4096 + lane * 64;
#pragma unroll
      for (int q = 0; q < 16; ++q) { float4 t = *(const float4*)(src + q * 4); S[q * 4] = t.x; S[q * 4 + 1] = t.y; S[q * 4 + 2] = t.z; S[q * 4 + 3] = t.w; }
    }
    for (int s0 = 0; s0 < n; s0 += 8) {
      const int ns = min(8, n - s0);
      const int pos0 = dir ? end - 1 - s0 : start + s0;
      scan_prologue8<8, true>(p, sbase, L, hd, dir, pos0, ns, 0, sv);
      unsigned tch = 0u;
      if (s0 + 8 < n) tch = scan_touch(p, sbase, L, hd, dir, dir ? pos0 - 8 : pos0 + 8);
      scan_steps<8, true, true>(S, sv, ns, lane, [&](int st, float o) {
        const int pos = dir ? pos0 - st : pos0 + st;
        const size_t sr = (size_t)(sbase + pos);
        if (dir == 0) MIX[sr * 1024 + 512 + hd * 64 + lane] = f2bf(o);
        else OB[sr * 512 + hd * 64 + lane] = f2bf(o);
      });
      asm volatile("" :: "v"(tch));
    }
  }
}

DI void phase_rwkv_final(const P& p) {
  const int lane = threadIdx.x & 63, gw = (blockIdx.x * NTH + threadIdx.x) >> 6, nw = (gridDim.x * NTH) >> 6;
  bf16_t* MIX = (bf16_t*)(p.ws + O_MIX);
  const bf16_t* OB = (const bf16_t*)(p.ws + O_OB);
  const bf16_t* G = (const bf16_t*)(p.ws + O_G);
  const bf16_t* PRKV = (const bf16_t*)(p.ws + O_PRKV);
  const float* bonus = (const float*)(p.ws + O_BONUS);
  const int hd = lane >> 3, c0 = lane * 8;
  float mp[8], mn[8], lg[8], lb[8];
#pragma unroll
  for (int j = 0; j < 8; ++j) { mp[j] = p.mu_prev[1024 + c0 + j]; mn[j] = p.mu_next[1024 + c0 + j]; lg[j] = p.d_ln_g[c0 + j]; lb[j] = p.d_ln_b[c0 + j]; }
  for (int sr = gw; sr < T_; sr += nw) {
    int pos; int b = seq_of(sr, pos);
    const int L = seq_len(b);
    const u32x4 uf = *(const u32x4*)(MIX + (size_t)sr * 1024 + 512 + c0);
    const u32x4 ub = *(const u32x4*)(OB + (size_t)sr * 512 + c0);
    const u32x4 ug = *(const u32x4*)(G + (size_t)sr * 512 + c0);
    const bf16_t* vr = PRKV + (size_t)sr * 1536 + 1024 + c0;
    const u32x4 vc = *(const u32x4*)vr;
    const u32x4 vp = *(const u32x4*)(pos > 0 ? vr - 1536 : vr);
    const u32x4 vn = *(const u32x4*)(pos < L - 1 ? vr + 1536 : vr);
    const float2 bn = *(const float2*)(bonus + ((size_t)sr * 8 + hd) * 2);
    const bool hp = pos > 0, hn = pos < L - 1;
    float o[8], gg[8], vsh[8];
    float sm = 0.f;
#pragma unroll
    for (int j = 0; j < 4; ++j) {
      o[2 * j] = lo2f(uf[j]) + lo2f(ub[j]); o[2 * j + 1] = hi2f(uf[j]) + hi2f(ub[j]);
      gg[2 * j] = lo2f(ug[j]); gg[2 * j + 1] = hi2f(ug[j]);
      sm += o[2 * j] + o[2 * j + 1];
      const float c_lo = lo2f(vc[j]), c_hi = hi2f(vc[j]);
      const float p_lo = hp ? lo2f(vp[j]) : 0.f, p_hi = hp ? hi2f(vp[j]) : 0.f;
      const float n_lo = hn ? lo2f(vn[j]) : 0.f, n_hi = hn ? hi2f(vn[j]) : 0.f;
      vsh[2 * j] = c_lo + mp[2 * j] * (p_lo - c_lo) + mn[2 * j] * (n_lo - c_lo);
      vsh[2 * j + 1] = c_hi + mp[2 * j + 1] * (p_hi - c_hi) + mn[2 * j + 1] * (n_hi - c_hi);
    }
    sm += __shfl_xor(sm, 1); sm += __shfl_xor(sm, 2); sm += __shfl_xor(sm, 4);
    const float mean = sm * (1.f / 64.f);
    float vs = 0.f;
#pragma unroll
    for (int j = 0; j < 8; ++j) { float dlt = o[j] - mean; vs += dlt * dlt; }
    vs += __shfl_xor(vs, 1); vs += __shfl_xor(vs, 2); vs += __shfl_xor(vs, 4);
    const float rstd = rsqrtf(vs * (1.f / 64.f) + 64e-5f);
    const float bsum = bn.x + bn.y;
    float y[8];
#pragma unroll
    for (int j = 0; j < 8; ++j) y[j] = ((o[j] - mean) * rstd * lg[j] + lb[j] + bsum * vsh[j]) * gg[j];
    *(uint4*)(MIX + (size_t)sr * 1024 + 512 + c0) = make_uint4(pack2(y[0], y[1]), pack2(y[2], y[3]), pack2(y[4], y[5]), pack2(y[6], y[7]));
  }
}

#define XB_TMO      128
#define XB_XCNT(j)  (256  + 64 * (j))
#define XB_XSUB(j)  (1280 + 64 * (j))
#define XB_XGEN(j)  (2304 + 64 * (j))
#define XB_TOP      3328
#define XB_TOPGEN   3392
#define XCD_BAR_WORDS 3456
#define XB_SPIN_CAP (1u << 23)
#define LAS __attribute__((address_space(3)))

__device__ __forceinline__ unsigned xb_ld(unsigned* p)              { return __hip_atomic_load(p, __ATOMIC_RELAXED, __HIP_MEMORY_SCOPE_AGENT); }
__device__ __forceinline__ unsigned xb_add(unsigned* p, unsigned v) { return __hip_atomic_fetch_add(p, v, __ATOMIC_RELAXED, __HIP_MEMORY_SCOPE_AGENT); }
__device__ __forceinline__ unsigned xb_xcc_id() { return (unsigned)__builtin_amdgcn_s_getreg((3 << 11) | 20) & 0xFu; }
#define XB_SPIN(cond, bar) do { unsigned _sp = 0; while (cond) { __builtin_amdgcn_s_sleep(1); \
    if ((++_sp & 255u) == 0u) { if (xb_ld(&(bar)[XB_TMO])) break; if (_sp > XB_SPIN_CAP) { atomicAdd(&(bar)[XB_TMO], 1u); break; } } } } while (0)

struct XcdBarrier {
    unsigned* bar; unsigned x;
    volatile LAS unsigned* st;
};

__device__ __forceinline__ XcdBarrier xcd_barrier_post(unsigned* bar, volatile LAS unsigned* st) {
    XcdBarrier b; b.bar = bar; b.x = xb_xcc_id(); b.st = st;
    if (threadIdx.x == 0) (void)xb_add(&bar[XB_XCNT(b.x)], 1u);
    return b;
}
__device__ __forceinline__ void xcd_barrier_complete(unsigned* bar, unsigned x, unsigned& nloc, unsigned& nx) {
    const unsigned G = gridDim.x * gridDim.y * gridDim.z;
    unsigned sum, cnt, mine, sp = 0u;
    for (;;) {
        sum = 0u; cnt = 0u; mine = 0u;
#pragma unroll
        for (unsigned j = 0; j < 16; ++j) { const unsigned c = xb_ld(&bar[XB_XCNT(j)]); sum += c; cnt += (c > 0u) ? 1u : 0u; mine = (j == x) ? c : mine; }
        if (sum == G) break;
        __builtin_amdgcn_s_sleep(1);
        if ((++sp & 255u) == 0u) { if (xb_ld(&bar[XB_TMO])) break; if (sp > XB_SPIN_CAP) { atomicAdd(&bar[XB_TMO], 1u); break; } }
    }
    nloc = mine > 0u ? mine : 1u; nx = cnt > 0u ? cnt : 1u;
}

__device__ __forceinline__ void xcd_barrier(const XcdBarrier& b) {
    asm volatile("s_waitcnt vmcnt(0)" ::: "memory");
    __syncthreads();
    if (threadIdx.x == 0) {
        unsigned* bar = b.bar;
        __builtin_amdgcn_s_waitcnt(0);
        unsigned nloc = b.st[0], nx = b.st[1];
        if (nloc == 0u) { xcd_barrier_complete(bar, b.x, nloc, nx); b.st[0] = nloc; b.st[1] = nx; }
        const unsigned old = xb_add(&bar[XB_XSUB(b.x)], 1u);
        const unsigned gen = old / nloc;
        if (old + 1u == (gen + 1u) * nloc) {
            __builtin_amdgcn_fence(__ATOMIC_RELEASE, "agent");
            asm volatile("s_waitcnt vmcnt(0)" ::: "memory");
            const unsigned og = xb_add(&bar[XB_TOP], 1u);
            const unsigned tg = og / nx;
            if (og + 1u == (tg + 1u) * nx) xb_add(&bar[XB_TOPGEN], 1u);
            else XB_SPIN(xb_ld(&bar[XB_TOPGEN]) == tg, bar);
            __builtin_amdgcn_fence(__ATOMIC_ACQUIRE, "agent");
            xb_add(&bar[XB_XGEN(b.x)], 1u);
            asm volatile("s_waitcnt vmcnt(0)" ::: "memory");
        } else {
            XB_SPIN(xb_ld(&bar[XB_XGEN(b.x)]) == gen, bar);
            __builtin_amdgcn_fence(__ATOMIC_ACQUIRE, "agent");
            asm volatile("s_waitcnt vmcnt(0)" ::: "memory");
        }
    }
    __syncthreads();
}

constexpr int NPHASE = 23;
__global__ void __launch_bounds__(NTH, 2) mega(P p) {
  extern __shared__ __attribute__((aligned(16))) unsigned char shm[];
  char* lds = (char*)shm;
  char* ws = p.ws;
  if (threadIdx.x == 0) *(uint4*)(shm + 131072) = make_uint4(0u, 0u, 0u, 0u);
  __syncthreads();
  const XcdBarrier xb = xcd_barrier_post((unsigned*)(ws + O_BAR), (volatile LAS unsigned*)(shm + 131072));
#ifndef DUP_MASK
#define DUP_MASK 0u
#endif
#define RUN(k, call) if (p.ph0 <= k && k < p.ph1) { call; if (k + 1 < p.ph1) { if (k == 0) cg::this_grid().sync(); else xcd_barrier(xb); } }
  RUN(0, phase_prep(p))
  RUN(1, phase_gemm_big((const bf16_t*)(ws + O_HN), (const bf16_t*)(ws + O_WIN0), 1536, 1024, (bf16_t*)(ws + O_PROJ0), 1536, 0, ws, shm))
  RUN(2, phase_prepA(p, lds))
  RUN(3, phase_attnA(p, lds))
  RUN(4, phase_fnet_gemm(p, lds))
  RUN(5, phase_gemm_big((const bf16_t*)(ws + O_MIX), (const bf16_t*)(ws + O_WOUT0), 1024, 1024, (bf16_t*)(ws + O_HN), 1024, 0, ws, shm))
  RUN(6, phase_resnorm(p, p.post_mix_g, p.pre_ffn_g, true))
  RUN(7, phase_gemm_gateup((const bf16_t*)(ws + O_HN), (const bf16_t*)(ws + O_WGU0), (bf16_t*)(ws + O_ACT), shm))
  RUN(8, phase_gemm_big((const bf16_t*)(ws + O_ACT), (const bf16_t*)(ws + O_WD0), 1024, DFF, (bf16_t*)(ws + O_HN), 1024, 0, ws, shm))
  RUN(9, phase_resnorm(p, p.post_ffn_g, p.pre_mix_g + 1024))
  RUN(10, phase_gemm_big((const bf16_t*)(ws + O_HN), (const bf16_t*)(ws + O_WIN1), 2816, 1024, nullptr, 0, 1, ws, shm))
  RUN(11, phase_prepC(p, lds))
  RUN(12, phase_attnC(p, lds))
  RUN(13, phase_scan1(p, lds))
  RUN(14, (phase_scan2(p, lds), late_weights(p)))
  RUN(15, phase_scan3(p, lds))
  RUN(16, phase_gemm_small((const bf16_t*)(ws + O_LR) + 256, 384, (const bf16_t*)(ws + O_GUP), 512, 128, (bf16_t*)(ws + O_G), 512, lds))
  RUN(17, phase_rwkv_final(p))
  RUN(18, phase_gemm_big((const bf16_t*)(ws + O_MIX), (const bf16_t*)(ws + O_WOUT1), 1024, 1024, (bf16_t*)(ws + O_HN), 1024, 0, ws, shm))
  RUN(19, phase_resnorm(p, p.post_mix_g + 1024, p.pre_ffn_g + 1024))
  RUN(20, phase_gemm_gateup((const bf16_t*)(ws + O_HN), (const bf16_t*)(ws + O_WGU1), (bf16_t*)(ws + O_ACT), shm))
  RUN(21, phase_gemm_big((const bf16_t*)(ws + O_ACT), (const bf16_t*)(ws + O_WD1), 1024, DFF, (bf16_t*)(ws + O_HN), 1024, 0, ws, shm))
  RUN(22, phase_resnorm(p, p.post_ffn_g + 1024, nullptr))
#undef RUN
}

extern "C" void kernel_launch(void* const* d_in, const int* in_sizes, int n_in, void* d_out, int out_size, void* d_ws, size_t ws_size,
                              hipStream_t stream) {
  static int grid_blocks = 0;
  if (!grid_blocks) {
    int dev = 0, cus = 0, per_cu = 0;
    (void)hipGetDevice(&dev);
    (void)hipDeviceGetAttribute(&cus, hipDeviceAttributeMultiprocessorCount, dev);
    if (hipFuncSetAttribute((const void*)mega, hipFuncAttributeMaxDynamicSharedMemorySize, LDS_BYTES) != hipSuccess) fprintf(stderr, "hipFuncSetAttribute failed\n");
    if (hipOccupancyMaxActiveBlocksPerMultiprocessor(&per_cu, (const void*)mega, NTH, LDS_BYTES) != hipSuccess || per_cu < 1) {
      fprintf(stderr, "occupancy query says %d\n", per_cu);
      (void)hipGetLastError();
    }
    grid_blocks = cus;
  }
  if (ws_size < O_BAR + CTL_BYTES) { fprintf(stderr, "workspace too small\n"); return; }
  if (hipMemsetAsync((char*)d_ws + O_BAR, 0, CTL_BYTES, stream) != hipSuccess) { fprintf(stderr, "memset failed\n"); return; }
  P p{};
  const float** f = (const float**)&p;
  for (int i = 0; i < 32; ++i) f[i] = (const float*)d_in[i];
  p.out = (float*)d_out;
  p.ws = (char*)d_ws;
#if FUSED
  p.ph0 = 0; p.ph1 = NPHASE;
  void* args[] = {&p};
  hipError_t e = hipLaunchCooperativeKernel((void*)mega, dim3(grid_blocks), dim3(NTH), args, LDS_BYTES, stream);
  if (e != hipSuccess) fprintf(stderr, "cooperative launch failed: %s (grid %d)\n", hipGetErrorString(e), grid_blocks);
#else
  for (int ph = 0; ph < NPHASE; ++ph) {
    p.ph0 = ph; p.ph1 = ph + 1;
    hipLaunchKernelGGL(mega, dim3(grid_blocks), dim3(NTH), LDS_BYTES, stream, p);
  }
#endif
}
```

```cpp
#include <hip/hip_runtime.h>
#include <hip/hip_cooperative_groups.h>
#include <cstdio>
namespace cg = cooperative_groups;

#ifndef FUSED
#define FUSED 1
#endif

typedef unsigned short bf16_t;
using bf16x8 = __attribute__((ext_vector_type(8))) short;
using s16x4 = __attribute__((ext_vector_type(4))) short;
using f32x16 = __attribute__((ext_vector_type(16))) float;
using u32x4 = __attribute__((ext_vector_type(4))) unsigned;
using f32x4v = __attribute__((ext_vector_type(4))) float;
#define DI __device__ __forceinline__
#define MFMA32(a, b, c) __builtin_amdgcn_mfma_f32_32x32x16_bf16((a), (b), (c), 0, 0, 0)
constexpr int NTH = 512;
constexpr int LDS_BYTES = 131072 + 16;

constexpr int DM_ = 1024;
constexpr int T_ = 49296;
constexpr int TP_ = 49408;
constexpr int NT_ = TP_ / 128;
constexpr int DFF = 2816;
constexpr float EPS = 1e-6f;
constexpr float LOG2E = 1.4426950408889634f;

constexpr size_t SZ_ROW1024 = (size_t)TP_ * 1024 * 2;
constexpr size_t O_WIN0 = 0;
constexpr size_t O_WOUT0 = O_WIN0 + (size_t)1536 * 1024 * 2;
constexpr size_t O_WGU0 = O_WOUT0 + (size_t)1024 * 1024 * 2;
constexpr size_t O_WD0 = O_WGU0 + (size_t)5632 * 1024 * 2;
constexpr size_t O_DM257 = O_WD0 + (size_t)1024 * 2816 * 2;
constexpr size_t O_DM1025 = O_DM257 + (size_t)384 * 576 * 2;
constexpr size_t O_WIN1 = O_DM1025 + (size_t)1152 * 2112 * 2;
constexpr size_t O_WOUT1 = O_WIN1 + (size_t)2816 * 1024 * 2;
constexpr size_t O_WGU1 = O_WOUT1 + (size_t)1024 * 1024 * 2;
constexpr size_t O_WD1 = O_WGU1 + (size_t)5632 * 1024 * 2;
constexpr size_t O_GUP = O_WD1 + (size_t)1024 * 2816 * 2;
constexpr size_t O_RA = O_GUP + (size_t)512 * 128 * 2;
constexpr size_t O_RB = O_RA + SZ_ROW1024;
constexpr size_t O_RC = O_RB + (size_t)TP_ * 2816 * 2;
constexpr size_t O_META = O_RC + SZ_ROW1024;
constexpr size_t O_WC = O_META + (size_t)144 * 1024 * 4;
constexpr size_t O_WUPT = O_WC + (size_t)4 * 64 * 128 * 4;
constexpr size_t O_AUPT = O_WUPT + (size_t)2 * 512 * 64 * 2;
constexpr size_t O_END = O_AUPT + (size_t)2 * 512 * 64 * 2;
constexpr size_t O_HN = O_RA;
constexpr size_t O_VTA = O_RA;
constexpr size_t O_LR = O_RA;
constexpr size_t O_BONUS = O_RA + (size_t)TP_ * 384 * 2;
constexpr size_t O_VTC = O_BONUS + (size_t)T_ * 16 * 4;
constexpr size_t O_OB = O_RA + (size_t)TP_ * 512 * 2;
constexpr size_t O_PROJ0 = O_RB;
constexpr size_t O_ZB = O_PROJ0 + (size_t)TP_ * 1536 * 2;
constexpr size_t O_Y = O_ZB + (size_t)TP_ * 512 * 2;
constexpr size_t O_ACT = O_RB;
constexpr size_t O_PRKV = O_RB;
constexpr size_t O_PC = O_PRKV + (size_t)TP_ * 1536 * 2;
constexpr size_t O_PLOW = O_PC + (size_t)TP_ * 768 * 2;
constexpr size_t O_PQ = O_PC;
constexpr size_t O_G = O_PC;
constexpr size_t O_MIX = O_RC;
static_assert(O_VTC + (size_t)49728 * 128 * 2 <= O_RB, "vtc");
static_assert(O_Y + (size_t)(8 * 16 * 256 * 576 + 16 * 256 * 2112) * 2 <= O_RC, "y");
static_assert(O_PQ + (size_t)3216 * 32768 <= O_RC, "pq");
constexpr size_t O_BAR = (O_END + 255) / 256 * 256;
constexpr size_t O_CNT = O_BAR + 3456 * 4;
constexpr size_t CTL_BYTES = 3456 * 4 + 4 * 256;
static_assert(O_BAR + CTL_BYTES <= (size_t)536870912, "ws");

struct P {
  const float *x_prompt, *x_sample, *meta, *pre_mix_g, *post_mix_g, *pre_ffn_g, *post_ffn_g;
  const float *even_w_in, *even_w_out, *a_q_gain, *a_k_gain, *b_norm_g, *b_w, *b_b;
  const float *odd_w_in, *odd_w_out, *c_sink, *mu_prev, *mu_next, *d_w0, *d_w_up, *d_a0, *d_a_up, *d_g_up;
  const float *d_k_k, *d_k_a, *d_r_k, *d_ln_g, *d_ln_b, *ffn_gate, *ffn_up, *ffn_down;
  float* out;
  char* ws;
  int ph0, ph1;
};

typedef float f32x2 __attribute__((ext_vector_type(2)));
typedef __bf16 bf16x2_t __attribute__((ext_vector_type(2)));
DI bf16_t f2bf(float x) { return __builtin_bit_cast(bf16_t, (__bf16)x); }
DI float bf2f(bf16_t b) { return __uint_as_float(((unsigned)b) << 16); }
DI unsigned pack2(float a, float b) { f32x2 v = {a, b}; return __builtin_bit_cast(unsigned, __builtin_convertvector(v, bf16x2_t)); }
DI float lo2f(unsigned u) { return __uint_as_float(u << 16); }
DI float hi2f(unsigned u) { return __uint_as_float(u & 0xffff0000u); }
DI float wave_sum(float v) {
  for (int o = 32; o > 0; o >>= 1) v += __shfl_xor(v, o);
  return v;
}
DI int seq_of(int sr, int& pos) {
  if (sr < 32896) { int b = sr / 4112; pos = sr - b * 4112; return b; }
  pos = sr - 32896; return 8;
}
DI int seq_len(int b) { return b < 8 ? 4112 : 16400; }
DI int seq_base(int b) { return b < 8 ? b * 4112 : 32896; }
DI float* hrow(const P& p, int sr) {
  int pos; int b = seq_of(sr, pos);
  if (pos < 16) return (float*)(p.ws + O_META) + (size_t)(b * 16 + pos) * 1024;
  return p.out + ((size_t)(b < 8 ? b * 4096 : 32768) + (pos - 16)) * 1024;
}
DI float sigmoidf_(float x) { return 1.f / (1.f + expf(-x)); }
DI int crow_of(int seq, int pos) { return pos < 16 ? 49152 + seq * 16 + pos : (seq < 8 ? seq * 4096 : 32768) + pos - 16; }
constexpr int OBASE_SEQ = 0x7fffffff;

DI void transpose_w(const float* W, int K, int ldw, int N, bf16_t* Wt, int mode, const float* W2, int gtid, int gsz) {
  int nk8 = K / 8;
  long total = (long)N * nk8;
  for (long it = gtid; it < total; it += gsz) {
    int n = (int)(it % N), k8 = (int)(it / N);
    const float* src = W;
    int c = n;
    if (mode == 1) {
      int blk = n >> 8, w = n & 255;
      c = blk * 128 + (w & 127);
      if (w >= 128) src = W2;
    }
    unsigned r[4];
#pragma unroll
    for (int j = 0; j < 4; ++j) {
      float a = src[(size_t)(k8 * 8 + 2 * j) * ldw + c];
      float b = src[(size_t)(k8 * 8 + 2 * j + 1) * ldw + c];
      r[j] = pack2(a, b);
    }
    *(uint4*)(Wt + (size_t)n * K + k8 * 8) = make_uint4(r[0], r[1], r[2], r[3]);
  }
}

DI void late_weights(const P& p) {
  char* ws = p.ws;
  int gtid, gsz;
  if (gridDim.x > 144 + 16) { if (blockIdx.x < 144) return; gtid = (blockIdx.x - 144) * NTH + threadIdx.x; gsz = (gridDim.x - 144) * NTH; }
  else { gtid = blockIdx.x * NTH + threadIdx.x; gsz = gridDim.x * NTH; }
  transpose_w(p.odd_w_out, 1024, 1024, 1024, (bf16_t*)(ws + O_WOUT1), 0, nullptr, gtid, gsz);
  transpose_w(p.ffn_gate + (size_t)1024 * DFF, 1024, DFF, 5632, (bf16_t*)(ws + O_WGU1), 1, p.ffn_up + (size_t)1024 * DFF, gtid, gsz);
  transpose_w(p.ffn_down + (size_t)DFF * 1024, DFF, 1024, 1024, (bf16_t*)(ws + O_WD1), 0, nullptr, gtid, gsz);
}

DI void phase_prep(const P& p) {
  const int gtid = blockIdx.x * NTH + threadIdx.x, gsz = gridDim.x * NTH;
  char* ws = p.ws;
  transpose_w(p.even_w_in, 1024, 1536, 1536, (bf16_t*)(ws + O_WIN0), 0, nullptr, gtid, gsz);
  transpose_w(p.even_w_out, 1024, 1024, 1024, (bf16_t*)(ws + O_WOUT0), 0, nullptr, gtid, gsz);
  transpose_w(p.odd_w_in, 1024, 2688, 2688, (bf16_t*)(ws + O_WIN1), 0, nullptr, gtid, gsz);
  transpose_w(p.ffn_gate, 1024, DFF, 5632, (bf16_t*)(ws + O_WGU0), 1, p.ffn_up, gtid, gsz);
  transpose_w(p.ffn_down, DFF, 1024, 1024, (bf16_t*)(ws + O_WD0), 0, nullptr, gtid, gsz);
  transpose_w(p.d_g_up, 128, 512, 512, (bf16_t*)(ws + O_GUP), 0, nullptr, gtid, gsz);
  for (int d = 0; d < 2; ++d) {
    transpose_w(p.d_w_up + (size_t)d * 64 * 512, 64, 512, 512, (bf16_t*)(ws + O_WUPT) + (size_t)d * 512 * 64, 0, nullptr, gtid, gsz);
    transpose_w(p.d_a_up + (size_t)d * 64 * 512, 64, 512, 512, (bf16_t*)(ws + O_AUPT) + (size_t)d * 512 * 64, 0, nullptr, gtid, gsz);
  }
  for (int it = gtid; it < 128 * 1024 / 8; it += gsz) *(uint4*)((bf16_t*)(ws + O_WIN1) + (size_t)2688 * 1024 + (size_t)it * 8) = make_uint4(0, 0, 0, 0);
  for (int which = 0; which < 2; ++which) {
    const int M = which ? 1025 : 257, MP = which ? 1152 : 384, KP = which ? 2112 : 576;
    bf16_t* dm = (bf16_t*)(ws + (which ? O_DM1025 : O_DM257));
    for (int it = gtid; it < MP * KP; it += gsz) {
      int r = it / KP, c = it - r * KP;
      float v = 0.f;
      if (r < M && c < 2 * M) {
        int n2 = c < M ? c : c - M;
        int m = (r * n2) % M;
        float s, co;
        sincospif(2.0f * (float)m / (float)M, &s, &co);
        v = c < M ? co : s;
      }
      dm[it] = f2bf(v);
    }
  }
  for (int it = gtid; it < 4 * 64 * 128; it += gsz) {
    int o = it & 127, c = (it >> 7) & 63, g = it >> 13;
    int d = o & 63;
    float acc = 0.f;
    for (int c2 = 0; c2 < 64; ++c2) {
      float s, co;
      sincospif((float)((c * c2) & 63) / 32.f, &s, &co);
      float w = p.b_w[(g * 64 + c2) * 64 + d];
      acc += (o < 64 ? co : -s) * w;
    }
    ((float*)(ws + O_WC))[it] = acc;
  }
  const int lane = threadIdx.x & 63, gw = gtid >> 6, nw = gsz >> 6;
  bf16_t* HN = (bf16_t*)(ws + O_HN);
  for (int sr = gw; sr < TP_; sr += nw) {
    if (sr >= T_) {
#pragma unroll
      for (int q = 0; q < 2; ++q) *(uint4*)(HN + (size_t)sr * 1024 + q * 512 + lane * 8) = make_uint4(0, 0, 0, 0);
      continue;
    }
    int pos; int b = seq_of(sr, pos);
    const float* src = pos < 16 ? p.meta + pos * 1024
                                : (b < 8 ? p.x_prompt + ((size_t)b * 4096 + pos - 16) * 1024 : p.x_sample + (size_t)(pos - 16) * 1024);
    float4 v[4];
    float ss = 0.f;
#pragma unroll
    for (int q = 0; q < 4; ++q) {
      v[q] = *(const float4*)(src + q * 256 + lane * 4);
      ss += v[q].x * v[q].x + v[q].y * v[q].y + v[q].z * v[q].z + v[q].w * v[q].w;
    }
    ss = wave_sum(ss);
    float rs = rsqrtf(ss * (1.f / 1024.f) + EPS);
#pragma unroll
    for (int q = 0; q < 4; ++q) {
      float4 g = *(const float4*)(p.pre_mix_g + q * 256 + lane * 4);
      uint2 o = make_uint2(pack2(v[q].x * rs * g.x, v[q].y * rs * g.y), pack2(v[q].z * rs * g.z, v[q].w * rs * g.w));
      *(uint2*)(HN + (size_t)sr * 1024 + q * 256 + lane * 4) = o;
    }
  }
}

DI void gemm_tile(const bf16_t* __restrict__ A, int lda, const bf16_t* __restrict__ B, int ldb, int K, char* lds, f32x16 (&acc)[2][2]) {
  const int tid = threadIdx.x & 255, lane = tid & 63, wave = tid >> 6, wm = wave >> 1, wn = wave & 1;
  const int l31 = lane & 31, h = lane >> 5;
  bf16_t* As = (bf16_t*)lds;
  bf16_t* Bs = As + 128 * 72;
#pragma unroll
  for (int a = 0; a < 2; ++a)
#pragma unroll
    for (int b = 0; b < 2; ++b)
#pragma unroll
      for (int i = 0; i < 16; ++i) acc[a][b][i] = 0.f;
  const int lr = tid >> 3, lc = (tid & 7) * 8;
  const bf16_t* Ag = A + (size_t)lr * lda + lc;
  const bf16_t* Bg = B + (size_t)lr * ldb + lc;
  u32x4 ra[4], rb[4];
#pragma unroll
  for (int q = 0; q < 4; ++q) {
    ra[q] = *(const u32x4*)(Ag + (size_t)(32 * q) * lda);
    rb[q] = *(const u32x4*)(Bg + (size_t)(32 * q) * ldb);
  }
#pragma unroll
  for (int q = 0; q < 4; ++q) {
    *(u32x4*)(As + (lr + 32 * q) * 72 + lc) = ra[q];
    *(u32x4*)(Bs + (lr + 32 * q) * 72 + lc) = rb[q];
  }
  __syncthreads();
  const int nk = K >> 6;
  for (int kt = 0; kt < nk; ++kt) {
    if (kt + 1 < nk) {
#pragma unroll
      for (int q = 0; q < 4; ++q) {
        ra[q] = *(const u32x4*)(Ag + (size_t)(32 * q) * lda + (kt + 1) * 64);
        rb[q] = *(const u32x4*)(Bg + (size_t)(32 * q) * ldb + (kt + 1) * 64);
      }
    }
#pragma unroll
    for (int ks = 0; ks < 4; ++ks) {
      bf16x8 a[2], b[2];
#pragma unroll
      for (int t = 0; t < 2; ++t) {
        a[t] = *(const bf16x8*)(As + (wm * 64 + t * 32 + l31) * 72 + ks * 16 + 8 * h);
        b[t] = *(const bf16x8*)(Bs + (wn * 64 + t * 32 + l31) * 72 + ks * 16 + 8 * h);
      }
#pragma unroll
      for (int mt = 0; mt < 2; ++mt)
#pragma unroll
        for (int nt = 0; nt < 2; ++nt) acc[mt][nt] = MFMA32(a[mt], b[nt], acc[mt][nt]);
    }
    __syncthreads();
    if (kt + 1 < nk) {
#pragma unroll
      for (int q = 0; q < 4; ++q) {
        *(u32x4*)(As + (lr + 32 * q) * 72 + lc) = ra[q];
        *(u32x4*)(Bs + (lr + 32 * q) * 72 + lc) = rb[q];
      }
      __syncthreads();
    }
  }
}
#define ACC_ROW(mt, i) (wm * 64 + (mt) * 32 + ((i) & 3) + 8 * ((i) >> 2) + 4 * h)
#define ACC_COL(nt) (wn * 64 + (nt) * 32 + l31)
#define GEMM_IDS const int lane = threadIdx.x & 63, wave = (threadIdx.x & 255) >> 6, wm = wave >> 1, wn = wave & 1, l31 = lane & 31, h = lane >> 5; (void)wm; (void)wn; (void)l31; (void)h;

DI void phase_gemm_small(const bf16_t* A, int lda, const bf16_t* W, int N, int K, bf16_t* C, int ldc, char* lds) {
  GEMM_IDS
  const int sb = threadIdx.x >> 8;
  const int ntn = N / 128;
  const int total = NT_ * ntn;
  for (int t0 = blockIdx.x * 2; t0 < total; t0 += gridDim.x * 2) {
    const int t = t0 + sb;
    const int tm = t / ntn, tn = t - tm * ntn;
    f32x16 acc[2][2];
    gemm_tile(A + (size_t)tm * 128 * lda, lda, W + (size_t)tn * 128 * K, K, K, lds + sb * 36864, acc);
#pragma unroll
    for (int mt = 0; mt < 2; ++mt)
#pragma unroll
      for (int nt = 0; nt < 2; ++nt)
#pragma unroll
        for (int i = 0; i < 16; ++i) {
          int row = tm * 128 + ACC_ROW(mt, i), col = tn * 128 + ACC_COL(nt);
          C[(size_t)row * ldc + col] = f2bf(acc[mt][nt][i]);
        }
  }
}

namespace pg8 {
#define PG8_LAS __attribute__((address_space(3)))
typedef unsigned short bf16_t;
typedef short bf16x8 __attribute__((ext_vector_type(8)));
typedef float f32x4 __attribute__((ext_vector_type(4)));
typedef unsigned u32x4 __attribute__((ext_vector_type(4)));
constexpr int BM = 256, BK = 64, HALF = 128, HTB = HALF * BK * 2  , STAGE_BYTES = 8 * HTB, NXCD = 8, WGM = 8;

__host__ __device__ __forceinline__ int lds_byte(int r, int c) { const int st = (r >> 4) * 2 + (c >> 5), rr = r & 15, cc = c & 31, ob = rr * 64 + cc * 2; return st * 1024 + (ob ^ (((ob >> 9) & 1) << 5)); }
__host__ __device__ __forceinline__ void stage_rc(int b, int& R, int& C) { const int st = b / 1024, sb = b % 1024, swz = sb ^ (((sb >> 9) & 1) << 5); R = (st >> 1) * 16 + swz / 64; C = (st & 1) * 32 + (swz % 64) / 2; }
__host__ __device__ __forceinline__ int perm32(int rho) { const int n = rho >> 4, i = rho & 15; return 8 * (i >> 2) + 4 * n + (i & 3); }

struct Unit { int pm, pn; };
struct Gemm { const bf16_t* A; const bf16_t* Bt; int M, N, K; };

struct StaticOrder {
    int nM, nN, nwg, G, c;
    __host__ __device__ void init(int M, int N, int G_, int c_) { nM = M / BM; nN = N / BM; nwg = nM * nN; G = G_; c = c_; }
    __host__ __device__ bool next(int i, Unit& u) const {
        const long L = (long)i * G + c; if (L >= nwg) return false;
        int wgid = (int)L; { const int q = nwg / NXCD, r = nwg % NXCD, xcd = wgid % NXCD, off = wgid / NXCD; wgid = (xcd < r ? xcd * (q + 1) : r * (q + 1) + (xcd - r) * q) + off; }
        const int nig = WGM * nN, gid = wgid / nig, fm = gid * WGM, gsz = (nM - fm) < WGM ? (nM - fm) : WGM;
        u.pm = fm + ((wgid % nig) % gsz); u.pn = (wgid % nig) / gsz; return true;
    }
    __device__ __forceinline__ void a_ready(const Unit&) const {}
    __device__ __forceinline__ void done(const Unit&) const {}
};
__device__ __forceinline__ unsigned cvt_pk_bf16(float lo, float hi) { unsigned r; asm volatile("v_cvt_pk_bf16_f32 %0, %1, %2" : "=v"(r) : "v"(lo), "v"(hi)); return r; }

struct EpiRoute {
    static constexpr bool PERM = true, AFTER_DRAIN = false;
    bf16_t* O; int ldc; int route; bf16_t* pc; bf16_t* prkv; bf16_t* plow;
    __device__ __forceinline__ void operator()(const f32x4 (&acc)[2][2][4][2], const Unit& u, int wr, int wc, int fr, int fq) const {
        const int row0 = u.pm * BM + wr * 64 + fr;
#pragma unroll
        for (int bj = 0; bj < 2; ++bj) {
            int colh = u.pn * BM + bj * HALF; bf16_t* base = O; int ld = ldc;
            if (route) {
                if (colh < 768) { base = pc; ld = 768; }
                else if (colh < 2304) { base = prkv; ld = 1536; colh -= 768; }
                else if (colh < 2688) { base = plow; ld = 384; colh -= 2304; }
                else continue;
            }
            const int col0 = colh + wc * 32 + 8 * fq;
#pragma unroll
            for (int ai = 0; ai < 2; ++ai)
#pragma unroll
                for (int m = 0; m < 4; ++m) { bf16_t* rowp = base + (size_t)(row0 + ai * HALF + m * 16) * ld + col0;
                    const f32x4 v0 = acc[ai][bj][m][0], v1 = acc[ai][bj][m][1];
                    u32x4 w; w.x = cvt_pk_bf16(v0[0], v0[1]); w.y = cvt_pk_bf16(v0[2], v0[3]); w.z = cvt_pk_bf16(v1[0], v1[1]); w.w = cvt_pk_bf16(v1[2], v1[3]);
                    *(u32x4*)rowp = w; }
        }
    }
};
struct EpiGateUp {
    static constexpr bool PERM = true, AFTER_DRAIN = false;
    bf16_t* ACT;
    __device__ __forceinline__ void operator()(const f32x4 (&acc)[2][2][4][2], const Unit& u, int wr, int wc, int fr, int fq) const {
        const int row0 = u.pm * BM + wr * 64 + fr, col0 = u.pn * HALF + wc * 32 + 8 * fq;
#pragma unroll
        for (int ai = 0; ai < 2; ++ai)
#pragma unroll
            for (int m = 0; m < 4; ++m) { bf16_t* rowp = ACT + (size_t)(row0 + ai * HALF + m * 16) * 2816 + col0;
                float v[8];
#pragma unroll
                for (int n = 0; n < 2; ++n)
#pragma unroll
                    for (int j = 0; j < 4; ++j) { const float g = acc[ai][0][m][n][j], uu = acc[ai][1][m][n][j]; v[n * 4 + j] = g * __builtin_amdgcn_rcpf(1.f + __expf(-g)) * uu; }
                u32x4 w; w.x = cvt_pk_bf16(v[0], v[1]); w.y = cvt_pk_bf16(v[2], v[3]); w.z = cvt_pk_bf16(v[4], v[5]); w.w = cvt_pk_bf16(v[6], v[7]);
                *(u32x4*)rowp = w; }
    }
};
template <class Epi, class Sched, bool STAMP = false>
__device__ __forceinline__ void gemm_phase(PG8_LAS unsigned char* lds, const Gemm g, const Sched& S, const Epi& E, unsigned long long* stamps) {
    const int tid = threadIdx.x, wid = __builtin_amdgcn_readfirstlane(tid >> 6), lane = tid & 63, wr = wid >> 2, wc = wid & 3, fr = lane & 15, fq = lane >> 4;
    const int K = g.K, nt = K / BK;
    int ts_lo = 0, ts_hi = 0, nts = 0; const unsigned long long rt_entry = STAMP ? (unsigned long long)wall_clock64() : 0ull;
#define PG8_STAMP() do { if (STAMP && wid == 0 && nts < 64) { const unsigned long long _c = (unsigned long long)clock64(); \
        ts_lo = (lane == nts) ? (int)(unsigned)_c : ts_lo; ts_hi = (lane == nts) ? (int)(unsigned)(_c >> 32) : ts_hi; ++nts; } } while (0)
    PG8_STAMP();
    unsigned voffA[2], voffB[2];
#pragma unroll
    for (int i = 0; i < 2; ++i) { int R, C; stage_rc(tid * 16 + i * 8192, R, C); const int Rb = Epi::PERM ? ((R & ~31) + perm32(R & 31)) : R;
        voffA[i] = (unsigned)(R * K + C) * 2u; voffB[i] = (unsigned)(Rb * K + C) * 2u; }
    const size_t kstep = (size_t)(BK * 2);
    const size_t hstep = (size_t)HALF * K * 2;
    const size_t tstep = 2 * hstep;
    const unsigned ldsw = (unsigned)wid * 1024u;
    const int aoff = lds_byte(wr * 64 + fr, fq * 8), boff = lds_byte(wc * 32 + fr, fq * 8);
#define PG8_SA(b, h) (((b) * 2 + (h)) * HTB)
#define PG8_SB(b, h) ((4 + (b) * 2 + (h)) * HTB)
#define PG8_STAGE(bufoff, gbase, voff) do { _Pragma("unroll") for (int _i = 0; _i < 2; ++_i) \
        __builtin_amdgcn_global_load_lds((const unsigned*)((const char*)(gbase) + (voff)[_i]), (PG8_LAS unsigned*)(lds + (bufoff) + ldsw + _i * 8192), 16, 0, 0); } while (0)
#define PG8_LDA(dst, b, h) do { _Pragma("unroll") for (int m = 0; m < 4; ++m) _Pragma("unroll") for (int k = 0; k < 2; ++k) dst[m][k] = *(const PG8_LAS bf16x8*)(lds + PG8_SA(b, h) + aoff + m * 2048 + k * 1024); } while (0)
#define PG8_LDB(dst, b, h) do { _Pragma("unroll") for (int n = 0; n < 2; ++n) _Pragma("unroll") for (int k = 0; k < 2; ++k) dst[n][k] = *(const PG8_LAS bf16x8*)(lds + PG8_SB(b, h) + boff + n * 2048 + k * 1024); } while (0)
#define PG8_MMA(ai, bj, At, Bt) do { __builtin_amdgcn_s_setprio(1); _Pragma("unroll") for (int m = 0; m < 4; ++m) _Pragma("unroll") for (int n = 0; n < 2; ++n) _Pragma("unroll") for (int k = 0; k < 2; ++k) \
        acc[ai][bj][m][n] = __builtin_amdgcn_mfma_f32_16x16x32_bf16(Bt[n][k], At[m][k], acc[ai][bj][m][n], 0, 0, 0); __builtin_amdgcn_s_setprio(0); } while (0)
#define PG8_WAIT_V(n) asm volatile("s_waitcnt vmcnt(" #n ")" ::: "memory")
#define PG8_WAIT_L(n) asm volatile("s_waitcnt lgkmcnt(" #n ")" ::: "memory")
#define PG8_BAR __builtin_amdgcn_s_barrier()
#define PG8_SCHED __builtin_amdgcn_sched_barrier(0)
    Unit cur, nxt; int ui = 0;
    if (!S.next(0, cur)) return;
    f32x4 acc[2][2][4][2];
#pragma unroll
    for (int a = 0; a < 2; ++a)
#pragma unroll
        for (int b = 0; b < 2; ++b)
#pragma unroll
            for (int m = 0; m < 4; ++m)
#pragma unroll
                for (int n = 0; n < 2; ++n) acc[a][b][m][n] = (f32x4){0.f, 0.f, 0.f, 0.f};
    bf16x8 At[4][2], B0[2][2], B1[2][2];
    const char* cA = (const char*)g.A + (size_t)cur.pm * tstep; const char* cB = (const char*)g.Bt + (size_t)cur.pn * tstep;
    S.a_ready(cur);
    PG8_STAGE(PG8_SB(0, 0), cB, voffB); PG8_STAGE(PG8_SA(0, 0), cA, voffA); PG8_STAGE(PG8_SB(0, 1), cB + hstep, voffB); PG8_STAGE(PG8_SA(0, 1), cA + hstep, voffA);
    if (wr == 1) PG8_BAR;
    PG8_WAIT_V(4); PG8_BAR;
    PG8_STAGE(PG8_SB(1, 0), cB + kstep, voffB); PG8_STAGE(PG8_SA(1, 0), cA + kstep, voffA); PG8_STAGE(PG8_SB(1, 1), cB + hstep + kstep, voffB);
    PG8_WAIT_V(6); PG8_BAR;
    PG8_STAMP();
    for (;;) {
        const bool has_next = S.next(ui + 1, nxt);
        const char* nA = has_next ? (const char*)g.A + (size_t)nxt.pm * tstep : cA; const char* nB = has_next ? (const char*)g.Bt + (size_t)nxt.pn * tstep : cB;
        for (int t = 0; t < nt; t += 2) {
            const bool last = (t == nt - 2);
            const char* a1 = cA + (size_t)(t + 1) * kstep;
            const char* a2 = last ? nA : cA + (size_t)(t + 2) * kstep; const char* b2 = last ? nB : cB + (size_t)(t + 2) * kstep;
            const char* a3 = a2 + kstep; const char* b3 = b2 + kstep;
            if (last && has_next) S.a_ready(nxt);
            PG8_LDB(B0, 0, 0); PG8_SCHED; PG8_LDA(At, 0, 0); PG8_STAGE(PG8_SA(1, 1), a1 + hstep, voffA);
            PG8_WAIT_L(8); PG8_BAR; PG8_WAIT_L(0); PG8_MMA(0, 0, At, B0); PG8_BAR; PG8_SCHED;
            PG8_LDB(B1, 0, 1); PG8_STAGE(PG8_SB(0, 0), b2, voffB);
            PG8_BAR; PG8_WAIT_L(0); PG8_MMA(0, 1, At, B1); PG8_BAR;
            PG8_LDA(At, 0, 1); PG8_STAGE(PG8_SA(0, 0), a2, voffA);
            PG8_BAR; PG8_WAIT_L(0); PG8_MMA(1, 0, At, B0); PG8_BAR; PG8_SCHED;
            PG8_STAGE(PG8_SB(0, 1), b2 + hstep, voffB);
            PG8_WAIT_V(6); PG8_BAR; PG8_MMA(1, 1, At, B1); PG8_BAR;
            PG8_LDB(B0, 1, 0); PG8_SCHED; PG8_LDA(At, 1, 0); PG8_STAGE(PG8_SA(0, 1), a2 + hstep, voffA);
            PG8_WAIT_L(8); PG8_BAR; PG8_WAIT_L(0); PG8_MMA(0, 0, At, B0); PG8_BAR; PG8_SCHED;
            PG8_LDB(B1, 1, 1); PG8_STAGE(PG8_SB(1, 0), b3, voffB);
            PG8_BAR; PG8_WAIT_L(0); PG8_MMA(0, 1, At, B1); PG8_BAR;
            PG8_LDA(At, 1, 1); PG8_STAGE(PG8_SA(1, 0), a3, voffA);
            PG8_BAR; PG8_WAIT_L(0); PG8_MMA(1, 0, At, B0); PG8_BAR; PG8_SCHED;
            PG8_STAGE(PG8_SB(1, 1), b3 + hstep, voffB);
            PG8_WAIT_V(6); PG8_BAR; PG8_MMA(1, 1, At, B1); PG8_BAR;
        }
        PG8_STAMP();
        if constexpr (!Epi::AFTER_DRAIN) { E(acc, cur, wr, wc, fr, fq); S.done(cur); }
        PG8_STAMP();
        if (!has_next) break;
#pragma unroll
        for (int a = 0; a < 2; ++a)
#pragma unroll
            for (int b = 0; b < 2; ++b)
#pragma unroll
                for (int m = 0; m < 4; ++m)
#pragma unroll
                    for (int n = 0; n < 2; ++n) acc[a][b][m][n] = (f32x4){0.f, 0.f, 0.f, 0.f};
        cur = nxt; cA = nA; cB = nB; ++ui;
    }
    PG8_WAIT_V(0);
    if (wr == 0) PG8_BAR;
    PG8_BAR;
    if constexpr (Epi::AFTER_DRAIN) { E.fused(acc, cur, wr, wc, fr, fq, lds, wid, lane); S.done(cur); }
    PG8_STAMP();
    if (STAMP && wid == 0) { stamps[lane] = lane < nts ? (((unsigned long long)(unsigned)ts_hi << 32) | (unsigned)ts_lo) : 0ull;
        if (lane == 62) stamps[62] = rt_entry; if (lane == 63) stamps[63] = (unsigned long long)wall_clock64(); }
#undef PG8_STAMP
#undef PG8_SA
#undef PG8_SB
#undef PG8_STAGE
#undef PG8_LDA
#undef PG8_LDB
#undef PG8_MMA
#undef PG8_WAIT_V
#undef PG8_WAIT_L
#undef PG8_BAR
#undef PG8_SCHED
}
}

DI void phase_gemm_big(const bf16_t* A, const bf16_t* W, int N, int K, bf16_t* C, int ldc, int route, char* ws, unsigned char* lds, int Mrows = TP_) {
  pg8::Gemm g{A, W, Mrows, N, K};
  pg8::StaticOrder S; S.init(Mrows, N, gridDim.x, blockIdx.x);
  pg8::EpiRoute E{C, ldc, route, (bf16_t*)(ws + O_PC), (bf16_t*)(ws + O_PRKV), (bf16_t*)(ws + O_PLOW)};
  pg8::gemm_phase<pg8::EpiRoute, pg8::StaticOrder, false>((PG8_LAS unsigned char*)lds, g, S, E, nullptr);
}
DI void phase_gemm_gateup(const bf16_t* A, const bf16_t* W, bf16_t* ACT, unsigned char* lds, int Mrows = TP_) {
  pg8::Gemm g{A, W, Mrows, 5632, 1024};
  pg8::StaticOrder S; S.init(Mrows, 5632, gridDim.x, blockIdx.x);
  pg8::EpiGateUp E{ACT};
  pg8::gemm_phase<pg8::EpiGateUp, pg8::StaticOrder, false>((PG8_LAS unsigned char*)lds, g, S, E, nullptr);
}

template <bool COMPACT = false>
DI void phase_resnorm(const P& p, const float* g1, const float* g2, bool first = false) {
  const int lane = threadIdx.x & 63, gw = (blockIdx.x * NTH + threadIdx.x) >> 6, nw = (gridDim.x * NTH) >> 6;
  bf16_t* HN = (bf16_t*)(p.ws + O_HN);
  for (int sr = gw; sr < (COMPACT ? 49152 : T_); sr += nw) {
    float* hr = COMPACT ? p.out + (size_t)sr * 1024 : hrow(p, sr);
    const float* hsrc = hr;
    if (first) {
      int pos; const int b = seq_of(sr, pos);
      hsrc = pos < 16 ? p.meta + pos * 1024 : (b < 8 ? p.x_prompt + ((size_t)b * 4096 + pos - 16) * 1024 : p.x_sample + (size_t)(pos - 16) * 1024);
    }
    float x[16];
    float ss = 0.f;
#pragma unroll
    for (int q = 0; q < 4; ++q) {
      const uint2 u = *(const uint2*)(HN + (size_t)sr * 1024 + q * 256 + lane * 4);
      x[q * 4] = lo2f(u.x); x[q * 4 + 1] = hi2f(u.x); x[q * 4 + 2] = lo2f(u.y); x[q * 4 + 3] = hi2f(u.y);
      ss += x[q * 4] * x[q * 4] + x[q * 4 + 1] * x[q * 4 + 1] + x[q * 4 + 2] * x[q * 4 + 2] + x[q * 4 + 3] * x[q * 4 + 3];
    }
    f32x4v hh[4];
#pragma unroll
    for (int q = 0; q < 4; ++q) {
      if (first) hh[q] = *(const f32x4v*)(hsrc + q * 256 + lane * 4);
      else { const uint2 hu = *(const uint2*)((const bf16_t*)hsrc + q * 256 + lane * 4); hh[q] = (f32x4v){lo2f(hu.x), hi2f(hu.x), lo2f(hu.y), hi2f(hu.y)}; }
    }
    ss = wave_sum(ss);
    const float rs = rsqrtf(ss * (1.f / 1024.f) + EPS);
    float ss2 = 0.f;
#pragma unroll
    for (int q = 0; q < 4; ++q) {
      const float4 g = *(const float4*)(g1 + q * 256 + lane * 4);
      hh[q].x += x[q * 4 + 0] * rs * g.x; hh[q].y += x[q * 4 + 1] * rs * g.y; hh[q].z += x[q * 4 + 2] * rs * g.z; hh[q].w += x[q * 4 + 3] * rs * g.w;
      if (g2) *(uint2*)((bf16_t*)hr + q * 256 + lane * 4) = make_uint2(pack2(hh[q].x, hh[q].y), pack2(hh[q].z, hh[q].w));
      else *(f32x4v*)(hr + q * 256 + lane * 4) = hh[q];
      ss2 += hh[q].x * hh[q].x + hh[q].y * hh[q].y + hh[q].z * hh[q].z + hh[q].w * hh[q].w;
    }
    if (g2) {
      ss2 = wave_sum(ss2);
      const float rs2 = rsqrtf(ss2 * (1.f / 1024.f) + EPS);
#pragma unroll
      for (int q = 0; q < 4; ++q) {
        const float4 g = *(const float4*)(g2 + q * 256 + lane * 4);
        *(uint2*)(HN + (size_t)sr * 1024 + q * 256 + lane * 4) = make_uint2(pack2(hh[q].x * rs2 * g.x, hh[q].y * rs2 * g.y), pack2(hh[q].z * rs2 * g.z, hh[q].w * rs2 * g.w));
      }
    }
  }
}

DI size_t vta_base(int seq) { return seq < 8 ? (size_t)seq * 256 * 4160 : (size_t)8 * 256 * 4160; }
template <int NC> DI void vt_transpose(const bf16_t* src, int ld, int col0, bf16_t* VT, char* lds) {
  bf16_t* tl = (bf16_t*)lds;
  const int tid = threadIdx.x;
  constexpr int CPT = NC / 8, TPR = 512 / NC, PPT = 64 / TPR;
  for (int it = blockIdx.x; it < 257 + 8 * 65; it += gridDim.x) {
    int seq, kt;
    if (it < 257) { seq = 8; kt = it; } else { const int j = it - 257; seq = j / 65; kt = j - seq * 65; }
    const int L = seq_len(seq), LP = L + 48, sbase = seq_base(seq);
    const size_t vb = (seq < 8 ? (size_t)seq * NC * 4160 : (size_t)8 * NC * 4160);
    __syncthreads();
    const int pl = tid >> 3, part = tid & 7;
    const int pos = 64 * kt + pl - 48;
#pragma unroll
    for (int q = 0; q < CPT / 8; ++q) {
      u32x4 v = (u32x4)(0u);
      if (pos >= 0) v = *(const u32x4*)(src + (size_t)(sbase + pos) * ld + col0 + part * CPT + q * 8);
#pragma unroll
      for (int j = 0; j < 4; ++j) {
        tl[(part * CPT + q * 8 + 2 * j) * 72 + pl] = (bf16_t)(v[j] & 0xffffu);
        tl[(part * CPT + q * 8 + 2 * j + 1) * 72 + pl] = (bf16_t)(v[j] >> 16);
      }
    }
    __syncthreads();
    const int row = tid / TPR, seg = tid % TPR;
    bf16_t* dst = VT + vb + (size_t)row * LP + 64 * kt + seg * PPT;
#pragma unroll
    for (int q = 0; q < PPT / 8; ++q) *(u32x4*)(dst + q * 8) = *(const u32x4*)(tl + row * 72 + seg * PPT + q * 8);
  }
}

DI void phase_prepA(const P& p, char* lds) {
  const int lane = threadIdx.x & 63, wave = threadIdx.x >> 6;
  bf16_t* PROJ = (bf16_t*)(p.ws + O_PROJ0);
  bf16_t* ZB = (bf16_t*)(p.ws + O_ZB);
  const float* WC = (const float*)(p.ws + O_WC);
  vt_transpose<256>(PROJ, 1536, 1024, (bf16_t*)(p.ws + O_VTA), lds);
  __syncthreads();
  float* fl = (float*)lds + wave * 1024;
  float* csl = (float*)lds + 8 * 1024 + wave * 64;
  const float inv = exp2f(-(float)(lane & 15) * (13.287712379549449f / 16.f));
  const int qr = lane & 3;
  float gn[16];
#pragma unroll
  for (int j = 0; j < 16; ++j) gn[j] = (lane < 48 ? p.a_q_gain : p.a_k_gain)[16 * qr + j] * (lane < 48 ? 0.125f * LOG2E : 1.f);
  for (int r0 = blockIdx.x * 32; r0 < TP_; r0 += gridDim.x * 32) {
    const int srb = r0 + wave * 4;
#pragma unroll 1
    for (int rr = 0; rr < 4; ++rr) {
      const int sr = srb + rr;
      if (sr < T_) {
        int pos; seq_of(sr, pos);
        float rowf, colf;
        if (pos < 16) { rowf = colf = (float)(pos - 16); }
        else { int t = pos - 16; rowf = (float)(t >> 6); colf = (float)(t & 63); }
        {
          float sn1, cs1;
          sincosf(((lane & 16) ? colf : rowf) * inv, &sn1, &cs1);
          if (lane < 32) { csl[lane] = cs1; csl[32 + lane] = sn1; }
        }
        bf16_t* pr = PROJ + (size_t)sr * 1536;
        {
        const u32x4 u0 = *(const u32x4*)(pr + 16 * lane), u1 = *(const u32x4*)(pr + 16 * lane + 8);
        float x[16];
        float ss = 0.f;
#pragma unroll
        for (int j = 0; j < 4; ++j) {
          x[2 * j] = lo2f(u0[j]); x[2 * j + 1] = hi2f(u0[j]); x[8 + 2 * j] = lo2f(u1[j]); x[8 + 2 * j + 1] = hi2f(u1[j]);
        }
#pragma unroll
        for (int j = 0; j < 16; ++j) ss += x[j] * x[j];
        ss += __shfl_xor(ss, 1); ss += __shfl_xor(ss, 2);
        const float rs = rsqrtf(ss * (1.f / 64.f) + EPS);
        const float* cp = csl + 16 * (qr >> 1);
        float o[16];
#pragma unroll
        for (int j4 = 0; j4 < 4; ++j4) {
          const f32x4v c4 = *(const f32x4v*)(cp + 4 * j4), s4 = *(const f32x4v*)(cp + 32 + 4 * j4);
#pragma unroll
          for (int e = 0; e < 4; ++e) {
            const int j = 4 * j4 + e;
            const float xn = x[j] * rs * gn[j];
            const float pa = __shfl_xor(xn, 1);
            o[j] = xn * c4[e] + pa * ((qr & 1) ? s4[e] : -s4[e]);
          }
        }
        *(u32x4*)(pr + 16 * lane) = (u32x4){pack2(o[0], o[1]), pack2(o[2], o[3]), pack2(o[4], o[5]), pack2(o[6], o[7])};
        *(u32x4*)(pr + 16 * lane + 8) = (u32x4){pack2(o[8], o[9]), pack2(o[10], o[11]), pack2(o[12], o[13]), pack2(o[14], o[15])};
        }
        uint2 u = *(const uint2*)(pr + 1280 + lane * 4);
        float f0 = lo2f(u.x), f1 = hi2f(u.x), f2 = lo2f(u.y), f3 = hi2f(u.y);
        float ss = f0 * f0 + f1 * f1 + f2 * f2 + f3 * f3;
        ss += __shfl_xor(ss, 1); ss += __shfl_xor(ss, 2); ss += __shfl_xor(ss, 4); ss += __shfl_xor(ss, 8);
        float rs = rsqrtf(ss * (1.f / 64.f) + EPS);
        float4 g = *(const float4*)(p.b_norm_g + lane * 4);
        *(float4*)(fl + rr * 256 + lane * 4) = make_float4(f0 * rs * g.x, f1 * rs * g.y, f2 * rs * g.z, f3 * rs * g.w);
      } else {
        *(float4*)(fl + rr * 256 + lane * 4) = make_float4(0.f, 0.f, 0.f, 0.f);
      }
    }
    __syncthreads();
    {
      const int g = lane >> 4, o0 = (lane & 15) * 8;
      float acc[4][8];
#pragma unroll
      for (int rr = 0; rr < 4; ++rr)
#pragma unroll
        for (int j = 0; j < 8; ++j) acc[rr][j] = 0.f;
      const float* wc = WC + (size_t)g * 64 * 128 + o0;
#pragma unroll 4
      for (int c = 0; c < 64; ++c) {
        const float4 w0 = *(const float4*)(wc + c * 128), w1 = *(const float4*)(wc + c * 128 + 4);
#pragma unroll
        for (int rr = 0; rr < 4; ++rr) {
          const float f = fl[rr * 256 + g * 64 + c];
          acc[rr][0] += f * w0.x; acc[rr][1] += f * w0.y; acc[rr][2] += f * w0.z; acc[rr][3] += f * w0.w;
          acc[rr][4] += f * w1.x; acc[rr][5] += f * w1.y; acc[rr][6] += f * w1.z; acc[rr][7] += f * w1.w;
        }
      }
#pragma unroll
      for (int rr = 0; rr < 4; ++rr)
        if (srb + rr < T_)
          *(uint4*)(ZB + (size_t)(srb + rr) * 512 + g * 128 + o0) = make_uint4(pack2(acc[rr][0], acc[rr][1]), pack2(acc[rr][2], acc[rr][3]), pack2(acc[rr][4], acc[rr][5]), pack2(acc[rr][6], acc[rr][7]));
    }
    __syncthreads();
  }
}

template <int MODE>
DI void flash_item(const bf16_t* __restrict__ Q, int ldq, const bf16_t* __restrict__ Kb, int ldk, const bf16_t* __restrict__ Vt, int LP,
                   bf16_t* O, int ldo, int sbase, int S, int qt, float sinkl2, char* lds, int obase = OBASE_SEQ) {
  const int tid = threadIdx.x & 255, lane = tid & 63, wave = tid >> 6, l31 = lane & 31, h = lane >> 5;
  bf16_t* Ks = (bf16_t*)lds;
  bf16_t* Vs = Ks + 2 * 64 * 72;
  const int rl = wave * 32 + l31;
  const int qpos = qt == 0 ? (rl < 16 ? rl : 15) : 16 + 128 * (qt - 1) + rl;
  const bool qvalid = qt > 0 || rl < 16;
  bf16x8 qf[4];
  {
    const bf16_t* qr = Q + (size_t)(sbase + qpos) * ldq;
#pragma unroll
    for (int s = 0; s < 4; ++s) qf[s] = *(const bf16x8*)(qr + 16 * s + 8 * h);
  }
  const int nkt_all = (S + 64) / 64;
  int klo = 1, n;
  if (MODE == 0) { n = nkt_all; }
  else {
    if (qt == 0) { klo = 1; n = 3; }
    else {
      int c = qt - 1;
      klo = 2 * c - 1; if (klo < 1) klo = 1;
      int khi = 2 * c + 4; if (khi > nkt_all - 1) khi = nkt_all - 1;
      n = 1 + (khi - klo + 1);
    }
  }
  const int ldr = tid >> 2, ldp = (tid & 3) * 16;
  u32x4 rk0, rk1, rv0, rv1;
  auto ktile = [&](int idx) { return idx == 0 ? 0 : klo + idx - 1; };
#define FL_GLOAD(idx)                                                                               \
  {                                                                                                 \
    int kt_ = ktile(idx);                                                                           \
    int pos_ = 64 * kt_ + ldr - 48;                                                                 \
    if (pos_ >= 0) {                                                                                \
      const bf16_t* kp_ = Kb + (size_t)(sbase + pos_) * ldk + ldp;                                  \
      rk0 = *(const u32x4*)kp_; rk1 = *(const u32x4*)(kp_ + 8);                                 \
    } else { rk0 = (u32x4)(0u); rk1 = rk0; }                                       \
    const bf16_t* vp_ = Vt + (size_t)ldr * LP + 64 * kt_ + ldp;                                     \
    rv0 = *(const u32x4*)vp_; rv1 = *(const u32x4*)(vp_ + 8);                                   \
  }
#define FL_SSTORE(buf)                                                                              \
  {                                                                                                 \
    *(u32x4*)(Ks + (buf) * 64 * 72 + ldr * 72 + ldp) = rk0; *(u32x4*)(Ks + (buf) * 64 * 72 + ldr * 72 + ldp + 8) = rk1; \
    { bf16_t* vd_ = Vs + (buf) * 64 * 68 + ldr * 68 + ldp; *(uint2*)vd_ = make_uint2(rv0.x, rv0.y); *(uint2*)(vd_ + 4) = make_uint2(rv0.z, rv0.w); *(uint2*)(vd_ + 8) = make_uint2(rv1.x, rv1.y); *(uint2*)(vd_ + 12) = make_uint2(rv1.z, rv1.w); } \
  }
  f32x16 oacc[2];
#pragma unroll
  for (int i = 0; i < 16; ++i) { oacc[0][i] = 0.f; oacc[1][i] = 0.f; }
  float m = MODE == 1 ? -1e30f : 0.f, l = 0.f;
  FL_GLOAD(0)
  FL_SSTORE(0)
  __syncthreads();
  for (int idx = 0; idx < n; ++idx) {
    const int cur = idx & 1;
    if (idx + 1 < n) FL_GLOAD(idx + 1)
    const int kt = ktile(idx);
    const bf16_t* ks = Ks + cur * 64 * 72;
    const bf16_t* vs = Vs + cur * 64 * 68;
    f32x16 sacc[2];
    {
      bf16x8 kf[2][4];
#pragma unroll
      for (int t = 0; t < 2; ++t)
#pragma unroll
        for (int s = 0; s < 4; ++s) kf[t][s] = *(const bf16x8*)(ks + (32 * t + l31) * 72 + 16 * s + 8 * h);
#pragma unroll
      for (int t = 0; t < 2; ++t)
#pragma unroll
        for (int i = 0; i < 16; ++i) sacc[t][i] = 0.f;
      __builtin_amdgcn_sched_barrier(0);
#pragma unroll
      for (int s = 0; s < 4; ++s)
#pragma unroll
        for (int t = 0; t < 2; ++t) sacc[t] = MFMA32(kf[t][s], qf[s], sacc[t]);
    }
    bf16x8 vfr[2][2][2];
#pragma unroll
    for (int t = 0; t < 2; ++t)
#pragma unroll
      for (int s2 = 0; s2 < 2; ++s2)
#pragma unroll
        for (int dt = 0; dt < 2; ++dt) {
          const bf16_t* vp = vs + (32 * dt + l31) * 68 + 32 * t + 16 * s2 + 4 * h;
          uint2 lo = *(const uint2*)vp, hi = *(const uint2*)(vp + 8);
          u32x4 v4 = {lo.x, lo.y, hi.x, hi.y};
          vfr[t][s2][dt] = __builtin_bit_cast(bf16x8, v4);
        }
    __builtin_amdgcn_sched_barrier(0);
    if (kt == 0) {
#pragma unroll
      for (int t = 0; t < 2; ++t)
#pragma unroll
        for (int i = 0; i < 16; ++i) {
          int kl = 32 * t + (i & 3) + 8 * (i >> 2) + 4 * h;
          if (kl < 48) sacc[t][i] = -1e30f;
        }
    } else if (MODE == 1) {
#pragma unroll
      for (int t = 0; t < 2; ++t)
#pragma unroll
        for (int i = 0; i < 16; ++i) {
          int kl = 32 * t + (i & 3) + 8 * (i >> 2) + 4 * h;
          int tk = 64 * (kt - 1) + kl;
          bool vis;
          if (qt == 0) vis = tk <= 112 + qpos;
          else { int tq = qpos - 16; int d = tq - tk; vis = d <= 128 && d >= -128; }
          if (!vis) sacc[t][i] = -1e30f;
        }
    }
    float tmax = -1e30f;
    if (MODE == 1) {
#pragma unroll
      for (int t = 0; t < 2; ++t)
#pragma unroll
        for (int i = 0; i < 16; ++i) tmax = fmaxf(tmax, sacc[t][i]);
      tmax = fmaxf(tmax, __shfl_xor(tmax, 32));
    }
    if (MODE == 1 && __builtin_amdgcn_ballot_w64(tmax > m) != 0ull) {
      const float mn = fmaxf(m, tmax);
      const float alpha = __builtin_amdgcn_exp2f(m - mn);
      m = mn;
      l *= alpha;
#pragma unroll
      for (int i = 0; i < 16; ++i) { oacc[0][i] *= alpha; oacc[1][i] *= alpha; }
    }
    const f32x2 m2 = {m, m};
    f32x2 ls2 = {0.f, 0.f};
    unsigned pk[2][8];
#pragma unroll
    for (int t = 0; t < 2; ++t)
#pragma unroll
      for (int i2 = 0; i2 < 8; ++i2) {
        f32x2 d = {sacc[t][2 * i2], sacc[t][2 * i2 + 1]};
        if (MODE == 1) d = d - m2;
        f32x2 e = {__builtin_amdgcn_exp2f(d.x), __builtin_amdgcn_exp2f(d.y)};
        ls2 += e;
        pk[t][i2] = __builtin_bit_cast(unsigned, __builtin_convertvector(e, bf16x2_t));
      }
    l += ls2.x + ls2.y;
#pragma unroll
    for (int t = 0; t < 2; ++t)
#pragma unroll
      for (int s2 = 0; s2 < 2; ++s2) {
        u32x4 pk4 = {pk[t][4 * s2], pk[t][4 * s2 + 1], pk[t][4 * s2 + 2], pk[t][4 * s2 + 3]};
        bf16x8 pf = __builtin_bit_cast(bf16x8, pk4);
#pragma unroll
        for (int dt = 0; dt < 2; ++dt) oacc[dt] = MFMA32(vfr[t][s2][dt], pf, oacc[dt]);
      }
    if (idx + 1 < n) FL_SSTORE(cur ^ 1)
    __syncthreads();
  }
  l += __shfl_xor(l, 32);
  if (MODE == 1) l += __builtin_amdgcn_exp2f(sinkl2 - m);
  const float il = 1.f / l;
  if (qvalid) {
    bf16_t* orow = O + (size_t)((obase == OBASE_SEQ ? sbase : obase) + qpos) * ldo;
#pragma unroll
    for (int dt = 0; dt < 2; ++dt)
#pragma unroll
      for (int g = 0; g < 4; ++g) {
        int d = 32 * dt + 8 * g + 4 * h;
        uint2 o = make_uint2(pack2(oacc[dt][4 * g] * il, oacc[dt][4 * g + 1] * il), pack2(oacc[dt][4 * g + 2] * il, oacc[dt][4 * g + 3] * il));
        *(uint2*)(orow + d) = o;
      }
  }
#undef FL_GLOAD
#undef FL_SSTORE
}

DI void dft4(float& r0, float& i0, float& r1, float& i1, float& r2, float& i2, float& r3, float& i3) {
  const float t0r = r0 + r2, t0i = i0 + i2, t1r = r0 - r2, t1i = i0 - i2;
  const float t2r = r1 + r3, t2i = i1 + i3, t3r = i1 - i3, t3i = r3 - r1;
  r0 = t0r + t2r; i0 = t0i + t2i; r1 = t1r + t3r; i1 = t1i + t3i; r2 = t0r - t2r; i2 = t0i - t2i; r3 = t1r - t3r; i3 = t1i - t3i;
}
DI void dft16(float (&zr)[16], float (&zi)[16]) {
#pragma unroll
  for (int b = 0; b < 4; ++b) dft4(zr[b], zi[b], zr[4 + b], zi[4 + b], zr[8 + b], zi[8 + b], zr[12 + b], zi[12 + b]);
  constexpr float C1 = 0.9238795325112867f, S1 = 0.3826834323650898f, C2 = 0.7071067811865476f;
  const float wr[10] = {1.f, C1, C2, S1, 0.f, 0.f, -C2, 0.f, 0.f, -C1};
  const float wi[10] = {0.f, -S1, -C2, -C1, -1.f, 0.f, -C2, 0.f, 0.f, S1};
#pragma unroll
  for (int q = 1; q < 4; ++q)
#pragma unroll
    for (int b = 1; b < 4; ++b) {
      const float c = wr[b * q], d = wi[b * q];
      const float xr = zr[4 * q + b], xi = zi[4 * q + b];
      zr[4 * q + b] = xr * c - xi * d; zi[4 * q + b] = xr * d + xi * c;
    }
#pragma unroll
  for (int q = 0; q < 4; ++q) dft4(zr[4 * q], zi[4 * q], zr[4 * q + 1], zi[4 * q + 1], zr[4 * q + 2], zi[4 * q + 2], zr[4 * q + 3], zi[4 * q + 3]);
}

DI size_t y_base(int seq) { return seq < 8 ? (size_t)seq * 16 * 256 * 576 : (size_t)8 * 16 * 256 * 576; }
DI void phase_attnA(const P& p, char* lds) {
  const bf16_t* PROJ = (const bf16_t*)(p.ws + O_PROJ0);
  const bf16_t* VT = (const bf16_t*)(p.ws + O_VTA);
  bf16_t* MIX = (bf16_t*)(p.ws + O_MIX);
  const int nS = 129 * 6, nP = 8 * 33 * 6;
  const int sb = threadIdx.x >> 8;
  unsigned* head = (unsigned*)(p.ws + O_CNT);
  for (;;) {
    if (threadIdx.x == 0) *(volatile int*)(lds + 2 * 36864) = (int)__hip_atomic_fetch_add(head, 1u, __ATOMIC_RELAXED, __HIP_MEMORY_SCOPE_AGENT);
    __syncthreads();
    const int it = *(volatile int*)(lds + 2 * 36864);
    __syncthreads();
    if (it >= nS + nP) break;
    int seq, qt, hq;
    if (it < nS) { seq = 8; hq = (it % 6) * 2 + sb; qt = it / 6; }
    else { int j = it - nS; hq = (j % 6) * 2 + sb; j /= 6; qt = j % 33; seq = j / 33; }
    const int kv = hq / 3;
    const int L = seq_len(seq), LP = L + 48;
    flash_item<0>(PROJ + hq * 64, 1536, PROJ + 768 + kv * 64, 1536, VT + vta_base(seq) + (size_t)kv * 64 * LP, LP,
                  MIX + hq * 64, 1024, seq_base(seq), L - 16, qt, 0.f, lds + sb * 36864);
  }
  const bf16_t* ZB = (const bf16_t*)(p.ws + O_ZB);
  bf16_t* Y = (bf16_t*)(p.ws + O_Y);
  const int lane = threadIdx.x & 63, wave = threadIdx.x >> 6;
  const int nI_S = 17 * 16, nI_P = 8 * 5 * 16;
  for (;;) {
    if (threadIdx.x == 0) *(volatile int*)(lds + 2 * 36864) = (int)__hip_atomic_fetch_add(head + 64, 1u, __ATOMIC_RELAXED, __HIP_MEMORY_SCOPE_AGENT);
    __syncthreads();
    const int it = *(volatile int*)(lds + 2 * 36864);
    __syncthreads();
    if (it >= nI_S + nI_P) break;
    int seq, nb, cb;
    if (it < nI_S) { seq = 8; cb = it & 15; nb = it >> 4; }
    else { int j = it - nI_S; cb = j & 15; j >>= 4; nb = j % 5; seq = j / 5; }
    const int M = seq < 8 ? 257 : 1025, KP = seq < 8 ? 576 : 2112, L = 16 * M;
    const int n2 = nb * 64 + lane;
    const int ch = cb * 16 + wave * 2;
    const int g = ch >> 6, d = ch & 63;
    bf16_t* yb = Y + y_base(seq);
    if (n2 < M) {
      float ar[16], ai[16], br[16], bi[16];
#pragma unroll
      for (int n1 = 0; n1 < 16; ++n1) {
        const bf16_t* zp = ZB + (size_t)(seq_base(seq) + M * n1 + n2) * 512 + g * 128 + d;
        unsigned re = *(const unsigned*)zp, im = *(const unsigned*)(zp + 64);
        ar[n1] = lo2f(re); br[n1] = hi2f(re); ai[n1] = lo2f(im); bi[n1] = hi2f(im);
      }
      dft16(ar, ai);
      dft16(br, bi);
      float t1s, t1c;
      sincospif(-2.f * (float)n2 / (float)L, &t1s, &t1c);
      float tc = 1.f, ts = 0.f;
#pragma unroll
      for (int k1 = 0; k1 < 16; ++k1) {
        const int ix = 4 * (k1 & 3) + (k1 >> 2);
        const float yr0 = ar[ix] * tc - ai[ix] * ts, yi0 = ar[ix] * ts + ai[ix] * tc;
        const float yr1 = br[ix] * tc - bi[ix] * ts, yi1 = br[ix] * ts + bi[ix] * tc;
        bf16_t* y0 = yb + ((size_t)k1 * 256 + ch) * KP;
        y0[n2] = f2bf(yr0); y0[M + n2] = f2bf(yi0);
        y0[KP + n2] = f2bf(yr1); y0[KP + M + n2] = f2bf(yi1);
        const float nc = tc * t1c - ts * t1s; ts = tc * t1s + ts * t1c; tc = nc;
      }
    } else if (n2 < KP - M) {
      for (int k1 = 0; k1 < 16; ++k1) {
        bf16_t* y0 = yb + ((size_t)k1 * 256 + ch) * KP;
        y0[M + n2] = 0; y0[KP + M + n2] = 0;
      }
    }
  }
}

DI void phase_fnet_gemm(const P& p, char* lds) {
  GEMM_IDS
  bf16_t* MIX = (bf16_t*)(p.ws + O_MIX);
  const bf16_t* Y = (const bf16_t*)(p.ws + O_Y);
  const int nS = 16 * 9 * 2, nP = 8 * 16 * 3 * 2;
  const int sb = threadIdx.x >> 8;
  for (int it0 = blockIdx.x * 2; it0 < nS + nP; it0 += gridDim.x * 2) {
    const int it = it0 + sb;
    int seq, k1, tm, tn;
    if (it < nS) { seq = 8; tn = it & 1; int j = it >> 1; tm = j % 9; k1 = j / 9; }
    else { int j = it - nS; tn = j & 1; j >>= 1; tm = j % 3; j /= 3; k1 = j & 15; seq = j >> 4; }
    const int M = seq < 8 ? 257 : 1025, KP = seq < 8 ? 576 : 2112, L = 16 * M;
    const bf16_t* dm = (const bf16_t*)(p.ws + (seq < 8 ? O_DM257 : O_DM1025));
    f32x16 acc[2][2];
    gemm_tile(dm + (size_t)tm * 128 * KP, KP, Y + y_base(seq) + ((size_t)k1 * 256 + tn * 128) * KP, KP, KP, lds + sb * 36864, acc);
    const float scale = rsqrtf(64.f * (float)L);
#pragma unroll
    for (int mt = 0; mt < 2; ++mt)
#pragma unroll
      for (int nt = 0; nt < 2; ++nt)
#pragma unroll
        for (int i = 0; i < 16; ++i) {
          int k2 = tm * 128 + ACC_ROW(mt, i), ch = tn * 128 + ACC_COL(nt);
          if (k2 < M) {
            int pos = k1 + 16 * k2;
            MIX[(size_t)(seq_base(seq) + pos) * 1024 + 768 + ch] = f2bf(acc[mt][nt][i] * scale + p.b_b[ch]);
          }
        }
  }
}

DI size_t vtc_base(int seq) { return seq < 8 ? (size_t)seq * 128 * 4160 : (size_t)8 * 128 * 4160; }
DI void phase_prepC(const P& p, char* lds) {
  const int gtid = blockIdx.x * NTH + threadIdx.x, gsz = gridDim.x * NTH;
  const int lane = threadIdx.x & 63, gw = gtid >> 6, nw = gsz >> 6;
  bf16_t* PC = (bf16_t*)(p.ws + O_PC);
  bf16_t* VT = (bf16_t*)(p.ws + O_VTC);
  const bf16_t* PLOW = (const bf16_t*)(p.ws + O_PLOW);
  bf16_t* LR = (bf16_t*)(p.ws + O_LR);
  vt_transpose<128>(PC, 768, 640, VT, lds);
  for (int sr = gw; sr < T_; sr += nw) {
    int pos; int b = seq_of(sr, pos);
    const int L = seq_len(b), LP = L + 48;
    bf16_t* pr = PC + (size_t)sr * 768;
    float cs[8], sn[8];
    {
      float s1, c1;
      sincosf((float)pos * exp2f(-(float)(lane & 7) * (18.931568569324174f / 8.f)), &s1, &c1);
#pragma unroll
      for (int j = 0; j < 8; ++j) { sn[j] = __shfl(s1, j); cs[j] = __shfl(c1, j); }
    }
#pragma unroll
    for (int part = 0; part < 2; ++part) {
      const bool act = part == 0 || lane < 16;
      const int col = part * 512 + (act ? lane : 0) * 8;
      uint4 u = *(const uint4*)(pr + col);
      float e[8] = {lo2f(u.x), hi2f(u.x), lo2f(u.y), hi2f(u.y), lo2f(u.z), hi2f(u.z), lo2f(u.w), hi2f(u.w)};
      float o[8];
#pragma unroll
      for (int j = 0; j < 8; ++j) {
        float pa = __shfl_xor(e[j], 1);
        float rot = e[j] * cs[j] + pa * ((lane & 1) ? sn[j] : -sn[j]);
        o[j] = (lane & 7) < 2 ? rot : e[j];
        if (part == 0) o[j] *= 0.125f * LOG2E;
      }
      if (act) *(uint4*)(pr + col) = make_uint4(pack2(o[0], o[1]), pack2(o[2], o[3]), pack2(o[4], o[5]), pack2(o[6], o[7]));
    }
#pragma unroll
    for (int q = 0; q < 6; ++q) {
      int c = q * 64 + lane;
      float u = bf2f(PLOW[(size_t)sr * 384 + c]);
      float up = pos > 0 ? bf2f(PLOW[(size_t)(sr - 1) * 384 + c]) : 0.f;
      float un = pos < L - 1 ? bf2f(PLOW[(size_t)(sr + 1) * 384 + c]) : 0.f;
      float us = u + p.mu_prev[1536 + c] * (up - u) + p.mu_next[1536 + c] * (un - u);
      float v = c < 128 ? tanhf(us) : (c < 256 ? us : sigmoidf_(us));
      LR[(size_t)sr * 384 + c] = f2bf(v);
    }
  }
}

DI void phase_attnC(const P& p, char* lds) {
  const bf16_t* PC = (const bf16_t*)(p.ws + O_PC);
  const bf16_t* VT = (const bf16_t*)(p.ws + O_VTC);
  bf16_t* MIX = (bf16_t*)(p.ws + O_MIX);
  const int nS = 129 * 4, nP = 8 * 33 * 4;
  const int sb = threadIdx.x >> 8;
  for (int it = blockIdx.x; it < nS + nP; it += gridDim.x) {
    int seq, qt, hq;
    if (it < nS) { seq = 8; hq = (it & 3) * 2 + sb; qt = it >> 2; }
    else { int j = it - nS; hq = (j & 3) * 2 + sb; j >>= 2; qt = j % 33; seq = j / 33; }
    const int kv = hq >> 2;
    const int L = seq_len(seq), LP = L + 48;
    flash_item<1>(PC + hq * 64, 768, PC + 512 + kv * 64, 768, VT + vtc_base(seq) + (size_t)kv * 64 * LP, LP,
                  MIX + hq * 64, 1024, seq_base(seq), L - 16, qt, p.c_sink[hq] * LOG2E, lds + sb * 36864, qt == 0 ? 49152 + seq * 16 : (seq < 8 ? seq * 4096 : 32768) - 16);
  }
}

DI void chunk_decode(int cg_, int& seq, int& c) {
  if (cg_ < 136) { seq = cg_ / 17; c = cg_ - seq * 17; } else { seq = 8; c = cg_ - 136; }
}
DI float shiftv(const bf16_t* PRKV, int sr, int pos, int L, int col, float mp, float mn) {
  float u = bf2f(PRKV[(size_t)sr * 1536 + col]);
  float up = pos > 0 ? bf2f(PRKV[(size_t)(sr - 1) * 1536 + col]) : 0.f;
  float un = pos < L - 1 ? bf2f(PRKV[(size_t)(sr + 1) * 1536 + col]) : 0.f;
  return u + mp * (up - u) + mn * (un - u);
}
enum { VW = 0, VA = 1, VB = 2, VK = 3, VV = 4, VR = 5 };
#define DPP_FMAC(acc, x, y, N) asm("v_fmac_f32_dpp %0, %1, %2 row_newbcast:%3 row_mask:0xf bank_mask:0xf" : "+v"(acc) : "v"(x), "v"(y), "n"(N))
#define DPP_MUL(sv_, x, N) asm("v_mul_f32_dpp %0, %1, %0 row_newbcast:%2 row_mask:0xf bank_mask:0xf" : "+v"(sv_) : "v"(x), "n"(N))
template <int N> DI void dpp_dot4(float& a0, float& a1, float& a2, float& a3, const float (&S)[64], const float4& x) {
  DPP_FMAC(a0, x.x, S[N], N); DPP_FMAC(a1, x.y, S[16 + N], N); DPP_FMAC(a2, x.z, S[32 + N], N); DPP_FMAC(a3, x.w, S[48 + N], N);
  if constexpr (N < 15) dpp_dot4<N + 1>(a0, a1, a2, a3, S, x);
}
template <int N, bool HASV, bool OUT> DI void dpp_upd4(float (&S)[64], const float4& xb, const float4& xk, const float4& xr, float sa, float vi,
                                                       float& o0, float& o1, float& o2, float& o3) {
  DPP_FMAC(S[N], xb.x, sa, N); DPP_FMAC(S[16 + N], xb.y, sa, N); DPP_FMAC(S[32 + N], xb.z, sa, N); DPP_FMAC(S[48 + N], xb.w, sa, N);
  if (HASV) { DPP_FMAC(S[N], xk.x, vi, N); DPP_FMAC(S[16 + N], xk.y, vi, N); DPP_FMAC(S[32 + N], xk.z, vi, N); DPP_FMAC(S[48 + N], xk.w, vi, N); }
  if (OUT) { DPP_FMAC(o0, xr.x, S[N], N); DPP_FMAC(o1, xr.y, S[16 + N], N); DPP_FMAC(o2, xr.z, S[32 + N], N); DPP_FMAC(o3, xr.w, S[48 + N], N); }
  if constexpr (N < 15) dpp_upd4<N + 1, HASV, OUT>(S, xb, xk, xr, sa, vi, o0, o1, o2, o3);
}
template <int N> DI void dpp_scale4(float (&S)[64], const float4& xg) {
  DPP_MUL(S[N], xg.x, N); DPP_MUL(S[16 + N], xg.y, N); DPP_MUL(S[32 + N], xg.z, N); DPP_MUL(S[48 + N], xg.w, N);
  if constexpr (N < 15) dpp_scale4<N + 1>(S, xg);
}
template <int NST, bool HASV, bool OUT, class F>
DI void scan_steps(float (&S)[64], const float* sv, int ns, int lane, F&& emit) {
  const int l15 = lane & 15;
  (void)ns;
#pragma unroll 4
  for (int s = 0; s < NST; ++s) {
    const float4 xa = *(const float4*)(sv + VA * NST * 64 + s * 64 + l15 * 4);
    const float4 xb = *(const float4*)(sv + VB * NST * 64 + s * 64 + l15 * 4);
    float4 xk = xb, xr = xb;
    if (HASV) xk = *(const float4*)(sv + VK * NST * 64 + s * 64 + l15 * 4);
    if (OUT) xr = *(const float4*)(sv + VR * NST * 64 + s * 64 + l15 * 4);
    const float vi = HASV ? sv[VV * NST * 64 + s * 64 + lane] : 0.f;
    float sa0 = 0.f, sa1 = 0.f, sa2 = 0.f, sa3 = 0.f;
    dpp_dot4<0>(sa0, sa1, sa2, sa3, S, xa);
    const float sa = (sa0 + sa1) + (sa2 + sa3);
    float o0 = 0.f, o1 = 0.f, o2 = 0.f, o3 = 0.f;
    dpp_upd4<0, HASV, OUT>(S, xb, xk, xr, sa, vi, o0, o1, o2, o3);
    if (OUT) emit(s, (o0 + o1) + (o2 + o3));
    if ((s & 7) == 7) {
      const float4 xg = *(const float4*)(sv + VW * NST * 64 + (s >> 3) * 64 + l15 * 4);
      dpp_scale4<0>(S, xg);
    }
  }
}
DI int vperm(int j) { return (j & 15) * 4 + (j >> 4); }

DI void shift8(const bf16_t* PRKV, const P& p, int sbase, int pos, int L, int off, int c0, float (&out)[8]) {
  const bf16_t* rp = PRKV + (size_t)(sbase + pos) * 1536 + off + c0;
  const u32x4 uc = *(const u32x4*)rp;
  u32x4 up = (u32x4)(0u), un = (u32x4)(0u);
  if (pos > 0) up = *(const u32x4*)(rp - 1536);
  if (pos < L - 1) un = *(const u32x4*)(rp + 1536);
  const f32x4v mp0 = *(const f32x4v*)(p.mu_prev + off + c0), mp1 = *(const f32x4v*)(p.mu_prev + off + c0 + 4);
  const f32x4v mn0 = *(const f32x4v*)(p.mu_next + off + c0), mn1 = *(const f32x4v*)(p.mu_next + off + c0 + 4);
#pragma unroll
  for (int e2 = 0; e2 < 4; ++e2) {
    const float c_lo = lo2f(uc[e2]), c_hi = hi2f(uc[e2]);
    const float mpl = e2 < 2 ? mp0[2 * e2] : mp1[2 * e2 - 4], mph = e2 < 2 ? mp0[2 * e2 + 1] : mp1[2 * e2 - 3];
    const float mnl = e2 < 2 ? mn0[2 * e2] : mn1[2 * e2 - 4], mnh = e2 < 2 ? mn0[2 * e2 + 1] : mn1[2 * e2 - 3];
    out[2 * e2] = c_lo + mpl * (lo2f(up[e2]) - c_lo) + mnl * (lo2f(un[e2]) - c_lo);
    out[2 * e2 + 1] = c_hi + mph * (hi2f(up[e2]) - c_hi) + mnh * (hi2f(un[e2]) - c_hi);
  }
}

template <int NST, bool P3>
DI void scan_prologue8(const P& p, int sbase, int L, int hd, int dir, int pos0, int nsteps, int sb0, float* sv) {
  const int lane = threadIdx.x & 63, l31 = lane & 31, h = lane >> 5;
  const bf16_t* PRKV = (const bf16_t*)(p.ws + O_PRKV);
  const bf16_t* LR = (const bf16_t*)(p.ws + O_LR);
  const bf16_t* WUPT = (const bf16_t*)(p.ws + O_WUPT) + (size_t)(dir * 512 + hd * 64) * 64;
  const bf16_t* AUPT = (const bf16_t*)(p.ws + O_AUPT) + (size_t)(dir * 512 + hd * 64) * 64;
  float* bonus = (float*)(p.ws + O_BONUS);
  {
    int sl = sb0 + (l31 & 7); if (sl > nsteps - 1) sl = nsteps - 1;
    const int pos = dir ? pos0 - sl : pos0 + sl;
    const bf16_t* lrp = LR + (size_t)(sbase + pos) * 384 + dir * 64 + 8 * h;
#pragma unroll 1
    for (int mat = 0; mat < 2; ++mat) {
      const bf16_t* Wm = mat ? AUPT : WUPT;
      const float* bias = mat ? p.d_a0 : p.d_w0;
      f32x16 ac[2];
#pragma unroll
      for (int nt = 0; nt < 2; ++nt)
#pragma unroll
        for (int i = 0; i < 16; ++i) ac[nt][i] = 0.f;
#pragma unroll
      for (int ks = 0; ks < 4; ++ks) {
        const bf16x8 fa = *(const bf16x8*)(lrp + mat * 128 + 16 * ks);
#pragma unroll
        for (int nt = 0; nt < 2; ++nt) {
          const bf16x8 bw = *(const bf16x8*)(Wm + (size_t)(32 * nt + l31) * 64 + 16 * ks + 8 * h);
          ac[nt] = MFMA32(fa, bw, ac[nt]);
        }
      }
#pragma unroll
      for (int nt = 0; nt < 2; ++nt) {
        const int j = 32 * nt + l31;
        const float b0 = bias[dir * 512 + hd * 64 + j];
#pragma unroll
        for (int i = 0; i < 4; ++i) {
          const int st = sb0 + i + 4 * h;
          const float sg = 1.f / (1.f + __expf(-(b0 + ac[nt][i])));
          if (mat) sv[VK * NST * 64 + st * 64 + j] = sg;
          else ac[nt][i] = __expf(-0.6065306597126334f * sg);
        }
        if (!mat) {
          float g0 = ac[nt][0], g1 = g0 * ac[nt][1], g2 = g1 * ac[nt][2], g3 = g2 * ac[nt][3];
          const float tot_lo = __shfl(g3, l31);
          if (h) { g0 *= tot_lo; g1 *= tot_lo; g2 *= tot_lo; g3 *= tot_lo; }
          float* gd = sv + VA * NST * 64 + (sb0 + 4 * h) * 64 + j;
          gd[0] = g0; gd[64] = g1; gd[128] = g2; gd[192] = g3;
          if (h) sv[VW * NST * 64 + (sb0 >> 3) * 64 + vperm(j)] = g3;
        }
      }
    }
  }
  const int stp = lane >> 3, seg = lane & 7, c0 = hd * 64 + 8 * seg;
  const int s = sb0 + stp;
  const int ss = s < nsteps ? s : nsteps - 1;
  const int pos = dir ? pos0 - ss : pos0 + ss;
  float k[8], a[8], gam[8], gpr[8];
  shift8(PRKV, p, sbase, pos, L, 512, c0, k);
  {
    const f32x4v a0 = *(const f32x4v*)(sv + VK * NST * 64 + s * 64 + 8 * seg), a1 = *(const f32x4v*)(sv + VK * NST * 64 + s * 64 + 8 * seg + 4);
    const f32x4v g0 = *(const f32x4v*)(sv + VA * NST * 64 + s * 64 + 8 * seg), g1 = *(const f32x4v*)(sv + VA * NST * 64 + s * 64 + 8 * seg + 4);
    const int sp = stp > 0 ? s - 1 : s;
    const f32x4v q0 = *(const f32x4v*)(sv + VA * NST * 64 + sp * 64 + 8 * seg), q1 = *(const f32x4v*)(sv + VA * NST * 64 + sp * 64 + 8 * seg + 4);
#pragma unroll
    for (int e = 0; e < 4; ++e) {
      a[e] = a0[e]; a[4 + e] = a1[e]; gam[e] = g0[e]; gam[4 + e] = g1[e];
      gpr[e] = stp > 0 ? q0[e] : 1.f; gpr[4 + e] = stp > 0 ? q1[e] : 1.f;
    }
  }
  const f32x4v kk0 = *(const f32x4v*)(p.d_k_k + c0), kk1 = *(const f32x4v*)(p.d_k_k + c0 + 4);
  const f32x4v ka0 = *(const f32x4v*)(p.d_k_a + c0), ka1 = *(const f32x4v*)(p.d_k_a + c0 + 4);
  float kk[8], kd[8];
  float n2 = 0.f;
#pragma unroll
  for (int e = 0; e < 8; ++e) {
    kk[e] = k[e] * (e < 4 ? kk0[e] : kk1[e - 4]);
    n2 += kk[e] * kk[e];
    kd[e] = k[e] * (1.f + (a[e] - 1.f) * (e < 4 ? ka0[e] : ka1[e - 4]));
  }
  n2 += __shfl_xor(n2, 1); n2 += __shfl_xor(n2, 2); n2 += __shfl_xor(n2, 4);
  const float rn = rsqrtf(fmaxf(n2, 1e-24f));
#pragma unroll
  for (int e = 0; e < 8; ++e) {
    const int ix = s * 64 + vperm(8 * seg + e);
    const float kn = kk[e] * rn;
    const float ig = __builtin_amdgcn_rcpf(gam[e]);
    sv[VA * NST * 64 + ix] = -kn * gpr[e];
    sv[VB * NST * 64 + ix] = kn * a[e] * ig;
    sv[VK * NST * 64 + ix] = kd[e] * ig;
  }
  {
    float v[8];
    shift8(PRKV, p, sbase, pos, L, 1024, c0, v);
    *(f32x4v*)(sv + VV * NST * 64 + s * 64 + 8 * seg) = (f32x4v){v[0], v[1], v[2], v[3]};
    *(f32x4v*)(sv + VV * NST * 64 + s * 64 + 8 * seg + 4) = (f32x4v){v[4], v[5], v[6], v[7]};
  }
  if (P3) {
    float r[8];
    shift8(PRKV, p, sbase, pos, L, 0, c0, r);
    const f32x4v rk0 = *(const f32x4v*)(p.d_r_k + c0), rk1 = *(const f32x4v*)(p.d_r_k + c0 + 4);
    float bn = 0.f;
#pragma unroll
    for (int e = 0; e < 8; ++e) {
      sv[VR * NST * 64 + s * 64 + vperm(8 * seg + e)] = r[e] * gam[e];
      bn += r[e] * kd[e] * (e < 4 ? rk0[e] : rk1[e - 4]);
    }
    bn += __shfl_xor(bn, 1); bn += __shfl_xor(bn, 2); bn += __shfl_xor(bn, 4);
    if (s < nsteps && seg == 0) bonus[((size_t)(sbase + pos) * 8 + hd) * 2 + dir] = bn;
  }
}

DI unsigned scan_touch(const P& p, int sbase, int L, int hd, int dir, int posf  ) {
  const int lane = threadIdx.x & 63;
  const bf16_t* PRKV = (const bf16_t*)(p.ws + O_PRKV);
  const bf16_t* LR = (const bf16_t*)(p.ws + O_LR);
  const int lo = dir ? posf - 8 : posf - 1;
  const unsigned* ptr;
  if (lane < 30) { int row = lo + lane / 3; row = row < 0 ? 0 : (row > L - 1 ? L - 1 : row); ptr = (const unsigned*)(PRKV + (size_t)(sbase + row) * 1536 + (lane % 3) * 512 + hd * 64); }
  else { const int i2 = (lane - 30) & 15; int row = dir ? posf - (i2 >> 1) : posf + (i2 >> 1); row = row < 0 ? 0 : (row > L - 1 ? L - 1 : row); ptr = (const unsigned*)(LR + (size_t)(sbase + row) * 384 + (i2 & 1) * 128 + dir * 64); }
  return *ptr;
}

template <bool HALF> DI void scan1_body(const P& p, char* lds) {
  float* PQ = (float*)(p.ws + O_PQ);
  const int lane = threadIdx.x & 63, wave = __builtin_amdgcn_readfirstlane(threadIdx.x >> 6), slot = wave >> 1;
  constexpr int half = HALF ? 1 : 0;
  float* sv = (float*)lds + slot * (6 * 16 * 64);
  for (int g = blockIdx.x; g < 804; g += gridDim.x) {
    int seq, c, hp;
    if (g < 768) { const int lc = g >> 2; hp = g & 3; if (lc < 128) { seq = lc >> 4; c = lc & 15; } else { seq = 8; c = lc - 128; } }
    else { const int j = g - 768; hp = j & 3; seq = j >> 2; c = seq < 8 ? 16 : 64; }
    const int cgi = seq < 8 ? seq * 17 + c : 136 + c;
    const int hd = hp * 2 + (slot >> 1), dir = slot & 1;
    const int it = (cgi * 8 + hd) * 2 + dir;
    const int L = seq_len(seq), sbase = seq_base(seq);
    const int start = c * 256, end = min(L, start + 256), n = end - start;
    float S[64];
#pragma unroll
    for (int j = 0; j < 64; ++j) S[j] = (half == 0 && j == lane) ? 1.f : 0.f;
    for (int s0 = 0; s0 < n; s0 += 16) {
      const int ns = min(16, n - s0);
      const int pos0 = dir ? end - 1 - s0 : start + s0;
      __syncthreads();
      scan_prologue8<16, false>(p, sbase, L, hd, dir, pos0, ns, half * 8, sv);
      __syncthreads();
      unsigned tch = 0u;
      if (s0 + 16 < n) tch = scan_touch(p, sbase, L, hd, dir, dir ? pos0 - 16 - half * 8 : pos0 + 16 + half * 8);
      scan_steps<16, HALF, false>(S, sv, ns, lane, [](int, float) {});
      asm volatile("" :: "v"(tch));
    }
    float* dst = PQ + (size_t)it * 8192 + (size_t)(half * 64 + lane) * 64;
#pragma unroll
    for (int q = 0; q < 16; ++q) *(float4*)(dst + q * 4) = make_float4(S[q * 4], S[q * 4 + 1], S[q * 4 + 2], S[q * 4 + 3]);
  }
}

DI void phase_scan1(const P& p, char* lds) {
  const int w_ = __builtin_amdgcn_readfirstlane(threadIdx.x >> 6);
  if ((w_ ^ (w_ >> 2)) & 1) scan1_body<true>(p, lds); else scan1_body<false>(p, lds);
}

DI void phase_scan2(const P& p, char* lds) {
  float* Ss = (float*)lds;
  float* Ps = Ss + 64 * 65;
  float* PQ = (float*)(p.ws + O_PQ);
  const int tid = threadIdx.x, lane = tid & 63, wave = __builtin_amdgcn_readfirstlane(tid >> 6), l31 = lane & 31, h = lane >> 5;
  const int r0 = 32 * (wave >> 1), c0 = 32 * (wave & 1);
  for (int it = blockIdx.x; it < 144; it += gridDim.x) {
    const int dir = it & 1, hd = (it >> 1) & 7, seq = it >> 4;
    const int nch = seq < 8 ? 17 : 65, cg0 = seq < 8 ? seq * 17 : 136;
    f32x16 S;
#pragma unroll
    for (int i = 0; i < 16; ++i) S[i] = 0.f;
    f32x4v pn0, pn1;
    {
      const int c = dir ? nch - 1 : 0;
      const float* Pg = PQ + (size_t)(((cg0 + c) * 8 + hd) * 2 + dir) * 8192;
      pn0 = *(const f32x4v*)(Pg + tid * 4); pn1 = *(const f32x4v*)(Pg + (512 + tid) * 4);
    }
    for (int cc = 0; cc < nch; ++cc) {
      const int c = dir ? nch - 1 - cc : cc;
      float* Qg = PQ + (size_t)(((cg0 + c) * 8 + hd) * 2 + dir) * 8192 + 4096;
      __syncthreads();
      { const int m = tid >> 4, cq = (tid & 15) * 4; *(f32x4v*)(Ps + m * 68 + cq) = pn0; *(f32x4v*)(Ps + (m + 32) * 68 + cq) = pn1; }
      f32x16 acc;
      if (wave < 4) {
#pragma unroll
        for (int i = 0; i < 16; ++i) {
          const int row = r0 + (i & 3) + 8 * (i >> 2) + 4 * h;
          Ss[row * 65 + c0 + l31] = S[i];
          float* qp = Qg + row * 64 + c0 + l31;
          acc[i] = *qp;
          *qp = S[i];
        }
      }
      if (cc + 1 < nch) {
        const int c2 = dir ? nch - 2 - cc : cc + 1;
        const float* Pg2 = PQ + (size_t)(((cg0 + c2) * 8 + hd) * 2 + dir) * 8192;
        pn0 = *(const f32x4v*)(Pg2 + tid * 4); pn1 = *(const f32x4v*)(Pg2 + (512 + tid) * 4);
      }
      __syncthreads();
      if (wave < 4) {
#pragma unroll 8
        for (int kk = 0; kk < 32; ++kk) {
          const float av = Ss[(r0 + l31) * 65 + 2 * kk + h];
          const float bv = Ps[(2 * kk + h) * 68 + c0 + l31];
          acc = __builtin_amdgcn_mfma_f32_32x32x2f32(av, bv, acc, 0, 0, 0);
        }
        S = acc;
      }
    }
  }
}

DI void phase_scan3(const P& p, char* lds) {
  const float* PQ = (const float*)(p.ws + O_PQ);
  bf16_t* MIX = (bf16_t*)(p.ws + O_MIX);
  bf16_t* OB = (bf16_t*)(p.ws + O_OB);
  const int lane = threadIdx.x & 63, wave = __builtin_amdgcn_readfirstlane(threadIdx.x >> 6);
  float* sv = (float*)lds + wave * (6 * 8 * 64);
  const bool bal = gridDim.x == 256;
  const int NW = gridDim.x * 8, gw = blockIdx.x * 8 + wave;
  for (int k = 0; ; ++k) {
    int oi;
    if (bal) {
      if (k == 0) oi = gw;
      else if (k == 1) { if (wave >= 4) continue; oi = 2048 + blockIdx.x * 4 + wave; }
      else if (k == 2) { if (wave != 7 || blockIdx.x >= 144) break; oi = 3072 + blockIdx.x; }
      else break;
    } else { oi = gw + k * NW; if (oi >= 3216) break; }
    int seq, c, hd, dir;
    if (oi < 3072) { const int lc = oi >> 4; hd = (oi >> 1) & 7; dir = oi & 1; if (lc < 128) { seq = lc >> 4; c = lc & 15; } else { seq = 8; c = lc - 128; } }
    else { const int j = oi - 3072; hd = (j >> 1) & 7; dir = j & 1; seq = j >> 4; c = seq < 8 ? 16 : 64; }
    const int it = ((seq < 8 ? seq * 17 + c : 136 + c) * 8 + hd) * 2 + dir;
    const int L = seq_len(seq), sbase = seq_base(seq);
    const int start = c * 256, end = min(L, start + 256), n = end - start;
    float S[64];
    {
      const float* src = PQ + (size_t)it * 8192 + 4096 + lane * 64;
#pragma unroll
      for (int q = 0; q < 16; ++q) { float4 t = *(const float4*)(src + q * 4); S[q * 4] = t.x; S[q * 4 + 1] = t.y; S[q * 4 + 2] = t.z; S[q * 4 + 3] = t.w; }
    }
    for (int s0 = 0; s0 < n; s0 += 8) {
      const int ns = min(8, n - s0);
      const int pos0 = dir ? end - 1 - s0 : start + s0;
      scan_prologue8<8, true>(p, sbase, L, hd, dir, pos0, ns, 0, sv);
      unsigned tch = 0u;
      if (s0 + 8 < n) tch = scan_touch(p, sbase, L, hd, dir, dir ? pos0 - 8 : pos0 + 8);
      scan_steps<8, true, true>(S, sv, ns, lane, [&](int st, float o) {
        const int pos = dir ? pos0 - st : pos0 + st;
        const size_t sr = (size_t)(sbase + pos);
        if (dir == 0) MIX[(size_t)crow_of(seq, pos) * 1024 + 512 + hd * 64 + lane] = f2bf(o);
        else OB[sr * 512 + hd * 64 + lane] = f2bf(o);
      });
      asm volatile("" :: "v"(tch));
    }
  }
}

DI void phase_rwkv_final(const P& p) {
  const int lane = threadIdx.x & 63, gw = (blockIdx.x * NTH + threadIdx.x) >> 6, nw = (gridDim.x * NTH) >> 6;
  bf16_t* MIX = (bf16_t*)(p.ws + O_MIX);
  const bf16_t* OB = (const bf16_t*)(p.ws + O_OB);
  const bf16_t* G = (const bf16_t*)(p.ws + O_G);
  const bf16_t* PRKV = (const bf16_t*)(p.ws + O_PRKV);
  const float* bonus = (const float*)(p.ws + O_BONUS);
  const int hd = lane >> 3, c0 = lane * 8;
  float mp[8], mn[8], lg[8], lb[8];
#pragma unroll
  for (int j = 0; j < 8; ++j) { mp[j] = p.mu_prev[1024 + c0 + j]; mn[j] = p.mu_next[1024 + c0 + j]; lg[j] = p.d_ln_g[c0 + j]; lb[j] = p.d_ln_b[c0 + j]; }
  for (int sr = gw; sr < T_; sr += nw) {
    int pos; int b = seq_of(sr, pos);
    const int L = seq_len(b);
    const size_t cr = (size_t)crow_of(b, pos);
    const u32x4 uf = *(const u32x4*)(MIX + cr * 1024 + 512 + c0);
    const u32x4 ub = *(const u32x4*)(OB + (size_t)sr * 512 + c0);
    const u32x4 ug = *(const u32x4*)(G + (size_t)sr * 512 + c0);
    const bf16_t* vr = PRKV + (size_t)sr * 1536 + 1024 + c0;
    const u32x4 vc = *(const u32x4*)vr;
    const u32x4 vp = *(const u32x4*)(pos > 0 ? vr - 1536 : vr);
    const u32x4 vn = *(const u32x4*)(pos < L - 1 ? vr + 1536 : vr);
    const float2 bn = *(const float2*)(bonus + ((size_t)sr * 8 + hd) * 2);
    const bool hp = pos > 0, hn = pos < L - 1;
    float o[8], gg[8], vsh[8];
    float sm = 0.f;
#pragma unroll
    for (int j = 0; j < 4; ++j) {
      o[2 * j] = lo2f(uf[j]) + lo2f(ub[j]); o[2 * j + 1] = hi2f(uf[j]) + hi2f(ub[j]);
      gg[2 * j] = lo2f(ug[j]); gg[2 * j + 1] = hi2f(ug[j]);
      sm += o[2 * j] + o[2 * j + 1];
      const float c_lo = lo2f(vc[j]), c_hi = hi2f(vc[j]);
      const float p_lo = hp ? lo2f(vp[j]) : 0.f, p_hi = hp ? hi2f(vp[j]) : 0.f;
      const float n_lo = hn ? lo2f(vn[j]) : 0.f, n_hi = hn ? hi2f(vn[j]) : 0.f;
      vsh[2 * j] = c_lo + mp[2 * j] * (p_lo - c_lo) + mn[2 * j] * (n_lo - c_lo);
      vsh[2 * j + 1] = c_hi + mp[2 * j + 1] * (p_hi - c_hi) + mn[2 * j + 1] * (n_hi - c_hi);
    }
    sm += __shfl_xor(sm, 1); sm += __shfl_xor(sm, 2); sm += __shfl_xor(sm, 4);
    const float mean = sm * (1.f / 64.f);
    float vs = 0.f;
#pragma unroll
    for (int j = 0; j < 8; ++j) { float dlt = o[j] - mean; vs += dlt * dlt; }
    vs += __shfl_xor(vs, 1); vs += __shfl_xor(vs, 2); vs += __shfl_xor(vs, 4);
    const float rstd = rsqrtf(vs * (1.f / 64.f) + 64e-5f);
    const float bsum = bn.x + bn.y;
    float y[8];
#pragma unroll
    for (int j = 0; j < 8; ++j) y[j] = ((o[j] - mean) * rstd * lg[j] + lb[j] + bsum * vsh[j]) * gg[j];
    *(uint4*)(MIX + cr * 1024 + 512 + c0) = make_uint4(pack2(y[0], y[1]), pack2(y[2], y[3]), pack2(y[4], y[5]), pack2(y[6], y[7]));
  }
}

#define XB_TMO      128
#define XB_XCNT(j)  (256  + 64 * (j))
#define XB_XSUB(j)  (1280 + 64 * (j))
#define XB_XGEN(j)  (2304 + 64 * (j))
#define XB_TOP      3328
#define XB_TOPGEN   3392
#define XCD_BAR_WORDS 3456
#define XB_SPIN_CAP (1u << 23)
#define LAS __attribute__((address_space(3)))

__device__ __forceinline__ unsigned xb_ld(unsigned* p)              { return __hip_atomic_load(p, __ATOMIC_RELAXED, __HIP_MEMORY_SCOPE_AGENT); }
__device__ __forceinline__ unsigned xb_add(unsigned* p, unsigned v) { return __hip_atomic_fetch_add(p, v, __ATOMIC_RELAXED, __HIP_MEMORY_SCOPE_AGENT); }
__device__ __forceinline__ unsigned xb_xcc_id() { return (unsigned)__builtin_amdgcn_s_getreg((3 << 11) | 20) & 0xFu; }
#define XB_SPIN(cond, bar) do { unsigned _sp = 0; while (cond) { __builtin_amdgcn_s_sleep(1); \
    if ((++_sp & 255u) == 0u) { if (xb_ld(&(bar)[XB_TMO])) break; if (_sp > XB_SPIN_CAP) { atomicAdd(&(bar)[XB_TMO], 1u); break; } } } } while (0)

struct XcdBarrier {
    unsigned* bar; unsigned x;
    volatile LAS unsigned* st;
};

__device__ __forceinline__ XcdBarrier xcd_barrier_post(unsigned* bar, volatile LAS unsigned* st) {
    XcdBarrier b; b.bar = bar; b.x = xb_xcc_id(); b.st = st;
    if (threadIdx.x == 0) (void)xb_add(&bar[XB_XCNT(b.x)], 1u);
    return b;
}
__device__ __forceinline__ void xcd_barrier_complete(unsigned* bar, unsigned x, unsigned& nloc, unsigned& nx) {
    const unsigned G = gridDim.x * gridDim.y * gridDim.z;
    unsigned sum, cnt, mine, sp = 0u;
    for (;;) {
        sum = 0u; cnt = 0u; mine = 0u;
#pragma unroll
        for (unsigned j = 0; j < 16; ++j) { const unsigned c = xb_ld(&bar[XB_XCNT(j)]); sum += c; cnt += (c > 0u) ? 1u : 0u; mine = (j == x) ? c : mine; }
        if (sum == G) break;
        __builtin_amdgcn_s_sleep(1);
        if ((++sp & 255u) == 0u) { if (xb_ld(&bar[XB_TMO])) break; if (sp > XB_SPIN_CAP) { atomicAdd(&bar[XB_TMO], 1u); break; } }
    }
    nloc = mine > 0u ? mine : 1u; nx = cnt > 0u ? cnt : 1u;
}

__device__ __forceinline__ void xcd_barrier(const XcdBarrier& b) {
    asm volatile("s_waitcnt vmcnt(0)" ::: "memory");
    __syncthreads();
    if (threadIdx.x == 0) {
        unsigned* bar = b.bar;
        __builtin_amdgcn_s_waitcnt(0);
        unsigned nloc = b.st[0], nx = b.st[1];
        if (nloc == 0u) { xcd_barrier_complete(bar, b.x, nloc, nx); b.st[0] = nloc; b.st[1] = nx; }
        const unsigned old = xb_add(&bar[XB_XSUB(b.x)], 1u);
        const unsigned gen = old / nloc;
        if (old + 1u == (gen + 1u) * nloc) {
            __builtin_amdgcn_fence(__ATOMIC_RELEASE, "agent");
            asm volatile("s_waitcnt vmcnt(0)" ::: "memory");
            const unsigned og = xb_add(&bar[XB_TOP], 1u);
            const unsigned tg = og / nx;
            if (og + 1u == (tg + 1u) * nx) xb_add(&bar[XB_TOPGEN], 1u);
            else XB_SPIN(xb_ld(&bar[XB_TOPGEN]) == tg, bar);
            __builtin_amdgcn_fence(__ATOMIC_ACQUIRE, "agent");
            xb_add(&bar[XB_XGEN(b.x)], 1u);
            asm volatile("s_waitcnt vmcnt(0)" ::: "memory");
        } else {
            XB_SPIN(xb_ld(&bar[XB_XGEN(b.x)]) == gen, bar);
            __builtin_amdgcn_fence(__ATOMIC_ACQUIRE, "agent");
            asm volatile("s_waitcnt vmcnt(0)" ::: "memory");
        }
    }
    __syncthreads();
}

constexpr int NPHASE = 23;
__global__ void __launch_bounds__(NTH, 2) mega(P p) {
  extern __shared__ __attribute__((aligned(16))) unsigned char shm[];
  char* lds = (char*)shm;
  char* ws = p.ws;
  if (threadIdx.x == 0) *(uint4*)(shm + 131072) = make_uint4(0u, 0u, 0u, 0u);
  __syncthreads();
  const XcdBarrier xb = xcd_barrier_post((unsigned*)(ws + O_BAR), (volatile LAS unsigned*)(shm + 131072));
#ifndef DUP_MASK
#define DUP_MASK 0u
#endif
#define RUN(k, call) if (p.ph0 <= k && k < p.ph1) { call; if (k + 1 < p.ph1) { if (k == 0) cg::this_grid().sync(); else xcd_barrier(xb); } }
  RUN(0, phase_prep(p))
  RUN(1, phase_gemm_big((const bf16_t*)(ws + O_HN), (const bf16_t*)(ws + O_WIN0), 1536, 1024, (bf16_t*)(ws + O_PROJ0), 1536, 0, ws, shm))
  RUN(2, phase_prepA(p, lds))
  RUN(3, phase_attnA(p, lds))
  RUN(4, phase_fnet_gemm(p, lds))
  RUN(5, phase_gemm_big((const bf16_t*)(ws + O_MIX), (const bf16_t*)(ws + O_WOUT0), 1024, 1024, (bf16_t*)(ws + O_HN), 1024, 0, ws, shm))
  RUN(6, phase_resnorm(p, p.post_mix_g, p.pre_ffn_g, true))
  RUN(7, phase_gemm_gateup((const bf16_t*)(ws + O_HN), (const bf16_t*)(ws + O_WGU0), (bf16_t*)(ws + O_ACT), shm))
  RUN(8, phase_gemm_big((const bf16_t*)(ws + O_ACT), (const bf16_t*)(ws + O_WD0), 1024, DFF, (bf16_t*)(ws + O_HN), 1024, 0, ws, shm))
  RUN(9, phase_resnorm(p, p.post_ffn_g, p.pre_mix_g + 1024))
  RUN(10, phase_gemm_big((const bf16_t*)(ws + O_HN), (const bf16_t*)(ws + O_WIN1), 2816, 1024, nullptr, 0, 1, ws, shm))
  RUN(11, phase_prepC(p, lds))
  RUN(12, phase_attnC(p, lds))
  RUN(13, phase_scan1(p, lds))
  RUN(14, (phase_scan2(p, lds), late_weights(p)))
  RUN(15, phase_scan3(p, lds))
  RUN(16, phase_gemm_small((const bf16_t*)(ws + O_LR) + 256, 384, (const bf16_t*)(ws + O_GUP), 512, 128, (bf16_t*)(ws + O_G), 512, lds))
  RUN(17, phase_rwkv_final(p))
  RUN(18, phase_gemm_big((const bf16_t*)(ws + O_MIX), (const bf16_t*)(ws + O_WOUT1), 1024, 1024, (bf16_t*)(ws + O_HN), 1024, 0, ws, shm, 49152))
  RUN(19, phase_resnorm<true>(p, p.post_mix_g + 1024, p.pre_ffn_g + 1024))
  RUN(20, phase_gemm_gateup((const bf16_t*)(ws + O_HN), (const bf16_t*)(ws + O_WGU1), (bf16_t*)(ws + O_ACT), shm, 49152))
  RUN(21, phase_gemm_big((const bf16_t*)(ws + O_ACT), (const bf16_t*)(ws + O_WD1), 1024, DFF, (bf16_t*)(ws + O_HN), 1024, 0, ws, shm, 49152))
  RUN(22, phase_resnorm<true>(p, p.post_ffn_g + 1024, nullptr))
#undef RUN
}

extern "C" void kernel_launch(void* const* d_in, const int* in_sizes, int n_in, void* d_out, int out_size, void* d_ws, size_t ws_size,
                              hipStream_t stream) {
  static int grid_blocks = 0;
  if (!grid_blocks) {
    int dev = 0, cus = 0, per_cu = 0;
    (void)hipGetDevice(&dev);
    (void)hipDeviceGetAttribute(&cus, hipDeviceAttributeMultiprocessorCount, dev);
    if (hipFuncSetAttribute((const void*)mega, hipFuncAttributeMaxDynamicSharedMemorySize, LDS_BYTES) != hipSuccess) fprintf(stderr, "hipFuncSetAttribute failed\n");
    if (hipOccupancyMaxActiveBlocksPerMultiprocessor(&per_cu, (const void*)mega, NTH, LDS_BYTES) != hipSuccess || per_cu < 1) {
      fprintf(stderr, "occupancy query says %d\n", per_cu);
      (void)hipGetLastError();
    }
    grid_blocks = cus;
  }
  if (ws_size < O_BAR + CTL_BYTES) { fprintf(stderr, "workspace too small\n"); return; }
  if (hipMemsetAsync((char*)d_ws + O_BAR, 0, CTL_BYTES, stream) != hipSuccess) { fprintf(stderr, "memset failed\n"); return; }
  P p{};
  const float** f = (const float**)&p;
  for (int i = 0; i < 32; ++i) f[i] = (const float*)d_in[i];
  p.out = (float*)d_out;
  p.ws = (char*)d_ws;
#if FUSED
  p.ph0 = 0; p.ph1 = NPHASE;
  void* args[] = {&p};
  hipError_t e = hipLaunchCooperativeKernel((void*)mega, dim3(grid_blocks), dim3(NTH), args, LDS_BYTES, stream);
  if (e != hipSuccess) fprintf(stderr, "cooperative launch failed: %s (grid %d)\n", hipGetErrorString(e), grid_blocks);
#else
  for (int ph = 0; ph < NPHASE; ++ph) {
    p.ph0 = ph; p.ph1 = ph + 1;
    hipLaunchKernelGGL(mega, dim3(grid_blocks), dim3(NTH), LDS_BYTES, stream, p);
  }
#endif
}
```

```cpp
#include <hip/hip_runtime.h>
#include <hip/hip_cooperative_groups.h>
#include <cstdio>
namespace cg = cooperative_groups;

#ifndef FUSED
#define FUSED 1
#endif

typedef unsigned short bf16_t;
using bf16x8 = __attribute__((ext_vector_type(8))) short;
using s16x4 = __attribute__((ext_vector_type(4))) short;
using f32x16 = __attribute__((ext_vector_type(16))) float;
using u32x4 = __attribute__((ext_vector_type(4))) unsigned;
using f32x4v = __attribute__((ext_vector_type(4))) float;
#define DI __device__ __forceinline__
#define MFMA32(a, b, c) __builtin_amdgcn_mfma_f32_32x32x16_bf16((a), (b), (c), 0, 0, 0)
constexpr int NTH = 512;
constexpr int LDS_BYTES = 131072 + 16;

constexpr int DM_ = 1024;
constexpr int T_ = 49296;
constexpr int TP_ = 49408;
constexpr int NT_ = TP_ / 128;
constexpr int DFF = 2816;
constexpr float EPS = 1e-6f;
constexpr float LOG2E = 1.4426950408889634f;

constexpr size_t SZ_ROW1024 = (size_t)TP_ * 1024 * 2;
constexpr size_t O_WIN0 = 0;
constexpr size_t O_WOUT0 = O_WIN0 + (size_t)1536 * 1024 * 2;
constexpr size_t O_WGU0 = O_WOUT0 + (size_t)1024 * 1024 * 2;
constexpr size_t O_WD0 = O_WGU0 + (size_t)5632 * 1024 * 2;
constexpr size_t O_DM257 = O_WD0 + (size_t)1024 * 2816 * 2;
constexpr size_t O_DM1025 = O_DM257 + (size_t)384 * 576 * 2;
constexpr size_t O_WIN1 = O_DM1025 + (size_t)1152 * 2112 * 2;
constexpr size_t O_WOUT1 = O_WIN1 + (size_t)2816 * 1024 * 2;
constexpr size_t O_WGU1 = O_WOUT1 + (size_t)1024 * 1024 * 2;
constexpr size_t O_WD1 = O_WGU1 + (size_t)5632 * 1024 * 2;
constexpr size_t O_GUP = O_WD1 + (size_t)1024 * 2816 * 2;
constexpr size_t O_RA = O_GUP + (size_t)512 * 128 * 2;
constexpr size_t O_RB = O_RA + SZ_ROW1024;
constexpr size_t O_RC = O_RB + (size_t)TP_ * 2816 * 2;
constexpr size_t O_META = O_RC + SZ_ROW1024;
constexpr size_t O_WC = O_META + (size_t)144 * 1024 * 4;
constexpr size_t O_WUPT = O_WC + (size_t)4 * 64 * 128 * 4;
constexpr size_t O_AUPT = O_WUPT + (size_t)2 * 512 * 64 * 2;
constexpr size_t O_END = O_AUPT + (size_t)2 * 512 * 64 * 2;
constexpr size_t O_HN = O_RA;
constexpr size_t O_VTA = O_RA;
constexpr size_t O_LR = O_RA;
constexpr size_t O_BONUS = O_RA + (size_t)TP_ * 384 * 2;
constexpr size_t O_VTC = O_BONUS + (size_t)T_ * 16 * 4;
constexpr size_t O_OB = O_RA + (size_t)TP_ * 512 * 2;
constexpr size_t O_PROJ0 = O_RB;
constexpr size_t O_ZB = O_PROJ0 + (size_t)TP_ * 1536 * 2;
constexpr size_t O_Y = O_ZB + (size_t)TP_ * 512 * 2;
constexpr size_t O_ACT = O_RB;
constexpr size_t O_PRKV = O_RB;
constexpr size_t O_PC = O_PRKV + (size_t)TP_ * 1536 * 2;
constexpr size_t O_PLOW = O_PC + (size_t)TP_ * 768 * 2;
constexpr size_t O_PQ = O_PC;
constexpr size_t O_G = O_PC;
constexpr size_t O_MIX = O_RC;
static_assert(O_VTC + (size_t)49728 * 128 * 2 <= O_RB, "vtc");
static_assert(O_Y + (size_t)(8 * 16 * 256 * 576 + 16 * 256 * 2112) * 2 <= O_RC, "y");
static_assert(O_PQ + (size_t)3216 * 32768 <= O_RC, "pq");
constexpr size_t O_BAR = (O_END + 255) / 256 * 256;
constexpr size_t O_CNT = O_BAR + 3456 * 4;
constexpr size_t CTL_BYTES = 3456 * 4 + 4 * 256;
static_assert(O_BAR + CTL_BYTES <= (size_t)536870912, "ws");

struct P {
  const float *x_prompt, *x_sample, *meta, *pre_mix_g, *post_mix_g, *pre_ffn_g, *post_ffn_g;
  const float *even_w_in, *even_w_out, *a_q_gain, *a_k_gain, *b_norm_g, *b_w, *b_b;
  const float *odd_w_in, *odd_w_out, *c_sink, *mu_prev, *mu_next, *d_w0, *d_w_up, *d_a0, *d_a_up, *d_g_up;
  const float *d_k_k, *d_k_a, *d_r_k, *d_ln_g, *d_ln_b, *ffn_gate, *ffn_up, *ffn_down;
  float* out;
  char* ws;
  int ph0, ph1;
};

typedef float f32x2 __attribute__((ext_vector_type(2)));
typedef __bf16 bf16x2_t __attribute__((ext_vector_type(2)));
DI bf16_t f2bf(float x) { return __builtin_bit_cast(bf16_t, (__bf16)x); }
DI float bf2f(bf16_t b) { return __uint_as_float(((unsigned)b) << 16); }
DI unsigned pack2(float a, float b) { f32x2 v = {a, b}; return __builtin_bit_cast(unsigned, __builtin_convertvector(v, bf16x2_t)); }
DI float lo2f(unsigned u) { return __uint_as_float(u << 16); }
DI float hi2f(unsigned u) { return __uint_as_float(u & 0xffff0000u); }
DI float wave_sum(float v) {
  for (int o = 32; o > 0; o >>= 1) v += __shfl_xor(v, o);
  return v;
}
DI int seq_of(int sr, int& pos) {
  if (sr < 32896) { int b = sr / 4112; pos = sr - b * 4112; return b; }
  pos = sr - 32896; return 8;
}
DI int seq_len(int b) { return b < 8 ? 4112 : 16400; }
DI int seq_base(int b) { return b < 8 ? b * 4112 : 32896; }
DI float* hrow(const P& p, int sr) {
  int pos; int b = seq_of(sr, pos);
  if (pos < 16) return (float*)(p.ws + O_META) + (size_t)(b * 16 + pos) * 1024;
  return p.out + ((size_t)(b < 8 ? b * 4096 : 32768) + (pos - 16)) * 1024;
}
DI float sigmoidf_(float x) { return 1.f / (1.f + expf(-x)); }
DI int crow_of(int seq, int pos) { return pos < 16 ? 49152 + seq * 16 + pos : (seq < 8 ? seq * 4096 : 32768) + pos - 16; }
constexpr int OBASE_SEQ = 0x7fffffff;

DI void transpose_w(const float* W, int K, int ldw, int N, bf16_t* Wt, int mode, const float* W2, int gtid, int gsz) {
  int nk8 = K / 8;
  long total = (long)N * nk8;
  for (long it = gtid; it < total; it += gsz) {
    int n = (int)(it % N), k8 = (int)(it / N);
    const float* src = W;
    int c = n;
    if (mode == 1) {
      int blk = n >> 8, w = n & 255;
      c = blk * 128 + (w & 127);
      if (w >= 128) src = W2;
    }
    unsigned r[4];
#pragma unroll
    for (int j = 0; j < 4; ++j) {
      float a = src[(size_t)(k8 * 8 + 2 * j) * ldw + c];
      float b = src[(size_t)(k8 * 8 + 2 * j + 1) * ldw + c];
      r[j] = pack2(a, b);
    }
    *(uint4*)(Wt + (size_t)n * K + k8 * 8) = make_uint4(r[0], r[1], r[2], r[3]);
  }
}

DI void late_weights(const P& p) {
  char* ws = p.ws;
  int gtid, gsz;
  if (gridDim.x > 144 + 16) { if (blockIdx.x < 144) return; gtid = (blockIdx.x - 144) * NTH + threadIdx.x; gsz = (gridDim.x - 144) * NTH; }
  else { gtid = blockIdx.x * NTH + threadIdx.x; gsz = gridDim.x * NTH; }
  transpose_w(p.odd_w_out, 1024, 1024, 1024, (bf16_t*)(ws + O_WOUT1), 0, nullptr, gtid, gsz);
  transpose_w(p.ffn_gate + (size_t)1024 * DFF, 1024, DFF, 5632, (bf16_t*)(ws + O_WGU1), 1, p.ffn_up + (size_t)1024 * DFF, gtid, gsz);
  transpose_w(p.ffn_down + (size_t)DFF * 1024, DFF, 1024, 1024, (bf16_t*)(ws + O_WD1), 0, nullptr, gtid, gsz);
}

DI void phase_prep(const P& p) {
  const int gtid = blockIdx.x * NTH + threadIdx.x, gsz = gridDim.x * NTH;
  char* ws = p.ws;
  transpose_w(p.even_w_in, 1024, 1536, 1536, (bf16_t*)(ws + O_WIN0), 0, nullptr, gtid, gsz);
  transpose_w(p.even_w_out, 1024, 1024, 1024, (bf16_t*)(ws + O_WOUT0), 0, nullptr, gtid, gsz);
  transpose_w(p.odd_w_in, 1024, 2688, 2688, (bf16_t*)(ws + O_WIN1), 0, nullptr, gtid, gsz);
  transpose_w(p.ffn_gate, 1024, DFF, 5632, (bf16_t*)(ws + O_WGU0), 1, p.ffn_up, gtid, gsz);
  transpose_w(p.ffn_down, DFF, 1024, 1024, (bf16_t*)(ws + O_WD0), 0, nullptr, gtid, gsz);
  transpose_w(p.d_g_up, 128, 512, 512, (bf16_t*)(ws + O_GUP), 0, nullptr, gtid, gsz);
  for (int d = 0; d < 2; ++d) {
    transpose_w(p.d_w_up + (size_t)d * 64 * 512, 64, 512, 512, (bf16_t*)(ws + O_WUPT) + (size_t)d * 512 * 64, 0, nullptr, gtid, gsz);
    transpose_w(p.d_a_up + (size_t)d * 64 * 512, 64, 512, 512, (bf16_t*)(ws + O_AUPT) + (size_t)d * 512 * 64, 0, nullptr, gtid, gsz);
  }
  for (int it = gtid; it < 128 * 1024 / 8; it += gsz) *(uint4*)((bf16_t*)(ws + O_WIN1) + (size_t)2688 * 1024 + (size_t)it * 8) = make_uint4(0, 0, 0, 0);
  for (int which = 0; which < 2; ++which) {
    const int M = which ? 1025 : 257, MP = which ? 1152 : 384, KP = which ? 2112 : 576;
    bf16_t* dm = (bf16_t*)(ws + (which ? O_DM1025 : O_DM257));
    for (int it = gtid; it < MP * KP; it += gsz) {
      int r = it / KP, c = it - r * KP;
      float v = 0.f;
      if (r < M && c < 2 * M) {
        int n2 = c < M ? c : c - M;
        int m = (r * n2) % M;
        float s, co;
        sincospif(2.0f * (float)m / (float)M, &s, &co);
        v = c < M ? co : s;
      }
      dm[it] = f2bf(v);
    }
  }
  for (int it = gtid; it < 4 * 64 * 128; it += gsz) {
    int o = it & 127, c = (it >> 7) & 63, g = it >> 13;
    int d = o & 63;
    float acc = 0.f;
    for (int c2 = 0; c2 < 64; ++c2) {
      float s, co;
      sincospif((float)((c * c2) & 63) / 32.f, &s, &co);
      float w = p.b_w[(g * 64 + c2) * 64 + d];
      acc += (o < 64 ? co : -s) * w;
    }
    ((float*)(ws + O_WC))[it] = acc;
  }
  const int lane = threadIdx.x & 63, gw = gtid >> 6, nw = gsz >> 6;
  bf16_t* HN = (bf16_t*)(ws + O_HN);
  for (int sr = gw; sr < TP_; sr += nw) {
    if (sr >= T_) {
#pragma unroll
      for (int q = 0; q < 2; ++q) *(uint4*)(HN + (size_t)sr * 1024 + q * 512 + lane * 8) = make_uint4(0, 0, 0, 0);
      continue;
    }
    int pos; int b = seq_of(sr, pos);
    const float* src = pos < 16 ? p.meta + pos * 1024
                                : (b < 8 ? p.x_prompt + ((size_t)b * 4096 + pos - 16) * 1024 : p.x_sample + (size_t)(pos - 16) * 1024);
    float4 v[4];
    float ss = 0.f;
#pragma unroll
    for (int q = 0; q < 4; ++q) {
      v[q] = *(const float4*)(src + q * 256 + lane * 4);
      ss += v[q].x * v[q].x + v[q].y * v[q].y + v[q].z * v[q].z + v[q].w * v[q].w;
    }
    ss = wave_sum(ss);
    float rs = rsqrtf(ss * (1.f / 1024.f) + EPS);
#pragma unroll
    for (int q = 0; q < 4; ++q) {
      float4 g = *(const float4*)(p.pre_mix_g + q * 256 + lane * 4);
      uint2 o = make_uint2(pack2(v[q].x * rs * g.x, v[q].y * rs * g.y), pack2(v[q].z * rs * g.z, v[q].w * rs * g.w));
      *(uint2*)(HN + (size_t)sr * 1024 + q * 256 + lane * 4) = o;
    }
  }
}

DI void gemm_tile(const bf16_t* __restrict__ A, int lda, const bf16_t* __restrict__ B, int ldb, int K, char* lds, f32x16 (&acc)[2][2]) {
  const int tid = threadIdx.x & 255, lane = tid & 63, wave = tid >> 6, wm = wave >> 1, wn = wave & 1;
  const int l31 = lane & 31, h = lane >> 5;
  bf16_t* As = (bf16_t*)lds;
  bf16_t* Bs = As + 128 * 72;
#pragma unroll
  for (int a = 0; a < 2; ++a)
#pragma unroll
    for (int b = 0; b < 2; ++b)
#pragma unroll
      for (int i = 0; i < 16; ++i) acc[a][b][i] = 0.f;
  const int lr = tid >> 3, lc = (tid & 7) * 8;
  const bf16_t* Ag = A + (size_t)lr * lda + lc;
  const bf16_t* Bg = B + (size_t)lr * ldb + lc;
  u32x4 ra[4], rb[4];
#pragma unroll
  for (int q = 0; q < 4; ++q) {
    ra[q] = *(const u32x4*)(Ag + (size_t)(32 * q) * lda);
    rb[q] = *(const u32x4*)(Bg + (size_t)(32 * q) * ldb);
  }
#pragma unroll
  for (int q = 0; q < 4; ++q) {
    *(u32x4*)(As + (lr + 32 * q) * 72 + lc) = ra[q];
    *(u32x4*)(Bs + (lr + 32 * q) * 72 + lc) = rb[q];
  }
  __syncthreads();
  const int nk = K >> 6;
  for (int kt = 0; kt < nk; ++kt) {
    if (kt + 1 < nk) {
#pragma unroll
      for (int q = 0; q < 4; ++q) {
        ra[q] = *(const u32x4*)(Ag + (size_t)(32 * q) * lda + (kt + 1) * 64);
        rb[q] = *(const u32x4*)(Bg + (size_t)(32 * q) * ldb + (kt + 1) * 64);
      }
    }
#pragma unroll
    for (int ks = 0; ks < 4; ++ks) {
      bf16x8 a[2], b[2];
#pragma unroll
      for (int t = 0; t < 2; ++t) {
        a[t] = *(const bf16x8*)(As + (wm * 64 + t * 32 + l31) * 72 + ks * 16 + 8 * h);
        b[t] = *(const bf16x8*)(Bs + (wn * 64 + t * 32 + l31) * 72 + ks * 16 + 8 * h);
      }
#pragma unroll
      for (int mt = 0; mt < 2; ++mt)
#pragma unroll
        for (int nt = 0; nt < 2; ++nt) acc[mt][nt] = MFMA32(a[mt], b[nt], acc[mt][nt]);
    }
    __syncthreads();
    if (kt + 1 < nk) {
#pragma unroll
      for (int q = 0; q < 4; ++q) {
        *(u32x4*)(As + (lr + 32 * q) * 72 + lc) = ra[q];
        *(u32x4*)(Bs + (lr + 32 * q) * 72 + lc) = rb[q];
      }
      __syncthreads();
    }
  }
}
#define ACC_ROW(mt, i) (wm * 64 + (mt) * 32 + ((i) & 3) + 8 * ((i) >> 2) + 4 * h)
#define ACC_COL(nt) (wn * 64 + (nt) * 32 + l31)
#define GEMM_IDS const int lane = threadIdx.x & 63, wave = (threadIdx.x & 255) >> 6, wm = wave >> 1, wn = wave & 1, l31 = lane & 31, h = lane >> 5; (void)wm; (void)wn; (void)l31; (void)h;

DI void phase_gemm_small(const bf16_t* A, int lda, const bf16_t* W, int N, int K, bf16_t* C, int ldc, char* lds) {
  GEMM_IDS
  const int sb = threadIdx.x >> 8;
  const int ntn = N / 128;
  const int total = NT_ * ntn;
  for (int t0 = blockIdx.x * 2; t0 < total; t0 += gridDim.x * 2) {
    const int t = t0 + sb;
    const int tm = t / ntn, tn = t - tm * ntn;
    f32x16 acc[2][2];
    gemm_tile(A + (size_t)tm * 128 * lda, lda, W + (size_t)tn * 128 * K, K, K, lds + sb * 36864, acc);
#pragma unroll
    for (int mt = 0; mt < 2; ++mt)
#pragma unroll
      for (int nt = 0; nt < 2; ++nt)
#pragma unroll
        for (int i = 0; i < 16; ++i) {
          int row = tm * 128 + ACC_ROW(mt, i), col = tn * 128 + ACC_COL(nt);
          C[(size_t)row * ldc + col] = f2bf(acc[mt][nt][i]);
        }
  }
}

namespace pg8 {
#define PG8_LAS __attribute__((address_space(3)))
typedef unsigned short bf16_t;
typedef short bf16x8 __attribute__((ext_vector_type(8)));
typedef float f32x4 __attribute__((ext_vector_type(4)));
typedef unsigned u32x4 __attribute__((ext_vector_type(4)));
constexpr int BM = 256, BK = 64, HALF = 128, HTB = HALF * BK * 2  , STAGE_BYTES = 8 * HTB, NXCD = 8, WGM = 8;

__host__ __device__ __forceinline__ int lds_byte(int r, int c) { const int st = (r >> 4) * 2 + (c >> 5), rr = r & 15, cc = c & 31, ob = rr * 64 + cc * 2; return st * 1024 + (ob ^ (((ob >> 9) & 1) << 5)); }
__host__ __device__ __forceinline__ void stage_rc(int b, int& R, int& C) { const int st = b / 1024, sb = b % 1024, swz = sb ^ (((sb >> 9) & 1) << 5); R = (st >> 1) * 16 + swz / 64; C = (st & 1) * 32 + (swz % 64) / 2; }
__host__ __device__ __forceinline__ int perm32(int rho) { const int n = rho >> 4, i = rho & 15; return 8 * (i >> 2) + 4 * n + (i & 3); }

struct Unit { int pm, pn; };
struct Gemm { const bf16_t* A; const bf16_t* Bt; int M, N, K; };

struct StaticOrder {
    int nM, nN, nwg, G, c;
    __host__ __device__ void init(int M, int N, int G_, int c_) { nM = M / BM; nN = N / BM; nwg = nM * nN; G = G_; c = c_; }
    __host__ __device__ bool next(int i, Unit& u) const {
        const long L = (long)i * G + c; if (L >= nwg) return false;
        int wgid = (int)L; { const int q = nwg / NXCD, r = nwg % NXCD, xcd = wgid % NXCD, off = wgid / NXCD; wgid = (xcd < r ? xcd * (q + 1) : r * (q + 1) + (xcd - r) * q) + off; }
        const int nig = WGM * nN, gid = wgid / nig, fm = gid * WGM, gsz = (nM - fm) < WGM ? (nM - fm) : WGM;
        u.pm = fm + ((wgid % nig) % gsz); u.pn = (wgid % nig) / gsz; return true;
    }
    __device__ __forceinline__ void a_ready(const Unit&) const {}
    __device__ __forceinline__ void done(const Unit&) const {}
};
__device__ __forceinline__ unsigned cvt_pk_bf16(float lo, float hi) { unsigned r; asm volatile("v_cvt_pk_bf16_f32 %0, %1, %2" : "=v"(r) : "v"(lo), "v"(hi)); return r; }

struct EpiRoute {
    static constexpr bool PERM = true, AFTER_DRAIN = false;
    bf16_t* O; int ldc; int route; bf16_t* pc; bf16_t* prkv; bf16_t* plow;
    __device__ __forceinline__ void operator()(const f32x4 (&acc)[2][2][4][2], const Unit& u, int wr, int wc, int fr, int fq) const {
        const int row0 = u.pm * BM + wr * 64 + fr;
#pragma unroll
        for (int bj = 0; bj < 2; ++bj) {
            int colh = u.pn * BM + bj * HALF; bf16_t* base = O; int ld = ldc;
            if (route) {
                if (colh < 768) { base = pc; ld = 768; }
                else if (colh < 2304) { base = prkv; ld = 1536; colh -= 768; }
                else if (colh < 2688) { base = plow; ld = 384; colh -= 2304; }
                else continue;
            }
            const int col0 = colh + wc * 32 + 8 * fq;
#pragma unroll
            for (int ai = 0; ai < 2; ++ai)
#pragma unroll
                for (int m = 0; m < 4; ++m) { bf16_t* rowp = base + (size_t)(row0 + ai * HALF + m * 16) * ld + col0;
                    const f32x4 v0 = acc[ai][bj][m][0], v1 = acc[ai][bj][m][1];
                    u32x4 w; w.x = cvt_pk_bf16(v0[0], v0[1]); w.y = cvt_pk_bf16(v0[2], v0[3]); w.z = cvt_pk_bf16(v1[0], v1[1]); w.w = cvt_pk_bf16(v1[2], v1[3]);
                    *(u32x4*)rowp = w; }
        }
    }
};
struct EpiGateUp {
    static constexpr bool PERM = true, AFTER_DRAIN = false;
    bf16_t* ACT;
    __device__ __forceinline__ void operator()(const f32x4 (&acc)[2][2][4][2], const Unit& u, int wr, int wc, int fr, int fq) const {
        const int row0 = u.pm * BM + wr * 64 + fr, col0 = u.pn * HALF + wc * 32 + 8 * fq;
#pragma unroll
        for (int ai = 0; ai < 2; ++ai)
#pragma unroll
            for (int m = 0; m < 4; ++m) { bf16_t* rowp = ACT + (size_t)(row0 + ai * HALF + m * 16) * 2816 + col0;
                float v[8];
#pragma unroll
                for (int n = 0; n < 2; ++n)
#pragma unroll
                    for (int j = 0; j < 4; ++j) { const float g = acc[ai][0][m][n][j], uu = acc[ai][1][m][n][j]; v[n * 4 + j] = g * __builtin_amdgcn_rcpf(1.f + __expf(-g)) * uu; }
                u32x4 w; w.x = cvt_pk_bf16(v[0], v[1]); w.y = cvt_pk_bf16(v[2], v[3]); w.z = cvt_pk_bf16(v[4], v[5]); w.w = cvt_pk_bf16(v[6], v[7]);
                *(u32x4*)rowp = w; }
    }
};
template <class Epi, class Sched, bool STAMP = false>
__device__ __forceinline__ void gemm_phase(PG8_LAS unsigned char* lds, const Gemm g, const Sched& S, const Epi& E, unsigned long long* stamps) {
    const int tid = threadIdx.x, wid = __builtin_amdgcn_readfirstlane(tid >> 6), lane = tid & 63, wr = wid >> 2, wc = wid & 3, fr = lane & 15, fq = lane >> 4;
    const int K = g.K, nt = K / BK;
    int ts_lo = 0, ts_hi = 0, nts = 0; const unsigned long long rt_entry = STAMP ? (unsigned long long)wall_clock64() : 0ull;
#define PG8_STAMP() do { if (STAMP && wid == 0 && nts < 64) { const unsigned long long _c = (unsigned long long)clock64(); \
        ts_lo = (lane == nts) ? (int)(unsigned)_c : ts_lo; ts_hi = (lane == nts) ? (int)(unsigned)(_c >> 32) : ts_hi; ++nts; } } while (0)
    PG8_STAMP();
    unsigned voffA[2], voffB[2];
#pragma unroll
    for (int i = 0; i < 2; ++i) { int R, C; stage_rc(tid * 16 + i * 8192, R, C); const int Rb = Epi::PERM ? ((R & ~31) + perm32(R & 31)) : R;
        voffA[i] = (unsigned)(R * K + C) * 2u; voffB[i] = (unsigned)(Rb * K + C) * 2u; }
    const size_t kstep = (size_t)(BK * 2);
    const size_t hstep = (size_t)HALF * K * 2;
    const size_t tstep = 2 * hstep;
    const unsigned ldsw = (unsigned)wid * 1024u;
    const int aoff = lds_byte(wr * 64 + fr, fq * 8), boff = lds_byte(wc * 32 + fr, fq * 8);
#define PG8_SA(b, h) (((b) * 2 + (h)) * HTB)
#define PG8_SB(b, h) ((4 + (b) * 2 + (h)) * HTB)
#define PG8_STAGE(bufoff, gbase, voff) do { _Pragma("unroll") for (int _i = 0; _i < 2; ++_i) \
        __builtin_amdgcn_global_load_lds((const unsigned*)((const char*)(gbase) + (voff)[_i]), (PG8_LAS unsigned*)(lds + (bufoff) + ldsw + _i * 8192), 16, 0, 0); } while (0)
#define PG8_LDA(dst, b, h) do { _Pragma("unroll") for (int m = 0; m < 4; ++m) _Pragma("unroll") for (int k = 0; k < 2; ++k) dst[m][k] = *(const PG8_LAS bf16x8*)(lds + PG8_SA(b, h) + aoff + m * 2048 + k * 1024); } while (0)
#define PG8_LDB(dst, b, h) do { _Pragma("unroll") for (int n = 0; n < 2; ++n) _Pragma("unroll") for (int k = 0; k < 2; ++k) dst[n][k] = *(const PG8_LAS bf16x8*)(lds + PG8_SB(b, h) + boff + n * 2048 + k * 1024); } while (0)
#define PG8_MMA(ai, bj, At, Bt) do { __builtin_amdgcn_s_setprio(1); _Pragma("unroll") for (int m = 0; m < 4; ++m) _Pragma("unroll") for (int n = 0; n < 2; ++n) _Pragma("unroll") for (int k = 0; k < 2; ++k) \
        acc[ai][bj][m][n] = __builtin_amdgcn_mfma_f32_16x16x32_bf16(Bt[n][k], At[m][k], acc[ai][bj][m][n], 0, 0, 0); __builtin_amdgcn_s_setprio(0); } while (0)
#define PG8_WAIT_V(n) asm volatile("s_waitcnt vmcnt(" #n ")" ::: "memory")
#define PG8_WAIT_L(n) asm volatile("s_waitcnt lgkmcnt(" #n ")" ::: "memory")
#define PG8_BAR __builtin_amdgcn_s_barrier()
#define PG8_SCHED __builtin_amdgcn_sched_barrier(0)
    Unit cur, nxt; int ui = 0;
    if (!S.next(0, cur)) return;
    f32x4 acc[2][2][4][2];
#pragma unroll
    for (int a = 0; a < 2; ++a)
#pragma unroll
        for (int b = 0; b < 2; ++b)
#pragma unroll
            for (int m = 0; m < 4; ++m)
#pragma unroll
                for (int n = 0; n < 2; ++n) acc[a][b][m][n] = (f32x4){0.f, 0.f, 0.f, 0.f};
    bf16x8 At[4][2], B0[2][2], B1[2][2];
    const char* cA = (const char*)g.A + (size_t)cur.pm * tstep; const char* cB = (const char*)g.Bt + (size_t)cur.pn * tstep;
    S.a_ready(cur);
    PG8_STAGE(PG8_SB(0, 0), cB, voffB); PG8_STAGE(PG8_SA(0, 0), cA, voffA); PG8_STAGE(PG8_SB(0, 1), cB + hstep, voffB); PG8_STAGE(PG8_SA(0, 1), cA + hstep, voffA);
    if (wr == 1) PG8_BAR;
    PG8_WAIT_V(4); PG8_BAR;
    PG8_STAGE(PG8_SB(1, 0), cB + kstep, voffB); PG8_STAGE(PG8_SA(1, 0), cA + kstep, voffA); PG8_STAGE(PG8_SB(1, 1), cB + hstep + kstep, voffB);
    PG8_WAIT_V(6); PG8_BAR;
    PG8_STAMP();
    for (;;) {
        const bool has_next = S.next(ui + 1, nxt);
        const char* nA = has_next ? (const char*)g.A + (size_t)nxt.pm * tstep : cA; const char* nB = has_next ? (const char*)g.Bt + (size_t)nxt.pn * tstep : cB;
        for (int t = 0; t < nt; t += 2) {
            const bool last = (t == nt - 2);
            const char* a1 = cA + (size_t)(t + 1) * kstep;
            const char* a2 = last ? nA : cA + (size_t)(t + 2) * kstep; const char* b2 = last ? nB : cB + (size_t)(t + 2) * kstep;
            const char* a3 = a2 + kstep; const char* b3 = b2 + kstep;
            if (last && has_next) S.a_ready(nxt);
            PG8_LDB(B0, 0, 0); PG8_SCHED; PG8_LDA(At, 0, 0); PG8_STAGE(PG8_SA(1, 1), a1 + hstep, voffA);
            PG8_WAIT_L(8); PG8_BAR; PG8_WAIT_L(0); PG8_MMA(0, 0, At, B0); PG8_BAR; PG8_SCHED;
            PG8_LDB(B1, 0, 1); PG8_STAGE(PG8_SB(0, 0), b2, voffB);
            PG8_BAR; PG8_WAIT_L(0); PG8_MMA(0, 1, At, B1); PG8_BAR;
            PG8_LDA(At, 0, 1); PG8_STAGE(PG8_SA(0, 0), a2, voffA);
            PG8_BAR; PG8_WAIT_L(0); PG8_MMA(1, 0, At, B0); PG8_BAR; PG8_SCHED;
            PG8_STAGE(PG8_SB(0, 1), b2 + hstep, voffB);
            PG8_WAIT_V(6); PG8_BAR; PG8_MMA(1, 1, At, B1); PG8_BAR;
            PG8_LDB(B0, 1, 0); PG8_SCHED; PG8_LDA(At, 1, 0); PG8_STAGE(PG8_SA(0, 1), a2 + hstep, voffA);
            PG8_WAIT_L(8); PG8_BAR; PG8_WAIT_L(0); PG8_MMA(0, 0, At, B0); PG8_BAR; PG8_SCHED;
            PG8_LDB(B1, 1, 1); PG8_STAGE(PG8_SB(1, 0), b3, voffB);
            PG8_BAR; PG8_WAIT_L(0); PG8_MMA(0, 1, At, B1); PG8_BAR;
            PG8_LDA(At, 1, 1); PG8_STAGE(PG8_SA(1, 0), a3, voffA);
            PG8_BAR; PG8_WAIT_L(0); PG8_MMA(1, 0, At, B0); PG8_BAR; PG8_SCHED;
            PG8_STAGE(PG8_SB(1, 1), b3 + hstep, voffB);
            PG8_WAIT_V(6); PG8_BAR; PG8_MMA(1, 1, At, B1); PG8_BAR;
        }
        PG8_STAMP();
        if constexpr (!Epi::AFTER_DRAIN) { E(acc, cur, wr, wc, fr, fq); S.done(cur); }
        PG8_STAMP();
        if (!has_next) break;
#pragma unroll
        for (int a = 0; a < 2; ++a)
#pragma unroll
            for (int b = 0; b < 2; ++b)
#pragma unroll
                for (int m = 0; m < 4; ++m)
#pragma unroll
                    for (int n = 0; n < 2; ++n) acc[a][b][m][n] = (f32x4){0.f, 0.f, 0.f, 0.f};
        cur = nxt; cA = nA; cB = nB; ++ui;
    }
    PG8_WAIT_V(0);
    if (wr == 0) PG8_BAR;
    PG8_BAR;
    if constexpr (Epi::AFTER_DRAIN) { E.fused(acc, cur, wr, wc, fr, fq, lds, wid, lane); S.done(cur); }
    PG8_STAMP();
    if (STAMP && wid == 0) { stamps[lane] = lane < nts ? (((unsigned long long)(unsigned)ts_hi << 32) | (unsigned)ts_lo) : 0ull;
        if (lane == 62) stamps[62] = rt_entry; if (lane == 63) stamps[63] = (unsigned long long)wall_clock64(); }
#undef PG8_STAMP
#undef PG8_SA
#undef PG8_SB
#undef PG8_STAGE
#undef PG8_LDA
#undef PG8_LDB
#undef PG8_MMA
#undef PG8_WAIT_V
#undef PG8_WAIT_L
#undef PG8_BAR
#undef PG8_SCHED
}
}

DI void phase_gemm_big(const bf16_t* A, const bf16_t* W, int N, int K, bf16_t* C, int ldc, int route, char* ws, unsigned char* lds, int Mrows = TP_) {
  pg8::Gemm g{A, W, Mrows, N, K};
  pg8::StaticOrder S; S.init(Mrows, N, gridDim.x, blockIdx.x);
  pg8::EpiRoute E{C, ldc, route, (bf16_t*)(ws + O_PC), (bf16_t*)(ws + O_PRKV), (bf16_t*)(ws + O_PLOW)};
  pg8::gemm_phase<pg8::EpiRoute, pg8::StaticOrder, false>((PG8_LAS unsigned char*)lds, g, S, E, nullptr);
}
DI void phase_gemm_gateup(const bf16_t* A, const bf16_t* W, bf16_t* ACT, unsigned char* lds, int Mrows = TP_) {
  pg8::Gemm g{A, W, Mrows, 5632, 1024};
  pg8::StaticOrder S; S.init(Mrows, 5632, gridDim.x, blockIdx.x);
  pg8::EpiGateUp E{ACT};
  pg8::gemm_phase<pg8::EpiGateUp, pg8::StaticOrder, false>((PG8_LAS unsigned char*)lds, g, S, E, nullptr);
}

template <bool COMPACT = false>
DI void phase_resnorm(const P& p, const float* g1, const float* g2, bool first = false) {
  const int lane = threadIdx.x & 63, gw = (blockIdx.x * NTH + threadIdx.x) >> 6, nw = (gridDim.x * NTH) >> 6;
  bf16_t* HN = (bf16_t*)(p.ws + O_HN);
  for (int sr = gw; sr < (COMPACT ? 49152 : T_); sr += nw) {
    float* hr = COMPACT ? p.out + (size_t)sr * 1024 : hrow(p, sr);
    const float* hsrc = hr;
    if (first) {
      int pos; const int b = seq_of(sr, pos);
      hsrc = pos < 16 ? p.meta + pos * 1024 : (b < 8 ? p.x_prompt + ((size_t)b * 4096 + pos - 16) * 1024 : p.x_sample + (size_t)(pos - 16) * 1024);
    }
    float x[16];
    float ss = 0.f;
#pragma unroll
    for (int q = 0; q < 4; ++q) {
      const uint2 u = *(const uint2*)(HN + (size_t)sr * 1024 + q * 256 + lane * 4);
      x[q * 4] = lo2f(u.x); x[q * 4 + 1] = hi2f(u.x); x[q * 4 + 2] = lo2f(u.y); x[q * 4 + 3] = hi2f(u.y);
      ss += x[q * 4] * x[q * 4] + x[q * 4 + 1] * x[q * 4 + 1] + x[q * 4 + 2] * x[q * 4 + 2] + x[q * 4 + 3] * x[q * 4 + 3];
    }
    f32x4v hh[4];
#pragma unroll
    for (int q = 0; q < 4; ++q) {
      if (first) hh[q] = *(const f32x4v*)(hsrc + q * 256 + lane * 4);
      else { const uint2 hu = *(const uint2*)((const bf16_t*)hsrc + q * 256 + lane * 4); hh[q] = (f32x4v){lo2f(hu.x), hi2f(hu.x), lo2f(hu.y), hi2f(hu.y)}; }
    }
    ss = wave_sum(ss);
    const float rs = rsqrtf(ss * (1.f / 1024.f) + EPS);
    float ss2 = 0.f;
#pragma unroll
    for (int q = 0; q < 4; ++q) {
      const float4 g = *(const float4*)(g1 + q * 256 + lane * 4);
      hh[q].x += x[q * 4 + 0] * rs * g.x; hh[q].y += x[q * 4 + 1] * rs * g.y; hh[q].z += x[q * 4 + 2] * rs * g.z; hh[q].w += x[q * 4 + 3] * rs * g.w;
      if (g2) *(uint2*)((bf16_t*)hr + q * 256 + lane * 4) = make_uint2(pack2(hh[q].x, hh[q].y), pack2(hh[q].z, hh[q].w));
      else *(f32x4v*)(hr + q * 256 + lane * 4) = hh[q];
      ss2 += hh[q].x * hh[q].x + hh[q].y * hh[q].y + hh[q].z * hh[q].z + hh[q].w * hh[q].w;
    }
    if (g2) {
      ss2 = wave_sum(ss2);
      const float rs2 = rsqrtf(ss2 * (1.f / 1024.f) + EPS);
#pragma unroll
      for (int q = 0; q < 4; ++q) {
        const float4 g = *(const float4*)(g2 + q * 256 + lane * 4);
        *(uint2*)(HN + (size_t)sr * 1024 + q * 256 + lane * 4) = make_uint2(pack2(hh[q].x * rs2 * g.x, hh[q].y * rs2 * g.y), pack2(hh[q].z * rs2 * g.z, hh[q].w * rs2 * g.w));
      }
    }
  }
}

DI size_t vta_base(int seq) { return seq < 8 ? (size_t)seq * 256 * 4160 : (size_t)8 * 256 * 4160; }
template <int NC> DI void vt_transpose(const bf16_t* src, int ld, int col0, bf16_t* VT, char* lds) {
  bf16_t* tl = (bf16_t*)lds;
  const int tid = threadIdx.x;
  constexpr int CPT = NC / 8, TPR = 512 / NC, PPT = 64 / TPR;
  for (int it = blockIdx.x; it < 257 + 8 * 65; it += gridDim.x) {
    int seq, kt;
    if (it < 257) { seq = 8; kt = it; } else { const int j = it - 257; seq = j / 65; kt = j - seq * 65; }
    const int L = seq_len(seq), LP = L + 48, sbase = seq_base(seq);
    const size_t vb = (seq < 8 ? (size_t)seq * NC * 4160 : (size_t)8 * NC * 4160);
    __syncthreads();
    const int pl = tid >> 3, part = tid & 7;
    const int pos = 64 * kt + pl - 48;
#pragma unroll
    for (int q = 0; q < CPT / 8; ++q) {
      u32x4 v = (u32x4)(0u);
      if (pos >= 0) v = *(const u32x4*)(src + (size_t)(sbase + pos) * ld + col0 + part * CPT + q * 8);
#pragma unroll
      for (int j = 0; j < 4; ++j) {
        tl[(part * CPT + q * 8 + 2 * j) * 72 + pl] = (bf16_t)(v[j] & 0xffffu);
        tl[(part * CPT + q * 8 + 2 * j + 1) * 72 + pl] = (bf16_t)(v[j] >> 16);
      }
    }
    __syncthreads();
    const int row = tid / TPR, seg = tid % TPR;
    bf16_t* dst = VT + vb + (size_t)row * LP + 64 * kt + seg * PPT;
#pragma unroll
    for (int q = 0; q < PPT / 8; ++q) *(u32x4*)(dst + q * 8) = *(const u32x4*)(tl + row * 72 + seg * PPT + q * 8);
  }
}

DI void phase_prepA(const P& p, char* lds) {
  const int lane = threadIdx.x & 63, wave = threadIdx.x >> 6;
  bf16_t* PROJ = (bf16_t*)(p.ws + O_PROJ0);
  bf16_t* ZB = (bf16_t*)(p.ws + O_ZB);
  const float* WC = (const float*)(p.ws + O_WC);
  vt_transpose<256>(PROJ, 1536, 1024, (bf16_t*)(p.ws + O_VTA), lds);
  __syncthreads();
  float* fl = (float*)lds + wave * 1024;
  float* csl = (float*)lds + 8 * 1024 + wave * 64;
  const float inv = exp2f(-(float)(lane & 15) * (13.287712379549449f / 16.f));
  const int qr = lane & 3;
  float gn[16];
#pragma unroll
  for (int j = 0; j < 16; ++j) gn[j] = (lane < 48 ? p.a_q_gain : p.a_k_gain)[16 * qr + j] * (lane < 48 ? 0.125f * LOG2E : 1.f);
  for (int r0 = blockIdx.x * 32; r0 < TP_; r0 += gridDim.x * 32) {
    const int srb = r0 + wave * 4;
#pragma unroll 1
    for (int rr = 0; rr < 4; ++rr) {
      const int sr = srb + rr;
      if (sr < T_) {
        int pos; seq_of(sr, pos);
        float rowf, colf;
        if (pos < 16) { rowf = colf = (float)(pos - 16); }
        else { int t = pos - 16; rowf = (float)(t >> 6); colf = (float)(t & 63); }
        {
          float sn1, cs1;
          sincosf(((lane & 16) ? colf : rowf) * inv, &sn1, &cs1);
          if (lane < 32) { csl[lane] = cs1; csl[32 + lane] = sn1; }
        }
        bf16_t* pr = PROJ + (size_t)sr * 1536;
        {
        const u32x4 u0 = *(const u32x4*)(pr + 16 * lane), u1 = *(const u32x4*)(pr + 16 * lane + 8);
        float x[16];
        float ss = 0.f;
#pragma unroll
        for (int j = 0; j < 4; ++j) {
          x[2 * j] = lo2f(u0[j]); x[2 * j + 1] = hi2f(u0[j]); x[8 + 2 * j] = lo2f(u1[j]); x[8 + 2 * j + 1] = hi2f(u1[j]);
        }
#pragma unroll
        for (int j = 0; j < 16; ++j) ss += x[j] * x[j];
        ss += __shfl_xor(ss, 1); ss += __shfl_xor(ss, 2);
        const float rs = rsqrtf(ss * (1.f / 64.f) + EPS);
        const float* cp = csl + 16 * (qr >> 1);
        float o[16];
#pragma unroll
        for (int j4 = 0; j4 < 4; ++j4) {
          const f32x4v c4 = *(const f32x4v*)(cp + 4 * j4), s4 = *(const f32x4v*)(cp + 32 + 4 * j4);
#pragma unroll
          for (int e = 0; e < 4; ++e) {
            const int j = 4 * j4 + e;
            const float xn = x[j] * rs * gn[j];
            const float pa = __shfl_xor(xn, 1);
            o[j] = xn * c4[e] + pa * ((qr & 1) ? s4[e] : -s4[e]);
          }
        }
        *(u32x4*)(pr + 16 * lane) = (u32x4){pack2(o[0], o[1]), pack2(o[2], o[3]), pack2(o[4], o[5]), pack2(o[6], o[7])};
        *(u32x4*)(pr + 16 * lane + 8) = (u32x4){pack2(o[8], o[9]), pack2(o[10], o[11]), pack2(o[12], o[13]), pack2(o[14], o[15])};
        }
        uint2 u = *(const uint2*)(pr + 1280 + lane * 4);
        float f0 = lo2f(u.x), f1 = hi2f(u.x), f2 = lo2f(u.y), f3 = hi2f(u.y);
        float ss = f0 * f0 + f1 * f1 + f2 * f2 + f3 * f3;
        ss += __shfl_xor(ss, 1); ss += __shfl_xor(ss, 2); ss += __shfl_xor(ss, 4); ss += __shfl_xor(ss, 8);
        float rs = rsqrtf(ss * (1.f / 64.f) + EPS);
        float4 g = *(const float4*)(p.b_norm_g + lane * 4);
        *(float4*)(fl + rr * 256 + lane * 4) = make_float4(f0 * rs * g.x, f1 * rs * g.y, f2 * rs * g.z, f3 * rs * g.w);
      } else {
        *(float4*)(fl + rr * 256 + lane * 4) = make_float4(0.f, 0.f, 0.f, 0.f);
      }
    }
    __syncthreads();
    {
      const int g = lane >> 4, o0 = (lane & 15) * 8;
      float acc[4][8];
#pragma unroll
      for (int rr = 0; rr < 4; ++rr)
#pragma unroll
        for (int j = 0; j < 8; ++j) acc[rr][j] = 0.f;
      const float* wc = WC + (size_t)g * 64 * 128 + o0;
#pragma unroll 4
      for (int c = 0; c < 64; ++c) {
        const float4 w0 = *(const float4*)(wc + c * 128), w1 = *(const float4*)(wc + c * 128 + 4);
#pragma unroll
        for (int rr = 0; rr < 4; ++rr) {
          const float f = fl[rr * 256 + g * 64 + c];
          acc[rr][0] += f * w0.x; acc[rr][1] += f * w0.y; acc[rr][2] += f * w0.z; acc[rr][3] += f * w0.w;
          acc[rr][4] += f * w1.x; acc[rr][5] += f * w1.y; acc[rr][6] += f * w1.z; acc[rr][7] += f * w1.w;
        }
      }
#pragma unroll
      for (int rr = 0; rr < 4; ++rr)
        if (srb + rr < T_)
          *(uint4*)(ZB + (size_t)(srb + rr) * 512 + g * 128 + o0) = make_uint4(pack2(acc[rr][0], acc[rr][1]), pack2(acc[rr][2], acc[rr][3]), pack2(acc[rr][4], acc[rr][5]), pack2(acc[rr][6], acc[rr][7]));
    }
    __syncthreads();
  }
}

template <int MODE>
DI void flash_item(const bf16_t* __restrict__ Q, int ldq, const bf16_t* __restrict__ Kb, int ldk, const bf16_t* __restrict__ Vt, int LP,
                   bf16_t* O, int ldo, int sbase, int S, int qt, float sinkl2, char* lds, int obase = OBASE_SEQ) {
  const int tid = threadIdx.x & 255, lane = tid & 63, wave = tid >> 6, l31 = lane & 31, h = lane >> 5;
  bf16_t* Ks = (bf16_t*)lds;
  bf16_t* Vs = Ks + 2 * 64 * 72;
  const int rl = wave * 32 + l31;
  const int qpos = qt == 0 ? (rl < 16 ? rl : 15) : 16 + 128 * (qt - 1) + rl;
  const bool qvalid = qt > 0 || rl < 16;
  bf16x8 qf[4];
  {
    const bf16_t* qr = Q + (size_t)(sbase + qpos) * ldq;
#pragma unroll
    for (int s = 0; s < 4; ++s) qf[s] = *(const bf16x8*)(qr + 16 * s + 8 * h);
  }
  const int nkt_all = (S + 64) / 64;
  int klo = 1, n;
  if (MODE == 0) { n = nkt_all; }
  else {
    if (qt == 0) { klo = 1; n = 3; }
    else {
      int c = qt - 1;
      klo = 2 * c - 1; if (klo < 1) klo = 1;
      int khi = 2 * c + 4; if (khi > nkt_all - 1) khi = nkt_all - 1;
      n = 1 + (khi - klo + 1);
    }
  }
  const int ldr = tid >> 2, ldp = (tid & 3) * 16;
  u32x4 rk0, rk1, rv0, rv1;
  auto ktile = [&](int idx) { return idx == 0 ? 0 : klo + idx - 1; };
#define FL_GLOAD(idx)                                                                               \
  {                                                                                                 \
    int kt_ = ktile(idx);                                                                           \
    int pos_ = 64 * kt_ + ldr - 48;                                                                 \
    if (pos_ >= 0) {                                                                                \
      const bf16_t* kp_ = Kb + (size_t)(sbase + pos_) * ldk + ldp;                                  \
      rk0 = *(const u32x4*)kp_; rk1 = *(const u32x4*)(kp_ + 8);                                 \
    } else { rk0 = (u32x4)(0u); rk1 = rk0; }                                       \
    const bf16_t* vp_ = Vt + (size_t)ldr * LP + 64 * kt_ + ldp;                                     \
    rv0 = *(const u32x4*)vp_; rv1 = *(const u32x4*)(vp_ + 8);                                   \
  }
#define FL_SSTORE(buf)                                                                              \
  {                                                                                                 \
    *(u32x4*)(Ks + (buf) * 64 * 72 + ldr * 72 + ldp) = rk0; *(u32x4*)(Ks + (buf) * 64 * 72 + ldr * 72 + ldp + 8) = rk1; \
    { bf16_t* vd_ = Vs + (buf) * 64 * 68 + ldr * 68 + ldp; *(uint2*)vd_ = make_uint2(rv0.x, rv0.y); *(uint2*)(vd_ + 4) = make_uint2(rv0.z, rv0.w); *(uint2*)(vd_ + 8) = make_uint2(rv1.x, rv1.y); *(uint2*)(vd_ + 12) = make_uint2(rv1.z, rv1.w); } \
  }
  f32x16 oacc[2];
#pragma unroll
  for (int i = 0; i < 16; ++i) { oacc[0][i] = 0.f; oacc[1][i] = 0.f; }
  float m = MODE == 1 ? -1e30f : 0.f, l = 0.f;
  FL_GLOAD(0)
  FL_SSTORE(0)
  __syncthreads();
  for (int idx = 0; idx < n; ++idx) {
    const int cur = idx & 1;
    if (idx + 1 < n) FL_GLOAD(idx + 1)
    const int kt = ktile(idx);
    const bf16_t* ks = Ks + cur * 64 * 72;
    const bf16_t* vs = Vs + cur * 64 * 68;
    f32x16 sacc[2];
    {
      bf16x8 kf[2][4];
#pragma unroll
      for (int t = 0; t < 2; ++t)
#pragma unroll
        for (int s = 0; s < 4; ++s) kf[t][s] = *(const bf16x8*)(ks + (32 * t + l31) * 72 + 16 * s + 8 * h);
#pragma unroll
      for (int t = 0; t < 2; ++t)
#pragma unroll
        for (int i = 0; i < 16; ++i) sacc[t][i] = 0.f;
      __builtin_amdgcn_sched_barrier(0);
#pragma unroll
      for (int s = 0; s < 4; ++s)
#pragma unroll
        for (int t = 0; t < 2; ++t) sacc[t] = MFMA32(kf[t][s], qf[s], sacc[t]);
    }
    bf16x8 vfr[2][2][2];
#pragma unroll
    for (int t = 0; t < 2; ++t)
#pragma unroll
      for (int s2 = 0; s2 < 2; ++s2)
#pragma unroll
        for (int dt = 0; dt < 2; ++dt) {
          const bf16_t* vp = vs + (32 * dt + l31) * 68 + 32 * t + 16 * s2 + 4 * h;
          uint2 lo = *(const uint2*)vp, hi = *(const uint2*)(vp + 8);
          u32x4 v4 = {lo.x, lo.y, hi.x, hi.y};
          vfr[t][s2][dt] = __builtin_bit_cast(bf16x8, v4);
        }
    __builtin_amdgcn_sched_barrier(0);
    if (kt == 0) {
#pragma unroll
      for (int t = 0; t < 2; ++t)
#pragma unroll
        for (int i = 0; i < 16; ++i) {
          int kl = 32 * t + (i & 3) + 8 * (i >> 2) + 4 * h;
          if (kl < 48) sacc[t][i] = -1e30f;
        }
    } else if (MODE == 1) {
#pragma unroll
      for (int t = 0; t < 2; ++t)
#pragma unroll
        for (int i = 0; i < 16; ++i) {
          int kl = 32 * t + (i & 3) + 8 * (i >> 2) + 4 * h;
          int tk = 64 * (kt - 1) + kl;
          bool vis;
          if (qt == 0) vis = tk <= 112 + qpos;
          else { int tq = qpos - 16; int d = tq - tk; vis = d <= 128 && d >= -128; }
          if (!vis) sacc[t][i] = -1e30f;
        }
    }
    float tmax = -1e30f;
    if (MODE == 1) {
#pragma unroll
      for (int t = 0; t < 2; ++t)
#pragma unroll
        for (int i = 0; i < 16; ++i) tmax = fmaxf(tmax, sacc[t][i]);
      tmax = fmaxf(tmax, __shfl_xor(tmax, 32));
    }
    if (MODE == 1 && __builtin_amdgcn_ballot_w64(tmax > m) != 0ull) {
      const float mn = fmaxf(m, tmax);
      const float alpha = __builtin_amdgcn_exp2f(m - mn);
      m = mn;
      l *= alpha;
#pragma unroll
      for (int i = 0; i < 16; ++i) { oacc[0][i] *= alpha; oacc[1][i] *= alpha; }
    }
    const f32x2 m2 = {m, m};
    f32x2 ls2 = {0.f, 0.f};
    unsigned pk[2][8];
#pragma unroll
    for (int t = 0; t < 2; ++t)
#pragma unroll
      for (int i2 = 0; i2 < 8; ++i2) {
        f32x2 d = {sacc[t][2 * i2], sacc[t][2 * i2 + 1]};
        if (MODE == 1) d = d - m2;
        f32x2 e = {__builtin_amdgcn_exp2f(d.x), __builtin_amdgcn_exp2f(d.y)};
        ls2 += e;
        pk[t][i2] = __builtin_bit_cast(unsigned, __builtin_convertvector(e, bf16x2_t));
      }
    l += ls2.x + ls2.y;
#pragma unroll
    for (int t = 0; t < 2; ++t)
#pragma unroll
      for (int s2 = 0; s2 < 2; ++s2) {
        u32x4 pk4 = {pk[t][4 * s2], pk[t][4 * s2 + 1], pk[t][4 * s2 + 2], pk[t][4 * s2 + 3]};
        bf16x8 pf = __builtin_bit_cast(bf16x8, pk4);
#pragma unroll
        for (int dt = 0; dt < 2; ++dt) oacc[dt] = MFMA32(vfr[t][s2][dt], pf, oacc[dt]);
      }
    if (idx + 1 < n) FL_SSTORE(cur ^ 1)
    __syncthreads();
  }
  l += __shfl_xor(l, 32);
  if (MODE == 1) l += __builtin_amdgcn_exp2f(sinkl2 - m);
  const float il = 1.f / l;
  if (qvalid) {
    bf16_t* orow = O + (size_t)((obase == OBASE_SEQ ? sbase : obase) + qpos) * ldo;
#pragma unroll
    for (int dt = 0; dt < 2; ++dt)
#pragma unroll
      for (int g = 0; g < 4; ++g) {
        int d = 32 * dt + 8 * g + 4 * h;
        uint2 o = make_uint2(pack2(oacc[dt][4 * g] * il, oacc[dt][4 * g + 1] * il), pack2(oacc[dt][4 * g + 2] * il, oacc[dt][4 * g + 3] * il));
        *(uint2*)(orow + d) = o;
      }
  }
#undef FL_GLOAD
#undef FL_SSTORE
}

DI void dft4(float& r0, float& i0, float& r1, float& i1, float& r2, float& i2, float& r3, float& i3) {
  const float t0r = r0 + r2, t0i = i0 + i2, t1r = r0 - r2, t1i = i0 - i2;
  const float t2r = r1 + r3, t2i = i1 + i3, t3r = i1 - i3, t3i = r3 - r1;
  r0 = t0r + t2r; i0 = t0i + t2i; r1 = t1r + t3r; i1 = t1i + t3i; r2 = t0r - t2r; i2 = t0i - t2i; r3 = t1r - t3r; i3 = t1i - t3i;
}
DI void dft16(float (&zr)[16], float (&zi)[16]) {
#pragma unroll
  for (int b = 0; b < 4; ++b) dft4(zr[b], zi[b], zr[4 + b], zi[4 + b], zr[8 + b], zi[8 + b], zr[12 + b], zi[12 + b]);
  constexpr float C1 = 0.9238795325112867f, S1 = 0.3826834323650898f, C2 = 0.7071067811865476f;
  const float wr[10] = {1.f, C1, C2, S1, 0.f, 0.f, -C2, 0.f, 0.f, -C1};
  const float wi[10] = {0.f, -S1, -C2, -C1, -1.f, 0.f, -C2, 0.f, 0.f, S1};
#pragma unroll
  for (int q = 1; q < 4; ++q)
#pragma unroll
    for (int b = 1; b < 4; ++b) {
      const float c = wr[b * q], d = wi[b * q];
      const float xr = zr[4 * q + b], xi = zi[4 * q + b];
      zr[4 * q + b] = xr * c - xi * d; zi[4 * q + b] = xr * d + xi * c;
    }
#pragma unroll
  for (int q = 0; q < 4; ++q) dft4(zr[4 * q], zi[4 * q], zr[4 * q + 1], zi[4 * q + 1], zr[4 * q + 2], zi[4 * q + 2], zr[4 * q + 3], zi[4 * q + 3]);
}

DI size_t y_base(int seq) { return seq < 8 ? (size_t)seq * 16 * 256 * 576 : (size_t)8 * 16 * 256 * 576; }
DI void phase_attnA(const P& p, char* lds) {
  const bf16_t* PROJ = (const bf16_t*)(p.ws + O_PROJ0);
  const bf16_t* VT = (const bf16_t*)(p.ws + O_VTA);
  bf16_t* MIX = (bf16_t*)(p.ws + O_MIX);
  const int nS = 129 * 6, nP = 8 * 33 * 6;
  const int sb = threadIdx.x >> 8;
  unsigned* head = (unsigned*)(p.ws + O_CNT);
  for (;;) {
    if (threadIdx.x == 0) *(volatile int*)(lds + 2 * 36864) = (int)__hip_atomic_fetch_add(head, 1u, __ATOMIC_RELAXED, __HIP_MEMORY_SCOPE_AGENT);
    __syncthreads();
    const int it = *(volatile int*)(lds + 2 * 36864);
    __syncthreads();
    if (it >= nS + nP) break;
    int seq, qt, hq;
    if (it < nS) { seq = 8; hq = (it % 6) * 2 + sb; qt = it / 6; }
    else { int j = it - nS; hq = (j % 6) * 2 + sb; j /= 6; qt = j % 33; seq = j / 33; }
    const int kv = hq / 3;
    const int L = seq_len(seq), LP = L + 48;
    flash_item<0>(PROJ + hq * 64, 1536, PROJ + 768 + kv * 64, 1536, VT + vta_base(seq) + (size_t)kv * 64 * LP, LP,
                  MIX + hq * 64, 1024, seq_base(seq), L - 16, qt, 0.f, lds + sb * 36864);
  }
  const bf16_t* ZB = (const bf16_t*)(p.ws + O_ZB);
  bf16_t* Y = (bf16_t*)(p.ws + O_Y);
  const int lane = threadIdx.x & 63, wave = threadIdx.x >> 6;
  const int nI_S = 17 * 16, nI_P = 8 * 5 * 16;
  for (;;) {
    if (threadIdx.x == 0) *(volatile int*)(lds + 2 * 36864) = (int)__hip_atomic_fetch_add(head + 64, 1u, __ATOMIC_RELAXED, __HIP_MEMORY_SCOPE_AGENT);
    __syncthreads();
    const int it = *(volatile int*)(lds + 2 * 36864);
    __syncthreads();
    if (it >= nI_S + nI_P) break;
    int seq, nb, cb;
    if (it < nI_S) { seq = 8; cb = it & 15; nb = it >> 4; }
    else { int j = it - nI_S; cb = j & 15; j >>= 4; nb = j % 5; seq = j / 5; }
    const int M = seq < 8 ? 257 : 1025, KP = seq < 8 ? 576 : 2112, L = 16 * M;
    const int n2 = nb * 64 + lane;
    const int ch = cb * 16 + wave * 2;
    const int g = ch >> 6, d = ch & 63;
    bf16_t* yb = Y + y_base(seq);
    if (n2 < M) {
      float ar[16], ai[16], br[16], bi[16];
#pragma unroll
      for (int n1 = 0; n1 < 16; ++n1) {
        const bf16_t* zp = ZB + (size_t)(seq_base(seq) + M * n1 + n2) * 512 + g * 128 + d;
        unsigned re = *(const unsigned*)zp, im = *(const unsigned*)(zp + 64);
        ar[n1] = lo2f(re); br[n1] = hi2f(re); ai[n1] = lo2f(im); bi[n1] = hi2f(im);
      }
      dft16(ar, ai);
      dft16(br, bi);
      float t1s, t1c;
      sincospif(-2.f * (float)n2 / (float)L, &t1s, &t1c);
      float tc = 1.f, ts = 0.f;
#pragma unroll
      for (int k1 = 0; k1 < 16; ++k1) {
        const int ix = 4 * (k1 & 3) + (k1 >> 2);
        const float yr0 = ar[ix] * tc - ai[ix] * ts, yi0 = ar[ix] * ts + ai[ix] * tc;
        const float yr1 = br[ix] * tc - bi[ix] * ts, yi1 = br[ix] * ts + bi[ix] * tc;
        bf16_t* y0 = yb + ((size_t)k1 * 256 + ch) * KP;
        y0[n2] = f2bf(yr0); y0[M + n2] = f2bf(yi0);
        y0[KP + n2] = f2bf(yr1); y0[KP + M + n2] = f2bf(yi1);
        const float nc = tc * t1c - ts * t1s; ts = tc * t1s + ts * t1c; tc = nc;
      }
    } else if (n2 < KP - M) {
      for (int k1 = 0; k1 < 16; ++k1) {
        bf16_t* y0 = yb + ((size_t)k1 * 256 + ch) * KP;
        y0[M + n2] = 0; y0[KP + M + n2] = 0;
      }
    }
  }
}

DI void phase_fnet_gemm(const P& p, char* lds) {
  GEMM_IDS
  bf16_t* MIX = (bf16_t*)(p.ws + O_MIX);
  const bf16_t* Y = (const bf16_t*)(p.ws + O_Y);
  const int nS = 16 * 9 * 2, nP = 8 * 16 * 3 * 2;
  const int sb = threadIdx.x >> 8;
  for (int it0 = blockIdx.x * 2; it0 < nS + nP; it0 += gridDim.x * 2) {
    const int it = it0 + sb;
    int seq, k1, tm, tn;
    if (it < nS) { seq = 8; tn = it & 1; int j = it >> 1; tm = j % 9; k1 = j / 9; }
    else { int j = it - nS; tn = j & 1; j >>= 1; tm = j % 3; j /= 3; k1 = j & 15; seq = j >> 4; }
    const int M = seq < 8 ? 257 : 1025, KP = seq < 8 ? 576 : 2112, L = 16 * M;
    const bf16_t* dm = (const bf16_t*)(p.ws + (seq < 8 ? O_DM257 : O_DM1025));
    f32x16 acc[2][2];
    gemm_tile(dm + (size_t)tm * 128 * KP, KP, Y + y_base(seq) + ((size_t)k1 * 256 + tn * 128) * KP, KP, KP, lds + sb * 36864, acc);
    const float scale = rsqrtf(64.f * (float)L);
#pragma unroll
    for (int mt = 0; mt < 2; ++mt)
#pragma unroll
      for (int nt = 0; nt < 2; ++nt)
#pragma unroll
        for (int i = 0; i < 16; ++i) {
          int k2 = tm * 128 + ACC_ROW(mt, i), ch = tn * 128 + ACC_COL(nt);
          if (k2 < M) {
            int pos = k1 + 16 * k2;
            MIX[(size_t)(seq_base(seq) + pos) * 1024 + 768 + ch] = f2bf(acc[mt][nt][i] * scale + p.b_b[ch]);
          }
        }
  }
}

DI size_t vtc_base(int seq) { return seq < 8 ? (size_t)seq * 128 * 4160 : (size_t)8 * 128 * 4160; }
DI void phase_prepC(const P& p, char* lds) {
  const int gtid = blockIdx.x * NTH + threadIdx.x, gsz = gridDim.x * NTH;
  const int lane = threadIdx.x & 63, gw = gtid >> 6, nw = gsz >> 6;
  bf16_t* PC = (bf16_t*)(p.ws + O_PC);
  bf16_t* VT = (bf16_t*)(p.ws + O_VTC);
  const bf16_t* PLOW = (const bf16_t*)(p.ws + O_PLOW);
  bf16_t* LR = (bf16_t*)(p.ws + O_LR);
  vt_transpose<128>(PC, 768, 640, VT, lds);
  for (int sr = gw; sr < T_; sr += nw) {
    int pos; int b = seq_of(sr, pos);
    const int L = seq_len(b), LP = L + 48;
    bf16_t* pr = PC + (size_t)sr * 768;
    float cs[8], sn[8];
    {
      float s1, c1;
      sincosf((float)pos * exp2f(-(float)(lane & 7) * (18.931568569324174f / 8.f)), &s1, &c1);
#pragma unroll
      for (int j = 0; j < 8; ++j) { sn[j] = __shfl(s1, j); cs[j] = __shfl(c1, j); }
    }
#pragma unroll
    for (int part = 0; part < 2; ++part) {
      const bool act = part == 0 || lane < 16;
      const int col = part * 512 + (act ? lane : 0) * 8;
      uint4 u = *(const uint4*)(pr + col);
      float e[8] = {lo2f(u.x), hi2f(u.x), lo2f(u.y), hi2f(u.y), lo2f(u.z), hi2f(u.z), lo2f(u.w), hi2f(u.w)};
      float o[8];
#pragma unroll
      for (int j = 0; j < 8; ++j) {
        float pa = __shfl_xor(e[j], 1);
        float rot = e[j] * cs[j] + pa * ((lane & 1) ? sn[j] : -sn[j]);
        o[j] = (lane & 7) < 2 ? rot : e[j];
        if (part == 0) o[j] *= 0.125f * LOG2E;
      }
      if (act) *(uint4*)(pr + col) = make_uint4(pack2(o[0], o[1]), pack2(o[2], o[3]), pack2(o[4], o[5]), pack2(o[6], o[7]));
    }
#pragma unroll
    for (int q = 0; q < 6; ++q) {
      int c = q * 64 + lane;
      float u = bf2f(PLOW[(size_t)sr * 384 + c]);
      float up = pos > 0 ? bf2f(PLOW[(size_t)(sr - 1) * 384 + c]) : 0.f;
      float un = pos < L - 1 ? bf2f(PLOW[(size_t)(sr + 1) * 384 + c]) : 0.f;
      float us = u + p.mu_prev[1536 + c] * (up - u) + p.mu_next[1536 + c] * (un - u);
      float v = c < 128 ? tanhf(us) : (c < 256 ? us : sigmoidf_(us));
      LR[(size_t)sr * 384 + c] = f2bf(v);
    }
  }
}

DI void phase_attnC(const P& p, char* lds) {
  const bf16_t* PC = (const bf16_t*)(p.ws + O_PC);
  const bf16_t* VT = (const bf16_t*)(p.ws + O_VTC);
  bf16_t* MIX = (bf16_t*)(p.ws + O_MIX);
  const int nS = 129 * 4, nP = 8 * 33 * 4;
  const int sb = threadIdx.x >> 8;
  for (int it = blockIdx.x; it < nS + nP; it += gridDim.x) {
    int seq, qt, hq;
    if (it < nS) { seq = 8; hq = (it & 3) * 2 + sb; qt = it >> 2; }
    else { int j = it - nS; hq = (j & 3) * 2 + sb; j >>= 2; qt = j % 33; seq = j / 33; }
    const int kv = hq >> 2;
    const int L = seq_len(seq), LP = L + 48;
    flash_item<1>(PC + hq * 64, 768, PC + 512 + kv * 64, 768, VT + vtc_base(seq) + (size_t)kv * 64 * LP, LP,
                  MIX + hq * 64, 1024, seq_base(seq), L - 16, qt, p.c_sink[hq] * LOG2E, lds + sb * 36864, qt == 0 ? 49152 + seq * 16 : (seq < 8 ? seq * 4096 : 32768) - 16);
  }
}

DI void chunk_decode(int cg_, int& seq, int& c) {
  if (cg_ < 136) { seq = cg_ / 17; c = cg_ - seq * 17; } else { seq = 8; c = cg_ - 136; }
}
DI float shiftv(const bf16_t* PRKV, int sr, int pos, int L, int col, float mp, float mn) {
  float u = bf2f(PRKV[(size_t)sr * 1536 + col]);
  float up = pos > 0 ? bf2f(PRKV[(size_t)(sr - 1) * 1536 + col]) : 0.f;
  float un = pos < L - 1 ? bf2f(PRKV[(size_t)(sr + 1) * 1536 + col]) : 0.f;
  return u + mp * (up - u) + mn * (un - u);
}
enum { VW = 0, VA = 1, VB = 2, VK = 3, VV = 4, VR = 5 };
#define DPP_FMAC(acc, x, y, N) asm("v_fmac_f32_dpp %0, %1, %2 row_newbcast:%3 row_mask:0xf bank_mask:0xf" : "+v"(acc) : "v"(x), "v"(y), "n"(N))
#define DPP_MUL(sv_, x, N) asm("v_mul_f32_dpp %0, %1, %0 row_newbcast:%2 row_mask:0xf bank_mask:0xf" : "+v"(sv_) : "v"(x), "n"(N))
template <int N> DI void dpp_dot4(float& a0, float& a1, float& a2, float& a3, const float (&S)[64], const float4& x) {
  DPP_FMAC(a0, x.x, S[N], N); DPP_FMAC(a1, x.y, S[16 + N], N); DPP_FMAC(a2, x.z, S[32 + N], N); DPP_FMAC(a3, x.w, S[48 + N], N);
  if constexpr (N < 15) dpp_dot4<N + 1>(a0, a1, a2, a3, S, x);
}
template <int N, bool HASV, bool OUT> DI void dpp_upd4(float (&S)[64], const float4& xb, const float4& xk, const float4& xr, float sa, float vi,
                                                       float& o0, float& o1, float& o2, float& o3) {
  DPP_FMAC(S[N], xb.x, sa, N); DPP_FMAC(S[16 + N], xb.y, sa, N); DPP_FMAC(S[32 + N], xb.z, sa, N); DPP_FMAC(S[48 + N], xb.w, sa, N);
  if (HASV) { DPP_FMAC(S[N], xk.x, vi, N); DPP_FMAC(S[16 + N], xk.y, vi, N); DPP_FMAC(S[32 + N], xk.z, vi, N); DPP_FMAC(S[48 + N], xk.w, vi, N); }
  if (OUT) { DPP_FMAC(o0, xr.x, S[N], N); DPP_FMAC(o1, xr.y, S[16 + N], N); DPP_FMAC(o2, xr.z, S[32 + N], N); DPP_FMAC(o3, xr.w, S[48 + N], N); }
  if constexpr (N < 15) dpp_upd4<N + 1, HASV, OUT>(S, xb, xk, xr, sa, vi, o0, o1, o2, o3);
}
template <int N> DI void dpp_scale4(float (&S)[64], const float4& xg) {
  DPP_MUL(S[N], xg.x, N); DPP_MUL(S[16 + N], xg.y, N); DPP_MUL(S[32 + N], xg.z, N); DPP_MUL(S[48 + N], xg.w, N);
  if constexpr (N < 15) dpp_scale4<N + 1>(S, xg);
}
template <int NST, bool HASV, bool OUT, class F>
DI void scan_steps(float (&S)[64], const float* sv, int ns, int lane, F&& emit) {
  const int l15 = lane & 15;
  (void)ns;
#pragma unroll 4
  for (int s = 0; s < NST; ++s) {
    const float4 xa = *(const float4*)(sv + VA * NST * 64 + s * 64 + l15 * 4);
    const float4 xb = *(const float4*)(sv + VB * NST * 64 + s * 64 + l15 * 4);
    float4 xk = xb, xr = xb;
    if (HASV) xk = *(const float4*)(sv + VK * NST * 64 + s * 64 + l15 * 4);
    if (OUT) xr = *(const float4*)(sv + VR * NST * 64 + s * 64 + l15 * 4);
    const float vi = HASV ? sv[VV * NST * 64 + s * 64 + lane] : 0.f;
    float sa0 = 0.f, sa1 = 0.f, sa2 = 0.f, sa3 = 0.f;
    dpp_dot4<0>(sa0, sa1, sa2, sa3, S, xa);
    const float sa = (sa0 + sa1) + (sa2 + sa3);
    float o0 = 0.f, o1 = 0.f, o2 = 0.f, o3 = 0.f;
    dpp_upd4<0, HASV, OUT>(S, xb, xk, xr, sa, vi, o0, o1, o2, o3);
    if (OUT) emit(s, (o0 + o1) + (o2 + o3));
    if ((s & 7) == 7) {
      const float4 xg = *(const float4*)(sv + VW * NST * 64 + (s >> 3) * 64 + l15 * 4);
      dpp_scale4<0>(S, xg);
    }
  }
}
DI int vperm(int j) { return (j & 15) * 4 + (j >> 4); }

DI void shift8(const bf16_t* PRKV, const P& p, int sbase, int pos, int L, int off, int c0, float (&out)[8]) {
  const bf16_t* rp = PRKV + (size_t)(sbase + pos) * 1536 + off + c0;
  const u32x4 uc = *(const u32x4*)rp;
  u32x4 up = (u32x4)(0u), un = (u32x4)(0u);
  if (pos > 0) up = *(const u32x4*)(rp - 1536);
  if (pos < L - 1) un = *(const u32x4*)(rp + 1536);
  const f32x4v mp0 = *(const f32x4v*)(p.mu_prev + off + c0), mp1 = *(const f32x4v*)(p.mu_prev + off + c0 + 4);
  const f32x4v mn0 = *(const f32x4v*)(p.mu_next + off + c0), mn1 = *(const f32x4v*)(p.mu_next + off + c0 + 4);
#pragma unroll
  for (int e2 = 0; e2 < 4; ++e2) {
    const float c_lo = lo2f(uc[e2]), c_hi = hi2f(uc[e2]);
    const float mpl = e2 < 2 ? mp0[2 * e2] : mp1[2 * e2 - 4], mph = e2 < 2 ? mp0[2 * e2 + 1] : mp1[2 * e2 - 3];
    const float mnl = e2 < 2 ? mn0[2 * e2] : mn1[2 * e2 - 4], mnh = e2 < 2 ? mn0[2 * e2 + 1] : mn1[2 * e2 - 3];
    out[2 * e2] = c_lo + mpl * (lo2f(up[e2]) - c_lo) + mnl * (lo2f(un[e2]) - c_lo);
    out[2 * e2 + 1] = c_hi + mph * (hi2f(up[e2]) - c_hi) + mnh * (hi2f(un[e2]) - c_hi);
  }
}

template <int NST, bool P3>
DI void scan_prologue8(const P& p, int sbase, int L, int hd, int dir, int pos0, int nsteps, int sb0, float* sv) {
  const int lane = threadIdx.x & 63, l31 = lane & 31, h = lane >> 5;
  const bf16_t* PRKV = (const bf16_t*)(p.ws + O_PRKV);
  const bf16_t* LR = (const bf16_t*)(p.ws + O_LR);
  const bf16_t* WUPT = (const bf16_t*)(p.ws + O_WUPT) + (size_t)(dir * 512 + hd * 64) * 64;
  const bf16_t* AUPT = (const bf16_t*)(p.ws + O_AUPT) + (size_t)(dir * 512 + hd * 64) * 64;
  float* bonus = (float*)(p.ws + O_BONUS);
  {
    int sl = sb0 + (l31 & 7); if (sl > nsteps - 1) sl = nsteps - 1;
    const int pos = dir ? pos0 - sl : pos0 + sl;
    const bf16_t* lrp = LR + (size_t)(sbase + pos) * 384 + dir * 64 + 8 * h;
#pragma unroll 1
    for (int mat = 0; mat < 2; ++mat) {
      const bf16_t* Wm = mat ? AUPT : WUPT;
      const float* bias = mat ? p.d_a0 : p.d_w0;
      f32x16 ac[2];
#pragma unroll
      for (int nt = 0; nt < 2; ++nt)
#pragma unroll
        for (int i = 0; i < 16; ++i) ac[nt][i] = 0.f;
#pragma unroll
      for (int ks = 0; ks < 4; ++ks) {
        const bf16x8 fa = *(const bf16x8*)(lrp + mat * 128 + 16 * ks);
#pragma unroll
        for (int nt = 0; nt < 2; ++nt) {
          const bf16x8 bw = *(const bf16x8*)(Wm + (size_t)(32 * nt + l31) * 64 + 16 * ks + 8 * h);
          ac[nt] = MFMA32(fa, bw, ac[nt]);
        }
      }
#pragma unroll
      for (int nt = 0; nt < 2; ++nt) {
        const int j = 32 * nt + l31;
        const float b0 = bias[dir * 512 + hd * 64 + j];
#pragma unroll
        for (int i = 0; i < 4; ++i) {
          const int st = sb0 + i + 4 * h;
          const float sg = 1.f / (1.f + __expf(-(b0 + ac[nt][i])));
          if (mat) sv[VK * NST * 64 + st * 64 + j] = sg;
          else ac[nt][i] = __expf(-0.6065306597126334f * sg);
        }
        if (!mat) {
          float g0 = ac[nt][0], g1 = g0 * ac[nt][1], g2 = g1 * ac[nt][2], g3 = g2 * ac[nt][3];
          const float tot_lo = __shfl(g3, l31);
          if (h) { g0 *= tot_lo; g1 *= tot_lo; g2 *= tot_lo; g3 *= tot_lo; }
          float* gd = sv + VA * NST * 64 + (sb0 + 4 * h) * 64 + j;
          gd[0] = g0; gd[64] = g1; gd[128] = g2; gd[192] = g3;
          if (h) sv[VW * NST * 64 + (sb0 >> 3) * 64 + vperm(j)] = g3;
        }
      }
    }
  }
  const int stp = lane >> 3, seg = lane & 7, c0 = hd * 64 + 8 * seg;
  const int s = sb0 + stp;
  const int ss = s < nsteps ? s : nsteps - 1;
  const int pos = dir ? pos0 - ss : pos0 + ss;
  float k[8], a[8], gam[8], gpr[8];
  shift8(PRKV, p, sbase, pos, L, 512, c0, k);
  {
    const f32x4v a0 = *(const f32x4v*)(sv + VK * NST * 64 + s * 64 + 8 * seg), a1 = *(const f32x4v*)(sv + VK * NST * 64 + s * 64 + 8 * seg + 4);
    const f32x4v g0 = *(const f32x4v*)(sv + VA * NST * 64 + s * 64 + 8 * seg), g1 = *(const f32x4v*)(sv + VA * NST * 64 + s * 64 + 8 * seg + 4);
    const int sp = stp > 0 ? s - 1 : s;
    const f32x4v q0 = *(const f32x4v*)(sv + VA * NST * 64 + sp * 64 + 8 * seg), q1 = *(const f32x4v*)(sv + VA * NST * 64 + sp * 64 + 8 * seg + 4);
#pragma unroll
    for (int e = 0; e < 4; ++e) {
      a[e] = a0[e]; a[4 + e] = a1[e]; gam[e] = g0[e]; gam[4 + e] = g1[e];
      gpr[e] = stp > 0 ? q0[e] : 1.f; gpr[4 + e] = stp > 0 ? q1[e] : 1.f;
    }
  }
  const f32x4v kk0 = *(const f32x4v*)(p.d_k_k + c0), kk1 = *(const f32x4v*)(p.d_k_k + c0 + 4);
  const f32x4v ka0 = *(const f32x4v*)(p.d_k_a + c0), ka1 = *(const f32x4v*)(p.d_k_a + c0 + 4);
  float kk[8], kd[8];
  float n2 = 0.f;
#pragma unroll
  for (int e = 0; e < 8; ++e) {
    kk[e] = k[e] * (e < 4 ? kk0[e] : kk1[e - 4]);
    n2 += kk[e] * kk[e];
    kd[e] = k[e] * (1.f + (a[e] - 1.f) * (e < 4 ? ka0[e] : ka1[e - 4]));
  }
  n2 += __shfl_xor(n2, 1); n2 += __shfl_xor(n2, 2); n2 += __shfl_xor(n2, 4);
  const float rn = rsqrtf(fmaxf(n2, 1e-24f));
#pragma unroll
  for (int e = 0; e < 8; ++e) {
    const int ix = s * 64 + vperm(8 * seg + e);
    const float kn = kk[e] * rn;
    const float ig = __builtin_amdgcn_rcpf(gam[e]);
    sv[VA * NST * 64 + ix] = -kn * gpr[e];
    sv[VB * NST * 64 + ix] = kn * a[e] * ig;
    sv[VK * NST * 64 + ix] = kd[e] * ig;
  }
  {
    float v[8];
    shift8(PRKV, p, sbase, pos, L, 1024, c0, v);
    *(f32x4v*)(sv + VV * NST * 64 + s * 64 + 8 * seg) = (f32x4v){v[0], v[1], v[2], v[3]};
    *(f32x4v*)(sv + VV * NST * 64 + s * 64 + 8 * seg + 4) = (f32x4v){v[4], v[5], v[6], v[7]};
  }
  if (P3) {
    float r[8];
    shift8(PRKV, p, sbase, pos, L, 0, c0, r);
    const f32x4v rk0 = *(const f32x4v*)(p.d_r_k + c0), rk1 = *(const f32x4v*)(p.d_r_k + c0 + 4);
    float bn = 0.f;
#pragma unroll
    for (int e = 0; e < 8; ++e) {
      sv[VR * NST * 64 + s * 64 + vperm(8 * seg + e)] = r[e] * gam[e];
      bn += r[e] * kd[e] * (e < 4 ? rk0[e] : rk1[e - 4]);
    }
    bn += __shfl_xor(bn, 1); bn += __shfl_xor(bn, 2); bn += __shfl_xor(bn, 4);
    if (s < nsteps && seg == 0) bonus[((size_t)(sbase + pos) * 8 + hd) * 2 + dir] = bn;
  }
}

DI unsigned scan_touch(const P& p, int sbase, int L, int hd, int dir, int posf  ) {
  const int lane = threadIdx.x & 63;
  const bf16_t* PRKV = (const bf16_t*)(p.ws + O_PRKV);
  const bf16_t* LR = (const bf16_t*)(p.ws + O_LR);
  const int lo = dir ? posf - 8 : posf - 1;
  const unsigned* ptr;
  if (lane < 30) { int row = lo + lane / 3; row = row < 0 ? 0 : (row > L - 1 ? L - 1 : row); ptr = (const unsigned*)(PRKV + (size_t)(sbase + row) * 1536 + (lane % 3) * 512 + hd * 64); }
  else { const int i2 = (lane - 30) & 15; int row = dir ? posf - (i2 >> 1) : posf + (i2 >> 1); row = row < 0 ? 0 : (row > L - 1 ? L - 1 : row); ptr = (const unsigned*)(LR + (size_t)(sbase + row) * 384 + (i2 & 1) * 128 + dir * 64); }
  return *ptr;
}

template <bool HALF> DI void scan1_body(const P& p, char* lds) {
  float* PQ = (float*)(p.ws + O_PQ);
  const int lane = threadIdx.x & 63, wave = __builtin_amdgcn_readfirstlane(threadIdx.x >> 6), slot = wave >> 1;
  constexpr int half = HALF ? 1 : 0;
  float* sv = (float*)lds + slot * (6 * 16 * 64);
  for (int g = blockIdx.x; g < 804; g += gridDim.x) {
    int seq, c, hp;
    if (g < 768) { const int lc = g >> 2; hp = g & 3; if (lc < 128) { seq = lc >> 4; c = lc & 15; } else { seq = 8; c = lc - 128; } }
    else { const int j = g - 768; hp = j & 3; seq = j >> 2; c = seq < 8 ? 16 : 64; }
    const int cgi = seq < 8 ? seq * 17 + c : 136 + c;
    const int hd = hp * 2 + (slot >> 1), dir = slot & 1;
    const int it = (cgi * 8 + hd) * 2 + dir;
    const int L = seq_len(seq), sbase = seq_base(seq);
    const int start = c * 256, end = min(L, start + 256), n = end - start;
    float S[64];
#pragma unroll
    for (int j = 0; j < 64; ++j) S[j] = (half == 0 && j == lane) ? 1.f : 0.f;
    for (int s0 = 0; s0 < n; s0 += 16) {
      const int ns = min(16, n - s0);
      const int pos0 = dir ? end - 1 - s0 : start + s0;
      __syncthreads();
      scan_prologue8<16, false>(p, sbase, L, hd, dir, pos0, ns, half * 8, sv);
      __syncthreads();
      unsigned tch = 0u;
      if (s0 + 16 < n) tch = scan_touch(p, sbase, L, hd, dir, dir ? pos0 - 16 - half * 8 : pos0 + 16 + half * 8);
      scan_steps<16, HALF, false>(S, sv, ns, lane, [](int, float) {});
      asm volatile("" :: "v"(tch));
    }
    float* dst = PQ + (size_t)it * 8192 + (size_t)(half * 64 + lane) * 64;
#pragma unroll
    for (int q = 0; q < 16; ++q) *(float4*)(dst + q * 4) = make_float4(S[q * 4], S[q * 4 + 1], S[q * 4 + 2], S[q * 4 + 3]);
  }
}

DI void phase_scan1(const P& p, char* lds) {
  const int w_ = __builtin_amdgcn_readfirstlane(threadIdx.x >> 6);
  if ((w_ ^ (w_ >> 2)) & 1) scan1_body<true>(p, lds); else scan1_body<false>(p, lds);
}

DI void phase_scan2(const P& p, char* lds) {
  float* Ss = (float*)lds;
  float* Ps = Ss + 64 * 65;
  float* PQ = (float*)(p.ws + O_PQ);
  const int tid = threadIdx.x, lane = tid & 63, wave = __builtin_amdgcn_readfirstlane(tid >> 6), l31 = lane & 31, h = lane >> 5;
  const int r0 = 32 * (wave >> 1), c0 = 32 * (wave & 1);
  for (int it = blockIdx.x; it < 144; it += gridDim.x) {
    const int dir = it & 1, hd = (it >> 1) & 7, seq = it >> 4;
    const int nch = seq < 8 ? 17 : 65, cg0 = seq < 8 ? seq * 17 : 136;
    f32x16 S;
#pragma unroll
    for (int i = 0; i < 16; ++i) S[i] = 0.f;
    f32x4v pn0, pn1;
    {
      const int c = dir ? nch - 1 : 0;
      const float* Pg = PQ + (size_t)(((cg0 + c) * 8 + hd) * 2 + dir) * 8192;
      pn0 = *(const f32x4v*)(Pg + tid * 4); pn1 = *(const f32x4v*)(Pg + (512 + tid) * 4);
    }
    for (int cc = 0; cc < nch; ++cc) {
      const int c = dir ? nch - 1 - cc : cc;
      float* Qg = PQ + (size_t)(((cg0 + c) * 8 + hd) * 2 + dir) * 8192 + 4096;
      __syncthreads();
      { const int m = tid >> 4, cq = (tid & 15) * 4; *(f32x4v*)(Ps + m * 68 + cq) = pn0; *(f32x4v*)(Ps + (m + 32) * 68 + cq) = pn1; }
      f32x16 acc;
      if (wave < 4) {
#pragma unroll
        for (int i = 0; i < 16; ++i) {
          const int row = r0 + (i & 3) + 8 * (i >> 2) + 4 * h;
          Ss[row * 65 + c0 + l31] = S[i];
          float* qp = Qg + row * 64 + c0 + l31;
          acc[i] = *qp;
          *qp = S[i];
        }
      }
      if (cc + 1 < nch) {
        const int c2 = dir ? nch - 2 - cc : cc + 1;
        const float* Pg2 = PQ + (size_t)(((cg0 + c2) * 8 + hd) * 2 + dir) * 8192;
        pn0 = *(const f32x4v*)(Pg2 + tid * 4); pn1 = *(const f32x4v*)(Pg2 + (512 + tid) * 4);
      }
      __syncthreads();
      if (wave < 4) {
#pragma unroll 8
        for (int kk = 0; kk < 32; ++kk) {
          const float av = Ss[(r0 + l31) * 65 + 2 * kk + h];
          const float bv = Ps[(2 * kk + h) * 68 + c0 + l31];
          acc = __builtin_amdgcn_mfma_f32_32x32x2f32(av, bv, acc, 0, 0, 0);
        }
        S = acc;
      }
    }
  }
}

DI void phase_scan3(const P& p, char* lds) {
  const float* PQ = (const float*)(p.ws + O_PQ);
  bf16_t* MIX = (bf16_t*)(p.ws + O_MIX);
  bf16_t* OB = (bf16_t*)(p.ws + O_OB);
  const int lane = threadIdx.x & 63, wave = __builtin_amdgcn_readfirstlane(threadIdx.x >> 6);
  float* sv = (float*)lds + wave * (6 * 8 * 64);
  const bool bal = gridDim.x == 256;
  const int NW = gridDim.x * 8, gw = blockIdx.x * 8 + wave;
  for (int k = 0; ; ++k) {
    int oi;
    if (bal) {
      if (k == 0) oi = gw;
      else if (k == 1) { if (wave >= 4) continue; oi = 2048 + blockIdx.x * 4 + wave; }
      else if (k == 2) { if (wave != 7 || blockIdx.x >= 144) break; oi = 3072 + blockIdx.x; }
      else break;
    } else { oi = gw + k * NW; if (oi >= 3216) break; }
    int seq, c, hd, dir;
    if (oi < 3072) { const int lc = oi >> 4; hd = (oi >> 1) & 7; dir = oi & 1; if (lc < 128) { seq = lc >> 4; c = lc & 15; } else { seq = 8; c = lc - 128; } }
    else { const int j = oi - 3072; hd = (j >> 1) & 7; dir = j & 1; seq = j >> 4; c = seq < 8 ? 16 : 64; }
    const int it = ((seq < 8 ? seq * 17 + c : 136 + c) * 8 + hd) * 2 + dir;
    const int L = seq_len(seq), sbase = seq_base(seq);
    const int start = c * 256, end = min(L, start + 256), n = end - start;
    float S[64];
    {
      const float* src = PQ + (size_t)it * 8192 + 4096 + lane * 64;
#pragma unroll
      for (int q = 0; q < 16; ++q) { float4 t = *(const float4*)(src + q * 4); S[q * 4] = t.x; S[q * 4 + 1] = t.y; S[q * 4 + 2] = t.z; S[q * 4 + 3] = t.w; }
    }
    for (int s0 = 0; s0 < n; s0 += 8) {
      const int ns = min(8, n - s0);
      const int pos0 = dir ? end - 1 - s0 : start + s0;
      scan_prologue8<8, true>(p, sbase, L, hd, dir, pos0, ns, 0, sv);
      unsigned tch = 0u;
      if (s0 + 8 < n) tch = scan_touch(p, sbase, L, hd, dir, dir ? pos0 - 8 : pos0 + 8);
      scan_steps<8, true, true>(S, sv, ns, lane, [&](int st, float o) {
        const int pos = dir ? pos0 - st : pos0 + st;
        const size_t sr = (size_t)(sbase + pos);
        if (dir == 0) MIX[(size_t)crow_of(seq, pos) * 1024 + 512 + hd * 64 + lane] = f2bf(o);
        else OB[sr * 512 + hd * 64 + lane] = f2bf(o);
      });
      asm volatile("" :: "v"(tch));
    }
  }
}

DI void phase_rwkv_final(const P& p) {
  const int lane = threadIdx.x & 63, gw = (blockIdx.x * NTH + threadIdx.x) >> 6, nw = (gridDim.x * NTH) >> 6;
  bf16_t* MIX = (bf16_t*)(p.ws + O_MIX);
  const bf16_t* OB = (const bf16_t*)(p.ws + O_OB);
  const bf16_t* G = (const bf16_t*)(p.ws + O_G);
  const bf16_t* PRKV = (const bf16_t*)(p.ws + O_PRKV);
  const float* bonus = (const float*)(p.ws + O_BONUS);
  const int hd = lane >> 3, c0 = lane * 8;
  float mp[8], mn[8], lg[8], lb[8];
#pragma unroll
  for (int j = 0; j < 8; ++j) { mp[j] = p.mu_prev[1024 + c0 + j]; mn[j] = p.mu_next[1024 + c0 + j]; lg[j] = p.d_ln_g[c0 + j]; lb[j] = p.d_ln_b[c0 + j]; }
  for (int sr = gw; sr < T_; sr += nw) {
    int pos; int b = seq_of(sr, pos);
    const int L = seq_len(b);
    const size_t cr = (size_t)crow_of(b, pos);
    const u32x4 uf = *(const u32x4*)(MIX + cr * 1024 + 512 + c0);
    const u32x4 ub = *(const u32x4*)(OB + (size_t)sr * 512 + c0);
    const u32x4 ug = *(const u32x4*)(G + (size_t)sr * 512 + c0);
    const bf16_t* vr = PRKV + (size_t)sr * 1536 + 1024 + c0;
    const u32x4 vc = *(const u32x4*)vr;
    const u32x4 vp = *(const u32x4*)(pos > 0 ? vr - 1536 : vr);
    const u32x4 vn = *(const u32x4*)(pos < L - 1 ? vr + 1536 : vr);
    const float2 bn = *(const float2*)(bonus + ((size_t)sr * 8 + hd) * 2);
    const bool hp = pos > 0, hn = pos < L - 1;
    float o[8], gg[8], vsh[8];
    float sm = 0.f;
#pragma unroll
    for (int j = 0; j < 4; ++j) {
      o[2 * j] = lo2f(uf[j]) + lo2f(ub[j]); o[2 * j + 1] = hi2f(uf[j]) + hi2f(ub[j]);
      gg[2 * j] = lo2f(ug[j]); gg[2 * j + 1] = hi2f(ug[j]);
      sm += o[2 * j] + o[2 * j + 1];
      const float c_lo = lo2f(vc[j]), c_hi = hi2f(vc[j]);
      const float p_lo = hp ? lo2f(vp[j]) : 0.f, p_hi = hp ? hi2f(vp[j]) : 0.f;
      const float n_lo = hn ? lo2f(vn[j]) : 0.f, n_hi = hn ? hi2f(vn[j]) : 0.f;
      vsh[2 * j] = c_lo + mp[2 * j] * (p_lo - c_lo) + mn[2 * j] * (n_lo - c_lo);
      vsh[2 * j + 1] = c_hi + mp[2 * j + 1] * (p_hi - c_hi) + mn[2 * j + 1] * (n_hi - c_hi);
    }
    sm += __shfl_xor(sm, 1); sm += __shfl_xor(sm, 2); sm += __shfl_xor(sm, 4);
    const float mean = sm * (1.f / 64.f);
    float vs = 0.f;
#pragma unroll
    for (int j = 0; j < 8; ++j) { float dlt = o[j] - mean; vs += dlt * dlt; }
    vs += __shfl_xor(vs, 1); vs += __shfl_xor(vs, 2); vs += __shfl_xor(vs, 4);
    const float rstd = rsqrtf(vs * (1.f / 64.f) + 64e-5f);
    const float bsum = bn.x + bn.y;
    float y[8];
#pragma unroll
    for (int j = 0; j < 8; ++j) y[j] = ((o[j] - mean) * rstd * lg[j] + lb[j] + bsum * vsh[j]) * gg[j];
    *(uint4*)(MIX + cr * 1024 + 512 + c0) = make_uint4(pack2(y[0], y[1]), pack2(y[2], y[3]), pack2(y[4], y[5]), pack2(y[6], y[7]));
  }
}

#define XB_TMO      128
#define XB_XCNT(j)  (256  + 64 * (j))
#define XB_XSUB(j)  (1280 + 64 * (j))
#define XB_XGEN(j)  (2304 + 64 * (j))
#define XB_TOP      3328
#define XB_TOPGEN   3392
#define XCD_BAR_WORDS 3456
#define XB_SPIN_CAP (1u << 23)
#define LAS __attribute__((address_space(3)))

__device__ __forceinline__ unsigned xb_ld(unsigned* p)              { return __hip_atomic_load(p, __ATOMIC_RELAXED, __HIP_MEMORY_SCOPE_AGENT); }
__device__ __forceinline__ unsigned xb_add(unsigned* p, unsigned v) { return __hip_atomic_fetch_add(p, v, __ATOMIC_RELAXED, __HIP_MEMORY_SCOPE_AGENT); }
__device__ __forceinline__ unsigned xb_xcc_id() { return (unsigned)__builtin_amdgcn_s_getreg((3 << 11) | 20) & 0xFu; }
#define XB_SPIN(cond, bar) do { unsigned _sp = 0; while (cond) { __builtin_amdgcn_s_sleep(1); \
    if ((++_sp & 255u) == 0u) { if (xb_ld(&(bar)[XB_TMO])) break; if (_sp > XB_SPIN_CAP) { atomicAdd(&(bar)[XB_TMO], 1u); break; } } } } while (0)

struct XcdBarrier {
    unsigned* bar; unsigned x;
    volatile LAS unsigned* st;
};

__device__ __forceinline__ XcdBarrier xcd_barrier_post(unsigned* bar, volatile LAS unsigned* st) {
    XcdBarrier b; b.bar = bar; b.x = xb_xcc_id(); b.st = st;
    if (threadIdx.x == 0) (void)xb_add(&bar[XB_XCNT(b.x)], 1u);
    return b;
}
__device__ __forceinline__ void xcd_barrier_complete(unsigned* bar, unsigned x, unsigned& nloc, unsigned& nx) {
    const unsigned G = gridDim.x * gridDim.y * gridDim.z;
    unsigned sum, cnt, mine, sp = 0u;
    for (;;) {
        sum = 0u; cnt = 0u; mine = 0u;
#pragma unroll
        for (unsigned j = 0; j < 16; ++j) { const unsigned c = xb_ld(&bar[XB_XCNT(j)]); sum += c; cnt += (c > 0u) ? 1u : 0u; mine = (j == x) ? c : mine; }
        if (sum == G) break;
        __builtin_amdgcn_s_sleep(1);
        if ((++sp & 255u) == 0u) { if (xb_ld(&bar[XB_TMO])) break; if (sp > XB_SPIN_CAP) { atomicAdd(&bar[XB_TMO], 1u); break; } }
    }
    nloc = mine > 0u ? mine : 1u; nx = cnt > 0u ? cnt : 1u;
}

__device__ __forceinline__ void xcd_barrier(const XcdBarrier& b) {
    asm volatile("s_waitcnt vmcnt(0)" ::: "memory");
    __syncthreads();
    if (threadIdx.x == 0) {
        unsigned* bar = b.bar;
        __builtin_amdgcn_s_waitcnt(0);
        unsigned nloc = b.st[0], nx = b.st[1];
        if (nloc == 0u) { xcd_barrier_complete(bar, b.x, nloc, nx); b.st[0] = nloc; b.st[1] = nx; }
        const unsigned old = xb_add(&bar[XB_XSUB(b.x)], 1u);
        const unsigned gen = old / nloc;
        if (old + 1u == (gen + 1u) * nloc) {
            __builtin_amdgcn_fence(__ATOMIC_RELEASE, "agent");
            asm volatile("s_waitcnt vmcnt(0)" ::: "memory");
            const unsigned og = xb_add(&bar[XB_TOP], 1u);
            const unsigned tg = og / nx;
            if (og + 1u == (tg + 1u) * nx) xb_add(&bar[XB_TOPGEN], 1u);
            else XB_SPIN(xb_ld(&bar[XB_TOPGEN]) == tg, bar);
            __builtin_amdgcn_fence(__ATOMIC_ACQUIRE, "agent");
            xb_add(&bar[XB_XGEN(b.x)], 1u);
            asm volatile("s_waitcnt vmcnt(0)" ::: "memory");
        } else {
            XB_SPIN(xb_ld(&bar[XB_XGEN(b.x)]) == gen, bar);
            __builtin_amdgcn_fence(__ATOMIC_ACQUIRE, "agent");
            asm volatile("s_waitcnt vmcnt(0)" ::: "memory");
        }
    }
    __syncthreads();
}

constexpr int NPHASE = 23;
__global__ void __launch_bounds__(NTH, 2) mega(P p) {
  extern __shared__ __attribute__((aligned(16))) unsigned char shm[];
  char* lds = (char*)shm;
  char* ws = p.ws;
  if (threadIdx.x == 0) *(uint4*)(shm + 131072) = make_uint4(0u, 0u, 0u, 0u);
  __syncthreads();
  const XcdBarrier xb = xcd_barrier_post((unsigned*)(ws + O_BAR), (volatile LAS unsigned*)(shm + 131072));
#ifndef DUP_MASK
#define DUP_MASK 0u
#endif
  if (p.ph0 > 1000) cg::this_grid().sync();
#define RUN(k, call) if (p.ph0 <= k && k < p.ph1) { call; if (k + 1 < p.ph1) xcd_barrier(xb); }
  RUN(0, phase_prep(p))
  RUN(1, phase_gemm_big((const bf16_t*)(ws + O_HN), (const bf16_t*)(ws + O_WIN0), 1536, 1024, (bf16_t*)(ws + O_PROJ0), 1536, 0, ws, shm))
  RUN(2, phase_prepA(p, lds))
  RUN(3, phase_attnA(p, lds))
  RUN(4, phase_fnet_gemm(p, lds))
  RUN(5, phase_gemm_big((const bf16_t*)(ws + O_MIX), (const bf16_t*)(ws + O_WOUT0), 1024, 1024, (bf16_t*)(ws + O_HN), 1024, 0, ws, shm))
  RUN(6, phase_resnorm(p, p.post_mix_g, p.pre_ffn_g, true))
  RUN(7, phase_gemm_gateup((const bf16_t*)(ws + O_HN), (const bf16_t*)(ws + O_WGU0), (bf16_t*)(ws + O_ACT), shm))
  RUN(8, phase_gemm_big((const bf16_t*)(ws + O_ACT), (const bf16_t*)(ws + O_WD0), 1024, DFF, (bf16_t*)(ws + O_HN), 1024, 0, ws, shm))
  RUN(9, phase_resnorm(p, p.post_ffn_g, p.pre_mix_g + 1024))
  RUN(10, phase_gemm_big((const bf16_t*)(ws + O_HN), (const bf16_t*)(ws + O_WIN1), 2816, 1024, nullptr, 0, 1, ws, shm))
  RUN(11, phase_prepC(p, lds))
  RUN(12, phase_attnC(p, lds))
  RUN(13, phase_scan1(p, lds))
  RUN(14, (phase_scan2(p, lds), late_weights(p)))
  RUN(15, phase_scan3(p, lds))
  RUN(16, phase_gemm_small((const bf16_t*)(ws + O_LR) + 256, 384, (const bf16_t*)(ws + O_GUP), 512, 128, (bf16_t*)(ws + O_G), 512, lds))
  RUN(17, phase_rwkv_final(p))
  RUN(18, phase_gemm_big((const bf16_t*)(ws + O_MIX), (const bf16_t*)(ws + O_WOUT1), 1024, 1024, (bf16_t*)(ws + O_HN), 1024, 0, ws, shm, 49152))
  RUN(19, phase_resnorm<true>(p, p.post_mix_g + 1024, p.pre_ffn_g + 1024))
  RUN(20, phase_gemm_gateup((const bf16_t*)(ws + O_HN), (const bf16_t*)(ws + O_WGU1), (bf16_t*)(ws + O_ACT), shm, 49152))
  RUN(21, phase_gemm_big((const bf16_t*)(ws + O_ACT), (const bf16_t*)(ws + O_WD1), 1024, DFF, (bf16_t*)(ws + O_HN), 1024, 0, ws, shm, 49152))
  RUN(22, phase_resnorm<true>(p, p.post_ffn_g + 1024, nullptr))
#undef RUN
}

extern "C" void kernel_launch(void* const* d_in, const int* in_sizes, int n_in, void* d_out, int out_size, void* d_ws, size_t ws_size,
                              hipStream_t stream) {
  static int grid_blocks = 0;
  if (!grid_blocks) {
    int dev = 0, cus = 0, per_cu = 0;
    (void)hipGetDevice(&dev);
    (void)hipDeviceGetAttribute(&cus, hipDeviceAttributeMultiprocessorCount, dev);
    if (hipFuncSetAttribute((const void*)mega, hipFuncAttributeMaxDynamicSharedMemorySize, LDS_BYTES) != hipSuccess) fprintf(stderr, "hipFuncSetAttribute failed\n");
    if (hipOccupancyMaxActiveBlocksPerMultiprocessor(&per_cu, (const void*)mega, NTH, LDS_BYTES) != hipSuccess || per_cu < 1) {
      fprintf(stderr, "occupancy query says %d\n", per_cu);
      (void)hipGetLastError();
    }
    grid_blocks = cus;
  }
  if (ws_size < O_BAR + CTL_BYTES) { fprintf(stderr, "workspace too small\n"); return; }
  if (hipMemsetAsync((char*)d_ws + O_BAR, 0, CTL_BYTES, stream) != hipSuccess) { fprintf(stderr, "memset failed\n"); return; }
  P p{};
  const float** f = (const float**)&p;
  for (int i = 0; i < 32; ++i) f[i] = (const float*)d_in[i];
  p.out = (float*)d_out;
  p.ws = (char*)d_ws;
#if FUSED
  p.ph0 = 0; p.ph1 = NPHASE;
  void* args[] = {&p};
  hipError_t e = hipLaunchCooperativeKernel((void*)mega, dim3(grid_blocks), dim3(NTH), args, LDS_BYTES, stream);
  if (e != hipSuccess) fprintf(stderr, "cooperative launch failed: %s (grid %d)\n", hipGetErrorString(e), grid_blocks);
#else
  for (int ph = 0; ph < NPHASE; ++ph) {
    p.ph0 = ph; p.ph1 = ph + 1;
    hipLaunchKernelGGL(mega, dim3(grid_blocks), dim3(NTH), LDS_BYTES, stream, p);
  }
#endif
}
```
